# Optimizing an MI355X kernel written in HIP

```python
import jax, jax.numpy as jnp
from jax import lax
import numpy as np

D_MODEL = 1024
BATCH = 8
SEQ = 2048
DEPTH = 1

CHUNK = 64
N_META = 16
EPS = 1e-6

D_MIX = D_MODEL
M_HEADS = 4
M_HEAD_DIM = (D_MIX // 2) // M_HEADS
M_WIDTH = M_HEADS * M_HEAD_DIM
CONV_W = 4
F_HEADS = 8
F_HEAD_DIM = (D_MIX - M_WIDTH) // F_HEADS
F_WIDTH = F_HEADS * F_HEAD_DIM
Q_BLOCK = 128

PROJ_SIZES = (M_WIDTH, M_WIDTH, M_WIDTH, M_WIDTH, M_HEADS, M_HEADS, F_WIDTH, F_WIDTH, F_WIDTH, F_HEADS)
PROJ_DIM = 4 * M_WIDTH + 2 * M_HEADS + 3 * F_WIDTH + F_HEADS

PEER_HEADS = 8
N_KEYS = 128
N_EXPERTS = N_KEYS * N_KEYS
PEER_TOPK = 16
PEER_QDIM = 256
PEER_HALF = PEER_QDIM // 2
PEER_TOKEN_BLOCK = 128

kernel_name = "hybrid_mlstm_fox_peer_block"


def _rmsnorm(x, g):
    xf = x.astype(jnp.float32)
    y = xf * lax.rsqrt(jnp.mean(xf * xf, axis=-1, keepdims=True) + EPS)
    return (y * g.astype(jnp.float32)).astype(x.dtype)


def _proj_splits():
    out, acc = [], 0
    for s in PROJ_SIZES[:-1]:
        acc += s
        out.append(acc)
    return out


def _causal_dwconv(x, w):
    c = x.shape[-1]
    return lax.conv_general_dilated(
        x, w.astype(x.dtype)[:, None, :], window_strides=(1,),
        padding=[(CONV_W - 1, 0)], dimension_numbers=("NWC", "WIO", "NWC"),
        feature_group_count=c)


def _mlstm(q, k, v, o_pre, i_pre, f_pre, out_gain):
    f32 = jnp.float32
    B, L, _ = q.shape
    n_chunks = -(-L // CHUNK)
    pad = n_chunks * CHUNK - L

    def heads(t):
        t = jnp.pad(t.astype(f32), ((0, 0), (0, pad), (0, 0)))
        return t.reshape(B, n_chunks, CHUNK, M_HEADS, M_HEAD_DIM).transpose(1, 0, 3, 2, 4)

    def gates(t):
        t = jnp.pad(t.astype(f32), ((0, 0), (0, pad), (0, 0)))
        return t.reshape(B, n_chunks, CHUNK, M_HEADS).transpose(1, 0, 3, 2)

    qc = heads(q)
    kc = heads(k) * (M_HEAD_DIM ** -0.5)
    vc = heads(v)
    logi = gates(i_pre)
    logf = jax.nn.log_sigmoid(gates(f_pre))
    causal = jnp.asarray(np.tril(np.ones((CHUNK, CHUNK), dtype=bool)))

    def step(carry, inp):
        C, n, m = carry
        qb, kb, vb, li, lf = inp
        b = jnp.cumsum(lf, axis=-1)
        Dm = jnp.where(causal, b[..., :, None] - b[..., None, :] + li[..., None, :], -jnp.inf)
        m_inter = b + m[..., None]
        m_t = jnp.maximum(m_inter, jnp.max(Dm, axis=-1))
        S = jnp.einsum('bhtd,bhsd->bhts', qb, kb) * jnp.exp(Dm - m_t[..., None])
        w_inter = jnp.exp(m_inter - m_t)
        num = jnp.einsum('bhts,bhsd->bhtd', S, vb) + w_inter[..., None] * jnp.einsum('bhvk,bhtk->bhtv', C, qb)
        den = jnp.sum(S, axis=-1) + w_inter * jnp.einsum('bhk,bhtk->bht', n, qb)
        h = num / jnp.maximum(jnp.abs(den), jnp.exp(-m_t))[..., None]
        b_end = b[..., -1]
        g = b_end[..., None] - b + li
        m_new = jnp.maximum(b_end + m, jnp.max(g, axis=-1))
        decay = jnp.exp(b_end + m - m_new)
        wg = jnp.exp(g - m_new[..., None])
        C = decay[..., None, None] * C + jnp.einsum('bhs,bhsv,bhsk->bhvk', wg, vb, kb)
        n = decay[..., None] * n + jnp.einsum('bhs,bhsk->bhk', wg, kb)
        return (C, n, m_new), h

    init = (jnp.zeros((B, M_HEADS, M_HEAD_DIM, M_HEAD_DIM), f32),
            jnp.zeros((B, M_HEADS, M_HEAD_DIM), f32),
            jnp.zeros((B, M_HEADS), f32))
    _, h = lax.scan(step, init, (qc, kc, vc, logi, logf))
    h = h.transpose(1, 0, 3, 2, 4).reshape(B, n_chunks * CHUNK, M_HEADS, M_HEAD_DIM)[:, :L]
    h = _rmsnorm(h, out_gain.reshape(M_HEADS, M_HEAD_DIM)).reshape(B, L, M_WIDTH)
    h = h * jax.nn.sigmoid(o_pre.astype(f32))
    return h.astype(q.dtype)


def _forgetting_attention(q, k, v, f_pre, g_q, g_k):
    B, L, _ = q.shape

    def heads(t):
        return t.reshape(B, L, F_HEADS, F_HEAD_DIM).transpose(0, 2, 1, 3)

    qh = _rmsnorm(heads(q), g_q)
    kh = _rmsnorm(heads(k), g_k)
    vh = heads(v)
    c = jnp.cumsum(jax.nn.log_sigmoid(f_pre.astype(jnp.float32)), axis=1).transpose(0, 2, 1)
    scale = F_HEAD_DIM ** -0.5
    outs = []
    for start in range(0, L, Q_BLOCK):
        end = min(start + Q_BLOCK, L)
        logits = jnp.einsum('bhtd,bhsd->bhts', qh[:, :, start:end], kh[:, :, :end]).astype(jnp.float32) * scale
        logits = logits + c[:, :, start:end, None] - c[:, :, None, :end]
        mask = np.arange(start, end)[:, None] >= np.arange(end)[None, :]
        logits = jnp.where(mask, logits, -jnp.inf)
        p = jax.nn.softmax(logits, axis=-1).astype(vh.dtype)
        outs.append(jnp.einsum('bhts,bhsd->bhtd', p, vh[:, :, :end]))
    out = jnp.concatenate(outs, axis=2)
    return out.transpose(0, 2, 1, 3).reshape(B, L, F_WIDTH)


def _peer(x, w_query, sub_keys, u_emb, v_emb):
    B, L, D = x.shape
    T = B * L
    Tp = -(-T // PEER_TOKEN_BLOCK) * PEER_TOKEN_BLOCK
    xt = jnp.pad(x.reshape(T, D), ((0, Tp - T), (0, 0))).reshape(-1, PEER_TOKEN_BLOCK, D)
    keys32 = sub_keys.astype(jnp.float32)

    def block(xb):
        tb = xb.shape[0]
        qh = (xb @ w_query).astype(jnp.float32).reshape(tb, PEER_HEADS, 2, PEER_HALF)
        scores = jnp.einsum('thpc,hpnc->thpn', qh, keys32)
        val, idx = lax.top_k(scores, PEER_TOPK)
        cand = (val[:, :, 0, :, None] + val[:, :, 1, None, :]).reshape(tb, PEER_HEADS, PEER_TOPK * PEER_TOPK)
        cand_id = (idx[:, :, 0, :, None] * N_KEYS + idx[:, :, 1, None, :]).reshape(tb, PEER_HEADS, PEER_TOPK * PEER_TOPK)
        top_s, pos = lax.top_k(cand, PEER_TOPK)
        ids = jnp.take_along_axis(cand_id, pos, axis=-1).reshape(tb, PEER_HEADS * PEER_TOPK)
        gate = jax.nn.softmax(top_s, axis=-1).reshape(tb, PEER_HEADS * PEER_TOPK)
        u = u_emb[ids]
        act = jax.nn.gelu(jnp.einsum('ted,td->te', u, xb).astype(jnp.float32), approximate=False)
        w = (gate * act).astype(xb.dtype)
        return jnp.einsum('te,ted->td', w, v_emb[ids])

    out = lax.map(block, xt)
    return out.reshape(Tp, D)[:T].reshape(B, L, D)


def setup_inputs(seed: int = 0) -> dict:
    key = jax.random.key(seed)
    ks = jax.random.split(key, 20)
    f32 = jnp.float32
    nrm = lambda k, shape, s: jax.random.normal(k, shape, f32) * s
    fbias_m = jnp.broadcast_to(jnp.linspace(3.0, 6.0, M_HEADS, dtype=f32), (DEPTH, M_HEADS))
    fbias_f = jnp.broadcast_to(jnp.linspace(2.0, 6.0, F_HEADS, dtype=f32), (DEPTH, F_HEADS))
    return {
        "x": nrm(ks[0], (BATCH, SEQ, D_MODEL), 1.0),
        "meta_tokens": nrm(ks[1], (N_META, D_MODEL), 1.0),
        "norm_mix": 1.0 + nrm(ks[2], (DEPTH, D_MODEL), 0.02),
        "w_in": nrm(ks[3], (DEPTH, D_MODEL, PROJ_DIM), D_MODEL ** -0.5),
        "conv_qk": nrm(ks[4], (DEPTH, CONV_W, 2 * M_WIDTH), CONV_W ** -0.5),
        "b_igate": nrm(ks[5], (DEPTH, M_HEADS), 0.1),
        "b_fgate_m": fbias_m + nrm(ks[6], (DEPTH, M_HEADS), 0.1),
        "m_out_norm": 1.0 + nrm(ks[7], (DEPTH, M_WIDTH), 0.02),
        "b_fgate_f": fbias_f + nrm(ks[8], (DEPTH, F_HEADS), 0.1),
        "f_q_norm": 1.0 + nrm(ks[9], (DEPTH, F_HEAD_DIM), 0.02),
        "f_k_norm": 1.0 + nrm(ks[10], (DEPTH, F_HEAD_DIM), 0.02),
        "w_out": nrm(ks[11], (DEPTH, D_MIX, D_MODEL), D_MIX ** -0.5),
        "norm_ffn": 1.0 + nrm(ks[12], (DEPTH, D_MODEL), 0.02),
        "peer_query": nrm(ks[13], (DEPTH, D_MODEL, PEER_HEADS * PEER_QDIM), D_MODEL ** -0.5),
        "peer_sub_keys": nrm(ks[14], (DEPTH, PEER_HEADS, 2, N_KEYS, PEER_HALF), PEER_HALF ** -0.5),
        "peer_u": nrm(ks[15], (DEPTH, N_EXPERTS, D_MODEL), D_MODEL ** -0.5),
        "peer_v": nrm(ks[16], (DEPTH, N_EXPERTS, D_MODEL), 0.1),
    }


def reference(x, meta_tokens, norm_mix, w_in, conv_qk, b_igate, b_fgate_m, m_out_norm,
              b_fgate_f, f_q_norm, f_k_norm, w_out, norm_ffn, peer_query, peer_sub_keys,
              peer_u, peer_v):
    B = x.shape[0]
    meta = jnp.broadcast_to(meta_tokens.astype(x.dtype)[None], (B, N_META, D_MODEL))
    h_res = jnp.concatenate([meta, x], axis=1)
    splits = _proj_splits()
    for layer in range(DEPTH):
        hn = _rmsnorm(h_res, norm_mix[layer])
        z = hn @ w_in[layer]
        mq, mk, mv, mo, mi, mf, fq, fk, fv, ff = jnp.split(z, splits, axis=-1)
        qk = jax.nn.silu(_causal_dwconv(jnp.concatenate([mq, mk], axis=-1), conv_qk[layer]))
        mq, mk = jnp.split(qk, 2, axis=-1)
        y_m = _mlstm(mq, mk, mv, mo, mi + b_igate[layer], mf + b_fgate_m[layer], m_out_norm[layer])
        y_f = _forgetting_attention(fq, fk, fv, ff + b_fgate_f[layer], f_q_norm[layer], f_k_norm[layer])
        h_res = h_res + jnp.concatenate([y_m, y_f], axis=-1) @ w_out[layer]
        if layer == DEPTH - 1:
            h_res = h_res[:, N_META:]
        h_res = h_res + _peer(_rmsnorm(h_res, norm_ffn[layer]), peer_query[layer],
                              peer_sub_keys[layer], peer_u[layer], peer_v[layer])
    return h_res
```

```cpp
#include <hip/hip_runtime.h>
#include <stdint.h>
#include <stdio.h>

namespace {

constexpr int NB = 8, SEQ = 2048, DM = 1024, NMETA = 16, L = SEQ + NMETA;
constexpr int T1 = NB * L;
constexpr int T2 = NB * SEQ;
constexpr int NZ = 3584;
constexpr int ZC_MQ = 0, ZC_MK = 512, ZC_MV = 1024, ZC_MO = 1536, ZC_FQ = 2048, ZC_FK = 2560, ZC_FV = 3072;
constexpr int PROJ = 3600;
constexpr float EPS = 1e-6f;

constexpr size_t WS_CTL = 0;
constexpr size_t WS_RA = 65536;
constexpr size_t WS_Z = WS_RA + (size_t)T1 * DM * 2;
constexpr size_t WS_GATES = WS_Z + (size_t)T1 * NZ * 2;
constexpr size_t WS_CUM = WS_GATES + (size_t)T1 * 16 * 4;
constexpr size_t WS_BT1 = WS_CUM + (size_t)NB * 8 * L * 4;
constexpr size_t WS_BT2 = WS_BT1 + (size_t)NZ * DM * 2;
constexpr size_t WS_BT3 = WS_BT2 + (size_t)DM * DM * 2;
constexpr size_t WS_KEYS = WS_BT3 + (size_t)2048 * DM * 2;
constexpr size_t WS_U = WS_KEYS + (size_t)16 * 128 * 128 * 2;
constexpr size_t WS_V = WS_U + (size_t)16384 * DM * 2;
constexpr size_t WS_END = WS_V + (size_t)16384 * DM * 2;
constexpr size_t WS_XN = WS_Z;
constexpr size_t WS_QP = WS_Z + (size_t)T2 * DM * 2;

typedef unsigned short bf16_t;
typedef short bf16x8 __attribute__((ext_vector_type(8)));
typedef float f32x4 __attribute__((ext_vector_type(4)));
typedef __attribute__((ext_vector_type(2))) __bf16 bf16x2_t;

struct Params {
    const float* x; const float* meta; const float* norm_mix; const float* w_in; const float* conv_qk;
    const float* b_igate; const float* b_fgate_m; const float* m_out_norm; const float* b_fgate_f;
    const float* f_q_norm; const float* f_k_norm; const float* w_out; const float* norm_ffn;
    const float* peer_query; const float* peer_keys; const float* peer_u; const float* peer_v;
    float* out; unsigned char* ws;
};

__device__ __forceinline__ unsigned f2bf(float f) { unsigned u = __float_as_uint(f); return (u + 0x7fffu + ((u >> 16) & 1u)) >> 16; }
__device__ __forceinline__ float bf2f(unsigned h) { return __uint_as_float(h << 16); }
__device__ __forceinline__ unsigned pk2(float lo, float hi) { return f2bf(lo) | (f2bf(hi) << 16); }
__device__ __forceinline__ float bflo(unsigned w) { return __uint_as_float(w << 16); }
__device__ __forceinline__ float bfhi(unsigned w) { return __uint_as_float(w & 0xffff0000u); }
__device__ __forceinline__ float wave_sum(float v) {
#pragma unroll
    for (int o = 32; o > 0; o >>= 1) v += __shfl_xor(v, o, 64);
    return v;
}
__device__ __forceinline__ float wave_max(float v) {
#pragma unroll
    for (int o = 32; o > 0; o >>= 1) v = fmaxf(v, __shfl_xor(v, o, 64));
    return v;
}
__device__ __forceinline__ float logsigmoidf(float x) { return fminf(x, 0.f) - log1pf(expf(-fabsf(x))); }
__device__ __forceinline__ unsigned ord_key(float f) { unsigned u = __float_as_uint(f); return u ^ ((u >> 31) ? 0xffffffffu : 0x80000000u); }
__device__ __forceinline__ float unord_key(unsigned k) { unsigned u = (k & 0x80000000u) ? (k ^ 0x80000000u) : ~k; return __uint_as_float(u); }

__global__ void __launch_bounds__(256) k_prep_rows(Params P) {
    extern __shared__ __attribute__((aligned(16))) unsigned char smem[];
    float* gw = (float*)smem;
    const int tid = threadIdx.x, lane = tid & 63, wave = tid >> 6;
    for (int idx = tid; idx < 16 * 1024; idx += 256) {
        const int k = idx >> 4, c = idx & 15;
        const int col = c < 8 ? 2048 + c : 3592 + (c - 8);
        gw[c * 1024 + k] = P.w_in[(size_t)k * PROJ + col];
    }
    __syncthreads();
    bf16_t* hn = (bf16_t*)(P.ws + WS_RA);
    float* gates = (float*)(P.ws + WS_GATES);
    const int c0 = lane * 8, c1 = 512 + lane * 8;
    float g[16];
    {
        const float4 a0 = *(const float4*)(P.norm_mix + c0), a1 = *(const float4*)(P.norm_mix + c0 + 4);
        const float4 a2 = *(const float4*)(P.norm_mix + c1), a3 = *(const float4*)(P.norm_mix + c1 + 4);
        g[0] = a0.x; g[1] = a0.y; g[2] = a0.z; g[3] = a0.w; g[4] = a1.x; g[5] = a1.y; g[6] = a1.z; g[7] = a1.w;
        g[8] = a2.x; g[9] = a2.y; g[10] = a2.z; g[11] = a2.w; g[12] = a3.x; g[13] = a3.y; g[14] = a3.z; g[15] = a3.w;
    }
    for (int r = blockIdx.x * 4 + wave; r < T1; r += gridDim.x * 4) {
        const int b = r / L, p = r - b * L;
        const float* src = (p < NMETA) ? (P.meta + (size_t)p * DM) : (P.x + ((size_t)b * SEQ + (p - NMETA)) * DM);
        float v[16];
        {
            const float4 a0 = *(const float4*)(src + c0), a1 = *(const float4*)(src + c0 + 4);
            const float4 a2 = *(const float4*)(src + c1), a3 = *(const float4*)(src + c1 + 4);
            v[0] = a0.x; v[1] = a0.y; v[2] = a0.z; v[3] = a0.w; v[4] = a1.x; v[5] = a1.y; v[6] = a1.z; v[7] = a1.w;
            v[8] = a2.x; v[9] = a2.y; v[10] = a2.z; v[11] = a2.w; v[12] = a3.x; v[13] = a3.y; v[14] = a3.z; v[15] = a3.w;
        }
        float ss = 0.f;
#pragma unroll
        for (int j = 0; j < 16; ++j) ss += v[j] * v[j];
        ss = wave_sum(ss);
        const float rstd = rsqrtf(ss * (1.0f / DM) + EPS);
#pragma unroll
        for (int j = 0; j < 16; ++j) v[j] = v[j] * rstd * g[j];
        uint4 o0, o1;
        o0.x = pk2(v[0], v[1]); o0.y = pk2(v[2], v[3]); o0.z = pk2(v[4], v[5]); o0.w = pk2(v[6], v[7]);
        o1.x = pk2(v[8], v[9]); o1.y = pk2(v[10], v[11]); o1.z = pk2(v[12], v[13]); o1.w = pk2(v[14], v[15]);
        *(uint4*)(hn + (size_t)r * DM + c0) = o0;
        *(uint4*)(hn + (size_t)r * DM + c1) = o1;
        float mine = 0.f;
#pragma unroll
        for (int c = 0; c < 16; ++c) {
            const float* gwc = gw + c * 1024;
            float s = 0.f;
#pragma unroll
            for (int j = 0; j < 8; ++j) s += v[j] * gwc[c0 + j];
#pragma unroll
            for (int j = 0; j < 8; ++j) s += v[8 + j] * gwc[c1 + j];
            s = wave_sum(s);
            if (lane == c) mine = s;
        }
        if (lane < 16) {
            float val;
            if (lane < 4) val = mine + P.b_igate[lane];
            else if (lane < 8) val = logsigmoidf(mine + P.b_fgate_m[lane - 4]);
            else val = logsigmoidf(mine + P.b_fgate_f[lane - 8]);
            gates[(size_t)r * 16 + lane] = val;
        }
    }
}

__global__ void __launch_bounds__(256) k_transpose(const float* __restrict__ W, int ldn, int N, int colshift_from, int colshift, bf16_t* __restrict__ out) {
    __shared__ float tile[64][65];
    const int tid = threadIdx.x;
    const int ntn = N / 64;
    const int tk = blockIdx.x / ntn, tn = blockIdx.x % ntn;
    const int k0 = tk * 64, n0 = tn * 64;
    {
        const int nl = tid & 63;
        int n = n0 + nl; if (n >= colshift_from) n += colshift;
#pragma unroll
        for (int i = 0; i < 16; ++i) { const int kl = (tid >> 6) + 4 * i; tile[kl][nl] = W[(size_t)(k0 + kl) * ldn + n]; }
    }
    __syncthreads();
    {
        const int kl = tid & 63;
#pragma unroll
        for (int i = 0; i < 16; ++i) { const int nl = (tid >> 6) + 4 * i; out[(size_t)(n0 + nl) * 1024 + k0 + kl] = (bf16_t)f2bf(tile[kl][nl]); }
    }
}

__global__ void __launch_bounds__(256) k_convert(const float* __restrict__ src, bf16_t* __restrict__ dst, size_t n8) {
    for (size_t i = (size_t)blockIdx.x * 256 + threadIdx.x; i < n8; i += (size_t)gridDim.x * 256) {
        const float4 a = *(const float4*)(src + i * 8), b = *(const float4*)(src + i * 8 + 4);
        uint4 o; o.x = pk2(a.x, a.y); o.y = pk2(a.z, a.w); o.z = pk2(b.x, b.y); o.w = pk2(b.z, b.w);
        *(uint4*)(dst + i * 8) = o;
    }
}

template <int MODE>
__device__ __forceinline__ void gemm_tile(const Params& P, int tm, int tn, unsigned char* smem) {
    const bf16_t* A; const bf16_t* Bt;
    if (MODE == 1) { A = (const bf16_t*)(P.ws + WS_RA); Bt = (const bf16_t*)(P.ws + WS_BT1); }
    else if (MODE == 2) { A = (const bf16_t*)(P.ws + WS_RA); Bt = (const bf16_t*)(P.ws + WS_BT2); }
    else { A = (const bf16_t*)(P.ws + WS_XN); Bt = (const bf16_t*)(P.ws + WS_BT3); }
    const int tid = threadIdx.x, lane = tid & 63, wave = tid >> 6, wr = wave >> 1, wc = wave & 1, g = lane >> 4, lr = lane & 15;
    const int m0 = tm * 128, n0 = tn * 128;
    const int srow = tid >> 3, sc = tid & 7;
    const bf16_t* aptr[4]; const bf16_t* bptr[4]; int soff[4];
#pragma unroll
    for (int j = 0; j < 4; ++j) {
        const int row = srow + 32 * j;
        int ar = m0 + row;
        if (MODE == 2) { const int b = ar >> 11, t = ar & 2047; ar = b * L + NMETA + t; }
        aptr[j] = A + (size_t)ar * 1024 + sc * 8;
        bptr[j] = Bt + (size_t)(n0 + row) * 1024 + sc * 8;
        soff[j] = row * 128 + ((sc ^ (row & 7)) << 4);
    }
    f32x4 acc[4][4];
#pragma unroll
    for (int i = 0; i < 4; ++i)
#pragma unroll
        for (int j = 0; j < 4; ++j) acc[i][j] = (f32x4){0.f, 0.f, 0.f, 0.f};
    uint4 ra[4], rb[4];
#pragma unroll
    for (int j = 0; j < 4; ++j) { ra[j] = *(const uint4*)(aptr[j]); rb[j] = *(const uint4*)(bptr[j]); }
    unsigned char* sA0 = smem; unsigned char* sB0 = smem + 16384; unsigned char* sA1 = smem + 32768; unsigned char* sB1 = smem + 49152;
#pragma unroll
    for (int j = 0; j < 4; ++j) { *(uint4*)(sA0 + soff[j]) = ra[j]; *(uint4*)(sB0 + soff[j]) = rb[j]; }
    __syncthreads();
    const int arow_off = (wr * 64 + lr) * 128, brow_off = (wc * 64 + lr) * 128, sw = lr & 7;
    for (int kt = 0; kt < 16; ++kt) {
        unsigned char* sA = (kt & 1) ? sA1 : sA0; unsigned char* sB = (kt & 1) ? sB1 : sB0;
        unsigned char* nA = (kt & 1) ? sA0 : sA1; unsigned char* nB = (kt & 1) ? sB0 : sB1;
        if (kt < 15) {
#pragma unroll
            for (int j = 0; j < 4; ++j) { ra[j] = *(const uint4*)(aptr[j] + (kt + 1) * 64); rb[j] = *(const uint4*)(bptr[j] + (kt + 1) * 64); }
        }
#pragma unroll
        for (int s = 0; s < 2; ++s) {
            bf16x8 a[4], b[4];
            const int ch = (((s * 4 + g) ^ sw) << 4);
#pragma unroll
            for (int i = 0; i < 4; ++i) a[i] = *(const bf16x8*)(sA + arow_off + i * 2048 + ch);
#pragma unroll
            for (int j = 0; j < 4; ++j) b[j] = *(const bf16x8*)(sB + brow_off + j * 2048 + ch);
#pragma unroll
            for (int i = 0; i < 4; ++i)
#pragma unroll
                for (int j = 0; j < 4; ++j) acc[i][j] = __builtin_amdgcn_mfma_f32_16x16x32_bf16(a[i], b[j], acc[i][j], 0, 0, 0);
        }
        if (kt < 15) {
#pragma unroll
            for (int j = 0; j < 4; ++j) { *(uint4*)(nA + soff[j]) = ra[j]; *(uint4*)(nB + soff[j]) = rb[j]; }
        }
        __syncthreads();
    }
#pragma unroll
    for (int i = 0; i < 4; ++i)
#pragma unroll
        for (int j = 0; j < 4; ++j)
#pragma unroll
            for (int r = 0; r < 4; ++r) {
                const int row = m0 + wr * 64 + 16 * i + 4 * g + r, col = n0 + wc * 64 + 16 * j + lr;
                const float v = acc[i][j][r];
                if (MODE == 1) { ((bf16_t*)(P.ws + WS_Z))[(size_t)row * NZ + col] = (bf16_t)f2bf(v); }
                else if (MODE == 2) { P.out[(size_t)row * DM + col] = v + P.x[(size_t)row * DM + col]; }
                else { ((bf16_t*)(P.ws + WS_QP))[(size_t)row * 2048 + col] = (bf16_t)f2bf(v); }
            }
}

template <int MODE>
__global__ void __launch_bounds__(256) k_gemm(Params P, int ntn) {
    extern __shared__ __attribute__((aligned(16))) unsigned char smem[];
    const int tm = blockIdx.x / ntn, tn = blockIdx.x % ntn;
    gemm_tile<MODE>(P, tm, tn, smem);
}

__global__ void __launch_bounds__(256) k_fox_norm(Params P) {
    const int idx = blockIdx.x * 256 + threadIdx.x;
    if (idx >= T1 * 16) return;
    const int r = idx >> 4, wh = idx & 15, which = wh >> 3, h = wh & 7;
    bf16_t* zp = (bf16_t*)(P.ws + WS_Z) + (size_t)r * NZ + (which ? ZC_FK : ZC_FQ) + h * 64;
    const float* gain = which ? P.f_k_norm : P.f_q_norm;
    uint4 v[8];
#pragma unroll
    for (int i = 0; i < 8; ++i) v[i] = *(const uint4*)(zp + i * 8);
    float f[64];
#pragma unroll
    for (int i = 0; i < 8; ++i) {
        f[i * 8 + 0] = bflo(v[i].x); f[i * 8 + 1] = bfhi(v[i].x); f[i * 8 + 2] = bflo(v[i].y); f[i * 8 + 3] = bfhi(v[i].y);
        f[i * 8 + 4] = bflo(v[i].z); f[i * 8 + 5] = bfhi(v[i].z); f[i * 8 + 6] = bflo(v[i].w); f[i * 8 + 7] = bfhi(v[i].w);
    }
    float ss = 0.f;
#pragma unroll
    for (int i = 0; i < 64; ++i) ss += f[i] * f[i];
    const float rstd = rsqrtf(ss * (1.0f / 64.0f) + EPS) * (which ? 1.0f : 0.125f);
#pragma unroll
    for (int i = 0; i < 8; ++i) {
        uint4 o;
        o.x = pk2(f[i * 8 + 0] * rstd * gain[i * 8 + 0], f[i * 8 + 1] * rstd * gain[i * 8 + 1]);
        o.y = pk2(f[i * 8 + 2] * rstd * gain[i * 8 + 2], f[i * 8 + 3] * rstd * gain[i * 8 + 3]);
        o.z = pk2(f[i * 8 + 4] * rstd * gain[i * 8 + 4], f[i * 8 + 5] * rstd * gain[i * 8 + 5]);
        o.w = pk2(f[i * 8 + 6] * rstd * gain[i * 8 + 6], f[i * 8 + 7] * rstd * gain[i * 8 + 7]);
        *(uint4*)(zp + i * 8) = o;
    }
}

__global__ void __launch_bounds__(64) k_fox_cum(Params P) {
    const int bh = blockIdx.x, b = bh >> 3, h = bh & 7, lane = threadIdx.x;
    const float* gates = (const float*)(P.ws + WS_GATES);
    float* cum = (float*)(P.ws + WS_CUM) + (size_t)bh * L;
    constexpr int SEG = 33;
    const int t0 = lane * SEG;
    float loc = 0.f;
    for (int i = 0; i < SEG; ++i) { const int t = t0 + i; if (t < L) loc += gates[(size_t)(b * L + t) * 16 + 8 + h]; }
    float incl = loc;
#pragma unroll
    for (int o = 1; o < 64; o <<= 1) { const float n = __shfl_up(incl, o, 64); if (lane >= o) incl += n; }
    float run = incl - loc;
    for (int i = 0; i < SEG; ++i) { const int t = t0 + i; if (t < L) { run += gates[(size_t)(b * L + t) * 16 + 8 + h]; cum[t] = run; } }
}

__global__ void __launch_bounds__(256) k_attn_naive(Params P) {
    const int lane = threadIdx.x & 63;
    const int w = blockIdx.x * 4 + (threadIdx.x >> 6);
    if (w >= NB * 8 * L) return;
    const int bh = w / L, t = w - bh * L, b = bh >> 3, h = bh & 7;
    const bf16_t* z = (const bf16_t*)(P.ws + WS_Z);
    const float* cum = (const float*)(P.ws + WS_CUM) + (size_t)bh * L;
    float q[64];
    {
        const bf16_t* qp = z + (size_t)(b * L + t) * NZ + ZC_FQ + h * 64;
#pragma unroll
        for (int i = 0; i < 8; ++i) {
            const uint4 v = *(const uint4*)(qp + i * 8);
            q[i * 8 + 0] = bflo(v.x); q[i * 8 + 1] = bfhi(v.x); q[i * 8 + 2] = bflo(v.y); q[i * 8 + 3] = bfhi(v.y);
            q[i * 8 + 4] = bflo(v.z); q[i * 8 + 5] = bfhi(v.z); q[i * 8 + 6] = bflo(v.w); q[i * 8 + 7] = bfhi(v.w);
        }
    }
    const float ct = cum[t];
    float m = -INFINITY, lsum = 0.f;
    float acc[64];
#pragma unroll
    for (int i = 0; i < 64; ++i) acc[i] = 0.f;
    for (int s = lane; s <= t; s += 64) {
        const bf16_t* kp = z + (size_t)(b * L + s) * NZ + ZC_FK + h * 64;
        const bf16_t* vp = z + (size_t)(b * L + s) * NZ + ZC_FV + h * 64;
        float dot = 0.f;
#pragma unroll
        for (int i = 0; i < 8; ++i) {
            const uint4 v = *(const uint4*)(kp + i * 8);
            dot += q[i * 8 + 0] * bflo(v.x) + q[i * 8 + 1] * bfhi(v.x) + q[i * 8 + 2] * bflo(v.y) + q[i * 8 + 3] * bfhi(v.y)
                 + q[i * 8 + 4] * bflo(v.z) + q[i * 8 + 5] * bfhi(v.z) + q[i * 8 + 6] * bflo(v.w) + q[i * 8 + 7] * bfhi(v.w);
        }
        const float logit = dot + ct - cum[s];
        const float mn = fmaxf(m, logit);
        const float sc = __expf(m - mn), p = __expf(logit - mn);
        m = mn; lsum = lsum * sc + p;
#pragma unroll
        for (int i = 0; i < 8; ++i) {
            const uint4 v = *(const uint4*)(vp + i * 8);
            acc[i * 8 + 0] = acc[i * 8 + 0] * sc + p * bflo(v.x); acc[i * 8 + 1] = acc[i * 8 + 1] * sc + p * bfhi(v.x);
            acc[i * 8 + 2] = acc[i * 8 + 2] * sc + p * bflo(v.y); acc[i * 8 + 3] = acc[i * 8 + 3] * sc + p * bfhi(v.y);
            acc[i * 8 + 4] = acc[i * 8 + 4] * sc + p * bflo(v.z); acc[i * 8 + 5] = acc[i * 8 + 5] * sc + p * bfhi(v.z);
            acc[i * 8 + 6] = acc[i * 8 + 6] * sc + p * bflo(v.w); acc[i * 8 + 7] = acc[i * 8 + 7] * sc + p * bfhi(v.w);
        }
    }
    const float M = wave_max(m);
    const float fac = (m == -INFINITY) ? 0.f : __expf(m - M);
    const float ltot = wave_sum(lsum * fac);
    float mine = 0.f;
#pragma unroll
    for (int d = 0; d < 64; ++d) { const float s = wave_sum(acc[d] * fac); if (lane == d) mine = s; }
    bf16_t* y = (bf16_t*)(P.ws + WS_RA);
    y[(size_t)(b * L + t) * DM + 512 + h * 64 + lane] = (bf16_t)f2bf(mine / ltot);
}

__global__ void __launch_bounds__(256) k_mlstm_naive(Params P) {
    __shared__ float sq[128], sk[128], sv[128], red[8];
    const int tid = threadIdx.x, lane = tid & 63, wave = tid >> 6;
    const int b = blockIdx.x >> 2, h = blockIdx.x & 3;
    const int dv = tid >> 1, half = tid & 1;
    const bf16_t* z = (const bf16_t*)(P.ws + WS_Z);
    const float* gates = (const float*)(P.ws + WS_GATES);
    bf16_t* y = (bf16_t*)(P.ws + WS_RA);
    const int ch = tid & 127, isk = tid >> 7;
    const int zcol = (isk ? ZC_MK : ZC_MQ) + h * 128 + ch;
    const float w0 = P.conv_qk[0 * 1024 + zcol], w1 = P.conv_qk[1 * 1024 + zcol], w2 = P.conv_qk[2 * 1024 + zcol], w3 = P.conv_qk[3 * 1024 + zcol];
    const float gain = P.m_out_norm[h * 128 + dv];
    float x0 = 0.f, x1 = 0.f, x2 = 0.f;
    float C[64];
#pragma unroll
    for (int j = 0; j < 64; ++j) C[j] = 0.f;
    float nval = 0.f, m = 0.f;
    size_t r = (size_t)b * L;
    float xt_n = bf2f(z[r * NZ + zcol]);
    float v_n = (tid < 128) ? bf2f(z[r * NZ + ZC_MV + h * 128 + tid]) : 0.f;
    float li_n = gates[r * 16 + h], lf_n = gates[r * 16 + 4 + h];
    float o_n = bf2f(z[r * NZ + ZC_MO + h * 128 + dv]);
    for (int t = 0; t < L; ++t) {
        const float xt = xt_n, vcur = v_n, li = li_n, lf = lf_n, ocur = o_n;
        r = (size_t)b * L + t;
        if (t + 1 < L) {
            const size_t rn = r + 1;
            xt_n = bf2f(z[rn * NZ + zcol]);
            if (tid < 128) v_n = bf2f(z[rn * NZ + ZC_MV + h * 128 + tid]);
            li_n = gates[rn * 16 + h]; lf_n = gates[rn * 16 + 4 + h];
            o_n = bf2f(z[rn * NZ + ZC_MO + h * 128 + dv]);
        }
        const float cv = w0 * x0 + w1 * x1 + w2 * x2 + w3 * xt;
        x0 = x1; x1 = x2; x2 = xt;
        const float sil = cv / (1.f + __expf(-cv));
        if (isk) sk[ch] = sil * 0.08838834764831845f; else sq[ch] = sil;
        if (tid < 128) sv[tid] = vcur;
        __syncthreads();
        const float m_new = fmaxf(lf + m, li);
        const float ip = __expf(li - m_new), fp = __expf(lf + m - m_new);
        m = m_new;
        const float vv = sv[dv] * ip;
        float part = 0.f;
#pragma unroll
        for (int j = 0; j < 64; ++j) { const int dk = half * 64 + j; C[j] = fp * C[j] + vv * sk[dk]; part += C[j] * sq[dk]; }
        part += __shfl_xor(part, 1, 64);
        float dn = 0.f;
        if (tid < 128) { nval = fp * nval + ip * sk[tid]; dn = nval * sq[tid]; }
        dn = wave_sum(dn);
        if (lane == 0) red[wave] = dn;
        __syncthreads();
        const float den = red[0] + red[1] + red[2] + red[3];
        const float hval = part / fmaxf(fabsf(den), __expf(-m));
        float sqv = half == 0 ? hval * hval : 0.f;
        sqv = wave_sum(sqv);
        if (lane == 0) red[4 + wave] = sqv;
        __syncthreads();
        const float ssq = red[4] + red[5] + red[6] + red[7];
        const float rstd = rsqrtf(ssq * (1.0f / 128.0f) + EPS);
        if (half == 0) {
            const float yv = hval * rstd * gain * (1.f / (1.f + __expf(-ocur)));
            y[r * DM + h * 128 + dv] = (bf16_t)f2bf(yv);
        }
    }
}

__global__ void __launch_bounds__(256) k_xn(Params P) {
    const int lane = threadIdx.x & 63;
    const int r = blockIdx.x * 4 + (threadIdx.x >> 6);
    if (r >= T2) return;
    const float* src = P.out + (size_t)r * DM;
    const int c0 = lane * 8, c1 = 512 + lane * 8;
    float v[16], g[16];
    {
        const float4 a0 = *(const float4*)(src + c0), a1 = *(const float4*)(src + c0 + 4), a2 = *(const float4*)(src + c1), a3 = *(const float4*)(src + c1 + 4);
        v[0] = a0.x; v[1] = a0.y; v[2] = a0.z; v[3] = a0.w; v[4] = a1.x; v[5] = a1.y; v[6] = a1.z; v[7] = a1.w;
        v[8] = a2.x; v[9] = a2.y; v[10] = a2.z; v[11] = a2.w; v[12] = a3.x; v[13] = a3.y; v[14] = a3.z; v[15] = a3.w;
        const float4 b0 = *(const float4*)(P.norm_ffn + c0), b1 = *(const float4*)(P.norm_ffn + c0 + 4), b2 = *(const float4*)(P.norm_ffn + c1), b3 = *(const float4*)(P.norm_ffn + c1 + 4);
        g[0] = b0.x; g[1] = b0.y; g[2] = b0.z; g[3] = b0.w; g[4] = b1.x; g[5] = b1.y; g[6] = b1.z; g[7] = b1.w;
        g[8] = b2.x; g[9] = b2.y; g[10] = b2.z; g[11] = b2.w; g[12] = b3.x; g[13] = b3.y; g[14] = b3.z; g[15] = b3.w;
    }
    float ss = 0.f;
#pragma unroll
    for (int j = 0; j < 16; ++j) ss += v[j] * v[j];
    ss = wave_sum(ss);
    const float rstd = rsqrtf(ss * (1.0f / DM) + EPS);
#pragma unroll
    for (int j = 0; j < 16; ++j) v[j] = v[j] * rstd * g[j];
    uint4 o0, o1;
    o0.x = pk2(v[0], v[1]); o0.y = pk2(v[2], v[3]); o0.z = pk2(v[4], v[5]); o0.w = pk2(v[6], v[7]);
    o1.x = pk2(v[8], v[9]); o1.y = pk2(v[10], v[11]); o1.z = pk2(v[12], v[13]); o1.w = pk2(v[14], v[15]);
    bf16_t* xn = (bf16_t*)(P.ws + WS_XN);
    *(uint4*)(xn + (size_t)r * DM + c0) = o0;
    *(uint4*)(xn + (size_t)r * DM + c1) = o1;
}

__global__ void __launch_bounds__(256) k_scores_topk(Params P) {
    __shared__ float sqv[16][128];
    __shared__ float ssc[16][129];
    const int tid = threadIdx.x;
    const int hp = blockIdx.x & 15, tt0 = (blockIdx.x >> 4) * 16;
    const bf16_t* qp = (const bf16_t*)(P.ws + WS_QP);
    const bf16_t* keys = (const bf16_t*)(P.ws + WS_KEYS) + (size_t)hp * 128 * 128;
    for (int i = tid; i < 16 * 128; i += 256) { const int tt = i >> 7, c = i & 127; sqv[tt][c] = bf2f(qp[(size_t)(tt0 + tt) * 2048 + hp * 128 + c]); }
    const int n = tid & 127, tg = tid >> 7;
    float kr[128];
#pragma unroll
    for (int i = 0; i < 16; ++i) {
        const uint4 v = *(const uint4*)(keys + (size_t)n * 128 + i * 8);
        kr[i * 8 + 0] = bflo(v.x); kr[i * 8 + 1] = bfhi(v.x); kr[i * 8 + 2] = bflo(v.y); kr[i * 8 + 3] = bfhi(v.y);
        kr[i * 8 + 4] = bflo(v.z); kr[i * 8 + 5] = bfhi(v.z); kr[i * 8 + 6] = bflo(v.w); kr[i * 8 + 7] = bfhi(v.w);
    }
    __syncthreads();
    for (int j = 0; j < 8; ++j) {
        const int tt = tg * 8 + j;
        float s = 0.f;
#pragma unroll
        for (int c = 0; c < 128; ++c) s += sqv[tt][c] * kr[c];
        ssc[tt][n] = s;
    }
    __syncthreads();
    if (tid < 16) {
        unsigned top[16];
#pragma unroll
        for (int i = 0; i < 16; ++i) top[i] = 0u;
        for (int c = 0; c < 128; ++c) {
            unsigned kx = (ord_key(ssc[tid][c]) & ~127u) | (unsigned)(127 - c);
#pragma unroll
            for (int i = 0; i < 16; ++i) { const unsigned hi = max(top[i], kx), lo = min(top[i], kx); top[i] = hi; kx = lo; }
        }
        unsigned* tk = (unsigned*)(P.ws + WS_RA) + ((size_t)(tt0 + tid) * 16 + hp) * 16;
#pragma unroll
        for (int i = 0; i < 16; ++i) tk[i] = top[i];
    }
}

__global__ void __launch_bounds__(256) k_peer(Params P) {
    __shared__ int sidx[4][256];
    __shared__ float sval[4][256];
    __shared__ int sid[4][128];
    __shared__ float sgate[4][128];
    const int lane = threadIdx.x & 63, wave = threadIdx.x >> 6;
    const int t = blockIdx.x * 4 + wave;
    if (t >= T2) return;
    const unsigned* tk = (const unsigned*)(P.ws + WS_RA) + (size_t)t * 256;
#pragma unroll
    for (int i = 0; i < 4; ++i) {
        const unsigned k = tk[lane * 4 + i];
        sidx[wave][lane * 4 + i] = 127 - (int)(k & 127u);
        sval[wave][lane * 4 + i] = unord_key(k & ~127u);
    }
    __builtin_amdgcn_s_waitcnt(0xc07f);
    __builtin_amdgcn_wave_barrier();
    if (lane < 8) {
        const int hd = lane;
        float v0[16], v1[16];
#pragma unroll
        for (int i = 0; i < 16; ++i) { v0[i] = sval[wave][(2 * hd) * 16 + i]; v1[i] = sval[wave][(2 * hd + 1) * 16 + i]; }
        unsigned top[16];
#pragma unroll
        for (int i = 0; i < 16; ++i) top[i] = 0u;
#pragma unroll
        for (int i = 0; i < 16; ++i)
#pragma unroll
            for (int j = 0; j < 16; ++j)
                if ((i + 1) * (j + 1) <= 16) {
                    unsigned kx = (ord_key(v0[i] + v1[j]) & ~255u) | (unsigned)(255 - (i * 16 + j));
#pragma unroll
                    for (int q = 0; q < 16; ++q) { const unsigned hi = max(top[q], kx), lo = min(top[q], kx); top[q] = hi; kx = lo; }
                }
        const float smax = unord_key(top[0] & ~255u);
        float e[16]; float den = 0.f;
#pragma unroll
        for (int q = 0; q < 16; ++q) { e[q] = __expf(unord_key(top[q] & ~255u) - smax); den += e[q]; }
        const float inv = 1.f / den;
#pragma unroll
        for (int q = 0; q < 16; ++q) {
            const int pos = 255 - (int)(top[q] & 255u), i = pos >> 4, j = pos & 15;
            sid[wave][hd * 16 + q] = sidx[wave][(2 * hd) * 16 + i] * 128 + sidx[wave][(2 * hd + 1) * 16 + j];
            sgate[wave][hd * 16 + q] = e[q] * inv;
        }
    }
    __builtin_amdgcn_s_waitcnt(0xc07f);
    __builtin_amdgcn_wave_barrier();
    const bf16_t* xn = (const bf16_t*)(P.ws + WS_XN) + (size_t)t * DM;
    const bf16_t* U = (const bf16_t*)(P.ws + WS_U);
    const bf16_t* V = (const bf16_t*)(P.ws + WS_V);
    const int c0 = lane * 8, c1 = 512 + lane * 8;
    const uint4 xa = *(const uint4*)(xn + c0), xb = *(const uint4*)(xn + c1);
    float xf[16];
    xf[0] = bflo(xa.x); xf[1] = bfhi(xa.x); xf[2] = bflo(xa.y); xf[3] = bfhi(xa.y); xf[4] = bflo(xa.z); xf[5] = bfhi(xa.z); xf[6] = bflo(xa.w); xf[7] = bfhi(xa.w);
    xf[8] = bflo(xb.x); xf[9] = bfhi(xb.x); xf[10] = bflo(xb.y); xf[11] = bfhi(xb.y); xf[12] = bflo(xb.z); xf[13] = bfhi(xb.z); xf[14] = bflo(xb.w); xf[15] = bfhi(xb.w);
    float acc[16];
#pragma unroll
    for (int j = 0; j < 16; ++j) acc[j] = 0.f;
    for (int e0 = 0; e0 < 128; e0 += 4) {
        uint4 ua[4], ub[4], va[4], vb[4];
#pragma unroll
        for (int q = 0; q < 4; ++q) {
            const int id = sid[wave][e0 + q];
            ua[q] = *(const uint4*)(U + (size_t)id * DM + c0); ub[q] = *(const uint4*)(U + (size_t)id * DM + c1);
            va[q] = *(const uint4*)(V + (size_t)id * DM + c0); vb[q] = *(const uint4*)(V + (size_t)id * DM + c1);
        }
#pragma unroll
        for (int q = 0; q < 4; ++q) {
            float d = xf[0] * bflo(ua[q].x) + xf[1] * bfhi(ua[q].x) + xf[2] * bflo(ua[q].y) + xf[3] * bfhi(ua[q].y)
                    + xf[4] * bflo(ua[q].z) + xf[5] * bfhi(ua[q].z) + xf[6] * bflo(ua[q].w) + xf[7] * bfhi(ua[q].w)
                    + xf[8] * bflo(ub[q].x) + xf[9] * bfhi(ub[q].x) + xf[10] * bflo(ub[q].y) + xf[11] * bfhi(ub[q].y)
                    + xf[12] * bflo(ub[q].z) + xf[13] * bfhi(ub[q].z) + xf[14] * bflo(ub[q].w) + xf[15] * bfhi(ub[q].w);
            d = wave_sum(d);
            const float ge = 0.5f * d * (1.f + erff(d * 0.70710678118654752f));
            const float w = sgate[wave][e0 + q] * ge;
            acc[0] += w * bflo(va[q].x); acc[1] += w * bfhi(va[q].x); acc[2] += w * bflo(va[q].y); acc[3] += w * bfhi(va[q].y);
            acc[4] += w * bflo(va[q].z); acc[5] += w * bfhi(va[q].z); acc[6] += w * bflo(va[q].w); acc[7] += w * bfhi(va[q].w);
            acc[8] += w * bflo(vb[q].x); acc[9] += w * bfhi(vb[q].x); acc[10] += w * bflo(vb[q].y); acc[11] += w * bfhi(vb[q].y);
            acc[12] += w * bflo(vb[q].z); acc[13] += w * bfhi(vb[q].z); acc[14] += w * bflo(vb[q].w); acc[15] += w * bfhi(vb[q].w);
        }
    }
    float* o = P.out + (size_t)t * DM;
    float4 h0 = *(float4*)(o + c0), h1 = *(float4*)(o + c0 + 4), h2 = *(float4*)(o + c1), h3 = *(float4*)(o + c1 + 4);
    h0.x += acc[0]; h0.y += acc[1]; h0.z += acc[2]; h0.w += acc[3]; h1.x += acc[4]; h1.y += acc[5]; h1.z += acc[6]; h1.w += acc[7];
    h2.x += acc[8]; h2.y += acc[9]; h2.z += acc[10]; h2.w += acc[11]; h3.x += acc[12]; h3.y += acc[13]; h3.z += acc[14]; h3.w += acc[15];
    *(float4*)(o + c0) = h0; *(float4*)(o + c0 + 4) = h1; *(float4*)(o + c1) = h2; *(float4*)(o + c1 + 4) = h3;
}

}

extern "C" void kernel_launch(void* const* d_in, const int* in_sizes, int n_in, void* d_out, int out_size, void* d_ws, size_t ws_size, hipStream_t stream) {
    if (n_in != 17 || ws_size < WS_END) { fprintf(stderr, "kernel_launch: unexpected n_in %d or ws_size %zu (need %zu)\n", n_in, ws_size, (size_t)WS_END); return; }
    Params P{};
    P.x = (const float*)d_in[0]; P.meta = (const float*)d_in[1]; P.norm_mix = (const float*)d_in[2]; P.w_in = (const float*)d_in[3];
    P.conv_qk = (const float*)d_in[4]; P.b_igate = (const float*)d_in[5]; P.b_fgate_m = (const float*)d_in[6]; P.m_out_norm = (const float*)d_in[7];
    P.b_fgate_f = (const float*)d_in[8]; P.f_q_norm = (const float*)d_in[9]; P.f_k_norm = (const float*)d_in[10]; P.w_out = (const float*)d_in[11];
    P.norm_ffn = (const float*)d_in[12]; P.peer_query = (const float*)d_in[13]; P.peer_keys = (const float*)d_in[14]; P.peer_u = (const float*)d_in[15];
    P.peer_v = (const float*)d_in[16]; P.out = (float*)d_out; P.ws = (unsigned char*)d_ws;
    static bool attr_done = false;
    if (!attr_done) {
        hipFuncSetAttribute((const void*)k_prep_rows, hipFuncAttributeMaxDynamicSharedMemorySize, 65536);
        hipFuncSetAttribute((const void*)k_gemm<1>, hipFuncAttributeMaxDynamicSharedMemorySize, 65536);
        hipFuncSetAttribute((const void*)k_gemm<2>, hipFuncAttributeMaxDynamicSharedMemorySize, 65536);
        hipFuncSetAttribute((const void*)k_gemm<3>, hipFuncAttributeMaxDynamicSharedMemorySize, 65536);
        attr_done = true;
    }
    unsigned char* ws = (unsigned char*)d_ws;
    hipLaunchKernelGGL(k_prep_rows, dim3(512), dim3(256), 65536, stream, P);
    hipLaunchKernelGGL(k_transpose, dim3(16 * (NZ / 64)), dim3(256), 0, stream, P.w_in, PROJ, NZ, 2048, 8, (bf16_t*)(ws + WS_BT1));
    hipLaunchKernelGGL(k_transpose, dim3(16 * (1024 / 64)), dim3(256), 0, stream, P.w_out, 1024, 1024, 1 << 30, 0, (bf16_t*)(ws + WS_BT2));
    hipLaunchKernelGGL(k_transpose, dim3(16 * (2048 / 64)), dim3(256), 0, stream, P.peer_query, 2048, 2048, 1 << 30, 0, (bf16_t*)(ws + WS_BT3));
    hipLaunchKernelGGL(k_convert, dim3(128), dim3(256), 0, stream, P.peer_keys, (bf16_t*)(ws + WS_KEYS), (size_t)(16 * 128 * 128 / 8));
    hipLaunchKernelGGL(k_convert, dim3(2048), dim3(256), 0, stream, P.peer_u, (bf16_t*)(ws + WS_U), (size_t)16384 * 1024 / 8);
    hipLaunchKernelGGL(k_convert, dim3(2048), dim3(256), 0, stream, P.peer_v, (bf16_t*)(ws + WS_V), (size_t)16384 * 1024 / 8);
    hipLaunchKernelGGL(k_gemm<1>, dim3((T1 / 128) * (NZ / 128)), dim3(256), 65536, stream, P, NZ / 128);
    hipLaunchKernelGGL(k_fox_norm, dim3(T1 * 16 / 256), dim3(256), 0, stream, P);
    hipLaunchKernelGGL(k_fox_cum, dim3(64), dim3(64), 0, stream, P);
    hipLaunchKernelGGL(k_mlstm_naive, dim3(32), dim3(256), 0, stream, P);
    hipLaunchKernelGGL(k_attn_naive, dim3((NB * 8 * L + 3) / 4), dim3(256), 0, stream, P);
    hipLaunchKernelGGL(k_gemm<2>, dim3((T2 / 128) * (1024 / 128)), dim3(256), 65536, stream, P, 1024 / 128);
    hipLaunchKernelGGL(k_xn, dim3(T2 / 4), dim3(256), 0, stream, P);
    hipLaunchKernelGGL(k_gemm<3>, dim3((T2 / 128) * (2048 / 128)), dim3(256), 65536, stream, P, 2048 / 128);
    hipLaunchKernelGGL(k_scores_topk, dim3((T2 / 16) * 16), dim3(256), 0, stream, P);
    hipLaunchKernelGGL(k_peer, dim3(T2 / 4), dim3(256), 0, stream, P);
}
```

```cpp
#include <hip/hip_runtime.h>
#include <stdint.h>
#include <stdio.h>
#include <hip/hip_cooperative_groups.h>
namespace cg = cooperative_groups;

namespace {

constexpr int NB = 8, SEQ = 2048, DM = 1024, NMETA = 16, L = SEQ + NMETA;
constexpr int T1 = NB * L;
constexpr int T2 = NB * SEQ;
constexpr int NZ = 3584;
constexpr int ZC_MQ = 0, ZC_MK = 512, ZC_MV = 1024, ZC_MO = 1536, ZC_FQ = 2048, ZC_FK = 2560, ZC_FV = 3072;
constexpr int PROJ = 3600;
constexpr float EPS = 1e-6f;

constexpr size_t WS_CTL = 0;
constexpr size_t WS_RA = 65536;
constexpr size_t WS_Z = WS_RA + (size_t)T1 * DM * 2;
constexpr size_t WS_GATES = WS_Z + (size_t)T1 * NZ * 2;
constexpr size_t WS_CUM = WS_GATES + (size_t)T1 * 16 * 4;
constexpr size_t WS_SSQ = WS_CUM + (size_t)NB * 8 * L * 4;
constexpr size_t WS_RSTD = WS_SSQ + (size_t)T2 * 16 * 4;
constexpr size_t WS_BT1 = WS_RSTD + (size_t)T2 * 4;
constexpr size_t WS_BT2 = WS_BT1 + (size_t)NZ * DM * 2;
constexpr size_t WS_BT3 = WS_BT2 + (size_t)DM * DM * 2;
constexpr size_t WS_KEYS = WS_BT3 + (size_t)2048 * DM * 2;
constexpr size_t WS_U = WS_KEYS + (size_t)16 * 128 * 128 * 2;
constexpr size_t WS_V = WS_U + (size_t)16384 * DM * 2;
constexpr size_t WS_END = WS_V + (size_t)16384 * DM * 2;
constexpr size_t WS_XN = WS_Z;
constexpr size_t WS_QP = WS_Z + (size_t)T2 * DM * 2;

typedef unsigned short bf16_t;
typedef short bf16x8 __attribute__((ext_vector_type(8)));
typedef float f32x4 __attribute__((ext_vector_type(4)));
typedef __attribute__((ext_vector_type(2))) __bf16 bf16x2_t;

struct Params {
    const float* x; const float* meta; const float* norm_mix; const float* w_in; const float* conv_qk;
    const float* b_igate; const float* b_fgate_m; const float* m_out_norm; const float* b_fgate_f;
    const float* f_q_norm; const float* f_k_norm; const float* w_out; const float* norm_ffn;
    const float* peer_query; const float* peer_keys; const float* peer_u; const float* peer_v;
    float* out; unsigned char* ws;
};

__device__ __forceinline__ unsigned f2bf(float f) { unsigned u = __float_as_uint(f); return (u + 0x7fffu + ((u >> 16) & 1u)) >> 16; }
__device__ __forceinline__ float bf2f(unsigned h) { return __uint_as_float(h << 16); }
__device__ __forceinline__ unsigned pk2(float lo, float hi) { return f2bf(lo) | (f2bf(hi) << 16); }
__device__ __forceinline__ float bflo(unsigned w) { return __uint_as_float(w << 16); }
__device__ __forceinline__ float bfhi(unsigned w) { return __uint_as_float(w & 0xffff0000u); }
__device__ __forceinline__ float wave_sum(float v) {
#pragma unroll
    for (int o = 32; o > 0; o >>= 1) v += __shfl_xor(v, o, 64);
    return v;
}
__device__ __forceinline__ float wave_max(float v) {
#pragma unroll
    for (int o = 32; o > 0; o >>= 1) v = fmaxf(v, __shfl_xor(v, o, 64));
    return v;
}
__device__ __forceinline__ float logsigmoidf(float x) { return fminf(x, 0.f) - log1pf(expf(-fabsf(x))); }
__device__ __forceinline__ unsigned ord_key(float f) { unsigned u = __float_as_uint(f); return u ^ ((u >> 31) ? 0xffffffffu : 0x80000000u); }
__device__ __forceinline__ float unord_key(unsigned k) { unsigned u = (k & 0x80000000u) ? (k ^ 0x80000000u) : ~k; return __uint_as_float(u); }

__device__ __forceinline__ void phase0(const Params& P, unsigned char* smem) {
    const int tid = threadIdx.x, lane = tid & 63, wave = tid >> 6;
    unsigned* ctl = (unsigned*)(P.ws + WS_CTL);
    if (blockIdx.x == 0 && tid < 64) ctl[tid] = 0u;
    float* gw = (float*)smem;
    for (int idx = tid; idx < 16 * 1024; idx += 256) {
        const int k = idx >> 4, c = idx & 15;
        const int col = c < 8 ? 2048 + c : 3592 + (c - 8);
        gw[c * 1024 + k] = P.w_in[(size_t)k * PROJ + col];
    }
    __syncthreads();
    {
        bf16_t* hn = (bf16_t*)(P.ws + WS_RA);
        float* gates = (float*)(P.ws + WS_GATES);
        const int c0 = lane * 8, c1 = 512 + lane * 8;
        for (int r = blockIdx.x * 4 + wave; r < T1; r += gridDim.x * 4) {
            const int b = r / L, p = r - b * L;
            const float* src = (p < NMETA) ? (P.meta + (size_t)p * DM) : (P.x + ((size_t)b * SEQ + (p - NMETA)) * DM);
            float v[16];
            {
                const float4 a0 = *(const float4*)(src + c0), a1 = *(const float4*)(src + c0 + 4);
                const float4 a2 = *(const float4*)(src + c1), a3 = *(const float4*)(src + c1 + 4);
                v[0] = a0.x; v[1] = a0.y; v[2] = a0.z; v[3] = a0.w; v[4] = a1.x; v[5] = a1.y; v[6] = a1.z; v[7] = a1.w;
                v[8] = a2.x; v[9] = a2.y; v[10] = a2.z; v[11] = a2.w; v[12] = a3.x; v[13] = a3.y; v[14] = a3.z; v[15] = a3.w;
            }
            float ss = 0.f;
#pragma unroll
            for (int j = 0; j < 16; ++j) ss += v[j] * v[j];
            ss = wave_sum(ss);
            const float rstd = rsqrtf(ss * (1.0f / DM) + EPS);
            {
                const float4 a0 = *(const float4*)(P.norm_mix + c0), a1 = *(const float4*)(P.norm_mix + c0 + 4);
                const float4 a2 = *(const float4*)(P.norm_mix + c1), a3 = *(const float4*)(P.norm_mix + c1 + 4);
                v[0] *= rstd * a0.x; v[1] *= rstd * a0.y; v[2] *= rstd * a0.z; v[3] *= rstd * a0.w; v[4] *= rstd * a1.x; v[5] *= rstd * a1.y; v[6] *= rstd * a1.z; v[7] *= rstd * a1.w;
                v[8] *= rstd * a2.x; v[9] *= rstd * a2.y; v[10] *= rstd * a2.z; v[11] *= rstd * a2.w; v[12] *= rstd * a3.x; v[13] *= rstd * a3.y; v[14] *= rstd * a3.z; v[15] *= rstd * a3.w;
            }
            uint4 o0, o1;
            o0.x = pk2(v[0], v[1]); o0.y = pk2(v[2], v[3]); o0.z = pk2(v[4], v[5]); o0.w = pk2(v[6], v[7]);
            o1.x = pk2(v[8], v[9]); o1.y = pk2(v[10], v[11]); o1.z = pk2(v[12], v[13]); o1.w = pk2(v[14], v[15]);
            *(uint4*)(hn + (size_t)r * DM + c0) = o0;
            *(uint4*)(hn + (size_t)r * DM + c1) = o1;
            float mine = 0.f;
#pragma unroll 1
            for (int c = 0; c < 16; ++c) {
                const float* gwc = gw + c * 1024;
                const float4 w0 = *(const float4*)(gwc + c0), w1 = *(const float4*)(gwc + c0 + 4), w2 = *(const float4*)(gwc + c1), w3 = *(const float4*)(gwc + c1 + 4);
                float s = v[0] * w0.x + v[1] * w0.y + v[2] * w0.z + v[3] * w0.w + v[4] * w1.x + v[5] * w1.y + v[6] * w1.z + v[7] * w1.w
                        + v[8] * w2.x + v[9] * w2.y + v[10] * w2.z + v[11] * w2.w + v[12] * w3.x + v[13] * w3.y + v[14] * w3.z + v[15] * w3.w;
                s = wave_sum(s);
                if (lane == c) mine = s;
            }
            if (lane < 16) {
                float val;
                if (lane < 4) val = mine + P.b_igate[lane];
                else if (lane < 8) val = logsigmoidf(mine + P.b_fgate_m[lane - 4]);
                else val = logsigmoidf(mine + P.b_fgate_f[lane - 8]);
                gates[(size_t)r * 16 + lane] = val;
            }
        }
    }
    __syncthreads();
    {
        float (*tile)[65] = (float (*)[65])smem;
        for (int item = blockIdx.x; item < 1664; item += gridDim.x) {
            const float* W; int ldn, ntn, shift_from, it; bf16_t* out;
            if (item < 896) { W = P.w_in; ldn = PROJ; ntn = 56; shift_from = 2048; it = item; out = (bf16_t*)(P.ws + WS_BT1); }
            else if (item < 1152) { W = P.w_out; ldn = 1024; ntn = 16; shift_from = 1 << 30; it = item - 896; out = (bf16_t*)(P.ws + WS_BT2); }
            else { W = P.peer_query; ldn = 2048; ntn = 32; shift_from = 1 << 30; it = item - 1152; out = (bf16_t*)(P.ws + WS_BT3); }
            const int tk = it / ntn, tn = it - tk * ntn, k0 = tk * 64, n0 = tn * 64;
            {
                const int nl = tid & 63;
                int n = n0 + nl; if (n >= shift_from) n += 8;
#pragma unroll
                for (int i = 0; i < 16; ++i) { const int kl = (tid >> 6) + 4 * i; tile[kl][nl] = W[(size_t)(k0 + kl) * ldn + n]; }
            }
            __syncthreads();
            {
                const int kl = tid & 63;
#pragma unroll
                for (int i = 0; i < 16; ++i) { const int nl = (tid >> 6) + 4 * i; out[(size_t)(n0 + nl) * 1024 + k0 + kl] = (bf16_t)f2bf(tile[kl][nl]); }
            }
            __syncthreads();
        }
    }
    {
        const size_t gt = (size_t)blockIdx.x * 256 + tid, gs = (size_t)gridDim.x * 256;
        for (int which = 0; which < 3; ++which) {
            const float* src = which == 0 ? P.peer_keys : (which == 1 ? P.peer_u : P.peer_v);
            bf16_t* dst = (bf16_t*)(P.ws + (which == 0 ? WS_KEYS : (which == 1 ? WS_U : WS_V)));
            const size_t n8 = which == 0 ? (size_t)(16 * 128 * 128 / 8) : (size_t)16384 * 1024 / 8;
            for (size_t i = gt; i < n8; i += gs) {
                const float4 a = *(const float4*)(src + i * 8), b = *(const float4*)(src + i * 8 + 4);
                uint4 o; o.x = pk2(a.x, a.y); o.y = pk2(a.z, a.w); o.z = pk2(b.x, b.y); o.w = pk2(b.z, b.w);
                *(uint4*)(dst + i * 8) = o;
            }
        }
    }
}

__device__ __forceinline__ void mma_ktile(const unsigned char* sA, const unsigned char* sB, int arow_off, int brow_off, int g, int sw, f32x4 (&acc)[4][4]) {
#pragma unroll
    for (int s = 0; s < 2; ++s) {
        bf16x8 a[4], b[4];
        const int ch = (((s * 4 + g) ^ sw) << 4);
#pragma unroll
        for (int i = 0; i < 4; ++i) a[i] = *(const bf16x8*)(sA + arow_off + i * 2048 + ch);
#pragma unroll
        for (int j = 0; j < 4; ++j) b[j] = *(const bf16x8*)(sB + brow_off + j * 2048 + ch);
#pragma unroll
        for (int i = 0; i < 4; ++i)
#pragma unroll
            for (int j = 0; j < 4; ++j) acc[i][j] = __builtin_amdgcn_mfma_f32_16x16x32_bf16(b[j], a[i], acc[i][j], 0, 0, 0);
    }
}

__device__ __forceinline__ void store_tile_bf16(const f32x4 (&acc)[4][4], unsigned char* smem, bf16_t* dst, size_t ld, int m0, int n0, int tid, int wr, int wc, int g, int lr) {
#pragma unroll
    for (int i = 0; i < 4; ++i)
#pragma unroll
        for (int j = 0; j < 4; ++j) {
            const int row = wr * 64 + 16 * i + lr, col = wc * 64 + 16 * j + 4 * g;
            uint2 w; w.x = pk2(acc[i][j][0], acc[i][j][1]); w.y = pk2(acc[i][j][2], acc[i][j][3]);
            *(uint2*)(smem + row * 272 + col * 2) = w;
        }
    __syncthreads();
#pragma unroll
    for (int q = 0; q < 8; ++q) {
        const int id = tid + 256 * q, row = id >> 4, ch = id & 15;
        const uint4 v = *(const uint4*)(smem + row * 272 + ch * 16);
        *(uint4*)(dst + (size_t)(m0 + row) * ld + n0 + ch * 8) = v;
    }
    __syncthreads();
}

template <int MODE>
__device__ __forceinline__ void gemm_tile(const Params& P, int tm, int tn, unsigned char* smem) {
    const bf16_t* A; const bf16_t* Bt;
    if (MODE == 1) { A = (const bf16_t*)(P.ws + WS_RA); Bt = (const bf16_t*)(P.ws + WS_BT1); }
    else if (MODE == 2) { A = (const bf16_t*)(P.ws + WS_RA); Bt = (const bf16_t*)(P.ws + WS_BT2); }
    else { A = (const bf16_t*)(P.ws + WS_XN); Bt = (const bf16_t*)(P.ws + WS_BT3); }
    const int tid = threadIdx.x, lane = tid & 63, wave = tid >> 6, wr = wave >> 1, wc = wave & 1, g = lane >> 4, lr = lane & 15;
    const int m0 = tm * 128, n0 = tn * 128;
    const int srow = tid >> 3, sc = tid & 7;
    const bf16_t* aptr[4]; const bf16_t* bptr[4]; int soff[4];
#pragma unroll
    for (int j = 0; j < 4; ++j) {
        const int row = srow + 32 * j;
        int ar = m0 + row;
        if (MODE == 2) { const int b = ar >> 11, t = ar & 2047; ar = b * L + NMETA + t; }
        aptr[j] = A + (size_t)ar * 1024 + sc * 8;
        bptr[j] = Bt + (size_t)(n0 + row) * 1024 + sc * 8;
        soff[j] = row * 128 + ((sc ^ (row & 7)) << 4);
    }
    f32x4 acc[4][4];
#pragma unroll
    for (int i = 0; i < 4; ++i)
#pragma unroll
        for (int j = 0; j < 4; ++j) acc[i][j] = (f32x4){0.f, 0.f, 0.f, 0.f};
    uint4 ra[4], rb[4];
#pragma unroll
    for (int j = 0; j < 4; ++j) { ra[j] = *(const uint4*)(aptr[j]); rb[j] = *(const uint4*)(bptr[j]); }
    unsigned char* sA0 = smem; unsigned char* sB0 = smem + 16384; unsigned char* sA1 = smem + 32768; unsigned char* sB1 = smem + 49152;
#pragma unroll
    for (int j = 0; j < 4; ++j) { *(uint4*)(sA0 + soff[j]) = ra[j]; *(uint4*)(sB0 + soff[j]) = rb[j]; }
    __syncthreads();
    const int arow_off = (wr * 64 + lr) * 128, brow_off = (wc * 64 + lr) * 128, sw = lr & 7;
    for (int kt = 0; kt < 16; ++kt) {
        unsigned char* sA = (kt & 1) ? sA1 : sA0; unsigned char* sB = (kt & 1) ? sB1 : sB0;
        unsigned char* nA = (kt & 1) ? sA0 : sA1; unsigned char* nB = (kt & 1) ? sB0 : sB1;
        if (kt < 15) {
#pragma unroll
            for (int j = 0; j < 4; ++j) { ra[j] = *(const uint4*)(aptr[j] + (kt + 1) * 64); rb[j] = *(const uint4*)(bptr[j] + (kt + 1) * 64); }
        }
        mma_ktile(sA, sB, arow_off, brow_off, g, sw, acc);
        if (kt < 15) {
#pragma unroll
            for (int j = 0; j < 4; ++j) { *(uint4*)(nA + soff[j]) = ra[j]; *(uint4*)(nB + soff[j]) = rb[j]; }
        }
        __syncthreads();
    }
    if (MODE == 1) {
        if (n0 >= ZC_FQ && n0 < ZC_FV) {
            const bool isk = n0 >= ZC_FK;
            const float* gain = isk ? P.f_k_norm : P.f_q_norm;
            const float scl = isk ? 1.0f : 0.125f;
            float gn[4][4];
#pragma unroll
            for (int j = 0; j < 4; ++j)
#pragma unroll
                for (int r = 0; r < 4; ++r) gn[j][r] = gain[16 * j + 4 * g + r];
#pragma unroll
            for (int i = 0; i < 4; ++i) {
                float ss = 0.f;
#pragma unroll
                for (int j = 0; j < 4; ++j)
#pragma unroll
                    for (int r = 0; r < 4; ++r) ss += acc[i][j][r] * acc[i][j][r];
                ss += __shfl_xor(ss, 16, 64); ss += __shfl_xor(ss, 32, 64);
                const float rstd = rsqrtf(ss * (1.0f / 64.0f) + EPS) * scl;
#pragma unroll
                for (int j = 0; j < 4; ++j)
#pragma unroll
                    for (int r = 0; r < 4; ++r) acc[i][j][r] *= rstd * gn[j][r];
            }
        }
        store_tile_bf16(acc, smem, (bf16_t*)(P.ws + WS_Z), NZ, m0, n0, tid, wr, wc, g, lr);
    } else if (MODE == 2) {
        float* ssq = (float*)(P.ws + WS_SSQ);
#pragma unroll
        for (int i = 0; i < 4; ++i) {
            const int row = m0 + wr * 64 + 16 * i + lr;
            float ss = 0.f;
#pragma unroll
            for (int j = 0; j < 4; ++j) {
                const int col = n0 + wc * 64 + 16 * j + 4 * g;
                const float4 xv = *(const float4*)(P.x + (size_t)row * DM + col);
                const float4 gv = *(const float4*)(P.norm_ffn + col);
                float4 hv; hv.x = acc[i][j][0] + xv.x; hv.y = acc[i][j][1] + xv.y; hv.z = acc[i][j][2] + xv.z; hv.w = acc[i][j][3] + xv.w;
                *(float4*)(P.out + (size_t)row * DM + col) = hv;
                ss += hv.x * hv.x + hv.y * hv.y + hv.z * hv.z + hv.w * hv.w;
                acc[i][j][0] = hv.x * gv.x; acc[i][j][1] = hv.y * gv.y; acc[i][j][2] = hv.z * gv.z; acc[i][j][3] = hv.w * gv.w;
            }
            ss += __shfl_xor(ss, 16, 64); ss += __shfl_xor(ss, 32, 64);
            if (g == 0) ssq[(size_t)row * 16 + tn * 2 + wc] = ss;
        }
        store_tile_bf16(acc, smem, (bf16_t*)(P.ws + WS_XN), 1024, m0, n0, tid, wr, wc, g, lr);
    } else {
        const int hp = tn;
        const float* ssq = (const float*)(P.ws + WS_SSQ);
        float rs[4];
#pragma unroll
        for (int i = 0; i < 4; ++i) {
            const int row = m0 + wr * 64 + 16 * i + lr;
            const float4 p0 = *(const float4*)(ssq + (size_t)row * 16), p1 = *(const float4*)(ssq + (size_t)row * 16 + 4);
            const float4 p2 = *(const float4*)(ssq + (size_t)row * 16 + 8), p3 = *(const float4*)(ssq + (size_t)row * 16 + 12);
            const float s = ((p0.x + p0.y) + (p0.z + p0.w)) + ((p1.x + p1.y) + (p1.z + p1.w)) + ((p2.x + p2.y) + (p2.z + p2.w)) + ((p3.x + p3.y) + (p3.z + p3.w));
            rs[i] = rsqrtf(s * (1.0f / DM) + EPS);
            if (tn == 0 && wc == 0 && g == 0) ((float*)(P.ws + WS_RSTD))[row] = rs[i];
        }
        {
            unsigned char* sAq = wc ? sA1 : sA0;
#pragma unroll
            for (int i = 0; i < 4; ++i)
#pragma unroll
                for (int j = 0; j < 4; ++j) {
                    const int row = wr * 64 + 16 * i + lr;
                    const int chunk = 2 * j + (g >> 1);
                    uint2 w; w.x = pk2(acc[i][j][0] * rs[i], acc[i][j][1] * rs[i]); w.y = pk2(acc[i][j][2] * rs[i], acc[i][j][3] * rs[i]);
                    *(uint2*)(sAq + row * 128 + ((chunk ^ (row & 7)) << 4) + 8 * (g & 1)) = w;
                }
            const bf16_t* keys = (const bf16_t*)(P.ws + WS_KEYS) + (size_t)hp * 128 * 128;
#pragma unroll
            for (int j = 0; j < 4; ++j) {
                const int row = srow + 32 * j;
                const uint4 k0 = *(const uint4*)(keys + (size_t)row * 128 + sc * 8);
                const uint4 k1 = *(const uint4*)(keys + (size_t)row * 128 + 64 + sc * 8);
                *(uint4*)(sB0 + soff[j]) = k0; *(uint4*)(sB1 + soff[j]) = k1;
            }
        }
        __syncthreads();
#pragma unroll
        for (int i = 0; i < 4; ++i)
#pragma unroll
            for (int j = 0; j < 4; ++j) acc[i][j] = (f32x4){0.f, 0.f, 0.f, 0.f};
        mma_ktile(sA0, sB0, arow_off, brow_off, g, sw, acc);
        mma_ktile(sA1, sB1, arow_off, brow_off, g, sw, acc);
        __syncthreads();
#pragma unroll
        for (int i = 0; i < 4; ++i)
#pragma unroll
            for (int j = 0; j < 4; ++j) {
                const int row = wr * 64 + 16 * i + lr;
                const int c4 = wc * 16 + 4 * j + g;
                *(f32x4*)(smem + row * 512 + ((c4 ^ (row & 31)) << 4)) = acc[i][j];
            }
        __syncthreads();
        unsigned top[16];
#pragma unroll
        for (int q = 0; q < 16; ++q) top[q] = 0u;
        const int row = tid & 127, half = tid >> 7;
#pragma unroll 1
        for (int s = 0; s < 16; ++s) {
            const int c4 = half * 16 + s;
            const f32x4 v = *(const f32x4*)(smem + row * 512 + ((c4 ^ (row & 31)) << 4));
#pragma unroll
            for (int e = 0; e < 4; ++e) {
                unsigned kx = (ord_key(v[e]) & ~127u) | (unsigned)(127 - (c4 * 4 + e));
#pragma unroll
                for (int q = 0; q < 16; ++q) { const unsigned hi = max(top[q], kx), lo = min(top[q], kx); top[q] = hi; kx = lo; }
            }
        }
        __syncthreads();
        if (half) {
            uint4* lp = (uint4*)(smem + row * 64);
            lp[0] = make_uint4(top[0], top[1], top[2], top[3]); lp[1] = make_uint4(top[4], top[5], top[6], top[7]);
            lp[2] = make_uint4(top[8], top[9], top[10], top[11]); lp[3] = make_uint4(top[12], top[13], top[14], top[15]);
        }
        __syncthreads();
        if (!half) {
            const uint4* lp = (const uint4*)(smem + row * 64);
#pragma unroll
            for (int c = 0; c < 4; ++c) {
                const uint4 o = lp[c];
                unsigned ks[4] = {o.x, o.y, o.z, o.w};
#pragma unroll
                for (int e = 0; e < 4; ++e) {
                    unsigned kx = ks[e];
#pragma unroll
                    for (int q = 0; q < 16; ++q) { const unsigned hi = max(top[q], kx), lo = min(top[q], kx); top[q] = hi; kx = lo; }
                }
            }
            uint4* tk = (uint4*)((unsigned*)(P.ws + WS_RA) + ((size_t)(m0 + row) * 16 + hp) * 16);
            tk[0] = make_uint4(top[0], top[1], top[2], top[3]); tk[1] = make_uint4(top[4], top[5], top[6], top[7]);
            tk[2] = make_uint4(top[8], top[9], top[10], top[11]); tk[3] = make_uint4(top[12], top[13], top[14], top[15]);
        }
        __syncthreads();
    }
}

__device__ __forceinline__ void fox_cum_wave(const Params& P, int bh, int lane) {
    const int b = bh >> 3, h = bh & 7;
    const float* gates = (const float*)(P.ws + WS_GATES);
    float* cum = (float*)(P.ws + WS_CUM) + (size_t)bh * L;
    constexpr int SEG = 33;
    const int t0 = lane * SEG;
    float loc = 0.f;
    for (int i = 0; i < SEG; ++i) { const int t = t0 + i; if (t < L) loc += gates[(size_t)(b * L + t) * 16 + 8 + h]; }
    float incl = loc;
#pragma unroll
    for (int o = 1; o < 64; o <<= 1) { const float n = __shfl_up(incl, o, 64); if (lane >= o) incl += n; }
    float run = incl - loc;
    for (int i = 0; i < SEG; ++i) { const int t = t0 + i; if (t < L) { run += gates[(size_t)(b * L + t) * 16 + 8 + h]; cum[t] = run; } }
}

__device__ __forceinline__ void attn_naive_wave(const Params& P, int bh, int t, int lane) {
    const int b = bh >> 3, h = bh & 7;
    const bf16_t* z = (const bf16_t*)(P.ws + WS_Z);
    const float* cum = (const float*)(P.ws + WS_CUM) + (size_t)bh * L;
    float q[64];
    {
        const bf16_t* qp = z + (size_t)(b * L + t) * NZ + ZC_FQ + h * 64;
#pragma unroll
        for (int i = 0; i < 8; ++i) {
            const uint4 v = *(const uint4*)(qp + i * 8);
            q[i * 8 + 0] = bflo(v.x); q[i * 8 + 1] = bfhi(v.x); q[i * 8 + 2] = bflo(v.y); q[i * 8 + 3] = bfhi(v.y);
            q[i * 8 + 4] = bflo(v.z); q[i * 8 + 5] = bfhi(v.z); q[i * 8 + 6] = bflo(v.w); q[i * 8 + 7] = bfhi(v.w);
        }
    }
    const float ct = cum[t];
    float m = -INFINITY, lsum = 0.f;
    float acc[64];
#pragma unroll
    for (int i = 0; i < 64; ++i) acc[i] = 0.f;
    for (int s = lane; s <= t; s += 64) {
        const bf16_t* kp = z + (size_t)(b * L + s) * NZ + ZC_FK + h * 64;
        const bf16_t* vp = z + (size_t)(b * L + s) * NZ + ZC_FV + h * 64;
        float dot = 0.f;
#pragma unroll
        for (int i = 0; i < 8; ++i) {
            const uint4 v = *(const uint4*)(kp + i * 8);
            dot += q[i * 8 + 0] * bflo(v.x) + q[i * 8 + 1] * bfhi(v.x) + q[i * 8 + 2] * bflo(v.y) + q[i * 8 + 3] * bfhi(v.y)
                 + q[i * 8 + 4] * bflo(v.z) + q[i * 8 + 5] * bfhi(v.z) + q[i * 8 + 6] * bflo(v.w) + q[i * 8 + 7] * bfhi(v.w);
        }
        const float logit = dot + ct - cum[s];
        const float mn = fmaxf(m, logit);
        const float sc = __expf(m - mn), p = __expf(logit - mn);
        m = mn; lsum = lsum * sc + p;
#pragma unroll
        for (int i = 0; i < 8; ++i) {
            const uint4 v = *(const uint4*)(vp + i * 8);
            acc[i * 8 + 0] = acc[i * 8 + 0] * sc + p * bflo(v.x); acc[i * 8 + 1] = acc[i * 8 + 1] * sc + p * bfhi(v.x);
            acc[i * 8 + 2] = acc[i * 8 + 2] * sc + p * bflo(v.y); acc[i * 8 + 3] = acc[i * 8 + 3] * sc + p * bfhi(v.y);
            acc[i * 8 + 4] = acc[i * 8 + 4] * sc + p * bflo(v.z); acc[i * 8 + 5] = acc[i * 8 + 5] * sc + p * bfhi(v.z);
            acc[i * 8 + 6] = acc[i * 8 + 6] * sc + p * bflo(v.w); acc[i * 8 + 7] = acc[i * 8 + 7] * sc + p * bfhi(v.w);
        }
    }
    const float M = wave_max(m);
    const float fac = (m == -INFINITY) ? 0.f : __expf(m - M);
    const float ltot = wave_sum(lsum * fac);
    float mine = 0.f;
#pragma unroll
    for (int d = 0; d < 64; ++d) { const float s = wave_sum(acc[d] * fac); if (lane == d) mine = s; }
    bf16_t* y = (bf16_t*)(P.ws + WS_RA);
    y[(size_t)(b * L + t) * DM + 512 + h * 64 + lane] = (bf16_t)f2bf(mine / ltot);
}

__device__ __forceinline__ void mlstm_naive_block(const Params& P, int bhm, unsigned char* smem) {
    float* sq = (float*)smem; float* sk = sq + 128; float* sv = sk + 128; float* red = sv + 128;
    const int tid = threadIdx.x, lane = tid & 63, wave = tid >> 6;
    const int b = bhm >> 2, h = bhm & 3;
    const int dv = tid >> 1, half = tid & 1;
    const bf16_t* z = (const bf16_t*)(P.ws + WS_Z);
    const float* gates = (const float*)(P.ws + WS_GATES);
    bf16_t* y = (bf16_t*)(P.ws + WS_RA);
    const int ch = tid & 127, isk = tid >> 7;
    const int zcol = (isk ? ZC_MK : ZC_MQ) + h * 128 + ch;
    const float w0 = P.conv_qk[0 * 1024 + zcol], w1 = P.conv_qk[1 * 1024 + zcol], w2 = P.conv_qk[2 * 1024 + zcol], w3 = P.conv_qk[3 * 1024 + zcol];
    const float gain = P.m_out_norm[h * 128 + dv];
    float x0 = 0.f, x1 = 0.f, x2 = 0.f;
    float C[64];
#pragma unroll
    for (int j = 0; j < 64; ++j) C[j] = 0.f;
    float nval = 0.f, m = 0.f;
    size_t r = (size_t)b * L;
    float xt_n = bf2f(z[r * NZ + zcol]);
    float v_n = (tid < 128) ? bf2f(z[r * NZ + ZC_MV + h * 128 + tid]) : 0.f;
    float li_n = gates[r * 16 + h], lf_n = gates[r * 16 + 4 + h];
    float o_n = bf2f(z[r * NZ + ZC_MO + h * 128 + dv]);
    for (int t = 0; t < L; ++t) {
        const float xt = xt_n, vcur = v_n, li = li_n, lf = lf_n, ocur = o_n;
        r = (size_t)b * L + t;
        if (t + 1 < L) {
            const size_t rn = r + 1;
            xt_n = bf2f(z[rn * NZ + zcol]);
            if (tid < 128) v_n = bf2f(z[rn * NZ + ZC_MV + h * 128 + tid]);
            li_n = gates[rn * 16 + h]; lf_n = gates[rn * 16 + 4 + h];
            o_n = bf2f(z[rn * NZ + ZC_MO + h * 128 + dv]);
        }
        const float cv = w0 * x0 + w1 * x1 + w2 * x2 + w3 * xt;
        x0 = x1; x1 = x2; x2 = xt;
        const float sil = cv / (1.f + __expf(-cv));
        if (isk) sk[ch] = sil * 0.08838834764831845f; else sq[ch] = sil;
        if (tid < 128) sv[tid] = vcur;
        __syncthreads();
        const float m_new = fmaxf(lf + m, li);
        const float ip = __expf(li - m_new), fp = __expf(lf + m - m_new);
        m = m_new;
        const float vv = sv[dv] * ip;
        float part = 0.f;
#pragma unroll
        for (int j = 0; j < 64; ++j) { const int dk = half * 64 + j; C[j] = fp * C[j] + vv * sk[dk]; part += C[j] * sq[dk]; }
        part += __shfl_xor(part, 1, 64);
        float dn = 0.f;
        if (tid < 128) { nval = fp * nval + ip * sk[tid]; dn = nval * sq[tid]; }
        dn = wave_sum(dn);
        if (lane == 0) red[wave] = dn;
        __syncthreads();
        const float den = red[0] + red[1] + red[2] + red[3];
        const float hval = part / fmaxf(fabsf(den), __expf(-m));
        float sqv = half == 0 ? hval * hval : 0.f;
        sqv = wave_sum(sqv);
        if (lane == 0) red[4 + wave] = sqv;
        __syncthreads();
        const float ssq = red[4] + red[5] + red[6] + red[7];
        const float rstd = rsqrtf(ssq * (1.0f / 128.0f) + EPS);
        if (half == 0) {
            const float yv = hval * rstd * gain * (1.f / (1.f + __expf(-ocur)));
            y[r * DM + h * 128 + dv] = (bf16_t)f2bf(yv);
        }
    }
    __syncthreads();
}

__device__ __forceinline__ void peer_token(const Params& P, int t, int lane, int* sidx, float* sval, int* sid, float* sgate) {
    const unsigned* tk = (const unsigned*)(P.ws + WS_RA) + (size_t)t * 256;
#pragma unroll
    for (int i = 0; i < 4; ++i) {
        const unsigned k = tk[lane * 4 + i];
        sidx[lane * 4 + i] = 127 - (int)(k & 127u);
        sval[lane * 4 + i] = unord_key(k & ~127u);
    }
    __builtin_amdgcn_s_waitcnt(0xc07f);
    __builtin_amdgcn_wave_barrier();
    if (lane < 8) {
        const int hd = lane;
        float v0[16], v1[16];
#pragma unroll
        for (int i = 0; i < 16; ++i) { v0[i] = sval[(2 * hd) * 16 + i]; v1[i] = sval[(2 * hd + 1) * 16 + i]; }
        unsigned top[16];
#pragma unroll
        for (int i = 0; i < 16; ++i) top[i] = 0u;
#pragma unroll
        for (int i = 0; i < 16; ++i)
#pragma unroll
            for (int j = 0; j < 16; ++j)
                if ((i + 1) * (j + 1) <= 16) {
                    unsigned kx = (ord_key(v0[i] + v1[j]) & ~255u) | (unsigned)(255 - (i * 16 + j));
#pragma unroll
                    for (int q = 0; q < 16; ++q) { const unsigned hi = max(top[q], kx), lo = min(top[q], kx); top[q] = hi; kx = lo; }
                }
        const float smax = unord_key(top[0] & ~255u);
        float e[16]; float den = 0.f;
#pragma unroll
        for (int q = 0; q < 16; ++q) { e[q] = __expf(unord_key(top[q] & ~255u) - smax); den += e[q]; }
        const float inv = 1.f / den;
#pragma unroll
        for (int q = 0; q < 16; ++q) {
            const int pos = 255 - (int)(top[q] & 255u), i = pos >> 4, j = pos & 15;
            sid[hd * 16 + q] = sidx[(2 * hd) * 16 + i] * 128 + sidx[(2 * hd + 1) * 16 + j];
            sgate[hd * 16 + q] = e[q] * inv;
        }
    }
    __builtin_amdgcn_s_waitcnt(0xc07f);
    __builtin_amdgcn_wave_barrier();
    const bf16_t* xn = (const bf16_t*)(P.ws + WS_XN) + (size_t)t * DM;
    const float rstd = ((const float*)(P.ws + WS_RSTD))[t];
    const bf16_t* U = (const bf16_t*)(P.ws + WS_U);
    const bf16_t* V = (const bf16_t*)(P.ws + WS_V);
    const int c0 = lane * 8, c1 = 512 + lane * 8;
    const uint4 xa = *(const uint4*)(xn + c0), xb = *(const uint4*)(xn + c1);
    float xf[16];
    xf[0] = bflo(xa.x); xf[1] = bfhi(xa.x); xf[2] = bflo(xa.y); xf[3] = bfhi(xa.y); xf[4] = bflo(xa.z); xf[5] = bfhi(xa.z); xf[6] = bflo(xa.w); xf[7] = bfhi(xa.w);
    xf[8] = bflo(xb.x); xf[9] = bfhi(xb.x); xf[10] = bflo(xb.y); xf[11] = bfhi(xb.y); xf[12] = bflo(xb.z); xf[13] = bfhi(xb.z); xf[14] = bflo(xb.w); xf[15] = bfhi(xb.w);
    float acc[16];
#pragma unroll
    for (int j = 0; j < 16; ++j) acc[j] = 0.f;
#pragma unroll 1
    for (int e0 = 0; e0 < 128; e0 += 4) {
        uint4 ua[4], ub[4], va[4], vb[4];
#pragma unroll
        for (int q = 0; q < 4; ++q) {
            const int id = sid[e0 + q];
            ua[q] = *(const uint4*)(U + (size_t)id * DM + c0); ub[q] = *(const uint4*)(U + (size_t)id * DM + c1);
            va[q] = *(const uint4*)(V + (size_t)id * DM + c0); vb[q] = *(const uint4*)(V + (size_t)id * DM + c1);
        }
#pragma unroll
        for (int q = 0; q < 4; ++q) {
            float d = xf[0] * bflo(ua[q].x) + xf[1] * bfhi(ua[q].x) + xf[2] * bflo(ua[q].y) + xf[3] * bfhi(ua[q].y)
                    + xf[4] * bflo(ua[q].z) + xf[5] * bfhi(ua[q].z) + xf[6] * bflo(ua[q].w) + xf[7] * bfhi(ua[q].w)
                    + xf[8] * bflo(ub[q].x) + xf[9] * bfhi(ub[q].x) + xf[10] * bflo(ub[q].y) + xf[11] * bfhi(ub[q].y)
                    + xf[12] * bflo(ub[q].z) + xf[13] * bfhi(ub[q].z) + xf[14] * bflo(ub[q].w) + xf[15] * bfhi(ub[q].w);
            d = wave_sum(d) * rstd;
            const float ge = 0.5f * d * (1.f + erff(d * 0.70710678118654752f));
            const float w = sgate[e0 + q] * ge;
            acc[0] += w * bflo(va[q].x); acc[1] += w * bfhi(va[q].x); acc[2] += w * bflo(va[q].y); acc[3] += w * bfhi(va[q].y);
            acc[4] += w * bflo(va[q].z); acc[5] += w * bfhi(va[q].z); acc[6] += w * bflo(va[q].w); acc[7] += w * bfhi(va[q].w);
            acc[8] += w * bflo(vb[q].x); acc[9] += w * bfhi(vb[q].x); acc[10] += w * bflo(vb[q].y); acc[11] += w * bfhi(vb[q].y);
            acc[12] += w * bflo(vb[q].z); acc[13] += w * bfhi(vb[q].z); acc[14] += w * bflo(vb[q].w); acc[15] += w * bfhi(vb[q].w);
        }
    }
    float* o = P.out + (size_t)t * DM;
    float4 h0 = *(float4*)(o + c0), h1 = *(float4*)(o + c0 + 4), h2 = *(float4*)(o + c1), h3 = *(float4*)(o + c1 + 4);
    h0.x += acc[0]; h0.y += acc[1]; h0.z += acc[2]; h0.w += acc[3]; h1.x += acc[4]; h1.y += acc[5]; h1.z += acc[6]; h1.w += acc[7];
    h2.x += acc[8]; h2.y += acc[9]; h2.z += acc[10]; h2.w += acc[11]; h3.x += acc[12]; h3.y += acc[13]; h3.z += acc[14]; h3.w += acc[15];
    *(float4*)(o + c0) = h0; *(float4*)(o + c0 + 4) = h1; *(float4*)(o + c1) = h2; *(float4*)(o + c1 + 4) = h3;
    __builtin_amdgcn_s_waitcnt(0xc07f);
    __builtin_amdgcn_wave_barrier();
}

__global__ void __launch_bounds__(256, 2) mega(Params P) {
    extern __shared__ __attribute__((aligned(16))) unsigned char smem[];
    cg::grid_group grid = cg::this_grid();
    const int tid = threadIdx.x, lane = tid & 63, wave = tid >> 6;
    const int G = gridDim.x, bid = blockIdx.x;
    unsigned* ctl = (unsigned*)(P.ws + WS_CTL);
    phase0(P, smem);
    grid.sync();
    {
        const int gw = bid * 4 + wave;
        if (gw < 64) fox_cum_wave(P, gw, lane);
        for (int tile = bid; tile < 129 * 28; tile += G) gemm_tile<1>(P, tile / 28, tile % 28, smem);
    }
    grid.sync();
    {
        volatile int* s_item = (volatile int*)(smem + 4096);
        for (;;) {
            if (tid == 0) *s_item = (int)atomicAdd(&ctl[0], 1u);
            __syncthreads();
            const int item = *s_item;
            __syncthreads();
            if (item >= 32 + 64 * 516) break;
            if (item < 32) mlstm_naive_block(P, item, smem);
            else {
                const int a = item - 32, tg = a >> 6, bh = a & 63;
                const int t = L - 1 - (4 * tg + wave);
                attn_naive_wave(P, bh, t, lane);
            }
        }
    }
    grid.sync();
    for (int tile = bid; tile < 128 * 8; tile += G) gemm_tile<2>(P, tile >> 3, tile & 7, smem);
    grid.sync();
    for (int tile = bid; tile < 128 * 16; tile += G) gemm_tile<3>(P, tile >> 4, tile & 15, smem);
    grid.sync();
    {
        int* sidx = (int*)(smem + wave * 3072); float* sval = (float*)(smem + wave * 3072 + 1024);
        int* sid = (int*)(smem + wave * 3072 + 2048); float* sgate = (float*)(smem + wave * 3072 + 2560);
        for (int t = bid * 4 + wave; t < T2; t += G * 4) peer_token(P, t, lane, sidx, sval, sid, sgate);
    }
}

}

extern "C" void kernel_launch(void* const* d_in, const int* in_sizes, int n_in, void* d_out, int out_size, void* d_ws, size_t ws_size, hipStream_t stream) {
    if (n_in != 17 || ws_size < WS_END) { fprintf(stderr, "kernel_launch: unexpected n_in %d or ws_size %zu (need %zu)\n", n_in, ws_size, (size_t)WS_END); return; }
    constexpr int LDS_BYTES = 65536;
    static int grid_blocks = 0;
    if (!grid_blocks) {
        int dev = 0, cus = 0, per_cu = 0;
        (void)hipGetDevice(&dev);
        (void)hipDeviceGetAttribute(&cus, hipDeviceAttributeMultiprocessorCount, dev);
        (void)hipFuncSetAttribute((const void*)mega, hipFuncAttributeMaxDynamicSharedMemorySize, LDS_BYTES);
        (void)hipOccupancyMaxActiveBlocksPerMultiprocessor(&per_cu, (const void*)mega, 256, LDS_BYTES);
        if (per_cu < 1) per_cu = 1;
        if (per_cu > 2) per_cu = 2;
        grid_blocks = cus * per_cu;
        fprintf(stderr, "kernel_launch: cus %d per_cu %d grid %d\n", cus, per_cu, grid_blocks);
    }
    Params P{};
    P.x = (const float*)d_in[0]; P.meta = (const float*)d_in[1]; P.norm_mix = (const float*)d_in[2]; P.w_in = (const float*)d_in[3];
    P.conv_qk = (const float*)d_in[4]; P.b_igate = (const float*)d_in[5]; P.b_fgate_m = (const float*)d_in[6]; P.m_out_norm = (const float*)d_in[7];
    P.b_fgate_f = (const float*)d_in[8]; P.f_q_norm = (const float*)d_in[9]; P.f_k_norm = (const float*)d_in[10]; P.w_out = (const float*)d_in[11];
    P.norm_ffn = (const float*)d_in[12]; P.peer_query = (const float*)d_in[13]; P.peer_keys = (const float*)d_in[14]; P.peer_u = (const float*)d_in[15];
    P.peer_v = (const float*)d_in[16]; P.out = (float*)d_out; P.ws = (unsigned char*)d_ws;
    void* args[] = {&P};
    hipError_t e = hipLaunchCooperativeKernel((const void*)mega, dim3(grid_blocks), dim3(256), args, LDS_BYTES, stream);
    if (e != hipSuccess) fprintf(stderr, "cooperative launch failed: %s (grid %d)\n", hipGetErrorString(e), grid_blocks);
}
```

```cpp
#include <hip/hip_runtime.h>
#include <stdint.h>
#include <stdio.h>
#include <hip/hip_cooperative_groups.h>
namespace cg = cooperative_groups;

namespace {

constexpr int NB = 8, SEQ = 2048, DM = 1024, NMETA = 16, L = SEQ + NMETA;
constexpr int T1 = NB * L;
constexpr int T2 = NB * SEQ;
constexpr int NZ = 3584;
constexpr int ZC_MQ = 0, ZC_MK = 512, ZC_MV = 1024, ZC_MO = 1536, ZC_FQ = 2048, ZC_FK = 2560, ZC_FV = 3072;
constexpr int PROJ = 3600;
constexpr float EPS = 1e-6f;

constexpr size_t WS_CTL = 0;
constexpr size_t WS_RA = 65536;
constexpr size_t WS_Z = WS_RA + (size_t)T1 * DM * 2;
constexpr size_t WS_Y = WS_Z + (size_t)T1 * NZ * 2;
constexpr size_t WS_GATES = WS_Y + (size_t)T1 * DM * 2;
constexpr size_t WS_CUM = WS_GATES + (size_t)T1 * 16 * 4;
constexpr size_t WS_SSQ = WS_CUM + (size_t)NB * 8 * L * 4;
constexpr size_t WS_RSTD = WS_SSQ + (size_t)T2 * 16 * 4;
constexpr size_t WS_SSQM = WS_RSTD + (size_t)T2 * 4;
constexpr size_t WS_BT1 = WS_SSQM + (size_t)T1 * 16 * 4;
constexpr size_t WS_BT2 = WS_BT1 + (size_t)NZ * DM * 2;
constexpr size_t WS_BT3 = WS_BT2 + (size_t)DM * DM * 2;
constexpr size_t WS_KEYS = WS_BT3 + (size_t)2048 * DM * 2;
constexpr size_t WS_END = WS_KEYS + (size_t)16 * 128 * 128 * 2;
constexpr size_t WS_XN = WS_Z;
constexpr size_t WS_U = WS_Z + (size_t)T2 * DM * 2;
constexpr size_t WS_V = WS_U + (size_t)16384 * DM * 2;
constexpr float LOG2E = 1.4426950408889634f;

typedef unsigned short bf16_t;
typedef short bf16x8 __attribute__((ext_vector_type(8)));
typedef float f32x4 __attribute__((ext_vector_type(4)));
typedef __attribute__((ext_vector_type(2))) __bf16 bf16x2_t;

struct Params {
    const float* x; const float* meta; const float* norm_mix; const float* w_in; const float* conv_qk;
    const float* b_igate; const float* b_fgate_m; const float* m_out_norm; const float* b_fgate_f;
    const float* f_q_norm; const float* f_k_norm; const float* w_out; const float* norm_ffn;
    const float* peer_query; const float* peer_keys; const float* peer_u; const float* peer_v;
    float* out; unsigned char* ws;
};

__device__ __forceinline__ unsigned f2bf(float f) { unsigned u = __float_as_uint(f); return (u + 0x7fffu + ((u >> 16) & 1u)) >> 16; }
__device__ __forceinline__ float bf2f(unsigned h) { return __uint_as_float(h << 16); }
__device__ __forceinline__ unsigned pk2(float lo, float hi) { return f2bf(lo) | (f2bf(hi) << 16); }
__device__ __forceinline__ float bflo(unsigned w) { return __uint_as_float(w << 16); }
__device__ __forceinline__ float bfhi(unsigned w) { return __uint_as_float(w & 0xffff0000u); }
__device__ __forceinline__ float wave_sum(float v) {
#pragma unroll
    for (int o = 32; o > 0; o >>= 1) v += __shfl_xor(v, o, 64);
    return v;
}
__device__ __forceinline__ float wave_max(float v) {
#pragma unroll
    for (int o = 32; o > 0; o >>= 1) v = fmaxf(v, __shfl_xor(v, o, 64));
    return v;
}
__device__ __forceinline__ float logsigmoidf(float x) { return fminf(x, 0.f) - log1pf(expf(-fabsf(x))); }
__device__ __forceinline__ unsigned ord_key(float f) { unsigned u = __float_as_uint(f); return u ^ ((u >> 31) ? 0xffffffffu : 0x80000000u); }
__device__ __forceinline__ float unord_key(unsigned k) { unsigned u = (k & 0x80000000u) ? (k ^ 0x80000000u) : ~k; return __uint_as_float(u); }

__device__ __forceinline__ void phase0(const Params& P, unsigned char* smem) {
    const int tid = threadIdx.x, lane = tid & 63, wave = tid >> 6;
    unsigned* ctl = (unsigned*)(P.ws + WS_CTL);
    if (blockIdx.x == 0 && tid < 64) ctl[tid] = 0u;
    float* gw = (float*)smem;
    for (int idx = tid; idx < 16 * 1024; idx += 256) {
        const int k = idx >> 4, c = idx & 15;
        const int col = c < 8 ? 2048 + c : 3592 + (c - 8);
        gw[c * 1024 + k] = P.w_in[(size_t)k * PROJ + col];
    }
    __syncthreads();
    {
        bf16_t* hn = (bf16_t*)(P.ws + WS_RA);
        float* gates = (float*)(P.ws + WS_GATES);
        const int c0 = lane * 8, c1 = 512 + lane * 8;
        for (int r = blockIdx.x * 4 + wave; r < T1; r += gridDim.x * 4) {
            const int b = r / L, p = r - b * L;
            const float* src = (p < NMETA) ? (P.meta + (size_t)p * DM) : (P.x + ((size_t)b * SEQ + (p - NMETA)) * DM);
            float v[16];
            {
                const float4 a0 = *(const float4*)(src + c0), a1 = *(const float4*)(src + c0 + 4);
                const float4 a2 = *(const float4*)(src + c1), a3 = *(const float4*)(src + c1 + 4);
                v[0] = a0.x; v[1] = a0.y; v[2] = a0.z; v[3] = a0.w; v[4] = a1.x; v[5] = a1.y; v[6] = a1.z; v[7] = a1.w;
                v[8] = a2.x; v[9] = a2.y; v[10] = a2.z; v[11] = a2.w; v[12] = a3.x; v[13] = a3.y; v[14] = a3.z; v[15] = a3.w;
            }
            float ss = 0.f;
#pragma unroll
            for (int j = 0; j < 16; ++j) ss += v[j] * v[j];
            ss = wave_sum(ss);
            const float rstd = rsqrtf(ss * (1.0f / DM) + EPS);
            {
                const float4 a0 = *(const float4*)(P.norm_mix + c0), a1 = *(const float4*)(P.norm_mix + c0 + 4);
                const float4 a2 = *(const float4*)(P.norm_mix + c1), a3 = *(const float4*)(P.norm_mix + c1 + 4);
                v[0] *= rstd * a0.x; v[1] *= rstd * a0.y; v[2] *= rstd * a0.z; v[3] *= rstd * a0.w; v[4] *= rstd * a1.x; v[5] *= rstd * a1.y; v[6] *= rstd * a1.z; v[7] *= rstd * a1.w;
                v[8] *= rstd * a2.x; v[9] *= rstd * a2.y; v[10] *= rstd * a2.z; v[11] *= rstd * a2.w; v[12] *= rstd * a3.x; v[13] *= rstd * a3.y; v[14] *= rstd * a3.z; v[15] *= rstd * a3.w;
            }
            uint4 o0, o1;
            o0.x = pk2(v[0], v[1]); o0.y = pk2(v[2], v[3]); o0.z = pk2(v[4], v[5]); o0.w = pk2(v[6], v[7]);
            o1.x = pk2(v[8], v[9]); o1.y = pk2(v[10], v[11]); o1.z = pk2(v[12], v[13]); o1.w = pk2(v[14], v[15]);
            *(uint4*)(hn + (size_t)r * DM + c0) = o0;
            *(uint4*)(hn + (size_t)r * DM + c1) = o1;
            float mine = 0.f;
#pragma unroll 1
            for (int c = 0; c < 16; ++c) {
                const float* gwc = gw + c * 1024;
                const float4 w0 = *(const float4*)(gwc + c0), w1 = *(const float4*)(gwc + c0 + 4), w2 = *(const float4*)(gwc + c1), w3 = *(const float4*)(gwc + c1 + 4);
                float s = v[0] * w0.x + v[1] * w0.y + v[2] * w0.z + v[3] * w0.w + v[4] * w1.x + v[5] * w1.y + v[6] * w1.z + v[7] * w1.w
                        + v[8] * w2.x + v[9] * w2.y + v[10] * w2.z + v[11] * w2.w + v[12] * w3.x + v[13] * w3.y + v[14] * w3.z + v[15] * w3.w;
                s = wave_sum(s);
                if (lane == c) mine = s;
            }
            if (lane < 16) {
                float val;
                if (lane < 4) val = mine + P.b_igate[lane];
                else if (lane < 8) val = logsigmoidf(mine + P.b_fgate_m[lane - 4]);
                else val = logsigmoidf(mine + P.b_fgate_f[lane - 8]);
                gates[(size_t)r * 16 + lane] = val;
            }
        }
    }
    __syncthreads();
    {
        float (*tile)[65] = (float (*)[65])smem;
        for (int item = blockIdx.x; item < 1664; item += gridDim.x) {
            const float* W; int ldn, ntn, shift_from, it; bf16_t* out;
            if (item < 896) { W = P.w_in; ldn = PROJ; ntn = 56; shift_from = 2048; it = item; out = (bf16_t*)(P.ws + WS_BT1); }
            else if (item < 1152) { W = P.w_out; ldn = 1024; ntn = 16; shift_from = 1 << 30; it = item - 896; out = (bf16_t*)(P.ws + WS_BT2); }
            else { W = P.peer_query; ldn = 2048; ntn = 32; shift_from = 1 << 30; it = item - 1152; out = (bf16_t*)(P.ws + WS_BT3); }
            const int tk = it / ntn, tn = it - tk * ntn, k0 = tk * 64, n0 = tn * 64;
            {
                const int nl = tid & 63;
                int n = n0 + nl; if (n >= shift_from) n += 8;
#pragma unroll
                for (int i = 0; i < 16; ++i) { const int kl = (tid >> 6) + 4 * i; tile[kl][nl] = W[(size_t)(k0 + kl) * ldn + n]; }
            }
            __syncthreads();
            {
                const int kl = tid & 63;
#pragma unroll
                for (int i = 0; i < 16; ++i) { const int nl = (tid >> 6) + 4 * i; out[(size_t)(n0 + nl) * 1024 + k0 + kl] = (bf16_t)f2bf(tile[kl][nl]); }
            }
            __syncthreads();
        }
    }
    {
        const size_t gt = (size_t)blockIdx.x * 256 + tid, gs = (size_t)gridDim.x * 256;
        const float* src = P.peer_keys; bf16_t* dst = (bf16_t*)(P.ws + WS_KEYS);
        for (size_t i = gt; i < (size_t)(16 * 128 * 128 / 8); i += gs) {
            const float4 a = *(const float4*)(src + i * 8), b = *(const float4*)(src + i * 8 + 4);
            uint4 o; o.x = pk2(a.x, a.y); o.y = pk2(a.z, a.w); o.z = pk2(b.x, b.y); o.w = pk2(b.z, b.w);
            *(uint4*)(dst + i * 8) = o;
        }
    }
}

__device__ __forceinline__ void convert_uv_slice(const Params& P, int part, int nparts) {
    const size_t n8 = (size_t)16384 * 1024 / 8;
    const size_t per = (n8 + nparts - 1) / nparts, lo = per * part, hi = (lo + per < n8) ? lo + per : n8;
    for (int which = 0; which < 2; ++which) {
        const float* src = which ? P.peer_v : P.peer_u;
        bf16_t* dst = (bf16_t*)(P.ws + (which ? WS_V : WS_U));
        for (size_t i = lo + threadIdx.x; i < hi; i += 256) {
            const float4 a = *(const float4*)(src + i * 8), b = *(const float4*)(src + i * 8 + 4);
            uint4 o; o.x = pk2(a.x, a.y); o.y = pk2(a.z, a.w); o.z = pk2(b.x, b.y); o.w = pk2(b.z, b.w);
            *(uint4*)(dst + i * 8) = o;
        }
    }
}

__device__ __forceinline__ void mma_ktile(const unsigned char* sA, const unsigned char* sB, int arow_off, int brow_off, int g, int sw, f32x4 (&acc)[4][4]) {
#pragma unroll
    for (int s = 0; s < 2; ++s) {
        bf16x8 a[4], b[4];
        const int ch = (((s * 4 + g) ^ sw) << 4);
#pragma unroll
        for (int i = 0; i < 4; ++i) a[i] = *(const bf16x8*)(sA + arow_off + i * 2048 + ch);
#pragma unroll
        for (int j = 0; j < 4; ++j) b[j] = *(const bf16x8*)(sB + brow_off + j * 2048 + ch);
#pragma unroll
        for (int i = 0; i < 4; ++i)
#pragma unroll
            for (int j = 0; j < 4; ++j) acc[i][j] = __builtin_amdgcn_mfma_f32_16x16x32_bf16(b[j], a[i], acc[i][j], 0, 0, 0);
    }
}

__device__ __forceinline__ void store_tile_bf16(const f32x4 (&acc)[4][4], unsigned char* smem, bf16_t* dst, size_t ld, int m0, int n0, int tid, int wr, int wc, int g, int lr) {
#pragma unroll
    for (int i = 0; i < 4; ++i)
#pragma unroll
        for (int j = 0; j < 4; ++j) {
            const int row = wr * 64 + 16 * i + lr, col = wc * 64 + 16 * j + 4 * g;
            uint2 w; w.x = pk2(acc[i][j][0], acc[i][j][1]); w.y = pk2(acc[i][j][2], acc[i][j][3]);
            *(uint2*)(smem + row * 272 + col * 2) = w;
        }
    __syncthreads();
#pragma unroll
    for (int q = 0; q < 8; ++q) {
        const int id = tid + 256 * q, row = id >> 4, ch = id & 15;
        const uint4 v = *(const uint4*)(smem + row * 272 + ch * 16);
        *(uint4*)(dst + (size_t)(m0 + row) * ld + n0 + ch * 8) = v;
    }
    __syncthreads();
}

template <int MODE>
__device__ __forceinline__ void gemm_tile(const Params& P, int tm, int tn, unsigned char* smem) {
    const bf16_t* A; const bf16_t* Bt;
    if (MODE == 1) { A = (const bf16_t*)(P.ws + WS_RA); Bt = (const bf16_t*)(P.ws + WS_BT1); }
    else if (MODE == 2) { A = (const bf16_t*)(P.ws + WS_Y); Bt = (const bf16_t*)(P.ws + WS_BT2); }
    else { A = (const bf16_t*)(P.ws + WS_XN); Bt = (const bf16_t*)(P.ws + WS_BT3); }
    const int tid = threadIdx.x, lane = tid & 63, wave = tid >> 6, wr = wave >> 1, wc = wave & 1, g = lane >> 4, lr = lane & 15;
    const int m0 = tm * 128, n0 = tn * 128;
    const int srow = tid >> 3, sc = tid & 7;
    const bf16_t* aptr[4]; const bf16_t* bptr[4]; int soff[4];
#pragma unroll
    for (int j = 0; j < 4; ++j) {
        const int row = srow + 32 * j;
        int ar = m0 + row;
        if (MODE == 2) { const int b = ar >> 11, t = ar & 2047; ar = b * L + NMETA + t; }
        aptr[j] = A + (size_t)ar * 1024 + sc * 8;
        bptr[j] = Bt + (size_t)(n0 + row) * 1024 + sc * 8;
        soff[j] = row * 128 + ((sc ^ (row & 7)) << 4);
    }
    f32x4 acc[4][4];
#pragma unroll
    for (int i = 0; i < 4; ++i)
#pragma unroll
        for (int j = 0; j < 4; ++j) acc[i][j] = (f32x4){0.f, 0.f, 0.f, 0.f};
    uint4 ra[4], rb[4];
#pragma unroll
    for (int j = 0; j < 4; ++j) { ra[j] = *(const uint4*)(aptr[j]); rb[j] = *(const uint4*)(bptr[j]); }
    const float* ssqm_row[4];
    if (MODE == 2) {
#pragma unroll
        for (int j = 0; j < 4; ++j) {
            int ar = m0 + srow + 32 * j; { const int b = ar >> 11, t = ar & 2047; ar = b * L + NMETA + t; }
            ssqm_row[j] = (const float*)(P.ws + WS_SSQM) + (size_t)ar * 16;
            const float4 q4 = *(const float4*)(ssqm_row[j]);
            const float rs = rsqrtf(((q4.x + q4.y) + (q4.z + q4.w)) * (1.0f / 128.0f) + EPS);
            ra[j].x = pk2(bflo(ra[j].x) * rs, bfhi(ra[j].x) * rs); ra[j].y = pk2(bflo(ra[j].y) * rs, bfhi(ra[j].y) * rs);
            ra[j].z = pk2(bflo(ra[j].z) * rs, bfhi(ra[j].z) * rs); ra[j].w = pk2(bflo(ra[j].w) * rs, bfhi(ra[j].w) * rs);
        }
    }
    unsigned char* sA0 = smem; unsigned char* sB0 = smem + 16384; unsigned char* sA1 = smem + 32768; unsigned char* sB1 = smem + 49152;
#pragma unroll
    for (int j = 0; j < 4; ++j) { *(uint4*)(sA0 + soff[j]) = ra[j]; *(uint4*)(sB0 + soff[j]) = rb[j]; }
    __syncthreads();
    const int arow_off = (wr * 64 + lr) * 128, brow_off = (wc * 64 + lr) * 128, sw = lr & 7;
    for (int kt = 0; kt < 16; ++kt) {
        unsigned char* sA = (kt & 1) ? sA1 : sA0; unsigned char* sB = (kt & 1) ? sB1 : sB0;
        unsigned char* nA = (kt & 1) ? sA0 : sA1; unsigned char* nB = (kt & 1) ? sB0 : sB1;
        if (kt < 15) {
#pragma unroll
            for (int j = 0; j < 4; ++j) { ra[j] = *(const uint4*)(aptr[j] + (kt + 1) * 64); rb[j] = *(const uint4*)(bptr[j] + (kt + 1) * 64); }
            if (MODE == 2 && kt + 1 < 8) {
                const int head = (kt + 1) >> 1;
#pragma unroll
                for (int j = 0; j < 4; ++j) {
                    const float4 q4 = *(const float4*)(ssqm_row[j] + head * 4);
                    const float rs = rsqrtf(((q4.x + q4.y) + (q4.z + q4.w)) * (1.0f / 128.0f) + EPS);
                    ra[j].x = pk2(bflo(ra[j].x) * rs, bfhi(ra[j].x) * rs); ra[j].y = pk2(bflo(ra[j].y) * rs, bfhi(ra[j].y) * rs);
                    ra[j].z = pk2(bflo(ra[j].z) * rs, bfhi(ra[j].z) * rs); ra[j].w = pk2(bflo(ra[j].w) * rs, bfhi(ra[j].w) * rs);
                }
            }
        }
        mma_ktile(sA, sB, arow_off, brow_off, g, sw, acc);
        if (kt < 15) {
#pragma unroll
            for (int j = 0; j < 4; ++j) { *(uint4*)(nA + soff[j]) = ra[j]; *(uint4*)(nB + soff[j]) = rb[j]; }
        }
        __syncthreads();
    }
    if (MODE == 1) {
        if (n0 >= ZC_FQ && n0 < ZC_FV) {
            const bool isk = n0 >= ZC_FK;
            const float* gain = isk ? P.f_k_norm : P.f_q_norm;
            const float scl = isk ? 1.0f : 0.125f * LOG2E;
            float gn[4][4];
#pragma unroll
            for (int j = 0; j < 4; ++j)
#pragma unroll
                for (int r = 0; r < 4; ++r) gn[j][r] = gain[16 * j + 4 * g + r];
#pragma unroll
            for (int i = 0; i < 4; ++i) {
                float ss = 0.f;
#pragma unroll
                for (int j = 0; j < 4; ++j)
#pragma unroll
                    for (int r = 0; r < 4; ++r) ss += acc[i][j][r] * acc[i][j][r];
                ss += __shfl_xor(ss, 16, 64); ss += __shfl_xor(ss, 32, 64);
                const float rstd = rsqrtf(ss * (1.0f / 64.0f) + EPS) * scl;
#pragma unroll
                for (int j = 0; j < 4; ++j)
#pragma unroll
                    for (int r = 0; r < 4; ++r) acc[i][j][r] *= rstd * gn[j][r];
            }
        }
        store_tile_bf16(acc, smem, (bf16_t*)(P.ws + WS_Z), NZ, m0, n0, tid, wr, wc, g, lr);
    } else if (MODE == 2) {
        float* ssq = (float*)(P.ws + WS_SSQ);
#pragma unroll
        for (int i = 0; i < 4; ++i) {
            const int row = m0 + wr * 64 + 16 * i + lr;
            float ss = 0.f;
#pragma unroll
            for (int j = 0; j < 4; ++j) {
                const int col = n0 + wc * 64 + 16 * j + 4 * g;
                const float4 xv = *(const float4*)(P.x + (size_t)row * DM + col);
                const float4 gv = *(const float4*)(P.norm_ffn + col);
                float4 hv; hv.x = acc[i][j][0] + xv.x; hv.y = acc[i][j][1] + xv.y; hv.z = acc[i][j][2] + xv.z; hv.w = acc[i][j][3] + xv.w;
                *(float4*)(P.out + (size_t)row * DM + col) = hv;
                ss += hv.x * hv.x + hv.y * hv.y + hv.z * hv.z + hv.w * hv.w;
                acc[i][j][0] = hv.x * gv.x; acc[i][j][1] = hv.y * gv.y; acc[i][j][2] = hv.z * gv.z; acc[i][j][3] = hv.w * gv.w;
            }
            ss += __shfl_xor(ss, 16, 64); ss += __shfl_xor(ss, 32, 64);
            if (g == 0) ssq[(size_t)row * 16 + tn * 2 + wc] = ss;
        }
        store_tile_bf16(acc, smem, (bf16_t*)(P.ws + WS_XN), 1024, m0, n0, tid, wr, wc, g, lr);
    } else {
        const int hp = tn;
        const float* ssq = (const float*)(P.ws + WS_SSQ);
        float rs[4];
#pragma unroll
        for (int i = 0; i < 4; ++i) {
            const int row = m0 + wr * 64 + 16 * i + lr;
            const float4 p0 = *(const float4*)(ssq + (size_t)row * 16), p1 = *(const float4*)(ssq + (size_t)row * 16 + 4);
            const float4 p2 = *(const float4*)(ssq + (size_t)row * 16 + 8), p3 = *(const float4*)(ssq + (size_t)row * 16 + 12);
            const float s = ((p0.x + p0.y) + (p0.z + p0.w)) + ((p1.x + p1.y) + (p1.z + p1.w)) + ((p2.x + p2.y) + (p2.z + p2.w)) + ((p3.x + p3.y) + (p3.z + p3.w));
            rs[i] = rsqrtf(s * (1.0f / DM) + EPS);
            if (tn == 0 && wc == 0 && g == 0) ((float*)(P.ws + WS_RSTD))[row] = rs[i];
        }
        {
            unsigned char* sAq = wc ? sA1 : sA0;
#pragma unroll
            for (int i = 0; i < 4; ++i)
#pragma unroll
                for (int j = 0; j < 4; ++j) {
                    const int row = wr * 64 + 16 * i + lr;
                    const int chunk = 2 * j + (g >> 1);
                    uint2 w; w.x = pk2(acc[i][j][0] * rs[i], acc[i][j][1] * rs[i]); w.y = pk2(acc[i][j][2] * rs[i], acc[i][j][3] * rs[i]);
                    *(uint2*)(sAq + row * 128 + ((chunk ^ (row & 7)) << 4) + 8 * (g & 1)) = w;
                }
            const bf16_t* keys = (const bf16_t*)(P.ws + WS_KEYS) + (size_t)hp * 128 * 128;
#pragma unroll
            for (int j = 0; j < 4; ++j) {
                const int row = srow + 32 * j;
                const uint4 k0 = *(const uint4*)(keys + (size_t)row * 128 + sc * 8);
                const uint4 k1 = *(const uint4*)(keys + (size_t)row * 128 + 64 + sc * 8);
                *(uint4*)(sB0 + soff[j]) = k0; *(uint4*)(sB1 + soff[j]) = k1;
            }
        }
        __syncthreads();
#pragma unroll
        for (int i = 0; i < 4; ++i)
#pragma unroll
            for (int j = 0; j < 4; ++j) acc[i][j] = (f32x4){0.f, 0.f, 0.f, 0.f};
        mma_ktile(sA0, sB0, arow_off, brow_off, g, sw, acc);
        mma_ktile(sA1, sB1, arow_off, brow_off, g, sw, acc);
        __syncthreads();
#pragma unroll
        for (int i = 0; i < 4; ++i)
#pragma unroll
            for (int j = 0; j < 4; ++j) {
                const int row = wr * 64 + 16 * i + lr;
                const int c4 = wc * 16 + 4 * j + g;
                *(f32x4*)(smem + row * 512 + ((c4 ^ (row & 31)) << 4)) = acc[i][j];
            }
        __syncthreads();
        unsigned top[16];
#pragma unroll
        for (int q = 0; q < 16; ++q) top[q] = 0u;
        const int row = tid & 127, half = tid >> 7;
#pragma unroll 1
        for (int s = 0; s < 16; ++s) {
            const int c4 = half * 16 + s;
            const f32x4 v = *(const f32x4*)(smem + row * 512 + ((c4 ^ (row & 31)) << 4));
#pragma unroll
            for (int e = 0; e < 4; ++e) {
                unsigned kx = (ord_key(v[e]) & ~127u) | (unsigned)(127 - (c4 * 4 + e));
#pragma unroll
                for (int q = 0; q < 16; ++q) { const unsigned hi = max(top[q], kx), lo = min(top[q], kx); top[q] = hi; kx = lo; }
            }
        }
        __syncthreads();
        if (half) {
            uint4* lp = (uint4*)(smem + row * 64);
            lp[0] = make_uint4(top[0], top[1], top[2], top[3]); lp[1] = make_uint4(top[4], top[5], top[6], top[7]);
            lp[2] = make_uint4(top[8], top[9], top[10], top[11]); lp[3] = make_uint4(top[12], top[13], top[14], top[15]);
        }
        __syncthreads();
        if (!half) {
            const uint4* lp = (const uint4*)(smem + row * 64);
#pragma unroll
            for (int c = 0; c < 4; ++c) {
                const uint4 o = lp[c];
                unsigned ks[4] = {o.x, o.y, o.z, o.w};
#pragma unroll
                for (int e = 0; e < 4; ++e) {
                    unsigned kx = ks[e];
#pragma unroll
                    for (int q = 0; q < 16; ++q) { const unsigned hi = max(top[q], kx), lo = min(top[q], kx); top[q] = hi; kx = lo; }
                }
            }
            uint4* tk = (uint4*)((unsigned*)(P.ws + WS_RA) + ((size_t)(m0 + row) * 16 + hp) * 16);
            tk[0] = make_uint4(top[0], top[1], top[2], top[3]); tk[1] = make_uint4(top[4], top[5], top[6], top[7]);
            tk[2] = make_uint4(top[8], top[9], top[10], top[11]); tk[3] = make_uint4(top[12], top[13], top[14], top[15]);
        }
        __syncthreads();
    }
}

__device__ __forceinline__ void fox_cum_wave(const Params& P, int bh, int lane) {
    const int b = bh >> 3, h = bh & 7;
    const float* gates = (const float*)(P.ws + WS_GATES);
    float* cum = (float*)(P.ws + WS_CUM) + (size_t)bh * L;
    constexpr int SEG = 33;
    const int t0 = lane * SEG;
    float loc = 0.f;
    for (int i = 0; i < SEG; ++i) { const int t = t0 + i; if (t < L) loc += gates[(size_t)(b * L + t) * 16 + 8 + h]; }
    float incl = loc;
#pragma unroll
    for (int o = 1; o < 64; o <<= 1) { const float n = __shfl_up(incl, o, 64); if (lane >= o) incl += n; }
    float run = incl - loc;
    for (int i = 0; i < SEG; ++i) { const int t = t0 + i; if (t < L) { run += gates[(size_t)(b * L + t) * 16 + 8 + h]; cum[t] = run * LOG2E; } }
}

#define TR_SLOW 0
__device__ __forceinline__ unsigned cvt_pk_bf16(float lo, float hi) { unsigned r; asm volatile("v_cvt_pk_bf16_f32 %0, %1, %2" : "=v"(r) : "v"(lo), "v"(hi)); return r; }
__device__ __forceinline__ int vimg_off(int row, int ch) { return row * 128 + ((ch ^ (((row >> 1) & 3) << 1)) << 4); }
__device__ __forceinline__ uint2 tr_frag(const unsigned char* img, int row0, int c, int g, int lr) {
#if TR_SLOW
    unsigned short e[4];
#pragma unroll
    for (int k = 0; k < 4; ++k) { const int row = row0 + 4 * g + k, col = 16 * c + lr; e[k] = *(const unsigned short*)(img + vimg_off(row, col >> 3) + (col & 7) * 2); }
    uint2 r; r.x = (unsigned)e[0] | ((unsigned)e[1] << 16); r.y = (unsigned)e[2] | ((unsigned)e[3] << 16); return r;
#else
    const int q = lr >> 2, p = lr & 3, row = row0 + 4 * g + q;
    const unsigned addr = (unsigned)(size_t)(img + vimg_off(row, 2 * c + (p >> 1)) + 8 * (p & 1));
    uint2 r;
    asm volatile("ds_read_b64_tr_b16 %0, %1\n\ts_waitcnt lgkmcnt(0)" : "=&v"(r) : "v"(addr) : "memory");
    return r;
#endif
}

__device__ __forceinline__ void attn_block(const Params& P, int bh, int qb, unsigned char* smem) {
    const int tid = threadIdx.x, lane = tid & 63, w = tid >> 6, g = lane >> 4, lr = lane & 15;
    const int b = bh >> 3, h = bh & 7;
    const bf16_t* z = (const bf16_t*)(P.ws + WS_Z);
    const float* cum = (const float*)(P.ws + WS_CUM) + (size_t)bh * L;
    const int tq = qb * 64 + 16 * w + lr;
    const bool qvalid = tq < L;
    bf16x8 qf[2];
    {
        const bf16_t* qp = z + (size_t)(b * L + (qvalid ? tq : 0)) * NZ + ZC_FQ + h * 64 + 8 * g;
        qf[0] = *(const bf16x8*)(qp); qf[1] = *(const bf16x8*)(qp + 32);
    }
    const float cq = cum[qvalid ? tq : 0];
    const int srow0 = tid >> 3, sch = tid & 7;
    uint4 rk[2], rv[2]; float rc = 0.f;
    auto load_tile = [&](int kv) {
#pragma unroll
        for (int j = 0; j < 2; ++j) {
            const int key = kv * 64 + srow0 + 32 * j;
            if (key < L) {
                const bf16_t* p = z + (size_t)(b * L + key) * NZ + h * 64 + sch * 8;
                rk[j] = *(const uint4*)(p + ZC_FK); rv[j] = *(const uint4*)(p + ZC_FV);
            } else { rk[j] = make_uint4(0, 0, 0, 0); rv[j] = make_uint4(0, 0, 0, 0); }
        }
        if (tid < 64) { const int key = kv * 64 + tid; rc = key < L ? cum[key] : 0.f; }
    };
    auto store_tile = [&](int buf) {
        unsigned char* sK = smem + buf * 16384; unsigned char* sV = sK + 8192;
#pragma unroll
        for (int j = 0; j < 2; ++j) {
            const int row = srow0 + 32 * j;
            *(uint4*)(sK + row * 128 + ((sch ^ (row & 7)) << 4)) = rk[j];
            *(uint4*)(sV + vimg_off(row, sch)) = rv[j];
        }
        if (tid < 64) ((float*)(smem + 32768 + buf * 256))[tid] = rc;
    };
    float m = -INFINITY, lsum = 0.f;
    f32x4 o[4];
#pragma unroll
    for (int c = 0; c < 4; ++c) o[c] = (f32x4){0.f, 0.f, 0.f, 0.f};
    load_tile(0); store_tile(0);
    __syncthreads();
    for (int kv = 0; kv <= qb; ++kv) {
        const int buf = kv & 1;
        if (kv < qb) load_tile(kv + 1);
        const unsigned char* sK = smem + buf * 16384; const unsigned char* sV = sK + 8192;
        const float* sck = (const float*)(smem + 32768 + buf * 256);
        f32x4 sa[4];
#pragma unroll
        for (int c = 0; c < 4; ++c) {
            sa[c] = (f32x4){0.f, 0.f, 0.f, 0.f};
#pragma unroll
            for (int s = 0; s < 2; ++s) {
                const bf16x8 kf = *(const bf16x8*)(sK + (16 * c + lr) * 128 + (((4 * s + g) ^ (lr & 7)) << 4));
                sa[c] = __builtin_amdgcn_mfma_f32_16x16x32_bf16(kf, qf[s], sa[c], 0, 0, 0);
            }
        }
        const bool diag = (kv == qb);
        float mx = -INFINITY;
#pragma unroll
        for (int c = 0; c < 4; ++c) {
            const f32x4 ck = *(const f32x4*)(sck + 16 * c + 4 * g);
#pragma unroll
            for (int r = 0; r < 4; ++r) {
                float v = sa[c][r] + (cq - ck[r]);
                if (diag && (16 * c + 4 * g + r > 16 * w + lr)) v = -INFINITY;
                sa[c][r] = v; mx = fmaxf(mx, v);
            }
        }
        mx = fmaxf(mx, __shfl_xor(mx, 16, 64)); mx = fmaxf(mx, __shfl_xor(mx, 32, 64));
        const float mn = fmaxf(m, mx);
        const float alpha = __builtin_amdgcn_exp2f(m - mn);
        m = mn;
        float ps = 0.f;
#pragma unroll
        for (int c = 0; c < 4; ++c)
#pragma unroll
            for (int r = 0; r < 4; ++r) { const float p = __builtin_amdgcn_exp2f(sa[c][r] - mn); sa[c][r] = p; ps += p; }
        lsum = lsum * alpha + ps;
#pragma unroll
        for (int c = 0; c < 4; ++c) o[c] *= alpha;
        bf16x8 pf[2];
#pragma unroll
        for (int s2 = 0; s2 < 2; ++s2) {
            uint4 u;
            u.x = cvt_pk_bf16(sa[2 * s2][0], sa[2 * s2][1]); u.y = cvt_pk_bf16(sa[2 * s2][2], sa[2 * s2][3]);
            u.z = cvt_pk_bf16(sa[2 * s2 + 1][0], sa[2 * s2 + 1][1]); u.w = cvt_pk_bf16(sa[2 * s2 + 1][2], sa[2 * s2 + 1][3]);
            pf[s2] = __builtin_bit_cast(bf16x8, u);
        }
#pragma unroll
        for (int c = 0; c < 4; ++c)
#pragma unroll
            for (int s2 = 0; s2 < 2; ++s2) {
                const uint2 lo = tr_frag(sV, 32 * s2, c, g, lr), hi = tr_frag(sV, 32 * s2 + 16, c, g, lr);
                uint4 u; u.x = lo.x; u.y = lo.y; u.z = hi.x; u.w = hi.y;
                o[c] = __builtin_amdgcn_mfma_f32_16x16x32_bf16(__builtin_bit_cast(bf16x8, u), pf[s2], o[c], 0, 0, 0);
            }
        if (kv < qb) store_tile(buf ^ 1);
        __syncthreads();
    }
    lsum += __shfl_xor(lsum, 16, 64); lsum += __shfl_xor(lsum, 32, 64);
    const float inv = 1.0f / lsum;
    if (qvalid) {
        bf16_t* y = (bf16_t*)(P.ws + WS_Y) + (size_t)(b * L + tq) * DM + 512 + h * 64 + 4 * g;
#pragma unroll
        for (int c = 0; c < 4; ++c) {
            uint2 u; u.x = pk2(o[c][0] * inv, o[c][1] * inv); u.y = pk2(o[c][2] * inv, o[c][3] * inv);
            *(uint2*)(y + 16 * c) = u;
        }
    }
}

__device__ __forceinline__ void conv_item(const Params& P, int ci) {
    const int tid = threadIdx.x, cc = tid & 127, rg = tid >> 7;
    const bf16_t* z = (const bf16_t*)(P.ws + WS_Z);
    bf16_t* qk = (bf16_t*)(P.ws + WS_RA);
    const int col0 = cc * 8;
    float w[4][8];
#pragma unroll
    for (int j = 0; j < 4; ++j) {
        const float4 a = *(const float4*)(P.conv_qk + j * 1024 + col0), b = *(const float4*)(P.conv_qk + j * 1024 + col0 + 4);
        w[j][0] = a.x; w[j][1] = a.y; w[j][2] = a.z; w[j][3] = a.w; w[j][4] = b.x; w[j][5] = b.y; w[j][6] = b.z; w[j][7] = b.w;
    }
    const float oscale = (col0 >= 512) ? 0.08838834764831845f : 1.0f;
    const int r0 = ci * 64 + rg * 32;
    int t = r0 % L;
    float xw[3][8];
#pragma unroll
    for (int j = 0; j < 3; ++j) {
        const int back = 3 - j;
        if (t - back >= 0) {
            const uint4 v = *(const uint4*)(z + (size_t)(r0 - back) * NZ + col0);
            xw[j][0] = bflo(v.x); xw[j][1] = bfhi(v.x); xw[j][2] = bflo(v.y); xw[j][3] = bfhi(v.y); xw[j][4] = bflo(v.z); xw[j][5] = bfhi(v.z); xw[j][6] = bflo(v.w); xw[j][7] = bfhi(v.w);
        } else {
#pragma unroll
            for (int e = 0; e < 8; ++e) xw[j][e] = 0.f;
        }
    }
#pragma unroll 2
    for (int i = 0; i < 32; ++i) {
        const int r = r0 + i;
        if (t == 0) {
#pragma unroll
            for (int j = 0; j < 3; ++j)
#pragma unroll
                for (int e = 0; e < 8; ++e) xw[j][e] = 0.f;
        }
        const uint4 v = *(const uint4*)(z + (size_t)r * NZ + col0);
        float xt[8];
        xt[0] = bflo(v.x); xt[1] = bfhi(v.x); xt[2] = bflo(v.y); xt[3] = bfhi(v.y); xt[4] = bflo(v.z); xt[5] = bfhi(v.z); xt[6] = bflo(v.w); xt[7] = bfhi(v.w);
        float o[8];
#pragma unroll
        for (int e = 0; e < 8; ++e) {
            const float cv = w[0][e] * xw[0][e] + w[1][e] * xw[1][e] + w[2][e] * xw[2][e] + w[3][e] * xt[e];
            o[e] = oscale * cv / (1.f + __expf(-cv));
            xw[0][e] = xw[1][e]; xw[1][e] = xw[2][e]; xw[2][e] = xt[e];
        }
        uint4 ov; ov.x = pk2(o[0], o[1]); ov.y = pk2(o[2], o[3]); ov.z = pk2(o[4], o[5]); ov.w = pk2(o[6], o[7]);
        *(uint4*)(qk + (size_t)r * 1024 + col0) = ov;
        t = (t + 1 == L) ? 0 : t + 1;
    }
}

__device__ __forceinline__ void mlstm_block(const Params& P, int mi, unsigned char* smem) {
    const int tid = threadIdx.x, lane = tid & 63, w = tid >> 6, g = lane >> 4, lr = lane & 15;
    const int wu = __builtin_amdgcn_readfirstlane(w);
    const int b = mi >> 4, h = (mi >> 2) & 3, dq = mi & 3;
    const bf16_t* z = (const bf16_t*)(P.ws + WS_Z);
    const bf16_t* qk = (const bf16_t*)(P.ws + WS_RA);
    const float* gates = (const float*)(P.ws + WS_GATES);
    bf16_t* y = (bf16_t*)(P.ws + WS_Y);
    float* ssqm = (float*)(P.ws + WS_SSQM);
    unsigned char* sCb = smem + 49152;
    for (int i = tid; i < 12288 / 16; i += 256) *(uint4*)(sCb + i * 16) = make_uint4(0, 0, 0, 0);
    if (tid < 128) {
        const int row = tid >> 1, ch = 4 + (tid & 1);
        const uint4 v = (tid & 1) ? make_uint4(0, 0, 0, 0) : make_uint4(0x3F80u, 0, 0, 0);
        *(uint4*)(smem + 16384 + vimg_off(row, ch)) = v;
        *(uint4*)(smem + 24576 + 16384 + vimg_off(row, ch)) = v;
    }
    const float* gainp = P.m_out_norm + h * 128 + dq * 32 + 4 * g;
    f32x4 Ct[2][3];
#pragma unroll
    for (int a = 0; a < 2; ++a)
#pragma unroll
        for (int c = 0; c < 3; ++c) Ct[a][c] = (f32x4){0.f, 0.f, 0.f, 0.f};
    float m_prev = 0.f;
    uint4 pk_[4]; uint4 pv_ = make_uint4(0, 0, 0, 0); bf16x8 qf[4]; float plf = 0.f, pli = 0.f;
    auto load_q = [&](int k) {
        const int pos = 64 * k + 16 * w + lr;
        const bf16_t* qp = qk + (size_t)(b * L + (pos < L ? pos : 0)) * 1024 + h * 128 + 8 * g;
#pragma unroll
        for (int ks = 0; ks < 4; ++ks) { qf[ks] = *(const bf16x8*)(qp + 32 * ks); if (pos >= L) qf[ks] = (bf16x8){0, 0, 0, 0, 0, 0, 0, 0}; }
    };
    auto prefetch = [&](int k) {
#pragma unroll
        for (int j = 0; j < 4; ++j) {
            const int id = tid + 256 * j, row = id >> 4, ch16 = id & 15, pos = 64 * k + row;
            pk_[j] = (pos < L) ? *(const uint4*)(qk + (size_t)(b * L + pos) * 1024 + 512 + h * 128 + ch16 * 8) : make_uint4(0, 0, 0, 0);
        }
        {
            const int row = tid >> 2, ch = tid & 3, pos = 64 * k + row;
            pv_ = (pos < L) ? *(const uint4*)(z + (size_t)(b * L + pos) * NZ + ZC_MV + h * 128 + dq * 32 + ch * 8) : make_uint4(0, 0, 0, 0);
        }
        if (wu == 0) {
            const int pos = 64 * k + lane;
            if (pos < L) { plf = gates[(size_t)(b * L + pos) * 16 + 4 + h]; pli = gates[(size_t)(b * L + pos) * 16 + h]; }
            else { plf = 0.f; pli = -INFINITY; }
        }
    };
    auto stage = [&](int buf) {
        unsigned char* sK = smem + buf * 24576; unsigned char* sV = sK + 16384;
#pragma unroll
        for (int j = 0; j < 4; ++j) {
            const int id = tid + 256 * j, row = id >> 4, ch16 = id & 15;
            *(uint4*)(sK + (ch16 >> 3) * 8192 + vimg_off(row, ch16 & 7)) = pk_[j];
        }
        { const int row = tid >> 2, ch = tid & 3; *(uint4*)(sV + vimg_off(row, ch)) = pv_; }
        if (wu == 0) {
            float* ga = (float*)(smem + 61440 + buf * 1296);
            float bc = plf;
#pragma unroll
            for (int o = 1; o < 64; o <<= 1) { const float n = __shfl_up(bc, o, 64); if (lane >= o) bc += n; }
            const float a = pli - bc;
            float am = a;
#pragma unroll
            for (int o = 1; o < 64; o <<= 1) { const float n = __shfl_up(am, o, 64); if (lane >= o) am = fmaxf(am, n); }
            const float M = fmaxf(m_prev, am);
            const float M63 = __shfl(M, 63, 64), b63 = __shfl(bc, 63, 64);
            ga[lane] = a; ga[64 + lane] = __expf(a - M63); ga[128 + lane] = __expf(m_prev - M); ga[192 + lane] = __expf(-(bc + M)); ga[256 + lane] = M;
            if (lane == 0) ga[320] = __expf(m_prev - M63);
            m_prev = b63 + M63;
        }
    };
    prefetch(0); load_q(0);
    __syncthreads();
    stage(0);
    __syncthreads();
    constexpr int NCH = (L + 63) / 64;
    for (int k = 0; k < NCH; ++k) {
        const int buf = k & 1;
        const unsigned char* sK = smem + buf * 24576; const unsigned char* sV = sK + 16384;
        const float* ga = (const float*)(smem + 61440 + buf * 1296);
        const int pos = 64 * k + 16 * w + lr;
        const bool tvalid = pos < L;
        const size_t rrow = (size_t)(b * L + (tvalid ? pos : 0));
        if (k + 1 < NCH) prefetch(k + 1);
        const float Mt = ga[256 + 16 * w + lr], Wi = ga[128 + 16 * w + lr];
        bf16x8 pf[2];
        {
            f32x4 sa[4];
#pragma unroll
            for (int c = 0; c < 4; ++c) {
                sa[c] = (f32x4){0.f, 0.f, 0.f, 0.f};
                if (c <= wu) {
#pragma unroll
                    for (int ks = 0; ks < 4; ++ks) {
                        const bf16x8 kf = *(const bf16x8*)(sK + (ks >> 1) * 8192 + vimg_off(16 * c + lr, 4 * (ks & 1) + g));
                        sa[c] = __builtin_amdgcn_mfma_f32_16x16x32_bf16(kf, qf[ks], sa[c], 0, 0, 0);
                    }
                    const f32x4 av = *(const f32x4*)(ga + 16 * c + 4 * g);
#pragma unroll
                    for (int r = 0; r < 4; ++r) {
                        const float d = __expf(av[r] - Mt);
                        sa[c][r] = (16 * c + 4 * g + r <= 16 * w + lr) ? sa[c][r] * d : 0.f;
                    }
                }
            }
#pragma unroll
            for (int s2 = 0; s2 < 2; ++s2) {
                uint4 u;
                u.x = cvt_pk_bf16(sa[2 * s2][0], sa[2 * s2][1]); u.y = cvt_pk_bf16(sa[2 * s2][2], sa[2 * s2][3]);
                u.z = cvt_pk_bf16(sa[2 * s2 + 1][0], sa[2 * s2 + 1][1]); u.w = cvt_pk_bf16(sa[2 * s2 + 1][2], sa[2 * s2 + 1][3]);
                pf[s2] = __builtin_bit_cast(bf16x8, u);
            }
        }
        f32x4 na[3];
#pragma unroll
        for (int c = 0; c < 3; ++c) {
            na[c] = (f32x4){0.f, 0.f, 0.f, 0.f};
#pragma unroll
            for (int ks = 0; ks < 4; ++ks) {
                const bf16x8 cf = *(const bf16x8*)(sCb + (ks >> 1) * 6144 + vimg_off(16 * c + lr, 4 * (ks & 1) + g));
                na[c] = __builtin_amdgcn_mfma_f32_16x16x32_bf16(cf, qf[ks], na[c], 0, 0, 0);
            }
            na[c] *= Wi;
        }
        if (k + 1 < NCH) { load_q(k + 1); stage(buf ^ 1); }
        bf16x8 vf[3][2];
#pragma unroll
        for (int c = 0; c < 3; ++c)
#pragma unroll
            for (int s2 = 0; s2 < 2; ++s2) {
                const uint2 lo = tr_frag(sV, 32 * s2, c, g, lr), hi = tr_frag(sV, 32 * s2 + 16, c, g, lr);
                uint4 u; u.x = lo.x; u.y = lo.y; u.z = hi.x; u.w = hi.y;
                vf[c][s2] = __builtin_bit_cast(bf16x8, u);
            }
#pragma unroll
        for (int c = 0; c < 3; ++c) {
            na[c] = __builtin_amdgcn_mfma_f32_16x16x32_bf16(vf[c][0], pf[0], na[c], 0, 0, 0);
            na[c] = __builtin_amdgcn_mfma_f32_16x16x32_bf16(vf[c][1], pf[1], na[c], 0, 0, 0);
        }
        {
            const float Et = ga[192 + 16 * w + lr];
            const float den = __shfl(na[2][0], lr, 64);
            const float rden = 1.0f / fmaxf(fabsf(den), Et);
            float hs = 0.f;
#pragma unroll
            for (int c = 0; c < 2; ++c) {
                const uint2 og = *(const uint2*)(z + rrow * NZ + ZC_MO + h * 128 + dq * 32 + 16 * c + 4 * g);
                const float o0 = bflo(og.x), o1 = bfhi(og.x), o2 = bflo(og.y), o3 = bfhi(og.y);
                const float h0 = na[c][0] * rden, h1 = na[c][1] * rden, h2 = na[c][2] * rden, h3 = na[c][3] * rden;
                hs += h0 * h0 + h1 * h1 + h2 * h2 + h3 * h3;
                const float4 gn = *(const float4*)(gainp + 16 * c);
                uint2 u;
                u.x = pk2(h0 * gn.x / (1.f + __expf(-o0)), h1 * gn.y / (1.f + __expf(-o1)));
                u.y = pk2(h2 * gn.z / (1.f + __expf(-o2)), h3 * gn.w / (1.f + __expf(-o3)));
                if (tvalid) *(uint2*)(y + rrow * DM + h * 128 + dq * 32 + 16 * c + 4 * g) = u;
            }
            hs += __shfl_xor(hs, 16, 64); hs += __shfl_xor(hs, 32, 64);
            if (tvalid && g == 0) ssqm[rrow * 16 + h * 4 + dq] = hs;
        }
        {
            const float decay = ga[320];
#pragma unroll
            for (int a = 0; a < 2; ++a)
#pragma unroll
                for (int c = 0; c < 3; ++c) Ct[a][c] *= decay;
        }
#pragma unroll
        for (int s2 = 0; s2 < 2; ++s2) {
            const f32x4 w0 = *(const f32x4*)(ga + 64 + 32 * s2 + 4 * g), w1 = *(const f32x4*)(ga + 64 + 32 * s2 + 16 + 4 * g);
            bf16x8 vw[3];
#pragma unroll
            for (int c = 0; c < 3; ++c) {
                const uint4 u = __builtin_bit_cast(uint4, vf[c][s2]);
                uint4 o;
                o.x = cvt_pk_bf16(bflo(u.x) * w0[0], bfhi(u.x) * w0[1]); o.y = cvt_pk_bf16(bflo(u.y) * w0[2], bfhi(u.y) * w0[3]);
                o.z = cvt_pk_bf16(bflo(u.z) * w1[0], bfhi(u.z) * w1[1]); o.w = cvt_pk_bf16(bflo(u.w) * w1[2], bfhi(u.w) * w1[3]);
                vw[c] = __builtin_bit_cast(bf16x8, o);
            }
#pragma unroll
            for (int a = 0; a < 2; ++a) {
                const int jt = 2 * w + a;
                const uint2 lo = tr_frag(sK + (jt >> 2) * 8192, 32 * s2, jt & 3, g, lr), hi = tr_frag(sK + (jt >> 2) * 8192, 32 * s2 + 16, jt & 3, g, lr);
                uint4 u; u.x = lo.x; u.y = lo.y; u.z = hi.x; u.w = hi.y;
                const bf16x8 kt = __builtin_bit_cast(bf16x8, u);
#pragma unroll
                for (int c = 0; c < 3; ++c) Ct[a][c] = __builtin_amdgcn_mfma_f32_16x16x32_bf16(kt, vw[c], Ct[a][c], 0, 0, 0);
            }
        }
        __syncthreads();
#pragma unroll
        for (int a = 0; a < 2; ++a) {
            const int jt = 2 * w + a;
#pragma unroll
            for (int c = 0; c < 3; ++c) {
                uint2 u; u.x = cvt_pk_bf16(Ct[a][c][0], Ct[a][c][1]); u.y = cvt_pk_bf16(Ct[a][c][2], Ct[a][c][3]);
                *(uint2*)(sCb + (jt >> 2) * 6144 + vimg_off(16 * c + lr, 2 * (jt & 3) + (g >> 1)) + 8 * (g & 1)) = u;
            }
        }
        __syncthreads();
    }
}

__device__ __forceinline__ void peer_token(const Params& P, int t, int lane, int* sidx, float* sval, int* sid, float* sgate) {
    const unsigned* tk = (const unsigned*)(P.ws + WS_RA) + (size_t)t * 256;
#pragma unroll
    for (int i = 0; i < 4; ++i) {
        const unsigned k = tk[lane * 4 + i];
        sidx[lane * 4 + i] = 127 - (int)(k & 127u);
        sval[lane * 4 + i] = unord_key(k & ~127u);
    }
    __builtin_amdgcn_s_waitcnt(0xc07f);
    __builtin_amdgcn_wave_barrier();
    if (lane < 8) {
        const int hd = lane;
        float v0[16], v1[16];
#pragma unroll
        for (int i = 0; i < 16; ++i) { v0[i] = sval[(2 * hd) * 16 + i]; v1[i] = sval[(2 * hd + 1) * 16 + i]; }
        unsigned top[16];
#pragma unroll
        for (int i = 0; i < 16; ++i) top[i] = 0u;
#pragma unroll
        for (int i = 0; i < 16; ++i)
#pragma unroll
            for (int j = 0; j < 16; ++j)
                if ((i + 1) * (j + 1) <= 16) {
                    unsigned kx = (ord_key(v0[i] + v1[j]) & ~255u) | (unsigned)(255 - (i * 16 + j));
#pragma unroll
                    for (int q = 0; q < 16; ++q) { const unsigned hi = max(top[q], kx), lo = min(top[q], kx); top[q] = hi; kx = lo; }
                }
        const float smax = unord_key(top[0] & ~255u);
        float e[16]; float den = 0.f;
#pragma unroll
        for (int q = 0; q < 16; ++q) { e[q] = __expf(unord_key(top[q] & ~255u) - smax); den += e[q]; }
        const float inv = 1.f / den;
#pragma unroll
        for (int q = 0; q < 16; ++q) {
            const int pos = 255 - (int)(top[q] & 255u), i = pos >> 4, j = pos & 15;
            sid[hd * 16 + q] = sidx[(2 * hd) * 16 + i] * 128 + sidx[(2 * hd + 1) * 16 + j];
            sgate[hd * 16 + q] = e[q] * inv;
        }
    }
    __builtin_amdgcn_s_waitcnt(0xc07f);
    __builtin_amdgcn_wave_barrier();
    const bf16_t* xn = (const bf16_t*)(P.ws + WS_XN) + (size_t)t * DM;
    const float rstd = ((const float*)(P.ws + WS_RSTD))[t];
    const bf16_t* U = (const bf16_t*)(P.ws + WS_U);
    const bf16_t* V = (const bf16_t*)(P.ws + WS_V);
    const int c0 = lane * 8, c1 = 512 + lane * 8;
    const uint4 xa = *(const uint4*)(xn + c0), xb = *(const uint4*)(xn + c1);
    float xf[16];
    xf[0] = bflo(xa.x); xf[1] = bfhi(xa.x); xf[2] = bflo(xa.y); xf[3] = bfhi(xa.y); xf[4] = bflo(xa.z); xf[5] = bfhi(xa.z); xf[6] = bflo(xa.w); xf[7] = bfhi(xa.w);
    xf[8] = bflo(xb.x); xf[9] = bfhi(xb.x); xf[10] = bflo(xb.y); xf[11] = bfhi(xb.y); xf[12] = bflo(xb.z); xf[13] = bfhi(xb.z); xf[14] = bflo(xb.w); xf[15] = bfhi(xb.w);
    float acc[16];
#pragma unroll
    for (int j = 0; j < 16; ++j) acc[j] = 0.f;
#pragma unroll 1
    for (int e0 = 0; e0 < 128; e0 += 4) {
        uint4 ua[4], ub[4], va[4], vb[4];
#pragma unroll
        for (int q = 0; q < 4; ++q) {
            const int id = sid[e0 + q];
            ua[q] = *(const uint4*)(U + (size_t)id * DM + c0); ub[q] = *(const uint4*)(U + (size_t)id * DM + c1);
            va[q] = *(const uint4*)(V + (size_t)id * DM + c0); vb[q] = *(const uint4*)(V + (size_t)id * DM + c1);
        }
#pragma unroll
        for (int q = 0; q < 4; ++q) {
            float d = xf[0] * bflo(ua[q].x) + xf[1] * bfhi(ua[q].x) + xf[2] * bflo(ua[q].y) + xf[3] * bfhi(ua[q].y)
                    + xf[4] * bflo(ua[q].z) + xf[5] * bfhi(ua[q].z) + xf[6] * bflo(ua[q].w) + xf[7] * bfhi(ua[q].w)
                    + xf[8] * bflo(ub[q].x) + xf[9] * bfhi(ub[q].x) + xf[10] * bflo(ub[q].y) + xf[11] * bfhi(ub[q].y)
                    + xf[12] * bflo(ub[q].z) + xf[13] * bfhi(ub[q].z) + xf[14] * bflo(ub[q].w) + xf[15] * bfhi(ub[q].w);
            d = wave_sum(d) * rstd;
            const float ge = 0.5f * d * (1.f + erff(d * 0.70710678118654752f));
            const float w = sgate[e0 + q] * ge;
            acc[0] += w * bflo(va[q].x); acc[1] += w * bfhi(va[q].x); acc[2] += w * bflo(va[q].y); acc[3] += w * bfhi(va[q].y);
            acc[4] += w * bflo(va[q].z); acc[5] += w * bfhi(va[q].z); acc[6] += w * bflo(va[q].w); acc[7] += w * bfhi(va[q].w);
            acc[8] += w * bflo(vb[q].x); acc[9] += w * bfhi(vb[q].x); acc[10] += w * bflo(vb[q].y); acc[11] += w * bfhi(vb[q].y);
            acc[12] += w * bflo(vb[q].z); acc[13] += w * bfhi(vb[q].z); acc[14] += w * bflo(vb[q].w); acc[15] += w * bfhi(vb[q].w);
        }
    }
    float* o = P.out + (size_t)t * DM;
    float4 h0 = *(float4*)(o + c0), h1 = *(float4*)(o + c0 + 4), h2 = *(float4*)(o + c1), h3 = *(float4*)(o + c1 + 4);
    h0.x += acc[0]; h0.y += acc[1]; h0.z += acc[2]; h0.w += acc[3]; h1.x += acc[4]; h1.y += acc[5]; h1.z += acc[6]; h1.w += acc[7];
    h2.x += acc[8]; h2.y += acc[9]; h2.z += acc[10]; h2.w += acc[11]; h3.x += acc[12]; h3.y += acc[13]; h3.z += acc[14]; h3.w += acc[15];
    *(float4*)(o + c0) = h0; *(float4*)(o + c0 + 4) = h1; *(float4*)(o + c1) = h2; *(float4*)(o + c1 + 4) = h3;
    __builtin_amdgcn_s_waitcnt(0xc07f);
    __builtin_amdgcn_wave_barrier();
}

__global__ void __launch_bounds__(256, 2) mega(Params P) {
    extern __shared__ __attribute__((aligned(16))) unsigned char smem[];
    cg::grid_group grid = cg::this_grid();
    const int tid = threadIdx.x, lane = tid & 63, wave = tid >> 6;
    const int G = gridDim.x, bid = blockIdx.x;
    unsigned* ctl = (unsigned*)(P.ws + WS_CTL);
    phase0(P, smem);
    grid.sync();
    {
        const int gw = bid * 4 + wave;
        if (gw < 64) fox_cum_wave(P, gw, lane);
        for (int tile = bid; tile < 129 * 28; tile += G) gemm_tile<1>(P, tile / 28, tile % 28, smem);
    }
    grid.sync();
    {
        volatile int* s_item = (volatile int*)(smem + 65280);
        const int wave_u = __builtin_amdgcn_readfirstlane(wave);
        auto fetch = [&](unsigned* counter) -> int {
            if (wave_u == 0) {
                unsigned v = atomicAdd(counter, lane == 0 ? 1u : 0u);
                *s_item = (int)__builtin_amdgcn_readfirstlane(v);
            }
            __syncthreads();
            const int item = __builtin_amdgcn_readfirstlane(*s_item);
            __syncthreads();
            return item;
        };
        for (;;) {
            const int item = fetch(&ctl[0]);
            if (item >= 258) break;
            conv_item(P, item);
            __threadfence();
            __syncthreads();
            if (wave_u == 0) atomicAdd(&ctl[1], lane == 0 ? 1u : 0u);
        }
        for (;;) {
            const int item = fetch(&ctl[2]);
            if (item >= 128) break;
            if (wave_u == 0) {
                while (__hip_atomic_load(&ctl[1], __ATOMIC_RELAXED, __HIP_MEMORY_SCOPE_AGENT) < 258u) __builtin_amdgcn_s_sleep(8);
            }
            __threadfence();
            __syncthreads();
            mlstm_block(P, item, smem);
        }
        for (;;) {
            const int item = fetch(&ctl[3]);
            if (item >= 64 * 33) break;
            attn_block(P, item & 63, 32 - (item >> 6), smem);
        }
    }
    grid.sync();
    for (int tile = bid; tile < 128 * 8; tile += G) gemm_tile<2>(P, tile >> 3, tile & 7, smem);
    convert_uv_slice(P, bid, G);
    grid.sync();
    for (int tile = bid; tile < 128 * 16; tile += G) gemm_tile<3>(P, tile >> 4, tile & 15, smem);
    grid.sync();
    {
        int* sidx = (int*)(smem + wave * 3072); float* sval = (float*)(smem + wave * 3072 + 1024);
        int* sid = (int*)(smem + wave * 3072 + 2048); float* sgate = (float*)(smem + wave * 3072 + 2560);
        for (int t = bid * 4 + wave; t < T2; t += G * 4) peer_token(P, t, lane, sidx, sval, sid, sgate);
    }
}

}

extern "C" void kernel_launch(void* const* d_in, const int* in_sizes, int n_in, void* d_out, int out_size, void* d_ws, size_t ws_size, hipStream_t stream) {
    if (n_in != 17 || ws_size < WS_END) { fprintf(stderr, "kernel_launch: unexpected n_in %d or ws_size %zu (need %zu)\n", n_in, ws_size, (size_t)WS_END); return; }
    constexpr int LDS_BYTES = 65536;
    static int grid_blocks = 0;
    if (!grid_blocks) {
        int dev = 0, cus = 0, per_cu = 0;
        (void)hipGetDevice(&dev);
        (void)hipDeviceGetAttribute(&cus, hipDeviceAttributeMultiprocessorCount, dev);
        (void)hipFuncSetAttribute((const void*)mega, hipFuncAttributeMaxDynamicSharedMemorySize, LDS_BYTES);
        (void)hipOccupancyMaxActiveBlocksPerMultiprocessor(&per_cu, (const void*)mega, 256, LDS_BYTES);
        if (per_cu < 1) per_cu = 1;
        if (per_cu > 2) per_cu = 2;
        grid_blocks = cus * per_cu;
        fprintf(stderr, "kernel_launch: cus %d per_cu %d grid %d\n", cus, per_cu, grid_blocks);
    }
    Params P{};
    P.x = (const float*)d_in[0]; P.meta = (const float*)d_in[1]; P.norm_mix = (const float*)d_in[2]; P.w_in = (const float*)d_in[3];
    P.conv_qk = (const float*)d_in[4]; P.b_igate = (const float*)d_in[5]; P.b_fgate_m = (const float*)d_in[6]; P.m_out_norm = (const float*)d_in[7];
    P.b_fgate_f = (const float*)d_in[8]; P.f_q_norm = (const float*)d_in[9]; P.f_k_norm = (const float*)d_in[10]; P.w_out = (const float*)d_in[11];
    P.norm_ffn = (const float*)d_in[12]; P.peer_query = (const float*)d_in[13]; P.peer_keys = (const float*)d_in[14]; P.peer_u = (const float*)d_in[15];
    P.peer_v = (const float*)d_in[16]; P.out = (float*)d_out; P.ws = (unsigned char*)d_ws;
    void* args[] = {&P};
    hipError_t e = hipLaunchCooperativeKernel((const void*)mega, dim3(grid_blocks), dim3(256), args, LDS_BYTES, stream);
    if (e != hipSuccess) fprintf(stderr, "cooperative launch failed: %s (grid %d)\n", hipGetErrorString(e), grid_blocks);
}
```

```cpp
#include <hip/hip_runtime.h>
#include <stdint.h>
#include <stdio.h>
#include <hip/hip_cooperative_groups.h>
namespace cg = cooperative_groups;

namespace {

constexpr int NB = 8, SEQ = 2048, DM = 1024, NMETA = 16, L = SEQ + NMETA;
constexpr int T1 = NB * L;
constexpr int T2 = NB * SEQ;
constexpr int NZ = 3584;
constexpr int ZC_MQ = 0, ZC_MK = 512, ZC_MV = 1024, ZC_MO = 1536, ZC_FQ = 2048, ZC_FK = 2560, ZC_FV = 3072;
constexpr int PROJ = 3600;
constexpr float EPS = 1e-6f;

constexpr size_t WS_CTL = 0;
constexpr size_t WS_RA = 65536;
constexpr size_t WS_Z = WS_RA + (size_t)T1 * DM * 2;
constexpr size_t WS_Y = WS_Z + (size_t)T1 * NZ * 2;
constexpr size_t WS_GATES = WS_Y + (size_t)T1 * DM * 2;
constexpr size_t WS_CUM = WS_GATES + (size_t)T1 * 16 * 4;
constexpr size_t WS_SSQ = WS_CUM + (size_t)NB * 8 * L * 4;
constexpr size_t WS_RSTD = WS_SSQ + (size_t)T2 * 16 * 4;
constexpr size_t WS_SSQM = WS_RSTD + (size_t)T2 * 4;
constexpr size_t WS_BT1 = WS_SSQM + (size_t)T1 * 16 * 4;
constexpr size_t WS_BT2 = WS_BT1 + (size_t)NZ * DM * 2;
constexpr size_t WS_BT3 = WS_BT2 + (size_t)DM * DM * 2;
constexpr size_t WS_KEYS = WS_BT3 + (size_t)2048 * DM * 2;
constexpr size_t WS_END = WS_KEYS + (size_t)16 * 128 * 128 * 2;
constexpr size_t WS_XN = WS_Z;
constexpr size_t WS_U = WS_Z + (size_t)T2 * DM * 2;
constexpr size_t WS_V = WS_U + (size_t)16384 * DM;
constexpr size_t WS_USC = WS_V + (size_t)16384 * DM;
constexpr size_t WS_VSC = WS_USC + (size_t)16384 * 4;
constexpr float LOG2E = 1.4426950408889634f;

typedef unsigned short bf16_t;
typedef short bf16x8 __attribute__((ext_vector_type(8)));
typedef float f32x4 __attribute__((ext_vector_type(4)));
typedef __attribute__((ext_vector_type(2))) __bf16 bf16x2_t;

struct Params {
    const float* x; const float* meta; const float* norm_mix; const float* w_in; const float* conv_qk;
    const float* b_igate; const float* b_fgate_m; const float* m_out_norm; const float* b_fgate_f;
    const float* f_q_norm; const float* f_k_norm; const float* w_out; const float* norm_ffn;
    const float* peer_query; const float* peer_keys; const float* peer_u; const float* peer_v;
    float* out; unsigned char* ws;
};

__device__ __forceinline__ unsigned f2bf(float f) { unsigned u = __float_as_uint(f); return (u + 0x7fffu + ((u >> 16) & 1u)) >> 16; }
__device__ __forceinline__ float bf2f(unsigned h) { return __uint_as_float(h << 16); }
__device__ __forceinline__ unsigned pk2(float lo, float hi) { return f2bf(lo) | (f2bf(hi) << 16); }
__device__ __forceinline__ float bflo(unsigned w) { return __uint_as_float(w << 16); }
__device__ __forceinline__ float bfhi(unsigned w) { return __uint_as_float(w & 0xffff0000u); }
__device__ __forceinline__ float wave_sum(float v) {
#pragma unroll
    for (int o = 32; o > 0; o >>= 1) v += __shfl_xor(v, o, 64);
    return v;
}
__device__ __forceinline__ float wave_max(float v) {
#pragma unroll
    for (int o = 32; o > 0; o >>= 1) v = fmaxf(v, __shfl_xor(v, o, 64));
    return v;
}
__device__ __forceinline__ float logsigmoidf(float x) { return fminf(x, 0.f) - log1pf(expf(-fabsf(x))); }
__device__ __forceinline__ unsigned ord_key(float f) { unsigned u = __float_as_uint(f); return u ^ ((u >> 31) ? 0xffffffffu : 0x80000000u); }
__device__ __forceinline__ float unord_key(unsigned k) { unsigned u = (k & 0x80000000u) ? (k ^ 0x80000000u) : ~k; return __uint_as_float(u); }

__device__ __forceinline__ void phase0(const Params& P, unsigned char* smem) {
    const int tid = threadIdx.x, lane = tid & 63, wave = tid >> 6;
    unsigned* ctl = (unsigned*)(P.ws + WS_CTL);
    if (blockIdx.x == 0) for (int i = tid; i < 8192; i += 256) ctl[i] = 0u;
    float* gw = (float*)smem;
    for (int idx = tid; idx < 16 * 1024; idx += 256) {
        const int k = idx >> 4, c = idx & 15;
        const int col = c < 8 ? 2048 + c : 3592 + (c - 8);
        gw[c * 1024 + k] = P.w_in[(size_t)k * PROJ + col];
    }
    __syncthreads();
    {
        bf16_t* hn = (bf16_t*)(P.ws + WS_RA);
        float* gates = (float*)(P.ws + WS_GATES);
        const int c0 = lane * 8, c1 = 512 + lane * 8;
        for (int r = blockIdx.x * 4 + wave; r < T1; r += gridDim.x * 4) {
            const int b = r / L, p = r - b * L;
            const float* src = (p < NMETA) ? (P.meta + (size_t)p * DM) : (P.x + ((size_t)b * SEQ + (p - NMETA)) * DM);
            float v[16];
            {
                const float4 a0 = *(const float4*)(src + c0), a1 = *(const float4*)(src + c0 + 4);
                const float4 a2 = *(const float4*)(src + c1), a3 = *(const float4*)(src + c1 + 4);
                v[0] = a0.x; v[1] = a0.y; v[2] = a0.z; v[3] = a0.w; v[4] = a1.x; v[5] = a1.y; v[6] = a1.z; v[7] = a1.w;
                v[8] = a2.x; v[9] = a2.y; v[10] = a2.z; v[11] = a2.w; v[12] = a3.x; v[13] = a3.y; v[14] = a3.z; v[15] = a3.w;
            }
            float ss = 0.f;
#pragma unroll
            for (int j = 0; j < 16; ++j) ss += v[j] * v[j];
            ss = wave_sum(ss);
            const float rstd = rsqrtf(ss * (1.0f / DM) + EPS);
            {
                const float4 a0 = *(const float4*)(P.norm_mix + c0), a1 = *(const float4*)(P.norm_mix + c0 + 4);
                const float4 a2 = *(const float4*)(P.norm_mix + c1), a3 = *(const float4*)(P.norm_mix + c1 + 4);
                v[0] *= rstd * a0.x; v[1] *= rstd * a0.y; v[2] *= rstd * a0.z; v[3] *= rstd * a0.w; v[4] *= rstd * a1.x; v[5] *= rstd * a1.y; v[6] *= rstd * a1.z; v[7] *= rstd * a1.w;
                v[8] *= rstd * a2.x; v[9] *= rstd * a2.y; v[10] *= rstd * a2.z; v[11] *= rstd * a2.w; v[12] *= rstd * a3.x; v[13] *= rstd * a3.y; v[14] *= rstd * a3.z; v[15] *= rstd * a3.w;
            }
            uint4 o0, o1;
            o0.x = pk2(v[0], v[1]); o0.y = pk2(v[2], v[3]); o0.z = pk2(v[4], v[5]); o0.w = pk2(v[6], v[7]);
            o1.x = pk2(v[8], v[9]); o1.y = pk2(v[10], v[11]); o1.z = pk2(v[12], v[13]); o1.w = pk2(v[14], v[15]);
            *(uint4*)(hn + (size_t)r * DM + c0) = o0;
            *(uint4*)(hn + (size_t)r * DM + c1) = o1;
            float mine = 0.f;
#pragma unroll 1
            for (int c = 0; c < 16; ++c) {
                const float* gwc = gw + c * 1024;
                const float4 w0 = *(const float4*)(gwc + c0), w1 = *(const float4*)(gwc + c0 + 4), w2 = *(const float4*)(gwc + c1), w3 = *(const float4*)(gwc + c1 + 4);
                float s = v[0] * w0.x + v[1] * w0.y + v[2] * w0.z + v[3] * w0.w + v[4] * w1.x + v[5] * w1.y + v[6] * w1.z + v[7] * w1.w
                        + v[8] * w2.x + v[9] * w2.y + v[10] * w2.z + v[11] * w2.w + v[12] * w3.x + v[13] * w3.y + v[14] * w3.z + v[15] * w3.w;
                s = wave_sum(s);
                if (lane == c) mine = s;
            }
            if (lane < 16) {
                float val;
                if (lane < 4) val = mine + P.b_igate[lane];
                else if (lane < 8) val = logsigmoidf(mine + P.b_fgate_m[lane - 4]);
                else val = logsigmoidf(mine + P.b_fgate_f[lane - 8]);
                gates[(size_t)r * 16 + lane] = val;
            }
        }
    }
    __syncthreads();
    {
        float (*tile)[65] = (float (*)[65])smem;
        for (int item = blockIdx.x; item < 1664; item += gridDim.x) {
            const float* W; int ldn, ntn, shift_from, it; bf16_t* out;
            if (item < 896) { W = P.w_in; ldn = PROJ; ntn = 56; shift_from = 2048; it = item; out = (bf16_t*)(P.ws + WS_BT1); }
            else if (item < 1152) { W = P.w_out; ldn = 1024; ntn = 16; shift_from = 1 << 30; it = item - 896; out = (bf16_t*)(P.ws + WS_BT2); }
            else { W = P.peer_query; ldn = 2048; ntn = 32; shift_from = 1 << 30; it = item - 1152; out = (bf16_t*)(P.ws + WS_BT3); }
            const int tk = it / ntn, tn = it - tk * ntn, k0 = tk * 64, n0 = tn * 64;
            {
                const int nl = tid & 63;
                int n = n0 + nl; if (n >= shift_from) n += 8;
#pragma unroll
                for (int i = 0; i < 16; ++i) { const int kl = (tid >> 6) + 4 * i; tile[kl][nl] = W[(size_t)(k0 + kl) * ldn + n]; }
            }
            __syncthreads();
            {
                const int kl = tid & 63;
#pragma unroll
                for (int i = 0; i < 16; ++i) { const int nl = (tid >> 6) + 4 * i; out[(size_t)(n0 + nl) * 1024 + k0 + kl] = (bf16_t)f2bf(tile[kl][nl]); }
            }
            __syncthreads();
        }
    }
    {
        const size_t gt = (size_t)blockIdx.x * 256 + tid, gs = (size_t)gridDim.x * 256;
        const float* src = P.peer_keys; bf16_t* dst = (bf16_t*)(P.ws + WS_KEYS);
        for (size_t i = gt; i < (size_t)(16 * 128 * 128 / 8); i += gs) {
            const float4 a = *(const float4*)(src + i * 8), b = *(const float4*)(src + i * 8 + 4);
            uint4 o; o.x = pk2(a.x, a.y); o.y = pk2(a.z, a.w); o.z = pk2(b.x, b.y); o.w = pk2(b.z, b.w);
            *(uint4*)(dst + i * 8) = o;
        }
    }
}

typedef float f32x2 __attribute__((ext_vector_type(2)));
__device__ __forceinline__ void convert_uv_rows(const Params& P, int gwave, int nwaves, int lane) {
    for (int rr = gwave; rr < 2 * 16384; rr += nwaves) {
        const int which = rr >> 14, row = rr & 16383;
        const float* src = (which ? P.peer_v : P.peer_u) + (size_t)row * DM + lane * 16;
        const float4 a0 = *(const float4*)(src), a1 = *(const float4*)(src + 4), a2 = *(const float4*)(src + 8), a3 = *(const float4*)(src + 12);
        float mx = fmaxf(fmaxf(fmaxf(fabsf(a0.x), fabsf(a0.y)), fmaxf(fabsf(a0.z), fabsf(a0.w))), fmaxf(fmaxf(fabsf(a1.x), fabsf(a1.y)), fmaxf(fabsf(a1.z), fabsf(a1.w))));
        mx = fmaxf(mx, fmaxf(fmaxf(fmaxf(fabsf(a2.x), fabsf(a2.y)), fmaxf(fabsf(a2.z), fabsf(a2.w))), fmaxf(fmaxf(fabsf(a3.x), fabsf(a3.y)), fmaxf(fabsf(a3.z), fabsf(a3.w)))));
        mx = wave_max(mx);
        const float sc = mx > 0.f ? 256.0f / mx : 1.0f;
        uint4 o; int wd;
        wd = 0; wd = __builtin_amdgcn_cvt_pk_fp8_f32(a0.x * sc, a0.y * sc, wd, false); wd = __builtin_amdgcn_cvt_pk_fp8_f32(a0.z * sc, a0.w * sc, wd, true); o.x = (unsigned)wd;
        wd = 0; wd = __builtin_amdgcn_cvt_pk_fp8_f32(a1.x * sc, a1.y * sc, wd, false); wd = __builtin_amdgcn_cvt_pk_fp8_f32(a1.z * sc, a1.w * sc, wd, true); o.y = (unsigned)wd;
        wd = 0; wd = __builtin_amdgcn_cvt_pk_fp8_f32(a2.x * sc, a2.y * sc, wd, false); wd = __builtin_amdgcn_cvt_pk_fp8_f32(a2.z * sc, a2.w * sc, wd, true); o.z = (unsigned)wd;
        wd = 0; wd = __builtin_amdgcn_cvt_pk_fp8_f32(a3.x * sc, a3.y * sc, wd, false); wd = __builtin_amdgcn_cvt_pk_fp8_f32(a3.z * sc, a3.w * sc, wd, true); o.w = (unsigned)wd;
        *(uint4*)(P.ws + (which ? WS_V : WS_U) + (size_t)row * DM + lane * 16) = o;
        if (lane == 0) ((float*)(P.ws + (which ? WS_VSC : WS_USC)))[row] = mx > 0.f ? mx * (1.0f / 256.0f) : 1.0f;
    }
}

__device__ __forceinline__ void mma_ktile(const unsigned char* sA, const unsigned char* sB, int arow_off, int brow_off, int g, int sw, f32x4 (&acc)[4][4]) {
#pragma unroll
    for (int s = 0; s < 2; ++s) {
        bf16x8 a[4], b[4];
        const int ch = (((s * 4 + g) ^ sw) << 4);
#pragma unroll
        for (int i = 0; i < 4; ++i) a[i] = *(const bf16x8*)(sA + arow_off + i * 2048 + ch);
#pragma unroll
        for (int j = 0; j < 4; ++j) b[j] = *(const bf16x8*)(sB + brow_off + j * 2048 + ch);
#pragma unroll
        for (int i = 0; i < 4; ++i)
#pragma unroll
            for (int j = 0; j < 4; ++j) acc[i][j] = __builtin_amdgcn_mfma_f32_16x16x32_bf16(b[j], a[i], acc[i][j], 0, 0, 0);
    }
}

__device__ __forceinline__ void store_tile_bf16(const f32x4 (&acc)[4][4], unsigned char* smem, bf16_t* dst, size_t ld, int m0, int n0, int tid, int wr, int wc, int g, int lr) {
#pragma unroll
    for (int i = 0; i < 4; ++i)
#pragma unroll
        for (int j = 0; j < 4; ++j) {
            const int row = wr * 64 + 16 * i + lr, col = wc * 64 + 16 * j + 4 * g;
            uint2 w; w.x = pk2(acc[i][j][0], acc[i][j][1]); w.y = pk2(acc[i][j][2], acc[i][j][3]);
            *(uint2*)(smem + row * 272 + col * 2) = w;
        }
    __syncthreads();
#pragma unroll
    for (int q = 0; q < 8; ++q) {
        const int id = tid + 256 * q, row = id >> 4, ch = id & 15;
        const uint4 v = *(const uint4*)(smem + row * 272 + ch * 16);
        *(uint4*)(dst + (size_t)(m0 + row) * ld + n0 + ch * 8) = v;
    }
    __syncthreads();
}

template <int MODE>
__device__ __forceinline__ void gemm_tile(const Params& P, int tm, int tn, unsigned char* smem) {
    const bf16_t* A; const bf16_t* Bt;
    if (MODE == 1) { A = (const bf16_t*)(P.ws + WS_RA); Bt = (const bf16_t*)(P.ws + WS_BT1); }
    else if (MODE == 2) { A = (const bf16_t*)(P.ws + WS_Y); Bt = (const bf16_t*)(P.ws + WS_BT2); }
    else { A = (const bf16_t*)(P.ws + WS_XN); Bt = (const bf16_t*)(P.ws + WS_BT3); }
    const int tid = threadIdx.x, lane = tid & 63, wave = tid >> 6, wr = wave >> 1, wc = wave & 1, g = lane >> 4, lr = lane & 15;
    const int m0 = tm * 128, n0 = tn * 128;
    const int srow = tid >> 3, sc = tid & 7;
    const bf16_t* aptr[4]; const bf16_t* bptr[4]; int soff[4];
#pragma unroll
    for (int j = 0; j < 4; ++j) {
        const int row = srow + 32 * j;
        int ar = m0 + row;
        if (MODE == 2) { const int b = ar >> 11, t = ar & 2047; ar = b * L + NMETA + t; }
        aptr[j] = A + (size_t)ar * 1024 + sc * 8;
        bptr[j] = Bt + (size_t)(n0 + row) * 1024 + sc * 8;
        soff[j] = row * 128 + ((sc ^ (row & 7)) << 4);
    }
    f32x4 acc[4][4];
#pragma unroll
    for (int i = 0; i < 4; ++i)
#pragma unroll
        for (int j = 0; j < 4; ++j) acc[i][j] = (f32x4){0.f, 0.f, 0.f, 0.f};
    uint4 ra[4], rb[4];
#pragma unroll
    for (int j = 0; j < 4; ++j) { ra[j] = *(const uint4*)(aptr[j]); rb[j] = *(const uint4*)(bptr[j]); }
    const float* ssqm_row[4];
    if (MODE == 2) {
#pragma unroll
        for (int j = 0; j < 4; ++j) {
            int ar = m0 + srow + 32 * j; { const int b = ar >> 11, t = ar & 2047; ar = b * L + NMETA + t; }
            ssqm_row[j] = (const float*)(P.ws + WS_SSQM) + (size_t)ar * 16;
            const float4 q4 = *(const float4*)(ssqm_row[j]);
            const float rs = rsqrtf(((q4.x + q4.y) + (q4.z + q4.w)) * (1.0f / 128.0f) + EPS);
            ra[j].x = pk2(bflo(ra[j].x) * rs, bfhi(ra[j].x) * rs); ra[j].y = pk2(bflo(ra[j].y) * rs, bfhi(ra[j].y) * rs);
            ra[j].z = pk2(bflo(ra[j].z) * rs, bfhi(ra[j].z) * rs); ra[j].w = pk2(bflo(ra[j].w) * rs, bfhi(ra[j].w) * rs);
        }
    }
    unsigned char* sA0 = smem; unsigned char* sB0 = smem + 16384; unsigned char* sA1 = smem + 32768; unsigned char* sB1 = smem + 49152;
#pragma unroll
    for (int j = 0; j < 4; ++j) { *(uint4*)(sA0 + soff[j]) = ra[j]; *(uint4*)(sB0 + soff[j]) = rb[j]; }
    __syncthreads();
    const int arow_off = (wr * 64 + lr) * 128, brow_off = (wc * 64 + lr) * 128, sw = lr & 7;
    for (int kt = 0; kt < 16; ++kt) {
        unsigned char* sA = (kt & 1) ? sA1 : sA0; unsigned char* sB = (kt & 1) ? sB1 : sB0;
        unsigned char* nA = (kt & 1) ? sA0 : sA1; unsigned char* nB = (kt & 1) ? sB0 : sB1;
        if (kt < 15) {
#pragma unroll
            for (int j = 0; j < 4; ++j) { ra[j] = *(const uint4*)(aptr[j] + (kt + 1) * 64); rb[j] = *(const uint4*)(bptr[j] + (kt + 1) * 64); }
            if (MODE == 2 && kt + 1 < 8) {
                const int head = (kt + 1) >> 1;
#pragma unroll
                for (int j = 0; j < 4; ++j) {
                    const float4 q4 = *(const float4*)(ssqm_row[j] + head * 4);
                    const float rs = rsqrtf(((q4.x + q4.y) + (q4.z + q4.w)) * (1.0f / 128.0f) + EPS);
                    ra[j].x = pk2(bflo(ra[j].x) * rs, bfhi(ra[j].x) * rs); ra[j].y = pk2(bflo(ra[j].y) * rs, bfhi(ra[j].y) * rs);
                    ra[j].z = pk2(bflo(ra[j].z) * rs, bfhi(ra[j].z) * rs); ra[j].w = pk2(bflo(ra[j].w) * rs, bfhi(ra[j].w) * rs);
                }
            }
        }
        mma_ktile(sA, sB, arow_off, brow_off, g, sw, acc);
        if (kt < 15) {
#pragma unroll
            for (int j = 0; j < 4; ++j) { *(uint4*)(nA + soff[j]) = ra[j]; *(uint4*)(nB + soff[j]) = rb[j]; }
        }
        __syncthreads();
    }
    if (MODE == 1) {
        if (n0 >= ZC_FQ && n0 < ZC_FV) {
            const bool isk = n0 >= ZC_FK;
            const float* gain = isk ? P.f_k_norm : P.f_q_norm;
            const float scl = isk ? 1.0f : 0.125f * LOG2E;
            float gn[4][4];
#pragma unroll
            for (int j = 0; j < 4; ++j)
#pragma unroll
                for (int r = 0; r < 4; ++r) gn[j][r] = gain[16 * j + 4 * g + r];
#pragma unroll
            for (int i = 0; i < 4; ++i) {
                float ss = 0.f;
#pragma unroll
                for (int j = 0; j < 4; ++j)
#pragma unroll
                    for (int r = 0; r < 4; ++r) ss += acc[i][j][r] * acc[i][j][r];
                ss += __shfl_xor(ss, 16, 64); ss += __shfl_xor(ss, 32, 64);
                const float rstd = rsqrtf(ss * (1.0f / 64.0f) + EPS) * scl;
#pragma unroll
                for (int j = 0; j < 4; ++j)
#pragma unroll
                    for (int r = 0; r < 4; ++r) acc[i][j][r] *= rstd * gn[j][r];
            }
        }
        store_tile_bf16(acc, smem, (bf16_t*)(P.ws + WS_Z), NZ, m0, n0, tid, wr, wc, g, lr);
    } else if (MODE == 2) {
        float* ssq = (float*)(P.ws + WS_SSQ);
#pragma unroll
        for (int i = 0; i < 4; ++i) {
            const int row = m0 + wr * 64 + 16 * i + lr;
            float ss = 0.f;
#pragma unroll
            for (int j = 0; j < 4; ++j) {
                const int col = n0 + wc * 64 + 16 * j + 4 * g;
                const float4 xv = *(const float4*)(P.x + (size_t)row * DM + col);
                const float4 gv = *(const float4*)(P.norm_ffn + col);
                float4 hv; hv.x = acc[i][j][0] + xv.x; hv.y = acc[i][j][1] + xv.y; hv.z = acc[i][j][2] + xv.z; hv.w = acc[i][j][3] + xv.w;
                *(float4*)(P.out + (size_t)row * DM + col) = hv;
                ss += hv.x * hv.x + hv.y * hv.y + hv.z * hv.z + hv.w * hv.w;
                acc[i][j][0] = hv.x * gv.x; acc[i][j][1] = hv.y * gv.y; acc[i][j][2] = hv.z * gv.z; acc[i][j][3] = hv.w * gv.w;
            }
            ss += __shfl_xor(ss, 16, 64); ss += __shfl_xor(ss, 32, 64);
            if (g == 0) ssq[(size_t)row * 16 + tn * 2 + wc] = ss;
        }
        store_tile_bf16(acc, smem, (bf16_t*)(P.ws + WS_XN), 1024, m0, n0, tid, wr, wc, g, lr);
    } else {
        const int hp = tn;
        const float* ssq = (const float*)(P.ws + WS_SSQ);
        float rs[4];
#pragma unroll
        for (int i = 0; i < 4; ++i) {
            const int row = m0 + wr * 64 + 16 * i + lr;
            const float4 p0 = *(const float4*)(ssq + (size_t)row * 16), p1 = *(const float4*)(ssq + (size_t)row * 16 + 4);
            const float4 p2 = *(const float4*)(ssq + (size_t)row * 16 + 8), p3 = *(const float4*)(ssq + (size_t)row * 16 + 12);
            const float s = ((p0.x + p0.y) + (p0.z + p0.w)) + ((p1.x + p1.y) + (p1.z + p1.w)) + ((p2.x + p2.y) + (p2.z + p2.w)) + ((p3.x + p3.y) + (p3.z + p3.w));
            rs[i] = rsqrtf(s * (1.0f / DM) + EPS);
            if (tn == 0 && wc == 0 && g == 0) ((float*)(P.ws + WS_RSTD))[row] = rs[i];
        }
        {
            unsigned char* sAq = wc ? sA1 : sA0;
#pragma unroll
            for (int i = 0; i < 4; ++i)
#pragma unroll
                for (int j = 0; j < 4; ++j) {
                    const int row = wr * 64 + 16 * i + lr;
                    const int chunk = 2 * j + (g >> 1);
                    uint2 w; w.x = pk2(acc[i][j][0] * rs[i], acc[i][j][1] * rs[i]); w.y = pk2(acc[i][j][2] * rs[i], acc[i][j][3] * rs[i]);
                    *(uint2*)(sAq + row * 128 + ((chunk ^ (row & 7)) << 4) + 8 * (g & 1)) = w;
                }
            const bf16_t* keys = (const bf16_t*)(P.ws + WS_KEYS) + (size_t)hp * 128 * 128;
#pragma unroll
            for (int j = 0; j < 4; ++j) {
                const int row = srow + 32 * j;
                const uint4 k0 = *(const uint4*)(keys + (size_t)row * 128 + sc * 8);
                const uint4 k1 = *(const uint4*)(keys + (size_t)row * 128 + 64 + sc * 8);
                *(uint4*)(sB0 + soff[j]) = k0; *(uint4*)(sB1 + soff[j]) = k1;
            }
        }
        __syncthreads();
#pragma unroll
        for (int i = 0; i < 4; ++i)
#pragma unroll
            for (int j = 0; j < 4; ++j) acc[i][j] = (f32x4){0.f, 0.f, 0.f, 0.f};
        mma_ktile(sA0, sB0, arow_off, brow_off, g, sw, acc);
        mma_ktile(sA1, sB1, arow_off, brow_off, g, sw, acc);
        __syncthreads();
#pragma unroll
        for (int i = 0; i < 4; ++i)
#pragma unroll
            for (int j = 0; j < 4; ++j) {
                const int row = wr * 64 + 16 * i + lr;
                const int c4 = wc * 16 + 4 * j + g;
                *(f32x4*)(smem + row * 512 + ((c4 ^ (row & 31)) << 4)) = acc[i][j];
            }
        __syncthreads();
        unsigned top[16];
#pragma unroll
        for (int q = 0; q < 16; ++q) top[q] = 0u;
        const int row = tid & 127, half = tid >> 7;
#pragma unroll 1
        for (int s = 0; s < 16; ++s) {
            const int c4 = half * 16 + s;
            const f32x4 v = *(const f32x4*)(smem + row * 512 + ((c4 ^ (row & 31)) << 4));
#pragma unroll
            for (int e = 0; e < 4; ++e) {
                unsigned kx = (ord_key(v[e]) & ~127u) | (unsigned)(127 - (c4 * 4 + e));
#pragma unroll
                for (int q = 0; q < 16; ++q) { const unsigned hi = max(top[q], kx), lo = min(top[q], kx); top[q] = hi; kx = lo; }
            }
        }
        __syncthreads();
        if (half) {
            uint4* lp = (uint4*)(smem + row * 64);
            lp[0] = make_uint4(top[0], top[1], top[2], top[3]); lp[1] = make_uint4(top[4], top[5], top[6], top[7]);
            lp[2] = make_uint4(top[8], top[9], top[10], top[11]); lp[3] = make_uint4(top[12], top[13], top[14], top[15]);
        }
        __syncthreads();
        if (!half) {
            const uint4* lp = (const uint4*)(smem + row * 64);
#pragma unroll
            for (int c = 0; c < 4; ++c) {
                const uint4 o = lp[c];
                unsigned ks[4] = {o.x, o.y, o.z, o.w};
#pragma unroll
                for (int e = 0; e < 4; ++e) {
                    unsigned kx = ks[e];
#pragma unroll
                    for (int q = 0; q < 16; ++q) { const unsigned hi = max(top[q], kx), lo = min(top[q], kx); top[q] = hi; kx = lo; }
                }
            }
            uint4* tk = (uint4*)((unsigned*)(P.ws + WS_RA) + ((size_t)(m0 + row) * 16 + hp) * 16);
            tk[0] = make_uint4(top[0], top[1], top[2], top[3]); tk[1] = make_uint4(top[4], top[5], top[6], top[7]);
            tk[2] = make_uint4(top[8], top[9], top[10], top[11]); tk[3] = make_uint4(top[12], top[13], top[14], top[15]);
        }
        __syncthreads();
    }
}

__device__ __forceinline__ void fox_cum_wave(const Params& P, int bh, int lane) {
    const int b = bh >> 3, h = bh & 7;
    const float* gates = (const float*)(P.ws + WS_GATES);
    float* cum = (float*)(P.ws + WS_CUM) + (size_t)bh * L;
    constexpr int SEG = 33;
    const int t0 = lane * SEG;
    float loc = 0.f;
    for (int i = 0; i < SEG; ++i) { const int t = t0 + i; if (t < L) loc += gates[(size_t)(b * L + t) * 16 + 8 + h]; }
    float incl = loc;
#pragma unroll
    for (int o = 1; o < 64; o <<= 1) { const float n = __shfl_up(incl, o, 64); if (lane >= o) incl += n; }
    float run = incl - loc;
    for (int i = 0; i < SEG; ++i) { const int t = t0 + i; if (t < L) { run += gates[(size_t)(b * L + t) * 16 + 8 + h]; cum[t] = run * LOG2E; } }
}

#define TR_SLOW 0
__device__ __forceinline__ unsigned cvt_pk_bf16(float lo, float hi) { unsigned r; asm volatile("v_cvt_pk_bf16_f32 %0, %1, %2" : "=v"(r) : "v"(lo), "v"(hi)); return r; }
__device__ __forceinline__ int vimg_off(int row, int ch) { return row * 128 + ((ch ^ (((row >> 1) & 3) << 1)) << 4); }
__device__ __forceinline__ uint2 tr_frag(const unsigned char* img, int row0, int c, int g, int lr) {
#if TR_SLOW
    unsigned short e[4];
#pragma unroll
    for (int k = 0; k < 4; ++k) { const int row = row0 + 4 * g + k, col = 16 * c + lr; e[k] = *(const unsigned short*)(img + vimg_off(row, col >> 3) + (col & 7) * 2); }
    uint2 r; r.x = (unsigned)e[0] | ((unsigned)e[1] << 16); r.y = (unsigned)e[2] | ((unsigned)e[3] << 16); return r;
#else
    const int q = lr >> 2, p = lr & 3, row = row0 + 4 * g + q;
    const unsigned addr = (unsigned)(size_t)(img + vimg_off(row, 2 * c + (p >> 1)) + 8 * (p & 1));
    uint2 r;
    asm volatile("ds_read_b64_tr_b16 %0, %1\n\ts_waitcnt lgkmcnt(0)" : "=&v"(r) : "v"(addr) : "memory");
    return r;
#endif
}

__device__ __forceinline__ void attn_block(const Params& P, int bh, int qb, unsigned char* smem) {
    const int tid = threadIdx.x, lane = tid & 63, w = tid >> 6, g = lane >> 4, lr = lane & 15;
    const int b = bh >> 3, h = bh & 7;
    const bf16_t* z = (const bf16_t*)(P.ws + WS_Z);
    const float* cum = (const float*)(P.ws + WS_CUM) + (size_t)bh * L;
    const int tq = qb * 64 + 16 * w + lr;
    const bool qvalid = tq < L;
    bf16x8 qf[2];
    {
        const bf16_t* qp = z + (size_t)(b * L + (qvalid ? tq : 0)) * NZ + ZC_FQ + h * 64 + 8 * g;
        qf[0] = *(const bf16x8*)(qp); qf[1] = *(const bf16x8*)(qp + 32);
    }
    const float cq = cum[qvalid ? tq : 0];
    const int srow0 = tid >> 3, sch = tid & 7;
    uint4 rk[2], rv[2]; float rc = 0.f;
    auto load_tile = [&](int kv) {
#pragma unroll
        for (int j = 0; j < 2; ++j) {
            const int key = kv * 64 + srow0 + 32 * j;
            if (key < L) {
                const bf16_t* p = z + (size_t)(b * L + key) * NZ + h * 64 + sch * 8;
                rk[j] = *(const uint4*)(p + ZC_FK); rv[j] = *(const uint4*)(p + ZC_FV);
            } else { rk[j] = make_uint4(0, 0, 0, 0); rv[j] = make_uint4(0, 0, 0, 0); }
        }
        if (tid < 64) { const int key = kv * 64 + tid; rc = key < L ? cum[key] : 0.f; }
    };
    auto store_tile = [&](int buf) {
        unsigned char* sK = smem + buf * 16384; unsigned char* sV = sK + 8192;
#pragma unroll
        for (int j = 0; j < 2; ++j) {
            const int row = srow0 + 32 * j;
            *(uint4*)(sK + row * 128 + ((sch ^ (row & 7)) << 4)) = rk[j];
            *(uint4*)(sV + vimg_off(row, sch)) = rv[j];
        }
        if (tid < 64) ((float*)(smem + 32768 + buf * 256))[tid] = rc;
    };
    float m = -INFINITY, lsum = 0.f;
    f32x4 o[4];
#pragma unroll
    for (int c = 0; c < 4; ++c) o[c] = (f32x4){0.f, 0.f, 0.f, 0.f};
    load_tile(0); store_tile(0);
    __syncthreads();
    for (int kv = 0; kv <= qb; ++kv) {
        const int buf = kv & 1;
        if (kv < qb) load_tile(kv + 1);
        const unsigned char* sK = smem + buf * 16384; const unsigned char* sV = sK + 8192;
        const float* sck = (const float*)(smem + 32768 + buf * 256);
        f32x4 sa[4];
#pragma unroll
        for (int c = 0; c < 4; ++c) {
            sa[c] = (f32x4){0.f, 0.f, 0.f, 0.f};
#pragma unroll
            for (int s = 0; s < 2; ++s) {
                const bf16x8 kf = *(const bf16x8*)(sK + (16 * c + lr) * 128 + (((4 * s + g) ^ (lr & 7)) << 4));
                sa[c] = __builtin_amdgcn_mfma_f32_16x16x32_bf16(kf, qf[s], sa[c], 0, 0, 0);
            }
        }
        const bool diag = (kv == qb);
        float mx = -INFINITY;
#pragma unroll
        for (int c = 0; c < 4; ++c) {
            const f32x4 ck = *(const f32x4*)(sck + 16 * c + 4 * g);
#pragma unroll
            for (int r = 0; r < 4; ++r) {
                float v = sa[c][r] + (cq - ck[r]);
                if (diag && (16 * c + 4 * g + r > 16 * w + lr)) v = -INFINITY;
                sa[c][r] = v; mx = fmaxf(mx, v);
            }
        }
        mx = fmaxf(mx, __shfl_xor(mx, 16, 64)); mx = fmaxf(mx, __shfl_xor(mx, 32, 64));
        const float mn = fmaxf(m, mx);
        const float alpha = __builtin_amdgcn_exp2f(m - mn);
        m = mn;
        float ps = 0.f;
#pragma unroll
        for (int c = 0; c < 4; ++c)
#pragma unroll
            for (int r = 0; r < 4; ++r) { const float p = __builtin_amdgcn_exp2f(sa[c][r] - mn); sa[c][r] = p; ps += p; }
        lsum = lsum * alpha + ps;
#pragma unroll
        for (int c = 0; c < 4; ++c) o[c] *= alpha;
        bf16x8 pf[2];
#pragma unroll
        for (int s2 = 0; s2 < 2; ++s2) {
            uint4 u;
            u.x = cvt_pk_bf16(sa[2 * s2][0], sa[2 * s2][1]); u.y = cvt_pk_bf16(sa[2 * s2][2], sa[2 * s2][3]);
            u.z = cvt_pk_bf16(sa[2 * s2 + 1][0], sa[2 * s2 + 1][1]); u.w = cvt_pk_bf16(sa[2 * s2 + 1][2], sa[2 * s2 + 1][3]);
            pf[s2] = __builtin_bit_cast(bf16x8, u);
        }
#pragma unroll
        for (int c = 0; c < 4; ++c)
#pragma unroll
            for (int s2 = 0; s2 < 2; ++s2) {
                const uint2 lo = tr_frag(sV, 32 * s2, c, g, lr), hi = tr_frag(sV, 32 * s2 + 16, c, g, lr);
                uint4 u; u.x = lo.x; u.y = lo.y; u.z = hi.x; u.w = hi.y;
                o[c] = __builtin_amdgcn_mfma_f32_16x16x32_bf16(__builtin_bit_cast(bf16x8, u), pf[s2], o[c], 0, 0, 0);
            }
        if (kv < qb) store_tile(buf ^ 1);
        __syncthreads();
    }
    lsum += __shfl_xor(lsum, 16, 64); lsum += __shfl_xor(lsum, 32, 64);
    const float inv = 1.0f / lsum;
    if (qvalid) {
        bf16_t* y = (bf16_t*)(P.ws + WS_Y) + (size_t)(b * L + tq) * DM + 512 + h * 64 + 4 * g;
#pragma unroll
        for (int c = 0; c < 4; ++c) {
            uint2 u; u.x = pk2(o[c][0] * inv, o[c][1] * inv); u.y = pk2(o[c][2] * inv, o[c][3] * inv);
            *(uint2*)(y + 16 * c) = u;
        }
    }
}

__device__ __forceinline__ void conv_item(const Params& P, int ci) {
    const int tid = threadIdx.x, cc = tid & 127, rg = tid >> 7;
    const bf16_t* z = (const bf16_t*)(P.ws + WS_Z);
    bf16_t* qk = (bf16_t*)(P.ws + WS_RA);
    const int col0 = cc * 8;
    float w[4][8];
#pragma unroll
    for (int j = 0; j < 4; ++j) {
        const float4 a = *(const float4*)(P.conv_qk + j * 1024 + col0), b = *(const float4*)(P.conv_qk + j * 1024 + col0 + 4);
        w[j][0] = a.x; w[j][1] = a.y; w[j][2] = a.z; w[j][3] = a.w; w[j][4] = b.x; w[j][5] = b.y; w[j][6] = b.z; w[j][7] = b.w;
    }
    const float oscale = (col0 >= 512) ? 0.08838834764831845f : 1.0f;
    const int r0 = ci * 64 + rg * 32;
    int t = r0 % L;
    float xw[3][8];
#pragma unroll
    for (int j = 0; j < 3; ++j) {
        const int back = 3 - j;
        if (t - back >= 0) {
            const uint4 v = *(const uint4*)(z + (size_t)(r0 - back) * NZ + col0);
            xw[j][0] = bflo(v.x); xw[j][1] = bfhi(v.x); xw[j][2] = bflo(v.y); xw[j][3] = bfhi(v.y); xw[j][4] = bflo(v.z); xw[j][5] = bfhi(v.z); xw[j][6] = bflo(v.w); xw[j][7] = bfhi(v.w);
        } else {
#pragma unroll
            for (int e = 0; e < 8; ++e) xw[j][e] = 0.f;
        }
    }
#pragma unroll 2
    for (int i = 0; i < 32; ++i) {
        const int r = r0 + i;
        if (t == 0) {
#pragma unroll
            for (int j = 0; j < 3; ++j)
#pragma unroll
                for (int e = 0; e < 8; ++e) xw[j][e] = 0.f;
        }
        const uint4 v = *(const uint4*)(z + (size_t)r * NZ + col0);
        float xt[8];
        xt[0] = bflo(v.x); xt[1] = bfhi(v.x); xt[2] = bflo(v.y); xt[3] = bfhi(v.y); xt[4] = bflo(v.z); xt[5] = bfhi(v.z); xt[6] = bflo(v.w); xt[7] = bfhi(v.w);
        float o[8];
#pragma unroll
        for (int e = 0; e < 8; ++e) {
            const float cv = w[0][e] * xw[0][e] + w[1][e] * xw[1][e] + w[2][e] * xw[2][e] + w[3][e] * xt[e];
            o[e] = oscale * cv / (1.f + __expf(-cv));
            xw[0][e] = xw[1][e]; xw[1][e] = xw[2][e]; xw[2][e] = xt[e];
        }
        uint4 ov; ov.x = pk2(o[0], o[1]); ov.y = pk2(o[2], o[3]); ov.z = pk2(o[4], o[5]); ov.w = pk2(o[6], o[7]);
        *(uint4*)(qk + (size_t)r * 1024 + col0) = ov;
        t = (t + 1 == L) ? 0 : t + 1;
    }
}

__device__ __forceinline__ void mlstm_block(const Params& P, int mi, unsigned char* smem) {
    const int tid = threadIdx.x, lane = tid & 63, w = tid >> 6, g = lane >> 4, lr = lane & 15;
    const int wu = __builtin_amdgcn_readfirstlane(w);
    const int b = mi >> 4, h = (mi >> 2) & 3, dq = mi & 3;
    const bf16_t* z = (const bf16_t*)(P.ws + WS_Z);
    const bf16_t* qk = (const bf16_t*)(P.ws + WS_RA);
    const float* gates = (const float*)(P.ws + WS_GATES);
    bf16_t* y = (bf16_t*)(P.ws + WS_Y);
    float* ssqm = (float*)(P.ws + WS_SSQM);
    unsigned char* sCb = smem + 49152;
    for (int i = tid; i < 12288 / 16; i += 256) *(uint4*)(sCb + i * 16) = make_uint4(0, 0, 0, 0);
    if (tid < 128) {
        const int row = tid >> 1, ch = 4 + (tid & 1);
        const uint4 v = (tid & 1) ? make_uint4(0, 0, 0, 0) : make_uint4(0x3F80u, 0, 0, 0);
        *(uint4*)(smem + 16384 + vimg_off(row, ch)) = v;
        *(uint4*)(smem + 24576 + 16384 + vimg_off(row, ch)) = v;
    }
    const float* gainp = P.m_out_norm + h * 128 + dq * 32 + 4 * g;
    f32x4 Ct[2][3];
#pragma unroll
    for (int a = 0; a < 2; ++a)
#pragma unroll
        for (int c = 0; c < 3; ++c) Ct[a][c] = (f32x4){0.f, 0.f, 0.f, 0.f};
    float m_prev = 0.f;
    uint4 pk_[4]; uint4 pv_ = make_uint4(0, 0, 0, 0); bf16x8 qf[4]; float plf = 0.f, pli = 0.f;
    auto load_q = [&](int k) {
        const int pos = 64 * k + 16 * w + lr;
        const bf16_t* qp = qk + (size_t)(b * L + (pos < L ? pos : 0)) * 1024 + h * 128 + 8 * g;
#pragma unroll
        for (int ks = 0; ks < 4; ++ks) { qf[ks] = *(const bf16x8*)(qp + 32 * ks); if (pos >= L) qf[ks] = (bf16x8){0, 0, 0, 0, 0, 0, 0, 0}; }
    };
    auto prefetch = [&](int k) {
#pragma unroll
        for (int j = 0; j < 4; ++j) {
            const int id = tid + 256 * j, row = id >> 4, ch16 = id & 15, pos = 64 * k + row;
            pk_[j] = (pos < L) ? *(const uint4*)(qk + (size_t)(b * L + pos) * 1024 + 512 + h * 128 + ch16 * 8) : make_uint4(0, 0, 0, 0);
        }
        {
            const int row = tid >> 2, ch = tid & 3, pos = 64 * k + row;
            pv_ = (pos < L) ? *(const uint4*)(z + (size_t)(b * L + pos) * NZ + ZC_MV + h * 128 + dq * 32 + ch * 8) : make_uint4(0, 0, 0, 0);
        }
        if (wu == 0) {
            const int pos = 64 * k + lane;
            if (pos < L) { plf = gates[(size_t)(b * L + pos) * 16 + 4 + h]; pli = gates[(size_t)(b * L + pos) * 16 + h]; }
            else { plf = 0.f; pli = -INFINITY; }
        }
    };
    auto stage = [&](int buf) {
        unsigned char* sK = smem + buf * 24576; unsigned char* sV = sK + 16384;
#pragma unroll
        for (int j = 0; j < 4; ++j) {
            const int id = tid + 256 * j, row = id >> 4, ch16 = id & 15;
            *(uint4*)(sK + (ch16 >> 3) * 8192 + vimg_off(row, ch16 & 7)) = pk_[j];
        }
        { const int row = tid >> 2, ch = tid & 3; *(uint4*)(sV + vimg_off(row, ch)) = pv_; }
        if (wu == 0) {
            float* ga = (float*)(smem + 61440 + buf * 1296);
            float bc = plf;
#pragma unroll
            for (int o = 1; o < 64; o <<= 1) { const float n = __shfl_up(bc, o, 64); if (lane >= o) bc += n; }
            const float a = pli - bc;
            float am = a;
#pragma unroll
            for (int o = 1; o < 64; o <<= 1) { const float n = __shfl_up(am, o, 64); if (lane >= o) am = fmaxf(am, n); }
            const float M = fmaxf(m_prev, am);
            const float M63 = __shfl(M, 63, 64), b63 = __shfl(bc, 63, 64);
            ga[lane] = a; ga[64 + lane] = __expf(a - M63); ga[128 + lane] = __expf(m_prev - M); ga[192 + lane] = __expf(-(bc + M)); ga[256 + lane] = M;
            if (lane == 0) ga[320] = __expf(m_prev - M63);
            m_prev = b63 + M63;
        }
    };
    prefetch(0); load_q(0);
    __syncthreads();
    stage(0);
    __syncthreads();
    constexpr int NCH = (L + 63) / 64;
    for (int k = 0; k < NCH; ++k) {
        const int buf = k & 1;
        const unsigned char* sK = smem + buf * 24576; const unsigned char* sV = sK + 16384;
        const float* ga = (const float*)(smem + 61440 + buf * 1296);
        const int pos = 64 * k + 16 * w + lr;
        const bool tvalid = pos < L;
        const size_t rrow = (size_t)(b * L + (tvalid ? pos : 0));
        if (k + 1 < NCH) prefetch(k + 1);
        const float Mt = ga[256 + 16 * w + lr], Wi = ga[128 + 16 * w + lr];
        bf16x8 pf[2];
        {
            f32x4 sa[4];
#pragma unroll
            for (int c = 0; c < 4; ++c) {
                sa[c] = (f32x4){0.f, 0.f, 0.f, 0.f};
                if (c <= wu) {
#pragma unroll
                    for (int ks = 0; ks < 4; ++ks) {
                        const bf16x8 kf = *(const bf16x8*)(sK + (ks >> 1) * 8192 + vimg_off(16 * c + lr, 4 * (ks & 1) + g));
                        sa[c] = __builtin_amdgcn_mfma_f32_16x16x32_bf16(kf, qf[ks], sa[c], 0, 0, 0);
                    }
                    const f32x4 av = *(const f32x4*)(ga + 16 * c + 4 * g);
#pragma unroll
                    for (int r = 0; r < 4; ++r) {
                        const float d = __expf(av[r] - Mt);
                        sa[c][r] = (16 * c + 4 * g + r <= 16 * w + lr) ? sa[c][r] * d : 0.f;
                    }
                }
            }
#pragma unroll
            for (int s2 = 0; s2 < 2; ++s2) {
                uint4 u;
                u.x = cvt_pk_bf16(sa[2 * s2][0], sa[2 * s2][1]); u.y = cvt_pk_bf16(sa[2 * s2][2], sa[2 * s2][3]);
                u.z = cvt_pk_bf16(sa[2 * s2 + 1][0], sa[2 * s2 + 1][1]); u.w = cvt_pk_bf16(sa[2 * s2 + 1][2], sa[2 * s2 + 1][3]);
                pf[s2] = __builtin_bit_cast(bf16x8, u);
            }
        }
        f32x4 na[3];
#pragma unroll
        for (int c = 0; c < 3; ++c) {
            na[c] = (f32x4){0.f, 0.f, 0.f, 0.f};
#pragma unroll
            for (int ks = 0; ks < 4; ++ks) {
                const bf16x8 cf = *(const bf16x8*)(sCb + (ks >> 1) * 6144 + vimg_off(16 * c + lr, 4 * (ks & 1) + g));
                na[c] = __builtin_amdgcn_mfma_f32_16x16x32_bf16(cf, qf[ks], na[c], 0, 0, 0);
            }
            na[c] *= Wi;
        }
        if (k + 1 < NCH) { load_q(k + 1); stage(buf ^ 1); }
        bf16x8 vf[3][2];
#pragma unroll
        for (int c = 0; c < 3; ++c)
#pragma unroll
            for (int s2 = 0; s2 < 2; ++s2) {
                const uint2 lo = tr_frag(sV, 32 * s2, c, g, lr), hi = tr_frag(sV, 32 * s2 + 16, c, g, lr);
                uint4 u; u.x = lo.x; u.y = lo.y; u.z = hi.x; u.w = hi.y;
                vf[c][s2] = __builtin_bit_cast(bf16x8, u);
            }
#pragma unroll
        for (int c = 0; c < 3; ++c) {
            na[c] = __builtin_amdgcn_mfma_f32_16x16x32_bf16(vf[c][0], pf[0], na[c], 0, 0, 0);
            na[c] = __builtin_amdgcn_mfma_f32_16x16x32_bf16(vf[c][1], pf[1], na[c], 0, 0, 0);
        }
        {
            const float Et = ga[192 + 16 * w + lr];
            const float den = __shfl(na[2][0], lr, 64);
            const float rden = 1.0f / fmaxf(fabsf(den), Et);
            float hs = 0.f;
#pragma unroll
            for (int c = 0; c < 2; ++c) {
                const uint2 og = *(const uint2*)(z + rrow * NZ + ZC_MO + h * 128 + dq * 32 + 16 * c + 4 * g);
                const float o0 = bflo(og.x), o1 = bfhi(og.x), o2 = bflo(og.y), o3 = bfhi(og.y);
                const float h0 = na[c][0] * rden, h1 = na[c][1] * rden, h2 = na[c][2] * rden, h3 = na[c][3] * rden;
                hs += h0 * h0 + h1 * h1 + h2 * h2 + h3 * h3;
                const float4 gn = *(const float4*)(gainp + 16 * c);
                uint2 u;
                u.x = pk2(h0 * gn.x / (1.f + __expf(-o0)), h1 * gn.y / (1.f + __expf(-o1)));
                u.y = pk2(h2 * gn.z / (1.f + __expf(-o2)), h3 * gn.w / (1.f + __expf(-o3)));
                if (tvalid) *(uint2*)(y + rrow * DM + h * 128 + dq * 32 + 16 * c + 4 * g) = u;
            }
            hs += __shfl_xor(hs, 16, 64); hs += __shfl_xor(hs, 32, 64);
            if (tvalid && g == 0) ssqm[rrow * 16 + h * 4 + dq] = hs;
        }
        {
            const float decay = ga[320];
#pragma unroll
            for (int a = 0; a < 2; ++a)
#pragma unroll
                for (int c = 0; c < 3; ++c) Ct[a][c] *= decay;
        }
#pragma unroll
        for (int s2 = 0; s2 < 2; ++s2) {
            const f32x4 w0 = *(const f32x4*)(ga + 64 + 32 * s2 + 4 * g), w1 = *(const f32x4*)(ga + 64 + 32 * s2 + 16 + 4 * g);
            bf16x8 vw[3];
#pragma unroll
            for (int c = 0; c < 3; ++c) {
                const uint4 u = __builtin_bit_cast(uint4, vf[c][s2]);
                uint4 o;
                o.x = cvt_pk_bf16(bflo(u.x) * w0[0], bfhi(u.x) * w0[1]); o.y = cvt_pk_bf16(bflo(u.y) * w0[2], bfhi(u.y) * w0[3]);
                o.z = cvt_pk_bf16(bflo(u.z) * w1[0], bfhi(u.z) * w1[1]); o.w = cvt_pk_bf16(bflo(u.w) * w1[2], bfhi(u.w) * w1[3]);
                vw[c] = __builtin_bit_cast(bf16x8, o);
            }
#pragma unroll
            for (int a = 0; a < 2; ++a) {
                const int jt = 2 * w + a;
                const uint2 lo = tr_frag(sK + (jt >> 2) * 8192, 32 * s2, jt & 3, g, lr), hi = tr_frag(sK + (jt >> 2) * 8192, 32 * s2 + 16, jt & 3, g, lr);
                uint4 u; u.x = lo.x; u.y = lo.y; u.z = hi.x; u.w = hi.y;
                const bf16x8 kt = __builtin_bit_cast(bf16x8, u);
#pragma unroll
                for (int c = 0; c < 3; ++c) Ct[a][c] = __builtin_amdgcn_mfma_f32_16x16x32_bf16(kt, vw[c], Ct[a][c], 0, 0, 0);
            }
        }
        __syncthreads();
#pragma unroll
        for (int a = 0; a < 2; ++a) {
            const int jt = 2 * w + a;
#pragma unroll
            for (int c = 0; c < 3; ++c) {
                uint2 u; u.x = cvt_pk_bf16(Ct[a][c][0], Ct[a][c][1]); u.y = cvt_pk_bf16(Ct[a][c][2], Ct[a][c][3]);
                *(uint2*)(sCb + (jt >> 2) * 6144 + vimg_off(16 * c + lr, 2 * (jt & 3) + (g >> 1)) + 8 * (g & 1)) = u;
            }
        }
        __syncthreads();
    }
}

__device__ __forceinline__ void peer_token(const Params& P, int t, int lane, int* sidx, float* sval, int* sid, float* sgate) {
    const unsigned* tk = (const unsigned*)(P.ws + WS_RA) + (size_t)t * 256;
#pragma unroll
    for (int i = 0; i < 4; ++i) {
        const unsigned k = tk[lane * 4 + i];
        sidx[lane * 4 + i] = 127 - (int)(k & 127u);
        sval[lane * 4 + i] = unord_key(k & ~127u);
    }
    __builtin_amdgcn_s_waitcnt(0xc07f);
    __builtin_amdgcn_wave_barrier();
    if (lane < 8) {
        const int hd = lane;
        float v0[16], v1[16];
#pragma unroll
        for (int i = 0; i < 16; ++i) { v0[i] = sval[(2 * hd) * 16 + i]; v1[i] = sval[(2 * hd + 1) * 16 + i]; }
        unsigned top[16];
#pragma unroll
        for (int i = 0; i < 16; ++i) top[i] = 0u;
#pragma unroll
        for (int i = 0; i < 16; ++i)
#pragma unroll
            for (int j = 0; j < 16; ++j)
                if ((i + 1) * (j + 1) <= 16) {
                    unsigned kx = (ord_key(v0[i] + v1[j]) & ~255u) | (unsigned)(255 - (i * 16 + j));
#pragma unroll
                    for (int q = 0; q < 16; ++q) { const unsigned hi = max(top[q], kx), lo = min(top[q], kx); top[q] = hi; kx = lo; }
                }
        const float smax = unord_key(top[0] & ~255u);
        float e[16]; float den = 0.f;
#pragma unroll
        for (int q = 0; q < 16; ++q) { e[q] = __expf(unord_key(top[q] & ~255u) - smax); den += e[q]; }
        const float inv = 1.f / den;
#pragma unroll
        for (int q = 0; q < 16; ++q) {
            const int pos = 255 - (int)(top[q] & 255u), i = pos >> 4, j = pos & 15;
            sid[hd * 16 + q] = sidx[(2 * hd) * 16 + i] * 128 + sidx[(2 * hd + 1) * 16 + j];
            sgate[hd * 16 + q] = e[q] * inv;
        }
    }
    __builtin_amdgcn_s_waitcnt(0xc07f);
    __builtin_amdgcn_wave_barrier();
    const bf16_t* xn = (const bf16_t*)(P.ws + WS_XN) + (size_t)t * DM;
    const float rstd = ((const float*)(P.ws + WS_RSTD))[t];
    const unsigned char* U = P.ws + WS_U + lane * 16;
    const unsigned char* V = P.ws + WS_V + lane * 16;
    const float* usc = (const float*)(P.ws + WS_USC);
    const float* vsc = (const float*)(P.ws + WS_VSC);
    float xf[16];
    {
        const uint4 xa = *(const uint4*)(xn + lane * 16), xb = *(const uint4*)(xn + lane * 16 + 8);
        xf[0] = bflo(xa.x); xf[1] = bfhi(xa.x); xf[2] = bflo(xa.y); xf[3] = bfhi(xa.y); xf[4] = bflo(xa.z); xf[5] = bfhi(xa.z); xf[6] = bflo(xa.w); xf[7] = bfhi(xa.w);
        xf[8] = bflo(xb.x); xf[9] = bfhi(xb.x); xf[10] = bflo(xb.y); xf[11] = bfhi(xb.y); xf[12] = bflo(xb.z); xf[13] = bfhi(xb.z); xf[14] = bflo(xb.w); xf[15] = bfhi(xb.w);
    }
    float acc[16];
#pragma unroll
    for (int j = 0; j < 16; ++j) acc[j] = 0.f;
    const int myq = ((lane >> 5) & 1) * 4 + ((lane >> 4) & 1) * 2 + ((lane >> 3) & 1);
#pragma unroll 1
    for (int e0 = 0; e0 < 128; e0 += 8) {
        uint4 ur[8], vr[8];
#pragma unroll
        for (int q = 0; q < 8; ++q) {
            const int id = sid[e0 + q];
            ur[q] = *(const uint4*)(U + (size_t)id * DM);
            vr[q] = *(const uint4*)(V + (size_t)id * DM);
        }
        const int myid = sid[e0 + myq];
        const float mysc = usc[myid] * rstd, myvs = vsc[myid] * sgate[e0 + myq];
        float d[8];
#pragma unroll
        for (int q = 0; q < 8; ++q) {
            const unsigned wds[4] = {ur[q].x, ur[q].y, ur[q].z, ur[q].w};
            float s = 0.f;
#pragma unroll
            for (int k = 0; k < 4; ++k) {
                const f32x2 lo = __builtin_amdgcn_cvt_pk_f32_fp8((int)wds[k], false), hi = __builtin_amdgcn_cvt_pk_f32_fp8((int)wds[k], true);
                s += xf[4 * k] * lo.x + xf[4 * k + 1] * lo.y + xf[4 * k + 2] * hi.x + xf[4 * k + 3] * hi.y;
            }
            d[q] = s;
        }
        float r4[4], r2[2], r1;
#pragma unroll
        for (int i = 0; i < 4; ++i) { const bool up = (lane & 32) != 0; const float keep = up ? d[i + 4] : d[i], send = up ? d[i] : d[i + 4]; r4[i] = keep + __shfl_xor(send, 32, 64); }
#pragma unroll
        for (int i = 0; i < 2; ++i) { const bool up = (lane & 16) != 0; const float keep = up ? r4[i + 2] : r4[i], send = up ? r4[i] : r4[i + 2]; r2[i] = keep + __shfl_xor(send, 16, 64); }
        { const bool up = (lane & 8) != 0; const float keep = up ? r2[1] : r2[0], send = up ? r2[0] : r2[1]; r1 = keep + __shfl_xor(send, 8, 64); }
        r1 += __shfl_xor(r1, 4, 64); r1 += __shfl_xor(r1, 2, 64); r1 += __shfl_xor(r1, 1, 64);
        const float a = r1 * mysc;
        const float wmine = myvs * 0.5f * a * (1.f + erff(a * 0.70710678118654752f));
#pragma unroll
        for (int q = 0; q < 8; ++q) {
            const float w = __shfl(wmine, ((q >> 2) & 1) * 32 + ((q >> 1) & 1) * 16 + (q & 1) * 8, 64);
            const unsigned wds[4] = {vr[q].x, vr[q].y, vr[q].z, vr[q].w};
#pragma unroll
            for (int k = 0; k < 4; ++k) {
                const f32x2 lo = __builtin_amdgcn_cvt_pk_f32_fp8((int)wds[k], false), hi = __builtin_amdgcn_cvt_pk_f32_fp8((int)wds[k], true);
                acc[4 * k] += w * lo.x; acc[4 * k + 1] += w * lo.y; acc[4 * k + 2] += w * hi.x; acc[4 * k + 3] += w * hi.y;
            }
        }
    }
    float* o = P.out + (size_t)t * DM + lane * 16;
    float4 h0 = *(float4*)(o), h1 = *(float4*)(o + 4), h2 = *(float4*)(o + 8), h3 = *(float4*)(o + 12);
    h0.x += acc[0]; h0.y += acc[1]; h0.z += acc[2]; h0.w += acc[3]; h1.x += acc[4]; h1.y += acc[5]; h1.z += acc[6]; h1.w += acc[7];
    h2.x += acc[8]; h2.y += acc[9]; h2.z += acc[10]; h2.w += acc[11]; h3.x += acc[12]; h3.y += acc[13]; h3.z += acc[14]; h3.w += acc[15];
    *(float4*)(o) = h0; *(float4*)(o + 4) = h1; *(float4*)(o + 8) = h2; *(float4*)(o + 12) = h3;
    __builtin_amdgcn_s_waitcnt(0xc07f);
    __builtin_amdgcn_wave_barrier();
}

#define LAS __attribute__((address_space(3)))
#define XB_TMO      128
#define XB_XCNT(j)  (256  + 64 * (j))
#define XB_XSUB(j)  (1280 + 64 * (j))
#define XB_XGEN(j)  (2304 + 64 * (j))
#define XB_TOP      3328
#define XB_TOPGEN   3392
#define XCD_BAR_WORDS 3456
#define XB_SPIN_CAP (1u << 18)
__device__ __forceinline__ unsigned xb_ld(unsigned* p)              { return __hip_atomic_load(p, __ATOMIC_RELAXED, __HIP_MEMORY_SCOPE_AGENT); }
__device__ __forceinline__ unsigned xb_add(unsigned* p, unsigned v) { return __hip_atomic_fetch_add(p, v, __ATOMIC_RELAXED, __HIP_MEMORY_SCOPE_AGENT); }
__device__ __forceinline__ unsigned xb_xcc_id() { return (unsigned)__builtin_amdgcn_s_getreg((3 << 11) | 20) & 0xFu; }
#define XB_SPIN(cond, bar) do { unsigned _sp = 0; while (cond) { __builtin_amdgcn_s_sleep(1); \
    if ((++_sp & 255u) == 0u) { if (xb_ld(&(bar)[XB_TMO])) break; if (_sp > XB_SPIN_CAP) { atomicAdd(&(bar)[XB_TMO], 1u); break; } } } } while (0)
struct XcdBarrier { unsigned* bar; unsigned x; volatile LAS unsigned* st; };
__device__ __forceinline__ XcdBarrier xcd_barrier_post(unsigned* bar, volatile LAS unsigned* st) {
    XcdBarrier b; b.bar = bar; b.x = xb_xcc_id(); b.st = st;
    if (threadIdx.x == 0) (void)xb_add(&bar[XB_XCNT(b.x)], 1u);
    return b;
}
__device__ __forceinline__ void xcd_barrier_complete(unsigned* bar, unsigned x, unsigned& nloc, unsigned& nx) {
    const unsigned G = gridDim.x * gridDim.y * gridDim.z;
    unsigned sum, cnt, mine, sp = 0u;
    for (;;) {
        sum = 0u; cnt = 0u; mine = 0u;
#pragma unroll
        for (unsigned j = 0; j < 16; ++j) { const unsigned c = xb_ld(&bar[XB_XCNT(j)]); sum += c; cnt += (c > 0u) ? 1u : 0u; mine = (j == x) ? c : mine; }
        if (sum == G) break;
        __builtin_amdgcn_s_sleep(1);
        if ((++sp & 255u) == 0u) { if (xb_ld(&bar[XB_TMO])) break; if (sp > XB_SPIN_CAP) { atomicAdd(&bar[XB_TMO], 1u); break; } }
    }
    nloc = mine > 0u ? mine : 1u; nx = cnt > 0u ? cnt : 1u;
}
__device__ __forceinline__ void xcd_barrier(const XcdBarrier& b) {
    asm volatile("s_waitcnt vmcnt(0)" ::: "memory");
    __syncthreads();
    if (threadIdx.x == 0) {
        unsigned* bar = b.bar;
        __builtin_amdgcn_s_waitcnt(0);
        unsigned nloc = b.st[0], nx = b.st[1];
        if (nloc == 0u) { xcd_barrier_complete(bar, b.x, nloc, nx); b.st[0] = nloc; b.st[1] = nx; }
        const unsigned old = xb_add(&bar[XB_XSUB(b.x)], 1u);
        const unsigned gen = old / nloc;
        if (old + 1u == (gen + 1u) * nloc) {
            __builtin_amdgcn_fence(__ATOMIC_RELEASE, "agent");
            asm volatile("s_waitcnt vmcnt(0)" ::: "memory");
            const unsigned og = xb_add(&bar[XB_TOP], 1u);
            const unsigned tg = og / nx;
            if (og + 1u == (tg + 1u) * nx) xb_add(&bar[XB_TOPGEN], 1u);
            else XB_SPIN(xb_ld(&bar[XB_TOPGEN]) == tg, bar);
            __builtin_amdgcn_fence(__ATOMIC_ACQUIRE, "agent");
            xb_add(&bar[XB_XGEN(b.x)], 1u);
            asm volatile("s_waitcnt vmcnt(0)" ::: "memory");
        } else {
            XB_SPIN(xb_ld(&bar[XB_XGEN(b.x)]) == gen, bar);
            __builtin_amdgcn_fence(__ATOMIC_ACQUIRE, "agent");
            asm volatile("s_waitcnt vmcnt(0)" ::: "memory");
        }
    }
    __syncthreads();
}

__global__ void __launch_bounds__(256, 2) mega(Params P) {
    extern __shared__ __attribute__((aligned(16))) unsigned char smem[];
    cg::grid_group grid = cg::this_grid();
    const int tid = threadIdx.x, lane = tid & 63, wave = tid >> 6;
    const int G = gridDim.x, bid = blockIdx.x;
    unsigned* ctl = (unsigned*)(P.ws + WS_CTL);
    volatile LAS unsigned* bst = (volatile LAS unsigned*)(smem + 65552);
    if (tid == 0) { bst[0] = 0u; bst[1] = 0u; }
    __syncthreads();
    phase0(P, smem);
    grid.sync();
    const XcdBarrier xb = xcd_barrier_post(ctl + 1024, bst);
    {
        const int gw = bid * 4 + wave;
        if (gw < 64) fox_cum_wave(P, gw, lane);
        for (int tile = bid; tile < 129 * 28; tile += G) gemm_tile<1>(P, tile / 28, tile % 28, smem);
    }
    xcd_barrier(xb);
    {
        volatile int* s_item = (volatile int*)(smem + 65536);
        const int wave_u = __builtin_amdgcn_readfirstlane(wave);
        auto fetch = [&](unsigned* counter) -> int {
            if (wave_u == 0) {
                unsigned v = atomicAdd(counter, lane == 0 ? 1u : 0u);
                *s_item = (int)__builtin_amdgcn_readfirstlane(v);
            }
            __syncthreads();
            const int item = __builtin_amdgcn_readfirstlane(*s_item);
            __syncthreads();
            return item;
        };
        for (;;) {
            const int item = fetch(&ctl[0]);
            if (item >= 258) break;
            conv_item(P, item);
            __threadfence();
            __syncthreads();
            if (wave_u == 0) atomicAdd(&ctl[1], lane == 0 ? 1u : 0u);
        }
        for (;;) {
            const int item = fetch(&ctl[2]);
            if (item >= 128) break;
            if (wave_u == 0) {
                while (__hip_atomic_load(&ctl[1], __ATOMIC_RELAXED, __HIP_MEMORY_SCOPE_AGENT) < 258u) __builtin_amdgcn_s_sleep(8);
            }
            __threadfence();
            __syncthreads();
            mlstm_block(P, item, smem);
        }
        for (;;) {
            const int item = fetch(&ctl[3]);
            if (item >= 64 * 33) break;
            attn_block(P, item & 63, 32 - (item >> 6), smem);
        }
    }
    xcd_barrier(xb);
    for (int tile = bid; tile < 128 * 8; tile += G) gemm_tile<2>(P, tile >> 3, tile & 7, smem);
    convert_uv_rows(P, bid * 4 + wave, G * 4, lane);
    xcd_barrier(xb);
    for (int tile = bid; tile < 128 * 16; tile += G) gemm_tile<3>(P, tile >> 4, tile & 15, smem);
    xcd_barrier(xb);
    {
        int* sidx = (int*)(smem + wave * 3072); float* sval = (float*)(smem + wave * 3072 + 1024);
        int* sid = (int*)(smem + wave * 3072 + 2048); float* sgate = (float*)(smem + wave * 3072 + 2560);
        for (int t = bid * 4 + wave; t < T2; t += G * 4) peer_token(P, t, lane, sidx, sval, sid, sgate);
    }
}

}

extern "C" void kernel_launch(void* const* d_in, const int* in_sizes, int n_in, void* d_out, int out_size, void* d_ws, size_t ws_size, hipStream_t stream) {
    if (n_in != 17 || ws_size < WS_END) { fprintf(stderr, "kernel_launch: unexpected n_in %d or ws_size %zu (need %zu)\n", n_in, ws_size, (size_t)WS_END); return; }
    constexpr int LDS_BYTES = 66560;
    static int grid_blocks = 0;
    if (!grid_blocks) {
        int dev = 0, cus = 0, per_cu = 0;
        (void)hipGetDevice(&dev);
        (void)hipDeviceGetAttribute(&cus, hipDeviceAttributeMultiprocessorCount, dev);
        (void)hipFuncSetAttribute((const void*)mega, hipFuncAttributeMaxDynamicSharedMemorySize, LDS_BYTES);
        (void)hipOccupancyMaxActiveBlocksPerMultiprocessor(&per_cu, (const void*)mega, 256, LDS_BYTES);
        if (per_cu < 1) per_cu = 1;
        if (per_cu > 2) per_cu = 2;
        grid_blocks = cus * per_cu;
        fprintf(stderr, "kernel_launch: cus %d per_cu %d grid %d\n", cus, per_cu, grid_blocks);
    }
    Params P{};
    P.x = (const float*)d_in[0]; P.meta = (const float*)d_in[1]; P.norm_mix = (const float*)d_in[2]; P.w_in = (const float*)d_in[3];
    P.conv_qk = (const float*)d_in[4]; P.b_igate = (const float*)d_in[5]; P.b_fgate_m = (const float*)d_in[6]; P.m_out_norm = (const float*)d_in[7];
    P.b_fgate_f = (const float*)d_in[8]; P.f_q_norm = (const float*)d_in[9]; P.f_k_norm = (const float*)d_in[10]; P.w_out = (const float*)d_in[11];
    P.norm_ffn = (const float*)d_in[12]; P.peer_query = (const float*)d_in[13]; P.peer_keys = (const float*)d_in[14]; P.peer_u = (const float*)d_in[15];
    P.peer_v = (const float*)d_in[16]; P.out = (float*)d_out; P.ws = (unsigned char*)d_ws;
    void* args[] = {&P};
    hipError_t e = hipLaunchCooperativeKernel((const void*)mega, dim3(grid_blocks), dim3(256), args, LDS_BYTES, stream);
    if (e != hipSuccess) fprintf(stderr, "cooperative launch failed: %s (grid %d)\n", hipGetErrorString(e), grid_blocks);
}
```

```cpp
#include <hip/hip_runtime.h>
#include <stdint.h>
#include <stdio.h>
#include <hip/hip_cooperative_groups.h>
namespace cg = cooperative_groups;

namespace {

constexpr int NB = 8, SEQ = 2048, DM = 1024, NMETA = 16, L = SEQ + NMETA;
constexpr int T1 = NB * L;
constexpr int T2 = NB * SEQ;
constexpr int NZ = 3584;
constexpr int ZC_MQ = 0, ZC_MK = 512, ZC_MV = 1024, ZC_MO = 1536, ZC_FQ = 2048, ZC_FK = 2560, ZC_FV = 3072;
constexpr int PROJ = 3600;
constexpr float EPS = 1e-6f;

constexpr size_t WS_CTL = 0;
constexpr size_t WS_RA = 65536;
constexpr size_t WS_Z = WS_RA + (size_t)T1 * DM * 2;
constexpr size_t WS_GATES = WS_Z + (size_t)T1 * NZ * 2;
constexpr size_t WS_CUM = WS_GATES + (size_t)T1 * 16 * 4;
constexpr size_t WS_SSQ = WS_CUM + (size_t)NB * 8 * L * 4;
constexpr size_t WS_RSTD = WS_SSQ + (size_t)T2 * 16 * 4;
constexpr size_t WS_SSQM = WS_RSTD + (size_t)T2 * 4;
constexpr size_t WS_BT2 = WS_SSQM + (size_t)T1 * 16 * 4;
constexpr size_t WS_BT3 = WS_BT2 + (size_t)DM * DM * 2;
constexpr size_t WS_KEYS = WS_BT3 + (size_t)2048 * DM * 2;
constexpr size_t WS_MSC = WS_KEYS + (size_t)16 * 128 * 128 * 2;
constexpr size_t WS_MST = WS_MSC + (size_t)128 * 33 * 16;
constexpr size_t WS_BT1 = WS_MST + (size_t)128 * 33 * 12288;
constexpr size_t WS_CBI = WS_BT1;
constexpr size_t WS_END = WS_CBI + (size_t)128 * 33 * 12288;
constexpr size_t WS_XN = WS_RA;
constexpr size_t WS_U = WS_MST;
constexpr size_t WS_V = WS_U + (size_t)16384 * DM;
constexpr size_t WS_USC = WS_V + (size_t)16384 * DM;
constexpr size_t WS_VSC = WS_USC + (size_t)16384 * 4;
constexpr size_t WS_TK = WS_CBI;
constexpr float LOG2E = 1.4426950408889634f;

typedef unsigned short bf16_t;
typedef short bf16x8 __attribute__((ext_vector_type(8)));
typedef float f32x4 __attribute__((ext_vector_type(4)));
typedef __attribute__((ext_vector_type(2))) __bf16 bf16x2_t;

struct Params {
    const float* x; const float* meta; const float* norm_mix; const float* w_in; const float* conv_qk;
    const float* b_igate; const float* b_fgate_m; const float* m_out_norm; const float* b_fgate_f;
    const float* f_q_norm; const float* f_k_norm; const float* w_out; const float* norm_ffn;
    const float* peer_query; const float* peer_keys; const float* peer_u; const float* peer_v;
    float* out; unsigned char* ws;
};

__device__ __forceinline__ unsigned f2bf(float f) { unsigned u = __float_as_uint(f); return (u + 0x7fffu + ((u >> 16) & 1u)) >> 16; }
__device__ __forceinline__ float bf2f(unsigned h) { return __uint_as_float(h << 16); }
typedef float f32x2 __attribute__((ext_vector_type(2)));
typedef __bf16 bf16x2v __attribute__((ext_vector_type(2)));
__device__ __forceinline__ unsigned cvt_pk_bf16(float lo, float hi) { f32x2 v = {lo, hi}; bf16x2v b = __builtin_convertvector(v, bf16x2v); return __builtin_bit_cast(unsigned, b); }
__device__ __forceinline__ unsigned pk2(float lo, float hi) { return cvt_pk_bf16(lo, hi); }
__device__ __forceinline__ float bflo(unsigned w) { return __uint_as_float(w << 16); }
__device__ __forceinline__ float bfhi(unsigned w) { return __uint_as_float(w & 0xffff0000u); }
__device__ __forceinline__ float wave_sum(float v) {
#pragma unroll
    for (int o = 32; o > 0; o >>= 1) v += __shfl_xor(v, o, 64);
    return v;
}
__device__ __forceinline__ float wave_max(float v) {
#pragma unroll
    for (int o = 32; o > 0; o >>= 1) v = fmaxf(v, __shfl_xor(v, o, 64));
    return v;
}
__device__ __forceinline__ float logsigmoidf(float x) { return fminf(x, 0.f) - log1pf(expf(-fabsf(x))); }
__device__ __forceinline__ unsigned ord_key(float f) { unsigned u = __float_as_uint(f); return u ^ ((u >> 31) ? 0xffffffffu : 0x80000000u); }
__device__ __forceinline__ float unord_key(unsigned k) { unsigned u = (k & 0x80000000u) ? (k ^ 0x80000000u) : ~k; return __uint_as_float(u); }

__device__ __forceinline__ void phase0(const Params& P, unsigned char* smem) {
    const int tid = threadIdx.x, lane = tid & 63, wave = tid >> 6;
    unsigned* ctl = (unsigned*)(P.ws + WS_CTL);
    if (blockIdx.x == 0) for (int i = tid; i < 8192; i += 256) ctl[i] = 0u;
    float* gw = (float*)smem;
    for (int idx = tid; idx < 16 * 1024; idx += 256) {
        const int k = idx >> 4, c = idx & 15;
        const int col = c < 8 ? 2048 + c : 3592 + (c - 8);
        gw[c * 1024 + k] = P.w_in[(size_t)k * PROJ + col];
    }
    __syncthreads();
    {
        bf16_t* hn = (bf16_t*)(P.ws + WS_RA);
        float* gates = (float*)(P.ws + WS_GATES);
        const int c0 = lane * 8, c1 = 512 + lane * 8;
        for (int r = blockIdx.x * 4 + wave; r < T1; r += gridDim.x * 4) {
            const int b = r / L, p = r - b * L;
            const float* src = (p < NMETA) ? (P.meta + (size_t)p * DM) : (P.x + ((size_t)b * SEQ + (p - NMETA)) * DM);
            float v[16];
            {
                const float4 a0 = *(const float4*)(src + c0), a1 = *(const float4*)(src + c0 + 4);
                const float4 a2 = *(const float4*)(src + c1), a3 = *(const float4*)(src + c1 + 4);
                v[0] = a0.x; v[1] = a0.y; v[2] = a0.z; v[3] = a0.w; v[4] = a1.x; v[5] = a1.y; v[6] = a1.z; v[7] = a1.w;
                v[8] = a2.x; v[9] = a2.y; v[10] = a2.z; v[11] = a2.w; v[12] = a3.x; v[13] = a3.y; v[14] = a3.z; v[15] = a3.w;
            }
            float ss = 0.f;
#pragma unroll
            for (int j = 0; j < 16; ++j) ss += v[j] * v[j];
            ss = wave_sum(ss);
            const float rstd = rsqrtf(ss * (1.0f / DM) + EPS);
            {
                const float4 a0 = *(const float4*)(P.norm_mix + c0), a1 = *(const float4*)(P.norm_mix + c0 + 4);
                const float4 a2 = *(const float4*)(P.norm_mix + c1), a3 = *(const float4*)(P.norm_mix + c1 + 4);
                v[0] *= rstd * a0.x; v[1] *= rstd * a0.y; v[2] *= rstd * a0.z; v[3] *= rstd * a0.w; v[4] *= rstd * a1.x; v[5] *= rstd * a1.y; v[6] *= rstd * a1.z; v[7] *= rstd * a1.w;
                v[8] *= rstd * a2.x; v[9] *= rstd * a2.y; v[10] *= rstd * a2.z; v[11] *= rstd * a2.w; v[12] *= rstd * a3.x; v[13] *= rstd * a3.y; v[14] *= rstd * a3.z; v[15] *= rstd * a3.w;
            }
            uint4 o0, o1;
            o0.x = pk2(v[0], v[1]); o0.y = pk2(v[2], v[3]); o0.z = pk2(v[4], v[5]); o0.w = pk2(v[6], v[7]);
            o1.x = pk2(v[8], v[9]); o1.y = pk2(v[10], v[11]); o1.z = pk2(v[12], v[13]); o1.w = pk2(v[14], v[15]);
            *(uint4*)(hn + (size_t)r * DM + c0) = o0;
            *(uint4*)(hn + (size_t)r * DM + c1) = o1;
            float mine = 0.f;
#pragma unroll 1
            for (int c = 0; c < 16; ++c) {
                const float* gwc = gw + c * 1024;
                const float4 w0 = *(const float4*)(gwc + c0), w1 = *(const float4*)(gwc + c0 + 4), w2 = *(const float4*)(gwc + c1), w3 = *(const float4*)(gwc + c1 + 4);
                float s = v[0] * w0.x + v[1] * w0.y + v[2] * w0.z + v[3] * w0.w + v[4] * w1.x + v[5] * w1.y + v[6] * w1.z + v[7] * w1.w
                        + v[8] * w2.x + v[9] * w2.y + v[10] * w2.z + v[11] * w2.w + v[12] * w3.x + v[13] * w3.y + v[14] * w3.z + v[15] * w3.w;
                s = wave_sum(s);
                if (lane == c) mine = s;
            }
            if (lane < 16) {
                float val;
                if (lane < 4) val = mine + P.b_igate[lane];
                else if (lane < 8) val = logsigmoidf(mine + P.b_fgate_m[lane - 4]);
                else val = logsigmoidf(mine + P.b_fgate_f[lane - 8]);
                gates[(size_t)r * 16 + lane] = val;
            }
        }
    }
    __syncthreads();
    {
        float (*tile)[65] = (float (*)[65])smem;
        for (int item = blockIdx.x; item < 1664; item += gridDim.x) {
            const float* W; int ldn, ntn, shift_from, it; bf16_t* out;
            if (item < 896) { W = P.w_in; ldn = PROJ; ntn = 56; shift_from = 2048; it = item; out = (bf16_t*)(P.ws + WS_BT1); }
            else if (item < 1152) { W = P.w_out; ldn = 1024; ntn = 16; shift_from = 1 << 30; it = item - 896; out = (bf16_t*)(P.ws + WS_BT2); }
            else { W = P.peer_query; ldn = 2048; ntn = 32; shift_from = 1 << 30; it = item - 1152; out = (bf16_t*)(P.ws + WS_BT3); }
            const int tk = it / ntn, tn = it - tk * ntn, k0 = tk * 64, n0 = tn * 64;
            {
                const int nl = tid & 63;
                int n = n0 + nl; if (n >= shift_from) n += 8;
#pragma unroll
                for (int i = 0; i < 16; ++i) { const int kl = (tid >> 6) + 4 * i; tile[kl][nl] = W[(size_t)(k0 + kl) * ldn + n]; }
            }
            __syncthreads();
            {
                const int kl = tid & 63;
#pragma unroll
                for (int i = 0; i < 16; ++i) { const int nl = (tid >> 6) + 4 * i; out[(size_t)(n0 + nl) * 1024 + k0 + kl] = (bf16_t)f2bf(tile[kl][nl]); }
            }
            __syncthreads();
        }
    }
    {
        const size_t gt = (size_t)blockIdx.x * 256 + tid, gs = (size_t)gridDim.x * 256;
        const float* src = P.peer_keys; bf16_t* dst = (bf16_t*)(P.ws + WS_KEYS);
        for (size_t i = gt; i < (size_t)(16 * 128 * 128 / 8); i += gs) {
            const float4 a = *(const float4*)(src + i * 8), b = *(const float4*)(src + i * 8 + 4);
            uint4 o; o.x = pk2(a.x, a.y); o.y = pk2(a.z, a.w); o.z = pk2(b.x, b.y); o.w = pk2(b.z, b.w);
            *(uint4*)(dst + i * 8) = o;
        }
    }
}

__device__ __forceinline__ void convert_uv_rows(const Params& P, int gwave, int nwaves, int lane) {
    for (int rr = gwave; rr < 2 * 16384; rr += nwaves) {
        const int which = rr >> 14, row = rr & 16383;
        const float* src = (which ? P.peer_v : P.peer_u) + (size_t)row * DM + lane * 16;
        const float4 a0 = *(const float4*)(src), a1 = *(const float4*)(src + 4), a2 = *(const float4*)(src + 8), a3 = *(const float4*)(src + 12);
        float mx = fmaxf(fmaxf(fmaxf(fabsf(a0.x), fabsf(a0.y)), fmaxf(fabsf(a0.z), fabsf(a0.w))), fmaxf(fmaxf(fabsf(a1.x), fabsf(a1.y)), fmaxf(fabsf(a1.z), fabsf(a1.w))));
        mx = fmaxf(mx, fmaxf(fmaxf(fmaxf(fabsf(a2.x), fabsf(a2.y)), fmaxf(fabsf(a2.z), fabsf(a2.w))), fmaxf(fmaxf(fabsf(a3.x), fabsf(a3.y)), fmaxf(fabsf(a3.z), fabsf(a3.w)))));
        mx = wave_max(mx);
        const float sc = mx > 0.f ? 256.0f / mx : 1.0f;
        uint4 o; int wd;
        wd = 0; wd = __builtin_amdgcn_cvt_pk_fp8_f32(a0.x * sc, a0.y * sc, wd, false); wd = __builtin_amdgcn_cvt_pk_fp8_f32(a0.z * sc, a0.w * sc, wd, true); o.x = (unsigned)wd;
        wd = 0; wd = __builtin_amdgcn_cvt_pk_fp8_f32(a1.x * sc, a1.y * sc, wd, false); wd = __builtin_amdgcn_cvt_pk_fp8_f32(a1.z * sc, a1.w * sc, wd, true); o.y = (unsigned)wd;
        wd = 0; wd = __builtin_amdgcn_cvt_pk_fp8_f32(a2.x * sc, a2.y * sc, wd, false); wd = __builtin_amdgcn_cvt_pk_fp8_f32(a2.z * sc, a2.w * sc, wd, true); o.z = (unsigned)wd;
        wd = 0; wd = __builtin_amdgcn_cvt_pk_fp8_f32(a3.x * sc, a3.y * sc, wd, false); wd = __builtin_amdgcn_cvt_pk_fp8_f32(a3.z * sc, a3.w * sc, wd, true); o.w = (unsigned)wd;
        *(uint4*)(P.ws + (which ? WS_V : WS_U) + (size_t)row * DM + lane * 16) = o;
        if (lane == 0) ((float*)(P.ws + (which ? WS_VSC : WS_USC)))[row] = mx > 0.f ? mx * (1.0f / 256.0f) : 1.0f;
    }
}

__device__ __forceinline__ void mma_ktile(const unsigned char* sA, const unsigned char* sB, int arow_off, int brow_off, int g, int sw, f32x4 (&acc)[4][4]) {
#pragma unroll
    for (int s = 0; s < 2; ++s) {
        bf16x8 a[4], b[4];
        const int ch = (((s * 4 + g) ^ sw) << 4);
#pragma unroll
        for (int i = 0; i < 4; ++i) a[i] = *(const bf16x8*)(sA + arow_off + i * 2048 + ch);
#pragma unroll
        for (int j = 0; j < 4; ++j) b[j] = *(const bf16x8*)(sB + brow_off + j * 2048 + ch);
#pragma unroll
        for (int i = 0; i < 4; ++i)
#pragma unroll
            for (int j = 0; j < 4; ++j) acc[i][j] = __builtin_amdgcn_mfma_f32_16x16x32_bf16(b[j], a[i], acc[i][j], 0, 0, 0);
    }
}

__device__ __forceinline__ void store_tile_bf16(const f32x4 (&acc)[4][4], unsigned char* smem, bf16_t* dst, size_t ld, int m0, int n0, int tid, int wr, int wc, int g, int lr) {
#pragma unroll
    for (int i = 0; i < 4; ++i)
#pragma unroll
        for (int j = 0; j < 4; ++j) {
            const int row = wr * 64 + 16 * i + lr, col = wc * 64 + 16 * j + 4 * g;
            uint2 w; w.x = pk2(acc[i][j][0], acc[i][j][1]); w.y = pk2(acc[i][j][2], acc[i][j][3]);
            *(uint2*)(smem + row * 272 + col * 2) = w;
        }
    __syncthreads();
#pragma unroll
    for (int q = 0; q < 8; ++q) {
        const int id = tid + 256 * q, row = id >> 4, ch = id & 15;
        const uint4 v = *(const uint4*)(smem + row * 272 + ch * 16);
        *(uint4*)(dst + (size_t)(m0 + row) * ld + n0 + ch * 8) = v;
    }
    __syncthreads();
}

template <int MODE>
__device__ __forceinline__ void gemm_tile(const Params& P, int tm, int tn, unsigned char* smem) {
    const bf16_t* A; const bf16_t* Bt;
    if (MODE == 1) { A = (const bf16_t*)(P.ws + WS_RA); Bt = (const bf16_t*)(P.ws + WS_BT1); }
    else if (MODE == 2) { A = (const bf16_t*)(P.ws + WS_Z); Bt = (const bf16_t*)(P.ws + WS_BT2); }
    else { A = (const bf16_t*)(P.ws + WS_XN); Bt = (const bf16_t*)(P.ws + WS_BT3); }
    const int tid = threadIdx.x, lane = tid & 63, wave = tid >> 6, wr = wave >> 1, wc = wave & 1, g = lane >> 4, lr = lane & 15;
    const int m0 = tm * 128, n0 = tn * 128;
    const int srow = tid >> 3, sc = tid & 7;
    const bf16_t* aptr[4]; const bf16_t* bptr[4]; int soff[4];
#pragma unroll
    for (int j = 0; j < 4; ++j) {
        const int row = srow + 32 * j;
        int ar = m0 + row;
        if (MODE == 2) { const int b = ar >> 11, t = ar & 2047; ar = b * L + NMETA + t; }
        aptr[j] = A + (size_t)ar * (MODE == 2 ? NZ : 1024) + sc * 8;
        bptr[j] = Bt + (size_t)(n0 + row) * 1024 + sc * 8;
        soff[j] = row * 128 + ((sc ^ (row & 7)) << 4);
    }
    f32x4 acc[4][4];
#pragma unroll
    for (int i = 0; i < 4; ++i)
#pragma unroll
        for (int j = 0; j < 4; ++j) acc[i][j] = (f32x4){0.f, 0.f, 0.f, 0.f};
    uint4 ra[4], rb[4];
#pragma unroll
    for (int j = 0; j < 4; ++j) { ra[j] = *(const uint4*)(aptr[j]); rb[j] = *(const uint4*)(bptr[j]); }
    const float* ssqm_row[4];
    if (MODE == 2) {
#pragma unroll
        for (int j = 0; j < 4; ++j) {
            int ar = m0 + srow + 32 * j; { const int b = ar >> 11, t = ar & 2047; ar = b * L + NMETA + t; }
            ssqm_row[j] = (const float*)(P.ws + WS_SSQM) + (size_t)ar * 16;
            const float4 q4 = *(const float4*)(ssqm_row[j]);
            const float rs = rsqrtf(((q4.x + q4.y) + (q4.z + q4.w)) * (1.0f / 128.0f) + EPS);
            ra[j].x = pk2(bflo(ra[j].x) * rs, bfhi(ra[j].x) * rs); ra[j].y = pk2(bflo(ra[j].y) * rs, bfhi(ra[j].y) * rs);
            ra[j].z = pk2(bflo(ra[j].z) * rs, bfhi(ra[j].z) * rs); ra[j].w = pk2(bflo(ra[j].w) * rs, bfhi(ra[j].w) * rs);
        }
    }
    unsigned char* sA0 = smem; unsigned char* sB0 = smem + 16384; unsigned char* sA1 = smem + 32768; unsigned char* sB1 = smem + 49152;
#pragma unroll
    for (int j = 0; j < 4; ++j) { *(uint4*)(sA0 + soff[j]) = ra[j]; *(uint4*)(sB0 + soff[j]) = rb[j]; }
    __syncthreads();
    const int arow_off = (wr * 64 + lr) * 128, brow_off = (wc * 64 + lr) * 128, sw = lr & 7;
    for (int kt = 0; kt < 16; ++kt) {
        unsigned char* sA = (kt & 1) ? sA1 : sA0; unsigned char* sB = (kt & 1) ? sB1 : sB0;
        unsigned char* nA = (kt & 1) ? sA0 : sA1; unsigned char* nB = (kt & 1) ? sB0 : sB1;
        if (kt < 15) {
#pragma unroll
            for (int j = 0; j < 4; ++j) { ra[j] = *(const uint4*)(aptr[j] + (kt + 1) * 64); rb[j] = *(const uint4*)(bptr[j] + (kt + 1) * 64); }
            if (MODE == 2 && kt + 1 < 8) {
                const int head = (kt + 1) >> 1;
#pragma unroll
                for (int j = 0; j < 4; ++j) {
                    const float4 q4 = *(const float4*)(ssqm_row[j] + head * 4);
                    const float rs = rsqrtf(((q4.x + q4.y) + (q4.z + q4.w)) * (1.0f / 128.0f) + EPS);
                    ra[j].x = pk2(bflo(ra[j].x) * rs, bfhi(ra[j].x) * rs); ra[j].y = pk2(bflo(ra[j].y) * rs, bfhi(ra[j].y) * rs);
                    ra[j].z = pk2(bflo(ra[j].z) * rs, bfhi(ra[j].z) * rs); ra[j].w = pk2(bflo(ra[j].w) * rs, bfhi(ra[j].w) * rs);
                }
            }
        }
        mma_ktile(sA, sB, arow_off, brow_off, g, sw, acc);
        if (kt < 15) {
#pragma unroll
            for (int j = 0; j < 4; ++j) { *(uint4*)(nA + soff[j]) = ra[j]; *(uint4*)(nB + soff[j]) = rb[j]; }
        }
        __syncthreads();
    }
    if (MODE == 1) {
        if (n0 >= ZC_FQ && n0 < ZC_FV) {
            const bool isk = n0 >= ZC_FK;
            const float* gain = isk ? P.f_k_norm : P.f_q_norm;
            const float scl = isk ? 1.0f : 0.125f * LOG2E;
            float gn[4][4];
#pragma unroll
            for (int j = 0; j < 4; ++j)
#pragma unroll
                for (int r = 0; r < 4; ++r) gn[j][r] = gain[16 * j + 4 * g + r];
#pragma unroll
            for (int i = 0; i < 4; ++i) {
                float ss = 0.f;
#pragma unroll
                for (int j = 0; j < 4; ++j)
#pragma unroll
                    for (int r = 0; r < 4; ++r) ss += acc[i][j][r] * acc[i][j][r];
                ss += __shfl_xor(ss, 16, 64); ss += __shfl_xor(ss, 32, 64);
                const float rstd = rsqrtf(ss * (1.0f / 64.0f) + EPS) * scl;
#pragma unroll
                for (int j = 0; j < 4; ++j)
#pragma unroll
                    for (int r = 0; r < 4; ++r) acc[i][j][r] *= rstd * gn[j][r];
            }
        }
        store_tile_bf16(acc, smem, (bf16_t*)(P.ws + WS_Z), NZ, m0, n0, tid, wr, wc, g, lr);
    } else if (MODE == 2) {
        float* ssq = (float*)(P.ws + WS_SSQ);
#pragma unroll
        for (int i = 0; i < 4; ++i) {
            const int row = m0 + wr * 64 + 16 * i + lr;
            float ss = 0.f;
#pragma unroll
            for (int j = 0; j < 4; ++j) {
                const int col = n0 + wc * 64 + 16 * j + 4 * g;
                const float4 xv = *(const float4*)(P.x + (size_t)row * DM + col);
                const float4 gv = *(const float4*)(P.norm_ffn + col);
                float4 hv; hv.x = acc[i][j][0] + xv.x; hv.y = acc[i][j][1] + xv.y; hv.z = acc[i][j][2] + xv.z; hv.w = acc[i][j][3] + xv.w;
                *(float4*)(P.out + (size_t)row * DM + col) = hv;
                ss += hv.x * hv.x + hv.y * hv.y + hv.z * hv.z + hv.w * hv.w;
                acc[i][j][0] = hv.x * gv.x; acc[i][j][1] = hv.y * gv.y; acc[i][j][2] = hv.z * gv.z; acc[i][j][3] = hv.w * gv.w;
            }
            ss += __shfl_xor(ss, 16, 64); ss += __shfl_xor(ss, 32, 64);
            if (g == 0) ssq[(size_t)row * 16 + tn * 2 + wc] = ss;
        }
        store_tile_bf16(acc, smem, (bf16_t*)(P.ws + WS_XN), 1024, m0, n0, tid, wr, wc, g, lr);
    } else {
        const int hp = tn;
        const float* ssq = (const float*)(P.ws + WS_SSQ);
        float rs[4];
#pragma unroll
        for (int i = 0; i < 4; ++i) {
            const int row = m0 + wr * 64 + 16 * i + lr;
            const float4 p0 = *(const float4*)(ssq + (size_t)row * 16), p1 = *(const float4*)(ssq + (size_t)row * 16 + 4);
            const float4 p2 = *(const float4*)(ssq + (size_t)row * 16 + 8), p3 = *(const float4*)(ssq + (size_t)row * 16 + 12);
            const float s = ((p0.x + p0.y) + (p0.z + p0.w)) + ((p1.x + p1.y) + (p1.z + p1.w)) + ((p2.x + p2.y) + (p2.z + p2.w)) + ((p3.x + p3.y) + (p3.z + p3.w));
            rs[i] = rsqrtf(s * (1.0f / DM) + EPS);
            if (tn == 0 && wc == 0 && g == 0) ((float*)(P.ws + WS_RSTD))[row] = rs[i];
        }
        {
            unsigned char* sAq = wc ? sA1 : sA0;
#pragma unroll
            for (int i = 0; i < 4; ++i)
#pragma unroll
                for (int j = 0; j < 4; ++j) {
                    const int row = wr * 64 + 16 * i + lr;
                    const int chunk = 2 * j + (g >> 1);
                    uint2 w; w.x = pk2(acc[i][j][0] * rs[i], acc[i][j][1] * rs[i]); w.y = pk2(acc[i][j][2] * rs[i], acc[i][j][3] * rs[i]);
                    *(uint2*)(sAq + row * 128 + ((chunk ^ (row & 7)) << 4) + 8 * (g & 1)) = w;
                }
            const bf16_t* keys = (const bf16_t*)(P.ws + WS_KEYS) + (size_t)hp * 128 * 128;
#pragma unroll
            for (int j = 0; j < 4; ++j) {
                const int row = srow + 32 * j;
                const uint4 k0 = *(const uint4*)(keys + (size_t)row * 128 + sc * 8);
                const uint4 k1 = *(const uint4*)(keys + (size_t)row * 128 + 64 + sc * 8);
                *(uint4*)(sB0 + soff[j]) = k0; *(uint4*)(sB1 + soff[j]) = k1;
            }
        }
        __syncthreads();
#pragma unroll
        for (int i = 0; i < 4; ++i)
#pragma unroll
            for (int j = 0; j < 4; ++j) acc[i][j] = (f32x4){0.f, 0.f, 0.f, 0.f};
        mma_ktile(sA0, sB0, arow_off, brow_off, g, sw, acc);
        mma_ktile(sA1, sB1, arow_off, brow_off, g, sw, acc);
        __syncthreads();
#pragma unroll
        for (int i = 0; i < 4; ++i)
#pragma unroll
            for (int j = 0; j < 4; ++j) {
                const int row = wr * 64 + 16 * i + lr;
                const int c4 = wc * 16 + 4 * j + g;
                *(f32x4*)(smem + row * 512 + ((c4 ^ (row & 31)) << 4)) = acc[i][j];
            }
        __syncthreads();
        unsigned top[16];
#pragma unroll
        for (int q = 0; q < 16; ++q) top[q] = 0u;
        const int row = tid & 127, half = tid >> 7;
#pragma unroll 1
        for (int s = 0; s < 16; ++s) {
            const int c4 = half * 16 + s;
            const f32x4 v = *(const f32x4*)(smem + row * 512 + ((c4 ^ (row & 31)) << 4));
#pragma unroll
            for (int e = 0; e < 4; ++e) {
                unsigned kx = (ord_key(v[e]) & ~127u) | (unsigned)(127 - (c4 * 4 + e));
#pragma unroll
                for (int q = 0; q < 16; ++q) { const unsigned hi = max(top[q], kx), lo = min(top[q], kx); top[q] = hi; kx = lo; }
            }
        }
        __syncthreads();
        if (half) {
            uint4* lp = (uint4*)(smem + row * 64);
            lp[0] = make_uint4(top[0], top[1], top[2], top[3]); lp[1] = make_uint4(top[4], top[5], top[6], top[7]);
            lp[2] = make_uint4(top[8], top[9], top[10], top[11]); lp[3] = make_uint4(top[12], top[13], top[14], top[15]);
        }
        __syncthreads();
        if (!half) {
            const uint4* lp = (const uint4*)(smem + row * 64);
#pragma unroll
            for (int c = 0; c < 4; ++c) {
                const uint4 o = lp[c];
                unsigned ks[4] = {o.x, o.y, o.z, o.w};
#pragma unroll
                for (int e = 0; e < 4; ++e) {
                    unsigned kx = ks[e];
#pragma unroll
                    for (int q = 0; q < 16; ++q) { const unsigned hi = max(top[q], kx), lo = min(top[q], kx); top[q] = hi; kx = lo; }
                }
            }
            uint4* tk = (uint4*)((unsigned*)(P.ws + WS_TK) + ((size_t)(m0 + row) * 16 + hp) * 16);
            tk[0] = make_uint4(top[0], top[1], top[2], top[3]); tk[1] = make_uint4(top[4], top[5], top[6], top[7]);
            tk[2] = make_uint4(top[8], top[9], top[10], top[11]); tk[3] = make_uint4(top[12], top[13], top[14], top[15]);
        }
        __syncthreads();
    }
}

__device__ __forceinline__ void fox_cum_wave(const Params& P, int bh, int lane) {
    const int b = bh >> 3, h = bh & 7;
    const float* gates = (const float*)(P.ws + WS_GATES);
    float* cum = (float*)(P.ws + WS_CUM) + (size_t)bh * L;
    constexpr int SEG = 33;
    const int t0 = lane * SEG;
    float loc = 0.f;
    for (int i = 0; i < SEG; ++i) { const int t = t0 + i; if (t < L) loc += gates[(size_t)(b * L + t) * 16 + 8 + h]; }
    float incl = loc;
#pragma unroll
    for (int o = 1; o < 64; o <<= 1) { const float n = __shfl_up(incl, o, 64); if (lane >= o) incl += n; }
    float run = incl - loc;
    for (int i = 0; i < SEG; ++i) { const int t = t0 + i; if (t < L) { run += gates[(size_t)(b * L + t) * 16 + 8 + h]; cum[t] = run * LOG2E; } }
}

#define TR_SLOW 0

__device__ __forceinline__ int vimg_off(int row, int ch) { return row * 128 + ((ch ^ (((row >> 1) & 3) << 1)) << 4); }
__device__ __forceinline__ uint2 tr_frag(const unsigned char* img, int row0, int c, int g, int lr) {
#if TR_SLOW
    unsigned short e[4];
#pragma unroll
    for (int k = 0; k < 4; ++k) { const int row = row0 + 4 * g + k, col = 16 * c + lr; e[k] = *(const unsigned short*)(img + vimg_off(row, col >> 3) + (col & 7) * 2); }
    uint2 r; r.x = (unsigned)e[0] | ((unsigned)e[1] << 16); r.y = (unsigned)e[2] | ((unsigned)e[3] << 16); return r;
#else
    const int q = lr >> 2, p = lr & 3, row = row0 + 4 * g + q;
    const unsigned addr = (unsigned)(size_t)(img + vimg_off(row, 2 * c + (p >> 1)) + 8 * (p & 1));
    uint2 r;
    asm volatile("ds_read_b64_tr_b16 %0, %1\n\ts_waitcnt lgkmcnt(0)" : "=&v"(r) : "v"(addr) : "memory");
    return r;
#endif
}

__device__ __forceinline__ unsigned tr_lane_addr(const unsigned char* img, int c, int g, int lr) {
    const int q = lr >> 2, p = lr & 3, row = 4 * g + q;
    return (unsigned)(size_t)(img + vimg_off(row, 2 * c + (p >> 1)) + 8 * (p & 1));
}
#define TR_GROUP(o0, o1, o2, o3, a) "ds_read_b64_tr_b16 %" #o0 ", %" #a "\n\tds_read_b64_tr_b16 %" #o1 ", %" #a " offset:2048\n\tds_read_b64_tr_b16 %" #o2 ", %" #a " offset:4096\n\tds_read_b64_tr_b16 %" #o3 ", %" #a " offset:6144\n\t"
__device__ __forceinline__ void tr_read_4c(const unsigned char* img, int g, int lr, uint2 (&r)[4][4]) {
    const unsigned a0 = tr_lane_addr(img, 0, g, lr), a1 = tr_lane_addr(img, 1, g, lr), a2 = tr_lane_addr(img, 2, g, lr), a3 = tr_lane_addr(img, 3, g, lr);
    asm volatile(TR_GROUP(0, 1, 2, 3, 16) TR_GROUP(4, 5, 6, 7, 17) TR_GROUP(8, 9, 10, 11, 18) TR_GROUP(12, 13, 14, 15, 19) "s_waitcnt lgkmcnt(0)"
        : "=&v"(r[0][0]), "=&v"(r[0][1]), "=&v"(r[0][2]), "=&v"(r[0][3]), "=&v"(r[1][0]), "=&v"(r[1][1]), "=&v"(r[1][2]), "=&v"(r[1][3]),
          "=&v"(r[2][0]), "=&v"(r[2][1]), "=&v"(r[2][2]), "=&v"(r[2][3]), "=&v"(r[3][0]), "=&v"(r[3][1]), "=&v"(r[3][2]), "=&v"(r[3][3])
        : "v"(a0), "v"(a1), "v"(a2), "v"(a3) : "memory");
}
__device__ __forceinline__ void tr_read_3c(const unsigned char* img, int g, int lr, uint2 (&r)[3][4]) {
    const unsigned a0 = tr_lane_addr(img, 0, g, lr), a1 = tr_lane_addr(img, 1, g, lr), a2 = tr_lane_addr(img, 2, g, lr);
    asm volatile(TR_GROUP(0, 1, 2, 3, 12) TR_GROUP(4, 5, 6, 7, 13) TR_GROUP(8, 9, 10, 11, 14) "s_waitcnt lgkmcnt(0)"
        : "=&v"(r[0][0]), "=&v"(r[0][1]), "=&v"(r[0][2]), "=&v"(r[0][3]), "=&v"(r[1][0]), "=&v"(r[1][1]), "=&v"(r[1][2]), "=&v"(r[1][3]),
          "=&v"(r[2][0]), "=&v"(r[2][1]), "=&v"(r[2][2]), "=&v"(r[2][3])
        : "v"(a0), "v"(a1), "v"(a2) : "memory");
}
__device__ __forceinline__ void tr_read_2(const unsigned char* img0, int c0, const unsigned char* img1, int c1, int g, int lr, uint2 (&r)[2][4]) {
    const unsigned a0 = tr_lane_addr(img0, c0, g, lr), a1 = tr_lane_addr(img1, c1, g, lr);
    asm volatile(TR_GROUP(0, 1, 2, 3, 8) TR_GROUP(4, 5, 6, 7, 9) "s_waitcnt lgkmcnt(0)"
        : "=&v"(r[0][0]), "=&v"(r[0][1]), "=&v"(r[0][2]), "=&v"(r[0][3]), "=&v"(r[1][0]), "=&v"(r[1][1]), "=&v"(r[1][2]), "=&v"(r[1][3])
        : "v"(a0), "v"(a1) : "memory");
}
__device__ __forceinline__ bf16x8 tr_pair(const uint2& lo, const uint2& hi) { uint4 u; u.x = lo.x; u.y = lo.y; u.z = hi.x; u.w = hi.y; return __builtin_bit_cast(bf16x8, u); }

__device__ __forceinline__ void attn_block(const Params& P, int bh, int qb, unsigned char* smem) {
    const int tid = threadIdx.x, lane = tid & 63, w = tid >> 6, g = lane >> 4, lr = lane & 15;
    const int b = bh >> 3, h = bh & 7;
    const bf16_t* z = (const bf16_t*)(P.ws + WS_Z);
    const float* cum = (const float*)(P.ws + WS_CUM) + (size_t)bh * L;
    const int tq = qb * 64 + 16 * w + lr;
    const bool qvalid = tq < L;
    bf16x8 qf[2];
    {
        const bf16_t* qp = z + (size_t)(b * L + (qvalid ? tq : 0)) * NZ + ZC_FQ + h * 64 + 8 * g;
        qf[0] = *(const bf16x8*)(qp); qf[1] = *(const bf16x8*)(qp + 32);
    }
    const float cq = cum[qvalid ? tq : 0];
    const int srow0 = tid >> 3, sch = tid & 7;
    uint4 rk[2], rv[2]; float rc = 0.f;
    auto load_tile = [&](int kv) {
#pragma unroll
        for (int j = 0; j < 2; ++j) {
            const int key = kv * 64 + srow0 + 32 * j;
            if (key < L) {
                const bf16_t* p = z + (size_t)(b * L + key) * NZ + h * 64 + sch * 8;
                rk[j] = *(const uint4*)(p + ZC_FK); rv[j] = *(const uint4*)(p + ZC_FV);
            } else { rk[j] = make_uint4(0, 0, 0, 0); rv[j] = make_uint4(0, 0, 0, 0); }
        }
        if (tid < 64) { const int key = kv * 64 + tid; rc = key < L ? cum[key] : 0.f; }
    };
    auto store_tile = [&](int buf) {
        unsigned char* sK = smem + buf * 16384; unsigned char* sV = sK + 8192;
#pragma unroll
        for (int j = 0; j < 2; ++j) {
            const int row = srow0 + 32 * j;
            *(uint4*)(sK + row * 128 + ((sch ^ (row & 7)) << 4)) = rk[j];
            *(uint4*)(sV + vimg_off(row, sch)) = rv[j];
        }
        if (tid < 64) ((float*)(smem + 32768 + buf * 256))[tid] = rc;
    };
    float m = -INFINITY, lsum = 0.f;
    f32x4 o[4];
#pragma unroll
    for (int c = 0; c < 4; ++c) o[c] = (f32x4){0.f, 0.f, 0.f, 0.f};
    load_tile(0); store_tile(0);
    __syncthreads();
    for (int kv = 0; kv <= qb; ++kv) {
        const int buf = kv & 1;
        if (kv < qb) load_tile(kv + 1);
        const unsigned char* sK = smem + buf * 16384; const unsigned char* sV = sK + 8192;
        const float* sck = (const float*)(smem + 32768 + buf * 256);
        f32x4 sa[4];
#pragma unroll
        for (int c = 0; c < 4; ++c) {
            sa[c] = (f32x4){0.f, 0.f, 0.f, 0.f};
#pragma unroll
            for (int s = 0; s < 2; ++s) {
                const bf16x8 kf = *(const bf16x8*)(sK + (16 * c + lr) * 128 + (((4 * s + g) ^ (lr & 7)) << 4));
                sa[c] = __builtin_amdgcn_mfma_f32_16x16x32_bf16(kf, qf[s], sa[c], 0, 0, 0);
            }
        }
        const bool diag = (kv == qb);
        float mx = -INFINITY;
#pragma unroll
        for (int c = 0; c < 4; ++c) {
            const f32x4 ck = *(const f32x4*)(sck + 16 * c + 4 * g);
#pragma unroll
            for (int r = 0; r < 4; ++r) {
                float v = sa[c][r] + (cq - ck[r]);
                if (diag && (16 * c + 4 * g + r > 16 * w + lr)) v = -INFINITY;
                sa[c][r] = v; mx = fmaxf(mx, v);
            }
        }
        mx = fmaxf(mx, __shfl_xor(mx, 16, 64)); mx = fmaxf(mx, __shfl_xor(mx, 32, 64));
        const float mn = fmaxf(m, mx);
        const float alpha = __builtin_amdgcn_exp2f(m - mn);
        m = mn;
        float ps = 0.f;
#pragma unroll
        for (int c = 0; c < 4; ++c)
#pragma unroll
            for (int r = 0; r < 4; ++r) { const float p = __builtin_amdgcn_exp2f(sa[c][r] - mn); sa[c][r] = p; ps += p; }
        lsum = lsum * alpha + ps;
#pragma unroll
        for (int c = 0; c < 4; ++c) o[c] *= alpha;
        bf16x8 pf[2];
#pragma unroll
        for (int s2 = 0; s2 < 2; ++s2) {
            uint4 u;
            u.x = cvt_pk_bf16(sa[2 * s2][0], sa[2 * s2][1]); u.y = cvt_pk_bf16(sa[2 * s2][2], sa[2 * s2][3]);
            u.z = cvt_pk_bf16(sa[2 * s2 + 1][0], sa[2 * s2 + 1][1]); u.w = cvt_pk_bf16(sa[2 * s2 + 1][2], sa[2 * s2 + 1][3]);
            pf[s2] = __builtin_bit_cast(bf16x8, u);
        }
        {
            uint2 vr[4][4];
            tr_read_4c(sV, g, lr, vr);
#pragma unroll
            for (int c = 0; c < 4; ++c)
#pragma unroll
                for (int s2 = 0; s2 < 2; ++s2) o[c] = __builtin_amdgcn_mfma_f32_16x16x32_bf16(tr_pair(vr[c][2 * s2], vr[c][2 * s2 + 1]), pf[s2], o[c], 0, 0, 0);
        }
        if (kv < qb) store_tile(buf ^ 1);
        __syncthreads();
    }
    lsum += __shfl_xor(lsum, 16, 64); lsum += __shfl_xor(lsum, 32, 64);
    const float inv = 1.0f / lsum;
    if (qvalid) {
        bf16_t* y = (bf16_t*)(P.ws + WS_Z) + (size_t)(b * L + tq) * NZ + 512 + h * 64 + 4 * g;
#pragma unroll
        for (int c = 0; c < 4; ++c) {
            uint2 u; u.x = pk2(o[c][0] * inv, o[c][1] * inv); u.y = pk2(o[c][2] * inv, o[c][3] * inv);
            *(uint2*)(y + 16 * c) = u;
        }
    }
}

__device__ __forceinline__ void conv_item(const Params& P, int ci) {
    const int tid = threadIdx.x, cc = tid & 127, rg = tid >> 7;
    const bf16_t* z = (const bf16_t*)(P.ws + WS_Z);
    bf16_t* qk = (bf16_t*)(P.ws + WS_RA);
    const int col0 = cc * 8;
    float w[4][8];
#pragma unroll
    for (int j = 0; j < 4; ++j) {
        const float4 a = *(const float4*)(P.conv_qk + j * 1024 + col0), b = *(const float4*)(P.conv_qk + j * 1024 + col0 + 4);
        w[j][0] = a.x; w[j][1] = a.y; w[j][2] = a.z; w[j][3] = a.w; w[j][4] = b.x; w[j][5] = b.y; w[j][6] = b.z; w[j][7] = b.w;
    }
    const float oscale = (col0 >= 512) ? 0.08838834764831845f : 1.0f;
    const int r0 = ci * 64 + rg * 32;
    int t = r0 % L;
    float xw[3][8];
#pragma unroll
    for (int j = 0; j < 3; ++j) {
        const int back = 3 - j;
        if (t - back >= 0) {
            const uint4 v = *(const uint4*)(z + (size_t)(r0 - back) * NZ + col0);
            xw[j][0] = bflo(v.x); xw[j][1] = bfhi(v.x); xw[j][2] = bflo(v.y); xw[j][3] = bfhi(v.y); xw[j][4] = bflo(v.z); xw[j][5] = bfhi(v.z); xw[j][6] = bflo(v.w); xw[j][7] = bfhi(v.w);
        } else {
#pragma unroll
            for (int e = 0; e < 8; ++e) xw[j][e] = 0.f;
        }
    }
#pragma unroll 2
    for (int i = 0; i < 32; ++i) {
        const int r = r0 + i;
        if (t == 0) {
#pragma unroll
            for (int j = 0; j < 3; ++j)
#pragma unroll
                for (int e = 0; e < 8; ++e) xw[j][e] = 0.f;
        }
        const uint4 v = *(const uint4*)(z + (size_t)r * NZ + col0);
        float xt[8];
        xt[0] = bflo(v.x); xt[1] = bfhi(v.x); xt[2] = bflo(v.y); xt[3] = bfhi(v.y); xt[4] = bflo(v.z); xt[5] = bfhi(v.z); xt[6] = bflo(v.w); xt[7] = bfhi(v.w);
        float o[8];
#pragma unroll
        for (int e = 0; e < 8; ++e) {
            const float cv = w[0][e] * xw[0][e] + w[1][e] * xw[1][e] + w[2][e] * xw[2][e] + w[3][e] * xt[e];
            o[e] = oscale * cv / (1.f + __expf(-cv));
            xw[0][e] = xw[1][e]; xw[1][e] = xw[2][e]; xw[2][e] = xt[e];
        }
        uint4 ov; ov.x = pk2(o[0], o[1]); ov.y = pk2(o[2], o[3]); ov.z = pk2(o[4], o[5]); ov.w = pk2(o[6], o[7]);
        *(uint4*)(qk + (size_t)r * 1024 + col0) = ov;
        t = (t + 1 == L) ? 0 : t + 1;
    }
}

__device__ __forceinline__ int st_piece_off(int jt, int c, int g, int lr) { return (jt >> 2) * 6144 + vimg_off(16 * c + lr, 2 * (jt & 3) + (g >> 1)) + 8 * (g & 1); }

__device__ __forceinline__ void mlstm_stage_kv(const Params& P, int b, int h, int dq, int k, unsigned char* smem, int tid) {
    const bf16_t* z = (const bf16_t*)(P.ws + WS_Z);
    const bf16_t* qk = (const bf16_t*)(P.ws + WS_RA);
    uint4 pk_[4]; uint4 pv_;
#pragma unroll
    for (int j = 0; j < 4; ++j) {
        const int id = tid + 256 * j, row = id >> 4, ch16 = id & 15, pos = 64 * k + row;
        pk_[j] = (pos < L) ? *(const uint4*)(qk + (size_t)(b * L + pos) * 1024 + 512 + h * 128 + ch16 * 8) : make_uint4(0, 0, 0, 0);
    }
    {
        const int row = tid >> 2, ch = tid & 3, pos = 64 * k + row;
        pv_ = (pos < L) ? *(const uint4*)(z + (size_t)(b * L + pos) * NZ + ZC_MV + h * 128 + dq * 32 + ch * 8) : make_uint4(0, 0, 0, 0);
    }
#pragma unroll
    for (int j = 0; j < 4; ++j) {
        const int id = tid + 256 * j, row = id >> 4, ch16 = id & 15;
        *(uint4*)(smem + (ch16 >> 3) * 8192 + vimg_off(row, ch16 & 7)) = pk_[j];
    }
    { const int row = tid >> 2, ch = tid & 3; *(uint4*)(smem + 16384 + vimg_off(row, ch)) = pv_; }
    if (tid < 128) {
        const int row = tid >> 1, ch = 4 + (tid & 1);
        *(uint4*)(smem + 16384 + vimg_off(row, ch)) = (tid & 1) ? make_uint4(0, 0, 0, 0) : make_uint4(0x3F80u, 0, 0, 0);
    }
}

__device__ __forceinline__ void mlstm_A(const Params& P, int item, unsigned char* smem) {
    const int tid = threadIdx.x, lane = tid & 63, w = tid >> 6, g = lane >> 4, lr = lane & 15;
    const int wu = __builtin_amdgcn_readfirstlane(w);
    const int k = item >> 7, bhd = item & 127, b = bhd >> 4, h = (bhd >> 2) & 3, dq = bhd & 3;
    const float* gates = (const float*)(P.ws + WS_GATES);
    float* ga = (float*)(smem + 36864);
    mlstm_stage_kv(P, b, h, dq, k, smem, tid);
    if (wu == 0) {
        const int pos = 64 * k + lane;
        float lf = 0.f, li = -INFINITY;
        if (pos < L) { lf = gates[(size_t)(b * L + pos) * 16 + 4 + h]; li = gates[(size_t)(b * L + pos) * 16 + h]; }
        float bc = lf;
#pragma unroll
        for (int o = 1; o < 64; o <<= 1) { const float n = __shfl_up(bc, o, 64); if (lane >= o) bc += n; }
        const float a = li - bc;
        const float A = wave_max(a);
        ga[lane] = __expf(a - A);
        if (lane == 63) { float* msc = (float*)(P.ws + WS_MSC) + ((size_t)bhd * 33 + k) * 4; msc[0] = A; msc[1] = bc; }
    }
    __syncthreads();
    const unsigned char* sK = smem; const unsigned char* sV = smem + 16384;
    f32x4 Ct[2][3];
#pragma unroll
    for (int a = 0; a < 2; ++a)
#pragma unroll
        for (int c = 0; c < 3; ++c) Ct[a][c] = (f32x4){0.f, 0.f, 0.f, 0.f};
    uint2 vr[3][4];
    tr_read_3c(sV, g, lr, vr);
#pragma unroll
    for (int s2 = 0; s2 < 2; ++s2) {
        const f32x4 w0 = *(const f32x4*)(ga + 32 * s2 + 4 * g), w1 = *(const f32x4*)(ga + 32 * s2 + 16 + 4 * g);
        bf16x8 vw[3];
#pragma unroll
        for (int c = 0; c < 3; ++c) {
            const uint2 lo = vr[c][2 * s2], hi = vr[c][2 * s2 + 1];
            uint4 o;
            o.x = cvt_pk_bf16(bflo(lo.x) * w0[0], bfhi(lo.x) * w0[1]); o.y = cvt_pk_bf16(bflo(lo.y) * w0[2], bfhi(lo.y) * w0[3]);
            o.z = cvt_pk_bf16(bflo(hi.x) * w1[0], bfhi(hi.x) * w1[1]); o.w = cvt_pk_bf16(bflo(hi.y) * w1[2], bfhi(hi.y) * w1[3]);
            vw[c] = __builtin_bit_cast(bf16x8, o);
        }
#pragma unroll
        for (int a = 0; a < 2; ++a) {
            const int jt = 2 * w + a;
            const uint2 lo = tr_frag(sK + (jt >> 2) * 8192, 32 * s2, jt & 3, g, lr), hi = tr_frag(sK + (jt >> 2) * 8192, 32 * s2 + 16, jt & 3, g, lr);
            const bf16x8 kt = tr_pair(lo, hi);
#pragma unroll
            for (int c = 0; c < 3; ++c) Ct[a][c] = __builtin_amdgcn_mfma_f32_16x16x32_bf16(kt, vw[c], Ct[a][c], 0, 0, 0);
        }
    }
    unsigned char* slot = P.ws + WS_MST + ((size_t)bhd * 33 + k) * 12288;
#pragma unroll
    for (int a = 0; a < 2; ++a)
#pragma unroll
        for (int c = 0; c < 3; ++c) {
            uint2 u; u.x = cvt_pk_bf16(Ct[a][c][0], Ct[a][c][1]); u.y = cvt_pk_bf16(Ct[a][c][2], Ct[a][c][3]);
            *(uint2*)(slot + st_piece_off(2 * w + a, c, g, lr)) = u;
        }
}

__device__ __forceinline__ void mlstm_B(const Params& P, int bhd) {
    const int tid = threadIdx.x, lane = tid & 63, w = tid >> 6, g = lane >> 4, lr = lane & 15;
    const unsigned char* base = P.ws + WS_MST + (size_t)bhd * 33 * 12288;
    unsigned char* obase = P.ws + WS_CBI + (size_t)bhd * 33 * 12288;
    float* msc = (float*)(P.ws + WS_MSC) + (size_t)bhd * 33 * 4;
    int off[6];
#pragma unroll
    for (int a = 0; a < 2; ++a)
#pragma unroll
        for (int c = 0; c < 3; ++c) off[a * 3 + c] = st_piece_off(2 * w + a, c, g, lr);
    float C[6][4];
#pragma unroll
    for (int i = 0; i < 6; ++i)
#pragma unroll
        for (int r = 0; r < 4; ++r) C[i][r] = 0.f;
    float m = 0.f;
    uint2 d0[6], d1[6];
    float2 ab0, ab1;
#pragma unroll
    for (int i = 0; i < 6; ++i) { d0[i] = *(const uint2*)(base + off[i]); d1[i] = *(const uint2*)(base + 12288 + off[i]); }
    ab0 = *(const float2*)(msc); ab1 = *(const float2*)(msc + 4);
    for (int k = 0; k < 33; ++k) {
        uint2 d2[6]; float2 ab2 = make_float2(0.f, 0.f);
        if (k + 2 < 33) {
#pragma unroll
            for (int i = 0; i < 6; ++i) d2[i] = *(const uint2*)(base + (size_t)(k + 2) * 12288 + off[i]);
            ab2 = *(const float2*)(msc + (k + 2) * 4);
        } else {
#pragma unroll
            for (int i = 0; i < 6; ++i) d2[i] = make_uint2(0, 0);
        }
#pragma unroll
        for (int i = 0; i < 6; ++i) {
            uint2 u; u.x = cvt_pk_bf16(C[i][0], C[i][1]); u.y = cvt_pk_bf16(C[i][2], C[i][3]);
            *(uint2*)(obase + (size_t)k * 12288 + off[i]) = u;
        }
        if (tid == 0) msc[k * 4 + 2] = m;
        const float M = fmaxf(m, ab0.x);
        const float decay = __expf(m - M), sc = __expf(ab0.x - M);
#pragma unroll
        for (int i = 0; i < 6; ++i) {
            C[i][0] = decay * C[i][0] + sc * bflo(d0[i].x); C[i][1] = decay * C[i][1] + sc * bfhi(d0[i].x);
            C[i][2] = decay * C[i][2] + sc * bflo(d0[i].y); C[i][3] = decay * C[i][3] + sc * bfhi(d0[i].y);
        }
        m = ab0.y + M;
#pragma unroll
        for (int i = 0; i < 6; ++i) { d0[i] = d1[i]; d1[i] = d2[i]; }
        ab0 = ab1; ab1 = ab2;
    }
}

__device__ __forceinline__ void mlstm_C(const Params& P, int item, unsigned char* smem) {
    const int tid = threadIdx.x, lane = tid & 63, w = tid >> 6, g = lane >> 4, lr = lane & 15;
    const int wu = __builtin_amdgcn_readfirstlane(w);
    const int k = item >> 7, bhd = item & 127, b = bhd >> 4, h = (bhd >> 2) & 3, dq = bhd & 3;
    const bf16_t* z = (const bf16_t*)(P.ws + WS_Z);
    const bf16_t* qk = (const bf16_t*)(P.ws + WS_RA);
    const float* gates = (const float*)(P.ws + WS_GATES);
    bf16_t* y = (bf16_t*)(P.ws + WS_Z);
    float* ssqm = (float*)(P.ws + WS_SSQM);
    const unsigned char* sK = smem; const unsigned char* sV = smem + 16384; unsigned char* sCb = smem + 24576;
    float* ga = (float*)(smem + 36864);
    const int pos = 64 * k + 16 * w + lr;
    const bool tvalid = pos < L;
    const size_t rrow = (size_t)(b * L + (tvalid ? pos : 0));
    bf16x8 qf[4];
    {
        const bf16_t* qp = qk + rrow * 1024 + h * 128 + 8 * g;
#pragma unroll
        for (int ks = 0; ks < 4; ++ks) { qf[ks] = *(const bf16x8*)(qp + 32 * ks); if (!tvalid) qf[ks] = (bf16x8){0, 0, 0, 0, 0, 0, 0, 0}; }
    }
    uint2 og2[2];
#pragma unroll
    for (int c = 0; c < 2; ++c) og2[c] = *(const uint2*)(z + rrow * NZ + ZC_MO + h * 128 + dq * 32 + 16 * c + 4 * g);
    {
        const unsigned char* slot = P.ws + WS_CBI + ((size_t)bhd * 33 + k) * 12288;
        uint4 cb[3];
#pragma unroll
        for (int j = 0; j < 3; ++j) cb[j] = *(const uint4*)(slot + (tid + 256 * j) * 16);
        mlstm_stage_kv(P, b, h, dq, k, smem, tid);
#pragma unroll
        for (int j = 0; j < 3; ++j) *(uint4*)(sCb + (tid + 256 * j) * 16) = cb[j];
    }
    if (wu == 0) {
        const float m_prev = ((const float*)(P.ws + WS_MSC))[((size_t)bhd * 33 + k) * 4 + 2];
        const int p2 = 64 * k + lane;
        float lf = 0.f, li = -INFINITY;
        if (p2 < L) { lf = gates[(size_t)(b * L + p2) * 16 + 4 + h]; li = gates[(size_t)(b * L + p2) * 16 + h]; }
        float bc = lf;
#pragma unroll
        for (int o = 1; o < 64; o <<= 1) { const float n = __shfl_up(bc, o, 64); if (lane >= o) bc += n; }
        const float a = li - bc;
        float am = a;
#pragma unroll
        for (int o = 1; o < 64; o <<= 1) { const float n = __shfl_up(am, o, 64); if (lane >= o) am = fmaxf(am, n); }
        const float M = fmaxf(m_prev, am);
        ga[lane] = a; ga[64 + lane] = __expf(m_prev - M); ga[128 + lane] = __expf(-(bc + M)); ga[192 + lane] = M;
    }
    __syncthreads();
    const float Mt = ga[192 + 16 * w + lr], Wi = ga[64 + 16 * w + lr];
    bf16x8 pf[2];
    {
        f32x4 sa[4];
#pragma unroll
        for (int c = 0; c < 4; ++c) {
            sa[c] = (f32x4){0.f, 0.f, 0.f, 0.f};
            if (c <= wu) {
#pragma unroll
                for (int ks = 0; ks < 4; ++ks) {
                    const bf16x8 kf = *(const bf16x8*)(sK + (ks >> 1) * 8192 + vimg_off(16 * c + lr, 4 * (ks & 1) + g));
                    sa[c] = __builtin_amdgcn_mfma_f32_16x16x32_bf16(kf, qf[ks], sa[c], 0, 0, 0);
                }
                const f32x4 av = *(const f32x4*)(ga + 16 * c + 4 * g);
#pragma unroll
                for (int r = 0; r < 4; ++r) {
                    const float d = __expf(av[r] - Mt);
                    sa[c][r] = (16 * c + 4 * g + r <= 16 * w + lr) ? sa[c][r] * d : 0.f;
                }
            }
        }
#pragma unroll
        for (int s2 = 0; s2 < 2; ++s2) {
            uint4 u;
            u.x = cvt_pk_bf16(sa[2 * s2][0], sa[2 * s2][1]); u.y = cvt_pk_bf16(sa[2 * s2][2], sa[2 * s2][3]);
            u.z = cvt_pk_bf16(sa[2 * s2 + 1][0], sa[2 * s2 + 1][1]); u.w = cvt_pk_bf16(sa[2 * s2 + 1][2], sa[2 * s2 + 1][3]);
            pf[s2] = __builtin_bit_cast(bf16x8, u);
        }
    }
    f32x4 na[3];
#pragma unroll
    for (int c = 0; c < 3; ++c) {
        na[c] = (f32x4){0.f, 0.f, 0.f, 0.f};
#pragma unroll
        for (int ks = 0; ks < 4; ++ks) {
            const bf16x8 cf = *(const bf16x8*)(sCb + (ks >> 1) * 6144 + vimg_off(16 * c + lr, 4 * (ks & 1) + g));
            na[c] = __builtin_amdgcn_mfma_f32_16x16x32_bf16(cf, qf[ks], na[c], 0, 0, 0);
        }
        na[c] *= Wi;
    }
    {
        uint2 vr[3][4];
        tr_read_3c(sV, g, lr, vr);
#pragma unroll
        for (int c = 0; c < 3; ++c) {
            na[c] = __builtin_amdgcn_mfma_f32_16x16x32_bf16(tr_pair(vr[c][0], vr[c][1]), pf[0], na[c], 0, 0, 0);
            na[c] = __builtin_amdgcn_mfma_f32_16x16x32_bf16(tr_pair(vr[c][2], vr[c][3]), pf[1], na[c], 0, 0, 0);
        }
    }
    const float Et = ga[128 + 16 * w + lr];
    const float den = __shfl(na[2][0], lr, 64);
    const float rden = 1.0f / fmaxf(fabsf(den), Et);
    const float* gainp = P.m_out_norm + h * 128 + dq * 32 + 4 * g;
    float hs = 0.f;
#pragma unroll
    for (int c = 0; c < 2; ++c) {
        const uint2 og = og2[c];
        const float o0 = bflo(og.x), o1 = bfhi(og.x), o2 = bflo(og.y), o3 = bfhi(og.y);
        const float h0 = na[c][0] * rden, h1 = na[c][1] * rden, h2 = na[c][2] * rden, h3 = na[c][3] * rden;
        hs += h0 * h0 + h1 * h1 + h2 * h2 + h3 * h3;
        const float4 gn = *(const float4*)(gainp + 16 * c);
        uint2 u;
        u.x = pk2(h0 * gn.x / (1.f + __expf(-o0)), h1 * gn.y / (1.f + __expf(-o1)));
        u.y = pk2(h2 * gn.z / (1.f + __expf(-o2)), h3 * gn.w / (1.f + __expf(-o3)));
        if (tvalid) *(uint2*)(y + rrow * NZ + h * 128 + dq * 32 + 16 * c + 4 * g) = u;
    }
    hs += __shfl_xor(hs, 16, 64); hs += __shfl_xor(hs, 32, 64);
    if (tvalid && g == 0) ssqm[rrow * 16 + h * 4 + dq] = hs;
}

__device__ __forceinline__ void peer_token(const Params& P, int t, int lane, int* sidx, float* sval, int* sid, float* sgate) {
    const unsigned* tk = (const unsigned*)(P.ws + WS_TK) + (size_t)t * 256;
#pragma unroll
    for (int i = 0; i < 4; ++i) {
        const unsigned k = tk[lane * 4 + i];
        sidx[lane * 4 + i] = 127 - (int)(k & 127u);
        sval[lane * 4 + i] = unord_key(k & ~127u);
    }
    __builtin_amdgcn_s_waitcnt(0xc07f);
    __builtin_amdgcn_wave_barrier();
    if (lane < 8) {
        const int hd = lane;
        float v0[16], v1[16];
#pragma unroll
        for (int i = 0; i < 16; ++i) { v0[i] = sval[(2 * hd) * 16 + i]; v1[i] = sval[(2 * hd + 1) * 16 + i]; }
        unsigned top[16];
#pragma unroll
        for (int i = 0; i < 16; ++i) top[i] = 0u;
#pragma unroll
        for (int i = 0; i < 16; ++i)
#pragma unroll
            for (int j = 0; j < 16; ++j)
                if ((i + 1) * (j + 1) <= 16) {
                    unsigned kx = (ord_key(v0[i] + v1[j]) & ~255u) | (unsigned)(255 - (i * 16 + j));
#pragma unroll
                    for (int q = 0; q < 16; ++q) { const unsigned hi = max(top[q], kx), lo = min(top[q], kx); top[q] = hi; kx = lo; }
                }
        const float smax = unord_key(top[0] & ~255u);
        float e[16]; float den = 0.f;
#pragma unroll
        for (int q = 0; q < 16; ++q) { e[q] = __expf(unord_key(top[q] & ~255u) - smax); den += e[q]; }
        const float inv = 1.f / den;
#pragma unroll
        for (int q = 0; q < 16; ++q) {
            const int pos = 255 - (int)(top[q] & 255u), i = pos >> 4, j = pos & 15;
            sid[hd * 16 + q] = sidx[(2 * hd) * 16 + i] * 128 + sidx[(2 * hd + 1) * 16 + j];
            sgate[hd * 16 + q] = e[q] * inv;
        }
    }
    __builtin_amdgcn_s_waitcnt(0xc07f);
    __builtin_amdgcn_wave_barrier();
    const bf16_t* xn = (const bf16_t*)(P.ws + WS_XN) + (size_t)t * DM;
    const float rstd = ((const float*)(P.ws + WS_RSTD))[t];
    const unsigned char* U = P.ws + WS_U + lane * 16;
    const unsigned char* V = P.ws + WS_V + lane * 16;
    const float* usc = (const float*)(P.ws + WS_USC);
    const float* vsc = (const float*)(P.ws + WS_VSC);
    float xf[16];
    {
        const uint4 xa = *(const uint4*)(xn + lane * 16), xb = *(const uint4*)(xn + lane * 16 + 8);
        xf[0] = bflo(xa.x); xf[1] = bfhi(xa.x); xf[2] = bflo(xa.y); xf[3] = bfhi(xa.y); xf[4] = bflo(xa.z); xf[5] = bfhi(xa.z); xf[6] = bflo(xa.w); xf[7] = bfhi(xa.w);
        xf[8] = bflo(xb.x); xf[9] = bfhi(xb.x); xf[10] = bflo(xb.y); xf[11] = bfhi(xb.y); xf[12] = bflo(xb.z); xf[13] = bfhi(xb.z); xf[14] = bflo(xb.w); xf[15] = bfhi(xb.w);
    }
    float acc[16];
#pragma unroll
    for (int j = 0; j < 16; ++j) acc[j] = 0.f;
    const int myq = ((lane >> 5) & 1) * 4 + ((lane >> 4) & 1) * 2 + ((lane >> 3) & 1);
#pragma unroll 1
    for (int e0 = 0; e0 < 128; e0 += 8) {
        uint4 ur[8], vr[8];
#pragma unroll
        for (int q = 0; q < 8; ++q) {
            const int id = sid[e0 + q];
            ur[q] = *(const uint4*)(U + (size_t)id * DM);
            vr[q] = *(const uint4*)(V + (size_t)id * DM);
        }
        const int myid = sid[e0 + myq];
        const float mysc = usc[myid] * rstd, myvs = vsc[myid] * sgate[e0 + myq];
        float d[8];
#pragma unroll
        for (int q = 0; q < 8; ++q) {
            const unsigned wds[4] = {ur[q].x, ur[q].y, ur[q].z, ur[q].w};
            float s = 0.f;
#pragma unroll
            for (int k = 0; k < 4; ++k) {
                const f32x2 lo = __builtin_amdgcn_cvt_pk_f32_fp8((int)wds[k], false), hi = __builtin_amdgcn_cvt_pk_f32_fp8((int)wds[k], true);
                s += xf[4 * k] * lo.x + xf[4 * k + 1] * lo.y + xf[4 * k + 2] * hi.x + xf[4 * k + 3] * hi.y;
            }
            d[q] = s;
        }
        float r4[4], r2[2], r1;
#pragma unroll
        for (int i = 0; i < 4; ++i) { const bool up = (lane & 32) != 0; const float keep = up ? d[i + 4] : d[i], send = up ? d[i] : d[i + 4]; r4[i] = keep + __shfl_xor(send, 32, 64); }
#pragma unroll
        for (int i = 0; i < 2; ++i) { const bool up = (lane & 16) != 0; const float keep = up ? r4[i + 2] : r4[i], send = up ? r4[i] : r4[i + 2]; r2[i] = keep + __shfl_xor(send, 16, 64); }
        { const bool up = (lane & 8) != 0; const float keep = up ? r2[1] : r2[0], send = up ? r2[0] : r2[1]; r1 = keep + __shfl_xor(send, 8, 64); }
        r1 += __shfl_xor(r1, 4, 64); r1 += __shfl_xor(r1, 2, 64); r1 += __shfl_xor(r1, 1, 64);
        const float a = r1 * mysc;
        const float wmine = myvs * 0.5f * a * (1.f + erff(a * 0.70710678118654752f));
#pragma unroll
        for (int q = 0; q < 8; ++q) {
            const float w = __shfl(wmine, ((q >> 2) & 1) * 32 + ((q >> 1) & 1) * 16 + (q & 1) * 8, 64);
            const unsigned wds[4] = {vr[q].x, vr[q].y, vr[q].z, vr[q].w};
#pragma unroll
            for (int k = 0; k < 4; ++k) {
                const f32x2 lo = __builtin_amdgcn_cvt_pk_f32_fp8((int)wds[k], false), hi = __builtin_amdgcn_cvt_pk_f32_fp8((int)wds[k], true);
                acc[4 * k] += w * lo.x; acc[4 * k + 1] += w * lo.y; acc[4 * k + 2] += w * hi.x; acc[4 * k + 3] += w * hi.y;
            }
        }
    }
    float* o = P.out + (size_t)t * DM + lane * 16;
    float4 h0 = *(float4*)(o), h1 = *(float4*)(o + 4), h2 = *(float4*)(o + 8), h3 = *(float4*)(o + 12);
    h0.x += acc[0]; h0.y += acc[1]; h0.z += acc[2]; h0.w += acc[3]; h1.x += acc[4]; h1.y += acc[5]; h1.z += acc[6]; h1.w += acc[7];
    h2.x += acc[8]; h2.y += acc[9]; h2.z += acc[10]; h2.w += acc[11]; h3.x += acc[12]; h3.y += acc[13]; h3.z += acc[14]; h3.w += acc[15];
    *(float4*)(o) = h0; *(float4*)(o + 4) = h1; *(float4*)(o + 8) = h2; *(float4*)(o + 12) = h3;
    __builtin_amdgcn_s_waitcnt(0xc07f);
    __builtin_amdgcn_wave_barrier();
}

#define LAS __attribute__((address_space(3)))
#define XB_TMO      128
#define XB_XCNT(j)  (256  + 64 * (j))
#define XB_XSUB(j)  (1280 + 64 * (j))
#define XB_XGEN(j)  (2304 + 64 * (j))
#define XB_TOP      3328
#define XB_TOPGEN   3392
#define XCD_BAR_WORDS 3456
#define XB_SPIN_CAP (1u << 18)
__device__ __forceinline__ unsigned xb_ld(unsigned* p)              { return __hip_atomic_load(p, __ATOMIC_RELAXED, __HIP_MEMORY_SCOPE_AGENT); }
__device__ __forceinline__ unsigned xb_add(unsigned* p, unsigned v) { return __hip_atomic_fetch_add(p, v, __ATOMIC_RELAXED, __HIP_MEMORY_SCOPE_AGENT); }
__device__ __forceinline__ unsigned xb_xcc_id() { return (unsigned)__builtin_amdgcn_s_getreg((3 << 11) | 20) & 0xFu; }
#define XB_SPIN(cond, bar) do { unsigned _sp = 0; while (cond) { __builtin_amdgcn_s_sleep(1); \
    if ((++_sp & 255u) == 0u) { if (xb_ld(&(bar)[XB_TMO])) break; if (_sp > XB_SPIN_CAP) { atomicAdd(&(bar)[XB_TMO], 1u); break; } } } } while (0)
struct XcdBarrier { unsigned* bar; unsigned x; volatile LAS unsigned* st; };
__device__ __forceinline__ XcdBarrier xcd_barrier_post(unsigned* bar, volatile LAS unsigned* st) {
    XcdBarrier b; b.bar = bar; b.x = xb_xcc_id(); b.st = st;
    if (threadIdx.x == 0) (void)xb_add(&bar[XB_XCNT(b.x)], 1u);
    return b;
}
__device__ __forceinline__ void xcd_barrier_complete(unsigned* bar, unsigned x, unsigned& nloc, unsigned& nx) {
    const unsigned G = gridDim.x * gridDim.y * gridDim.z;
    unsigned sum, cnt, mine, sp = 0u;
    for (;;) {
        sum = 0u; cnt = 0u; mine = 0u;
#pragma unroll
        for (unsigned j = 0; j < 16; ++j) { const unsigned c = xb_ld(&bar[XB_XCNT(j)]); sum += c; cnt += (c > 0u) ? 1u : 0u; mine = (j == x) ? c : mine; }
        if (sum == G) break;
        __builtin_amdgcn_s_sleep(1);
        if ((++sp & 255u) == 0u) { if (xb_ld(&bar[XB_TMO])) break; if (sp > XB_SPIN_CAP) { atomicAdd(&bar[XB_TMO], 1u); break; } }
    }
    nloc = mine > 0u ? mine : 1u; nx = cnt > 0u ? cnt : 1u;
}
__device__ __forceinline__ void xcd_barrier(const XcdBarrier& b) {
    asm volatile("s_waitcnt vmcnt(0)" ::: "memory");
    __syncthreads();
    if (threadIdx.x == 0) {
        unsigned* bar = b.bar;
        __builtin_amdgcn_s_waitcnt(0);
        unsigned nloc = b.st[0], nx = b.st[1];
        if (nloc == 0u) { xcd_barrier_complete(bar, b.x, nloc, nx); b.st[0] = nloc; b.st[1] = nx; }
        const unsigned old = xb_add(&bar[XB_XSUB(b.x)], 1u);
        const unsigned gen = old / nloc;
        if (old + 1u == (gen + 1u) * nloc) {
            __builtin_amdgcn_fence(__ATOMIC_RELEASE, "agent");
            asm volatile("s_waitcnt vmcnt(0)" ::: "memory");
            const unsigned og = xb_add(&bar[XB_TOP], 1u);
            const unsigned tg = og / nx;
            if (og + 1u == (tg + 1u) * nx) xb_add(&bar[XB_TOPGEN], 1u);
            else XB_SPIN(xb_ld(&bar[XB_TOPGEN]) == tg, bar);
            __builtin_amdgcn_fence(__ATOMIC_ACQUIRE, "agent");
            xb_add(&bar[XB_XGEN(b.x)], 1u);
            asm volatile("s_waitcnt vmcnt(0)" ::: "memory");
        } else {
            XB_SPIN(xb_ld(&bar[XB_XGEN(b.x)]) == gen, bar);
            __builtin_amdgcn_fence(__ATOMIC_ACQUIRE, "agent");
            asm volatile("s_waitcnt vmcnt(0)" ::: "memory");
        }
    }
    __syncthreads();
}

__device__ __forceinline__ void hand_release() { asm volatile("s_waitcnt vmcnt(0)" ::: "memory"); __builtin_amdgcn_fence(__ATOMIC_RELEASE, "agent"); asm volatile("s_waitcnt vmcnt(0)" ::: "memory"); }
__device__ __forceinline__ void hand_acquire() { __builtin_amdgcn_fence(__ATOMIC_ACQUIRE, "agent"); asm volatile("s_waitcnt vmcnt(0)" ::: "memory"); }

__global__ void __launch_bounds__(256, 2) mega(Params P) {
    extern __shared__ __attribute__((aligned(16))) unsigned char smem[];
    cg::grid_group grid = cg::this_grid();
    const int tid = threadIdx.x, lane = tid & 63, wave = tid >> 6;
    const int G = gridDim.x, bid = blockIdx.x;
    unsigned* ctl = (unsigned*)(P.ws + WS_CTL);
    volatile LAS unsigned* bst = (volatile LAS unsigned*)(smem + 65552);
    if (tid == 0) { bst[0] = 0u; bst[1] = 0u; }
    __syncthreads();
    phase0(P, smem);
    grid.sync();
    const XcdBarrier xb = xcd_barrier_post(ctl + 1024, bst);
    {
        const int gw = bid * 4 + wave;
        if (gw < 64) fox_cum_wave(P, gw, lane);
        for (int tile = bid; tile < 129 * 28; tile += G) gemm_tile<1>(P, tile / 28, tile % 28, smem);
    }
    xcd_barrier(xb);
    {
        volatile int* s_item = (volatile int*)(smem + 65536);
        const int wave_u = __builtin_amdgcn_readfirstlane(wave);
        auto fetch = [&](unsigned* counter) -> int {
            if (wave_u == 0) {
                unsigned v = atomicAdd(counter, lane == 0 ? 1u : 0u);
                *s_item = (int)__builtin_amdgcn_readfirstlane(v);
            }
            __syncthreads();
            const int item = __builtin_amdgcn_readfirstlane(*s_item);
            __syncthreads();
            return item;
        };
        for (;;) {
            const int item = fetch(&ctl[0]);
            if (item >= 258) break;
            conv_item(P, item);
        }
        xcd_barrier(xb);
        for (;;) {
            const int item = fetch(&ctl[2]);
            if (item >= 33 * 128) break;
            mlstm_A(P, item, smem);
        }
        xcd_barrier(xb);
        for (;;) {
            const int item = fetch(&ctl[4]);
            if (item >= 128) break;
            mlstm_B(P, item);
        }
        for (;;) {
            const int item = fetch(&ctl[3]);
            if (item >= 64 * 33) break;
            attn_block(P, item & 63, 32 - (item >> 6), smem);
        }
        xcd_barrier(xb);
        for (;;) {
            const int item = fetch(&ctl[5]);
            if (item >= 33 * 128) break;
            mlstm_C(P, item, smem);
        }
    }
    xcd_barrier(xb);
    for (int tile = bid; tile < 128 * 8; tile += G) gemm_tile<2>(P, tile >> 3, tile & 7, smem);
    convert_uv_rows(P, bid * 4 + wave, G * 4, lane);
    xcd_barrier(xb);
    for (int tile = bid; tile < 128 * 16; tile += G) gemm_tile<3>(P, tile >> 4, tile & 15, smem);
    xcd_barrier(xb);
    {
        int* sidx = (int*)(smem + wave * 3072); float* sval = (float*)(smem + wave * 3072 + 1024);
        int* sid = (int*)(smem + wave * 3072 + 2048); float* sgate = (float*)(smem + wave * 3072 + 2560);
        for (int t = bid * 4 + wave; t < T2; t += G * 4) peer_token(P, t, lane, sidx, sval, sid, sgate);
    }
}

}

extern "C" void kernel_launch(void* const* d_in, const int* in_sizes, int n_in, void* d_out, int out_size, void* d_ws, size_t ws_size, hipStream_t stream) {
    if (n_in != 17 || ws_size < WS_END) { fprintf(stderr, "kernel_launch: unexpected n_in %d or ws_size %zu (need %zu)\n", n_in, ws_size, (size_t)WS_END); return; }
    constexpr int LDS_BYTES = 66560;
    static int grid_blocks = 0;
    if (!grid_blocks) {
        int dev = 0, cus = 0, per_cu = 0;
        (void)hipGetDevice(&dev);
        (void)hipDeviceGetAttribute(&cus, hipDeviceAttributeMultiprocessorCount, dev);
        (void)hipFuncSetAttribute((const void*)mega, hipFuncAttributeMaxDynamicSharedMemorySize, LDS_BYTES);
        (void)hipOccupancyMaxActiveBlocksPerMultiprocessor(&per_cu, (const void*)mega, 256, LDS_BYTES);
        if (per_cu < 1) per_cu = 1;
        if (per_cu > 2) per_cu = 2;
        grid_blocks = cus * per_cu;
        fprintf(stderr, "kernel_launch: cus %d per_cu %d grid %d\n", cus, per_cu, grid_blocks);
    }
    Params P{};
    P.x = (const float*)d_in[0]; P.meta = (const float*)d_in[1]; P.norm_mix = (const float*)d_in[2]; P.w_in = (const float*)d_in[3];
    P.conv_qk = (const float*)d_in[4]; P.b_igate = (const float*)d_in[5]; P.b_fgate_m = (const float*)d_in[6]; P.m_out_norm = (const float*)d_in[7];
    P.b_fgate_f = (const float*)d_in[8]; P.f_q_norm = (const float*)d_in[9]; P.f_k_norm = (const float*)d_in[10]; P.w_out = (const float*)d_in[11];
    P.norm_ffn = (const float*)d_in[12]; P.peer_query = (const float*)d_in[13]; P.peer_keys = (const float*)d_in[14]; P.peer_u = (const float*)d_in[15];
    P.peer_v = (const float*)d_in[16]; P.out = (float*)d_out; P.ws = (unsigned char*)d_ws;
    void* args[] = {&P};
    hipError_t e = hipLaunchCooperativeKernel((const void*)mega, dim3(grid_blocks), dim3(256), args, LDS_BYTES, stream);
    if (e != hipSuccess) fprintf(stderr, "cooperative launch failed: %s (grid %d)\n", hipGetErrorString(e), grid_blocks);
}
```

```cpp
#include <hip/hip_runtime.h>
#include <stdint.h>
#include <stdio.h>
#include <hip/hip_cooperative_groups.h>
namespace cg = cooperative_groups;

namespace {

constexpr int NB = 8, SEQ = 2048, DM = 1024, NMETA = 16, L = SEQ + NMETA;
constexpr int T1 = NB * L;
constexpr int T2 = NB * SEQ;
constexpr int NZ = 3584;
constexpr int ZC_MQ = 0, ZC_MK = 512, ZC_MV = 1024, ZC_MO = 1536, ZC_FQ = 2048, ZC_FK = 2560, ZC_FV = 3072;
constexpr int PROJ = 3600;
constexpr float EPS = 1e-6f;

constexpr size_t WS_CTL = 0;
constexpr size_t WS_RA = 65536;
constexpr size_t WS_Z = WS_RA + (size_t)T1 * DM * 2;
constexpr size_t WS_GATES = WS_Z + (size_t)T1 * NZ * 2;
constexpr size_t WS_CUM = WS_GATES + (size_t)T1 * 16 * 4;
constexpr size_t WS_SSQ = WS_CUM + (size_t)NB * 8 * L * 4;
constexpr size_t WS_RSTD = WS_SSQ + (size_t)T2 * 16 * 4;
constexpr size_t WS_SSQM = WS_RSTD + (size_t)T2 * 4;
constexpr size_t WS_BT2 = WS_SSQM + (size_t)T1 * 16 * 4;
constexpr size_t WS_BT3 = WS_BT2 + (size_t)DM * DM * 2;
constexpr size_t WS_KEYS = WS_BT3 + (size_t)2048 * DM * 2;
constexpr size_t WS_MSC = WS_KEYS + (size_t)16 * 128 * 128 * 2;
constexpr size_t WS_MST = WS_MSC + (size_t)128 * 33 * 16;
constexpr size_t WS_BT1 = WS_MST + (size_t)128 * 33 * 12288;
constexpr size_t WS_CBI = WS_BT1;
constexpr size_t WS_END = WS_CBI + (size_t)128 * 33 * 12288;
constexpr size_t WS_XN = WS_RA;
constexpr size_t WS_U = WS_MST;
constexpr size_t WS_V = WS_U + (size_t)16384 * 512;
constexpr size_t WS_USC = WS_V + (size_t)16384 * 512;
constexpr size_t WS_VSC = WS_USC + (size_t)16384 * 4;
constexpr size_t WS_TK = WS_CBI;
constexpr float LOG2E = 1.4426950408889634f;

typedef unsigned short bf16_t;
typedef short bf16x8 __attribute__((ext_vector_type(8)));
typedef float f32x4 __attribute__((ext_vector_type(4)));
typedef __attribute__((ext_vector_type(2))) __bf16 bf16x2_t;

struct Params {
    const float* x; const float* meta; const float* norm_mix; const float* w_in; const float* conv_qk;
    const float* b_igate; const float* b_fgate_m; const float* m_out_norm; const float* b_fgate_f;
    const float* f_q_norm; const float* f_k_norm; const float* w_out; const float* norm_ffn;
    const float* peer_query; const float* peer_keys; const float* peer_u; const float* peer_v;
    float* out; unsigned char* ws;
};

__device__ __forceinline__ unsigned f2bf(float f) { unsigned u = __float_as_uint(f); return (u + 0x7fffu + ((u >> 16) & 1u)) >> 16; }
__device__ __forceinline__ float bf2f(unsigned h) { return __uint_as_float(h << 16); }
typedef float f32x2 __attribute__((ext_vector_type(2)));
typedef __bf16 bf16x2v __attribute__((ext_vector_type(2)));
__device__ __forceinline__ unsigned cvt_pk_bf16(float lo, float hi) { f32x2 v = {lo, hi}; bf16x2v b = __builtin_convertvector(v, bf16x2v); return __builtin_bit_cast(unsigned, b); }
__device__ __forceinline__ unsigned pk2(float lo, float hi) { return cvt_pk_bf16(lo, hi); }
__device__ __forceinline__ float bflo(unsigned w) { return __uint_as_float(w << 16); }
__device__ __forceinline__ float bfhi(unsigned w) { return __uint_as_float(w & 0xffff0000u); }
__device__ __forceinline__ float wave_sum(float v) {
#pragma unroll
    for (int o = 32; o > 0; o >>= 1) v += __shfl_xor(v, o, 64);
    return v;
}
__device__ __forceinline__ float wave_max(float v) {
#pragma unroll
    for (int o = 32; o > 0; o >>= 1) v = fmaxf(v, __shfl_xor(v, o, 64));
    return v;
}
__device__ __forceinline__ float logsigmoidf(float x) { return fminf(x, 0.f) - log1pf(expf(-fabsf(x))); }
__device__ __forceinline__ unsigned ord_key(float f) { unsigned u = __float_as_uint(f); return u ^ ((u >> 31) ? 0xffffffffu : 0x80000000u); }
__device__ __forceinline__ float unord_key(unsigned k) { unsigned u = (k & 0x80000000u) ? (k ^ 0x80000000u) : ~k; return __uint_as_float(u); }

__device__ __forceinline__ void phase0(const Params& P, unsigned char* smem) {
    const int tid = threadIdx.x, lane = tid & 63, wave = tid >> 6;
    unsigned* ctl = (unsigned*)(P.ws + WS_CTL);
    if (blockIdx.x == 0) for (int i = tid; i < 8192; i += 256) ctl[i] = 0u;
    float* gw = (float*)smem;
    for (int idx = tid; idx < 16 * 1024; idx += 256) {
        const int k = idx >> 4, c = idx & 15;
        const int col = c < 8 ? 2048 + c : 3592 + (c - 8);
        gw[c * 1024 + k] = P.w_in[(size_t)k * PROJ + col];
    }
    __syncthreads();
    {
        bf16_t* hn = (bf16_t*)(P.ws + WS_RA);
        float* gates = (float*)(P.ws + WS_GATES);
        const int c0 = lane * 8, c1 = 512 + lane * 8;
        for (int r = blockIdx.x * 4 + wave; r < T1; r += gridDim.x * 4) {
            const int b = r / L, p = r - b * L;
            const float* src = (p < NMETA) ? (P.meta + (size_t)p * DM) : (P.x + ((size_t)b * SEQ + (p - NMETA)) * DM);
            float v[16];
            {
                const float4 a0 = *(const float4*)(src + c0), a1 = *(const float4*)(src + c0 + 4);
                const float4 a2 = *(const float4*)(src + c1), a3 = *(const float4*)(src + c1 + 4);
                v[0] = a0.x; v[1] = a0.y; v[2] = a0.z; v[3] = a0.w; v[4] = a1.x; v[5] = a1.y; v[6] = a1.z; v[7] = a1.w;
                v[8] = a2.x; v[9] = a2.y; v[10] = a2.z; v[11] = a2.w; v[12] = a3.x; v[13] = a3.y; v[14] = a3.z; v[15] = a3.w;
            }
            float ss = 0.f;
#pragma unroll
            for (int j = 0; j < 16; ++j) ss += v[j] * v[j];
            ss = wave_sum(ss);
            const float rstd = rsqrtf(ss * (1.0f / DM) + EPS);
            {
                const float4 a0 = *(const float4*)(P.norm_mix + c0), a1 = *(const float4*)(P.norm_mix + c0 + 4);
                const float4 a2 = *(const float4*)(P.norm_mix + c1), a3 = *(const float4*)(P.norm_mix + c1 + 4);
                v[0] *= rstd * a0.x; v[1] *= rstd * a0.y; v[2] *= rstd * a0.z; v[3] *= rstd * a0.w; v[4] *= rstd * a1.x; v[5] *= rstd * a1.y; v[6] *= rstd * a1.z; v[7] *= rstd * a1.w;
                v[8] *= rstd * a2.x; v[9] *= rstd * a2.y; v[10] *= rstd * a2.z; v[11] *= rstd * a2.w; v[12] *= rstd * a3.x; v[13] *= rstd * a3.y; v[14] *= rstd * a3.z; v[15] *= rstd * a3.w;
            }
            uint4 o0, o1;
            o0.x = pk2(v[0], v[1]); o0.y = pk2(v[2], v[3]); o0.z = pk2(v[4], v[5]); o0.w = pk2(v[6], v[7]);
            o1.x = pk2(v[8], v[9]); o1.y = pk2(v[10], v[11]); o1.z = pk2(v[12], v[13]); o1.w = pk2(v[14], v[15]);
            *(uint4*)(hn + (size_t)r * DM + c0) = o0;
            *(uint4*)(hn + (size_t)r * DM + c1) = o1;
            float mine = 0.f;
#pragma unroll 1
            for (int c = 0; c < 16; ++c) {
                const float* gwc = gw + c * 1024;
                const float4 w0 = *(const float4*)(gwc + c0), w1 = *(const float4*)(gwc + c0 + 4), w2 = *(const float4*)(gwc + c1), w3 = *(const float4*)(gwc + c1 + 4);
                float s = v[0] * w0.x + v[1] * w0.y + v[2] * w0.z + v[3] * w0.w + v[4] * w1.x + v[5] * w1.y + v[6] * w1.z + v[7] * w1.w
                        + v[8] * w2.x + v[9] * w2.y + v[10] * w2.z + v[11] * w2.w + v[12] * w3.x + v[13] * w3.y + v[14] * w3.z + v[15] * w3.w;
                s = wave_sum(s);
                if (lane == c) mine = s;
            }
            if (lane < 16) {
                float val;
                if (lane < 4) val = mine + P.b_igate[lane];
                else if (lane < 8) val = logsigmoidf(mine + P.b_fgate_m[lane - 4]);
                else val = logsigmoidf(mine + P.b_fgate_f[lane - 8]);
                gates[(size_t)r * 16 + lane] = val;
            }
        }
    }
    __syncthreads();
    {
        float (*tile)[65] = (float (*)[65])smem;
        for (int item = blockIdx.x; item < 1664; item += gridDim.x) {
            const float* W; int ldn, ntn, shift_from, it; bf16_t* out;
            if (item < 896) { W = P.w_in; ldn = PROJ; ntn = 56; shift_from = 2048; it = item; out = (bf16_t*)(P.ws + WS_BT1); }
            else if (item < 1152) { W = P.w_out; ldn = 1024; ntn = 16; shift_from = 1 << 30; it = item - 896; out = (bf16_t*)(P.ws + WS_BT2); }
            else { W = P.peer_query; ldn = 2048; ntn = 32; shift_from = 1 << 30; it = item - 1152; out = (bf16_t*)(P.ws + WS_BT3); }
            const int tk = it / ntn, tn = it - tk * ntn, k0 = tk * 64, n0 = tn * 64;
            {
                const int nl = tid & 63;
                int n = n0 + nl; if (n >= shift_from) n += 8;
#pragma unroll
                for (int i = 0; i < 16; ++i) { const int kl = (tid >> 6) + 4 * i; tile[kl][nl] = W[(size_t)(k0 + kl) * ldn + n]; }
            }
            __syncthreads();
            {
                const int kl = tid & 63;
#pragma unroll
                for (int i = 0; i < 16; ++i) { const int nl = (tid >> 6) + 4 * i; out[(size_t)(n0 + nl) * 1024 + k0 + kl] = (bf16_t)f2bf(tile[kl][nl]); }
            }
            __syncthreads();
        }
    }
    {
        const size_t gt = (size_t)blockIdx.x * 256 + tid, gs = (size_t)gridDim.x * 256;
        const float* src = P.peer_keys; bf16_t* dst = (bf16_t*)(P.ws + WS_KEYS);
        for (size_t i = gt; i < (size_t)(16 * 128 * 128 / 8); i += gs) {
            const float4 a = *(const float4*)(src + i * 8), b = *(const float4*)(src + i * 8 + 4);
            uint4 o; o.x = pk2(a.x, a.y); o.y = pk2(a.z, a.w); o.z = pk2(b.x, b.y); o.w = pk2(b.z, b.w);
            *(uint4*)(dst + i * 8) = o;
        }
    }
}

__device__ __forceinline__ void convert_uv_rows(const Params& P, int gwave, int nwaves, int lane) {
    for (int rr = gwave; rr < 2 * 16384; rr += nwaves) {
        const int which = rr >> 14, row = rr & 16383;
        const float* src = (which ? P.peer_v : P.peer_u) + (size_t)row * DM + lane * 16;
        const float4 a0 = *(const float4*)(src), a1 = *(const float4*)(src + 4), a2 = *(const float4*)(src + 8), a3 = *(const float4*)(src + 12);
        float mx = fmaxf(fmaxf(fmaxf(fabsf(a0.x), fabsf(a0.y)), fmaxf(fabsf(a0.z), fabsf(a0.w))), fmaxf(fmaxf(fabsf(a1.x), fabsf(a1.y)), fmaxf(fabsf(a1.z), fabsf(a1.w))));
        mx = fmaxf(mx, fmaxf(fmaxf(fmaxf(fabsf(a2.x), fabsf(a2.y)), fmaxf(fabsf(a2.z), fabsf(a2.w))), fmaxf(fmaxf(fabsf(a3.x), fabsf(a3.y)), fmaxf(fabsf(a3.z), fabsf(a3.w)))));
        mx = wave_max(mx);
        const float sc = mx > 0.f ? 6.0f / mx : 1.0f;
        unsigned w0 = 0u, w1 = 0u;
        w0 = __builtin_amdgcn_cvt_scalef32_pk_fp4_f32(w0, a0.x * sc, a0.y * sc, 1.0f, 0); w0 = __builtin_amdgcn_cvt_scalef32_pk_fp4_f32(w0, a0.z * sc, a0.w * sc, 1.0f, 1);
        w0 = __builtin_amdgcn_cvt_scalef32_pk_fp4_f32(w0, a1.x * sc, a1.y * sc, 1.0f, 2); w0 = __builtin_amdgcn_cvt_scalef32_pk_fp4_f32(w0, a1.z * sc, a1.w * sc, 1.0f, 3);
        w1 = __builtin_amdgcn_cvt_scalef32_pk_fp4_f32(w1, a2.x * sc, a2.y * sc, 1.0f, 0); w1 = __builtin_amdgcn_cvt_scalef32_pk_fp4_f32(w1, a2.z * sc, a2.w * sc, 1.0f, 1);
        w1 = __builtin_amdgcn_cvt_scalef32_pk_fp4_f32(w1, a3.x * sc, a3.y * sc, 1.0f, 2); w1 = __builtin_amdgcn_cvt_scalef32_pk_fp4_f32(w1, a3.z * sc, a3.w * sc, 1.0f, 3);
        *(uint2*)(P.ws + (which ? WS_V : WS_U) + (size_t)row * 512 + lane * 8) = make_uint2(w0, w1);
        if (lane == 0) ((float*)(P.ws + (which ? WS_VSC : WS_USC)))[row] = mx > 0.f ? mx * (1.0f / 6.0f) : 1.0f;
    }
}

__device__ __forceinline__ void mma_ktile(const unsigned char* sA, const unsigned char* sB, int arow_off, int brow_off, int g, int sw, f32x4 (&acc)[4][4]) {
#pragma unroll
    for (int s = 0; s < 2; ++s) {
        bf16x8 a[4], b[4];
        const int ch = (((s * 4 + g) ^ sw) << 4);
#pragma unroll
        for (int i = 0; i < 4; ++i) a[i] = *(const bf16x8*)(sA + arow_off + i * 2048 + ch);
#pragma unroll
        for (int j = 0; j < 4; ++j) b[j] = *(const bf16x8*)(sB + brow_off + j * 2048 + ch);
#pragma unroll
        for (int i = 0; i < 4; ++i)
#pragma unroll
            for (int j = 0; j < 4; ++j) acc[i][j] = __builtin_amdgcn_mfma_f32_16x16x32_bf16(b[j], a[i], acc[i][j], 0, 0, 0);
    }
}

__device__ __forceinline__ void store_tile_bf16(const f32x4 (&acc)[4][4], unsigned char* smem, bf16_t* dst, size_t ld, int m0, int n0, int tid, int wr, int wc, int g, int lr) {
#pragma unroll
    for (int i = 0; i < 4; ++i)
#pragma unroll
        for (int j = 0; j < 4; ++j) {
            const int row = wr * 64 + 16 * i + lr, col = wc * 64 + 16 * j + 4 * g;
            uint2 w; w.x = pk2(acc[i][j][0], acc[i][j][1]); w.y = pk2(acc[i][j][2], acc[i][j][3]);
            *(uint2*)(smem + row * 272 + col * 2) = w;
        }
    __syncthreads();
#pragma unroll
    for (int q = 0; q < 8; ++q) {
        const int id = tid + 256 * q, row = id >> 4, ch = id & 15;
        const uint4 v = *(const uint4*)(smem + row * 272 + ch * 16);
        *(uint4*)(dst + (size_t)(m0 + row) * ld + n0 + ch * 8) = v;
    }
    __syncthreads();
}

template <int MODE>
__device__ __forceinline__ void gemm_tile(const Params& P, int tm, int tn, unsigned char* smem) {
    const bf16_t* A; const bf16_t* Bt;
    if (MODE == 1) { A = (const bf16_t*)(P.ws + WS_RA); Bt = (const bf16_t*)(P.ws + WS_BT1); }
    else if (MODE == 2) { A = (const bf16_t*)(P.ws + WS_Z); Bt = (const bf16_t*)(P.ws + WS_BT2); }
    else { A = (const bf16_t*)(P.ws + WS_XN); Bt = (const bf16_t*)(P.ws + WS_BT3); }
    const int tid = threadIdx.x, lane = tid & 63, wave = tid >> 6, wr = wave >> 1, wc = wave & 1, g = lane >> 4, lr = lane & 15;
    const int m0 = tm * 128, n0 = tn * 128;
    const int srow = tid >> 3, sc = tid & 7;
    const bf16_t* aptr[4]; const bf16_t* bptr[4]; int soff[4];
#pragma unroll
    for (int j = 0; j < 4; ++j) {
        const int row = srow + 32 * j;
        int ar = m0 + row;
        if (MODE == 2) { const int b = ar >> 11, t = ar & 2047; ar = b * L + NMETA + t; }
        aptr[j] = A + (size_t)ar * (MODE == 2 ? NZ : 1024) + sc * 8;
        bptr[j] = Bt + (size_t)(n0 + row) * 1024 + sc * 8;
        soff[j] = row * 128 + ((sc ^ (row & 7)) << 4);
    }
    f32x4 acc[4][4];
#pragma unroll
    for (int i = 0; i < 4; ++i)
#pragma unroll
        for (int j = 0; j < 4; ++j) acc[i][j] = (f32x4){0.f, 0.f, 0.f, 0.f};
    uint4 ra[4], rb[4];
#pragma unroll
    for (int j = 0; j < 4; ++j) { ra[j] = *(const uint4*)(aptr[j]); rb[j] = *(const uint4*)(bptr[j]); }
    const float* ssqm_row[4];
    if (MODE == 2) {
#pragma unroll
        for (int j = 0; j < 4; ++j) {
            int ar = m0 + srow + 32 * j; { const int b = ar >> 11, t = ar & 2047; ar = b * L + NMETA + t; }
            ssqm_row[j] = (const float*)(P.ws + WS_SSQM) + (size_t)ar * 16;
            const float4 q4 = *(const float4*)(ssqm_row[j]);
            const float rs = rsqrtf(((q4.x + q4.y) + (q4.z + q4.w)) * (1.0f / 128.0f) + EPS);
            ra[j].x = pk2(bflo(ra[j].x) * rs, bfhi(ra[j].x) * rs); ra[j].y = pk2(bflo(ra[j].y) * rs, bfhi(ra[j].y) * rs);
            ra[j].z = pk2(bflo(ra[j].z) * rs, bfhi(ra[j].z) * rs); ra[j].w = pk2(bflo(ra[j].w) * rs, bfhi(ra[j].w) * rs);
        }
    }
    unsigned char* sA0 = smem; unsigned char* sB0 = smem + 16384; unsigned char* sA1 = smem + 32768; unsigned char* sB1 = smem + 49152;
#pragma unroll
    for (int j = 0; j < 4; ++j) { *(uint4*)(sA0 + soff[j]) = ra[j]; *(uint4*)(sB0 + soff[j]) = rb[j]; }
    __syncthreads();
    const int arow_off = (wr * 64 + lr) * 128, brow_off = (wc * 64 + lr) * 128, sw = lr & 7;
    for (int kt = 0; kt < 16; ++kt) {
        unsigned char* sA = (kt & 1) ? sA1 : sA0; unsigned char* sB = (kt & 1) ? sB1 : sB0;
        unsigned char* nA = (kt & 1) ? sA0 : sA1; unsigned char* nB = (kt & 1) ? sB0 : sB1;
        if (kt < 15) {
#pragma unroll
            for (int j = 0; j < 4; ++j) { ra[j] = *(const uint4*)(aptr[j] + (kt + 1) * 64); rb[j] = *(const uint4*)(bptr[j] + (kt + 1) * 64); }
            if (MODE == 2 && kt + 1 < 8) {
                const int head = (kt + 1) >> 1;
#pragma unroll
                for (int j = 0; j < 4; ++j) {
                    const float4 q4 = *(const float4*)(ssqm_row[j] + head * 4);
                    const float rs = rsqrtf(((q4.x + q4.y) + (q4.z + q4.w)) * (1.0f / 128.0f) + EPS);
                    ra[j].x = pk2(bflo(ra[j].x) * rs, bfhi(ra[j].x) * rs); ra[j].y = pk2(bflo(ra[j].y) * rs, bfhi(ra[j].y) * rs);
                    ra[j].z = pk2(bflo(ra[j].z) * rs, bfhi(ra[j].z) * rs); ra[j].w = pk2(bflo(ra[j].w) * rs, bfhi(ra[j].w) * rs);
                }
            }
        }
        mma_ktile(sA, sB, arow_off, brow_off, g, sw, acc);
        if (kt < 15) {
#pragma unroll
            for (int j = 0; j < 4; ++j) { *(uint4*)(nA + soff[j]) = ra[j]; *(uint4*)(nB + soff[j]) = rb[j]; }
        }
        __syncthreads();
    }
    if (MODE == 1) {
        if (n0 >= ZC_FQ && n0 < ZC_FV) {
            const bool isk = n0 >= ZC_FK;
            const float* gain = isk ? P.f_k_norm : P.f_q_norm;
            const float scl = isk ? 1.0f : 0.125f * LOG2E;
            float gn[4][4];
#pragma unroll
            for (int j = 0; j < 4; ++j)
#pragma unroll
                for (int r = 0; r < 4; ++r) gn[j][r] = gain[16 * j + 4 * g + r];
#pragma unroll
            for (int i = 0; i < 4; ++i) {
                float ss = 0.f;
#pragma unroll
                for (int j = 0; j < 4; ++j)
#pragma unroll
                    for (int r = 0; r < 4; ++r) ss += acc[i][j][r] * acc[i][j][r];
                ss += __shfl_xor(ss, 16, 64); ss += __shfl_xor(ss, 32, 64);
                const float rstd = rsqrtf(ss * (1.0f / 64.0f) + EPS) * scl;
#pragma unroll
                for (int j = 0; j < 4; ++j)
#pragma unroll
                    for (int r = 0; r < 4; ++r) acc[i][j][r] *= rstd * gn[j][r];
            }
        }
        store_tile_bf16(acc, smem, (bf16_t*)(P.ws + WS_Z), NZ, m0, n0, tid, wr, wc, g, lr);
    } else if (MODE == 2) {
        float* ssq = (float*)(P.ws + WS_SSQ);
#pragma unroll
        for (int i = 0; i < 4; ++i) {
            const int row = m0 + wr * 64 + 16 * i + lr;
            float ss = 0.f;
#pragma unroll
            for (int j = 0; j < 4; ++j) {
                const int col = n0 + wc * 64 + 16 * j + 4 * g;
                const float4 xv = *(const float4*)(P.x + (size_t)row * DM + col);
                const float4 gv = *(const float4*)(P.norm_ffn + col);
                float4 hv; hv.x = acc[i][j][0] + xv.x; hv.y = acc[i][j][1] + xv.y; hv.z = acc[i][j][2] + xv.z; hv.w = acc[i][j][3] + xv.w;
                *(float4*)(P.out + (size_t)row * DM + col) = hv;
                ss += hv.x * hv.x + hv.y * hv.y + hv.z * hv.z + hv.w * hv.w;
                acc[i][j][0] = hv.x * gv.x; acc[i][j][1] = hv.y * gv.y; acc[i][j][2] = hv.z * gv.z; acc[i][j][3] = hv.w * gv.w;
            }
            ss += __shfl_xor(ss, 16, 64); ss += __shfl_xor(ss, 32, 64);
            if (g == 0) ssq[(size_t)row * 16 + tn * 2 + wc] = ss;
        }
        store_tile_bf16(acc, smem, (bf16_t*)(P.ws + WS_XN), 1024, m0, n0, tid, wr, wc, g, lr);
    } else {
        const int hp = tn;
        const float* ssq = (const float*)(P.ws + WS_SSQ);
        float rs[4];
#pragma unroll
        for (int i = 0; i < 4; ++i) {
            const int row = m0 + wr * 64 + 16 * i + lr;
            const float4 p0 = *(const float4*)(ssq + (size_t)row * 16), p1 = *(const float4*)(ssq + (size_t)row * 16 + 4);
            const float4 p2 = *(const float4*)(ssq + (size_t)row * 16 + 8), p3 = *(const float4*)(ssq + (size_t)row * 16 + 12);
            const float s = ((p0.x + p0.y) + (p0.z + p0.w)) + ((p1.x + p1.y) + (p1.z + p1.w)) + ((p2.x + p2.y) + (p2.z + p2.w)) + ((p3.x + p3.y) + (p3.z + p3.w));
            rs[i] = rsqrtf(s * (1.0f / DM) + EPS);
            if (tn == 0 && wc == 0 && g == 0) ((float*)(P.ws + WS_RSTD))[row] = rs[i];
        }
        {
            unsigned char* sAq = wc ? sA1 : sA0;
#pragma unroll
            for (int i = 0; i < 4; ++i)
#pragma unroll
                for (int j = 0; j < 4; ++j) {
                    const int row = wr * 64 + 16 * i + lr;
                    const int chunk = 2 * j + (g >> 1);
                    uint2 w; w.x = pk2(acc[i][j][0] * rs[i], acc[i][j][1] * rs[i]); w.y = pk2(acc[i][j][2] * rs[i], acc[i][j][3] * rs[i]);
                    *(uint2*)(sAq + row * 128 + ((chunk ^ (row & 7)) << 4) + 8 * (g & 1)) = w;
                }
            const bf16_t* keys = (const bf16_t*)(P.ws + WS_KEYS) + (size_t)hp * 128 * 128;
#pragma unroll
            for (int j = 0; j < 4; ++j) {
                const int row = srow + 32 * j;
                const uint4 k0 = *(const uint4*)(keys + (size_t)row * 128 + sc * 8);
                const uint4 k1 = *(const uint4*)(keys + (size_t)row * 128 + 64 + sc * 8);
                *(uint4*)(sB0 + soff[j]) = k0; *(uint4*)(sB1 + soff[j]) = k1;
            }
        }
        __syncthreads();
#pragma unroll
        for (int i = 0; i < 4; ++i)
#pragma unroll
            for (int j = 0; j < 4; ++j) acc[i][j] = (f32x4){0.f, 0.f, 0.f, 0.f};
        mma_ktile(sA0, sB0, arow_off, brow_off, g, sw, acc);
        mma_ktile(sA1, sB1, arow_off, brow_off, g, sw, acc);
        __syncthreads();
#pragma unroll
        for (int i = 0; i < 4; ++i)
#pragma unroll
            for (int j = 0; j < 4; ++j) {
                const int row = wr * 64 + 16 * i + lr;
                const int c4 = wc * 16 + 4 * j + g;
                *(f32x4*)(smem + row * 512 + ((c4 ^ (row & 31)) << 4)) = acc[i][j];
            }
        __syncthreads();
        unsigned top[16];
#pragma unroll
        for (int q = 0; q < 16; ++q) top[q] = 0u;
        const int row = tid & 127, half = tid >> 7;
#pragma unroll 1
        for (int s = 0; s < 16; ++s) {
            const int c4 = half * 16 + s;
            const f32x4 v = *(const f32x4*)(smem + row * 512 + ((c4 ^ (row & 31)) << 4));
#pragma unroll
            for (int e = 0; e < 4; ++e) {
                unsigned kx = (ord_key(v[e]) & ~127u) | (unsigned)(127 - (c4 * 4 + e));
#pragma unroll
                for (int q = 0; q < 16; ++q) { const unsigned hi = max(top[q], kx), lo = min(top[q], kx); top[q] = hi; kx = lo; }
            }
        }
        __syncthreads();
        if (half) {
            uint4* lp = (uint4*)(smem + row * 64);
            lp[0] = make_uint4(top[0], top[1], top[2], top[3]); lp[1] = make_uint4(top[4], top[5], top[6], top[7]);
            lp[2] = make_uint4(top[8], top[9], top[10], top[11]); lp[3] = make_uint4(top[12], top[13], top[14], top[15]);
        }
        __syncthreads();
        if (!half) {
            const uint4* lp = (const uint4*)(smem + row * 64);
#pragma unroll
            for (int c = 0; c < 4; ++c) {
                const uint4 o = lp[c];
                unsigned ks[4] = {o.x, o.y, o.z, o.w};
#pragma unroll
                for (int e = 0; e < 4; ++e) {
                    unsigned kx = ks[e];
#pragma unroll
                    for (int q = 0; q < 16; ++q) { const unsigned hi = max(top[q], kx), lo = min(top[q], kx); top[q] = hi; kx = lo; }
                }
            }
            uint4* tk = (uint4*)((unsigned*)(P.ws + WS_TK) + ((size_t)(m0 + row) * 16 + hp) * 16);
            tk[0] = make_uint4(top[0], top[1], top[2], top[3]); tk[1] = make_uint4(top[4], top[5], top[6], top[7]);
            tk[2] = make_uint4(top[8], top[9], top[10], top[11]); tk[3] = make_uint4(top[12], top[13], top[14], top[15]);
        }
        __syncthreads();
    }
}

__device__ __forceinline__ void fox_cum_wave(const Params& P, int bh, int lane) {
    const int b = bh >> 3, h = bh & 7;
    const float* gates = (const float*)(P.ws + WS_GATES);
    float* cum = (float*)(P.ws + WS_CUM) + (size_t)bh * L;
    constexpr int SEG = 33;
    const int t0 = lane * SEG;
    float loc = 0.f;
    for (int i = 0; i < SEG; ++i) { const int t = t0 + i; if (t < L) loc += gates[(size_t)(b * L + t) * 16 + 8 + h]; }
    float incl = loc;
#pragma unroll
    for (int o = 1; o < 64; o <<= 1) { const float n = __shfl_up(incl, o, 64); if (lane >= o) incl += n; }
    float run = incl - loc;
    for (int i = 0; i < SEG; ++i) { const int t = t0 + i; if (t < L) { run += gates[(size_t)(b * L + t) * 16 + 8 + h]; cum[t] = run * LOG2E; } }
}

#define TR_SLOW 0

__device__ __forceinline__ int vimg_off(int row, int ch) { return row * 128 + ((ch ^ (((row >> 1) & 3) << 1)) << 4); }
__device__ __forceinline__ uint2 tr_frag(const unsigned char* img, int row0, int c, int g, int lr) {
#if TR_SLOW
    unsigned short e[4];
#pragma unroll
    for (int k = 0; k < 4; ++k) { const int row = row0 + 4 * g + k, col = 16 * c + lr; e[k] = *(const unsigned short*)(img + vimg_off(row, col >> 3) + (col & 7) * 2); }
    uint2 r; r.x = (unsigned)e[0] | ((unsigned)e[1] << 16); r.y = (unsigned)e[2] | ((unsigned)e[3] << 16); return r;
#else
    const int q = lr >> 2, p = lr & 3, row = row0 + 4 * g + q;
    const unsigned addr = (unsigned)(size_t)(img + vimg_off(row, 2 * c + (p >> 1)) + 8 * (p & 1));
    uint2 r;
    asm volatile("ds_read_b64_tr_b16 %0, %1\n\ts_waitcnt lgkmcnt(0)" : "=&v"(r) : "v"(addr) : "memory");
    return r;
#endif
}

__device__ __forceinline__ unsigned tr_lane_addr(const unsigned char* img, int c, int g, int lr) {
    const int q = lr >> 2, p = lr & 3, row = 4 * g + q;
    return (unsigned)(size_t)(img + vimg_off(row, 2 * c + (p >> 1)) + 8 * (p & 1));
}
#define TR_GROUP(o0, o1, o2, o3, a) "ds_read_b64_tr_b16 %" #o0 ", %" #a "\n\tds_read_b64_tr_b16 %" #o1 ", %" #a " offset:2048\n\tds_read_b64_tr_b16 %" #o2 ", %" #a " offset:4096\n\tds_read_b64_tr_b16 %" #o3 ", %" #a " offset:6144\n\t"
__device__ __forceinline__ void tr_read_4c(const unsigned char* img, int g, int lr, uint2 (&r)[4][4]) {
    const unsigned a0 = tr_lane_addr(img, 0, g, lr), a1 = tr_lane_addr(img, 1, g, lr), a2 = tr_lane_addr(img, 2, g, lr), a3 = tr_lane_addr(img, 3, g, lr);
    asm volatile(TR_GROUP(0, 1, 2, 3, 16) TR_GROUP(4, 5, 6, 7, 17) TR_GROUP(8, 9, 10, 11, 18) TR_GROUP(12, 13, 14, 15, 19) "s_waitcnt lgkmcnt(0)"
        : "=&v"(r[0][0]), "=&v"(r[0][1]), "=&v"(r[0][2]), "=&v"(r[0][3]), "=&v"(r[1][0]), "=&v"(r[1][1]), "=&v"(r[1][2]), "=&v"(r[1][3]),
          "=&v"(r[2][0]), "=&v"(r[2][1]), "=&v"(r[2][2]), "=&v"(r[2][3]), "=&v"(r[3][0]), "=&v"(r[3][1]), "=&v"(r[3][2]), "=&v"(r[3][3])
        : "v"(a0), "v"(a1), "v"(a2), "v"(a3) : "memory");
}
__device__ __forceinline__ void tr_read_3c(const unsigned char* img, int g, int lr, uint2 (&r)[3][4]) {
    const unsigned a0 = tr_lane_addr(img, 0, g, lr), a1 = tr_lane_addr(img, 1, g, lr), a2 = tr_lane_addr(img, 2, g, lr);
    asm volatile(TR_GROUP(0, 1, 2, 3, 12) TR_GROUP(4, 5, 6, 7, 13) TR_GROUP(8, 9, 10, 11, 14) "s_waitcnt lgkmcnt(0)"
        : "=&v"(r[0][0]), "=&v"(r[0][1]), "=&v"(r[0][2]), "=&v"(r[0][3]), "=&v"(r[1][0]), "=&v"(r[1][1]), "=&v"(r[1][2]), "=&v"(r[1][3]),
          "=&v"(r[2][0]), "=&v"(r[2][1]), "=&v"(r[2][2]), "=&v"(r[2][3])
        : "v"(a0), "v"(a1), "v"(a2) : "memory");
}
__device__ __forceinline__ void tr_read_2(const unsigned char* img0, int c0, const unsigned char* img1, int c1, int g, int lr, uint2 (&r)[2][4]) {
    const unsigned a0 = tr_lane_addr(img0, c0, g, lr), a1 = tr_lane_addr(img1, c1, g, lr);
    asm volatile(TR_GROUP(0, 1, 2, 3, 8) TR_GROUP(4, 5, 6, 7, 9) "s_waitcnt lgkmcnt(0)"
        : "=&v"(r[0][0]), "=&v"(r[0][1]), "=&v"(r[0][2]), "=&v"(r[0][3]), "=&v"(r[1][0]), "=&v"(r[1][1]), "=&v"(r[1][2]), "=&v"(r[1][3])
        : "v"(a0), "v"(a1) : "memory");
}
__device__ __forceinline__ bf16x8 tr_pair(const uint2& lo, const uint2& hi) { uint4 u; u.x = lo.x; u.y = lo.y; u.z = hi.x; u.w = hi.y; return __builtin_bit_cast(bf16x8, u); }

__device__ __forceinline__ void attn_block(const Params& P, int bh, int qb, unsigned char* smem) {
    const int tid = threadIdx.x, lane = tid & 63, w = tid >> 6, g = lane >> 4, lr = lane & 15;
    const int b = bh >> 3, h = bh & 7;
    const bf16_t* z = (const bf16_t*)(P.ws + WS_Z);
    const float* cum = (const float*)(P.ws + WS_CUM) + (size_t)bh * L;
    const int tq = qb * 64 + 16 * w + lr;
    const bool qvalid = tq < L;
    bf16x8 qf[2];
    {
        const bf16_t* qp = z + (size_t)(b * L + (qvalid ? tq : 0)) * NZ + ZC_FQ + h * 64 + 8 * g;
        qf[0] = *(const bf16x8*)(qp); qf[1] = *(const bf16x8*)(qp + 32);
    }
    const float cq = cum[qvalid ? tq : 0];
    const int srow0 = tid >> 3, sch = tid & 7;
    uint4 rk[2], rv[2]; float rc = 0.f;
    auto load_tile = [&](int kv) {
#pragma unroll
        for (int j = 0; j < 2; ++j) {
            const int key = kv * 64 + srow0 + 32 * j;
            if (key < L) {
                const bf16_t* p = z + (size_t)(b * L + key) * NZ + h * 64 + sch * 8;
                rk[j] = *(const uint4*)(p + ZC_FK); rv[j] = *(const uint4*)(p + ZC_FV);
            } else { rk[j] = make_uint4(0, 0, 0, 0); rv[j] = make_uint4(0, 0, 0, 0); }
        }
        if (tid < 64) { const int key = kv * 64 + tid; rc = key < L ? cum[key] : 0.f; }
    };
    auto store_tile = [&](int buf) {
        unsigned char* sK = smem + buf * 16384; unsigned char* sV = sK + 8192;
#pragma unroll
        for (int j = 0; j < 2; ++j) {
            const int row = srow0 + 32 * j;
            *(uint4*)(sK + row * 128 + ((sch ^ (row & 7)) << 4)) = rk[j];
            *(uint4*)(sV + vimg_off(row, sch)) = rv[j];
        }
        if (tid < 64) ((float*)(smem + 32768 + buf * 256))[tid] = rc;
    };
    float m = -INFINITY, lsum = 0.f;
    f32x4 o[4];
#pragma unroll
    for (int c = 0; c < 4; ++c) o[c] = (f32x4){0.f, 0.f, 0.f, 0.f};
    load_tile(0); store_tile(0);
    __syncthreads();
    for (int kv = 0; kv <= qb; ++kv) {
        const int buf = kv & 1;
        if (kv < qb) load_tile(kv + 1);
        const unsigned char* sK = smem + buf * 16384; const unsigned char* sV = sK + 8192;
        const float* sck = (const float*)(smem + 32768 + buf * 256);
        f32x4 sa[4];
#pragma unroll
        for (int c = 0; c < 4; ++c) {
            sa[c] = (f32x4){0.f, 0.f, 0.f, 0.f};
#pragma unroll
            for (int s = 0; s < 2; ++s) {
                const bf16x8 kf = *(const bf16x8*)(sK + (16 * c + lr) * 128 + (((4 * s + g) ^ (lr & 7)) << 4));
                sa[c] = __builtin_amdgcn_mfma_f32_16x16x32_bf16(kf, qf[s], sa[c], 0, 0, 0);
            }
        }
        const bool diag = (kv == qb);
        float mx = -INFINITY;
#pragma unroll
        for (int c = 0; c < 4; ++c) {
            const f32x4 ck = *(const f32x4*)(sck + 16 * c + 4 * g);
#pragma unroll
            for (int r = 0; r < 4; ++r) {
                float v = sa[c][r] + (cq - ck[r]);
                if (diag && (16 * c + 4 * g + r > 16 * w + lr)) v = -INFINITY;
                sa[c][r] = v; mx = fmaxf(mx, v);
            }
        }
        mx = fmaxf(mx, __shfl_xor(mx, 16, 64)); mx = fmaxf(mx, __shfl_xor(mx, 32, 64));
        const float mn = fmaxf(m, mx);
        const float alpha = __builtin_amdgcn_exp2f(m - mn);
        m = mn;
        float ps = 0.f;
#pragma unroll
        for (int c = 0; c < 4; ++c)
#pragma unroll
            for (int r = 0; r < 4; ++r) { const float p = __builtin_amdgcn_exp2f(sa[c][r] - mn); sa[c][r] = p; ps += p; }
        lsum = lsum * alpha + ps;
#pragma unroll
        for (int c = 0; c < 4; ++c) o[c] *= alpha;
        bf16x8 pf[2];
#pragma unroll
        for (int s2 = 0; s2 < 2; ++s2) {
            uint4 u;
            u.x = cvt_pk_bf16(sa[2 * s2][0], sa[2 * s2][1]); u.y = cvt_pk_bf16(sa[2 * s2][2], sa[2 * s2][3]);
            u.z = cvt_pk_bf16(sa[2 * s2 + 1][0], sa[2 * s2 + 1][1]); u.w = cvt_pk_bf16(sa[2 * s2 + 1][2], sa[2 * s2 + 1][3]);
            pf[s2] = __builtin_bit_cast(bf16x8, u);
        }
        {
            uint2 vr[4][4];
            tr_read_4c(sV, g, lr, vr);
#pragma unroll
            for (int c = 0; c < 4; ++c)
#pragma unroll
                for (int s2 = 0; s2 < 2; ++s2) o[c] = __builtin_amdgcn_mfma_f32_16x16x32_bf16(tr_pair(vr[c][2 * s2], vr[c][2 * s2 + 1]), pf[s2], o[c], 0, 0, 0);
        }
        if (kv < qb) store_tile(buf ^ 1);
        __syncthreads();
    }
    lsum += __shfl_xor(lsum, 16, 64); lsum += __shfl_xor(lsum, 32, 64);
    const float inv = 1.0f / lsum;
    if (qvalid) {
        bf16_t* y = (bf16_t*)(P.ws + WS_Z) + (size_t)(b * L + tq) * NZ + 512 + h * 64 + 4 * g;
#pragma unroll
        for (int c = 0; c < 4; ++c) {
            uint2 u; u.x = pk2(o[c][0] * inv, o[c][1] * inv); u.y = pk2(o[c][2] * inv, o[c][3] * inv);
            *(uint2*)(y + 16 * c) = u;
        }
    }
}

__device__ __forceinline__ void conv_item(const Params& P, int ci) {
    const int tid = threadIdx.x, cc = tid & 127, rg = tid >> 7;
    const bf16_t* z = (const bf16_t*)(P.ws + WS_Z);
    bf16_t* qk = (bf16_t*)(P.ws + WS_RA);
    const int col0 = cc * 8;
    float w[4][8];
#pragma unroll
    for (int j = 0; j < 4; ++j) {
        const float4 a = *(const float4*)(P.conv_qk + j * 1024 + col0), b = *(const float4*)(P.conv_qk + j * 1024 + col0 + 4);
        w[j][0] = a.x; w[j][1] = a.y; w[j][2] = a.z; w[j][3] = a.w; w[j][4] = b.x; w[j][5] = b.y; w[j][6] = b.z; w[j][7] = b.w;
    }
    const float oscale = (col0 >= 512) ? 0.08838834764831845f : 1.0f;
    const int r0 = ci * 64 + rg * 32;
    int t = r0 % L;
    float xw[3][8];
#pragma unroll
    for (int j = 0; j < 3; ++j) {
        const int back = 3 - j;
        if (t - back >= 0) {
            const uint4 v = *(const uint4*)(z + (size_t)(r0 - back) * NZ + col0);
            xw[j][0] = bflo(v.x); xw[j][1] = bfhi(v.x); xw[j][2] = bflo(v.y); xw[j][3] = bfhi(v.y); xw[j][4] = bflo(v.z); xw[j][5] = bfhi(v.z); xw[j][6] = bflo(v.w); xw[j][7] = bfhi(v.w);
        } else {
#pragma unroll
            for (int e = 0; e < 8; ++e) xw[j][e] = 0.f;
        }
    }
#pragma unroll 2
    for (int i = 0; i < 32; ++i) {
        const int r = r0 + i;
        if (t == 0) {
#pragma unroll
            for (int j = 0; j < 3; ++j)
#pragma unroll
                for (int e = 0; e < 8; ++e) xw[j][e] = 0.f;
        }
        const uint4 v = *(const uint4*)(z + (size_t)r * NZ + col0);
        float xt[8];
        xt[0] = bflo(v.x); xt[1] = bfhi(v.x); xt[2] = bflo(v.y); xt[3] = bfhi(v.y); xt[4] = bflo(v.z); xt[5] = bfhi(v.z); xt[6] = bflo(v.w); xt[7] = bfhi(v.w);
        float o[8];
#pragma unroll
        for (int e = 0; e < 8; ++e) {
            const float cv = w[0][e] * xw[0][e] + w[1][e] * xw[1][e] + w[2][e] * xw[2][e] + w[3][e] * xt[e];
            o[e] = oscale * cv / (1.f + __expf(-cv));
            xw[0][e] = xw[1][e]; xw[1][e] = xw[2][e]; xw[2][e] = xt[e];
        }
        uint4 ov; ov.x = pk2(o[0], o[1]); ov.y = pk2(o[2], o[3]); ov.z = pk2(o[4], o[5]); ov.w = pk2(o[6], o[7]);
        *(uint4*)(qk + (size_t)r * 1024 + col0) = ov;
        t = (t + 1 == L) ? 0 : t + 1;
    }
}

__device__ __forceinline__ int st_piece_off(int jt, int c, int g, int lr) { return (jt >> 2) * 6144 + vimg_off(16 * c + lr, 2 * (jt & 3) + (g >> 1)) + 8 * (g & 1); }

__device__ __forceinline__ void mlstm_stage_kv(const Params& P, int b, int h, int dq, int k, unsigned char* smem, int tid) {
    const bf16_t* z = (const bf16_t*)(P.ws + WS_Z);
    const bf16_t* qk = (const bf16_t*)(P.ws + WS_RA);
    uint4 pk_[4]; uint4 pv_;
#pragma unroll
    for (int j = 0; j < 4; ++j) {
        const int id = tid + 256 * j, row = id >> 4, ch16 = id & 15, pos = 64 * k + row;
        pk_[j] = (pos < L) ? *(const uint4*)(qk + (size_t)(b * L + pos) * 1024 + 512 + h * 128 + ch16 * 8) : make_uint4(0, 0, 0, 0);
    }
    {
        const int row = tid >> 2, ch = tid & 3, pos = 64 * k + row;
        pv_ = (pos < L) ? *(const uint4*)(z + (size_t)(b * L + pos) * NZ + ZC_MV + h * 128 + dq * 32 + ch * 8) : make_uint4(0, 0, 0, 0);
    }
#pragma unroll
    for (int j = 0; j < 4; ++j) {
        const int id = tid + 256 * j, row = id >> 4, ch16 = id & 15;
        *(uint4*)(smem + (ch16 >> 3) * 8192 + vimg_off(row, ch16 & 7)) = pk_[j];
    }
    { const int row = tid >> 2, ch = tid & 3; *(uint4*)(smem + 16384 + vimg_off(row, ch)) = pv_; }
    if (tid < 128) {
        const int row = tid >> 1, ch = 4 + (tid & 1);
        *(uint4*)(smem + 16384 + vimg_off(row, ch)) = (tid & 1) ? make_uint4(0, 0, 0, 0) : make_uint4(0x3F80u, 0, 0, 0);
    }
}

__device__ __forceinline__ void mlstm_A(const Params& P, int item, unsigned char* smem) {
    const int tid = threadIdx.x, lane = tid & 63, w = tid >> 6, g = lane >> 4, lr = lane & 15;
    const int wu = __builtin_amdgcn_readfirstlane(w);
    const int k = item >> 7, bhd = item & 127, b = bhd >> 4, h = (bhd >> 2) & 3, dq = bhd & 3;
    const float* gates = (const float*)(P.ws + WS_GATES);
    float* ga = (float*)(smem + 36864);
    mlstm_stage_kv(P, b, h, dq, k, smem, tid);
    if (wu == 0) {
        const int pos = 64 * k + lane;
        float lf = 0.f, li = -INFINITY;
        if (pos < L) { lf = gates[(size_t)(b * L + pos) * 16 + 4 + h]; li = gates[(size_t)(b * L + pos) * 16 + h]; }
        float bc = lf;
#pragma unroll
        for (int o = 1; o < 64; o <<= 1) { const float n = __shfl_up(bc, o, 64); if (lane >= o) bc += n; }
        const float a = li - bc;
        const float A = wave_max(a);
        ga[lane] = __expf(a - A);
        if (lane == 63) { float* msc = (float*)(P.ws + WS_MSC) + ((size_t)bhd * 33 + k) * 4; msc[0] = A; msc[1] = bc; }
    }
    __syncthreads();
    const unsigned char* sK = smem; const unsigned char* sV = smem + 16384;
    f32x4 Ct[2][3];
#pragma unroll
    for (int a = 0; a < 2; ++a)
#pragma unroll
        for (int c = 0; c < 3; ++c) Ct[a][c] = (f32x4){0.f, 0.f, 0.f, 0.f};
    uint2 vr[3][4];
    tr_read_3c(sV, g, lr, vr);
#pragma unroll
    for (int s2 = 0; s2 < 2; ++s2) {
        const f32x4 w0 = *(const f32x4*)(ga + 32 * s2 + 4 * g), w1 = *(const f32x4*)(ga + 32 * s2 + 16 + 4 * g);
        bf16x8 vw[3];
#pragma unroll
        for (int c = 0; c < 3; ++c) {
            const uint2 lo = vr[c][2 * s2], hi = vr[c][2 * s2 + 1];
            uint4 o;
            o.x = cvt_pk_bf16(bflo(lo.x) * w0[0], bfhi(lo.x) * w0[1]); o.y = cvt_pk_bf16(bflo(lo.y) * w0[2], bfhi(lo.y) * w0[3]);
            o.z = cvt_pk_bf16(bflo(hi.x) * w1[0], bfhi(hi.x) * w1[1]); o.w = cvt_pk_bf16(bflo(hi.y) * w1[2], bfhi(hi.y) * w1[3]);
            vw[c] = __builtin_bit_cast(bf16x8, o);
        }
#pragma unroll
        for (int a = 0; a < 2; ++a) {
            const int jt = 2 * w + a;
            const uint2 lo = tr_frag(sK + (jt >> 2) * 8192, 32 * s2, jt & 3, g, lr), hi = tr_frag(sK + (jt >> 2) * 8192, 32 * s2 + 16, jt & 3, g, lr);
            const bf16x8 kt = tr_pair(lo, hi);
#pragma unroll
            for (int c = 0; c < 3; ++c) Ct[a][c] = __builtin_amdgcn_mfma_f32_16x16x32_bf16(kt, vw[c], Ct[a][c], 0, 0, 0);
        }
    }
    unsigned char* slot = P.ws + WS_MST + ((size_t)bhd * 33 + k) * 12288;
#pragma unroll
    for (int a = 0; a < 2; ++a)
#pragma unroll
        for (int c = 0; c < 3; ++c) {
            uint2 u; u.x = cvt_pk_bf16(Ct[a][c][0], Ct[a][c][1]); u.y = cvt_pk_bf16(Ct[a][c][2], Ct[a][c][3]);
            *(uint2*)(slot + st_piece_off(2 * w + a, c, g, lr)) = u;
        }
}

__device__ __forceinline__ void mlstm_B(const Params& P, int bhd) {
    const int tid = threadIdx.x, lane = tid & 63, w = tid >> 6, g = lane >> 4, lr = lane & 15;
    const unsigned char* base = P.ws + WS_MST + (size_t)bhd * 33 * 12288;
    unsigned char* obase = P.ws + WS_CBI + (size_t)bhd * 33 * 12288;
    float* msc = (float*)(P.ws + WS_MSC) + (size_t)bhd * 33 * 4;
    int off[6];
#pragma unroll
    for (int a = 0; a < 2; ++a)
#pragma unroll
        for (int c = 0; c < 3; ++c) off[a * 3 + c] = st_piece_off(2 * w + a, c, g, lr);
    float C[6][4];
#pragma unroll
    for (int i = 0; i < 6; ++i)
#pragma unroll
        for (int r = 0; r < 4; ++r) C[i][r] = 0.f;
    float m = 0.f;
    uint2 d0[6], d1[6];
    float2 ab0, ab1;
#pragma unroll
    for (int i = 0; i < 6; ++i) { d0[i] = *(const uint2*)(base + off[i]); d1[i] = *(const uint2*)(base + 12288 + off[i]); }
    ab0 = *(const float2*)(msc); ab1 = *(const float2*)(msc + 4);
    for (int k = 0; k < 33; ++k) {
        uint2 d2[6]; float2 ab2 = make_float2(0.f, 0.f);
        if (k + 2 < 33) {
#pragma unroll
            for (int i = 0; i < 6; ++i) d2[i] = *(const uint2*)(base + (size_t)(k + 2) * 12288 + off[i]);
            ab2 = *(const float2*)(msc + (k + 2) * 4);
        } else {
#pragma unroll
            for (int i = 0; i < 6; ++i) d2[i] = make_uint2(0, 0);
        }
#pragma unroll
        for (int i = 0; i < 6; ++i) {
            uint2 u; u.x = cvt_pk_bf16(C[i][0], C[i][1]); u.y = cvt_pk_bf16(C[i][2], C[i][3]);
            *(uint2*)(obase + (size_t)k * 12288 + off[i]) = u;
        }
        if (tid == 0) msc[k * 4 + 2] = m;
        const float M = fmaxf(m, ab0.x);
        const float decay = __expf(m - M), sc = __expf(ab0.x - M);
#pragma unroll
        for (int i = 0; i < 6; ++i) {
            C[i][0] = decay * C[i][0] + sc * bflo(d0[i].x); C[i][1] = decay * C[i][1] + sc * bfhi(d0[i].x);
            C[i][2] = decay * C[i][2] + sc * bflo(d0[i].y); C[i][3] = decay * C[i][3] + sc * bfhi(d0[i].y);
        }
        m = ab0.y + M;
#pragma unroll
        for (int i = 0; i < 6; ++i) { d0[i] = d1[i]; d1[i] = d2[i]; }
        ab0 = ab1; ab1 = ab2;
    }
}

__device__ __forceinline__ void mlstm_C(const Params& P, int item, unsigned char* smem) {
    const int tid = threadIdx.x, lane = tid & 63, w = tid >> 6, g = lane >> 4, lr = lane & 15;
    const int wu = __builtin_amdgcn_readfirstlane(w);
    const int k = item >> 7, bhd = item & 127, b = bhd >> 4, h = (bhd >> 2) & 3, dq = bhd & 3;
    const bf16_t* z = (const bf16_t*)(P.ws + WS_Z);
    const bf16_t* qk = (const bf16_t*)(P.ws + WS_RA);
    const float* gates = (const float*)(P.ws + WS_GATES);
    bf16_t* y = (bf16_t*)(P.ws + WS_Z);
    float* ssqm = (float*)(P.ws + WS_SSQM);
    const unsigned char* sK = smem; const unsigned char* sV = smem + 16384; unsigned char* sCb = smem + 24576;
    float* ga = (float*)(smem + 36864);
    const int pos = 64 * k + 16 * w + lr;
    const bool tvalid = pos < L;
    const size_t rrow = (size_t)(b * L + (tvalid ? pos : 0));
    bf16x8 qf[4];
    {
        const bf16_t* qp = qk + rrow * 1024 + h * 128 + 8 * g;
#pragma unroll
        for (int ks = 0; ks < 4; ++ks) { qf[ks] = *(const bf16x8*)(qp + 32 * ks); if (!tvalid) qf[ks] = (bf16x8){0, 0, 0, 0, 0, 0, 0, 0}; }
    }
    uint2 og2[2];
#pragma unroll
    for (int c = 0; c < 2; ++c) og2[c] = *(const uint2*)(z + rrow * NZ + ZC_MO + h * 128 + dq * 32 + 16 * c + 4 * g);
    {
        const unsigned char* slot = P.ws + WS_CBI + ((size_t)bhd * 33 + k) * 12288;
        uint4 cb[3];
#pragma unroll
        for (int j = 0; j < 3; ++j) cb[j] = *(const uint4*)(slot + (tid + 256 * j) * 16);
        mlstm_stage_kv(P, b, h, dq, k, smem, tid);
#pragma unroll
        for (int j = 0; j < 3; ++j) *(uint4*)(sCb + (tid + 256 * j) * 16) = cb[j];
    }
    if (wu == 0) {
        const float m_prev = ((const float*)(P.ws + WS_MSC))[((size_t)bhd * 33 + k) * 4 + 2];
        const int p2 = 64 * k + lane;
        float lf = 0.f, li = -INFINITY;
        if (p2 < L) { lf = gates[(size_t)(b * L + p2) * 16 + 4 + h]; li = gates[(size_t)(b * L + p2) * 16 + h]; }
        float bc = lf;
#pragma unroll
        for (int o = 1; o < 64; o <<= 1) { const float n = __shfl_up(bc, o, 64); if (lane >= o) bc += n; }
        const float a = li - bc;
        float am = a;
#pragma unroll
        for (int o = 1; o < 64; o <<= 1) { const float n = __shfl_up(am, o, 64); if (lane >= o) am = fmaxf(am, n); }
        const float M = fmaxf(m_prev, am);
        ga[lane] = a; ga[64 + lane] = __expf(m_prev - M); ga[128 + lane] = __expf(-(bc + M)); ga[192 + lane] = M;
    }
    __syncthreads();
    const float Mt = ga[192 + 16 * w + lr], Wi = ga[64 + 16 * w + lr];
    bf16x8 pf[2];
    {
        f32x4 sa[4];
#pragma unroll
        for (int c = 0; c < 4; ++c) {
            sa[c] = (f32x4){0.f, 0.f, 0.f, 0.f};
            if (c <= wu) {
#pragma unroll
                for (int ks = 0; ks < 4; ++ks) {
                    const bf16x8 kf = *(const bf16x8*)(sK + (ks >> 1) * 8192 + vimg_off(16 * c + lr, 4 * (ks & 1) + g));
                    sa[c] = __builtin_amdgcn_mfma_f32_16x16x32_bf16(kf, qf[ks], sa[c], 0, 0, 0);
                }
                const f32x4 av = *(const f32x4*)(ga + 16 * c + 4 * g);
#pragma unroll
                for (int r = 0; r < 4; ++r) {
                    const float d = __expf(av[r] - Mt);
                    sa[c][r] = (16 * c + 4 * g + r <= 16 * w + lr) ? sa[c][r] * d : 0.f;
                }
            }
        }
#pragma unroll
        for (int s2 = 0; s2 < 2; ++s2) {
            uint4 u;
            u.x = cvt_pk_bf16(sa[2 * s2][0], sa[2 * s2][1]); u.y = cvt_pk_bf16(sa[2 * s2][2], sa[2 * s2][3]);
            u.z = cvt_pk_bf16(sa[2 * s2 + 1][0], sa[2 * s2 + 1][1]); u.w = cvt_pk_bf16(sa[2 * s2 + 1][2], sa[2 * s2 + 1][3]);
            pf[s2] = __builtin_bit_cast(bf16x8, u);
        }
    }
    f32x4 na[3];
#pragma unroll
    for (int c = 0; c < 3; ++c) {
        na[c] = (f32x4){0.f, 0.f, 0.f, 0.f};
#pragma unroll
        for (int ks = 0; ks < 4; ++ks) {
            const bf16x8 cf = *(const bf16x8*)(sCb + (ks >> 1) * 6144 + vimg_off(16 * c + lr, 4 * (ks & 1) + g));
            na[c] = __builtin_amdgcn_mfma_f32_16x16x32_bf16(cf, qf[ks], na[c], 0, 0, 0);
        }
        na[c] *= Wi;
    }
    {
        uint2 vr[3][4];
        tr_read_3c(sV, g, lr, vr);
#pragma unroll
        for (int c = 0; c < 3; ++c) {
            na[c] = __builtin_amdgcn_mfma_f32_16x16x32_bf16(tr_pair(vr[c][0], vr[c][1]), pf[0], na[c], 0, 0, 0);
            na[c] = __builtin_amdgcn_mfma_f32_16x16x32_bf16(tr_pair(vr[c][2], vr[c][3]), pf[1], na[c], 0, 0, 0);
        }
    }
    const float Et = ga[128 + 16 * w + lr];
    const float den = __shfl(na[2][0], lr, 64);
    const float rden = 1.0f / fmaxf(fabsf(den), Et);
    const float* gainp = P.m_out_norm + h * 128 + dq * 32 + 4 * g;
    float hs = 0.f;
#pragma unroll
    for (int c = 0; c < 2; ++c) {
        const uint2 og = og2[c];
        const float o0 = bflo(og.x), o1 = bfhi(og.x), o2 = bflo(og.y), o3 = bfhi(og.y);
        const float h0 = na[c][0] * rden, h1 = na[c][1] * rden, h2 = na[c][2] * rden, h3 = na[c][3] * rden;
        hs += h0 * h0 + h1 * h1 + h2 * h2 + h3 * h3;
        const float4 gn = *(const float4*)(gainp + 16 * c);
        uint2 u;
        u.x = pk2(h0 * gn.x / (1.f + __expf(-o0)), h1 * gn.y / (1.f + __expf(-o1)));
        u.y = pk2(h2 * gn.z / (1.f + __expf(-o2)), h3 * gn.w / (1.f + __expf(-o3)));
        if (tvalid) *(uint2*)(y + rrow * NZ + h * 128 + dq * 32 + 16 * c + 4 * g) = u;
    }
    hs += __shfl_xor(hs, 16, 64); hs += __shfl_xor(hs, 32, 64);
    if (tvalid && g == 0) ssqm[rrow * 16 + h * 4 + dq] = hs;
}

__device__ __forceinline__ void peer_token(const Params& P, int t, int lane, int* sidx, float* sval, int* sid, float* sgate) {
    const unsigned* tk = (const unsigned*)(P.ws + WS_TK) + (size_t)t * 256;
#pragma unroll
    for (int i = 0; i < 4; ++i) {
        const unsigned k = tk[lane * 4 + i];
        sidx[lane * 4 + i] = 127 - (int)(k & 127u);
        sval[lane * 4 + i] = unord_key(k & ~127u);
    }
    __builtin_amdgcn_s_waitcnt(0xc07f);
    __builtin_amdgcn_wave_barrier();
    if (lane < 8) {
        const int hd = lane;
        float v0[16], v1[16];
#pragma unroll
        for (int i = 0; i < 16; ++i) { v0[i] = sval[(2 * hd) * 16 + i]; v1[i] = sval[(2 * hd + 1) * 16 + i]; }
        unsigned top[16];
#pragma unroll
        for (int i = 0; i < 16; ++i) top[i] = 0u;
#pragma unroll
        for (int i = 0; i < 16; ++i)
#pragma unroll
            for (int j = 0; j < 16; ++j)
                if ((i + 1) * (j + 1) <= 16) {
                    unsigned kx = (ord_key(v0[i] + v1[j]) & ~255u) | (unsigned)(255 - (i * 16 + j));
#pragma unroll
                    for (int q = 0; q < 16; ++q) { const unsigned hi = max(top[q], kx), lo = min(top[q], kx); top[q] = hi; kx = lo; }
                }
        const float smax = unord_key(top[0] & ~255u);
        float e[16]; float den = 0.f;
#pragma unroll
        for (int q = 0; q < 16; ++q) { e[q] = __expf(unord_key(top[q] & ~255u) - smax); den += e[q]; }
        const float inv = 1.f / den;
#pragma unroll
        for (int q = 0; q < 16; ++q) {
            const int pos = 255 - (int)(top[q] & 255u), i = pos >> 4, j = pos & 15;
            sid[hd * 16 + q] = sidx[(2 * hd) * 16 + i] * 128 + sidx[(2 * hd + 1) * 16 + j];
            sgate[hd * 16 + q] = e[q] * inv;
        }
    }
    __builtin_amdgcn_s_waitcnt(0xc07f);
    __builtin_amdgcn_wave_barrier();
    const bf16_t* xn = (const bf16_t*)(P.ws + WS_XN) + (size_t)t * DM;
    const float rstd = ((const float*)(P.ws + WS_RSTD))[t];
    const unsigned char* U = P.ws + WS_U + lane * 8;
    const unsigned char* V = P.ws + WS_V + lane * 8;
    const float* usc = (const float*)(P.ws + WS_USC);
    const float* vsc = (const float*)(P.ws + WS_VSC);
    float xf[16];
    {
        const uint4 xa = *(const uint4*)(xn + lane * 16), xb = *(const uint4*)(xn + lane * 16 + 8);
        xf[0] = bflo(xa.x); xf[1] = bfhi(xa.x); xf[2] = bflo(xa.y); xf[3] = bfhi(xa.y); xf[4] = bflo(xa.z); xf[5] = bfhi(xa.z); xf[6] = bflo(xa.w); xf[7] = bfhi(xa.w);
        xf[8] = bflo(xb.x); xf[9] = bfhi(xb.x); xf[10] = bflo(xb.y); xf[11] = bfhi(xb.y); xf[12] = bflo(xb.z); xf[13] = bfhi(xb.z); xf[14] = bflo(xb.w); xf[15] = bfhi(xb.w);
    }
    float acc[16];
#pragma unroll
    for (int j = 0; j < 16; ++j) acc[j] = 0.f;
    const int myq = ((lane >> 5) & 1) * 8 + ((lane >> 4) & 1) * 4 + ((lane >> 3) & 1) * 2 + ((lane >> 2) & 1);
#pragma unroll 1
    for (int e0 = 0; e0 < 128; e0 += 16) {
        uint2 ur[16], vr[16];
#pragma unroll
        for (int q = 0; q < 16; ++q) {
            const int id = sid[e0 + q];
            ur[q] = *(const uint2*)(U + (size_t)id * 512);
            vr[q] = *(const uint2*)(V + (size_t)id * 512);
        }
        const int myid = sid[e0 + myq];
        const float mysc = usc[myid] * rstd, myvs = vsc[myid] * sgate[e0 + myq];
        float d[16];
#pragma unroll
        for (int q = 0; q < 16; ++q) {
            float s0 = 0.f;
#define FP4_DOT(k) { const f32x2 a = __builtin_amdgcn_cvt_scalef32_pk_f32_fp4(ur[q].x, 1.0f, k), c = __builtin_amdgcn_cvt_scalef32_pk_f32_fp4(ur[q].y, 1.0f, k); \
                     s0 += xf[2 * k] * a.x + xf[2 * k + 1] * a.y + xf[8 + 2 * k] * c.x + xf[8 + 2 * k + 1] * c.y; }
            FP4_DOT(0) FP4_DOT(1) FP4_DOT(2) FP4_DOT(3)
#undef FP4_DOT
            d[q] = s0;
        }
        float r8[8], r4[4], r2[2], r1;
#pragma unroll
        for (int i = 0; i < 8; ++i) { const bool up = (lane & 32) != 0; const float keep = up ? d[i + 8] : d[i], send = up ? d[i] : d[i + 8]; r8[i] = keep + __shfl_xor(send, 32, 64); }
#pragma unroll
        for (int i = 0; i < 4; ++i) { const bool up = (lane & 16) != 0; const float keep = up ? r8[i + 4] : r8[i], send = up ? r8[i] : r8[i + 4]; r4[i] = keep + __shfl_xor(send, 16, 64); }
#pragma unroll
        for (int i = 0; i < 2; ++i) { const bool up = (lane & 8) != 0; const float keep = up ? r4[i + 2] : r4[i], send = up ? r4[i] : r4[i + 2]; r2[i] = keep + __shfl_xor(send, 8, 64); }
        { const bool up = (lane & 4) != 0; const float keep = up ? r2[1] : r2[0], send = up ? r2[0] : r2[1]; r1 = keep + __shfl_xor(send, 4, 64); }
        r1 += __shfl_xor(r1, 2, 64); r1 += __shfl_xor(r1, 1, 64);
        const float a = r1 * mysc;
        const float wmine = myvs * 0.5f * a * (1.f + erff(a * 0.70710678118654752f));
#pragma unroll
        for (int q = 0; q < 16; ++q) {
            const float w = __shfl(wmine, ((q >> 3) & 1) * 32 + ((q >> 2) & 1) * 16 + ((q >> 1) & 1) * 8 + (q & 1) * 4, 64);
#define FP4_AXPY(k) { const f32x2 a2 = __builtin_amdgcn_cvt_scalef32_pk_f32_fp4(vr[q].x, 1.0f, k), c2 = __builtin_amdgcn_cvt_scalef32_pk_f32_fp4(vr[q].y, 1.0f, k); \
                      acc[2 * k] += w * a2.x; acc[2 * k + 1] += w * a2.y; acc[8 + 2 * k] += w * c2.x; acc[8 + 2 * k + 1] += w * c2.y; }
            FP4_AXPY(0) FP4_AXPY(1) FP4_AXPY(2) FP4_AXPY(3)
#undef FP4_AXPY
        }
    }
    float* o = P.out + (size_t)t * DM + lane * 16;
    float4 h0 = *(float4*)(o), h1 = *(float4*)(o + 4), h2 = *(float4*)(o + 8), h3 = *(float4*)(o + 12);
    h0.x += acc[0]; h0.y += acc[1]; h0.z += acc[2]; h0.w += acc[3]; h1.x += acc[4]; h1.y += acc[5]; h1.z += acc[6]; h1.w += acc[7];
    h2.x += acc[8]; h2.y += acc[9]; h2.z += acc[10]; h2.w += acc[11]; h3.x += acc[12]; h3.y += acc[13]; h3.z += acc[14]; h3.w += acc[15];
    *(float4*)(o) = h0; *(float4*)(o + 4) = h1; *(float4*)(o + 8) = h2; *(float4*)(o + 12) = h3;
    __builtin_amdgcn_s_waitcnt(0xc07f);
    __builtin_amdgcn_wave_barrier();
}

#define LAS __attribute__((address_space(3)))
#define XB_TMO      128
#define XB_XCNT(j)  (256  + 64 * (j))
#define XB_XSUB(j)  (1280 + 64 * (j))
#define XB_XGEN(j)  (2304 + 64 * (j))
#define XB_TOP      3328
#define XB_TOPGEN   3392
#define XCD_BAR_WORDS 3456
#define XB_SPIN_CAP (1u << 18)
__device__ __forceinline__ unsigned xb_ld(unsigned* p)              { return __hip_atomic_load(p, __ATOMIC_RELAXED, __HIP_MEMORY_SCOPE_AGENT); }
__device__ __forceinline__ unsigned xb_add(unsigned* p, unsigned v) { return __hip_atomic_fetch_add(p, v, __ATOMIC_RELAXED, __HIP_MEMORY_SCOPE_AGENT); }
__device__ __forceinline__ unsigned xb_xcc_id() { return (unsigned)__builtin_amdgcn_s_getreg((3 << 11) | 20) & 0xFu; }
#define XB_SPIN(cond, bar) do { unsigned _sp = 0; while (cond) { __builtin_amdgcn_s_sleep(1); \
    if ((++_sp & 255u) == 0u) { if (xb_ld(&(bar)[XB_TMO])) break; if (_sp > XB_SPIN_CAP) { atomicAdd(&(bar)[XB_TMO], 1u); break; } } } } while (0)
struct XcdBarrier { unsigned* bar; unsigned x; volatile LAS unsigned* st; };
__device__ __forceinline__ XcdBarrier xcd_barrier_post(unsigned* bar, volatile LAS unsigned* st) {
    XcdBarrier b; b.bar = bar; b.x = xb_xcc_id(); b.st = st;
    if (threadIdx.x == 0) (void)xb_add(&bar[XB_XCNT(b.x)], 1u);
    return b;
}
__device__ __forceinline__ void xcd_barrier_complete(unsigned* bar, unsigned x, unsigned& nloc, unsigned& nx) {
    const unsigned G = gridDim.x * gridDim.y * gridDim.z;
    unsigned sum, cnt, mine, sp = 0u;
    for (;;) {
        sum = 0u; cnt = 0u; mine = 0u;
#pragma unroll
        for (unsigned j = 0; j < 16; ++j) { const unsigned c = xb_ld(&bar[XB_XCNT(j)]); sum += c; cnt += (c > 0u) ? 1u : 0u; mine = (j == x) ? c : mine; }
        if (sum == G) break;
        __builtin_amdgcn_s_sleep(1);
        if ((++sp & 255u) == 0u) { if (xb_ld(&bar[XB_TMO])) break; if (sp > XB_SPIN_CAP) { atomicAdd(&bar[XB_TMO], 1u); break; } }
    }
    nloc = mine > 0u ? mine : 1u; nx = cnt > 0u ? cnt : 1u;
}
__device__ __forceinline__ void xcd_barrier(const XcdBarrier& b) {
    asm volatile("s_waitcnt vmcnt(0)" ::: "memory");
    __syncthreads();
    if (threadIdx.x == 0) {
        unsigned* bar = b.bar;
        __builtin_amdgcn_s_waitcnt(0);
        unsigned nloc = b.st[0], nx = b.st[1];
        if (nloc == 0u) { xcd_barrier_complete(bar, b.x, nloc, nx); b.st[0] = nloc; b.st[1] = nx; }
        const unsigned old = xb_add(&bar[XB_XSUB(b.x)], 1u);
        const unsigned gen = old / nloc;
        if (old + 1u == (gen + 1u) * nloc) {
            __builtin_amdgcn_fence(__ATOMIC_RELEASE, "agent");
            asm volatile("s_waitcnt vmcnt(0)" ::: "memory");
            const unsigned og = xb_add(&bar[XB_TOP], 1u);
            const unsigned tg = og / nx;
            if (og + 1u == (tg + 1u) * nx) xb_add(&bar[XB_TOPGEN], 1u);
            else XB_SPIN(xb_ld(&bar[XB_TOPGEN]) == tg, bar);
            __builtin_amdgcn_fence(__ATOMIC_ACQUIRE, "agent");
            xb_add(&bar[XB_XGEN(b.x)], 1u);
            asm volatile("s_waitcnt vmcnt(0)" ::: "memory");
        } else {
            XB_SPIN(xb_ld(&bar[XB_XGEN(b.x)]) == gen, bar);
            __builtin_amdgcn_fence(__ATOMIC_ACQUIRE, "agent");
            asm volatile("s_waitcnt vmcnt(0)" ::: "memory");
        }
    }
    __syncthreads();
}

__device__ __forceinline__ void hand_release() { asm volatile("s_waitcnt vmcnt(0)" ::: "memory"); __builtin_amdgcn_fence(__ATOMIC_RELEASE, "agent"); asm volatile("s_waitcnt vmcnt(0)" ::: "memory"); }
__device__ __forceinline__ void hand_acquire() { __builtin_amdgcn_fence(__ATOMIC_ACQUIRE, "agent"); asm volatile("s_waitcnt vmcnt(0)" ::: "memory"); }

__global__ void __launch_bounds__(256, 2) mega(Params P) {
    extern __shared__ __attribute__((aligned(16))) unsigned char smem[];
    cg::grid_group grid = cg::this_grid();
    const int tid = threadIdx.x, lane = tid & 63, wave = tid >> 6;
    const int G = gridDim.x, bid = blockIdx.x;
    unsigned* ctl = (unsigned*)(P.ws + WS_CTL);
    volatile LAS unsigned* bst = (volatile LAS unsigned*)(smem + 65552);
    if (tid == 0) { bst[0] = 0u; bst[1] = 0u; }
    __syncthreads();
    phase0(P, smem);
    grid.sync();
    const XcdBarrier xb = xcd_barrier_post(ctl + 1024, bst);
    {
        const int gw = bid * 4 + wave;
        if (gw < 64) fox_cum_wave(P, gw, lane);
        for (int tile = bid; tile < 129 * 28; tile += G) gemm_tile<1>(P, tile / 28, tile % 28, smem);
    }
    xcd_barrier(xb);
    {
        volatile int* s_item = (volatile int*)(smem + 65536);
        const int wave_u = __builtin_amdgcn_readfirstlane(wave);
        auto fetch = [&](unsigned* counter) -> int {
            if (wave_u == 0) {
                unsigned v = atomicAdd(counter, lane == 0 ? 1u : 0u);
                *s_item = (int)__builtin_amdgcn_readfirstlane(v);
            }
            __syncthreads();
            const int item = __builtin_amdgcn_readfirstlane(*s_item);
            __syncthreads();
            return item;
        };
        for (;;) {
            const int item = fetch(&ctl[0]);
            if (item >= 258) break;
            conv_item(P, item);
        }
        xcd_barrier(xb);
        for (;;) {
            const int item = fetch(&ctl[2]);
            if (item >= 33 * 128) break;
            mlstm_A(P, item, smem);
        }
        xcd_barrier(xb);
        for (;;) {
            const int item = fetch(&ctl[4]);
            if (item >= 128) break;
            mlstm_B(P, item);
        }
        for (;;) {
            const int item = fetch(&ctl[3]);
            if (item >= 64 * 33) break;
            attn_block(P, item & 63, 32 - (item >> 6), smem);
        }
        xcd_barrier(xb);
        for (;;) {
            const int item = fetch(&ctl[5]);
            if (item >= 33 * 128) break;
            mlstm_C(P, item, smem);
        }
    }
    xcd_barrier(xb);
    for (int tile = bid; tile < 128 * 8; tile += G) gemm_tile<2>(P, tile >> 3, tile & 7, smem);
    convert_uv_rows(P, bid * 4 + wave, G * 4, lane);
    xcd_barrier(xb);
    for (int tile = bid; tile < 128 * 16; tile += G) gemm_tile<3>(P, tile >> 4, tile & 15, smem);
    xcd_barrier(xb);
    {
        int* sidx = (int*)(smem + wave * 3072); float* sval = (float*)(smem + wave * 3072 + 1024);
        int* sid = (int*)(smem + wave * 3072 + 2048); float* sgate = (float*)(smem + wave * 3072 + 2560);
        for (int t = bid * 4 + wave; t < T2; t += G * 4) peer_token(P, t, lane, sidx, sval, sid, sgate);
    }
}

}

extern "C" void kernel_launch(void* const* d_in, const int* in_sizes, int n_in, void* d_out, int out_size, void* d_ws, size_t ws_size, hipStream_t stream) {
    if (n_in != 17 || ws_size < WS_END) { fprintf(stderr, "kernel_launch: unexpected n_in %d or ws_size %zu (need %zu)\n", n_in, ws_size, (size_t)WS_END); return; }
    constexpr int LDS_BYTES = 66560;
    static int grid_blocks = 0;
    if (!grid_blocks) {
        int dev = 0, cus = 0, per_cu = 0;
        (void)hipGetDevice(&dev);
        (void)hipDeviceGetAttribute(&cus, hipDeviceAttributeMultiprocessorCount, dev);
        (void)hipFuncSetAttribute((const void*)mega, hipFuncAttributeMaxDynamicSharedMemorySize, LDS_BYTES);
        (void)hipOccupancyMaxActiveBlocksPerMultiprocessor(&per_cu, (const void*)mega, 256, LDS_BYTES);
        if (per_cu < 1) per_cu = 1;
        if (per_cu > 2) per_cu = 2;
        grid_blocks = cus * per_cu;
        fprintf(stderr, "kernel_launch: cus %d per_cu %d grid %d\n", cus, per_cu, grid_blocks);
    }
    Params P{};
    P.x = (const float*)d_in[0]; P.meta = (const float*)d_in[1]; P.norm_mix = (const float*)d_in[2]; P.w_in = (const float*)d_in[3];
    P.conv_qk = (const float*)d_in[4]; P.b_igate = (const float*)d_in[5]; P.b_fgate_m = (const float*)d_in[6]; P.m_out_norm = (const float*)d_in[7];
    P.b_fgate_f = (const float*)d_in[8]; P.f_q_norm = (const float*)d_in[9]; P.f_k_norm = (const float*)d_in[10]; P.w_out = (const float*)d_in[11];
    P.norm_ffn = (const float*)d_in[12]; P.peer_query = (const float*)d_in[13]; P.peer_keys = (const float*)d_in[14]; P.peer_u = (const float*)d_in[15];
    P.peer_v = (const float*)d_in[16]; P.out = (float*)d_out; P.ws = (unsigned char*)d_ws;
    void* args[] = {&P};
    hipError_t e = hipLaunchCooperativeKernel((const void*)mega, dim3(grid_blocks), dim3(256), args, LDS_BYTES, stream);
    if (e != hipSuccess) fprintf(stderr, "cooperative launch failed: %s (grid %d)\n", hipGetErrorString(e), grid_blocks);
}
```

```cpp
#include <hip/hip_runtime.h>
#include <stdint.h>
#include <stdio.h>
#include <hip/hip_cooperative_groups.h>
namespace cg = cooperative_groups;

namespace {

constexpr int NB = 8, SEQ = 2048, DM = 1024, NMETA = 16, L = SEQ + NMETA;
constexpr int T1 = NB * L;
constexpr int T2 = NB * SEQ;
constexpr int NZ = 3584;
constexpr int ZC_MQ = 0, ZC_MK = 512, ZC_MV = 1024, ZC_MO = 1536, ZC_FQ = 2048, ZC_FK = 2560, ZC_FV = 3072;
constexpr int PROJ = 3600;
constexpr float EPS = 1e-6f;

constexpr size_t WS_CTL = 0;
constexpr size_t WS_RA = 65536;
constexpr size_t WS_Z = WS_RA + (size_t)T1 * DM * 2;
constexpr size_t WS_GATES = WS_Z + (size_t)T1 * NZ * 2;
constexpr size_t WS_CUM = WS_GATES + (size_t)T1 * 16 * 4;
constexpr size_t WS_SSQ = WS_CUM + (size_t)NB * 8 * L * 4;
constexpr size_t WS_RSTD = WS_SSQ + (size_t)T2 * 16 * 4;
constexpr size_t WS_SSQM = WS_RSTD + (size_t)T2 * 4;
constexpr size_t WS_BT2 = WS_SSQM + (size_t)T1 * 16 * 4;
constexpr size_t WS_BT3 = WS_BT2 + (size_t)DM * DM * 2;
constexpr size_t WS_KEYS = WS_BT3 + (size_t)2048 * DM * 2;
constexpr size_t WS_MSC = WS_KEYS + (size_t)16 * 128 * 128 * 2;
constexpr size_t WS_MST = WS_MSC + (size_t)128 * 33 * 16;
constexpr size_t WS_BT1 = WS_MST + (size_t)128 * 33 * 12288;
constexpr size_t WS_CBI = WS_BT1;
constexpr size_t WS_END = WS_CBI + (size_t)128 * 33 * 12288;
constexpr size_t WS_XN = WS_RA;
constexpr size_t WS_U = WS_MST;
constexpr size_t WS_V = WS_U + (size_t)16384 * 512;
constexpr size_t WS_USC = WS_V + (size_t)16384 * 512;
constexpr size_t WS_VSC = WS_USC + (size_t)16384 * 4;
constexpr size_t WS_TK = WS_CBI;
constexpr float LOG2E = 1.4426950408889634f;

typedef unsigned short bf16_t;
typedef short bf16x8 __attribute__((ext_vector_type(8)));
typedef float f32x4 __attribute__((ext_vector_type(4)));
typedef __attribute__((ext_vector_type(2))) __bf16 bf16x2_t;

struct Params {
    const float* x; const float* meta; const float* norm_mix; const float* w_in; const float* conv_qk;
    const float* b_igate; const float* b_fgate_m; const float* m_out_norm; const float* b_fgate_f;
    const float* f_q_norm; const float* f_k_norm; const float* w_out; const float* norm_ffn;
    const float* peer_query; const float* peer_keys; const float* peer_u; const float* peer_v;
    float* out; unsigned char* ws;
};

__device__ __forceinline__ unsigned f2bf(float f) { unsigned u = __float_as_uint(f); return (u + 0x7fffu + ((u >> 16) & 1u)) >> 16; }
__device__ __forceinline__ float bf2f(unsigned h) { return __uint_as_float(h << 16); }
typedef float f32x2 __attribute__((ext_vector_type(2)));
typedef __bf16 bf16x2v __attribute__((ext_vector_type(2)));
__device__ __forceinline__ unsigned cvt_pk_bf16(float lo, float hi) { f32x2 v = {lo, hi}; bf16x2v b = __builtin_convertvector(v, bf16x2v); return __builtin_bit_cast(unsigned, b); }
__device__ __forceinline__ unsigned pk2(float lo, float hi) { return cvt_pk_bf16(lo, hi); }
__device__ __forceinline__ float bflo(unsigned w) { return __uint_as_float(w << 16); }
__device__ __forceinline__ float bfhi(unsigned w) { return __uint_as_float(w & 0xffff0000u); }
__device__ __forceinline__ float wave_sum(float v) {
#pragma unroll
    for (int o = 32; o > 0; o >>= 1) v += __shfl_xor(v, o, 64);
    return v;
}
__device__ __forceinline__ float wave_max(float v) {
#pragma unroll
    for (int o = 32; o > 0; o >>= 1) v = fmaxf(v, __shfl_xor(v, o, 64));
    return v;
}
__device__ __forceinline__ float logsigmoidf(float x) { return fminf(x, 0.f) - log1pf(expf(-fabsf(x))); }
__device__ __forceinline__ unsigned ord_key(float f) { unsigned u = __float_as_uint(f); return u ^ ((u >> 31) ? 0xffffffffu : 0x80000000u); }
__device__ __forceinline__ float unord_key(unsigned k) { unsigned u = (k & 0x80000000u) ? (k ^ 0x80000000u) : ~k; return __uint_as_float(u); }

__device__ __forceinline__ void phase0(const Params& P, unsigned char* smem) {
    const int tid = threadIdx.x, lane = tid & 63, wave = tid >> 6;
    unsigned* ctl = (unsigned*)(P.ws + WS_CTL);
    if (blockIdx.x == 0) for (int i = tid; i < 8192; i += 256) ctl[i] = 0u;
    float* gw = (float*)smem;
    for (int idx = tid; idx < 16 * 1024; idx += 256) {
        const int k = idx >> 4, c = idx & 15;
        const int col = c < 8 ? 2048 + c : 3592 + (c - 8);
        gw[c * 1024 + k] = P.w_in[(size_t)k * PROJ + col];
    }
    __syncthreads();
    {
        bf16_t* hn = (bf16_t*)(P.ws + WS_RA);
        float* gates = (float*)(P.ws + WS_GATES);
        const int c0 = lane * 8, c1 = 512 + lane * 8;
        for (int r = blockIdx.x * 4 + wave; r < T1; r += gridDim.x * 4) {
            const int b = r / L, p = r - b * L;
            const float* src = (p < NMETA) ? (P.meta + (size_t)p * DM) : (P.x + ((size_t)b * SEQ + (p - NMETA)) * DM);
            float v[16];
            {
                const float4 a0 = *(const float4*)(src + c0), a1 = *(const float4*)(src + c0 + 4);
                const float4 a2 = *(const float4*)(src + c1), a3 = *(const float4*)(src + c1 + 4);
                v[0] = a0.x; v[1] = a0.y; v[2] = a0.z; v[3] = a0.w; v[4] = a1.x; v[5] = a1.y; v[6] = a1.z; v[7] = a1.w;
                v[8] = a2.x; v[9] = a2.y; v[10] = a2.z; v[11] = a2.w; v[12] = a3.x; v[13] = a3.y; v[14] = a3.z; v[15] = a3.w;
            }
            float ss = 0.f;
#pragma unroll
            for (int j = 0; j < 16; ++j) ss += v[j] * v[j];
            ss = wave_sum(ss);
            const float rstd = rsqrtf(ss * (1.0f / DM) + EPS);
            {
                const float4 a0 = *(const float4*)(P.norm_mix + c0), a1 = *(const float4*)(P.norm_mix + c0 + 4);
                const float4 a2 = *(const float4*)(P.norm_mix + c1), a3 = *(const float4*)(P.norm_mix + c1 + 4);
                v[0] *= rstd * a0.x; v[1] *= rstd * a0.y; v[2] *= rstd * a0.z; v[3] *= rstd * a0.w; v[4] *= rstd * a1.x; v[5] *= rstd * a1.y; v[6] *= rstd * a1.z; v[7] *= rstd * a1.w;
                v[8] *= rstd * a2.x; v[9] *= rstd * a2.y; v[10] *= rstd * a2.z; v[11] *= rstd * a2.w; v[12] *= rstd * a3.x; v[13] *= rstd * a3.y; v[14] *= rstd * a3.z; v[15] *= rstd * a3.w;
            }
            uint4 o0, o1;
            o0.x = pk2(v[0], v[1]); o0.y = pk2(v[2], v[3]); o0.z = pk2(v[4], v[5]); o0.w = pk2(v[6], v[7]);
            o1.x = pk2(v[8], v[9]); o1.y = pk2(v[10], v[11]); o1.z = pk2(v[12], v[13]); o1.w = pk2(v[14], v[15]);
            *(uint4*)(hn + (size_t)r * DM + c0) = o0;
            *(uint4*)(hn + (size_t)r * DM + c1) = o1;
            float mine = 0.f;
#pragma unroll 1
            for (int c = 0; c < 16; ++c) {
                const float* gwc = gw + c * 1024;
                const float4 w0 = *(const float4*)(gwc + c0), w1 = *(const float4*)(gwc + c0 + 4), w2 = *(const float4*)(gwc + c1), w3 = *(const float4*)(gwc + c1 + 4);
                float s = v[0] * w0.x + v[1] * w0.y + v[2] * w0.z + v[3] * w0.w + v[4] * w1.x + v[5] * w1.y + v[6] * w1.z + v[7] * w1.w
                        + v[8] * w2.x + v[9] * w2.y + v[10] * w2.z + v[11] * w2.w + v[12] * w3.x + v[13] * w3.y + v[14] * w3.z + v[15] * w3.w;
                s = wave_sum(s);
                if (lane == c) mine = s;
            }
            if (lane < 16) {
                float val;
                if (lane < 4) val = mine + P.b_igate[lane];
                else if (lane < 8) val = logsigmoidf(mine + P.b_fgate_m[lane - 4]);
                else val = logsigmoidf(mine + P.b_fgate_f[lane - 8]);
                gates[(size_t)r * 16 + lane] = val;
            }
        }
    }
    __syncthreads();
    {
        float (*tile)[65] = (float (*)[65])smem;
        for (int item = blockIdx.x; item < 1664; item += gridDim.x) {
            const float* W; int ldn, ntn, shift_from, it; bf16_t* out;
            if (item < 896) { W = P.w_in; ldn = PROJ; ntn = 56; shift_from = 2048; it = item; out = (bf16_t*)(P.ws + WS_BT1); }
            else if (item < 1152) { W = P.w_out; ldn = 1024; ntn = 16; shift_from = 1 << 30; it = item - 896; out = (bf16_t*)(P.ws + WS_BT2); }
            else { W = P.peer_query; ldn = 2048; ntn = 32; shift_from = 1 << 30; it = item - 1152; out = (bf16_t*)(P.ws + WS_BT3); }
            const int tk = it / ntn, tn = it - tk * ntn, k0 = tk * 64, n0 = tn * 64;
            {
                const int nl = tid & 63;
                int n = n0 + nl; if (n >= shift_from) n += 8;
#pragma unroll
                for (int i = 0; i < 16; ++i) { const int kl = (tid >> 6) + 4 * i; tile[kl][nl] = W[(size_t)(k0 + kl) * ldn + n]; }
            }
            __syncthreads();
            {
                const int kl = tid & 63;
#pragma unroll
                for (int i = 0; i < 16; ++i) { const int nl = (tid >> 6) + 4 * i; out[(size_t)(n0 + nl) * 1024 + k0 + kl] = (bf16_t)f2bf(tile[kl][nl]); }
            }
            __syncthreads();
        }
    }
    {
        const size_t gt = (size_t)blockIdx.x * 256 + tid, gs = (size_t)gridDim.x * 256;
        const float* src = P.peer_keys; bf16_t* dst = (bf16_t*)(P.ws + WS_KEYS);
        for (size_t i = gt; i < (size_t)(16 * 128 * 128 / 8); i += gs) {
            const float4 a = *(const float4*)(src + i * 8), b = *(const float4*)(src + i * 8 + 4);
            uint4 o; o.x = pk2(a.x, a.y); o.y = pk2(a.z, a.w); o.z = pk2(b.x, b.y); o.w = pk2(b.z, b.w);
            *(uint4*)(dst + i * 8) = o;
        }
    }
}

__device__ __forceinline__ void convert_uv_rows(const Params& P, int gwave, int nwaves, int lane) {
    for (int rr = gwave; rr < 2 * 16384; rr += nwaves) {
        const int which = rr >> 14, row = rr & 16383;
        const float* src = (which ? P.peer_v : P.peer_u) + (size_t)row * DM + lane * 16;
        const float4 a0 = *(const float4*)(src), a1 = *(const float4*)(src + 4), a2 = *(const float4*)(src + 8), a3 = *(const float4*)(src + 12);
        float mx = fmaxf(fmaxf(fmaxf(fabsf(a0.x), fabsf(a0.y)), fmaxf(fabsf(a0.z), fabsf(a0.w))), fmaxf(fmaxf(fabsf(a1.x), fabsf(a1.y)), fmaxf(fabsf(a1.z), fabsf(a1.w))));
        mx = fmaxf(mx, fmaxf(fmaxf(fmaxf(fabsf(a2.x), fabsf(a2.y)), fmaxf(fabsf(a2.z), fabsf(a2.w))), fmaxf(fmaxf(fabsf(a3.x), fabsf(a3.y)), fmaxf(fabsf(a3.z), fabsf(a3.w)))));
        mx = wave_max(mx);
        const float sc = mx > 0.f ? 6.0f / mx : 1.0f;
        unsigned w0 = 0u, w1 = 0u;
        w0 = __builtin_amdgcn_cvt_scalef32_pk_fp4_f32(w0, a0.x * sc, a0.y * sc, 1.0f, 0); w0 = __builtin_amdgcn_cvt_scalef32_pk_fp4_f32(w0, a0.z * sc, a0.w * sc, 1.0f, 1);
        w0 = __builtin_amdgcn_cvt_scalef32_pk_fp4_f32(w0, a1.x * sc, a1.y * sc, 1.0f, 2); w0 = __builtin_amdgcn_cvt_scalef32_pk_fp4_f32(w0, a1.z * sc, a1.w * sc, 1.0f, 3);
        w1 = __builtin_amdgcn_cvt_scalef32_pk_fp4_f32(w1, a2.x * sc, a2.y * sc, 1.0f, 0); w1 = __builtin_amdgcn_cvt_scalef32_pk_fp4_f32(w1, a2.z * sc, a2.w * sc, 1.0f, 1);
        w1 = __builtin_amdgcn_cvt_scalef32_pk_fp4_f32(w1, a3.x * sc, a3.y * sc, 1.0f, 2); w1 = __builtin_amdgcn_cvt_scalef32_pk_fp4_f32(w1, a3.z * sc, a3.w * sc, 1.0f, 3);
        *(uint2*)(P.ws + (which ? WS_V : WS_U) + (size_t)row * 512 + lane * 8) = make_uint2(w0, w1);
        if (lane == 0) ((float*)(P.ws + (which ? WS_VSC : WS_USC)))[row] = mx > 0.f ? mx * (1.0f / 6.0f) : 1.0f;
    }
}

__device__ __forceinline__ void mma_ktile(const unsigned char* sA, const unsigned char* sB, int arow_off, int brow_off, int g, int sw, f32x4 (&acc)[4][4]) {
#pragma unroll
    for (int s = 0; s < 2; ++s) {
        bf16x8 a[4], b[4];
        const int ch = (((s * 4 + g) ^ sw) << 4);
#pragma unroll
        for (int i = 0; i < 4; ++i) a[i] = *(const bf16x8*)(sA + arow_off + i * 2048 + ch);
#pragma unroll
        for (int j = 0; j < 4; ++j) b[j] = *(const bf16x8*)(sB + brow_off + j * 2048 + ch);
#pragma unroll
        for (int i = 0; i < 4; ++i)
#pragma unroll
            for (int j = 0; j < 4; ++j) acc[i][j] = __builtin_amdgcn_mfma_f32_16x16x32_bf16(b[j], a[i], acc[i][j], 0, 0, 0);
    }
}

__device__ __forceinline__ void store_tile_bf16(const f32x4 (&acc)[4][4], unsigned char* smem, bf16_t* dst, size_t ld, int m0, int n0, int tid, int wr, int wc, int g, int lr) {
#pragma unroll
    for (int i = 0; i < 4; ++i)
#pragma unroll
        for (int j = 0; j < 4; ++j) {
            const int row = wr * 64 + 16 * i + lr, col = wc * 64 + 16 * j + 4 * g;
            uint2 w; w.x = pk2(acc[i][j][0], acc[i][j][1]); w.y = pk2(acc[i][j][2], acc[i][j][3]);
            *(uint2*)(smem + row * 272 + col * 2) = w;
        }
    __syncthreads();
#pragma unroll
    for (int q = 0; q < 8; ++q) {
        const int id = tid + 256 * q, row = id >> 4, ch = id & 15;
        const uint4 v = *(const uint4*)(smem + row * 272 + ch * 16);
        *(uint4*)(dst + (size_t)(m0 + row) * ld + n0 + ch * 8) = v;
    }
    __syncthreads();
}

template <int MODE>
__device__ __forceinline__ void gemm_tile(const Params& P, int tm, int tn, unsigned char* smem) {
    const bf16_t* A; const bf16_t* Bt;
    if (MODE == 1) { A = (const bf16_t*)(P.ws + WS_RA); Bt = (const bf16_t*)(P.ws + WS_BT1); }
    else if (MODE == 2) { A = (const bf16_t*)(P.ws + WS_Z); Bt = (const bf16_t*)(P.ws + WS_BT2); }
    else { A = (const bf16_t*)(P.ws + WS_XN); Bt = (const bf16_t*)(P.ws + WS_BT3); }
    const int tid = threadIdx.x, lane = tid & 63, wave = tid >> 6, wr = wave >> 1, wc = wave & 1, g = lane >> 4, lr = lane & 15;
    const int m0 = tm * 128, n0 = tn * 128;
    const int srow = tid >> 3, sc = tid & 7;
    const bf16_t* aptr[4]; const bf16_t* bptr[4]; int soff[4];
#pragma unroll
    for (int j = 0; j < 4; ++j) {
        const int row = srow + 32 * j;
        int ar = m0 + row;
        if (MODE == 2) { const int b = ar >> 11, t = ar & 2047; ar = b * L + NMETA + t; }
        aptr[j] = A + (size_t)ar * (MODE == 2 ? NZ : 1024) + sc * 8;
        bptr[j] = Bt + (size_t)(n0 + row) * 1024 + sc * 8;
        soff[j] = row * 128 + ((sc ^ (row & 7)) << 4);
    }
    f32x4 acc[4][4];
#pragma unroll
    for (int i = 0; i < 4; ++i)
#pragma unroll
        for (int j = 0; j < 4; ++j) acc[i][j] = (f32x4){0.f, 0.f, 0.f, 0.f};
    uint4 ra[4], rb[4];
#pragma unroll
    for (int j = 0; j < 4; ++j) { ra[j] = *(const uint4*)(aptr[j]); rb[j] = *(const uint4*)(bptr[j]); }
    unsigned char* sA0 = smem; unsigned char* sB0 = smem + 16384; unsigned char* sA1 = smem + 32768; unsigned char* sB1 = smem + 49152;
#pragma unroll
    for (int j = 0; j < 4; ++j) { *(uint4*)(sA0 + soff[j]) = ra[j]; *(uint4*)(sB0 + soff[j]) = rb[j]; }
    __syncthreads();
    const int arow_off = (wr * 64 + lr) * 128, brow_off = (wc * 64 + lr) * 128, sw = lr & 7;
    for (int kt = 0; kt < 16; ++kt) {
        unsigned char* sA = (kt & 1) ? sA1 : sA0; unsigned char* sB = (kt & 1) ? sB1 : sB0;
        unsigned char* nA = (kt & 1) ? sA0 : sA1; unsigned char* nB = (kt & 1) ? sB0 : sB1;
        if (kt < 15) {
#pragma unroll
            for (int j = 0; j < 4; ++j) { ra[j] = *(const uint4*)(aptr[j] + (kt + 1) * 64); rb[j] = *(const uint4*)(bptr[j] + (kt + 1) * 64); }
        }
        mma_ktile(sA, sB, arow_off, brow_off, g, sw, acc);
        if (kt < 15) {
#pragma unroll
            for (int j = 0; j < 4; ++j) { *(uint4*)(nA + soff[j]) = ra[j]; *(uint4*)(nB + soff[j]) = rb[j]; }
        }
        __syncthreads();
    }
    if (MODE == 1) {
        if (n0 >= ZC_FQ && n0 < ZC_FV) {
            const bool isk = n0 >= ZC_FK;
            const float* gain = isk ? P.f_k_norm : P.f_q_norm;
            const float scl = isk ? 1.0f : 0.125f * LOG2E;
            float gn[4][4];
#pragma unroll
            for (int j = 0; j < 4; ++j)
#pragma unroll
                for (int r = 0; r < 4; ++r) gn[j][r] = gain[16 * j + 4 * g + r];
#pragma unroll
            for (int i = 0; i < 4; ++i) {
                float ss = 0.f;
#pragma unroll
                for (int j = 0; j < 4; ++j)
#pragma unroll
                    for (int r = 0; r < 4; ++r) ss += acc[i][j][r] * acc[i][j][r];
                ss += __shfl_xor(ss, 16, 64); ss += __shfl_xor(ss, 32, 64);
                const float rstd = rsqrtf(ss * (1.0f / 64.0f) + EPS) * scl;
#pragma unroll
                for (int j = 0; j < 4; ++j)
#pragma unroll
                    for (int r = 0; r < 4; ++r) acc[i][j][r] *= rstd * gn[j][r];
            }
        }
        store_tile_bf16(acc, smem, (bf16_t*)(P.ws + WS_Z), NZ, m0, n0, tid, wr, wc, g, lr);
    } else if (MODE == 2) {
        float* ssq = (float*)(P.ws + WS_SSQ);
#pragma unroll
        for (int i = 0; i < 4; ++i) {
            const int row = m0 + wr * 64 + 16 * i + lr;
            float ss = 0.f;
#pragma unroll
            for (int j = 0; j < 4; ++j) {
                const int col = n0 + wc * 64 + 16 * j + 4 * g;
                const float4 xv = *(const float4*)(P.x + (size_t)row * DM + col);
                const float4 gv = *(const float4*)(P.norm_ffn + col);
                float4 hv; hv.x = acc[i][j][0] + xv.x; hv.y = acc[i][j][1] + xv.y; hv.z = acc[i][j][2] + xv.z; hv.w = acc[i][j][3] + xv.w;
                *(float4*)(P.out + (size_t)row * DM + col) = hv;
                ss += hv.x * hv.x + hv.y * hv.y + hv.z * hv.z + hv.w * hv.w;
                acc[i][j][0] = hv.x * gv.x; acc[i][j][1] = hv.y * gv.y; acc[i][j][2] = hv.z * gv.z; acc[i][j][3] = hv.w * gv.w;
            }
            ss += __shfl_xor(ss, 16, 64); ss += __shfl_xor(ss, 32, 64);
            if (g == 0) ssq[(size_t)row * 16 + tn * 2 + wc] = ss;
        }
        store_tile_bf16(acc, smem, (bf16_t*)(P.ws + WS_XN), 1024, m0, n0, tid, wr, wc, g, lr);
    } else {
        const int hp = tn;
        const float* ssq = (const float*)(P.ws + WS_SSQ);
        float rs[4];
#pragma unroll
        for (int i = 0; i < 4; ++i) {
            const int row = m0 + wr * 64 + 16 * i + lr;
            const float4 p0 = *(const float4*)(ssq + (size_t)row * 16), p1 = *(const float4*)(ssq + (size_t)row * 16 + 4);
            const float4 p2 = *(const float4*)(ssq + (size_t)row * 16 + 8), p3 = *(const float4*)(ssq + (size_t)row * 16 + 12);
            const float s = ((p0.x + p0.y) + (p0.z + p0.w)) + ((p1.x + p1.y) + (p1.z + p1.w)) + ((p2.x + p2.y) + (p2.z + p2.w)) + ((p3.x + p3.y) + (p3.z + p3.w));
            rs[i] = rsqrtf(s * (1.0f / DM) + EPS);
            if (tn == 0 && wc == 0 && g == 0) ((float*)(P.ws + WS_RSTD))[row] = rs[i];
        }
        {
            unsigned char* sAq = wc ? sA1 : sA0;
#pragma unroll
            for (int i = 0; i < 4; ++i)
#pragma unroll
                for (int j = 0; j < 4; ++j) {
                    const int row = wr * 64 + 16 * i + lr;
                    const int chunk = 2 * j + (g >> 1);
                    uint2 w; w.x = pk2(acc[i][j][0] * rs[i], acc[i][j][1] * rs[i]); w.y = pk2(acc[i][j][2] * rs[i], acc[i][j][3] * rs[i]);
                    *(uint2*)(sAq + row * 128 + ((chunk ^ (row & 7)) << 4) + 8 * (g & 1)) = w;
                }
            const bf16_t* keys = (const bf16_t*)(P.ws + WS_KEYS) + (size_t)hp * 128 * 128;
#pragma unroll
            for (int j = 0; j < 4; ++j) {
                const int row = srow + 32 * j;
                const uint4 k0 = *(const uint4*)(keys + (size_t)row * 128 + sc * 8);
                const uint4 k1 = *(const uint4*)(keys + (size_t)row * 128 + 64 + sc * 8);
                *(uint4*)(sB0 + soff[j]) = k0; *(uint4*)(sB1 + soff[j]) = k1;
            }
        }
        __syncthreads();
#pragma unroll
        for (int i = 0; i < 4; ++i)
#pragma unroll
            for (int j = 0; j < 4; ++j) acc[i][j] = (f32x4){0.f, 0.f, 0.f, 0.f};
        mma_ktile(sA0, sB0, arow_off, brow_off, g, sw, acc);
        mma_ktile(sA1, sB1, arow_off, brow_off, g, sw, acc);
        __syncthreads();
#pragma unroll
        for (int i = 0; i < 4; ++i)
#pragma unroll
            for (int j = 0; j < 4; ++j) {
                const int row = wr * 64 + 16 * i + lr;
                const int c4 = wc * 16 + 4 * j + g;
                *(f32x4*)(smem + row * 512 + ((c4 ^ (row & 31)) << 4)) = acc[i][j];
            }
        __syncthreads();
        unsigned top[16];
#pragma unroll
        for (int q = 0; q < 16; ++q) top[q] = 0u;
        const int row = tid & 127, half = tid >> 7;
#pragma unroll 1
        for (int s = 0; s < 16; ++s) {
            const int c4 = half * 16 + s;
            const f32x4 v = *(const f32x4*)(smem + row * 512 + ((c4 ^ (row & 31)) << 4));
#pragma unroll
            for (int e = 0; e < 4; ++e) {
                unsigned kx = (ord_key(v[e]) & ~127u) | (unsigned)(127 - (c4 * 4 + e));
#pragma unroll
                for (int q = 0; q < 16; ++q) { const unsigned hi = max(top[q], kx), lo = min(top[q], kx); top[q] = hi; kx = lo; }
            }
        }
        __syncthreads();
        if (half) {
            uint4* lp = (uint4*)(smem + row * 64);
            lp[0] = make_uint4(top[0], top[1], top[2], top[3]); lp[1] = make_uint4(top[4], top[5], top[6], top[7]);
            lp[2] = make_uint4(top[8], top[9], top[10], top[11]); lp[3] = make_uint4(top[12], top[13], top[14], top[15]);
        }
        __syncthreads();
        if (!half) {
            const uint4* lp = (const uint4*)(smem + row * 64);
#pragma unroll
            for (int c = 0; c < 4; ++c) {
                const uint4 o = lp[c];
                unsigned ks[4] = {o.x, o.y, o.z, o.w};
#pragma unroll
                for (int e = 0; e < 4; ++e) {
                    unsigned kx = ks[e];
#pragma unroll
                    for (int q = 0; q < 16; ++q) { const unsigned hi = max(top[q], kx), lo = min(top[q], kx); top[q] = hi; kx = lo; }
                }
            }
            uint4* tk = (uint4*)((unsigned*)(P.ws + WS_TK) + ((size_t)(m0 + row) * 16 + hp) * 16);
            tk[0] = make_uint4(top[0], top[1], top[2], top[3]); tk[1] = make_uint4(top[4], top[5], top[6], top[7]);
            tk[2] = make_uint4(top[8], top[9], top[10], top[11]); tk[3] = make_uint4(top[12], top[13], top[14], top[15]);
        }
        __syncthreads();
    }
}

__device__ __forceinline__ void fox_cum_wave(const Params& P, int bh, int lane) {
    const int b = bh >> 3, h = bh & 7;
    const float* gates = (const float*)(P.ws + WS_GATES);
    float* cum = (float*)(P.ws + WS_CUM) + (size_t)bh * L;
    constexpr int SEG = 33;
    const int t0 = lane * SEG;
    float loc = 0.f;
    for (int i = 0; i < SEG; ++i) { const int t = t0 + i; if (t < L) loc += gates[(size_t)(b * L + t) * 16 + 8 + h]; }
    float incl = loc;
#pragma unroll
    for (int o = 1; o < 64; o <<= 1) { const float n = __shfl_up(incl, o, 64); if (lane >= o) incl += n; }
    float run = incl - loc;
    for (int i = 0; i < SEG; ++i) { const int t = t0 + i; if (t < L) { run += gates[(size_t)(b * L + t) * 16 + 8 + h]; cum[t] = run * LOG2E; } }
}

#define TR_SLOW 0

__device__ __forceinline__ int vimg_off(int row, int ch) { return row * 128 + ((ch ^ (((row >> 1) & 3) << 1)) << 4); }
__device__ __forceinline__ uint2 tr_frag(const unsigned char* img, int row0, int c, int g, int lr) {
#if TR_SLOW
    unsigned short e[4];
#pragma unroll
    for (int k = 0; k < 4; ++k) { const int row = row0 + 4 * g + k, col = 16 * c + lr; e[k] = *(const unsigned short*)(img + vimg_off(row, col >> 3) + (col & 7) * 2); }
    uint2 r; r.x = (unsigned)e[0] | ((unsigned)e[1] << 16); r.y = (unsigned)e[2] | ((unsigned)e[3] << 16); return r;
#else
    const int q = lr >> 2, p = lr & 3, row = row0 + 4 * g + q;
    const unsigned addr = (unsigned)(size_t)(img + vimg_off(row, 2 * c + (p >> 1)) + 8 * (p & 1));
    uint2 r;
    asm volatile("ds_read_b64_tr_b16 %0, %1\n\ts_waitcnt lgkmcnt(0)" : "=&v"(r) : "v"(addr) : "memory");
    return r;
#endif
}

__device__ __forceinline__ unsigned tr_lane_addr(const unsigned char* img, int c, int g, int lr) {
    const int q = lr >> 2, p = lr & 3, row = 4 * g + q;
    return (unsigned)(size_t)(img + vimg_off(row, 2 * c + (p >> 1)) + 8 * (p & 1));
}
#define TR_GROUP(o0, o1, o2, o3, a) "ds_read_b64_tr_b16 %" #o0 ", %" #a "\n\tds_read_b64_tr_b16 %" #o1 ", %" #a " offset:2048\n\tds_read_b64_tr_b16 %" #o2 ", %" #a " offset:4096\n\tds_read_b64_tr_b16 %" #o3 ", %" #a " offset:6144\n\t"
__device__ __forceinline__ void tr_read_4c(const unsigned char* img, int g, int lr, uint2 (&r)[4][4]) {
    const unsigned a0 = tr_lane_addr(img, 0, g, lr), a1 = tr_lane_addr(img, 1, g, lr), a2 = tr_lane_addr(img, 2, g, lr), a3 = tr_lane_addr(img, 3, g, lr);
    asm volatile(TR_GROUP(0, 1, 2, 3, 16) TR_GROUP(4, 5, 6, 7, 17) TR_GROUP(8, 9, 10, 11, 18) TR_GROUP(12, 13, 14, 15, 19) "s_waitcnt lgkmcnt(0)"
        : "=&v"(r[0][0]), "=&v"(r[0][1]), "=&v"(r[0][2]), "=&v"(r[0][3]), "=&v"(r[1][0]), "=&v"(r[1][1]), "=&v"(r[1][2]), "=&v"(r[1][3]),
          "=&v"(r[2][0]), "=&v"(r[2][1]), "=&v"(r[2][2]), "=&v"(r[2][3]), "=&v"(r[3][0]), "=&v"(r[3][1]), "=&v"(r[3][2]), "=&v"(r[3][3])
        : "v"(a0), "v"(a1), "v"(a2), "v"(a3) : "memory");
}
__device__ __forceinline__ void tr_read_3c(const unsigned char* img, int g, int lr, uint2 (&r)[3][4]) {
    const unsigned a0 = tr_lane_addr(img, 0, g, lr), a1 = tr_lane_addr(img, 1, g, lr), a2 = tr_lane_addr(img, 2, g, lr);
    asm volatile(TR_GROUP(0, 1, 2, 3, 12) TR_GROUP(4, 5, 6, 7, 13) TR_GROUP(8, 9, 10, 11, 14) "s_waitcnt lgkmcnt(0)"
        : "=&v"(r[0][0]), "=&v"(r[0][1]), "=&v"(r[0][2]), "=&v"(r[0][3]), "=&v"(r[1][0]), "=&v"(r[1][1]), "=&v"(r[1][2]), "=&v"(r[1][3]),
          "=&v"(r[2][0]), "=&v"(r[2][1]), "=&v"(r[2][2]), "=&v"(r[2][3])
        : "v"(a0), "v"(a1), "v"(a2) : "memory");
}
__device__ __forceinline__ void tr_read_2(const unsigned char* img0, int c0, const unsigned char* img1, int c1, int g, int lr, uint2 (&r)[2][4]) {
    const unsigned a0 = tr_lane_addr(img0, c0, g, lr), a1 = tr_lane_addr(img1, c1, g, lr);
    asm volatile(TR_GROUP(0, 1, 2, 3, 8) TR_GROUP(4, 5, 6, 7, 9) "s_waitcnt lgkmcnt(0)"
        : "=&v"(r[0][0]), "=&v"(r[0][1]), "=&v"(r[0][2]), "=&v"(r[0][3]), "=&v"(r[1][0]), "=&v"(r[1][1]), "=&v"(r[1][2]), "=&v"(r[1][3])
        : "v"(a0), "v"(a1) : "memory");
}
__device__ __forceinline__ bf16x8 tr_pair(const uint2& lo, const uint2& hi) { uint4 u; u.x = lo.x; u.y = lo.y; u.z = hi.x; u.w = hi.y; return __builtin_bit_cast(bf16x8, u); }

__device__ __forceinline__ void attn_block(const Params& P, int bh, int qb, unsigned char* smem) {
    const int tid = threadIdx.x, lane = tid & 63, w = tid >> 6, g = lane >> 4, lr = lane & 15;
    const int b = bh >> 3, h = bh & 7;
    const bf16_t* z = (const bf16_t*)(P.ws + WS_Z);
    const float* cum = (const float*)(P.ws + WS_CUM) + (size_t)bh * L;
    const int tq = qb * 64 + 16 * w + lr;
    const bool qvalid = tq < L;
    bf16x8 qf[2];
    {
        const bf16_t* qp = z + (size_t)(b * L + (qvalid ? tq : 0)) * NZ + ZC_FQ + h * 64 + 8 * g;
        qf[0] = *(const bf16x8*)(qp); qf[1] = *(const bf16x8*)(qp + 32);
    }
    const float cq = cum[qvalid ? tq : 0];
    const int srow0 = tid >> 3, sch = tid & 7;
    uint4 rk[2], rv[2]; float rc = 0.f;
    auto load_tile = [&](int kv) {
#pragma unroll
        for (int j = 0; j < 2; ++j) {
            const int key = kv * 64 + srow0 + 32 * j;
            if (key < L) {
                const bf16_t* p = z + (size_t)(b * L + key) * NZ + h * 64 + sch * 8;
                rk[j] = *(const uint4*)(p + ZC_FK); rv[j] = *(const uint4*)(p + ZC_FV);
            } else { rk[j] = make_uint4(0, 0, 0, 0); rv[j] = make_uint4(0, 0, 0, 0); }
        }
        if (tid < 64) { const int key = kv * 64 + tid; rc = key < L ? cum[key] : 0.f; }
    };
    auto store_tile = [&](int buf) {
        unsigned char* sK = smem + buf * 16384; unsigned char* sV = sK + 8192;
#pragma unroll
        for (int j = 0; j < 2; ++j) {
            const int row = srow0 + 32 * j;
            *(uint4*)(sK + row * 128 + ((sch ^ (row & 7)) << 4)) = rk[j];
            *(uint4*)(sV + vimg_off(row, sch)) = rv[j];
        }
        if (tid < 64) ((float*)(smem + 32768 + buf * 256))[tid] = rc;
    };
    float m = -INFINITY, lsum = 0.f;
    f32x4 o[4];
#pragma unroll
    for (int c = 0; c < 4; ++c) o[c] = (f32x4){0.f, 0.f, 0.f, 0.f};
    load_tile(0); store_tile(0);
    __syncthreads();
    for (int kv = 0; kv <= qb; ++kv) {
        const int buf = kv & 1;
        if (kv < qb) load_tile(kv + 1);
        const unsigned char* sK = smem + buf * 16384; const unsigned char* sV = sK + 8192;
        const float* sck = (const float*)(smem + 32768 + buf * 256);
        f32x4 sa[4];
#pragma unroll
        for (int c = 0; c < 4; ++c) {
            sa[c] = (f32x4){0.f, 0.f, 0.f, 0.f};
#pragma unroll
            for (int s = 0; s < 2; ++s) {
                const bf16x8 kf = *(const bf16x8*)(sK + (16 * c + lr) * 128 + (((4 * s + g) ^ (lr & 7)) << 4));
                sa[c] = __builtin_amdgcn_mfma_f32_16x16x32_bf16(kf, qf[s], sa[c], 0, 0, 0);
            }
        }
        const bool diag = (kv == qb);
        float mx = -INFINITY;
#pragma unroll
        for (int c = 0; c < 4; ++c) {
            const f32x4 ck = *(const f32x4*)(sck + 16 * c + 4 * g);
#pragma unroll
            for (int r = 0; r < 4; ++r) {
                float v = sa[c][r] + (cq - ck[r]);
                if (diag && (16 * c + 4 * g + r > 16 * w + lr)) v = -INFINITY;
                sa[c][r] = v; mx = fmaxf(mx, v);
            }
        }
        mx = fmaxf(mx, __shfl_xor(mx, 16, 64)); mx = fmaxf(mx, __shfl_xor(mx, 32, 64));
        const float mn = fmaxf(m, mx);
        const float alpha = __builtin_amdgcn_exp2f(m - mn);
        m = mn;
        float ps = 0.f;
#pragma unroll
        for (int c = 0; c < 4; ++c)
#pragma unroll
            for (int r = 0; r < 4; ++r) { const float p = __builtin_amdgcn_exp2f(sa[c][r] - mn); sa[c][r] = p; ps += p; }
        lsum = lsum * alpha + ps;
#pragma unroll
        for (int c = 0; c < 4; ++c) o[c] *= alpha;
        bf16x8 pf[2];
#pragma unroll
        for (int s2 = 0; s2 < 2; ++s2) {
            uint4 u;
            u.x = cvt_pk_bf16(sa[2 * s2][0], sa[2 * s2][1]); u.y = cvt_pk_bf16(sa[2 * s2][2], sa[2 * s2][3]);
            u.z = cvt_pk_bf16(sa[2 * s2 + 1][0], sa[2 * s2 + 1][1]); u.w = cvt_pk_bf16(sa[2 * s2 + 1][2], sa[2 * s2 + 1][3]);
            pf[s2] = __builtin_bit_cast(bf16x8, u);
        }
        {
            uint2 vr[4][4];
            tr_read_4c(sV, g, lr, vr);
#pragma unroll
            for (int c = 0; c < 4; ++c)
#pragma unroll
                for (int s2 = 0; s2 < 2; ++s2) o[c] = __builtin_amdgcn_mfma_f32_16x16x32_bf16(tr_pair(vr[c][2 * s2], vr[c][2 * s2 + 1]), pf[s2], o[c], 0, 0, 0);
        }
        if (kv < qb) store_tile(buf ^ 1);
        __syncthreads();
    }
    lsum += __shfl_xor(lsum, 16, 64); lsum += __shfl_xor(lsum, 32, 64);
    const float inv = 1.0f / lsum;
    if (qvalid) {
        bf16_t* y = (bf16_t*)(P.ws + WS_Z) + (size_t)(b * L + tq) * NZ + 512 + h * 64 + 4 * g;
#pragma unroll
        for (int c = 0; c < 4; ++c) {
            uint2 u; u.x = pk2(o[c][0] * inv, o[c][1] * inv); u.y = pk2(o[c][2] * inv, o[c][3] * inv);
            *(uint2*)(y + 16 * c) = u;
        }
    }
}

__device__ __forceinline__ void conv_item(const Params& P, int ci) {
    const int tid = threadIdx.x, cc = tid & 127, rg = tid >> 7;
    const bf16_t* z = (const bf16_t*)(P.ws + WS_Z);
    bf16_t* qk = (bf16_t*)(P.ws + WS_RA);
    const int col0 = cc * 8;
    float w[4][8];
#pragma unroll
    for (int j = 0; j < 4; ++j) {
        const float4 a = *(const float4*)(P.conv_qk + j * 1024 + col0), b = *(const float4*)(P.conv_qk + j * 1024 + col0 + 4);
        w[j][0] = a.x; w[j][1] = a.y; w[j][2] = a.z; w[j][3] = a.w; w[j][4] = b.x; w[j][5] = b.y; w[j][6] = b.z; w[j][7] = b.w;
    }
    const float oscale = (col0 >= 512) ? 0.08838834764831845f : 1.0f;
    const int r0 = ci * 64 + rg * 32;
    int t = r0 % L;
    float xw[3][8];
#pragma unroll
    for (int j = 0; j < 3; ++j) {
        const int back = 3 - j;
        if (t - back >= 0) {
            const uint4 v = *(const uint4*)(z + (size_t)(r0 - back) * NZ + col0);
            xw[j][0] = bflo(v.x); xw[j][1] = bfhi(v.x); xw[j][2] = bflo(v.y); xw[j][3] = bfhi(v.y); xw[j][4] = bflo(v.z); xw[j][5] = bfhi(v.z); xw[j][6] = bflo(v.w); xw[j][7] = bfhi(v.w);
        } else {
#pragma unroll
            for (int e = 0; e < 8; ++e) xw[j][e] = 0.f;
        }
    }
#pragma unroll 2
    for (int i = 0; i < 32; ++i) {
        const int r = r0 + i;
        if (t == 0) {
#pragma unroll
            for (int j = 0; j < 3; ++j)
#pragma unroll
                for (int e = 0; e < 8; ++e) xw[j][e] = 0.f;
        }
        const uint4 v = *(const uint4*)(z + (size_t)r * NZ + col0);
        float xt[8];
        xt[0] = bflo(v.x); xt[1] = bfhi(v.x); xt[2] = bflo(v.y); xt[3] = bfhi(v.y); xt[4] = bflo(v.z); xt[5] = bfhi(v.z); xt[6] = bflo(v.w); xt[7] = bfhi(v.w);
        float o[8];
#pragma unroll
        for (int e = 0; e < 8; ++e) {
            const float cv = w[0][e] * xw[0][e] + w[1][e] * xw[1][e] + w[2][e] * xw[2][e] + w[3][e] * xt[e];
            o[e] = oscale * cv / (1.f + __expf(-cv));
            xw[0][e] = xw[1][e]; xw[1][e] = xw[2][e]; xw[2][e] = xt[e];
        }
        uint4 ov; ov.x = pk2(o[0], o[1]); ov.y = pk2(o[2], o[3]); ov.z = pk2(o[4], o[5]); ov.w = pk2(o[6], o[7]);
        *(uint4*)(qk + (size_t)r * 1024 + col0) = ov;
        t = (t + 1 == L) ? 0 : t + 1;
    }
}

constexpr int ST_IMG = 36864;
__device__ __forceinline__ int st_piece_off(int jt, int c, int g, int lr) { return (jt >> 2) * 18432 + vimg_off(16 * c + lr, 2 * (jt & 3) + (g >> 1)) + 8 * (g & 1); }

__device__ __forceinline__ void mlstm_stage_kv(const Params& P, int b, int h, int k, unsigned char* sKimg, unsigned char* sVimg, int tid) {
    const bf16_t* z = (const bf16_t*)(P.ws + WS_Z);
    const bf16_t* qk = (const bf16_t*)(P.ws + WS_RA);
    uint4 pk_[4], pv_[4];
#pragma unroll
    for (int j = 0; j < 4; ++j) {
        const int id = tid + 256 * j, row = id >> 4, ch16 = id & 15, pos = 64 * k + row;
        const bool ok = pos < L;
        pk_[j] = ok ? *(const uint4*)(qk + (size_t)(b * L + pos) * 1024 + 512 + h * 128 + ch16 * 8) : make_uint4(0, 0, 0, 0);
        pv_[j] = ok ? *(const uint4*)(z + (size_t)(b * L + pos) * NZ + ZC_MV + h * 128 + ch16 * 8) : make_uint4(0, 0, 0, 0);
    }
#pragma unroll
    for (int j = 0; j < 4; ++j) {
        const int id = tid + 256 * j, row = id >> 4, ch16 = id & 15;
        *(uint4*)(sKimg + (ch16 >> 3) * 8192 + vimg_off(row, ch16 & 7)) = pk_[j];
        *(uint4*)(sVimg + (ch16 >> 3) * 8192 + vimg_off(row, ch16 & 7)) = pv_[j];
    }
    if (tid < 128) {
        const int row = tid >> 1, ch = tid & 1;
        *(uint4*)(sVimg + 16384 + vimg_off(row, ch)) = ch ? make_uint4(0, 0, 0, 0) : make_uint4(0x3F80u, 0, 0, 0);
    }
}

__device__ __forceinline__ void mlstm_A(const Params& P, int item, unsigned char* smem) {
    const int tid = threadIdx.x, lane = tid & 63, w = tid >> 6, g = lane >> 4, lr = lane & 15;
    const int wu = __builtin_amdgcn_readfirstlane(w);
    const int k = item >> 5, bh = item & 31, b = bh >> 2, h = bh & 3;
    const float* gates = (const float*)(P.ws + WS_GATES);
    const unsigned char* sK = smem; const unsigned char* sV = smem + 16384;
    float* ga = (float*)(smem + 40960);
    mlstm_stage_kv(P, b, h, k, smem, smem + 16384, tid);
    if (wu == 0) {
        const int pos = 64 * k + lane;
        float lf = 0.f, li = -INFINITY;
        if (pos < L) { lf = gates[(size_t)(b * L + pos) * 16 + 4 + h]; li = gates[(size_t)(b * L + pos) * 16 + h]; }
        float bc = lf;
#pragma unroll
        for (int o = 1; o < 64; o <<= 1) { const float n = __shfl_up(bc, o, 64); if (lane >= o) bc += n; }
        const float a = li - bc;
        const float A = wave_max(a);
        ga[lane] = __expf(a - A);
        if (lane == 63) { float* msc = (float*)(P.ws + WS_MSC) + ((size_t)bh * 33 + k) * 4; msc[0] = A; msc[1] = bc; }
    }
    __syncthreads();
    f32x4 Ct[2][9];
#pragma unroll
    for (int a = 0; a < 2; ++a)
#pragma unroll
        for (int c = 0; c < 9; ++c) Ct[a][c] = (f32x4){0.f, 0.f, 0.f, 0.f};
    bf16x8 kt[2][2];
#pragma unroll
    for (int a = 0; a < 2; ++a)
#pragma unroll
        for (int s2 = 0; s2 < 2; ++s2) {
            const int jt = 2 * w + a;
            kt[a][s2] = tr_pair(tr_frag(sK + (jt >> 2) * 8192, 32 * s2, jt & 3, g, lr), tr_frag(sK + (jt >> 2) * 8192, 32 * s2 + 16, jt & 3, g, lr));
        }
    f32x4 wg4[4];
#pragma unroll
    for (int j = 0; j < 4; ++j) wg4[j] = *(const f32x4*)(ga + 16 * j + 4 * g);
#define MA_TILE(c, lo0, hi0, lo1, hi1) { \
        { const f32x4 w0 = wg4[0], w1 = wg4[1]; uint4 o; \
          o.x = cvt_pk_bf16(bflo(lo0.x) * w0[0], bfhi(lo0.x) * w0[1]); o.y = cvt_pk_bf16(bflo(lo0.y) * w0[2], bfhi(lo0.y) * w0[3]); \
          o.z = cvt_pk_bf16(bflo(hi0.x) * w1[0], bfhi(hi0.x) * w1[1]); o.w = cvt_pk_bf16(bflo(hi0.y) * w1[2], bfhi(hi0.y) * w1[3]); \
          const bf16x8 vw = __builtin_bit_cast(bf16x8, o); \
          Ct[0][c] = __builtin_amdgcn_mfma_f32_16x16x32_bf16(kt[0][0], vw, Ct[0][c], 0, 0, 0); Ct[1][c] = __builtin_amdgcn_mfma_f32_16x16x32_bf16(kt[1][0], vw, Ct[1][c], 0, 0, 0); } \
        { const f32x4 w0 = wg4[2], w1 = wg4[3]; uint4 o; \
          o.x = cvt_pk_bf16(bflo(lo1.x) * w0[0], bfhi(lo1.x) * w0[1]); o.y = cvt_pk_bf16(bflo(lo1.y) * w0[2], bfhi(lo1.y) * w0[3]); \
          o.z = cvt_pk_bf16(bflo(hi1.x) * w1[0], bfhi(hi1.x) * w1[1]); o.w = cvt_pk_bf16(bflo(hi1.y) * w1[2], bfhi(hi1.y) * w1[3]); \
          const bf16x8 vw = __builtin_bit_cast(bf16x8, o); \
          Ct[0][c] = __builtin_amdgcn_mfma_f32_16x16x32_bf16(kt[0][1], vw, Ct[0][c], 0, 0, 0); Ct[1][c] = __builtin_amdgcn_mfma_f32_16x16x32_bf16(kt[1][1], vw, Ct[1][c], 0, 0, 0); } }
    {
        uint2 vr[4][4];
        tr_read_4c(sV, g, lr, vr);
        MA_TILE(0, vr[0][0], vr[0][1], vr[0][2], vr[0][3]) MA_TILE(1, vr[1][0], vr[1][1], vr[1][2], vr[1][3])
        MA_TILE(2, vr[2][0], vr[2][1], vr[2][2], vr[2][3]) MA_TILE(3, vr[3][0], vr[3][1], vr[3][2], vr[3][3])
        tr_read_4c(sV + 8192, g, lr, vr);
        MA_TILE(4, vr[0][0], vr[0][1], vr[0][2], vr[0][3]) MA_TILE(5, vr[1][0], vr[1][1], vr[1][2], vr[1][3])
        MA_TILE(6, vr[2][0], vr[2][1], vr[2][2], vr[2][3]) MA_TILE(7, vr[3][0], vr[3][1], vr[3][2], vr[3][3])
        const uint2 o0 = tr_frag(sV + 16384, 0, 0, g, lr), o1 = tr_frag(sV + 16384, 16, 0, g, lr), o2 = tr_frag(sV + 16384, 32, 0, g, lr), o3 = tr_frag(sV + 16384, 48, 0, g, lr);
        MA_TILE(8, o0, o1, o2, o3)
    }
#undef MA_TILE
    unsigned char* slot = P.ws + WS_MST + ((size_t)bh * 33 + k) * ST_IMG;
#pragma unroll
    for (int a = 0; a < 2; ++a)
#pragma unroll
        for (int c = 0; c < 9; ++c) {
            uint2 u; u.x = cvt_pk_bf16(Ct[a][c][0], Ct[a][c][1]); u.y = cvt_pk_bf16(Ct[a][c][2], Ct[a][c][3]);
            *(uint2*)(slot + st_piece_off(2 * w + a, c, g, lr)) = u;
        }
}

__device__ __forceinline__ void mlstm_B(const Params& P, int item) {
    const int tid = threadIdx.x;
    const int bh = item / 3, part = item - bh * 3;
    const unsigned char* base = P.ws + WS_MST + (size_t)bh * 33 * ST_IMG + part * 12288 + tid * 48;
    unsigned char* obase = P.ws + WS_CBI + (size_t)bh * 33 * ST_IMG + part * 12288 + tid * 48;
    float* msc = (float*)(P.ws + WS_MSC) + (size_t)bh * 33 * 4;
    float C[6][4];
#pragma unroll
    for (int i = 0; i < 6; ++i)
#pragma unroll
        for (int r = 0; r < 4; ++r) C[i][r] = 0.f;
    float m = 0.f;
    uint2 d0[6], d1[6];
    float2 ab0, ab1;
#pragma unroll
    for (int i = 0; i < 6; ++i) { d0[i] = *(const uint2*)(base + i * 8); d1[i] = *(const uint2*)(base + ST_IMG + i * 8); }
    ab0 = *(const float2*)(msc); ab1 = *(const float2*)(msc + 4);
    for (int k = 0; k < 33; ++k) {
        uint2 d2[6]; float2 ab2 = make_float2(0.f, 0.f);
        if (k + 2 < 33) {
#pragma unroll
            for (int i = 0; i < 6; ++i) d2[i] = *(const uint2*)(base + (size_t)(k + 2) * ST_IMG + i * 8);
            ab2 = *(const float2*)(msc + (k + 2) * 4);
        } else {
#pragma unroll
            for (int i = 0; i < 6; ++i) d2[i] = make_uint2(0, 0);
        }
#pragma unroll
        for (int i = 0; i < 6; ++i) {
            uint2 u; u.x = cvt_pk_bf16(C[i][0], C[i][1]); u.y = cvt_pk_bf16(C[i][2], C[i][3]);
            *(uint2*)(obase + (size_t)k * ST_IMG + i * 8) = u;
        }
        if (tid == 0 && part == 0) msc[k * 4 + 2] = m;
        const float M = fmaxf(m, ab0.x);
        const float decay = __expf(m - M), sc = __expf(ab0.x - M);
#pragma unroll
        for (int i = 0; i < 6; ++i) {
            C[i][0] = decay * C[i][0] + sc * bflo(d0[i].x); C[i][1] = decay * C[i][1] + sc * bfhi(d0[i].x);
            C[i][2] = decay * C[i][2] + sc * bflo(d0[i].y); C[i][3] = decay * C[i][3] + sc * bfhi(d0[i].y);
        }
        m = ab0.y + M;
#pragma unroll
        for (int i = 0; i < 6; ++i) { d0[i] = d1[i]; d1[i] = d2[i]; }
        ab0 = ab1; ab1 = ab2;
    }
}

__device__ __forceinline__ void mlstm_C(const Params& P, int item, unsigned char* smem) {
    const int tid = threadIdx.x, lane = tid & 63, w = tid >> 6, g = lane >> 4, lr = lane & 15;
    const int wu = __builtin_amdgcn_readfirstlane(w);
    const int k = item >> 5, bh = item & 31, b = bh >> 2, h = bh & 3;
    const bf16_t* z = (const bf16_t*)(P.ws + WS_Z);
    const bf16_t* qk = (const bf16_t*)(P.ws + WS_RA);
    const float* gates = (const float*)(P.ws + WS_GATES);
    bf16_t* y = (bf16_t*)(P.ws + WS_Z);
    const unsigned char* sK = smem; const unsigned char* sV = smem + 36864; unsigned char* sCb = smem;
    float* ga = (float*)(smem + 61440);
    const int pos = 64 * k + 16 * w + lr;
    const bool tvalid = pos < L;
    const size_t rrow = (size_t)(b * L + (tvalid ? pos : 0));
    const unsigned char* cslot = P.ws + WS_CBI + ((size_t)bh * 33 + k) * ST_IMG + tid * 16;
    const uint4 cb0 = *(const uint4*)(cslot), cb1 = *(const uint4*)(cslot + 4096), cb2 = *(const uint4*)(cslot + 8192), cb3 = *(const uint4*)(cslot + 12288), cb4 = *(const uint4*)(cslot + 16384),
                cb5 = *(const uint4*)(cslot + 20480), cb6 = *(const uint4*)(cslot + 24576), cb7 = *(const uint4*)(cslot + 28672), cb8 = *(const uint4*)(cslot + 32768);
    bf16x8 qf[4];
    {
        const bf16_t* qp = qk + rrow * 1024 + h * 128 + 8 * g;
#pragma unroll
        for (int ks = 0; ks < 4; ++ks) { qf[ks] = *(const bf16x8*)(qp + 32 * ks); if (!tvalid) qf[ks] = (bf16x8){0, 0, 0, 0, 0, 0, 0, 0}; }
    }
    mlstm_stage_kv(P, b, h, k, smem, smem + 36864, tid);
    if (wu == 0) {
        const float m_prev = ((const float*)(P.ws + WS_MSC))[((size_t)bh * 33 + k) * 4 + 2];
        const int p2 = 64 * k + lane;
        float lf = 0.f, li = -INFINITY;
        if (p2 < L) { lf = gates[(size_t)(b * L + p2) * 16 + 4 + h]; li = gates[(size_t)(b * L + p2) * 16 + h]; }
        float bc = lf;
#pragma unroll
        for (int o = 1; o < 64; o <<= 1) { const float n = __shfl_up(bc, o, 64); if (lane >= o) bc += n; }
        const float a = li - bc;
        float am = a;
#pragma unroll
        for (int o = 1; o < 64; o <<= 1) { const float n = __shfl_up(am, o, 64); if (lane >= o) am = fmaxf(am, n); }
        const float M = fmaxf(m_prev, am);
        ga[lane] = a; ga[64 + lane] = __expf(m_prev - M); ga[128 + lane] = __expf(-(bc + M)); ga[192 + lane] = M;
    }
    __syncthreads();
    const float Mt = ga[192 + 16 * w + lr], Wi = ga[64 + 16 * w + lr], Et = ga[128 + 16 * w + lr];
    bf16x8 pf[2];
    {
        f32x4 sa[4];
#pragma unroll
        for (int c = 0; c < 4; ++c) {
            sa[c] = (f32x4){0.f, 0.f, 0.f, 0.f};
            if (c <= wu) {
#pragma unroll
                for (int ks = 0; ks < 4; ++ks) {
                    const bf16x8 kf = *(const bf16x8*)(sK + (ks >> 1) * 8192 + vimg_off(16 * c + lr, 4 * (ks & 1) + g));
                    sa[c] = __builtin_amdgcn_mfma_f32_16x16x32_bf16(kf, qf[ks], sa[c], 0, 0, 0);
                }
                const f32x4 av = *(const f32x4*)(ga + 16 * c + 4 * g);
#pragma unroll
                for (int r = 0; r < 4; ++r) {
                    const float d = __expf(av[r] - Mt);
                    sa[c][r] = (16 * c + 4 * g + r <= 16 * w + lr) ? sa[c][r] * d : 0.f;
                }
            }
        }
#pragma unroll
        for (int s2 = 0; s2 < 2; ++s2) {
            uint4 u;
            u.x = cvt_pk_bf16(sa[2 * s2][0], sa[2 * s2][1]); u.y = cvt_pk_bf16(sa[2 * s2][2], sa[2 * s2][3]);
            u.z = cvt_pk_bf16(sa[2 * s2 + 1][0], sa[2 * s2 + 1][1]); u.w = cvt_pk_bf16(sa[2 * s2 + 1][2], sa[2 * s2 + 1][3]);
            pf[s2] = __builtin_bit_cast(bf16x8, u);
        }
    }
    __syncthreads();
    {
        unsigned char* d = sCb + tid * 16;
        *(uint4*)(d) = cb0; *(uint4*)(d + 4096) = cb1; *(uint4*)(d + 8192) = cb2; *(uint4*)(d + 12288) = cb3; *(uint4*)(d + 16384) = cb4;
        *(uint4*)(d + 20480) = cb5; *(uint4*)(d + 24576) = cb6; *(uint4*)(d + 28672) = cb7; *(uint4*)(d + 32768) = cb8;
    }
    __syncthreads();
    f32x4 na[9];
#define MC_TILE(c, lo0, hi0, lo1, hi1) { \
        na[c] = (f32x4){0.f, 0.f, 0.f, 0.f}; \
        _Pragma("unroll") for (int ks = 0; ks < 4; ++ks) { \
            const bf16x8 cf = *(const bf16x8*)(sCb + (ks >> 1) * 18432 + vimg_off(16 * (c) + lr, 4 * (ks & 1) + g)); \
            na[c] = __builtin_amdgcn_mfma_f32_16x16x32_bf16(cf, qf[ks], na[c], 0, 0, 0); } \
        na[c] *= Wi; \
        na[c] = __builtin_amdgcn_mfma_f32_16x16x32_bf16(tr_pair(lo0, hi0), pf[0], na[c], 0, 0, 0); \
        na[c] = __builtin_amdgcn_mfma_f32_16x16x32_bf16(tr_pair(lo1, hi1), pf[1], na[c], 0, 0, 0); }
    {
        uint2 vr[4][4];
        tr_read_4c(sV, g, lr, vr);
        MC_TILE(0, vr[0][0], vr[0][1], vr[0][2], vr[0][3]) MC_TILE(1, vr[1][0], vr[1][1], vr[1][2], vr[1][3])
        MC_TILE(2, vr[2][0], vr[2][1], vr[2][2], vr[2][3]) MC_TILE(3, vr[3][0], vr[3][1], vr[3][2], vr[3][3])
        tr_read_4c(sV + 8192, g, lr, vr);
        MC_TILE(4, vr[0][0], vr[0][1], vr[0][2], vr[0][3]) MC_TILE(5, vr[1][0], vr[1][1], vr[1][2], vr[1][3])
        MC_TILE(6, vr[2][0], vr[2][1], vr[2][2], vr[2][3]) MC_TILE(7, vr[3][0], vr[3][1], vr[3][2], vr[3][3])
        const uint2 o0 = tr_frag(sV + 16384, 0, 0, g, lr), o1 = tr_frag(sV + 16384, 16, 0, g, lr), o2 = tr_frag(sV + 16384, 32, 0, g, lr), o3 = tr_frag(sV + 16384, 48, 0, g, lr);
        MC_TILE(8, o0, o1, o2, o3)
    }
#undef MC_TILE
    const float den = __shfl(na[8][0], lr, 64);
    const float rden = 1.0f / fmaxf(fabsf(den), Et);
    float hs = 0.f;
#pragma unroll
    for (int c = 0; c < 8; ++c) { na[c] *= rden; hs += na[c][0] * na[c][0] + na[c][1] * na[c][1] + na[c][2] * na[c][2] + na[c][3] * na[c][3]; }
    hs += __shfl_xor(hs, 16, 64); hs += __shfl_xor(hs, 32, 64);
    const float rstd = rsqrtf(hs * (1.0f / 128.0f) + EPS);
    const float* gainp = P.m_out_norm + h * 128 + 4 * g;
#pragma unroll
    for (int c = 0; c < 8; ++c) {
        const uint2 og = *(const uint2*)(z + rrow * NZ + ZC_MO + h * 128 + 16 * c + 4 * g);
        const float o0 = bflo(og.x), o1 = bfhi(og.x), o2 = bflo(og.y), o3 = bfhi(og.y);
        const float4 gn = *(const float4*)(gainp + 16 * c);
        uint2 u;
        u.x = pk2(na[c][0] * rstd * gn.x / (1.f + __expf(-o0)), na[c][1] * rstd * gn.y / (1.f + __expf(-o1)));
        u.y = pk2(na[c][2] * rstd * gn.z / (1.f + __expf(-o2)), na[c][3] * rstd * gn.w / (1.f + __expf(-o3)));
        if (tvalid) *(uint2*)(y + rrow * NZ + h * 128 + 16 * c + 4 * g) = u;
    }
}

__device__ __forceinline__ void peer_token(const Params& P, int t, int lane, int* sidx, float* sval, int* sid, float* sgate) {
    const unsigned* tk = (const unsigned*)(P.ws + WS_TK) + (size_t)t * 256;
#pragma unroll
    for (int i = 0; i < 4; ++i) {
        const unsigned k = tk[lane * 4 + i];
        sidx[lane * 4 + i] = 127 - (int)(k & 127u);
        sval[lane * 4 + i] = unord_key(k & ~127u);
    }
    __builtin_amdgcn_s_waitcnt(0xc07f);
    __builtin_amdgcn_wave_barrier();
    if (lane < 8) {
        const int hd = lane;
        float v0[16], v1[16];
#pragma unroll
        for (int i = 0; i < 16; ++i) { v0[i] = sval[(2 * hd) * 16 + i]; v1[i] = sval[(2 * hd + 1) * 16 + i]; }
        unsigned top[16];
#pragma unroll
        for (int i = 0; i < 16; ++i) top[i] = 0u;
#pragma unroll
        for (int i = 0; i < 16; ++i)
#pragma unroll
            for (int j = 0; j < 16; ++j)
                if ((i + 1) * (j + 1) <= 16) {
                    unsigned kx = (ord_key(v0[i] + v1[j]) & ~255u) | (unsigned)(255 - (i * 16 + j));
#pragma unroll
                    for (int q = 0; q < 16; ++q) { const unsigned hi = max(top[q], kx), lo = min(top[q], kx); top[q] = hi; kx = lo; }
                }
        const float smax = unord_key(top[0] & ~255u);
        float e[16]; float den = 0.f;
#pragma unroll
        for (int q = 0; q < 16; ++q) { e[q] = __expf(unord_key(top[q] & ~255u) - smax); den += e[q]; }
        const float inv = 1.f / den;
#pragma unroll
        for (int q = 0; q < 16; ++q) {
            const int pos = 255 - (int)(top[q] & 255u), i = pos >> 4, j = pos & 15;
            sid[hd * 16 + q] = sidx[(2 * hd) * 16 + i] * 128 + sidx[(2 * hd + 1) * 16 + j];
            sgate[hd * 16 + q] = e[q] * inv;
        }
    }
    __builtin_amdgcn_s_waitcnt(0xc07f);
    __builtin_amdgcn_wave_barrier();
    const bf16_t* xn = (const bf16_t*)(P.ws + WS_XN) + (size_t)t * DM;
    const float rstd = ((const float*)(P.ws + WS_RSTD))[t];
    const unsigned char* U = P.ws + WS_U + lane * 8;
    const unsigned char* V = P.ws + WS_V + lane * 8;
    const float* usc = (const float*)(P.ws + WS_USC);
    const float* vsc = (const float*)(P.ws + WS_VSC);
    float xf[16];
    {
        const uint4 xa = *(const uint4*)(xn + lane * 16), xb = *(const uint4*)(xn + lane * 16 + 8);
        xf[0] = bflo(xa.x); xf[1] = bfhi(xa.x); xf[2] = bflo(xa.y); xf[3] = bfhi(xa.y); xf[4] = bflo(xa.z); xf[5] = bfhi(xa.z); xf[6] = bflo(xa.w); xf[7] = bfhi(xa.w);
        xf[8] = bflo(xb.x); xf[9] = bfhi(xb.x); xf[10] = bflo(xb.y); xf[11] = bfhi(xb.y); xf[12] = bflo(xb.z); xf[13] = bfhi(xb.z); xf[14] = bflo(xb.w); xf[15] = bfhi(xb.w);
    }
    float acc[16];
#pragma unroll
    for (int j = 0; j < 16; ++j) acc[j] = 0.f;
    const int myq = ((lane >> 5) & 1) * 8 + ((lane >> 4) & 1) * 4 + ((lane >> 3) & 1) * 2 + ((lane >> 2) & 1);
#pragma unroll 1
    for (int e0 = 0; e0 < 128; e0 += 16) {
        uint2 ur[16], vr[16];
#pragma unroll
        for (int q = 0; q < 16; ++q) {
            const int id = sid[e0 + q];
            ur[q] = *(const uint2*)(U + (size_t)id * 512);
            vr[q] = *(const uint2*)(V + (size_t)id * 512);
        }
        const int myid = sid[e0 + myq];
        const float mysc = usc[myid] * rstd, myvs = vsc[myid] * sgate[e0 + myq];
        float d[16];
#pragma unroll
        for (int q = 0; q < 16; ++q) {
            float s0 = 0.f;
#define FP4_DOT(k) { const f32x2 a = __builtin_amdgcn_cvt_scalef32_pk_f32_fp4(ur[q].x, 1.0f, k), c = __builtin_amdgcn_cvt_scalef32_pk_f32_fp4(ur[q].y, 1.0f, k); \
                     s0 += xf[2 * k] * a.x + xf[2 * k + 1] * a.y + xf[8 + 2 * k] * c.x + xf[8 + 2 * k + 1] * c.y; }
            FP4_DOT(0) FP4_DOT(1) FP4_DOT(2) FP4_DOT(3)
#undef FP4_DOT
            d[q] = s0;
        }
        float r8[8], r4[4], r2[2], r1;
#pragma unroll
        for (int i = 0; i < 8; ++i) { const bool up = (lane & 32) != 0; const float keep = up ? d[i + 8] : d[i], send = up ? d[i] : d[i + 8]; r8[i] = keep + __shfl_xor(send, 32, 64); }
#pragma unroll
        for (int i = 0; i < 4; ++i) { const bool up = (lane & 16) != 0; const float keep = up ? r8[i + 4] : r8[i], send = up ? r8[i] : r8[i + 4]; r4[i] = keep + __shfl_xor(send, 16, 64); }
#pragma unroll
        for (int i = 0; i < 2; ++i) { const bool up = (lane & 8) != 0; const float keep = up ? r4[i + 2] : r4[i], send = up ? r4[i] : r4[i + 2]; r2[i] = keep + __shfl_xor(send, 8, 64); }
        { const bool up = (lane & 4) != 0; const float keep = up ? r2[1] : r2[0], send = up ? r2[0] : r2[1]; r1 = keep + __shfl_xor(send, 4, 64); }
        r1 += __shfl_xor(r1, 2, 64); r1 += __shfl_xor(r1, 1, 64);
        const float a = r1 * mysc;
        const float wmine = myvs * 0.5f * a * (1.f + erff(a * 0.70710678118654752f));
#pragma unroll
        for (int q = 0; q < 16; ++q) {
            const float w = __shfl(wmine, ((q >> 3) & 1) * 32 + ((q >> 2) & 1) * 16 + ((q >> 1) & 1) * 8 + (q & 1) * 4, 64);
#define FP4_AXPY(k) { const f32x2 a2 = __builtin_amdgcn_cvt_scalef32_pk_f32_fp4(vr[q].x, 1.0f, k), c2 = __builtin_amdgcn_cvt_scalef32_pk_f32_fp4(vr[q].y, 1.0f, k); \
                      acc[2 * k] += w * a2.x; acc[2 * k + 1] += w * a2.y; acc[8 + 2 * k] += w * c2.x; acc[8 + 2 * k + 1] += w * c2.y; }
            FP4_AXPY(0) FP4_AXPY(1) FP4_AXPY(2) FP4_AXPY(3)
#undef FP4_AXPY
        }
    }
    float* o = P.out + (size_t)t * DM + lane * 16;
    float4 h0 = *(float4*)(o), h1 = *(float4*)(o + 4), h2 = *(float4*)(o + 8), h3 = *(float4*)(o + 12);
    h0.x += acc[0]; h0.y += acc[1]; h0.z += acc[2]; h0.w += acc[3]; h1.x += acc[4]; h1.y += acc[5]; h1.z += acc[6]; h1.w += acc[7];
    h2.x += acc[8]; h2.y += acc[9]; h2.z += acc[10]; h2.w += acc[11]; h3.x += acc[12]; h3.y += acc[13]; h3.z += acc[14]; h3.w += acc[15];
    *(float4*)(o) = h0; *(float4*)(o + 4) = h1; *(float4*)(o + 8) = h2; *(float4*)(o + 12) = h3;
    __builtin_amdgcn_s_waitcnt(0xc07f);
    __builtin_amdgcn_wave_barrier();
}

#define LAS __attribute__((address_space(3)))
#define XB_TMO      128
#define XB_XCNT(j)  (256  + 64 * (j))
#define XB_XSUB(j)  (1280 + 64 * (j))
#define XB_XGEN(j)  (2304 + 64 * (j))
#define XB_TOP      3328
#define XB_TOPGEN   3392
#define XCD_BAR_WORDS 3456
#define XB_SPIN_CAP (1u << 18)
__device__ __forceinline__ unsigned xb_ld(unsigned* p)              { return __hip_atomic_load(p, __ATOMIC_RELAXED, __HIP_MEMORY_SCOPE_AGENT); }
__device__ __forceinline__ unsigned xb_add(unsigned* p, unsigned v) { return __hip_atomic_fetch_add(p, v, __ATOMIC_RELAXED, __HIP_MEMORY_SCOPE_AGENT); }
__device__ __forceinline__ unsigned xb_xcc_id() { return (unsigned)__builtin_amdgcn_s_getreg((3 << 11) | 20) & 0xFu; }
#define XB_SPIN(cond, bar) do { unsigned _sp = 0; while (cond) { __builtin_amdgcn_s_sleep(1); \
    if ((++_sp & 255u) == 0u) { if (xb_ld(&(bar)[XB_TMO])) break; if (_sp > XB_SPIN_CAP) { atomicAdd(&(bar)[XB_TMO], 1u); break; } } } } while (0)
struct XcdBarrier { unsigned* bar; unsigned x; volatile LAS unsigned* st; };
__device__ __forceinline__ XcdBarrier xcd_barrier_post(unsigned* bar, volatile LAS unsigned* st) {
    XcdBarrier b; b.bar = bar; b.x = xb_xcc_id(); b.st = st;
    if (threadIdx.x == 0) (void)xb_add(&bar[XB_XCNT(b.x)], 1u);
    return b;
}
__device__ __forceinline__ void xcd_barrier_complete(unsigned* bar, unsigned x, unsigned& nloc, unsigned& nx) {
    const unsigned G = gridDim.x * gridDim.y * gridDim.z;
    unsigned sum, cnt, mine, sp = 0u;
    for (;;) {
        sum = 0u; cnt = 0u; mine = 0u;
#pragma unroll
        for (unsigned j = 0; j < 16; ++j) { const unsigned c = xb_ld(&bar[XB_XCNT(j)]); sum += c; cnt += (c > 0u) ? 1u : 0u; mine = (j == x) ? c : mine; }
        if (sum == G) break;
        __builtin_amdgcn_s_sleep(1);
        if ((++sp & 255u) == 0u) { if (xb_ld(&bar[XB_TMO])) break; if (sp > XB_SPIN_CAP) { atomicAdd(&bar[XB_TMO], 1u); break; } }
    }
    nloc = mine > 0u ? mine : 1u; nx = cnt > 0u ? cnt : 1u;
}
__device__ __forceinline__ void xcd_barrier(const XcdBarrier& b) {
    asm volatile("s_waitcnt vmcnt(0)" ::: "memory");
    __syncthreads();
    if (threadIdx.x == 0) {
        unsigned* bar = b.bar;
        __builtin_amdgcn_s_waitcnt(0);
        unsigned nloc = b.st[0], nx = b.st[1];
        if (nloc == 0u) { xcd_barrier_complete(bar, b.x, nloc, nx); b.st[0] = nloc; b.st[1] = nx; }
        const unsigned old = xb_add(&bar[XB_XSUB(b.x)], 1u);
        const unsigned gen = old / nloc;
        if (old + 1u == (gen + 1u) * nloc) {
            __builtin_amdgcn_fence(__ATOMIC_RELEASE, "agent");
            asm volatile("s_waitcnt vmcnt(0)" ::: "memory");
            const unsigned og = xb_add(&bar[XB_TOP], 1u);
            const unsigned tg = og / nx;
            if (og + 1u == (tg + 1u) * nx) xb_add(&bar[XB_TOPGEN], 1u);
            else XB_SPIN(xb_ld(&bar[XB_TOPGEN]) == tg, bar);
            __builtin_amdgcn_fence(__ATOMIC_ACQUIRE, "agent");
            xb_add(&bar[XB_XGEN(b.x)], 1u);
            asm volatile("s_waitcnt vmcnt(0)" ::: "memory");
        } else {
            XB_SPIN(xb_ld(&bar[XB_XGEN(b.x)]) == gen, bar);
            __builtin_amdgcn_fence(__ATOMIC_ACQUIRE, "agent");
            asm volatile("s_waitcnt vmcnt(0)" ::: "memory");
        }
    }
    __syncthreads();
}

__device__ __forceinline__ void hand_release() { asm volatile("s_waitcnt vmcnt(0)" ::: "memory"); __builtin_amdgcn_fence(__ATOMIC_RELEASE, "agent"); asm volatile("s_waitcnt vmcnt(0)" ::: "memory"); }
__device__ __forceinline__ void hand_acquire() { __builtin_amdgcn_fence(__ATOMIC_ACQUIRE, "agent"); asm volatile("s_waitcnt vmcnt(0)" ::: "memory"); }

__global__ void __launch_bounds__(256, 2) mega(Params P) {
    extern __shared__ __attribute__((aligned(16))) unsigned char smem[];
    cg::grid_group grid = cg::this_grid();
    const int tid = threadIdx.x, lane = tid & 63, wave = tid >> 6;
    const int G = gridDim.x, bid = blockIdx.x;
    unsigned* ctl = (unsigned*)(P.ws + WS_CTL);
    volatile LAS unsigned* bst = (volatile LAS unsigned*)(smem + 65552);
    if (tid == 0) { bst[0] = 0u; bst[1] = 0u; }
    __syncthreads();
    phase0(P, smem);
    grid.sync();
    const XcdBarrier xb = xcd_barrier_post(ctl + 1024, bst);
    {
        const int gw = bid * 4 + wave;
        if (gw < 64) fox_cum_wave(P, gw, lane);
        for (int tile = bid; tile < 129 * 28; tile += G) gemm_tile<1>(P, tile / 28, tile % 28, smem);
    }
    xcd_barrier(xb);
    {
        volatile int* s_item = (volatile int*)(smem + 65536);
        const int wave_u = __builtin_amdgcn_readfirstlane(wave);
        auto fetch = [&](unsigned* counter) -> int {
            if (wave_u == 0) {
                unsigned v = atomicAdd(counter, lane == 0 ? 1u : 0u);
                *s_item = (int)__builtin_amdgcn_readfirstlane(v);
            }
            __syncthreads();
            const int item = __builtin_amdgcn_readfirstlane(*s_item);
            __syncthreads();
            return item;
        };
        for (;;) {
            const int item = fetch(&ctl[0]);
            if (item >= 258) break;
            conv_item(P, item);
        }
        xcd_barrier(xb);
        for (;;) {
            const int item = fetch(&ctl[2]);
            if (item >= 33 * 32) break;
            mlstm_A(P, item, smem);
        }
        xcd_barrier(xb);
        for (;;) {
            const int item = fetch(&ctl[4]);
            if (item >= 96) break;
            mlstm_B(P, item);
        }
        for (;;) {
            const int item = fetch(&ctl[3]);
            if (item >= 64 * 33) break;
            attn_block(P, item & 63, 32 - (item >> 6), smem);
        }
        xcd_barrier(xb);
        for (;;) {
            const int item = fetch(&ctl[5]);
            if (item >= 33 * 32) break;
            mlstm_C(P, item, smem);
        }
    }
    xcd_barrier(xb);
    for (int tile = bid; tile < 128 * 8; tile += G) gemm_tile<2>(P, tile >> 3, tile & 7, smem);
    convert_uv_rows(P, bid * 4 + wave, G * 4, lane);
    xcd_barrier(xb);
    for (int tile = bid; tile < 128 * 16; tile += G) gemm_tile<3>(P, tile >> 4, tile & 15, smem);
    xcd_barrier(xb);
    {
        int* sidx = (int*)(smem + wave * 3072); float* sval = (float*)(smem + wave * 3072 + 1024);
        int* sid = (int*)(smem + wave * 3072 + 2048); float* sgate = (float*)(smem + wave * 3072 + 2560);
        for (int t = bid * 4 + wave; t < T2; t += G * 4) peer_token(P, t, lane, sidx, sval, sid, sgate);
    }
}

}

extern "C" void kernel_launch(void* const* d_in, const int* in_sizes, int n_in, void* d_out, int out_size, void* d_ws, size_t ws_size, hipStream_t stream) {
    if (n_in != 17 || ws_size < WS_END) { fprintf(stderr, "kernel_launch: unexpected n_in %d or ws_size %zu (need %zu)\n", n_in, ws_size, (size_t)WS_END); return; }
    constexpr int LDS_BYTES = 66560;
    static int grid_blocks = 0;
    if (!grid_blocks) {
        int dev = 0, cus = 0, per_cu = 0;
        (void)hipGetDevice(&dev);
        (void)hipDeviceGetAttribute(&cus, hipDeviceAttributeMultiprocessorCount, dev);
        (void)hipFuncSetAttribute((const void*)mega, hipFuncAttributeMaxDynamicSharedMemorySize, LDS_BYTES);
        (void)hipOccupancyMaxActiveBlocksPerMultiprocessor(&per_cu, (const void*)mega, 256, LDS_BYTES);
        if (per_cu < 1) per_cu = 1;
        if (per_cu > 2) per_cu = 2;
        grid_blocks = cus * per_cu;
        fprintf(stderr, "kernel_launch: cus %d per_cu %d grid %d\n", cus, per_cu, grid_blocks);
    }
    Params P{};
    P.x = (const float*)d_in[0]; P.meta = (const float*)d_in[1]; P.norm_mix = (const float*)d_in[2]; P.w_in = (const float*)d_in[3];
    P.conv_qk = (const float*)d_in[4]; P.b_igate = (const float*)d_in[5]; P.b_fgate_m = (const float*)d_in[6]; P.m_out_norm = (const float*)d_in[7];
    P.b_fgate_f = (const float*)d_in[8]; P.f_q_norm = (const float*)d_in[9]; P.f_k_norm = (const float*)d_in[10]; P.w_out = (const float*)d_in[11];
    P.norm_ffn = (const float*)d_in[12]; P.peer_query = (const float*)d_in[13]; P.peer_keys = (const float*)d_in[14]; P.peer_u = (const float*)d_in[15];
    P.peer_v = (const float*)d_in[16]; P.out = (float*)d_out; P.ws = (unsigned char*)d_ws;
    void* args[] = {&P};
    hipError_t e = hipLaunchCooperativeKernel((const void*)mega, dim3(grid_blocks), dim3(256), args, LDS_BYTES, stream);
    if (e != hipSuccess) fprintf(stderr, "cooperative launch failed: %s (grid %d)\n", hipGetErrorString(e), grid_blocks);
}
```

```cpp
#include <hip/hip_runtime.h>
#include <stdint.h>
#include <stdio.h>
#include <hip/hip_cooperative_groups.h>
namespace cg = cooperative_groups;

namespace {

constexpr int NB = 8, SEQ = 2048, DM = 1024, NMETA = 16, L = SEQ + NMETA;
constexpr int T1 = NB * L;
constexpr int T2 = NB * SEQ;
constexpr int NZ = 3584;
constexpr int ZC_MQ = 0, ZC_MK = 512, ZC_MV = 1024, ZC_MO = 1536, ZC_FQ = 2048, ZC_FK = 2560, ZC_FV = 3072;
constexpr int PROJ = 3600;
constexpr float EPS = 1e-6f;

constexpr size_t WS_CTL = 0;
constexpr size_t WS_RA = 65536;
constexpr size_t WS_Z = WS_RA + (size_t)T1 * DM * 2;
constexpr size_t WS_GATES = WS_Z + (size_t)T1 * NZ * 2;
constexpr size_t WS_CUM = WS_GATES + (size_t)T1 * 16 * 4;
constexpr size_t WS_SSQ = WS_CUM + (size_t)NB * 8 * L * 4;
constexpr size_t WS_RSTD = WS_SSQ + (size_t)T2 * 16 * 4;
constexpr size_t WS_SSQM = WS_RSTD + (size_t)T2 * 4;
constexpr size_t WS_BT2 = WS_SSQM + (size_t)T1 * 16 * 4;
constexpr size_t WS_BT3 = WS_BT2 + (size_t)DM * DM * 2;
constexpr size_t WS_KEYS = WS_BT3 + (size_t)2048 * DM * 2;
constexpr size_t WS_MSC = WS_KEYS + (size_t)16 * 128 * 128 * 2;
constexpr size_t WS_MST = WS_MSC + (size_t)128 * 33 * 16;
constexpr size_t WS_BT1 = WS_MST + (size_t)32 * 33 * 36864;
constexpr size_t WS_CBI = WS_BT1;
constexpr size_t WS_UV = WS_CBI + (size_t)32 * 33 * 36864;
constexpr size_t WS_END = WS_UV + (size_t)2 * 16384 * 512 + (size_t)2 * 16384 * 4;
constexpr size_t WS_XN = WS_RA;
constexpr size_t WS_U = WS_UV;
constexpr size_t WS_V = WS_U + (size_t)16384 * 512;
constexpr size_t WS_USC = WS_V + (size_t)16384 * 512;
constexpr size_t WS_VSC = WS_USC + (size_t)16384 * 4;
constexpr size_t WS_TK = WS_CBI;
constexpr float LOG2E = 1.4426950408889634f;

typedef unsigned short bf16_t;
typedef short bf16x8 __attribute__((ext_vector_type(8)));
typedef float f32x4 __attribute__((ext_vector_type(4)));
typedef __attribute__((ext_vector_type(2))) __bf16 bf16x2_t;

struct Params {
    const float* x; const float* meta; const float* norm_mix; const float* w_in; const float* conv_qk;
    const float* b_igate; const float* b_fgate_m; const float* m_out_norm; const float* b_fgate_f;
    const float* f_q_norm; const float* f_k_norm; const float* w_out; const float* norm_ffn;
    const float* peer_query; const float* peer_keys; const float* peer_u; const float* peer_v;
    float* out; unsigned char* ws;
};

__device__ __forceinline__ unsigned f2bf(float f) { unsigned u = __float_as_uint(f); return (u + 0x7fffu + ((u >> 16) & 1u)) >> 16; }
__device__ __forceinline__ float bf2f(unsigned h) { return __uint_as_float(h << 16); }
typedef float f32x2 __attribute__((ext_vector_type(2)));
typedef __bf16 bf16x2v __attribute__((ext_vector_type(2)));
__device__ __forceinline__ unsigned cvt_pk_bf16(float lo, float hi) { f32x2 v = {lo, hi}; bf16x2v b = __builtin_convertvector(v, bf16x2v); return __builtin_bit_cast(unsigned, b); }
__device__ __forceinline__ unsigned pk2(float lo, float hi) { return cvt_pk_bf16(lo, hi); }
__device__ __forceinline__ float bflo(unsigned w) { return __uint_as_float(w << 16); }
__device__ __forceinline__ float bfhi(unsigned w) { return __uint_as_float(w & 0xffff0000u); }
__device__ __forceinline__ float wave_sum(float v) {
#pragma unroll
    for (int o = 32; o > 0; o >>= 1) v += __shfl_xor(v, o, 64);
    return v;
}
__device__ __forceinline__ float wave_max(float v) {
#pragma unroll
    for (int o = 32; o > 0; o >>= 1) v = fmaxf(v, __shfl_xor(v, o, 64));
    return v;
}
__device__ __forceinline__ float logsigmoidf(float x) { return fminf(x, 0.f) - log1pf(expf(-fabsf(x))); }
__device__ __forceinline__ unsigned ord_key(float f) { unsigned u = __float_as_uint(f); return u ^ ((u >> 31) ? 0xffffffffu : 0x80000000u); }
__device__ __forceinline__ float unord_key(unsigned k) { unsigned u = (k & 0x80000000u) ? (k ^ 0x80000000u) : ~k; return __uint_as_float(u); }

__device__ __forceinline__ void phase0(const Params& P, unsigned char* smem) {
    const int tid = threadIdx.x, lane = tid & 63, wave = tid >> 6;
    unsigned* ctl = (unsigned*)(P.ws + WS_CTL);
    float* gw = (float*)smem;
    for (int idx = tid; idx < 16 * 1024; idx += 256) {
        const int k = idx >> 4, c = idx & 15;
        const int col = c < 8 ? 2048 + c : 3592 + (c - 8);
        gw[c * 1024 + k] = P.w_in[(size_t)k * PROJ + col];
    }
    __syncthreads();
    {
        bf16_t* hn = (bf16_t*)(P.ws + WS_RA);
        float* gates = (float*)(P.ws + WS_GATES);
        const int c0 = lane * 8, c1 = 512 + lane * 8;
        float gm[16];
        {
            const float4 a0 = *(const float4*)(P.norm_mix + c0), a1 = *(const float4*)(P.norm_mix + c0 + 4);
            const float4 a2 = *(const float4*)(P.norm_mix + c1), a3 = *(const float4*)(P.norm_mix + c1 + 4);
            gm[0] = a0.x; gm[1] = a0.y; gm[2] = a0.z; gm[3] = a0.w; gm[4] = a1.x; gm[5] = a1.y; gm[6] = a1.z; gm[7] = a1.w;
            gm[8] = a2.x; gm[9] = a2.y; gm[10] = a2.z; gm[11] = a2.w; gm[12] = a3.x; gm[13] = a3.y; gm[14] = a3.z; gm[15] = a3.w;
        }
        const int myq = ((lane >> 5) & 1) * 8 + ((lane >> 4) & 1) * 4 + ((lane >> 3) & 1) * 2 + ((lane >> 2) & 1);
        const float mybias = myq < 4 ? P.b_igate[myq] : (myq < 8 ? P.b_fgate_m[myq - 4] : P.b_fgate_f[myq - 8]);
        const int rstep = gridDim.x * 4;
        int r = blockIdx.x * 4 + wave;
        float4 n0, n1, n2, n3;
        auto load_row = [&](int rr) {
            const int b = rr / L, p = rr - b * L;
            const float* src = (p < NMETA) ? (P.meta + (size_t)p * DM) : (P.x + ((size_t)b * SEQ + (p - NMETA)) * DM);
            n0 = *(const float4*)(src + c0); n1 = *(const float4*)(src + c0 + 4); n2 = *(const float4*)(src + c1); n3 = *(const float4*)(src + c1 + 4);
        };
        if (r < T1) load_row(r);
        for (; r < T1; r += rstep) {
            float v[16];
            v[0] = n0.x; v[1] = n0.y; v[2] = n0.z; v[3] = n0.w; v[4] = n1.x; v[5] = n1.y; v[6] = n1.z; v[7] = n1.w;
            v[8] = n2.x; v[9] = n2.y; v[10] = n2.z; v[11] = n2.w; v[12] = n3.x; v[13] = n3.y; v[14] = n3.z; v[15] = n3.w;
            if (r + rstep < T1) load_row(r + rstep);
            float ss = 0.f;
#pragma unroll
            for (int j = 0; j < 16; ++j) ss += v[j] * v[j];
            ss = wave_sum(ss);
            const float rstd = rsqrtf(ss * (1.0f / DM) + EPS);
#pragma unroll
            for (int j = 0; j < 16; ++j) v[j] *= rstd * gm[j];
            uint4 o0, o1;
            o0.x = pk2(v[0], v[1]); o0.y = pk2(v[2], v[3]); o0.z = pk2(v[4], v[5]); o0.w = pk2(v[6], v[7]);
            o1.x = pk2(v[8], v[9]); o1.y = pk2(v[10], v[11]); o1.z = pk2(v[12], v[13]); o1.w = pk2(v[14], v[15]);
            *(uint4*)(hn + (size_t)r * DM + c0) = o0;
            *(uint4*)(hn + (size_t)r * DM + c1) = o1;
            float r8[8], r4[4], r2[2], r1;
#pragma unroll
            for (int i = 0; i < 8; ++i) {
                float dd[2];
#pragma unroll
                for (int hh = 0; hh < 2; ++hh) {
                    const float* gwc = gw + (i + 8 * hh) * 1024;
                    const float4 w0 = *(const float4*)(gwc + c0), w1 = *(const float4*)(gwc + c0 + 4), w2 = *(const float4*)(gwc + c1), w3 = *(const float4*)(gwc + c1 + 4);
                    dd[hh] = v[0] * w0.x + v[1] * w0.y + v[2] * w0.z + v[3] * w0.w + v[4] * w1.x + v[5] * w1.y + v[6] * w1.z + v[7] * w1.w
                           + v[8] * w2.x + v[9] * w2.y + v[10] * w2.z + v[11] * w2.w + v[12] * w3.x + v[13] * w3.y + v[14] * w3.z + v[15] * w3.w;
                }
                const bool up = (lane & 32) != 0; const float keep = up ? dd[1] : dd[0], send = up ? dd[0] : dd[1];
                r8[i] = keep + __shfl_xor(send, 32, 64);
                __builtin_amdgcn_sched_barrier(0);
            }
#pragma unroll
            for (int i = 0; i < 4; ++i) { const bool up = (lane & 16) != 0; const float keep = up ? r8[i + 4] : r8[i], send = up ? r8[i] : r8[i + 4]; r4[i] = keep + __shfl_xor(send, 16, 64); }
#pragma unroll
            for (int i = 0; i < 2; ++i) { const bool up = (lane & 8) != 0; const float keep = up ? r4[i + 2] : r4[i], send = up ? r4[i] : r4[i + 2]; r2[i] = keep + __shfl_xor(send, 8, 64); }
            { const bool up = (lane & 4) != 0; const float keep = up ? r2[1] : r2[0], send = up ? r2[0] : r2[1]; r1 = keep + __shfl_xor(send, 4, 64); }
            r1 += __shfl_xor(r1, 2, 64); r1 += __shfl_xor(r1, 1, 64);
            if ((lane & 3) == 0) {
                const float pre = r1 + mybias;
                gates[(size_t)r * 16 + myq] = myq < 4 ? pre : logsigmoidf(pre);
            }
        }
    }
    __syncthreads();
    {
        float (*tile)[65] = (float (*)[65])smem;
        for (int item = blockIdx.x; item < 1664; item += gridDim.x) {
            const float* W; int ldn, ntn, shift_from, it; bf16_t* out;
            if (item < 896) { W = P.w_in; ldn = PROJ; ntn = 56; shift_from = 2048; it = item; out = (bf16_t*)(P.ws + WS_BT1); }
            else if (item < 1152) { W = P.w_out; ldn = 1024; ntn = 16; shift_from = 1 << 30; it = item - 896; out = (bf16_t*)(P.ws + WS_BT2); }
            else { W = P.peer_query; ldn = 2048; ntn = 32; shift_from = 1 << 30; it = item - 1152; out = (bf16_t*)(P.ws + WS_BT3); }
            const int tk = it / ntn, tn = it - tk * ntn, k0 = tk * 64, n0 = tn * 64;
            {
                const int nl = tid & 63;
                int n = n0 + nl; if (n >= shift_from) n += 8;
#pragma unroll
                for (int i = 0; i < 16; ++i) { const int kl = (tid >> 6) + 4 * i; tile[kl][nl] = W[(size_t)(k0 + kl) * ldn + n]; }
            }
            __syncthreads();
            {
                const int kl = tid & 63;
#pragma unroll
                for (int i = 0; i < 16; ++i) { const int nl = (tid >> 6) + 4 * i; out[(size_t)(n0 + nl) * 1024 + k0 + kl] = (bf16_t)f2bf(tile[kl][nl]); }
            }
            __syncthreads();
        }
    }
    {
        const size_t gt = (size_t)blockIdx.x * 256 + tid, gs = (size_t)gridDim.x * 256;
        const float* src = P.peer_keys; bf16_t* dst = (bf16_t*)(P.ws + WS_KEYS);
        for (size_t i = gt; i < (size_t)(16 * 128 * 128 / 8); i += gs) {
            const float4 a = *(const float4*)(src + i * 8), b = *(const float4*)(src + i * 8 + 4);
            uint4 o; o.x = pk2(a.x, a.y); o.y = pk2(a.z, a.w); o.z = pk2(b.x, b.y); o.w = pk2(b.z, b.w);
            *(uint4*)(dst + i * 8) = o;
        }
    }
}

__device__ __forceinline__ void convert_uv_rows(const Params& P, int gwave, int nwaves, int lane) {
    for (int rr0 = gwave * 4; rr0 < 2 * 16384; rr0 += nwaves * 4) {
        float4 a[4][4];
#pragma unroll
        for (int q = 0; q < 4; ++q) {
            const int rr = rr0 + q, which = rr >> 14, row = rr & 16383;
            const float* src = (which ? P.peer_v : P.peer_u) + (size_t)row * DM + lane * 16;
            a[q][0] = *(const float4*)(src); a[q][1] = *(const float4*)(src + 4); a[q][2] = *(const float4*)(src + 8); a[q][3] = *(const float4*)(src + 12);
        }
#pragma unroll
        for (int q = 0; q < 4; ++q) {
            const int rr = rr0 + q, which = rr >> 14, row = rr & 16383;
            float mx = 0.f;
#pragma unroll
            for (int j = 0; j < 4; ++j) mx = fmaxf(mx, fmaxf(fmaxf(fabsf(a[q][j].x), fabsf(a[q][j].y)), fmaxf(fabsf(a[q][j].z), fabsf(a[q][j].w))));
            mx = wave_max(mx);
            const float sc = mx > 0.f ? 6.0f / mx : 1.0f;
            unsigned w0 = 0u, w1 = 0u;
            w0 = __builtin_amdgcn_cvt_scalef32_pk_fp4_f32(w0, a[q][0].x * sc, a[q][0].y * sc, 1.0f, 0); w0 = __builtin_amdgcn_cvt_scalef32_pk_fp4_f32(w0, a[q][0].z * sc, a[q][0].w * sc, 1.0f, 1);
            w0 = __builtin_amdgcn_cvt_scalef32_pk_fp4_f32(w0, a[q][1].x * sc, a[q][1].y * sc, 1.0f, 2); w0 = __builtin_amdgcn_cvt_scalef32_pk_fp4_f32(w0, a[q][1].z * sc, a[q][1].w * sc, 1.0f, 3);
            w1 = __builtin_amdgcn_cvt_scalef32_pk_fp4_f32(w1, a[q][2].x * sc, a[q][2].y * sc, 1.0f, 0); w1 = __builtin_amdgcn_cvt_scalef32_pk_fp4_f32(w1, a[q][2].z * sc, a[q][2].w * sc, 1.0f, 1);
            w1 = __builtin_amdgcn_cvt_scalef32_pk_fp4_f32(w1, a[q][3].x * sc, a[q][3].y * sc, 1.0f, 2); w1 = __builtin_amdgcn_cvt_scalef32_pk_fp4_f32(w1, a[q][3].z * sc, a[q][3].w * sc, 1.0f, 3);
            *(uint2*)(P.ws + (which ? WS_V : WS_U) + (size_t)row * 512 + lane * 8) = make_uint2(w0, w1);
            if (lane == 0) ((float*)(P.ws + (which ? WS_VSC : WS_USC)))[row] = mx > 0.f ? mx * (1.0f / 6.0f) : 1.0f;
        }
    }
}

__device__ __forceinline__ void mma_ktile(const unsigned char* sA, const unsigned char* sB, int arow_off, int brow_off, int g, int sw, f32x4 (&acc)[4][4]) {
#pragma unroll
    for (int s = 0; s < 2; ++s) {
        bf16x8 a[4], b[4];
        const int ch = (((s * 4 + g) ^ sw) << 4);
#pragma unroll
        for (int i = 0; i < 4; ++i) a[i] = *(const bf16x8*)(sA + arow_off + i * 2048 + ch);
#pragma unroll
        for (int j = 0; j < 4; ++j) b[j] = *(const bf16x8*)(sB + brow_off + j * 2048 + ch);
#pragma unroll
        for (int i = 0; i < 4; ++i)
#pragma unroll
            for (int j = 0; j < 4; ++j) acc[i][j] = __builtin_amdgcn_mfma_f32_16x16x32_bf16(b[j], a[i], acc[i][j], 0, 0, 0);
    }
}

__device__ __forceinline__ void store_tile_bf16(const f32x4 (&acc)[4][4], unsigned char* smem, bf16_t* dst, size_t ld, int m0, int n0, int tid, int wr, int wc, int g, int lr) {
#pragma unroll
    for (int i = 0; i < 4; ++i)
#pragma unroll
        for (int j = 0; j < 4; ++j) {
            const int row = wr * 64 + 16 * i + lr, col = wc * 64 + 16 * j + 4 * g;
            uint2 w; w.x = pk2(acc[i][j][0], acc[i][j][1]); w.y = pk2(acc[i][j][2], acc[i][j][3]);
            *(uint2*)(smem + row * 272 + col * 2) = w;
        }
    __syncthreads();
#pragma unroll
    for (int q = 0; q < 8; ++q) {
        const int id = tid + 256 * q, row = id >> 4, ch = id & 15;
        const uint4 v = *(const uint4*)(smem + row * 272 + ch * 16);
        *(uint4*)(dst + (size_t)(m0 + row) * ld + n0 + ch * 8) = v;
    }
    __syncthreads();
}

template <int MODE>
__device__ __forceinline__ void gemm_tile(const Params& P, int tm, int tn, unsigned char* smem) {
    const bf16_t* A; const bf16_t* Bt;
    if (MODE == 1) { A = (const bf16_t*)(P.ws + WS_RA); Bt = (const bf16_t*)(P.ws + WS_BT1); }
    else if (MODE == 2) { A = (const bf16_t*)(P.ws + WS_Z); Bt = (const bf16_t*)(P.ws + WS_BT2); }
    else { A = (const bf16_t*)(P.ws + WS_XN); Bt = (const bf16_t*)(P.ws + WS_BT3); }
    const int tid = threadIdx.x, lane = tid & 63, wave = tid >> 6, wr = wave >> 1, wc = wave & 1, g = lane >> 4, lr = lane & 15;
    const int m0 = tm * 128, n0 = tn * 128;
    const int srow = tid >> 3, sc = tid & 7;
    const bf16_t* aptr[4]; const bf16_t* bptr[4]; int soff[4];
#pragma unroll
    for (int j = 0; j < 4; ++j) {
        const int row = srow + 32 * j;
        int ar = m0 + row;
        if (MODE == 2) { const int b = ar >> 11, t = ar & 2047; ar = b * L + NMETA + t; }
        aptr[j] = A + (size_t)ar * (MODE == 2 ? NZ : 1024) + sc * 8;
        bptr[j] = Bt + (size_t)(n0 + row) * 1024 + sc * 8;
        soff[j] = row * 128 + ((sc ^ (row & 7)) << 4);
    }
    f32x4 acc[4][4];
#pragma unroll
    for (int i = 0; i < 4; ++i)
#pragma unroll
        for (int j = 0; j < 4; ++j) acc[i][j] = (f32x4){0.f, 0.f, 0.f, 0.f};
    uint4 ra[4], rb[4];
#pragma unroll
    for (int j = 0; j < 4; ++j) { ra[j] = *(const uint4*)(aptr[j]); rb[j] = *(const uint4*)(bptr[j]); }
    unsigned char* sA0 = smem; unsigned char* sB0 = smem + 16384; unsigned char* sA1 = smem + 32768; unsigned char* sB1 = smem + 49152;
#pragma unroll
    for (int j = 0; j < 4; ++j) { *(uint4*)(sA0 + soff[j]) = ra[j]; *(uint4*)(sB0 + soff[j]) = rb[j]; }
    __syncthreads();
    const int arow_off = (wr * 64 + lr) * 128, brow_off = (wc * 64 + lr) * 128, sw = lr & 7;
    for (int kt = 0; kt < 16; ++kt) {
        unsigned char* sA = (kt & 1) ? sA1 : sA0; unsigned char* sB = (kt & 1) ? sB1 : sB0;
        unsigned char* nA = (kt & 1) ? sA0 : sA1; unsigned char* nB = (kt & 1) ? sB0 : sB1;
        if (kt < 15) {
#pragma unroll
            for (int j = 0; j < 4; ++j) { ra[j] = *(const uint4*)(aptr[j] + (kt + 1) * 64); rb[j] = *(const uint4*)(bptr[j] + (kt + 1) * 64); }
        }
        mma_ktile(sA, sB, arow_off, brow_off, g, sw, acc);
        if (kt < 15) {
#pragma unroll
            for (int j = 0; j < 4; ++j) { *(uint4*)(nA + soff[j]) = ra[j]; *(uint4*)(nB + soff[j]) = rb[j]; }
        }
        __syncthreads();
    }
    if (MODE == 1) {
        if (n0 >= ZC_FQ && n0 < ZC_FV) {
            const bool isk = n0 >= ZC_FK;
            const float* gain = isk ? P.f_k_norm : P.f_q_norm;
            const float scl = isk ? 1.0f : 0.125f * LOG2E;
            float gn[4][4];
#pragma unroll
            for (int j = 0; j < 4; ++j)
#pragma unroll
                for (int r = 0; r < 4; ++r) gn[j][r] = gain[16 * j + 4 * g + r];
#pragma unroll
            for (int i = 0; i < 4; ++i) {
                float ss = 0.f;
#pragma unroll
                for (int j = 0; j < 4; ++j)
#pragma unroll
                    for (int r = 0; r < 4; ++r) ss += acc[i][j][r] * acc[i][j][r];
                ss += __shfl_xor(ss, 16, 64); ss += __shfl_xor(ss, 32, 64);
                const float rstd = rsqrtf(ss * (1.0f / 64.0f) + EPS) * scl;
#pragma unroll
                for (int j = 0; j < 4; ++j)
#pragma unroll
                    for (int r = 0; r < 4; ++r) acc[i][j][r] *= rstd * gn[j][r];
            }
        }
        store_tile_bf16(acc, smem, (bf16_t*)(P.ws + WS_Z), NZ, m0, n0, tid, wr, wc, g, lr);
    } else if (MODE == 2) {
        float* ssq = (float*)(P.ws + WS_SSQ);
#pragma unroll
        for (int i = 0; i < 4; ++i) {
            const int row = m0 + wr * 64 + 16 * i + lr;
            float ss = 0.f;
#pragma unroll
            for (int j = 0; j < 4; ++j) {
                const int col = n0 + wc * 64 + 16 * j + 4 * g;
                const float4 xv = *(const float4*)(P.x + (size_t)row * DM + col);
                const float4 gv = *(const float4*)(P.norm_ffn + col);
                float4 hv; hv.x = acc[i][j][0] + xv.x; hv.y = acc[i][j][1] + xv.y; hv.z = acc[i][j][2] + xv.z; hv.w = acc[i][j][3] + xv.w;
                *(float4*)(P.out + (size_t)row * DM + col) = hv;
                ss += hv.x * hv.x + hv.y * hv.y + hv.z * hv.z + hv.w * hv.w;
                acc[i][j][0] = hv.x * gv.x; acc[i][j][1] = hv.y * gv.y; acc[i][j][2] = hv.z * gv.z; acc[i][j][3] = hv.w * gv.w;
            }
            ss += __shfl_xor(ss, 16, 64); ss += __shfl_xor(ss, 32, 64);
            if (g == 0) ssq[(size_t)row * 16 + tn * 2 + wc] = ss;
        }
        store_tile_bf16(acc, smem, (bf16_t*)(P.ws + WS_XN), 1024, m0, n0, tid, wr, wc, g, lr);
    } else {
        const int hp = tn;
        const float* ssq = (const float*)(P.ws + WS_SSQ);
        float rs[4];
#pragma unroll
        for (int i = 0; i < 4; ++i) {
            const int row = m0 + wr * 64 + 16 * i + lr;
            const float4 p0 = *(const float4*)(ssq + (size_t)row * 16), p1 = *(const float4*)(ssq + (size_t)row * 16 + 4);
            const float4 p2 = *(const float4*)(ssq + (size_t)row * 16 + 8), p3 = *(const float4*)(ssq + (size_t)row * 16 + 12);
            const float s = ((p0.x + p0.y) + (p0.z + p0.w)) + ((p1.x + p1.y) + (p1.z + p1.w)) + ((p2.x + p2.y) + (p2.z + p2.w)) + ((p3.x + p3.y) + (p3.z + p3.w));
            rs[i] = rsqrtf(s * (1.0f / DM) + EPS);
            if (tn == 0 && wc == 0 && g == 0) ((float*)(P.ws + WS_RSTD))[row] = rs[i];
        }
        {
            unsigned char* sAq = wc ? sA1 : sA0;
#pragma unroll
            for (int i = 0; i < 4; ++i)
#pragma unroll
                for (int j = 0; j < 4; ++j) {
                    const int row = wr * 64 + 16 * i + lr;
                    const int chunk = 2 * j + (g >> 1);
                    uint2 w; w.x = pk2(acc[i][j][0] * rs[i], acc[i][j][1] * rs[i]); w.y = pk2(acc[i][j][2] * rs[i], acc[i][j][3] * rs[i]);
                    *(uint2*)(sAq + row * 128 + ((chunk ^ (row & 7)) << 4) + 8 * (g & 1)) = w;
                }
            const bf16_t* keys = (const bf16_t*)(P.ws + WS_KEYS) + (size_t)hp * 128 * 128;
#pragma unroll
            for (int j = 0; j < 4; ++j) {
                const int row = srow + 32 * j;
                const uint4 k0 = *(const uint4*)(keys + (size_t)row * 128 + sc * 8);
                const uint4 k1 = *(const uint4*)(keys + (size_t)row * 128 + 64 + sc * 8);
                *(uint4*)(sB0 + soff[j]) = k0; *(uint4*)(sB1 + soff[j]) = k1;
            }
        }
        __syncthreads();
#pragma unroll
        for (int i = 0; i < 4; ++i)
#pragma unroll
            for (int j = 0; j < 4; ++j) acc[i][j] = (f32x4){0.f, 0.f, 0.f, 0.f};
        mma_ktile(sA0, sB0, arow_off, brow_off, g, sw, acc);
        mma_ktile(sA1, sB1, arow_off, brow_off, g, sw, acc);
        __syncthreads();
#pragma unroll
        for (int i = 0; i < 4; ++i)
#pragma unroll
            for (int j = 0; j < 4; ++j) {
                const int row = wr * 64 + 16 * i + lr;
                const int c4 = wc * 16 + 4 * j + g;
                *(f32x4*)(smem + row * 512 + ((c4 ^ (row & 31)) << 4)) = acc[i][j];
            }
        __syncthreads();
        unsigned top[16];
#pragma unroll
        for (int q = 0; q < 16; ++q) top[q] = 0u;
        const int row = tid & 127, half = tid >> 7;
#pragma unroll 1
        for (int s = 0; s < 16; ++s) {
            const int c4 = half * 16 + s;
            const f32x4 v = *(const f32x4*)(smem + row * 512 + ((c4 ^ (row & 31)) << 4));
#pragma unroll
            for (int e = 0; e < 4; ++e) {
                unsigned kx = (ord_key(v[e]) & ~127u) | (unsigned)(127 - (c4 * 4 + e));
#pragma unroll
                for (int q = 0; q < 16; ++q) { const unsigned hi = max(top[q], kx), lo = min(top[q], kx); top[q] = hi; kx = lo; }
            }
        }
        __syncthreads();
        if (half) {
            uint4* lp = (uint4*)(smem + row * 64);
            lp[0] = make_uint4(top[0], top[1], top[2], top[3]); lp[1] = make_uint4(top[4], top[5], top[6], top[7]);
            lp[2] = make_uint4(top[8], top[9], top[10], top[11]); lp[3] = make_uint4(top[12], top[13], top[14], top[15]);
        }
        __syncthreads();
        if (!half) {
            const uint4* lp = (const uint4*)(smem + row * 64);
#pragma unroll
            for (int c = 0; c < 4; ++c) {
                const uint4 o = lp[c];
                unsigned ks[4] = {o.x, o.y, o.z, o.w};
#pragma unroll
                for (int e = 0; e < 4; ++e) {
                    unsigned kx = ks[e];
#pragma unroll
                    for (int q = 0; q < 16; ++q) { const unsigned hi = max(top[q], kx), lo = min(top[q], kx); top[q] = hi; kx = lo; }
                }
            }
            uint4* tk = (uint4*)((unsigned*)(P.ws + WS_TK) + ((size_t)(m0 + row) * 16 + hp) * 16);
            tk[0] = make_uint4(top[0], top[1], top[2], top[3]); tk[1] = make_uint4(top[4], top[5], top[6], top[7]);
            tk[2] = make_uint4(top[8], top[9], top[10], top[11]); tk[3] = make_uint4(top[12], top[13], top[14], top[15]);
        }
        __syncthreads();
    }
}

__device__ __forceinline__ void fox_cum_wave(const Params& P, int bh, int lane) {
    const int b = bh >> 3, h = bh & 7;
    const float* gates = (const float*)(P.ws + WS_GATES);
    float* cum = (float*)(P.ws + WS_CUM) + (size_t)bh * L;
    constexpr int SEG = 33;
    const int t0 = lane * SEG;
    float loc = 0.f;
    for (int i = 0; i < SEG; ++i) { const int t = t0 + i; if (t < L) loc += gates[(size_t)(b * L + t) * 16 + 8 + h]; }
    float incl = loc;
#pragma unroll
    for (int o = 1; o < 64; o <<= 1) { const float n = __shfl_up(incl, o, 64); if (lane >= o) incl += n; }
    float run = incl - loc;
    for (int i = 0; i < SEG; ++i) { const int t = t0 + i; if (t < L) { run += gates[(size_t)(b * L + t) * 16 + 8 + h]; cum[t] = run * LOG2E; } }
}

#define TR_SLOW 0

__device__ __forceinline__ int vimg_off(int row, int ch) { return row * 128 + ((ch ^ (((row >> 1) & 3) << 1)) << 4); }
__device__ __forceinline__ uint2 tr_frag(const unsigned char* img, int row0, int c, int g, int lr) {
#if TR_SLOW
    unsigned short e[4];
#pragma unroll
    for (int k = 0; k < 4; ++k) { const int row = row0 + 4 * g + k, col = 16 * c + lr; e[k] = *(const unsigned short*)(img + vimg_off(row, col >> 3) + (col & 7) * 2); }
    uint2 r; r.x = (unsigned)e[0] | ((unsigned)e[1] << 16); r.y = (unsigned)e[2] | ((unsigned)e[3] << 16); return r;
#else
    const int q = lr >> 2, p = lr & 3, row = row0 + 4 * g + q;
    const unsigned addr = (unsigned)(size_t)(img + vimg_off(row, 2 * c + (p >> 1)) + 8 * (p & 1));
    uint2 r;
    asm volatile("ds_read_b64_tr_b16 %0, %1\n\ts_waitcnt lgkmcnt(0)" : "=&v"(r) : "v"(addr) : "memory");
    return r;
#endif
}

__device__ __forceinline__ unsigned tr_lane_addr(const unsigned char* img, int c, int g, int lr) {
    const int q = lr >> 2, p = lr & 3, row = 4 * g + q;
    return (unsigned)(size_t)(img + vimg_off(row, 2 * c + (p >> 1)) + 8 * (p & 1));
}
#define TR_GROUP(o0, o1, o2, o3, a) "ds_read_b64_tr_b16 %" #o0 ", %" #a "\n\tds_read_b64_tr_b16 %" #o1 ", %" #a " offset:2048\n\tds_read_b64_tr_b16 %" #o2 ", %" #a " offset:4096\n\tds_read_b64_tr_b16 %" #o3 ", %" #a " offset:6144\n\t"
__device__ __forceinline__ void tr_read_4c(const unsigned char* img, int g, int lr, uint2 (&r)[4][4]) {
    const unsigned a0 = tr_lane_addr(img, 0, g, lr), a1 = tr_lane_addr(img, 1, g, lr), a2 = tr_lane_addr(img, 2, g, lr), a3 = tr_lane_addr(img, 3, g, lr);
    asm volatile(TR_GROUP(0, 1, 2, 3, 16) TR_GROUP(4, 5, 6, 7, 17) TR_GROUP(8, 9, 10, 11, 18) TR_GROUP(12, 13, 14, 15, 19) "s_waitcnt lgkmcnt(0)"
        : "=&v"(r[0][0]), "=&v"(r[0][1]), "=&v"(r[0][2]), "=&v"(r[0][3]), "=&v"(r[1][0]), "=&v"(r[1][1]), "=&v"(r[1][2]), "=&v"(r[1][3]),
          "=&v"(r[2][0]), "=&v"(r[2][1]), "=&v"(r[2][2]), "=&v"(r[2][3]), "=&v"(r[3][0]), "=&v"(r[3][1]), "=&v"(r[3][2]), "=&v"(r[3][3])
        : "v"(a0), "v"(a1), "v"(a2), "v"(a3) : "memory");
}
__device__ __forceinline__ void tr_read_3c(const unsigned char* img, int g, int lr, uint2 (&r)[3][4]) {
    const unsigned a0 = tr_lane_addr(img, 0, g, lr), a1 = tr_lane_addr(img, 1, g, lr), a2 = tr_lane_addr(img, 2, g, lr);
    asm volatile(TR_GROUP(0, 1, 2, 3, 12) TR_GROUP(4, 5, 6, 7, 13) TR_GROUP(8, 9, 10, 11, 14) "s_waitcnt lgkmcnt(0)"
        : "=&v"(r[0][0]), "=&v"(r[0][1]), "=&v"(r[0][2]), "=&v"(r[0][3]), "=&v"(r[1][0]), "=&v"(r[1][1]), "=&v"(r[1][2]), "=&v"(r[1][3]),
          "=&v"(r[2][0]), "=&v"(r[2][1]), "=&v"(r[2][2]), "=&v"(r[2][3])
        : "v"(a0), "v"(a1), "v"(a2) : "memory");
}
__device__ __forceinline__ void tr_read_2(const unsigned char* img0, int c0, const unsigned char* img1, int c1, int g, int lr, uint2 (&r)[2][4]) {
    const unsigned a0 = tr_lane_addr(img0, c0, g, lr), a1 = tr_lane_addr(img1, c1, g, lr);
    asm volatile(TR_GROUP(0, 1, 2, 3, 8) TR_GROUP(4, 5, 6, 7, 9) "s_waitcnt lgkmcnt(0)"
        : "=&v"(r[0][0]), "=&v"(r[0][1]), "=&v"(r[0][2]), "=&v"(r[0][3]), "=&v"(r[1][0]), "=&v"(r[1][1]), "=&v"(r[1][2]), "=&v"(r[1][3])
        : "v"(a0), "v"(a1) : "memory");
}
__device__ __forceinline__ bf16x8 tr_pair(const uint2& lo, const uint2& hi) { uint4 u; u.x = lo.x; u.y = lo.y; u.z = hi.x; u.w = hi.y; return __builtin_bit_cast(bf16x8, u); }

__device__ __forceinline__ void attn_block(const Params& P, int bh, int qb, unsigned char* smem) {
    const int tid = threadIdx.x, lane = tid & 63, w = tid >> 6, g = lane >> 4, lr = lane & 15;
    const int b = bh >> 3, h = bh & 7;
    const bf16_t* z = (const bf16_t*)(P.ws + WS_Z);
    const float* cum = (const float*)(P.ws + WS_CUM) + (size_t)bh * L;
    int tq[2]; bool qvalid[2]; bf16x8 qf[2][2]; float cq[2];
#pragma unroll
    for (int u = 0; u < 2; ++u) {
        tq[u] = qb * 128 + 32 * w + 16 * u + lr;
        qvalid[u] = tq[u] < L;
        const bf16_t* qp = z + (size_t)(b * L + (qvalid[u] ? tq[u] : 0)) * NZ + ZC_FQ + h * 64 + 8 * g;
        qf[u][0] = *(const bf16x8*)(qp); qf[u][1] = *(const bf16x8*)(qp + 32);
        cq[u] = cum[qvalid[u] ? tq[u] : 0];
    }
    const int nkv = (2 * qb + 2 < 33) ? 2 * qb + 2 : 33;
    const int srow0 = tid >> 3, sch = tid & 7;
    uint4 rk[2], rv[2]; float rc = 0.f;
    auto load_tile = [&](int kv) {
#pragma unroll
        for (int j = 0; j < 2; ++j) {
            const int key = kv * 64 + srow0 + 32 * j;
            if (key < L) {
                const bf16_t* p = z + (size_t)(b * L + key) * NZ + h * 64 + sch * 8;
                rk[j] = *(const uint4*)(p + ZC_FK); rv[j] = *(const uint4*)(p + ZC_FV);
            } else { rk[j] = make_uint4(0, 0, 0, 0); rv[j] = make_uint4(0, 0, 0, 0); }
        }
        if (tid < 64) { const int key = kv * 64 + tid; rc = key < L ? cum[key] : 0.f; }
    };
    auto store_tile = [&](int buf) {
        unsigned char* sK = smem + buf * 16384; unsigned char* sV = sK + 8192;
#pragma unroll
        for (int j = 0; j < 2; ++j) {
            const int row = srow0 + 32 * j;
            *(uint4*)(sK + row * 128 + ((sch ^ (row & 7)) << 4)) = rk[j];
            *(uint4*)(sV + vimg_off(row, sch)) = rv[j];
        }
        if (tid < 64) ((float*)(smem + 32768 + buf * 256))[tid] = rc;
    };
    float m[2] = {-INFINITY, -INFINITY}, lsum[2] = {0.f, 0.f};
    f32x4 o[2][4];
#pragma unroll
    for (int u = 0; u < 2; ++u)
#pragma unroll
        for (int c = 0; c < 4; ++c) o[u][c] = (f32x4){0.f, 0.f, 0.f, 0.f};
    load_tile(0); store_tile(0);
    __syncthreads();
    for (int kv = 0; kv < nkv; ++kv) {
        const int buf = kv & 1;
        if (kv + 1 < nkv) load_tile(kv + 1);
        const unsigned char* sK = smem + buf * 16384; const unsigned char* sV = sK + 8192;
        const float* sck = (const float*)(smem + 32768 + buf * 256);
        f32x4 sa[2][4];
#pragma unroll
        for (int c = 0; c < 4; ++c) {
            sa[0][c] = (f32x4){0.f, 0.f, 0.f, 0.f}; sa[1][c] = (f32x4){0.f, 0.f, 0.f, 0.f};
#pragma unroll
            for (int s = 0; s < 2; ++s) {
                const bf16x8 kf = *(const bf16x8*)(sK + (16 * c + lr) * 128 + (((4 * s + g) ^ (lr & 7)) << 4));
                sa[0][c] = __builtin_amdgcn_mfma_f32_16x16x32_bf16(kf, qf[0][s], sa[0][c], 0, 0, 0);
                sa[1][c] = __builtin_amdgcn_mfma_f32_16x16x32_bf16(kf, qf[1][s], sa[1][c], 0, 0, 0);
            }
        }
        const bool diag = (kv >= 2 * qb);
        bf16x8 pf[2][2];
#pragma unroll
        for (int u = 0; u < 2; ++u) {
            float mx = -INFINITY;
#pragma unroll
            for (int c = 0; c < 4; ++c) {
                const f32x4 ck = *(const f32x4*)(sck + 16 * c + 4 * g);
#pragma unroll
                for (int r = 0; r < 4; ++r) {
                    float v = sa[u][c][r] + (cq[u] - ck[r]);
                    if (diag && (64 * kv + 16 * c + 4 * g + r > tq[u])) v = -INFINITY;
                    sa[u][c][r] = v; mx = fmaxf(mx, v);
                }
            }
            mx = fmaxf(mx, __shfl_xor(mx, 16, 64)); mx = fmaxf(mx, __shfl_xor(mx, 32, 64));
            const float mn = fmaxf(m[u], mx);
            const float alpha = __builtin_amdgcn_exp2f(m[u] - mn);
            m[u] = mn;
            float ps = 0.f;
#pragma unroll
            for (int c = 0; c < 4; ++c)
#pragma unroll
                for (int r = 0; r < 4; ++r) { const float p = __builtin_amdgcn_exp2f(sa[u][c][r] - mn); sa[u][c][r] = p; ps += p; }
            lsum[u] = lsum[u] * alpha + ps;
#pragma unroll
            for (int c = 0; c < 4; ++c) o[u][c] *= alpha;
#pragma unroll
            for (int s2 = 0; s2 < 2; ++s2) {
                uint4 uu;
                uu.x = cvt_pk_bf16(sa[u][2 * s2][0], sa[u][2 * s2][1]); uu.y = cvt_pk_bf16(sa[u][2 * s2][2], sa[u][2 * s2][3]);
                uu.z = cvt_pk_bf16(sa[u][2 * s2 + 1][0], sa[u][2 * s2 + 1][1]); uu.w = cvt_pk_bf16(sa[u][2 * s2 + 1][2], sa[u][2 * s2 + 1][3]);
                pf[u][s2] = __builtin_bit_cast(bf16x8, uu);
            }
        }
        {
            uint2 vr[4][4];
            tr_read_4c(sV, g, lr, vr);
#pragma unroll
            for (int c = 0; c < 4; ++c)
#pragma unroll
                for (int s2 = 0; s2 < 2; ++s2) {
                    const bf16x8 vf = tr_pair(vr[c][2 * s2], vr[c][2 * s2 + 1]);
                    o[0][c] = __builtin_amdgcn_mfma_f32_16x16x32_bf16(vf, pf[0][s2], o[0][c], 0, 0, 0);
                    o[1][c] = __builtin_amdgcn_mfma_f32_16x16x32_bf16(vf, pf[1][s2], o[1][c], 0, 0, 0);
                }
        }
        if (kv + 1 < nkv) store_tile(buf ^ 1);
        __syncthreads();
    }
#pragma unroll
    for (int u = 0; u < 2; ++u) {
        float ls = lsum[u];
        ls += __shfl_xor(ls, 16, 64); ls += __shfl_xor(ls, 32, 64);
        const float inv = 1.0f / ls;
        if (qvalid[u]) {
            bf16_t* y = (bf16_t*)(P.ws + WS_Z) + (size_t)(b * L + tq[u]) * NZ + 512 + h * 64 + 4 * g;
#pragma unroll
            for (int c = 0; c < 4; ++c) {
                uint2 uu; uu.x = pk2(o[u][c][0] * inv, o[u][c][1] * inv); uu.y = pk2(o[u][c][2] * inv, o[u][c][3] * inv);
                *(uint2*)(y + 16 * c) = uu;
            }
        }
    }
}

__device__ __forceinline__ void conv_item(const Params& P, int ci) {
    const int tid = threadIdx.x, cc = tid & 127, rg = tid >> 7;
    const bf16_t* z = (const bf16_t*)(P.ws + WS_Z);
    bf16_t* qk = (bf16_t*)(P.ws + WS_RA);
    const int col0 = cc * 8;
    float w[4][8];
#pragma unroll
    for (int j = 0; j < 4; ++j) {
        const float4 a = *(const float4*)(P.conv_qk + j * 1024 + col0), b = *(const float4*)(P.conv_qk + j * 1024 + col0 + 4);
        w[j][0] = a.x; w[j][1] = a.y; w[j][2] = a.z; w[j][3] = a.w; w[j][4] = b.x; w[j][5] = b.y; w[j][6] = b.z; w[j][7] = b.w;
    }
    const float oscale = (col0 >= 512) ? 0.08838834764831845f : 1.0f;
    const int r0 = ci * 64 + rg * 32;
    int t = r0 % L;
    float xw[3][8];
#pragma unroll
    for (int j = 0; j < 3; ++j) {
        const int back = 3 - j;
        if (t - back >= 0) {
            const uint4 v = *(const uint4*)(z + (size_t)(r0 - back) * NZ + col0);
            xw[j][0] = bflo(v.x); xw[j][1] = bfhi(v.x); xw[j][2] = bflo(v.y); xw[j][3] = bfhi(v.y); xw[j][4] = bflo(v.z); xw[j][5] = bfhi(v.z); xw[j][6] = bflo(v.w); xw[j][7] = bfhi(v.w);
        } else {
#pragma unroll
            for (int e = 0; e < 8; ++e) xw[j][e] = 0.f;
        }
    }
#pragma unroll 2
    for (int i = 0; i < 32; ++i) {
        const int r = r0 + i;
        if (t == 0) {
#pragma unroll
            for (int j = 0; j < 3; ++j)
#pragma unroll
                for (int e = 0; e < 8; ++e) xw[j][e] = 0.f;
        }
        const uint4 v = *(const uint4*)(z + (size_t)r * NZ + col0);
        float xt[8];
        xt[0] = bflo(v.x); xt[1] = bfhi(v.x); xt[2] = bflo(v.y); xt[3] = bfhi(v.y); xt[4] = bflo(v.z); xt[5] = bfhi(v.z); xt[6] = bflo(v.w); xt[7] = bfhi(v.w);
        float o[8];
#pragma unroll
        for (int e = 0; e < 8; ++e) {
            const float cv = w[0][e] * xw[0][e] + w[1][e] * xw[1][e] + w[2][e] * xw[2][e] + w[3][e] * xt[e];
            o[e] = oscale * cv / (1.f + __expf(-cv));
            xw[0][e] = xw[1][e]; xw[1][e] = xw[2][e]; xw[2][e] = xt[e];
        }
        uint4 ov; ov.x = pk2(o[0], o[1]); ov.y = pk2(o[2], o[3]); ov.z = pk2(o[4], o[5]); ov.w = pk2(o[6], o[7]);
        *(uint4*)(qk + (size_t)r * 1024 + col0) = ov;
        t = (t + 1 == L) ? 0 : t + 1;
    }
}

constexpr int ST_IMG = 36864;
__device__ __forceinline__ int st_piece_off(int jt, int c, int g, int lr) { return (jt >> 2) * 18432 + vimg_off(16 * c + lr, 2 * (jt & 3) + (g >> 1)) + 8 * (g & 1); }

__device__ __forceinline__ void mlstm_stage_kv(const Params& P, int b, int h, int k, unsigned char* sKimg, unsigned char* sVimg, int tid) {
    const bf16_t* z = (const bf16_t*)(P.ws + WS_Z);
    const bf16_t* qk = (const bf16_t*)(P.ws + WS_RA);
    uint4 pk_[4], pv_[4];
#pragma unroll
    for (int j = 0; j < 4; ++j) {
        const int id = tid + 256 * j, row = id >> 4, ch16 = id & 15, pos = 64 * k + row;
        const bool ok = pos < L;
        pk_[j] = ok ? *(const uint4*)(qk + (size_t)(b * L + pos) * 1024 + 512 + h * 128 + ch16 * 8) : make_uint4(0, 0, 0, 0);
        pv_[j] = ok ? *(const uint4*)(z + (size_t)(b * L + pos) * NZ + ZC_MV + h * 128 + ch16 * 8) : make_uint4(0, 0, 0, 0);
    }
#pragma unroll
    for (int j = 0; j < 4; ++j) {
        const int id = tid + 256 * j, row = id >> 4, ch16 = id & 15;
        *(uint4*)(sKimg + (ch16 >> 3) * 8192 + vimg_off(row, ch16 & 7)) = pk_[j];
        *(uint4*)(sVimg + (ch16 >> 3) * 8192 + vimg_off(row, ch16 & 7)) = pv_[j];
    }
    if (tid < 128) {
        const int row = tid >> 1, ch = tid & 1;
        *(uint4*)(sVimg + 16384 + vimg_off(row, ch)) = ch ? make_uint4(0, 0, 0, 0) : make_uint4(0x3F80u, 0, 0, 0);
    }
}

__device__ __forceinline__ void mlstm_A(const Params& P, int item, unsigned char* smem) {
    const int tid = threadIdx.x, lane = tid & 63, w = tid >> 6, g = lane >> 4, lr = lane & 15;
    const int wu = __builtin_amdgcn_readfirstlane(w);
    const int k = item >> 5, bh = item & 31, b = bh >> 2, h = bh & 3;
    const float* gates = (const float*)(P.ws + WS_GATES);
    const unsigned char* sK = smem; const unsigned char* sV = smem + 16384;
    float* ga = (float*)(smem + 40960);
    mlstm_stage_kv(P, b, h, k, smem, smem + 16384, tid);
    if (wu == 0) {
        const int pos = 64 * k + lane;
        float lf = 0.f, li = -INFINITY;
        if (pos < L) { lf = gates[(size_t)(b * L + pos) * 16 + 4 + h]; li = gates[(size_t)(b * L + pos) * 16 + h]; }
        float bc = lf;
#pragma unroll
        for (int o = 1; o < 64; o <<= 1) { const float n = __shfl_up(bc, o, 64); if (lane >= o) bc += n; }
        const float a = li - bc;
        const float A = wave_max(a);
        ga[lane] = __expf(a - A);
        if (lane == 63) { float* msc = (float*)(P.ws + WS_MSC) + ((size_t)bh * 33 + k) * 4; msc[0] = A; msc[1] = bc; }
    }
    __syncthreads();
    f32x4 Ct[2][9];
#pragma unroll
    for (int a = 0; a < 2; ++a)
#pragma unroll
        for (int c = 0; c < 9; ++c) Ct[a][c] = (f32x4){0.f, 0.f, 0.f, 0.f};
    bf16x8 kt[2][2];
#pragma unroll
    for (int a = 0; a < 2; ++a)
#pragma unroll
        for (int s2 = 0; s2 < 2; ++s2) {
            const int jt = 2 * w + a;
            kt[a][s2] = tr_pair(tr_frag(sK + (jt >> 2) * 8192, 32 * s2, jt & 3, g, lr), tr_frag(sK + (jt >> 2) * 8192, 32 * s2 + 16, jt & 3, g, lr));
        }
    f32x4 wg4[4];
#pragma unroll
    for (int j = 0; j < 4; ++j) wg4[j] = *(const f32x4*)(ga + 16 * j + 4 * g);
#define MA_TILE(c, lo0, hi0, lo1, hi1) { \
        { const f32x4 w0 = wg4[0], w1 = wg4[1]; uint4 o; \
          o.x = cvt_pk_bf16(bflo(lo0.x) * w0[0], bfhi(lo0.x) * w0[1]); o.y = cvt_pk_bf16(bflo(lo0.y) * w0[2], bfhi(lo0.y) * w0[3]); \
          o.z = cvt_pk_bf16(bflo(hi0.x) * w1[0], bfhi(hi0.x) * w1[1]); o.w = cvt_pk_bf16(bflo(hi0.y) * w1[2], bfhi(hi0.y) * w1[3]); \
          const bf16x8 vw = __builtin_bit_cast(bf16x8, o); \
          Ct[0][c] = __builtin_amdgcn_mfma_f32_16x16x32_bf16(kt[0][0], vw, Ct[0][c], 0, 0, 0); Ct[1][c] = __builtin_amdgcn_mfma_f32_16x16x32_bf16(kt[1][0], vw, Ct[1][c], 0, 0, 0); } \
        { const f32x4 w0 = wg4[2], w1 = wg4[3]; uint4 o; \
          o.x = cvt_pk_bf16(bflo(lo1.x) * w0[0], bfhi(lo1.x) * w0[1]); o.y = cvt_pk_bf16(bflo(lo1.y) * w0[2], bfhi(lo1.y) * w0[3]); \
          o.z = cvt_pk_bf16(bflo(hi1.x) * w1[0], bfhi(hi1.x) * w1[1]); o.w = cvt_pk_bf16(bflo(hi1.y) * w1[2], bfhi(hi1.y) * w1[3]); \
          const bf16x8 vw = __builtin_bit_cast(bf16x8, o); \
          Ct[0][c] = __builtin_amdgcn_mfma_f32_16x16x32_bf16(kt[0][1], vw, Ct[0][c], 0, 0, 0); Ct[1][c] = __builtin_amdgcn_mfma_f32_16x16x32_bf16(kt[1][1], vw, Ct[1][c], 0, 0, 0); } }
    {
        uint2 vr[4][4];
        tr_read_4c(sV, g, lr, vr);
        MA_TILE(0, vr[0][0], vr[0][1], vr[0][2], vr[0][3]) MA_TILE(1, vr[1][0], vr[1][1], vr[1][2], vr[1][3])
        MA_TILE(2, vr[2][0], vr[2][1], vr[2][2], vr[2][3]) MA_TILE(3, vr[3][0], vr[3][1], vr[3][2], vr[3][3])
        tr_read_4c(sV + 8192, g, lr, vr);
        MA_TILE(4, vr[0][0], vr[0][1], vr[0][2], vr[0][3]) MA_TILE(5, vr[1][0], vr[1][1], vr[1][2], vr[1][3])
        MA_TILE(6, vr[2][0], vr[2][1], vr[2][2], vr[2][3]) MA_TILE(7, vr[3][0], vr[3][1], vr[3][2], vr[3][3])
        const uint2 o0 = tr_frag(sV + 16384, 0, 0, g, lr), o1 = tr_frag(sV + 16384, 16, 0, g, lr), o2 = tr_frag(sV + 16384, 32, 0, g, lr), o3 = tr_frag(sV + 16384, 48, 0, g, lr);
        MA_TILE(8, o0, o1, o2, o3)
    }
#undef MA_TILE
    unsigned char* slot = P.ws + WS_MST + ((size_t)bh * 33 + k) * ST_IMG;
#pragma unroll
    for (int a = 0; a < 2; ++a)
#pragma unroll
        for (int c = 0; c < 9; ++c) {
            uint2 u; u.x = cvt_pk_bf16(Ct[a][c][0], Ct[a][c][1]); u.y = cvt_pk_bf16(Ct[a][c][2], Ct[a][c][3]);
            *(uint2*)(slot + st_piece_off(2 * w + a, c, g, lr)) = u;
        }
}

__device__ __forceinline__ void mlstm_B(const Params& P, int item) {
    const int tid = threadIdx.x;
    const int bh = item / 3, part = item - bh * 3;
    const unsigned char* base = P.ws + WS_MST + (size_t)bh * 33 * ST_IMG + part * 12288 + tid * 48;
    unsigned char* obase = P.ws + WS_CBI + (size_t)bh * 33 * ST_IMG + part * 12288 + tid * 48;
    float* msc = (float*)(P.ws + WS_MSC) + (size_t)bh * 33 * 4;
    float C[6][4];
#pragma unroll
    for (int i = 0; i < 6; ++i)
#pragma unroll
        for (int r = 0; r < 4; ++r) C[i][r] = 0.f;
    float m = 0.f;
    uint2 d0[6], d1[6];
    float2 ab0, ab1;
#pragma unroll
    for (int i = 0; i < 6; ++i) { d0[i] = *(const uint2*)(base + i * 8); d1[i] = *(const uint2*)(base + ST_IMG + i * 8); }
    ab0 = *(const float2*)(msc); ab1 = *(const float2*)(msc + 4);
    for (int k = 0; k < 33; ++k) {
        uint2 d2[6]; float2 ab2 = make_float2(0.f, 0.f);
        if (k + 2 < 33) {
#pragma unroll
            for (int i = 0; i < 6; ++i) d2[i] = *(const uint2*)(base + (size_t)(k + 2) * ST_IMG + i * 8);
            ab2 = *(const float2*)(msc + (k + 2) * 4);
        } else {
#pragma unroll
            for (int i = 0; i < 6; ++i) d2[i] = make_uint2(0, 0);
        }
#pragma unroll
        for (int i = 0; i < 6; ++i) {
            uint2 u; u.x = cvt_pk_bf16(C[i][0], C[i][1]); u.y = cvt_pk_bf16(C[i][2], C[i][3]);
            *(uint2*)(obase + (size_t)k * ST_IMG + i * 8) = u;
        }
        if (tid == 0 && part == 0) msc[k * 4 + 2] = m;
        const float M = fmaxf(m, ab0.x);
        const float decay = __expf(m - M), sc = __expf(ab0.x - M);
#pragma unroll
        for (int i = 0; i < 6; ++i) {
            C[i][0] = decay * C[i][0] + sc * bflo(d0[i].x); C[i][1] = decay * C[i][1] + sc * bfhi(d0[i].x);
            C[i][2] = decay * C[i][2] + sc * bflo(d0[i].y); C[i][3] = decay * C[i][3] + sc * bfhi(d0[i].y);
        }
        m = ab0.y + M;
#pragma unroll
        for (int i = 0; i < 6; ++i) { d0[i] = d1[i]; d1[i] = d2[i]; }
        ab0 = ab1; ab1 = ab2;
    }
}

__device__ __forceinline__ void mlstm_C(const Params& P, int item, unsigned char* smem) {
    const int tid = threadIdx.x, lane = tid & 63, w = tid >> 6, g = lane >> 4, lr = lane & 15;
    const int wu = __builtin_amdgcn_readfirstlane(w);
    const int k = item >> 5, bh = item & 31, b = bh >> 2, h = bh & 3;
    const bf16_t* z = (const bf16_t*)(P.ws + WS_Z);
    const bf16_t* qk = (const bf16_t*)(P.ws + WS_RA);
    const float* gates = (const float*)(P.ws + WS_GATES);
    bf16_t* y = (bf16_t*)(P.ws + WS_Z);
    const unsigned char* sK = smem; const unsigned char* sV = smem + 36864; unsigned char* sCb = smem;
    float* ga = (float*)(smem + 61440);
    const int pos = 64 * k + 16 * w + lr;
    const bool tvalid = pos < L;
    const size_t rrow = (size_t)(b * L + (tvalid ? pos : 0));
    const unsigned char* cslot = P.ws + WS_CBI + ((size_t)bh * 33 + k) * ST_IMG + tid * 16;
    const uint4 cb0 = *(const uint4*)(cslot), cb1 = *(const uint4*)(cslot + 4096), cb2 = *(const uint4*)(cslot + 8192), cb3 = *(const uint4*)(cslot + 12288), cb4 = *(const uint4*)(cslot + 16384),
                cb5 = *(const uint4*)(cslot + 20480), cb6 = *(const uint4*)(cslot + 24576), cb7 = *(const uint4*)(cslot + 28672), cb8 = *(const uint4*)(cslot + 32768);
    bf16x8 qf[4];
    {
        const bf16_t* qp = qk + rrow * 1024 + h * 128 + 8 * g;
#pragma unroll
        for (int ks = 0; ks < 4; ++ks) { qf[ks] = *(const bf16x8*)(qp + 32 * ks); if (!tvalid) qf[ks] = (bf16x8){0, 0, 0, 0, 0, 0, 0, 0}; }
    }
    mlstm_stage_kv(P, b, h, k, smem, smem + 36864, tid);
    if (wu == 0) {
        const float m_prev = ((const float*)(P.ws + WS_MSC))[((size_t)bh * 33 + k) * 4 + 2];
        const int p2 = 64 * k + lane;
        float lf = 0.f, li = -INFINITY;
        if (p2 < L) { lf = gates[(size_t)(b * L + p2) * 16 + 4 + h]; li = gates[(size_t)(b * L + p2) * 16 + h]; }
        float bc = lf;
#pragma unroll
        for (int o = 1; o < 64; o <<= 1) { const float n = __shfl_up(bc, o, 64); if (lane >= o) bc += n; }
        const float a = li - bc;
        float am = a;
#pragma unroll
        for (int o = 1; o < 64; o <<= 1) { const float n = __shfl_up(am, o, 64); if (lane >= o) am = fmaxf(am, n); }
        const float M = fmaxf(m_prev, am);
        ga[lane] = a; ga[64 + lane] = __expf(m_prev - M); ga[128 + lane] = __expf(-(bc + M)); ga[192 + lane] = M;
    }
    __syncthreads();
    const float Mt = ga[192 + 16 * w + lr], Wi = ga[64 + 16 * w + lr], Et = ga[128 + 16 * w + lr];
    bf16x8 pf[2];
    {
        f32x4 sa[4];
#pragma unroll
        for (int c = 0; c < 4; ++c) {
            sa[c] = (f32x4){0.f, 0.f, 0.f, 0.f};
            if (c <= wu) {
#pragma unroll
                for (int ks = 0; ks < 4; ++ks) {
                    const bf16x8 kf = *(const bf16x8*)(sK + (ks >> 1) * 8192 + vimg_off(16 * c + lr, 4 * (ks & 1) + g));
                    sa[c] = __builtin_amdgcn_mfma_f32_16x16x32_bf16(kf, qf[ks], sa[c], 0, 0, 0);
                }
                const f32x4 av = *(const f32x4*)(ga + 16 * c + 4 * g);
#pragma unroll
                for (int r = 0; r < 4; ++r) {
                    const float d = __expf(av[r] - Mt);
                    sa[c][r] = (16 * c + 4 * g + r <= 16 * w + lr) ? sa[c][r] * d : 0.f;
                }
            }
        }
#pragma unroll
        for (int s2 = 0; s2 < 2; ++s2) {
            uint4 u;
            u.x = cvt_pk_bf16(sa[2 * s2][0], sa[2 * s2][1]); u.y = cvt_pk_bf16(sa[2 * s2][2], sa[2 * s2][3]);
            u.z = cvt_pk_bf16(sa[2 * s2 + 1][0], sa[2 * s2 + 1][1]); u.w = cvt_pk_bf16(sa[2 * s2 + 1][2], sa[2 * s2 + 1][3]);
            pf[s2] = __builtin_bit_cast(bf16x8, u);
        }
    }
    __syncthreads();
    {
        unsigned char* d = sCb + tid * 16;
        *(uint4*)(d) = cb0; *(uint4*)(d + 4096) = cb1; *(uint4*)(d + 8192) = cb2; *(uint4*)(d + 12288) = cb3; *(uint4*)(d + 16384) = cb4;
        *(uint4*)(d + 20480) = cb5; *(uint4*)(d + 24576) = cb6; *(uint4*)(d + 28672) = cb7; *(uint4*)(d + 32768) = cb8;
    }
    __syncthreads();
    f32x4 na[9];
#define MC_TILE(c, lo0, hi0, lo1, hi1) { \
        na[c] = (f32x4){0.f, 0.f, 0.f, 0.f}; \
        _Pragma("unroll") for (int ks = 0; ks < 4; ++ks) { \
            const bf16x8 cf = *(const bf16x8*)(sCb + (ks >> 1) * 18432 + vimg_off(16 * (c) + lr, 4 * (ks & 1) + g)); \
            na[c] = __builtin_amdgcn_mfma_f32_16x16x32_bf16(cf, qf[ks], na[c], 0, 0, 0); } \
        na[c] *= Wi; \
        na[c] = __builtin_amdgcn_mfma_f32_16x16x32_bf16(tr_pair(lo0, hi0), pf[0], na[c], 0, 0, 0); \
        na[c] = __builtin_amdgcn_mfma_f32_16x16x32_bf16(tr_pair(lo1, hi1), pf[1], na[c], 0, 0, 0); }
    {
        uint2 vr[4][4];
        tr_read_4c(sV, g, lr, vr);
        MC_TILE(0, vr[0][0], vr[0][1], vr[0][2], vr[0][3]) MC_TILE(1, vr[1][0], vr[1][1], vr[1][2], vr[1][3])
        MC_TILE(2, vr[2][0], vr[2][1], vr[2][2], vr[2][3]) MC_TILE(3, vr[3][0], vr[3][1], vr[3][2], vr[3][3])
        tr_read_4c(sV + 8192, g, lr, vr);
        MC_TILE(4, vr[0][0], vr[0][1], vr[0][2], vr[0][3]) MC_TILE(5, vr[1][0], vr[1][1], vr[1][2], vr[1][3])
        MC_TILE(6, vr[2][0], vr[2][1], vr[2][2], vr[2][3]) MC_TILE(7, vr[3][0], vr[3][1], vr[3][2], vr[3][3])
        const uint2 o0 = tr_frag(sV + 16384, 0, 0, g, lr), o1 = tr_frag(sV + 16384, 16, 0, g, lr), o2 = tr_frag(sV + 16384, 32, 0, g, lr), o3 = tr_frag(sV + 16384, 48, 0, g, lr);
        MC_TILE(8, o0, o1, o2, o3)
    }
#undef MC_TILE
    const float den = __shfl(na[8][0], lr, 64);
    const float rden = 1.0f / fmaxf(fabsf(den), Et);
    float hs = 0.f;
#pragma unroll
    for (int c = 0; c < 8; ++c) { na[c] *= rden; hs += na[c][0] * na[c][0] + na[c][1] * na[c][1] + na[c][2] * na[c][2] + na[c][3] * na[c][3]; }
    hs += __shfl_xor(hs, 16, 64); hs += __shfl_xor(hs, 32, 64);
    const float rstd = rsqrtf(hs * (1.0f / 128.0f) + EPS);
    const float* gainp = P.m_out_norm + h * 128 + 4 * g;
#pragma unroll
    for (int c = 0; c < 8; ++c) {
        const uint2 og = *(const uint2*)(z + rrow * NZ + ZC_MO + h * 128 + 16 * c + 4 * g);
        const float o0 = bflo(og.x), o1 = bfhi(og.x), o2 = bflo(og.y), o3 = bfhi(og.y);
        const float4 gn = *(const float4*)(gainp + 16 * c);
        uint2 u;
        u.x = pk2(na[c][0] * rstd * gn.x / (1.f + __expf(-o0)), na[c][1] * rstd * gn.y / (1.f + __expf(-o1)));
        u.y = pk2(na[c][2] * rstd * gn.z / (1.f + __expf(-o2)), na[c][3] * rstd * gn.w / (1.f + __expf(-o3)));
        if (tvalid) *(uint2*)(y + rrow * NZ + h * 128 + 16 * c + 4 * g) = u;
    }
}

__device__ __forceinline__ void peer_token(const Params& P, int t, int lane, int* sidx, float* sval, int* sid, float* sgate) {
    const unsigned* tk = (const unsigned*)(P.ws + WS_TK) + (size_t)t * 256;
#pragma unroll
    for (int i = 0; i < 4; ++i) {
        const unsigned k = tk[lane * 4 + i];
        sidx[lane * 4 + i] = 127 - (int)(k & 127u);
        sval[lane * 4 + i] = unord_key(k & ~127u);
    }
    __builtin_amdgcn_s_waitcnt(0xc07f);
    __builtin_amdgcn_wave_barrier();
    if (lane < 8) {
        const int hd = lane;
        float v0[16], v1[16];
#pragma unroll
        for (int i = 0; i < 16; ++i) { v0[i] = sval[(2 * hd) * 16 + i]; v1[i] = sval[(2 * hd + 1) * 16 + i]; }
        unsigned top[16];
#pragma unroll
        for (int i = 0; i < 16; ++i) top[i] = 0u;
#pragma unroll
        for (int i = 0; i < 16; ++i)
#pragma unroll
            for (int j = 0; j < 16; ++j)
                if ((i + 1) * (j + 1) <= 16) {
                    unsigned kx = (ord_key(v0[i] + v1[j]) & ~255u) | (unsigned)(255 - (i * 16 + j));
#pragma unroll
                    for (int q = 0; q < 16; ++q) { const unsigned hi = max(top[q], kx), lo = min(top[q], kx); top[q] = hi; kx = lo; }
                }
        const float smax = unord_key(top[0] & ~255u);
        float e[16]; float den = 0.f;
#pragma unroll
        for (int q = 0; q < 16; ++q) { e[q] = __expf(unord_key(top[q] & ~255u) - smax); den += e[q]; }
        const float inv = 1.f / den;
#pragma unroll
        for (int q = 0; q < 16; ++q) {
            const int pos = 255 - (int)(top[q] & 255u), i = pos >> 4, j = pos & 15;
            sid[hd * 16 + q] = sidx[(2 * hd) * 16 + i] * 128 + sidx[(2 * hd + 1) * 16 + j];
            sgate[hd * 16 + q] = e[q] * inv;
        }
    }
    __builtin_amdgcn_s_waitcnt(0xc07f);
    __builtin_amdgcn_wave_barrier();
    const bf16_t* xn = (const bf16_t*)(P.ws + WS_XN) + (size_t)t * DM;
    const float rstd = ((const float*)(P.ws + WS_RSTD))[t];
    const unsigned char* U = P.ws + WS_U + lane * 8;
    const unsigned char* V = P.ws + WS_V + lane * 8;
    const float* usc = (const float*)(P.ws + WS_USC);
    const float* vsc = (const float*)(P.ws + WS_VSC);
    f32x2 xf[8];
    {
        const uint4 xa = *(const uint4*)(xn + lane * 16), xb = *(const uint4*)(xn + lane * 16 + 8);
        xf[0] = (f32x2){bflo(xa.x), bfhi(xa.x)}; xf[1] = (f32x2){bflo(xa.y), bfhi(xa.y)}; xf[2] = (f32x2){bflo(xa.z), bfhi(xa.z)}; xf[3] = (f32x2){bflo(xa.w), bfhi(xa.w)};
        xf[4] = (f32x2){bflo(xb.x), bfhi(xb.x)}; xf[5] = (f32x2){bflo(xb.y), bfhi(xb.y)}; xf[6] = (f32x2){bflo(xb.z), bfhi(xb.z)}; xf[7] = (f32x2){bflo(xb.w), bfhi(xb.w)};
    }
    f32x2 acc[8];
#pragma unroll
    for (int j = 0; j < 8; ++j) acc[j] = (f32x2){0.f, 0.f};
    const int myq = ((lane >> 5) & 1) * 8 + ((lane >> 4) & 1) * 4 + ((lane >> 3) & 1) * 2 + ((lane >> 2) & 1);
#pragma unroll 1
    for (int e0 = 0; e0 < 128; e0 += 16) {
        uint2 ur[16], vr[16];
#pragma unroll
        for (int q = 0; q < 16; ++q) {
            const int id = sid[e0 + q];
            ur[q] = *(const uint2*)(U + (size_t)id * 512);
            vr[q] = *(const uint2*)(V + (size_t)id * 512);
        }
        const int myid = sid[e0 + myq];
        const float mysc = usc[myid] * rstd, myvs = vsc[myid] * sgate[e0 + myq];
        float d[16];
#pragma unroll
        for (int q = 0; q < 16; ++q) {
            f32x2 s2 = (f32x2){0.f, 0.f};
#define FP4_DOT(k) { s2 += xf[k] * __builtin_amdgcn_cvt_scalef32_pk_f32_fp4(ur[q].x, 1.0f, k); s2 += xf[4 + k] * __builtin_amdgcn_cvt_scalef32_pk_f32_fp4(ur[q].y, 1.0f, k); }
            FP4_DOT(0) FP4_DOT(1) FP4_DOT(2) FP4_DOT(3)
#undef FP4_DOT
            const float s0 = s2.x + s2.y;
            d[q] = s0;
        }
        float r8[8], r4[4], r2[2], r1;
#pragma unroll
        for (int i = 0; i < 8; ++i) { const bool up = (lane & 32) != 0; const float keep = up ? d[i + 8] : d[i], send = up ? d[i] : d[i + 8]; r8[i] = keep + __shfl_xor(send, 32, 64); }
#pragma unroll
        for (int i = 0; i < 4; ++i) { const bool up = (lane & 16) != 0; const float keep = up ? r8[i + 4] : r8[i], send = up ? r8[i] : r8[i + 4]; r4[i] = keep + __shfl_xor(send, 16, 64); }
#pragma unroll
        for (int i = 0; i < 2; ++i) { const bool up = (lane & 8) != 0; const float keep = up ? r4[i + 2] : r4[i], send = up ? r4[i] : r4[i + 2]; r2[i] = keep + __shfl_xor(send, 8, 64); }
        { const bool up = (lane & 4) != 0; const float keep = up ? r2[1] : r2[0], send = up ? r2[0] : r2[1]; r1 = keep + __shfl_xor(send, 4, 64); }
        r1 += __shfl_xor(r1, 2, 64); r1 += __shfl_xor(r1, 1, 64);
        const float a = r1 * mysc;
        const float wmine = myvs * 0.5f * a * (1.f + erff(a * 0.70710678118654752f));
#pragma unroll
        for (int q = 0; q < 16; ++q) {
            const float w = __shfl(wmine, ((q >> 3) & 1) * 32 + ((q >> 2) & 1) * 16 + ((q >> 1) & 1) * 8 + (q & 1) * 4, 64);
#define FP4_AXPY(k) { acc[k] += w * __builtin_amdgcn_cvt_scalef32_pk_f32_fp4(vr[q].x, 1.0f, k); acc[4 + k] += w * __builtin_amdgcn_cvt_scalef32_pk_f32_fp4(vr[q].y, 1.0f, k); }
            FP4_AXPY(0) FP4_AXPY(1) FP4_AXPY(2) FP4_AXPY(3)
#undef FP4_AXPY
        }
    }
    float* o = P.out + (size_t)t * DM + lane * 16;
    float4 h0 = *(float4*)(o), h1 = *(float4*)(o + 4), h2 = *(float4*)(o + 8), h3 = *(float4*)(o + 12);
    h0.x += acc[0].x; h0.y += acc[0].y; h0.z += acc[1].x; h0.w += acc[1].y; h1.x += acc[2].x; h1.y += acc[2].y; h1.z += acc[3].x; h1.w += acc[3].y;
    h2.x += acc[4].x; h2.y += acc[4].y; h2.z += acc[5].x; h2.w += acc[5].y; h3.x += acc[6].x; h3.y += acc[6].y; h3.z += acc[7].x; h3.w += acc[7].y;
    *(float4*)(o) = h0; *(float4*)(o + 4) = h1; *(float4*)(o + 8) = h2; *(float4*)(o + 12) = h3;
    __builtin_amdgcn_s_waitcnt(0xc07f);
    __builtin_amdgcn_wave_barrier();
}

#define LAS __attribute__((address_space(3)))
#define XB_TMO      128
#define XB_XCNT(j)  (256  + 64 * (j))
#define XB_XSUB(j)  (1280 + 64 * (j))
#define XB_XGEN(j)  (2304 + 64 * (j))
#define XB_TOP      3328
#define XB_TOPGEN   3392
#define XCD_BAR_WORDS 3456
#define XB_SPIN_CAP (1u << 18)
__device__ __forceinline__ unsigned xb_ld(unsigned* p)              { return __hip_atomic_load(p, __ATOMIC_RELAXED, __HIP_MEMORY_SCOPE_AGENT); }
__device__ __forceinline__ unsigned xb_add(unsigned* p, unsigned v) { return __hip_atomic_fetch_add(p, v, __ATOMIC_RELAXED, __HIP_MEMORY_SCOPE_AGENT); }
__device__ __forceinline__ unsigned xb_xcc_id() { return (unsigned)__builtin_amdgcn_s_getreg((3 << 11) | 20) & 0xFu; }
#define XB_SPIN(cond, bar) do { unsigned _sp = 0; while (cond) { __builtin_amdgcn_s_sleep(1); \
    if ((++_sp & 255u) == 0u) { if (xb_ld(&(bar)[XB_TMO])) break; if (_sp > XB_SPIN_CAP) { atomicAdd(&(bar)[XB_TMO], 1u); break; } } } } while (0)
struct XcdBarrier { unsigned* bar; unsigned x; volatile LAS unsigned* st; };
__device__ __forceinline__ XcdBarrier xcd_barrier_post(unsigned* bar, volatile LAS unsigned* st) {
    XcdBarrier b; b.bar = bar; b.x = xb_xcc_id(); b.st = st;
    if (threadIdx.x == 0) (void)xb_add(&bar[XB_XCNT(b.x)], 1u);
    return b;
}
__device__ __forceinline__ void xcd_barrier_complete(unsigned* bar, unsigned x, unsigned& nloc, unsigned& nx) {
    const unsigned G = gridDim.x * gridDim.y * gridDim.z;
    unsigned sum, cnt, mine, sp = 0u;
    for (;;) {
        sum = 0u; cnt = 0u; mine = 0u;
#pragma unroll
        for (unsigned j = 0; j < 16; ++j) { const unsigned c = xb_ld(&bar[XB_XCNT(j)]); sum += c; cnt += (c > 0u) ? 1u : 0u; mine = (j == x) ? c : mine; }
        if (sum == G) break;
        __builtin_amdgcn_s_sleep(1);
        if ((++sp & 255u) == 0u) { if (xb_ld(&bar[XB_TMO])) break; if (sp > XB_SPIN_CAP) { atomicAdd(&bar[XB_TMO], 1u); break; } }
    }
    nloc = mine > 0u ? mine : 1u; nx = cnt > 0u ? cnt : 1u;
}
__device__ __forceinline__ void xcd_barrier(const XcdBarrier& b) {
    asm volatile("s_waitcnt vmcnt(0)" ::: "memory");
    __syncthreads();
    if (threadIdx.x == 0) {
        unsigned* bar = b.bar;
        __builtin_amdgcn_s_waitcnt(0);
        unsigned nloc = b.st[0], nx = b.st[1];
        if (nloc == 0u) { xcd_barrier_complete(bar, b.x, nloc, nx); b.st[0] = nloc; b.st[1] = nx; }
        const unsigned old = xb_add(&bar[XB_XSUB(b.x)], 1u);
        const unsigned gen = old / nloc;
        if (old + 1u == (gen + 1u) * nloc) {
            __builtin_amdgcn_fence(__ATOMIC_RELEASE, "agent");
            asm volatile("s_waitcnt vmcnt(0)" ::: "memory");
            const unsigned og = xb_add(&bar[XB_TOP], 1u);
            const unsigned tg = og / nx;
            if (og + 1u == (tg + 1u) * nx) xb_add(&bar[XB_TOPGEN], 1u);
            else XB_SPIN(xb_ld(&bar[XB_TOPGEN]) == tg, bar);
            __builtin_amdgcn_fence(__ATOMIC_ACQUIRE, "agent");
            xb_add(&bar[XB_XGEN(b.x)], 1u);
            asm volatile("s_waitcnt vmcnt(0)" ::: "memory");
        } else {
            XB_SPIN(xb_ld(&bar[XB_XGEN(b.x)]) == gen, bar);
            __builtin_amdgcn_fence(__ATOMIC_ACQUIRE, "agent");
            asm volatile("s_waitcnt vmcnt(0)" ::: "memory");
        }
    }
    __syncthreads();
}

__device__ __forceinline__ void hand_release() { asm volatile("s_waitcnt vmcnt(0)" ::: "memory"); __builtin_amdgcn_fence(__ATOMIC_RELEASE, "agent"); asm volatile("s_waitcnt vmcnt(0)" ::: "memory"); }
__device__ __forceinline__ void hand_acquire() { __builtin_amdgcn_fence(__ATOMIC_ACQUIRE, "agent"); asm volatile("s_waitcnt vmcnt(0)" ::: "memory"); }

__global__ void __launch_bounds__(256, 2) mega(Params P) {
    extern __shared__ __attribute__((aligned(16))) unsigned char smem[];
    cg::grid_group grid = cg::this_grid();
    const int tid = threadIdx.x, lane = tid & 63, wave = tid >> 6;
    const int G = gridDim.x, bid = blockIdx.x;
    unsigned* ctl = (unsigned*)(P.ws + WS_CTL);
    volatile LAS unsigned* bst = (volatile LAS unsigned*)(smem + 65552);
    if (tid == 0) { bst[0] = 0u; bst[1] = 0u; }
    __syncthreads();
    if (bid == 0) for (int i = tid; i < 8192; i += 256) ctl[i] = 0u;
    grid.sync();
    const XcdBarrier xb = xcd_barrier_post(ctl + 1024, bst);
    phase0(P, smem);
    xcd_barrier(xb);
    {
        const int gw = bid * 4 + wave;
        if (gw < 64) fox_cum_wave(P, gw, lane);
        for (int tile = bid; tile < 129 * 28; tile += G) gemm_tile<1>(P, tile / 28, tile % 28, smem);
    }
    xcd_barrier(xb);
    {
        volatile int* s_item = (volatile int*)(smem + 65536);
        const int wave_u = __builtin_amdgcn_readfirstlane(wave);
        auto fetch = [&](unsigned* counter) -> int {
            if (wave_u == 0) {
                unsigned v = atomicAdd(counter, lane == 0 ? 1u : 0u);
                *s_item = (int)__builtin_amdgcn_readfirstlane(v);
            }
            __syncthreads();
            const int item = __builtin_amdgcn_readfirstlane(*s_item);
            __syncthreads();
            return item;
        };
        for (;;) {
            const int item = fetch(&ctl[0]);
            if (item >= 258) break;
            conv_item(P, item);
        }
        xcd_barrier(xb);
        for (;;) {
            const int item = fetch(&ctl[2]);
            if (item >= 33 * 32) break;
            mlstm_A(P, item, smem);
        }
        xcd_barrier(xb);
        for (;;) {
            const int item = fetch(&ctl[4]);
            if (item >= 96) break;
            mlstm_B(P, item);
        }
        for (;;) {
            const int item = fetch(&ctl[3]);
            if (item >= 64 * 17) break;
            attn_block(P, item & 63, 16 - (item >> 6), smem);
        }
        xcd_barrier(xb);
        for (;;) {
            const int item = fetch(&ctl[5]);
            if (item >= 33 * 32) break;
            mlstm_C(P, item, smem);
        }
    }
    xcd_barrier(xb);
    for (int tile = bid; tile < 128 * 8; tile += G) gemm_tile<2>(P, tile >> 3, tile & 7, smem);
    convert_uv_rows(P, bid * 4 + wave, G * 4, lane);
    xcd_barrier(xb);
    for (int tile = bid; tile < 128 * 16; tile += G) gemm_tile<3>(P, tile >> 4, tile & 15, smem);
    xcd_barrier(xb);
    {
        int* sidx = (int*)(smem + wave * 3072); float* sval = (float*)(smem + wave * 3072 + 1024);
        int* sid = (int*)(smem + wave * 3072 + 2048); float* sgate = (float*)(smem + wave * 3072 + 2560);
        for (int t = bid * 4 + wave; t < T2; t += G * 4) peer_token(P, t, lane, sidx, sval, sid, sgate);
    }
}

}

extern "C" void kernel_launch(void* const* d_in, const int* in_sizes, int n_in, void* d_out, int out_size, void* d_ws, size_t ws_size, hipStream_t stream) {
    if (n_in != 17 || ws_size < WS_END) { fprintf(stderr, "kernel_launch: unexpected n_in %d or ws_size %zu (need %zu)\n", n_in, ws_size, (size_t)WS_END); return; }
    constexpr int LDS_BYTES = 66560;
    static int grid_blocks = 0;
    if (!grid_blocks) {
        int dev = 0, cus = 0, per_cu = 0;
        (void)hipGetDevice(&dev);
        (void)hipDeviceGetAttribute(&cus, hipDeviceAttributeMultiprocessorCount, dev);
        (void)hipFuncSetAttribute((const void*)mega, hipFuncAttributeMaxDynamicSharedMemorySize, LDS_BYTES);
        (void)hipOccupancyMaxActiveBlocksPerMultiprocessor(&per_cu, (const void*)mega, 256, LDS_BYTES);
        if (per_cu < 1) per_cu = 1;
        if (per_cu > 2) per_cu = 2;
        grid_blocks = cus * per_cu;
        fprintf(stderr, "kernel_launch: cus %d per_cu %d grid %d\n", cus, per_cu, grid_blocks);
    }
    Params P{};
    P.x = (const float*)d_in[0]; P.meta = (const float*)d_in[1]; P.norm_mix = (const float*)d_in[2]; P.w_in = (const float*)d_in[3];
    P.conv_qk = (const float*)d_in[4]; P.b_igate = (const float*)d_in[5]; P.b_fgate_m = (const float*)d_in[6]; P.m_out_norm = (const float*)d_in[7];
    P.b_fgate_f = (const float*)d_in[8]; P.f_q_norm = (const float*)d_in[9]; P.f_k_norm = (const float*)d_in[10]; P.w_out = (const float*)d_in[11];
    P.norm_ffn = (const float*)d_in[12]; P.peer_query = (const float*)d_in[13]; P.peer_keys = (const float*)d_in[14]; P.peer_u = (const float*)d_in[15];
    P.peer_v = (const float*)d_in[16]; P.out = (float*)d_out; P.ws = (unsigned char*)d_ws;
    void* args[] = {&P};
    hipError_t e = hipLaunchCooperativeKernel((const void*)mega, dim3(grid_blocks), dim3(256), args, LDS_BYTES, stream);
    if (e != hipSuccess) fprintf(stderr, "cooperative launch failed: %s (grid %d)\n", hipGetErrorString(e), grid_blocks);
}
```

```cpp
#include <hip/hip_runtime.h>
#include <stdint.h>
#include <stdio.h>
#include <hip/hip_cooperative_groups.h>
namespace cg = cooperative_groups;

namespace {

constexpr int NB = 8, SEQ = 2048, DM = 1024, NMETA = 16, L = SEQ + NMETA;
constexpr int T1 = NB * L;
constexpr int T2 = NB * SEQ;
constexpr int NZ = 3584;
constexpr int ZC_MQ = 0, ZC_MK = 512, ZC_MV = 1024, ZC_MO = 1536, ZC_FQ = 2048, ZC_FK = 2560, ZC_FV = 3072;
constexpr int PROJ = 3600;
constexpr float EPS = 1e-6f;

constexpr size_t WS_CTL = 0;
constexpr size_t WS_RA = 65536;
constexpr size_t WS_Z = WS_RA + (size_t)T1 * DM * 2;
constexpr size_t WS_GATES = WS_Z + (size_t)T1 * NZ * 2;
constexpr size_t WS_CUM = WS_GATES + (size_t)T1 * 16 * 4;
constexpr size_t WS_SSQ = WS_CUM + (size_t)NB * 8 * L * 4;
constexpr size_t WS_RSTD = WS_SSQ + (size_t)T2 * 16 * 4;
constexpr size_t WS_SSQM = WS_RSTD + (size_t)T2 * 4;
constexpr size_t WS_BT2 = WS_SSQM + (size_t)T1 * 16 * 4;
constexpr size_t WS_BT3 = WS_BT2 + (size_t)DM * DM * 2;
constexpr size_t WS_KEYS = WS_BT3 + (size_t)2048 * DM * 2;
constexpr size_t WS_MSC = WS_KEYS + (size_t)16 * 128 * 128 * 2;
constexpr size_t WS_MST = WS_MSC + (size_t)128 * 33 * 16;
constexpr size_t WS_BT1 = WS_MST + (size_t)32 * 33 * 36864;
constexpr size_t WS_CBI = WS_BT1;
constexpr size_t WS_UV = WS_CBI + (size_t)32 * 33 * 36864;
constexpr size_t WS_END = WS_UV + (size_t)2 * 16384 * 512 + (size_t)2 * 16384 * 4;
constexpr size_t WS_XN = WS_RA;
constexpr size_t WS_U = WS_UV;
constexpr size_t WS_V = WS_U + (size_t)16384 * 512;
constexpr size_t WS_USC = WS_V + (size_t)16384 * 512;
constexpr size_t WS_VSC = WS_USC + (size_t)16384 * 4;
constexpr size_t WS_TK = WS_CBI;
constexpr float LOG2E = 1.4426950408889634f;

typedef unsigned short bf16_t;
typedef short bf16x8 __attribute__((ext_vector_type(8)));
typedef float f32x4 __attribute__((ext_vector_type(4)));
typedef __attribute__((ext_vector_type(2))) __bf16 bf16x2_t;

struct Params {
    const float* x; const float* meta; const float* norm_mix; const float* w_in; const float* conv_qk;
    const float* b_igate; const float* b_fgate_m; const float* m_out_norm; const float* b_fgate_f;
    const float* f_q_norm; const float* f_k_norm; const float* w_out; const float* norm_ffn;
    const float* peer_query; const float* peer_keys; const float* peer_u; const float* peer_v;
    float* out; unsigned char* ws;
};

__device__ __forceinline__ unsigned f2bf(float f) { unsigned u = __float_as_uint(f); return (u + 0x7fffu + ((u >> 16) & 1u)) >> 16; }
__device__ __forceinline__ float bf2f(unsigned h) { return __uint_as_float(h << 16); }
typedef float f32x2 __attribute__((ext_vector_type(2)));
typedef __bf16 bf16x2v __attribute__((ext_vector_type(2)));
__device__ __forceinline__ unsigned cvt_pk_bf16(float lo, float hi) { f32x2 v = {lo, hi}; bf16x2v b = __builtin_convertvector(v, bf16x2v); return __builtin_bit_cast(unsigned, b); }
__device__ __forceinline__ unsigned pk2(float lo, float hi) { return cvt_pk_bf16(lo, hi); }
__device__ __forceinline__ float bflo(unsigned w) { return __uint_as_float(w << 16); }
__device__ __forceinline__ float bfhi(unsigned w) { return __uint_as_float(w & 0xffff0000u); }
__device__ __forceinline__ float wave_sum(float v) {
#pragma unroll
    for (int o = 32; o > 0; o >>= 1) v += __shfl_xor(v, o, 64);
    return v;
}
__device__ __forceinline__ float wave_max(float v) {
#pragma unroll
    for (int o = 32; o > 0; o >>= 1) v = fmaxf(v, __shfl_xor(v, o, 64));
    return v;
}
__device__ __forceinline__ float logsigmoidf(float x) { return fminf(x, 0.f) - log1pf(expf(-fabsf(x))); }
__device__ __forceinline__ unsigned ord_key(float f) { unsigned u = __float_as_uint(f); return u ^ ((u >> 31) ? 0xffffffffu : 0x80000000u); }
__device__ __forceinline__ float unord_key(unsigned k) { unsigned u = (k & 0x80000000u) ? (k ^ 0x80000000u) : ~k; return __uint_as_float(u); }

__device__ __forceinline__ void phase0(const Params& P, unsigned char* smem) {
    const int tid = threadIdx.x, lane = tid & 63, wave = tid >> 6;
    unsigned* ctl = (unsigned*)(P.ws + WS_CTL);
    float* gw = (float*)smem;
    for (int idx = tid; idx < 16 * 1024; idx += 256) {
        const int k = idx >> 4, c = idx & 15;
        const int col = c < 8 ? 2048 + c : 3592 + (c - 8);
        gw[c * 1024 + k] = P.w_in[(size_t)k * PROJ + col];
    }
    __syncthreads();
    {
        bf16_t* hn = (bf16_t*)(P.ws + WS_RA);
        float* gates = (float*)(P.ws + WS_GATES);
        const int c0 = lane * 8, c1 = 512 + lane * 8;
        float gm[16];
        {
            const float4 a0 = *(const float4*)(P.norm_mix + c0), a1 = *(const float4*)(P.norm_mix + c0 + 4);
            const float4 a2 = *(const float4*)(P.norm_mix + c1), a3 = *(const float4*)(P.norm_mix + c1 + 4);
            gm[0] = a0.x; gm[1] = a0.y; gm[2] = a0.z; gm[3] = a0.w; gm[4] = a1.x; gm[5] = a1.y; gm[6] = a1.z; gm[7] = a1.w;
            gm[8] = a2.x; gm[9] = a2.y; gm[10] = a2.z; gm[11] = a2.w; gm[12] = a3.x; gm[13] = a3.y; gm[14] = a3.z; gm[15] = a3.w;
        }
        const int myq = ((lane >> 5) & 1) * 8 + ((lane >> 4) & 1) * 4 + ((lane >> 3) & 1) * 2 + ((lane >> 2) & 1);
        const float mybias = myq < 4 ? P.b_igate[myq] : (myq < 8 ? P.b_fgate_m[myq - 4] : P.b_fgate_f[myq - 8]);
        const int rstep = gridDim.x * 4;
        int r = blockIdx.x * 4 + wave;
        float4 n0, n1, n2, n3;
        auto load_row = [&](int rr) {
            const int b = rr / L, p = rr - b * L;
            const float* src = (p < NMETA) ? (P.meta + (size_t)p * DM) : (P.x + ((size_t)b * SEQ + (p - NMETA)) * DM);
            n0 = *(const float4*)(src + c0); n1 = *(const float4*)(src + c0 + 4); n2 = *(const float4*)(src + c1); n3 = *(const float4*)(src + c1 + 4);
        };
        if (r < T1) load_row(r);
        for (; r < T1; r += rstep) {
            float v[16];
            v[0] = n0.x; v[1] = n0.y; v[2] = n0.z; v[3] = n0.w; v[4] = n1.x; v[5] = n1.y; v[6] = n1.z; v[7] = n1.w;
            v[8] = n2.x; v[9] = n2.y; v[10] = n2.z; v[11] = n2.w; v[12] = n3.x; v[13] = n3.y; v[14] = n3.z; v[15] = n3.w;
            if (r + rstep < T1) load_row(r + rstep);
            float ss = 0.f;
#pragma unroll
            for (int j = 0; j < 16; ++j) ss += v[j] * v[j];
            ss = wave_sum(ss);
            const float rstd = rsqrtf(ss * (1.0f / DM) + EPS);
#pragma unroll
            for (int j = 0; j < 16; ++j) v[j] *= rstd * gm[j];
            uint4 o0, o1;
            o0.x = pk2(v[0], v[1]); o0.y = pk2(v[2], v[3]); o0.z = pk2(v[4], v[5]); o0.w = pk2(v[6], v[7]);
            o1.x = pk2(v[8], v[9]); o1.y = pk2(v[10], v[11]); o1.z = pk2(v[12], v[13]); o1.w = pk2(v[14], v[15]);
            *(uint4*)(hn + (size_t)r * DM + c0) = o0;
            *(uint4*)(hn + (size_t)r * DM + c1) = o1;
            float r8[8], r4[4], r2[2], r1;
#pragma unroll
            for (int i = 0; i < 8; ++i) {
                float dd[2];
#pragma unroll
                for (int hh = 0; hh < 2; ++hh) {
                    const float* gwc = gw + (i + 8 * hh) * 1024;
                    const float4 w0 = *(const float4*)(gwc + c0), w1 = *(const float4*)(gwc + c0 + 4), w2 = *(const float4*)(gwc + c1), w3 = *(const float4*)(gwc + c1 + 4);
                    dd[hh] = v[0] * w0.x + v[1] * w0.y + v[2] * w0.z + v[3] * w0.w + v[4] * w1.x + v[5] * w1.y + v[6] * w1.z + v[7] * w1.w
                           + v[8] * w2.x + v[9] * w2.y + v[10] * w2.z + v[11] * w2.w + v[12] * w3.x + v[13] * w3.y + v[14] * w3.z + v[15] * w3.w;
                }
                const bool up = (lane & 32) != 0; const float keep = up ? dd[1] : dd[0], send = up ? dd[0] : dd[1];
                r8[i] = keep + __shfl_xor(send, 32, 64);
                __builtin_amdgcn_sched_barrier(0);
            }
#pragma unroll
            for (int i = 0; i < 4; ++i) { const bool up = (lane & 16) != 0; const float keep = up ? r8[i + 4] : r8[i], send = up ? r8[i] : r8[i + 4]; r4[i] = keep + __shfl_xor(send, 16, 64); }
#pragma unroll
            for (int i = 0; i < 2; ++i) { const bool up = (lane & 8) != 0; const float keep = up ? r4[i + 2] : r4[i], send = up ? r4[i] : r4[i + 2]; r2[i] = keep + __shfl_xor(send, 8, 64); }
            { const bool up = (lane & 4) != 0; const float keep = up ? r2[1] : r2[0], send = up ? r2[0] : r2[1]; r1 = keep + __shfl_xor(send, 4, 64); }
            r1 += __shfl_xor(r1, 2, 64); r1 += __shfl_xor(r1, 1, 64);
            if ((lane & 3) == 0) {
                const float pre = r1 + mybias;
                gates[(size_t)r * 16 + myq] = myq < 4 ? pre : logsigmoidf(pre);
            }
        }
    }
    __syncthreads();
    {
        float (*tile)[65] = (float (*)[65])smem;
        for (int item = blockIdx.x; item < 1664; item += gridDim.x) {
            const float* W; int ldn, ntn, shift_from, it; bf16_t* out;
            if (item < 896) { W = P.w_in; ldn = PROJ; ntn = 56; shift_from = 2048; it = item; out = (bf16_t*)(P.ws + WS_BT1); }
            else if (item < 1152) { W = P.w_out; ldn = 1024; ntn = 16; shift_from = 1 << 30; it = item - 896; out = (bf16_t*)(P.ws + WS_BT2); }
            else { W = P.peer_query; ldn = 2048; ntn = 32; shift_from = 1 << 30; it = item - 1152; out = (bf16_t*)(P.ws + WS_BT3); }
            const int tk = it / ntn, tn = it - tk * ntn, k0 = tk * 64, n0 = tn * 64;
            {
                const int nl = tid & 63;
                int n = n0 + nl; if (n >= shift_from) n += 8;
#pragma unroll
                for (int i = 0; i < 16; ++i) { const int kl = (tid >> 6) + 4 * i; tile[kl][nl] = W[(size_t)(k0 + kl) * ldn + n]; }
            }
            __syncthreads();
            {
                const int kl = tid & 63;
#pragma unroll
                for (int i = 0; i < 16; ++i) { const int nl = (tid >> 6) + 4 * i; out[(size_t)(n0 + nl) * 1024 + k0 + kl] = (bf16_t)f2bf(tile[kl][nl]); }
            }
            __syncthreads();
        }
    }
    {
        const size_t gt = (size_t)blockIdx.x * 256 + tid, gs = (size_t)gridDim.x * 256;
        const float* src = P.peer_keys; bf16_t* dst = (bf16_t*)(P.ws + WS_KEYS);
        for (size_t i = gt; i < (size_t)(16 * 128 * 128 / 8); i += gs) {
            const float4 a = *(const float4*)(src + i * 8), b = *(const float4*)(src + i * 8 + 4);
            uint4 o; o.x = pk2(a.x, a.y); o.y = pk2(a.z, a.w); o.z = pk2(b.x, b.y); o.w = pk2(b.z, b.w);
            *(uint4*)(dst + i * 8) = o;
        }
    }
}

__device__ __forceinline__ void convert_uv_rows(const Params& P, int gwave, int nwaves, int lane) {
    for (int rr0 = gwave * 4; rr0 < 2 * 16384; rr0 += nwaves * 4) {
        float4 a[4][4];
#pragma unroll
        for (int q = 0; q < 4; ++q) {
            const int rr = rr0 + q, which = rr >> 14, row = rr & 16383;
            const float* src = (which ? P.peer_v : P.peer_u) + (size_t)row * DM + lane * 16;
            a[q][0] = *(const float4*)(src); a[q][1] = *(const float4*)(src + 4); a[q][2] = *(const float4*)(src + 8); a[q][3] = *(const float4*)(src + 12);
        }
#pragma unroll
        for (int q = 0; q < 4; ++q) {
            const int rr = rr0 + q, which = rr >> 14, row = rr & 16383;
            float mx = 0.f;
#pragma unroll
            for (int j = 0; j < 4; ++j) mx = fmaxf(mx, fmaxf(fmaxf(fabsf(a[q][j].x), fabsf(a[q][j].y)), fmaxf(fabsf(a[q][j].z), fabsf(a[q][j].w))));
            mx = wave_max(mx);
            const float sc = mx > 0.f ? 6.0f / mx : 1.0f;
            unsigned w0 = 0u, w1 = 0u;
            w0 = __builtin_amdgcn_cvt_scalef32_pk_fp4_f32(w0, a[q][0].x * sc, a[q][0].y * sc, 1.0f, 0); w0 = __builtin_amdgcn_cvt_scalef32_pk_fp4_f32(w0, a[q][0].z * sc, a[q][0].w * sc, 1.0f, 1);
            w0 = __builtin_amdgcn_cvt_scalef32_pk_fp4_f32(w0, a[q][1].x * sc, a[q][1].y * sc, 1.0f, 2); w0 = __builtin_amdgcn_cvt_scalef32_pk_fp4_f32(w0, a[q][1].z * sc, a[q][1].w * sc, 1.0f, 3);
            w1 = __builtin_amdgcn_cvt_scalef32_pk_fp4_f32(w1, a[q][2].x * sc, a[q][2].y * sc, 1.0f, 0); w1 = __builtin_amdgcn_cvt_scalef32_pk_fp4_f32(w1, a[q][2].z * sc, a[q][2].w * sc, 1.0f, 1);
            w1 = __builtin_amdgcn_cvt_scalef32_pk_fp4_f32(w1, a[q][3].x * sc, a[q][3].y * sc, 1.0f, 2); w1 = __builtin_amdgcn_cvt_scalef32_pk_fp4_f32(w1, a[q][3].z * sc, a[q][3].w * sc, 1.0f, 3);
            *(uint2*)(P.ws + (which ? WS_V : WS_U) + (size_t)row * 512 + lane * 8) = make_uint2(w0, w1);
            if (lane == 0) ((float*)(P.ws + (which ? WS_VSC : WS_USC)))[row] = mx > 0.f ? mx * (1.0f / 6.0f) : 1.0f;
        }
    }
}

__device__ __forceinline__ void bitonic_sort16_desc(unsigned (&v)[16]) {
#pragma unroll
    for (int k = 2; k <= 16; k <<= 1)
#pragma unroll
        for (int j = k >> 1; j >= 1; j >>= 1)
#pragma unroll
            for (int i = 0; i < 16; ++i)
                if ((i & j) == 0) {
                    const int p = i | j;
                    const bool desc = (k >= 16) ? true : ((i & k) == 0);
                    const unsigned hi = max(v[i], v[p]), lo = min(v[i], v[p]);
                    v[i] = desc ? hi : lo; v[p] = desc ? lo : hi;
                }
}
__device__ __forceinline__ void bitonic_merge16_top(unsigned (&a)[16], const unsigned (&b)[16]) {
#pragma unroll
    for (int i = 0; i < 16; ++i) a[i] = max(a[i], b[15 - i]);
#pragma unroll
    for (int j = 8; j >= 1; j >>= 1)
#pragma unroll
        for (int i = 0; i < 16; ++i)
            if ((i & j) == 0) { const int p = i | j; const unsigned hi = max(a[i], a[p]), lo = min(a[i], a[p]); a[i] = hi; a[p] = lo; }
}

__device__ __forceinline__ void mma_ktile(const unsigned char* sA, const unsigned char* sB, int arow_off, int brow_off, int g, int sw, f32x4 (&acc)[4][4]) {
#pragma unroll
    for (int s = 0; s < 2; ++s) {
        bf16x8 a[4], b[4];
        const int ch = (((s * 4 + g) ^ sw) << 4);
#pragma unroll
        for (int i = 0; i < 4; ++i) a[i] = *(const bf16x8*)(sA + arow_off + i * 2048 + ch);
#pragma unroll
        for (int j = 0; j < 4; ++j) b[j] = *(const bf16x8*)(sB + brow_off + j * 2048 + ch);
#pragma unroll
        for (int i = 0; i < 4; ++i)
#pragma unroll
            for (int j = 0; j < 4; ++j) acc[i][j] = __builtin_amdgcn_mfma_f32_16x16x32_bf16(b[j], a[i], acc[i][j], 0, 0, 0);
    }
}

__device__ __forceinline__ void store_tile_bf16(const f32x4 (&acc)[4][4], unsigned char* smem, bf16_t* dst, size_t ld, int m0, int n0, int tid, int wr, int wc, int g, int lr) {
#pragma unroll
    for (int i = 0; i < 4; ++i)
#pragma unroll
        for (int j = 0; j < 4; ++j) {
            const int row = wr * 64 + 16 * i + lr, col = wc * 64 + 16 * j + 4 * g;
            uint2 w; w.x = pk2(acc[i][j][0], acc[i][j][1]); w.y = pk2(acc[i][j][2], acc[i][j][3]);
            *(uint2*)(smem + row * 272 + col * 2) = w;
        }
    __syncthreads();
#pragma unroll
    for (int q = 0; q < 8; ++q) {
        const int id = tid + 256 * q, row = id >> 4, ch = id & 15;
        const uint4 v = *(const uint4*)(smem + row * 272 + ch * 16);
        *(uint4*)(dst + (size_t)(m0 + row) * ld + n0 + ch * 8) = v;
    }
    __syncthreads();
}

template <int MODE>
__device__ __forceinline__ void gemm_tile(const Params& P, int tm, int tn, unsigned char* smem) {
    const bf16_t* A; const bf16_t* Bt;
    if (MODE == 1) { A = (const bf16_t*)(P.ws + WS_RA); Bt = (const bf16_t*)(P.ws + WS_BT1); }
    else if (MODE == 2) { A = (const bf16_t*)(P.ws + WS_Z); Bt = (const bf16_t*)(P.ws + WS_BT2); }
    else { A = (const bf16_t*)(P.ws + WS_XN); Bt = (const bf16_t*)(P.ws + WS_BT3); }
    const int tid = threadIdx.x, lane = tid & 63, wave = tid >> 6, wr = wave >> 1, wc = wave & 1, g = lane >> 4, lr = lane & 15;
    const int m0 = tm * 128, n0 = tn * 128;
    const int srow = tid >> 3, sc = tid & 7;
    const bf16_t* aptr[4]; const bf16_t* bptr[4]; int soff[4];
#pragma unroll
    for (int j = 0; j < 4; ++j) {
        const int row = srow + 32 * j;
        int ar = m0 + row;
        if (MODE == 2) { const int b = ar >> 11, t = ar & 2047; ar = b * L + NMETA + t; }
        aptr[j] = A + (size_t)ar * (MODE == 2 ? NZ : 1024) + sc * 8;
        bptr[j] = Bt + (size_t)(n0 + row) * 1024 + sc * 8;
        soff[j] = row * 128 + ((sc ^ (row & 7)) << 4);
    }
    f32x4 acc[4][4];
#pragma unroll
    for (int i = 0; i < 4; ++i)
#pragma unroll
        for (int j = 0; j < 4; ++j) acc[i][j] = (f32x4){0.f, 0.f, 0.f, 0.f};
    uint4 ra[4], rb[4];
#pragma unroll
    for (int j = 0; j < 4; ++j) { ra[j] = *(const uint4*)(aptr[j]); rb[j] = *(const uint4*)(bptr[j]); }
    unsigned char* sA0 = smem; unsigned char* sB0 = smem + 16384; unsigned char* sA1 = smem + 32768; unsigned char* sB1 = smem + 49152;
#pragma unroll
    for (int j = 0; j < 4; ++j) { *(uint4*)(sA0 + soff[j]) = ra[j]; *(uint4*)(sB0 + soff[j]) = rb[j]; }
    __syncthreads();
    const int arow_off = (wr * 64 + lr) * 128, brow_off = (wc * 64 + lr) * 128, sw = lr & 7;
    for (int kt = 0; kt < 16; ++kt) {
        unsigned char* sA = (kt & 1) ? sA1 : sA0; unsigned char* sB = (kt & 1) ? sB1 : sB0;
        unsigned char* nA = (kt & 1) ? sA0 : sA1; unsigned char* nB = (kt & 1) ? sB0 : sB1;
        if (kt < 15) {
#pragma unroll
            for (int j = 0; j < 4; ++j) { ra[j] = *(const uint4*)(aptr[j] + (kt + 1) * 64); rb[j] = *(const uint4*)(bptr[j] + (kt + 1) * 64); }
        }
        mma_ktile(sA, sB, arow_off, brow_off, g, sw, acc);
        if (kt < 15) {
#pragma unroll
            for (int j = 0; j < 4; ++j) { *(uint4*)(nA + soff[j]) = ra[j]; *(uint4*)(nB + soff[j]) = rb[j]; }
        }
        __syncthreads();
    }
    if (MODE == 1) {
        if (n0 >= ZC_FQ && n0 < ZC_FV) {
            const bool isk = n0 >= ZC_FK;
            const float* gain = isk ? P.f_k_norm : P.f_q_norm;
            const float scl = isk ? 1.0f : 0.125f * LOG2E;
            float gn[4][4];
#pragma unroll
            for (int j = 0; j < 4; ++j)
#pragma unroll
                for (int r = 0; r < 4; ++r) gn[j][r] = gain[16 * j + 4 * g + r];
#pragma unroll
            for (int i = 0; i < 4; ++i) {
                float ss = 0.f;
#pragma unroll
                for (int j = 0; j < 4; ++j)
#pragma unroll
                    for (int r = 0; r < 4; ++r) ss += acc[i][j][r] * acc[i][j][r];
                ss += __shfl_xor(ss, 16, 64); ss += __shfl_xor(ss, 32, 64);
                const float rstd = rsqrtf(ss * (1.0f / 64.0f) + EPS) * scl;
#pragma unroll
                for (int j = 0; j < 4; ++j)
#pragma unroll
                    for (int r = 0; r < 4; ++r) acc[i][j][r] *= rstd * gn[j][r];
            }
        }
        store_tile_bf16(acc, smem, (bf16_t*)(P.ws + WS_Z), NZ, m0, n0, tid, wr, wc, g, lr);
    } else if (MODE == 2) {
        float* ssq = (float*)(P.ws + WS_SSQ);
#pragma unroll
        for (int i = 0; i < 4; ++i) {
            const int row = m0 + wr * 64 + 16 * i + lr;
            float ss = 0.f;
#pragma unroll
            for (int j = 0; j < 4; ++j) {
                const int col = n0 + wc * 64 + 16 * j + 4 * g;
                const float4 xv = *(const float4*)(P.x + (size_t)row * DM + col);
                const float4 gv = *(const float4*)(P.norm_ffn + col);
                float4 hv; hv.x = acc[i][j][0] + xv.x; hv.y = acc[i][j][1] + xv.y; hv.z = acc[i][j][2] + xv.z; hv.w = acc[i][j][3] + xv.w;
                ss += hv.x * hv.x + hv.y * hv.y + hv.z * hv.z + hv.w * hv.w;
                acc[i][j][0] = hv.x * gv.x; acc[i][j][1] = hv.y * gv.y; acc[i][j][2] = hv.z * gv.z; acc[i][j][3] = hv.w * gv.w;
            }
            ss += __shfl_xor(ss, 16, 64); ss += __shfl_xor(ss, 32, 64);
            if (g == 0) ssq[(size_t)row * 16 + tn * 2 + wc] = ss;
        }
        store_tile_bf16(acc, smem, (bf16_t*)(P.ws + WS_XN), 1024, m0, n0, tid, wr, wc, g, lr);
    } else {
        const int hp = tn;
        const float* ssq = (const float*)(P.ws + WS_SSQ);
        float rs[4];
#pragma unroll
        for (int i = 0; i < 4; ++i) {
            const int row = m0 + wr * 64 + 16 * i + lr;
            const float4 p0 = *(const float4*)(ssq + (size_t)row * 16), p1 = *(const float4*)(ssq + (size_t)row * 16 + 4);
            const float4 p2 = *(const float4*)(ssq + (size_t)row * 16 + 8), p3 = *(const float4*)(ssq + (size_t)row * 16 + 12);
            const float s = ((p0.x + p0.y) + (p0.z + p0.w)) + ((p1.x + p1.y) + (p1.z + p1.w)) + ((p2.x + p2.y) + (p2.z + p2.w)) + ((p3.x + p3.y) + (p3.z + p3.w));
            rs[i] = rsqrtf(s * (1.0f / DM) + EPS);
            if (tn == 0 && wc == 0 && g == 0) ((float*)(P.ws + WS_RSTD))[row] = rs[i];
        }
        {
            unsigned char* sAq = wc ? sA1 : sA0;
#pragma unroll
            for (int i = 0; i < 4; ++i)
#pragma unroll
                for (int j = 0; j < 4; ++j) {
                    const int row = wr * 64 + 16 * i + lr;
                    const int chunk = 2 * j + (g >> 1);
                    uint2 w; w.x = pk2(acc[i][j][0] * rs[i], acc[i][j][1] * rs[i]); w.y = pk2(acc[i][j][2] * rs[i], acc[i][j][3] * rs[i]);
                    *(uint2*)(sAq + row * 128 + ((chunk ^ (row & 7)) << 4) + 8 * (g & 1)) = w;
                }
            const bf16_t* keys = (const bf16_t*)(P.ws + WS_KEYS) + (size_t)hp * 128 * 128;
#pragma unroll
            for (int j = 0; j < 4; ++j) {
                const int row = srow + 32 * j;
                const uint4 k0 = *(const uint4*)(keys + (size_t)row * 128 + sc * 8);
                const uint4 k1 = *(const uint4*)(keys + (size_t)row * 128 + 64 + sc * 8);
                *(uint4*)(sB0 + soff[j]) = k0; *(uint4*)(sB1 + soff[j]) = k1;
            }
        }
        __syncthreads();
#pragma unroll
        for (int i = 0; i < 4; ++i)
#pragma unroll
            for (int j = 0; j < 4; ++j) acc[i][j] = (f32x4){0.f, 0.f, 0.f, 0.f};
        mma_ktile(sA0, sB0, arow_off, brow_off, g, sw, acc);
        mma_ktile(sA1, sB1, arow_off, brow_off, g, sw, acc);
        __syncthreads();
#pragma unroll
        for (int i = 0; i < 4; ++i)
#pragma unroll
            for (int j = 0; j < 4; ++j) {
                const int row = wr * 64 + 16 * i + lr;
                const int c4 = wc * 16 + 4 * j + g;
                *(f32x4*)(smem + row * 512 + ((c4 ^ (row & 31)) << 4)) = acc[i][j];
            }
        __syncthreads();
        unsigned top[16];
        const int row = tid & 127, half = tid >> 7;
        {
            auto load_keys = [&](unsigned (&dst)[16], int q4) {
#pragma unroll
                for (int s4 = 0; s4 < 4; ++s4) {
                    const int c4 = half * 16 + q4 * 4 + s4;
                    const f32x4 v = *(const f32x4*)(smem + row * 512 + ((c4 ^ (row & 31)) << 4));
#pragma unroll
                    for (int e = 0; e < 4; ++e) dst[s4 * 4 + e] = (ord_key(v[e]) & ~127u) | (unsigned)(127 - (c4 * 4 + e));
                }
            };
            load_keys(top, 0);
            bitonic_sort16_desc(top);
#pragma unroll 1
            for (int q4 = 1; q4 < 4; ++q4) {
                unsigned gq[16];
                load_keys(gq, q4);
                bitonic_sort16_desc(gq);
                bitonic_merge16_top(top, gq);
            }
        }
        __syncthreads();
        if (half) {
            uint4* lp = (uint4*)(smem + row * 64);
            lp[0] = make_uint4(top[0], top[1], top[2], top[3]); lp[1] = make_uint4(top[4], top[5], top[6], top[7]);
            lp[2] = make_uint4(top[8], top[9], top[10], top[11]); lp[3] = make_uint4(top[12], top[13], top[14], top[15]);
        }
        __syncthreads();
        if (!half) {
            const uint4* lp = (const uint4*)(smem + row * 64);
            unsigned other[16];
#pragma unroll
            for (int c = 0; c < 4; ++c) { const uint4 o = lp[c]; other[4 * c] = o.x; other[4 * c + 1] = o.y; other[4 * c + 2] = o.z; other[4 * c + 3] = o.w; }
            bitonic_merge16_top(top, other);
            uint4* tk = (uint4*)((unsigned*)(P.ws + WS_TK) + ((size_t)(m0 + row) * 16 + hp) * 16);
            tk[0] = make_uint4(top[0], top[1], top[2], top[3]); tk[1] = make_uint4(top[4], top[5], top[6], top[7]);
            tk[2] = make_uint4(top[8], top[9], top[10], top[11]); tk[3] = make_uint4(top[12], top[13], top[14], top[15]);
        }
        __syncthreads();
    }
}

__device__ __forceinline__ void fox_cum_wave(const Params& P, int bh, int lane) {
    const int b = bh >> 3, h = bh & 7;
    const float* gates = (const float*)(P.ws + WS_GATES);
    float* cum = (float*)(P.ws + WS_CUM) + (size_t)bh * L;
    constexpr int SEG = 33;
    const int t0 = lane * SEG;
    float loc = 0.f;
    for (int i = 0; i < SEG; ++i) { const int t = t0 + i; if (t < L) loc += gates[(size_t)(b * L + t) * 16 + 8 + h]; }
    float incl = loc;
#pragma unroll
    for (int o = 1; o < 64; o <<= 1) { const float n = __shfl_up(incl, o, 64); if (lane >= o) incl += n; }
    float run = incl - loc;
    for (int i = 0; i < SEG; ++i) { const int t = t0 + i; if (t < L) { run += gates[(size_t)(b * L + t) * 16 + 8 + h]; cum[t] = run * LOG2E; } }
}

#define TR_SLOW 0

__device__ __forceinline__ int vimg_off(int row, int ch) { return row * 128 + ((ch ^ (((row >> 1) & 3) << 1)) << 4); }
__device__ __forceinline__ uint2 tr_frag(const unsigned char* img, int row0, int c, int g, int lr) {
#if TR_SLOW
    unsigned short e[4];
#pragma unroll
    for (int k = 0; k < 4; ++k) { const int row = row0 + 4 * g + k, col = 16 * c + lr; e[k] = *(const unsigned short*)(img + vimg_off(row, col >> 3) + (col & 7) * 2); }
    uint2 r; r.x = (unsigned)e[0] | ((unsigned)e[1] << 16); r.y = (unsigned)e[2] | ((unsigned)e[3] << 16); return r;
#else
    const int q = lr >> 2, p = lr & 3, row = row0 + 4 * g + q;
    const unsigned addr = (unsigned)(size_t)(img + vimg_off(row, 2 * c + (p >> 1)) + 8 * (p & 1));
    uint2 r;
    asm volatile("ds_read_b64_tr_b16 %0, %1\n\ts_waitcnt lgkmcnt(0)" : "=&v"(r) : "v"(addr) : "memory");
    return r;
#endif
}

__device__ __forceinline__ unsigned tr_lane_addr(const unsigned char* img, int c, int g, int lr) {
    const int q = lr >> 2, p = lr & 3, row = 4 * g + q;
    return (unsigned)(size_t)(img + vimg_off(row, 2 * c + (p >> 1)) + 8 * (p & 1));
}
#define TR_GROUP(o0, o1, o2, o3, a) "ds_read_b64_tr_b16 %" #o0 ", %" #a "\n\tds_read_b64_tr_b16 %" #o1 ", %" #a " offset:2048\n\tds_read_b64_tr_b16 %" #o2 ", %" #a " offset:4096\n\tds_read_b64_tr_b16 %" #o3 ", %" #a " offset:6144\n\t"
__device__ __forceinline__ void tr_read_4c(const unsigned char* img, int g, int lr, uint2 (&r)[4][4]) {
    const unsigned a0 = tr_lane_addr(img, 0, g, lr), a1 = tr_lane_addr(img, 1, g, lr), a2 = tr_lane_addr(img, 2, g, lr), a3 = tr_lane_addr(img, 3, g, lr);
    asm volatile(TR_GROUP(0, 1, 2, 3, 16) TR_GROUP(4, 5, 6, 7, 17) TR_GROUP(8, 9, 10, 11, 18) TR_GROUP(12, 13, 14, 15, 19) "s_waitcnt lgkmcnt(0)"
        : "=&v"(r[0][0]), "=&v"(r[0][1]), "=&v"(r[0][2]), "=&v"(r[0][3]), "=&v"(r[1][0]), "=&v"(r[1][1]), "=&v"(r[1][2]), "=&v"(r[1][3]),
          "=&v"(r[2][0]), "=&v"(r[2][1]), "=&v"(r[2][2]), "=&v"(r[2][3]), "=&v"(r[3][0]), "=&v"(r[3][1]), "=&v"(r[3][2]), "=&v"(r[3][3])
        : "v"(a0), "v"(a1), "v"(a2), "v"(a3) : "memory");
}
__device__ __forceinline__ void tr_read_3c(const unsigned char* img, int g, int lr, uint2 (&r)[3][4]) {
    const unsigned a0 = tr_lane_addr(img, 0, g, lr), a1 = tr_lane_addr(img, 1, g, lr), a2 = tr_lane_addr(img, 2, g, lr);
    asm volatile(TR_GROUP(0, 1, 2, 3, 12) TR_GROUP(4, 5, 6, 7, 13) TR_GROUP(8, 9, 10, 11, 14) "s_waitcnt lgkmcnt(0)"
        : "=&v"(r[0][0]), "=&v"(r[0][1]), "=&v"(r[0][2]), "=&v"(r[0][3]), "=&v"(r[1][0]), "=&v"(r[1][1]), "=&v"(r[1][2]), "=&v"(r[1][3]),
          "=&v"(r[2][0]), "=&v"(r[2][1]), "=&v"(r[2][2]), "=&v"(r[2][3])
        : "v"(a0), "v"(a1), "v"(a2) : "memory");
}
__device__ __forceinline__ void tr_read_2(const unsigned char* img0, int c0, const unsigned char* img1, int c1, int g, int lr, uint2 (&r)[2][4]) {
    const unsigned a0 = tr_lane_addr(img0, c0, g, lr), a1 = tr_lane_addr(img1, c1, g, lr);
    asm volatile(TR_GROUP(0, 1, 2, 3, 8) TR_GROUP(4, 5, 6, 7, 9) "s_waitcnt lgkmcnt(0)"
        : "=&v"(r[0][0]), "=&v"(r[0][1]), "=&v"(r[0][2]), "=&v"(r[0][3]), "=&v"(r[1][0]), "=&v"(r[1][1]), "=&v"(r[1][2]), "=&v"(r[1][3])
        : "v"(a0), "v"(a1) : "memory");
}
__device__ __forceinline__ bf16x8 tr_pair(const uint2& lo, const uint2& hi) { uint4 u; u.x = lo.x; u.y = lo.y; u.z = hi.x; u.w = hi.y; return __builtin_bit_cast(bf16x8, u); }

__device__ __forceinline__ void attn_block(const Params& P, int bh, int qb, unsigned char* smem) {
    const int tid = threadIdx.x, lane = tid & 63, w = tid >> 6, g = lane >> 4, lr = lane & 15;
    const int b = bh >> 3, h = bh & 7;
    const bf16_t* z = (const bf16_t*)(P.ws + WS_Z);
    const float* cum = (const float*)(P.ws + WS_CUM) + (size_t)bh * L;
    int tq[2]; bool qvalid[2]; bf16x8 qf[2][2]; float cq[2];
#pragma unroll
    for (int u = 0; u < 2; ++u) {
        tq[u] = qb * 128 + 32 * w + 16 * u + lr;
        qvalid[u] = tq[u] < L;
        const bf16_t* qp = z + (size_t)(b * L + (qvalid[u] ? tq[u] : 0)) * NZ + ZC_FQ + h * 64 + 8 * g;
        qf[u][0] = *(const bf16x8*)(qp); qf[u][1] = *(const bf16x8*)(qp + 32);
        cq[u] = cum[qvalid[u] ? tq[u] : 0];
    }
    const int nkv = (2 * qb + 2 < 33) ? 2 * qb + 2 : 33;
    const int srow0 = tid >> 3, sch = tid & 7;
    uint4 rk[2], rv[2]; float rc = 0.f;
    auto load_tile = [&](int kv) {
#pragma unroll
        for (int j = 0; j < 2; ++j) {
            const int key = kv * 64 + srow0 + 32 * j;
            if (key < L) {
                const bf16_t* p = z + (size_t)(b * L + key) * NZ + h * 64 + sch * 8;
                rk[j] = *(const uint4*)(p + ZC_FK); rv[j] = *(const uint4*)(p + ZC_FV);
            } else { rk[j] = make_uint4(0, 0, 0, 0); rv[j] = make_uint4(0, 0, 0, 0); }
        }
        if (tid < 64) { const int key = kv * 64 + tid; rc = key < L ? cum[key] : 0.f; }
    };
    auto store_tile = [&](int buf) {
        unsigned char* sK = smem + buf * 16384; unsigned char* sV = sK + 8192;
#pragma unroll
        for (int j = 0; j < 2; ++j) {
            const int row = srow0 + 32 * j;
            *(uint4*)(sK + row * 128 + ((sch ^ (row & 7)) << 4)) = rk[j];
            *(uint4*)(sV + vimg_off(row, sch)) = rv[j];
        }
        if (tid < 64) ((float*)(smem + 32768 + buf * 256))[tid] = rc;
    };
    float m[2] = {-INFINITY, -INFINITY}, lsum[2] = {0.f, 0.f};
    f32x4 o[2][4];
#pragma unroll
    for (int u = 0; u < 2; ++u)
#pragma unroll
        for (int c = 0; c < 4; ++c) o[u][c] = (f32x4){0.f, 0.f, 0.f, 0.f};
    load_tile(0); store_tile(0);
    __syncthreads();
    for (int kv = 0; kv < nkv; ++kv) {
        const int buf = kv & 1;
        if (kv + 1 < nkv) load_tile(kv + 1);
        const unsigned char* sK = smem + buf * 16384; const unsigned char* sV = sK + 8192;
        const float* sck = (const float*)(smem + 32768 + buf * 256);
        f32x4 sa[2][4];
#pragma unroll
        for (int c = 0; c < 4; ++c) {
            sa[0][c] = (f32x4){0.f, 0.f, 0.f, 0.f}; sa[1][c] = (f32x4){0.f, 0.f, 0.f, 0.f};
#pragma unroll
            for (int s = 0; s < 2; ++s) {
                const bf16x8 kf = *(const bf16x8*)(sK + (16 * c + lr) * 128 + (((4 * s + g) ^ (lr & 7)) << 4));
                sa[0][c] = __builtin_amdgcn_mfma_f32_16x16x32_bf16(kf, qf[0][s], sa[0][c], 0, 0, 0);
                sa[1][c] = __builtin_amdgcn_mfma_f32_16x16x32_bf16(kf, qf[1][s], sa[1][c], 0, 0, 0);
            }
        }
        const bool diag = (kv >= 2 * qb);
        bf16x8 pf[2][2];
#pragma unroll
        for (int u = 0; u < 2; ++u) {
            float mx = -INFINITY;
#pragma unroll
            for (int c = 0; c < 4; ++c) {
                const f32x4 ck = *(const f32x4*)(sck + 16 * c + 4 * g);
#pragma unroll
                for (int r = 0; r < 4; ++r) {
                    float v = sa[u][c][r] + (cq[u] - ck[r]);
                    if (diag && (64 * kv + 16 * c + 4 * g + r > tq[u])) v = -INFINITY;
                    sa[u][c][r] = v; mx = fmaxf(mx, v);
                }
            }
            mx = fmaxf(mx, __shfl_xor(mx, 16, 64)); mx = fmaxf(mx, __shfl_xor(mx, 32, 64));
            const float mn = fmaxf(m[u], mx);
            const float alpha = __builtin_amdgcn_exp2f(m[u] - mn);
            m[u] = mn;
            float ps = 0.f;
#pragma unroll
            for (int c = 0; c < 4; ++c)
#pragma unroll
                for (int r = 0; r < 4; ++r) { const float p = __builtin_amdgcn_exp2f(sa[u][c][r] - mn); sa[u][c][r] = p; ps += p; }
            lsum[u] = lsum[u] * alpha + ps;
#pragma unroll
            for (int c = 0; c < 4; ++c) o[u][c] *= alpha;
#pragma unroll
            for (int s2 = 0; s2 < 2; ++s2) {
                uint4 uu;
                uu.x = cvt_pk_bf16(sa[u][2 * s2][0], sa[u][2 * s2][1]); uu.y = cvt_pk_bf16(sa[u][2 * s2][2], sa[u][2 * s2][3]);
                uu.z = cvt_pk_bf16(sa[u][2 * s2 + 1][0], sa[u][2 * s2 + 1][1]); uu.w = cvt_pk_bf16(sa[u][2 * s2 + 1][2], sa[u][2 * s2 + 1][3]);
                pf[u][s2] = __builtin_bit_cast(bf16x8, uu);
            }
        }
        {
            uint2 vr[4][4];
            tr_read_4c(sV, g, lr, vr);
#pragma unroll
            for (int c = 0; c < 4; ++c)
#pragma unroll
                for (int s2 = 0; s2 < 2; ++s2) {
                    const bf16x8 vf = tr_pair(vr[c][2 * s2], vr[c][2 * s2 + 1]);
                    o[0][c] = __builtin_amdgcn_mfma_f32_16x16x32_bf16(vf, pf[0][s2], o[0][c], 0, 0, 0);
                    o[1][c] = __builtin_amdgcn_mfma_f32_16x16x32_bf16(vf, pf[1][s2], o[1][c], 0, 0, 0);
                }
        }
        if (kv + 1 < nkv) store_tile(buf ^ 1);
        __syncthreads();
    }
#pragma unroll
    for (int u = 0; u < 2; ++u) {
        float ls = lsum[u];
        ls += __shfl_xor(ls, 16, 64); ls += __shfl_xor(ls, 32, 64);
        const float inv = 1.0f / ls;
        if (qvalid[u]) {
            bf16_t* y = (bf16_t*)(P.ws + WS_Z) + (size_t)(b * L + tq[u]) * NZ + 512 + h * 64 + 4 * g;
#pragma unroll
            for (int c = 0; c < 4; ++c) {
                uint2 uu; uu.x = pk2(o[u][c][0] * inv, o[u][c][1] * inv); uu.y = pk2(o[u][c][2] * inv, o[u][c][3] * inv);
                *(uint2*)(y + 16 * c) = uu;
            }
        }
    }
}

__device__ __forceinline__ void conv_item(const Params& P, int ci) {
    const int tid = threadIdx.x, cc = tid & 127, rg = tid >> 7;
    const bf16_t* z = (const bf16_t*)(P.ws + WS_Z);
    bf16_t* qk = (bf16_t*)(P.ws + WS_RA);
    const int col0 = cc * 8;
    float w[4][8];
#pragma unroll
    for (int j = 0; j < 4; ++j) {
        const float4 a = *(const float4*)(P.conv_qk + j * 1024 + col0), b = *(const float4*)(P.conv_qk + j * 1024 + col0 + 4);
        w[j][0] = a.x; w[j][1] = a.y; w[j][2] = a.z; w[j][3] = a.w; w[j][4] = b.x; w[j][5] = b.y; w[j][6] = b.z; w[j][7] = b.w;
    }
    const float oscale = (col0 >= 512) ? 0.08838834764831845f : 1.0f;
    const int r0 = ci * 64 + rg * 32;
    int t = r0 % L;
    float xw[3][8];
#pragma unroll
    for (int j = 0; j < 3; ++j) {
        const int back = 3 - j;
        if (t - back >= 0) {
            const uint4 v = *(const uint4*)(z + (size_t)(r0 - back) * NZ + col0);
            xw[j][0] = bflo(v.x); xw[j][1] = bfhi(v.x); xw[j][2] = bflo(v.y); xw[j][3] = bfhi(v.y); xw[j][4] = bflo(v.z); xw[j][5] = bfhi(v.z); xw[j][6] = bflo(v.w); xw[j][7] = bfhi(v.w);
        } else {
#pragma unroll
            for (int e = 0; e < 8; ++e) xw[j][e] = 0.f;
        }
    }
#pragma unroll 2
    for (int i = 0; i < 32; ++i) {
        const int r = r0 + i;
        if (t == 0) {
#pragma unroll
            for (int j = 0; j < 3; ++j)
#pragma unroll
                for (int e = 0; e < 8; ++e) xw[j][e] = 0.f;
        }
        const uint4 v = *(const uint4*)(z + (size_t)r * NZ + col0);
        float xt[8];
        xt[0] = bflo(v.x); xt[1] = bfhi(v.x); xt[2] = bflo(v.y); xt[3] = bfhi(v.y); xt[4] = bflo(v.z); xt[5] = bfhi(v.z); xt[6] = bflo(v.w); xt[7] = bfhi(v.w);
        float o[8];
#pragma unroll
        for (int e = 0; e < 8; ++e) {
            const float cv = w[0][e] * xw[0][e] + w[1][e] * xw[1][e] + w[2][e] * xw[2][e] + w[3][e] * xt[e];
            o[e] = oscale * cv / (1.f + __expf(-cv));
            xw[0][e] = xw[1][e]; xw[1][e] = xw[2][e]; xw[2][e] = xt[e];
        }
        uint4 ov; ov.x = pk2(o[0], o[1]); ov.y = pk2(o[2], o[3]); ov.z = pk2(o[4], o[5]); ov.w = pk2(o[6], o[7]);
        *(uint4*)(qk + (size_t)r * 1024 + col0) = ov;
        t = (t + 1 == L) ? 0 : t + 1;
    }
}

constexpr int ST_IMG = 36864;
__device__ __forceinline__ int st_piece_off(int jt, int c, int g, int lr) { return (jt >> 2) * 18432 + vimg_off(16 * c + lr, 2 * (jt & 3) + (g >> 1)) + 8 * (g & 1); }

__device__ __forceinline__ void mlstm_stage_kv(const Params& P, int b, int h, int k, unsigned char* sKimg, unsigned char* sVimg, int tid) {
    const bf16_t* z = (const bf16_t*)(P.ws + WS_Z);
    const bf16_t* qk = (const bf16_t*)(P.ws + WS_RA);
    uint4 pk_[4], pv_[4];
#pragma unroll
    for (int j = 0; j < 4; ++j) {
        const int id = tid + 256 * j, row = id >> 4, ch16 = id & 15, pos = 64 * k + row;
        const bool ok = pos < L;
        pk_[j] = ok ? *(const uint4*)(qk + (size_t)(b * L + pos) * 1024 + 512 + h * 128 + ch16 * 8) : make_uint4(0, 0, 0, 0);
        pv_[j] = ok ? *(const uint4*)(z + (size_t)(b * L + pos) * NZ + ZC_MV + h * 128 + ch16 * 8) : make_uint4(0, 0, 0, 0);
    }
#pragma unroll
    for (int j = 0; j < 4; ++j) {
        const int id = tid + 256 * j, row = id >> 4, ch16 = id & 15;
        *(uint4*)(sKimg + (ch16 >> 3) * 8192 + vimg_off(row, ch16 & 7)) = pk_[j];
        *(uint4*)(sVimg + (ch16 >> 3) * 8192 + vimg_off(row, ch16 & 7)) = pv_[j];
    }
    if (tid < 128) {
        const int row = tid >> 1, ch = tid & 1;
        *(uint4*)(sVimg + 16384 + vimg_off(row, ch)) = ch ? make_uint4(0, 0, 0, 0) : make_uint4(0x3F80u, 0, 0, 0);
    }
}

__device__ __forceinline__ void mlstm_stage_A(const Params& P, int b, int h, int k, unsigned char* sKimg, unsigned char* sVimg, int tid) {
    const bf16_t* z = (const bf16_t*)(P.ws + WS_Z);
    bf16_t* qk = (bf16_t*)(P.ws + WS_RA);
    uint4 pv_[4];
#pragma unroll
    for (int j = 0; j < 4; ++j) {
        const int id = tid + 256 * j, row = id >> 4, ch16 = id & 15, pos = 64 * k + row;
        pv_[j] = (pos < L) ? *(const uint4*)(z + (size_t)(b * L + pos) * NZ + ZC_MV + h * 128 + ch16 * 8) : make_uint4(0, 0, 0, 0);
    }
    const int cch = tid & 31, rg = tid >> 5, isk = cch >> 4;
    const int zcol = (isk ? ZC_MK : ZC_MQ) + h * 128 + (cch & 15) * 8;
    float w[4][8];
#pragma unroll
    for (int j = 0; j < 4; ++j) {
        const float4 a = *(const float4*)(P.conv_qk + j * 1024 + zcol), c = *(const float4*)(P.conv_qk + j * 1024 + zcol + 4);
        w[j][0] = a.x; w[j][1] = a.y; w[j][2] = a.z; w[j][3] = a.w; w[j][4] = c.x; w[j][5] = c.y; w[j][6] = c.z; w[j][7] = c.w;
    }
    const float oscale = isk ? 0.08838834764831845f : 1.0f;
    const int p0 = 64 * k + 8 * rg;
    uint4 raw[11];
#pragma unroll
    for (int i = 0; i < 11; ++i) {
        const int pos = p0 - 3 + i;
        raw[i] = (pos >= 0 && pos < L) ? *(const uint4*)(z + (size_t)(b * L + pos) * NZ + zcol) : make_uint4(0, 0, 0, 0);
    }
#pragma unroll
    for (int j = 0; j < 4; ++j) {
        const int id = tid + 256 * j, row = id >> 4, ch16 = id & 15;
        *(uint4*)(sVimg + (ch16 >> 3) * 8192 + vimg_off(row, ch16 & 7)) = pv_[j];
    }
    if (tid < 128) {
        const int row = tid >> 1, ch = tid & 1;
        *(uint4*)(sVimg + 16384 + vimg_off(row, ch)) = ch ? make_uint4(0, 0, 0, 0) : make_uint4(0x3F80u, 0, 0, 0);
    }
#pragma unroll
    for (int i = 0; i < 8; ++i) {
        const int pos = p0 + i, row = 8 * rg + i;
        float o[8];
#pragma unroll
        for (int e = 0; e < 8; ++e) {
            const unsigned w0 = (&raw[i].x)[e >> 1], w1 = (&raw[i + 1].x)[e >> 1], w2 = (&raw[i + 2].x)[e >> 1], w3 = (&raw[i + 3].x)[e >> 1];
            const float x0 = (e & 1) ? bfhi(w0) : bflo(w0), x1 = (e & 1) ? bfhi(w1) : bflo(w1), x2 = (e & 1) ? bfhi(w2) : bflo(w2), x3 = (e & 1) ? bfhi(w3) : bflo(w3);
            const float cv = w[0][e] * x0 + w[1][e] * x1 + w[2][e] * x2 + w[3][e] * x3;
            o[e] = oscale * cv / (1.f + __expf(-cv));
        }
        uint4 ov; ov.x = pk2(o[0], o[1]); ov.y = pk2(o[2], o[3]); ov.z = pk2(o[4], o[5]); ov.w = pk2(o[6], o[7]);
        const bool ok = pos < L;
        if (!ok) ov = make_uint4(0, 0, 0, 0);
        if (ok) *(uint4*)(qk + (size_t)(b * L + pos) * 1024 + (isk ? 512 : 0) + h * 128 + (cch & 15) * 8) = ov;
        if (isk) { const int ch16 = cch & 15; *(uint4*)(sKimg + (ch16 >> 3) * 8192 + vimg_off(row, ch16 & 7)) = ov; }
    }
}

__device__ __forceinline__ void mlstm_A(const Params& P, int item, unsigned char* smem) {
    const int tid = threadIdx.x, lane = tid & 63, w = tid >> 6, g = lane >> 4, lr = lane & 15;
    const int wu = __builtin_amdgcn_readfirstlane(w);
    const int k = item >> 5, bh = item & 31, b = bh >> 2, h = bh & 3;
    const float* gates = (const float*)(P.ws + WS_GATES);
    const unsigned char* sK = smem; const unsigned char* sV = smem + 16384;
    float* ga = (float*)(smem + 40960);
    mlstm_stage_A(P, b, h, k, smem, smem + 16384, tid);
    if (wu == 0) {
        const int pos = 64 * k + lane;
        float lf = 0.f, li = -INFINITY;
        if (pos < L) { lf = gates[(size_t)(b * L + pos) * 16 + 4 + h]; li = gates[(size_t)(b * L + pos) * 16 + h]; }
        float bc = lf;
#pragma unroll
        for (int o = 1; o < 64; o <<= 1) { const float n = __shfl_up(bc, o, 64); if (lane >= o) bc += n; }
        const float a = li - bc;
        const float A = wave_max(a);
        ga[lane] = __expf(a - A);
        if (lane == 63) { float* msc = (float*)(P.ws + WS_MSC) + ((size_t)bh * 33 + k) * 4; msc[0] = A; msc[1] = bc; }
    }
    __syncthreads();
    f32x4 Ct[2][9];
#pragma unroll
    for (int a = 0; a < 2; ++a)
#pragma unroll
        for (int c = 0; c < 9; ++c) Ct[a][c] = (f32x4){0.f, 0.f, 0.f, 0.f};
    bf16x8 kt[2][2];
#pragma unroll
    for (int a = 0; a < 2; ++a)
#pragma unroll
        for (int s2 = 0; s2 < 2; ++s2) {
            const int jt = 2 * w + a;
            kt[a][s2] = tr_pair(tr_frag(sK + (jt >> 2) * 8192, 32 * s2, jt & 3, g, lr), tr_frag(sK + (jt >> 2) * 8192, 32 * s2 + 16, jt & 3, g, lr));
        }
    f32x4 wg4[4];
#pragma unroll
    for (int j = 0; j < 4; ++j) wg4[j] = *(const f32x4*)(ga + 16 * j + 4 * g);
#define MA_TILE(c, lo0, hi0, lo1, hi1) { \
        { const f32x4 w0 = wg4[0], w1 = wg4[1]; uint4 o; \
          o.x = cvt_pk_bf16(bflo(lo0.x) * w0[0], bfhi(lo0.x) * w0[1]); o.y = cvt_pk_bf16(bflo(lo0.y) * w0[2], bfhi(lo0.y) * w0[3]); \
          o.z = cvt_pk_bf16(bflo(hi0.x) * w1[0], bfhi(hi0.x) * w1[1]); o.w = cvt_pk_bf16(bflo(hi0.y) * w1[2], bfhi(hi0.y) * w1[3]); \
          const bf16x8 vw = __builtin_bit_cast(bf16x8, o); \
          Ct[0][c] = __builtin_amdgcn_mfma_f32_16x16x32_bf16(kt[0][0], vw, Ct[0][c], 0, 0, 0); Ct[1][c] = __builtin_amdgcn_mfma_f32_16x16x32_bf16(kt[1][0], vw, Ct[1][c], 0, 0, 0); } \
        { const f32x4 w0 = wg4[2], w1 = wg4[3]; uint4 o; \
          o.x = cvt_pk_bf16(bflo(lo1.x) * w0[0], bfhi(lo1.x) * w0[1]); o.y = cvt_pk_bf16(bflo(lo1.y) * w0[2], bfhi(lo1.y) * w0[3]); \
          o.z = cvt_pk_bf16(bflo(hi1.x) * w1[0], bfhi(hi1.x) * w1[1]); o.w = cvt_pk_bf16(bflo(hi1.y) * w1[2], bfhi(hi1.y) * w1[3]); \
          const bf16x8 vw = __builtin_bit_cast(bf16x8, o); \
          Ct[0][c] = __builtin_amdgcn_mfma_f32_16x16x32_bf16(kt[0][1], vw, Ct[0][c], 0, 0, 0); Ct[1][c] = __builtin_amdgcn_mfma_f32_16x16x32_bf16(kt[1][1], vw, Ct[1][c], 0, 0, 0); } }
    {
        uint2 vr[4][4];
        tr_read_4c(sV, g, lr, vr);
        MA_TILE(0, vr[0][0], vr[0][1], vr[0][2], vr[0][3]) MA_TILE(1, vr[1][0], vr[1][1], vr[1][2], vr[1][3])
        MA_TILE(2, vr[2][0], vr[2][1], vr[2][2], vr[2][3]) MA_TILE(3, vr[3][0], vr[3][1], vr[3][2], vr[3][3])
        tr_read_4c(sV + 8192, g, lr, vr);
        MA_TILE(4, vr[0][0], vr[0][1], vr[0][2], vr[0][3]) MA_TILE(5, vr[1][0], vr[1][1], vr[1][2], vr[1][3])
        MA_TILE(6, vr[2][0], vr[2][1], vr[2][2], vr[2][3]) MA_TILE(7, vr[3][0], vr[3][1], vr[3][2], vr[3][3])
        const uint2 o0 = tr_frag(sV + 16384, 0, 0, g, lr), o1 = tr_frag(sV + 16384, 16, 0, g, lr), o2 = tr_frag(sV + 16384, 32, 0, g, lr), o3 = tr_frag(sV + 16384, 48, 0, g, lr);
        MA_TILE(8, o0, o1, o2, o3)
    }
#undef MA_TILE
    unsigned char* slot = P.ws + WS_MST + ((size_t)bh * 33 + k) * ST_IMG;
#pragma unroll
    for (int a = 0; a < 2; ++a)
#pragma unroll
        for (int c = 0; c < 9; ++c) {
            uint2 u; u.x = cvt_pk_bf16(Ct[a][c][0], Ct[a][c][1]); u.y = cvt_pk_bf16(Ct[a][c][2], Ct[a][c][3]);
            *(uint2*)(slot + st_piece_off(2 * w + a, c, g, lr)) = u;
        }
}

__device__ __forceinline__ void mlstm_B(const Params& P, int item) {
    const int tid = threadIdx.x;
    const int bh = item / 3, part = item - bh * 3;
    const unsigned char* base = P.ws + WS_MST + (size_t)bh * 33 * ST_IMG + part * 12288 + tid * 48;
    unsigned char* obase = P.ws + WS_CBI + (size_t)bh * 33 * ST_IMG + part * 12288 + tid * 48;
    float* msc = (float*)(P.ws + WS_MSC) + (size_t)bh * 33 * 4;
    float C[6][4];
#pragma unroll
    for (int i = 0; i < 6; ++i)
#pragma unroll
        for (int r = 0; r < 4; ++r) C[i][r] = 0.f;
    float m = 0.f;
    uint2 d0[6], d1[6];
    float2 ab0, ab1;
#pragma unroll
    for (int i = 0; i < 6; ++i) { d0[i] = *(const uint2*)(base + i * 8); d1[i] = *(const uint2*)(base + ST_IMG + i * 8); }
    ab0 = *(const float2*)(msc); ab1 = *(const float2*)(msc + 4);
    for (int k = 0; k < 33; ++k) {
        uint2 d2[6]; float2 ab2 = make_float2(0.f, 0.f);
        if (k + 2 < 33) {
#pragma unroll
            for (int i = 0; i < 6; ++i) d2[i] = *(const uint2*)(base + (size_t)(k + 2) * ST_IMG + i * 8);
            ab2 = *(const float2*)(msc + (k + 2) * 4);
        } else {
#pragma unroll
            for (int i = 0; i < 6; ++i) d2[i] = make_uint2(0, 0);
        }
#pragma unroll
        for (int i = 0; i < 6; ++i) {
            uint2 u; u.x = cvt_pk_bf16(C[i][0], C[i][1]); u.y = cvt_pk_bf16(C[i][2], C[i][3]);
            *(uint2*)(obase + (size_t)k * ST_IMG + i * 8) = u;
        }
        if (tid == 0 && part == 0) msc[k * 4 + 2] = m;
        const float M = fmaxf(m, ab0.x);
        const float decay = __expf(m - M), sc = __expf(ab0.x - M);
#pragma unroll
        for (int i = 0; i < 6; ++i) {
            C[i][0] = decay * C[i][0] + sc * bflo(d0[i].x); C[i][1] = decay * C[i][1] + sc * bfhi(d0[i].x);
            C[i][2] = decay * C[i][2] + sc * bflo(d0[i].y); C[i][3] = decay * C[i][3] + sc * bfhi(d0[i].y);
        }
        m = ab0.y + M;
#pragma unroll
        for (int i = 0; i < 6; ++i) { d0[i] = d1[i]; d1[i] = d2[i]; }
        ab0 = ab1; ab1 = ab2;
    }
}

__device__ __forceinline__ void mlstm_C(const Params& P, int item, unsigned char* smem) {
    const int tid = threadIdx.x, lane = tid & 63, w = tid >> 6, g = lane >> 4, lr = lane & 15;
    const int wu = __builtin_amdgcn_readfirstlane(w);
    const int k = item >> 5, bh = item & 31, b = bh >> 2, h = bh & 3;
    const bf16_t* z = (const bf16_t*)(P.ws + WS_Z);
    const bf16_t* qk = (const bf16_t*)(P.ws + WS_RA);
    const float* gates = (const float*)(P.ws + WS_GATES);
    bf16_t* y = (bf16_t*)(P.ws + WS_Z);
    const unsigned char* sK = smem; const unsigned char* sV = smem + 36864; unsigned char* sCb = smem;
    float* ga = (float*)(smem + 61440);
    const int pos = 64 * k + 16 * w + lr;
    const bool tvalid = pos < L;
    const size_t rrow = (size_t)(b * L + (tvalid ? pos : 0));
    const unsigned char* cslot = P.ws + WS_CBI + ((size_t)bh * 33 + k) * ST_IMG + tid * 16;
    const uint4 cb0 = *(const uint4*)(cslot), cb1 = *(const uint4*)(cslot + 4096), cb2 = *(const uint4*)(cslot + 8192), cb3 = *(const uint4*)(cslot + 12288), cb4 = *(const uint4*)(cslot + 16384),
                cb5 = *(const uint4*)(cslot + 20480), cb6 = *(const uint4*)(cslot + 24576), cb7 = *(const uint4*)(cslot + 28672), cb8 = *(const uint4*)(cslot + 32768);
    bf16x8 qf[4];
    {
        const bf16_t* qp = qk + rrow * 1024 + h * 128 + 8 * g;
#pragma unroll
        for (int ks = 0; ks < 4; ++ks) { qf[ks] = *(const bf16x8*)(qp + 32 * ks); if (!tvalid) qf[ks] = (bf16x8){0, 0, 0, 0, 0, 0, 0, 0}; }
    }
    mlstm_stage_kv(P, b, h, k, smem, smem + 36864, tid);
    if (wu == 0) {
        const float m_prev = ((const float*)(P.ws + WS_MSC))[((size_t)bh * 33 + k) * 4 + 2];
        const int p2 = 64 * k + lane;
        float lf = 0.f, li = -INFINITY;
        if (p2 < L) { lf = gates[(size_t)(b * L + p2) * 16 + 4 + h]; li = gates[(size_t)(b * L + p2) * 16 + h]; }
        float bc = lf;
#pragma unroll
        for (int o = 1; o < 64; o <<= 1) { const float n = __shfl_up(bc, o, 64); if (lane >= o) bc += n; }
        const float a = li - bc;
        float am = a;
#pragma unroll
        for (int o = 1; o < 64; o <<= 1) { const float n = __shfl_up(am, o, 64); if (lane >= o) am = fmaxf(am, n); }
        const float M = fmaxf(m_prev, am);
        ga[lane] = a; ga[64 + lane] = __expf(m_prev - M); ga[128 + lane] = __expf(-(bc + M)); ga[192 + lane] = M;
    }
    __syncthreads();
    const float Mt = ga[192 + 16 * w + lr], Wi = ga[64 + 16 * w + lr], Et = ga[128 + 16 * w + lr];
    bf16x8 pf[2];
    {
        f32x4 sa[4];
#pragma unroll
        for (int c = 0; c < 4; ++c) {
            sa[c] = (f32x4){0.f, 0.f, 0.f, 0.f};
            if (c <= wu) {
#pragma unroll
                for (int ks = 0; ks < 4; ++ks) {
                    const bf16x8 kf = *(const bf16x8*)(sK + (ks >> 1) * 8192 + vimg_off(16 * c + lr, 4 * (ks & 1) + g));
                    sa[c] = __builtin_amdgcn_mfma_f32_16x16x32_bf16(kf, qf[ks], sa[c], 0, 0, 0);
                }
                const f32x4 av = *(const f32x4*)(ga + 16 * c + 4 * g);
#pragma unroll
                for (int r = 0; r < 4; ++r) {
                    const float d = __expf(av[r] - Mt);
                    sa[c][r] = (16 * c + 4 * g + r <= 16 * w + lr) ? sa[c][r] * d : 0.f;
                }
            }
        }
#pragma unroll
        for (int s2 = 0; s2 < 2; ++s2) {
            uint4 u;
            u.x = cvt_pk_bf16(sa[2 * s2][0], sa[2 * s2][1]); u.y = cvt_pk_bf16(sa[2 * s2][2], sa[2 * s2][3]);
            u.z = cvt_pk_bf16(sa[2 * s2 + 1][0], sa[2 * s2 + 1][1]); u.w = cvt_pk_bf16(sa[2 * s2 + 1][2], sa[2 * s2 + 1][3]);
            pf[s2] = __builtin_bit_cast(bf16x8, u);
        }
    }
    __syncthreads();
    {
        unsigned char* d = sCb + tid * 16;
        *(uint4*)(d) = cb0; *(uint4*)(d + 4096) = cb1; *(uint4*)(d + 8192) = cb2; *(uint4*)(d + 12288) = cb3; *(uint4*)(d + 16384) = cb4;
        *(uint4*)(d + 20480) = cb5; *(uint4*)(d + 24576) = cb6; *(uint4*)(d + 28672) = cb7; *(uint4*)(d + 32768) = cb8;
    }
    __syncthreads();
    f32x4 na[9];
#define MC_TILE(c, lo0, hi0, lo1, hi1) { \
        na[c] = (f32x4){0.f, 0.f, 0.f, 0.f}; \
        _Pragma("unroll") for (int ks = 0; ks < 4; ++ks) { \
            const bf16x8 cf = *(const bf16x8*)(sCb + (ks >> 1) * 18432 + vimg_off(16 * (c) + lr, 4 * (ks & 1) + g)); \
            na[c] = __builtin_amdgcn_mfma_f32_16x16x32_bf16(cf, qf[ks], na[c], 0, 0, 0); } \
        na[c] *= Wi; \
        na[c] = __builtin_amdgcn_mfma_f32_16x16x32_bf16(tr_pair(lo0, hi0), pf[0], na[c], 0, 0, 0); \
        na[c] = __builtin_amdgcn_mfma_f32_16x16x32_bf16(tr_pair(lo1, hi1), pf[1], na[c], 0, 0, 0); }
    {
        uint2 vr[4][4];
        tr_read_4c(sV, g, lr, vr);
        MC_TILE(0, vr[0][0], vr[0][1], vr[0][2], vr[0][3]) MC_TILE(1, vr[1][0], vr[1][1], vr[1][2], vr[1][3])
        MC_TILE(2, vr[2][0], vr[2][1], vr[2][2], vr[2][3]) MC_TILE(3, vr[3][0], vr[3][1], vr[3][2], vr[3][3])
        tr_read_4c(sV + 8192, g, lr, vr);
        MC_TILE(4, vr[0][0], vr[0][1], vr[0][2], vr[0][3]) MC_TILE(5, vr[1][0], vr[1][1], vr[1][2], vr[1][3])
        MC_TILE(6, vr[2][0], vr[2][1], vr[2][2], vr[2][3]) MC_TILE(7, vr[3][0], vr[3][1], vr[3][2], vr[3][3])
        const uint2 o0 = tr_frag(sV + 16384, 0, 0, g, lr), o1 = tr_frag(sV + 16384, 16, 0, g, lr), o2 = tr_frag(sV + 16384, 32, 0, g, lr), o3 = tr_frag(sV + 16384, 48, 0, g, lr);
        MC_TILE(8, o0, o1, o2, o3)
    }
#undef MC_TILE
    const float den = __shfl(na[8][0], lr, 64);
    const float rden = 1.0f / fmaxf(fabsf(den), Et);
    float hs = 0.f;
#pragma unroll
    for (int c = 0; c < 8; ++c) { na[c] *= rden; hs += na[c][0] * na[c][0] + na[c][1] * na[c][1] + na[c][2] * na[c][2] + na[c][3] * na[c][3]; }
    hs += __shfl_xor(hs, 16, 64); hs += __shfl_xor(hs, 32, 64);
    const float rstd = rsqrtf(hs * (1.0f / 128.0f) + EPS);
    const float* gainp = P.m_out_norm + h * 128 + 4 * g;
#pragma unroll
    for (int c = 0; c < 8; ++c) {
        const uint2 og = *(const uint2*)(z + rrow * NZ + ZC_MO + h * 128 + 16 * c + 4 * g);
        const float o0 = bflo(og.x), o1 = bfhi(og.x), o2 = bflo(og.y), o3 = bfhi(og.y);
        const float4 gn = *(const float4*)(gainp + 16 * c);
        uint2 u;
        u.x = pk2(na[c][0] * rstd * gn.x / (1.f + __expf(-o0)), na[c][1] * rstd * gn.y / (1.f + __expf(-o1)));
        u.y = pk2(na[c][2] * rstd * gn.z / (1.f + __expf(-o2)), na[c][3] * rstd * gn.w / (1.f + __expf(-o3)));
        if (tvalid) *(uint2*)(y + rrow * NZ + h * 128 + 16 * c + 4 * g) = u;
    }
}

__device__ __forceinline__ void peer_token(const Params& P, int t, int lane, int* sidx, float* sval, int* sid, float* sgate, const unsigned char* slut) {
    const unsigned* tk = (const unsigned*)(P.ws + WS_TK) + (size_t)t * 256;
#pragma unroll
    for (int i = 0; i < 4; ++i) {
        const unsigned k = tk[lane * 4 + i];
        sidx[lane * 4 + i] = 127 - (int)(k & 127u);
        sval[lane * 4 + i] = unord_key(k & ~127u);
    }
    __builtin_amdgcn_s_waitcnt(0xc07f);
    __builtin_amdgcn_wave_barrier();
    {
        const int hd = lane >> 3, sub = lane & 7;
        unsigned x[8];
#pragma unroll
        for (int r = 0; r < 8; ++r) {
            const int c = sub * 8 + r;
            const unsigned ij = slut[c < 50 ? c : 0];
            const int i = ij >> 4, j = ij & 15;
            const unsigned kx = (ord_key(sval[(2 * hd) * 16 + i] + sval[(2 * hd + 1) * 16 + j]) & ~255u) | (unsigned)(255 - (i * 16 + j));
            x[r] = c < 50 ? kx : 0u;
        }
#pragma unroll
        for (int k = 2; k <= 64; k <<= 1) {
#pragma unroll
            for (int j = k >> 1; j >= 1; j >>= 1) {
                if (j >= 8) {
                    const int ld = j >> 3;
                    const bool lower = (sub & ld) == 0;
                    const bool desc = k >= 64 ? true : ((sub * 8) & k) == 0;
                    const bool takemax = (lower == desc);
#pragma unroll
                    for (int r = 0; r < 8; ++r) {
                        const unsigned o = (unsigned)__shfl_xor((int)x[r], ld, 64);
                        const unsigned hi = max(x[r], o), lo = min(x[r], o);
                        x[r] = takemax ? hi : lo;
                    }
                } else {
#pragma unroll
                    for (int r = 0; r < 8; ++r) {
                        if ((r & j) == 0) {
                            const int p = r | j;
                            const unsigned hi = max(x[r], x[p]), lo = min(x[r], x[p]);
                            if (k <= 4) { const bool desc = (r & k) == 0; x[r] = desc ? hi : lo; x[p] = desc ? lo : hi; }
                            else if (k >= 64) { x[r] = hi; x[p] = lo; }
                            else { const bool desc = ((sub * 8) & k) == 0; x[r] = desc ? hi : lo; x[p] = desc ? lo : hi; }
                        }
                    }
                }
            }
        }
        const float smax = unord_key((unsigned)__shfl((int)x[0], hd * 8, 64) & ~255u);
        float e[8]; float den = 0.f;
#pragma unroll
        for (int r = 0; r < 8; ++r) { e[r] = __expf(unord_key(x[r] & ~255u) - smax); den += e[r]; }
        den += __shfl_xor(den, 1, 64);
        const float inv = 1.f / den;
        if (sub < 2) {
#pragma unroll
            for (int r = 0; r < 8; ++r) {
                const int pos = 255 - (int)(x[r] & 255u), i = pos >> 4, j = pos & 15;
                sid[hd * 16 + sub * 8 + r] = sidx[(2 * hd) * 16 + i] * 128 + sidx[(2 * hd + 1) * 16 + j];
                sgate[hd * 16 + sub * 8 + r] = e[r] * inv;
            }
        }
    }
    __builtin_amdgcn_s_waitcnt(0xc07f);
    __builtin_amdgcn_wave_barrier();
    const bf16_t* xn = (const bf16_t*)(P.ws + WS_XN) + (size_t)t * DM;
    const float rstd = ((const float*)(P.ws + WS_RSTD))[t];
    const unsigned char* U = P.ws + WS_U + lane * 8;
    const unsigned char* V = P.ws + WS_V + lane * 8;
    const float* usc = (const float*)(P.ws + WS_USC);
    const float* vsc = (const float*)(P.ws + WS_VSC);
    f32x2 xf[8];
    {
        const uint4 xa = *(const uint4*)(xn + lane * 16), xb = *(const uint4*)(xn + lane * 16 + 8);
        xf[0] = (f32x2){bflo(xa.x), bfhi(xa.x)}; xf[1] = (f32x2){bflo(xa.y), bfhi(xa.y)}; xf[2] = (f32x2){bflo(xa.z), bfhi(xa.z)}; xf[3] = (f32x2){bflo(xa.w), bfhi(xa.w)};
        xf[4] = (f32x2){bflo(xb.x), bfhi(xb.x)}; xf[5] = (f32x2){bflo(xb.y), bfhi(xb.y)}; xf[6] = (f32x2){bflo(xb.z), bfhi(xb.z)}; xf[7] = (f32x2){bflo(xb.w), bfhi(xb.w)};
    }
    f32x2 acc[8];
#pragma unroll
    for (int j = 0; j < 8; ++j) acc[j] = (f32x2){0.f, 0.f};
    const int myq = ((lane >> 5) & 1) * 8 + ((lane >> 4) & 1) * 4 + ((lane >> 3) & 1) * 2 + ((lane >> 2) & 1);
#pragma unroll 1
    for (int e0 = 0; e0 < 128; e0 += 16) {
        uint2 ur[16], vr[16];
#pragma unroll
        for (int q = 0; q < 16; ++q) {
            const int id = sid[e0 + q];
            ur[q] = *(const uint2*)(U + (size_t)id * 512);
            vr[q] = *(const uint2*)(V + (size_t)id * 512);
        }
        const int myid = sid[e0 + myq];
        const float mysc = usc[myid] * rstd, myvs = vsc[myid] * sgate[e0 + myq];
        float d[16];
#pragma unroll
        for (int q = 0; q < 16; ++q) {
            f32x2 s2 = (f32x2){0.f, 0.f};
#define FP4_DOT(k) { s2 += xf[k] * __builtin_amdgcn_cvt_scalef32_pk_f32_fp4(ur[q].x, 1.0f, k); s2 += xf[4 + k] * __builtin_amdgcn_cvt_scalef32_pk_f32_fp4(ur[q].y, 1.0f, k); }
            FP4_DOT(0) FP4_DOT(1) FP4_DOT(2) FP4_DOT(3)
#undef FP4_DOT
            const float s0 = s2.x + s2.y;
            d[q] = s0;
        }
        float r8[8], r4[4], r2[2], r1;
#pragma unroll
        for (int i = 0; i < 8; ++i) { const bool up = (lane & 32) != 0; const float keep = up ? d[i + 8] : d[i], send = up ? d[i] : d[i + 8]; r8[i] = keep + __shfl_xor(send, 32, 64); }
#pragma unroll
        for (int i = 0; i < 4; ++i) { const bool up = (lane & 16) != 0; const float keep = up ? r8[i + 4] : r8[i], send = up ? r8[i] : r8[i + 4]; r4[i] = keep + __shfl_xor(send, 16, 64); }
#pragma unroll
        for (int i = 0; i < 2; ++i) { const bool up = (lane & 8) != 0; const float keep = up ? r4[i + 2] : r4[i], send = up ? r4[i] : r4[i + 2]; r2[i] = keep + __shfl_xor(send, 8, 64); }
        { const bool up = (lane & 4) != 0; const float keep = up ? r2[1] : r2[0], send = up ? r2[0] : r2[1]; r1 = keep + __shfl_xor(send, 4, 64); }
        r1 += __shfl_xor(r1, 2, 64); r1 += __shfl_xor(r1, 1, 64);
        const float a = r1 * mysc;
        const float wmine = myvs * 0.5f * a * (1.f + erff(a * 0.70710678118654752f));
#pragma unroll
        for (int q = 0; q < 16; ++q) {
            const float w = __shfl(wmine, ((q >> 3) & 1) * 32 + ((q >> 2) & 1) * 16 + ((q >> 1) & 1) * 8 + (q & 1) * 4, 64);
#define FP4_AXPY(k) { acc[k] += w * __builtin_amdgcn_cvt_scalef32_pk_f32_fp4(vr[q].x, 1.0f, k); acc[4 + k] += w * __builtin_amdgcn_cvt_scalef32_pk_f32_fp4(vr[q].y, 1.0f, k); }
            FP4_AXPY(0) FP4_AXPY(1) FP4_AXPY(2) FP4_AXPY(3)
#undef FP4_AXPY
        }
    }
    float* o = P.out + (size_t)t * DM + lane * 16;
    float4 h0, h1, h2, h3;
    {
        const float4 g0 = *(const float4*)(P.norm_ffn + lane * 16), g1 = *(const float4*)(P.norm_ffn + lane * 16 + 4), g2 = *(const float4*)(P.norm_ffn + lane * 16 + 8), g3 = *(const float4*)(P.norm_ffn + lane * 16 + 12);
        h0.x = xf[0].x / g0.x + acc[0].x; h0.y = xf[0].y / g0.y + acc[0].y; h0.z = xf[1].x / g0.z + acc[1].x; h0.w = xf[1].y / g0.w + acc[1].y;
        h1.x = xf[2].x / g1.x + acc[2].x; h1.y = xf[2].y / g1.y + acc[2].y; h1.z = xf[3].x / g1.z + acc[3].x; h1.w = xf[3].y / g1.w + acc[3].y;
        h2.x = xf[4].x / g2.x + acc[4].x; h2.y = xf[4].y / g2.y + acc[4].y; h2.z = xf[5].x / g2.z + acc[5].x; h2.w = xf[5].y / g2.w + acc[5].y;
        h3.x = xf[6].x / g3.x + acc[6].x; h3.y = xf[6].y / g3.y + acc[6].y; h3.z = xf[7].x / g3.z + acc[7].x; h3.w = xf[7].y / g3.w + acc[7].y;
    }
    *(float4*)(o) = h0; *(float4*)(o + 4) = h1; *(float4*)(o + 8) = h2; *(float4*)(o + 12) = h3;
    __builtin_amdgcn_s_waitcnt(0xc07f);
    __builtin_amdgcn_wave_barrier();
}

#define LAS __attribute__((address_space(3)))
#define XB_TMO      128
#define XB_XCNT(j)  (256  + 64 * (j))
#define XB_XSUB(j)  (1280 + 64 * (j))
#define XB_XGEN(j)  (2304 + 64 * (j))
#define XB_TOP      3328
#define XB_TOPGEN   3392
#define XCD_BAR_WORDS 3456
#define XB_SPIN_CAP (1u << 18)
__device__ __forceinline__ unsigned xb_ld(unsigned* p)              { return __hip_atomic_load(p, __ATOMIC_RELAXED, __HIP_MEMORY_SCOPE_AGENT); }
__device__ __forceinline__ unsigned xb_add(unsigned* p, unsigned v) { return __hip_atomic_fetch_add(p, v, __ATOMIC_RELAXED, __HIP_MEMORY_SCOPE_AGENT); }
__device__ __forceinline__ unsigned xb_xcc_id() { return (unsigned)__builtin_amdgcn_s_getreg((3 << 11) | 20) & 0xFu; }
#define XB_SPIN(cond, bar) do { unsigned _sp = 0; while (cond) { __builtin_amdgcn_s_sleep(1); \
    if ((++_sp & 255u) == 0u) { if (xb_ld(&(bar)[XB_TMO])) break; if (_sp > XB_SPIN_CAP) { atomicAdd(&(bar)[XB_TMO], 1u); break; } } } } while (0)
struct XcdBarrier { unsigned* bar; unsigned x; volatile LAS unsigned* st; };
__device__ __forceinline__ XcdBarrier xcd_barrier_post(unsigned* bar, volatile LAS unsigned* st) {
    XcdBarrier b; b.bar = bar; b.x = xb_xcc_id(); b.st = st;
    if (threadIdx.x == 0) (void)xb_add(&bar[XB_XCNT(b.x)], 1u);
    return b;
}
__device__ __forceinline__ void xcd_barrier_complete(unsigned* bar, unsigned x, unsigned& nloc, unsigned& nx) {
    const unsigned G = gridDim.x * gridDim.y * gridDim.z;
    unsigned sum, cnt, mine, sp = 0u;
    for (;;) {
        sum = 0u; cnt = 0u; mine = 0u;
#pragma unroll
        for (unsigned j = 0; j < 16; ++j) { const unsigned c = xb_ld(&bar[XB_XCNT(j)]); sum += c; cnt += (c > 0u) ? 1u : 0u; mine = (j == x) ? c : mine; }
        if (sum == G) break;
        __builtin_amdgcn_s_sleep(1);
        if ((++sp & 255u) == 0u) { if (xb_ld(&bar[XB_TMO])) break; if (sp > XB_SPIN_CAP) { atomicAdd(&bar[XB_TMO], 1u); break; } }
    }
    nloc = mine > 0u ? mine : 1u; nx = cnt > 0u ? cnt : 1u;
}
__device__ __forceinline__ void xcd_barrier(const XcdBarrier& b) {
    asm volatile("s_waitcnt vmcnt(0)" ::: "memory");
    __syncthreads();
    if (threadIdx.x == 0) {
        unsigned* bar = b.bar;
        __builtin_amdgcn_s_waitcnt(0);
        unsigned nloc = b.st[0], nx = b.st[1];
        if (nloc == 0u) { xcd_barrier_complete(bar, b.x, nloc, nx); b.st[0] = nloc; b.st[1] = nx; }
        const unsigned old = xb_add(&bar[XB_XSUB(b.x)], 1u);
        const unsigned gen = old / nloc;
        if (old + 1u == (gen + 1u) * nloc) {
            __builtin_amdgcn_fence(__ATOMIC_RELEASE, "agent");
            asm volatile("s_waitcnt vmcnt(0)" ::: "memory");
            const unsigned og = xb_add(&bar[XB_TOP], 1u);
            const unsigned tg = og / nx;
            if (og + 1u == (tg + 1u) * nx) xb_add(&bar[XB_TOPGEN], 1u);
            else XB_SPIN(xb_ld(&bar[XB_TOPGEN]) == tg, bar);
            __builtin_amdgcn_fence(__ATOMIC_ACQUIRE, "agent");
            xb_add(&bar[XB_XGEN(b.x)], 1u);
            asm volatile("s_waitcnt vmcnt(0)" ::: "memory");
        } else {
            XB_SPIN(xb_ld(&bar[XB_XGEN(b.x)]) == gen, bar);
            __builtin_amdgcn_fence(__ATOMIC_ACQUIRE, "agent");
            asm volatile("s_waitcnt vmcnt(0)" ::: "memory");
        }
    }
    __syncthreads();
}

__device__ __forceinline__ void hand_release() { asm volatile("s_waitcnt vmcnt(0)" ::: "memory"); __builtin_amdgcn_fence(__ATOMIC_RELEASE, "agent"); asm volatile("s_waitcnt vmcnt(0)" ::: "memory"); }
__device__ __forceinline__ void hand_acquire() { __builtin_amdgcn_fence(__ATOMIC_ACQUIRE, "agent"); asm volatile("s_waitcnt vmcnt(0)" ::: "memory"); }

__global__ void __launch_bounds__(256, 2) mega(Params P) {
    extern __shared__ __attribute__((aligned(16))) unsigned char smem[];
    cg::grid_group grid = cg::this_grid();
    const int tid = threadIdx.x, lane = tid & 63, wave = tid >> 6;
    const int G = gridDim.x, bid = blockIdx.x;
    unsigned* ctl = (unsigned*)(P.ws + WS_CTL);
    volatile LAS unsigned* bst = (volatile LAS unsigned*)(smem + 65552);
    if (tid == 0) { bst[0] = 0u; bst[1] = 0u; }
    __syncthreads();
    if (bid == 0) for (int i = tid; i < 8192; i += 256) ctl[i] = 0u;
    grid.sync();
    const XcdBarrier xb = xcd_barrier_post(ctl + 1024, bst);
    phase0(P, smem);
    xcd_barrier(xb);
    {
        const int gw = bid * 4 + wave;
        if (gw < 64) fox_cum_wave(P, gw, lane);
        for (int tile = bid; tile < 129 * 28; tile += G) gemm_tile<1>(P, tile / 28, tile % 28, smem);
        {
            const int rem = (129 * 28) % G;
            if (rem > 0 && rem < G) { if (bid >= rem) convert_uv_rows(P, (bid - rem) * 4 + wave, (G - rem) * 4, lane); }
            else convert_uv_rows(P, bid * 4 + wave, G * 4, lane);
        }
    }
    xcd_barrier(xb);
    {
        volatile int* s_item = (volatile int*)(smem + 65536);
        const int wave_u = __builtin_amdgcn_readfirstlane(wave);
        auto fetch = [&](unsigned* counter) -> int {
            if (wave_u == 0) {
                unsigned v = atomicAdd(counter, lane == 0 ? 1u : 0u);
                *s_item = (int)__builtin_amdgcn_readfirstlane(v);
            }
            __syncthreads();
            const int item = __builtin_amdgcn_readfirstlane(*s_item);
            __syncthreads();
            return item;
        };
        for (;;) {
            const int item = fetch(&ctl[2]);
            if (item >= 33 * 32) break;
            mlstm_A(P, item, smem);
        }
        xcd_barrier(xb);
        for (;;) {
            const int item = fetch(&ctl[4]);
            if (item >= 96) break;
            mlstm_B(P, item);
        }
        for (;;) {
            const int item = fetch(&ctl[3]);
            if (item >= 64 * 17) break;
            attn_block(P, item & 63, 16 - (item >> 6), smem);
        }
        xcd_barrier(xb);
        for (;;) {
            const int item = fetch(&ctl[5]);
            if (item >= 33 * 32) break;
            mlstm_C(P, item, smem);
        }
    }
    xcd_barrier(xb);
    for (int tile = bid; tile < 128 * 8; tile += G) gemm_tile<2>(P, tile >> 3, tile & 7, smem);
    xcd_barrier(xb);
    for (int tile = bid; tile < 128 * 16; tile += G) gemm_tile<3>(P, tile >> 4, tile & 15, smem);
    xcd_barrier(xb);
    {
        unsigned char* slut = smem + 12288;
        if (tid < 64) {
            int c = tid, i = 0;
            while (i < 16 && c >= 16 / (i + 1)) { c -= 16 / (i + 1); ++i; }
            slut[tid] = (unsigned char)(i < 16 ? ((i << 4) | c) : 0);
        }
        __syncthreads();
        int* sidx = (int*)(smem + wave * 3072); float* sval = (float*)(smem + wave * 3072 + 1024);
        int* sid = (int*)(smem + wave * 3072 + 2048); float* sgate = (float*)(smem + wave * 3072 + 2560);
        for (int t = bid * 4 + wave; t < T2; t += G * 4) peer_token(P, t, lane, sidx, sval, sid, sgate, slut);
    }
}

}

extern "C" void kernel_launch(void* const* d_in, const int* in_sizes, int n_in, void* d_out, int out_size, void* d_ws, size_t ws_size, hipStream_t stream) {
    if (n_in != 17 || ws_size < WS_END) { fprintf(stderr, "kernel_launch: unexpected n_in %d or ws_size %zu (need %zu)\n", n_in, ws_size, (size_t)WS_END); return; }
    constexpr int LDS_BYTES = 66560;
    static int grid_blocks = 0;
    if (!grid_blocks) {
        int dev = 0, cus = 0, per_cu = 0;
        (void)hipGetDevice(&dev);
        (void)hipDeviceGetAttribute(&cus, hipDeviceAttributeMultiprocessorCount, dev);
        (void)hipFuncSetAttribute((const void*)mega, hipFuncAttributeMaxDynamicSharedMemorySize, LDS_BYTES);
        (void)hipOccupancyMaxActiveBlocksPerMultiprocessor(&per_cu, (const void*)mega, 256, LDS_BYTES);
        if (per_cu < 1) per_cu = 1;
        if (per_cu > 2) per_cu = 2;
        grid_blocks = cus * per_cu;
        fprintf(stderr, "kernel_launch: cus %d per_cu %d grid %d\n", cus, per_cu, grid_blocks);
    }
    Params P{};
    P.x = (const float*)d_in[0]; P.meta = (const float*)d_in[1]; P.norm_mix = (const float*)d_in[2]; P.w_in = (const float*)d_in[3];
    P.conv_qk = (const float*)d_in[4]; P.b_igate = (const float*)d_in[5]; P.b_fgate_m = (const float*)d_in[6]; P.m_out_norm = (const float*)d_in[7];
    P.b_fgate_f = (const float*)d_in[8]; P.f_q_norm = (const float*)d_in[9]; P.f_k_norm = (const float*)d_in[10]; P.w_out = (const float*)d_in[11];
    P.norm_ffn = (const float*)d_in[12]; P.peer_query = (const float*)d_in[13]; P.peer_keys = (const float*)d_in[14]; P.peer_u = (const float*)d_in[15];
    P.peer_v = (const float*)d_in[16]; P.out = (float*)d_out; P.ws = (unsigned char*)d_ws;
    void* args[] = {&P};
    hipError_t e = hipLaunchCooperativeKernel((const void*)mega, dim3(grid_blocks), dim3(256), args, LDS_BYTES, stream);
    if (e != hipSuccess) fprintf(stderr, "cooperative launch failed: %s (grid %d)\n", hipGetErrorString(e), grid_blocks);
}
```

```cpp
#include <hip/hip_runtime.h>
#include <stdint.h>
#include <stdio.h>
#include <hip/hip_cooperative_groups.h>
namespace cg = cooperative_groups;

namespace {

constexpr int NB = 8, SEQ = 2048, DM = 1024, NMETA = 16, L = SEQ + NMETA;
constexpr int T1 = NB * L;
constexpr int T2 = NB * SEQ;
constexpr int NZ = 3584;
constexpr int ZC_MQ = 0, ZC_MK = 512, ZC_MV = 1024, ZC_MO = 1536, ZC_FQ = 2048, ZC_FK = 2560, ZC_FV = 3072;
constexpr int PROJ = 3600;
constexpr float EPS = 1e-6f;

constexpr size_t WS_CTL = 0;
constexpr size_t WS_RA = 65536;
constexpr size_t WS_Z = WS_RA + (size_t)T1 * DM * 2;
constexpr size_t WS_GATES = WS_Z + (size_t)T1 * NZ * 2;
constexpr size_t WS_CUM = WS_GATES + (size_t)T1 * 16 * 4;
constexpr size_t WS_SSQ = WS_CUM + (size_t)NB * 8 * L * 4;
constexpr size_t WS_RSTD = WS_SSQ + (size_t)T2 * 16 * 4;
constexpr size_t WS_SSQM = WS_RSTD + (size_t)T2 * 4;
constexpr size_t WS_BT2 = WS_SSQM + (size_t)T1 * 16 * 4;
constexpr size_t WS_BT3 = WS_BT2 + (size_t)DM * DM * 2;
constexpr size_t WS_KEYS = WS_BT3 + (size_t)2048 * DM * 2;
constexpr size_t WS_MSC = WS_KEYS + (size_t)16 * 128 * 128 * 2;
constexpr size_t WS_MST = WS_MSC + (size_t)128 * 33 * 16;
constexpr size_t WS_BT1 = WS_MST + (size_t)32 * 33 * 36864;
constexpr size_t WS_CBI = WS_BT1;
constexpr size_t WS_UV = WS_CBI + (size_t)32 * 33 * 36864;
constexpr size_t WS_END = WS_UV + (size_t)2 * 16384 * 512 + (size_t)2 * 16384 * 4;
constexpr size_t WS_XN = WS_RA;
constexpr size_t WS_U = WS_UV;
constexpr size_t WS_V = WS_U + (size_t)16384 * 512;
constexpr size_t WS_USC = WS_V + (size_t)16384 * 512;
constexpr size_t WS_VSC = WS_USC + (size_t)16384 * 4;
constexpr size_t WS_TK = WS_CBI;
constexpr float LOG2E = 1.4426950408889634f;

typedef unsigned short bf16_t;
typedef short bf16x8 __attribute__((ext_vector_type(8)));
typedef float f32x4 __attribute__((ext_vector_type(4)));
typedef __attribute__((ext_vector_type(2))) __bf16 bf16x2_t;

struct Params {
    const float* x; const float* meta; const float* norm_mix; const float* w_in; const float* conv_qk;
    const float* b_igate; const float* b_fgate_m; const float* m_out_norm; const float* b_fgate_f;
    const float* f_q_norm; const float* f_k_norm; const float* w_out; const float* norm_ffn;
    const float* peer_query; const float* peer_keys; const float* peer_u; const float* peer_v;
    float* out; unsigned char* ws;
};

__device__ __forceinline__ unsigned f2bf(float f) { unsigned u = __float_as_uint(f); return (u + 0x7fffu + ((u >> 16) & 1u)) >> 16; }
__device__ __forceinline__ float bf2f(unsigned h) { return __uint_as_float(h << 16); }
typedef float f32x2 __attribute__((ext_vector_type(2)));
typedef __bf16 bf16x2v __attribute__((ext_vector_type(2)));
__device__ __forceinline__ unsigned cvt_pk_bf16(float lo, float hi) { f32x2 v = {lo, hi}; bf16x2v b = __builtin_convertvector(v, bf16x2v); return __builtin_bit_cast(unsigned, b); }
__device__ __forceinline__ unsigned pk2(float lo, float hi) { return cvt_pk_bf16(lo, hi); }
__device__ __forceinline__ float bflo(unsigned w) { return __uint_as_float(w << 16); }
__device__ __forceinline__ float bfhi(unsigned w) { return __uint_as_float(w & 0xffff0000u); }
__device__ __forceinline__ float wave_sum(float v) {
#pragma unroll
    for (int o = 32; o > 0; o >>= 1) v += __shfl_xor(v, o, 64);
    return v;
}
__device__ __forceinline__ float wave_max(float v) {
#pragma unroll
    for (int o = 32; o > 0; o >>= 1) v = fmaxf(v, __shfl_xor(v, o, 64));
    return v;
}
__device__ __forceinline__ float logsigmoidf(float x) { return fminf(x, 0.f) - log1pf(expf(-fabsf(x))); }
__device__ __forceinline__ unsigned ord_key(float f) { unsigned u = __float_as_uint(f); return u ^ ((u >> 31) ? 0xffffffffu : 0x80000000u); }
__device__ __forceinline__ float unord_key(unsigned k) { unsigned u = (k & 0x80000000u) ? (k ^ 0x80000000u) : ~k; return __uint_as_float(u); }

__device__ __forceinline__ void phase0(const Params& P, unsigned char* smem) {
    const int tid = threadIdx.x, lane = tid & 63, wave = tid >> 6;
    unsigned* ctl = (unsigned*)(P.ws + WS_CTL);
    float* gw = (float*)smem;
    for (int idx = tid; idx < 16 * 1024; idx += 256) {
        const int k = idx >> 4, c = idx & 15;
        const int col = c < 8 ? 2048 + c : 3592 + (c - 8);
        gw[c * 1024 + k] = P.w_in[(size_t)k * PROJ + col];
    }
    __syncthreads();
    {
        bf16_t* hn = (bf16_t*)(P.ws + WS_RA);
        float* gates = (float*)(P.ws + WS_GATES);
        const int c0 = lane * 8, c1 = 512 + lane * 8;
        float gm[16];
        {
            const float4 a0 = *(const float4*)(P.norm_mix + c0), a1 = *(const float4*)(P.norm_mix + c0 + 4);
            const float4 a2 = *(const float4*)(P.norm_mix + c1), a3 = *(const float4*)(P.norm_mix + c1 + 4);
            gm[0] = a0.x; gm[1] = a0.y; gm[2] = a0.z; gm[3] = a0.w; gm[4] = a1.x; gm[5] = a1.y; gm[6] = a1.z; gm[7] = a1.w;
            gm[8] = a2.x; gm[9] = a2.y; gm[10] = a2.z; gm[11] = a2.w; gm[12] = a3.x; gm[13] = a3.y; gm[14] = a3.z; gm[15] = a3.w;
        }
        const int myq = ((lane >> 5) & 1) * 8 + ((lane >> 4) & 1) * 4 + ((lane >> 3) & 1) * 2 + ((lane >> 2) & 1);
        const float mybias = myq < 4 ? P.b_igate[myq] : (myq < 8 ? P.b_fgate_m[myq - 4] : P.b_fgate_f[myq - 8]);
        const int rstep = gridDim.x * 4;
        int r = blockIdx.x * 4 + wave;
        float4 n0, n1, n2, n3;
        auto load_row = [&](int rr) {
            const int b = rr / L, p = rr - b * L;
            const float* src = (p < NMETA) ? (P.meta + (size_t)p * DM) : (P.x + ((size_t)b * SEQ + (p - NMETA)) * DM);
            n0 = *(const float4*)(src + c0); n1 = *(const float4*)(src + c0 + 4); n2 = *(const float4*)(src + c1); n3 = *(const float4*)(src + c1 + 4);
        };
        if (r < T1) load_row(r);
        for (; r < T1; r += rstep) {
            float v[16];
            v[0] = n0.x; v[1] = n0.y; v[2] = n0.z; v[3] = n0.w; v[4] = n1.x; v[5] = n1.y; v[6] = n1.z; v[7] = n1.w;
            v[8] = n2.x; v[9] = n2.y; v[10] = n2.z; v[11] = n2.w; v[12] = n3.x; v[13] = n3.y; v[14] = n3.z; v[15] = n3.w;
            if (r + rstep < T1) load_row(r + rstep);
            float ss = 0.f;
#pragma unroll
            for (int j = 0; j < 16; ++j) ss += v[j] * v[j];
            ss = wave_sum(ss);
            const float rstd = rsqrtf(ss * (1.0f / DM) + EPS);
#pragma unroll
            for (int j = 0; j < 16; ++j) v[j] *= rstd * gm[j];
            uint4 o0, o1;
            o0.x = pk2(v[0], v[1]); o0.y = pk2(v[2], v[3]); o0.z = pk2(v[4], v[5]); o0.w = pk2(v[6], v[7]);
            o1.x = pk2(v[8], v[9]); o1.y = pk2(v[10], v[11]); o1.z = pk2(v[12], v[13]); o1.w = pk2(v[14], v[15]);
            *(uint4*)(hn + (size_t)r * DM + c0) = o0;
            *(uint4*)(hn + (size_t)r * DM + c1) = o1;
            float r8[8], r4[4], r2[2], r1;
#pragma unroll
            for (int i = 0; i < 8; ++i) {
                float dd[2];
#pragma unroll
                for (int hh = 0; hh < 2; ++hh) {
                    const float* gwc = gw + (i + 8 * hh) * 1024;
                    const float4 w0 = *(const float4*)(gwc + c0), w1 = *(const float4*)(gwc + c0 + 4), w2 = *(const float4*)(gwc + c1), w3 = *(const float4*)(gwc + c1 + 4);
                    dd[hh] = v[0] * w0.x + v[1] * w0.y + v[2] * w0.z + v[3] * w0.w + v[4] * w1.x + v[5] * w1.y + v[6] * w1.z + v[7] * w1.w
                           + v[8] * w2.x + v[9] * w2.y + v[10] * w2.z + v[11] * w2.w + v[12] * w3.x + v[13] * w3.y + v[14] * w3.z + v[15] * w3.w;
                }
                const bool up = (lane & 32) != 0; const float keep = up ? dd[1] : dd[0], send = up ? dd[0] : dd[1];
                r8[i] = keep + __shfl_xor(send, 32, 64);
                __builtin_amdgcn_sched_barrier(0);
            }
#pragma unroll
            for (int i = 0; i < 4; ++i) { const bool up = (lane & 16) != 0; const float keep = up ? r8[i + 4] : r8[i], send = up ? r8[i] : r8[i + 4]; r4[i] = keep + __shfl_xor(send, 16, 64); }
#pragma unroll
            for (int i = 0; i < 2; ++i) { const bool up = (lane & 8) != 0; const float keep = up ? r4[i + 2] : r4[i], send = up ? r4[i] : r4[i + 2]; r2[i] = keep + __shfl_xor(send, 8, 64); }
            { const bool up = (lane & 4) != 0; const float keep = up ? r2[1] : r2[0], send = up ? r2[0] : r2[1]; r1 = keep + __shfl_xor(send, 4, 64); }
            r1 += __shfl_xor(r1, 2, 64); r1 += __shfl_xor(r1, 1, 64);
            if ((lane & 3) == 0) {
                const float pre = r1 + mybias;
                gates[(size_t)r * 16 + myq] = myq < 4 ? pre : logsigmoidf(pre);
            }
        }
    }
    __syncthreads();
    {
        float (*tile)[65] = (float (*)[65])smem;
        for (int item = blockIdx.x; item < 1664; item += gridDim.x) {
            const float* W; int ldn, ntn, shift_from, it; bf16_t* out;
            if (item < 896) { W = P.w_in; ldn = PROJ; ntn = 56; shift_from = 2048; it = item; out = (bf16_t*)(P.ws + WS_BT1); }
            else if (item < 1152) { W = P.w_out; ldn = 1024; ntn = 16; shift_from = 1 << 30; it = item - 896; out = (bf16_t*)(P.ws + WS_BT2); }
            else { W = P.peer_query; ldn = 2048; ntn = 32; shift_from = 1 << 30; it = item - 1152; out = (bf16_t*)(P.ws + WS_BT3); }
            const int tk = it / ntn, tn = it - tk * ntn, k0 = tk * 64, n0 = tn * 64;
            {
                const int nl = tid & 63;
                int n = n0 + nl; if (n >= shift_from) n += 8;
#pragma unroll
                for (int i = 0; i < 16; ++i) { const int kl = (tid >> 6) + 4 * i; tile[kl][nl] = W[(size_t)(k0 + kl) * ldn + n]; }
            }
            __syncthreads();
            {
                const int kl = tid & 63;
#pragma unroll
                for (int i = 0; i < 16; ++i) { const int nl = (tid >> 6) + 4 * i; out[(size_t)(n0 + nl) * 1024 + k0 + kl] = (bf16_t)f2bf(tile[kl][nl]); }
            }
            __syncthreads();
        }
    }
    {
        const size_t gt = (size_t)blockIdx.x * 256 + tid, gs = (size_t)gridDim.x * 256;
        const float* src = P.peer_keys; bf16_t* dst = (bf16_t*)(P.ws + WS_KEYS);
        for (size_t i = gt; i < (size_t)(16 * 128 * 128 / 8); i += gs) {
            const float4 a = *(const float4*)(src + i * 8), b = *(const float4*)(src + i * 8 + 4);
            uint4 o; o.x = pk2(a.x, a.y); o.y = pk2(a.z, a.w); o.z = pk2(b.x, b.y); o.w = pk2(b.z, b.w);
            *(uint4*)(dst + i * 8) = o;
        }
    }
}

__device__ __forceinline__ void convert_uv_rows(const Params& P, int gwave, int nwaves, int lane) {
    for (int rr0 = gwave * 4; rr0 < 2 * 16384; rr0 += nwaves * 4) {
        float4 a[4][4];
#pragma unroll
        for (int q = 0; q < 4; ++q) {
            const int rr = rr0 + q, which = rr >> 14, row = rr & 16383;
            const float* src = (which ? P.peer_v : P.peer_u) + (size_t)row * DM + lane * 16;
            a[q][0] = *(const float4*)(src); a[q][1] = *(const float4*)(src + 4); a[q][2] = *(const float4*)(src + 8); a[q][3] = *(const float4*)(src + 12);
        }
#pragma unroll
        for (int q = 0; q < 4; ++q) {
            const int rr = rr0 + q, which = rr >> 14, row = rr & 16383;
            float mx = 0.f;
#pragma unroll
            for (int j = 0; j < 4; ++j) mx = fmaxf(mx, fmaxf(fmaxf(fabsf(a[q][j].x), fabsf(a[q][j].y)), fmaxf(fabsf(a[q][j].z), fabsf(a[q][j].w))));
            mx = wave_max(mx);
            const float sc = mx > 0.f ? 6.0f / mx : 1.0f;
            unsigned w0 = 0u, w1 = 0u;
            w0 = __builtin_amdgcn_cvt_scalef32_pk_fp4_f32(w0, a[q][0].x * sc, a[q][0].y * sc, 1.0f, 0); w0 = __builtin_amdgcn_cvt_scalef32_pk_fp4_f32(w0, a[q][0].z * sc, a[q][0].w * sc, 1.0f, 1);
            w0 = __builtin_amdgcn_cvt_scalef32_pk_fp4_f32(w0, a[q][1].x * sc, a[q][1].y * sc, 1.0f, 2); w0 = __builtin_amdgcn_cvt_scalef32_pk_fp4_f32(w0, a[q][1].z * sc, a[q][1].w * sc, 1.0f, 3);
            w1 = __builtin_amdgcn_cvt_scalef32_pk_fp4_f32(w1, a[q][2].x * sc, a[q][2].y * sc, 1.0f, 0); w1 = __builtin_amdgcn_cvt_scalef32_pk_fp4_f32(w1, a[q][2].z * sc, a[q][2].w * sc, 1.0f, 1);
            w1 = __builtin_amdgcn_cvt_scalef32_pk_fp4_f32(w1, a[q][3].x * sc, a[q][3].y * sc, 1.0f, 2); w1 = __builtin_amdgcn_cvt_scalef32_pk_fp4_f32(w1, a[q][3].z * sc, a[q][3].w * sc, 1.0f, 3);
            *(uint2*)(P.ws + (which ? WS_V : WS_U) + (size_t)row * 512 + lane * 8) = make_uint2(w0, w1);
            if (lane == 0) ((float*)(P.ws + (which ? WS_VSC : WS_USC)))[row] = mx > 0.f ? mx * (1.0f / 6.0f) : 1.0f;
        }
    }
}

__device__ __forceinline__ void bitonic_sort16_desc(unsigned (&v)[16]) {
#pragma unroll
    for (int k = 2; k <= 16; k <<= 1)
#pragma unroll
        for (int j = k >> 1; j >= 1; j >>= 1)
#pragma unroll
            for (int i = 0; i < 16; ++i)
                if ((i & j) == 0) {
                    const int p = i | j;
                    const bool desc = (k >= 16) ? true : ((i & k) == 0);
                    const unsigned hi = max(v[i], v[p]), lo = min(v[i], v[p]);
                    v[i] = desc ? hi : lo; v[p] = desc ? lo : hi;
                }
}
__device__ __forceinline__ void bitonic_merge16_top(unsigned (&a)[16], const unsigned (&b)[16]) {
#pragma unroll
    for (int i = 0; i < 16; ++i) a[i] = max(a[i], b[15 - i]);
#pragma unroll
    for (int j = 8; j >= 1; j >>= 1)
#pragma unroll
        for (int i = 0; i < 16; ++i)
            if ((i & j) == 0) { const int p = i | j; const unsigned hi = max(a[i], a[p]), lo = min(a[i], a[p]); a[i] = hi; a[p] = lo; }
}

__device__ __forceinline__ void mma_ktile(const unsigned char* sA, const unsigned char* sB, int arow_off, int brow_off, int g, int sw, f32x4 (&acc)[4][4]) {
#pragma unroll
    for (int s = 0; s < 2; ++s) {
        bf16x8 a[4], b[4];
        const int ch = (((s * 4 + g) ^ sw) << 4);
#pragma unroll
        for (int i = 0; i < 4; ++i) a[i] = *(const bf16x8*)(sA + arow_off + i * 2048 + ch);
#pragma unroll
        for (int j = 0; j < 4; ++j) b[j] = *(const bf16x8*)(sB + brow_off + j * 2048 + ch);
#pragma unroll
        for (int i = 0; i < 4; ++i)
#pragma unroll
            for (int j = 0; j < 4; ++j) acc[i][j] = __builtin_amdgcn_mfma_f32_16x16x32_bf16(b[j], a[i], acc[i][j], 0, 0, 0);
    }
}

__device__ __forceinline__ void store_tile_bf16(const f32x4 (&acc)[4][4], unsigned char* smem, bf16_t* dst, size_t ld, int m0, int n0, int tid, int wr, int wc, int g, int lr) {
#pragma unroll
    for (int i = 0; i < 4; ++i)
#pragma unroll
        for (int j = 0; j < 4; ++j) {
            const int row = wr * 64 + 16 * i + lr, col = wc * 64 + 16 * j + 4 * g;
            uint2 w; w.x = pk2(acc[i][j][0], acc[i][j][1]); w.y = pk2(acc[i][j][2], acc[i][j][3]);
            *(uint2*)(smem + row * 272 + col * 2) = w;
        }
    __syncthreads();
#pragma unroll
    for (int q = 0; q < 8; ++q) {
        const int id = tid + 256 * q, row = id >> 4, ch = id & 15;
        const uint4 v = *(const uint4*)(smem + row * 272 + ch * 16);
        *(uint4*)(dst + (size_t)(m0 + row) * ld + n0 + ch * 8) = v;
    }
    __syncthreads();
}

template <int MODE>
__device__ __forceinline__ void gemm_tile(const Params& P, int tm, int tn, unsigned char* smem) {
    const bf16_t* A; const bf16_t* Bt;
    if (MODE == 1) { A = (const bf16_t*)(P.ws + WS_RA); Bt = (const bf16_t*)(P.ws + WS_BT1); }
    else if (MODE == 2) { A = (const bf16_t*)(P.ws + WS_Z); Bt = (const bf16_t*)(P.ws + WS_BT2); }
    else { A = (const bf16_t*)(P.ws + WS_XN); Bt = (const bf16_t*)(P.ws + WS_BT3); }
    const int tid = threadIdx.x, lane = tid & 63, wave = tid >> 6, wr = wave >> 1, wc = wave & 1, g = lane >> 4, lr = lane & 15;
    const int m0 = tm * 128, n0 = tn * 128;
    const int srow = tid >> 3, sc = tid & 7;
    const bf16_t* aptr[4]; const bf16_t* bptr[4]; int soff[4];
#pragma unroll
    for (int j = 0; j < 4; ++j) {
        const int row = srow + 32 * j;
        int ar = m0 + row;
        if (MODE == 2) { const int b = ar >> 11, t = ar & 2047; ar = b * L + NMETA + t; }
        aptr[j] = A + (size_t)ar * (MODE == 2 ? NZ : 1024) + sc * 8;
        bptr[j] = Bt + (size_t)(n0 + row) * 1024 + sc * 8;
        soff[j] = row * 128 + ((sc ^ (row & 7)) << 4);
    }
    f32x4 acc[4][4];
#pragma unroll
    for (int i = 0; i < 4; ++i)
#pragma unroll
        for (int j = 0; j < 4; ++j) acc[i][j] = (f32x4){0.f, 0.f, 0.f, 0.f};
    uint4 ra[4], rb[4];
#pragma unroll
    for (int j = 0; j < 4; ++j) { ra[j] = *(const uint4*)(aptr[j]); rb[j] = *(const uint4*)(bptr[j]); }
    unsigned char* sA0 = smem; unsigned char* sB0 = smem + 16384; unsigned char* sA1 = smem + 32768; unsigned char* sB1 = smem + 49152;
#pragma unroll
    for (int j = 0; j < 4; ++j) { *(uint4*)(sA0 + soff[j]) = ra[j]; *(uint4*)(sB0 + soff[j]) = rb[j]; }
    __syncthreads();
    const int arow_off = (wr * 64 + lr) * 128, brow_off = (wc * 64 + lr) * 128, sw = lr & 7;
    for (int kt = 0; kt < 16; ++kt) {
        unsigned char* sA = (kt & 1) ? sA1 : sA0; unsigned char* sB = (kt & 1) ? sB1 : sB0;
        unsigned char* nA = (kt & 1) ? sA0 : sA1; unsigned char* nB = (kt & 1) ? sB0 : sB1;
        if (kt < 15) {
#pragma unroll
            for (int j = 0; j < 4; ++j) { ra[j] = *(const uint4*)(aptr[j] + (kt + 1) * 64); rb[j] = *(const uint4*)(bptr[j] + (kt + 1) * 64); }
        }
        mma_ktile(sA, sB, arow_off, brow_off, g, sw, acc);
        if (kt < 15) {
#pragma unroll
            for (int j = 0; j < 4; ++j) { *(uint4*)(nA + soff[j]) = ra[j]; *(uint4*)(nB + soff[j]) = rb[j]; }
        }
        __syncthreads();
    }
    if (MODE == 1) {
        if (n0 >= ZC_FQ && n0 < ZC_FV) {
            const bool isk = n0 >= ZC_FK;
            const float* gain = isk ? P.f_k_norm : P.f_q_norm;
            const float scl = isk ? 1.0f : 0.125f * LOG2E;
            float gn[4][4];
#pragma unroll
            for (int j = 0; j < 4; ++j)
#pragma unroll
                for (int r = 0; r < 4; ++r) gn[j][r] = gain[16 * j + 4 * g + r];
#pragma unroll
            for (int i = 0; i < 4; ++i) {
                float ss = 0.f;
#pragma unroll
                for (int j = 0; j < 4; ++j)
#pragma unroll
                    for (int r = 0; r < 4; ++r) ss += acc[i][j][r] * acc[i][j][r];
                ss += __shfl_xor(ss, 16, 64); ss += __shfl_xor(ss, 32, 64);
                const float rstd = rsqrtf(ss * (1.0f / 64.0f) + EPS) * scl;
#pragma unroll
                for (int j = 0; j < 4; ++j)
#pragma unroll
                    for (int r = 0; r < 4; ++r) acc[i][j][r] *= rstd * gn[j][r];
            }
        }
        store_tile_bf16(acc, smem, (bf16_t*)(P.ws + WS_Z), NZ, m0, n0, tid, wr, wc, g, lr);
    } else if (MODE == 2) {
        float* ssq = (float*)(P.ws + WS_SSQ);
#pragma unroll
        for (int i = 0; i < 4; ++i) {
            const int row = m0 + wr * 64 + 16 * i + lr;
            float ss = 0.f;
#pragma unroll
            for (int j = 0; j < 4; ++j) {
                const int col = n0 + wc * 64 + 16 * j + 4 * g;
                const float4 xv = *(const float4*)(P.x + (size_t)row * DM + col);
                const float4 gv = *(const float4*)(P.norm_ffn + col);
                float4 hv; hv.x = acc[i][j][0] + xv.x; hv.y = acc[i][j][1] + xv.y; hv.z = acc[i][j][2] + xv.z; hv.w = acc[i][j][3] + xv.w;
                ss += hv.x * hv.x + hv.y * hv.y + hv.z * hv.z + hv.w * hv.w;
                acc[i][j][0] = hv.x * gv.x; acc[i][j][1] = hv.y * gv.y; acc[i][j][2] = hv.z * gv.z; acc[i][j][3] = hv.w * gv.w;
            }
            ss += __shfl_xor(ss, 16, 64); ss += __shfl_xor(ss, 32, 64);
            if (g == 0) ssq[(size_t)row * 16 + tn * 2 + wc] = ss;
        }
        store_tile_bf16(acc, smem, (bf16_t*)(P.ws + WS_XN), 1024, m0, n0, tid, wr, wc, g, lr);
    } else {
        const int hp = tn;
        const float* ssq = (const float*)(P.ws + WS_SSQ);
        float rs[4];
#pragma unroll
        for (int i = 0; i < 4; ++i) {
            const int row = m0 + wr * 64 + 16 * i + lr;
            const float4 p0 = *(const float4*)(ssq + (size_t)row * 16), p1 = *(const float4*)(ssq + (size_t)row * 16 + 4);
            const float4 p2 = *(const float4*)(ssq + (size_t)row * 16 + 8), p3 = *(const float4*)(ssq + (size_t)row * 16 + 12);
            const float s = ((p0.x + p0.y) + (p0.z + p0.w)) + ((p1.x + p1.y) + (p1.z + p1.w)) + ((p2.x + p2.y) + (p2.z + p2.w)) + ((p3.x + p3.y) + (p3.z + p3.w));
            rs[i] = rsqrtf(s * (1.0f / DM) + EPS);
            if (tn == 0 && wc == 0 && g == 0) ((float*)(P.ws + WS_RSTD))[row] = rs[i];
        }
        {
            unsigned char* sAq = wc ? sA1 : sA0;
#pragma unroll
            for (int i = 0; i < 4; ++i)
#pragma unroll
                for (int j = 0; j < 4; ++j) {
                    const int row = wr * 64 + 16 * i + lr;
                    const int chunk = 2 * j + (g >> 1);
                    uint2 w; w.x = pk2(acc[i][j][0] * rs[i], acc[i][j][1] * rs[i]); w.y = pk2(acc[i][j][2] * rs[i], acc[i][j][3] * rs[i]);
                    *(uint2*)(sAq + row * 128 + ((chunk ^ (row & 7)) << 4) + 8 * (g & 1)) = w;
                }
            const bf16_t* keys = (const bf16_t*)(P.ws + WS_KEYS) + (size_t)hp * 128 * 128;
#pragma unroll
            for (int j = 0; j < 4; ++j) {
                const int row = srow + 32 * j;
                const uint4 k0 = *(const uint4*)(keys + (size_t)row * 128 + sc * 8);
                const uint4 k1 = *(const uint4*)(keys + (size_t)row * 128 + 64 + sc * 8);
                *(uint4*)(sB0 + soff[j]) = k0; *(uint4*)(sB1 + soff[j]) = k1;
            }
        }
        __syncthreads();
#pragma unroll
        for (int i = 0; i < 4; ++i)
#pragma unroll
            for (int j = 0; j < 4; ++j) acc[i][j] = (f32x4){0.f, 0.f, 0.f, 0.f};
        mma_ktile(sA0, sB0, arow_off, brow_off, g, sw, acc);
        mma_ktile(sA1, sB1, arow_off, brow_off, g, sw, acc);
        __syncthreads();
#pragma unroll
        for (int i = 0; i < 4; ++i)
#pragma unroll
            for (int j = 0; j < 4; ++j) {
                const int row = wr * 64 + 16 * i + lr;
                const int c4 = wc * 16 + 4 * j + g;
                *(f32x4*)(smem + row * 512 + ((c4 ^ (row & 31)) << 4)) = acc[i][j];
            }
        __syncthreads();
        unsigned top[16];
        const int row = tid & 127, half = tid >> 7;
        {
            auto load_keys = [&](unsigned (&dst)[16], int q4) {
#pragma unroll
                for (int s4 = 0; s4 < 4; ++s4) {
                    const int c4 = half * 16 + q4 * 4 + s4;
                    const f32x4 v = *(const f32x4*)(smem + row * 512 + ((c4 ^ (row & 31)) << 4));
#pragma unroll
                    for (int e = 0; e < 4; ++e) dst[s4 * 4 + e] = (ord_key(v[e]) & ~127u) | (unsigned)(127 - (c4 * 4 + e));
                }
            };
            load_keys(top, 0);
            bitonic_sort16_desc(top);
#pragma unroll 1
            for (int q4 = 1; q4 < 4; ++q4) {
                unsigned gq[16];
                load_keys(gq, q4);
                bitonic_sort16_desc(gq);
                bitonic_merge16_top(top, gq);
            }
        }
        __syncthreads();
        if (half) {
            uint4* lp = (uint4*)(smem + row * 64);
            lp[0] = make_uint4(top[0], top[1], top[2], top[3]); lp[1] = make_uint4(top[4], top[5], top[6], top[7]);
            lp[2] = make_uint4(top[8], top[9], top[10], top[11]); lp[3] = make_uint4(top[12], top[13], top[14], top[15]);
        }
        __syncthreads();
        if (!half) {
            const uint4* lp = (const uint4*)(smem + row * 64);
            unsigned other[16];
#pragma unroll
            for (int c = 0; c < 4; ++c) { const uint4 o = lp[c]; other[4 * c] = o.x; other[4 * c + 1] = o.y; other[4 * c + 2] = o.z; other[4 * c + 3] = o.w; }
            bitonic_merge16_top(top, other);
            uint4* tk = (uint4*)((unsigned*)(P.ws + WS_TK) + ((size_t)(m0 + row) * 16 + hp) * 16);
            tk[0] = make_uint4(top[0], top[1], top[2], top[3]); tk[1] = make_uint4(top[4], top[5], top[6], top[7]);
            tk[2] = make_uint4(top[8], top[9], top[10], top[11]); tk[3] = make_uint4(top[12], top[13], top[14], top[15]);
        }
        __syncthreads();
    }
}

__device__ __forceinline__ void fox_cum_wave(const Params& P, int bh, int lane) {
    const int b = bh >> 3, h = bh & 7;
    const float* gates = (const float*)(P.ws + WS_GATES);
    float* cum = (float*)(P.ws + WS_CUM) + (size_t)bh * L;
    constexpr int SEG = 33;
    const int t0 = lane * SEG;
    float loc = 0.f;
    for (int i = 0; i < SEG; ++i) { const int t = t0 + i; if (t < L) loc += gates[(size_t)(b * L + t) * 16 + 8 + h]; }
    float incl = loc;
#pragma unroll
    for (int o = 1; o < 64; o <<= 1) { const float n = __shfl_up(incl, o, 64); if (lane >= o) incl += n; }
    float run = incl - loc;
    for (int i = 0; i < SEG; ++i) { const int t = t0 + i; if (t < L) { run += gates[(size_t)(b * L + t) * 16 + 8 + h]; cum[t] = run * LOG2E; } }
}

#define TR_SLOW 0

__device__ __forceinline__ int vimg_off(int row, int ch) { return row * 128 + ((ch ^ (((row >> 1) & 3) << 1)) << 4); }
__device__ __forceinline__ uint2 tr_frag(const unsigned char* img, int row0, int c, int g, int lr) {
#if TR_SLOW
    unsigned short e[4];
#pragma unroll
    for (int k = 0; k < 4; ++k) { const int row = row0 + 4 * g + k, col = 16 * c + lr; e[k] = *(const unsigned short*)(img + vimg_off(row, col >> 3) + (col & 7) * 2); }
    uint2 r; r.x = (unsigned)e[0] | ((unsigned)e[1] << 16); r.y = (unsigned)e[2] | ((unsigned)e[3] << 16); return r;
#else
    const int q = lr >> 2, p = lr & 3, row = row0 + 4 * g + q;
    const unsigned addr = (unsigned)(size_t)(img + vimg_off(row, 2 * c + (p >> 1)) + 8 * (p & 1));
    uint2 r;
    asm volatile("ds_read_b64_tr_b16 %0, %1\n\ts_waitcnt lgkmcnt(0)" : "=&v"(r) : "v"(addr) : "memory");
    return r;
#endif
}

__device__ __forceinline__ unsigned tr_lane_addr(const unsigned char* img, int c, int g, int lr) {
    const int q = lr >> 2, p = lr & 3, row = 4 * g + q;
    return (unsigned)(size_t)(img + vimg_off(row, 2 * c + (p >> 1)) + 8 * (p & 1));
}
#define TR_GROUP(o0, o1, o2, o3, a) "ds_read_b64_tr_b16 %" #o0 ", %" #a "\n\tds_read_b64_tr_b16 %" #o1 ", %" #a " offset:2048\n\tds_read_b64_tr_b16 %" #o2 ", %" #a " offset:4096\n\tds_read_b64_tr_b16 %" #o3 ", %" #a " offset:6144\n\t"
__device__ __forceinline__ void tr_read_4c(const unsigned char* img, int g, int lr, uint2 (&r)[4][4]) {
    const unsigned a0 = tr_lane_addr(img, 0, g, lr), a1 = tr_lane_addr(img, 1, g, lr), a2 = tr_lane_addr(img, 2, g, lr), a3 = tr_lane_addr(img, 3, g, lr);
    asm volatile(TR_GROUP(0, 1, 2, 3, 16) TR_GROUP(4, 5, 6, 7, 17) TR_GROUP(8, 9, 10, 11, 18) TR_GROUP(12, 13, 14, 15, 19) "s_waitcnt lgkmcnt(0)"
        : "=&v"(r[0][0]), "=&v"(r[0][1]), "=&v"(r[0][2]), "=&v"(r[0][3]), "=&v"(r[1][0]), "=&v"(r[1][1]), "=&v"(r[1][2]), "=&v"(r[1][3]),
          "=&v"(r[2][0]), "=&v"(r[2][1]), "=&v"(r[2][2]), "=&v"(r[2][3]), "=&v"(r[3][0]), "=&v"(r[3][1]), "=&v"(r[3][2]), "=&v"(r[3][3])
        : "v"(a0), "v"(a1), "v"(a2), "v"(a3) : "memory");
}
__device__ __forceinline__ void tr_read_3c(const unsigned char* img, int g, int lr, uint2 (&r)[3][4]) {
    const unsigned a0 = tr_lane_addr(img, 0, g, lr), a1 = tr_lane_addr(img, 1, g, lr), a2 = tr_lane_addr(img, 2, g, lr);
    asm volatile(TR_GROUP(0, 1, 2, 3, 12) TR_GROUP(4, 5, 6, 7, 13) TR_GROUP(8, 9, 10, 11, 14) "s_waitcnt lgkmcnt(0)"
        : "=&v"(r[0][0]), "=&v"(r[0][1]), "=&v"(r[0][2]), "=&v"(r[0][3]), "=&v"(r[1][0]), "=&v"(r[1][1]), "=&v"(r[1][2]), "=&v"(r[1][3]),
          "=&v"(r[2][0]), "=&v"(r[2][1]), "=&v"(r[2][2]), "=&v"(r[2][3])
        : "v"(a0), "v"(a1), "v"(a2) : "memory");
}
__device__ __forceinline__ void tr_read_2(const unsigned char* img0, int c0, const unsigned char* img1, int c1, int g, int lr, uint2 (&r)[2][4]) {
    const unsigned a0 = tr_lane_addr(img0, c0, g, lr), a1 = tr_lane_addr(img1, c1, g, lr);
    asm volatile(TR_GROUP(0, 1, 2, 3, 8) TR_GROUP(4, 5, 6, 7, 9) "s_waitcnt lgkmcnt(0)"
        : "=&v"(r[0][0]), "=&v"(r[0][1]), "=&v"(r[0][2]), "=&v"(r[0][3]), "=&v"(r[1][0]), "=&v"(r[1][1]), "=&v"(r[1][2]), "=&v"(r[1][3])
        : "v"(a0), "v"(a1) : "memory");
}
__device__ __forceinline__ bf16x8 tr_pair(const uint2& lo, const uint2& hi) { uint4 u; u.x = lo.x; u.y = lo.y; u.z = hi.x; u.w = hi.y; return __builtin_bit_cast(bf16x8, u); }

__device__ __forceinline__ void attn_block(const Params& P, int bh, int qb, unsigned char* smem) {
    const int tid = threadIdx.x, lane = tid & 63, w = tid >> 6, g = lane >> 4, lr = lane & 15;
    const int b = bh >> 3, h = bh & 7;
    const bf16_t* z = (const bf16_t*)(P.ws + WS_Z);
    const float* cum = (const float*)(P.ws + WS_CUM) + (size_t)bh * L;
    int tq[2]; bool qvalid[2]; bf16x8 qf[2][2]; float cq[2];
#pragma unroll
    for (int u = 0; u < 2; ++u) {
        tq[u] = qb * 128 + 32 * w + 16 * u + lr;
        qvalid[u] = tq[u] < L;
        const bf16_t* qp = z + (size_t)(b * L + (qvalid[u] ? tq[u] : 0)) * NZ + ZC_FQ + h * 64 + 8 * g;
        qf[u][0] = *(const bf16x8*)(qp); qf[u][1] = *(const bf16x8*)(qp + 32);
        cq[u] = cum[qvalid[u] ? tq[u] : 0];
    }
    const int nkv = (2 * qb + 2 < 33) ? 2 * qb + 2 : 33;
    const int srow0 = tid >> 3, sch = tid & 7;
    uint4 rk[2], rv[2]; float rc = 0.f;
    auto load_tile = [&](int kv) {
#pragma unroll
        for (int j = 0; j < 2; ++j) {
            const int key = kv * 64 + srow0 + 32 * j;
            if (key < L) {
                const bf16_t* p = z + (size_t)(b * L + key) * NZ + h * 64 + sch * 8;
                rk[j] = *(const uint4*)(p + ZC_FK); rv[j] = *(const uint4*)(p + ZC_FV);
            } else { rk[j] = make_uint4(0, 0, 0, 0); rv[j] = make_uint4(0, 0, 0, 0); }
        }
        if (tid < 64) { const int key = kv * 64 + tid; rc = key < L ? cum[key] : 0.f; }
    };
    auto store_tile = [&](int buf) {
        unsigned char* sK = smem + buf * 16384; unsigned char* sV = sK + 8192;
#pragma unroll
        for (int j = 0; j < 2; ++j) {
            const int row = srow0 + 32 * j;
            *(uint4*)(sK + row * 128 + ((sch ^ (row & 7)) << 4)) = rk[j];
            *(uint4*)(sV + vimg_off(row, sch)) = rv[j];
        }
        if (tid < 64) ((float*)(smem + 32768 + buf * 256))[tid] = rc;
    };
    float m[2] = {-INFINITY, -INFINITY}, lsum[2] = {0.f, 0.f};
    f32x4 o[2][4];
#pragma unroll
    for (int u = 0; u < 2; ++u)
#pragma unroll
        for (int c = 0; c < 4; ++c) o[u][c] = (f32x4){0.f, 0.f, 0.f, 0.f};
    load_tile(0); store_tile(0);
    __syncthreads();
    for (int kv = 0; kv < nkv; ++kv) {
        const int buf = kv & 1;
        if (kv + 1 < nkv) load_tile(kv + 1);
        const unsigned char* sK = smem + buf * 16384; const unsigned char* sV = sK + 8192;
        const float* sck = (const float*)(smem + 32768 + buf * 256);
        f32x4 sa[2][4];
#pragma unroll
        for (int c = 0; c < 4; ++c) {
            sa[0][c] = (f32x4){0.f, 0.f, 0.f, 0.f}; sa[1][c] = (f32x4){0.f, 0.f, 0.f, 0.f};
#pragma unroll
            for (int s = 0; s < 2; ++s) {
                const bf16x8 kf = *(const bf16x8*)(sK + (16 * c + lr) * 128 + (((4 * s + g) ^ (lr & 7)) << 4));
                sa[0][c] = __builtin_amdgcn_mfma_f32_16x16x32_bf16(kf, qf[0][s], sa[0][c], 0, 0, 0);
                sa[1][c] = __builtin_amdgcn_mfma_f32_16x16x32_bf16(kf, qf[1][s], sa[1][c], 0, 0, 0);
            }
        }
        const bool diag = (kv >= 2 * qb);
        bf16x8 pf[2][2];
#pragma unroll
        for (int u = 0; u < 2; ++u) {
            float mx = -INFINITY;
#pragma unroll
            for (int c = 0; c < 4; ++c) {
                const f32x4 ck = *(const f32x4*)(sck + 16 * c + 4 * g);
#pragma unroll
                for (int r = 0; r < 4; ++r) {
                    float v = sa[u][c][r] + (cq[u] - ck[r]);
                    if (diag && (64 * kv + 16 * c + 4 * g + r > tq[u])) v = -INFINITY;
                    sa[u][c][r] = v; mx = fmaxf(mx, v);
                }
            }
            mx = fmaxf(mx, __shfl_xor(mx, 16, 64)); mx = fmaxf(mx, __shfl_xor(mx, 32, 64));
            const float mn = fmaxf(m[u], mx);
            const float alpha = __builtin_amdgcn_exp2f(m[u] - mn);
            m[u] = mn;
            float ps = 0.f;
#pragma unroll
            for (int c = 0; c < 4; ++c)
#pragma unroll
                for (int r = 0; r < 4; ++r) { const float p = __builtin_amdgcn_exp2f(sa[u][c][r] - mn); sa[u][c][r] = p; ps += p; }
            lsum[u] = lsum[u] * alpha + ps;
#pragma unroll
            for (int c = 0; c < 4; ++c) o[u][c] *= alpha;
#pragma unroll
            for (int s2 = 0; s2 < 2; ++s2) {
                uint4 uu;
                uu.x = cvt_pk_bf16(sa[u][2 * s2][0], sa[u][2 * s2][1]); uu.y = cvt_pk_bf16(sa[u][2 * s2][2], sa[u][2 * s2][3]);
                uu.z = cvt_pk_bf16(sa[u][2 * s2 + 1][0], sa[u][2 * s2 + 1][1]); uu.w = cvt_pk_bf16(sa[u][2 * s2 + 1][2], sa[u][2 * s2 + 1][3]);
                pf[u][s2] = __builtin_bit_cast(bf16x8, uu);
            }
        }
        {
            uint2 vr[4][4];
            tr_read_4c(sV, g, lr, vr);
#pragma unroll
            for (int c = 0; c < 4; ++c)
#pragma unroll
                for (int s2 = 0; s2 < 2; ++s2) {
                    const bf16x8 vf = tr_pair(vr[c][2 * s2], vr[c][2 * s2 + 1]);
                    o[0][c] = __builtin_amdgcn_mfma_f32_16x16x32_bf16(vf, pf[0][s2], o[0][c], 0, 0, 0);
                    o[1][c] = __builtin_amdgcn_mfma_f32_16x16x32_bf16(vf, pf[1][s2], o[1][c], 0, 0, 0);
                }
        }
        if (kv + 1 < nkv) store_tile(buf ^ 1);
        __syncthreads();
    }
#pragma unroll
    for (int u = 0; u < 2; ++u) {
        float ls = lsum[u];
        ls += __shfl_xor(ls, 16, 64); ls += __shfl_xor(ls, 32, 64);
        const float inv = 1.0f / ls;
        if (qvalid[u]) {
            bf16_t* y = (bf16_t*)(P.ws + WS_Z) + (size_t)(b * L + tq[u]) * NZ + 512 + h * 64 + 4 * g;
#pragma unroll
            for (int c = 0; c < 4; ++c) {
                uint2 uu; uu.x = pk2(o[u][c][0] * inv, o[u][c][1] * inv); uu.y = pk2(o[u][c][2] * inv, o[u][c][3] * inv);
                *(uint2*)(y + 16 * c) = uu;
            }
        }
    }
}

__device__ __forceinline__ void conv_item(const Params& P, int ci) {
    const int tid = threadIdx.x, cc = tid & 127, rg = tid >> 7;
    const bf16_t* z = (const bf16_t*)(P.ws + WS_Z);
    bf16_t* qk = (bf16_t*)(P.ws + WS_RA);
    const int col0 = cc * 8;
    float w[4][8];
#pragma unroll
    for (int j = 0; j < 4; ++j) {
        const float4 a = *(const float4*)(P.conv_qk + j * 1024 + col0), b = *(const float4*)(P.conv_qk + j * 1024 + col0 + 4);
        w[j][0] = a.x; w[j][1] = a.y; w[j][2] = a.z; w[j][3] = a.w; w[j][4] = b.x; w[j][5] = b.y; w[j][6] = b.z; w[j][7] = b.w;
    }
    const float oscale = (col0 >= 512) ? 0.08838834764831845f : 1.0f;
    const int r0 = ci * 64 + rg * 32;
    int t = r0 % L;
    float xw[3][8];
#pragma unroll
    for (int j = 0; j < 3; ++j) {
        const int back = 3 - j;
        if (t - back >= 0) {
            const uint4 v = *(const uint4*)(z + (size_t)(r0 - back) * NZ + col0);
            xw[j][0] = bflo(v.x); xw[j][1] = bfhi(v.x); xw[j][2] = bflo(v.y); xw[j][3] = bfhi(v.y); xw[j][4] = bflo(v.z); xw[j][5] = bfhi(v.z); xw[j][6] = bflo(v.w); xw[j][7] = bfhi(v.w);
        } else {
#pragma unroll
            for (int e = 0; e < 8; ++e) xw[j][e] = 0.f;
        }
    }
#pragma unroll 2
    for (int i = 0; i < 32; ++i) {
        const int r = r0 + i;
        if (t == 0) {
#pragma unroll
            for (int j = 0; j < 3; ++j)
#pragma unroll
                for (int e = 0; e < 8; ++e) xw[j][e] = 0.f;
        }
        const uint4 v = *(const uint4*)(z + (size_t)r * NZ + col0);
        float xt[8];
        xt[0] = bflo(v.x); xt[1] = bfhi(v.x); xt[2] = bflo(v.y); xt[3] = bfhi(v.y); xt[4] = bflo(v.z); xt[5] = bfhi(v.z); xt[6] = bflo(v.w); xt[7] = bfhi(v.w);
        float o[8];
#pragma unroll
        for (int e = 0; e < 8; ++e) {
            const float cv = w[0][e] * xw[0][e] + w[1][e] * xw[1][e] + w[2][e] * xw[2][e] + w[3][e] * xt[e];
            o[e] = oscale * cv / (1.f + __expf(-cv));
            xw[0][e] = xw[1][e]; xw[1][e] = xw[2][e]; xw[2][e] = xt[e];
        }
        uint4 ov; ov.x = pk2(o[0], o[1]); ov.y = pk2(o[2], o[3]); ov.z = pk2(o[4], o[5]); ov.w = pk2(o[6], o[7]);
        *(uint4*)(qk + (size_t)r * 1024 + col0) = ov;
        t = (t + 1 == L) ? 0 : t + 1;
    }
}

constexpr int ST_IMG = 36864;
__device__ __forceinline__ int st_piece_off(int jt, int c, int g, int lr) { return (jt >> 2) * 18432 + vimg_off(16 * c + lr, 2 * (jt & 3) + (g >> 1)) + 8 * (g & 1); }

__device__ __forceinline__ void mlstm_stage_kv(const Params& P, int b, int h, int k, unsigned char* sKimg, unsigned char* sVimg, int tid) {
    const bf16_t* z = (const bf16_t*)(P.ws + WS_Z);
    const bf16_t* qk = (const bf16_t*)(P.ws + WS_RA);
    uint4 pk_[4], pv_[4];
#pragma unroll
    for (int j = 0; j < 4; ++j) {
        const int id = tid + 256 * j, row = id >> 4, ch16 = id & 15, pos = 64 * k + row;
        const bool ok = pos < L;
        pk_[j] = ok ? *(const uint4*)(qk + (size_t)(b * L + pos) * 1024 + 512 + h * 128 + ch16 * 8) : make_uint4(0, 0, 0, 0);
        pv_[j] = ok ? *(const uint4*)(z + (size_t)(b * L + pos) * NZ + ZC_MV + h * 128 + ch16 * 8) : make_uint4(0, 0, 0, 0);
    }
#pragma unroll
    for (int j = 0; j < 4; ++j) {
        const int id = tid + 256 * j, row = id >> 4, ch16 = id & 15;
        *(uint4*)(sKimg + (ch16 >> 3) * 8192 + vimg_off(row, ch16 & 7)) = pk_[j];
        *(uint4*)(sVimg + (ch16 >> 3) * 8192 + vimg_off(row, ch16 & 7)) = pv_[j];
    }
    if (tid < 128) {
        const int row = tid >> 1, ch = tid & 1;
        *(uint4*)(sVimg + 16384 + vimg_off(row, ch)) = ch ? make_uint4(0, 0, 0, 0) : make_uint4(0x3F80u, 0, 0, 0);
    }
}

__device__ __forceinline__ void mlstm_stage_A(const Params& P, int b, int h, int k, unsigned char* sKimg, unsigned char* sVimg, int tid) {
    const bf16_t* z = (const bf16_t*)(P.ws + WS_Z);
    bf16_t* qk = (bf16_t*)(P.ws + WS_RA);
    uint4 pv_[4];
#pragma unroll
    for (int j = 0; j < 4; ++j) {
        const int id = tid + 256 * j, row = id >> 4, ch16 = id & 15, pos = 64 * k + row;
        pv_[j] = (pos < L) ? *(const uint4*)(z + (size_t)(b * L + pos) * NZ + ZC_MV + h * 128 + ch16 * 8) : make_uint4(0, 0, 0, 0);
    }
    const int cch = tid & 31, rg = tid >> 5, isk = cch >> 4;
    const int zcol = (isk ? ZC_MK : ZC_MQ) + h * 128 + (cch & 15) * 8;
    float w[4][8];
#pragma unroll
    for (int j = 0; j < 4; ++j) {
        const float4 a = *(const float4*)(P.conv_qk + j * 1024 + zcol), c = *(const float4*)(P.conv_qk + j * 1024 + zcol + 4);
        w[j][0] = a.x; w[j][1] = a.y; w[j][2] = a.z; w[j][3] = a.w; w[j][4] = c.x; w[j][5] = c.y; w[j][6] = c.z; w[j][7] = c.w;
    }
    const float oscale = isk ? 0.08838834764831845f : 1.0f;
    const int p0 = 64 * k + 8 * rg;
    uint4 raw[11];
#pragma unroll
    for (int i = 0; i < 11; ++i) {
        const int pos = p0 - 3 + i;
        raw[i] = (pos >= 0 && pos < L) ? *(const uint4*)(z + (size_t)(b * L + pos) * NZ + zcol) : make_uint4(0, 0, 0, 0);
    }
#pragma unroll
    for (int j = 0; j < 4; ++j) {
        const int id = tid + 256 * j, row = id >> 4, ch16 = id & 15;
        *(uint4*)(sVimg + (ch16 >> 3) * 8192 + vimg_off(row, ch16 & 7)) = pv_[j];
    }
    if (tid < 128) {
        const int row = tid >> 1, ch = tid & 1;
        *(uint4*)(sVimg + 16384 + vimg_off(row, ch)) = ch ? make_uint4(0, 0, 0, 0) : make_uint4(0x3F80u, 0, 0, 0);
    }
#pragma unroll
    for (int i = 0; i < 8; ++i) {
        const int pos = p0 + i, row = 8 * rg + i;
        float o[8];
#pragma unroll
        for (int e = 0; e < 8; ++e) {
            const unsigned w0 = (&raw[i].x)[e >> 1], w1 = (&raw[i + 1].x)[e >> 1], w2 = (&raw[i + 2].x)[e >> 1], w3 = (&raw[i + 3].x)[e >> 1];
            const float x0 = (e & 1) ? bfhi(w0) : bflo(w0), x1 = (e & 1) ? bfhi(w1) : bflo(w1), x2 = (e & 1) ? bfhi(w2) : bflo(w2), x3 = (e & 1) ? bfhi(w3) : bflo(w3);
            const float cv = w[0][e] * x0 + w[1][e] * x1 + w[2][e] * x2 + w[3][e] * x3;
            o[e] = oscale * cv / (1.f + __expf(-cv));
        }
        uint4 ov; ov.x = pk2(o[0], o[1]); ov.y = pk2(o[2], o[3]); ov.z = pk2(o[4], o[5]); ov.w = pk2(o[6], o[7]);
        const bool ok = pos < L;
        if (!ok) ov = make_uint4(0, 0, 0, 0);
        if (ok) *(uint4*)(qk + (size_t)(b * L + pos) * 1024 + (isk ? 512 : 0) + h * 128 + (cch & 15) * 8) = ov;
        if (isk) { const int ch16 = cch & 15; *(uint4*)(sKimg + (ch16 >> 3) * 8192 + vimg_off(row, ch16 & 7)) = ov; }
    }
}

__device__ __forceinline__ void mlstm_A(const Params& P, int item, unsigned char* smem) {
    const int tid = threadIdx.x, lane = tid & 63, w = tid >> 6, g = lane >> 4, lr = lane & 15;
    const int wu = __builtin_amdgcn_readfirstlane(w);
    const int k = item >> 5, bh = item & 31, b = bh >> 2, h = bh & 3;
    const float* gates = (const float*)(P.ws + WS_GATES);
    const unsigned char* sK = smem; const unsigned char* sV = smem + 16384;
    float* ga = (float*)(smem + 40960);
    mlstm_stage_A(P, b, h, k, smem, smem + 16384, tid);
    if (wu == 0) {
        const int pos = 64 * k + lane;
        float lf = 0.f, li = -INFINITY;
        if (pos < L) { lf = gates[(size_t)(b * L + pos) * 16 + 4 + h]; li = gates[(size_t)(b * L + pos) * 16 + h]; }
        float bc = lf;
#pragma unroll
        for (int o = 1; o < 64; o <<= 1) { const float n = __shfl_up(bc, o, 64); if (lane >= o) bc += n; }
        const float a = li - bc;
        const float A = wave_max(a);
        ga[lane] = __expf(a - A);
        if (lane == 63) { float* msc = (float*)(P.ws + WS_MSC) + ((size_t)bh * 33 + k) * 4; msc[0] = A; msc[1] = bc; }
    }
    __syncthreads();
    f32x4 Ct[2][9];
#pragma unroll
    for (int a = 0; a < 2; ++a)
#pragma unroll
        for (int c = 0; c < 9; ++c) Ct[a][c] = (f32x4){0.f, 0.f, 0.f, 0.f};
    bf16x8 kt[2][2];
#pragma unroll
    for (int a = 0; a < 2; ++a)
#pragma unroll
        for (int s2 = 0; s2 < 2; ++s2) {
            const int jt = 2 * w + a;
            kt[a][s2] = tr_pair(tr_frag(sK + (jt >> 2) * 8192, 32 * s2, jt & 3, g, lr), tr_frag(sK + (jt >> 2) * 8192, 32 * s2 + 16, jt & 3, g, lr));
        }
    f32x4 wg4[4];
#pragma unroll
    for (int j = 0; j < 4; ++j) wg4[j] = *(const f32x4*)(ga + 16 * j + 4 * g);
#define MA_TILE(c, lo0, hi0, lo1, hi1) { \
        { const f32x4 w0 = wg4[0], w1 = wg4[1]; uint4 o; \
          o.x = cvt_pk_bf16(bflo(lo0.x) * w0[0], bfhi(lo0.x) * w0[1]); o.y = cvt_pk_bf16(bflo(lo0.y) * w0[2], bfhi(lo0.y) * w0[3]); \
          o.z = cvt_pk_bf16(bflo(hi0.x) * w1[0], bfhi(hi0.x) * w1[1]); o.w = cvt_pk_bf16(bflo(hi0.y) * w1[2], bfhi(hi0.y) * w1[3]); \
          const bf16x8 vw = __builtin_bit_cast(bf16x8, o); \
          Ct[0][c] = __builtin_amdgcn_mfma_f32_16x16x32_bf16(kt[0][0], vw, Ct[0][c], 0, 0, 0); Ct[1][c] = __builtin_amdgcn_mfma_f32_16x16x32_bf16(kt[1][0], vw, Ct[1][c], 0, 0, 0); } \
        { const f32x4 w0 = wg4[2], w1 = wg4[3]; uint4 o; \
          o.x = cvt_pk_bf16(bflo(lo1.x) * w0[0], bfhi(lo1.x) * w0[1]); o.y = cvt_pk_bf16(bflo(lo1.y) * w0[2], bfhi(lo1.y) * w0[3]); \
          o.z = cvt_pk_bf16(bflo(hi1.x) * w1[0], bfhi(hi1.x) * w1[1]); o.w = cvt_pk_bf16(bflo(hi1.y) * w1[2], bfhi(hi1.y) * w1[3]); \
          const bf16x8 vw = __builtin_bit_cast(bf16x8, o); \
          Ct[0][c] = __builtin_amdgcn_mfma_f32_16x16x32_bf16(kt[0][1], vw, Ct[0][c], 0, 0, 0); Ct[1][c] = __builtin_amdgcn_mfma_f32_16x16x32_bf16(kt[1][1], vw, Ct[1][c], 0, 0, 0); } }
    {
        uint2 vr[4][4];
        tr_read_4c(sV, g, lr, vr);
        MA_TILE(0, vr[0][0], vr[0][1], vr[0][2], vr[0][3]) MA_TILE(1, vr[1][0], vr[1][1], vr[1][2], vr[1][3])
        MA_TILE(2, vr[2][0], vr[2][1], vr[2][2], vr[2][3]) MA_TILE(3, vr[3][0], vr[3][1], vr[3][2], vr[3][3])
        tr_read_4c(sV + 8192, g, lr, vr);
        MA_TILE(4, vr[0][0], vr[0][1], vr[0][2], vr[0][3]) MA_TILE(5, vr[1][0], vr[1][1], vr[1][2], vr[1][3])
        MA_TILE(6, vr[2][0], vr[2][1], vr[2][2], vr[2][3]) MA_TILE(7, vr[3][0], vr[3][1], vr[3][2], vr[3][3])
        const uint2 o0 = tr_frag(sV + 16384, 0, 0, g, lr), o1 = tr_frag(sV + 16384, 16, 0, g, lr), o2 = tr_frag(sV + 16384, 32, 0, g, lr), o3 = tr_frag(sV + 16384, 48, 0, g, lr);
        MA_TILE(8, o0, o1, o2, o3)
    }
#undef MA_TILE
    unsigned char* slot = P.ws + WS_MST + ((size_t)bh * 33 + k) * ST_IMG;
#pragma unroll
    for (int a = 0; a < 2; ++a)
#pragma unroll
        for (int c = 0; c < 9; ++c) {
            uint2 u; u.x = cvt_pk_bf16(Ct[a][c][0], Ct[a][c][1]); u.y = cvt_pk_bf16(Ct[a][c][2], Ct[a][c][3]);
            *(uint2*)(slot + st_piece_off(2 * w + a, c, g, lr)) = u;
        }
}

__device__ __forceinline__ void mlstm_B(const Params& P, int item) {
    const int tid = threadIdx.x;
    const int bh = item / 3, part = item - bh * 3;
    const unsigned char* base = P.ws + WS_MST + (size_t)bh * 33 * ST_IMG + part * 12288 + tid * 48;
    unsigned char* obase = P.ws + WS_CBI + (size_t)bh * 33 * ST_IMG + part * 12288 + tid * 48;
    float* msc = (float*)(P.ws + WS_MSC) + (size_t)bh * 33 * 4;
    float C[6][4];
#pragma unroll
    for (int i = 0; i < 6; ++i)
#pragma unroll
        for (int r = 0; r < 4; ++r) C[i][r] = 0.f;
    float m = 0.f;
    uint2 d0[6], d1[6];
    float2 ab0, ab1;
#pragma unroll
    for (int i = 0; i < 6; ++i) { d0[i] = *(const uint2*)(base + i * 8); d1[i] = *(const uint2*)(base + ST_IMG + i * 8); }
    ab0 = *(const float2*)(msc); ab1 = *(const float2*)(msc + 4);
    for (int k = 0; k < 33; ++k) {
        uint2 d2[6]; float2 ab2 = make_float2(0.f, 0.f);
        if (k + 2 < 33) {
#pragma unroll
            for (int i = 0; i < 6; ++i) d2[i] = *(const uint2*)(base + (size_t)(k + 2) * ST_IMG + i * 8);
            ab2 = *(const float2*)(msc + (k + 2) * 4);
        } else {
#pragma unroll
            for (int i = 0; i < 6; ++i) d2[i] = make_uint2(0, 0);
        }
#pragma unroll
        for (int i = 0; i < 6; ++i) {
            uint2 u; u.x = cvt_pk_bf16(C[i][0], C[i][1]); u.y = cvt_pk_bf16(C[i][2], C[i][3]);
            *(uint2*)(obase + (size_t)k * ST_IMG + i * 8) = u;
        }
        if (tid == 0 && part == 0) msc[k * 4 + 2] = m;
        const float M = fmaxf(m, ab0.x);
        const float decay = __expf(m - M), sc = __expf(ab0.x - M);
#pragma unroll
        for (int i = 0; i < 6; ++i) {
            C[i][0] = decay * C[i][0] + sc * bflo(d0[i].x); C[i][1] = decay * C[i][1] + sc * bfhi(d0[i].x);
            C[i][2] = decay * C[i][2] + sc * bflo(d0[i].y); C[i][3] = decay * C[i][3] + sc * bfhi(d0[i].y);
        }
        m = ab0.y + M;
#pragma unroll
        for (int i = 0; i < 6; ++i) { d0[i] = d1[i]; d1[i] = d2[i]; }
        ab0 = ab1; ab1 = ab2;
    }
}

__device__ __forceinline__ void mlstm_C(const Params& P, int item, unsigned char* smem) {
    const int tid = threadIdx.x, lane = tid & 63, w = tid >> 6, g = lane >> 4, lr = lane & 15;
    const int wu = __builtin_amdgcn_readfirstlane(w);
    const int k = item >> 5, bh = item & 31, b = bh >> 2, h = bh & 3;
    const bf16_t* z = (const bf16_t*)(P.ws + WS_Z);
    const bf16_t* qk = (const bf16_t*)(P.ws + WS_RA);
    const float* gates = (const float*)(P.ws + WS_GATES);
    bf16_t* y = (bf16_t*)(P.ws + WS_Z);
    const unsigned char* sK = smem; const unsigned char* sV = smem + 36864; unsigned char* sCb = smem;
    float* ga = (float*)(smem + 61440);
    const int pos = 64 * k + 16 * w + lr;
    const bool tvalid = pos < L;
    const size_t rrow = (size_t)(b * L + (tvalid ? pos : 0));
    const unsigned char* cslot = P.ws + WS_CBI + ((size_t)bh * 33 + k) * ST_IMG + tid * 16;
    const uint4 cb0 = *(const uint4*)(cslot), cb1 = *(const uint4*)(cslot + 4096), cb2 = *(const uint4*)(cslot + 8192), cb3 = *(const uint4*)(cslot + 12288), cb4 = *(const uint4*)(cslot + 16384),
                cb5 = *(const uint4*)(cslot + 20480), cb6 = *(const uint4*)(cslot + 24576), cb7 = *(const uint4*)(cslot + 28672), cb8 = *(const uint4*)(cslot + 32768);
    bf16x8 qf[4];
    {
        const bf16_t* qp = qk + rrow * 1024 + h * 128 + 8 * g;
#pragma unroll
        for (int ks = 0; ks < 4; ++ks) { qf[ks] = *(const bf16x8*)(qp + 32 * ks); if (!tvalid) qf[ks] = (bf16x8){0, 0, 0, 0, 0, 0, 0, 0}; }
    }
    mlstm_stage_kv(P, b, h, k, smem, smem + 36864, tid);
    if (wu == 0) {
        const float m_prev = ((const float*)(P.ws + WS_MSC))[((size_t)bh * 33 + k) * 4 + 2];
        const int p2 = 64 * k + lane;
        float lf = 0.f, li = -INFINITY;
        if (p2 < L) { lf = gates[(size_t)(b * L + p2) * 16 + 4 + h]; li = gates[(size_t)(b * L + p2) * 16 + h]; }
        float bc = lf;
#pragma unroll
        for (int o = 1; o < 64; o <<= 1) { const float n = __shfl_up(bc, o, 64); if (lane >= o) bc += n; }
        const float a = li - bc;
        float am = a;
#pragma unroll
        for (int o = 1; o < 64; o <<= 1) { const float n = __shfl_up(am, o, 64); if (lane >= o) am = fmaxf(am, n); }
        const float M = fmaxf(m_prev, am);
        ga[lane] = a; ga[64 + lane] = __expf(m_prev - M); ga[128 + lane] = __expf(-(bc + M)); ga[192 + lane] = M;
    }
    __syncthreads();
    const float Mt = ga[192 + 16 * w + lr], Wi = ga[64 + 16 * w + lr], Et = ga[128 + 16 * w + lr];
    bf16x8 pf[2];
    {
        f32x4 sa[4];
#pragma unroll
        for (int c = 0; c < 4; ++c) {
            sa[c] = (f32x4){0.f, 0.f, 0.f, 0.f};
            if (c <= wu) {
#pragma unroll
                for (int ks = 0; ks < 4; ++ks) {
                    const bf16x8 kf = *(const bf16x8*)(sK + (ks >> 1) * 8192 + vimg_off(16 * c + lr, 4 * (ks & 1) + g));
                    sa[c] = __builtin_amdgcn_mfma_f32_16x16x32_bf16(kf, qf[ks], sa[c], 0, 0, 0);
                }
                const f32x4 av = *(const f32x4*)(ga + 16 * c + 4 * g);
#pragma unroll
                for (int r = 0; r < 4; ++r) {
                    const float d = __expf(av[r] - Mt);
                    sa[c][r] = (16 * c + 4 * g + r <= 16 * w + lr) ? sa[c][r] * d : 0.f;
                }
            }
        }
#pragma unroll
        for (int s2 = 0; s2 < 2; ++s2) {
            uint4 u;
            u.x = cvt_pk_bf16(sa[2 * s2][0], sa[2 * s2][1]); u.y = cvt_pk_bf16(sa[2 * s2][2], sa[2 * s2][3]);
            u.z = cvt_pk_bf16(sa[2 * s2 + 1][0], sa[2 * s2 + 1][1]); u.w = cvt_pk_bf16(sa[2 * s2 + 1][2], sa[2 * s2 + 1][3]);
            pf[s2] = __builtin_bit_cast(bf16x8, u);
        }
    }
    __syncthreads();
    {
        unsigned char* d = sCb + tid * 16;
        *(uint4*)(d) = cb0; *(uint4*)(d + 4096) = cb1; *(uint4*)(d + 8192) = cb2; *(uint4*)(d + 12288) = cb3; *(uint4*)(d + 16384) = cb4;
        *(uint4*)(d + 20480) = cb5; *(uint4*)(d + 24576) = cb6; *(uint4*)(d + 28672) = cb7; *(uint4*)(d + 32768) = cb8;
    }
    __syncthreads();
    f32x4 na[9];
#define MC_TILE(c, lo0, hi0, lo1, hi1) { \
        na[c] = (f32x4){0.f, 0.f, 0.f, 0.f}; \
        _Pragma("unroll") for (int ks = 0; ks < 4; ++ks) { \
            const bf16x8 cf = *(const bf16x8*)(sCb + (ks >> 1) * 18432 + vimg_off(16 * (c) + lr, 4 * (ks & 1) + g)); \
            na[c] = __builtin_amdgcn_mfma_f32_16x16x32_bf16(cf, qf[ks], na[c], 0, 0, 0); } \
        na[c] *= Wi; \
        na[c] = __builtin_amdgcn_mfma_f32_16x16x32_bf16(tr_pair(lo0, hi0), pf[0], na[c], 0, 0, 0); \
        na[c] = __builtin_amdgcn_mfma_f32_16x16x32_bf16(tr_pair(lo1, hi1), pf[1], na[c], 0, 0, 0); }
    {
        uint2 vr[4][4];
        tr_read_4c(sV, g, lr, vr);
        MC_TILE(0, vr[0][0], vr[0][1], vr[0][2], vr[0][3]) MC_TILE(1, vr[1][0], vr[1][1], vr[1][2], vr[1][3])
        MC_TILE(2, vr[2][0], vr[2][1], vr[2][2], vr[2][3]) MC_TILE(3, vr[3][0], vr[3][1], vr[3][2], vr[3][3])
        tr_read_4c(sV + 8192, g, lr, vr);
        MC_TILE(4, vr[0][0], vr[0][1], vr[0][2], vr[0][3]) MC_TILE(5, vr[1][0], vr[1][1], vr[1][2], vr[1][3])
        MC_TILE(6, vr[2][0], vr[2][1], vr[2][2], vr[2][3]) MC_TILE(7, vr[3][0], vr[3][1], vr[3][2], vr[3][3])
        const uint2 o0 = tr_frag(sV + 16384, 0, 0, g, lr), o1 = tr_frag(sV + 16384, 16, 0, g, lr), o2 = tr_frag(sV + 16384, 32, 0, g, lr), o3 = tr_frag(sV + 16384, 48, 0, g, lr);
        MC_TILE(8, o0, o1, o2, o3)
    }
#undef MC_TILE
    const float den = __shfl(na[8][0], lr, 64);
    const float rden = 1.0f / fmaxf(fabsf(den), Et);
    float hs = 0.f;
#pragma unroll
    for (int c = 0; c < 8; ++c) { na[c] *= rden; hs += na[c][0] * na[c][0] + na[c][1] * na[c][1] + na[c][2] * na[c][2] + na[c][3] * na[c][3]; }
    hs += __shfl_xor(hs, 16, 64); hs += __shfl_xor(hs, 32, 64);
    const float rstd = rsqrtf(hs * (1.0f / 128.0f) + EPS);
    const float* gainp = P.m_out_norm + h * 128 + 4 * g;
#pragma unroll
    for (int c = 0; c < 8; ++c) {
        const uint2 og = *(const uint2*)(z + rrow * NZ + ZC_MO + h * 128 + 16 * c + 4 * g);
        const float o0 = bflo(og.x), o1 = bfhi(og.x), o2 = bflo(og.y), o3 = bfhi(og.y);
        const float4 gn = *(const float4*)(gainp + 16 * c);
        uint2 u;
        u.x = pk2(na[c][0] * rstd * gn.x / (1.f + __expf(-o0)), na[c][1] * rstd * gn.y / (1.f + __expf(-o1)));
        u.y = pk2(na[c][2] * rstd * gn.z / (1.f + __expf(-o2)), na[c][3] * rstd * gn.w / (1.f + __expf(-o3)));
        if (tvalid) *(uint2*)(y + rrow * NZ + h * 128 + 16 * c + 4 * g) = u;
    }
}

__device__ __forceinline__ void peer_token(const Params& P, int t, int lane, int* sidx, float* sval, int* sid, float* sgate, const unsigned char* slut) {
    const unsigned* tk = (const unsigned*)(P.ws + WS_TK) + (size_t)t * 256;
#pragma unroll
    for (int i = 0; i < 4; ++i) {
        const unsigned k = tk[lane * 4 + i];
        sidx[lane * 4 + i] = 127 - (int)(k & 127u);
        sval[lane * 4 + i] = unord_key(k & ~127u);
    }
    __builtin_amdgcn_s_waitcnt(0xc07f);
    __builtin_amdgcn_wave_barrier();
    {
        const int hd = lane >> 3, sub = lane & 7;
        unsigned x[8];
#pragma unroll
        for (int r = 0; r < 8; ++r) {
            const int c = sub * 8 + r;
            const unsigned ij = slut[c < 50 ? c : 0];
            const int i = ij >> 4, j = ij & 15;
            const unsigned kx = (ord_key(sval[(2 * hd) * 16 + i] + sval[(2 * hd + 1) * 16 + j]) & ~255u) | (unsigned)(255 - (i * 16 + j));
            x[r] = c < 50 ? kx : 0u;
        }
#pragma unroll
        for (int k = 2; k <= 64; k <<= 1) {
#pragma unroll
            for (int j = k >> 1; j >= 1; j >>= 1) {
                if (j >= 8) {
                    const int ld = j >> 3;
                    const bool lower = (sub & ld) == 0;
                    const bool desc = k >= 64 ? true : ((sub * 8) & k) == 0;
                    const bool takemax = (lower == desc);
#pragma unroll
                    for (int r = 0; r < 8; ++r) {
                        const unsigned o = (unsigned)__shfl_xor((int)x[r], ld, 64);
                        const unsigned hi = max(x[r], o), lo = min(x[r], o);
                        x[r] = takemax ? hi : lo;
                    }
                } else {
#pragma unroll
                    for (int r = 0; r < 8; ++r) {
                        if ((r & j) == 0) {
                            const int p = r | j;
                            const unsigned hi = max(x[r], x[p]), lo = min(x[r], x[p]);
                            if (k <= 4) { const bool desc = (r & k) == 0; x[r] = desc ? hi : lo; x[p] = desc ? lo : hi; }
                            else if (k >= 64) { x[r] = hi; x[p] = lo; }
                            else { const bool desc = ((sub * 8) & k) == 0; x[r] = desc ? hi : lo; x[p] = desc ? lo : hi; }
                        }
                    }
                }
            }
        }
        const float smax = unord_key((unsigned)__shfl((int)x[0], hd * 8, 64) & ~255u);
        float e[8]; float den = 0.f;
#pragma unroll
        for (int r = 0; r < 8; ++r) { e[r] = __expf(unord_key(x[r] & ~255u) - smax); den += e[r]; }
        den += __shfl_xor(den, 1, 64);
        const float inv = 1.f / den;
        if (sub < 2) {
#pragma unroll
            for (int r = 0; r < 8; ++r) {
                const int pos = 255 - (int)(x[r] & 255u), i = pos >> 4, j = pos & 15;
                sid[hd * 16 + sub * 8 + r] = sidx[(2 * hd) * 16 + i] * 128 + sidx[(2 * hd + 1) * 16 + j];
                sgate[hd * 16 + sub * 8 + r] = e[r] * inv;
            }
        }
    }
    __builtin_amdgcn_s_waitcnt(0xc07f);
    __builtin_amdgcn_wave_barrier();
    const bf16_t* xn = (const bf16_t*)(P.ws + WS_XN) + (size_t)t * DM;
    const float rstd = ((const float*)(P.ws + WS_RSTD))[t];
    const unsigned char* U = P.ws + WS_U + lane * 8;
    const unsigned char* V = P.ws + WS_V + lane * 8;
    const float* usc = (const float*)(P.ws + WS_USC);
    const float* vsc = (const float*)(P.ws + WS_VSC);
    f32x2 xf[8];
    {
        const uint4 xa = *(const uint4*)(xn + lane * 16), xb = *(const uint4*)(xn + lane * 16 + 8);
        xf[0] = (f32x2){bflo(xa.x), bfhi(xa.x)}; xf[1] = (f32x2){bflo(xa.y), bfhi(xa.y)}; xf[2] = (f32x2){bflo(xa.z), bfhi(xa.z)}; xf[3] = (f32x2){bflo(xa.w), bfhi(xa.w)};
        xf[4] = (f32x2){bflo(xb.x), bfhi(xb.x)}; xf[5] = (f32x2){bflo(xb.y), bfhi(xb.y)}; xf[6] = (f32x2){bflo(xb.z), bfhi(xb.z)}; xf[7] = (f32x2){bflo(xb.w), bfhi(xb.w)};
    }
    f32x2 acc[8];
#pragma unroll
    for (int j = 0; j < 8; ++j) acc[j] = (f32x2){0.f, 0.f};
    const int myq = ((lane >> 5) & 1) * 8 + ((lane >> 4) & 1) * 4 + ((lane >> 3) & 1) * 2 + ((lane >> 2) & 1);
#pragma unroll 1
    for (int e0 = 0; e0 < 128; e0 += 16) {
        uint2 ur[16], vr[16];
#pragma unroll
        for (int q = 0; q < 16; ++q) {
            const int id = sid[e0 + q];
            ur[q] = *(const uint2*)(U + (size_t)id * 512);
            vr[q] = *(const uint2*)(V + (size_t)id * 512);
        }
        const int myid = sid[e0 + myq];
        const float mysc = usc[myid] * rstd, myvs = vsc[myid] * sgate[e0 + myq];
        float d[16];
#pragma unroll
        for (int q = 0; q < 16; ++q) {
            f32x2 s2 = (f32x2){0.f, 0.f};
#define FP4_DOT(k) { s2 += xf[k] * __builtin_amdgcn_cvt_scalef32_pk_f32_fp4(ur[q].x, 1.0f, k); s2 += xf[4 + k] * __builtin_amdgcn_cvt_scalef32_pk_f32_fp4(ur[q].y, 1.0f, k); }
            FP4_DOT(0) FP4_DOT(1) FP4_DOT(2) FP4_DOT(3)
#undef FP4_DOT
            const float s0 = s2.x + s2.y;
            d[q] = s0;
        }
        float r8[8], r4[4], r2[2], r1;
#pragma unroll
        for (int i = 0; i < 8; ++i) { const bool up = (lane & 32) != 0; const float keep = up ? d[i + 8] : d[i], send = up ? d[i] : d[i + 8]; r8[i] = keep + __shfl_xor(send, 32, 64); }
#pragma unroll
        for (int i = 0; i < 4; ++i) { const bool up = (lane & 16) != 0; const float keep = up ? r8[i + 4] : r8[i], send = up ? r8[i] : r8[i + 4]; r4[i] = keep + __shfl_xor(send, 16, 64); }
#pragma unroll
        for (int i = 0; i < 2; ++i) { const bool up = (lane & 8) != 0; const float keep = up ? r4[i + 2] : r4[i], send = up ? r4[i] : r4[i + 2]; r2[i] = keep + __shfl_xor(send, 8, 64); }
        { const bool up = (lane & 4) != 0; const float keep = up ? r2[1] : r2[0], send = up ? r2[0] : r2[1]; r1 = keep + __shfl_xor(send, 4, 64); }
        r1 += __shfl_xor(r1, 2, 64); r1 += __shfl_xor(r1, 1, 64);
        const float a = r1 * mysc;
        const float wmine = myvs * 0.5f * a * (1.f + erff(a * 0.70710678118654752f));
#pragma unroll
        for (int q = 0; q < 16; ++q) {
            const float w = __shfl(wmine, ((q >> 3) & 1) * 32 + ((q >> 2) & 1) * 16 + ((q >> 1) & 1) * 8 + (q & 1) * 4, 64);
#define FP4_AXPY(k) { acc[k] += w * __builtin_amdgcn_cvt_scalef32_pk_f32_fp4(vr[q].x, 1.0f, k); acc[4 + k] += w * __builtin_amdgcn_cvt_scalef32_pk_f32_fp4(vr[q].y, 1.0f, k); }
            FP4_AXPY(0) FP4_AXPY(1) FP4_AXPY(2) FP4_AXPY(3)
#undef FP4_AXPY
        }
    }
    float* o = P.out + (size_t)t * DM + lane * 16;
    float4 h0, h1, h2, h3;
    {
        const float4 g0 = *(const float4*)(P.norm_ffn + lane * 16), g1 = *(const float4*)(P.norm_ffn + lane * 16 + 4), g2 = *(const float4*)(P.norm_ffn + lane * 16 + 8), g3 = *(const float4*)(P.norm_ffn + lane * 16 + 12);
        h0.x = xf[0].x / g0.x + acc[0].x; h0.y = xf[0].y / g0.y + acc[0].y; h0.z = xf[1].x / g0.z + acc[1].x; h0.w = xf[1].y / g0.w + acc[1].y;
        h1.x = xf[2].x / g1.x + acc[2].x; h1.y = xf[2].y / g1.y + acc[2].y; h1.z = xf[3].x / g1.z + acc[3].x; h1.w = xf[3].y / g1.w + acc[3].y;
        h2.x = xf[4].x / g2.x + acc[4].x; h2.y = xf[4].y / g2.y + acc[4].y; h2.z = xf[5].x / g2.z + acc[5].x; h2.w = xf[5].y / g2.w + acc[5].y;
        h3.x = xf[6].x / g3.x + acc[6].x; h3.y = xf[6].y / g3.y + acc[6].y; h3.z = xf[7].x / g3.z + acc[7].x; h3.w = xf[7].y / g3.w + acc[7].y;
    }
    *(float4*)(o) = h0; *(float4*)(o + 4) = h1; *(float4*)(o + 8) = h2; *(float4*)(o + 12) = h3;
    __builtin_amdgcn_s_waitcnt(0xc07f);
    __builtin_amdgcn_wave_barrier();
}

#define LAS __attribute__((address_space(3)))
#define XB_TMO      128
#define XB_XCNT(j)  (256  + 64 * (j))
#define XB_XSUB(j)  (1280 + 64 * (j))
#define XB_XGEN(j)  (2304 + 64 * (j))
#define XB_TOP      3328
#define XB_TOPGEN   3392
#define XCD_BAR_WORDS 3456
#define XB_SPIN_CAP (1u << 18)
__device__ __forceinline__ unsigned xb_ld(unsigned* p)              { return __hip_atomic_load(p, __ATOMIC_RELAXED, __HIP_MEMORY_SCOPE_AGENT); }
__device__ __forceinline__ unsigned xb_add(unsigned* p, unsigned v) { return __hip_atomic_fetch_add(p, v, __ATOMIC_RELAXED, __HIP_MEMORY_SCOPE_AGENT); }
__device__ __forceinline__ unsigned xb_xcc_id() { return (unsigned)__builtin_amdgcn_s_getreg((3 << 11) | 20) & 0xFu; }
#define XB_SPIN(cond, bar) do { unsigned _sp = 0; while (cond) { __builtin_amdgcn_s_sleep(1); \
    if ((++_sp & 255u) == 0u) { if (xb_ld(&(bar)[XB_TMO])) break; if (_sp > XB_SPIN_CAP) { atomicAdd(&(bar)[XB_TMO], 1u); break; } } } } while (0)
struct XcdBarrier { unsigned* bar; unsigned x; volatile LAS unsigned* st; };
__device__ __forceinline__ XcdBarrier xcd_barrier_post(unsigned* bar, volatile LAS unsigned* st) {
    XcdBarrier b; b.bar = bar; b.x = xb_xcc_id(); b.st = st;
    if (threadIdx.x == 0) (void)xb_add(&bar[XB_XCNT(b.x)], 1u);
    return b;
}
__device__ __forceinline__ void xcd_barrier_complete(unsigned* bar, unsigned x, unsigned& nloc, unsigned& nx) {
    const unsigned G = gridDim.x * gridDim.y * gridDim.z;
    unsigned sum, cnt, mine, sp = 0u;
    for (;;) {
        sum = 0u; cnt = 0u; mine = 0u;
#pragma unroll
        for (unsigned j = 0; j < 16; ++j) { const unsigned c = xb_ld(&bar[XB_XCNT(j)]); sum += c; cnt += (c > 0u) ? 1u : 0u; mine = (j == x) ? c : mine; }
        if (sum == G) break;
        __builtin_amdgcn_s_sleep(1);
        if ((++sp & 255u) == 0u) { if (xb_ld(&bar[XB_TMO])) break; if (sp > XB_SPIN_CAP) { atomicAdd(&bar[XB_TMO], 1u); break; } }
    }
    nloc = mine > 0u ? mine : 1u; nx = cnt > 0u ? cnt : 1u;
}
__device__ __forceinline__ void xcd_barrier(const XcdBarrier& b) {
    asm volatile("s_waitcnt vmcnt(0)" ::: "memory");
    __syncthreads();
    if (threadIdx.x == 0) {
        unsigned* bar = b.bar;
        __builtin_amdgcn_s_waitcnt(0);
        unsigned nloc = b.st[0], nx = b.st[1];
        if (nloc == 0u) { xcd_barrier_complete(bar, b.x, nloc, nx); b.st[0] = nloc; b.st[1] = nx; }
        const unsigned old = xb_add(&bar[XB_XSUB(b.x)], 1u);
        const unsigned gen = old / nloc;
        if (old + 1u == (gen + 1u) * nloc) {
            __builtin_amdgcn_fence(__ATOMIC_RELEASE, "agent");
            asm volatile("s_waitcnt vmcnt(0)" ::: "memory");
            const unsigned og = xb_add(&bar[XB_TOP], 1u);
            const unsigned tg = og / nx;
            if (og + 1u == (tg + 1u) * nx) xb_add(&bar[XB_TOPGEN], 1u);
            else XB_SPIN(xb_ld(&bar[XB_TOPGEN]) == tg, bar);
            __builtin_amdgcn_fence(__ATOMIC_ACQUIRE, "agent");
            xb_add(&bar[XB_XGEN(b.x)], 1u);
            asm volatile("s_waitcnt vmcnt(0)" ::: "memory");
        } else {
            XB_SPIN(xb_ld(&bar[XB_XGEN(b.x)]) == gen, bar);
            __builtin_amdgcn_fence(__ATOMIC_ACQUIRE, "agent");
            asm volatile("s_waitcnt vmcnt(0)" ::: "memory");
        }
    }
    __syncthreads();
}

__device__ __forceinline__ void hand_release() { asm volatile("s_waitcnt vmcnt(0)" ::: "memory"); __builtin_amdgcn_fence(__ATOMIC_RELEASE, "agent"); asm volatile("s_waitcnt vmcnt(0)" ::: "memory"); }
__device__ __forceinline__ void hand_acquire() { __builtin_amdgcn_fence(__ATOMIC_ACQUIRE, "agent"); asm volatile("s_waitcnt vmcnt(0)" ::: "memory"); }

__global__ void __launch_bounds__(256, 2) mega(Params P) {
    extern __shared__ __attribute__((aligned(16))) unsigned char smem[];
    const int tid = threadIdx.x, lane = tid & 63, wave = tid >> 6;
    const int G = gridDim.x, bid = blockIdx.x;
    unsigned* ctl = (unsigned*)(P.ws + WS_CTL);
    volatile LAS unsigned* bst = (volatile LAS unsigned*)(smem + 65552);
    if (tid == 0) { bst[0] = 0u; bst[1] = 0u; }
    __syncthreads();
    const XcdBarrier xb = xcd_barrier_post(ctl + 1024, bst);
    phase0(P, smem);
    xcd_barrier(xb);
    {
        const int gw = bid * 4 + wave;
        if (gw < 64) fox_cum_wave(P, gw, lane);
        for (int tile = bid; tile < 129 * 28; tile += G) gemm_tile<1>(P, tile / 28, tile % 28, smem);
        {
            const int rem = (129 * 28) % G;
            if (rem > 0 && rem < G) { if (bid >= rem) convert_uv_rows(P, (bid - rem) * 4 + wave, (G - rem) * 4, lane); }
            else convert_uv_rows(P, bid * 4 + wave, G * 4, lane);
        }
    }
    xcd_barrier(xb);
    {
        volatile int* s_item = (volatile int*)(smem + 65536);
        const int wave_u = __builtin_amdgcn_readfirstlane(wave);
        auto fetch = [&](unsigned* counter) -> int {
            if (wave_u == 0) {
                unsigned v = atomicAdd(counter, lane == 0 ? 1u : 0u);
                *s_item = (int)__builtin_amdgcn_readfirstlane(v);
            }
            __syncthreads();
            const int item = __builtin_amdgcn_readfirstlane(*s_item);
            __syncthreads();
            return item;
        };
        for (;;) {
            const int item = fetch(&ctl[2]);
            if (item >= 33 * 32) break;
            mlstm_A(P, item, smem);
        }
        xcd_barrier(xb);
        for (;;) {
            const int item = fetch(&ctl[4]);
            if (item >= 96) break;
            mlstm_B(P, item);
        }
        for (;;) {
            const int item = fetch(&ctl[3]);
            if (item >= 64 * 17) break;
            attn_block(P, item & 63, 16 - (item >> 6), smem);
        }
        xcd_barrier(xb);
        for (;;) {
            const int item = fetch(&ctl[5]);
            if (item >= 33 * 32) break;
            mlstm_C(P, item, smem);
        }
    }
    xcd_barrier(xb);
    for (int tile = bid; tile < 128 * 8; tile += G) gemm_tile<2>(P, tile >> 3, tile & 7, smem);
    xcd_barrier(xb);
    for (int tile = bid; tile < 128 * 16; tile += G) gemm_tile<3>(P, tile >> 4, tile & 15, smem);
    xcd_barrier(xb);
    {
        unsigned char* slut = smem + 12288;
        if (tid < 64) {
            int c = tid, i = 0;
            while (i < 16 && c >= 16 / (i + 1)) { c -= 16 / (i + 1); ++i; }
            slut[tid] = (unsigned char)(i < 16 ? ((i << 4) | c) : 0);
        }
        __syncthreads();
        int* sidx = (int*)(smem + wave * 3072); float* sval = (float*)(smem + wave * 3072 + 1024);
        int* sid = (int*)(smem + wave * 3072 + 2048); float* sgate = (float*)(smem + wave * 3072 + 2560);
        for (int t = bid * 4 + wave; t < T2; t += G * 4) peer_token(P, t, lane, sidx, sval, sid, sgate, slut);
    }
}

}

extern "C" void kernel_launch(void* const* d_in, const int* in_sizes, int n_in, void* d_out, int out_size, void* d_ws, size_t ws_size, hipStream_t stream) {
    if (n_in != 17 || ws_size < WS_END) { fprintf(stderr, "kernel_launch: unexpected n_in %d or ws_size %zu (need %zu)\n", n_in, ws_size, (size_t)WS_END); return; }
    constexpr int LDS_BYTES = 66560;
    static int grid_blocks = 0;
    if (!grid_blocks) {
        int dev = 0, cus = 0, per_cu = 0;
        (void)hipGetDevice(&dev);
        (void)hipDeviceGetAttribute(&cus, hipDeviceAttributeMultiprocessorCount, dev);
        (void)hipFuncSetAttribute((const void*)mega, hipFuncAttributeMaxDynamicSharedMemorySize, LDS_BYTES);
        (void)hipOccupancyMaxActiveBlocksPerMultiprocessor(&per_cu, (const void*)mega, 256, LDS_BYTES);
        if (per_cu < 1) per_cu = 1;
        if (per_cu > 2) per_cu = 2;
        grid_blocks = cus * per_cu;
        fprintf(stderr, "kernel_launch: cus %d per_cu %d grid %d\n", cus, per_cu, grid_blocks);
    }
    Params P{};
    P.x = (const float*)d_in[0]; P.meta = (const float*)d_in[1]; P.norm_mix = (const float*)d_in[2]; P.w_in = (const float*)d_in[3];
    P.conv_qk = (const float*)d_in[4]; P.b_igate = (const float*)d_in[5]; P.b_fgate_m = (const float*)d_in[6]; P.m_out_norm = (const float*)d_in[7];
    P.b_fgate_f = (const float*)d_in[8]; P.f_q_norm = (const float*)d_in[9]; P.f_k_norm = (const float*)d_in[10]; P.w_out = (const float*)d_in[11];
    P.norm_ffn = (const float*)d_in[12]; P.peer_query = (const float*)d_in[13]; P.peer_keys = (const float*)d_in[14]; P.peer_u = (const float*)d_in[15];
    P.peer_v = (const float*)d_in[16]; P.out = (float*)d_out; P.ws = (unsigned char*)d_ws;
    (void)hipMemsetAsync((unsigned char*)d_ws + WS_CTL, 0, 32768, stream);
    void* args[] = {&P};
    hipError_t e = hipLaunchCooperativeKernel((const void*)mega, dim3(grid_blocks), dim3(256), args, LDS_BYTES, stream);
    if (e != hipSuccess) fprintf(stderr, "cooperative launch failed: %s (grid %d)\n", hipGetErrorString(e), grid_blocks);
}
```

```cpp
#include <hip/hip_runtime.h>
#include <stdint.h>
#include <stdio.h>
#include <hip/hip_cooperative_groups.h>
namespace cg = cooperative_groups;

namespace {

constexpr int NB = 8, SEQ = 2048, DM = 1024, NMETA = 16, L = SEQ + NMETA;
constexpr int T1 = NB * L;
constexpr int T2 = NB * SEQ;
constexpr int NZ = 3584;
constexpr int ZC_MQ = 0, ZC_MK = 512, ZC_MV = 1024, ZC_MO = 1536, ZC_FQ = 2048, ZC_FK = 2560, ZC_FV = 3072;
constexpr int PROJ = 3600;
constexpr float EPS = 1e-6f;

constexpr size_t WS_CTL = 0;
constexpr size_t WS_RA = 65536;
constexpr size_t WS_Z = WS_RA + (size_t)T1 * DM * 2;
constexpr size_t WS_GATES = WS_Z + (size_t)T1 * NZ * 2;
constexpr size_t WS_CUM = WS_GATES + (size_t)T1 * 16 * 4;
constexpr size_t WS_SSQ = WS_CUM + (size_t)NB * 8 * L * 4;
constexpr size_t WS_RSTD = WS_SSQ + (size_t)T2 * 16 * 4;
constexpr size_t WS_SSQM = WS_RSTD + (size_t)T2 * 4;
constexpr size_t WS_BT2 = WS_SSQM + (size_t)T1 * 16 * 4;
constexpr size_t WS_BT3 = WS_BT2 + (size_t)DM * DM * 2;
constexpr size_t WS_KEYS = WS_BT3 + (size_t)2048 * DM * 2;
constexpr size_t WS_MSC = WS_KEYS + (size_t)16 * 128 * 128 * 2;
constexpr size_t WS_MST = WS_MSC + (size_t)128 * 33 * 16;
constexpr size_t WS_BT1 = WS_MST + (size_t)32 * 33 * 36864;
constexpr size_t WS_CBI = WS_BT1;
constexpr size_t WS_UV = WS_CBI + (size_t)32 * 33 * 36864;
constexpr size_t WS_END = WS_UV + (size_t)2 * 16384 * 512 + (size_t)2 * 16384 * 4;
constexpr size_t WS_XN = WS_RA;
constexpr size_t WS_U = WS_UV;
constexpr size_t WS_V = WS_U + (size_t)16384 * 512;
constexpr size_t WS_USC = WS_V + (size_t)16384 * 512;
constexpr size_t WS_VSC = WS_USC + (size_t)16384 * 4;
constexpr size_t WS_TK = WS_CBI;
constexpr float LOG2E = 1.4426950408889634f;

typedef unsigned short bf16_t;
typedef short bf16x8 __attribute__((ext_vector_type(8)));
typedef float f32x4 __attribute__((ext_vector_type(4)));
typedef __attribute__((ext_vector_type(2))) __bf16 bf16x2_t;

struct Params {
    const float* x; const float* meta; const float* norm_mix; const float* w_in; const float* conv_qk;
    const float* b_igate; const float* b_fgate_m; const float* m_out_norm; const float* b_fgate_f;
    const float* f_q_norm; const float* f_k_norm; const float* w_out; const float* norm_ffn;
    const float* peer_query; const float* peer_keys; const float* peer_u; const float* peer_v;
    float* out; unsigned char* ws;
};

__device__ __forceinline__ unsigned f2bf(float f) { unsigned u = __float_as_uint(f); return (u + 0x7fffu + ((u >> 16) & 1u)) >> 16; }
__device__ __forceinline__ float bf2f(unsigned h) { return __uint_as_float(h << 16); }
typedef float f32x2 __attribute__((ext_vector_type(2)));
typedef __bf16 bf16x2v __attribute__((ext_vector_type(2)));
__device__ __forceinline__ unsigned cvt_pk_bf16(float lo, float hi) { f32x2 v = {lo, hi}; bf16x2v b = __builtin_convertvector(v, bf16x2v); return __builtin_bit_cast(unsigned, b); }
__device__ __forceinline__ unsigned pk2(float lo, float hi) { return cvt_pk_bf16(lo, hi); }
__device__ __forceinline__ float bflo(unsigned w) { return __uint_as_float(w << 16); }
__device__ __forceinline__ float bfhi(unsigned w) { return __uint_as_float(w & 0xffff0000u); }
__device__ __forceinline__ float wave_sum(float v) {
#pragma unroll
    for (int o = 32; o > 0; o >>= 1) v += __shfl_xor(v, o, 64);
    return v;
}
__device__ __forceinline__ float wave_max(float v) {
#pragma unroll
    for (int o = 32; o > 0; o >>= 1) v = fmaxf(v, __shfl_xor(v, o, 64));
    return v;
}
__device__ __forceinline__ float logsigmoidf(float x) { return fminf(x, 0.f) - log1pf(expf(-fabsf(x))); }
__device__ __forceinline__ unsigned ord_key(float f) { unsigned u = __float_as_uint(f); return u ^ ((u >> 31) ? 0xffffffffu : 0x80000000u); }
__device__ __forceinline__ float unord_key(unsigned k) { unsigned u = (k & 0x80000000u) ? (k ^ 0x80000000u) : ~k; return __uint_as_float(u); }

__device__ __forceinline__ void phase0(const Params& P, unsigned char* smem) {
    const int tid = threadIdx.x, lane = tid & 63, wave = tid >> 6;
    unsigned* ctl = (unsigned*)(P.ws + WS_CTL);
    float* gw = (float*)smem;
    for (int idx = tid; idx < 16 * 1024; idx += 256) {
        const int k = idx >> 4, c = idx & 15;
        const int col = c < 8 ? 2048 + c : 3592 + (c - 8);
        gw[c * 1024 + k] = P.w_in[(size_t)k * PROJ + col];
    }
    __syncthreads();
    {
        bf16_t* hn = (bf16_t*)(P.ws + WS_RA);
        float* gates = (float*)(P.ws + WS_GATES);
        const int c0 = lane * 8, c1 = 512 + lane * 8;
        float gm[16];
        {
            const float4 a0 = *(const float4*)(P.norm_mix + c0), a1 = *(const float4*)(P.norm_mix + c0 + 4);
            const float4 a2 = *(const float4*)(P.norm_mix + c1), a3 = *(const float4*)(P.norm_mix + c1 + 4);
            gm[0] = a0.x; gm[1] = a0.y; gm[2] = a0.z; gm[3] = a0.w; gm[4] = a1.x; gm[5] = a1.y; gm[6] = a1.z; gm[7] = a1.w;
            gm[8] = a2.x; gm[9] = a2.y; gm[10] = a2.z; gm[11] = a2.w; gm[12] = a3.x; gm[13] = a3.y; gm[14] = a3.z; gm[15] = a3.w;
        }
        const int myq = ((lane >> 5) & 1) * 8 + ((lane >> 4) & 1) * 4 + ((lane >> 3) & 1) * 2 + ((lane >> 2) & 1);
        const float mybias = myq < 4 ? P.b_igate[myq] : (myq < 8 ? P.b_fgate_m[myq - 4] : P.b_fgate_f[myq - 8]);
        const int rstep = gridDim.x * 4;
        int r = blockIdx.x * 4 + wave;
        float4 n0, n1, n2, n3;
        auto load_row = [&](int rr) {
            const int b = rr / L, p = rr - b * L;
            const float* src = (p < NMETA) ? (P.meta + (size_t)p * DM) : (P.x + ((size_t)b * SEQ + (p - NMETA)) * DM);
            n0 = *(const float4*)(src + c0); n1 = *(const float4*)(src + c0 + 4); n2 = *(const float4*)(src + c1); n3 = *(const float4*)(src + c1 + 4);
        };
        if (r < T1) load_row(r);
        for (; r < T1; r += rstep) {
            float v[16];
            v[0] = n0.x; v[1] = n0.y; v[2] = n0.z; v[3] = n0.w; v[4] = n1.x; v[5] = n1.y; v[6] = n1.z; v[7] = n1.w;
            v[8] = n2.x; v[9] = n2.y; v[10] = n2.z; v[11] = n2.w; v[12] = n3.x; v[13] = n3.y; v[14] = n3.z; v[15] = n3.w;
            if (r + rstep < T1) load_row(r + rstep);
            float ss = 0.f;
#pragma unroll
            for (int j = 0; j < 16; ++j) ss += v[j] * v[j];
            ss = wave_sum(ss);
            const float rstd = rsqrtf(ss * (1.0f / DM) + EPS);
#pragma unroll
            for (int j = 0; j < 16; ++j) v[j] *= rstd * gm[j];
            uint4 o0, o1;
            o0.x = pk2(v[0], v[1]); o0.y = pk2(v[2], v[3]); o0.z = pk2(v[4], v[5]); o0.w = pk2(v[6], v[7]);
            o1.x = pk2(v[8], v[9]); o1.y = pk2(v[10], v[11]); o1.z = pk2(v[12], v[13]); o1.w = pk2(v[14], v[15]);
            *(uint4*)(hn + (size_t)r * DM + c0) = o0;
            *(uint4*)(hn + (size_t)r * DM + c1) = o1;
            float r8[8], r4[4], r2[2], r1;
#pragma unroll
            for (int i = 0; i < 8; ++i) {
                float dd[2];
#pragma unroll
                for (int hh = 0; hh < 2; ++hh) {
                    const float* gwc = gw + (i + 8 * hh) * 1024;
                    const float4 w0 = *(const float4*)(gwc + c0), w1 = *(const float4*)(gwc + c0 + 4), w2 = *(const float4*)(gwc + c1), w3 = *(const float4*)(gwc + c1 + 4);
                    dd[hh] = v[0] * w0.x + v[1] * w0.y + v[2] * w0.z + v[3] * w0.w + v[4] * w1.x + v[5] * w1.y + v[6] * w1.z + v[7] * w1.w
                           + v[8] * w2.x + v[9] * w2.y + v[10] * w2.z + v[11] * w2.w + v[12] * w3.x + v[13] * w3.y + v[14] * w3.z + v[15] * w3.w;
                }
                const bool up = (lane & 32) != 0; const float keep = up ? dd[1] : dd[0], send = up ? dd[0] : dd[1];
                r8[i] = keep + __shfl_xor(send, 32, 64);
                __builtin_amdgcn_sched_barrier(0);
            }
#pragma unroll
            for (int i = 0; i < 4; ++i) { const bool up = (lane & 16) != 0; const float keep = up ? r8[i + 4] : r8[i], send = up ? r8[i] : r8[i + 4]; r4[i] = keep + __shfl_xor(send, 16, 64); }
#pragma unroll
            for (int i = 0; i < 2; ++i) { const bool up = (lane & 8) != 0; const float keep = up ? r4[i + 2] : r4[i], send = up ? r4[i] : r4[i + 2]; r2[i] = keep + __shfl_xor(send, 8, 64); }
            { const bool up = (lane & 4) != 0; const float keep = up ? r2[1] : r2[0], send = up ? r2[0] : r2[1]; r1 = keep + __shfl_xor(send, 4, 64); }
            r1 += __shfl_xor(r1, 2, 64); r1 += __shfl_xor(r1, 1, 64);
            if ((lane & 3) == 0) {
                const float pre = r1 + mybias;
                gates[(size_t)r * 16 + myq] = myq < 4 ? pre : logsigmoidf(pre);
            }
        }
    }
    __syncthreads();
    {
        float (*tile)[65] = (float (*)[65])smem;
        for (int item = blockIdx.x; item < 1664; item += gridDim.x) {
            const float* W; int ldn, ntn, shift_from, it; bf16_t* out;
            if (item < 896) { W = P.w_in; ldn = PROJ; ntn = 56; shift_from = 2048; it = item; out = (bf16_t*)(P.ws + WS_BT1); }
            else if (item < 1152) { W = P.w_out; ldn = 1024; ntn = 16; shift_from = 1 << 30; it = item - 896; out = (bf16_t*)(P.ws + WS_BT2); }
            else { W = P.peer_query; ldn = 2048; ntn = 32; shift_from = 1 << 30; it = item - 1152; out = (bf16_t*)(P.ws + WS_BT3); }
            const int tk = it / ntn, tn = it - tk * ntn, k0 = tk * 64, n0 = tn * 64;
            {
                const int nl = tid & 63;
                int n = n0 + nl; if (n >= shift_from) n += 8;
#pragma unroll
                for (int i = 0; i < 16; ++i) { const int kl = (tid >> 6) + 4 * i; tile[kl][nl] = W[(size_t)(k0 + kl) * ldn + n]; }
            }
            __syncthreads();
            {
                const int kl = tid & 63;
#pragma unroll
                for (int i = 0; i < 16; ++i) { const int nl = (tid >> 6) + 4 * i; out[(size_t)(n0 + nl) * 1024 + k0 + kl] = (bf16_t)f2bf(tile[kl][nl]); }
            }
            __syncthreads();
        }
    }
    {
        const size_t gt = (size_t)blockIdx.x * 256 + tid, gs = (size_t)gridDim.x * 256;
        const float* src = P.peer_keys; bf16_t* dst = (bf16_t*)(P.ws + WS_KEYS);
        for (size_t i = gt; i < (size_t)(16 * 128 * 128 / 8); i += gs) {
            const float4 a = *(const float4*)(src + i * 8), b = *(const float4*)(src + i * 8 + 4);
            uint4 o; o.x = pk2(a.x, a.y); o.y = pk2(a.z, a.w); o.z = pk2(b.x, b.y); o.w = pk2(b.z, b.w);
            *(uint4*)(dst + i * 8) = o;
        }
    }
}

__device__ __forceinline__ void convert_uv_rows(const Params& P, int gwave, int nwaves, int lane) {
    for (int rr0 = gwave * 4; rr0 < 2 * 16384; rr0 += nwaves * 4) {
        float4 a[4][4];
#pragma unroll
        for (int q = 0; q < 4; ++q) {
            const int rr = rr0 + q, which = rr >> 14, row = rr & 16383;
            const float* src = (which ? P.peer_v : P.peer_u) + (size_t)row * DM + lane * 16;
            a[q][0] = *(const float4*)(src); a[q][1] = *(const float4*)(src + 4); a[q][2] = *(const float4*)(src + 8); a[q][3] = *(const float4*)(src + 12);
        }
#pragma unroll
        for (int q = 0; q < 4; ++q) {
            const int rr = rr0 + q, which = rr >> 14, row = rr & 16383;
            float mx = 0.f;
#pragma unroll
            for (int j = 0; j < 4; ++j) mx = fmaxf(mx, fmaxf(fmaxf(fabsf(a[q][j].x), fabsf(a[q][j].y)), fmaxf(fabsf(a[q][j].z), fabsf(a[q][j].w))));
            mx = wave_max(mx);
            const float sc = mx > 0.f ? 6.0f / mx : 1.0f;
            unsigned w0 = 0u, w1 = 0u;
            w0 = __builtin_amdgcn_cvt_scalef32_pk_fp4_f32(w0, a[q][0].x * sc, a[q][0].y * sc, 1.0f, 0); w0 = __builtin_amdgcn_cvt_scalef32_pk_fp4_f32(w0, a[q][0].z * sc, a[q][0].w * sc, 1.0f, 1);
            w0 = __builtin_amdgcn_cvt_scalef32_pk_fp4_f32(w0, a[q][1].x * sc, a[q][1].y * sc, 1.0f, 2); w0 = __builtin_amdgcn_cvt_scalef32_pk_fp4_f32(w0, a[q][1].z * sc, a[q][1].w * sc, 1.0f, 3);
            w1 = __builtin_amdgcn_cvt_scalef32_pk_fp4_f32(w1, a[q][2].x * sc, a[q][2].y * sc, 1.0f, 0); w1 = __builtin_amdgcn_cvt_scalef32_pk_fp4_f32(w1, a[q][2].z * sc, a[q][2].w * sc, 1.0f, 1);
            w1 = __builtin_amdgcn_cvt_scalef32_pk_fp4_f32(w1, a[q][3].x * sc, a[q][3].y * sc, 1.0f, 2); w1 = __builtin_amdgcn_cvt_scalef32_pk_fp4_f32(w1, a[q][3].z * sc, a[q][3].w * sc, 1.0f, 3);
            *(uint2*)(P.ws + (which ? WS_V : WS_U) + (size_t)row * 512 + lane * 8) = make_uint2(w0, w1);
            if (lane == 0) ((float*)(P.ws + (which ? WS_VSC : WS_USC)))[row] = mx > 0.f ? mx * (1.0f / 6.0f) : 1.0f;
        }
    }
}

__device__ __forceinline__ void bitonic_sort16_desc(unsigned (&v)[16]) {
#pragma unroll
    for (int k = 2; k <= 16; k <<= 1)
#pragma unroll
        for (int j = k >> 1; j >= 1; j >>= 1)
#pragma unroll
            for (int i = 0; i < 16; ++i)
                if ((i & j) == 0) {
                    const int p = i | j;
                    const bool desc = (k >= 16) ? true : ((i & k) == 0);
                    const unsigned hi = max(v[i], v[p]), lo = min(v[i], v[p]);
                    v[i] = desc ? hi : lo; v[p] = desc ? lo : hi;
                }
}
__device__ __forceinline__ void bitonic_merge16_top(unsigned (&a)[16], const unsigned (&b)[16]) {
#pragma unroll
    for (int i = 0; i < 16; ++i) a[i] = max(a[i], b[15 - i]);
#pragma unroll
    for (int j = 8; j >= 1; j >>= 1)
#pragma unroll
        for (int i = 0; i < 16; ++i)
            if ((i & j) == 0) { const int p = i | j; const unsigned hi = max(a[i], a[p]), lo = min(a[i], a[p]); a[i] = hi; a[p] = lo; }
}

__device__ __forceinline__ void mma_ktile(const unsigned char* sA, const unsigned char* sB, int arow_off, int brow_off, int g, int sw, f32x4 (&acc)[4][4]) {
#pragma unroll
    for (int s = 0; s < 2; ++s) {
        bf16x8 a[4], b[4];
        const int ch = (((s * 4 + g) ^ sw) << 4);
#pragma unroll
        for (int i = 0; i < 4; ++i) a[i] = *(const bf16x8*)(sA + arow_off + i * 2048 + ch);
#pragma unroll
        for (int j = 0; j < 4; ++j) b[j] = *(const bf16x8*)(sB + brow_off + j * 2048 + ch);
#pragma unroll
        for (int i = 0; i < 4; ++i)
#pragma unroll
            for (int j = 0; j < 4; ++j) acc[i][j] = __builtin_amdgcn_mfma_f32_16x16x32_bf16(b[j], a[i], acc[i][j], 0, 0, 0);
    }
}

__device__ __forceinline__ void store_tile_bf16(const f32x4 (&acc)[4][4], unsigned char* smem, bf16_t* dst, size_t ld, int m0, int n0, int tid, int wr, int wc, int g, int lr) {
#pragma unroll
    for (int i = 0; i < 4; ++i)
#pragma unroll
        for (int j = 0; j < 4; ++j) {
            const int row = wr * 64 + 16 * i + lr, col = wc * 64 + 16 * j + 4 * g;
            uint2 w; w.x = pk2(acc[i][j][0], acc[i][j][1]); w.y = pk2(acc[i][j][2], acc[i][j][3]);
            *(uint2*)(smem + row * 272 + col * 2) = w;
        }
    __syncthreads();
#pragma unroll
    for (int q = 0; q < 8; ++q) {
        const int id = tid + 256 * q, row = id >> 4, ch = id & 15;
        const uint4 v = *(const uint4*)(smem + row * 272 + ch * 16);
        *(uint4*)(dst + (size_t)(m0 + row) * ld + n0 + ch * 8) = v;
    }
    __syncthreads();
}

template <int MODE>
__device__ __forceinline__ void gemm_tile(const Params& P, int tm, int tn, unsigned char* smem) {
    const bf16_t* A; const bf16_t* Bt;
    if (MODE == 1) { A = (const bf16_t*)(P.ws + WS_RA); Bt = (const bf16_t*)(P.ws + WS_BT1); }
    else if (MODE == 2) { A = (const bf16_t*)(P.ws + WS_Z); Bt = (const bf16_t*)(P.ws + WS_BT2); }
    else { A = (const bf16_t*)(P.ws + WS_XN); Bt = (const bf16_t*)(P.ws + WS_BT3); }
    const int tid = threadIdx.x, lane = tid & 63, wave = tid >> 6, wr = wave >> 1, wc = wave & 1, g = lane >> 4, lr = lane & 15;
    const int m0 = tm * 128, n0 = tn * 128;
    const int srow = tid >> 3, sc = tid & 7;
    const bf16_t* aptr[4]; const bf16_t* bptr[4]; int soff[4];
#pragma unroll
    for (int j = 0; j < 4; ++j) {
        const int row = srow + 32 * j;
        int ar = m0 + row;
        if (MODE == 2) { const int b = ar >> 11, t = ar & 2047; ar = b * L + NMETA + t; }
        aptr[j] = A + (size_t)ar * (MODE == 2 ? NZ : 1024) + sc * 8;
        bptr[j] = Bt + (size_t)(n0 + row) * 1024 + sc * 8;
        soff[j] = row * 128 + ((sc ^ (row & 7)) << 4);
    }
    f32x4 acc[4][4];
#pragma unroll
    for (int i = 0; i < 4; ++i)
#pragma unroll
        for (int j = 0; j < 4; ++j) acc[i][j] = (f32x4){0.f, 0.f, 0.f, 0.f};
    uint4 ra[4], rb[4];
#pragma unroll
    for (int j = 0; j < 4; ++j) { ra[j] = *(const uint4*)(aptr[j]); rb[j] = *(const uint4*)(bptr[j]); }
    unsigned char* sA0 = smem; unsigned char* sB0 = smem + 16384; unsigned char* sA1 = smem + 32768; unsigned char* sB1 = smem + 49152;
#pragma unroll
    for (int j = 0; j < 4; ++j) { *(uint4*)(sA0 + soff[j]) = ra[j]; *(uint4*)(sB0 + soff[j]) = rb[j]; }
    __syncthreads();
    const int arow_off = (wr * 64 + lr) * 128, brow_off = (wc * 64 + lr) * 128, sw = lr & 7;
    for (int kt = 0; kt < 16; ++kt) {
        unsigned char* sA = (kt & 1) ? sA1 : sA0; unsigned char* sB = (kt & 1) ? sB1 : sB0;
        unsigned char* nA = (kt & 1) ? sA0 : sA1; unsigned char* nB = (kt & 1) ? sB0 : sB1;
        if (kt < 15) {
#pragma unroll
            for (int j = 0; j < 4; ++j) { ra[j] = *(const uint4*)(aptr[j] + (kt + 1) * 64); rb[j] = *(const uint4*)(bptr[j] + (kt + 1) * 64); }
        }
        mma_ktile(sA, sB, arow_off, brow_off, g, sw, acc);
        if (kt < 15) {
#pragma unroll
            for (int j = 0; j < 4; ++j) { *(uint4*)(nA + soff[j]) = ra[j]; *(uint4*)(nB + soff[j]) = rb[j]; }
        }
        __syncthreads();
    }
    if (MODE == 1) {
        if (n0 >= ZC_FQ && n0 < ZC_FV) {
            const bool isk = n0 >= ZC_FK;
            const float* gain = isk ? P.f_k_norm : P.f_q_norm;
            const float scl = isk ? 1.0f : 0.125f * LOG2E;
            float gn[4][4];
#pragma unroll
            for (int j = 0; j < 4; ++j)
#pragma unroll
                for (int r = 0; r < 4; ++r) gn[j][r] = gain[16 * j + 4 * g + r];
#pragma unroll
            for (int i = 0; i < 4; ++i) {
                float ss = 0.f;
#pragma unroll
                for (int j = 0; j < 4; ++j)
#pragma unroll
                    for (int r = 0; r < 4; ++r) ss += acc[i][j][r] * acc[i][j][r];
                ss += __shfl_xor(ss, 16, 64); ss += __shfl_xor(ss, 32, 64);
                const float rstd = rsqrtf(ss * (1.0f / 64.0f) + EPS) * scl;
#pragma unroll
                for (int j = 0; j < 4; ++j)
#pragma unroll
                    for (int r = 0; r < 4; ++r) acc[i][j][r] *= rstd * gn[j][r];
            }
        }
        store_tile_bf16(acc, smem, (bf16_t*)(P.ws + WS_Z), NZ, m0, n0, tid, wr, wc, g, lr);
    } else if (MODE == 2) {
        float* ssq = (float*)(P.ws + WS_SSQ);
#pragma unroll
        for (int i = 0; i < 4; ++i) {
            const int row = m0 + wr * 64 + 16 * i + lr;
            float ss = 0.f;
#pragma unroll
            for (int j = 0; j < 4; ++j) {
                const int col = n0 + wc * 64 + 16 * j + 4 * g;
                const float4 xv = *(const float4*)(P.x + (size_t)row * DM + col);
                const float4 gv = *(const float4*)(P.norm_ffn + col);
                float4 hv; hv.x = acc[i][j][0] + xv.x; hv.y = acc[i][j][1] + xv.y; hv.z = acc[i][j][2] + xv.z; hv.w = acc[i][j][3] + xv.w;
                ss += hv.x * hv.x + hv.y * hv.y + hv.z * hv.z + hv.w * hv.w;
                acc[i][j][0] = hv.x * gv.x; acc[i][j][1] = hv.y * gv.y; acc[i][j][2] = hv.z * gv.z; acc[i][j][3] = hv.w * gv.w;
            }
            ss += __shfl_xor(ss, 16, 64); ss += __shfl_xor(ss, 32, 64);
            if (g == 0) ssq[(size_t)row * 16 + tn * 2 + wc] = ss;
        }
        store_tile_bf16(acc, smem, (bf16_t*)(P.ws + WS_XN), 1024, m0, n0, tid, wr, wc, g, lr);
    } else {
        const int hp = tn;
        const float* ssq = (const float*)(P.ws + WS_SSQ);
        float rs[4];
#pragma unroll
        for (int i = 0; i < 4; ++i) {
            const int row = m0 + wr * 64 + 16 * i + lr;
            const float4 p0 = *(const float4*)(ssq + (size_t)row * 16), p1 = *(const float4*)(ssq + (size_t)row * 16 + 4);
            const float4 p2 = *(const float4*)(ssq + (size_t)row * 16 + 8), p3 = *(const float4*)(ssq + (size_t)row * 16 + 12);
            const float s = ((p0.x + p0.y) + (p0.z + p0.w)) + ((p1.x + p1.y) + (p1.z + p1.w)) + ((p2.x + p2.y) + (p2.z + p2.w)) + ((p3.x + p3.y) + (p3.z + p3.w));
            rs[i] = rsqrtf(s * (1.0f / DM) + EPS);
            if (tn == 0 && wc == 0 && g == 0) ((float*)(P.ws + WS_RSTD))[row] = rs[i];
        }
        {
            unsigned char* sAq = wc ? sA1 : sA0;
#pragma unroll
            for (int i = 0; i < 4; ++i)
#pragma unroll
                for (int j = 0; j < 4; ++j) {
                    const int row = wr * 64 + 16 * i + lr;
                    const int chunk = 2 * j + (g >> 1);
                    uint2 w; w.x = pk2(acc[i][j][0] * rs[i], acc[i][j][1] * rs[i]); w.y = pk2(acc[i][j][2] * rs[i], acc[i][j][3] * rs[i]);
                    *(uint2*)(sAq + row * 128 + ((chunk ^ (row & 7)) << 4) + 8 * (g & 1)) = w;
                }
            const bf16_t* keys = (const bf16_t*)(P.ws + WS_KEYS) + (size_t)hp * 128 * 128;
#pragma unroll
            for (int j = 0; j < 4; ++j) {
                const int row = srow + 32 * j;
                const uint4 k0 = *(const uint4*)(keys + (size_t)row * 128 + sc * 8);
                const uint4 k1 = *(const uint4*)(keys + (size_t)row * 128 + 64 + sc * 8);
                *(uint4*)(sB0 + soff[j]) = k0; *(uint4*)(sB1 + soff[j]) = k1;
            }
        }
        __syncthreads();
#pragma unroll
        for (int i = 0; i < 4; ++i)
#pragma unroll
            for (int j = 0; j < 4; ++j) acc[i][j] = (f32x4){0.f, 0.f, 0.f, 0.f};
        mma_ktile(sA0, sB0, arow_off, brow_off, g, sw, acc);
        mma_ktile(sA1, sB1, arow_off, brow_off, g, sw, acc);
        __syncthreads();
#pragma unroll
        for (int i = 0; i < 4; ++i)
#pragma unroll
            for (int j = 0; j < 4; ++j) {
                const int row = wr * 64 + 16 * i + lr;
                const int c4 = wc * 16 + 4 * j + g;
                *(f32x4*)(smem + row * 512 + ((c4 ^ (row & 31)) << 4)) = acc[i][j];
            }
        __syncthreads();
        unsigned top[16];
        const int row = tid & 127, half = tid >> 7;
        {
            auto load_keys = [&](unsigned (&dst)[16], int q4) {
#pragma unroll
                for (int s4 = 0; s4 < 4; ++s4) {
                    const int c4 = half * 16 + q4 * 4 + s4;
                    const f32x4 v = *(const f32x4*)(smem + row * 512 + ((c4 ^ (row & 31)) << 4));
#pragma unroll
                    for (int e = 0; e < 4; ++e) dst[s4 * 4 + e] = (ord_key(v[e]) & ~127u) | (unsigned)(127 - (c4 * 4 + e));
                }
            };
            load_keys(top, 0);
            bitonic_sort16_desc(top);
#pragma unroll 1
            for (int q4 = 1; q4 < 4; ++q4) {
                unsigned gq[16];
                load_keys(gq, q4);
                bitonic_sort16_desc(gq);
                bitonic_merge16_top(top, gq);
            }
        }
        __syncthreads();
        if (half) {
            uint4* lp = (uint4*)(smem + row * 64);
            lp[0] = make_uint4(top[0], top[1], top[2], top[3]); lp[1] = make_uint4(top[4], top[5], top[6], top[7]);
            lp[2] = make_uint4(top[8], top[9], top[10], top[11]); lp[3] = make_uint4(top[12], top[13], top[14], top[15]);
        }
        __syncthreads();
        if (!half) {
            const uint4* lp = (const uint4*)(smem + row * 64);
            unsigned other[16];
#pragma unroll
            for (int c = 0; c < 4; ++c) { const uint4 o = lp[c]; other[4 * c] = o.x; other[4 * c + 1] = o.y; other[4 * c + 2] = o.z; other[4 * c + 3] = o.w; }
            bitonic_merge16_top(top, other);
            uint4* tk = (uint4*)((unsigned*)(P.ws + WS_TK) + ((size_t)(m0 + row) * 16 + hp) * 16);
            tk[0] = make_uint4(top[0], top[1], top[2], top[3]); tk[1] = make_uint4(top[4], top[5], top[6], top[7]);
            tk[2] = make_uint4(top[8], top[9], top[10], top[11]); tk[3] = make_uint4(top[12], top[13], top[14], top[15]);
        }
        __syncthreads();
    }
}

__device__ __forceinline__ void fox_cum_wave(const Params& P, int bh, int lane) {
    const int b = bh >> 3, h = bh & 7;
    const float* gates = (const float*)(P.ws + WS_GATES);
    float* cum = (float*)(P.ws + WS_CUM) + (size_t)bh * L;
    constexpr int SEG = 33;
    const int t0 = lane * SEG;
    float loc = 0.f;
    for (int i = 0; i < SEG; ++i) { const int t = t0 + i; if (t < L) loc += gates[(size_t)(b * L + t) * 16 + 8 + h]; }
    float incl = loc;
#pragma unroll
    for (int o = 1; o < 64; o <<= 1) { const float n = __shfl_up(incl, o, 64); if (lane >= o) incl += n; }
    float run = incl - loc;
    for (int i = 0; i < SEG; ++i) { const int t = t0 + i; if (t < L) { run += gates[(size_t)(b * L + t) * 16 + 8 + h]; cum[t] = run * LOG2E; } }
}

#define TR_SLOW 0

__device__ __forceinline__ int vimg_off(int row, int ch) { return row * 128 + ((ch ^ (((row >> 1) & 3) << 1)) << 4); }
__device__ __forceinline__ uint2 tr_frag(const unsigned char* img, int row0, int c, int g, int lr) {
#if TR_SLOW
    unsigned short e[4];
#pragma unroll
    for (int k = 0; k < 4; ++k) { const int row = row0 + 4 * g + k, col = 16 * c + lr; e[k] = *(const unsigned short*)(img + vimg_off(row, col >> 3) + (col & 7) * 2); }
    uint2 r; r.x = (unsigned)e[0] | ((unsigned)e[1] << 16); r.y = (unsigned)e[2] | ((unsigned)e[3] << 16); return r;
#else
    const int q = lr >> 2, p = lr & 3, row = row0 + 4 * g + q;
    const unsigned addr = (unsigned)(size_t)(img + vimg_off(row, 2 * c + (p >> 1)) + 8 * (p & 1));
    uint2 r;
    asm volatile("ds_read_b64_tr_b16 %0, %1\n\ts_waitcnt lgkmcnt(0)" : "=&v"(r) : "v"(addr) : "memory");
    return r;
#endif
}

__device__ __forceinline__ unsigned tr_lane_addr(const unsigned char* img, int c, int g, int lr) {
    const int q = lr >> 2, p = lr & 3, row = 4 * g + q;
    return (unsigned)(size_t)(img + vimg_off(row, 2 * c + (p >> 1)) + 8 * (p & 1));
}
#define TR_GROUP(o0, o1, o2, o3, a) "ds_read_b64_tr_b16 %" #o0 ", %" #a "\n\tds_read_b64_tr_b16 %" #o1 ", %" #a " offset:2048\n\tds_read_b64_tr_b16 %" #o2 ", %" #a " offset:4096\n\tds_read_b64_tr_b16 %" #o3 ", %" #a " offset:6144\n\t"
__device__ __forceinline__ void tr_read_4c(const unsigned char* img, int g, int lr, uint2 (&r)[4][4]) {
    const unsigned a0 = tr_lane_addr(img, 0, g, lr), a1 = tr_lane_addr(img, 1, g, lr), a2 = tr_lane_addr(img, 2, g, lr), a3 = tr_lane_addr(img, 3, g, lr);
    asm volatile(TR_GROUP(0, 1, 2, 3, 16) TR_GROUP(4, 5, 6, 7, 17) TR_GROUP(8, 9, 10, 11, 18) TR_GROUP(12, 13, 14, 15, 19) "s_waitcnt lgkmcnt(0)"
        : "=&v"(r[0][0]), "=&v"(r[0][1]), "=&v"(r[0][2]), "=&v"(r[0][3]), "=&v"(r[1][0]), "=&v"(r[1][1]), "=&v"(r[1][2]), "=&v"(r[1][3]),
          "=&v"(r[2][0]), "=&v"(r[2][1]), "=&v"(r[2][2]), "=&v"(r[2][3]), "=&v"(r[3][0]), "=&v"(r[3][1]), "=&v"(r[3][2]), "=&v"(r[3][3])
        : "v"(a0), "v"(a1), "v"(a2), "v"(a3) : "memory");
}
__device__ __forceinline__ void tr_read_3c(const unsigned char* img, int g, int lr, uint2 (&r)[3][4]) {
    const unsigned a0 = tr_lane_addr(img, 0, g, lr), a1 = tr_lane_addr(img, 1, g, lr), a2 = tr_lane_addr(img, 2, g, lr);
    asm volatile(TR_GROUP(0, 1, 2, 3, 12) TR_GROUP(4, 5, 6, 7, 13) TR_GROUP(8, 9, 10, 11, 14) "s_waitcnt lgkmcnt(0)"
        : "=&v"(r[0][0]), "=&v"(r[0][1]), "=&v"(r[0][2]), "=&v"(r[0][3]), "=&v"(r[1][0]), "=&v"(r[1][1]), "=&v"(r[1][2]), "=&v"(r[1][3]),
          "=&v"(r[2][0]), "=&v"(r[2][1]), "=&v"(r[2][2]), "=&v"(r[2][3])
        : "v"(a0), "v"(a1), "v"(a2) : "memory");
}
__device__ __forceinline__ void tr_read_2(const unsigned char* img0, int c0, const unsigned char* img1, int c1, int g, int lr, uint2 (&r)[2][4]) {
    const unsigned a0 = tr_lane_addr(img0, c0, g, lr), a1 = tr_lane_addr(img1, c1, g, lr);
    asm volatile(TR_GROUP(0, 1, 2, 3, 8) TR_GROUP(4, 5, 6, 7, 9) "s_waitcnt lgkmcnt(0)"
        : "=&v"(r[0][0]), "=&v"(r[0][1]), "=&v"(r[0][2]), "=&v"(r[0][3]), "=&v"(r[1][0]), "=&v"(r[1][1]), "=&v"(r[1][2]), "=&v"(r[1][3])
        : "v"(a0), "v"(a1) : "memory");
}
__device__ __forceinline__ bf16x8 tr_pair(const uint2& lo, const uint2& hi) { uint4 u; u.x = lo.x; u.y = lo.y; u.z = hi.x; u.w = hi.y; return __builtin_bit_cast(bf16x8, u); }

__device__ __forceinline__ void attn_block(const Params& P, int bh, int qb, unsigned char* smem) {
    const int tid = threadIdx.x, lane = tid & 63, w = tid >> 6, g = lane >> 4, lr = lane & 15;
    const int b = bh >> 3, h = bh & 7;
    const bf16_t* z = (const bf16_t*)(P.ws + WS_Z);
    const float* cum = (const float*)(P.ws + WS_CUM) + (size_t)bh * L;
    int tq[2]; bool qvalid[2]; bf16x8 qf[2][2]; float cq[2];
#pragma unroll
    for (int u = 0; u < 2; ++u) {
        tq[u] = qb * 128 + 32 * w + 16 * u + lr;
        qvalid[u] = tq[u] < L;
        const bf16_t* qp = z + (size_t)(b * L + (qvalid[u] ? tq[u] : 0)) * NZ + ZC_FQ + h * 64 + 8 * g;
        qf[u][0] = *(const bf16x8*)(qp); qf[u][1] = *(const bf16x8*)(qp + 32);
        cq[u] = cum[qvalid[u] ? tq[u] : 0];
    }
    const int nkv = (2 * qb + 2 < 33) ? 2 * qb + 2 : 33;
    const int srow0 = tid >> 3, sch = tid & 7;
    uint4 rk[2], rv[2]; float rc = 0.f;
    auto load_tile = [&](int kv) {
#pragma unroll
        for (int j = 0; j < 2; ++j) {
            const int key = kv * 64 + srow0 + 32 * j;
            if (key < L) {
                const bf16_t* p = z + (size_t)(b * L + key) * NZ + h * 64 + sch * 8;
                rk[j] = *(const uint4*)(p + ZC_FK); rv[j] = *(const uint4*)(p + ZC_FV);
            } else { rk[j] = make_uint4(0, 0, 0, 0); rv[j] = make_uint4(0, 0, 0, 0); }
        }
        if (tid < 64) { const int key = kv * 64 + tid; rc = key < L ? cum[key] : 0.f; }
    };
    auto store_tile = [&](int buf) {
        unsigned char* sK = smem + buf * 16384; unsigned char* sV = sK + 8192;
#pragma unroll
        for (int j = 0; j < 2; ++j) {
            const int row = srow0 + 32 * j;
            *(uint4*)(sK + row * 128 + ((sch ^ (row & 7)) << 4)) = rk[j];
            *(uint4*)(sV + vimg_off(row, sch)) = rv[j];
        }
        if (tid < 64) ((float*)(smem + 32768 + buf * 256))[tid] = rc;
    };
    float m[2] = {-INFINITY, -INFINITY}, lsum[2] = {0.f, 0.f};
    f32x4 o[2][4];
#pragma unroll
    for (int u = 0; u < 2; ++u)
#pragma unroll
        for (int c = 0; c < 4; ++c) o[u][c] = (f32x4){0.f, 0.f, 0.f, 0.f};
    load_tile(0); store_tile(0);
    __syncthreads();
    for (int kv = 0; kv < nkv; ++kv) {
        const int buf = kv & 1;
        if (kv + 1 < nkv) load_tile(kv + 1);
        const unsigned char* sK = smem + buf * 16384; const unsigned char* sV = sK + 8192;
        const float* sck = (const float*)(smem + 32768 + buf * 256);
        f32x4 sa[2][4];
#pragma unroll
        for (int c = 0; c < 4; ++c) {
            sa[0][c] = (f32x4){0.f, 0.f, 0.f, 0.f}; sa[1][c] = (f32x4){0.f, 0.f, 0.f, 0.f};
#pragma unroll
            for (int s = 0; s < 2; ++s) {
                const bf16x8 kf = *(const bf16x8*)(sK + (16 * c + lr) * 128 + (((4 * s + g) ^ (lr & 7)) << 4));
                sa[0][c] = __builtin_amdgcn_mfma_f32_16x16x32_bf16(kf, qf[0][s], sa[0][c], 0, 0, 0);
                sa[1][c] = __builtin_amdgcn_mfma_f32_16x16x32_bf16(kf, qf[1][s], sa[1][c], 0, 0, 0);
            }
        }
        const bool diag = (kv >= 2 * qb);
        bf16x8 pf[2][2];
#pragma unroll
        for (int u = 0; u < 2; ++u) {
            float mx = -INFINITY;
#pragma unroll
            for (int c = 0; c < 4; ++c) {
                const f32x4 ck = *(const f32x4*)(sck + 16 * c + 4 * g);
#pragma unroll
                for (int r = 0; r < 4; ++r) {
                    float v = sa[u][c][r] + (cq[u] - ck[r]);
                    if (diag && (64 * kv + 16 * c + 4 * g + r > tq[u])) v = -INFINITY;
                    sa[u][c][r] = v; mx = fmaxf(mx, v);
                }
            }
            mx = fmaxf(mx, __shfl_xor(mx, 16, 64)); mx = fmaxf(mx, __shfl_xor(mx, 32, 64));
            const float mn = fmaxf(m[u], mx);
            const float alpha = __builtin_amdgcn_exp2f(m[u] - mn);
            m[u] = mn;
            float ps = 0.f;
#pragma unroll
            for (int c = 0; c < 4; ++c)
#pragma unroll
                for (int r = 0; r < 4; ++r) { const float p = __builtin_amdgcn_exp2f(sa[u][c][r] - mn); sa[u][c][r] = p; ps += p; }
            lsum[u] = lsum[u] * alpha + ps;
#pragma unroll
            for (int c = 0; c < 4; ++c) o[u][c] *= alpha;
#pragma unroll
            for (int s2 = 0; s2 < 2; ++s2) {
                uint4 uu;
                uu.x = cvt_pk_bf16(sa[u][2 * s2][0], sa[u][2 * s2][1]); uu.y = cvt_pk_bf16(sa[u][2 * s2][2], sa[u][2 * s2][3]);
                uu.z = cvt_pk_bf16(sa[u][2 * s2 + 1][0], sa[u][2 * s2 + 1][1]); uu.w = cvt_pk_bf16(sa[u][2 * s2 + 1][2], sa[u][2 * s2 + 1][3]);
                pf[u][s2] = __builtin_bit_cast(bf16x8, uu);
            }
        }
        {
            uint2 vr[4][4];
            tr_read_4c(sV, g, lr, vr);
#pragma unroll
            for (int c = 0; c < 4; ++c)
#pragma unroll
                for (int s2 = 0; s2 < 2; ++s2) {
                    const bf16x8 vf = tr_pair(vr[c][2 * s2], vr[c][2 * s2 + 1]);
                    o[0][c] = __builtin_amdgcn_mfma_f32_16x16x32_bf16(vf, pf[0][s2], o[0][c], 0, 0, 0);
                    o[1][c] = __builtin_amdgcn_mfma_f32_16x16x32_bf16(vf, pf[1][s2], o[1][c], 0, 0, 0);
                }
        }
        if (kv + 1 < nkv) store_tile(buf ^ 1);
        __syncthreads();
    }
#pragma unroll
    for (int u = 0; u < 2; ++u) {
        float ls = lsum[u];
        ls += __shfl_xor(ls, 16, 64); ls += __shfl_xor(ls, 32, 64);
        const float inv = 1.0f / ls;
        if (qvalid[u]) {
            bf16_t* y = (bf16_t*)(P.ws + WS_Z) + (size_t)(b * L + tq[u]) * NZ + 512 + h * 64 + 4 * g;
#pragma unroll
            for (int c = 0; c < 4; ++c) {
                uint2 uu; uu.x = pk2(o[u][c][0] * inv, o[u][c][1] * inv); uu.y = pk2(o[u][c][2] * inv, o[u][c][3] * inv);
                *(uint2*)(y + 16 * c) = uu;
            }
        }
    }
}

__device__ __forceinline__ void conv_item(const Params& P, int ci) {
    const int tid = threadIdx.x, cc = tid & 127, rg = tid >> 7;
    const bf16_t* z = (const bf16_t*)(P.ws + WS_Z);
    bf16_t* qk = (bf16_t*)(P.ws + WS_RA);
    const int col0 = cc * 8;
    float w[4][8];
#pragma unroll
    for (int j = 0; j < 4; ++j) {
        const float4 a = *(const float4*)(P.conv_qk + j * 1024 + col0), b = *(const float4*)(P.conv_qk + j * 1024 + col0 + 4);
        w[j][0] = a.x; w[j][1] = a.y; w[j][2] = a.z; w[j][3] = a.w; w[j][4] = b.x; w[j][5] = b.y; w[j][6] = b.z; w[j][7] = b.w;
    }
    const float oscale = (col0 >= 512) ? 0.08838834764831845f : 1.0f;
    const int r0 = ci * 64 + rg * 32;
    int t = r0 % L;
    float xw[3][8];
#pragma unroll
    for (int j = 0; j < 3; ++j) {
        const int back = 3 - j;
        if (t - back >= 0) {
            const uint4 v = *(const uint4*)(z + (size_t)(r0 - back) * NZ + col0);
            xw[j][0] = bflo(v.x); xw[j][1] = bfhi(v.x); xw[j][2] = bflo(v.y); xw[j][3] = bfhi(v.y); xw[j][4] = bflo(v.z); xw[j][5] = bfhi(v.z); xw[j][6] = bflo(v.w); xw[j][7] = bfhi(v.w);
        } else {
#pragma unroll
            for (int e = 0; e < 8; ++e) xw[j][e] = 0.f;
        }
    }
#pragma unroll 2
    for (int i = 0; i < 32; ++i) {
        const int r = r0 + i;
        if (t == 0) {
#pragma unroll
            for (int j = 0; j < 3; ++j)
#pragma unroll
                for (int e = 0; e < 8; ++e) xw[j][e] = 0.f;
        }
        const uint4 v = *(const uint4*)(z + (size_t)r * NZ + col0);
        float xt[8];
        xt[0] = bflo(v.x); xt[1] = bfhi(v.x); xt[2] = bflo(v.y); xt[3] = bfhi(v.y); xt[4] = bflo(v.z); xt[5] = bfhi(v.z); xt[6] = bflo(v.w); xt[7] = bfhi(v.w);
        float o[8];
#pragma unroll
        for (int e = 0; e < 8; ++e) {
            const float cv = w[0][e] * xw[0][e] + w[1][e] * xw[1][e] + w[2][e] * xw[2][e] + w[3][e] * xt[e];
            o[e] = oscale * cv / (1.f + __expf(-cv));
            xw[0][e] = xw[1][e]; xw[1][e] = xw[2][e]; xw[2][e] = xt[e];
        }
        uint4 ov; ov.x = pk2(o[0], o[1]); ov.y = pk2(o[2], o[3]); ov.z = pk2(o[4], o[5]); ov.w = pk2(o[6], o[7]);
        *(uint4*)(qk + (size_t)r * 1024 + col0) = ov;
        t = (t + 1 == L) ? 0 : t + 1;
    }
}

constexpr int ST_IMG = 36864;
__device__ __forceinline__ int st_piece_off(int jt, int c, int g, int lr) { return (jt >> 2) * 18432 + vimg_off(16 * c + lr, 2 * (jt & 3) + (g >> 1)) + 8 * (g & 1); }

__device__ __forceinline__ void mlstm_stage_kv(const Params& P, int b, int h, int k, unsigned char* sKimg, unsigned char* sVimg, int tid) {
    const bf16_t* z = (const bf16_t*)(P.ws + WS_Z);
    const bf16_t* qk = (const bf16_t*)(P.ws + WS_RA);
    uint4 pk_[4], pv_[4];
#pragma unroll
    for (int j = 0; j < 4; ++j) {
        const int id = tid + 256 * j, row = id >> 4, ch16 = id & 15, pos = 64 * k + row;
        const bool ok = pos < L;
        pk_[j] = ok ? *(const uint4*)(qk + (size_t)(b * L + pos) * 1024 + 512 + h * 128 + ch16 * 8) : make_uint4(0, 0, 0, 0);
        pv_[j] = ok ? *(const uint4*)(z + (size_t)(b * L + pos) * NZ + ZC_MV + h * 128 + ch16 * 8) : make_uint4(0, 0, 0, 0);
    }
#pragma unroll
    for (int j = 0; j < 4; ++j) {
        const int id = tid + 256 * j, row = id >> 4, ch16 = id & 15;
        *(uint4*)(sKimg + (ch16 >> 3) * 8192 + vimg_off(row, ch16 & 7)) = pk_[j];
        *(uint4*)(sVimg + (ch16 >> 3) * 8192 + vimg_off(row, ch16 & 7)) = pv_[j];
    }
    if (tid < 128) {
        const int row = tid >> 1, ch = tid & 1;
        *(uint4*)(sVimg + 16384 + vimg_off(row, ch)) = ch ? make_uint4(0, 0, 0, 0) : make_uint4(0x3F80u, 0, 0, 0);
    }
}

__device__ __forceinline__ void mlstm_stage_A(const Params& P, int b, int h, int k, unsigned char* sKimg, unsigned char* sVimg, int tid) {
    const bf16_t* z = (const bf16_t*)(P.ws + WS_Z);
    bf16_t* qk = (bf16_t*)(P.ws + WS_RA);
    uint4 pv_[4];
#pragma unroll
    for (int j = 0; j < 4; ++j) {
        const int id = tid + 256 * j, row = id >> 4, ch16 = id & 15, pos = 64 * k + row;
        pv_[j] = (pos < L) ? *(const uint4*)(z + (size_t)(b * L + pos) * NZ + ZC_MV + h * 128 + ch16 * 8) : make_uint4(0, 0, 0, 0);
    }
    const int cch = tid & 31, rg = tid >> 5, isk = cch >> 4;
    const int zcol = (isk ? ZC_MK : ZC_MQ) + h * 128 + (cch & 15) * 8;
    float w[4][8];
#pragma unroll
    for (int j = 0; j < 4; ++j) {
        const float4 a = *(const float4*)(P.conv_qk + j * 1024 + zcol), c = *(const float4*)(P.conv_qk + j * 1024 + zcol + 4);
        w[j][0] = a.x; w[j][1] = a.y; w[j][2] = a.z; w[j][3] = a.w; w[j][4] = c.x; w[j][5] = c.y; w[j][6] = c.z; w[j][7] = c.w;
    }
    const float oscale = isk ? 0.08838834764831845f : 1.0f;
    const int p0 = 64 * k + 8 * rg;
    uint4 raw[11];
#pragma unroll
    for (int i = 0; i < 11; ++i) {
        const int pos = p0 - 3 + i;
        raw[i] = (pos >= 0 && pos < L) ? *(const uint4*)(z + (size_t)(b * L + pos) * NZ + zcol) : make_uint4(0, 0, 0, 0);
    }
#pragma unroll
    for (int j = 0; j < 4; ++j) {
        const int id = tid + 256 * j, row = id >> 4, ch16 = id & 15;
        *(uint4*)(sVimg + (ch16 >> 3) * 8192 + vimg_off(row, ch16 & 7)) = pv_[j];
    }
    if (tid < 128) {
        const int row = tid >> 1, ch = tid & 1;
        *(uint4*)(sVimg + 16384 + vimg_off(row, ch)) = ch ? make_uint4(0, 0, 0, 0) : make_uint4(0x3F80u, 0, 0, 0);
    }
#pragma unroll
    for (int i = 0; i < 8; ++i) {
        const int pos = p0 + i, row = 8 * rg + i;
        float o[8];
#pragma unroll
        for (int e = 0; e < 8; ++e) {
            const unsigned w0 = (&raw[i].x)[e >> 1], w1 = (&raw[i + 1].x)[e >> 1], w2 = (&raw[i + 2].x)[e >> 1], w3 = (&raw[i + 3].x)[e >> 1];
            const float x0 = (e & 1) ? bfhi(w0) : bflo(w0), x1 = (e & 1) ? bfhi(w1) : bflo(w1), x2 = (e & 1) ? bfhi(w2) : bflo(w2), x3 = (e & 1) ? bfhi(w3) : bflo(w3);
            const float cv = w[0][e] * x0 + w[1][e] * x1 + w[2][e] * x2 + w[3][e] * x3;
            o[e] = oscale * cv / (1.f + __expf(-cv));
        }
        uint4 ov; ov.x = pk2(o[0], o[1]); ov.y = pk2(o[2], o[3]); ov.z = pk2(o[4], o[5]); ov.w = pk2(o[6], o[7]);
        const bool ok = pos < L;
        if (!ok) ov = make_uint4(0, 0, 0, 0);
        if (ok) *(uint4*)(qk + (size_t)(b * L + pos) * 1024 + (isk ? 512 : 0) + h * 128 + (cch & 15) * 8) = ov;
        if (isk) { const int ch16 = cch & 15; *(uint4*)(sKimg + (ch16 >> 3) * 8192 + vimg_off(row, ch16 & 7)) = ov; }
    }
}

__device__ __forceinline__ void mlstm_A(const Params& P, int item, unsigned char* smem) {
    const int tid = threadIdx.x, lane = tid & 63, w = tid >> 6, g = lane >> 4, lr = lane & 15;
    const int wu = __builtin_amdgcn_readfirstlane(w);
    const int k = item >> 5, bh = item & 31, b = bh >> 2, h = bh & 3;
    const float* gates = (const float*)(P.ws + WS_GATES);
    const unsigned char* sK = smem; const unsigned char* sV = smem + 16384;
    float* ga = (float*)(smem + 40960);
    mlstm_stage_A(P, b, h, k, smem, smem + 16384, tid);
    if (wu == 0) {
        const int pos = 64 * k + lane;
        float lf = 0.f, li = -INFINITY;
        if (pos < L) { lf = gates[(size_t)(b * L + pos) * 16 + 4 + h]; li = gates[(size_t)(b * L + pos) * 16 + h]; }
        float bc = lf;
#pragma unroll
        for (int o = 1; o < 64; o <<= 1) { const float n = __shfl_up(bc, o, 64); if (lane >= o) bc += n; }
        const float a = li - bc;
        const float A = wave_max(a);
        ga[lane] = __expf(a - A);
        if (lane == 63) { float* msc = (float*)(P.ws + WS_MSC) + ((size_t)bh * 33 + k) * 4; msc[0] = A; msc[1] = bc; }
    }
    __syncthreads();
    f32x4 Ct[2][9];
#pragma unroll
    for (int a = 0; a < 2; ++a)
#pragma unroll
        for (int c = 0; c < 9; ++c) Ct[a][c] = (f32x4){0.f, 0.f, 0.f, 0.f};
    bf16x8 kt[2][2];
#pragma unroll
    for (int a = 0; a < 2; ++a)
#pragma unroll
        for (int s2 = 0; s2 < 2; ++s2) {
            const int jt = 2 * w + a;
            kt[a][s2] = tr_pair(tr_frag(sK + (jt >> 2) * 8192, 32 * s2, jt & 3, g, lr), tr_frag(sK + (jt >> 2) * 8192, 32 * s2 + 16, jt & 3, g, lr));
        }
    f32x4 wg4[4];
#pragma unroll
    for (int j = 0; j < 4; ++j) wg4[j] = *(const f32x4*)(ga + 16 * j + 4 * g);
#define MA_TILE(c, lo0, hi0, lo1, hi1) { \
        { const f32x4 w0 = wg4[0], w1 = wg4[1]; uint4 o; \
          o.x = cvt_pk_bf16(bflo(lo0.x) * w0[0], bfhi(lo0.x) * w0[1]); o.y = cvt_pk_bf16(bflo(lo0.y) * w0[2], bfhi(lo0.y) * w0[3]); \
          o.z = cvt_pk_bf16(bflo(hi0.x) * w1[0], bfhi(hi0.x) * w1[1]); o.w = cvt_pk_bf16(bflo(hi0.y) * w1[2], bfhi(hi0.y) * w1[3]); \
          const bf16x8 vw = __builtin_bit_cast(bf16x8, o); \
          Ct[0][c] = __builtin_amdgcn_mfma_f32_16x16x32_bf16(kt[0][0], vw, Ct[0][c], 0, 0, 0); Ct[1][c] = __builtin_amdgcn_mfma_f32_16x16x32_bf16(kt[1][0], vw, Ct[1][c], 0, 0, 0); } \
        { const f32x4 w0 = wg4[2], w1 = wg4[3]; uint4 o; \
          o.x = cvt_pk_bf16(bflo(lo1.x) * w0[0], bfhi(lo1.x) * w0[1]); o.y = cvt_pk_bf16(bflo(lo1.y) * w0[2], bfhi(lo1.y) * w0[3]); \
          o.z = cvt_pk_bf16(bflo(hi1.x) * w1[0], bfhi(hi1.x) * w1[1]); o.w = cvt_pk_bf16(bflo(hi1.y) * w1[2], bfhi(hi1.y) * w1[3]); \
          const bf16x8 vw = __builtin_bit_cast(bf16x8, o); \
          Ct[0][c] = __builtin_amdgcn_mfma_f32_16x16x32_bf16(kt[0][1], vw, Ct[0][c], 0, 0, 0); Ct[1][c] = __builtin_amdgcn_mfma_f32_16x16x32_bf16(kt[1][1], vw, Ct[1][c], 0, 0, 0); } }
    {
        uint2 vr[4][4];
        tr_read_4c(sV, g, lr, vr);
        MA_TILE(0, vr[0][0], vr[0][1], vr[0][2], vr[0][3]) MA_TILE(1, vr[1][0], vr[1][1], vr[1][2], vr[1][3])
        MA_TILE(2, vr[2][0], vr[2][1], vr[2][2], vr[2][3]) MA_TILE(3, vr[3][0], vr[3][1], vr[3][2], vr[3][3])
        tr_read_4c(sV + 8192, g, lr, vr);
        MA_TILE(4, vr[0][0], vr[0][1], vr[0][2], vr[0][3]) MA_TILE(5, vr[1][0], vr[1][1], vr[1][2], vr[1][3])
        MA_TILE(6, vr[2][0], vr[2][1], vr[2][2], vr[2][3]) MA_TILE(7, vr[3][0], vr[3][1], vr[3][2], vr[3][3])
        const uint2 o0 = tr_frag(sV + 16384, 0, 0, g, lr), o1 = tr_frag(sV + 16384, 16, 0, g, lr), o2 = tr_frag(sV + 16384, 32, 0, g, lr), o3 = tr_frag(sV + 16384, 48, 0, g, lr);
        MA_TILE(8, o0, o1, o2, o3)
    }
#undef MA_TILE
    unsigned char* slot = P.ws + WS_MST + ((size_t)bh * 33 + k) * ST_IMG;
#pragma unroll
    for (int a = 0; a < 2; ++a)
#pragma unroll
        for (int c = 0; c < 9; ++c) {
            uint2 u; u.x = cvt_pk_bf16(Ct[a][c][0], Ct[a][c][1]); u.y = cvt_pk_bf16(Ct[a][c][2], Ct[a][c][3]);
            *(uint2*)(slot + st_piece_off(2 * w + a, c, g, lr)) = u;
        }
}

__device__ __forceinline__ void mlstm_B(const Params& P, int item) {
    const int tid = threadIdx.x;
    const int bh = item / 3, part = item - bh * 3;
    const unsigned char* base = P.ws + WS_MST + (size_t)bh * 33 * ST_IMG + part * 12288 + tid * 48;
    unsigned char* obase = P.ws + WS_CBI + (size_t)bh * 33 * ST_IMG + part * 12288 + tid * 48;
    float* msc = (float*)(P.ws + WS_MSC) + (size_t)bh * 33 * 4;
    float C[6][4];
#pragma unroll
    for (int i = 0; i < 6; ++i)
#pragma unroll
        for (int r = 0; r < 4; ++r) C[i][r] = 0.f;
    float m = 0.f;
    uint2 d0[6], d1[6];
    float2 ab0, ab1;
#pragma unroll
    for (int i = 0; i < 6; ++i) { d0[i] = *(const uint2*)(base + i * 8); d1[i] = *(const uint2*)(base + ST_IMG + i * 8); }
    ab0 = *(const float2*)(msc); ab1 = *(const float2*)(msc + 4);
    for (int k = 0; k < 33; ++k) {
        uint2 d2[6]; float2 ab2 = make_float2(0.f, 0.f);
        if (k + 2 < 33) {
#pragma unroll
            for (int i = 0; i < 6; ++i) d2[i] = *(const uint2*)(base + (size_t)(k + 2) * ST_IMG + i * 8);
            ab2 = *(const float2*)(msc + (k + 2) * 4);
        } else {
#pragma unroll
            for (int i = 0; i < 6; ++i) d2[i] = make_uint2(0, 0);
        }
#pragma unroll
        for (int i = 0; i < 6; ++i) {
            uint2 u; u.x = cvt_pk_bf16(C[i][0], C[i][1]); u.y = cvt_pk_bf16(C[i][2], C[i][3]);
            *(uint2*)(obase + (size_t)k * ST_IMG + i * 8) = u;
        }
        if (tid == 0 && part == 0) msc[k * 4 + 2] = m;
        const float M = fmaxf(m, ab0.x);
        const float decay = __expf(m - M), sc = __expf(ab0.x - M);
#pragma unroll
        for (int i = 0; i < 6; ++i) {
            C[i][0] = decay * C[i][0] + sc * bflo(d0[i].x); C[i][1] = decay * C[i][1] + sc * bfhi(d0[i].x);
            C[i][2] = decay * C[i][2] + sc * bflo(d0[i].y); C[i][3] = decay * C[i][3] + sc * bfhi(d0[i].y);
        }
        m = ab0.y + M;
#pragma unroll
        for (int i = 0; i < 6; ++i) { d0[i] = d1[i]; d1[i] = d2[i]; }
        ab0 = ab1; ab1 = ab2;
    }
}

__device__ __forceinline__ void mlstm_C(const Params& P, int item, unsigned char* smem) {
    const int tid = threadIdx.x, lane = tid & 63, w = tid >> 6, g = lane >> 4, lr = lane & 15;
    const int wu = __builtin_amdgcn_readfirstlane(w);
    const int k = item >> 5, bh = item & 31, b = bh >> 2, h = bh & 3;
    const bf16_t* z = (const bf16_t*)(P.ws + WS_Z);
    const bf16_t* qk = (const bf16_t*)(P.ws + WS_RA);
    const float* gates = (const float*)(P.ws + WS_GATES);
    bf16_t* y = (bf16_t*)(P.ws + WS_Z);
    const unsigned char* sK = smem; const unsigned char* sV = smem + 36864; unsigned char* sCb = smem;
    float* ga = (float*)(smem + 61440);
    const int pos = 64 * k + 16 * w + lr;
    const bool tvalid = pos < L;
    const size_t rrow = (size_t)(b * L + (tvalid ? pos : 0));
    const unsigned char* cslot = P.ws + WS_CBI + ((size_t)bh * 33 + k) * ST_IMG + tid * 16;
    const uint4 cb0 = *(const uint4*)(cslot), cb1 = *(const uint4*)(cslot + 4096), cb2 = *(const uint4*)(cslot + 8192), cb3 = *(const uint4*)(cslot + 12288), cb4 = *(const uint4*)(cslot + 16384),
                cb5 = *(const uint4*)(cslot + 20480), cb6 = *(const uint4*)(cslot + 24576), cb7 = *(const uint4*)(cslot + 28672), cb8 = *(const uint4*)(cslot + 32768);
    bf16x8 qf[4];
    {
        const bf16_t* qp = qk + rrow * 1024 + h * 128 + 8 * g;
#pragma unroll
        for (int ks = 0; ks < 4; ++ks) { qf[ks] = *(const bf16x8*)(qp + 32 * ks); if (!tvalid) qf[ks] = (bf16x8){0, 0, 0, 0, 0, 0, 0, 0}; }
    }
    mlstm_stage_kv(P, b, h, k, smem, smem + 36864, tid);
    if (wu == 0) {
        const float m_prev = ((const float*)(P.ws + WS_MSC))[((size_t)bh * 33 + k) * 4 + 2];
        const int p2 = 64 * k + lane;
        float lf = 0.f, li = -INFINITY;
        if (p2 < L) { lf = gates[(size_t)(b * L + p2) * 16 + 4 + h]; li = gates[(size_t)(b * L + p2) * 16 + h]; }
        float bc = lf;
#pragma unroll
        for (int o = 1; o < 64; o <<= 1) { const float n = __shfl_up(bc, o, 64); if (lane >= o) bc += n; }
        const float a = li - bc;
        float am = a;
#pragma unroll
        for (int o = 1; o < 64; o <<= 1) { const float n = __shfl_up(am, o, 64); if (lane >= o) am = fmaxf(am, n); }
        const float M = fmaxf(m_prev, am);
        ga[lane] = a; ga[64 + lane] = __expf(m_prev - M); ga[128 + lane] = __expf(-(bc + M)); ga[192 + lane] = M;
    }
    __syncthreads();
    const float Mt = ga[192 + 16 * w + lr], Wi = ga[64 + 16 * w + lr], Et = ga[128 + 16 * w + lr];
    bf16x8 pf[2];
    {
        f32x4 sa[4];
#pragma unroll
        for (int c = 0; c < 4; ++c) {
            sa[c] = (f32x4){0.f, 0.f, 0.f, 0.f};
            if (c <= wu) {
#pragma unroll
                for (int ks = 0; ks < 4; ++ks) {
                    const bf16x8 kf = *(const bf16x8*)(sK + (ks >> 1) * 8192 + vimg_off(16 * c + lr, 4 * (ks & 1) + g));
                    sa[c] = __builtin_amdgcn_mfma_f32_16x16x32_bf16(kf, qf[ks], sa[c], 0, 0, 0);
                }
                const f32x4 av = *(const f32x4*)(ga + 16 * c + 4 * g);
#pragma unroll
                for (int r = 0; r < 4; ++r) {
                    const float d = __expf(av[r] - Mt);
                    sa[c][r] = (16 * c + 4 * g + r <= 16 * w + lr) ? sa[c][r] * d : 0.f;
                }
            }
        }
#pragma unroll
        for (int s2 = 0; s2 < 2; ++s2) {
            uint4 u;
            u.x = cvt_pk_bf16(sa[2 * s2][0], sa[2 * s2][1]); u.y = cvt_pk_bf16(sa[2 * s2][2], sa[2 * s2][3]);
            u.z = cvt_pk_bf16(sa[2 * s2 + 1][0], sa[2 * s2 + 1][1]); u.w = cvt_pk_bf16(sa[2 * s2 + 1][2], sa[2 * s2 + 1][3]);
            pf[s2] = __builtin_bit_cast(bf16x8, u);
        }
    }
    __syncthreads();
    {
        unsigned char* d = sCb + tid * 16;
        *(uint4*)(d) = cb0; *(uint4*)(d + 4096) = cb1; *(uint4*)(d + 8192) = cb2; *(uint4*)(d + 12288) = cb3; *(uint4*)(d + 16384) = cb4;
        *(uint4*)(d + 20480) = cb5; *(uint4*)(d + 24576) = cb6; *(uint4*)(d + 28672) = cb7; *(uint4*)(d + 32768) = cb8;
    }
    __syncthreads();
    f32x4 na[9];
#define MC_TILE(c, lo0, hi0, lo1, hi1) { \
        na[c] = (f32x4){0.f, 0.f, 0.f, 0.f}; \
        _Pragma("unroll") for (int ks = 0; ks < 4; ++ks) { \
            const bf16x8 cf = *(const bf16x8*)(sCb + (ks >> 1) * 18432 + vimg_off(16 * (c) + lr, 4 * (ks & 1) + g)); \
            na[c] = __builtin_amdgcn_mfma_f32_16x16x32_bf16(cf, qf[ks], na[c], 0, 0, 0); } \
        na[c] *= Wi; \
        na[c] = __builtin_amdgcn_mfma_f32_16x16x32_bf16(tr_pair(lo0, hi0), pf[0], na[c], 0, 0, 0); \
        na[c] = __builtin_amdgcn_mfma_f32_16x16x32_bf16(tr_pair(lo1, hi1), pf[1], na[c], 0, 0, 0); }
    {
        uint2 vr[4][4];
        tr_read_4c(sV, g, lr, vr);
        MC_TILE(0, vr[0][0], vr[0][1], vr[0][2], vr[0][3]) MC_TILE(1, vr[1][0], vr[1][1], vr[1][2], vr[1][3])
        MC_TILE(2, vr[2][0], vr[2][1], vr[2][2], vr[2][3]) MC_TILE(3, vr[3][0], vr[3][1], vr[3][2], vr[3][3])
        tr_read_4c(sV + 8192, g, lr, vr);
        MC_TILE(4, vr[0][0], vr[0][1], vr[0][2], vr[0][3]) MC_TILE(5, vr[1][0], vr[1][1], vr[1][2], vr[1][3])
        MC_TILE(6, vr[2][0], vr[2][1], vr[2][2], vr[2][3]) MC_TILE(7, vr[3][0], vr[3][1], vr[3][2], vr[3][3])
        const uint2 o0 = tr_frag(sV + 16384, 0, 0, g, lr), o1 = tr_frag(sV + 16384, 16, 0, g, lr), o2 = tr_frag(sV + 16384, 32, 0, g, lr), o3 = tr_frag(sV + 16384, 48, 0, g, lr);
        MC_TILE(8, o0, o1, o2, o3)
    }
#undef MC_TILE
    const float den = __shfl(na[8][0], lr, 64);
    const float rden = 1.0f / fmaxf(fabsf(den), Et);
    float hs = 0.f;
#pragma unroll
    for (int c = 0; c < 8; ++c) { na[c] *= rden; hs += na[c][0] * na[c][0] + na[c][1] * na[c][1] + na[c][2] * na[c][2] + na[c][3] * na[c][3]; }
    hs += __shfl_xor(hs, 16, 64); hs += __shfl_xor(hs, 32, 64);
    const float rstd = rsqrtf(hs * (1.0f / 128.0f) + EPS);
    const float* gainp = P.m_out_norm + h * 128 + 4 * g;
#pragma unroll
    for (int c = 0; c < 8; ++c) {
        const uint2 og = *(const uint2*)(z + rrow * NZ + ZC_MO + h * 128 + 16 * c + 4 * g);
        const float o0 = bflo(og.x), o1 = bfhi(og.x), o2 = bflo(og.y), o3 = bfhi(og.y);
        const float4 gn = *(const float4*)(gainp + 16 * c);
        uint2 u;
        u.x = pk2(na[c][0] * rstd * gn.x / (1.f + __expf(-o0)), na[c][1] * rstd * gn.y / (1.f + __expf(-o1)));
        u.y = pk2(na[c][2] * rstd * gn.z / (1.f + __expf(-o2)), na[c][3] * rstd * gn.w / (1.f + __expf(-o3)));
        if (tvalid) *(uint2*)(y + rrow * NZ + h * 128 + 16 * c + 4 * g) = u;
    }
}

__device__ __forceinline__ void peer_token(const Params& P, int t, int lane, int* sidx, float* sval, int* sid, float* sgate, const unsigned char* slut, const unsigned* szero) {
    const unsigned* tk = (const unsigned*)(P.ws + WS_TK) + (size_t)t * 256;
#pragma unroll
    for (int i = 0; i < 4; ++i) {
        const unsigned k = tk[lane * 4 + i];
        sidx[lane * 4 + i] = 127 - (int)(k & 127u);
        sval[lane * 4 + i] = unord_key(k & ~127u);
    }
    __builtin_amdgcn_s_waitcnt(0xc07f);
    __builtin_amdgcn_wave_barrier();
    {
        const int hd = lane >> 3, sub = lane & 7;
        unsigned x[8];
#pragma unroll
        for (int r = 0; r < 8; ++r) {
            const int c = sub * 8 + r;
            const unsigned ij = slut[c < 50 ? c : 0];
            const int i = ij >> 4, j = ij & 15;
            const unsigned kx = (ord_key(sval[(2 * hd) * 16 + i] + sval[(2 * hd + 1) * 16 + j]) & ~255u) | (unsigned)(255 - (i * 16 + j));
            x[r] = c < 50 ? kx : 0u;
        }
#pragma unroll
        for (int k = 2; k <= 64; k <<= 1) {
#pragma unroll
            for (int j = k >> 1; j >= 1; j >>= 1) {
                if (j >= 8) {
                    const int ld = j >> 3;
                    const bool lower = (sub & ld) == 0;
                    const bool desc = k >= 64 ? true : ((sub * 8) & k) == 0;
                    const bool takemax = (lower == desc);
#pragma unroll
                    for (int r = 0; r < 8; ++r) {
                        const unsigned o = (unsigned)__shfl_xor((int)x[r], ld, 64);
                        const unsigned hi = max(x[r], o), lo = min(x[r], o);
                        x[r] = takemax ? hi : lo;
                    }
                } else {
#pragma unroll
                    for (int r = 0; r < 8; ++r) {
                        if ((r & j) == 0) {
                            const int p = r | j;
                            const unsigned hi = max(x[r], x[p]), lo = min(x[r], x[p]);
                            if (k <= 4) { const bool desc = (r & k) == 0; x[r] = desc ? hi : lo; x[p] = desc ? lo : hi; }
                            else if (k >= 64) { x[r] = hi; x[p] = lo; }
                            else { const bool desc = ((sub * 8) & k) == 0; x[r] = desc ? hi : lo; x[p] = desc ? lo : hi; }
                        }
                    }
                }
            }
        }
        const float smax = unord_key((unsigned)__shfl((int)x[0], hd * 8, 64) & ~255u);
        float e[8]; float den = 0.f;
#pragma unroll
        for (int r = 0; r < 8; ++r) { e[r] = __expf(unord_key(x[r] & ~255u) - smax); den += e[r]; }
        den += __shfl_xor(den, 1, 64);
        const float inv = 1.f / den;
        if (sub < 2) {
#pragma unroll
            for (int r = 0; r < 8; ++r) {
                const int pos = 255 - (int)(x[r] & 255u), i = pos >> 4, j = pos & 15;
                sid[hd * 16 + sub * 8 + r] = sidx[(2 * hd) * 16 + i] * 128 + sidx[(2 * hd + 1) * 16 + j];
                sgate[hd * 16 + sub * 8 + r] = e[r] * inv;
            }
        }
    }
    __builtin_amdgcn_s_waitcnt(0xc07f);
    __builtin_amdgcn_wave_barrier();
    const bf16_t* xn = (const bf16_t*)(P.ws + WS_XN) + (size_t)t * DM;
    const float rstd = ((const float*)(P.ws + WS_RSTD))[t];
    const unsigned char* V = P.ws + WS_V + lane * 8;
    const float* usc = (const float*)(P.ws + WS_USC);
    const float* vsc = (const float*)(P.ws + WS_VSC);
    const int g = lane >> 4, lr = lane & 15;
    unsigned char* shi = (unsigned char*)sval;
    unsigned char* slo = (unsigned char*)sidx;
    {
        const uint4 xa = *(const uint4*)(xn + lane * 16), xb = *(const uint4*)(xn + lane * 16 + 8);
        const unsigned xw[8] = {xa.x, xa.y, xa.z, xa.w, xb.x, xb.y, xb.z, xb.w};
        unsigned hi[4], lo[4];
#pragma unroll
        for (int i = 0; i < 4; ++i) {
            const float x0 = bflo(xw[2 * i]), x1 = bfhi(xw[2 * i]), x2 = bflo(xw[2 * i + 1]), x3 = bfhi(xw[2 * i + 1]);
            int wd = 0;
            wd = __builtin_amdgcn_cvt_pk_fp8_f32(x0, x1, wd, false);
            wd = __builtin_amdgcn_cvt_pk_fp8_f32(x2, x3, wd, true);
            const f32x2 h01 = __builtin_amdgcn_cvt_pk_f32_fp8(wd, false), h23 = __builtin_amdgcn_cvt_pk_f32_fp8(wd, true);
            int wl = 0;
            wl = __builtin_amdgcn_cvt_pk_fp8_f32(x0 - h01.x, x1 - h01.y, wl, false);
            wl = __builtin_amdgcn_cvt_pk_fp8_f32(x2 - h23.x, x3 - h23.y, wl, true);
            hi[i] = (unsigned)wd; lo[i] = (unsigned)wl;
        }
        *(uint4*)(shi + lane * 16) = make_uint4(hi[0], hi[1], hi[2], hi[3]);
        *(uint4*)(slo + lane * 16) = make_uint4(lo[0], lo[1], lo[2], lo[3]);
    }
    __builtin_amdgcn_s_waitcnt(0xc07f);
    __builtin_amdgcn_wave_barrier();
    {
        typedef int v8i __attribute__((ext_vector_type(8)));
        const unsigned char* Ub = P.ws + WS_U + 16 * g;
        const unsigned char* bsrc = (lr == 0) ? (shi + 16 * g) : (lr == 1) ? (slo + 16 * g) : (const unsigned char*)szero;
        const int bstep = (lr < 2) ? 128 : 0, bhalf = (lr < 2) ? 64 : 16;
        v8i Bv[8];
#pragma unroll
        for (int st = 0; st < 8; ++st) {
            const uint4 b0 = *(const uint4*)(bsrc + bstep * st), b1 = *(const uint4*)(bsrc + bstep * st + bhalf);
            Bv[st] = (v8i){(int)b0.x, (int)b0.y, (int)b0.z, (int)b0.w, (int)b1.x, (int)b1.y, (int)b1.z, (int)b1.w};
        }
        unsigned off[8];
#pragma unroll
        for (int T = 0; T < 8; ++T) off[T] = (unsigned)sid[16 * T + lr] * 512u;
        __builtin_amdgcn_s_waitcnt(0xc07f);
        __builtin_amdgcn_wave_barrier();
        float* sact = (float*)sidx + ((lr == 1) ? 128 : 0);
        uint4 abuf[2][8];
#pragma unroll
        for (int st = 0; st < 8; ++st) abuf[0][st] = *(const uint4*)(Ub + off[0] + 64 * st);
#pragma unroll
        for (int T = 0; T < 8; ++T) {
            if (T + 1 < 8) {
#pragma unroll
                for (int st = 0; st < 8; ++st) abuf[(T + 1) & 1][st] = *(const uint4*)(Ub + off[T + 1] + 64 * st);
            }
            f32x4 au = (f32x4){0.f, 0.f, 0.f, 0.f};
#pragma unroll
            for (int st = 0; st < 8; ++st) {
                const uint4 a4 = abuf[T & 1][st];
                const v8i Av = {(int)a4.x, (int)a4.y, (int)a4.z, (int)a4.w, 0, 0, 0, 0};
                au = __builtin_amdgcn_mfma_scale_f32_16x16x128_f8f6f4(Av, Bv[st], au, 4, 0, 0, 0x7f7f7f7f, 0, 0x7f7f7f7f);
            }
            if (lr < 2) *(f32x4*)(sact + 16 * T + 4 * g) = au;
        }
    }
    __builtin_amdgcn_s_waitcnt(0xc07f);
    __builtin_amdgcn_wave_barrier();
    {
        float* sw = (float*)sidx;
        float wv[2];
#pragma unroll
        for (int hh = 0; hh < 2; ++hh) {
            const int e = lane + 64 * hh, id = sid[e];
            const float a = (sw[e] + sw[128 + e]) * usc[id] * rstd;
            wv[hh] = sgate[e] * vsc[id] * 0.5f * a * (1.f + erff(a * 0.70710678118654752f));
        }
        sw[lane] = wv[0]; sw[lane + 64] = wv[1];
    }
    __builtin_amdgcn_s_waitcnt(0xc07f);
    __builtin_amdgcn_wave_barrier();
    f32x2 acc[8];
#pragma unroll
    for (int j = 0; j < 8; ++j) acc[j] = (f32x2){0.f, 0.f};
#pragma unroll 1
    for (int e0 = 0; e0 < 128; e0 += 16) {
        uint2 vr[16];
#pragma unroll
        for (int q = 0; q < 16; ++q) vr[q] = *(const uint2*)(V + (size_t)sid[e0 + q] * 512);
        const float* sw = (const float*)sidx + e0;
        const f32x4 w0 = *(const f32x4*)(sw), w1 = *(const f32x4*)(sw + 4), w2 = *(const f32x4*)(sw + 8), w3 = *(const f32x4*)(sw + 12);
        const float wq[16] = {w0[0], w0[1], w0[2], w0[3], w1[0], w1[1], w1[2], w1[3], w2[0], w2[1], w2[2], w2[3], w3[0], w3[1], w3[2], w3[3]};
#pragma unroll
        for (int q = 0; q < 16; ++q) {
            const float w = wq[q];
#define FP4_AXPY(k) { acc[k] += w * __builtin_amdgcn_cvt_scalef32_pk_f32_fp4(vr[q].x, 1.0f, k); acc[4 + k] += w * __builtin_amdgcn_cvt_scalef32_pk_f32_fp4(vr[q].y, 1.0f, k); }
            FP4_AXPY(0) FP4_AXPY(1) FP4_AXPY(2) FP4_AXPY(3)
#undef FP4_AXPY
        }
    }
    f32x2 xf[8];
    {
        const uint4 xa = *(const uint4*)(xn + lane * 16), xb = *(const uint4*)(xn + lane * 16 + 8);
        xf[0] = (f32x2){bflo(xa.x), bfhi(xa.x)}; xf[1] = (f32x2){bflo(xa.y), bfhi(xa.y)}; xf[2] = (f32x2){bflo(xa.z), bfhi(xa.z)}; xf[3] = (f32x2){bflo(xa.w), bfhi(xa.w)};
        xf[4] = (f32x2){bflo(xb.x), bfhi(xb.x)}; xf[5] = (f32x2){bflo(xb.y), bfhi(xb.y)}; xf[6] = (f32x2){bflo(xb.z), bfhi(xb.z)}; xf[7] = (f32x2){bflo(xb.w), bfhi(xb.w)};
    }
    float* o = P.out + (size_t)t * DM + lane * 16;
    float4 h0, h1, h2, h3;
    {
        const float4 g0 = *(const float4*)(P.norm_ffn + lane * 16), g1 = *(const float4*)(P.norm_ffn + lane * 16 + 4), g2 = *(const float4*)(P.norm_ffn + lane * 16 + 8), g3 = *(const float4*)(P.norm_ffn + lane * 16 + 12);
        h0.x = xf[0].x / g0.x + acc[0].x; h0.y = xf[0].y / g0.y + acc[0].y; h0.z = xf[1].x / g0.z + acc[1].x; h0.w = xf[1].y / g0.w + acc[1].y;
        h1.x = xf[2].x / g1.x + acc[2].x; h1.y = xf[2].y / g1.y + acc[2].y; h1.z = xf[3].x / g1.z + acc[3].x; h1.w = xf[3].y / g1.w + acc[3].y;
        h2.x = xf[4].x / g2.x + acc[4].x; h2.y = xf[4].y / g2.y + acc[4].y; h2.z = xf[5].x / g2.z + acc[5].x; h2.w = xf[5].y / g2.w + acc[5].y;
        h3.x = xf[6].x / g3.x + acc[6].x; h3.y = xf[6].y / g3.y + acc[6].y; h3.z = xf[7].x / g3.z + acc[7].x; h3.w = xf[7].y / g3.w + acc[7].y;
    }
    *(float4*)(o) = h0; *(float4*)(o + 4) = h1; *(float4*)(o + 8) = h2; *(float4*)(o + 12) = h3;
    __builtin_amdgcn_s_waitcnt(0xc07f);
    __builtin_amdgcn_wave_barrier();
}

#define LAS __attribute__((address_space(3)))
#define XB_TMO      128
#define XB_XCNT(j)  (256  + 64 * (j))
#define XB_XSUB(j)  (1280 + 64 * (j))
#define XB_XGEN(j)  (2304 + 64 * (j))
#define XB_TOP      3328
#define XB_TOPGEN   3392
#define XCD_BAR_WORDS 3456
#define XB_SPIN_CAP (1u << 18)
__device__ __forceinline__ unsigned xb_ld(unsigned* p)              { return __hip_atomic_load(p, __ATOMIC_RELAXED, __HIP_MEMORY_SCOPE_AGENT); }
__device__ __forceinline__ unsigned xb_add(unsigned* p, unsigned v) { return __hip_atomic_fetch_add(p, v, __ATOMIC_RELAXED, __HIP_MEMORY_SCOPE_AGENT); }
__device__ __forceinline__ unsigned xb_xcc_id() { return (unsigned)__builtin_amdgcn_s_getreg((3 << 11) | 20) & 0xFu; }
#define XB_SPIN(cond, bar) do { unsigned _sp = 0; while (cond) { __builtin_amdgcn_s_sleep(1); \
    if ((++_sp & 255u) == 0u) { if (xb_ld(&(bar)[XB_TMO])) break; if (_sp > XB_SPIN_CAP) { atomicAdd(&(bar)[XB_TMO], 1u); break; } } } } while (0)
struct XcdBarrier { unsigned* bar; unsigned x; volatile LAS unsigned* st; };
__device__ __forceinline__ XcdBarrier xcd_barrier_post(unsigned* bar, volatile LAS unsigned* st) {
    XcdBarrier b; b.bar = bar; b.x = xb_xcc_id(); b.st = st;
    if (threadIdx.x == 0) (void)xb_add(&bar[XB_XCNT(b.x)], 1u);
    return b;
}
__device__ __forceinline__ void xcd_barrier_complete(unsigned* bar, unsigned x, unsigned& nloc, unsigned& nx) {
    const unsigned G = gridDim.x * gridDim.y * gridDim.z;
    unsigned sum, cnt, mine, sp = 0u;
    for (;;) {
        sum = 0u; cnt = 0u; mine = 0u;
#pragma unroll
        for (unsigned j = 0; j < 16; ++j) { const unsigned c = xb_ld(&bar[XB_XCNT(j)]); sum += c; cnt += (c > 0u) ? 1u : 0u; mine = (j == x) ? c : mine; }
        if (sum == G) break;
        __builtin_amdgcn_s_sleep(1);
        if ((++sp & 255u) == 0u) { if (xb_ld(&bar[XB_TMO])) break; if (sp > XB_SPIN_CAP) { atomicAdd(&bar[XB_TMO], 1u); break; } }
    }
    nloc = mine > 0u ? mine : 1u; nx = cnt > 0u ? cnt : 1u;
}
__device__ __forceinline__ void xcd_barrier(const XcdBarrier& b) {
    asm volatile("s_waitcnt vmcnt(0)" ::: "memory");
    __syncthreads();
    if (threadIdx.x == 0) {
        unsigned* bar = b.bar;
        __builtin_amdgcn_s_waitcnt(0);
        unsigned nloc = b.st[0], nx = b.st[1];
        if (nloc == 0u) { xcd_barrier_complete(bar, b.x, nloc, nx); b.st[0] = nloc; b.st[1] = nx; }
        const unsigned old = xb_add(&bar[XB_XSUB(b.x)], 1u);
        const unsigned gen = old / nloc;
        if (old + 1u == (gen + 1u) * nloc) {
            __builtin_amdgcn_fence(__ATOMIC_RELEASE, "agent");
            asm volatile("s_waitcnt vmcnt(0)" ::: "memory");
            const unsigned og = xb_add(&bar[XB_TOP], 1u);
            const unsigned tg = og / nx;
            if (og + 1u == (tg + 1u) * nx) xb_add(&bar[XB_TOPGEN], 1u);
            else XB_SPIN(xb_ld(&bar[XB_TOPGEN]) == tg, bar);
            __builtin_amdgcn_fence(__ATOMIC_ACQUIRE, "agent");
            xb_add(&bar[XB_XGEN(b.x)], 1u);
            asm volatile("s_waitcnt vmcnt(0)" ::: "memory");
        } else {
            XB_SPIN(xb_ld(&bar[XB_XGEN(b.x)]) == gen, bar);
            __builtin_amdgcn_fence(__ATOMIC_ACQUIRE, "agent");
            asm volatile("s_waitcnt vmcnt(0)" ::: "memory");
        }
    }
    __syncthreads();
}

__device__ __forceinline__ void hand_release() { asm volatile("s_waitcnt vmcnt(0)" ::: "memory"); __builtin_amdgcn_fence(__ATOMIC_RELEASE, "agent"); asm volatile("s_waitcnt vmcnt(0)" ::: "memory"); }
__device__ __forceinline__ void hand_acquire() { __builtin_amdgcn_fence(__ATOMIC_ACQUIRE, "agent"); asm volatile("s_waitcnt vmcnt(0)" ::: "memory"); }

__global__ void __launch_bounds__(256, 2) mega(Params P) {
    extern __shared__ __attribute__((aligned(16))) unsigned char smem[];
    const int tid = threadIdx.x, lane = tid & 63, wave = tid >> 6;
    const int G = gridDim.x, bid = blockIdx.x;
    unsigned* ctl = (unsigned*)(P.ws + WS_CTL);
    volatile LAS unsigned* bst = (volatile LAS unsigned*)(smem + 65552);
    if (tid == 0) { bst[0] = 0u; bst[1] = 0u; }
    __syncthreads();
    const XcdBarrier xb = xcd_barrier_post(ctl + 1024, bst);
    phase0(P, smem);
    xcd_barrier(xb);
    {
        const int gw = bid * 4 + wave;
        if (gw < 64) fox_cum_wave(P, gw, lane);
        for (int tile = bid; tile < 129 * 28; tile += G) gemm_tile<1>(P, tile / 28, tile % 28, smem);
        {
            const int rem = (129 * 28) % G;
            if (rem > 0 && rem < G) { if (bid >= rem) convert_uv_rows(P, (bid - rem) * 4 + wave, (G - rem) * 4, lane); }
            else convert_uv_rows(P, bid * 4 + wave, G * 4, lane);
        }
    }
    xcd_barrier(xb);
    {
        volatile int* s_item = (volatile int*)(smem + 65536);
        const int wave_u = __builtin_amdgcn_readfirstlane(wave);
        auto fetch = [&](unsigned* counter) -> int {
            if (wave_u == 0) {
                unsigned v = atomicAdd(counter, lane == 0 ? 1u : 0u);
                *s_item = (int)__builtin_amdgcn_readfirstlane(v);
            }
            __syncthreads();
            const int item = __builtin_amdgcn_readfirstlane(*s_item);
            __syncthreads();
            return item;
        };
        for (;;) {
            const int item = fetch(&ctl[2]);
            if (item >= 33 * 32) break;
            mlstm_A(P, item, smem);
        }
        xcd_barrier(xb);
        for (;;) {
            const int item = fetch(&ctl[4]);
            if (item >= 96) break;
            mlstm_B(P, item);
        }
        for (;;) {
            const int item = fetch(&ctl[3]);
            if (item >= 64 * 17) break;
            attn_block(P, item & 63, 16 - (item >> 6), smem);
        }
        xcd_barrier(xb);
        for (;;) {
            const int item = fetch(&ctl[5]);
            if (item >= 33 * 32) break;
            mlstm_C(P, item, smem);
        }
    }
    xcd_barrier(xb);
    for (int tile = bid; tile < 128 * 8; tile += G) gemm_tile<2>(P, tile >> 3, tile & 7, smem);
    xcd_barrier(xb);
    for (int tile = bid; tile < 128 * 16; tile += G) gemm_tile<3>(P, tile >> 4, tile & 15, smem);
    xcd_barrier(xb);
    {
        unsigned char* slut = smem + 12288;
        if (tid < 64) {
            int c = tid, i = 0;
            while (i < 16 && c >= 16 / (i + 1)) { c -= 16 / (i + 1); ++i; }
            slut[tid] = (unsigned char)(i < 16 ? ((i << 4) | c) : 0);
        }
        unsigned* szero = (unsigned*)(smem + 12288 + 64);
        if (tid < 16) szero[tid] = 0u;
        __syncthreads();
        int* sidx = (int*)(smem + wave * 3072); float* sval = (float*)(smem + wave * 3072 + 1024);
        int* sid = (int*)(smem + wave * 3072 + 2048); float* sgate = (float*)(smem + wave * 3072 + 2560);
        for (int t = bid * 4 + wave; t < T2; t += G * 4) peer_token(P, t, lane, sidx, sval, sid, sgate, slut, szero);
    }
}

}

extern "C" void kernel_launch(void* const* d_in, const int* in_sizes, int n_in, void* d_out, int out_size, void* d_ws, size_t ws_size, hipStream_t stream) {
    if (n_in != 17 || ws_size < WS_END) { fprintf(stderr, "kernel_launch: unexpected n_in %d or ws_size %zu (need %zu)\n", n_in, ws_size, (size_t)WS_END); return; }
    constexpr int LDS_BYTES = 66560;
    static int grid_blocks = 0;
    if (!grid_blocks) {
        int dev = 0, cus = 0, per_cu = 0;
        (void)hipGetDevice(&dev);
        (void)hipDeviceGetAttribute(&cus, hipDeviceAttributeMultiprocessorCount, dev);
        (void)hipFuncSetAttribute((const void*)mega, hipFuncAttributeMaxDynamicSharedMemorySize, LDS_BYTES);
        (void)hipOccupancyMaxActiveBlocksPerMultiprocessor(&per_cu, (const void*)mega, 256, LDS_BYTES);
        if (per_cu < 1) per_cu = 1;
        if (per_cu > 2) per_cu = 2;
        grid_blocks = cus * per_cu;
        fprintf(stderr, "kernel_launch: cus %d per_cu %d grid %d\n", cus, per_cu, grid_blocks);
    }
    Params P{};
    P.x = (const float*)d_in[0]; P.meta = (const float*)d_in[1]; P.norm_mix = (const float*)d_in[2]; P.w_in = (const float*)d_in[3];
    P.conv_qk = (const float*)d_in[4]; P.b_igate = (const float*)d_in[5]; P.b_fgate_m = (const float*)d_in[6]; P.m_out_norm = (const float*)d_in[7];
    P.b_fgate_f = (const float*)d_in[8]; P.f_q_norm = (const float*)d_in[9]; P.f_k_norm = (const float*)d_in[10]; P.w_out = (const float*)d_in[11];
    P.norm_ffn = (const float*)d_in[12]; P.peer_query = (const float*)d_in[13]; P.peer_keys = (const float*)d_in[14]; P.peer_u = (const float*)d_in[15];
    P.peer_v = (const float*)d_in[16]; P.out = (float*)d_out; P.ws = (unsigned char*)d_ws;
    (void)hipMemsetAsync((unsigned char*)d_ws + WS_CTL, 0, 32768, stream);
    void* args[] = {&P};
    hipError_t e = hipLaunchCooperativeKernel((const void*)mega, dim3(grid_blocks), dim3(256), args, LDS_BYTES, stream);
    if (e != hipSuccess) fprintf(stderr, "cooperative launch failed: %s (grid %d)\n", hipGetErrorString(e), grid_blocks);
}
```

```cpp
#include <hip/hip_runtime.h>
#include <stdint.h>
#include <stdio.h>
#include <hip/hip_cooperative_groups.h>
namespace cg = cooperative_groups;

namespace {

constexpr int NB = 8, SEQ = 2048, DM = 1024, NMETA = 16, L = SEQ + NMETA;
constexpr int T1 = NB * L;
constexpr int T2 = NB * SEQ;
constexpr int NZ = 3584;
constexpr int ZC_MQ = 0, ZC_MK = 512, ZC_MV = 1024, ZC_MO = 1536, ZC_FQ = 2048, ZC_FK = 2560, ZC_FV = 3072;
constexpr int PROJ = 3600;
constexpr float EPS = 1e-6f;

constexpr size_t WS_CTL = 0;
constexpr size_t WS_RA = 65536;
constexpr size_t WS_Z = WS_RA + (size_t)T1 * DM * 2;
constexpr size_t WS_GATES = WS_Z + (size_t)T1 * NZ * 2;
constexpr size_t WS_CUM = WS_GATES + (size_t)T1 * 16 * 4;
constexpr size_t WS_SSQ = WS_CUM + (size_t)NB * 8 * L * 4;
constexpr size_t WS_RSTD = WS_SSQ + (size_t)T2 * 16 * 4;
constexpr size_t WS_SSQM = WS_RSTD + (size_t)T2 * 4;
constexpr size_t WS_BT2 = WS_SSQM + (size_t)T1 * 16 * 4;
constexpr size_t WS_BT3 = WS_BT2 + (size_t)DM * DM * 2;
constexpr size_t WS_KEYS = WS_BT3 + (size_t)2048 * DM * 2;
constexpr size_t WS_MSC = WS_KEYS + (size_t)16 * 128 * 128 * 2;
constexpr size_t WS_MST = WS_MSC + (size_t)128 * 33 * 16;
constexpr size_t WS_BT1 = WS_MST + (size_t)32 * 33 * 36864;
constexpr size_t WS_CBI = WS_BT1;
constexpr size_t WS_UV = WS_CBI + (size_t)32 * 33 * 36864;
constexpr size_t WS_END = WS_UV + (size_t)2 * 16384 * 512 + (size_t)2 * 16384 * 4;
constexpr size_t WS_XN = WS_RA;
constexpr size_t WS_U = WS_UV;
constexpr size_t WS_V = WS_U + (size_t)16384 * 512;
constexpr size_t WS_USC = WS_V + (size_t)16384 * 512;
constexpr size_t WS_VSC = WS_USC + (size_t)16384 * 4;
constexpr size_t WS_TK = WS_CBI;
constexpr float LOG2E = 1.4426950408889634f;

typedef unsigned short bf16_t;
typedef short bf16x8 __attribute__((ext_vector_type(8)));
typedef float f32x4 __attribute__((ext_vector_type(4)));
typedef __attribute__((ext_vector_type(2))) __bf16 bf16x2_t;

struct Params {
    const float* x; const float* meta; const float* norm_mix; const float* w_in; const float* conv_qk;
    const float* b_igate; const float* b_fgate_m; const float* m_out_norm; const float* b_fgate_f;
    const float* f_q_norm; const float* f_k_norm; const float* w_out; const float* norm_ffn;
    const float* peer_query; const float* peer_keys; const float* peer_u; const float* peer_v;
    float* out; unsigned char* ws;
};

__device__ __forceinline__ unsigned f2bf(float f) { unsigned u = __float_as_uint(f); return (u + 0x7fffu + ((u >> 16) & 1u)) >> 16; }
__device__ __forceinline__ float bf2f(unsigned h) { return __uint_as_float(h << 16); }
typedef float f32x2 __attribute__((ext_vector_type(2)));
typedef __bf16 bf16x2v __attribute__((ext_vector_type(2)));
__device__ __forceinline__ unsigned cvt_pk_bf16(float lo, float hi) { f32x2 v = {lo, hi}; bf16x2v b = __builtin_convertvector(v, bf16x2v); return __builtin_bit_cast(unsigned, b); }
__device__ __forceinline__ unsigned pk2(float lo, float hi) { return cvt_pk_bf16(lo, hi); }
__device__ __forceinline__ float bflo(unsigned w) { return __uint_as_float(w << 16); }
__device__ __forceinline__ float bfhi(unsigned w) { return __uint_as_float(w & 0xffff0000u); }
__device__ __forceinline__ float wave_sum(float v) {
#pragma unroll
    for (int o = 32; o > 0; o >>= 1) v += __shfl_xor(v, o, 64);
    return v;
}
__device__ __forceinline__ float wave_max(float v) {
#pragma unroll
    for (int o = 32; o > 0; o >>= 1) v = fmaxf(v, __shfl_xor(v, o, 64));
    return v;
}
__device__ __forceinline__ float logsigmoidf(float x) { return fminf(x, 0.f) - log1pf(expf(-fabsf(x))); }
__device__ __forceinline__ unsigned ord_key(float f) { unsigned u = __float_as_uint(f); return u ^ ((u >> 31) ? 0xffffffffu : 0x80000000u); }
__device__ __forceinline__ float unord_key(unsigned k) { unsigned u = (k & 0x80000000u) ? (k ^ 0x80000000u) : ~k; return __uint_as_float(u); }

__device__ __forceinline__ void phase0(const Params& P, unsigned char* smem) {
    const int tid = threadIdx.x, lane = tid & 63, wave = tid >> 6;
    unsigned* ctl = (unsigned*)(P.ws + WS_CTL);
    float* gw = (float*)smem;
    for (int idx = tid; idx < 16 * 1024; idx += 256) {
        const int k = idx >> 4, c = idx & 15;
        const int col = c < 8 ? 2048 + c : 3592 + (c - 8);
        gw[c * 1024 + k] = P.w_in[(size_t)k * PROJ + col];
    }
    __syncthreads();
    {
        bf16_t* hn = (bf16_t*)(P.ws + WS_RA);
        float* gates = (float*)(P.ws + WS_GATES);
        const int c0 = lane * 8, c1 = 512 + lane * 8;
        float gm[16];
        {
            const float4 a0 = *(const float4*)(P.norm_mix + c0), a1 = *(const float4*)(P.norm_mix + c0 + 4);
            const float4 a2 = *(const float4*)(P.norm_mix + c1), a3 = *(const float4*)(P.norm_mix + c1 + 4);
            gm[0] = a0.x; gm[1] = a0.y; gm[2] = a0.z; gm[3] = a0.w; gm[4] = a1.x; gm[5] = a1.y; gm[6] = a1.z; gm[7] = a1.w;
            gm[8] = a2.x; gm[9] = a2.y; gm[10] = a2.z; gm[11] = a2.w; gm[12] = a3.x; gm[13] = a3.y; gm[14] = a3.z; gm[15] = a3.w;
        }
        const int myq = ((lane >> 5) & 1) * 8 + ((lane >> 4) & 1) * 4 + ((lane >> 3) & 1) * 2 + ((lane >> 2) & 1);
        const float mybias = myq < 4 ? P.b_igate[myq] : (myq < 8 ? P.b_fgate_m[myq - 4] : P.b_fgate_f[myq - 8]);
        const int rstep = gridDim.x * 4;
        int r = blockIdx.x * 4 + wave;
        float4 n0, n1, n2, n3;
        auto load_row = [&](int rr) {
            const int b = rr / L, p = rr - b * L;
            const float* src = (p < NMETA) ? (P.meta + (size_t)p * DM) : (P.x + ((size_t)b * SEQ + (p - NMETA)) * DM);
            n0 = *(const float4*)(src + c0); n1 = *(const float4*)(src + c0 + 4); n2 = *(const float4*)(src + c1); n3 = *(const float4*)(src + c1 + 4);
        };
        if (r < T1) load_row(r);
        for (; r < T1; r += rstep) {
            float v[16];
            v[0] = n0.x; v[1] = n0.y; v[2] = n0.z; v[3] = n0.w; v[4] = n1.x; v[5] = n1.y; v[6] = n1.z; v[7] = n1.w;
            v[8] = n2.x; v[9] = n2.y; v[10] = n2.z; v[11] = n2.w; v[12] = n3.x; v[13] = n3.y; v[14] = n3.z; v[15] = n3.w;
            if (r + rstep < T1) load_row(r + rstep);
            float ss = 0.f;
#pragma unroll
            for (int j = 0; j < 16; ++j) ss += v[j] * v[j];
            ss = wave_sum(ss);
            const float rstd = rsqrtf(ss * (1.0f / DM) + EPS);
#pragma unroll
            for (int j = 0; j < 16; ++j) v[j] *= rstd * gm[j];
            uint4 o0, o1;
            o0.x = pk2(v[0], v[1]); o0.y = pk2(v[2], v[3]); o0.z = pk2(v[4], v[5]); o0.w = pk2(v[6], v[7]);
            o1.x = pk2(v[8], v[9]); o1.y = pk2(v[10], v[11]); o1.z = pk2(v[12], v[13]); o1.w = pk2(v[14], v[15]);
            *(uint4*)(hn + (size_t)r * DM + c0) = o0;
            *(uint4*)(hn + (size_t)r * DM + c1) = o1;
            float r8[8], r4[4], r2[2], r1;
#pragma unroll
            for (int i = 0; i < 8; ++i) {
                float dd[2];
#pragma unroll
                for (int hh = 0; hh < 2; ++hh) {
                    const float* gwc = gw + (i + 8 * hh) * 1024;
                    const float4 w0 = *(const float4*)(gwc + c0), w1 = *(const float4*)(gwc + c0 + 4), w2 = *(const float4*)(gwc + c1), w3 = *(const float4*)(gwc + c1 + 4);
                    dd[hh] = v[0] * w0.x + v[1] * w0.y + v[2] * w0.z + v[3] * w0.w + v[4] * w1.x + v[5] * w1.y + v[6] * w1.z + v[7] * w1.w
                           + v[8] * w2.x + v[9] * w2.y + v[10] * w2.z + v[11] * w2.w + v[12] * w3.x + v[13] * w3.y + v[14] * w3.z + v[15] * w3.w;
                }
                const bool up = (lane & 32) != 0; const float keep = up ? dd[1] : dd[0], send = up ? dd[0] : dd[1];
                r8[i] = keep + __shfl_xor(send, 32, 64);
                __builtin_amdgcn_sched_barrier(0);
            }
#pragma unroll
            for (int i = 0; i < 4; ++i) { const bool up = (lane & 16) != 0; const float keep = up ? r8[i + 4] : r8[i], send = up ? r8[i] : r8[i + 4]; r4[i] = keep + __shfl_xor(send, 16, 64); }
#pragma unroll
            for (int i = 0; i < 2; ++i) { const bool up = (lane & 8) != 0; const float keep = up ? r4[i + 2] : r4[i], send = up ? r4[i] : r4[i + 2]; r2[i] = keep + __shfl_xor(send, 8, 64); }
            { const bool up = (lane & 4) != 0; const float keep = up ? r2[1] : r2[0], send = up ? r2[0] : r2[1]; r1 = keep + __shfl_xor(send, 4, 64); }
            r1 += __shfl_xor(r1, 2, 64); r1 += __shfl_xor(r1, 1, 64);
            if ((lane & 3) == 0) {
                const float pre = r1 + mybias;
                gates[(size_t)r * 16 + myq] = myq < 4 ? pre : logsigmoidf(pre);
            }
        }
    }
    __syncthreads();
    {
        float (*tile)[65] = (float (*)[65])smem;
        for (int item = blockIdx.x; item < 1664; item += gridDim.x) {
            const float* W; int ldn, ntn, shift_from, it; bf16_t* out;
            if (item < 896) { W = P.w_in; ldn = PROJ; ntn = 56; shift_from = 2048; it = item; out = (bf16_t*)(P.ws + WS_BT1); }
            else if (item < 1152) { W = P.w_out; ldn = 1024; ntn = 16; shift_from = 1 << 30; it = item - 896; out = (bf16_t*)(P.ws + WS_BT2); }
            else { W = P.peer_query; ldn = 2048; ntn = 32; shift_from = 1 << 30; it = item - 1152; out = (bf16_t*)(P.ws + WS_BT3); }
            const int tk = it / ntn, tn = it - tk * ntn, k0 = tk * 64, n0 = tn * 64;
            {
                const int nl = tid & 63;
                int n = n0 + nl; if (n >= shift_from) n += 8;
#pragma unroll
                for (int i = 0; i < 16; ++i) { const int kl = (tid >> 6) + 4 * i; tile[kl][nl] = W[(size_t)(k0 + kl) * ldn + n]; }
            }
            __syncthreads();
            {
                const int kl = tid & 63;
#pragma unroll
                for (int i = 0; i < 16; ++i) { const int nl = (tid >> 6) + 4 * i; out[(size_t)(n0 + nl) * 1024 + k0 + kl] = (bf16_t)f2bf(tile[kl][nl]); }
            }
            __syncthreads();
        }
    }
    {
        const size_t gt = (size_t)blockIdx.x * 256 + tid, gs = (size_t)gridDim.x * 256;
        const float* src = P.peer_keys; bf16_t* dst = (bf16_t*)(P.ws + WS_KEYS);
        for (size_t i = gt; i < (size_t)(16 * 128 * 128 / 8); i += gs) {
            const float4 a = *(const float4*)(src + i * 8), b = *(const float4*)(src + i * 8 + 4);
            uint4 o; o.x = pk2(a.x, a.y); o.y = pk2(a.z, a.w); o.z = pk2(b.x, b.y); o.w = pk2(b.z, b.w);
            *(uint4*)(dst + i * 8) = o;
        }
    }
}

__device__ __forceinline__ void convert_uv_rows(const Params& P, int gwave, int nwaves, int lane) {
    for (int rr0 = gwave * 4; rr0 < 2 * 16384; rr0 += nwaves * 4) {
        float4 a[4][4];
#pragma unroll
        for (int q = 0; q < 4; ++q) {
            const int rr = rr0 + q, which = rr >> 14, row = rr & 16383;
            const float* src = (which ? P.peer_v : P.peer_u) + (size_t)row * DM + lane * 16;
            a[q][0] = *(const float4*)(src); a[q][1] = *(const float4*)(src + 4); a[q][2] = *(const float4*)(src + 8); a[q][3] = *(const float4*)(src + 12);
        }
#pragma unroll
        for (int q = 0; q < 4; ++q) {
            const int rr = rr0 + q, which = rr >> 14, row = rr & 16383;
            float mx = 0.f;
#pragma unroll
            for (int j = 0; j < 4; ++j) mx = fmaxf(mx, fmaxf(fmaxf(fabsf(a[q][j].x), fabsf(a[q][j].y)), fmaxf(fabsf(a[q][j].z), fabsf(a[q][j].w))));
            mx = wave_max(mx);
            const float sc = mx > 0.f ? 6.0f / mx : 1.0f;
            unsigned w0 = 0u, w1 = 0u;
            w0 = __builtin_amdgcn_cvt_scalef32_pk_fp4_f32(w0, a[q][0].x * sc, a[q][0].y * sc, 1.0f, 0); w0 = __builtin_amdgcn_cvt_scalef32_pk_fp4_f32(w0, a[q][0].z * sc, a[q][0].w * sc, 1.0f, 1);
            w0 = __builtin_amdgcn_cvt_scalef32_pk_fp4_f32(w0, a[q][1].x * sc, a[q][1].y * sc, 1.0f, 2); w0 = __builtin_amdgcn_cvt_scalef32_pk_fp4_f32(w0, a[q][1].z * sc, a[q][1].w * sc, 1.0f, 3);
            w1 = __builtin_amdgcn_cvt_scalef32_pk_fp4_f32(w1, a[q][2].x * sc, a[q][2].y * sc, 1.0f, 0); w1 = __builtin_amdgcn_cvt_scalef32_pk_fp4_f32(w1, a[q][2].z * sc, a[q][2].w * sc, 1.0f, 1);
            w1 = __builtin_amdgcn_cvt_scalef32_pk_fp4_f32(w1, a[q][3].x * sc, a[q][3].y * sc, 1.0f, 2); w1 = __builtin_amdgcn_cvt_scalef32_pk_fp4_f32(w1, a[q][3].z * sc, a[q][3].w * sc, 1.0f, 3);
            *(uint2*)(P.ws + (which ? WS_V : WS_U) + (size_t)row * 512 + lane * 8) = make_uint2(w0, w1);
            if (lane == 0) ((float*)(P.ws + (which ? WS_VSC : WS_USC)))[row] = mx > 0.f ? mx * (1.0f / 6.0f) : 1.0f;
        }
    }
}

__device__ __forceinline__ void bitonic_sort16_desc(unsigned (&v)[16]) {
#pragma unroll
    for (int k = 2; k <= 16; k <<= 1)
#pragma unroll
        for (int j = k >> 1; j >= 1; j >>= 1)
#pragma unroll
            for (int i = 0; i < 16; ++i)
                if ((i & j) == 0) {
                    const int p = i | j;
                    const bool desc = (k >= 16) ? true : ((i & k) == 0);
                    const unsigned hi = max(v[i], v[p]), lo = min(v[i], v[p]);
                    v[i] = desc ? hi : lo; v[p] = desc ? lo : hi;
                }
}
__device__ __forceinline__ void bitonic_merge16_top(unsigned (&a)[16], const unsigned (&b)[16]) {
#pragma unroll
    for (int i = 0; i < 16; ++i) a[i] = max(a[i], b[15 - i]);
#pragma unroll
    for (int j = 8; j >= 1; j >>= 1)
#pragma unroll
        for (int i = 0; i < 16; ++i)
            if ((i & j) == 0) { const int p = i | j; const unsigned hi = max(a[i], a[p]), lo = min(a[i], a[p]); a[i] = hi; a[p] = lo; }
}

__device__ __forceinline__ void mma_ktile(const unsigned char* sA, const unsigned char* sB, int arow_off, int brow_off, int g, int sw, f32x4 (&acc)[4][4]) {
#pragma unroll
    for (int s = 0; s < 2; ++s) {
        bf16x8 a[4], b[4];
        const int ch = (((s * 4 + g) ^ sw) << 4);
#pragma unroll
        for (int i = 0; i < 4; ++i) a[i] = *(const bf16x8*)(sA + arow_off + i * 2048 + ch);
#pragma unroll
        for (int j = 0; j < 4; ++j) b[j] = *(const bf16x8*)(sB + brow_off + j * 2048 + ch);
#pragma unroll
        for (int i = 0; i < 4; ++i)
#pragma unroll
            for (int j = 0; j < 4; ++j) acc[i][j] = __builtin_amdgcn_mfma_f32_16x16x32_bf16(b[j], a[i], acc[i][j], 0, 0, 0);
    }
}

__device__ __forceinline__ void store_tile_bf16(const f32x4 (&acc)[4][4], unsigned char* smem, bf16_t* dst, size_t ld, int m0, int n0, int tid, int wr, int wc, int g, int lr) {
#pragma unroll
    for (int i = 0; i < 4; ++i)
#pragma unroll
        for (int j = 0; j < 4; ++j) {
            const int row = wr * 64 + 16 * i + lr, col = wc * 64 + 16 * j + 4 * g;
            uint2 w; w.x = pk2(acc[i][j][0], acc[i][j][1]); w.y = pk2(acc[i][j][2], acc[i][j][3]);
            *(uint2*)(smem + row * 272 + col * 2) = w;
        }
    __syncthreads();
#pragma unroll
    for (int q = 0; q < 8; ++q) {
        const int id = tid + 256 * q, row = id >> 4, ch = id & 15;
        const uint4 v = *(const uint4*)(smem + row * 272 + ch * 16);
        *(uint4*)(dst + (size_t)(m0 + row) * ld + n0 + ch * 8) = v;
    }
    __syncthreads();
}

template <int MODE>
__device__ __forceinline__ void gemm_tile(const Params& P, int tm, int tn, unsigned char* smem) {
    const bf16_t* A; const bf16_t* Bt;
    if (MODE == 1) { A = (const bf16_t*)(P.ws + WS_RA); Bt = (const bf16_t*)(P.ws + WS_BT1); }
    else if (MODE == 2) { A = (const bf16_t*)(P.ws + WS_Z); Bt = (const bf16_t*)(P.ws + WS_BT2); }
    else { A = (const bf16_t*)(P.ws + WS_XN); Bt = (const bf16_t*)(P.ws + WS_BT3); }
    const int tid = threadIdx.x, lane = tid & 63, wave = tid >> 6, wr = wave >> 1, wc = wave & 1, g = lane >> 4, lr = lane & 15;
    const int m0 = tm * 128, n0 = tn * 128;
    const int srow = tid >> 3, sc = tid & 7;
    const bf16_t* aptr[4]; const bf16_t* bptr[4]; int soff[4];
#pragma unroll
    for (int j = 0; j < 4; ++j) {
        const int row = srow + 32 * j;
        int ar = m0 + row;
        if (MODE == 2) { const int b = ar >> 11, t = ar & 2047; ar = b * L + NMETA + t; }
        aptr[j] = A + (size_t)ar * (MODE == 2 ? NZ : 1024) + sc * 8;
        bptr[j] = Bt + (size_t)(n0 + row) * 1024 + sc * 8;
        soff[j] = row * 128 + ((sc ^ (row & 7)) << 4);
    }
    f32x4 acc[4][4];
#pragma unroll
    for (int i = 0; i < 4; ++i)
#pragma unroll
        for (int j = 0; j < 4; ++j) acc[i][j] = (f32x4){0.f, 0.f, 0.f, 0.f};
    uint4 ra[4], rb[4];
#pragma unroll
    for (int j = 0; j < 4; ++j) { ra[j] = *(const uint4*)(aptr[j]); rb[j] = *(const uint4*)(bptr[j]); }
    unsigned char* sA0 = smem; unsigned char* sB0 = smem + 16384; unsigned char* sA1 = smem + 32768; unsigned char* sB1 = smem + 49152;
#pragma unroll
    for (int j = 0; j < 4; ++j) { *(uint4*)(sA0 + soff[j]) = ra[j]; *(uint4*)(sB0 + soff[j]) = rb[j]; }
    __syncthreads();
    const int arow_off = (wr * 64 + lr) * 128, brow_off = (wc * 64 + lr) * 128, sw = lr & 7;
    for (int kt = 0; kt < 16; ++kt) {
        unsigned char* sA = (kt & 1) ? sA1 : sA0; unsigned char* sB = (kt & 1) ? sB1 : sB0;
        unsigned char* nA = (kt & 1) ? sA0 : sA1; unsigned char* nB = (kt & 1) ? sB0 : sB1;
        if (kt < 15) {
#pragma unroll
            for (int j = 0; j < 4; ++j) { ra[j] = *(const uint4*)(aptr[j] + (kt + 1) * 64); rb[j] = *(const uint4*)(bptr[j] + (kt + 1) * 64); }
        }
        mma_ktile(sA, sB, arow_off, brow_off, g, sw, acc);
        if (kt < 15) {
#pragma unroll
            for (int j = 0; j < 4; ++j) { *(uint4*)(nA + soff[j]) = ra[j]; *(uint4*)(nB + soff[j]) = rb[j]; }
        }
        __syncthreads();
    }
    if (MODE == 1) {
        if (n0 >= ZC_FQ && n0 < ZC_FV) {
            const bool isk = n0 >= ZC_FK;
            const float* gain = isk ? P.f_k_norm : P.f_q_norm;
            const float scl = isk ? 1.0f : 0.125f * LOG2E;
            float gn[4][4];
#pragma unroll
            for (int j = 0; j < 4; ++j)
#pragma unroll
                for (int r = 0; r < 4; ++r) gn[j][r] = gain[16 * j + 4 * g + r];
#pragma unroll
            for (int i = 0; i < 4; ++i) {
                float ss = 0.f;
#pragma unroll
                for (int j = 0; j < 4; ++j)
#pragma unroll
                    for (int r = 0; r < 4; ++r) ss += acc[i][j][r] * acc[i][j][r];
                ss += __shfl_xor(ss, 16, 64); ss += __shfl_xor(ss, 32, 64);
                const float rstd = rsqrtf(ss * (1.0f / 64.0f) + EPS) * scl;
#pragma unroll
                for (int j = 0; j < 4; ++j)
#pragma unroll
                    for (int r = 0; r < 4; ++r) acc[i][j][r] *= rstd * gn[j][r];
            }
        }
        store_tile_bf16(acc, smem, (bf16_t*)(P.ws + WS_Z), NZ, m0, n0, tid, wr, wc, g, lr);
    } else if (MODE == 2) {
        float* ssq = (float*)(P.ws + WS_SSQ);
#pragma unroll
        for (int i = 0; i < 4; ++i) {
            const int row = m0 + wr * 64 + 16 * i + lr;
            float ss = 0.f;
#pragma unroll
            for (int j = 0; j < 4; ++j) {
                const int col = n0 + wc * 64 + 16 * j + 4 * g;
                const float4 xv = *(const float4*)(P.x + (size_t)row * DM + col);
                const float4 gv = *(const float4*)(P.norm_ffn + col);
                float4 hv; hv.x = acc[i][j][0] + xv.x; hv.y = acc[i][j][1] + xv.y; hv.z = acc[i][j][2] + xv.z; hv.w = acc[i][j][3] + xv.w;
                ss += hv.x * hv.x + hv.y * hv.y + hv.z * hv.z + hv.w * hv.w;
                acc[i][j][0] = hv.x * gv.x; acc[i][j][1] = hv.y * gv.y; acc[i][j][2] = hv.z * gv.z; acc[i][j][3] = hv.w * gv.w;
            }
            ss += __shfl_xor(ss, 16, 64); ss += __shfl_xor(ss, 32, 64);
            if (g == 0) ssq[(size_t)row * 16 + tn * 2 + wc] = ss;
        }
        store_tile_bf16(acc, smem, (bf16_t*)(P.ws + WS_XN), 1024, m0, n0, tid, wr, wc, g, lr);
    } else {
        const int hp = tn;
        const float* ssq = (const float*)(P.ws + WS_SSQ);
        float rs[4];
#pragma unroll
        for (int i = 0; i < 4; ++i) {
            const int row = m0 + wr * 64 + 16 * i + lr;
            const float4 p0 = *(const float4*)(ssq + (size_t)row * 16), p1 = *(const float4*)(ssq + (size_t)row * 16 + 4);
            const float4 p2 = *(const float4*)(ssq + (size_t)row * 16 + 8), p3 = *(const float4*)(ssq + (size_t)row * 16 + 12);
            const float s = ((p0.x + p0.y) + (p0.z + p0.w)) + ((p1.x + p1.y) + (p1.z + p1.w)) + ((p2.x + p2.y) + (p2.z + p2.w)) + ((p3.x + p3.y) + (p3.z + p3.w));
            rs[i] = rsqrtf(s * (1.0f / DM) + EPS);
            if (tn == 0 && wc == 0 && g == 0) ((float*)(P.ws + WS_RSTD))[row] = rs[i];
        }
        {
            unsigned char* sAq = wc ? sA1 : sA0;
#pragma unroll
            for (int i = 0; i < 4; ++i)
#pragma unroll
                for (int j = 0; j < 4; ++j) {
                    const int row = wr * 64 + 16 * i + lr;
                    const int chunk = 2 * j + (g >> 1);
                    uint2 w; w.x = pk2(acc[i][j][0] * rs[i], acc[i][j][1] * rs[i]); w.y = pk2(acc[i][j][2] * rs[i], acc[i][j][3] * rs[i]);
                    *(uint2*)(sAq + row * 128 + ((chunk ^ (row & 7)) << 4) + 8 * (g & 1)) = w;
                }
            const bf16_t* keys = (const bf16_t*)(P.ws + WS_KEYS) + (size_t)hp * 128 * 128;
#pragma unroll
            for (int j = 0; j < 4; ++j) {
                const int row = srow + 32 * j;
                const uint4 k0 = *(const uint4*)(keys + (size_t)row * 128 + sc * 8);
                const uint4 k1 = *(const uint4*)(keys + (size_t)row * 128 + 64 + sc * 8);
                *(uint4*)(sB0 + soff[j]) = k0; *(uint4*)(sB1 + soff[j]) = k1;
            }
        }
        __syncthreads();
#pragma unroll
        for (int i = 0; i < 4; ++i)
#pragma unroll
            for (int j = 0; j < 4; ++j) acc[i][j] = (f32x4){0.f, 0.f, 0.f, 0.f};
        mma_ktile(sA0, sB0, arow_off, brow_off, g, sw, acc);
        mma_ktile(sA1, sB1, arow_off, brow_off, g, sw, acc);
        __syncthreads();
#pragma unroll
        for (int i = 0; i < 4; ++i)
#pragma unroll
            for (int j = 0; j < 4; ++j) {
                const int row = wr * 64 + 16 * i + lr;
                const int c4 = wc * 16 + 4 * j + g;
                *(f32x4*)(smem + row * 512 + ((c4 ^ (row & 31)) << 4)) = acc[i][j];
            }
        __syncthreads();
        unsigned top[16];
        const int row = tid & 127, half = tid >> 7;
        {
            auto load_keys = [&](unsigned (&dst)[16], int q4) {
#pragma unroll
                for (int s4 = 0; s4 < 4; ++s4) {
                    const int c4 = half * 16 + q4 * 4 + s4;
                    const f32x4 v = *(const f32x4*)(smem + row * 512 + ((c4 ^ (row & 31)) << 4));
#pragma unroll
                    for (int e = 0; e < 4; ++e) dst[s4 * 4 + e] = (ord_key(v[e]) & ~127u) | (unsigned)(127 - (c4 * 4 + e));
                }
            };
            load_keys(top, 0);
            bitonic_sort16_desc(top);
#pragma unroll 1
            for (int q4 = 1; q4 < 4; ++q4) {
                unsigned gq[16];
                load_keys(gq, q4);
                bitonic_sort16_desc(gq);
                bitonic_merge16_top(top, gq);
            }
        }
        __syncthreads();
        if (half) {
            uint4* lp = (uint4*)(smem + row * 64);
            lp[0] = make_uint4(top[0], top[1], top[2], top[3]); lp[1] = make_uint4(top[4], top[5], top[6], top[7]);
            lp[2] = make_uint4(top[8], top[9], top[10], top[11]); lp[3] = make_uint4(top[12], top[13], top[14], top[15]);
        }
        __syncthreads();
        if (!half) {
            const uint4* lp = (const uint4*)(smem + row * 64);
            unsigned other[16];
#pragma unroll
            for (int c = 0; c < 4; ++c) { const uint4 o = lp[c]; other[4 * c] = o.x; other[4 * c + 1] = o.y; other[4 * c + 2] = o.z; other[4 * c + 3] = o.w; }
            bitonic_merge16_top(top, other);
            uint4* tk = (uint4*)((unsigned*)(P.ws + WS_TK) + ((size_t)(m0 + row) * 16 + hp) * 16);
            tk[0] = make_uint4(top[0], top[1], top[2], top[3]); tk[1] = make_uint4(top[4], top[5], top[6], top[7]);
            tk[2] = make_uint4(top[8], top[9], top[10], top[11]); tk[3] = make_uint4(top[12], top[13], top[14], top[15]);
        }
        __syncthreads();
    }
}

__device__ __forceinline__ void fox_cum_wave(const Params& P, int bh, int lane) {
    const int b = bh >> 3, h = bh & 7;
    const float* gates = (const float*)(P.ws + WS_GATES);
    float* cum = (float*)(P.ws + WS_CUM) + (size_t)bh * L;
    constexpr int SEG = 33;
    const int t0 = lane * SEG;
    float loc = 0.f;
    for (int i = 0; i < SEG; ++i) { const int t = t0 + i; if (t < L) loc += gates[(size_t)(b * L + t) * 16 + 8 + h]; }
    float incl = loc;
#pragma unroll
    for (int o = 1; o < 64; o <<= 1) { const float n = __shfl_up(incl, o, 64); if (lane >= o) incl += n; }
    float run = incl - loc;
    for (int i = 0; i < SEG; ++i) { const int t = t0 + i; if (t < L) { run += gates[(size_t)(b * L + t) * 16 + 8 + h]; cum[t] = run * LOG2E; } }
}

#define TR_SLOW 0

__device__ __forceinline__ int vimg_off(int row, int ch) { return row * 128 + ((ch ^ (((row >> 1) & 3) << 1)) << 4); }
__device__ __forceinline__ uint2 tr_frag(const unsigned char* img, int row0, int c, int g, int lr) {
#if TR_SLOW
    unsigned short e[4];
#pragma unroll
    for (int k = 0; k < 4; ++k) { const int row = row0 + 4 * g + k, col = 16 * c + lr; e[k] = *(const unsigned short*)(img + vimg_off(row, col >> 3) + (col & 7) * 2); }
    uint2 r; r.x = (unsigned)e[0] | ((unsigned)e[1] << 16); r.y = (unsigned)e[2] | ((unsigned)e[3] << 16); return r;
#else
    const int q = lr >> 2, p = lr & 3, row = row0 + 4 * g + q;
    const unsigned addr = (unsigned)(size_t)(img + vimg_off(row, 2 * c + (p >> 1)) + 8 * (p & 1));
    uint2 r;
    asm volatile("ds_read_b64_tr_b16 %0, %1\n\ts_waitcnt lgkmcnt(0)" : "=&v"(r) : "v"(addr) : "memory");
    return r;
#endif
}

__device__ __forceinline__ unsigned tr_lane_addr(const unsigned char* img, int c, int g, int lr) {
    const int q = lr >> 2, p = lr & 3, row = 4 * g + q;
    return (unsigned)(size_t)(img + vimg_off(row, 2 * c + (p >> 1)) + 8 * (p & 1));
}
#define TR_GROUP(o0, o1, o2, o3, a) "ds_read_b64_tr_b16 %" #o0 ", %" #a "\n\tds_read_b64_tr_b16 %" #o1 ", %" #a " offset:2048\n\tds_read_b64_tr_b16 %" #o2 ", %" #a " offset:4096\n\tds_read_b64_tr_b16 %" #o3 ", %" #a " offset:6144\n\t"
__device__ __forceinline__ void tr_read_4c(const unsigned char* img, int g, int lr, uint2 (&r)[4][4]) {
    const unsigned a0 = tr_lane_addr(img, 0, g, lr), a1 = tr_lane_addr(img, 1, g, lr), a2 = tr_lane_addr(img, 2, g, lr), a3 = tr_lane_addr(img, 3, g, lr);
    asm volatile(TR_GROUP(0, 1, 2, 3, 16) TR_GROUP(4, 5, 6, 7, 17) TR_GROUP(8, 9, 10, 11, 18) TR_GROUP(12, 13, 14, 15, 19) "s_waitcnt lgkmcnt(0)"
        : "=&v"(r[0][0]), "=&v"(r[0][1]), "=&v"(r[0][2]), "=&v"(r[0][3]), "=&v"(r[1][0]), "=&v"(r[1][1]), "=&v"(r[1][2]), "=&v"(r[1][3]),
          "=&v"(r[2][0]), "=&v"(r[2][1]), "=&v"(r[2][2]), "=&v"(r[2][3]), "=&v"(r[3][0]), "=&v"(r[3][1]), "=&v"(r[3][2]), "=&v"(r[3][3])
        : "v"(a0), "v"(a1), "v"(a2), "v"(a3) : "memory");
}
__device__ __forceinline__ void tr_read_3c(const unsigned char* img, int g, int lr, uint2 (&r)[3][4]) {
    const unsigned a0 = tr_lane_addr(img, 0, g, lr), a1 = tr_lane_addr(img, 1, g, lr), a2 = tr_lane_addr(img, 2, g, lr);
    asm volatile(TR_GROUP(0, 1, 2, 3, 12) TR_GROUP(4, 5, 6, 7, 13) TR_GROUP(8, 9, 10, 11, 14) "s_waitcnt lgkmcnt(0)"
        : "=&v"(r[0][0]), "=&v"(r[0][1]), "=&v"(r[0][2]), "=&v"(r[0][3]), "=&v"(r[1][0]), "=&v"(r[1][1]), "=&v"(r[1][2]), "=&v"(r[1][3]),
          "=&v"(r[2][0]), "=&v"(r[2][1]), "=&v"(r[2][2]), "=&v"(r[2][3])
        : "v"(a0), "v"(a1), "v"(a2) : "memory");
}
__device__ __forceinline__ void tr_read_2(const unsigned char* img0, int c0, const unsigned char* img1, int c1, int g, int lr, uint2 (&r)[2][4]) {
    const unsigned a0 = tr_lane_addr(img0, c0, g, lr), a1 = tr_lane_addr(img1, c1, g, lr);
    asm volatile(TR_GROUP(0, 1, 2, 3, 8) TR_GROUP(4, 5, 6, 7, 9) "s_waitcnt lgkmcnt(0)"
        : "=&v"(r[0][0]), "=&v"(r[0][1]), "=&v"(r[0][2]), "=&v"(r[0][3]), "=&v"(r[1][0]), "=&v"(r[1][1]), "=&v"(r[1][2]), "=&v"(r[1][3])
        : "v"(a0), "v"(a1) : "memory");
}
__device__ __forceinline__ bf16x8 tr_pair(const uint2& lo, const uint2& hi) { uint4 u; u.x = lo.x; u.y = lo.y; u.z = hi.x; u.w = hi.y; return __builtin_bit_cast(bf16x8, u); }

__device__ __forceinline__ void attn_block(const Params& P, int bh, int qb, unsigned char* smem) {
    const int tid = threadIdx.x, lane = tid & 63, w = tid >> 6, g = lane >> 4, lr = lane & 15;
    const int b = bh >> 3, h = bh & 7;
    const bf16_t* z = (const bf16_t*)(P.ws + WS_Z);
    const float* cum = (const float*)(P.ws + WS_CUM) + (size_t)bh * L;
    int tq[2]; bool qvalid[2]; bf16x8 qf[2][2]; float cq[2];
#pragma unroll
    for (int u = 0; u < 2; ++u) {
        tq[u] = qb * 128 + 32 * w + 16 * u + lr;
        qvalid[u] = tq[u] < L;
        const bf16_t* qp = z + (size_t)(b * L + (qvalid[u] ? tq[u] : 0)) * NZ + ZC_FQ + h * 64 + 8 * g;
        qf[u][0] = *(const bf16x8*)(qp); qf[u][1] = *(const bf16x8*)(qp + 32);
        cq[u] = cum[qvalid[u] ? tq[u] : 0];
    }
    const int nkv = (2 * qb + 2 < 33) ? 2 * qb + 2 : 33;
    const int srow0 = tid >> 3, sch = tid & 7;
    uint4 rk[2], rv[2]; float rc = 0.f;
    auto load_tile = [&](int kv) {
#pragma unroll
        for (int j = 0; j < 2; ++j) {
            const int key = kv * 64 + srow0 + 32 * j;
            if (key < L) {
                const bf16_t* p = z + (size_t)(b * L + key) * NZ + h * 64 + sch * 8;
                rk[j] = *(const uint4*)(p + ZC_FK); rv[j] = *(const uint4*)(p + ZC_FV);
            } else { rk[j] = make_uint4(0, 0, 0, 0); rv[j] = make_uint4(0, 0, 0, 0); }
        }
        if (tid < 64) { const int key = kv * 64 + tid; rc = key < L ? cum[key] : 0.f; }
    };
    auto store_tile = [&](int buf) {
        unsigned char* sK = smem + buf * 16384; unsigned char* sV = sK + 8192;
#pragma unroll
        for (int j = 0; j < 2; ++j) {
            const int row = srow0 + 32 * j;
            *(uint4*)(sK + row * 128 + ((sch ^ (row & 7)) << 4)) = rk[j];
            *(uint4*)(sV + vimg_off(row, sch)) = rv[j];
        }
        if (tid < 64) ((float*)(smem + 32768 + buf * 256))[tid] = rc;
    };
    float m[2] = {-INFINITY, -INFINITY}, lsum[2] = {0.f, 0.f};
    f32x4 o[2][4];
#pragma unroll
    for (int u = 0; u < 2; ++u)
#pragma unroll
        for (int c = 0; c < 4; ++c) o[u][c] = (f32x4){0.f, 0.f, 0.f, 0.f};
    load_tile(0); store_tile(0);
    __syncthreads();
    for (int kv = 0; kv < nkv; ++kv) {
        const int buf = kv & 1;
        if (kv + 1 < nkv) load_tile(kv + 1);
        const unsigned char* sK = smem + buf * 16384; const unsigned char* sV = sK + 8192;
        const float* sck = (const float*)(smem + 32768 + buf * 256);
        f32x4 sa[2][4];
#pragma unroll
        for (int c = 0; c < 4; ++c) {
            sa[0][c] = (f32x4){0.f, 0.f, 0.f, 0.f}; sa[1][c] = (f32x4){0.f, 0.f, 0.f, 0.f};
#pragma unroll
            for (int s = 0; s < 2; ++s) {
                const bf16x8 kf = *(const bf16x8*)(sK + (16 * c + lr) * 128 + (((4 * s + g) ^ (lr & 7)) << 4));
                sa[0][c] = __builtin_amdgcn_mfma_f32_16x16x32_bf16(kf, qf[0][s], sa[0][c], 0, 0, 0);
                sa[1][c] = __builtin_amdgcn_mfma_f32_16x16x32_bf16(kf, qf[1][s], sa[1][c], 0, 0, 0);
            }
        }
        const bool diag = (kv >= 2 * qb);
        bf16x8 pf[2][2];
#pragma unroll
        for (int u = 0; u < 2; ++u) {
            float mx = -INFINITY;
#pragma unroll
            for (int c = 0; c < 4; ++c) {
                const f32x4 ck = *(const f32x4*)(sck + 16 * c + 4 * g);
#pragma unroll
                for (int r = 0; r < 4; ++r) {
                    float v = sa[u][c][r] + (cq[u] - ck[r]);
                    if (diag && (64 * kv + 16 * c + 4 * g + r > tq[u])) v = -INFINITY;
                    sa[u][c][r] = v; mx = fmaxf(mx, v);
                }
            }
            mx = fmaxf(mx, __shfl_xor(mx, 16, 64)); mx = fmaxf(mx, __shfl_xor(mx, 32, 64));
            const float mn = fmaxf(m[u], mx);
            const float alpha = __builtin_amdgcn_exp2f(m[u] - mn);
            m[u] = mn;
            float ps = 0.f;
#pragma unroll
            for (int c = 0; c < 4; ++c)
#pragma unroll
                for (int r = 0; r < 4; ++r) { const float p = __builtin_amdgcn_exp2f(sa[u][c][r] - mn); sa[u][c][r] = p; ps += p; }
            lsum[u] = lsum[u] * alpha + ps;
#pragma unroll
            for (int c = 0; c < 4; ++c) o[u][c] *= alpha;
#pragma unroll
            for (int s2 = 0; s2 < 2; ++s2) {
                uint4 uu;
                uu.x = cvt_pk_bf16(sa[u][2 * s2][0], sa[u][2 * s2][1]); uu.y = cvt_pk_bf16(sa[u][2 * s2][2], sa[u][2 * s2][3]);
                uu.z = cvt_pk_bf16(sa[u][2 * s2 + 1][0], sa[u][2 * s2 + 1][1]); uu.w = cvt_pk_bf16(sa[u][2 * s2 + 1][2], sa[u][2 * s2 + 1][3]);
                pf[u][s2] = __builtin_bit_cast(bf16x8, uu);
            }
        }
        {
            uint2 vr[4][4];
            tr_read_4c(sV, g, lr, vr);
#pragma unroll
            for (int c = 0; c < 4; ++c)
#pragma unroll
                for (int s2 = 0; s2 < 2; ++s2) {
                    const bf16x8 vf = tr_pair(vr[c][2 * s2], vr[c][2 * s2 + 1]);
                    o[0][c] = __builtin_amdgcn_mfma_f32_16x16x32_bf16(vf, pf[0][s2], o[0][c], 0, 0, 0);
                    o[1][c] = __builtin_amdgcn_mfma_f32_16x16x32_bf16(vf, pf[1][s2], o[1][c], 0, 0, 0);
                }
        }
        if (kv + 1 < nkv) store_tile(buf ^ 1);
        __syncthreads();
    }
#pragma unroll
    for (int u = 0; u < 2; ++u) {
        float ls = lsum[u];
        ls += __shfl_xor(ls, 16, 64); ls += __shfl_xor(ls, 32, 64);
        const float inv = 1.0f / ls;
        if (qvalid[u]) {
            bf16_t* y = (bf16_t*)(P.ws + WS_Z) + (size_t)(b * L + tq[u]) * NZ + 512 + h * 64 + 4 * g;
#pragma unroll
            for (int c = 0; c < 4; ++c) {
                uint2 uu; uu.x = pk2(o[u][c][0] * inv, o[u][c][1] * inv); uu.y = pk2(o[u][c][2] * inv, o[u][c][3] * inv);
                *(uint2*)(y + 16 * c) = uu;
            }
        }
    }
}

__device__ __forceinline__ void conv_item(const Params& P, int ci) {
    const int tid = threadIdx.x, cc = tid & 127, rg = tid >> 7;
    const bf16_t* z = (const bf16_t*)(P.ws + WS_Z);
    bf16_t* qk = (bf16_t*)(P.ws + WS_RA);
    const int col0 = cc * 8;
    float w[4][8];
#pragma unroll
    for (int j = 0; j < 4; ++j) {
        const float4 a = *(const float4*)(P.conv_qk + j * 1024 + col0), b = *(const float4*)(P.conv_qk + j * 1024 + col0 + 4);
        w[j][0] = a.x; w[j][1] = a.y; w[j][2] = a.z; w[j][3] = a.w; w[j][4] = b.x; w[j][5] = b.y; w[j][6] = b.z; w[j][7] = b.w;
    }
    const float oscale = (col0 >= 512) ? 0.08838834764831845f : 1.0f;
    const int r0 = ci * 64 + rg * 32;
    int t = r0 % L;
    float xw[3][8];
#pragma unroll
    for (int j = 0; j < 3; ++j) {
        const int back = 3 - j;
        if (t - back >= 0) {
            const uint4 v = *(const uint4*)(z + (size_t)(r0 - back) * NZ + col0);
            xw[j][0] = bflo(v.x); xw[j][1] = bfhi(v.x); xw[j][2] = bflo(v.y); xw[j][3] = bfhi(v.y); xw[j][4] = bflo(v.z); xw[j][5] = bfhi(v.z); xw[j][6] = bflo(v.w); xw[j][7] = bfhi(v.w);
        } else {
#pragma unroll
            for (int e = 0; e < 8; ++e) xw[j][e] = 0.f;
        }
    }
#pragma unroll 2
    for (int i = 0; i < 32; ++i) {
        const int r = r0 + i;
        if (t == 0) {
#pragma unroll
            for (int j = 0; j < 3; ++j)
#pragma unroll
                for (int e = 0; e < 8; ++e) xw[j][e] = 0.f;
        }
        const uint4 v = *(const uint4*)(z + (size_t)r * NZ + col0);
        float xt[8];
        xt[0] = bflo(v.x); xt[1] = bfhi(v.x); xt[2] = bflo(v.y); xt[3] = bfhi(v.y); xt[4] = bflo(v.z); xt[5] = bfhi(v.z); xt[6] = bflo(v.w); xt[7] = bfhi(v.w);
        float o[8];
#pragma unroll
        for (int e = 0; e < 8; ++e) {
            const float cv = w[0][e] * xw[0][e] + w[1][e] * xw[1][e] + w[2][e] * xw[2][e] + w[3][e] * xt[e];
            o[e] = oscale * cv / (1.f + __expf(-cv));
            xw[0][e] = xw[1][e]; xw[1][e] = xw[2][e]; xw[2][e] = xt[e];
        }
        uint4 ov; ov.x = pk2(o[0], o[1]); ov.y = pk2(o[2], o[3]); ov.z = pk2(o[4], o[5]); ov.w = pk2(o[6], o[7]);
        *(uint4*)(qk + (size_t)r * 1024 + col0) = ov;
        t = (t + 1 == L) ? 0 : t + 1;
    }
}

constexpr int ST_IMG = 36864;
__device__ __forceinline__ int st_piece_off(int jt, int c, int g, int lr) { return (jt >> 2) * 18432 + vimg_off(16 * c + lr, 2 * (jt & 3) + (g >> 1)) + 8 * (g & 1); }

__device__ __forceinline__ void mlstm_stage_kv(const Params& P, int b, int h, int k, unsigned char* sKimg, unsigned char* sVimg, int tid) {
    const bf16_t* z = (const bf16_t*)(P.ws + WS_Z);
    const bf16_t* qk = (const bf16_t*)(P.ws + WS_RA);
    uint4 pk_[4], pv_[4];
#pragma unroll
    for (int j = 0; j < 4; ++j) {
        const int id = tid + 256 * j, row = id >> 4, ch16 = id & 15, pos = 64 * k + row;
        const bool ok = pos < L;
        pk_[j] = ok ? *(const uint4*)(qk + (size_t)(b * L + pos) * 1024 + 512 + h * 128 + ch16 * 8) : make_uint4(0, 0, 0, 0);
        pv_[j] = ok ? *(const uint4*)(z + (size_t)(b * L + pos) * NZ + ZC_MV + h * 128 + ch16 * 8) : make_uint4(0, 0, 0, 0);
    }
#pragma unroll
    for (int j = 0; j < 4; ++j) {
        const int id = tid + 256 * j, row = id >> 4, ch16 = id & 15;
        *(uint4*)(sKimg + (ch16 >> 3) * 8192 + vimg_off(row, ch16 & 7)) = pk_[j];
        *(uint4*)(sVimg + (ch16 >> 3) * 8192 + vimg_off(row, ch16 & 7)) = pv_[j];
    }
    if (tid < 128) {
        const int row = tid >> 1, ch = tid & 1;
        *(uint4*)(sVimg + 16384 + vimg_off(row, ch)) = ch ? make_uint4(0, 0, 0, 0) : make_uint4(0x3F80u, 0, 0, 0);
    }
}

__device__ __forceinline__ void mlstm_stage_A(const Params& P, int b, int h, int k, unsigned char* sKimg, unsigned char* sVimg, int tid) {
    const bf16_t* z = (const bf16_t*)(P.ws + WS_Z);
    bf16_t* qk = (bf16_t*)(P.ws + WS_RA);
    uint4 pv_[4];
#pragma unroll
    for (int j = 0; j < 4; ++j) {
        const int id = tid + 256 * j, row = id >> 4, ch16 = id & 15, pos = 64 * k + row;
        pv_[j] = (pos < L) ? *(const uint4*)(z + (size_t)(b * L + pos) * NZ + ZC_MV + h * 128 + ch16 * 8) : make_uint4(0, 0, 0, 0);
    }
    const int cch = tid & 31, rg = tid >> 5, isk = cch >> 4;
    const int zcol = (isk ? ZC_MK : ZC_MQ) + h * 128 + (cch & 15) * 8;
    float w[4][8];
#pragma unroll
    for (int j = 0; j < 4; ++j) {
        const float4 a = *(const float4*)(P.conv_qk + j * 1024 + zcol), c = *(const float4*)(P.conv_qk + j * 1024 + zcol + 4);
        w[j][0] = a.x; w[j][1] = a.y; w[j][2] = a.z; w[j][3] = a.w; w[j][4] = c.x; w[j][5] = c.y; w[j][6] = c.z; w[j][7] = c.w;
    }
    const float oscale = isk ? 0.08838834764831845f : 1.0f;
    const int p0 = 64 * k + 8 * rg;
    uint4 raw[11];
#pragma unroll
    for (int i = 0; i < 11; ++i) {
        const int pos = p0 - 3 + i;
        raw[i] = (pos >= 0 && pos < L) ? *(const uint4*)(z + (size_t)(b * L + pos) * NZ + zcol) : make_uint4(0, 0, 0, 0);
    }
#pragma unroll
    for (int j = 0; j < 4; ++j) {
        const int id = tid + 256 * j, row = id >> 4, ch16 = id & 15;
        *(uint4*)(sVimg + (ch16 >> 3) * 8192 + vimg_off(row, ch16 & 7)) = pv_[j];
    }
    if (tid < 128) {
        const int row = tid >> 1, ch = tid & 1;
        *(uint4*)(sVimg + 16384 + vimg_off(row, ch)) = ch ? make_uint4(0, 0, 0, 0) : make_uint4(0x3F80u, 0, 0, 0);
    }
#pragma unroll
    for (int i = 0; i < 8; ++i) {
        const int pos = p0 + i, row = 8 * rg + i;
        float o[8];
#pragma unroll
        for (int e = 0; e < 8; ++e) {
            const unsigned w0 = (&raw[i].x)[e >> 1], w1 = (&raw[i + 1].x)[e >> 1], w2 = (&raw[i + 2].x)[e >> 1], w3 = (&raw[i + 3].x)[e >> 1];
            const float x0 = (e & 1) ? bfhi(w0) : bflo(w0), x1 = (e & 1) ? bfhi(w1) : bflo(w1), x2 = (e & 1) ? bfhi(w2) : bflo(w2), x3 = (e & 1) ? bfhi(w3) : bflo(w3);
            const float cv = w[0][e] * x0 + w[1][e] * x1 + w[2][e] * x2 + w[3][e] * x3;
            o[e] = oscale * cv / (1.f + __expf(-cv));
        }
        uint4 ov; ov.x = pk2(o[0], o[1]); ov.y = pk2(o[2], o[3]); ov.z = pk2(o[4], o[5]); ov.w = pk2(o[6], o[7]);
        const bool ok = pos < L;
        if (!ok) ov = make_uint4(0, 0, 0, 0);
        if (ok) *(uint4*)(qk + (size_t)(b * L + pos) * 1024 + (isk ? 512 : 0) + h * 128 + (cch & 15) * 8) = ov;
        if (isk) { const int ch16 = cch & 15; *(uint4*)(sKimg + (ch16 >> 3) * 8192 + vimg_off(row, ch16 & 7)) = ov; }
    }
}

__device__ __forceinline__ void mlstm_A(const Params& P, int item, unsigned char* smem) {
    const int tid = threadIdx.x, lane = tid & 63, w = tid >> 6, g = lane >> 4, lr = lane & 15;
    const int wu = __builtin_amdgcn_readfirstlane(w);
    const int k = item >> 5, bh = item & 31, b = bh >> 2, h = bh & 3;
    const float* gates = (const float*)(P.ws + WS_GATES);
    const unsigned char* sK = smem; const unsigned char* sV = smem + 16384;
    float* ga = (float*)(smem + 40960);
    mlstm_stage_A(P, b, h, k, smem, smem + 16384, tid);
    if (wu == 0) {
        const int pos = 64 * k + lane;
        float lf = 0.f, li = -INFINITY;
        if (pos < L) { lf = gates[(size_t)(b * L + pos) * 16 + 4 + h]; li = gates[(size_t)(b * L + pos) * 16 + h]; }
        float bc = lf;
#pragma unroll
        for (int o = 1; o < 64; o <<= 1) { const float n = __shfl_up(bc, o, 64); if (lane >= o) bc += n; }
        const float a = li - bc;
        const float A = wave_max(a);
        ga[lane] = __expf(a - A);
        if (lane == 63) { float* msc = (float*)(P.ws + WS_MSC) + ((size_t)bh * 33 + k) * 4; msc[0] = A; msc[1] = bc; }
    }
    __syncthreads();
    f32x4 Ct[2][9];
#pragma unroll
    for (int a = 0; a < 2; ++a)
#pragma unroll
        for (int c = 0; c < 9; ++c) Ct[a][c] = (f32x4){0.f, 0.f, 0.f, 0.f};
    bf16x8 kt[2][2];
#pragma unroll
    for (int a = 0; a < 2; ++a)
#pragma unroll
        for (int s2 = 0; s2 < 2; ++s2) {
            const int jt = 2 * w + a;
            kt[a][s2] = tr_pair(tr_frag(sK + (jt >> 2) * 8192, 32 * s2, jt & 3, g, lr), tr_frag(sK + (jt >> 2) * 8192, 32 * s2 + 16, jt & 3, g, lr));
        }
    f32x4 wg4[4];
#pragma unroll
    for (int j = 0; j < 4; ++j) wg4[j] = *(const f32x4*)(ga + 16 * j + 4 * g);
#define MA_TILE(c, lo0, hi0, lo1, hi1) { \
        { const f32x4 w0 = wg4[0], w1 = wg4[1]; uint4 o; \
          o.x = cvt_pk_bf16(bflo(lo0.x) * w0[0], bfhi(lo0.x) * w0[1]); o.y = cvt_pk_bf16(bflo(lo0.y) * w0[2], bfhi(lo0.y) * w0[3]); \
          o.z = cvt_pk_bf16(bflo(hi0.x) * w1[0], bfhi(hi0.x) * w1[1]); o.w = cvt_pk_bf16(bflo(hi0.y) * w1[2], bfhi(hi0.y) * w1[3]); \
          const bf16x8 vw = __builtin_bit_cast(bf16x8, o); \
          Ct[0][c] = __builtin_amdgcn_mfma_f32_16x16x32_bf16(kt[0][0], vw, Ct[0][c], 0, 0, 0); Ct[1][c] = __builtin_amdgcn_mfma_f32_16x16x32_bf16(kt[1][0], vw, Ct[1][c], 0, 0, 0); } \
        { const f32x4 w0 = wg4[2], w1 = wg4[3]; uint4 o; \
          o.x = cvt_pk_bf16(bflo(lo1.x) * w0[0], bfhi(lo1.x) * w0[1]); o.y = cvt_pk_bf16(bflo(lo1.y) * w0[2], bfhi(lo1.y) * w0[3]); \
          o.z = cvt_pk_bf16(bflo(hi1.x) * w1[0], bfhi(hi1.x) * w1[1]); o.w = cvt_pk_bf16(bflo(hi1.y) * w1[2], bfhi(hi1.y) * w1[3]); \
          const bf16x8 vw = __builtin_bit_cast(bf16x8, o); \
          Ct[0][c] = __builtin_amdgcn_mfma_f32_16x16x32_bf16(kt[0][1], vw, Ct[0][c], 0, 0, 0); Ct[1][c] = __builtin_amdgcn_mfma_f32_16x16x32_bf16(kt[1][1], vw, Ct[1][c], 0, 0, 0); } }
    {
        uint2 vr[4][4];
        tr_read_4c(sV, g, lr, vr);
        MA_TILE(0, vr[0][0], vr[0][1], vr[0][2], vr[0][3]) MA_TILE(1, vr[1][0], vr[1][1], vr[1][2], vr[1][3])
        MA_TILE(2, vr[2][0], vr[2][1], vr[2][2], vr[2][3]) MA_TILE(3, vr[3][0], vr[3][1], vr[3][2], vr[3][3])
        tr_read_4c(sV + 8192, g, lr, vr);
        MA_TILE(4, vr[0][0], vr[0][1], vr[0][2], vr[0][3]) MA_TILE(5, vr[1][0], vr[1][1], vr[1][2], vr[1][3])
        MA_TILE(6, vr[2][0], vr[2][1], vr[2][2], vr[2][3]) MA_TILE(7, vr[3][0], vr[3][1], vr[3][2], vr[3][3])
        const uint2 o0 = tr_frag(sV + 16384, 0, 0, g, lr), o1 = tr_frag(sV + 16384, 16, 0, g, lr), o2 = tr_frag(sV + 16384, 32, 0, g, lr), o3 = tr_frag(sV + 16384, 48, 0, g, lr);
        MA_TILE(8, o0, o1, o2, o3)
    }
#undef MA_TILE
    unsigned char* slot = P.ws + WS_MST + ((size_t)bh * 33 + k) * ST_IMG;
#pragma unroll
    for (int a = 0; a < 2; ++a)
#pragma unroll
        for (int c = 0; c < 9; ++c) {
            uint2 u; u.x = cvt_pk_bf16(Ct[a][c][0], Ct[a][c][1]); u.y = cvt_pk_bf16(Ct[a][c][2], Ct[a][c][3]);
            *(uint2*)(slot + st_piece_off(2 * w + a, c, g, lr)) = u;
        }
}

__device__ __forceinline__ void mlstm_B(const Params& P, int item) {
    const int tid = threadIdx.x;
    const int bh = item / 3, part = item - bh * 3;
    const unsigned char* base = P.ws + WS_MST + (size_t)bh * 33 * ST_IMG + part * 12288 + tid * 48;
    unsigned char* obase = P.ws + WS_CBI + (size_t)bh * 33 * ST_IMG + part * 12288 + tid * 48;
    float* msc = (float*)(P.ws + WS_MSC) + (size_t)bh * 33 * 4;
    float C[6][4];
#pragma unroll
    for (int i = 0; i < 6; ++i)
#pragma unroll
        for (int r = 0; r < 4; ++r) C[i][r] = 0.f;
    float m = 0.f;
    uint2 d0[6], d1[6];
    float2 ab0, ab1;
#pragma unroll
    for (int i = 0; i < 6; ++i) { d0[i] = *(const uint2*)(base + i * 8); d1[i] = *(const uint2*)(base + ST_IMG + i * 8); }
    ab0 = *(const float2*)(msc); ab1 = *(const float2*)(msc + 4);
    for (int k = 0; k < 33; ++k) {
        uint2 d2[6]; float2 ab2 = make_float2(0.f, 0.f);
        if (k + 2 < 33) {
#pragma unroll
            for (int i = 0; i < 6; ++i) d2[i] = *(const uint2*)(base + (size_t)(k + 2) * ST_IMG + i * 8);
            ab2 = *(const float2*)(msc + (k + 2) * 4);
        } else {
#pragma unroll
            for (int i = 0; i < 6; ++i) d2[i] = make_uint2(0, 0);
        }
#pragma unroll
        for (int i = 0; i < 6; ++i) {
            uint2 u; u.x = cvt_pk_bf16(C[i][0], C[i][1]); u.y = cvt_pk_bf16(C[i][2], C[i][3]);
            *(uint2*)(obase + (size_t)k * ST_IMG + i * 8) = u;
        }
        if (tid == 0 && part == 0) msc[k * 4 + 2] = m;
        const float M = fmaxf(m, ab0.x);
        const float decay = __expf(m - M), sc = __expf(ab0.x - M);
#pragma unroll
        for (int i = 0; i < 6; ++i) {
            C[i][0] = decay * C[i][0] + sc * bflo(d0[i].x); C[i][1] = decay * C[i][1] + sc * bfhi(d0[i].x);
            C[i][2] = decay * C[i][2] + sc * bflo(d0[i].y); C[i][3] = decay * C[i][3] + sc * bfhi(d0[i].y);
        }
        m = ab0.y + M;
#pragma unroll
        for (int i = 0; i < 6; ++i) { d0[i] = d1[i]; d1[i] = d2[i]; }
        ab0 = ab1; ab1 = ab2;
    }
}

__device__ __forceinline__ void mlstm_C(const Params& P, int item, unsigned char* smem) {
    const int tid = threadIdx.x, lane = tid & 63, w = tid >> 6, g = lane >> 4, lr = lane & 15;
    const int wu = __builtin_amdgcn_readfirstlane(w);
    const int k = item >> 5, bh = item & 31, b = bh >> 2, h = bh & 3;
    const bf16_t* z = (const bf16_t*)(P.ws + WS_Z);
    const bf16_t* qk = (const bf16_t*)(P.ws + WS_RA);
    const float* gates = (const float*)(P.ws + WS_GATES);
    bf16_t* y = (bf16_t*)(P.ws + WS_Z);
    const unsigned char* sK = smem; const unsigned char* sV = smem + 36864; unsigned char* sCb = smem;
    float* ga = (float*)(smem + 61440);
    const int pos = 64 * k + 16 * w + lr;
    const bool tvalid = pos < L;
    const size_t rrow = (size_t)(b * L + (tvalid ? pos : 0));
    const unsigned char* cslot = P.ws + WS_CBI + ((size_t)bh * 33 + k) * ST_IMG + tid * 16;
    const uint4 cb0 = *(const uint4*)(cslot), cb1 = *(const uint4*)(cslot + 4096), cb2 = *(const uint4*)(cslot + 8192), cb3 = *(const uint4*)(cslot + 12288), cb4 = *(const uint4*)(cslot + 16384),
                cb5 = *(const uint4*)(cslot + 20480), cb6 = *(const uint4*)(cslot + 24576), cb7 = *(const uint4*)(cslot + 28672), cb8 = *(const uint4*)(cslot + 32768);
    bf16x8 qf[4];
    {
        const bf16_t* qp = qk + rrow * 1024 + h * 128 + 8 * g;
#pragma unroll
        for (int ks = 0; ks < 4; ++ks) { qf[ks] = *(const bf16x8*)(qp + 32 * ks); if (!tvalid) qf[ks] = (bf16x8){0, 0, 0, 0, 0, 0, 0, 0}; }
    }
    mlstm_stage_kv(P, b, h, k, smem, smem + 36864, tid);
    if (wu == 0) {
        const float m_prev = ((const float*)(P.ws + WS_MSC))[((size_t)bh * 33 + k) * 4 + 2];
        const int p2 = 64 * k + lane;
        float lf = 0.f, li = -INFINITY;
        if (p2 < L) { lf = gates[(size_t)(b * L + p2) * 16 + 4 + h]; li = gates[(size_t)(b * L + p2) * 16 + h]; }
        float bc = lf;
#pragma unroll
        for (int o = 1; o < 64; o <<= 1) { const float n = __shfl_up(bc, o, 64); if (lane >= o) bc += n; }
        const float a = li - bc;
        float am = a;
#pragma unroll
        for (int o = 1; o < 64; o <<= 1) { const float n = __shfl_up(am, o, 64); if (lane >= o) am = fmaxf(am, n); }
        const float M = fmaxf(m_prev, am);
        ga[lane] = a; ga[64 + lane] = __expf(m_prev - M); ga[128 + lane] = __expf(-(bc + M)); ga[192 + lane] = M;
    }
    __syncthreads();
    const float Mt = ga[192 + 16 * w + lr], Wi = ga[64 + 16 * w + lr], Et = ga[128 + 16 * w + lr];
    bf16x8 pf[2];
    {
        f32x4 sa[4];
#pragma unroll
        for (int c = 0; c < 4; ++c) {
            sa[c] = (f32x4){0.f, 0.f, 0.f, 0.f};
            if (c <= wu) {
#pragma unroll
                for (int ks = 0; ks < 4; ++ks) {
                    const bf16x8 kf = *(const bf16x8*)(sK + (ks >> 1) * 8192 + vimg_off(16 * c + lr, 4 * (ks & 1) + g));
                    sa[c] = __builtin_amdgcn_mfma_f32_16x16x32_bf16(kf, qf[ks], sa[c], 0, 0, 0);
                }
                const f32x4 av = *(const f32x4*)(ga + 16 * c + 4 * g);
#pragma unroll
                for (int r = 0; r < 4; ++r) {
                    const float d = __expf(av[r] - Mt);
                    sa[c][r] = (16 * c + 4 * g + r <= 16 * w + lr) ? sa[c][r] * d : 0.f;
                }
            }
        }
#pragma unroll
        for (int s2 = 0; s2 < 2; ++s2) {
            uint4 u;
            u.x = cvt_pk_bf16(sa[2 * s2][0], sa[2 * s2][1]); u.y = cvt_pk_bf16(sa[2 * s2][2], sa[2 * s2][3]);
            u.z = cvt_pk_bf16(sa[2 * s2 + 1][0], sa[2 * s2 + 1][1]); u.w = cvt_pk_bf16(sa[2 * s2 + 1][2], sa[2 * s2 + 1][3]);
            pf[s2] = __builtin_bit_cast(bf16x8, u);
        }
    }
    __syncthreads();
    {
        unsigned char* d = sCb + tid * 16;
        *(uint4*)(d) = cb0; *(uint4*)(d + 4096) = cb1; *(uint4*)(d + 8192) = cb2; *(uint4*)(d + 12288) = cb3; *(uint4*)(d + 16384) = cb4;
        *(uint4*)(d + 20480) = cb5; *(uint4*)(d + 24576) = cb6; *(uint4*)(d + 28672) = cb7; *(uint4*)(d + 32768) = cb8;
    }
    __syncthreads();
    f32x4 na[9];
#define MC_TILE(c, lo0, hi0, lo1, hi1) { \
        na[c] = (f32x4){0.f, 0.f, 0.f, 0.f}; \
        _Pragma("unroll") for (int ks = 0; ks < 4; ++ks) { \
            const bf16x8 cf = *(const bf16x8*)(sCb + (ks >> 1) * 18432 + vimg_off(16 * (c) + lr, 4 * (ks & 1) + g)); \
            na[c] = __builtin_amdgcn_mfma_f32_16x16x32_bf16(cf, qf[ks], na[c], 0, 0, 0); } \
        na[c] *= Wi; \
        na[c] = __builtin_amdgcn_mfma_f32_16x16x32_bf16(tr_pair(lo0, hi0), pf[0], na[c], 0, 0, 0); \
        na[c] = __builtin_amdgcn_mfma_f32_16x16x32_bf16(tr_pair(lo1, hi1), pf[1], na[c], 0, 0, 0); }
    {
        uint2 vr[4][4];
        tr_read_4c(sV, g, lr, vr);
        MC_TILE(0, vr[0][0], vr[0][1], vr[0][2], vr[0][3]) MC_TILE(1, vr[1][0], vr[1][1], vr[1][2], vr[1][3])
        MC_TILE(2, vr[2][0], vr[2][1], vr[2][2], vr[2][3]) MC_TILE(3, vr[3][0], vr[3][1], vr[3][2], vr[3][3])
        tr_read_4c(sV + 8192, g, lr, vr);
        MC_TILE(4, vr[0][0], vr[0][1], vr[0][2], vr[0][3]) MC_TILE(5, vr[1][0], vr[1][1], vr[1][2], vr[1][3])
        MC_TILE(6, vr[2][0], vr[2][1], vr[2][2], vr[2][3]) MC_TILE(7, vr[3][0], vr[3][1], vr[3][2], vr[3][3])
        const uint2 o0 = tr_frag(sV + 16384, 0, 0, g, lr), o1 = tr_frag(sV + 16384, 16, 0, g, lr), o2 = tr_frag(sV + 16384, 32, 0, g, lr), o3 = tr_frag(sV + 16384, 48, 0, g, lr);
        MC_TILE(8, o0, o1, o2, o3)
    }
#undef MC_TILE
    const float den = __shfl(na[8][0], lr, 64);
    const float rden = 1.0f / fmaxf(fabsf(den), Et);
    float hs = 0.f;
#pragma unroll
    for (int c = 0; c < 8; ++c) { na[c] *= rden; hs += na[c][0] * na[c][0] + na[c][1] * na[c][1] + na[c][2] * na[c][2] + na[c][3] * na[c][3]; }
    hs += __shfl_xor(hs, 16, 64); hs += __shfl_xor(hs, 32, 64);
    const float rstd = rsqrtf(hs * (1.0f / 128.0f) + EPS);
    const float* gainp = P.m_out_norm + h * 128 + 4 * g;
#pragma unroll
    for (int c = 0; c < 8; ++c) {
        const uint2 og = *(const uint2*)(z + rrow * NZ + ZC_MO + h * 128 + 16 * c + 4 * g);
        const float o0 = bflo(og.x), o1 = bfhi(og.x), o2 = bflo(og.y), o3 = bfhi(og.y);
        const float4 gn = *(const float4*)(gainp + 16 * c);
        uint2 u;
        u.x = pk2(na[c][0] * rstd * gn.x / (1.f + __expf(-o0)), na[c][1] * rstd * gn.y / (1.f + __expf(-o1)));
        u.y = pk2(na[c][2] * rstd * gn.z / (1.f + __expf(-o2)), na[c][3] * rstd * gn.w / (1.f + __expf(-o3)));
        if (tvalid) *(uint2*)(y + rrow * NZ + h * 128 + 16 * c + 4 * g) = u;
    }
}

__device__ __forceinline__ void peer_token(const Params& P, int t, int lane, int* sidx, float* sval, int* sid, float* sgate, const unsigned char* slut, const unsigned* szero) {
    const unsigned* tk = (const unsigned*)(P.ws + WS_TK) + (size_t)t * 256;
#pragma unroll
    for (int i = 0; i < 4; ++i) {
        const unsigned k = tk[lane * 4 + i];
        sidx[lane * 4 + i] = 127 - (int)(k & 127u);
        sval[lane * 4 + i] = unord_key(k & ~127u);
    }
    __builtin_amdgcn_s_waitcnt(0xc07f);
    __builtin_amdgcn_wave_barrier();
    {
        const int hd = lane >> 3, sub = lane & 7;
        unsigned x[8];
#pragma unroll
        for (int r = 0; r < 8; ++r) {
            const int c = sub * 8 + r;
            const unsigned ij = slut[c < 50 ? c : 0];
            const int i = ij >> 4, j = ij & 15;
            const unsigned kx = (ord_key(sval[(2 * hd) * 16 + i] + sval[(2 * hd + 1) * 16 + j]) & ~255u) | (unsigned)(255 - (i * 16 + j));
            x[r] = c < 50 ? kx : 0u;
        }
#pragma unroll
        for (int k = 2; k <= 64; k <<= 1) {
#pragma unroll
            for (int j = k >> 1; j >= 1; j >>= 1) {
                if (j >= 8) {
                    const int ld = j >> 3;
                    const bool lower = (sub & ld) == 0;
                    const bool desc = k >= 64 ? true : ((sub * 8) & k) == 0;
                    const bool takemax = (lower == desc);
#pragma unroll
                    for (int r = 0; r < 8; ++r) {
                        const unsigned o = (unsigned)__shfl_xor((int)x[r], ld, 64);
                        const unsigned hi = max(x[r], o), lo = min(x[r], o);
                        x[r] = takemax ? hi : lo;
                    }
                } else {
#pragma unroll
                    for (int r = 0; r < 8; ++r) {
                        if ((r & j) == 0) {
                            const int p = r | j;
                            const unsigned hi = max(x[r], x[p]), lo = min(x[r], x[p]);
                            if (k <= 4) { const bool desc = (r & k) == 0; x[r] = desc ? hi : lo; x[p] = desc ? lo : hi; }
                            else if (k >= 64) { x[r] = hi; x[p] = lo; }
                            else { const bool desc = ((sub * 8) & k) == 0; x[r] = desc ? hi : lo; x[p] = desc ? lo : hi; }
                        }
                    }
                }
            }
        }
        const float smax = unord_key((unsigned)__shfl((int)x[0], hd * 8, 64) & ~255u);
        float e[8]; float den = 0.f;
#pragma unroll
        for (int r = 0; r < 8; ++r) { e[r] = __expf(unord_key(x[r] & ~255u) - smax); den += e[r]; }
        den += __shfl_xor(den, 1, 64);
        const float inv = 1.f / den;
        if (sub < 2) {
#pragma unroll
            for (int r = 0; r < 8; ++r) {
                const int pos = 255 - (int)(x[r] & 255u), i = pos >> 4, j = pos & 15;
                sid[hd * 16 + sub * 8 + r] = sidx[(2 * hd) * 16 + i] * 128 + sidx[(2 * hd + 1) * 16 + j];
                sgate[hd * 16 + sub * 8 + r] = e[r] * inv;
            }
        }
    }
    __builtin_amdgcn_s_waitcnt(0xc07f);
    __builtin_amdgcn_wave_barrier();
    const bf16_t* xn = (const bf16_t*)(P.ws + WS_XN) + (size_t)t * DM;
    const float rstd = ((const float*)(P.ws + WS_RSTD))[t];
    const unsigned char* V = P.ws + WS_V + lane * 8;
    const float* usc = (const float*)(P.ws + WS_USC);
    const float* vsc = (const float*)(P.ws + WS_VSC);
    const int g = lane >> 4, lr = lane & 15;
    unsigned char* shi = (unsigned char*)sval;
    unsigned char* slo = (unsigned char*)sidx;
    {
        const uint4 xa = *(const uint4*)(xn + lane * 16), xb = *(const uint4*)(xn + lane * 16 + 8);
        const unsigned xw[8] = {xa.x, xa.y, xa.z, xa.w, xb.x, xb.y, xb.z, xb.w};
        unsigned hi[4], lo[4];
#pragma unroll
        for (int i = 0; i < 4; ++i) {
            const float x0 = bflo(xw[2 * i]), x1 = bfhi(xw[2 * i]), x2 = bflo(xw[2 * i + 1]), x3 = bfhi(xw[2 * i + 1]);
            int wd = 0;
            wd = __builtin_amdgcn_cvt_pk_fp8_f32(x0, x1, wd, false);
            wd = __builtin_amdgcn_cvt_pk_fp8_f32(x2, x3, wd, true);
            const f32x2 h01 = __builtin_amdgcn_cvt_pk_f32_fp8(wd, false), h23 = __builtin_amdgcn_cvt_pk_f32_fp8(wd, true);
            int wl = 0;
            wl = __builtin_amdgcn_cvt_pk_fp8_f32(x0 - h01.x, x1 - h01.y, wl, false);
            wl = __builtin_amdgcn_cvt_pk_fp8_f32(x2 - h23.x, x3 - h23.y, wl, true);
            hi[i] = (unsigned)wd; lo[i] = (unsigned)wl;
        }
        *(uint4*)(shi + lane * 16) = make_uint4(hi[0], hi[1], hi[2], hi[3]);
        *(uint4*)(slo + lane * 16) = make_uint4(lo[0], lo[1], lo[2], lo[3]);
    }
    __builtin_amdgcn_s_waitcnt(0xc07f);
    __builtin_amdgcn_wave_barrier();
    {
        typedef int v8i __attribute__((ext_vector_type(8)));
        const unsigned char* Ub = P.ws + WS_U + 16 * g;
        const unsigned char* bsrc = (lr == 0) ? (shi + 16 * g) : (lr == 1) ? (slo + 16 * g) : (const unsigned char*)szero;
        const int bstep = (lr < 2) ? 128 : 0, bhalf = (lr < 2) ? 64 : 16;
        v8i Bv[8];
#pragma unroll
        for (int st = 0; st < 8; ++st) {
            const uint4 b0 = *(const uint4*)(bsrc + bstep * st), b1 = *(const uint4*)(bsrc + bstep * st + bhalf);
            Bv[st] = (v8i){(int)b0.x, (int)b0.y, (int)b0.z, (int)b0.w, (int)b1.x, (int)b1.y, (int)b1.z, (int)b1.w};
        }
        unsigned off[8];
#pragma unroll
        for (int T = 0; T < 8; ++T) off[T] = (unsigned)sid[16 * T + lr] * 512u;
        __builtin_amdgcn_s_waitcnt(0xc07f);
        __builtin_amdgcn_wave_barrier();
        float* sact = (float*)sidx + ((lr == 1) ? 128 : 0);
        uint4 abuf[2][8];
#pragma unroll
        for (int st = 0; st < 8; ++st) abuf[0][st] = *(const uint4*)(Ub + off[0] + 64 * st);
#pragma unroll
        for (int T = 0; T < 8; ++T) {
            if (T + 1 < 8) {
#pragma unroll
                for (int st = 0; st < 8; ++st) abuf[(T + 1) & 1][st] = *(const uint4*)(Ub + off[T + 1] + 64 * st);
            }
            f32x4 au = (f32x4){0.f, 0.f, 0.f, 0.f};
#pragma unroll
            for (int st = 0; st < 8; ++st) {
                const uint4 a4 = abuf[T & 1][st];
                const v8i Av = {(int)a4.x, (int)a4.y, (int)a4.z, (int)a4.w, 0, 0, 0, 0};
                au = __builtin_amdgcn_mfma_scale_f32_16x16x128_f8f6f4(Av, Bv[st], au, 4, 0, 0, 0x7f7f7f7f, 0, 0x7f7f7f7f);
            }
            if (lr < 2) *(f32x4*)(sact + 16 * T + 4 * g) = au;
        }
    }
    __builtin_amdgcn_s_waitcnt(0xc07f);
    __builtin_amdgcn_wave_barrier();
    {
        float* sw = (float*)sidx;
        float wv[2];
#pragma unroll
        for (int hh = 0; hh < 2; ++hh) {
            const int e = lane + 64 * hh, id = sid[e];
            const float a = (sw[e] + sw[128 + e]) * usc[id] * rstd;
            wv[hh] = sgate[e] * vsc[id] * 0.5f * a * (1.f + erff(a * 0.70710678118654752f));
        }
        sw[lane] = wv[0]; sw[lane + 64] = wv[1];
    }
    __builtin_amdgcn_s_waitcnt(0xc07f);
    __builtin_amdgcn_wave_barrier();
    f32x2 acc[8];
#pragma unroll
    for (int j = 0; j < 8; ++j) acc[j] = (f32x2){0.f, 0.f};
#pragma unroll 1
    for (int e0 = 0; e0 < 128; e0 += 16) {
        uint2 vr[16];
#pragma unroll
        for (int q = 0; q < 16; ++q) vr[q] = *(const uint2*)(V + (size_t)sid[e0 + q] * 512);
        const float* sw = (const float*)sidx + e0;
        const f32x4 w0 = *(const f32x4*)(sw), w1 = *(const f32x4*)(sw + 4), w2 = *(const f32x4*)(sw + 8), w3 = *(const f32x4*)(sw + 12);
        const float wq[16] = {w0[0], w0[1], w0[2], w0[3], w1[0], w1[1], w1[2], w1[3], w2[0], w2[1], w2[2], w2[3], w3[0], w3[1], w3[2], w3[3]};
#pragma unroll
        for (int q = 0; q < 16; ++q) {
            const float w = wq[q];
#define FP4_AXPY(k) { acc[k] += w * __builtin_amdgcn_cvt_scalef32_pk_f32_fp4(vr[q].x, 1.0f, k); acc[4 + k] += w * __builtin_amdgcn_cvt_scalef32_pk_f32_fp4(vr[q].y, 1.0f, k); }
            FP4_AXPY(0) FP4_AXPY(1) FP4_AXPY(2) FP4_AXPY(3)
#undef FP4_AXPY
        }
    }
    f32x2 xf[8];
    {
        const uint4 xa = *(const uint4*)(xn + lane * 16), xb = *(const uint4*)(xn + lane * 16 + 8);
        xf[0] = (f32x2){bflo(xa.x), bfhi(xa.x)}; xf[1] = (f32x2){bflo(xa.y), bfhi(xa.y)}; xf[2] = (f32x2){bflo(xa.z), bfhi(xa.z)}; xf[3] = (f32x2){bflo(xa.w), bfhi(xa.w)};
        xf[4] = (f32x2){bflo(xb.x), bfhi(xb.x)}; xf[5] = (f32x2){bflo(xb.y), bfhi(xb.y)}; xf[6] = (f32x2){bflo(xb.z), bfhi(xb.z)}; xf[7] = (f32x2){bflo(xb.w), bfhi(xb.w)};
    }
    float* o = P.out + (size_t)t * DM + lane * 16;
    float4 h0, h1, h2, h3;
    {
        const float4 g0 = *(const float4*)(P.norm_ffn + lane * 16), g1 = *(const float4*)(P.norm_ffn + lane * 16 + 4), g2 = *(const float4*)(P.norm_ffn + lane * 16 + 8), g3 = *(const float4*)(P.norm_ffn + lane * 16 + 12);
        h0.x = xf[0].x / g0.x + acc[0].x; h0.y = xf[0].y / g0.y + acc[0].y; h0.z = xf[1].x / g0.z + acc[1].x; h0.w = xf[1].y / g0.w + acc[1].y;
        h1.x = xf[2].x / g1.x + acc[2].x; h1.y = xf[2].y / g1.y + acc[2].y; h1.z = xf[3].x / g1.z + acc[3].x; h1.w = xf[3].y / g1.w + acc[3].y;
        h2.x = xf[4].x / g2.x + acc[4].x; h2.y = xf[4].y / g2.y + acc[4].y; h2.z = xf[5].x / g2.z + acc[5].x; h2.w = xf[5].y / g2.w + acc[5].y;
        h3.x = xf[6].x / g3.x + acc[6].x; h3.y = xf[6].y / g3.y + acc[6].y; h3.z = xf[7].x / g3.z + acc[7].x; h3.w = xf[7].y / g3.w + acc[7].y;
    }
    *(float4*)(o) = h0; *(float4*)(o + 4) = h1; *(float4*)(o + 8) = h2; *(float4*)(o + 12) = h3;
    __builtin_amdgcn_s_waitcnt(0xc07f);
    __builtin_amdgcn_wave_barrier();
}

#define LAS __attribute__((address_space(3)))
#define XB_TMO      128
#define XB_XCNT(j)  (256  + 64 * (j))
#define XB_XSUB(j)  (1280 + 64 * (j))
#define XB_XGEN(j)  (2304 + 64 * (j))
#define XB_TOP      3328
#define XB_TOPGEN   3392
#define XCD_BAR_WORDS 3456
#define XB_SPIN_CAP (1u << 18)
__device__ __forceinline__ unsigned xb_ld(unsigned* p)              { return __hip_atomic_load(p, __ATOMIC_RELAXED, __HIP_MEMORY_SCOPE_AGENT); }
__device__ __forceinline__ unsigned xb_add(unsigned* p, unsigned v) { return __hip_atomic_fetch_add(p, v, __ATOMIC_RELAXED, __HIP_MEMORY_SCOPE_AGENT); }
__device__ __forceinline__ unsigned xb_xcc_id() { return (unsigned)__builtin_amdgcn_s_getreg((3 << 11) | 20) & 0xFu; }
#define XB_SPIN(cond, bar) do { unsigned _sp = 0; while (cond) { __builtin_amdgcn_s_sleep(1); \
    if ((++_sp & 255u) == 0u) { if (xb_ld(&(bar)[XB_TMO])) break; if (_sp > XB_SPIN_CAP) { atomicAdd(&(bar)[XB_TMO], 1u); break; } } } } while (0)
struct XcdBarrier { unsigned* bar; unsigned x; volatile LAS unsigned* st; };
__device__ __forceinline__ XcdBarrier xcd_barrier_post(unsigned* bar, volatile LAS unsigned* st) {
    XcdBarrier b; b.bar = bar; b.x = xb_xcc_id(); b.st = st;
    if (threadIdx.x == 0) (void)xb_add(&bar[XB_XCNT(b.x)], 1u);
    return b;
}
__device__ __forceinline__ void xcd_barrier_complete(unsigned* bar, unsigned x, unsigned& nloc, unsigned& nx) {
    const unsigned G = gridDim.x * gridDim.y * gridDim.z;
    unsigned sum, cnt, mine, sp = 0u;
    for (;;) {
        sum = 0u; cnt = 0u; mine = 0u;
#pragma unroll
        for (unsigned j = 0; j < 16; ++j) { const unsigned c = xb_ld(&bar[XB_XCNT(j)]); sum += c; cnt += (c > 0u) ? 1u : 0u; mine = (j == x) ? c : mine; }
        if (sum == G) break;
        __builtin_amdgcn_s_sleep(1);
        if ((++sp & 255u) == 0u) { if (xb_ld(&bar[XB_TMO])) break; if (sp > XB_SPIN_CAP) { atomicAdd(&bar[XB_TMO], 1u); break; } }
    }
    nloc = mine > 0u ? mine : 1u; nx = cnt > 0u ? cnt : 1u;
}
__device__ __forceinline__ void xcd_barrier(const XcdBarrier& b) {
    asm volatile("s_waitcnt vmcnt(0)" ::: "memory");
    __syncthreads();
    if (threadIdx.x == 0) {
        unsigned* bar = b.bar;
        __builtin_amdgcn_s_waitcnt(0);
        unsigned nloc = b.st[0], nx = b.st[1];
        if (nloc == 0u) { xcd_barrier_complete(bar, b.x, nloc, nx); b.st[0] = nloc; b.st[1] = nx; }
        const unsigned old = xb_add(&bar[XB_XSUB(b.x)], 1u);
        const unsigned gen = old / nloc;
        if (old + 1u == (gen + 1u) * nloc) {
            __builtin_amdgcn_fence(__ATOMIC_RELEASE, "agent");
            asm volatile("s_waitcnt vmcnt(0)" ::: "memory");
            const unsigned og = xb_add(&bar[XB_TOP], 1u);
            const unsigned tg = og / nx;
            if (og + 1u == (tg + 1u) * nx) xb_add(&bar[XB_TOPGEN], 1u);
            else XB_SPIN(xb_ld(&bar[XB_TOPGEN]) == tg, bar);
            __builtin_amdgcn_fence(__ATOMIC_ACQUIRE, "agent");
            xb_add(&bar[XB_XGEN(b.x)], 1u);
            asm volatile("s_waitcnt vmcnt(0)" ::: "memory");
        } else {
            XB_SPIN(xb_ld(&bar[XB_XGEN(b.x)]) == gen, bar);
            __builtin_amdgcn_fence(__ATOMIC_ACQUIRE, "agent");
            asm volatile("s_waitcnt vmcnt(0)" ::: "memory");
        }
    }
    __syncthreads();
}

__device__ __forceinline__ void hand_release() { asm volatile("s_waitcnt vmcnt(0)" ::: "memory"); __builtin_amdgcn_fence(__ATOMIC_RELEASE, "agent"); asm volatile("s_waitcnt vmcnt(0)" ::: "memory"); }
__device__ __forceinline__ void hand_acquire() { __builtin_amdgcn_fence(__ATOMIC_ACQUIRE, "agent"); asm volatile("s_waitcnt vmcnt(0)" ::: "memory"); }

__global__ void __launch_bounds__(256, 2) mega(Params P) {
    extern __shared__ __attribute__((aligned(16))) unsigned char smem[];
    const int tid = threadIdx.x, lane = tid & 63, wave = tid >> 6;
    const int G = gridDim.x, bid = blockIdx.x;
    unsigned* ctl = (unsigned*)(P.ws + WS_CTL);
    volatile LAS unsigned* bst = (volatile LAS unsigned*)(smem + 65552);
    if (tid == 0) { bst[0] = 0u; bst[1] = 0u; }
    __syncthreads();
    const XcdBarrier xb = xcd_barrier_post(ctl + 1024, bst);
    unsigned* cucnt = ctl + 5120;
    if (tid == 0) {
        const unsigned phys = ((xb_xcc_id() & 7u) << 8) | ((unsigned)__builtin_amdgcn_s_getreg((7 << 11) | (8 << 6) | 4) & 0xFFu);
        bst[2] = phys; bst[3] = xb_add(&cucnt[phys], 1u);
    }
    phase0(P, smem);
    xcd_barrier(xb);
    {
        int vb;
        const unsigned phys = bst[2];
        unsigned part = 0;
#pragma unroll
        for (int q = 0; q < 8; ++q) { const unsigned i = (unsigned)(tid + 256 * q); const unsigned c = xb_ld(&cucnt[i]); part += (i < phys) ? c : 0u; }
#pragma unroll
        for (int o = 1; o < 64; o <<= 1) part += (unsigned)__shfl_xor((int)part, o, 64);
        if (lane == 0) bst[4 + wave] = part;
        __syncthreads();
        vb = (int)(bst[4] + bst[5] + bst[6] + bst[7] + bst[3]);
        vb = __builtin_amdgcn_readfirstlane(vb);
        if (vb < 0 || vb >= G) vb = bid;
        __syncthreads();
        if (tid == 0) bst[8] = (unsigned)vb;
        __syncthreads();
    }
#define VB_LOAD() __builtin_amdgcn_readfirstlane((int)bst[8])
    {
        const int gw = bid * 4 + wave;
        if (gw < 64) fox_cum_wave(P, gw, lane);
        const int vb = VB_LOAD();
        for (int tile = vb; tile < 129 * 28; tile += G) gemm_tile<1>(P, tile / 28, tile % 28, smem);
        {
            const int rem = (129 * 28) % G;
            if (rem > 0 && rem < G) { if (vb >= rem) convert_uv_rows(P, (vb - rem) * 4 + wave, (G - rem) * 4, lane); }
            else convert_uv_rows(P, vb * 4 + wave, G * 4, lane);
        }
    }
    xcd_barrier(xb);
    {
        volatile int* s_item = (volatile int*)(smem + 65536);
        const int wave_u = __builtin_amdgcn_readfirstlane(wave);
        auto fetch = [&](unsigned* counter) -> int {
            if (wave_u == 0) {
                unsigned v = atomicAdd(counter, lane == 0 ? 1u : 0u);
                *s_item = (int)__builtin_amdgcn_readfirstlane(v);
            }
            __syncthreads();
            const int item = __builtin_amdgcn_readfirstlane(*s_item);
            __syncthreads();
            return item;
        };
        for (;;) {
            const int item = fetch(&ctl[2]);
            if (item >= 33 * 32) break;
            mlstm_A(P, item, smem);
        }
        xcd_barrier(xb);
        for (;;) {
            const int item = fetch(&ctl[4]);
            if (item >= 96) break;
            mlstm_B(P, item);
        }
        for (;;) {
            const int item = fetch(&ctl[3]);
            if (item >= 64 * 17) break;
            attn_block(P, item & 63, 16 - (item >> 6), smem);
        }
        xcd_barrier(xb);
        for (;;) {
            const int item = fetch(&ctl[5]);
            if (item >= 33 * 32) break;
            mlstm_C(P, item, smem);
        }
    }
    xcd_barrier(xb);
    for (int tile = VB_LOAD(); tile < 128 * 8; tile += G) gemm_tile<2>(P, tile >> 3, tile & 7, smem);
    xcd_barrier(xb);
    for (int tile = VB_LOAD(); tile < 128 * 16; tile += G) gemm_tile<3>(P, tile >> 4, tile & 15, smem);
    xcd_barrier(xb);
    {
        unsigned char* slut = smem + 12288;
        if (tid < 64) {
            int c = tid, i = 0;
            while (i < 16 && c >= 16 / (i + 1)) { c -= 16 / (i + 1); ++i; }
            slut[tid] = (unsigned char)(i < 16 ? ((i << 4) | c) : 0);
        }
        unsigned* szero = (unsigned*)(smem + 12288 + 64);
        if (tid < 16) szero[tid] = 0u;
        __syncthreads();
        int* sidx = (int*)(smem + wave * 3072); float* sval = (float*)(smem + wave * 3072 + 1024);
        int* sid = (int*)(smem + wave * 3072 + 2048); float* sgate = (float*)(smem + wave * 3072 + 2560);
        int lane5 = lane;
        asm volatile("" : "+v"(lane5));
        for (int t = bid * 4 + wave; t < T2; t += G * 4) peer_token(P, t, lane5, sidx, sval, sid, sgate, slut, szero);
    }
}

}

extern "C" void kernel_launch(void* const* d_in, const int* in_sizes, int n_in, void* d_out, int out_size, void* d_ws, size_t ws_size, hipStream_t stream) {
    if (n_in != 17 || ws_size < WS_END) { fprintf(stderr, "kernel_launch: unexpected n_in %d or ws_size %zu (need %zu)\n", n_in, ws_size, (size_t)WS_END); return; }
    constexpr int LDS_BYTES = 66560;
    static int grid_blocks = 0;
    if (!grid_blocks) {
        int dev = 0, cus = 0, per_cu = 0;
        (void)hipGetDevice(&dev);
        (void)hipDeviceGetAttribute(&cus, hipDeviceAttributeMultiprocessorCount, dev);
        (void)hipFuncSetAttribute((const void*)mega, hipFuncAttributeMaxDynamicSharedMemorySize, LDS_BYTES);
        (void)hipOccupancyMaxActiveBlocksPerMultiprocessor(&per_cu, (const void*)mega, 256, LDS_BYTES);
        if (per_cu < 1) per_cu = 1;
        if (per_cu > 2) per_cu = 2;
        grid_blocks = cus * per_cu;
        fprintf(stderr, "kernel_launch: cus %d per_cu %d grid %d\n", cus, per_cu, grid_blocks);
    }
    Params P{};
    P.x = (const float*)d_in[0]; P.meta = (const float*)d_in[1]; P.norm_mix = (const float*)d_in[2]; P.w_in = (const float*)d_in[3];
    P.conv_qk = (const float*)d_in[4]; P.b_igate = (const float*)d_in[5]; P.b_fgate_m = (const float*)d_in[6]; P.m_out_norm = (const float*)d_in[7];
    P.b_fgate_f = (const float*)d_in[8]; P.f_q_norm = (const float*)d_in[9]; P.f_k_norm = (const float*)d_in[10]; P.w_out = (const float*)d_in[11];
    P.norm_ffn = (const float*)d_in[12]; P.peer_query = (const float*)d_in[13]; P.peer_keys = (const float*)d_in[14]; P.peer_u = (const float*)d_in[15];
    P.peer_v = (const float*)d_in[16]; P.out = (float*)d_out; P.ws = (unsigned char*)d_ws;
    (void)hipMemsetAsync((unsigned char*)d_ws + WS_CTL, 0, 32768, stream);
    void* args[] = {&P};
    hipError_t e = hipLaunchCooperativeKernel((const void*)mega, dim3(grid_blocks), dim3(256), args, LDS_BYTES, stream);
    if (e != hipSuccess) fprintf(stderr, "cooperative launch failed: %s (grid %d)\n", hipGetErrorString(e), grid_blocks);
}
```

```cpp
#include <hip/hip_runtime.h>
#include <stdint.h>
#include <stdio.h>
#include <hip/hip_cooperative_groups.h>
namespace cg = cooperative_groups;

namespace {

constexpr int NB = 8, SEQ = 2048, DM = 1024, NMETA = 16, L = SEQ + NMETA;
constexpr int T1 = NB * L;
constexpr int T2 = NB * SEQ;
constexpr int NZ = 3584;
constexpr int ZC_MQ = 0, ZC_MK = 512, ZC_MV = 1024, ZC_MO = 1536, ZC_FQ = 2048, ZC_FK = 2560, ZC_FV = 3072;
constexpr int PROJ = 3600;
constexpr float EPS = 1e-6f;

constexpr size_t WS_CTL = 0;
constexpr size_t WS_RA = 65536;
constexpr size_t WS_Z = WS_RA + (size_t)T1 * DM * 2;
constexpr size_t WS_GATES = WS_Z + (size_t)T1 * NZ * 2;
constexpr size_t WS_CUM = WS_GATES + (size_t)T1 * 16 * 4;
constexpr size_t WS_SSQ = WS_CUM + (size_t)NB * 8 * L * 4;
constexpr size_t WS_RSTD = WS_SSQ + (size_t)T2 * 16 * 4;
constexpr size_t WS_SSQM = WS_RSTD + (size_t)T2 * 4;
constexpr size_t WS_BT2 = WS_SSQM + (size_t)T1 * 16 * 4;
constexpr size_t WS_BT3 = WS_BT2 + (size_t)DM * DM * 2;
constexpr size_t WS_KEYS = WS_BT3 + (size_t)2048 * DM * 2;
constexpr size_t WS_MSC = WS_KEYS + (size_t)16 * 128 * 128 * 2;
constexpr size_t WS_MST = WS_MSC + (size_t)128 * 33 * 16;
constexpr size_t WS_BT1 = WS_MST + (size_t)32 * 33 * 36864;
constexpr size_t WS_CBI = WS_BT1;
constexpr size_t WS_UV = WS_CBI + (size_t)32 * 33 * 36864;
constexpr size_t WS_END = WS_UV + (size_t)2 * 16384 * 512 + (size_t)2 * 16384 * 4;
constexpr size_t WS_XN = WS_RA;
constexpr size_t WS_U = WS_UV;
constexpr size_t WS_V = WS_U + (size_t)16384 * 512;
constexpr size_t WS_USC = WS_V + (size_t)16384 * 512;
constexpr size_t WS_VSC = WS_USC + (size_t)16384 * 4;
constexpr size_t WS_TK = WS_CBI;
constexpr float LOG2E = 1.4426950408889634f;

typedef unsigned short bf16_t;
typedef short bf16x8 __attribute__((ext_vector_type(8)));
typedef float f32x4 __attribute__((ext_vector_type(4)));
typedef __attribute__((ext_vector_type(2))) __bf16 bf16x2_t;

struct Params {
    const float* x; const float* meta; const float* norm_mix; const float* w_in; const float* conv_qk;
    const float* b_igate; const float* b_fgate_m; const float* m_out_norm; const float* b_fgate_f;
    const float* f_q_norm; const float* f_k_norm; const float* w_out; const float* norm_ffn;
    const float* peer_query; const float* peer_keys; const float* peer_u; const float* peer_v;
    float* out; unsigned char* ws;
};

__device__ __forceinline__ unsigned f2bf(float f) { unsigned u = __float_as_uint(f); return (u + 0x7fffu + ((u >> 16) & 1u)) >> 16; }
__device__ __forceinline__ float bf2f(unsigned h) { return __uint_as_float(h << 16); }
typedef float f32x2 __attribute__((ext_vector_type(2)));
typedef __bf16 bf16x2v __attribute__((ext_vector_type(2)));
__device__ __forceinline__ unsigned cvt_pk_bf16(float lo, float hi) { f32x2 v = {lo, hi}; bf16x2v b = __builtin_convertvector(v, bf16x2v); return __builtin_bit_cast(unsigned, b); }
__device__ __forceinline__ unsigned pk2(float lo, float hi) { return cvt_pk_bf16(lo, hi); }
__device__ __forceinline__ float bflo(unsigned w) { return __uint_as_float(w << 16); }
__device__ __forceinline__ float bfhi(unsigned w) { return __uint_as_float(w & 0xffff0000u); }
__device__ __forceinline__ float wave_sum(float v) {
#pragma unroll
    for (int o = 32; o > 0; o >>= 1) v += __shfl_xor(v, o, 64);
    return v;
}
__device__ __forceinline__ float wave_max(float v) {
#pragma unroll
    for (int o = 32; o > 0; o >>= 1) v = fmaxf(v, __shfl_xor(v, o, 64));
    return v;
}
__device__ __forceinline__ float logsigmoidf(float x) { return fminf(x, 0.f) - log1pf(expf(-fabsf(x))); }
__device__ __forceinline__ unsigned ord_key(float f) { unsigned u = __float_as_uint(f); return u ^ ((u >> 31) ? 0xffffffffu : 0x80000000u); }
__device__ __forceinline__ float unord_key(unsigned k) { unsigned u = (k & 0x80000000u) ? (k ^ 0x80000000u) : ~k; return __uint_as_float(u); }

__device__ __forceinline__ void phase0(const Params& P, unsigned char* smem) {
    const int tid = threadIdx.x, lane = tid & 63, wave = tid >> 6;
    unsigned* ctl = (unsigned*)(P.ws + WS_CTL);
    float* gw = (float*)smem;
    for (int idx = tid; idx < 16 * 1024; idx += 256) {
        const int k = idx >> 4, c = idx & 15;
        const int col = c < 8 ? 2048 + c : 3592 + (c - 8);
        gw[c * 1024 + k] = P.w_in[(size_t)k * PROJ + col];
    }
    __syncthreads();
    {
        bf16_t* hn = (bf16_t*)(P.ws + WS_RA);
        float* gates = (float*)(P.ws + WS_GATES);
        const int c0 = lane * 8, c1 = 512 + lane * 8;
        float gm[16];
        {
            const float4 a0 = *(const float4*)(P.norm_mix + c0), a1 = *(const float4*)(P.norm_mix + c0 + 4);
            const float4 a2 = *(const float4*)(P.norm_mix + c1), a3 = *(const float4*)(P.norm_mix + c1 + 4);
            gm[0] = a0.x; gm[1] = a0.y; gm[2] = a0.z; gm[3] = a0.w; gm[4] = a1.x; gm[5] = a1.y; gm[6] = a1.z; gm[7] = a1.w;
            gm[8] = a2.x; gm[9] = a2.y; gm[10] = a2.z; gm[11] = a2.w; gm[12] = a3.x; gm[13] = a3.y; gm[14] = a3.z; gm[15] = a3.w;
        }
        const int myq = ((lane >> 5) & 1) * 8 + ((lane >> 4) & 1) * 4 + ((lane >> 3) & 1) * 2 + ((lane >> 2) & 1);
        const float mybias = myq < 4 ? P.b_igate[myq] : (myq < 8 ? P.b_fgate_m[myq - 4] : P.b_fgate_f[myq - 8]);
        const int rstep = gridDim.x * 4;
        int r = blockIdx.x * 4 + wave;
        float4 n0, n1, n2, n3;
        auto load_row = [&](int rr) {
            const int b = rr / L, p = rr - b * L;
            const float* src = (p < NMETA) ? (P.meta + (size_t)p * DM) : (P.x + ((size_t)b * SEQ + (p - NMETA)) * DM);
            n0 = *(const float4*)(src + c0); n1 = *(const float4*)(src + c0 + 4); n2 = *(const float4*)(src + c1); n3 = *(const float4*)(src + c1 + 4);
        };
        if (r < T1) load_row(r);
        for (; r < T1; r += rstep) {
            float v[16];
            v[0] = n0.x; v[1] = n0.y; v[2] = n0.z; v[3] = n0.w; v[4] = n1.x; v[5] = n1.y; v[6] = n1.z; v[7] = n1.w;
            v[8] = n2.x; v[9] = n2.y; v[10] = n2.z; v[11] = n2.w; v[12] = n3.x; v[13] = n3.y; v[14] = n3.z; v[15] = n3.w;
            if (r + rstep < T1) load_row(r + rstep);
            float ss = 0.f;
#pragma unroll
            for (int j = 0; j < 16; ++j) ss += v[j] * v[j];
            ss = wave_sum(ss);
            const float rstd = rsqrtf(ss * (1.0f / DM) + EPS);
#pragma unroll
            for (int j = 0; j < 16; ++j) v[j] *= rstd * gm[j];
            uint4 o0, o1;
            o0.x = pk2(v[0], v[1]); o0.y = pk2(v[2], v[3]); o0.z = pk2(v[4], v[5]); o0.w = pk2(v[6], v[7]);
            o1.x = pk2(v[8], v[9]); o1.y = pk2(v[10], v[11]); o1.z = pk2(v[12], v[13]); o1.w = pk2(v[14], v[15]);
            *(uint4*)(hn + (size_t)r * DM + c0) = o0;
            *(uint4*)(hn + (size_t)r * DM + c1) = o1;
            float r8[8], r4[4], r2[2], r1;
#pragma unroll
            for (int i = 0; i < 8; ++i) {
                float dd[2];
#pragma unroll
                for (int hh = 0; hh < 2; ++hh) {
                    const float* gwc = gw + (i + 8 * hh) * 1024;
                    const float4 w0 = *(const float4*)(gwc + c0), w1 = *(const float4*)(gwc + c0 + 4), w2 = *(const float4*)(gwc + c1), w3 = *(const float4*)(gwc + c1 + 4);
                    dd[hh] = v[0] * w0.x + v[1] * w0.y + v[2] * w0.z + v[3] * w0.w + v[4] * w1.x + v[5] * w1.y + v[6] * w1.z + v[7] * w1.w
                           + v[8] * w2.x + v[9] * w2.y + v[10] * w2.z + v[11] * w2.w + v[12] * w3.x + v[13] * w3.y + v[14] * w3.z + v[15] * w3.w;
                }
                const bool up = (lane & 32) != 0; const float keep = up ? dd[1] : dd[0], send = up ? dd[0] : dd[1];
                r8[i] = keep + __shfl_xor(send, 32, 64);
                __builtin_amdgcn_sched_barrier(0);
            }
#pragma unroll
            for (int i = 0; i < 4; ++i) { const bool up = (lane & 16) != 0; const float keep = up ? r8[i + 4] : r8[i], send = up ? r8[i] : r8[i + 4]; r4[i] = keep + __shfl_xor(send, 16, 64); }
#pragma unroll
            for (int i = 0; i < 2; ++i) { const bool up = (lane & 8) != 0; const float keep = up ? r4[i + 2] : r4[i], send = up ? r4[i] : r4[i + 2]; r2[i] = keep + __shfl_xor(send, 8, 64); }
            { const bool up = (lane & 4) != 0; const float keep = up ? r2[1] : r2[0], send = up ? r2[0] : r2[1]; r1 = keep + __shfl_xor(send, 4, 64); }
            r1 += __shfl_xor(r1, 2, 64); r1 += __shfl_xor(r1, 1, 64);
            if ((lane & 3) == 0) {
                const float pre = r1 + mybias;
                gates[(size_t)r * 16 + myq] = myq < 4 ? pre : logsigmoidf(pre);
            }
        }
    }
    __syncthreads();
    {
        float (*tile)[65] = (float (*)[65])smem;
        for (int item = blockIdx.x; item < 1664; item += gridDim.x) {
            const float* W; int ldn, ntn, shift_from, it; bf16_t* out;
            if (item < 896) { W = P.w_in; ldn = PROJ; ntn = 56; shift_from = 2048; it = item; out = (bf16_t*)(P.ws + WS_BT1); }
            else if (item < 1152) { W = P.w_out; ldn = 1024; ntn = 16; shift_from = 1 << 30; it = item - 896; out = (bf16_t*)(P.ws + WS_BT2); }
            else { W = P.peer_query; ldn = 2048; ntn = 32; shift_from = 1 << 30; it = item - 1152; out = (bf16_t*)(P.ws + WS_BT3); }
            const int tk = it / ntn, tn = it - tk * ntn, k0 = tk * 64, n0 = tn * 64;
            {
                const int nl = tid & 63;
                int n = n0 + nl; if (n >= shift_from) n += 8;
#pragma unroll
                for (int i = 0; i < 16; ++i) { const int kl = (tid >> 6) + 4 * i; tile[kl][nl] = W[(size_t)(k0 + kl) * ldn + n]; }
            }
            __syncthreads();
            {
                const int kl = tid & 63;
#pragma unroll
                for (int i = 0; i < 16; ++i) { const int nl = (tid >> 6) + 4 * i; out[(size_t)(n0 + nl) * 1024 + k0 + kl] = (bf16_t)f2bf(tile[kl][nl]); }
            }
            __syncthreads();
        }
    }
    {
        const size_t gt = (size_t)blockIdx.x * 256 + tid, gs = (size_t)gridDim.x * 256;
        const float* src = P.peer_keys; bf16_t* dst = (bf16_t*)(P.ws + WS_KEYS);
        for (size_t i = gt; i < (size_t)(16 * 128 * 128 / 8); i += gs) {
            const float4 a = *(const float4*)(src + i * 8), b = *(const float4*)(src + i * 8 + 4);
            uint4 o; o.x = pk2(a.x, a.y); o.y = pk2(a.z, a.w); o.z = pk2(b.x, b.y); o.w = pk2(b.z, b.w);
            *(uint4*)(dst + i * 8) = o;
        }
    }
}

__device__ __forceinline__ void convert_uv_rows(const Params& P, int gwave, int nwaves, int lane) {
    for (int rr0 = gwave * 4; rr0 < 2 * 16384; rr0 += nwaves * 4) {
        float4 a[4][4];
#pragma unroll
        for (int q = 0; q < 4; ++q) {
            const int rr = rr0 + q, which = rr >> 14, row = rr & 16383;
            const float* src = (which ? P.peer_v : P.peer_u) + (size_t)row * DM + lane * 16;
            a[q][0] = *(const float4*)(src); a[q][1] = *(const float4*)(src + 4); a[q][2] = *(const float4*)(src + 8); a[q][3] = *(const float4*)(src + 12);
        }
#pragma unroll
        for (int q = 0; q < 4; ++q) {
            const int rr = rr0 + q, which = rr >> 14, row = rr & 16383;
            float mx = 0.f;
#pragma unroll
            for (int j = 0; j < 4; ++j) mx = fmaxf(mx, fmaxf(fmaxf(fabsf(a[q][j].x), fabsf(a[q][j].y)), fmaxf(fabsf(a[q][j].z), fabsf(a[q][j].w))));
            mx = wave_max(mx);
            const float sc = mx > 0.f ? 6.0f / mx : 1.0f;
            unsigned w0 = 0u, w1 = 0u;
            w0 = __builtin_amdgcn_cvt_scalef32_pk_fp4_f32(w0, a[q][0].x * sc, a[q][0].y * sc, 1.0f, 0); w0 = __builtin_amdgcn_cvt_scalef32_pk_fp4_f32(w0, a[q][0].z * sc, a[q][0].w * sc, 1.0f, 1);
            w0 = __builtin_amdgcn_cvt_scalef32_pk_fp4_f32(w0, a[q][1].x * sc, a[q][1].y * sc, 1.0f, 2); w0 = __builtin_amdgcn_cvt_scalef32_pk_fp4_f32(w0, a[q][1].z * sc, a[q][1].w * sc, 1.0f, 3);
            w1 = __builtin_amdgcn_cvt_scalef32_pk_fp4_f32(w1, a[q][2].x * sc, a[q][2].y * sc, 1.0f, 0); w1 = __builtin_amdgcn_cvt_scalef32_pk_fp4_f32(w1, a[q][2].z * sc, a[q][2].w * sc, 1.0f, 1);
            w1 = __builtin_amdgcn_cvt_scalef32_pk_fp4_f32(w1, a[q][3].x * sc, a[q][3].y * sc, 1.0f, 2); w1 = __builtin_amdgcn_cvt_scalef32_pk_fp4_f32(w1, a[q][3].z * sc, a[q][3].w * sc, 1.0f, 3);
            *(uint2*)(P.ws + (which ? WS_V : WS_U) + (size_t)row * 512 + lane * 8) = make_uint2(w0, w1);
            if (lane == 0) ((float*)(P.ws + (which ? WS_VSC : WS_USC)))[row] = mx > 0.f ? mx * (1.0f / 6.0f) : 1.0f;
        }
    }
}

__device__ __forceinline__ void bitonic_sort16_desc(unsigned (&v)[16]) {
#pragma unroll
    for (int k = 2; k <= 16; k <<= 1)
#pragma unroll
        for (int j = k >> 1; j >= 1; j >>= 1)
#pragma unroll
            for (int i = 0; i < 16; ++i)
                if ((i & j) == 0) {
                    const int p = i | j;
                    const bool desc = (k >= 16) ? true : ((i & k) == 0);
                    const unsigned hi = max(v[i], v[p]), lo = min(v[i], v[p]);
                    v[i] = desc ? hi : lo; v[p] = desc ? lo : hi;
                }
}
__device__ __forceinline__ void bitonic_merge16_top(unsigned (&a)[16], const unsigned (&b)[16]) {
#pragma unroll
    for (int i = 0; i < 16; ++i) a[i] = max(a[i], b[15 - i]);
#pragma unroll
    for (int j = 8; j >= 1; j >>= 1)
#pragma unroll
        for (int i = 0; i < 16; ++i)
            if ((i & j) == 0) { const int p = i | j; const unsigned hi = max(a[i], a[p]), lo = min(a[i], a[p]); a[i] = hi; a[p] = lo; }
}

__device__ __forceinline__ int opaque_tid() { int t = threadIdx.x; asm volatile("" : "+v"(t)); return t; }

__device__ __forceinline__ void mma_ktile(const unsigned char* sA, const unsigned char* sB, int arow_off, int brow_off, int g, int sw, f32x4 (&acc)[4][4]) {
#pragma unroll
    for (int s = 0; s < 2; ++s) {
        bf16x8 a[4], b[4];
        const int ch = (((s * 4 + g) ^ sw) << 4);
#pragma unroll
        for (int i = 0; i < 4; ++i) a[i] = *(const bf16x8*)(sA + arow_off + i * 2048 + ch);
#pragma unroll
        for (int j = 0; j < 4; ++j) b[j] = *(const bf16x8*)(sB + brow_off + j * 2048 + ch);
#pragma unroll
        for (int i = 0; i < 4; ++i)
#pragma unroll
            for (int j = 0; j < 4; ++j) acc[i][j] = __builtin_amdgcn_mfma_f32_16x16x32_bf16(b[j], a[i], acc[i][j], 0, 0, 0);
    }
}

__device__ __forceinline__ void store_tile_bf16(const f32x4 (&acc)[4][4], unsigned char* smem, bf16_t* dst, size_t ld, int m0, int n0, int tid, int wr, int wc, int g, int lr) {
#pragma unroll
    for (int i = 0; i < 4; ++i)
#pragma unroll
        for (int j = 0; j < 4; ++j) {
            const int row = wr * 64 + 16 * i + lr, col = wc * 64 + 16 * j + 4 * g;
            uint2 w; w.x = pk2(acc[i][j][0], acc[i][j][1]); w.y = pk2(acc[i][j][2], acc[i][j][3]);
            *(uint2*)(smem + row * 272 + col * 2) = w;
        }
    __syncthreads();
#pragma unroll
    for (int q = 0; q < 8; ++q) {
        const int id = tid + 256 * q, row = id >> 4, ch = id & 15;
        const uint4 v = *(const uint4*)(smem + row * 272 + ch * 16);
        *(uint4*)(dst + (size_t)(m0 + row) * ld + n0 + ch * 8) = v;
    }
    __syncthreads();
}

template <int MODE>
__device__ __forceinline__ void gemm_tile(const Params& P, int tm, int tn, unsigned char* smem) {
    const bf16_t* A; const bf16_t* Bt;
    if (MODE == 1) { A = (const bf16_t*)(P.ws + WS_RA); Bt = (const bf16_t*)(P.ws + WS_BT1); }
    else if (MODE == 2) { A = (const bf16_t*)(P.ws + WS_Z); Bt = (const bf16_t*)(P.ws + WS_BT2); }
    else { A = (const bf16_t*)(P.ws + WS_XN); Bt = (const bf16_t*)(P.ws + WS_BT3); }
    const int tid = opaque_tid(), lane = tid & 63, wave = tid >> 6, wr = wave >> 1, wc = wave & 1, g = lane >> 4, lr = lane & 15;
    const int m0 = tm * 128, n0 = tn * 128;
    const int srow = tid >> 3, sc = tid & 7;
    constexpr unsigned LDA = (MODE == 2 ? NZ : 1024) * 2u;
    unsigned aoff, boff; int soff0;
    {
        int ar = m0 + srow;
        if (MODE == 2) { const int b = ar >> 11, t = ar & 2047; ar = b * L + NMETA + t; }
        aoff = (unsigned)ar * LDA + (unsigned)sc * 16u;
        boff = (unsigned)(n0 + srow) * 2048u + (unsigned)sc * 16u;
        soff0 = srow * 128 + ((sc ^ (srow & 7)) << 4);
    }
    const unsigned char* Ab = (const unsigned char*)A; const unsigned char* Bb = (const unsigned char*)Bt;
    f32x4 acc[4][4];
#pragma unroll
    for (int i = 0; i < 4; ++i)
#pragma unroll
        for (int j = 0; j < 4; ++j) acc[i][j] = (f32x4){0.f, 0.f, 0.f, 0.f};
    uint4 ra0, ra1, ra2, ra3, rb0, rb1, rb2, rb3;
#define G_LOAD(KT) { const unsigned ko = (unsigned)(KT) * 128u; \
        ra0 = *(const uint4*)(Ab + (aoff + ko)); ra1 = *(const uint4*)(Ab + (aoff + 32u * LDA + ko)); ra2 = *(const uint4*)(Ab + (aoff + 64u * LDA + ko)); ra3 = *(const uint4*)(Ab + (aoff + 96u * LDA + ko)); \
        rb0 = *(const uint4*)(Bb + (boff + ko)); rb1 = *(const uint4*)(Bb + (boff + 32u * 2048u + ko)); rb2 = *(const uint4*)(Bb + (boff + 64u * 2048u + ko)); rb3 = *(const uint4*)(Bb + (boff + 96u * 2048u + ko)); }
#define G_WRITE(SA, SB) { *(uint4*)((SA) + soff0) = ra0; *(uint4*)((SA) + soff0 + 4096) = ra1; *(uint4*)((SA) + soff0 + 8192) = ra2; *(uint4*)((SA) + soff0 + 12288) = ra3; \
        *(uint4*)((SB) + soff0) = rb0; *(uint4*)((SB) + soff0 + 4096) = rb1; *(uint4*)((SB) + soff0 + 8192) = rb2; *(uint4*)((SB) + soff0 + 12288) = rb3; }
    unsigned char* sA0 = smem; unsigned char* sB0 = smem + 16384; unsigned char* sA1 = smem + 32768; unsigned char* sB1 = smem + 49152;
    G_LOAD(0)
    G_WRITE(sA0, sB0)
    __syncthreads();
    const int arow_off = (wr * 64 + lr) * 128, brow_off = (wc * 64 + lr) * 128, sw = lr & 7;
    G_LOAD(1)
    for (int kt = 0; kt < 16; ++kt) {
        unsigned char* sA = (kt & 1) ? sA1 : sA0; unsigned char* sB = (kt & 1) ? sB1 : sB0;
        unsigned char* nA = (kt & 1) ? sA0 : sA1; unsigned char* nB = (kt & 1) ? sB0 : sB1;
        mma_ktile(sA, sB, arow_off, brow_off, g, sw, acc);
        if (kt < 15) G_WRITE(nA, nB)
        if (kt < 14) G_LOAD(kt + 2)
        __syncthreads();
    }
#undef G_LOAD
#undef G_WRITE
    if (MODE == 1) {
        if (n0 >= ZC_FQ && n0 < ZC_FV) {
            const bool isk = n0 >= ZC_FK;
            const float* gain = isk ? P.f_k_norm : P.f_q_norm;
            const float scl = isk ? 1.0f : 0.125f * LOG2E;
            float gn[4][4];
#pragma unroll
            for (int j = 0; j < 4; ++j)
#pragma unroll
                for (int r = 0; r < 4; ++r) gn[j][r] = gain[16 * j + 4 * g + r];
#pragma unroll
            for (int i = 0; i < 4; ++i) {
                float ss = 0.f;
#pragma unroll
                for (int j = 0; j < 4; ++j)
#pragma unroll
                    for (int r = 0; r < 4; ++r) ss += acc[i][j][r] * acc[i][j][r];
                ss += __shfl_xor(ss, 16, 64); ss += __shfl_xor(ss, 32, 64);
                const float rstd = rsqrtf(ss * (1.0f / 64.0f) + EPS) * scl;
#pragma unroll
                for (int j = 0; j < 4; ++j)
#pragma unroll
                    for (int r = 0; r < 4; ++r) acc[i][j][r] *= rstd * gn[j][r];
            }
        }
        store_tile_bf16(acc, smem, (bf16_t*)(P.ws + WS_Z), NZ, m0, n0, tid, wr, wc, g, lr);
    } else if (MODE == 2) {
        float* ssq = (float*)(P.ws + WS_SSQ);
#pragma unroll
        for (int i = 0; i < 4; ++i) {
            const int row = m0 + wr * 64 + 16 * i + lr;
            float ss = 0.f;
#pragma unroll
            for (int j = 0; j < 4; ++j) {
                const int col = n0 + wc * 64 + 16 * j + 4 * g;
                const float4 xv = *(const float4*)(P.x + (size_t)row * DM + col);
                const float4 gv = *(const float4*)(P.norm_ffn + col);
                float4 hv; hv.x = acc[i][j][0] + xv.x; hv.y = acc[i][j][1] + xv.y; hv.z = acc[i][j][2] + xv.z; hv.w = acc[i][j][3] + xv.w;
                ss += hv.x * hv.x + hv.y * hv.y + hv.z * hv.z + hv.w * hv.w;
                acc[i][j][0] = hv.x * gv.x; acc[i][j][1] = hv.y * gv.y; acc[i][j][2] = hv.z * gv.z; acc[i][j][3] = hv.w * gv.w;
            }
            ss += __shfl_xor(ss, 16, 64); ss += __shfl_xor(ss, 32, 64);
            if (g == 0) ssq[(size_t)row * 16 + tn * 2 + wc] = ss;
        }
        store_tile_bf16(acc, smem, (bf16_t*)(P.ws + WS_XN), 1024, m0, n0, tid, wr, wc, g, lr);
    } else {
        const int hp = tn;
        const float* ssq = (const float*)(P.ws + WS_SSQ);
        float rs[4];
#pragma unroll
        for (int i = 0; i < 4; ++i) {
            const int row = m0 + wr * 64 + 16 * i + lr;
            const float4 p0 = *(const float4*)(ssq + (size_t)row * 16), p1 = *(const float4*)(ssq + (size_t)row * 16 + 4);
            const float4 p2 = *(const float4*)(ssq + (size_t)row * 16 + 8), p3 = *(const float4*)(ssq + (size_t)row * 16 + 12);
            const float s = ((p0.x + p0.y) + (p0.z + p0.w)) + ((p1.x + p1.y) + (p1.z + p1.w)) + ((p2.x + p2.y) + (p2.z + p2.w)) + ((p3.x + p3.y) + (p3.z + p3.w));
            rs[i] = rsqrtf(s * (1.0f / DM) + EPS);
            if (tn == 0 && wc == 0 && g == 0) ((float*)(P.ws + WS_RSTD))[row] = rs[i];
        }
        {
            unsigned char* sAq = wc ? sA1 : sA0;
#pragma unroll
            for (int i = 0; i < 4; ++i)
#pragma unroll
                for (int j = 0; j < 4; ++j) {
                    const int row = wr * 64 + 16 * i + lr;
                    const int chunk = 2 * j + (g >> 1);
                    uint2 w; w.x = pk2(acc[i][j][0] * rs[i], acc[i][j][1] * rs[i]); w.y = pk2(acc[i][j][2] * rs[i], acc[i][j][3] * rs[i]);
                    *(uint2*)(sAq + row * 128 + ((chunk ^ (row & 7)) << 4) + 8 * (g & 1)) = w;
                }
            const bf16_t* keys = (const bf16_t*)(P.ws + WS_KEYS) + (size_t)hp * 128 * 128;
#pragma unroll
            for (int j = 0; j < 4; ++j) {
                const int row = srow + 32 * j;
                const uint4 k0 = *(const uint4*)(keys + (size_t)row * 128 + sc * 8);
                const uint4 k1 = *(const uint4*)(keys + (size_t)row * 128 + 64 + sc * 8);
                *(uint4*)(sB0 + soff0 + j * 4096) = k0; *(uint4*)(sB1 + soff0 + j * 4096) = k1;
            }
        }
        __syncthreads();
#pragma unroll
        for (int i = 0; i < 4; ++i)
#pragma unroll
            for (int j = 0; j < 4; ++j) acc[i][j] = (f32x4){0.f, 0.f, 0.f, 0.f};
        mma_ktile(sA0, sB0, arow_off, brow_off, g, sw, acc);
        mma_ktile(sA1, sB1, arow_off, brow_off, g, sw, acc);
        __syncthreads();
#pragma unroll
        for (int i = 0; i < 4; ++i)
#pragma unroll
            for (int j = 0; j < 4; ++j) {
                const int row = wr * 64 + 16 * i + lr;
                const int c4 = wc * 16 + 4 * j + g;
                *(f32x4*)(smem + row * 512 + ((c4 ^ (row & 31)) << 4)) = acc[i][j];
            }
        __syncthreads();
        unsigned top[16];
        const int row = tid & 127, half = tid >> 7;
        {
            auto load_keys = [&](unsigned (&dst)[16], int q4) {
#pragma unroll
                for (int s4 = 0; s4 < 4; ++s4) {
                    const int c4 = half * 16 + q4 * 4 + s4;
                    const f32x4 v = *(const f32x4*)(smem + row * 512 + ((c4 ^ (row & 31)) << 4));
#pragma unroll
                    for (int e = 0; e < 4; ++e) dst[s4 * 4 + e] = (ord_key(v[e]) & ~127u) | (unsigned)(127 - (c4 * 4 + e));
                }
            };
            load_keys(top, 0);
            bitonic_sort16_desc(top);
#pragma unroll 1
            for (int q4 = 1; q4 < 4; ++q4) {
                unsigned gq[16];
                load_keys(gq, q4);
                bitonic_sort16_desc(gq);
                bitonic_merge16_top(top, gq);
            }
        }
        __syncthreads();
        if (half) {
            uint4* lp = (uint4*)(smem + row * 64);
            lp[0] = make_uint4(top[0], top[1], top[2], top[3]); lp[1] = make_uint4(top[4], top[5], top[6], top[7]);
            lp[2] = make_uint4(top[8], top[9], top[10], top[11]); lp[3] = make_uint4(top[12], top[13], top[14], top[15]);
        }
        __syncthreads();
        if (!half) {
            const uint4* lp = (const uint4*)(smem + row * 64);
            unsigned other[16];
#pragma unroll
            for (int c = 0; c < 4; ++c) { const uint4 o = lp[c]; other[4 * c] = o.x; other[4 * c + 1] = o.y; other[4 * c + 2] = o.z; other[4 * c + 3] = o.w; }
            bitonic_merge16_top(top, other);
            uint4* tk = (uint4*)((unsigned*)(P.ws + WS_TK) + ((size_t)(m0 + row) * 16 + hp) * 16);
            tk[0] = make_uint4(top[0], top[1], top[2], top[3]); tk[1] = make_uint4(top[4], top[5], top[6], top[7]);
            tk[2] = make_uint4(top[8], top[9], top[10], top[11]); tk[3] = make_uint4(top[12], top[13], top[14], top[15]);
        }
        __syncthreads();
    }
}

__device__ __forceinline__ void fox_cum_wave(const Params& P, int bh, int lane) {
    const int b = bh >> 3, h = bh & 7;
    const float* gates = (const float*)(P.ws + WS_GATES);
    float* cum = (float*)(P.ws + WS_CUM) + (size_t)bh * L;
    constexpr int SEG = 33;
    const int t0 = lane * SEG;
    float loc = 0.f;
    for (int i = 0; i < SEG; ++i) { const int t = t0 + i; if (t < L) loc += gates[(size_t)(b * L + t) * 16 + 8 + h]; }
    float incl = loc;
#pragma unroll
    for (int o = 1; o < 64; o <<= 1) { const float n = __shfl_up(incl, o, 64); if (lane >= o) incl += n; }
    float run = incl - loc;
    for (int i = 0; i < SEG; ++i) { const int t = t0 + i; if (t < L) { run += gates[(size_t)(b * L + t) * 16 + 8 + h]; cum[t] = run * LOG2E; } }
}

#define TR_SLOW 0

__device__ __forceinline__ int vimg_off(int row, int ch) { return row * 128 + ((ch ^ (((row >> 1) & 3) << 1)) << 4); }
__device__ __forceinline__ uint2 tr_frag(const unsigned char* img, int row0, int c, int g, int lr) {
#if TR_SLOW
    unsigned short e[4];
#pragma unroll
    for (int k = 0; k < 4; ++k) { const int row = row0 + 4 * g + k, col = 16 * c + lr; e[k] = *(const unsigned short*)(img + vimg_off(row, col >> 3) + (col & 7) * 2); }
    uint2 r; r.x = (unsigned)e[0] | ((unsigned)e[1] << 16); r.y = (unsigned)e[2] | ((unsigned)e[3] << 16); return r;
#else
    const int q = lr >> 2, p = lr & 3, row = row0 + 4 * g + q;
    const unsigned addr = (unsigned)(size_t)(img + vimg_off(row, 2 * c + (p >> 1)) + 8 * (p & 1));
    uint2 r;
    asm volatile("ds_read_b64_tr_b16 %0, %1\n\ts_waitcnt lgkmcnt(0)" : "=&v"(r) : "v"(addr) : "memory");
    return r;
#endif
}

__device__ __forceinline__ unsigned tr_lane_addr(const unsigned char* img, int c, int g, int lr) {
    const int q = lr >> 2, p = lr & 3, row = 4 * g + q;
    return (unsigned)(size_t)(img + vimg_off(row, 2 * c + (p >> 1)) + 8 * (p & 1));
}
#define TR_GROUP(o0, o1, o2, o3, a) "ds_read_b64_tr_b16 %" #o0 ", %" #a "\n\tds_read_b64_tr_b16 %" #o1 ", %" #a " offset:2048\n\tds_read_b64_tr_b16 %" #o2 ", %" #a " offset:4096\n\tds_read_b64_tr_b16 %" #o3 ", %" #a " offset:6144\n\t"
__device__ __forceinline__ void tr_read_4c(const unsigned char* img, int g, int lr, uint2 (&r)[4][4]) {
    const unsigned a0 = tr_lane_addr(img, 0, g, lr), a1 = tr_lane_addr(img, 1, g, lr), a2 = tr_lane_addr(img, 2, g, lr), a3 = tr_lane_addr(img, 3, g, lr);
    asm volatile(TR_GROUP(0, 1, 2, 3, 16) TR_GROUP(4, 5, 6, 7, 17) TR_GROUP(8, 9, 10, 11, 18) TR_GROUP(12, 13, 14, 15, 19) "s_waitcnt lgkmcnt(0)"
        : "=&v"(r[0][0]), "=&v"(r[0][1]), "=&v"(r[0][2]), "=&v"(r[0][3]), "=&v"(r[1][0]), "=&v"(r[1][1]), "=&v"(r[1][2]), "=&v"(r[1][3]),
          "=&v"(r[2][0]), "=&v"(r[2][1]), "=&v"(r[2][2]), "=&v"(r[2][3]), "=&v"(r[3][0]), "=&v"(r[3][1]), "=&v"(r[3][2]), "=&v"(r[3][3])
        : "v"(a0), "v"(a1), "v"(a2), "v"(a3) : "memory");
}
__device__ __forceinline__ void tr_read_3c(const unsigned char* img, int g, int lr, uint2 (&r)[3][4]) {
    const unsigned a0 = tr_lane_addr(img, 0, g, lr), a1 = tr_lane_addr(img, 1, g, lr), a2 = tr_lane_addr(img, 2, g, lr);
    asm volatile(TR_GROUP(0, 1, 2, 3, 12) TR_GROUP(4, 5, 6, 7, 13) TR_GROUP(8, 9, 10, 11, 14) "s_waitcnt lgkmcnt(0)"
        : "=&v"(r[0][0]), "=&v"(r[0][1]), "=&v"(r[0][2]), "=&v"(r[0][3]), "=&v"(r[1][0]), "=&v"(r[1][1]), "=&v"(r[1][2]), "=&v"(r[1][3]),
          "=&v"(r[2][0]), "=&v"(r[2][1]), "=&v"(r[2][2]), "=&v"(r[2][3])
        : "v"(a0), "v"(a1), "v"(a2) : "memory");
}
__device__ __forceinline__ void tr_read_2(const unsigned char* img0, int c0, const unsigned char* img1, int c1, int g, int lr, uint2 (&r)[2][4]) {
    const unsigned a0 = tr_lane_addr(img0, c0, g, lr), a1 = tr_lane_addr(img1, c1, g, lr);
    asm volatile(TR_GROUP(0, 1, 2, 3, 8) TR_GROUP(4, 5, 6, 7, 9) "s_waitcnt lgkmcnt(0)"
        : "=&v"(r[0][0]), "=&v"(r[0][1]), "=&v"(r[0][2]), "=&v"(r[0][3]), "=&v"(r[1][0]), "=&v"(r[1][1]), "=&v"(r[1][2]), "=&v"(r[1][3])
        : "v"(a0), "v"(a1) : "memory");
}
__device__ __forceinline__ bf16x8 tr_pair(const uint2& lo, const uint2& hi) { uint4 u; u.x = lo.x; u.y = lo.y; u.z = hi.x; u.w = hi.y; return __builtin_bit_cast(bf16x8, u); }

__device__ __forceinline__ void attn_block(const Params& P, int bh, int qb, unsigned char* smem) {
    const int tid = opaque_tid(), lane = tid & 63, w = tid >> 6, g = lane >> 4, lr = lane & 15;
    const int b = bh >> 3, h = bh & 7;
    const bf16_t* z = (const bf16_t*)(P.ws + WS_Z);
    const float* cum = (const float*)(P.ws + WS_CUM) + (size_t)bh * L;
    int tq[2]; bool qvalid[2]; bf16x8 qf[2][2]; float cq[2];
#pragma unroll
    for (int u = 0; u < 2; ++u) {
        tq[u] = qb * 128 + 32 * w + 16 * u + lr;
        qvalid[u] = tq[u] < L;
        const bf16_t* qp = z + (size_t)(b * L + (qvalid[u] ? tq[u] : 0)) * NZ + ZC_FQ + h * 64 + 8 * g;
        qf[u][0] = *(const bf16x8*)(qp); qf[u][1] = *(const bf16x8*)(qp + 32);
        cq[u] = cum[qvalid[u] ? tq[u] : 0];
    }
    const int nkv = (2 * qb + 2 < 33) ? 2 * qb + 2 : 33;
    const int srow0 = tid >> 3, sch = tid & 7;
    uint4 rk[2], rv[2]; float rc = 0.f;
    auto load_tile = [&](int kv) {
#pragma unroll
        for (int j = 0; j < 2; ++j) {
            const int key = kv * 64 + srow0 + 32 * j;
            if (key < L) {
                const bf16_t* p = z + (size_t)(b * L + key) * NZ + h * 64 + sch * 8;
                rk[j] = *(const uint4*)(p + ZC_FK); rv[j] = *(const uint4*)(p + ZC_FV);
            } else { rk[j] = make_uint4(0, 0, 0, 0); rv[j] = make_uint4(0, 0, 0, 0); }
        }
        if (tid < 64) { const int key = kv * 64 + tid; rc = key < L ? cum[key] : 0.f; }
    };
    auto store_tile = [&](int buf) {
        unsigned char* sK = smem + buf * 16384; unsigned char* sV = sK + 8192;
#pragma unroll
        for (int j = 0; j < 2; ++j) {
            const int row = srow0 + 32 * j;
            *(uint4*)(sK + row * 128 + ((sch ^ (row & 7)) << 4)) = rk[j];
            *(uint4*)(sV + vimg_off(row, sch)) = rv[j];
        }
        if (tid < 64) ((float*)(smem + 32768 + buf * 256))[tid] = rc;
    };
    float m[2] = {-INFINITY, -INFINITY}, lsum[2] = {0.f, 0.f};
    f32x4 o[2][4];
#pragma unroll
    for (int u = 0; u < 2; ++u)
#pragma unroll
        for (int c = 0; c < 4; ++c) o[u][c] = (f32x4){0.f, 0.f, 0.f, 0.f};
    load_tile(0); store_tile(0);
    __syncthreads();
    for (int kv = 0; kv < nkv; ++kv) {
        const int buf = kv & 1;
        if (kv + 1 < nkv) load_tile(kv + 1);
        const unsigned char* sK = smem + buf * 16384; const unsigned char* sV = sK + 8192;
        const float* sck = (const float*)(smem + 32768 + buf * 256);
        f32x4 sa[2][4];
#pragma unroll
        for (int c = 0; c < 4; ++c) {
            sa[0][c] = (f32x4){0.f, 0.f, 0.f, 0.f}; sa[1][c] = (f32x4){0.f, 0.f, 0.f, 0.f};
#pragma unroll
            for (int s = 0; s < 2; ++s) {
                const bf16x8 kf = *(const bf16x8*)(sK + (16 * c + lr) * 128 + (((4 * s + g) ^ (lr & 7)) << 4));
                sa[0][c] = __builtin_amdgcn_mfma_f32_16x16x32_bf16(kf, qf[0][s], sa[0][c], 0, 0, 0);
                sa[1][c] = __builtin_amdgcn_mfma_f32_16x16x32_bf16(kf, qf[1][s], sa[1][c], 0, 0, 0);
            }
        }
        const bool diag = (kv >= 2 * qb);
        bf16x8 pf[2][2];
#pragma unroll
        for (int u = 0; u < 2; ++u) {
            float mx = -INFINITY;
#pragma unroll
            for (int c = 0; c < 4; ++c) {
                const f32x4 ck = *(const f32x4*)(sck + 16 * c + 4 * g);
#pragma unroll
                for (int r = 0; r < 4; ++r) {
                    float v = sa[u][c][r] + (cq[u] - ck[r]);
                    if (diag && (64 * kv + 16 * c + 4 * g + r > tq[u])) v = -INFINITY;
                    sa[u][c][r] = v; mx = fmaxf(mx, v);
                }
            }
            mx = fmaxf(mx, __shfl_xor(mx, 16, 64)); mx = fmaxf(mx, __shfl_xor(mx, 32, 64));
            const float mn = fmaxf(m[u], mx);
            const float alpha = __builtin_amdgcn_exp2f(m[u] - mn);
            m[u] = mn;
            float ps = 0.f;
#pragma unroll
            for (int c = 0; c < 4; ++c)
#pragma unroll
                for (int r = 0; r < 4; ++r) { const float p = __builtin_amdgcn_exp2f(sa[u][c][r] - mn); sa[u][c][r] = p; ps += p; }
            lsum[u] = lsum[u] * alpha + ps;
#pragma unroll
            for (int c = 0; c < 4; ++c) o[u][c] *= alpha;
#pragma unroll
            for (int s2 = 0; s2 < 2; ++s2) {
                uint4 uu;
                uu.x = cvt_pk_bf16(sa[u][2 * s2][0], sa[u][2 * s2][1]); uu.y = cvt_pk_bf16(sa[u][2 * s2][2], sa[u][2 * s2][3]);
                uu.z = cvt_pk_bf16(sa[u][2 * s2 + 1][0], sa[u][2 * s2 + 1][1]); uu.w = cvt_pk_bf16(sa[u][2 * s2 + 1][2], sa[u][2 * s2 + 1][3]);
                pf[u][s2] = __builtin_bit_cast(bf16x8, uu);
            }
        }
        {
            uint2 vr[4][4];
            tr_read_4c(sV, g, lr, vr);
#pragma unroll
            for (int c = 0; c < 4; ++c)
#pragma unroll
                for (int s2 = 0; s2 < 2; ++s2) {
                    const bf16x8 vf = tr_pair(vr[c][2 * s2], vr[c][2 * s2 + 1]);
                    o[0][c] = __builtin_amdgcn_mfma_f32_16x16x32_bf16(vf, pf[0][s2], o[0][c], 0, 0, 0);
                    o[1][c] = __builtin_amdgcn_mfma_f32_16x16x32_bf16(vf, pf[1][s2], o[1][c], 0, 0, 0);
                }
        }
        if (kv + 1 < nkv) store_tile(buf ^ 1);
        __syncthreads();
    }
#pragma unroll
    for (int u = 0; u < 2; ++u) {
        float ls = lsum[u];
        ls += __shfl_xor(ls, 16, 64); ls += __shfl_xor(ls, 32, 64);
        const float inv = 1.0f / ls;
        if (qvalid[u]) {
            bf16_t* y = (bf16_t*)(P.ws + WS_Z) + (size_t)(b * L + tq[u]) * NZ + 512 + h * 64 + 4 * g;
#pragma unroll
            for (int c = 0; c < 4; ++c) {
                uint2 uu; uu.x = pk2(o[u][c][0] * inv, o[u][c][1] * inv); uu.y = pk2(o[u][c][2] * inv, o[u][c][3] * inv);
                *(uint2*)(y + 16 * c) = uu;
            }
        }
    }
}

__device__ __forceinline__ void conv_item(const Params& P, int ci) {
    const int tid = opaque_tid(), cc = tid & 127, rg = tid >> 7;
    const bf16_t* z = (const bf16_t*)(P.ws + WS_Z);
    bf16_t* qk = (bf16_t*)(P.ws + WS_RA);
    const int col0 = cc * 8;
    float w[4][8];
#pragma unroll
    for (int j = 0; j < 4; ++j) {
        const float4 a = *(const float4*)(P.conv_qk + j * 1024 + col0), b = *(const float4*)(P.conv_qk + j * 1024 + col0 + 4);
        w[j][0] = a.x; w[j][1] = a.y; w[j][2] = a.z; w[j][3] = a.w; w[j][4] = b.x; w[j][5] = b.y; w[j][6] = b.z; w[j][7] = b.w;
    }
    const float oscale = (col0 >= 512) ? 0.08838834764831845f : 1.0f;
    const int r0 = ci * 64 + rg * 32;
    int t = r0 % L;
    float xw[3][8];
#pragma unroll
    for (int j = 0; j < 3; ++j) {
        const int back = 3 - j;
        if (t - back >= 0) {
            const uint4 v = *(const uint4*)(z + (size_t)(r0 - back) * NZ + col0);
            xw[j][0] = bflo(v.x); xw[j][1] = bfhi(v.x); xw[j][2] = bflo(v.y); xw[j][3] = bfhi(v.y); xw[j][4] = bflo(v.z); xw[j][5] = bfhi(v.z); xw[j][6] = bflo(v.w); xw[j][7] = bfhi(v.w);
        } else {
#pragma unroll
            for (int e = 0; e < 8; ++e) xw[j][e] = 0.f;
        }
    }
#pragma unroll 2
    for (int i = 0; i < 32; ++i) {
        const int r = r0 + i;
        if (t == 0) {
#pragma unroll
            for (int j = 0; j < 3; ++j)
#pragma unroll
                for (int e = 0; e < 8; ++e) xw[j][e] = 0.f;
        }
        const uint4 v = *(const uint4*)(z + (size_t)r * NZ + col0);
        float xt[8];
        xt[0] = bflo(v.x); xt[1] = bfhi(v.x); xt[2] = bflo(v.y); xt[3] = bfhi(v.y); xt[4] = bflo(v.z); xt[5] = bfhi(v.z); xt[6] = bflo(v.w); xt[7] = bfhi(v.w);
        float o[8];
#pragma unroll
        for (int e = 0; e < 8; ++e) {
            const float cv = w[0][e] * xw[0][e] + w[1][e] * xw[1][e] + w[2][e] * xw[2][e] + w[3][e] * xt[e];
            o[e] = oscale * cv / (1.f + __expf(-cv));
            xw[0][e] = xw[1][e]; xw[1][e] = xw[2][e]; xw[2][e] = xt[e];
        }
        uint4 ov; ov.x = pk2(o[0], o[1]); ov.y = pk2(o[2], o[3]); ov.z = pk2(o[4], o[5]); ov.w = pk2(o[6], o[7]);
        *(uint4*)(qk + (size_t)r * 1024 + col0) = ov;
        t = (t + 1 == L) ? 0 : t + 1;
    }
}

constexpr int ST_IMG = 36864;
__device__ __forceinline__ int st_piece_off(int jt, int c, int g, int lr) { return (jt >> 2) * 18432 + vimg_off(16 * c + lr, 2 * (jt & 3) + (g >> 1)) + 8 * (g & 1); }

__device__ __forceinline__ void mlstm_stage_kv(const Params& P, int b, int h, int k, unsigned char* sKimg, unsigned char* sVimg, int tid) {
    const bf16_t* z = (const bf16_t*)(P.ws + WS_Z);
    const bf16_t* qk = (const bf16_t*)(P.ws + WS_RA);
    uint4 pk_[4], pv_[4];
#pragma unroll
    for (int j = 0; j < 4; ++j) {
        const int id = tid + 256 * j, row = id >> 4, ch16 = id & 15, pos = 64 * k + row;
        const bool ok = pos < L;
        pk_[j] = ok ? *(const uint4*)(qk + (size_t)(b * L + pos) * 1024 + 512 + h * 128 + ch16 * 8) : make_uint4(0, 0, 0, 0);
        pv_[j] = ok ? *(const uint4*)(z + (size_t)(b * L + pos) * NZ + ZC_MV + h * 128 + ch16 * 8) : make_uint4(0, 0, 0, 0);
    }
#pragma unroll
    for (int j = 0; j < 4; ++j) {
        const int id = tid + 256 * j, row = id >> 4, ch16 = id & 15;
        *(uint4*)(sKimg + (ch16 >> 3) * 8192 + vimg_off(row, ch16 & 7)) = pk_[j];
        *(uint4*)(sVimg + (ch16 >> 3) * 8192 + vimg_off(row, ch16 & 7)) = pv_[j];
    }
    if (tid < 128) {
        const int row = tid >> 1, ch = tid & 1;
        *(uint4*)(sVimg + 16384 + vimg_off(row, ch)) = ch ? make_uint4(0, 0, 0, 0) : make_uint4(0x3F80u, 0, 0, 0);
    }
}

__device__ __forceinline__ void mlstm_stage_A(const Params& P, int b, int h, int k, unsigned char* sKimg, unsigned char* sVimg, int tid) {
    const bf16_t* z = (const bf16_t*)(P.ws + WS_Z);
    bf16_t* qk = (bf16_t*)(P.ws + WS_RA);
    uint4 pv_[4];
#pragma unroll
    for (int j = 0; j < 4; ++j) {
        const int id = tid + 256 * j, row = id >> 4, ch16 = id & 15, pos = 64 * k + row;
        pv_[j] = (pos < L) ? *(const uint4*)(z + (size_t)(b * L + pos) * NZ + ZC_MV + h * 128 + ch16 * 8) : make_uint4(0, 0, 0, 0);
    }
    const int cch = tid & 31, rg = tid >> 5, isk = cch >> 4;
    const int zcol = (isk ? ZC_MK : ZC_MQ) + h * 128 + (cch & 15) * 8;
    float w[4][8];
#pragma unroll
    for (int j = 0; j < 4; ++j) {
        const float4 a = *(const float4*)(P.conv_qk + j * 1024 + zcol), c = *(const float4*)(P.conv_qk + j * 1024 + zcol + 4);
        w[j][0] = a.x; w[j][1] = a.y; w[j][2] = a.z; w[j][3] = a.w; w[j][4] = c.x; w[j][5] = c.y; w[j][6] = c.z; w[j][7] = c.w;
    }
    const float oscale = isk ? 0.08838834764831845f : 1.0f;
    const int p0 = 64 * k + 8 * rg;
    uint4 raw[11];
#pragma unroll
    for (int i = 0; i < 11; ++i) {
        const int pos = p0 - 3 + i;
        raw[i] = (pos >= 0 && pos < L) ? *(const uint4*)(z + (size_t)(b * L + pos) * NZ + zcol) : make_uint4(0, 0, 0, 0);
    }
#pragma unroll
    for (int j = 0; j < 4; ++j) {
        const int id = tid + 256 * j, row = id >> 4, ch16 = id & 15;
        *(uint4*)(sVimg + (ch16 >> 3) * 8192 + vimg_off(row, ch16 & 7)) = pv_[j];
    }
    if (tid < 128) {
        const int row = tid >> 1, ch = tid & 1;
        *(uint4*)(sVimg + 16384 + vimg_off(row, ch)) = ch ? make_uint4(0, 0, 0, 0) : make_uint4(0x3F80u, 0, 0, 0);
    }
#pragma unroll
    for (int i = 0; i < 8; ++i) {
        const int pos = p0 + i, row = 8 * rg + i;
        float o[8];
#pragma unroll
        for (int e = 0; e < 8; ++e) {
            const unsigned w0 = (&raw[i].x)[e >> 1], w1 = (&raw[i + 1].x)[e >> 1], w2 = (&raw[i + 2].x)[e >> 1], w3 = (&raw[i + 3].x)[e >> 1];
            const float x0 = (e & 1) ? bfhi(w0) : bflo(w0), x1 = (e & 1) ? bfhi(w1) : bflo(w1), x2 = (e & 1) ? bfhi(w2) : bflo(w2), x3 = (e & 1) ? bfhi(w3) : bflo(w3);
            const float cv = w[0][e] * x0 + w[1][e] * x1 + w[2][e] * x2 + w[3][e] * x3;
            o[e] = oscale * cv / (1.f + __expf(-cv));
        }
        uint4 ov; ov.x = pk2(o[0], o[1]); ov.y = pk2(o[2], o[3]); ov.z = pk2(o[4], o[5]); ov.w = pk2(o[6], o[7]);
        const bool ok = pos < L;
        if (!ok) ov = make_uint4(0, 0, 0, 0);
        if (ok) *(uint4*)(qk + (size_t)(b * L + pos) * 1024 + (isk ? 512 : 0) + h * 128 + (cch & 15) * 8) = ov;
        if (isk) { const int ch16 = cch & 15; *(uint4*)(sKimg + (ch16 >> 3) * 8192 + vimg_off(row, ch16 & 7)) = ov; }
    }
}

__device__ __forceinline__ void mlstm_A(const Params& P, int item, unsigned char* smem) {
    const int tid = opaque_tid(), lane = tid & 63, w = tid >> 6, g = lane >> 4, lr = lane & 15;
    const int wu = __builtin_amdgcn_readfirstlane(w);
    const int k = item >> 5, bh = item & 31, b = bh >> 2, h = bh & 3;
    const float* gates = (const float*)(P.ws + WS_GATES);
    const unsigned char* sK = smem; const unsigned char* sV = smem + 16384;
    float* ga = (float*)(smem + 40960);
    mlstm_stage_A(P, b, h, k, smem, smem + 16384, tid);
    if (wu == 0) {
        const int pos = 64 * k + lane;
        float lf = 0.f, li = -INFINITY;
        if (pos < L) { lf = gates[(size_t)(b * L + pos) * 16 + 4 + h]; li = gates[(size_t)(b * L + pos) * 16 + h]; }
        float bc = lf;
#pragma unroll
        for (int o = 1; o < 64; o <<= 1) { const float n = __shfl_up(bc, o, 64); if (lane >= o) bc += n; }
        const float a = li - bc;
        const float A = wave_max(a);
        ga[lane] = __expf(a - A);
        if (lane == 63) { float* msc = (float*)(P.ws + WS_MSC) + ((size_t)bh * 33 + k) * 4; msc[0] = A; msc[1] = bc; }
    }
    __syncthreads();
    f32x4 Ct[2][9];
#pragma unroll
    for (int a = 0; a < 2; ++a)
#pragma unroll
        for (int c = 0; c < 9; ++c) Ct[a][c] = (f32x4){0.f, 0.f, 0.f, 0.f};
    bf16x8 kt[2][2];
#pragma unroll
    for (int a = 0; a < 2; ++a)
#pragma unroll
        for (int s2 = 0; s2 < 2; ++s2) {
            const int jt = 2 * w + a;
            kt[a][s2] = tr_pair(tr_frag(sK + (jt >> 2) * 8192, 32 * s2, jt & 3, g, lr), tr_frag(sK + (jt >> 2) * 8192, 32 * s2 + 16, jt & 3, g, lr));
        }
    f32x4 wg4[4];
#pragma unroll
    for (int j = 0; j < 4; ++j) wg4[j] = *(const f32x4*)(ga + 16 * j + 4 * g);
#define MA_TILE(c, lo0, hi0, lo1, hi1) { \
        { const f32x4 w0 = wg4[0], w1 = wg4[1]; uint4 o; \
          o.x = cvt_pk_bf16(bflo(lo0.x) * w0[0], bfhi(lo0.x) * w0[1]); o.y = cvt_pk_bf16(bflo(lo0.y) * w0[2], bfhi(lo0.y) * w0[3]); \
          o.z = cvt_pk_bf16(bflo(hi0.x) * w1[0], bfhi(hi0.x) * w1[1]); o.w = cvt_pk_bf16(bflo(hi0.y) * w1[2], bfhi(hi0.y) * w1[3]); \
          const bf16x8 vw = __builtin_bit_cast(bf16x8, o); \
          Ct[0][c] = __builtin_amdgcn_mfma_f32_16x16x32_bf16(kt[0][0], vw, Ct[0][c], 0, 0, 0); Ct[1][c] = __builtin_amdgcn_mfma_f32_16x16x32_bf16(kt[1][0], vw, Ct[1][c], 0, 0, 0); } \
        { const f32x4 w0 = wg4[2], w1 = wg4[3]; uint4 o; \
          o.x = cvt_pk_bf16(bflo(lo1.x) * w0[0], bfhi(lo1.x) * w0[1]); o.y = cvt_pk_bf16(bflo(lo1.y) * w0[2], bfhi(lo1.y) * w0[3]); \
          o.z = cvt_pk_bf16(bflo(hi1.x) * w1[0], bfhi(hi1.x) * w1[1]); o.w = cvt_pk_bf16(bflo(hi1.y) * w1[2], bfhi(hi1.y) * w1[3]); \
          const bf16x8 vw = __builtin_bit_cast(bf16x8, o); \
          Ct[0][c] = __builtin_amdgcn_mfma_f32_16x16x32_bf16(kt[0][1], vw, Ct[0][c], 0, 0, 0); Ct[1][c] = __builtin_amdgcn_mfma_f32_16x16x32_bf16(kt[1][1], vw, Ct[1][c], 0, 0, 0); } }
    {
        uint2 vr[4][4];
        tr_read_4c(sV, g, lr, vr);
        MA_TILE(0, vr[0][0], vr[0][1], vr[0][2], vr[0][3]) MA_TILE(1, vr[1][0], vr[1][1], vr[1][2], vr[1][3])
        MA_TILE(2, vr[2][0], vr[2][1], vr[2][2], vr[2][3]) MA_TILE(3, vr[3][0], vr[3][1], vr[3][2], vr[3][3])
        tr_read_4c(sV + 8192, g, lr, vr);
        MA_TILE(4, vr[0][0], vr[0][1], vr[0][2], vr[0][3]) MA_TILE(5, vr[1][0], vr[1][1], vr[1][2], vr[1][3])
        MA_TILE(6, vr[2][0], vr[2][1], vr[2][2], vr[2][3]) MA_TILE(7, vr[3][0], vr[3][1], vr[3][2], vr[3][3])
        const uint2 o0 = tr_frag(sV + 16384, 0, 0, g, lr), o1 = tr_frag(sV + 16384, 16, 0, g, lr), o2 = tr_frag(sV + 16384, 32, 0, g, lr), o3 = tr_frag(sV + 16384, 48, 0, g, lr);
        MA_TILE(8, o0, o1, o2, o3)
    }
#undef MA_TILE
    unsigned char* slot = P.ws + WS_MST + ((size_t)bh * 33 + k) * ST_IMG;
#pragma unroll
    for (int a = 0; a < 2; ++a)
#pragma unroll
        for (int c = 0; c < 9; ++c) {
            uint2 u; u.x = cvt_pk_bf16(Ct[a][c][0], Ct[a][c][1]); u.y = cvt_pk_bf16(Ct[a][c][2], Ct[a][c][3]);
            *(uint2*)(slot + st_piece_off(2 * w + a, c, g, lr)) = u;
        }
}

__device__ __forceinline__ void mlstm_B(const Params& P, int item) {
    const int tid = opaque_tid();
    const int bh = item / 3, part = item - bh * 3;
    const unsigned char* base = P.ws + WS_MST + (size_t)bh * 33 * ST_IMG + part * 12288 + tid * 48;
    unsigned char* obase = P.ws + WS_CBI + (size_t)bh * 33 * ST_IMG + part * 12288 + tid * 48;
    float* msc = (float*)(P.ws + WS_MSC) + (size_t)bh * 33 * 4;
    float C[6][4];
#pragma unroll
    for (int i = 0; i < 6; ++i)
#pragma unroll
        for (int r = 0; r < 4; ++r) C[i][r] = 0.f;
    float m = 0.f;
    uint2 d0[6], d1[6];
    float2 ab0, ab1;
#pragma unroll
    for (int i = 0; i < 6; ++i) { d0[i] = *(const uint2*)(base + i * 8); d1[i] = *(const uint2*)(base + ST_IMG + i * 8); }
    ab0 = *(const float2*)(msc); ab1 = *(const float2*)(msc + 4);
    for (int k = 0; k < 33; ++k) {
        uint2 d2[6]; float2 ab2 = make_float2(0.f, 0.f);
        if (k + 2 < 33) {
#pragma unroll
            for (int i = 0; i < 6; ++i) d2[i] = *(const uint2*)(base + (size_t)(k + 2) * ST_IMG + i * 8);
            ab2 = *(const float2*)(msc + (k + 2) * 4);
        } else {
#pragma unroll
            for (int i = 0; i < 6; ++i) d2[i] = make_uint2(0, 0);
        }
#pragma unroll
        for (int i = 0; i < 6; ++i) {
            uint2 u; u.x = cvt_pk_bf16(C[i][0], C[i][1]); u.y = cvt_pk_bf16(C[i][2], C[i][3]);
            *(uint2*)(obase + (size_t)k * ST_IMG + i * 8) = u;
        }
        if (tid == 0 && part == 0) msc[k * 4 + 2] = m;
        const float M = fmaxf(m, ab0.x);
        const float decay = __expf(m - M), sc = __expf(ab0.x - M);
#pragma unroll
        for (int i = 0; i < 6; ++i) {
            C[i][0] = decay * C[i][0] + sc * bflo(d0[i].x); C[i][1] = decay * C[i][1] + sc * bfhi(d0[i].x);
            C[i][2] = decay * C[i][2] + sc * bflo(d0[i].y); C[i][3] = decay * C[i][3] + sc * bfhi(d0[i].y);
        }
        m = ab0.y + M;
#pragma unroll
        for (int i = 0; i < 6; ++i) { d0[i] = d1[i]; d1[i] = d2[i]; }
        ab0 = ab1; ab1 = ab2;
    }
}

__device__ __forceinline__ void mlstm_C(const Params& P, int item, unsigned char* smem) {
    const int tid = opaque_tid(), lane = tid & 63, w = tid >> 6, g = lane >> 4, lr = lane & 15;
    const int wu = __builtin_amdgcn_readfirstlane(w);
    const int k = item >> 5, bh = item & 31, b = bh >> 2, h = bh & 3;
    const bf16_t* z = (const bf16_t*)(P.ws + WS_Z);
    const bf16_t* qk = (const bf16_t*)(P.ws + WS_RA);
    const float* gates = (const float*)(P.ws + WS_GATES);
    bf16_t* y = (bf16_t*)(P.ws + WS_Z);
    const unsigned char* sK = smem; const unsigned char* sV = smem + 36864; unsigned char* sCb = smem;
    float* ga = (float*)(smem + 61440);
    const int pos = 64 * k + 16 * w + lr;
    const bool tvalid = pos < L;
    const size_t rrow = (size_t)(b * L + (tvalid ? pos : 0));
    const unsigned char* cslot = P.ws + WS_CBI + ((size_t)bh * 33 + k) * ST_IMG + tid * 16;
    const uint4 cb0 = *(const uint4*)(cslot), cb1 = *(const uint4*)(cslot + 4096), cb2 = *(const uint4*)(cslot + 8192), cb3 = *(const uint4*)(cslot + 12288), cb4 = *(const uint4*)(cslot + 16384),
                cb5 = *(const uint4*)(cslot + 20480), cb6 = *(const uint4*)(cslot + 24576), cb7 = *(const uint4*)(cslot + 28672), cb8 = *(const uint4*)(cslot + 32768);
    bf16x8 qf[4];
    {
        const bf16_t* qp = qk + rrow * 1024 + h * 128 + 8 * g;
#pragma unroll
        for (int ks = 0; ks < 4; ++ks) { qf[ks] = *(const bf16x8*)(qp + 32 * ks); if (!tvalid) qf[ks] = (bf16x8){0, 0, 0, 0, 0, 0, 0, 0}; }
    }
    mlstm_stage_kv(P, b, h, k, smem, smem + 36864, tid);
    if (wu == 0) {
        const float m_prev = ((const float*)(P.ws + WS_MSC))[((size_t)bh * 33 + k) * 4 + 2];
        const int p2 = 64 * k + lane;
        float lf = 0.f, li = -INFINITY;
        if (p2 < L) { lf = gates[(size_t)(b * L + p2) * 16 + 4 + h]; li = gates[(size_t)(b * L + p2) * 16 + h]; }
        float bc = lf;
#pragma unroll
        for (int o = 1; o < 64; o <<= 1) { const float n = __shfl_up(bc, o, 64); if (lane >= o) bc += n; }
        const float a = li - bc;
        float am = a;
#pragma unroll
        for (int o = 1; o < 64; o <<= 1) { const float n = __shfl_up(am, o, 64); if (lane >= o) am = fmaxf(am, n); }
        const float M = fmaxf(m_prev, am);
        ga[lane] = a; ga[64 + lane] = __expf(m_prev - M); ga[128 + lane] = __expf(-(bc + M)); ga[192 + lane] = M;
    }
    __syncthreads();
    const float Mt = ga[192 + 16 * w + lr], Wi = ga[64 + 16 * w + lr], Et = ga[128 + 16 * w + lr];
    bf16x8 pf[2];
    {
        f32x4 sa[4];
#pragma unroll
        for (int c = 0; c < 4; ++c) {
            sa[c] = (f32x4){0.f, 0.f, 0.f, 0.f};
            if (c <= wu) {
#pragma unroll
                for (int ks = 0; ks < 4; ++ks) {
                    const bf16x8 kf = *(const bf16x8*)(sK + (ks >> 1) * 8192 + vimg_off(16 * c + lr, 4 * (ks & 1) + g));
                    sa[c] = __builtin_amdgcn_mfma_f32_16x16x32_bf16(kf, qf[ks], sa[c], 0, 0, 0);
                }
                const f32x4 av = *(const f32x4*)(ga + 16 * c + 4 * g);
#pragma unroll
                for (int r = 0; r < 4; ++r) {
                    const float d = __expf(av[r] - Mt);
                    sa[c][r] = (16 * c + 4 * g + r <= 16 * w + lr) ? sa[c][r] * d : 0.f;
                }
            }
        }
#pragma unroll
        for (int s2 = 0; s2 < 2; ++s2) {
            uint4 u;
            u.x = cvt_pk_bf16(sa[2 * s2][0], sa[2 * s2][1]); u.y = cvt_pk_bf16(sa[2 * s2][2], sa[2 * s2][3]);
            u.z = cvt_pk_bf16(sa[2 * s2 + 1][0], sa[2 * s2 + 1][1]); u.w = cvt_pk_bf16(sa[2 * s2 + 1][2], sa[2 * s2 + 1][3]);
            pf[s2] = __builtin_bit_cast(bf16x8, u);
        }
    }
    __syncthreads();
    {
        unsigned char* d = sCb + tid * 16;
        *(uint4*)(d) = cb0; *(uint4*)(d + 4096) = cb1; *(uint4*)(d + 8192) = cb2; *(uint4*)(d + 12288) = cb3; *(uint4*)(d + 16384) = cb4;
        *(uint4*)(d + 20480) = cb5; *(uint4*)(d + 24576) = cb6; *(uint4*)(d + 28672) = cb7; *(uint4*)(d + 32768) = cb8;
    }
    __syncthreads();
    f32x4 na[9];
#define MC_TILE(c, lo0, hi0, lo1, hi1) { \
        na[c] = (f32x4){0.f, 0.f, 0.f, 0.f}; \
        _Pragma("unroll") for (int ks = 0; ks < 4; ++ks) { \
            const bf16x8 cf = *(const bf16x8*)(sCb + (ks >> 1) * 18432 + vimg_off(16 * (c) + lr, 4 * (ks & 1) + g)); \
            na[c] = __builtin_amdgcn_mfma_f32_16x16x32_bf16(cf, qf[ks], na[c], 0, 0, 0); } \
        na[c] *= Wi; \
        na[c] = __builtin_amdgcn_mfma_f32_16x16x32_bf16(tr_pair(lo0, hi0), pf[0], na[c], 0, 0, 0); \
        na[c] = __builtin_amdgcn_mfma_f32_16x16x32_bf16(tr_pair(lo1, hi1), pf[1], na[c], 0, 0, 0); }
    {
        uint2 vr[4][4];
        tr_read_4c(sV, g, lr, vr);
        MC_TILE(0, vr[0][0], vr[0][1], vr[0][2], vr[0][3]) MC_TILE(1, vr[1][0], vr[1][1], vr[1][2], vr[1][3])
        MC_TILE(2, vr[2][0], vr[2][1], vr[2][2], vr[2][3]) MC_TILE(3, vr[3][0], vr[3][1], vr[3][2], vr[3][3])
        tr_read_4c(sV + 8192, g, lr, vr);
        MC_TILE(4, vr[0][0], vr[0][1], vr[0][2], vr[0][3]) MC_TILE(5, vr[1][0], vr[1][1], vr[1][2], vr[1][3])
        MC_TILE(6, vr[2][0], vr[2][1], vr[2][2], vr[2][3]) MC_TILE(7, vr[3][0], vr[3][1], vr[3][2], vr[3][3])
        const uint2 o0 = tr_frag(sV + 16384, 0, 0, g, lr), o1 = tr_frag(sV + 16384, 16, 0, g, lr), o2 = tr_frag(sV + 16384, 32, 0, g, lr), o3 = tr_frag(sV + 16384, 48, 0, g, lr);
        MC_TILE(8, o0, o1, o2, o3)
    }
#undef MC_TILE
    const float den = __shfl(na[8][0], lr, 64);
    const float rden = 1.0f / fmaxf(fabsf(den), Et);
    float hs = 0.f;
#pragma unroll
    for (int c = 0; c < 8; ++c) { na[c] *= rden; hs += na[c][0] * na[c][0] + na[c][1] * na[c][1] + na[c][2] * na[c][2] + na[c][3] * na[c][3]; }
    hs += __shfl_xor(hs, 16, 64); hs += __shfl_xor(hs, 32, 64);
    const float rstd = rsqrtf(hs * (1.0f / 128.0f) + EPS);
    const float* gainp = P.m_out_norm + h * 128 + 4 * g;
#pragma unroll
    for (int c = 0; c < 8; ++c) {
        const uint2 og = *(const uint2*)(z + rrow * NZ + ZC_MO + h * 128 + 16 * c + 4 * g);
        const float o0 = bflo(og.x), o1 = bfhi(og.x), o2 = bflo(og.y), o3 = bfhi(og.y);
        const float4 gn = *(const float4*)(gainp + 16 * c);
        uint2 u;
        u.x = pk2(na[c][0] * rstd * gn.x / (1.f + __expf(-o0)), na[c][1] * rstd * gn.y / (1.f + __expf(-o1)));
        u.y = pk2(na[c][2] * rstd * gn.z / (1.f + __expf(-o2)), na[c][3] * rstd * gn.w / (1.f + __expf(-o3)));
        if (tvalid) *(uint2*)(y + rrow * NZ + h * 128 + 16 * c + 4 * g) = u;
    }
}

__device__ __forceinline__ void peer_token(const Params& P, int t, int lane, int* sidx, float* sval, int* sid, float* sgate, const unsigned char* slut, const unsigned* szero) {
    const unsigned* tk = (const unsigned*)(P.ws + WS_TK) + (size_t)t * 256;
#pragma unroll
    for (int i = 0; i < 4; ++i) {
        const unsigned k = tk[lane * 4 + i];
        sidx[lane * 4 + i] = 127 - (int)(k & 127u);
        sval[lane * 4 + i] = unord_key(k & ~127u);
    }
    __builtin_amdgcn_s_waitcnt(0xc07f);
    __builtin_amdgcn_wave_barrier();
    {
        const int hd = lane >> 3, sub = lane & 7;
        unsigned x[8];
#pragma unroll
        for (int r = 0; r < 8; ++r) {
            const int c = sub * 8 + r;
            const unsigned ij = slut[c < 50 ? c : 0];
            const int i = ij >> 4, j = ij & 15;
            const unsigned kx = (ord_key(sval[(2 * hd) * 16 + i] + sval[(2 * hd + 1) * 16 + j]) & ~255u) | (unsigned)(255 - (i * 16 + j));
            x[r] = c < 50 ? kx : 0u;
        }
#pragma unroll
        for (int k = 2; k <= 64; k <<= 1) {
#pragma unroll
            for (int j = k >> 1; j >= 1; j >>= 1) {
                if (j >= 8) {
                    const int ld = j >> 3;
                    const bool lower = (sub & ld) == 0;
                    const bool desc = k >= 64 ? true : ((sub * 8) & k) == 0;
                    const bool takemax = (lower == desc);
#pragma unroll
                    for (int r = 0; r < 8; ++r) {
                        const unsigned o = (unsigned)__shfl_xor((int)x[r], ld, 64);
                        const unsigned hi = max(x[r], o), lo = min(x[r], o);
                        x[r] = takemax ? hi : lo;
                    }
                } else {
#pragma unroll
                    for (int r = 0; r < 8; ++r) {
                        if ((r & j) == 0) {
                            const int p = r | j;
                            const unsigned hi = max(x[r], x[p]), lo = min(x[r], x[p]);
                            if (k <= 4) { const bool desc = (r & k) == 0; x[r] = desc ? hi : lo; x[p] = desc ? lo : hi; }
                            else if (k >= 64) { x[r] = hi; x[p] = lo; }
                            else { const bool desc = ((sub * 8) & k) == 0; x[r] = desc ? hi : lo; x[p] = desc ? lo : hi; }
                        }
                    }
                }
            }
        }
        const float smax = unord_key((unsigned)__shfl((int)x[0], hd * 8, 64) & ~255u);
        float e[8]; float den = 0.f;
#pragma unroll
        for (int r = 0; r < 8; ++r) { e[r] = __expf(unord_key(x[r] & ~255u) - smax); den += e[r]; }
        den += __shfl_xor(den, 1, 64);
        const float inv = 1.f / den;
        if (sub < 2) {
#pragma unroll
            for (int r = 0; r < 8; ++r) {
                const int pos = 255 - (int)(x[r] & 255u), i = pos >> 4, j = pos & 15;
                sid[hd * 16 + sub * 8 + r] = sidx[(2 * hd) * 16 + i] * 128 + sidx[(2 * hd + 1) * 16 + j];
                sgate[hd * 16 + sub * 8 + r] = e[r] * inv;
            }
        }
    }
    __builtin_amdgcn_s_waitcnt(0xc07f);
    __builtin_amdgcn_wave_barrier();
    const bf16_t* xn = (const bf16_t*)(P.ws + WS_XN) + (size_t)t * DM;
    const float rstd = ((const float*)(P.ws + WS_RSTD))[t];
    const unsigned char* V = P.ws + WS_V + lane * 8;
    const float* usc = (const float*)(P.ws + WS_USC);
    const float* vsc = (const float*)(P.ws + WS_VSC);
    const int g = lane >> 4, lr = lane & 15;
    unsigned char* shi = (unsigned char*)sval;
    unsigned char* slo = (unsigned char*)sidx;
    {
        const uint4 xa = *(const uint4*)(xn + lane * 16), xb = *(const uint4*)(xn + lane * 16 + 8);
        const unsigned xw[8] = {xa.x, xa.y, xa.z, xa.w, xb.x, xb.y, xb.z, xb.w};
        unsigned hi[4], lo[4];
#pragma unroll
        for (int i = 0; i < 4; ++i) {
            const float x0 = bflo(xw[2 * i]), x1 = bfhi(xw[2 * i]), x2 = bflo(xw[2 * i + 1]), x3 = bfhi(xw[2 * i + 1]);
            int wd = 0;
            wd = __builtin_amdgcn_cvt_pk_fp8_f32(x0, x1, wd, false);
            wd = __builtin_amdgcn_cvt_pk_fp8_f32(x2, x3, wd, true);
            const f32x2 h01 = __builtin_amdgcn_cvt_pk_f32_fp8(wd, false), h23 = __builtin_amdgcn_cvt_pk_f32_fp8(wd, true);
            int wl = 0;
            wl = __builtin_amdgcn_cvt_pk_fp8_f32(x0 - h01.x, x1 - h01.y, wl, false);
            wl = __builtin_amdgcn_cvt_pk_fp8_f32(x2 - h23.x, x3 - h23.y, wl, true);
            hi[i] = (unsigned)wd; lo[i] = (unsigned)wl;
        }
        *(uint4*)(shi + lane * 16) = make_uint4(hi[0], hi[1], hi[2], hi[3]);
        *(uint4*)(slo + lane * 16) = make_uint4(lo[0], lo[1], lo[2], lo[3]);
    }
    __builtin_amdgcn_s_waitcnt(0xc07f);
    __builtin_amdgcn_wave_barrier();
    {
        typedef int v8i __attribute__((ext_vector_type(8)));
        const unsigned char* Ub = P.ws + WS_U + 16 * g;
        const unsigned char* bsrc = (lr == 0) ? (shi + 16 * g) : (lr == 1) ? (slo + 16 * g) : (const unsigned char*)szero;
        const int bstep = (lr < 2) ? 128 : 0, bhalf = (lr < 2) ? 64 : 16;
        v8i Bv[8];
#pragma unroll
        for (int st = 0; st < 8; ++st) {
            const uint4 b0 = *(const uint4*)(bsrc + bstep * st), b1 = *(const uint4*)(bsrc + bstep * st + bhalf);
            Bv[st] = (v8i){(int)b0.x, (int)b0.y, (int)b0.z, (int)b0.w, (int)b1.x, (int)b1.y, (int)b1.z, (int)b1.w};
        }
        unsigned off[8];
#pragma unroll
        for (int T = 0; T < 8; ++T) off[T] = (unsigned)sid[16 * T + lr] * 512u;
        __builtin_amdgcn_s_waitcnt(0xc07f);
        __builtin_amdgcn_wave_barrier();
        float* sact = (float*)sidx + ((lr == 1) ? 128 : 0);
        uint4 abuf[2][8];
#pragma unroll
        for (int st = 0; st < 8; ++st) abuf[0][st] = *(const uint4*)(Ub + off[0] + 64 * st);
#pragma unroll
        for (int T = 0; T < 8; ++T) {
            if (T + 1 < 8) {
#pragma unroll
                for (int st = 0; st < 8; ++st) abuf[(T + 1) & 1][st] = *(const uint4*)(Ub + off[T + 1] + 64 * st);
            }
            f32x4 au = (f32x4){0.f, 0.f, 0.f, 0.f};
#pragma unroll
            for (int st = 0; st < 8; ++st) {
                const uint4 a4 = abuf[T & 1][st];
                const v8i Av = {(int)a4.x, (int)a4.y, (int)a4.z, (int)a4.w, 0, 0, 0, 0};
                au = __builtin_amdgcn_mfma_scale_f32_16x16x128_f8f6f4(Av, Bv[st], au, 4, 0, 0, 0x7f7f7f7f, 0, 0x7f7f7f7f);
            }
            if (lr < 2) *(f32x4*)(sact + 16 * T + 4 * g) = au;
        }
    }
    __builtin_amdgcn_s_waitcnt(0xc07f);
    __builtin_amdgcn_wave_barrier();
    {
        float* sw = (float*)sidx;
        float wv[2];
#pragma unroll
        for (int hh = 0; hh < 2; ++hh) {
            const int e = lane + 64 * hh, id = sid[e];
            const float a = (sw[e] + sw[128 + e]) * usc[id] * rstd;
            wv[hh] = sgate[e] * vsc[id] * 0.5f * a * (1.f + erff(a * 0.70710678118654752f));
        }
        sw[lane] = wv[0]; sw[lane + 64] = wv[1];
    }
    __builtin_amdgcn_s_waitcnt(0xc07f);
    __builtin_amdgcn_wave_barrier();
    f32x2 acc[8];
#pragma unroll
    for (int j = 0; j < 8; ++j) acc[j] = (f32x2){0.f, 0.f};
#pragma unroll 1
    for (int e0 = 0; e0 < 128; e0 += 16) {
        uint2 vr[16];
#pragma unroll
        for (int q = 0; q < 16; ++q) vr[q] = *(const uint2*)(V + (size_t)sid[e0 + q] * 512);
        const float* sw = (const float*)sidx + e0;
        const f32x4 w0 = *(const f32x4*)(sw), w1 = *(const f32x4*)(sw + 4), w2 = *(const f32x4*)(sw + 8), w3 = *(const f32x4*)(sw + 12);
        const float wq[16] = {w0[0], w0[1], w0[2], w0[3], w1[0], w1[1], w1[2], w1[3], w2[0], w2[1], w2[2], w2[3], w3[0], w3[1], w3[2], w3[3]};
#pragma unroll
        for (int q = 0; q < 16; ++q) {
            const float w = wq[q];
#define FP4_AXPY(k) { acc[k] += w * __builtin_amdgcn_cvt_scalef32_pk_f32_fp4(vr[q].x, 1.0f, k); acc[4 + k] += w * __builtin_amdgcn_cvt_scalef32_pk_f32_fp4(vr[q].y, 1.0f, k); }
            FP4_AXPY(0) FP4_AXPY(1) FP4_AXPY(2) FP4_AXPY(3)
#undef FP4_AXPY
        }
    }
    f32x2 xf[8];
    {
        const uint4 xa = *(const uint4*)(xn + lane * 16), xb = *(const uint4*)(xn + lane * 16 + 8);
        xf[0] = (f32x2){bflo(xa.x), bfhi(xa.x)}; xf[1] = (f32x2){bflo(xa.y), bfhi(xa.y)}; xf[2] = (f32x2){bflo(xa.z), bfhi(xa.z)}; xf[3] = (f32x2){bflo(xa.w), bfhi(xa.w)};
        xf[4] = (f32x2){bflo(xb.x), bfhi(xb.x)}; xf[5] = (f32x2){bflo(xb.y), bfhi(xb.y)}; xf[6] = (f32x2){bflo(xb.z), bfhi(xb.z)}; xf[7] = (f32x2){bflo(xb.w), bfhi(xb.w)};
    }
    float* o = P.out + (size_t)t * DM + lane * 16;
    float4 h0, h1, h2, h3;
    {
        const float4 g0 = *(const float4*)(P.norm_ffn + lane * 16), g1 = *(const float4*)(P.norm_ffn + lane * 16 + 4), g2 = *(const float4*)(P.norm_ffn + lane * 16 + 8), g3 = *(const float4*)(P.norm_ffn + lane * 16 + 12);
        h0.x = xf[0].x / g0.x + acc[0].x; h0.y = xf[0].y / g0.y + acc[0].y; h0.z = xf[1].x / g0.z + acc[1].x; h0.w = xf[1].y / g0.w + acc[1].y;
        h1.x = xf[2].x / g1.x + acc[2].x; h1.y = xf[2].y / g1.y + acc[2].y; h1.z = xf[3].x / g1.z + acc[3].x; h1.w = xf[3].y / g1.w + acc[3].y;
        h2.x = xf[4].x / g2.x + acc[4].x; h2.y = xf[4].y / g2.y + acc[4].y; h2.z = xf[5].x / g2.z + acc[5].x; h2.w = xf[5].y / g2.w + acc[5].y;
        h3.x = xf[6].x / g3.x + acc[6].x; h3.y = xf[6].y / g3.y + acc[6].y; h3.z = xf[7].x / g3.z + acc[7].x; h3.w = xf[7].y / g3.w + acc[7].y;
    }
    *(float4*)(o) = h0; *(float4*)(o + 4) = h1; *(float4*)(o + 8) = h2; *(float4*)(o + 12) = h3;
    __builtin_amdgcn_s_waitcnt(0xc07f);
    __builtin_amdgcn_wave_barrier();
}

#define LAS __attribute__((address_space(3)))
#define XB_TMO      128
#define XB_XCNT(j)  (256  + 64 * (j))
#define XB_XSUB(j)  (1280 + 64 * (j))
#define XB_XGEN(j)  (2304 + 64 * (j))
#define XB_TOP      3328
#define XB_TOPGEN   3392
#define XCD_BAR_WORDS 3456
#define XB_SPIN_CAP (1u << 18)
__device__ __forceinline__ unsigned xb_ld(unsigned* p)              { return __hip_atomic_load(p, __ATOMIC_RELAXED, __HIP_MEMORY_SCOPE_AGENT); }
__device__ __forceinline__ unsigned xb_add(unsigned* p, unsigned v) { return __hip_atomic_fetch_add(p, v, __ATOMIC_RELAXED, __HIP_MEMORY_SCOPE_AGENT); }
__device__ __forceinline__ unsigned xb_xcc_id() { return (unsigned)__builtin_amdgcn_s_getreg((3 << 11) | 20) & 0xFu; }
#define XB_SPIN(cond, bar) do { unsigned _sp = 0; while (cond) { __builtin_amdgcn_s_sleep(1); \
    if ((++_sp & 255u) == 0u) { if (xb_ld(&(bar)[XB_TMO])) break; if (_sp > XB_SPIN_CAP) { atomicAdd(&(bar)[XB_TMO], 1u); break; } } } } while (0)
struct XcdBarrier { unsigned* bar; unsigned x; volatile LAS unsigned* st; };
__device__ __forceinline__ XcdBarrier xcd_barrier_post(unsigned* bar, volatile LAS unsigned* st) {
    XcdBarrier b; b.bar = bar; b.x = xb_xcc_id(); b.st = st;
    if (threadIdx.x == 0) (void)xb_add(&bar[XB_XCNT(b.x)], 1u);
    return b;
}
__device__ __forceinline__ void xcd_barrier_complete(unsigned* bar, unsigned x, unsigned& nloc, unsigned& nx) {
    const unsigned G = gridDim.x * gridDim.y * gridDim.z;
    unsigned sum, cnt, mine, sp = 0u;
    for (;;) {
        sum = 0u; cnt = 0u; mine = 0u;
#pragma unroll
        for (unsigned j = 0; j < 16; ++j) { const unsigned c = xb_ld(&bar[XB_XCNT(j)]); sum += c; cnt += (c > 0u) ? 1u : 0u; mine = (j == x) ? c : mine; }
        if (sum == G) break;
        __builtin_amdgcn_s_sleep(1);
        if ((++sp & 255u) == 0u) { if (xb_ld(&bar[XB_TMO])) break; if (sp > XB_SPIN_CAP) { atomicAdd(&bar[XB_TMO], 1u); break; } }
    }
    nloc = mine > 0u ? mine : 1u; nx = cnt > 0u ? cnt : 1u;
}
__device__ __forceinline__ void xcd_barrier(const XcdBarrier& b) {
    asm volatile("s_waitcnt vmcnt(0)" ::: "memory");
    __syncthreads();
    if (threadIdx.x == 0) {
        unsigned* bar = b.bar;
        __builtin_amdgcn_s_waitcnt(0);
        unsigned nloc = b.st[0], nx = b.st[1];
        if (nloc == 0u) { xcd_barrier_complete(bar, b.x, nloc, nx); b.st[0] = nloc; b.st[1] = nx; }
        const unsigned old = xb_add(&bar[XB_XSUB(b.x)], 1u);
        const unsigned gen = old / nloc;
        if (old + 1u == (gen + 1u) * nloc) {
            __builtin_amdgcn_fence(__ATOMIC_RELEASE, "agent");
            asm volatile("s_waitcnt vmcnt(0)" ::: "memory");
            const unsigned og = xb_add(&bar[XB_TOP], 1u);
            const unsigned tg = og / nx;
            if (og + 1u == (tg + 1u) * nx) xb_add(&bar[XB_TOPGEN], 1u);
            else XB_SPIN(xb_ld(&bar[XB_TOPGEN]) == tg, bar);
            __builtin_amdgcn_fence(__ATOMIC_ACQUIRE, "agent");
            xb_add(&bar[XB_XGEN(b.x)], 1u);
            asm volatile("s_waitcnt vmcnt(0)" ::: "memory");
        } else {
            XB_SPIN(xb_ld(&bar[XB_XGEN(b.x)]) == gen, bar);
            __builtin_amdgcn_fence(__ATOMIC_ACQUIRE, "agent");
            asm volatile("s_waitcnt vmcnt(0)" ::: "memory");
        }
    }
    __syncthreads();
}

__device__ __forceinline__ void hand_release() { asm volatile("s_waitcnt vmcnt(0)" ::: "memory"); __builtin_amdgcn_fence(__ATOMIC_RELEASE, "agent"); asm volatile("s_waitcnt vmcnt(0)" ::: "memory"); }
__device__ __forceinline__ void hand_acquire() { __builtin_amdgcn_fence(__ATOMIC_ACQUIRE, "agent"); asm volatile("s_waitcnt vmcnt(0)" ::: "memory"); }

__global__ void __launch_bounds__(256, 2) mega(Params P) {
    extern __shared__ __attribute__((aligned(16))) unsigned char smem[];
    const int tid = threadIdx.x, lane = tid & 63, wave = tid >> 6;
    const int G = gridDim.x, bid = blockIdx.x;
    unsigned* ctl = (unsigned*)(P.ws + WS_CTL);
    volatile LAS unsigned* bst = (volatile LAS unsigned*)(smem + 65552);
    if (tid == 0) { bst[0] = 0u; bst[1] = 0u; }
    __syncthreads();
    const XcdBarrier xb = xcd_barrier_post(ctl + 1024, bst);
    unsigned* cucnt = ctl + 5120;
    if (tid == 0) {
        const unsigned phys = ((xb_xcc_id() & 7u) << 8) | ((unsigned)__builtin_amdgcn_s_getreg((7 << 11) | (8 << 6) | 4) & 0xFFu);
        bst[2] = phys; bst[3] = xb_add(&cucnt[phys], 1u);
    }
    phase0(P, smem);
    xcd_barrier(xb);
    {
        int vb;
        const unsigned phys = bst[2];
        unsigned part = 0;
#pragma unroll
        for (int q = 0; q < 8; ++q) { const unsigned i = (unsigned)(tid + 256 * q); const unsigned c = xb_ld(&cucnt[i]); part += (i < phys) ? c : 0u; }
#pragma unroll
        for (int o = 1; o < 64; o <<= 1) part += (unsigned)__shfl_xor((int)part, o, 64);
        if (lane == 0) bst[4 + wave] = part;
        __syncthreads();
        vb = (int)(bst[4] + bst[5] + bst[6] + bst[7] + bst[3]);
        vb = __builtin_amdgcn_readfirstlane(vb);
        if (vb < 0 || vb >= G) vb = bid;
        __syncthreads();
        if (tid == 0) bst[8] = (unsigned)vb;
        __syncthreads();
    }
#define VB_LOAD() __builtin_amdgcn_readfirstlane((int)bst[8])
    {
        const int gw = bid * 4 + wave;
        if (gw < 64) fox_cum_wave(P, gw, lane);
        const int vb = VB_LOAD();
        for (int tile = vb; tile < 129 * 28; tile += G) gemm_tile<1>(P, tile / 28, tile % 28, smem);
        {
            const int rem = (129 * 28) % G;
            if (rem > 0 && rem < G) { if (vb >= rem) convert_uv_rows(P, (vb - rem) * 4 + wave, (G - rem) * 4, lane); }
            else convert_uv_rows(P, vb * 4 + wave, G * 4, lane);
        }
    }
    xcd_barrier(xb);
    {
        volatile int* s_item = (volatile int*)(smem + 65536);
        const int wave_u = __builtin_amdgcn_readfirstlane(wave);
        auto fetch = [&](unsigned* counter) -> int {
            if (wave_u == 0) {
                unsigned v = atomicAdd(counter, lane == 0 ? 1u : 0u);
                *s_item = (int)__builtin_amdgcn_readfirstlane(v);
            }
            __syncthreads();
            const int item = __builtin_amdgcn_readfirstlane(*s_item);
            __syncthreads();
            return item;
        };
        for (;;) {
            const int item = fetch(&ctl[2]);
            if (item >= 33 * 32) break;
            mlstm_A(P, item, smem);
        }
        xcd_barrier(xb);
        for (;;) {
            const int item = fetch(&ctl[4]);
            if (item >= 96) break;
            mlstm_B(P, item);
        }
        for (;;) {
            const int item = fetch(&ctl[3]);
            if (item >= 64 * 17) break;
            attn_block(P, item & 63, 16 - (item >> 6), smem);
        }
        xcd_barrier(xb);
        for (;;) {
            const int item = fetch(&ctl[5]);
            if (item >= 33 * 32) break;
            mlstm_C(P, item, smem);
        }
    }
    xcd_barrier(xb);
    for (int tile = VB_LOAD(); tile < 128 * 8; tile += G) gemm_tile<2>(P, tile >> 3, tile & 7, smem);
    xcd_barrier(xb);
    for (int tile = VB_LOAD(); tile < 128 * 16; tile += G) gemm_tile<3>(P, tile >> 4, tile & 15, smem);
    xcd_barrier(xb);
    {
        unsigned char* slut = smem + 12288;
        if (tid < 64) {
            int c = tid, i = 0;
            while (i < 16 && c >= 16 / (i + 1)) { c -= 16 / (i + 1); ++i; }
            slut[tid] = (unsigned char)(i < 16 ? ((i << 4) | c) : 0);
        }
        unsigned* szero = (unsigned*)(smem + 12288 + 64);
        if (tid < 16) szero[tid] = 0u;
        __syncthreads();
        int* sidx = (int*)(smem + wave * 3072); float* sval = (float*)(smem + wave * 3072 + 1024);
        int* sid = (int*)(smem + wave * 3072 + 2048); float* sgate = (float*)(smem + wave * 3072 + 2560);
        int lane5 = lane;
        asm volatile("" : "+v"(lane5));
        for (int t = bid * 4 + wave; t < T2; t += G * 4) peer_token(P, t, lane5, sidx, sval, sid, sgate, slut, szero);
    }
}

}

extern "C" void kernel_launch(void* const* d_in, const int* in_sizes, int n_in, void* d_out, int out_size, void* d_ws, size_t ws_size, hipStream_t stream) {
    if (n_in != 17 || ws_size < WS_END) { fprintf(stderr, "kernel_launch: unexpected n_in %d or ws_size %zu (need %zu)\n", n_in, ws_size, (size_t)WS_END); return; }
    constexpr int LDS_BYTES = 66560;
    static int grid_blocks = 0;
    if (!grid_blocks) {
        int dev = 0, cus = 0, per_cu = 0;
        (void)hipGetDevice(&dev);
        (void)hipDeviceGetAttribute(&cus, hipDeviceAttributeMultiprocessorCount, dev);
        (void)hipFuncSetAttribute((const void*)mega, hipFuncAttributeMaxDynamicSharedMemorySize, LDS_BYTES);
        (void)hipOccupancyMaxActiveBlocksPerMultiprocessor(&per_cu, (const void*)mega, 256, LDS_BYTES);
        if (per_cu < 1) per_cu = 1;
        if (per_cu > 2) per_cu = 2;
        grid_blocks = cus * per_cu;
        fprintf(stderr, "kernel_launch: cus %d per_cu %d grid %d\n", cus, per_cu, grid_blocks);
    }
    Params P{};
    P.x = (const float*)d_in[0]; P.meta = (const float*)d_in[1]; P.norm_mix = (const float*)d_in[2]; P.w_in = (const float*)d_in[3];
    P.conv_qk = (const float*)d_in[4]; P.b_igate = (const float*)d_in[5]; P.b_fgate_m = (const float*)d_in[6]; P.m_out_norm = (const float*)d_in[7];
    P.b_fgate_f = (const float*)d_in[8]; P.f_q_norm = (const float*)d_in[9]; P.f_k_norm = (const float*)d_in[10]; P.w_out = (const float*)d_in[11];
    P.norm_ffn = (const float*)d_in[12]; P.peer_query = (const float*)d_in[13]; P.peer_keys = (const float*)d_in[14]; P.peer_u = (const float*)d_in[15];
    P.peer_v = (const float*)d_in[16]; P.out = (float*)d_out; P.ws = (unsigned char*)d_ws;
    (void)hipMemsetAsync((unsigned char*)d_ws + WS_CTL, 0, 32768, stream);
    void* args[] = {&P};
    hipError_t e = hipLaunchCooperativeKernel((const void*)mega, dim3(grid_blocks), dim3(256), args, LDS_BYTES, stream);
    if (e != hipSuccess) fprintf(stderr, "cooperative launch failed: %s (grid %d)\n", hipGetErrorString(e), grid_blocks);
}
```

```cpp
#include <hip/hip_runtime.h>
#include <stdint.h>
#include <stdio.h>
#include <hip/hip_cooperative_groups.h>
namespace cg = cooperative_groups;

namespace {

constexpr int NB = 8, SEQ = 2048, DM = 1024, NMETA = 16, L = SEQ + NMETA;
constexpr int T1 = NB * L;
constexpr int T2 = NB * SEQ;
constexpr int NZ = 3584;
constexpr int ZC_MQ = 0, ZC_MK = 512, ZC_MV = 1024, ZC_MO = 1536, ZC_FQ = 2048, ZC_FK = 2560, ZC_FV = 3072;
constexpr int PROJ = 3600;
constexpr float EPS = 1e-6f;

constexpr size_t WS_CTL = 0;
constexpr size_t WS_RA = 65536;
constexpr size_t WS_Z = WS_RA + (size_t)T1 * DM * 2;
constexpr size_t WS_GATES = WS_Z + (size_t)T1 * NZ * 2;
constexpr size_t WS_CUM = WS_GATES + (size_t)T1 * 16 * 4;
constexpr size_t WS_SSQ = WS_CUM + (size_t)NB * 8 * L * 4;
constexpr size_t WS_RSTD = WS_SSQ + (size_t)T2 * 16 * 4;
constexpr size_t WS_SSQM = WS_RSTD + (size_t)T2 * 4;
constexpr size_t WS_BT2 = WS_SSQM + (size_t)T1 * 16 * 4;
constexpr size_t WS_BT3 = WS_BT2 + (size_t)DM * DM * 2;
constexpr size_t WS_KEYS = WS_BT3 + (size_t)2048 * DM * 2;
constexpr size_t WS_MSC = WS_KEYS + (size_t)16 * 128 * 128 * 2;
constexpr size_t WS_MST = WS_MSC + (size_t)128 * 33 * 16;
constexpr size_t WS_BT1 = WS_MST + (size_t)32 * 33 * 36864;
constexpr size_t WS_CBI = WS_BT1;
constexpr size_t WS_UV = WS_CBI + (size_t)32 * 33 * 36864;
constexpr size_t WS_END = WS_UV + (size_t)2 * 16384 * 512 + (size_t)2 * 16384 * 4;
constexpr size_t WS_XN = WS_RA;
constexpr size_t WS_U = WS_UV;
constexpr size_t WS_V = WS_U + (size_t)16384 * 512;
constexpr size_t WS_USC = WS_V + (size_t)16384 * 512;
constexpr size_t WS_VSC = WS_USC + (size_t)16384 * 4;
constexpr size_t WS_TK = WS_CBI;
constexpr float LOG2E = 1.4426950408889634f;

typedef unsigned short bf16_t;
typedef short bf16x8 __attribute__((ext_vector_type(8)));
typedef float f32x4 __attribute__((ext_vector_type(4)));
typedef __attribute__((ext_vector_type(2))) __bf16 bf16x2_t;

struct Params {
    const float* x; const float* meta; const float* norm_mix; const float* w_in; const float* conv_qk;
    const float* b_igate; const float* b_fgate_m; const float* m_out_norm; const float* b_fgate_f;
    const float* f_q_norm; const float* f_k_norm; const float* w_out; const float* norm_ffn;
    const float* peer_query; const float* peer_keys; const float* peer_u; const float* peer_v;
    float* out; unsigned char* ws;
};

__device__ __forceinline__ unsigned f2bf(float f) { unsigned u = __float_as_uint(f); return (u + 0x7fffu + ((u >> 16) & 1u)) >> 16; }
__device__ __forceinline__ float bf2f(unsigned h) { return __uint_as_float(h << 16); }
typedef float f32x2 __attribute__((ext_vector_type(2)));
typedef __bf16 bf16x2v __attribute__((ext_vector_type(2)));
__device__ __forceinline__ unsigned cvt_pk_bf16(float lo, float hi) { f32x2 v = {lo, hi}; bf16x2v b = __builtin_convertvector(v, bf16x2v); return __builtin_bit_cast(unsigned, b); }
__device__ __forceinline__ unsigned pk2(float lo, float hi) { return cvt_pk_bf16(lo, hi); }
__device__ __forceinline__ float bflo(unsigned w) { return __uint_as_float(w << 16); }
__device__ __forceinline__ float bfhi(unsigned w) { return __uint_as_float(w & 0xffff0000u); }
__device__ __forceinline__ float wave_sum(float v) {
#pragma unroll
    for (int o = 32; o > 0; o >>= 1) v += __shfl_xor(v, o, 64);
    return v;
}
__device__ __forceinline__ float wave_max(float v) {
#pragma unroll
    for (int o = 32; o > 0; o >>= 1) v = fmaxf(v, __shfl_xor(v, o, 64));
    return v;
}
__device__ __forceinline__ float logsigmoidf(float x) { return fminf(x, 0.f) - log1pf(expf(-fabsf(x))); }
__device__ __forceinline__ unsigned ord_key(float f) { unsigned u = __float_as_uint(f); return u ^ ((u >> 31) ? 0xffffffffu : 0x80000000u); }
__device__ __forceinline__ float unord_key(unsigned k) { unsigned u = (k & 0x80000000u) ? (k ^ 0x80000000u) : ~k; return __uint_as_float(u); }

__device__ __forceinline__ void phase0(const Params& P, unsigned char* smem) {
    const int tid = threadIdx.x, lane = tid & 63, wave = tid >> 6;
    unsigned* ctl = (unsigned*)(P.ws + WS_CTL);
    float* gw = (float*)smem;
    for (int idx = tid; idx < 16 * 1024; idx += 256) {
        const int k = idx >> 4, c = idx & 15;
        const int col = c < 8 ? 2048 + c : 3592 + (c - 8);
        gw[c * 1024 + k] = P.w_in[(size_t)k * PROJ + col];
    }
    __syncthreads();
    {
        bf16_t* hn = (bf16_t*)(P.ws + WS_RA);
        float* gates = (float*)(P.ws + WS_GATES);
        const int c0 = lane * 8, c1 = 512 + lane * 8;
        float gm[16];
        {
            const float4 a0 = *(const float4*)(P.norm_mix + c0), a1 = *(const float4*)(P.norm_mix + c0 + 4);
            const float4 a2 = *(const float4*)(P.norm_mix + c1), a3 = *(const float4*)(P.norm_mix + c1 + 4);
            gm[0] = a0.x; gm[1] = a0.y; gm[2] = a0.z; gm[3] = a0.w; gm[4] = a1.x; gm[5] = a1.y; gm[6] = a1.z; gm[7] = a1.w;
            gm[8] = a2.x; gm[9] = a2.y; gm[10] = a2.z; gm[11] = a2.w; gm[12] = a3.x; gm[13] = a3.y; gm[14] = a3.z; gm[15] = a3.w;
        }
        const int myq = ((lane >> 5) & 1) * 8 + ((lane >> 4) & 1) * 4 + ((lane >> 3) & 1) * 2 + ((lane >> 2) & 1);
        const float mybias = myq < 4 ? P.b_igate[myq] : (myq < 8 ? P.b_fgate_m[myq - 4] : P.b_fgate_f[myq - 8]);
        const int rstep = gridDim.x * 4;
        int r = blockIdx.x * 4 + wave;
        float4 n0, n1, n2, n3;
        auto load_row = [&](int rr) {
            const int b = rr / L, p = rr - b * L;
            const float* src = (p < NMETA) ? (P.meta + (size_t)p * DM) : (P.x + ((size_t)b * SEQ + (p - NMETA)) * DM);
            n0 = *(const float4*)(src + c0); n1 = *(const float4*)(src + c0 + 4); n2 = *(const float4*)(src + c1); n3 = *(const float4*)(src + c1 + 4);
        };
        if (r < T1) load_row(r);
        for (; r < T1; r += rstep) {
            float v[16];
            v[0] = n0.x; v[1] = n0.y; v[2] = n0.z; v[3] = n0.w; v[4] = n1.x; v[5] = n1.y; v[6] = n1.z; v[7] = n1.w;
            v[8] = n2.x; v[9] = n2.y; v[10] = n2.z; v[11] = n2.w; v[12] = n3.x; v[13] = n3.y; v[14] = n3.z; v[15] = n3.w;
            if (r + rstep < T1) load_row(r + rstep);
            float ss = 0.f;
#pragma unroll
            for (int j = 0; j < 16; ++j) ss += v[j] * v[j];
            ss = wave_sum(ss);
            const float rstd = rsqrtf(ss * (1.0f / DM) + EPS);
#pragma unroll
            for (int j = 0; j < 16; ++j) v[j] *= rstd * gm[j];
            uint4 o0, o1;
            o0.x = pk2(v[0], v[1]); o0.y = pk2(v[2], v[3]); o0.z = pk2(v[4], v[5]); o0.w = pk2(v[6], v[7]);
            o1.x = pk2(v[8], v[9]); o1.y = pk2(v[10], v[11]); o1.z = pk2(v[12], v[13]); o1.w = pk2(v[14], v[15]);
            *(uint4*)(hn + (size_t)r * DM + c0) = o0;
            *(uint4*)(hn + (size_t)r * DM + c1) = o1;
            float r8[8], r4[4], r2[2], r1;
#pragma unroll
            for (int i = 0; i < 8; ++i) {
                float dd[2];
#pragma unroll
                for (int hh = 0; hh < 2; ++hh) {
                    const float* gwc = gw + (i + 8 * hh) * 1024;
                    const float4 w0 = *(const float4*)(gwc + c0), w1 = *(const float4*)(gwc + c0 + 4), w2 = *(const float4*)(gwc + c1), w3 = *(const float4*)(gwc + c1 + 4);
                    dd[hh] = v[0] * w0.x + v[1] * w0.y + v[2] * w0.z + v[3] * w0.w + v[4] * w1.x + v[5] * w1.y + v[6] * w1.z + v[7] * w1.w
                           + v[8] * w2.x + v[9] * w2.y + v[10] * w2.z + v[11] * w2.w + v[12] * w3.x + v[13] * w3.y + v[14] * w3.z + v[15] * w3.w;
                }
                const bool up = (lane & 32) != 0; const float keep = up ? dd[1] : dd[0], send = up ? dd[0] : dd[1];
                r8[i] = keep + __shfl_xor(send, 32, 64);
                __builtin_amdgcn_sched_barrier(0);
            }
#pragma unroll
            for (int i = 0; i < 4; ++i) { const bool up = (lane & 16) != 0; const float keep = up ? r8[i + 4] : r8[i], send = up ? r8[i] : r8[i + 4]; r4[i] = keep + __shfl_xor(send, 16, 64); }
#pragma unroll
            for (int i = 0; i < 2; ++i) { const bool up = (lane & 8) != 0; const float keep = up ? r4[i + 2] : r4[i], send = up ? r4[i] : r4[i + 2]; r2[i] = keep + __shfl_xor(send, 8, 64); }
            { const bool up = (lane & 4) != 0; const float keep = up ? r2[1] : r2[0], send = up ? r2[0] : r2[1]; r1 = keep + __shfl_xor(send, 4, 64); }
            r1 += __shfl_xor(r1, 2, 64); r1 += __shfl_xor(r1, 1, 64);
            if ((lane & 3) == 0) {
                const float pre = r1 + mybias;
                gates[(size_t)r * 16 + myq] = myq < 4 ? pre : logsigmoidf(pre);
            }
        }
    }
    __syncthreads();
    {
        float (*tile)[65] = (float (*)[65])smem;
        for (int item = blockIdx.x; item < 1664; item += gridDim.x) {
            const float* W; int ldn, ntn, shift_from, it; bf16_t* out;
            if (item < 896) { W = P.w_in; ldn = PROJ; ntn = 56; shift_from = 2048; it = item; out = (bf16_t*)(P.ws + WS_BT1); }
            else if (item < 1152) { W = P.w_out; ldn = 1024; ntn = 16; shift_from = 1 << 30; it = item - 896; out = (bf16_t*)(P.ws + WS_BT2); }
            else { W = P.peer_query; ldn = 2048; ntn = 32; shift_from = 1 << 30; it = item - 1152; out = (bf16_t*)(P.ws + WS_BT3); }
            const int tk = it / ntn, tn = it - tk * ntn, k0 = tk * 64, n0 = tn * 64;
            {
                const int nl = tid & 63;
                int n = n0 + nl; if (n >= shift_from) n += 8;
#pragma unroll
                for (int i = 0; i < 16; ++i) { const int kl = (tid >> 6) + 4 * i; tile[kl][nl] = W[(size_t)(k0 + kl) * ldn + n]; }
            }
            __syncthreads();
            {
                const int kl = tid & 63;
#pragma unroll
                for (int i = 0; i < 16; ++i) { const int nl = (tid >> 6) + 4 * i; out[(size_t)(n0 + nl) * 1024 + k0 + kl] = (bf16_t)f2bf(tile[kl][nl]); }
            }
            __syncthreads();
        }
    }
    {
        const size_t gt = (size_t)blockIdx.x * 256 + tid, gs = (size_t)gridDim.x * 256;
        const float* src = P.peer_keys; bf16_t* dst = (bf16_t*)(P.ws + WS_KEYS);
        for (size_t i = gt; i < (size_t)(16 * 128 * 128 / 8); i += gs) {
            const float4 a = *(const float4*)(src + i * 8), b = *(const float4*)(src + i * 8 + 4);
            uint4 o; o.x = pk2(a.x, a.y); o.y = pk2(a.z, a.w); o.z = pk2(b.x, b.y); o.w = pk2(b.z, b.w);
            *(uint4*)(dst + i * 8) = o;
        }
    }
}

__device__ __forceinline__ void convert_uv_rows(const Params& P, int gwave, int nwaves, int lane) {
    for (int rr0 = gwave * 4; rr0 < 2 * 16384; rr0 += nwaves * 4) {
        float4 a[4][4];
#pragma unroll
        for (int q = 0; q < 4; ++q) {
            const int rr = rr0 + q, which = rr >> 14, row = rr & 16383;
            const float* src = (which ? P.peer_v : P.peer_u) + (size_t)row * DM + lane * 16;
            a[q][0] = *(const float4*)(src); a[q][1] = *(const float4*)(src + 4); a[q][2] = *(const float4*)(src + 8); a[q][3] = *(const float4*)(src + 12);
        }
#pragma unroll
        for (int q = 0; q < 4; ++q) {
            const int rr = rr0 + q, which = rr >> 14, row = rr & 16383;
            float mx = 0.f;
#pragma unroll
            for (int j = 0; j < 4; ++j) mx = fmaxf(mx, fmaxf(fmaxf(fabsf(a[q][j].x), fabsf(a[q][j].y)), fmaxf(fabsf(a[q][j].z), fabsf(a[q][j].w))));
            mx = wave_max(mx);
            const float sc = mx > 0.f ? 6.0f / mx : 1.0f;
            unsigned w0 = 0u, w1 = 0u;
            w0 = __builtin_amdgcn_cvt_scalef32_pk_fp4_f32(w0, a[q][0].x * sc, a[q][0].y * sc, 1.0f, 0); w0 = __builtin_amdgcn_cvt_scalef32_pk_fp4_f32(w0, a[q][0].z * sc, a[q][0].w * sc, 1.0f, 1);
            w0 = __builtin_amdgcn_cvt_scalef32_pk_fp4_f32(w0, a[q][1].x * sc, a[q][1].y * sc, 1.0f, 2); w0 = __builtin_amdgcn_cvt_scalef32_pk_fp4_f32(w0, a[q][1].z * sc, a[q][1].w * sc, 1.0f, 3);
            w1 = __builtin_amdgcn_cvt_scalef32_pk_fp4_f32(w1, a[q][2].x * sc, a[q][2].y * sc, 1.0f, 0); w1 = __builtin_amdgcn_cvt_scalef32_pk_fp4_f32(w1, a[q][2].z * sc, a[q][2].w * sc, 1.0f, 1);
            w1 = __builtin_amdgcn_cvt_scalef32_pk_fp4_f32(w1, a[q][3].x * sc, a[q][3].y * sc, 1.0f, 2); w1 = __builtin_amdgcn_cvt_scalef32_pk_fp4_f32(w1, a[q][3].z * sc, a[q][3].w * sc, 1.0f, 3);
            *(uint2*)(P.ws + (which ? WS_V : WS_U) + (size_t)row * 512 + lane * 8) = make_uint2(w0, w1);
            if (lane == 0) ((float*)(P.ws + (which ? WS_VSC : WS_USC)))[row] = mx > 0.f ? mx * (1.0f / 6.0f) : 1.0f;
        }
    }
}

__device__ __forceinline__ void bitonic_sort16_desc(unsigned (&v)[16]) {
#pragma unroll
    for (int k = 2; k <= 16; k <<= 1)
#pragma unroll
        for (int j = k >> 1; j >= 1; j >>= 1)
#pragma unroll
            for (int i = 0; i < 16; ++i)
                if ((i & j) == 0) {
                    const int p = i | j;
                    const bool desc = (k >= 16) ? true : ((i & k) == 0);
                    const unsigned hi = max(v[i], v[p]), lo = min(v[i], v[p]);
                    v[i] = desc ? hi : lo; v[p] = desc ? lo : hi;
                }
}
__device__ __forceinline__ void bitonic_merge16_top(unsigned (&a)[16], const unsigned (&b)[16]) {
#pragma unroll
    for (int i = 0; i < 16; ++i) a[i] = max(a[i], b[15 - i]);
#pragma unroll
    for (int j = 8; j >= 1; j >>= 1)
#pragma unroll
        for (int i = 0; i < 16; ++i)
            if ((i & j) == 0) { const int p = i | j; const unsigned hi = max(a[i], a[p]), lo = min(a[i], a[p]); a[i] = hi; a[p] = lo; }
}

__device__ __forceinline__ int opaque_tid() { int t = threadIdx.x; asm volatile("" : "+v"(t)); return t; }

__device__ __forceinline__ void mma_ktile(const unsigned char* sA, const unsigned char* sB, int arow_off, int brow_off, int g, int sw, f32x4 (&acc)[4][4]) {
#pragma unroll
    for (int s = 0; s < 2; ++s) {
        bf16x8 a[4], b[4];
        const int ch = (((s * 4 + g) ^ sw) << 4);
#pragma unroll
        for (int i = 0; i < 4; ++i) a[i] = *(const bf16x8*)(sA + arow_off + i * 2048 + ch);
#pragma unroll
        for (int j = 0; j < 4; ++j) b[j] = *(const bf16x8*)(sB + brow_off + j * 2048 + ch);
#pragma unroll
        for (int i = 0; i < 4; ++i)
#pragma unroll
            for (int j = 0; j < 4; ++j) acc[i][j] = __builtin_amdgcn_mfma_f32_16x16x32_bf16(b[j], a[i], acc[i][j], 0, 0, 0);
    }
}

__device__ __forceinline__ void store_tile_bf16(const f32x4 (&acc)[4][4], unsigned char* smem, bf16_t* dst, size_t ld, int m0, int n0, int tid, int wr, int wc, int g, int lr) {
#pragma unroll
    for (int i = 0; i < 4; ++i)
#pragma unroll
        for (int j = 0; j < 4; ++j) {
            const int row = wr * 64 + 16 * i + lr, col = wc * 64 + 16 * j + 4 * g;
            uint2 w; w.x = pk2(acc[i][j][0], acc[i][j][1]); w.y = pk2(acc[i][j][2], acc[i][j][3]);
            *(uint2*)(smem + row * 272 + col * 2) = w;
        }
    __syncthreads();
#pragma unroll
    for (int q = 0; q < 8; ++q) {
        const int id = tid + 256 * q, row = id >> 4, ch = id & 15;
        const uint4 v = *(const uint4*)(smem + row * 272 + ch * 16);
        *(uint4*)(dst + (size_t)(m0 + row) * ld + n0 + ch * 8) = v;
    }
    __syncthreads();
}

template <int MODE>
__device__ __forceinline__ void gemm_tile(const Params& P, int tm, int tn, unsigned char* smem) {
    const bf16_t* A; const bf16_t* Bt;
    if (MODE == 1) { A = (const bf16_t*)(P.ws + WS_RA); Bt = (const bf16_t*)(P.ws + WS_BT1); }
    else if (MODE == 2) { A = (const bf16_t*)(P.ws + WS_Z); Bt = (const bf16_t*)(P.ws + WS_BT2); }
    else { A = (const bf16_t*)(P.ws + WS_XN); Bt = (const bf16_t*)(P.ws + WS_BT3); }
    const int tid = opaque_tid(), lane = tid & 63, wave = tid >> 6, wr = wave >> 1, wc = wave & 1, g = lane >> 4, lr = lane & 15;
    const int m0 = tm * 128, n0 = tn * 128;
    const int srow = tid >> 3, sc = tid & 7;
    constexpr unsigned LDA = (MODE == 2 ? NZ : 1024) * 2u;
    unsigned aoff, boff; int soff0;
    {
        int ar = m0 + srow;
        if (MODE == 2) { const int b = ar >> 11, t = ar & 2047; ar = b * L + NMETA + t; }
        aoff = (unsigned)ar * LDA + (unsigned)sc * 16u;
        boff = (unsigned)(n0 + srow) * 2048u + (unsigned)sc * 16u;
        soff0 = srow * 128 + ((sc ^ (srow & 7)) << 4);
    }
    const unsigned char* Ab = (const unsigned char*)A; const unsigned char* Bb = (const unsigned char*)Bt;
    f32x4 acc[4][4];
#pragma unroll
    for (int i = 0; i < 4; ++i)
#pragma unroll
        for (int j = 0; j < 4; ++j) acc[i][j] = (f32x4){0.f, 0.f, 0.f, 0.f};
    uint4 ra0, ra1, ra2, ra3, rb0, rb1, rb2, rb3;
#define G_LOAD(KT) { const unsigned ko = (unsigned)(KT) * 128u; \
        ra0 = *(const uint4*)(Ab + (aoff + ko)); ra1 = *(const uint4*)(Ab + (aoff + 32u * LDA + ko)); ra2 = *(const uint4*)(Ab + (aoff + 64u * LDA + ko)); ra3 = *(const uint4*)(Ab + (aoff + 96u * LDA + ko)); \
        rb0 = *(const uint4*)(Bb + (boff + ko)); rb1 = *(const uint4*)(Bb + (boff + 32u * 2048u + ko)); rb2 = *(const uint4*)(Bb + (boff + 64u * 2048u + ko)); rb3 = *(const uint4*)(Bb + (boff + 96u * 2048u + ko)); }
#define G_WRITE(SA, SB) { *(uint4*)((SA) + soff0) = ra0; *(uint4*)((SA) + soff0 + 4096) = ra1; *(uint4*)((SA) + soff0 + 8192) = ra2; *(uint4*)((SA) + soff0 + 12288) = ra3; \
        *(uint4*)((SB) + soff0) = rb0; *(uint4*)((SB) + soff0 + 4096) = rb1; *(uint4*)((SB) + soff0 + 8192) = rb2; *(uint4*)((SB) + soff0 + 12288) = rb3; }
    unsigned char* sA0 = smem; unsigned char* sB0 = smem + 16384; unsigned char* sA1 = smem + 32768; unsigned char* sB1 = smem + 49152;
    G_LOAD(0)
    G_WRITE(sA0, sB0)
    __syncthreads();
    const int arow_off = (wr * 64 + lr) * 128, brow_off = (wc * 64 + lr) * 128, sw = lr & 7;
    G_LOAD(1)
    for (int kt = 0; kt < 16; ++kt) {
        unsigned char* sA = (kt & 1) ? sA1 : sA0; unsigned char* sB = (kt & 1) ? sB1 : sB0;
        unsigned char* nA = (kt & 1) ? sA0 : sA1; unsigned char* nB = (kt & 1) ? sB0 : sB1;
        mma_ktile(sA, sB, arow_off, brow_off, g, sw, acc);
        if (kt < 15) G_WRITE(nA, nB)
        if (kt < 14) G_LOAD(kt + 2)
        __syncthreads();
    }
#undef G_LOAD
#undef G_WRITE
    if (MODE == 1) {
        if (n0 >= ZC_FQ && n0 < ZC_FV) {
            const bool isk = n0 >= ZC_FK;
            const float* gain = isk ? P.f_k_norm : P.f_q_norm;
            const float scl = isk ? 1.0f : 0.125f * LOG2E;
            float gn[4][4];
#pragma unroll
            for (int j = 0; j < 4; ++j)
#pragma unroll
                for (int r = 0; r < 4; ++r) gn[j][r] = gain[16 * j + 4 * g + r];
#pragma unroll
            for (int i = 0; i < 4; ++i) {
                float ss = 0.f;
#pragma unroll
                for (int j = 0; j < 4; ++j)
#pragma unroll
                    for (int r = 0; r < 4; ++r) ss += acc[i][j][r] * acc[i][j][r];
                ss += __shfl_xor(ss, 16, 64); ss += __shfl_xor(ss, 32, 64);
                const float rstd = rsqrtf(ss * (1.0f / 64.0f) + EPS) * scl;
#pragma unroll
                for (int j = 0; j < 4; ++j)
#pragma unroll
                    for (int r = 0; r < 4; ++r) acc[i][j][r] *= rstd * gn[j][r];
            }
        }
        store_tile_bf16(acc, smem, (bf16_t*)(P.ws + WS_Z), NZ, m0, n0, tid, wr, wc, g, lr);
    } else if (MODE == 2) {
        float* ssq = (float*)(P.ws + WS_SSQ);
#pragma unroll
        for (int i = 0; i < 4; ++i) {
            const int row = m0 + wr * 64 + 16 * i + lr;
            float ss = 0.f;
#pragma unroll
            for (int j = 0; j < 4; ++j) {
                const int col = n0 + wc * 64 + 16 * j + 4 * g;
                const float4 xv = *(const float4*)(P.x + (size_t)row * DM + col);
                const float4 gv = *(const float4*)(P.norm_ffn + col);
                float4 hv; hv.x = acc[i][j][0] + xv.x; hv.y = acc[i][j][1] + xv.y; hv.z = acc[i][j][2] + xv.z; hv.w = acc[i][j][3] + xv.w;
                ss += hv.x * hv.x + hv.y * hv.y + hv.z * hv.z + hv.w * hv.w;
                acc[i][j][0] = hv.x * gv.x; acc[i][j][1] = hv.y * gv.y; acc[i][j][2] = hv.z * gv.z; acc[i][j][3] = hv.w * gv.w;
            }
            ss += __shfl_xor(ss, 16, 64); ss += __shfl_xor(ss, 32, 64);
            if (g == 0) ssq[(size_t)row * 16 + tn * 2 + wc] = ss;
        }
        store_tile_bf16(acc, smem, (bf16_t*)(P.ws + WS_XN), 1024, m0, n0, tid, wr, wc, g, lr);
    } else {
        const int hp = tn;
        const float* ssq = (const float*)(P.ws + WS_SSQ);
        float rs[4];
#pragma unroll
        for (int i = 0; i < 4; ++i) {
            const int row = m0 + wr * 64 + 16 * i + lr;
            const float4 p0 = *(const float4*)(ssq + (size_t)row * 16), p1 = *(const float4*)(ssq + (size_t)row * 16 + 4);
            const float4 p2 = *(const float4*)(ssq + (size_t)row * 16 + 8), p3 = *(const float4*)(ssq + (size_t)row * 16 + 12);
            const float s = ((p0.x + p0.y) + (p0.z + p0.w)) + ((p1.x + p1.y) + (p1.z + p1.w)) + ((p2.x + p2.y) + (p2.z + p2.w)) + ((p3.x + p3.y) + (p3.z + p3.w));
            rs[i] = rsqrtf(s * (1.0f / DM) + EPS);
            if (tn == 0 && wc == 0 && g == 0) ((float*)(P.ws + WS_RSTD))[row] = rs[i];
        }
        {
            unsigned char* sAq = wc ? sA1 : sA0;
#pragma unroll
            for (int i = 0; i < 4; ++i)
#pragma unroll
                for (int j = 0; j < 4; ++j) {
                    const int row = wr * 64 + 16 * i + lr;
                    const int chunk = 2 * j + (g >> 1);
                    uint2 w; w.x = pk2(acc[i][j][0] * rs[i], acc[i][j][1] * rs[i]); w.y = pk2(acc[i][j][2] * rs[i], acc[i][j][3] * rs[i]);
                    *(uint2*)(sAq + row * 128 + ((chunk ^ (row & 7)) << 4) + 8 * (g & 1)) = w;
                }
            const bf16_t* keys = (const bf16_t*)(P.ws + WS_KEYS) + (size_t)hp * 128 * 128;
#pragma unroll
            for (int j = 0; j < 4; ++j) {
                const int row = srow + 32 * j;
                const uint4 k0 = *(const uint4*)(keys + (size_t)row * 128 + sc * 8);
                const uint4 k1 = *(const uint4*)(keys + (size_t)row * 128 + 64 + sc * 8);
                *(uint4*)(sB0 + soff0 + j * 4096) = k0; *(uint4*)(sB1 + soff0 + j * 4096) = k1;
            }
        }
        __syncthreads();
#pragma unroll
        for (int i = 0; i < 4; ++i)
#pragma unroll
            for (int j = 0; j < 4; ++j) acc[i][j] = (f32x4){0.f, 0.f, 0.f, 0.f};
        mma_ktile(sA0, sB0, arow_off, brow_off, g, sw, acc);
        mma_ktile(sA1, sB1, arow_off, brow_off, g, sw, acc);
        __syncthreads();
#pragma unroll
        for (int i = 0; i < 4; ++i)
#pragma unroll
            for (int j = 0; j < 4; ++j) {
                const int row = wr * 64 + 16 * i + lr;
                const int c4 = wc * 16 + 4 * j + g;
                *(f32x4*)(smem + row * 512 + ((c4 ^ (row & 31)) << 4)) = acc[i][j];
            }
        __syncthreads();
        unsigned top[16];
        const int row = tid & 127, half = tid >> 7;
        {
            auto load_keys = [&](unsigned (&dst)[16], int q4) {
#pragma unroll
                for (int s4 = 0; s4 < 4; ++s4) {
                    const int c4 = half * 16 + q4 * 4 + s4;
                    const f32x4 v = *(const f32x4*)(smem + row * 512 + ((c4 ^ (row & 31)) << 4));
#pragma unroll
                    for (int e = 0; e < 4; ++e) dst[s4 * 4 + e] = (ord_key(v[e]) & ~127u) | (unsigned)(127 - (c4 * 4 + e));
                }
            };
            load_keys(top, 0);
            bitonic_sort16_desc(top);
#pragma unroll 1
            for (int q4 = 1; q4 < 4; ++q4) {
                unsigned gq[16];
                load_keys(gq, q4);
                bitonic_sort16_desc(gq);
                bitonic_merge16_top(top, gq);
            }
        }
        __syncthreads();
        if (half) {
            uint4* lp = (uint4*)(smem + row * 64);
            lp[0] = make_uint4(top[0], top[1], top[2], top[3]); lp[1] = make_uint4(top[4], top[5], top[6], top[7]);
            lp[2] = make_uint4(top[8], top[9], top[10], top[11]); lp[3] = make_uint4(top[12], top[13], top[14], top[15]);
        }
        __syncthreads();
        if (!half) {
            const uint4* lp = (const uint4*)(smem + row * 64);
            unsigned other[16];
#pragma unroll
            for (int c = 0; c < 4; ++c) { const uint4 o = lp[c]; other[4 * c] = o.x; other[4 * c + 1] = o.y; other[4 * c + 2] = o.z; other[4 * c + 3] = o.w; }
            bitonic_merge16_top(top, other);
            uint4* tk = (uint4*)((unsigned*)(P.ws + WS_TK) + ((size_t)(m0 + row) * 16 + hp) * 16);
            tk[0] = make_uint4(top[0], top[1], top[2], top[3]); tk[1] = make_uint4(top[4], top[5], top[6], top[7]);
            tk[2] = make_uint4(top[8], top[9], top[10], top[11]); tk[3] = make_uint4(top[12], top[13], top[14], top[15]);
        }
        __syncthreads();
    }
}

__device__ __forceinline__ void fox_cum_wave(const Params& P, int bh, int lane) {
    const int b = bh >> 3, h = bh & 7;
    const float* gates = (const float*)(P.ws + WS_GATES);
    float* cum = (float*)(P.ws + WS_CUM) + (size_t)bh * L;
    constexpr int SEG = 33;
    const int t0 = lane * SEG;
    float loc = 0.f;
    for (int i = 0; i < SEG; ++i) { const int t = t0 + i; if (t < L) loc += gates[(size_t)(b * L + t) * 16 + 8 + h]; }
    float incl = loc;
#pragma unroll
    for (int o = 1; o < 64; o <<= 1) { const float n = __shfl_up(incl, o, 64); if (lane >= o) incl += n; }
    float run = incl - loc;
    for (int i = 0; i < SEG; ++i) { const int t = t0 + i; if (t < L) { run += gates[(size_t)(b * L + t) * 16 + 8 + h]; cum[t] = run * LOG2E; } }
}

#define TR_SLOW 0

__device__ __forceinline__ int vimg_off(int row, int ch) { return row * 128 + ((ch ^ (((row >> 1) & 3) << 1)) << 4); }
__device__ __forceinline__ uint2 tr_frag(const unsigned char* img, int row0, int c, int g, int lr) {
#if TR_SLOW
    unsigned short e[4];
#pragma unroll
    for (int k = 0; k < 4; ++k) { const int row = row0 + 4 * g + k, col = 16 * c + lr; e[k] = *(const unsigned short*)(img + vimg_off(row, col >> 3) + (col & 7) * 2); }
    uint2 r; r.x = (unsigned)e[0] | ((unsigned)e[1] << 16); r.y = (unsigned)e[2] | ((unsigned)e[3] << 16); return r;
#else
    const int q = lr >> 2, p = lr & 3, row = row0 + 4 * g + q;
    const unsigned addr = (unsigned)(size_t)(img + vimg_off(row, 2 * c + (p >> 1)) + 8 * (p & 1));
    uint2 r;
    asm volatile("ds_read_b64_tr_b16 %0, %1\n\ts_waitcnt lgkmcnt(0)" : "=&v"(r) : "v"(addr) : "memory");
    return r;
#endif
}

__device__ __forceinline__ unsigned tr_lane_addr(const unsigned char* img, int c, int g, int lr) {
    const int q = lr >> 2, p = lr & 3, row = 4 * g + q;
    return (unsigned)(size_t)(img + vimg_off(row, 2 * c + (p >> 1)) + 8 * (p & 1));
}
#define TR_GROUP(o0, o1, o2, o3, a) "ds_read_b64_tr_b16 %" #o0 ", %" #a "\n\tds_read_b64_tr_b16 %" #o1 ", %" #a " offset:2048\n\tds_read_b64_tr_b16 %" #o2 ", %" #a " offset:4096\n\tds_read_b64_tr_b16 %" #o3 ", %" #a " offset:6144\n\t"
__device__ __forceinline__ void tr_read_4c(const unsigned char* img, int g, int lr, uint2 (&r)[4][4]) {
    const unsigned a0 = tr_lane_addr(img, 0, g, lr), a1 = tr_lane_addr(img, 1, g, lr), a2 = tr_lane_addr(img, 2, g, lr), a3 = tr_lane_addr(img, 3, g, lr);
    asm volatile(TR_GROUP(0, 1, 2, 3, 16) TR_GROUP(4, 5, 6, 7, 17) TR_GROUP(8, 9, 10, 11, 18) TR_GROUP(12, 13, 14, 15, 19) "s_waitcnt lgkmcnt(0)"
        : "=&v"(r[0][0]), "=&v"(r[0][1]), "=&v"(r[0][2]), "=&v"(r[0][3]), "=&v"(r[1][0]), "=&v"(r[1][1]), "=&v"(r[1][2]), "=&v"(r[1][3]),
          "=&v"(r[2][0]), "=&v"(r[2][1]), "=&v"(r[2][2]), "=&v"(r[2][3]), "=&v"(r[3][0]), "=&v"(r[3][1]), "=&v"(r[3][2]), "=&v"(r[3][3])
        : "v"(a0), "v"(a1), "v"(a2), "v"(a3) : "memory");
}
__device__ __forceinline__ void tr_read_3c(const unsigned char* img, int g, int lr, uint2 (&r)[3][4]) {
    const unsigned a0 = tr_lane_addr(img, 0, g, lr), a1 = tr_lane_addr(img, 1, g, lr), a2 = tr_lane_addr(img, 2, g, lr);
    asm volatile(TR_GROUP(0, 1, 2, 3, 12) TR_GROUP(4, 5, 6, 7, 13) TR_GROUP(8, 9, 10, 11, 14) "s_waitcnt lgkmcnt(0)"
        : "=&v"(r[0][0]), "=&v"(r[0][1]), "=&v"(r[0][2]), "=&v"(r[0][3]), "=&v"(r[1][0]), "=&v"(r[1][1]), "=&v"(r[1][2]), "=&v"(r[1][3]),
          "=&v"(r[2][0]), "=&v"(r[2][1]), "=&v"(r[2][2]), "=&v"(r[2][3])
        : "v"(a0), "v"(a1), "v"(a2) : "memory");
}
__device__ __forceinline__ void tr_read_2(const unsigned char* img0, int c0, const unsigned char* img1, int c1, int g, int lr, uint2 (&r)[2][4]) {
    const unsigned a0 = tr_lane_addr(img0, c0, g, lr), a1 = tr_lane_addr(img1, c1, g, lr);
    asm volatile(TR_GROUP(0, 1, 2, 3, 8) TR_GROUP(4, 5, 6, 7, 9) "s_waitcnt lgkmcnt(0)"
        : "=&v"(r[0][0]), "=&v"(r[0][1]), "=&v"(r[0][2]), "=&v"(r[0][3]), "=&v"(r[1][0]), "=&v"(r[1][1]), "=&v"(r[1][2]), "=&v"(r[1][3])
        : "v"(a0), "v"(a1) : "memory");
}
__device__ __forceinline__ bf16x8 tr_pair(const uint2& lo, const uint2& hi) { uint4 u; u.x = lo.x; u.y = lo.y; u.z = hi.x; u.w = hi.y; return __builtin_bit_cast(bf16x8, u); }

__device__ __forceinline__ void attn_block(const Params& P, int bh, int qb, unsigned char* smem) {
    const int tid = opaque_tid(), lane = tid & 63, w = tid >> 6, g = lane >> 4, lr = lane & 15;
    const int b = bh >> 3, h = bh & 7;
    const bf16_t* z = (const bf16_t*)(P.ws + WS_Z);
    const float* cum = (const float*)(P.ws + WS_CUM) + (size_t)bh * L;
    int tq[2]; bool qvalid[2]; bf16x8 qf[2][2];
#pragma unroll
    for (int u = 0; u < 2; ++u) {
        tq[u] = qb * 128 + 32 * w + 16 * u + lr;
        qvalid[u] = tq[u] < L;
        const bf16_t* qp = z + (size_t)(b * L + (qvalid[u] ? tq[u] : 0)) * NZ + ZC_FQ + h * 64 + 8 * g;
        qf[u][0] = *(const bf16x8*)(qp); qf[u][1] = *(const bf16x8*)(qp + 32);
    }
    const int nkv = (2 * qb + 2 < 33) ? 2 * qb + 2 : 33;
    const int srow0 = tid >> 3, sch = tid & 7;
    uint4 rk[2], rv[2]; float rc = 0.f;
    auto load_tile = [&](int kv) {
#pragma unroll
        for (int j = 0; j < 2; ++j) {
            const int key = kv * 64 + srow0 + 32 * j;
            if (key < L) {
                const bf16_t* p = z + (size_t)(b * L + key) * NZ + h * 64 + sch * 8;
                rk[j] = *(const uint4*)(p + ZC_FK); rv[j] = *(const uint4*)(p + ZC_FV);
            } else { rk[j] = make_uint4(0, 0, 0, 0); rv[j] = make_uint4(0, 0, 0, 0); }
        }
        if (tid < 64) { const int key = kv * 64 + tid; rc = key < L ? cum[key] : 0.f; }
    };
    auto store_tile = [&](int buf) {
        unsigned char* sK = smem + buf * 16384; unsigned char* sV = sK + 8192;
#pragma unroll
        for (int j = 0; j < 2; ++j) {
            const int row = srow0 + 32 * j;
            *(uint4*)(sK + row * 128 + ((sch ^ (row & 7)) << 4)) = rk[j];
            *(uint4*)(sV + vimg_off(row, sch)) = rv[j];
        }
        if (tid < 64) ((float*)(smem + 32768 + buf * 256))[tid] = rc;
    };
    float m[2] = {-1e30f, -1e30f};
    f32x4 o[2][5];
#pragma unroll
    for (int u = 0; u < 2; ++u)
#pragma unroll
        for (int c = 0; c < 5; ++c) o[u][c] = (f32x4){0.f, 0.f, 0.f, 0.f};
    const unsigned onew = (lr == 0) ? 0x3F803F80u : 0u;
    const bf16x8 vones = __builtin_bit_cast(bf16x8, make_uint4(onew, onew, onew, onew));
    load_tile(nkv - 1); store_tile((nkv - 1) & 1);
    __syncthreads();
    for (int kv = nkv - 1; kv >= 0; --kv) {
        const int buf = kv & 1;
        if (kv > 0) load_tile(kv - 1);
        const unsigned char* sK = smem + buf * 16384; const unsigned char* sV = sK + 8192;
        const float* sck = (const float*)(smem + 32768 + buf * 256);
        f32x4 sa[2][4];
#pragma unroll
        for (int c = 0; c < 4; ++c) {
            sa[0][c] = (f32x4){0.f, 0.f, 0.f, 0.f}; sa[1][c] = (f32x4){0.f, 0.f, 0.f, 0.f};
#pragma unroll
            for (int s = 0; s < 2; ++s) {
                const bf16x8 kf = *(const bf16x8*)(sK + (16 * c + lr) * 128 + (((4 * s + g) ^ (lr & 7)) << 4));
                sa[0][c] = __builtin_amdgcn_mfma_f32_16x16x32_bf16(kf, qf[0][s], sa[0][c], 0, 0, 0);
                sa[1][c] = __builtin_amdgcn_mfma_f32_16x16x32_bf16(kf, qf[1][s], sa[1][c], 0, 0, 0);
            }
        }
        if (kv >= 2 * qb) {
#pragma unroll
            for (int u = 0; u < 2; ++u)
#pragma unroll
                for (int c = 0; c < 4; ++c)
#pragma unroll
                    for (int r = 0; r < 4; ++r)
                        if (64 * kv + 16 * c + 4 * g + r > tq[u]) sa[u][c][r] = -INFINITY;
        }
        f32x4 ck[4];
#pragma unroll
        for (int c = 0; c < 4; ++c) ck[c] = *(const f32x4*)(sck + 16 * c + 4 * g);
        bf16x8 pf[2][2];
#pragma unroll
        for (int u = 0; u < 2; ++u) {
            float mx = -INFINITY;
#pragma unroll
            for (int c = 0; c < 4; ++c) {
                sa[u][c] -= ck[c];
                mx = fmaxf(mx, fmaxf(fmaxf(sa[u][c][0], sa[u][c][1]), fmaxf(sa[u][c][2], sa[u][c][3])));
            }
            mx = fmaxf(mx, __shfl_xor(mx, 16, 64)); mx = fmaxf(mx, __shfl_xor(mx, 32, 64));
            if (__builtin_amdgcn_ballot_w64(mx > m[u]) != 0ull) {
                const float mn = fmaxf(m[u], mx);
                const float alpha = __builtin_amdgcn_exp2f(m[u] - mn);
                m[u] = mn;
#pragma unroll
                for (int c = 0; c < 5; ++c) o[u][c] *= alpha;
            }
            const float mn = m[u];
#pragma unroll
            for (int c = 0; c < 4; ++c)
#pragma unroll
                for (int r = 0; r < 4; ++r) sa[u][c][r] = __builtin_amdgcn_exp2f(sa[u][c][r] - mn);
#pragma unroll
            for (int s2 = 0; s2 < 2; ++s2) {
                uint4 uu;
                uu.x = cvt_pk_bf16(sa[u][2 * s2][0], sa[u][2 * s2][1]); uu.y = cvt_pk_bf16(sa[u][2 * s2][2], sa[u][2 * s2][3]);
                uu.z = cvt_pk_bf16(sa[u][2 * s2 + 1][0], sa[u][2 * s2 + 1][1]); uu.w = cvt_pk_bf16(sa[u][2 * s2 + 1][2], sa[u][2 * s2 + 1][3]);
                pf[u][s2] = __builtin_bit_cast(bf16x8, uu);
            }
        }
        {
            uint2 vr[4][4];
            tr_read_4c(sV, g, lr, vr);
#pragma unroll
            for (int c = 0; c < 4; ++c)
#pragma unroll
                for (int s2 = 0; s2 < 2; ++s2) {
                    const bf16x8 vf = tr_pair(vr[c][2 * s2], vr[c][2 * s2 + 1]);
                    o[0][c] = __builtin_amdgcn_mfma_f32_16x16x32_bf16(vf, pf[0][s2], o[0][c], 0, 0, 0);
                    o[1][c] = __builtin_amdgcn_mfma_f32_16x16x32_bf16(vf, pf[1][s2], o[1][c], 0, 0, 0);
                }
#pragma unroll
            for (int s2 = 0; s2 < 2; ++s2) {
                o[0][4] = __builtin_amdgcn_mfma_f32_16x16x32_bf16(vones, pf[0][s2], o[0][4], 0, 0, 0);
                o[1][4] = __builtin_amdgcn_mfma_f32_16x16x32_bf16(vones, pf[1][s2], o[1][4], 0, 0, 0);
            }
        }
        if (kv > 0) store_tile(buf ^ 1);
        __syncthreads();
    }
#pragma unroll
    for (int u = 0; u < 2; ++u) {
        const float ls = __shfl(o[u][4][0], lr, 64);
        const float inv = 1.0f / ls;
        if (qvalid[u]) {
            bf16_t* y = (bf16_t*)(P.ws + WS_Z) + (size_t)(b * L + tq[u]) * NZ + 512 + h * 64 + 4 * g;
#pragma unroll
            for (int c = 0; c < 4; ++c) {
                uint2 uu; uu.x = pk2(o[u][c][0] * inv, o[u][c][1] * inv); uu.y = pk2(o[u][c][2] * inv, o[u][c][3] * inv);
                *(uint2*)(y + 16 * c) = uu;
            }
        }
    }
}

__device__ __forceinline__ void conv_item(const Params& P, int ci) {
    const int tid = opaque_tid(), cc = tid & 127, rg = tid >> 7;
    const bf16_t* z = (const bf16_t*)(P.ws + WS_Z);
    bf16_t* qk = (bf16_t*)(P.ws + WS_RA);
    const int col0 = cc * 8;
    float w[4][8];
#pragma unroll
    for (int j = 0; j < 4; ++j) {
        const float4 a = *(const float4*)(P.conv_qk + j * 1024 + col0), b = *(const float4*)(P.conv_qk + j * 1024 + col0 + 4);
        w[j][0] = a.x; w[j][1] = a.y; w[j][2] = a.z; w[j][3] = a.w; w[j][4] = b.x; w[j][5] = b.y; w[j][6] = b.z; w[j][7] = b.w;
    }
    const float oscale = (col0 >= 512) ? 0.08838834764831845f : 1.0f;
    const int r0 = ci * 64 + rg * 32;
    int t = r0 % L;
    float xw[3][8];
#pragma unroll
    for (int j = 0; j < 3; ++j) {
        const int back = 3 - j;
        if (t - back >= 0) {
            const uint4 v = *(const uint4*)(z + (size_t)(r0 - back) * NZ + col0);
            xw[j][0] = bflo(v.x); xw[j][1] = bfhi(v.x); xw[j][2] = bflo(v.y); xw[j][3] = bfhi(v.y); xw[j][4] = bflo(v.z); xw[j][5] = bfhi(v.z); xw[j][6] = bflo(v.w); xw[j][7] = bfhi(v.w);
        } else {
#pragma unroll
            for (int e = 0; e < 8; ++e) xw[j][e] = 0.f;
        }
    }
#pragma unroll 2
    for (int i = 0; i < 32; ++i) {
        const int r = r0 + i;
        if (t == 0) {
#pragma unroll
            for (int j = 0; j < 3; ++j)
#pragma unroll
                for (int e = 0; e < 8; ++e) xw[j][e] = 0.f;
        }
        const uint4 v = *(const uint4*)(z + (size_t)r * NZ + col0);
        float xt[8];
        xt[0] = bflo(v.x); xt[1] = bfhi(v.x); xt[2] = bflo(v.y); xt[3] = bfhi(v.y); xt[4] = bflo(v.z); xt[5] = bfhi(v.z); xt[6] = bflo(v.w); xt[7] = bfhi(v.w);
        float o[8];
#pragma unroll
        for (int e = 0; e < 8; ++e) {
            const float cv = w[0][e] * xw[0][e] + w[1][e] * xw[1][e] + w[2][e] * xw[2][e] + w[3][e] * xt[e];
            o[e] = oscale * cv / (1.f + __expf(-cv));
            xw[0][e] = xw[1][e]; xw[1][e] = xw[2][e]; xw[2][e] = xt[e];
        }
        uint4 ov; ov.x = pk2(o[0], o[1]); ov.y = pk2(o[2], o[3]); ov.z = pk2(o[4], o[5]); ov.w = pk2(o[6], o[7]);
        *(uint4*)(qk + (size_t)r * 1024 + col0) = ov;
        t = (t + 1 == L) ? 0 : t + 1;
    }
}

constexpr int ST_IMG = 36864;
__device__ __forceinline__ int st_piece_off(int jt, int c, int g, int lr) { return (jt >> 2) * 18432 + vimg_off(16 * c + lr, 2 * (jt & 3) + (g >> 1)) + 8 * (g & 1); }

__device__ __forceinline__ void mlstm_stage_kv(const Params& P, int b, int h, int k, unsigned char* sKimg, unsigned char* sVimg, int tid) {
    const bf16_t* z = (const bf16_t*)(P.ws + WS_Z);
    const bf16_t* qk = (const bf16_t*)(P.ws + WS_RA);
    uint4 pk_[4], pv_[4];
#pragma unroll
    for (int j = 0; j < 4; ++j) {
        const int id = tid + 256 * j, row = id >> 4, ch16 = id & 15, pos = 64 * k + row;
        const bool ok = pos < L;
        pk_[j] = ok ? *(const uint4*)(qk + (size_t)(b * L + pos) * 1024 + 512 + h * 128 + ch16 * 8) : make_uint4(0, 0, 0, 0);
        pv_[j] = ok ? *(const uint4*)(z + (size_t)(b * L + pos) * NZ + ZC_MV + h * 128 + ch16 * 8) : make_uint4(0, 0, 0, 0);
    }
#pragma unroll
    for (int j = 0; j < 4; ++j) {
        const int id = tid + 256 * j, row = id >> 4, ch16 = id & 15;
        *(uint4*)(sKimg + (ch16 >> 3) * 8192 + vimg_off(row, ch16 & 7)) = pk_[j];
        *(uint4*)(sVimg + (ch16 >> 3) * 8192 + vimg_off(row, ch16 & 7)) = pv_[j];
    }
    if (tid < 128) {
        const int row = tid >> 1, ch = tid & 1;
        *(uint4*)(sVimg + 16384 + vimg_off(row, ch)) = ch ? make_uint4(0, 0, 0, 0) : make_uint4(0x3F80u, 0, 0, 0);
    }
}

__device__ __forceinline__ void mlstm_stage_A(const Params& P, int b, int h, int k, unsigned char* sKimg, unsigned char* sVimg, int tid) {
    const bf16_t* z = (const bf16_t*)(P.ws + WS_Z);
    bf16_t* qk = (bf16_t*)(P.ws + WS_RA);
    uint4 pv_[4];
#pragma unroll
    for (int j = 0; j < 4; ++j) {
        const int id = tid + 256 * j, row = id >> 4, ch16 = id & 15, pos = 64 * k + row;
        pv_[j] = (pos < L) ? *(const uint4*)(z + (size_t)(b * L + pos) * NZ + ZC_MV + h * 128 + ch16 * 8) : make_uint4(0, 0, 0, 0);
    }
    const int cch = tid & 31, rg = tid >> 5, isk = cch >> 4;
    const int zcol = (isk ? ZC_MK : ZC_MQ) + h * 128 + (cch & 15) * 8;
    float w[4][8];
#pragma unroll
    for (int j = 0; j < 4; ++j) {
        const float4 a = *(const float4*)(P.conv_qk + j * 1024 + zcol), c = *(const float4*)(P.conv_qk + j * 1024 + zcol + 4);
        w[j][0] = a.x; w[j][1] = a.y; w[j][2] = a.z; w[j][3] = a.w; w[j][4] = c.x; w[j][5] = c.y; w[j][6] = c.z; w[j][7] = c.w;
    }
    const float oscale = isk ? 0.08838834764831845f : 1.0f;
    const int p0 = 64 * k + 8 * rg;
    uint4 raw[11];
#pragma unroll
    for (int i = 0; i < 11; ++i) {
        const int pos = p0 - 3 + i;
        raw[i] = (pos >= 0 && pos < L) ? *(const uint4*)(z + (size_t)(b * L + pos) * NZ + zcol) : make_uint4(0, 0, 0, 0);
    }
#pragma unroll
    for (int j = 0; j < 4; ++j) {
        const int id = tid + 256 * j, row = id >> 4, ch16 = id & 15;
        *(uint4*)(sVimg + (ch16 >> 3) * 8192 + vimg_off(row, ch16 & 7)) = pv_[j];
    }
    if (tid < 128) {
        const int row = tid >> 1, ch = tid & 1;
        *(uint4*)(sVimg + 16384 + vimg_off(row, ch)) = ch ? make_uint4(0, 0, 0, 0) : make_uint4(0x3F80u, 0, 0, 0);
    }
#pragma unroll
    for (int i = 0; i < 8; ++i) {
        const int pos = p0 + i, row = 8 * rg + i;
        float o[8];
#pragma unroll
        for (int e = 0; e < 8; ++e) {
            const unsigned w0 = (&raw[i].x)[e >> 1], w1 = (&raw[i + 1].x)[e >> 1], w2 = (&raw[i + 2].x)[e >> 1], w3 = (&raw[i + 3].x)[e >> 1];
            const float x0 = (e & 1) ? bfhi(w0) : bflo(w0), x1 = (e & 1) ? bfhi(w1) : bflo(w1), x2 = (e & 1) ? bfhi(w2) : bflo(w2), x3 = (e & 1) ? bfhi(w3) : bflo(w3);
            const float cv = w[0][e] * x0 + w[1][e] * x1 + w[2][e] * x2 + w[3][e] * x3;
            o[e] = oscale * cv / (1.f + __expf(-cv));
        }
        uint4 ov; ov.x = pk2(o[0], o[1]); ov.y = pk2(o[2], o[3]); ov.z = pk2(o[4], o[5]); ov.w = pk2(o[6], o[7]);
        const bool ok = pos < L;
        if (!ok) ov = make_uint4(0, 0, 0, 0);
        if (ok) *(uint4*)(qk + (size_t)(b * L + pos) * 1024 + (isk ? 512 : 0) + h * 128 + (cch & 15) * 8) = ov;
        if (isk) { const int ch16 = cch & 15; *(uint4*)(sKimg + (ch16 >> 3) * 8192 + vimg_off(row, ch16 & 7)) = ov; }
    }
}

__device__ __forceinline__ void mlstm_A(const Params& P, int item, unsigned char* smem) {
    const int tid = opaque_tid(), lane = tid & 63, w = tid >> 6, g = lane >> 4, lr = lane & 15;
    const int wu = __builtin_amdgcn_readfirstlane(w);
    const int k = item >> 5, bh = item & 31, b = bh >> 2, h = bh & 3;
    const float* gates = (const float*)(P.ws + WS_GATES);
    const unsigned char* sK = smem; const unsigned char* sV = smem + 16384;
    float* ga = (float*)(smem + 40960);
    mlstm_stage_A(P, b, h, k, smem, smem + 16384, tid);
    if (wu == 0) {
        const int pos = 64 * k + lane;
        float lf = 0.f, li = -INFINITY;
        if (pos < L) { lf = gates[(size_t)(b * L + pos) * 16 + 4 + h]; li = gates[(size_t)(b * L + pos) * 16 + h]; }
        float bc = lf;
#pragma unroll
        for (int o = 1; o < 64; o <<= 1) { const float n = __shfl_up(bc, o, 64); if (lane >= o) bc += n; }
        const float a = li - bc;
        const float A = wave_max(a);
        ga[lane] = __expf(a - A);
        if (lane == 63) { float* msc = (float*)(P.ws + WS_MSC) + ((size_t)bh * 33 + k) * 4; msc[0] = A; msc[1] = bc; }
    }
    __syncthreads();
    f32x4 Ct[2][9];
#pragma unroll
    for (int a = 0; a < 2; ++a)
#pragma unroll
        for (int c = 0; c < 9; ++c) Ct[a][c] = (f32x4){0.f, 0.f, 0.f, 0.f};
    bf16x8 kt[2][2];
#pragma unroll
    for (int a = 0; a < 2; ++a)
#pragma unroll
        for (int s2 = 0; s2 < 2; ++s2) {
            const int jt = 2 * w + a;
            kt[a][s2] = tr_pair(tr_frag(sK + (jt >> 2) * 8192, 32 * s2, jt & 3, g, lr), tr_frag(sK + (jt >> 2) * 8192, 32 * s2 + 16, jt & 3, g, lr));
        }
    f32x4 wg4[4];
#pragma unroll
    for (int j = 0; j < 4; ++j) wg4[j] = *(const f32x4*)(ga + 16 * j + 4 * g);
#define MA_TILE(c, lo0, hi0, lo1, hi1) { \
        { const f32x4 w0 = wg4[0], w1 = wg4[1]; uint4 o; \
          o.x = cvt_pk_bf16(bflo(lo0.x) * w0[0], bfhi(lo0.x) * w0[1]); o.y = cvt_pk_bf16(bflo(lo0.y) * w0[2], bfhi(lo0.y) * w0[3]); \
          o.z = cvt_pk_bf16(bflo(hi0.x) * w1[0], bfhi(hi0.x) * w1[1]); o.w = cvt_pk_bf16(bflo(hi0.y) * w1[2], bfhi(hi0.y) * w1[3]); \
          const bf16x8 vw = __builtin_bit_cast(bf16x8, o); \
          Ct[0][c] = __builtin_amdgcn_mfma_f32_16x16x32_bf16(kt[0][0], vw, Ct[0][c], 0, 0, 0); Ct[1][c] = __builtin_amdgcn_mfma_f32_16x16x32_bf16(kt[1][0], vw, Ct[1][c], 0, 0, 0); } \
        { const f32x4 w0 = wg4[2], w1 = wg4[3]; uint4 o; \
          o.x = cvt_pk_bf16(bflo(lo1.x) * w0[0], bfhi(lo1.x) * w0[1]); o.y = cvt_pk_bf16(bflo(lo1.y) * w0[2], bfhi(lo1.y) * w0[3]); \
          o.z = cvt_pk_bf16(bflo(hi1.x) * w1[0], bfhi(hi1.x) * w1[1]); o.w = cvt_pk_bf16(bflo(hi1.y) * w1[2], bfhi(hi1.y) * w1[3]); \
          const bf16x8 vw = __builtin_bit_cast(bf16x8, o); \
          Ct[0][c] = __builtin_amdgcn_mfma_f32_16x16x32_bf16(kt[0][1], vw, Ct[0][c], 0, 0, 0); Ct[1][c] = __builtin_amdgcn_mfma_f32_16x16x32_bf16(kt[1][1], vw, Ct[1][c], 0, 0, 0); } }
    {
        uint2 vr[4][4];
        tr_read_4c(sV, g, lr, vr);
        MA_TILE(0, vr[0][0], vr[0][1], vr[0][2], vr[0][3]) MA_TILE(1, vr[1][0], vr[1][1], vr[1][2], vr[1][3])
        MA_TILE(2, vr[2][0], vr[2][1], vr[2][2], vr[2][3]) MA_TILE(3, vr[3][0], vr[3][1], vr[3][2], vr[3][3])
        tr_read_4c(sV + 8192, g, lr, vr);
        MA_TILE(4, vr[0][0], vr[0][1], vr[0][2], vr[0][3]) MA_TILE(5, vr[1][0], vr[1][1], vr[1][2], vr[1][3])
        MA_TILE(6, vr[2][0], vr[2][1], vr[2][2], vr[2][3]) MA_TILE(7, vr[3][0], vr[3][1], vr[3][2], vr[3][3])
        const uint2 o0 = tr_frag(sV + 16384, 0, 0, g, lr), o1 = tr_frag(sV + 16384, 16, 0, g, lr), o2 = tr_frag(sV + 16384, 32, 0, g, lr), o3 = tr_frag(sV + 16384, 48, 0, g, lr);
        MA_TILE(8, o0, o1, o2, o3)
    }
#undef MA_TILE
    unsigned char* slot = P.ws + WS_MST + ((size_t)bh * 33 + k) * ST_IMG;
#pragma unroll
    for (int a = 0; a < 2; ++a)
#pragma unroll
        for (int c = 0; c < 9; ++c) {
            uint2 u; u.x = cvt_pk_bf16(Ct[a][c][0], Ct[a][c][1]); u.y = cvt_pk_bf16(Ct[a][c][2], Ct[a][c][3]);
            *(uint2*)(slot + st_piece_off(2 * w + a, c, g, lr)) = u;
        }
}

__device__ __forceinline__ void mlstm_B(const Params& P, int item) {
    const int tid = opaque_tid();
    const int bh = item / 3, part = item - bh * 3;
    const unsigned char* base = P.ws + WS_MST + (size_t)bh * 33 * ST_IMG + part * 12288 + tid * 48;
    unsigned char* obase = P.ws + WS_CBI + (size_t)bh * 33 * ST_IMG + part * 12288 + tid * 48;
    float* msc = (float*)(P.ws + WS_MSC) + (size_t)bh * 33 * 4;
    float C[6][4];
#pragma unroll
    for (int i = 0; i < 6; ++i)
#pragma unroll
        for (int r = 0; r < 4; ++r) C[i][r] = 0.f;
    float m = 0.f;
    uint2 d0[6], d1[6];
    float2 ab0, ab1;
#pragma unroll
    for (int i = 0; i < 6; ++i) { d0[i] = *(const uint2*)(base + i * 8); d1[i] = *(const uint2*)(base + ST_IMG + i * 8); }
    ab0 = *(const float2*)(msc); ab1 = *(const float2*)(msc + 4);
    for (int k = 0; k < 33; ++k) {
        uint2 d2[6]; float2 ab2 = make_float2(0.f, 0.f);
        if (k + 2 < 33) {
#pragma unroll
            for (int i = 0; i < 6; ++i) d2[i] = *(const uint2*)(base + (size_t)(k + 2) * ST_IMG + i * 8);
            ab2 = *(const float2*)(msc + (k + 2) * 4);
        } else {
#pragma unroll
            for (int i = 0; i < 6; ++i) d2[i] = make_uint2(0, 0);
        }
#pragma unroll
        for (int i = 0; i < 6; ++i) {
            uint2 u; u.x = cvt_pk_bf16(C[i][0], C[i][1]); u.y = cvt_pk_bf16(C[i][2], C[i][3]);
            *(uint2*)(obase + (size_t)k * ST_IMG + i * 8) = u;
        }
        if (tid == 0 && part == 0) msc[k * 4 + 2] = m;
        const float M = fmaxf(m, ab0.x);
        const float decay = __expf(m - M), sc = __expf(ab0.x - M);
#pragma unroll
        for (int i = 0; i < 6; ++i) {
            C[i][0] = decay * C[i][0] + sc * bflo(d0[i].x); C[i][1] = decay * C[i][1] + sc * bfhi(d0[i].x);
            C[i][2] = decay * C[i][2] + sc * bflo(d0[i].y); C[i][3] = decay * C[i][3] + sc * bfhi(d0[i].y);
        }
        m = ab0.y + M;
#pragma unroll
        for (int i = 0; i < 6; ++i) { d0[i] = d1[i]; d1[i] = d2[i]; }
        ab0 = ab1; ab1 = ab2;
    }
}

__device__ __forceinline__ void mlstm_C(const Params& P, int item, unsigned char* smem) {
    const int tid = opaque_tid(), lane = tid & 63, w = tid >> 6, g = lane >> 4, lr = lane & 15;
    const int wu = __builtin_amdgcn_readfirstlane(w);
    const int k = item >> 5, bh = item & 31, b = bh >> 2, h = bh & 3;
    const bf16_t* z = (const bf16_t*)(P.ws + WS_Z);
    const bf16_t* qk = (const bf16_t*)(P.ws + WS_RA);
    const float* gates = (const float*)(P.ws + WS_GATES);
    bf16_t* y = (bf16_t*)(P.ws + WS_Z);
    const unsigned char* sK = smem; const unsigned char* sV = smem + 36864; unsigned char* sCb = smem;
    float* ga = (float*)(smem + 61440);
    const int pos = 64 * k + 16 * w + lr;
    const bool tvalid = pos < L;
    const size_t rrow = (size_t)(b * L + (tvalid ? pos : 0));
    const unsigned char* cslot = P.ws + WS_CBI + ((size_t)bh * 33 + k) * ST_IMG + tid * 16;
    const uint4 cb0 = *(const uint4*)(cslot), cb1 = *(const uint4*)(cslot + 4096), cb2 = *(const uint4*)(cslot + 8192), cb3 = *(const uint4*)(cslot + 12288), cb4 = *(const uint4*)(cslot + 16384),
                cb5 = *(const uint4*)(cslot + 20480), cb6 = *(const uint4*)(cslot + 24576), cb7 = *(const uint4*)(cslot + 28672), cb8 = *(const uint4*)(cslot + 32768);
    bf16x8 qf[4];
    {
        const bf16_t* qp = qk + rrow * 1024 + h * 128 + 8 * g;
#pragma unroll
        for (int ks = 0; ks < 4; ++ks) { qf[ks] = *(const bf16x8*)(qp + 32 * ks); if (!tvalid) qf[ks] = (bf16x8){0, 0, 0, 0, 0, 0, 0, 0}; }
    }
    mlstm_stage_kv(P, b, h, k, smem, smem + 36864, tid);
    if (wu == 0) {
        const float m_prev = ((const float*)(P.ws + WS_MSC))[((size_t)bh * 33 + k) * 4 + 2];
        const int p2 = 64 * k + lane;
        float lf = 0.f, li = -INFINITY;
        if (p2 < L) { lf = gates[(size_t)(b * L + p2) * 16 + 4 + h]; li = gates[(size_t)(b * L + p2) * 16 + h]; }
        float bc = lf;
#pragma unroll
        for (int o = 1; o < 64; o <<= 1) { const float n = __shfl_up(bc, o, 64); if (lane >= o) bc += n; }
        const float a = li - bc;
        float am = a;
#pragma unroll
        for (int o = 1; o < 64; o <<= 1) { const float n = __shfl_up(am, o, 64); if (lane >= o) am = fmaxf(am, n); }
        const float M = fmaxf(m_prev, am);
        ga[lane] = a; ga[64 + lane] = __expf(m_prev - M); ga[128 + lane] = __expf(-(bc + M)); ga[192 + lane] = M;
    }
    __syncthreads();
    const float Mt = ga[192 + 16 * w + lr], Wi = ga[64 + 16 * w + lr], Et = ga[128 + 16 * w + lr];
    bf16x8 pf[2];
    {
        f32x4 sa[4];
#pragma unroll
        for (int c = 0; c < 4; ++c) {
            sa[c] = (f32x4){0.f, 0.f, 0.f, 0.f};
            if (c <= wu) {
#pragma unroll
                for (int ks = 0; ks < 4; ++ks) {
                    const bf16x8 kf = *(const bf16x8*)(sK + (ks >> 1) * 8192 + vimg_off(16 * c + lr, 4 * (ks & 1) + g));
                    sa[c] = __builtin_amdgcn_mfma_f32_16x16x32_bf16(kf, qf[ks], sa[c], 0, 0, 0);
                }
                const f32x4 av = *(const f32x4*)(ga + 16 * c + 4 * g);
#pragma unroll
                for (int r = 0; r < 4; ++r) {
                    const float d = __expf(av[r] - Mt);
                    sa[c][r] = (16 * c + 4 * g + r <= 16 * w + lr) ? sa[c][r] * d : 0.f;
                }
            }
        }
#pragma unroll
        for (int s2 = 0; s2 < 2; ++s2) {
            uint4 u;
            u.x = cvt_pk_bf16(sa[2 * s2][0], sa[2 * s2][1]); u.y = cvt_pk_bf16(sa[2 * s2][2], sa[2 * s2][3]);
            u.z = cvt_pk_bf16(sa[2 * s2 + 1][0], sa[2 * s2 + 1][1]); u.w = cvt_pk_bf16(sa[2 * s2 + 1][2], sa[2 * s2 + 1][3]);
            pf[s2] = __builtin_bit_cast(bf16x8, u);
        }
    }
    __syncthreads();
    {
        unsigned char* d = sCb + tid * 16;
        *(uint4*)(d) = cb0; *(uint4*)(d + 4096) = cb1; *(uint4*)(d + 8192) = cb2; *(uint4*)(d + 12288) = cb3; *(uint4*)(d + 16384) = cb4;
        *(uint4*)(d + 20480) = cb5; *(uint4*)(d + 24576) = cb6; *(uint4*)(d + 28672) = cb7; *(uint4*)(d + 32768) = cb8;
    }
    __syncthreads();
    f32x4 na[9];
#define MC_TILE(c, lo0, hi0, lo1, hi1) { \
        na[c] = (f32x4){0.f, 0.f, 0.f, 0.f}; \
        _Pragma("unroll") for (int ks = 0; ks < 4; ++ks) { \
            const bf16x8 cf = *(const bf16x8*)(sCb + (ks >> 1) * 18432 + vimg_off(16 * (c) + lr, 4 * (ks & 1) + g)); \
            na[c] = __builtin_amdgcn_mfma_f32_16x16x32_bf16(cf, qf[ks], na[c], 0, 0, 0); } \
        na[c] *= Wi; \
        na[c] = __builtin_amdgcn_mfma_f32_16x16x32_bf16(tr_pair(lo0, hi0), pf[0], na[c], 0, 0, 0); \
        na[c] = __builtin_amdgcn_mfma_f32_16x16x32_bf16(tr_pair(lo1, hi1), pf[1], na[c], 0, 0, 0); }
    {
        uint2 vr[4][4];
        tr_read_4c(sV, g, lr, vr);
        MC_TILE(0, vr[0][0], vr[0][1], vr[0][2], vr[0][3]) MC_TILE(1, vr[1][0], vr[1][1], vr[1][2], vr[1][3])
        MC_TILE(2, vr[2][0], vr[2][1], vr[2][2], vr[2][3]) MC_TILE(3, vr[3][0], vr[3][1], vr[3][2], vr[3][3])
        tr_read_4c(sV + 8192, g, lr, vr);
        MC_TILE(4, vr[0][0], vr[0][1], vr[0][2], vr[0][3]) MC_TILE(5, vr[1][0], vr[1][1], vr[1][2], vr[1][3])
        MC_TILE(6, vr[2][0], vr[2][1], vr[2][2], vr[2][3]) MC_TILE(7, vr[3][0], vr[3][1], vr[3][2], vr[3][3])
        const uint2 o0 = tr_frag(sV + 16384, 0, 0, g, lr), o1 = tr_frag(sV + 16384, 16, 0, g, lr), o2 = tr_frag(sV + 16384, 32, 0, g, lr), o3 = tr_frag(sV + 16384, 48, 0, g, lr);
        MC_TILE(8, o0, o1, o2, o3)
    }
#undef MC_TILE
    const float den = __shfl(na[8][0], lr, 64);
    const float rden = 1.0f / fmaxf(fabsf(den), Et);
    float hs = 0.f;
#pragma unroll
    for (int c = 0; c < 8; ++c) { na[c] *= rden; hs += na[c][0] * na[c][0] + na[c][1] * na[c][1] + na[c][2] * na[c][2] + na[c][3] * na[c][3]; }
    hs += __shfl_xor(hs, 16, 64); hs += __shfl_xor(hs, 32, 64);
    const float rstd = rsqrtf(hs * (1.0f / 128.0f) + EPS);
    const float* gainp = P.m_out_norm + h * 128 + 4 * g;
#pragma unroll
    for (int c = 0; c < 8; ++c) {
        const uint2 og = *(const uint2*)(z + rrow * NZ + ZC_MO + h * 128 + 16 * c + 4 * g);
        const float o0 = bflo(og.x), o1 = bfhi(og.x), o2 = bflo(og.y), o3 = bfhi(og.y);
        const float4 gn = *(const float4*)(gainp + 16 * c);
        uint2 u;
        u.x = pk2(na[c][0] * rstd * gn.x / (1.f + __expf(-o0)), na[c][1] * rstd * gn.y / (1.f + __expf(-o1)));
        u.y = pk2(na[c][2] * rstd * gn.z / (1.f + __expf(-o2)), na[c][3] * rstd * gn.w / (1.f + __expf(-o3)));
        if (tvalid) *(uint2*)(y + rrow * NZ + h * 128 + 16 * c + 4 * g) = u;
    }
}

__device__ __forceinline__ void peer_token(const Params& P, int t, int lane, int* sidx, float* sval, int* sid, float* sgate, const unsigned char* slut, const unsigned* szero) {
    const unsigned* tk = (const unsigned*)(P.ws + WS_TK) + (size_t)t * 256;
#pragma unroll
    for (int i = 0; i < 4; ++i) {
        const unsigned k = tk[lane * 4 + i];
        sidx[lane * 4 + i] = 127 - (int)(k & 127u);
        sval[lane * 4 + i] = unord_key(k & ~127u);
    }
    __builtin_amdgcn_s_waitcnt(0xc07f);
    __builtin_amdgcn_wave_barrier();
    {
        const int hd = lane >> 3, sub = lane & 7;
        unsigned x[8];
#pragma unroll
        for (int r = 0; r < 8; ++r) {
            const int c = sub * 8 + r;
            const unsigned ij = slut[c < 50 ? c : 0];
            const int i = ij >> 4, j = ij & 15;
            const unsigned kx = (ord_key(sval[(2 * hd) * 16 + i] + sval[(2 * hd + 1) * 16 + j]) & ~255u) | (unsigned)(255 - (i * 16 + j));
            x[r] = c < 50 ? kx : 0u;
        }
#pragma unroll
        for (int k = 2; k <= 64; k <<= 1) {
#pragma unroll
            for (int j = k >> 1; j >= 1; j >>= 1) {
                if (j >= 8) {
                    const int ld = j >> 3;
                    const bool lower = (sub & ld) == 0;
                    const bool desc = k >= 64 ? true : ((sub * 8) & k) == 0;
                    const bool takemax = (lower == desc);
#pragma unroll
                    for (int r = 0; r < 8; ++r) {
                        const unsigned o = (unsigned)__shfl_xor((int)x[r], ld, 64);
                        const unsigned hi = max(x[r], o), lo = min(x[r], o);
                        x[r] = takemax ? hi : lo;
                    }
                } else {
#pragma unroll
                    for (int r = 0; r < 8; ++r) {
                        if ((r & j) == 0) {
                            const int p = r | j;
                            const unsigned hi = max(x[r], x[p]), lo = min(x[r], x[p]);
                            if (k <= 4) { const bool desc = (r & k) == 0; x[r] = desc ? hi : lo; x[p] = desc ? lo : hi; }
                            else if (k >= 64) { x[r] = hi; x[p] = lo; }
                            else { const bool desc = ((sub * 8) & k) == 0; x[r] = desc ? hi : lo; x[p] = desc ? lo : hi; }
                        }
                    }
                }
            }
        }
        const float smax = unord_key((unsigned)__shfl((int)x[0], hd * 8, 64) & ~255u);
        float e[8]; float den = 0.f;
#pragma unroll
        for (int r = 0; r < 8; ++r) { e[r] = __expf(unord_key(x[r] & ~255u) - smax); den += e[r]; }
        den += __shfl_xor(den, 1, 64);
        const float inv = 1.f / den;
        if (sub < 2) {
#pragma unroll
            for (int r = 0; r < 8; ++r) {
                const int pos = 255 - (int)(x[r] & 255u), i = pos >> 4, j = pos & 15;
                sid[hd * 16 + sub * 8 + r] = sidx[(2 * hd) * 16 + i] * 128 + sidx[(2 * hd + 1) * 16 + j];
                sgate[hd * 16 + sub * 8 + r] = e[r] * inv;
            }
        }
    }
    __builtin_amdgcn_s_waitcnt(0xc07f);
    __builtin_amdgcn_wave_barrier();
    const bf16_t* xn = (const bf16_t*)(P.ws + WS_XN) + (size_t)t * DM;
    const float rstd = ((const float*)(P.ws + WS_RSTD))[t];
    const unsigned char* V = P.ws + WS_V + lane * 8;
    const float* usc = (const float*)(P.ws + WS_USC);
    const float* vsc = (const float*)(P.ws + WS_VSC);
    const int g = lane >> 4, lr = lane & 15;
    unsigned char* shi = (unsigned char*)sval;
    unsigned char* slo = (unsigned char*)sidx;
    {
        const uint4 xa = *(const uint4*)(xn + lane * 16), xb = *(const uint4*)(xn + lane * 16 + 8);
        const unsigned xw[8] = {xa.x, xa.y, xa.z, xa.w, xb.x, xb.y, xb.z, xb.w};
        unsigned hi[4], lo[4];
#pragma unroll
        for (int i = 0; i < 4; ++i) {
            const float x0 = bflo(xw[2 * i]), x1 = bfhi(xw[2 * i]), x2 = bflo(xw[2 * i + 1]), x3 = bfhi(xw[2 * i + 1]);
            int wd = 0;
            wd = __builtin_amdgcn_cvt_pk_fp8_f32(x0, x1, wd, false);
            wd = __builtin_amdgcn_cvt_pk_fp8_f32(x2, x3, wd, true);
            const f32x2 h01 = __builtin_amdgcn_cvt_pk_f32_fp8(wd, false), h23 = __builtin_amdgcn_cvt_pk_f32_fp8(wd, true);
            int wl = 0;
            wl = __builtin_amdgcn_cvt_pk_fp8_f32(x0 - h01.x, x1 - h01.y, wl, false);
            wl = __builtin_amdgcn_cvt_pk_fp8_f32(x2 - h23.x, x3 - h23.y, wl, true);
            hi[i] = (unsigned)wd; lo[i] = (unsigned)wl;
        }
        *(uint4*)(shi + lane * 16) = make_uint4(hi[0], hi[1], hi[2], hi[3]);
        *(uint4*)(slo + lane * 16) = make_uint4(lo[0], lo[1], lo[2], lo[3]);
    }
    __builtin_amdgcn_s_waitcnt(0xc07f);
    __builtin_amdgcn_wave_barrier();
    {
        typedef int v8i __attribute__((ext_vector_type(8)));
        const unsigned char* Ub = P.ws + WS_U + 16 * g;
        const unsigned char* bsrc = (lr == 0) ? (shi + 16 * g) : (lr == 1) ? (slo + 16 * g) : (const unsigned char*)szero;
        const int bstep = (lr < 2) ? 128 : 0, bhalf = (lr < 2) ? 64 : 16;
        v8i Bv[8];
#pragma unroll
        for (int st = 0; st < 8; ++st) {
            const uint4 b0 = *(const uint4*)(bsrc + bstep * st), b1 = *(const uint4*)(bsrc + bstep * st + bhalf);
            Bv[st] = (v8i){(int)b0.x, (int)b0.y, (int)b0.z, (int)b0.w, (int)b1.x, (int)b1.y, (int)b1.z, (int)b1.w};
        }
        unsigned off[8];
#pragma unroll
        for (int T = 0; T < 8; ++T) off[T] = (unsigned)sid[16 * T + lr] * 512u;
        __builtin_amdgcn_s_waitcnt(0xc07f);
        __builtin_amdgcn_wave_barrier();
        float* sact = (float*)sidx + ((lr == 1) ? 128 : 0);
        uint4 abuf[2][8];
#pragma unroll
        for (int st = 0; st < 8; ++st) abuf[0][st] = *(const uint4*)(Ub + off[0] + 64 * st);
#pragma unroll
        for (int T = 0; T < 8; ++T) {
            if (T + 1 < 8) {
#pragma unroll
                for (int st = 0; st < 8; ++st) abuf[(T + 1) & 1][st] = *(const uint4*)(Ub + off[T + 1] + 64 * st);
            }
            f32x4 au = (f32x4){0.f, 0.f, 0.f, 0.f};
#pragma unroll
            for (int st = 0; st < 8; ++st) {
                const uint4 a4 = abuf[T & 1][st];
                const v8i Av = {(int)a4.x, (int)a4.y, (int)a4.z, (int)a4.w, 0, 0, 0, 0};
                au = __builtin_amdgcn_mfma_scale_f32_16x16x128_f8f6f4(Av, Bv[st], au, 4, 0, 0, 0x7f7f7f7f, 0, 0x7f7f7f7f);
            }
            if (lr < 2) *(f32x4*)(sact + 16 * T + 4 * g) = au;
        }
    }
    __builtin_amdgcn_s_waitcnt(0xc07f);
    __builtin_amdgcn_wave_barrier();
    {
        float* sw = (float*)sidx;
        float wv[2];
#pragma unroll
        for (int hh = 0; hh < 2; ++hh) {
            const int e = lane + 64 * hh, id = sid[e];
            const float a = (sw[e] + sw[128 + e]) * usc[id] * rstd;
            wv[hh] = sgate[e] * vsc[id] * 0.5f * a * (1.f + erff(a * 0.70710678118654752f));
        }
        sw[lane] = wv[0]; sw[lane + 64] = wv[1];
    }
    __builtin_amdgcn_s_waitcnt(0xc07f);
    __builtin_amdgcn_wave_barrier();
    f32x2 acc[8];
#pragma unroll
    for (int j = 0; j < 8; ++j) acc[j] = (f32x2){0.f, 0.f};
#pragma unroll 1
    for (int e0 = 0; e0 < 128; e0 += 16) {
        uint2 vr[16];
#pragma unroll
        for (int q = 0; q < 16; ++q) vr[q] = *(const uint2*)(V + (size_t)sid[e0 + q] * 512);
        const float* sw = (const float*)sidx + e0;
        const f32x4 w0 = *(const f32x4*)(sw), w1 = *(const f32x4*)(sw + 4), w2 = *(const f32x4*)(sw + 8), w3 = *(const f32x4*)(sw + 12);
        const float wq[16] = {w0[0], w0[1], w0[2], w0[3], w1[0], w1[1], w1[2], w1[3], w2[0], w2[1], w2[2], w2[3], w3[0], w3[1], w3[2], w3[3]};
#pragma unroll
        for (int q = 0; q < 16; ++q) {
            const float w = wq[q];
#define FP4_AXPY(k) { acc[k] += w * __builtin_amdgcn_cvt_scalef32_pk_f32_fp4(vr[q].x, 1.0f, k); acc[4 + k] += w * __builtin_amdgcn_cvt_scalef32_pk_f32_fp4(vr[q].y, 1.0f, k); }
            FP4_AXPY(0) FP4_AXPY(1) FP4_AXPY(2) FP4_AXPY(3)
#undef FP4_AXPY
        }
    }
    f32x2 xf[8];
    {
        const uint4 xa = *(const uint4*)(xn + lane * 16), xb = *(const uint4*)(xn + lane * 16 + 8);
        xf[0] = (f32x2){bflo(xa.x), bfhi(xa.x)}; xf[1] = (f32x2){bflo(xa.y), bfhi(xa.y)}; xf[2] = (f32x2){bflo(xa.z), bfhi(xa.z)}; xf[3] = (f32x2){bflo(xa.w), bfhi(xa.w)};
        xf[4] = (f32x2){bflo(xb.x), bfhi(xb.x)}; xf[5] = (f32x2){bflo(xb.y), bfhi(xb.y)}; xf[6] = (f32x2){bflo(xb.z), bfhi(xb.z)}; xf[7] = (f32x2){bflo(xb.w), bfhi(xb.w)};
    }
    float* o = P.out + (size_t)t * DM + lane * 16;
    float4 h0, h1, h2, h3;
    {
        const float4 g0 = *(const float4*)(P.norm_ffn + lane * 16), g1 = *(const float4*)(P.norm_ffn + lane * 16 + 4), g2 = *(const float4*)(P.norm_ffn + lane * 16 + 8), g3 = *(const float4*)(P.norm_ffn + lane * 16 + 12);
        h0.x = xf[0].x / g0.x + acc[0].x; h0.y = xf[0].y / g0.y + acc[0].y; h0.z = xf[1].x / g0.z + acc[1].x; h0.w = xf[1].y / g0.w + acc[1].y;
        h1.x = xf[2].x / g1.x + acc[2].x; h1.y = xf[2].y / g1.y + acc[2].y; h1.z = xf[3].x / g1.z + acc[3].x; h1.w = xf[3].y / g1.w + acc[3].y;
        h2.x = xf[4].x / g2.x + acc[4].x; h2.y = xf[4].y / g2.y + acc[4].y; h2.z = xf[5].x / g2.z + acc[5].x; h2.w = xf[5].y / g2.w + acc[5].y;
        h3.x = xf[6].x / g3.x + acc[6].x; h3.y = xf[6].y / g3.y + acc[6].y; h3.z = xf[7].x / g3.z + acc[7].x; h3.w = xf[7].y / g3.w + acc[7].y;
    }
    *(float4*)(o) = h0; *(float4*)(o + 4) = h1; *(float4*)(o + 8) = h2; *(float4*)(o + 12) = h3;
    __builtin_amdgcn_s_waitcnt(0xc07f);
    __builtin_amdgcn_wave_barrier();
}

#define LAS __attribute__((address_space(3)))
#define XB_TMO      128
#define XB_XCNT(j)  (256  + 64 * (j))
#define XB_XSUB(j)  (1280 + 64 * (j))
#define XB_XGEN(j)  (2304 + 64 * (j))
#define XB_TOP      3328
#define XB_TOPGEN   3392
#define XCD_BAR_WORDS 3456
#define XB_SPIN_CAP (1u << 18)
__device__ __forceinline__ unsigned xb_ld(unsigned* p)              { return __hip_atomic_load(p, __ATOMIC_RELAXED, __HIP_MEMORY_SCOPE_AGENT); }
__device__ __forceinline__ unsigned xb_add(unsigned* p, unsigned v) { return __hip_atomic_fetch_add(p, v, __ATOMIC_RELAXED, __HIP_MEMORY_SCOPE_AGENT); }
__device__ __forceinline__ unsigned xb_xcc_id() { return (unsigned)__builtin_amdgcn_s_getreg((3 << 11) | 20) & 0xFu; }
#define XB_SPIN(cond, bar) do { unsigned _sp = 0; while (cond) { __builtin_amdgcn_s_sleep(1); \
    if ((++_sp & 255u) == 0u) { if (xb_ld(&(bar)[XB_TMO])) break; if (_sp > XB_SPIN_CAP) { atomicAdd(&(bar)[XB_TMO], 1u); break; } } } } while (0)
struct XcdBarrier { unsigned* bar; unsigned x; volatile LAS unsigned* st; };
__device__ __forceinline__ XcdBarrier xcd_barrier_post(unsigned* bar, volatile LAS unsigned* st) {
    XcdBarrier b; b.bar = bar; b.x = xb_xcc_id(); b.st = st;
    if (threadIdx.x == 0) (void)xb_add(&bar[XB_XCNT(b.x)], 1u);
    return b;
}
__device__ __forceinline__ void xcd_barrier_complete(unsigned* bar, unsigned x, unsigned& nloc, unsigned& nx) {
    const unsigned G = gridDim.x * gridDim.y * gridDim.z;
    unsigned sum, cnt, mine, sp = 0u;
    for (;;) {
        sum = 0u; cnt = 0u; mine = 0u;
#pragma unroll
        for (unsigned j = 0; j < 16; ++j) { const unsigned c = xb_ld(&bar[XB_XCNT(j)]); sum += c; cnt += (c > 0u) ? 1u : 0u; mine = (j == x) ? c : mine; }
        if (sum == G) break;
        __builtin_amdgcn_s_sleep(1);
        if ((++sp & 255u) == 0u) { if (xb_ld(&bar[XB_TMO])) break; if (sp > XB_SPIN_CAP) { atomicAdd(&bar[XB_TMO], 1u); break; } }
    }
    nloc = mine > 0u ? mine : 1u; nx = cnt > 0u ? cnt : 1u;
}
__device__ __forceinline__ void xcd_barrier(const XcdBarrier& b) {
    asm volatile("s_waitcnt vmcnt(0)" ::: "memory");
    __syncthreads();
    if (threadIdx.x == 0) {
        unsigned* bar = b.bar;
        __builtin_amdgcn_s_waitcnt(0);
        unsigned nloc = b.st[0], nx = b.st[1];
        if (nloc == 0u) { xcd_barrier_complete(bar, b.x, nloc, nx); b.st[0] = nloc; b.st[1] = nx; }
        const unsigned old = xb_add(&bar[XB_XSUB(b.x)], 1u);
        const unsigned gen = old / nloc;
        if (old + 1u == (gen + 1u) * nloc) {
            __builtin_amdgcn_fence(__ATOMIC_RELEASE, "agent");
            asm volatile("s_waitcnt vmcnt(0)" ::: "memory");
            const unsigned og = xb_add(&bar[XB_TOP], 1u);
            const unsigned tg = og / nx;
            if (og + 1u == (tg + 1u) * nx) xb_add(&bar[XB_TOPGEN], 1u);
            else XB_SPIN(xb_ld(&bar[XB_TOPGEN]) == tg, bar);
            __builtin_amdgcn_fence(__ATOMIC_ACQUIRE, "agent");
            xb_add(&bar[XB_XGEN(b.x)], 1u);
            asm volatile("s_waitcnt vmcnt(0)" ::: "memory");
        } else {
            XB_SPIN(xb_ld(&bar[XB_XGEN(b.x)]) == gen, bar);
            __builtin_amdgcn_fence(__ATOMIC_ACQUIRE, "agent");
            asm volatile("s_waitcnt vmcnt(0)" ::: "memory");
        }
    }
    __syncthreads();
}

__device__ __forceinline__ void hand_release() { asm volatile("s_waitcnt vmcnt(0)" ::: "memory"); __builtin_amdgcn_fence(__ATOMIC_RELEASE, "agent"); asm volatile("s_waitcnt vmcnt(0)" ::: "memory"); }
__device__ __forceinline__ void hand_acquire() { __builtin_amdgcn_fence(__ATOMIC_ACQUIRE, "agent"); asm volatile("s_waitcnt vmcnt(0)" ::: "memory"); }

__global__ void __launch_bounds__(256, 2) mega(Params P) {
    extern __shared__ __attribute__((aligned(16))) unsigned char smem[];
    const int tid = threadIdx.x, lane = tid & 63, wave = tid >> 6;
    const int G = gridDim.x, bid = blockIdx.x;
    unsigned* ctl = (unsigned*)(P.ws + WS_CTL);
    volatile LAS unsigned* bst = (volatile LAS unsigned*)(smem + 65552);
    if (tid == 0) { bst[0] = 0u; bst[1] = 0u; }
    __syncthreads();
    const XcdBarrier xb = xcd_barrier_post(ctl + 1024, bst);
    unsigned* cucnt = ctl + 5120;
    if (tid == 0) {
        const unsigned phys = ((xb_xcc_id() & 7u) << 8) | ((unsigned)__builtin_amdgcn_s_getreg((7 << 11) | (8 << 6) | 4) & 0xFFu);
        bst[2] = phys; bst[3] = xb_add(&cucnt[phys], 1u);
    }
    phase0(P, smem);
    xcd_barrier(xb);
    {
        int vb;
        const unsigned phys = bst[2];
        unsigned part = 0;
#pragma unroll
        for (int q = 0; q < 8; ++q) { const unsigned i = (unsigned)(tid + 256 * q); const unsigned c = xb_ld(&cucnt[i]); part += (i < phys) ? c : 0u; }
#pragma unroll
        for (int o = 1; o < 64; o <<= 1) part += (unsigned)__shfl_xor((int)part, o, 64);
        if (lane == 0) bst[4 + wave] = part;
        __syncthreads();
        vb = (int)(bst[4] + bst[5] + bst[6] + bst[7] + bst[3]);
        vb = __builtin_amdgcn_readfirstlane(vb);
        if (vb < 0 || vb >= G) vb = bid;
        __syncthreads();
        if (tid == 0) bst[8] = (unsigned)vb;
        __syncthreads();
    }
#define VB_LOAD() __builtin_amdgcn_readfirstlane((int)bst[8])
    {
        const int gw = bid * 4 + wave;
        if (gw < 64) fox_cum_wave(P, gw, lane);
        const int vb = VB_LOAD();
        for (int tile = vb; tile < 129 * 28; tile += G) gemm_tile<1>(P, tile / 28, tile % 28, smem);
        {
            const int rem = (129 * 28) % G;
            if (rem > 0 && rem < G) { if (vb >= rem) convert_uv_rows(P, (vb - rem) * 4 + wave, (G - rem) * 4, lane); }
            else convert_uv_rows(P, vb * 4 + wave, G * 4, lane);
        }
    }
    xcd_barrier(xb);
    {
        volatile int* s_item = (volatile int*)(smem + 65536);
        const int wave_u = __builtin_amdgcn_readfirstlane(wave);
        auto fetch = [&](unsigned* counter) -> int {
            if (wave_u == 0) {
                unsigned v = atomicAdd(counter, lane == 0 ? 1u : 0u);
                *s_item = (int)__builtin_amdgcn_readfirstlane(v);
            }
            __syncthreads();
            const int item = __builtin_amdgcn_readfirstlane(*s_item);
            __syncthreads();
            return item;
        };
        for (;;) {
            const int item = fetch(&ctl[2]);
            if (item >= 33 * 32) break;
            mlstm_A(P, item, smem);
        }
        xcd_barrier(xb);
        for (;;) {
            const int item = fetch(&ctl[4]);
            if (item >= 96) break;
            mlstm_B(P, item);
        }
        for (;;) {
            const int item = fetch(&ctl[3]);
            if (item >= 64 * 17) break;
            attn_block(P, item & 63, 16 - (item >> 6), smem);
        }
        xcd_barrier(xb);
        for (;;) {
            const int item = fetch(&ctl[5]);
            if (item >= 33 * 32) break;
            mlstm_C(P, item, smem);
        }
    }
    xcd_barrier(xb);
    for (int tile = VB_LOAD(); tile < 128 * 8; tile += G) gemm_tile<2>(P, tile >> 3, tile & 7, smem);
    xcd_barrier(xb);
    for (int tile = VB_LOAD(); tile < 128 * 16; tile += G) gemm_tile<3>(P, tile >> 4, tile & 15, smem);
    xcd_barrier(xb);
    {
        unsigned char* slut = smem + 12288;
        if (tid < 64) {
            int c = tid, i = 0;
            while (i < 16 && c >= 16 / (i + 1)) { c -= 16 / (i + 1); ++i; }
            slut[tid] = (unsigned char)(i < 16 ? ((i << 4) | c) : 0);
        }
        unsigned* szero = (unsigned*)(smem + 12288 + 64);
        if (tid < 16) szero[tid] = 0u;
        __syncthreads();
        int* sidx = (int*)(smem + wave * 3072); float* sval = (float*)(smem + wave * 3072 + 1024);
        int* sid = (int*)(smem + wave * 3072 + 2048); float* sgate = (float*)(smem + wave * 3072 + 2560);
        int lane5 = lane;
        asm volatile("" : "+v"(lane5));
        for (int t = bid * 4 + wave; t < T2; t += G * 4) peer_token(P, t, lane5, sidx, sval, sid, sgate, slut, szero);
    }
}

}

extern "C" void kernel_launch(void* const* d_in, const int* in_sizes, int n_in, void* d_out, int out_size, void* d_ws, size_t ws_size, hipStream_t stream) {
    if (n_in != 17 || ws_size < WS_END) { fprintf(stderr, "kernel_launch: unexpected n_in %d or ws_size %zu (need %zu)\n", n_in, ws_size, (size_t)WS_END); return; }
    constexpr int LDS_BYTES = 66560;
    static int grid_blocks = 0;
    if (!grid_blocks) {
        int dev = 0, cus = 0, per_cu = 0;
        (void)hipGetDevice(&dev);
        (void)hipDeviceGetAttribute(&cus, hipDeviceAttributeMultiprocessorCount, dev);
        (void)hipFuncSetAttribute((const void*)mega, hipFuncAttributeMaxDynamicSharedMemorySize, LDS_BYTES);
        (void)hipOccupancyMaxActiveBlocksPerMultiprocessor(&per_cu, (const void*)mega, 256, LDS_BYTES);
        if (per_cu < 1) per_cu = 1;
        if (per_cu > 2) per_cu = 2;
        grid_blocks = cus * per_cu;
        fprintf(stderr, "kernel_launch: cus %d per_cu %d grid %d\n", cus, per_cu, grid_blocks);
    }
    Params P{};
    P.x = (const float*)d_in[0]; P.meta = (const float*)d_in[1]; P.norm_mix = (const float*)d_in[2]; P.w_in = (const float*)d_in[3];
    P.conv_qk = (const float*)d_in[4]; P.b_igate = (const float*)d_in[5]; P.b_fgate_m = (const float*)d_in[6]; P.m_out_norm = (const float*)d_in[7];
    P.b_fgate_f = (const float*)d_in[8]; P.f_q_norm = (const float*)d_in[9]; P.f_k_norm = (const float*)d_in[10]; P.w_out = (const float*)d_in[11];
    P.norm_ffn = (const float*)d_in[12]; P.peer_query = (const float*)d_in[13]; P.peer_keys = (const float*)d_in[14]; P.peer_u = (const float*)d_in[15];
    P.peer_v = (const float*)d_in[16]; P.out = (float*)d_out; P.ws = (unsigned char*)d_ws;
    (void)hipMemsetAsync((unsigned char*)d_ws + WS_CTL, 0, 32768, stream);
    void* args[] = {&P};
    hipError_t e = hipLaunchCooperativeKernel((const void*)mega, dim3(grid_blocks), dim3(256), args, LDS_BYTES, stream);
    if (e != hipSuccess) fprintf(stderr, "cooperative launch failed: %s (grid %d)\n", hipGetErrorString(e), grid_blocks);
}
```

```cpp
#include <hip/hip_runtime.h>
#include <stdint.h>
#include <stdio.h>
#include <hip/hip_cooperative_groups.h>
namespace cg = cooperative_groups;

namespace {

constexpr int NB = 8, SEQ = 2048, DM = 1024, NMETA = 16, L = SEQ + NMETA;
constexpr int T1 = NB * L;
constexpr int T2 = NB * SEQ;
constexpr int NZ = 3584;
constexpr int ZC_MQ = 0, ZC_MK = 512, ZC_MV = 1024, ZC_MO = 1536, ZC_FQ = 2048, ZC_FK = 2560, ZC_FV = 3072;
constexpr int PROJ = 3600;
constexpr float EPS = 1e-6f;

constexpr size_t WS_CTL = 0;
constexpr size_t WS_RA = 65536;
constexpr size_t WS_Z = WS_RA + (size_t)T1 * DM * 2;
constexpr size_t WS_GATES = WS_Z + (size_t)T1 * NZ * 2;
constexpr size_t WS_CUM = WS_GATES + (size_t)T1 * 16 * 4;
constexpr size_t WS_SSQ = WS_CUM + (size_t)NB * 8 * L * 4;
constexpr size_t WS_RSTD = WS_SSQ + (size_t)T2 * 16 * 4;
constexpr size_t WS_SSQM = WS_RSTD + (size_t)T2 * 4;
constexpr size_t WS_BT2 = WS_SSQM + (size_t)T1 * 16 * 4;
constexpr size_t WS_BT3 = WS_BT2 + (size_t)DM * DM * 2;
constexpr size_t WS_KEYS = WS_BT3 + (size_t)2048 * DM * 2;
constexpr size_t WS_MSC = WS_KEYS + (size_t)16 * 128 * 128 * 2;
constexpr size_t WS_MST = WS_MSC + (size_t)128 * 33 * 16;
constexpr size_t WS_BT1 = WS_MST + (size_t)32 * 33 * 36864;
constexpr size_t WS_CBI = WS_BT1;
constexpr size_t WS_UV = WS_CBI + (size_t)32 * 33 * 36864;
constexpr size_t WS_END = WS_UV + (size_t)2 * 16384 * 512 + (size_t)2 * 16384 * 4;
constexpr size_t WS_XN = WS_RA;
constexpr size_t WS_U = WS_UV;
constexpr size_t WS_V = WS_U + (size_t)16384 * 512;
constexpr size_t WS_USC = WS_V + (size_t)16384 * 512;
constexpr size_t WS_VSC = WS_USC + (size_t)16384 * 4;
constexpr size_t WS_TK = WS_CBI;
constexpr float LOG2E = 1.4426950408889634f;

typedef unsigned short bf16_t;
typedef short bf16x8 __attribute__((ext_vector_type(8)));
typedef float f32x4 __attribute__((ext_vector_type(4)));
typedef __attribute__((ext_vector_type(2))) __bf16 bf16x2_t;

struct Params {
    const float* x; const float* meta; const float* norm_mix; const float* w_in; const float* conv_qk;
    const float* b_igate; const float* b_fgate_m; const float* m_out_norm; const float* b_fgate_f;
    const float* f_q_norm; const float* f_k_norm; const float* w_out; const float* norm_ffn;
    const float* peer_query; const float* peer_keys; const float* peer_u; const float* peer_v;
    float* out; unsigned char* ws;
};

__device__ __forceinline__ unsigned f2bf(float f) { unsigned u = __float_as_uint(f); return (u + 0x7fffu + ((u >> 16) & 1u)) >> 16; }
__device__ __forceinline__ float bf2f(unsigned h) { return __uint_as_float(h << 16); }
typedef float f32x2 __attribute__((ext_vector_type(2)));
typedef __bf16 bf16x2v __attribute__((ext_vector_type(2)));
__device__ __forceinline__ unsigned cvt_pk_bf16(float lo, float hi) { f32x2 v = {lo, hi}; bf16x2v b = __builtin_convertvector(v, bf16x2v); return __builtin_bit_cast(unsigned, b); }
__device__ __forceinline__ unsigned pk2(float lo, float hi) { return cvt_pk_bf16(lo, hi); }
__device__ __forceinline__ float bflo(unsigned w) { return __uint_as_float(w << 16); }
__device__ __forceinline__ float bfhi(unsigned w) { return __uint_as_float(w & 0xffff0000u); }
__device__ __forceinline__ float wave_sum(float v) {
#pragma unroll
    for (int o = 32; o > 0; o >>= 1) v += __shfl_xor(v, o, 64);
    return v;
}
__device__ __forceinline__ float wave_max(float v) {
#pragma unroll
    for (int o = 32; o > 0; o >>= 1) v = fmaxf(v, __shfl_xor(v, o, 64));
    return v;
}
__device__ __forceinline__ float logsigmoidf(float x) { return fminf(x, 0.f) - log1pf(expf(-fabsf(x))); }
__device__ __forceinline__ unsigned ord_key(float f) { unsigned u = __float_as_uint(f); return u ^ ((u >> 31) ? 0xffffffffu : 0x80000000u); }
__device__ __forceinline__ float unord_key(unsigned k) { unsigned u = (k & 0x80000000u) ? (k ^ 0x80000000u) : ~k; return __uint_as_float(u); }

__device__ __forceinline__ void phase0(const Params& P, unsigned char* smem) {
    const int tid = threadIdx.x, lane = tid & 63, wave = tid >> 6;
    unsigned* ctl = (unsigned*)(P.ws + WS_CTL);
    float* gw = (float*)smem;
    for (int idx = tid; idx < 16 * 1024; idx += 256) {
        const int k = idx >> 4, c = idx & 15;
        const int col = c < 8 ? 2048 + c : 3592 + (c - 8);
        gw[c * 1024 + k] = P.w_in[(size_t)k * PROJ + col];
    }
    __syncthreads();
    {
        bf16_t* hn = (bf16_t*)(P.ws + WS_RA);
        float* gates = (float*)(P.ws + WS_GATES);
        const int c0 = lane * 8, c1 = 512 + lane * 8;
        float gm[16];
        {
            const float4 a0 = *(const float4*)(P.norm_mix + c0), a1 = *(const float4*)(P.norm_mix + c0 + 4);
            const float4 a2 = *(const float4*)(P.norm_mix + c1), a3 = *(const float4*)(P.norm_mix + c1 + 4);
            gm[0] = a0.x; gm[1] = a0.y; gm[2] = a0.z; gm[3] = a0.w; gm[4] = a1.x; gm[5] = a1.y; gm[6] = a1.z; gm[7] = a1.w;
            gm[8] = a2.x; gm[9] = a2.y; gm[10] = a2.z; gm[11] = a2.w; gm[12] = a3.x; gm[13] = a3.y; gm[14] = a3.z; gm[15] = a3.w;
        }
        const int myq = ((lane >> 5) & 1) * 8 + ((lane >> 4) & 1) * 4 + ((lane >> 3) & 1) * 2 + ((lane >> 2) & 1);
        const float mybias = myq < 4 ? P.b_igate[myq] : (myq < 8 ? P.b_fgate_m[myq - 4] : P.b_fgate_f[myq - 8]);
        const int rstep = gridDim.x * 4;
        int r = blockIdx.x * 4 + wave;
        float4 n0, n1, n2, n3;
        auto load_row = [&](int rr) {
            const int b = rr / L, p = rr - b * L;
            const float* src = (p < NMETA) ? (P.meta + (size_t)p * DM) : (P.x + ((size_t)b * SEQ + (p - NMETA)) * DM);
            n0 = *(const float4*)(src + c0); n1 = *(const float4*)(src + c0 + 4); n2 = *(const float4*)(src + c1); n3 = *(const float4*)(src + c1 + 4);
        };
        if (r < T1) load_row(r);
        for (; r < T1; r += rstep) {
            float v[16];
            v[0] = n0.x; v[1] = n0.y; v[2] = n0.z; v[3] = n0.w; v[4] = n1.x; v[5] = n1.y; v[6] = n1.z; v[7] = n1.w;
            v[8] = n2.x; v[9] = n2.y; v[10] = n2.z; v[11] = n2.w; v[12] = n3.x; v[13] = n3.y; v[14] = n3.z; v[15] = n3.w;
            if (r + rstep < T1) load_row(r + rstep);
            float ss = 0.f;
#pragma unroll
            for (int j = 0; j < 16; ++j) ss += v[j] * v[j];
            ss = wave_sum(ss);
            const float rstd = rsqrtf(ss * (1.0f / DM) + EPS);
#pragma unroll
            for (int j = 0; j < 16; ++j) v[j] *= rstd * gm[j];
            uint4 o0, o1;
            o0.x = pk2(v[0], v[1]); o0.y = pk2(v[2], v[3]); o0.z = pk2(v[4], v[5]); o0.w = pk2(v[6], v[7]);
            o1.x = pk2(v[8], v[9]); o1.y = pk2(v[10], v[11]); o1.z = pk2(v[12], v[13]); o1.w = pk2(v[14], v[15]);
            *(uint4*)(hn + (size_t)r * DM + c0) = o0;
            *(uint4*)(hn + (size_t)r * DM + c1) = o1;
            float r8[8], r4[4], r2[2], r1;
#pragma unroll
            for (int i = 0; i < 8; ++i) {
                float dd[2];
#pragma unroll
                for (int hh = 0; hh < 2; ++hh) {
                    const float* gwc = gw + (i + 8 * hh) * 1024;
                    const float4 w0 = *(const float4*)(gwc + c0), w1 = *(const float4*)(gwc + c0 + 4), w2 = *(const float4*)(gwc + c1), w3 = *(const float4*)(gwc + c1 + 4);
                    dd[hh] = v[0] * w0.x + v[1] * w0.y + v[2] * w0.z + v[3] * w0.w + v[4] * w1.x + v[5] * w1.y + v[6] * w1.z + v[7] * w1.w
                           + v[8] * w2.x + v[9] * w2.y + v[10] * w2.z + v[11] * w2.w + v[12] * w3.x + v[13] * w3.y + v[14] * w3.z + v[15] * w3.w;
                }
                const bool up = (lane & 32) != 0; const float keep = up ? dd[1] : dd[0], send = up ? dd[0] : dd[1];
                r8[i] = keep + __shfl_xor(send, 32, 64);
                __builtin_amdgcn_sched_barrier(0);
            }
#pragma unroll
            for (int i = 0; i < 4; ++i) { const bool up = (lane & 16) != 0; const float keep = up ? r8[i + 4] : r8[i], send = up ? r8[i] : r8[i + 4]; r4[i] = keep + __shfl_xor(send, 16, 64); }
#pragma unroll
            for (int i = 0; i < 2; ++i) { const bool up = (lane & 8) != 0; const float keep = up ? r4[i + 2] : r4[i], send = up ? r4[i] : r4[i + 2]; r2[i] = keep + __shfl_xor(send, 8, 64); }
            { const bool up = (lane & 4) != 0; const float keep = up ? r2[1] : r2[0], send = up ? r2[0] : r2[1]; r1 = keep + __shfl_xor(send, 4, 64); }
            r1 += __shfl_xor(r1, 2, 64); r1 += __shfl_xor(r1, 1, 64);
            if ((lane & 3) == 0) {
                const float pre = r1 + mybias;
                gates[(size_t)r * 16 + myq] = myq < 4 ? pre : logsigmoidf(pre);
            }
        }
    }
    __syncthreads();
    {
        float (*tile)[65] = (float (*)[65])smem;
        for (int item = blockIdx.x; item < 1664; item += gridDim.x) {
            const float* W; int ldn, ntn, shift_from, it; bf16_t* out;
            if (item < 896) { W = P.w_in; ldn = PROJ; ntn = 56; shift_from = 2048; it = item; out = (bf16_t*)(P.ws + WS_BT1); }
            else if (item < 1152) { W = P.w_out; ldn = 1024; ntn = 16; shift_from = 1 << 30; it = item - 896; out = (bf16_t*)(P.ws + WS_BT2); }
            else { W = P.peer_query; ldn = 2048; ntn = 32; shift_from = 1 << 30; it = item - 1152; out = (bf16_t*)(P.ws + WS_BT3); }
            const int tk = it / ntn, tn = it - tk * ntn, k0 = tk * 64, n0 = tn * 64;
            {
                const int nl = tid & 63;
                int n = n0 + nl; if (n >= shift_from) n += 8;
#pragma unroll
                for (int i = 0; i < 16; ++i) { const int kl = (tid >> 6) + 4 * i; tile[kl][nl] = W[(size_t)(k0 + kl) * ldn + n]; }
            }
            __syncthreads();
            {
                const int kl = tid & 63;
#pragma unroll
                for (int i = 0; i < 16; ++i) { const int nl = (tid >> 6) + 4 * i; out[(size_t)(n0 + nl) * 1024 + k0 + kl] = (bf16_t)f2bf(tile[kl][nl]); }
            }
            __syncthreads();
        }
    }
    {
        const size_t gt = (size_t)blockIdx.x * 256 + tid, gs = (size_t)gridDim.x * 256;
        const float* src = P.peer_keys; bf16_t* dst = (bf16_t*)(P.ws + WS_KEYS);
        for (size_t i = gt; i < (size_t)(16 * 128 * 128 / 8); i += gs) {
            const float4 a = *(const float4*)(src + i * 8), b = *(const float4*)(src + i * 8 + 4);
            uint4 o; o.x = pk2(a.x, a.y); o.y = pk2(a.z, a.w); o.z = pk2(b.x, b.y); o.w = pk2(b.z, b.w);
            *(uint4*)(dst + i * 8) = o;
        }
    }
}

__device__ __forceinline__ void convert_uv_rows(const Params& P, int gwave, int nwaves, int lane) {
    for (int rr0 = gwave * 4; rr0 < 2 * 16384; rr0 += nwaves * 4) {
        float4 a[4][4];
#pragma unroll
        for (int q = 0; q < 4; ++q) {
            const int rr = rr0 + q, which = rr >> 14, row = rr & 16383;
            const float* src = (which ? P.peer_v : P.peer_u) + (size_t)row * DM + lane * 16;
            a[q][0] = *(const float4*)(src); a[q][1] = *(const float4*)(src + 4); a[q][2] = *(const float4*)(src + 8); a[q][3] = *(const float4*)(src + 12);
        }
#pragma unroll
        for (int q = 0; q < 4; ++q) {
            const int rr = rr0 + q, which = rr >> 14, row = rr & 16383;
            float mx = 0.f;
#pragma unroll
            for (int j = 0; j < 4; ++j) mx = fmaxf(mx, fmaxf(fmaxf(fabsf(a[q][j].x), fabsf(a[q][j].y)), fmaxf(fabsf(a[q][j].z), fabsf(a[q][j].w))));
            mx = wave_max(mx);
            const float sc = mx > 0.f ? 6.0f / mx : 1.0f;
            unsigned w0 = 0u, w1 = 0u;
            w0 = __builtin_amdgcn_cvt_scalef32_pk_fp4_f32(w0, a[q][0].x * sc, a[q][0].y * sc, 1.0f, 0); w0 = __builtin_amdgcn_cvt_scalef32_pk_fp4_f32(w0, a[q][0].z * sc, a[q][0].w * sc, 1.0f, 1);
            w0 = __builtin_amdgcn_cvt_scalef32_pk_fp4_f32(w0, a[q][1].x * sc, a[q][1].y * sc, 1.0f, 2); w0 = __builtin_amdgcn_cvt_scalef32_pk_fp4_f32(w0, a[q][1].z * sc, a[q][1].w * sc, 1.0f, 3);
            w1 = __builtin_amdgcn_cvt_scalef32_pk_fp4_f32(w1, a[q][2].x * sc, a[q][2].y * sc, 1.0f, 0); w1 = __builtin_amdgcn_cvt_scalef32_pk_fp4_f32(w1, a[q][2].z * sc, a[q][2].w * sc, 1.0f, 1);
            w1 = __builtin_amdgcn_cvt_scalef32_pk_fp4_f32(w1, a[q][3].x * sc, a[q][3].y * sc, 1.0f, 2); w1 = __builtin_amdgcn_cvt_scalef32_pk_fp4_f32(w1, a[q][3].z * sc, a[q][3].w * sc, 1.0f, 3);
            *(uint2*)(P.ws + (which ? WS_V : WS_U) + (size_t)row * 512 + lane * 8) = make_uint2(w0, w1);
            if (lane == 0) ((float*)(P.ws + (which ? WS_VSC : WS_USC)))[row] = mx > 0.f ? mx * (1.0f / 6.0f) : 1.0f;
        }
    }
}

__device__ __forceinline__ void bitonic_sort16_desc(unsigned (&v)[16]) {
#pragma unroll
    for (int k = 2; k <= 16; k <<= 1)
#pragma unroll
        for (int j = k >> 1; j >= 1; j >>= 1)
#pragma unroll
            for (int i = 0; i < 16; ++i)
                if ((i & j) == 0) {
                    const int p = i | j;
                    const bool desc = (k >= 16) ? true : ((i & k) == 0);
                    const unsigned hi = max(v[i], v[p]), lo = min(v[i], v[p]);
                    v[i] = desc ? hi : lo; v[p] = desc ? lo : hi;
                }
}
__device__ __forceinline__ void bitonic_merge16_top(unsigned (&a)[16], const unsigned (&b)[16]) {
#pragma unroll
    for (int i = 0; i < 16; ++i) a[i] = max(a[i], b[15 - i]);
#pragma unroll
    for (int j = 8; j >= 1; j >>= 1)
#pragma unroll
        for (int i = 0; i < 16; ++i)
            if ((i & j) == 0) { const int p = i | j; const unsigned hi = max(a[i], a[p]), lo = min(a[i], a[p]); a[i] = hi; a[p] = lo; }
}

__device__ __forceinline__ float x4_max(float x) {
    const unsigned xi = __float_as_uint(x);
    const auto r = __builtin_amdgcn_permlane32_swap(xi, xi, false, false);
    const float m = fmaxf(__uint_as_float(r[0]), __uint_as_float(r[1]));
    const unsigned mi = __float_as_uint(m);
    const auto r2 = __builtin_amdgcn_permlane16_swap(mi, mi, false, false);
    return fmaxf(__uint_as_float(r2[0]), __uint_as_float(r2[1]));
}
__device__ __forceinline__ float x4_sum(float x) {
    const unsigned xi = __float_as_uint(x);
    const auto r = __builtin_amdgcn_permlane32_swap(xi, xi, false, false);
    const float m = __uint_as_float(r[0]) + __uint_as_float(r[1]);
    const unsigned mi = __float_as_uint(m);
    const auto r2 = __builtin_amdgcn_permlane16_swap(mi, mi, false, false);
    return __uint_as_float(r2[0]) + __uint_as_float(r2[1]);
}

__device__ __forceinline__ int opaque_tid() { int t = threadIdx.x; asm volatile("" : "+v"(t)); return t; }

__device__ __forceinline__ void mma_ktile(const unsigned char* sA, const unsigned char* sB, int arow_off, int brow_off, int g, int sw, f32x4 (&acc)[4][4]) {
#pragma unroll
    for (int s = 0; s < 2; ++s) {
        bf16x8 a[4], b[4];
        const int ch = (((s * 4 + g) ^ sw) << 4);
#pragma unroll
        for (int i = 0; i < 4; ++i) a[i] = *(const bf16x8*)(sA + arow_off + i * 2048 + ch);
#pragma unroll
        for (int j = 0; j < 4; ++j) b[j] = *(const bf16x8*)(sB + brow_off + j * 2048 + ch);
#pragma unroll
        for (int i = 0; i < 4; ++i)
#pragma unroll
            for (int j = 0; j < 4; ++j) acc[i][j] = __builtin_amdgcn_mfma_f32_16x16x32_bf16(b[j], a[i], acc[i][j], 0, 0, 0);
    }
}

__device__ __forceinline__ void store_tile_bf16(const f32x4 (&acc)[4][4], unsigned char* smem, bf16_t* dst, size_t ld, int m0, int n0, int tid, int wr, int wc, int g, int lr) {
#pragma unroll
    for (int i = 0; i < 4; ++i)
#pragma unroll
        for (int j = 0; j < 4; ++j) {
            const int row = wr * 64 + 16 * i + lr, col = wc * 64 + 16 * j + 4 * g;
            uint2 w; w.x = pk2(acc[i][j][0], acc[i][j][1]); w.y = pk2(acc[i][j][2], acc[i][j][3]);
            *(uint2*)(smem + row * 272 + col * 2) = w;
        }
    __syncthreads();
#pragma unroll
    for (int q = 0; q < 8; ++q) {
        const int id = tid + 256 * q, row = id >> 4, ch = id & 15;
        const uint4 v = *(const uint4*)(smem + row * 272 + ch * 16);
        *(uint4*)(dst + (size_t)(m0 + row) * ld + n0 + ch * 8) = v;
    }
    __syncthreads();
}

template <int MODE>
__device__ __forceinline__ void gemm_tile(const Params& P, int tm, int tn, unsigned char* smem) {
    const bf16_t* A; const bf16_t* Bt;
    if (MODE == 1) { A = (const bf16_t*)(P.ws + WS_RA); Bt = (const bf16_t*)(P.ws + WS_BT1); }
    else if (MODE == 2) { A = (const bf16_t*)(P.ws + WS_Z); Bt = (const bf16_t*)(P.ws + WS_BT2); }
    else { A = (const bf16_t*)(P.ws + WS_XN); Bt = (const bf16_t*)(P.ws + WS_BT3); }
    const int tid = opaque_tid(), lane = tid & 63, wave = tid >> 6, wr = wave >> 1, wc = wave & 1, g = lane >> 4, lr = lane & 15;
    const int m0 = tm * 128, n0 = tn * 128;
    const int srow = tid >> 3, sc = tid & 7;
    constexpr unsigned LDA = (MODE == 2 ? NZ : 1024) * 2u;
    unsigned aoff, boff; int soff0;
    {
        int ar = m0 + srow;
        if (MODE == 2) { const int b = ar >> 11, t = ar & 2047; ar = b * L + NMETA + t; }
        aoff = (unsigned)ar * LDA + (unsigned)sc * 16u;
        boff = (unsigned)(n0 + srow) * 2048u + (unsigned)sc * 16u;
        soff0 = srow * 128 + ((sc ^ (srow & 7)) << 4);
    }
    const unsigned char* Ab = (const unsigned char*)A; const unsigned char* Bb = (const unsigned char*)Bt;
    f32x4 acc[4][4];
#pragma unroll
    for (int i = 0; i < 4; ++i)
#pragma unroll
        for (int j = 0; j < 4; ++j) acc[i][j] = (f32x4){0.f, 0.f, 0.f, 0.f};
    uint4 ra0, ra1, ra2, ra3, rb0, rb1, rb2, rb3;
#define G_LOAD(KT) { const unsigned ko = (unsigned)(KT) * 128u; \
        ra0 = *(const uint4*)(Ab + (aoff + ko)); ra1 = *(const uint4*)(Ab + (aoff + 32u * LDA + ko)); ra2 = *(const uint4*)(Ab + (aoff + 64u * LDA + ko)); ra3 = *(const uint4*)(Ab + (aoff + 96u * LDA + ko)); \
        rb0 = *(const uint4*)(Bb + (boff + ko)); rb1 = *(const uint4*)(Bb + (boff + 32u * 2048u + ko)); rb2 = *(const uint4*)(Bb + (boff + 64u * 2048u + ko)); rb3 = *(const uint4*)(Bb + (boff + 96u * 2048u + ko)); }
#define G_WRITE(SA, SB) { *(uint4*)((SA) + soff0) = ra0; *(uint4*)((SA) + soff0 + 4096) = ra1; *(uint4*)((SA) + soff0 + 8192) = ra2; *(uint4*)((SA) + soff0 + 12288) = ra3; \
        *(uint4*)((SB) + soff0) = rb0; *(uint4*)((SB) + soff0 + 4096) = rb1; *(uint4*)((SB) + soff0 + 8192) = rb2; *(uint4*)((SB) + soff0 + 12288) = rb3; }
    unsigned char* sA0 = smem; unsigned char* sB0 = smem + 16384; unsigned char* sA1 = smem + 32768; unsigned char* sB1 = smem + 49152;
    G_LOAD(0)
    G_WRITE(sA0, sB0)
    __syncthreads();
    const int arow_off = (wr * 64 + lr) * 128, brow_off = (wc * 64 + lr) * 128, sw = lr & 7;
    G_LOAD(1)
    for (int kt = 0; kt < 16; ++kt) {
        unsigned char* sA = (kt & 1) ? sA1 : sA0; unsigned char* sB = (kt & 1) ? sB1 : sB0;
        unsigned char* nA = (kt & 1) ? sA0 : sA1; unsigned char* nB = (kt & 1) ? sB0 : sB1;
        mma_ktile(sA, sB, arow_off, brow_off, g, sw, acc);
        if (kt < 15) G_WRITE(nA, nB)
        if (kt < 14) G_LOAD(kt + 2)
        __syncthreads();
    }
#undef G_LOAD
#undef G_WRITE
    if (MODE == 1) {
        if (n0 >= ZC_FQ && n0 < ZC_FV) {
            const bool isk = n0 >= ZC_FK;
            const float* gain = isk ? P.f_k_norm : P.f_q_norm;
            const float scl = isk ? 1.0f : 0.125f * LOG2E;
            float gn[4][4];
#pragma unroll
            for (int j = 0; j < 4; ++j)
#pragma unroll
                for (int r = 0; r < 4; ++r) gn[j][r] = gain[16 * j + 4 * g + r];
#pragma unroll
            for (int i = 0; i < 4; ++i) {
                float ss = 0.f;
#pragma unroll
                for (int j = 0; j < 4; ++j)
#pragma unroll
                    for (int r = 0; r < 4; ++r) ss += acc[i][j][r] * acc[i][j][r];
                ss = x4_sum(ss);
                const float rstd = rsqrtf(ss * (1.0f / 64.0f) + EPS) * scl;
#pragma unroll
                for (int j = 0; j < 4; ++j)
#pragma unroll
                    for (int r = 0; r < 4; ++r) acc[i][j][r] *= rstd * gn[j][r];
            }
        }
        store_tile_bf16(acc, smem, (bf16_t*)(P.ws + WS_Z), NZ, m0, n0, tid, wr, wc, g, lr);
    } else if (MODE == 2) {
        float* ssq = (float*)(P.ws + WS_SSQ);
#pragma unroll
        for (int i = 0; i < 4; ++i) {
            const int row = m0 + wr * 64 + 16 * i + lr;
            float ss = 0.f;
#pragma unroll
            for (int j = 0; j < 4; ++j) {
                const int col = n0 + wc * 64 + 16 * j + 4 * g;
                const float4 xv = *(const float4*)(P.x + (size_t)row * DM + col);
                const float4 gv = *(const float4*)(P.norm_ffn + col);
                float4 hv; hv.x = acc[i][j][0] + xv.x; hv.y = acc[i][j][1] + xv.y; hv.z = acc[i][j][2] + xv.z; hv.w = acc[i][j][3] + xv.w;
                ss += hv.x * hv.x + hv.y * hv.y + hv.z * hv.z + hv.w * hv.w;
                acc[i][j][0] = hv.x * gv.x; acc[i][j][1] = hv.y * gv.y; acc[i][j][2] = hv.z * gv.z; acc[i][j][3] = hv.w * gv.w;
            }
            ss = x4_sum(ss);
            if (g == 0) ssq[(size_t)row * 16 + tn * 2 + wc] = ss;
        }
        store_tile_bf16(acc, smem, (bf16_t*)(P.ws + WS_XN), 1024, m0, n0, tid, wr, wc, g, lr);
    } else {
        const int hp = tn;
        const float* ssq = (const float*)(P.ws + WS_SSQ);
        float rs[4];
#pragma unroll
        for (int i = 0; i < 4; ++i) {
            const int row = m0 + wr * 64 + 16 * i + lr;
            const float4 p0 = *(const float4*)(ssq + (size_t)row * 16), p1 = *(const float4*)(ssq + (size_t)row * 16 + 4);
            const float4 p2 = *(const float4*)(ssq + (size_t)row * 16 + 8), p3 = *(const float4*)(ssq + (size_t)row * 16 + 12);
            const float s = ((p0.x + p0.y) + (p0.z + p0.w)) + ((p1.x + p1.y) + (p1.z + p1.w)) + ((p2.x + p2.y) + (p2.z + p2.w)) + ((p3.x + p3.y) + (p3.z + p3.w));
            rs[i] = rsqrtf(s * (1.0f / DM) + EPS);
            if (tn == 0 && wc == 0 && g == 0) ((float*)(P.ws + WS_RSTD))[row] = rs[i];
        }
        {
            unsigned char* sAq = wc ? sA1 : sA0;
#pragma unroll
            for (int i = 0; i < 4; ++i)
#pragma unroll
                for (int j = 0; j < 4; ++j) {
                    const int row = wr * 64 + 16 * i + lr;
                    const int chunk = 2 * j + (g >> 1);
                    uint2 w; w.x = pk2(acc[i][j][0] * rs[i], acc[i][j][1] * rs[i]); w.y = pk2(acc[i][j][2] * rs[i], acc[i][j][3] * rs[i]);
                    *(uint2*)(sAq + row * 128 + ((chunk ^ (row & 7)) << 4) + 8 * (g & 1)) = w;
                }
            const bf16_t* keys = (const bf16_t*)(P.ws + WS_KEYS) + (size_t)hp * 128 * 128;
#pragma unroll
            for (int j = 0; j < 4; ++j) {
                const int row = srow + 32 * j;
                const uint4 k0 = *(const uint4*)(keys + (size_t)row * 128 + sc * 8);
                const uint4 k1 = *(const uint4*)(keys + (size_t)row * 128 + 64 + sc * 8);
                *(uint4*)(sB0 + soff0 + j * 4096) = k0; *(uint4*)(sB1 + soff0 + j * 4096) = k1;
            }
        }
        __syncthreads();
#pragma unroll
        for (int i = 0; i < 4; ++i)
#pragma unroll
            for (int j = 0; j < 4; ++j) acc[i][j] = (f32x4){0.f, 0.f, 0.f, 0.f};
        mma_ktile(sA0, sB0, arow_off, brow_off, g, sw, acc);
        mma_ktile(sA1, sB1, arow_off, brow_off, g, sw, acc);
        __syncthreads();
#pragma unroll
        for (int i = 0; i < 4; ++i)
#pragma unroll
            for (int j = 0; j < 4; ++j) {
                const int row = wr * 64 + 16 * i + lr;
                const int c4 = wc * 16 + 4 * j + g;
                *(f32x4*)(smem + row * 512 + ((c4 ^ (row & 31)) << 4)) = acc[i][j];
            }
        __syncthreads();
        unsigned top[16];
        const int row = tid & 127, half = tid >> 7;
        {
            auto load_keys = [&](unsigned (&dst)[16], int q4) {
#pragma unroll
                for (int s4 = 0; s4 < 4; ++s4) {
                    const int c4 = half * 16 + q4 * 4 + s4;
                    const f32x4 v = *(const f32x4*)(smem + row * 512 + ((c4 ^ (row & 31)) << 4));
#pragma unroll
                    for (int e = 0; e < 4; ++e) dst[s4 * 4 + e] = (ord_key(v[e]) & ~127u) | (unsigned)(127 - (c4 * 4 + e));
                }
            };
            load_keys(top, 0);
            bitonic_sort16_desc(top);
#pragma unroll 1
            for (int q4 = 1; q4 < 4; ++q4) {
                unsigned gq[16];
                load_keys(gq, q4);
                bitonic_sort16_desc(gq);
                bitonic_merge16_top(top, gq);
            }
        }
        __syncthreads();
        if (half) {
            uint4* lp = (uint4*)(smem + row * 64);
            lp[0] = make_uint4(top[0], top[1], top[2], top[3]); lp[1] = make_uint4(top[4], top[5], top[6], top[7]);
            lp[2] = make_uint4(top[8], top[9], top[10], top[11]); lp[3] = make_uint4(top[12], top[13], top[14], top[15]);
        }
        __syncthreads();
        if (!half) {
            const uint4* lp = (const uint4*)(smem + row * 64);
            unsigned other[16];
#pragma unroll
            for (int c = 0; c < 4; ++c) { const uint4 o = lp[c]; other[4 * c] = o.x; other[4 * c + 1] = o.y; other[4 * c + 2] = o.z; other[4 * c + 3] = o.w; }
            bitonic_merge16_top(top, other);
            uint4* tk = (uint4*)((unsigned*)(P.ws + WS_TK) + ((size_t)(m0 + row) * 16 + hp) * 16);
            tk[0] = make_uint4(top[0], top[1], top[2], top[3]); tk[1] = make_uint4(top[4], top[5], top[6], top[7]);
            tk[2] = make_uint4(top[8], top[9], top[10], top[11]); tk[3] = make_uint4(top[12], top[13], top[14], top[15]);
        }
        __syncthreads();
    }
}

__device__ __forceinline__ void fox_cum_wave(const Params& P, int bh, int lane) {
    const int b = bh >> 3, h = bh & 7;
    const float* gates = (const float*)(P.ws + WS_GATES);
    float* cum = (float*)(P.ws + WS_CUM) + (size_t)bh * L;
    constexpr int SEG = 33;
    const int t0 = lane * SEG;
    float loc = 0.f;
    for (int i = 0; i < SEG; ++i) { const int t = t0 + i; if (t < L) loc += gates[(size_t)(b * L + t) * 16 + 8 + h]; }
    float incl = loc;
#pragma unroll
    for (int o = 1; o < 64; o <<= 1) { const float n = __shfl_up(incl, o, 64); if (lane >= o) incl += n; }
    float run = incl - loc;
    for (int i = 0; i < SEG; ++i) { const int t = t0 + i; if (t < L) { run += gates[(size_t)(b * L + t) * 16 + 8 + h]; cum[t] = run * LOG2E; } }
}

#define TR_SLOW 0

__device__ __forceinline__ int vimg_off(int row, int ch) { return row * 128 + ((ch ^ (((row >> 1) & 3) << 1)) << 4); }
__device__ __forceinline__ uint2 tr_frag(const unsigned char* img, int row0, int c, int g, int lr) {
#if TR_SLOW
    unsigned short e[4];
#pragma unroll
    for (int k = 0; k < 4; ++k) { const int row = row0 + 4 * g + k, col = 16 * c + lr; e[k] = *(const unsigned short*)(img + vimg_off(row, col >> 3) + (col & 7) * 2); }
    uint2 r; r.x = (unsigned)e[0] | ((unsigned)e[1] << 16); r.y = (unsigned)e[2] | ((unsigned)e[3] << 16); return r;
#else
    const int q = lr >> 2, p = lr & 3, row = row0 + 4 * g + q;
    const unsigned addr = (unsigned)(size_t)(img + vimg_off(row, 2 * c + (p >> 1)) + 8 * (p & 1));
    uint2 r;
    asm volatile("ds_read_b64_tr_b16 %0, %1\n\ts_waitcnt lgkmcnt(0)" : "=&v"(r) : "v"(addr) : "memory");
    return r;
#endif
}

__device__ __forceinline__ unsigned tr_lane_addr(const unsigned char* img, int c, int g, int lr) {
    const int q = lr >> 2, p = lr & 3, row = 4 * g + q;
    return (unsigned)(size_t)(img + vimg_off(row, 2 * c + (p >> 1)) + 8 * (p & 1));
}
#define TR_GROUP(o0, o1, o2, o3, a) "ds_read_b64_tr_b16 %" #o0 ", %" #a "\n\tds_read_b64_tr_b16 %" #o1 ", %" #a " offset:2048\n\tds_read_b64_tr_b16 %" #o2 ", %" #a " offset:4096\n\tds_read_b64_tr_b16 %" #o3 ", %" #a " offset:6144\n\t"
__device__ __forceinline__ void tr_read_4c(const unsigned char* img, int g, int lr, uint2 (&r)[4][4]) {
    const unsigned a0 = tr_lane_addr(img, 0, g, lr), a1 = tr_lane_addr(img, 1, g, lr), a2 = tr_lane_addr(img, 2, g, lr), a3 = tr_lane_addr(img, 3, g, lr);
    asm volatile(TR_GROUP(0, 1, 2, 3, 16) TR_GROUP(4, 5, 6, 7, 17) TR_GROUP(8, 9, 10, 11, 18) TR_GROUP(12, 13, 14, 15, 19) "s_waitcnt lgkmcnt(0)"
        : "=&v"(r[0][0]), "=&v"(r[0][1]), "=&v"(r[0][2]), "=&v"(r[0][3]), "=&v"(r[1][0]), "=&v"(r[1][1]), "=&v"(r[1][2]), "=&v"(r[1][3]),
          "=&v"(r[2][0]), "=&v"(r[2][1]), "=&v"(r[2][2]), "=&v"(r[2][3]), "=&v"(r[3][0]), "=&v"(r[3][1]), "=&v"(r[3][2]), "=&v"(r[3][3])
        : "v"(a0), "v"(a1), "v"(a2), "v"(a3) : "memory");
}
__device__ __forceinline__ void tr_read_3c(const unsigned char* img, int g, int lr, uint2 (&r)[3][4]) {
    const unsigned a0 = tr_lane_addr(img, 0, g, lr), a1 = tr_lane_addr(img, 1, g, lr), a2 = tr_lane_addr(img, 2, g, lr);
    asm volatile(TR_GROUP(0, 1, 2, 3, 12) TR_GROUP(4, 5, 6, 7, 13) TR_GROUP(8, 9, 10, 11, 14) "s_waitcnt lgkmcnt(0)"
        : "=&v"(r[0][0]), "=&v"(r[0][1]), "=&v"(r[0][2]), "=&v"(r[0][3]), "=&v"(r[1][0]), "=&v"(r[1][1]), "=&v"(r[1][2]), "=&v"(r[1][3]),
          "=&v"(r[2][0]), "=&v"(r[2][1]), "=&v"(r[2][2]), "=&v"(r[2][3])
        : "v"(a0), "v"(a1), "v"(a2) : "memory");
}
__device__ __forceinline__ void tr_read_2(const unsigned char* img0, int c0, const unsigned char* img1, int c1, int g, int lr, uint2 (&r)[2][4]) {
    const unsigned a0 = tr_lane_addr(img0, c0, g, lr), a1 = tr_lane_addr(img1, c1, g, lr);
    asm volatile(TR_GROUP(0, 1, 2, 3, 8) TR_GROUP(4, 5, 6, 7, 9) "s_waitcnt lgkmcnt(0)"
        : "=&v"(r[0][0]), "=&v"(r[0][1]), "=&v"(r[0][2]), "=&v"(r[0][3]), "=&v"(r[1][0]), "=&v"(r[1][1]), "=&v"(r[1][2]), "=&v"(r[1][3])
        : "v"(a0), "v"(a1) : "memory");
}
__device__ __forceinline__ bf16x8 tr_pair(const uint2& lo, const uint2& hi) { uint4 u; u.x = lo.x; u.y = lo.y; u.z = hi.x; u.w = hi.y; return __builtin_bit_cast(bf16x8, u); }

__device__ __forceinline__ void attn_block(const Params& P, int bh, int qb, unsigned char* smem) {
    const int tid = opaque_tid(), lane = tid & 63, w = tid >> 6, g = lane >> 4, lr = lane & 15;
    const int b = bh >> 3, h = bh & 7;
    const bf16_t* z = (const bf16_t*)(P.ws + WS_Z);
    const float* cum = (const float*)(P.ws + WS_CUM) + (size_t)bh * L;
    int tq[2]; bool qvalid[2]; bf16x8 qf[2][2];
#pragma unroll
    for (int u = 0; u < 2; ++u) {
        tq[u] = qb * 128 + 32 * w + 16 * u + lr;
        qvalid[u] = tq[u] < L;
        const bf16_t* qp = z + (size_t)(b * L + (qvalid[u] ? tq[u] : 0)) * NZ + ZC_FQ + h * 64 + 8 * g;
        qf[u][0] = *(const bf16x8*)(qp); qf[u][1] = *(const bf16x8*)(qp + 32);
    }
    const int nkv = (2 * qb + 2 < 33) ? 2 * qb + 2 : 33;
    const int srow0 = tid >> 3, sch = tid & 7;
    uint4 rk[2], rv[2]; float rc = 0.f;
    auto load_tile = [&](int kv) {
#pragma unroll
        for (int j = 0; j < 2; ++j) {
            const int key = kv * 64 + srow0 + 32 * j;
            if (key < L) {
                const bf16_t* p = z + (size_t)(b * L + key) * NZ + h * 64 + sch * 8;
                rk[j] = *(const uint4*)(p + ZC_FK); rv[j] = *(const uint4*)(p + ZC_FV);
            } else { rk[j] = make_uint4(0, 0, 0, 0); rv[j] = make_uint4(0, 0, 0, 0); }
        }
        if (tid < 64) { const int key = kv * 64 + tid; rc = key < L ? cum[key] : 0.f; }
    };
    auto store_tile = [&](int buf) {
        unsigned char* sK = smem + buf * 16384; unsigned char* sV = sK + 8192;
#pragma unroll
        for (int j = 0; j < 2; ++j) {
            const int row = srow0 + 32 * j;
            *(uint4*)(sK + row * 128 + ((sch ^ (row & 7)) << 4)) = rk[j];
            *(uint4*)(sV + vimg_off(row, sch)) = rv[j];
        }
        if (tid < 64) ((float*)(smem + 32768 + buf * 256))[tid] = rc;
    };
    float m[2] = {-1e30f, -1e30f};
    f32x4 o[2][5];
#pragma unroll
    for (int u = 0; u < 2; ++u)
#pragma unroll
        for (int c = 0; c < 5; ++c) o[u][c] = (f32x4){0.f, 0.f, 0.f, 0.f};
    const unsigned onew = (lr == 0) ? 0x3F803F80u : 0u;
    const bf16x8 vones = __builtin_bit_cast(bf16x8, make_uint4(onew, onew, onew, onew));
    load_tile(nkv - 1); store_tile((nkv - 1) & 1);
    __syncthreads();
    for (int kv = nkv - 1; kv >= 0; --kv) {
        const int buf = kv & 1;
        if (kv > 0) load_tile(kv - 1);
        const unsigned char* sK = smem + buf * 16384; const unsigned char* sV = sK + 8192;
        const float* sck = (const float*)(smem + 32768 + buf * 256);
        f32x4 sa[2][4];
#pragma unroll
        for (int c = 0; c < 4; ++c) {
            sa[0][c] = (f32x4){0.f, 0.f, 0.f, 0.f}; sa[1][c] = (f32x4){0.f, 0.f, 0.f, 0.f};
#pragma unroll
            for (int s = 0; s < 2; ++s) {
                const bf16x8 kf = *(const bf16x8*)(sK + (16 * c + lr) * 128 + (((4 * s + g) ^ (lr & 7)) << 4));
                sa[0][c] = __builtin_amdgcn_mfma_f32_16x16x32_bf16(kf, qf[0][s], sa[0][c], 0, 0, 0);
                sa[1][c] = __builtin_amdgcn_mfma_f32_16x16x32_bf16(kf, qf[1][s], sa[1][c], 0, 0, 0);
            }
        }
        if (kv >= 2 * qb) {
#pragma unroll
            for (int u = 0; u < 2; ++u)
#pragma unroll
                for (int c = 0; c < 4; ++c)
#pragma unroll
                    for (int r = 0; r < 4; ++r)
                        if (64 * kv + 16 * c + 4 * g + r > tq[u]) sa[u][c][r] = -INFINITY;
        }
        f32x4 ck[4];
#pragma unroll
        for (int c = 0; c < 4; ++c) ck[c] = *(const f32x4*)(sck + 16 * c + 4 * g);
        bf16x8 pf[2][2];
#pragma unroll
        for (int u = 0; u < 2; ++u) {
            float mx = -INFINITY;
#pragma unroll
            for (int c = 0; c < 4; ++c) {
                sa[u][c] -= ck[c];
                mx = fmaxf(mx, fmaxf(fmaxf(sa[u][c][0], sa[u][c][1]), fmaxf(sa[u][c][2], sa[u][c][3])));
            }
            mx = x4_max(mx);
            if (__builtin_amdgcn_ballot_w64(mx > m[u]) != 0ull) {
                const float mn = fmaxf(m[u], mx);
                const float alpha = __builtin_amdgcn_exp2f(m[u] - mn);
                m[u] = mn;
#pragma unroll
                for (int c = 0; c < 5; ++c) o[u][c] *= alpha;
            }
            const float mn = m[u];
#pragma unroll
            for (int c = 0; c < 4; ++c)
#pragma unroll
                for (int r = 0; r < 4; ++r) sa[u][c][r] = __builtin_amdgcn_exp2f(sa[u][c][r] - mn);
#pragma unroll
            for (int s2 = 0; s2 < 2; ++s2) {
                uint4 uu;
                uu.x = cvt_pk_bf16(sa[u][2 * s2][0], sa[u][2 * s2][1]); uu.y = cvt_pk_bf16(sa[u][2 * s2][2], sa[u][2 * s2][3]);
                uu.z = cvt_pk_bf16(sa[u][2 * s2 + 1][0], sa[u][2 * s2 + 1][1]); uu.w = cvt_pk_bf16(sa[u][2 * s2 + 1][2], sa[u][2 * s2 + 1][3]);
                pf[u][s2] = __builtin_bit_cast(bf16x8, uu);
            }
        }
        {
            uint2 vr[4][4];
            tr_read_4c(sV, g, lr, vr);
#pragma unroll
            for (int c = 0; c < 4; ++c)
#pragma unroll
                for (int s2 = 0; s2 < 2; ++s2) {
                    const bf16x8 vf = tr_pair(vr[c][2 * s2], vr[c][2 * s2 + 1]);
                    o[0][c] = __builtin_amdgcn_mfma_f32_16x16x32_bf16(vf, pf[0][s2], o[0][c], 0, 0, 0);
                    o[1][c] = __builtin_amdgcn_mfma_f32_16x16x32_bf16(vf, pf[1][s2], o[1][c], 0, 0, 0);
                }
#pragma unroll
            for (int s2 = 0; s2 < 2; ++s2) {
                o[0][4] = __builtin_amdgcn_mfma_f32_16x16x32_bf16(vones, pf[0][s2], o[0][4], 0, 0, 0);
                o[1][4] = __builtin_amdgcn_mfma_f32_16x16x32_bf16(vones, pf[1][s2], o[1][4], 0, 0, 0);
            }
        }
        if (kv > 0) store_tile(buf ^ 1);
        __syncthreads();
    }
#pragma unroll
    for (int u = 0; u < 2; ++u) {
        const float ls = __shfl(o[u][4][0], lr, 64);
        const float inv = 1.0f / ls;
        if (qvalid[u]) {
            bf16_t* y = (bf16_t*)(P.ws + WS_Z) + (size_t)(b * L + tq[u]) * NZ + 512 + h * 64 + 4 * g;
#pragma unroll
            for (int c = 0; c < 4; ++c) {
                uint2 uu; uu.x = pk2(o[u][c][0] * inv, o[u][c][1] * inv); uu.y = pk2(o[u][c][2] * inv, o[u][c][3] * inv);
                *(uint2*)(y + 16 * c) = uu;
            }
        }
    }
}

__device__ __forceinline__ void conv_item(const Params& P, int ci) {
    const int tid = opaque_tid(), cc = tid & 127, rg = tid >> 7;
    const bf16_t* z = (const bf16_t*)(P.ws + WS_Z);
    bf16_t* qk = (bf16_t*)(P.ws + WS_RA);
    const int col0 = cc * 8;
    float w[4][8];
#pragma unroll
    for (int j = 0; j < 4; ++j) {
        const float4 a = *(const float4*)(P.conv_qk + j * 1024 + col0), b = *(const float4*)(P.conv_qk + j * 1024 + col0 + 4);
        w[j][0] = a.x; w[j][1] = a.y; w[j][2] = a.z; w[j][3] = a.w; w[j][4] = b.x; w[j][5] = b.y; w[j][6] = b.z; w[j][7] = b.w;
    }
    const float oscale = (col0 >= 512) ? 0.08838834764831845f : 1.0f;
    const int r0 = ci * 64 + rg * 32;
    int t = r0 % L;
    float xw[3][8];
#pragma unroll
    for (int j = 0; j < 3; ++j) {
        const int back = 3 - j;
        if (t - back >= 0) {
            const uint4 v = *(const uint4*)(z + (size_t)(r0 - back) * NZ + col0);
            xw[j][0] = bflo(v.x); xw[j][1] = bfhi(v.x); xw[j][2] = bflo(v.y); xw[j][3] = bfhi(v.y); xw[j][4] = bflo(v.z); xw[j][5] = bfhi(v.z); xw[j][6] = bflo(v.w); xw[j][7] = bfhi(v.w);
        } else {
#pragma unroll
            for (int e = 0; e < 8; ++e) xw[j][e] = 0.f;
        }
    }
#pragma unroll 2
    for (int i = 0; i < 32; ++i) {
        const int r = r0 + i;
        if (t == 0) {
#pragma unroll
            for (int j = 0; j < 3; ++j)
#pragma unroll
                for (int e = 0; e < 8; ++e) xw[j][e] = 0.f;
        }
        const uint4 v = *(const uint4*)(z + (size_t)r * NZ + col0);
        float xt[8];
        xt[0] = bflo(v.x); xt[1] = bfhi(v.x); xt[2] = bflo(v.y); xt[3] = bfhi(v.y); xt[4] = bflo(v.z); xt[5] = bfhi(v.z); xt[6] = bflo(v.w); xt[7] = bfhi(v.w);
        float o[8];
#pragma unroll
        for (int e = 0; e < 8; ++e) {
            const float cv = w[0][e] * xw[0][e] + w[1][e] * xw[1][e] + w[2][e] * xw[2][e] + w[3][e] * xt[e];
            o[e] = oscale * cv / (1.f + __expf(-cv));
            xw[0][e] = xw[1][e]; xw[1][e] = xw[2][e]; xw[2][e] = xt[e];
        }
        uint4 ov; ov.x = pk2(o[0], o[1]); ov.y = pk2(o[2], o[3]); ov.z = pk2(o[4], o[5]); ov.w = pk2(o[6], o[7]);
        *(uint4*)(qk + (size_t)r * 1024 + col0) = ov;
        t = (t + 1 == L) ? 0 : t + 1;
    }
}

constexpr int ST_IMG = 36864;
__device__ __forceinline__ int st_piece_off(int jt, int c, int g, int lr) { return (jt >> 2) * 18432 + vimg_off(16 * c + lr, 2 * (jt & 3) + (g >> 1)) + 8 * (g & 1); }

__device__ __forceinline__ void mlstm_stage_kv(const Params& P, int b, int h, int k, unsigned char* sKimg, unsigned char* sVimg, int tid) {
    const bf16_t* z = (const bf16_t*)(P.ws + WS_Z);
    const bf16_t* qk = (const bf16_t*)(P.ws + WS_RA);
    uint4 pk_[4], pv_[4];
#pragma unroll
    for (int j = 0; j < 4; ++j) {
        const int id = tid + 256 * j, row = id >> 4, ch16 = id & 15, pos = 64 * k + row;
        const bool ok = pos < L;
        pk_[j] = ok ? *(const uint4*)(qk + (size_t)(b * L + pos) * 1024 + 512 + h * 128 + ch16 * 8) : make_uint4(0, 0, 0, 0);
        pv_[j] = ok ? *(const uint4*)(z + (size_t)(b * L + pos) * NZ + ZC_MV + h * 128 + ch16 * 8) : make_uint4(0, 0, 0, 0);
    }
#pragma unroll
    for (int j = 0; j < 4; ++j) {
        const int id = tid + 256 * j, row = id >> 4, ch16 = id & 15;
        *(uint4*)(sKimg + (ch16 >> 3) * 8192 + vimg_off(row, ch16 & 7)) = pk_[j];
        *(uint4*)(sVimg + (ch16 >> 3) * 8192 + vimg_off(row, ch16 & 7)) = pv_[j];
    }
    if (tid < 128) {
        const int row = tid >> 1, ch = tid & 1;
        *(uint4*)(sVimg + 16384 + vimg_off(row, ch)) = ch ? make_uint4(0, 0, 0, 0) : make_uint4(0x3F80u, 0, 0, 0);
    }
}

__device__ __forceinline__ void mlstm_stage_A(const Params& P, int b, int h, int k, unsigned char* sKimg, unsigned char* sVimg, int tid) {
    const bf16_t* z = (const bf16_t*)(P.ws + WS_Z);
    bf16_t* qk = (bf16_t*)(P.ws + WS_RA);
    uint4 pv_[4];
#pragma unroll
    for (int j = 0; j < 4; ++j) {
        const int id = tid + 256 * j, row = id >> 4, ch16 = id & 15, pos = 64 * k + row;
        pv_[j] = (pos < L) ? *(const uint4*)(z + (size_t)(b * L + pos) * NZ + ZC_MV + h * 128 + ch16 * 8) : make_uint4(0, 0, 0, 0);
    }
    const int cch = tid & 31, rg = tid >> 5, isk = cch >> 4;
    const int zcol = (isk ? ZC_MK : ZC_MQ) + h * 128 + (cch & 15) * 8;
    float w[4][8];
#pragma unroll
    for (int j = 0; j < 4; ++j) {
        const float4 a = *(const float4*)(P.conv_qk + j * 1024 + zcol), c = *(const float4*)(P.conv_qk + j * 1024 + zcol + 4);
        w[j][0] = a.x; w[j][1] = a.y; w[j][2] = a.z; w[j][3] = a.w; w[j][4] = c.x; w[j][5] = c.y; w[j][6] = c.z; w[j][7] = c.w;
    }
    const float oscale = isk ? 0.08838834764831845f : 1.0f;
    const int p0 = 64 * k + 8 * rg;
    uint4 raw[11];
#pragma unroll
    for (int i = 0; i < 11; ++i) {
        const int pos = p0 - 3 + i;
        raw[i] = (pos >= 0 && pos < L) ? *(const uint4*)(z + (size_t)(b * L + pos) * NZ + zcol) : make_uint4(0, 0, 0, 0);
    }
#pragma unroll
    for (int j = 0; j < 4; ++j) {
        const int id = tid + 256 * j, row = id >> 4, ch16 = id & 15;
        *(uint4*)(sVimg + (ch16 >> 3) * 8192 + vimg_off(row, ch16 & 7)) = pv_[j];
    }
    if (tid < 128) {
        const int row = tid >> 1, ch = tid & 1;
        *(uint4*)(sVimg + 16384 + vimg_off(row, ch)) = ch ? make_uint4(0, 0, 0, 0) : make_uint4(0x3F80u, 0, 0, 0);
    }
#pragma unroll
    for (int i = 0; i < 8; ++i) {
        const int pos = p0 + i, row = 8 * rg + i;
        float o[8];
#pragma unroll
        for (int e = 0; e < 8; ++e) {
            const unsigned w0 = (&raw[i].x)[e >> 1], w1 = (&raw[i + 1].x)[e >> 1], w2 = (&raw[i + 2].x)[e >> 1], w3 = (&raw[i + 3].x)[e >> 1];
            const float x0 = (e & 1) ? bfhi(w0) : bflo(w0), x1 = (e & 1) ? bfhi(w1) : bflo(w1), x2 = (e & 1) ? bfhi(w2) : bflo(w2), x3 = (e & 1) ? bfhi(w3) : bflo(w3);
            const float cv = w[0][e] * x0 + w[1][e] * x1 + w[2][e] * x2 + w[3][e] * x3;
            o[e] = oscale * cv / (1.f + __expf(-cv));
        }
        uint4 ov; ov.x = pk2(o[0], o[1]); ov.y = pk2(o[2], o[3]); ov.z = pk2(o[4], o[5]); ov.w = pk2(o[6], o[7]);
        const bool ok = pos < L;
        if (!ok) ov = make_uint4(0, 0, 0, 0);
        if (ok) *(uint4*)(qk + (size_t)(b * L + pos) * 1024 + (isk ? 512 : 0) + h * 128 + (cch & 15) * 8) = ov;
        if (isk) { const int ch16 = cch & 15; *(uint4*)(sKimg + (ch16 >> 3) * 8192 + vimg_off(row, ch16 & 7)) = ov; }
    }
}

__device__ __forceinline__ void mlstm_A(const Params& P, int item, unsigned char* smem) {
    const int tid = opaque_tid(), lane = tid & 63, w = tid >> 6, g = lane >> 4, lr = lane & 15;
    const int wu = __builtin_amdgcn_readfirstlane(w);
    const int k = item >> 5, bh = item & 31, b = bh >> 2, h = bh & 3;
    const float* gates = (const float*)(P.ws + WS_GATES);
    const unsigned char* sK = smem; const unsigned char* sV = smem + 16384;
    float* ga = (float*)(smem + 40960);
    mlstm_stage_A(P, b, h, k, smem, smem + 16384, tid);
    if (wu == 0) {
        const int pos = 64 * k + lane;
        float lf = 0.f, li = -INFINITY;
        if (pos < L) { lf = gates[(size_t)(b * L + pos) * 16 + 4 + h]; li = gates[(size_t)(b * L + pos) * 16 + h]; }
        float bc = lf;
#pragma unroll
        for (int o = 1; o < 64; o <<= 1) { const float n = __shfl_up(bc, o, 64); if (lane >= o) bc += n; }
        const float a = li - bc;
        const float A = wave_max(a);
        ga[lane] = __expf(a - A);
        if (lane == 63) { float* msc = (float*)(P.ws + WS_MSC) + ((size_t)bh * 33 + k) * 4; msc[0] = A; msc[1] = bc; }
    }
    __syncthreads();
    f32x4 Ct[2][9];
#pragma unroll
    for (int a = 0; a < 2; ++a)
#pragma unroll
        for (int c = 0; c < 9; ++c) Ct[a][c] = (f32x4){0.f, 0.f, 0.f, 0.f};
    bf16x8 kt[2][2];
#pragma unroll
    for (int a = 0; a < 2; ++a)
#pragma unroll
        for (int s2 = 0; s2 < 2; ++s2) {
            const int jt = 2 * w + a;
            kt[a][s2] = tr_pair(tr_frag(sK + (jt >> 2) * 8192, 32 * s2, jt & 3, g, lr), tr_frag(sK + (jt >> 2) * 8192, 32 * s2 + 16, jt & 3, g, lr));
        }
    f32x4 wg4[4];
#pragma unroll
    for (int j = 0; j < 4; ++j) wg4[j] = *(const f32x4*)(ga + 16 * j + 4 * g);
#define MA_TILE(c, lo0, hi0, lo1, hi1) { \
        { const f32x4 w0 = wg4[0], w1 = wg4[1]; uint4 o; \
          o.x = cvt_pk_bf16(bflo(lo0.x) * w0[0], bfhi(lo0.x) * w0[1]); o.y = cvt_pk_bf16(bflo(lo0.y) * w0[2], bfhi(lo0.y) * w0[3]); \
          o.z = cvt_pk_bf16(bflo(hi0.x) * w1[0], bfhi(hi0.x) * w1[1]); o.w = cvt_pk_bf16(bflo(hi0.y) * w1[2], bfhi(hi0.y) * w1[3]); \
          const bf16x8 vw = __builtin_bit_cast(bf16x8, o); \
          Ct[0][c] = __builtin_amdgcn_mfma_f32_16x16x32_bf16(kt[0][0], vw, Ct[0][c], 0, 0, 0); Ct[1][c] = __builtin_amdgcn_mfma_f32_16x16x32_bf16(kt[1][0], vw, Ct[1][c], 0, 0, 0); } \
        { const f32x4 w0 = wg4[2], w1 = wg4[3]; uint4 o; \
          o.x = cvt_pk_bf16(bflo(lo1.x) * w0[0], bfhi(lo1.x) * w0[1]); o.y = cvt_pk_bf16(bflo(lo1.y) * w0[2], bfhi(lo1.y) * w0[3]); \
          o.z = cvt_pk_bf16(bflo(hi1.x) * w1[0], bfhi(hi1.x) * w1[1]); o.w = cvt_pk_bf16(bflo(hi1.y) * w1[2], bfhi(hi1.y) * w1[3]); \
          const bf16x8 vw = __builtin_bit_cast(bf16x8, o); \
          Ct[0][c] = __builtin_amdgcn_mfma_f32_16x16x32_bf16(kt[0][1], vw, Ct[0][c], 0, 0, 0); Ct[1][c] = __builtin_amdgcn_mfma_f32_16x16x32_bf16(kt[1][1], vw, Ct[1][c], 0, 0, 0); } }
    {
        uint2 vr[4][4];
        tr_read_4c(sV, g, lr, vr);
        MA_TILE(0, vr[0][0], vr[0][1], vr[0][2], vr[0][3]) MA_TILE(1, vr[1][0], vr[1][1], vr[1][2], vr[1][3])
        MA_TILE(2, vr[2][0], vr[2][1], vr[2][2], vr[2][3]) MA_TILE(3, vr[3][0], vr[3][1], vr[3][2], vr[3][3])
        tr_read_4c(sV + 8192, g, lr, vr);
        MA_TILE(4, vr[0][0], vr[0][1], vr[0][2], vr[0][3]) MA_TILE(5, vr[1][0], vr[1][1], vr[1][2], vr[1][3])
        MA_TILE(6, vr[2][0], vr[2][1], vr[2][2], vr[2][3]) MA_TILE(7, vr[3][0], vr[3][1], vr[3][2], vr[3][3])
        const uint2 o0 = tr_frag(sV + 16384, 0, 0, g, lr), o1 = tr_frag(sV + 16384, 16, 0, g, lr), o2 = tr_frag(sV + 16384, 32, 0, g, lr), o3 = tr_frag(sV + 16384, 48, 0, g, lr);
        MA_TILE(8, o0, o1, o2, o3)
    }
#undef MA_TILE
    unsigned char* slot = P.ws + WS_MST + ((size_t)bh * 33 + k) * ST_IMG;
#pragma unroll
    for (int a = 0; a < 2; ++a)
#pragma unroll
        for (int c = 0; c < 9; ++c) {
            uint2 u; u.x = cvt_pk_bf16(Ct[a][c][0], Ct[a][c][1]); u.y = cvt_pk_bf16(Ct[a][c][2], Ct[a][c][3]);
            *(uint2*)(slot + st_piece_off(2 * w + a, c, g, lr)) = u;
        }
}

__device__ __forceinline__ void mlstm_B(const Params& P, int item) {
    const int tid = opaque_tid();
    const int bh = item / 3, part = item - bh * 3;
    const unsigned char* base = P.ws + WS_MST + (size_t)bh * 33 * ST_IMG + part * 12288 + tid * 48;
    unsigned char* obase = P.ws + WS_CBI + (size_t)bh * 33 * ST_IMG + part * 12288 + tid * 48;
    float* msc = (float*)(P.ws + WS_MSC) + (size_t)bh * 33 * 4;
    float C[6][4];
#pragma unroll
    for (int i = 0; i < 6; ++i)
#pragma unroll
        for (int r = 0; r < 4; ++r) C[i][r] = 0.f;
    float m = 0.f;
    uint2 d0[6], d1[6];
    float2 ab0, ab1;
#pragma unroll
    for (int i = 0; i < 6; ++i) { d0[i] = *(const uint2*)(base + i * 8); d1[i] = *(const uint2*)(base + ST_IMG + i * 8); }
    ab0 = *(const float2*)(msc); ab1 = *(const float2*)(msc + 4);
    for (int k = 0; k < 33; ++k) {
        uint2 d2[6]; float2 ab2 = make_float2(0.f, 0.f);
        if (k + 2 < 33) {
#pragma unroll
            for (int i = 0; i < 6; ++i) d2[i] = *(const uint2*)(base + (size_t)(k + 2) * ST_IMG + i * 8);
            ab2 = *(const float2*)(msc + (k + 2) * 4);
        } else {
#pragma unroll
            for (int i = 0; i < 6; ++i) d2[i] = make_uint2(0, 0);
        }
#pragma unroll
        for (int i = 0; i < 6; ++i) {
            uint2 u; u.x = cvt_pk_bf16(C[i][0], C[i][1]); u.y = cvt_pk_bf16(C[i][2], C[i][3]);
            *(uint2*)(obase + (size_t)k * ST_IMG + i * 8) = u;
        }
        if (tid == 0 && part == 0) msc[k * 4 + 2] = m;
        const float M = fmaxf(m, ab0.x);
        const float decay = __expf(m - M), sc = __expf(ab0.x - M);
#pragma unroll
        for (int i = 0; i < 6; ++i) {
            C[i][0] = decay * C[i][0] + sc * bflo(d0[i].x); C[i][1] = decay * C[i][1] + sc * bfhi(d0[i].x);
            C[i][2] = decay * C[i][2] + sc * bflo(d0[i].y); C[i][3] = decay * C[i][3] + sc * bfhi(d0[i].y);
        }
        m = ab0.y + M;
#pragma unroll
        for (int i = 0; i < 6; ++i) { d0[i] = d1[i]; d1[i] = d2[i]; }
        ab0 = ab1; ab1 = ab2;
    }
}

__device__ __forceinline__ void mlstm_C(const Params& P, int item, unsigned char* smem) {
    const int tid = opaque_tid(), lane = tid & 63, w = tid >> 6, g = lane >> 4, lr = lane & 15;
    const int wu = __builtin_amdgcn_readfirstlane(w);
    const int k = item >> 5, bh = item & 31, b = bh >> 2, h = bh & 3;
    const bf16_t* z = (const bf16_t*)(P.ws + WS_Z);
    const bf16_t* qk = (const bf16_t*)(P.ws + WS_RA);
    const float* gates = (const float*)(P.ws + WS_GATES);
    bf16_t* y = (bf16_t*)(P.ws + WS_Z);
    const unsigned char* sK = smem; const unsigned char* sV = smem + 36864; unsigned char* sCb = smem;
    float* ga = (float*)(smem + 61440);
    const int pos = 64 * k + 16 * w + lr;
    const bool tvalid = pos < L;
    const size_t rrow = (size_t)(b * L + (tvalid ? pos : 0));
    const unsigned char* cslot = P.ws + WS_CBI + ((size_t)bh * 33 + k) * ST_IMG + tid * 16;
    const uint4 cb0 = *(const uint4*)(cslot), cb1 = *(const uint4*)(cslot + 4096), cb2 = *(const uint4*)(cslot + 8192), cb3 = *(const uint4*)(cslot + 12288), cb4 = *(const uint4*)(cslot + 16384),
                cb5 = *(const uint4*)(cslot + 20480), cb6 = *(const uint4*)(cslot + 24576), cb7 = *(const uint4*)(cslot + 28672), cb8 = *(const uint4*)(cslot + 32768);
    bf16x8 qf[4];
    {
        const bf16_t* qp = qk + rrow * 1024 + h * 128 + 8 * g;
#pragma unroll
        for (int ks = 0; ks < 4; ++ks) { qf[ks] = *(const bf16x8*)(qp + 32 * ks); if (!tvalid) qf[ks] = (bf16x8){0, 0, 0, 0, 0, 0, 0, 0}; }
    }
    mlstm_stage_kv(P, b, h, k, smem, smem + 36864, tid);
    if (wu == 0) {
        const float m_prev = ((const float*)(P.ws + WS_MSC))[((size_t)bh * 33 + k) * 4 + 2];
        const int p2 = 64 * k + lane;
        float lf = 0.f, li = -INFINITY;
        if (p2 < L) { lf = gates[(size_t)(b * L + p2) * 16 + 4 + h]; li = gates[(size_t)(b * L + p2) * 16 + h]; }
        float bc = lf;
#pragma unroll
        for (int o = 1; o < 64; o <<= 1) { const float n = __shfl_up(bc, o, 64); if (lane >= o) bc += n; }
        const float a = li - bc;
        float am = a;
#pragma unroll
        for (int o = 1; o < 64; o <<= 1) { const float n = __shfl_up(am, o, 64); if (lane >= o) am = fmaxf(am, n); }
        const float M = fmaxf(m_prev, am);
        ga[lane] = a; ga[64 + lane] = __expf(m_prev - M); ga[128 + lane] = __expf(-(bc + M)); ga[192 + lane] = M;
    }
    __syncthreads();
    const float Mt = ga[192 + 16 * w + lr], Wi = ga[64 + 16 * w + lr], Et = ga[128 + 16 * w + lr];
    bf16x8 pf[2];
    {
        f32x4 sa[4];
#pragma unroll
        for (int c = 0; c < 4; ++c) {
            sa[c] = (f32x4){0.f, 0.f, 0.f, 0.f};
            if (c <= wu) {
#pragma unroll
                for (int ks = 0; ks < 4; ++ks) {
                    const bf16x8 kf = *(const bf16x8*)(sK + (ks >> 1) * 8192 + vimg_off(16 * c + lr, 4 * (ks & 1) + g));
                    sa[c] = __builtin_amdgcn_mfma_f32_16x16x32_bf16(kf, qf[ks], sa[c], 0, 0, 0);
                }
                const f32x4 av = *(const f32x4*)(ga + 16 * c + 4 * g);
#pragma unroll
                for (int r = 0; r < 4; ++r) {
                    const float d = __expf(av[r] - Mt);
                    sa[c][r] = (16 * c + 4 * g + r <= 16 * w + lr) ? sa[c][r] * d : 0.f;
                }
            }
        }
#pragma unroll
        for (int s2 = 0; s2 < 2; ++s2) {
            uint4 u;
            u.x = cvt_pk_bf16(sa[2 * s2][0], sa[2 * s2][1]); u.y = cvt_pk_bf16(sa[2 * s2][2], sa[2 * s2][3]);
            u.z = cvt_pk_bf16(sa[2 * s2 + 1][0], sa[2 * s2 + 1][1]); u.w = cvt_pk_bf16(sa[2 * s2 + 1][2], sa[2 * s2 + 1][3]);
            pf[s2] = __builtin_bit_cast(bf16x8, u);
        }
    }
    __syncthreads();
    {
        unsigned char* d = sCb + tid * 16;
        *(uint4*)(d) = cb0; *(uint4*)(d + 4096) = cb1; *(uint4*)(d + 8192) = cb2; *(uint4*)(d + 12288) = cb3; *(uint4*)(d + 16384) = cb4;
        *(uint4*)(d + 20480) = cb5; *(uint4*)(d + 24576) = cb6; *(uint4*)(d + 28672) = cb7; *(uint4*)(d + 32768) = cb8;
    }
    __syncthreads();
    f32x4 na[9];
#define MC_TILE(c, lo0, hi0, lo1, hi1) { \
        na[c] = (f32x4){0.f, 0.f, 0.f, 0.f}; \
        _Pragma("unroll") for (int ks = 0; ks < 4; ++ks) { \
            const bf16x8 cf = *(const bf16x8*)(sCb + (ks >> 1) * 18432 + vimg_off(16 * (c) + lr, 4 * (ks & 1) + g)); \
            na[c] = __builtin_amdgcn_mfma_f32_16x16x32_bf16(cf, qf[ks], na[c], 0, 0, 0); } \
        na[c] *= Wi; \
        na[c] = __builtin_amdgcn_mfma_f32_16x16x32_bf16(tr_pair(lo0, hi0), pf[0], na[c], 0, 0, 0); \
        na[c] = __builtin_amdgcn_mfma_f32_16x16x32_bf16(tr_pair(lo1, hi1), pf[1], na[c], 0, 0, 0); }
    {
        uint2 vr[4][4];
        tr_read_4c(sV, g, lr, vr);
        MC_TILE(0, vr[0][0], vr[0][1], vr[0][2], vr[0][3]) MC_TILE(1, vr[1][0], vr[1][1], vr[1][2], vr[1][3])
        MC_TILE(2, vr[2][0], vr[2][1], vr[2][2], vr[2][3]) MC_TILE(3, vr[3][0], vr[3][1], vr[3][2], vr[3][3])
        tr_read_4c(sV + 8192, g, lr, vr);
        MC_TILE(4, vr[0][0], vr[0][1], vr[0][2], vr[0][3]) MC_TILE(5, vr[1][0], vr[1][1], vr[1][2], vr[1][3])
        MC_TILE(6, vr[2][0], vr[2][1], vr[2][2], vr[2][3]) MC_TILE(7, vr[3][0], vr[3][1], vr[3][2], vr[3][3])
        const uint2 o0 = tr_frag(sV + 16384, 0, 0, g, lr), o1 = tr_frag(sV + 16384, 16, 0, g, lr), o2 = tr_frag(sV + 16384, 32, 0, g, lr), o3 = tr_frag(sV + 16384, 48, 0, g, lr);
        MC_TILE(8, o0, o1, o2, o3)
    }
#undef MC_TILE
    const float den = __shfl(na[8][0], lr, 64);
    const float rden = 1.0f / fmaxf(fabsf(den), Et);
    float hs = 0.f;
#pragma unroll
    for (int c = 0; c < 8; ++c) { na[c] *= rden; hs += na[c][0] * na[c][0] + na[c][1] * na[c][1] + na[c][2] * na[c][2] + na[c][3] * na[c][3]; }
    hs = x4_sum(hs);
    const float rstd = rsqrtf(hs * (1.0f / 128.0f) + EPS);
    const float* gainp = P.m_out_norm + h * 128 + 4 * g;
#pragma unroll
    for (int c = 0; c < 8; ++c) {
        const uint2 og = *(const uint2*)(z + rrow * NZ + ZC_MO + h * 128 + 16 * c + 4 * g);
        const float o0 = bflo(og.x), o1 = bfhi(og.x), o2 = bflo(og.y), o3 = bfhi(og.y);
        const float4 gn = *(const float4*)(gainp + 16 * c);
        uint2 u;
        u.x = pk2(na[c][0] * rstd * gn.x / (1.f + __expf(-o0)), na[c][1] * rstd * gn.y / (1.f + __expf(-o1)));
        u.y = pk2(na[c][2] * rstd * gn.z / (1.f + __expf(-o2)), na[c][3] * rstd * gn.w / (1.f + __expf(-o3)));
        if (tvalid) *(uint2*)(y + rrow * NZ + h * 128 + 16 * c + 4 * g) = u;
    }
}

__device__ __forceinline__ void peer_token(const Params& P, int t, int lane, int* sidx, float* sval, int* sid, float* sgate, const unsigned char* slut, const unsigned* szero) {
    const unsigned* tk = (const unsigned*)(P.ws + WS_TK) + (size_t)t * 256;
#pragma unroll
    for (int i = 0; i < 4; ++i) {
        const unsigned k = tk[lane * 4 + i];
        sidx[lane * 4 + i] = 127 - (int)(k & 127u);
        sval[lane * 4 + i] = unord_key(k & ~127u);
    }
    __builtin_amdgcn_s_waitcnt(0xc07f);
    __builtin_amdgcn_wave_barrier();
    {
        const int hd = lane >> 3, sub = lane & 7;
        unsigned x[8];
#pragma unroll
        for (int r = 0; r < 8; ++r) {
            const int c = sub * 8 + r;
            const unsigned ij = slut[c < 50 ? c : 0];
            const int i = ij >> 4, j = ij & 15;
            const unsigned kx = (ord_key(sval[(2 * hd) * 16 + i] + sval[(2 * hd + 1) * 16 + j]) & ~255u) | (unsigned)(255 - (i * 16 + j));
            x[r] = c < 50 ? kx : 0u;
        }
#pragma unroll
        for (int k = 2; k <= 64; k <<= 1) {
#pragma unroll
            for (int j = k >> 1; j >= 1; j >>= 1) {
                if (j >= 8) {
                    const int ld = j >> 3;
                    const bool lower = (sub & ld) == 0;
                    const bool desc = k >= 64 ? true : ((sub * 8) & k) == 0;
                    const bool takemax = (lower == desc);
#pragma unroll
                    for (int r = 0; r < 8; ++r) {
                        const unsigned o = (unsigned)__shfl_xor((int)x[r], ld, 64);
                        const unsigned hi = max(x[r], o), lo = min(x[r], o);
                        x[r] = takemax ? hi : lo;
                    }
                } else {
#pragma unroll
                    for (int r = 0; r < 8; ++r) {
                        if ((r & j) == 0) {
                            const int p = r | j;
                            const unsigned hi = max(x[r], x[p]), lo = min(x[r], x[p]);
                            if (k <= 4) { const bool desc = (r & k) == 0; x[r] = desc ? hi : lo; x[p] = desc ? lo : hi; }
                            else if (k >= 64) { x[r] = hi; x[p] = lo; }
                            else { const bool desc = ((sub * 8) & k) == 0; x[r] = desc ? hi : lo; x[p] = desc ? lo : hi; }
                        }
                    }
                }
            }
        }
        const float smax = unord_key((unsigned)__shfl((int)x[0], hd * 8, 64) & ~255u);
        float e[8]; float den = 0.f;
#pragma unroll
        for (int r = 0; r < 8; ++r) { e[r] = __expf(unord_key(x[r] & ~255u) - smax); den += e[r]; }
        den += __shfl_xor(den, 1, 64);
        const float inv = 1.f / den;
        if (sub < 2) {
#pragma unroll
            for (int r = 0; r < 8; ++r) {
                const int pos = 255 - (int)(x[r] & 255u), i = pos >> 4, j = pos & 15;
                sid[hd * 16 + sub * 8 + r] = sidx[(2 * hd) * 16 + i] * 128 + sidx[(2 * hd + 1) * 16 + j];
                sgate[hd * 16 + sub * 8 + r] = e[r] * inv;
            }
        }
    }
    __builtin_amdgcn_s_waitcnt(0xc07f);
    __builtin_amdgcn_wave_barrier();
    const bf16_t* xn = (const bf16_t*)(P.ws + WS_XN) + (size_t)t * DM;
    const float rstd = ((const float*)(P.ws + WS_RSTD))[t];
    const unsigned char* V = P.ws + WS_V + lane * 8;
    const float* usc = (const float*)(P.ws + WS_USC);
    const float* vsc = (const float*)(P.ws + WS_VSC);
    const int g = lane >> 4, lr = lane & 15;
    unsigned char* shi = (unsigned char*)sval;
    unsigned char* slo = (unsigned char*)sidx;
    {
        const uint4 xa = *(const uint4*)(xn + lane * 16), xb = *(const uint4*)(xn + lane * 16 + 8);
        const unsigned xw[8] = {xa.x, xa.y, xa.z, xa.w, xb.x, xb.y, xb.z, xb.w};
        unsigned hi[4], lo[4];
#pragma unroll
        for (int i = 0; i < 4; ++i) {
            const float x0 = bflo(xw[2 * i]), x1 = bfhi(xw[2 * i]), x2 = bflo(xw[2 * i + 1]), x3 = bfhi(xw[2 * i + 1]);
            int wd = 0;
            wd = __builtin_amdgcn_cvt_pk_fp8_f32(x0, x1, wd, false);
            wd = __builtin_amdgcn_cvt_pk_fp8_f32(x2, x3, wd, true);
            const f32x2 h01 = __builtin_amdgcn_cvt_pk_f32_fp8(wd, false), h23 = __builtin_amdgcn_cvt_pk_f32_fp8(wd, true);
            int wl = 0;
            wl = __builtin_amdgcn_cvt_pk_fp8_f32(x0 - h01.x, x1 - h01.y, wl, false);
            wl = __builtin_amdgcn_cvt_pk_fp8_f32(x2 - h23.x, x3 - h23.y, wl, true);
            hi[i] = (unsigned)wd; lo[i] = (unsigned)wl;
        }
        *(uint4*)(shi + lane * 16) = make_uint4(hi[0], hi[1], hi[2], hi[3]);
        *(uint4*)(slo + lane * 16) = make_uint4(lo[0], lo[1], lo[2], lo[3]);
    }
    __builtin_amdgcn_s_waitcnt(0xc07f);
    __builtin_amdgcn_wave_barrier();
    {
        typedef int v8i __attribute__((ext_vector_type(8)));
        const unsigned char* Ub = P.ws + WS_U + 16 * g;
        const unsigned char* bsrc = (lr == 0) ? (shi + 16 * g) : (lr == 1) ? (slo + 16 * g) : (const unsigned char*)szero;
        const int bstep = (lr < 2) ? 128 : 0, bhalf = (lr < 2) ? 64 : 16;
        v8i Bv[8];
#pragma unroll
        for (int st = 0; st < 8; ++st) {
            const uint4 b0 = *(const uint4*)(bsrc + bstep * st), b1 = *(const uint4*)(bsrc + bstep * st + bhalf);
            Bv[st] = (v8i){(int)b0.x, (int)b0.y, (int)b0.z, (int)b0.w, (int)b1.x, (int)b1.y, (int)b1.z, (int)b1.w};
        }
        unsigned off[8];
#pragma unroll
        for (int T = 0; T < 8; ++T) off[T] = (unsigned)sid[16 * T + lr] * 512u;
        __builtin_amdgcn_s_waitcnt(0xc07f);
        __builtin_amdgcn_wave_barrier();
        float* sact = (float*)sidx + ((lr == 1) ? 128 : 0);
        uint4 abuf[2][8];
#pragma unroll
        for (int st = 0; st < 8; ++st) abuf[0][st] = *(const uint4*)(Ub + off[0] + 64 * st);
#pragma unroll
        for (int T = 0; T < 8; ++T) {
            if (T + 1 < 8) {
#pragma unroll
                for (int st = 0; st < 8; ++st) abuf[(T + 1) & 1][st] = *(const uint4*)(Ub + off[T + 1] + 64 * st);
            }
            f32x4 au = (f32x4){0.f, 0.f, 0.f, 0.f};
#pragma unroll
            for (int st = 0; st < 8; ++st) {
                const uint4 a4 = abuf[T & 1][st];
                const v8i Av = {(int)a4.x, (int)a4.y, (int)a4.z, (int)a4.w, 0, 0, 0, 0};
                au = __builtin_amdgcn_mfma_scale_f32_16x16x128_f8f6f4(Av, Bv[st], au, 4, 0, 0, 0x7f7f7f7f, 0, 0x7f7f7f7f);
            }
            if (lr < 2) *(f32x4*)(sact + 16 * T + 4 * g) = au;
        }
    }
    __builtin_amdgcn_s_waitcnt(0xc07f);
    __builtin_amdgcn_wave_barrier();
    {
        float* sw = (float*)sidx;
        float wv[2];
#pragma unroll
        for (int hh = 0; hh < 2; ++hh) {
            const int e = lane + 64 * hh, id = sid[e];
            const float a = (sw[e] + sw[128 + e]) * usc[id] * rstd;
            wv[hh] = sgate[e] * vsc[id] * 0.5f * a * (1.f + erff(a * 0.70710678118654752f));
        }
        sw[lane] = wv[0]; sw[lane + 64] = wv[1];
    }
    __builtin_amdgcn_s_waitcnt(0xc07f);
    __builtin_amdgcn_wave_barrier();
    f32x2 acc[8];
#pragma unroll
    for (int j = 0; j < 8; ++j) acc[j] = (f32x2){0.f, 0.f};
#pragma unroll 1
    for (int e0 = 0; e0 < 128; e0 += 16) {
        uint2 vr[16];
#pragma unroll
        for (int q = 0; q < 16; ++q) vr[q] = *(const uint2*)(V + (size_t)sid[e0 + q] * 512);
        const float* sw = (const float*)sidx + e0;
        const f32x4 w0 = *(const f32x4*)(sw), w1 = *(const f32x4*)(sw + 4), w2 = *(const f32x4*)(sw + 8), w3 = *(const f32x4*)(sw + 12);
        const float wq[16] = {w0[0], w0[1], w0[2], w0[3], w1[0], w1[1], w1[2], w1[3], w2[0], w2[1], w2[2], w2[3], w3[0], w3[1], w3[2], w3[3]};
#pragma unroll
        for (int q = 0; q < 16; ++q) {
            const float w = wq[q];
#define FP4_AXPY(k) { acc[k] += w * __builtin_amdgcn_cvt_scalef32_pk_f32_fp4(vr[q].x, 1.0f, k); acc[4 + k] += w * __builtin_amdgcn_cvt_scalef32_pk_f32_fp4(vr[q].y, 1.0f, k); }
            FP4_AXPY(0) FP4_AXPY(1) FP4_AXPY(2) FP4_AXPY(3)
#undef FP4_AXPY
        }
    }
    f32x2 xf[8];
    {
        const uint4 xa = *(const uint4*)(xn + lane * 16), xb = *(const uint4*)(xn + lane * 16 + 8);
        xf[0] = (f32x2){bflo(xa.x), bfhi(xa.x)}; xf[1] = (f32x2){bflo(xa.y), bfhi(xa.y)}; xf[2] = (f32x2){bflo(xa.z), bfhi(xa.z)}; xf[3] = (f32x2){bflo(xa.w), bfhi(xa.w)};
        xf[4] = (f32x2){bflo(xb.x), bfhi(xb.x)}; xf[5] = (f32x2){bflo(xb.y), bfhi(xb.y)}; xf[6] = (f32x2){bflo(xb.z), bfhi(xb.z)}; xf[7] = (f32x2){bflo(xb.w), bfhi(xb.w)};
    }
    float* o = P.out + (size_t)t * DM + lane * 16;
    float4 h0, h1, h2, h3;
    {
        const float4 g0 = *(const float4*)(P.norm_ffn + lane * 16), g1 = *(const float4*)(P.norm_ffn + lane * 16 + 4), g2 = *(const float4*)(P.norm_ffn + lane * 16 + 8), g3 = *(const float4*)(P.norm_ffn + lane * 16 + 12);
        h0.x = xf[0].x / g0.x + acc[0].x; h0.y = xf[0].y / g0.y + acc[0].y; h0.z = xf[1].x / g0.z + acc[1].x; h0.w = xf[1].y / g0.w + acc[1].y;
        h1.x = xf[2].x / g1.x + acc[2].x; h1.y = xf[2].y / g1.y + acc[2].y; h1.z = xf[3].x / g1.z + acc[3].x; h1.w = xf[3].y / g1.w + acc[3].y;
        h2.x = xf[4].x / g2.x + acc[4].x; h2.y = xf[4].y / g2.y + acc[4].y; h2.z = xf[5].x / g2.z + acc[5].x; h2.w = xf[5].y / g2.w + acc[5].y;
        h3.x = xf[6].x / g3.x + acc[6].x; h3.y = xf[6].y / g3.y + acc[6].y; h3.z = xf[7].x / g3.z + acc[7].x; h3.w = xf[7].y / g3.w + acc[7].y;
    }
    *(float4*)(o) = h0; *(float4*)(o + 4) = h1; *(float4*)(o + 8) = h2; *(float4*)(o + 12) = h3;
    __builtin_amdgcn_s_waitcnt(0xc07f);
    __builtin_amdgcn_wave_barrier();
}

#define LAS __attribute__((address_space(3)))
#define XB_TMO      128
#define XB_XCNT(j)  (256  + 64 * (j))
#define XB_XSUB(j)  (1280 + 64 * (j))
#define XB_XGEN(j)  (2304 + 64 * (j))
#define XB_TOP      3328
#define XB_TOPGEN   3392
#define XCD_BAR_WORDS 3456
#define XB_SPIN_CAP (1u << 18)
__device__ __forceinline__ unsigned xb_ld(unsigned* p)              { return __hip_atomic_load(p, __ATOMIC_RELAXED, __HIP_MEMORY_SCOPE_AGENT); }
__device__ __forceinline__ unsigned xb_add(unsigned* p, unsigned v) { return __hip_atomic_fetch_add(p, v, __ATOMIC_RELAXED, __HIP_MEMORY_SCOPE_AGENT); }
__device__ __forceinline__ unsigned xb_xcc_id() { return (unsigned)__builtin_amdgcn_s_getreg((3 << 11) | 20) & 0xFu; }
#define XB_SPIN(cond, bar) do { unsigned _sp = 0; while (cond) { __builtin_amdgcn_s_sleep(1); \
    if ((++_sp & 255u) == 0u) { if (xb_ld(&(bar)[XB_TMO])) break; if (_sp > XB_SPIN_CAP) { atomicAdd(&(bar)[XB_TMO], 1u); break; } } } } while (0)
struct XcdBarrier { unsigned* bar; unsigned x; volatile LAS unsigned* st; };
__device__ __forceinline__ XcdBarrier xcd_barrier_post(unsigned* bar, volatile LAS unsigned* st) {
    XcdBarrier b; b.bar = bar; b.x = xb_xcc_id(); b.st = st;
    if (threadIdx.x == 0) (void)xb_add(&bar[XB_XCNT(b.x)], 1u);
    return b;
}
__device__ __forceinline__ void xcd_barrier_complete(unsigned* bar, unsigned x, unsigned& nloc, unsigned& nx) {
    const unsigned G = gridDim.x * gridDim.y * gridDim.z;
    unsigned sum, cnt, mine, sp = 0u;
    for (;;) {
        sum = 0u; cnt = 0u; mine = 0u;
#pragma unroll
        for (unsigned j = 0; j < 16; ++j) { const unsigned c = xb_ld(&bar[XB_XCNT(j)]); sum += c; cnt += (c > 0u) ? 1u : 0u; mine = (j == x) ? c : mine; }
        if (sum == G) break;
        __builtin_amdgcn_s_sleep(1);
        if ((++sp & 255u) == 0u) { if (xb_ld(&bar[XB_TMO])) break; if (sp > XB_SPIN_CAP) { atomicAdd(&bar[XB_TMO], 1u); break; } }
    }
    nloc = mine > 0u ? mine : 1u; nx = cnt > 0u ? cnt : 1u;
}
__device__ __forceinline__ void xcd_barrier(const XcdBarrier& b) {
    asm volatile("s_waitcnt vmcnt(0)" ::: "memory");
    __syncthreads();
    if (threadIdx.x == 0) {
        unsigned* bar = b.bar;
        __builtin_amdgcn_s_waitcnt(0);
        unsigned nloc = b.st[0], nx = b.st[1];
        if (nloc == 0u) { xcd_barrier_complete(bar, b.x, nloc, nx); b.st[0] = nloc; b.st[1] = nx; }
        const unsigned old = xb_add(&bar[XB_XSUB(b.x)], 1u);
        const unsigned gen = old / nloc;
        if (old + 1u == (gen + 1u) * nloc) {
            __builtin_amdgcn_fence(__ATOMIC_RELEASE, "agent");
            asm volatile("s_waitcnt vmcnt(0)" ::: "memory");
            const unsigned og = xb_add(&bar[XB_TOP], 1u);
            const unsigned tg = og / nx;
            if (og + 1u == (tg + 1u) * nx) xb_add(&bar[XB_TOPGEN], 1u);
            else XB_SPIN(xb_ld(&bar[XB_TOPGEN]) == tg, bar);
            __builtin_amdgcn_fence(__ATOMIC_ACQUIRE, "agent");
            xb_add(&bar[XB_XGEN(b.x)], 1u);
            asm volatile("s_waitcnt vmcnt(0)" ::: "memory");
        } else {
            XB_SPIN(xb_ld(&bar[XB_XGEN(b.x)]) == gen, bar);
            __builtin_amdgcn_fence(__ATOMIC_ACQUIRE, "agent");
            asm volatile("s_waitcnt vmcnt(0)" ::: "memory");
        }
    }
    __syncthreads();
}

__device__ __forceinline__ void hand_release() { asm volatile("s_waitcnt vmcnt(0)" ::: "memory"); __builtin_amdgcn_fence(__ATOMIC_RELEASE, "agent"); asm volatile("s_waitcnt vmcnt(0)" ::: "memory"); }
__device__ __forceinline__ void hand_acquire() { __builtin_amdgcn_fence(__ATOMIC_ACQUIRE, "agent"); asm volatile("s_waitcnt vmcnt(0)" ::: "memory"); }

__global__ void __launch_bounds__(256, 2) mega(Params P) {
    extern __shared__ __attribute__((aligned(16))) unsigned char smem[];
    const int tid = threadIdx.x, lane = tid & 63, wave = tid >> 6;
    const int G = gridDim.x, bid = blockIdx.x;
    unsigned* ctl = (unsigned*)(P.ws + WS_CTL);
    volatile LAS unsigned* bst = (volatile LAS unsigned*)(smem + 65552);
    if (tid == 0) { bst[0] = 0u; bst[1] = 0u; }
    __syncthreads();
    const XcdBarrier xb = xcd_barrier_post(ctl + 1024, bst);
    unsigned* cucnt = ctl + 5120;
    if (tid == 0) {
        const unsigned phys = ((xb_xcc_id() & 7u) << 8) | ((unsigned)__builtin_amdgcn_s_getreg((7 << 11) | (8 << 6) | 4) & 0xFFu);
        bst[2] = phys; bst[3] = xb_add(&cucnt[phys], 1u);
    }
    phase0(P, smem);
    xcd_barrier(xb);
    {
        int vb;
        const unsigned phys = bst[2];
        unsigned part = 0;
#pragma unroll
        for (int q = 0; q < 8; ++q) { const unsigned i = (unsigned)(tid + 256 * q); const unsigned c = xb_ld(&cucnt[i]); part += (i < phys) ? c : 0u; }
#pragma unroll
        for (int o = 1; o < 64; o <<= 1) part += (unsigned)__shfl_xor((int)part, o, 64);
        if (lane == 0) bst[4 + wave] = part;
        __syncthreads();
        vb = (int)(bst[4] + bst[5] + bst[6] + bst[7] + bst[3]);
        vb = __builtin_amdgcn_readfirstlane(vb);
        if (vb < 0 || vb >= G) vb = bid;
        __syncthreads();
        if (tid == 0) bst[8] = (unsigned)vb;
        __syncthreads();
    }
#define VB_LOAD() __builtin_amdgcn_readfirstlane((int)bst[8])
    {
        const int gw = bid * 4 + wave;
        if (gw < 64) fox_cum_wave(P, gw, lane);
        const int vb = VB_LOAD();
        for (int tile = vb; tile < 129 * 28; tile += G) gemm_tile<1>(P, tile / 28, tile % 28, smem);
        {
            const int rem = (129 * 28) % G;
            if (rem > 0 && rem < G) { if (vb >= rem) convert_uv_rows(P, (vb - rem) * 4 + wave, (G - rem) * 4, lane); }
            else convert_uv_rows(P, vb * 4 + wave, G * 4, lane);
        }
    }
    xcd_barrier(xb);
    {
        volatile int* s_item = (volatile int*)(smem + 65536);
        const int wave_u = __builtin_amdgcn_readfirstlane(wave);
        auto fetch = [&](unsigned* counter) -> int {
            if (wave_u == 0) {
                unsigned v = atomicAdd(counter, lane == 0 ? 1u : 0u);
                *s_item = (int)__builtin_amdgcn_readfirstlane(v);
            }
            __syncthreads();
            const int item = __builtin_amdgcn_readfirstlane(*s_item);
            __syncthreads();
            return item;
        };
        for (;;) {
            const int item = fetch(&ctl[2]);
            if (item >= 33 * 32) break;
            mlstm_A(P, item, smem);
        }
        xcd_barrier(xb);
        for (;;) {
            const int item = fetch(&ctl[4]);
            if (item >= 96) break;
            mlstm_B(P, item);
        }
        for (;;) {
            const int item = fetch(&ctl[3]);
            if (item >= 64 * 17) break;
            attn_block(P, item & 63, 16 - (item >> 6), smem);
        }
        xcd_barrier(xb);
        for (;;) {
            const int item = fetch(&ctl[5]);
            if (item >= 33 * 32) break;
            mlstm_C(P, item, smem);
        }
    }
    xcd_barrier(xb);
    for (int tile = VB_LOAD(); tile < 128 * 8; tile += G) gemm_tile<2>(P, tile >> 3, tile & 7, smem);
    xcd_barrier(xb);
    for (int tile = VB_LOAD(); tile < 128 * 16; tile += G) gemm_tile<3>(P, tile >> 4, tile & 15, smem);
    xcd_barrier(xb);
    {
        unsigned char* slut = smem + 12288;
        if (tid < 64) {
            int c = tid, i = 0;
            while (i < 16 && c >= 16 / (i + 1)) { c -= 16 / (i + 1); ++i; }
            slut[tid] = (unsigned char)(i < 16 ? ((i << 4) | c) : 0);
        }
        unsigned* szero = (unsigned*)(smem + 12288 + 64);
        if (tid < 16) szero[tid] = 0u;
        __syncthreads();
        int* sidx = (int*)(smem + wave * 3072); float* sval = (float*)(smem + wave * 3072 + 1024);
        int* sid = (int*)(smem + wave * 3072 + 2048); float* sgate = (float*)(smem + wave * 3072 + 2560);
        int lane5 = lane;
        asm volatile("" : "+v"(lane5));
        for (int t = bid * 4 + wave; t < T2; t += G * 4) peer_token(P, t, lane5, sidx, sval, sid, sgate, slut, szero);
    }
}

}

extern "C" void kernel_launch(void* const* d_in, const int* in_sizes, int n_in, void* d_out, int out_size, void* d_ws, size_t ws_size, hipStream_t stream) {
    if (n_in != 17 || ws_size < WS_END) { fprintf(stderr, "kernel_launch: unexpected n_in %d or ws_size %zu (need %zu)\n", n_in, ws_size, (size_t)WS_END); return; }
    constexpr int LDS_BYTES = 66560;
    static int grid_blocks = 0;
    if (!grid_blocks) {
        int dev = 0, cus = 0, per_cu = 0;
        (void)hipGetDevice(&dev);
        (void)hipDeviceGetAttribute(&cus, hipDeviceAttributeMultiprocessorCount, dev);
        (void)hipFuncSetAttribute((const void*)mega, hipFuncAttributeMaxDynamicSharedMemorySize, LDS_BYTES);
        (void)hipOccupancyMaxActiveBlocksPerMultiprocessor(&per_cu, (const void*)mega, 256, LDS_BYTES);
        if (per_cu < 1) per_cu = 1;
        if (per_cu > 2) per_cu = 2;
        grid_blocks = cus * per_cu;
        fprintf(stderr, "kernel_launch: cus %d per_cu %d grid %d\n", cus, per_cu, grid_blocks);
    }
    Params P{};
    P.x = (const float*)d_in[0]; P.meta = (const float*)d_in[1]; P.norm_mix = (const float*)d_in[2]; P.w_in = (const float*)d_in[3];
    P.conv_qk = (const float*)d_in[4]; P.b_igate = (const float*)d_in[5]; P.b_fgate_m = (const float*)d_in[6]; P.m_out_norm = (const float*)d_in[7];
    P.b_fgate_f = (const float*)d_in[8]; P.f_q_norm = (const float*)d_in[9]; P.f_k_norm = (const float*)d_in[10]; P.w_out = (const float*)d_in[11];
    P.norm_ffn = (const float*)d_in[12]; P.peer_query = (const float*)d_in[13]; P.peer_keys = (const float*)d_in[14]; P.peer_u = (const float*)d_in[15];
    P.peer_v = (const float*)d_in[16]; P.out = (float*)d_out; P.ws = (unsigned char*)d_ws;
    (void)hipMemsetAsync((unsigned char*)d_ws + WS_CTL, 0, 32768, stream);
    void* args[] = {&P};
    hipError_t e = hipLaunchCooperativeKernel((const void*)mega, dim3(grid_blocks), dim3(256), args, LDS_BYTES, stream);
    if (e != hipSuccess) fprintf(stderr, "cooperative launch failed: %s (grid %d)\n", hipGetErrorString(e), grid_blocks);
}
```

```cpp
#include <hip/hip_runtime.h>
#include <stdint.h>
#include <stdio.h>
#include <hip/hip_cooperative_groups.h>
namespace cg = cooperative_groups;

namespace {

constexpr int NB = 8, SEQ = 2048, DM = 1024, NMETA = 16, L = SEQ + NMETA;
constexpr int T1 = NB * L;
constexpr int T2 = NB * SEQ;
constexpr int NZ = 3584;
constexpr int ZC_MQ = 0, ZC_MK = 512, ZC_MV = 1024, ZC_MO = 1536, ZC_FQ = 2048, ZC_FK = 2560, ZC_FV = 3072;
constexpr int PROJ = 3600;
constexpr float EPS = 1e-6f;

constexpr size_t WS_CTL = 0;
constexpr size_t WS_RA = 65536;
constexpr size_t WS_Z = WS_RA + (size_t)T1 * DM * 2;
constexpr size_t WS_GATES = WS_Z + (size_t)T1 * NZ * 2;
constexpr size_t WS_CUM = WS_GATES + (size_t)T1 * 16 * 4;
constexpr size_t WS_SSQ = WS_CUM + (size_t)NB * 8 * L * 4;
constexpr size_t WS_RSTD = WS_SSQ + (size_t)T2 * 16 * 4;
constexpr size_t WS_SSQM = WS_RSTD + (size_t)T2 * 4;
constexpr size_t WS_BT2 = WS_SSQM + (size_t)T1 * 16 * 4;
constexpr size_t WS_BT3 = WS_BT2 + (size_t)DM * DM * 2;
constexpr size_t WS_KEYS = WS_BT3 + (size_t)2048 * DM * 2;
constexpr size_t WS_MSC = WS_KEYS + (size_t)16 * 128 * 128 * 2;
constexpr size_t WS_MST = WS_MSC + (size_t)128 * 33 * 16;
constexpr size_t WS_BT1 = WS_MST + (size_t)32 * 33 * 36864;
constexpr size_t WS_CBI = WS_BT1;
constexpr size_t WS_UV = WS_CBI + (size_t)32 * 33 * 36864;
constexpr size_t WS_END = WS_UV + (size_t)2 * 16384 * 512 + (size_t)2 * 16384 * 4;
constexpr size_t WS_XN = WS_RA;
constexpr size_t WS_U = WS_UV;
constexpr size_t WS_V = WS_U + (size_t)16384 * 512;
constexpr size_t WS_USC = WS_V + (size_t)16384 * 512;
constexpr size_t WS_VSC = WS_USC + (size_t)16384 * 4;
constexpr size_t WS_TK = WS_CBI;
constexpr float LOG2E = 1.4426950408889634f;

typedef unsigned short bf16_t;
typedef short bf16x8 __attribute__((ext_vector_type(8)));
typedef float f32x4 __attribute__((ext_vector_type(4)));
typedef __attribute__((ext_vector_type(2))) __bf16 bf16x2_t;

struct Params {
    const float* x; const float* meta; const float* norm_mix; const float* w_in; const float* conv_qk;
    const float* b_igate; const float* b_fgate_m; const float* m_out_norm; const float* b_fgate_f;
    const float* f_q_norm; const float* f_k_norm; const float* w_out; const float* norm_ffn;
    const float* peer_query; const float* peer_keys; const float* peer_u; const float* peer_v;
    float* out; unsigned char* ws;
};

__device__ __forceinline__ unsigned f2bf(float f) { unsigned u = __float_as_uint(f); return (u + 0x7fffu + ((u >> 16) & 1u)) >> 16; }
__device__ __forceinline__ float bf2f(unsigned h) { return __uint_as_float(h << 16); }
typedef float f32x2 __attribute__((ext_vector_type(2)));
typedef __bf16 bf16x2v __attribute__((ext_vector_type(2)));
__device__ __forceinline__ unsigned cvt_pk_bf16(float lo, float hi) { f32x2 v = {lo, hi}; bf16x2v b = __builtin_convertvector(v, bf16x2v); return __builtin_bit_cast(unsigned, b); }
__device__ __forceinline__ unsigned pk2(float lo, float hi) { return cvt_pk_bf16(lo, hi); }
__device__ __forceinline__ float bflo(unsigned w) { return __uint_as_float(w << 16); }
__device__ __forceinline__ float bfhi(unsigned w) { return __uint_as_float(w & 0xffff0000u); }
__device__ __forceinline__ float wave_sum(float v) {
#pragma unroll
    for (int o = 32; o > 0; o >>= 1) v += __shfl_xor(v, o, 64);
    return v;
}
__device__ __forceinline__ float wave_max(float v) {
#pragma unroll
    for (int o = 32; o > 0; o >>= 1) v = fmaxf(v, __shfl_xor(v, o, 64));
    return v;
}
__device__ __forceinline__ float logsigmoidf(float x) { return fminf(x, 0.f) - log1pf(expf(-fabsf(x))); }
__device__ __forceinline__ unsigned ord_key(float f) { unsigned u = __float_as_uint(f); return u ^ ((u >> 31) ? 0xffffffffu : 0x80000000u); }
__device__ __forceinline__ float unord_key(unsigned k) { unsigned u = (k & 0x80000000u) ? (k ^ 0x80000000u) : ~k; return __uint_as_float(u); }

__device__ __forceinline__ void phase0(const Params& P, unsigned char* smem) {
    const int tid = threadIdx.x, lane = tid & 63, wave = tid >> 6;
    unsigned* ctl = (unsigned*)(P.ws + WS_CTL);
    float* gw = (float*)smem;
    for (int idx = tid; idx < 16 * 1024; idx += 256) {
        const int k = idx >> 4, c = idx & 15;
        const int col = c < 8 ? 2048 + c : 3592 + (c - 8);
        gw[c * 1024 + k] = P.w_in[(size_t)k * PROJ + col];
    }
    __syncthreads();
    {
        bf16_t* hn = (bf16_t*)(P.ws + WS_RA);
        float* gates = (float*)(P.ws + WS_GATES);
        const int c0 = lane * 8, c1 = 512 + lane * 8;
        float gm[16];
        {
            const float4 a0 = *(const float4*)(P.norm_mix + c0), a1 = *(const float4*)(P.norm_mix + c0 + 4);
            const float4 a2 = *(const float4*)(P.norm_mix + c1), a3 = *(const float4*)(P.norm_mix + c1 + 4);
            gm[0] = a0.x; gm[1] = a0.y; gm[2] = a0.z; gm[3] = a0.w; gm[4] = a1.x; gm[5] = a1.y; gm[6] = a1.z; gm[7] = a1.w;
            gm[8] = a2.x; gm[9] = a2.y; gm[10] = a2.z; gm[11] = a2.w; gm[12] = a3.x; gm[13] = a3.y; gm[14] = a3.z; gm[15] = a3.w;
        }
        const int myq = ((lane >> 5) & 1) * 8 + ((lane >> 4) & 1) * 4 + ((lane >> 3) & 1) * 2 + ((lane >> 2) & 1);
        const float mybias = myq < 4 ? P.b_igate[myq] : (myq < 8 ? P.b_fgate_m[myq - 4] : P.b_fgate_f[myq - 8]);
        const int rstep = gridDim.x * 4;
        int r = blockIdx.x * 4 + wave;
        float4 n0, n1, n2, n3;
        auto load_row = [&](int rr) {
            const int b = rr / L, p = rr - b * L;
            const float* src = (p < NMETA) ? (P.meta + (size_t)p * DM) : (P.x + ((size_t)b * SEQ + (p - NMETA)) * DM);
            n0 = *(const float4*)(src + c0); n1 = *(const float4*)(src + c0 + 4); n2 = *(const float4*)(src + c1); n3 = *(const float4*)(src + c1 + 4);
        };
        if (r < T1) load_row(r);
        for (; r < T1; r += rstep) {
            float v[16];
            v[0] = n0.x; v[1] = n0.y; v[2] = n0.z; v[3] = n0.w; v[4] = n1.x; v[5] = n1.y; v[6] = n1.z; v[7] = n1.w;
            v[8] = n2.x; v[9] = n2.y; v[10] = n2.z; v[11] = n2.w; v[12] = n3.x; v[13] = n3.y; v[14] = n3.z; v[15] = n3.w;
            if (r + rstep < T1) load_row(r + rstep);
            float ss = 0.f;
#pragma unroll
            for (int j = 0; j < 16; ++j) ss += v[j] * v[j];
            ss = wave_sum(ss);
            const float rstd = rsqrtf(ss * (1.0f / DM) + EPS);
#pragma unroll
            for (int j = 0; j < 16; ++j) v[j] *= rstd * gm[j];
            uint4 o0, o1;
            o0.x = pk2(v[0], v[1]); o0.y = pk2(v[2], v[3]); o0.z = pk2(v[4], v[5]); o0.w = pk2(v[6], v[7]);
            o1.x = pk2(v[8], v[9]); o1.y = pk2(v[10], v[11]); o1.z = pk2(v[12], v[13]); o1.w = pk2(v[14], v[15]);
            *(uint4*)(hn + (size_t)r * DM + c0) = o0;
            *(uint4*)(hn + (size_t)r * DM + c1) = o1;
            float r8[8], r4[4], r2[2], r1;
#pragma unroll
            for (int i = 0; i < 8; ++i) {
                float dd[2];
#pragma unroll
                for (int hh = 0; hh < 2; ++hh) {
                    const float* gwc = gw + (i + 8 * hh) * 1024;
                    const float4 w0 = *(const float4*)(gwc + c0), w1 = *(const float4*)(gwc + c0 + 4), w2 = *(const float4*)(gwc + c1), w3 = *(const float4*)(gwc + c1 + 4);
                    dd[hh] = v[0] * w0.x + v[1] * w0.y + v[2] * w0.z + v[3] * w0.w + v[4] * w1.x + v[5] * w1.y + v[6] * w1.z + v[7] * w1.w
                           + v[8] * w2.x + v[9] * w2.y + v[10] * w2.z + v[11] * w2.w + v[12] * w3.x + v[13] * w3.y + v[14] * w3.z + v[15] * w3.w;
                }
                const bool up = (lane & 32) != 0; const float keep = up ? dd[1] : dd[0], send = up ? dd[0] : dd[1];
                r8[i] = keep + __shfl_xor(send, 32, 64);
                __builtin_amdgcn_sched_barrier(0);
            }
#pragma unroll
            for (int i = 0; i < 4; ++i) { const bool up = (lane & 16) != 0; const float keep = up ? r8[i + 4] : r8[i], send = up ? r8[i] : r8[i + 4]; r4[i] = keep + __shfl_xor(send, 16, 64); }
#pragma unroll
            for (int i = 0; i < 2; ++i) { const bool up = (lane & 8) != 0; const float keep = up ? r4[i + 2] : r4[i], send = up ? r4[i] : r4[i + 2]; r2[i] = keep + __shfl_xor(send, 8, 64); }
            { const bool up = (lane & 4) != 0; const float keep = up ? r2[1] : r2[0], send = up ? r2[0] : r2[1]; r1 = keep + __shfl_xor(send, 4, 64); }
            r1 += __shfl_xor(r1, 2, 64); r1 += __shfl_xor(r1, 1, 64);
            if ((lane & 3) == 0) {
                const float pre = r1 + mybias;
                gates[(size_t)r * 16 + myq] = myq < 4 ? pre : logsigmoidf(pre);
            }
        }
    }
    __syncthreads();
    {
        float (*tile)[65] = (float (*)[65])smem;
        for (int item = blockIdx.x; item < 1664; item += gridDim.x) {
            const float* W; int ldn, ntn, shift_from, it; bf16_t* out;
            if (item < 896) { W = P.w_in; ldn = PROJ; ntn = 56; shift_from = 2048; it = item; out = (bf16_t*)(P.ws + WS_BT1); }
            else if (item < 1152) { W = P.w_out; ldn = 1024; ntn = 16; shift_from = 1 << 30; it = item - 896; out = (bf16_t*)(P.ws + WS_BT2); }
            else { W = P.peer_query; ldn = 2048; ntn = 32; shift_from = 1 << 30; it = item - 1152; out = (bf16_t*)(P.ws + WS_BT3); }
            const int tk = it / ntn, tn = it - tk * ntn, k0 = tk * 64, n0 = tn * 64;
            {
                const int nl = tid & 63;
                int n = n0 + nl; if (n >= shift_from) n += 8;
#pragma unroll
                for (int i = 0; i < 16; ++i) { const int kl = (tid >> 6) + 4 * i; tile[kl][nl] = W[(size_t)(k0 + kl) * ldn + n]; }
            }
            __syncthreads();
            {
                const int kl = tid & 63;
#pragma unroll
                for (int i = 0; i < 16; ++i) { const int nl = (tid >> 6) + 4 * i; out[(size_t)(n0 + nl) * 1024 + k0 + kl] = (bf16_t)f2bf(tile[kl][nl]); }
            }
            __syncthreads();
        }
    }
    {
        const size_t gt = (size_t)blockIdx.x * 256 + tid, gs = (size_t)gridDim.x * 256;
        const float* src = P.peer_keys; bf16_t* dst = (bf16_t*)(P.ws + WS_KEYS);
        for (size_t i = gt; i < (size_t)(16 * 128 * 128 / 8); i += gs) {
            const float4 a = *(const float4*)(src + i * 8), b = *(const float4*)(src + i * 8 + 4);
            uint4 o; o.x = pk2(a.x, a.y); o.y = pk2(a.z, a.w); o.z = pk2(b.x, b.y); o.w = pk2(b.z, b.w);
            *(uint4*)(dst + i * 8) = o;
        }
    }
}

__device__ __forceinline__ void convert_uv_rows(const Params& P, int gwave, int nwaves, int lane) {
    for (int rr0 = gwave * 4; rr0 < 2 * 16384; rr0 += nwaves * 4) {
        float4 a[4][4];
#pragma unroll
        for (int q = 0; q < 4; ++q) {
            const int rr = rr0 + q, which = rr >> 14, row = rr & 16383;
            const float* src = (which ? P.peer_v : P.peer_u) + (size_t)row * DM + lane * 16;
            a[q][0] = *(const float4*)(src); a[q][1] = *(const float4*)(src + 4); a[q][2] = *(const float4*)(src + 8); a[q][3] = *(const float4*)(src + 12);
        }
#pragma unroll
        for (int q = 0; q < 4; ++q) {
            const int rr = rr0 + q, which = rr >> 14, row = rr & 16383;
            float mx = 0.f;
#pragma unroll
            for (int j = 0; j < 4; ++j) mx = fmaxf(mx, fmaxf(fmaxf(fabsf(a[q][j].x), fabsf(a[q][j].y)), fmaxf(fabsf(a[q][j].z), fabsf(a[q][j].w))));
            mx = wave_max(mx);
            const float sc = mx > 0.f ? 6.0f / mx : 1.0f;
            unsigned w0 = 0u, w1 = 0u;
            w0 = __builtin_amdgcn_cvt_scalef32_pk_fp4_f32(w0, a[q][0].x * sc, a[q][0].y * sc, 1.0f, 0); w0 = __builtin_amdgcn_cvt_scalef32_pk_fp4_f32(w0, a[q][0].z * sc, a[q][0].w * sc, 1.0f, 1);
            w0 = __builtin_amdgcn_cvt_scalef32_pk_fp4_f32(w0, a[q][1].x * sc, a[q][1].y * sc, 1.0f, 2); w0 = __builtin_amdgcn_cvt_scalef32_pk_fp4_f32(w0, a[q][1].z * sc, a[q][1].w * sc, 1.0f, 3);
            w1 = __builtin_amdgcn_cvt_scalef32_pk_fp4_f32(w1, a[q][2].x * sc, a[q][2].y * sc, 1.0f, 0); w1 = __builtin_amdgcn_cvt_scalef32_pk_fp4_f32(w1, a[q][2].z * sc, a[q][2].w * sc, 1.0f, 1);
            w1 = __builtin_amdgcn_cvt_scalef32_pk_fp4_f32(w1, a[q][3].x * sc, a[q][3].y * sc, 1.0f, 2); w1 = __builtin_amdgcn_cvt_scalef32_pk_fp4_f32(w1, a[q][3].z * sc, a[q][3].w * sc, 1.0f, 3);
            *(uint2*)(P.ws + (which ? WS_V : WS_U) + (size_t)row * 512 + lane * 8) = make_uint2(w0, w1);
            if (lane == 0) ((float*)(P.ws + (which ? WS_VSC : WS_USC)))[row] = mx > 0.f ? mx * (1.0f / 6.0f) : 1.0f;
        }
    }
}

__device__ __forceinline__ void bitonic_sort16_desc(unsigned (&v)[16]) {
#pragma unroll
    for (int k = 2; k <= 16; k <<= 1)
#pragma unroll
        for (int j = k >> 1; j >= 1; j >>= 1)
#pragma unroll
            for (int i = 0; i < 16; ++i)
                if ((i & j) == 0) {
                    const int p = i | j;
                    const bool desc = (k >= 16) ? true : ((i & k) == 0);
                    const unsigned hi = max(v[i], v[p]), lo = min(v[i], v[p]);
                    v[i] = desc ? hi : lo; v[p] = desc ? lo : hi;
                }
}
__device__ __forceinline__ void bitonic_merge16_top(unsigned (&a)[16], const unsigned (&b)[16]) {
#pragma unroll
    for (int i = 0; i < 16; ++i) a[i] = max(a[i], b[15 - i]);
#pragma unroll
    for (int j = 8; j >= 1; j >>= 1)
#pragma unroll
        for (int i = 0; i < 16; ++i)
            if ((i & j) == 0) { const int p = i | j; const unsigned hi = max(a[i], a[p]), lo = min(a[i], a[p]); a[i] = hi; a[p] = lo; }
}

__device__ __forceinline__ float x4_max(float x) {
    const unsigned xi = __float_as_uint(x);
    const auto r = __builtin_amdgcn_permlane32_swap(xi, xi, false, false);
    const float m = fmaxf(__uint_as_float(r[0]), __uint_as_float(r[1]));
    const unsigned mi = __float_as_uint(m);
    const auto r2 = __builtin_amdgcn_permlane16_swap(mi, mi, false, false);
    return fmaxf(__uint_as_float(r2[0]), __uint_as_float(r2[1]));
}
__device__ __forceinline__ float x4_sum(float x) {
    const unsigned xi = __float_as_uint(x);
    const auto r = __builtin_amdgcn_permlane32_swap(xi, xi, false, false);
    const float m = __uint_as_float(r[0]) + __uint_as_float(r[1]);
    const unsigned mi = __float_as_uint(m);
    const auto r2 = __builtin_amdgcn_permlane16_swap(mi, mi, false, false);
    return __uint_as_float(r2[0]) + __uint_as_float(r2[1]);
}

__device__ __forceinline__ int opaque_tid() { int t = threadIdx.x; asm volatile("" : "+v"(t)); return t; }

__device__ __forceinline__ void mma_ktile(const unsigned char* sA, const unsigned char* sB, int arow_off, int brow_off, int g, int sw, f32x4 (&acc)[4][4]) {
#pragma unroll
    for (int s = 0; s < 2; ++s) {
        bf16x8 a[4], b[4];
        const int ch = (((s * 4 + g) ^ sw) << 4);
#pragma unroll
        for (int i = 0; i < 4; ++i) a[i] = *(const bf16x8*)(sA + arow_off + i * 2048 + ch);
#pragma unroll
        for (int j = 0; j < 4; ++j) b[j] = *(const bf16x8*)(sB + brow_off + j * 2048 + ch);
#pragma unroll
        for (int i = 0; i < 4; ++i)
#pragma unroll
            for (int j = 0; j < 4; ++j) acc[i][j] = __builtin_amdgcn_mfma_f32_16x16x32_bf16(b[j], a[i], acc[i][j], 0, 0, 0);
    }
}

__device__ __forceinline__ void store_tile_bf16(const f32x4 (&acc)[4][4], unsigned char* smem, bf16_t* dst, size_t ld, int m0, int n0, int tid, int wr, int wc, int g, int lr) {
#pragma unroll
    for (int i = 0; i < 4; ++i)
#pragma unroll
        for (int j = 0; j < 4; ++j) {
            const int row = wr * 64 + 16 * i + lr, col = wc * 64 + 16 * j + 4 * g;
            uint2 w; w.x = pk2(acc[i][j][0], acc[i][j][1]); w.y = pk2(acc[i][j][2], acc[i][j][3]);
            *(uint2*)(smem + row * 272 + col * 2) = w;
        }
    __syncthreads();
#pragma unroll
    for (int q = 0; q < 8; ++q) {
        const int id = tid + 256 * q, row = id >> 4, ch = id & 15;
        const uint4 v = *(const uint4*)(smem + row * 272 + ch * 16);
        *(uint4*)(dst + (size_t)(m0 + row) * ld + n0 + ch * 8) = v;
    }
    __syncthreads();
}

template <int MODE>
__device__ __forceinline__ void gemm_tile(const Params& P, int tm, int tn, unsigned char* smem) {
    const bf16_t* A; const bf16_t* Bt;
    if (MODE == 1) { A = (const bf16_t*)(P.ws + WS_RA); Bt = (const bf16_t*)(P.ws + WS_BT1); }
    else if (MODE == 2) { A = (const bf16_t*)(P.ws + WS_Z); Bt = (const bf16_t*)(P.ws + WS_BT2); }
    else { A = (const bf16_t*)(P.ws + WS_XN); Bt = (const bf16_t*)(P.ws + WS_BT3); }
    const int tid = opaque_tid(), lane = tid & 63, wave = tid >> 6, wr = wave >> 1, wc = wave & 1, g = lane >> 4, lr = lane & 15;
    const int m0 = tm * 128, n0 = tn * 128;
    const int srow = tid >> 3, sc = tid & 7;
    constexpr unsigned LDA = (MODE == 2 ? NZ : 1024) * 2u;
    unsigned aoff, boff; int soff0;
    {
        int ar = m0 + srow;
        if (MODE == 2) { const int b = ar >> 11, t = ar & 2047; ar = b * L + NMETA + t; }
        aoff = (unsigned)ar * LDA + (unsigned)sc * 16u;
        boff = (unsigned)(n0 + srow) * 2048u + (unsigned)sc * 16u;
        soff0 = srow * 128 + ((sc ^ (srow & 7)) << 4);
    }
    const unsigned char* Ab = (const unsigned char*)A; const unsigned char* Bb = (const unsigned char*)Bt;
    f32x4 acc[4][4];
#pragma unroll
    for (int i = 0; i < 4; ++i)
#pragma unroll
        for (int j = 0; j < 4; ++j) acc[i][j] = (f32x4){0.f, 0.f, 0.f, 0.f};
    uint4 ra0, ra1, ra2, ra3, rb0, rb1, rb2, rb3;
#define G_LOAD(KT) { const unsigned ko = (unsigned)(KT) * 128u; \
        ra0 = *(const uint4*)(Ab + (aoff + ko)); ra1 = *(const uint4*)(Ab + (aoff + 32u * LDA + ko)); ra2 = *(const uint4*)(Ab + (aoff + 64u * LDA + ko)); ra3 = *(const uint4*)(Ab + (aoff + 96u * LDA + ko)); \
        rb0 = *(const uint4*)(Bb + (boff + ko)); rb1 = *(const uint4*)(Bb + (boff + 32u * 2048u + ko)); rb2 = *(const uint4*)(Bb + (boff + 64u * 2048u + ko)); rb3 = *(const uint4*)(Bb + (boff + 96u * 2048u + ko)); }
#define G_WRITE(SA, SB) { *(uint4*)((SA) + soff0) = ra0; *(uint4*)((SA) + soff0 + 4096) = ra1; *(uint4*)((SA) + soff0 + 8192) = ra2; *(uint4*)((SA) + soff0 + 12288) = ra3; \
        *(uint4*)((SB) + soff0) = rb0; *(uint4*)((SB) + soff0 + 4096) = rb1; *(uint4*)((SB) + soff0 + 8192) = rb2; *(uint4*)((SB) + soff0 + 12288) = rb3; }
    unsigned char* sA0 = smem; unsigned char* sB0 = smem + 16384; unsigned char* sA1 = smem + 32768; unsigned char* sB1 = smem + 49152;
    G_LOAD(0)
    G_WRITE(sA0, sB0)
    __syncthreads();
    const int arow_off = (wr * 64 + lr) * 128, brow_off = (wc * 64 + lr) * 128, sw = lr & 7;
    G_LOAD(1)
    for (int kt = 0; kt < 16; ++kt) {
        unsigned char* sA = (kt & 1) ? sA1 : sA0; unsigned char* sB = (kt & 1) ? sB1 : sB0;
        unsigned char* nA = (kt & 1) ? sA0 : sA1; unsigned char* nB = (kt & 1) ? sB0 : sB1;
        bf16x8 fa[4], fb[4], ga[4], gb[4];
        const int ch0 = ((g ^ sw) << 4), ch1 = (((4 + g) ^ sw) << 4);
#pragma unroll
        for (int i = 0; i < 4; ++i) { fa[i] = *(const bf16x8*)(sA + arow_off + i * 2048 + ch0); fb[i] = *(const bf16x8*)(sB + brow_off + i * 2048 + ch0); }
        __builtin_amdgcn_sched_barrier(0);
        if (kt < 15) { *(uint4*)(nA + soff0) = ra0; *(uint4*)(nA + soff0 + 4096) = ra1; *(uint4*)(nA + soff0 + 8192) = ra2; *(uint4*)(nA + soff0 + 12288) = ra3; }
        if (kt < 14) { const unsigned ko = (unsigned)(kt + 2) * 128u;
            ra0 = *(const uint4*)(Ab + (aoff + ko)); ra1 = *(const uint4*)(Ab + (aoff + 32u * LDA + ko)); ra2 = *(const uint4*)(Ab + (aoff + 64u * LDA + ko)); ra3 = *(const uint4*)(Ab + (aoff + 96u * LDA + ko)); }
        __builtin_amdgcn_sched_barrier(0);
#pragma unroll
        for (int i = 0; i < 4; ++i) { ga[i] = *(const bf16x8*)(sA + arow_off + i * 2048 + ch1); gb[i] = *(const bf16x8*)(sB + brow_off + i * 2048 + ch1); }
#pragma unroll
        for (int i = 0; i < 4; ++i)
#pragma unroll
            for (int j = 0; j < 4; ++j) acc[i][j] = __builtin_amdgcn_mfma_f32_16x16x32_bf16(fb[j], fa[i], acc[i][j], 0, 0, 0);
        __builtin_amdgcn_sched_barrier(0);
        if (kt < 15) { *(uint4*)(nB + soff0) = rb0; *(uint4*)(nB + soff0 + 4096) = rb1; *(uint4*)(nB + soff0 + 8192) = rb2; *(uint4*)(nB + soff0 + 12288) = rb3; }
        if (kt < 14) { const unsigned ko = (unsigned)(kt + 2) * 128u;
            rb0 = *(const uint4*)(Bb + (boff + ko)); rb1 = *(const uint4*)(Bb + (boff + 32u * 2048u + ko)); rb2 = *(const uint4*)(Bb + (boff + 64u * 2048u + ko)); rb3 = *(const uint4*)(Bb + (boff + 96u * 2048u + ko)); }
        __builtin_amdgcn_sched_barrier(0);
#pragma unroll
        for (int i = 0; i < 4; ++i)
#pragma unroll
            for (int j = 0; j < 4; ++j) acc[i][j] = __builtin_amdgcn_mfma_f32_16x16x32_bf16(gb[j], ga[i], acc[i][j], 0, 0, 0);
        __syncthreads();
    }
#undef G_LOAD
#undef G_WRITE
    if (MODE == 1) {
        if (n0 >= ZC_FQ && n0 < ZC_FV) {
            const bool isk = n0 >= ZC_FK;
            const float* gain = isk ? P.f_k_norm : P.f_q_norm;
            const float scl = isk ? 1.0f : 0.125f * LOG2E;
            float gn[4][4];
#pragma unroll
            for (int j = 0; j < 4; ++j)
#pragma unroll
                for (int r = 0; r < 4; ++r) gn[j][r] = gain[16 * j + 4 * g + r];
#pragma unroll
            for (int i = 0; i < 4; ++i) {
                float ss = 0.f;
#pragma unroll
                for (int j = 0; j < 4; ++j)
#pragma unroll
                    for (int r = 0; r < 4; ++r) ss += acc[i][j][r] * acc[i][j][r];
                ss = x4_sum(ss);
                const float rstd = rsqrtf(ss * (1.0f / 64.0f) + EPS) * scl;
#pragma unroll
                for (int j = 0; j < 4; ++j)
#pragma unroll
                    for (int r = 0; r < 4; ++r) acc[i][j][r] *= rstd * gn[j][r];
            }
        }
        store_tile_bf16(acc, smem, (bf16_t*)(P.ws + WS_Z), NZ, m0, n0, tid, wr, wc, g, lr);
    } else if (MODE == 2) {
        float* ssq = (float*)(P.ws + WS_SSQ);
#pragma unroll
        for (int i = 0; i < 4; ++i) {
            const int row = m0 + wr * 64 + 16 * i + lr;
            float ss = 0.f;
#pragma unroll
            for (int j = 0; j < 4; ++j) {
                const int col = n0 + wc * 64 + 16 * j + 4 * g;
                const float4 xv = *(const float4*)(P.x + (size_t)row * DM + col);
                const float4 gv = *(const float4*)(P.norm_ffn + col);
                float4 hv; hv.x = acc[i][j][0] + xv.x; hv.y = acc[i][j][1] + xv.y; hv.z = acc[i][j][2] + xv.z; hv.w = acc[i][j][3] + xv.w;
                ss += hv.x * hv.x + hv.y * hv.y + hv.z * hv.z + hv.w * hv.w;
                acc[i][j][0] = hv.x * gv.x; acc[i][j][1] = hv.y * gv.y; acc[i][j][2] = hv.z * gv.z; acc[i][j][3] = hv.w * gv.w;
            }
            ss = x4_sum(ss);
            if (g == 0) ssq[(size_t)row * 16 + tn * 2 + wc] = ss;
        }
        store_tile_bf16(acc, smem, (bf16_t*)(P.ws + WS_XN), 1024, m0, n0, tid, wr, wc, g, lr);
    } else {
        const int hp = tn;
        const float* ssq = (const float*)(P.ws + WS_SSQ);
        float rs[4];
#pragma unroll
        for (int i = 0; i < 4; ++i) {
            const int row = m0 + wr * 64 + 16 * i + lr;
            const float4 p0 = *(const float4*)(ssq + (size_t)row * 16), p1 = *(const float4*)(ssq + (size_t)row * 16 + 4);
            const float4 p2 = *(const float4*)(ssq + (size_t)row * 16 + 8), p3 = *(const float4*)(ssq + (size_t)row * 16 + 12);
            const float s = ((p0.x + p0.y) + (p0.z + p0.w)) + ((p1.x + p1.y) + (p1.z + p1.w)) + ((p2.x + p2.y) + (p2.z + p2.w)) + ((p3.x + p3.y) + (p3.z + p3.w));
            rs[i] = rsqrtf(s * (1.0f / DM) + EPS);
            if (tn == 0 && wc == 0 && g == 0) ((float*)(P.ws + WS_RSTD))[row] = rs[i];
        }
        {
            unsigned char* sAq = wc ? sA1 : sA0;
#pragma unroll
            for (int i = 0; i < 4; ++i)
#pragma unroll
                for (int j = 0; j < 4; ++j) {
                    const int row = wr * 64 + 16 * i + lr;
                    const int chunk = 2 * j + (g >> 1);
                    uint2 w; w.x = pk2(acc[i][j][0] * rs[i], acc[i][j][1] * rs[i]); w.y = pk2(acc[i][j][2] * rs[i], acc[i][j][3] * rs[i]);
                    *(uint2*)(sAq + row * 128 + ((chunk ^ (row & 7)) << 4) + 8 * (g & 1)) = w;
                }
            const bf16_t* keys = (const bf16_t*)(P.ws + WS_KEYS) + (size_t)hp * 128 * 128;
#pragma unroll
            for (int j = 0; j < 4; ++j) {
                const int row = srow + 32 * j;
                const uint4 k0 = *(const uint4*)(keys + (size_t)row * 128 + sc * 8);
                const uint4 k1 = *(const uint4*)(keys + (size_t)row * 128 + 64 + sc * 8);
                *(uint4*)(sB0 + soff0 + j * 4096) = k0; *(uint4*)(sB1 + soff0 + j * 4096) = k1;
            }
        }
        __syncthreads();
#pragma unroll
        for (int i = 0; i < 4; ++i)
#pragma unroll
            for (int j = 0; j < 4; ++j) acc[i][j] = (f32x4){0.f, 0.f, 0.f, 0.f};
        mma_ktile(sA0, sB0, arow_off, brow_off, g, sw, acc);
        mma_ktile(sA1, sB1, arow_off, brow_off, g, sw, acc);
        __syncthreads();
#pragma unroll
        for (int i = 0; i < 4; ++i)
#pragma unroll
            for (int j = 0; j < 4; ++j) {
                const int row = wr * 64 + 16 * i + lr;
                const int c4 = wc * 16 + 4 * j + g;
                *(f32x4*)(smem + row * 512 + ((c4 ^ (row & 31)) << 4)) = acc[i][j];
            }
        __syncthreads();
        unsigned top[16];
        const int row = tid & 127, half = tid >> 7;
        {
            auto load_keys = [&](unsigned (&dst)[16], int q4) {
#pragma unroll
                for (int s4 = 0; s4 < 4; ++s4) {
                    const int c4 = half * 16 + q4 * 4 + s4;
                    const f32x4 v = *(const f32x4*)(smem + row * 512 + ((c4 ^ (row & 31)) << 4));
#pragma unroll
                    for (int e = 0; e < 4; ++e) dst[s4 * 4 + e] = (ord_key(v[e]) & ~127u) | (unsigned)(127 - (c4 * 4 + e));
                }
            };
            load_keys(top, 0);
            bitonic_sort16_desc(top);
#pragma unroll 1
            for (int q4 = 1; q4 < 4; ++q4) {
                unsigned gq[16];
                load_keys(gq, q4);
                bitonic_sort16_desc(gq);
                bitonic_merge16_top(top, gq);
            }
        }
        __syncthreads();
        if (half) {
            uint4* lp = (uint4*)(smem + row * 64);
            lp[0] = make_uint4(top[0], top[1], top[2], top[3]); lp[1] = make_uint4(top[4], top[5], top[6], top[7]);
            lp[2] = make_uint4(top[8], top[9], top[10], top[11]); lp[3] = make_uint4(top[12], top[13], top[14], top[15]);
        }
        __syncthreads();
        if (!half) {
            const uint4* lp = (const uint4*)(smem + row * 64);
            unsigned other[16];
#pragma unroll
            for (int c = 0; c < 4; ++c) { const uint4 o = lp[c]; other[4 * c] = o.x; other[4 * c + 1] = o.y; other[4 * c + 2] = o.z; other[4 * c + 3] = o.w; }
            bitonic_merge16_top(top, other);
            uint4* tk = (uint4*)((unsigned*)(P.ws + WS_TK) + ((size_t)(m0 + row) * 16 + hp) * 16);
            tk[0] = make_uint4(top[0], top[1], top[2], top[3]); tk[1] = make_uint4(top[4], top[5], top[6], top[7]);
            tk[2] = make_uint4(top[8], top[9], top[10], top[11]); tk[3] = make_uint4(top[12], top[13], top[14], top[15]);
        }
        __syncthreads();
    }
}

__device__ __forceinline__ void fox_cum_wave(const Params& P, int bh, int lane) {
    const int b = bh >> 3, h = bh & 7;
    const float* gates = (const float*)(P.ws + WS_GATES);
    float* cum = (float*)(P.ws + WS_CUM) + (size_t)bh * L;
    constexpr int SEG = 33;
    const int t0 = lane * SEG;
    float loc = 0.f;
    for (int i = 0; i < SEG; ++i) { const int t = t0 + i; if (t < L) loc += gates[(size_t)(b * L + t) * 16 + 8 + h]; }
    float incl = loc;
#pragma unroll
    for (int o = 1; o < 64; o <<= 1) { const float n = __shfl_up(incl, o, 64); if (lane >= o) incl += n; }
    float run = incl - loc;
    for (int i = 0; i < SEG; ++i) { const int t = t0 + i; if (t < L) { run += gates[(size_t)(b * L + t) * 16 + 8 + h]; cum[t] = run * LOG2E; } }
}

#define TR_SLOW 0

__device__ __forceinline__ int vimg_off(int row, int ch) { return row * 128 + ((ch ^ (((row >> 1) & 3) << 1)) << 4); }
__device__ __forceinline__ uint2 tr_frag(const unsigned char* img, int row0, int c, int g, int lr) {
#if TR_SLOW
    unsigned short e[4];
#pragma unroll
    for (int k = 0; k < 4; ++k) { const int row = row0 + 4 * g + k, col = 16 * c + lr; e[k] = *(const unsigned short*)(img + vimg_off(row, col >> 3) + (col & 7) * 2); }
    uint2 r; r.x = (unsigned)e[0] | ((unsigned)e[1] << 16); r.y = (unsigned)e[2] | ((unsigned)e[3] << 16); return r;
#else
    const int q = lr >> 2, p = lr & 3, row = row0 + 4 * g + q;
    const unsigned addr = (unsigned)(size_t)(img + vimg_off(row, 2 * c + (p >> 1)) + 8 * (p & 1));
    uint2 r;
    asm volatile("ds_read_b64_tr_b16 %0, %1\n\ts_waitcnt lgkmcnt(0)" : "=&v"(r) : "v"(addr) : "memory");
    return r;
#endif
}

__device__ __forceinline__ unsigned tr_lane_addr(const unsigned char* img, int c, int g, int lr) {
    const int q = lr >> 2, p = lr & 3, row = 4 * g + q;
    return (unsigned)(size_t)(img + vimg_off(row, 2 * c + (p >> 1)) + 8 * (p & 1));
}
#define TR_GROUP(o0, o1, o2, o3, a) "ds_read_b64_tr_b16 %" #o0 ", %" #a "\n\tds_read_b64_tr_b16 %" #o1 ", %" #a " offset:2048\n\tds_read_b64_tr_b16 %" #o2 ", %" #a " offset:4096\n\tds_read_b64_tr_b16 %" #o3 ", %" #a " offset:6144\n\t"
__device__ __forceinline__ void tr_read_4c(const unsigned char* img, int g, int lr, uint2 (&r)[4][4]) {
    const unsigned a0 = tr_lane_addr(img, 0, g, lr), a1 = tr_lane_addr(img, 1, g, lr), a2 = tr_lane_addr(img, 2, g, lr), a3 = tr_lane_addr(img, 3, g, lr);
    asm volatile(TR_GROUP(0, 1, 2, 3, 16) TR_GROUP(4, 5, 6, 7, 17) TR_GROUP(8, 9, 10, 11, 18) TR_GROUP(12, 13, 14, 15, 19) "s_waitcnt lgkmcnt(0)"
        : "=&v"(r[0][0]), "=&v"(r[0][1]), "=&v"(r[0][2]), "=&v"(r[0][3]), "=&v"(r[1][0]), "=&v"(r[1][1]), "=&v"(r[1][2]), "=&v"(r[1][3]),
          "=&v"(r[2][0]), "=&v"(r[2][1]), "=&v"(r[2][2]), "=&v"(r[2][3]), "=&v"(r[3][0]), "=&v"(r[3][1]), "=&v"(r[3][2]), "=&v"(r[3][3])
        : "v"(a0), "v"(a1), "v"(a2), "v"(a3) : "memory");
}
__device__ __forceinline__ void tr_read_3c(const unsigned char* img, int g, int lr, uint2 (&r)[3][4]) {
    const unsigned a0 = tr_lane_addr(img, 0, g, lr), a1 = tr_lane_addr(img, 1, g, lr), a2 = tr_lane_addr(img, 2, g, lr);
    asm volatile(TR_GROUP(0, 1, 2, 3, 12) TR_GROUP(4, 5, 6, 7, 13) TR_GROUP(8, 9, 10, 11, 14) "s_waitcnt lgkmcnt(0)"
        : "=&v"(r[0][0]), "=&v"(r[0][1]), "=&v"(r[0][2]), "=&v"(r[0][3]), "=&v"(r[1][0]), "=&v"(r[1][1]), "=&v"(r[1][2]), "=&v"(r[1][3]),
          "=&v"(r[2][0]), "=&v"(r[2][1]), "=&v"(r[2][2]), "=&v"(r[2][3])
        : "v"(a0), "v"(a1), "v"(a2) : "memory");
}
__device__ __forceinline__ void tr_read_2(const unsigned char* img0, int c0, const unsigned char* img1, int c1, int g, int lr, uint2 (&r)[2][4]) {
    const unsigned a0 = tr_lane_addr(img0, c0, g, lr), a1 = tr_lane_addr(img1, c1, g, lr);
    asm volatile(TR_GROUP(0, 1, 2, 3, 8) TR_GROUP(4, 5, 6, 7, 9) "s_waitcnt lgkmcnt(0)"
        : "=&v"(r[0][0]), "=&v"(r[0][1]), "=&v"(r[0][2]), "=&v"(r[0][3]), "=&v"(r[1][0]), "=&v"(r[1][1]), "=&v"(r[1][2]), "=&v"(r[1][3])
        : "v"(a0), "v"(a1) : "memory");
}
__device__ __forceinline__ bf16x8 tr_pair(const uint2& lo, const uint2& hi) { uint4 u; u.x = lo.x; u.y = lo.y; u.z = hi.x; u.w = hi.y; return __builtin_bit_cast(bf16x8, u); }

__device__ __forceinline__ void attn_block(const Params& P, int bh, int qb, unsigned char* smem) {
    const int tid = opaque_tid(), lane = tid & 63, w = tid >> 6, g = lane >> 4, lr = lane & 15;
    const int b = bh >> 3, h = bh & 7;
    const bf16_t* z = (const bf16_t*)(P.ws + WS_Z);
    const float* cum = (const float*)(P.ws + WS_CUM) + (size_t)bh * L;
    int tq[2]; bool qvalid[2]; bf16x8 qf[2][2];
#pragma unroll
    for (int u = 0; u < 2; ++u) {
        tq[u] = qb * 128 + 32 * w + 16 * u + lr;
        qvalid[u] = tq[u] < L;
        const bf16_t* qp = z + (size_t)(b * L + (qvalid[u] ? tq[u] : 0)) * NZ + ZC_FQ + h * 64 + 8 * g;
        qf[u][0] = *(const bf16x8*)(qp); qf[u][1] = *(const bf16x8*)(qp + 32);
    }
    const int nkv = (2 * qb + 2 < 33) ? 2 * qb + 2 : 33;
    const int srow0 = tid >> 3, sch = tid & 7;
    uint4 rk[2], rv[2]; float rc = 0.f;
    auto load_tile = [&](int kv) {
#pragma unroll
        for (int j = 0; j < 2; ++j) {
            const int key = kv * 64 + srow0 + 32 * j;
            if (key < L) {
                const bf16_t* p = z + (size_t)(b * L + key) * NZ + h * 64 + sch * 8;
                rk[j] = *(const uint4*)(p + ZC_FK); rv[j] = *(const uint4*)(p + ZC_FV);
            } else { rk[j] = make_uint4(0, 0, 0, 0); rv[j] = make_uint4(0, 0, 0, 0); }
        }
        if (tid < 64) { const int key = kv * 64 + tid; rc = key < L ? cum[key] : 0.f; }
    };
    auto store_tile = [&](int buf) {
        unsigned char* sK = smem + buf * 16384; unsigned char* sV = sK + 8192;
#pragma unroll
        for (int j = 0; j < 2; ++j) {
            const int row = srow0 + 32 * j;
            *(uint4*)(sK + row * 128 + ((sch ^ (row & 7)) << 4)) = rk[j];
            *(uint4*)(sV + vimg_off(row, sch)) = rv[j];
        }
        if (tid < 64) ((float*)(smem + 32768 + buf * 256))[tid] = rc;
    };
    float m[2] = {-1e30f, -1e30f};
    f32x4 o[2][5];
#pragma unroll
    for (int u = 0; u < 2; ++u)
#pragma unroll
        for (int c = 0; c < 5; ++c) o[u][c] = (f32x4){0.f, 0.f, 0.f, 0.f};
    const unsigned onew = (lr == 0) ? 0x3F803F80u : 0u;
    const bf16x8 vones = __builtin_bit_cast(bf16x8, make_uint4(onew, onew, onew, onew));
    load_tile(nkv - 1); store_tile((nkv - 1) & 1);
    __syncthreads();
    for (int kv = nkv - 1; kv >= 0; --kv) {
        const int buf = kv & 1;
        if (kv > 0) load_tile(kv - 1);
        const unsigned char* sK = smem + buf * 16384; const unsigned char* sV = sK + 8192;
        const float* sck = (const float*)(smem + 32768 + buf * 256);
        f32x4 sa[2][4];
#pragma unroll
        for (int c = 0; c < 4; ++c) {
            sa[0][c] = (f32x4){0.f, 0.f, 0.f, 0.f}; sa[1][c] = (f32x4){0.f, 0.f, 0.f, 0.f};
#pragma unroll
            for (int s = 0; s < 2; ++s) {
                const bf16x8 kf = *(const bf16x8*)(sK + (16 * c + lr) * 128 + (((4 * s + g) ^ (lr & 7)) << 4));
                sa[0][c] = __builtin_amdgcn_mfma_f32_16x16x32_bf16(kf, qf[0][s], sa[0][c], 0, 0, 0);
                sa[1][c] = __builtin_amdgcn_mfma_f32_16x16x32_bf16(kf, qf[1][s], sa[1][c], 0, 0, 0);
            }
        }
        if (kv >= 2 * qb) {
#pragma unroll
            for (int u = 0; u < 2; ++u)
#pragma unroll
                for (int c = 0; c < 4; ++c)
#pragma unroll
                    for (int r = 0; r < 4; ++r)
                        if (64 * kv + 16 * c + 4 * g + r > tq[u]) sa[u][c][r] = -INFINITY;
        }
        f32x4 ck[4];
#pragma unroll
        for (int c = 0; c < 4; ++c) ck[c] = *(const f32x4*)(sck + 16 * c + 4 * g);
        bf16x8 pf[2][2];
#pragma unroll
        for (int u = 0; u < 2; ++u) {
            float mx = -INFINITY;
#pragma unroll
            for (int c = 0; c < 4; ++c) {
                sa[u][c] -= ck[c];
                mx = fmaxf(mx, fmaxf(fmaxf(sa[u][c][0], sa[u][c][1]), fmaxf(sa[u][c][2], sa[u][c][3])));
            }
            mx = x4_max(mx);
            if (__builtin_amdgcn_ballot_w64(mx > m[u]) != 0ull) {
                const float mn = fmaxf(m[u], mx);
                const float alpha = __builtin_amdgcn_exp2f(m[u] - mn);
                m[u] = mn;
#pragma unroll
                for (int c = 0; c < 5; ++c) o[u][c] *= alpha;
            }
            const float mn = m[u];
#pragma unroll
            for (int c = 0; c < 4; ++c)
#pragma unroll
                for (int r = 0; r < 4; ++r) sa[u][c][r] = __builtin_amdgcn_exp2f(sa[u][c][r] - mn);
#pragma unroll
            for (int s2 = 0; s2 < 2; ++s2) {
                uint4 uu;
                uu.x = cvt_pk_bf16(sa[u][2 * s2][0], sa[u][2 * s2][1]); uu.y = cvt_pk_bf16(sa[u][2 * s2][2], sa[u][2 * s2][3]);
                uu.z = cvt_pk_bf16(sa[u][2 * s2 + 1][0], sa[u][2 * s2 + 1][1]); uu.w = cvt_pk_bf16(sa[u][2 * s2 + 1][2], sa[u][2 * s2 + 1][3]);
                pf[u][s2] = __builtin_bit_cast(bf16x8, uu);
            }
        }
        {
            uint2 vr[4][4];
            tr_read_4c(sV, g, lr, vr);
#pragma unroll
            for (int c = 0; c < 4; ++c)
#pragma unroll
                for (int s2 = 0; s2 < 2; ++s2) {
                    const bf16x8 vf = tr_pair(vr[c][2 * s2], vr[c][2 * s2 + 1]);
                    o[0][c] = __builtin_amdgcn_mfma_f32_16x16x32_bf16(vf, pf[0][s2], o[0][c], 0, 0, 0);
                    o[1][c] = __builtin_amdgcn_mfma_f32_16x16x32_bf16(vf, pf[1][s2], o[1][c], 0, 0, 0);
                }
#pragma unroll
            for (int s2 = 0; s2 < 2; ++s2) {
                o[0][4] = __builtin_amdgcn_mfma_f32_16x16x32_bf16(vones, pf[0][s2], o[0][4], 0, 0, 0);
                o[1][4] = __builtin_amdgcn_mfma_f32_16x16x32_bf16(vones, pf[1][s2], o[1][4], 0, 0, 0);
            }
        }
        if (kv > 0) store_tile(buf ^ 1);
        __syncthreads();
    }
#pragma unroll
    for (int u = 0; u < 2; ++u) {
        const float ls = __shfl(o[u][4][0], lr, 64);
        const float inv = 1.0f / ls;
        if (qvalid[u]) {
            bf16_t* y = (bf16_t*)(P.ws + WS_Z) + (size_t)(b * L + tq[u]) * NZ + 512 + h * 64 + 4 * g;
#pragma unroll
            for (int c = 0; c < 4; ++c) {
                uint2 uu; uu.x = pk2(o[u][c][0] * inv, o[u][c][1] * inv); uu.y = pk2(o[u][c][2] * inv, o[u][c][3] * inv);
                *(uint2*)(y + 16 * c) = uu;
            }
        }
    }
}

__device__ __forceinline__ void conv_item(const Params& P, int ci) {
    const int tid = opaque_tid(), cc = tid & 127, rg = tid >> 7;
    const bf16_t* z = (const bf16_t*)(P.ws + WS_Z);
    bf16_t* qk = (bf16_t*)(P.ws + WS_RA);
    const int col0 = cc * 8;
    float w[4][8];
#pragma unroll
    for (int j = 0; j < 4; ++j) {
        const float4 a = *(const float4*)(P.conv_qk + j * 1024 + col0), b = *(const float4*)(P.conv_qk + j * 1024 + col0 + 4);
        w[j][0] = a.x; w[j][1] = a.y; w[j][2] = a.z; w[j][3] = a.w; w[j][4] = b.x; w[j][5] = b.y; w[j][6] = b.z; w[j][7] = b.w;
    }
    const float oscale = (col0 >= 512) ? 0.08838834764831845f : 1.0f;
    const int r0 = ci * 64 + rg * 32;
    int t = r0 % L;
    float xw[3][8];
#pragma unroll
    for (int j = 0; j < 3; ++j) {
        const int back = 3 - j;
        if (t - back >= 0) {
            const uint4 v = *(const uint4*)(z + (size_t)(r0 - back) * NZ + col0);
            xw[j][0] = bflo(v.x); xw[j][1] = bfhi(v.x); xw[j][2] = bflo(v.y); xw[j][3] = bfhi(v.y); xw[j][4] = bflo(v.z); xw[j][5] = bfhi(v.z); xw[j][6] = bflo(v.w); xw[j][7] = bfhi(v.w);
        } else {
#pragma unroll
            for (int e = 0; e < 8; ++e) xw[j][e] = 0.f;
        }
    }
#pragma unroll 2
    for (int i = 0; i < 32; ++i) {
        const int r = r0 + i;
        if (t == 0) {
#pragma unroll
            for (int j = 0; j < 3; ++j)
#pragma unroll
                for (int e = 0; e < 8; ++e) xw[j][e] = 0.f;
        }
        const uint4 v = *(const uint4*)(z + (size_t)r * NZ + col0);
        float xt[8];
        xt[0] = bflo(v.x); xt[1] = bfhi(v.x); xt[2] = bflo(v.y); xt[3] = bfhi(v.y); xt[4] = bflo(v.z); xt[5] = bfhi(v.z); xt[6] = bflo(v.w); xt[7] = bfhi(v.w);
        float o[8];
#pragma unroll
        for (int e = 0; e < 8; ++e) {
            const float cv = w[0][e] * xw[0][e] + w[1][e] * xw[1][e] + w[2][e] * xw[2][e] + w[3][e] * xt[e];
            o[e] = oscale * cv / (1.f + __expf(-cv));
            xw[0][e] = xw[1][e]; xw[1][e] = xw[2][e]; xw[2][e] = xt[e];
        }
        uint4 ov; ov.x = pk2(o[0], o[1]); ov.y = pk2(o[2], o[3]); ov.z = pk2(o[4], o[5]); ov.w = pk2(o[6], o[7]);
        *(uint4*)(qk + (size_t)r * 1024 + col0) = ov;
        t = (t + 1 == L) ? 0 : t + 1;
    }
}

constexpr int ST_IMG = 36864;
__device__ __forceinline__ int st_piece_off(int jt, int c, int g, int lr) { return (jt >> 2) * 18432 + vimg_off(16 * c + lr, 2 * (jt & 3) + (g >> 1)) + 8 * (g & 1); }

__device__ __forceinline__ void mlstm_stage_kv(const Params& P, int b, int h, int k, unsigned char* sKimg, unsigned char* sVimg, int tid) {
    const bf16_t* z = (const bf16_t*)(P.ws + WS_Z);
    const bf16_t* qk = (const bf16_t*)(P.ws + WS_RA);
    uint4 pk_[4], pv_[4];
#pragma unroll
    for (int j = 0; j < 4; ++j) {
        const int id = tid + 256 * j, row = id >> 4, ch16 = id & 15, pos = 64 * k + row;
        const bool ok = pos < L;
        pk_[j] = ok ? *(const uint4*)(qk + (size_t)(b * L + pos) * 1024 + 512 + h * 128 + ch16 * 8) : make_uint4(0, 0, 0, 0);
        pv_[j] = ok ? *(const uint4*)(z + (size_t)(b * L + pos) * NZ + ZC_MV + h * 128 + ch16 * 8) : make_uint4(0, 0, 0, 0);
    }
#pragma unroll
    for (int j = 0; j < 4; ++j) {
        const int id = tid + 256 * j, row = id >> 4, ch16 = id & 15;
        *(uint4*)(sKimg + (ch16 >> 3) * 8192 + vimg_off(row, ch16 & 7)) = pk_[j];
        *(uint4*)(sVimg + (ch16 >> 3) * 8192 + vimg_off(row, ch16 & 7)) = pv_[j];
    }
    if (tid < 128) {
        const int row = tid >> 1, ch = tid & 1;
        *(uint4*)(sVimg + 16384 + vimg_off(row, ch)) = ch ? make_uint4(0, 0, 0, 0) : make_uint4(0x3F80u, 0, 0, 0);
    }
}

__device__ __forceinline__ void mlstm_stage_A(const Params& P, int b, int h, int k, unsigned char* sKimg, unsigned char* sVimg, int tid) {
    const bf16_t* z = (const bf16_t*)(P.ws + WS_Z);
    bf16_t* qk = (bf16_t*)(P.ws + WS_RA);
    uint4 pv_[4];
#pragma unroll
    for (int j = 0; j < 4; ++j) {
        const int id = tid + 256 * j, row = id >> 4, ch16 = id & 15, pos = 64 * k + row;
        pv_[j] = (pos < L) ? *(const uint4*)(z + (size_t)(b * L + pos) * NZ + ZC_MV + h * 128 + ch16 * 8) : make_uint4(0, 0, 0, 0);
    }
    const int cch = tid & 31, rg = tid >> 5, isk = cch >> 4;
    const int zcol = (isk ? ZC_MK : ZC_MQ) + h * 128 + (cch & 15) * 8;
    float w[4][8];
#pragma unroll
    for (int j = 0; j < 4; ++j) {
        const float4 a = *(const float4*)(P.conv_qk + j * 1024 + zcol), c = *(const float4*)(P.conv_qk + j * 1024 + zcol + 4);
        w[j][0] = a.x; w[j][1] = a.y; w[j][2] = a.z; w[j][3] = a.w; w[j][4] = c.x; w[j][5] = c.y; w[j][6] = c.z; w[j][7] = c.w;
    }
    const float oscale = isk ? 0.08838834764831845f : 1.0f;
    const int p0 = 64 * k + 8 * rg;
    uint4 raw[11];
#pragma unroll
    for (int i = 0; i < 11; ++i) {
        const int pos = p0 - 3 + i;
        raw[i] = (pos >= 0 && pos < L) ? *(const uint4*)(z + (size_t)(b * L + pos) * NZ + zcol) : make_uint4(0, 0, 0, 0);
    }
#pragma unroll
    for (int j = 0; j < 4; ++j) {
        const int id = tid + 256 * j, row = id >> 4, ch16 = id & 15;
        *(uint4*)(sVimg + (ch16 >> 3) * 8192 + vimg_off(row, ch16 & 7)) = pv_[j];
    }
    if (tid < 128) {
        const int row = tid >> 1, ch = tid & 1;
        *(uint4*)(sVimg + 16384 + vimg_off(row, ch)) = ch ? make_uint4(0, 0, 0, 0) : make_uint4(0x3F80u, 0, 0, 0);
    }
#pragma unroll
    for (int i = 0; i < 8; ++i) {
        const int pos = p0 + i, row = 8 * rg + i;
        float o[8];
#pragma unroll
        for (int e = 0; e < 8; ++e) {
            const unsigned w0 = (&raw[i].x)[e >> 1], w1 = (&raw[i + 1].x)[e >> 1], w2 = (&raw[i + 2].x)[e >> 1], w3 = (&raw[i + 3].x)[e >> 1];
            const float x0 = (e & 1) ? bfhi(w0) : bflo(w0), x1 = (e & 1) ? bfhi(w1) : bflo(w1), x2 = (e & 1) ? bfhi(w2) : bflo(w2), x3 = (e & 1) ? bfhi(w3) : bflo(w3);
            const float cv = w[0][e] * x0 + w[1][e] * x1 + w[2][e] * x2 + w[3][e] * x3;
            o[e] = oscale * cv / (1.f + __expf(-cv));
        }
        uint4 ov; ov.x = pk2(o[0], o[1]); ov.y = pk2(o[2], o[3]); ov.z = pk2(o[4], o[5]); ov.w = pk2(o[6], o[7]);
        const bool ok = pos < L;
        if (!ok) ov = make_uint4(0, 0, 0, 0);
        if (ok) *(uint4*)(qk + (size_t)(b * L + pos) * 1024 + (isk ? 512 : 0) + h * 128 + (cch & 15) * 8) = ov;
        if (isk) { const int ch16 = cch & 15; *(uint4*)(sKimg + (ch16 >> 3) * 8192 + vimg_off(row, ch16 & 7)) = ov; }
    }
}

__device__ __forceinline__ void mlstm_A(const Params& P, int item, unsigned char* smem) {
    const int tid = opaque_tid(), lane = tid & 63, w = tid >> 6, g = lane >> 4, lr = lane & 15;
    const int wu = __builtin_amdgcn_readfirstlane(w);
    const int k = item >> 5, bh = item & 31, b = bh >> 2, h = bh & 3;
    const float* gates = (const float*)(P.ws + WS_GATES);
    const unsigned char* sK = smem; const unsigned char* sV = smem + 16384;
    float* ga = (float*)(smem + 40960);
    mlstm_stage_A(P, b, h, k, smem, smem + 16384, tid);
    if (wu == 0) {
        const int pos = 64 * k + lane;
        float lf = 0.f, li = -INFINITY;
        if (pos < L) { lf = gates[(size_t)(b * L + pos) * 16 + 4 + h]; li = gates[(size_t)(b * L + pos) * 16 + h]; }
        float bc = lf;
#pragma unroll
        for (int o = 1; o < 64; o <<= 1) { const float n = __shfl_up(bc, o, 64); if (lane >= o) bc += n; }
        const float a = li - bc;
        const float A = wave_max(a);
        ga[lane] = __expf(a - A);
        if (lane == 63) { float* msc = (float*)(P.ws + WS_MSC) + ((size_t)bh * 33 + k) * 4; msc[0] = A; msc[1] = bc; }
    }
    __syncthreads();
    f32x4 Ct[2][9];
#pragma unroll
    for (int a = 0; a < 2; ++a)
#pragma unroll
        for (int c = 0; c < 9; ++c) Ct[a][c] = (f32x4){0.f, 0.f, 0.f, 0.f};
    bf16x8 kt[2][2];
#pragma unroll
    for (int a = 0; a < 2; ++a)
#pragma unroll
        for (int s2 = 0; s2 < 2; ++s2) {
            const int jt = 2 * w + a;
            kt[a][s2] = tr_pair(tr_frag(sK + (jt >> 2) * 8192, 32 * s2, jt & 3, g, lr), tr_frag(sK + (jt >> 2) * 8192, 32 * s2 + 16, jt & 3, g, lr));
        }
    f32x4 wg4[4];
#pragma unroll
    for (int j = 0; j < 4; ++j) wg4[j] = *(const f32x4*)(ga + 16 * j + 4 * g);
#define MA_TILE(c, lo0, hi0, lo1, hi1) { \
        { const f32x4 w0 = wg4[0], w1 = wg4[1]; uint4 o; \
          o.x = cvt_pk_bf16(bflo(lo0.x) * w0[0], bfhi(lo0.x) * w0[1]); o.y = cvt_pk_bf16(bflo(lo0.y) * w0[2], bfhi(lo0.y) * w0[3]); \
          o.z = cvt_pk_bf16(bflo(hi0.x) * w1[0], bfhi(hi0.x) * w1[1]); o.w = cvt_pk_bf16(bflo(hi0.y) * w1[2], bfhi(hi0.y) * w1[3]); \
          const bf16x8 vw = __builtin_bit_cast(bf16x8, o); \
          Ct[0][c] = __builtin_amdgcn_mfma_f32_16x16x32_bf16(kt[0][0], vw, Ct[0][c], 0, 0, 0); Ct[1][c] = __builtin_amdgcn_mfma_f32_16x16x32_bf16(kt[1][0], vw, Ct[1][c], 0, 0, 0); } \
        { const f32x4 w0 = wg4[2], w1 = wg4[3]; uint4 o; \
          o.x = cvt_pk_bf16(bflo(lo1.x) * w0[0], bfhi(lo1.x) * w0[1]); o.y = cvt_pk_bf16(bflo(lo1.y) * w0[2], bfhi(lo1.y) * w0[3]); \
          o.z = cvt_pk_bf16(bflo(hi1.x) * w1[0], bfhi(hi1.x) * w1[1]); o.w = cvt_pk_bf16(bflo(hi1.y) * w1[2], bfhi(hi1.y) * w1[3]); \
          const bf16x8 vw = __builtin_bit_cast(bf16x8, o); \
          Ct[0][c] = __builtin_amdgcn_mfma_f32_16x16x32_bf16(kt[0][1], vw, Ct[0][c], 0, 0, 0); Ct[1][c] = __builtin_amdgcn_mfma_f32_16x16x32_bf16(kt[1][1], vw, Ct[1][c], 0, 0, 0); } }
    {
        uint2 vr[4][4];
        tr_read_4c(sV, g, lr, vr);
        MA_TILE(0, vr[0][0], vr[0][1], vr[0][2], vr[0][3]) MA_TILE(1, vr[1][0], vr[1][1], vr[1][2], vr[1][3])
        MA_TILE(2, vr[2][0], vr[2][1], vr[2][2], vr[2][3]) MA_TILE(3, vr[3][0], vr[3][1], vr[3][2], vr[3][3])
        tr_read_4c(sV + 8192, g, lr, vr);
        MA_TILE(4, vr[0][0], vr[0][1], vr[0][2], vr[0][3]) MA_TILE(5, vr[1][0], vr[1][1], vr[1][2], vr[1][3])
        MA_TILE(6, vr[2][0], vr[2][1], vr[2][2], vr[2][3]) MA_TILE(7, vr[3][0], vr[3][1], vr[3][2], vr[3][3])
        const uint2 o0 = tr_frag(sV + 16384, 0, 0, g, lr), o1 = tr_frag(sV + 16384, 16, 0, g, lr), o2 = tr_frag(sV + 16384, 32, 0, g, lr), o3 = tr_frag(sV + 16384, 48, 0, g, lr);
        MA_TILE(8, o0, o1, o2, o3)
    }
#undef MA_TILE
    unsigned char* slot = P.ws + WS_MST + ((size_t)bh * 33 + k) * ST_IMG;
#pragma unroll
    for (int a = 0; a < 2; ++a)
#pragma unroll
        for (int c = 0; c < 9; ++c) {
            uint2 u; u.x = cvt_pk_bf16(Ct[a][c][0], Ct[a][c][1]); u.y = cvt_pk_bf16(Ct[a][c][2], Ct[a][c][3]);
            *(uint2*)(slot + st_piece_off(2 * w + a, c, g, lr)) = u;
        }
}

__device__ __forceinline__ void mlstm_B(const Params& P, int item) {
    const int tid = opaque_tid();
    const int bh = item / 3, part = item - bh * 3;
    const unsigned char* base = P.ws + WS_MST + (size_t)bh * 33 * ST_IMG + part * 12288 + tid * 48;
    unsigned char* obase = P.ws + WS_CBI + (size_t)bh * 33 * ST_IMG + part * 12288 + tid * 48;
    float* msc = (float*)(P.ws + WS_MSC) + (size_t)bh * 33 * 4;
    float C[6][4];
#pragma unroll
    for (int i = 0; i < 6; ++i)
#pragma unroll
        for (int r = 0; r < 4; ++r) C[i][r] = 0.f;
    float m = 0.f;
    uint2 d0[6], d1[6];
    float2 ab0, ab1;
#pragma unroll
    for (int i = 0; i < 6; ++i) { d0[i] = *(const uint2*)(base + i * 8); d1[i] = *(const uint2*)(base + ST_IMG + i * 8); }
    ab0 = *(const float2*)(msc); ab1 = *(const float2*)(msc + 4);
    for (int k = 0; k < 33; ++k) {
        uint2 d2[6]; float2 ab2 = make_float2(0.f, 0.f);
        if (k + 2 < 33) {
#pragma unroll
            for (int i = 0; i < 6; ++i) d2[i] = *(const uint2*)(base + (size_t)(k + 2) * ST_IMG + i * 8);
            ab2 = *(const float2*)(msc + (k + 2) * 4);
        } else {
#pragma unroll
            for (int i = 0; i < 6; ++i) d2[i] = make_uint2(0, 0);
        }
#pragma unroll
        for (int i = 0; i < 6; ++i) {
            uint2 u; u.x = cvt_pk_bf16(C[i][0], C[i][1]); u.y = cvt_pk_bf16(C[i][2], C[i][3]);
            *(uint2*)(obase + (size_t)k * ST_IMG + i * 8) = u;
        }
        if (tid == 0 && part == 0) msc[k * 4 + 2] = m;
        const float M = fmaxf(m, ab0.x);
        const float decay = __expf(m - M), sc = __expf(ab0.x - M);
#pragma unroll
        for (int i = 0; i < 6; ++i) {
            C[i][0] = decay * C[i][0] + sc * bflo(d0[i].x); C[i][1] = decay * C[i][1] + sc * bfhi(d0[i].x);
            C[i][2] = decay * C[i][2] + sc * bflo(d0[i].y); C[i][3] = decay * C[i][3] + sc * bfhi(d0[i].y);
        }
        m = ab0.y + M;
#pragma unroll
        for (int i = 0; i < 6; ++i) { d0[i] = d1[i]; d1[i] = d2[i]; }
        ab0 = ab1; ab1 = ab2;
    }
}

__device__ __forceinline__ void mlstm_C(const Params& P, int item, unsigned char* smem) {
    const int tid = opaque_tid(), lane = tid & 63, w = tid >> 6, g = lane >> 4, lr = lane & 15;
    const int wu = __builtin_amdgcn_readfirstlane(w);
    const int k = item >> 5, bh = item & 31, b = bh >> 2, h = bh & 3;
    const bf16_t* z = (const bf16_t*)(P.ws + WS_Z);
    const bf16_t* qk = (const bf16_t*)(P.ws + WS_RA);
    const float* gates = (const float*)(P.ws + WS_GATES);
    bf16_t* y = (bf16_t*)(P.ws + WS_Z);
    const unsigned char* sK = smem; const unsigned char* sV = smem + 36864; unsigned char* sCb = smem;
    float* ga = (float*)(smem + 61440);
    const int pos = 64 * k + 16 * w + lr;
    const bool tvalid = pos < L;
    const size_t rrow = (size_t)(b * L + (tvalid ? pos : 0));
    const unsigned char* cslot = P.ws + WS_CBI + ((size_t)bh * 33 + k) * ST_IMG + tid * 16;
    const uint4 cb0 = *(const uint4*)(cslot), cb1 = *(const uint4*)(cslot + 4096), cb2 = *(const uint4*)(cslot + 8192), cb3 = *(const uint4*)(cslot + 12288), cb4 = *(const uint4*)(cslot + 16384),
                cb5 = *(const uint4*)(cslot + 20480), cb6 = *(const uint4*)(cslot + 24576), cb7 = *(const uint4*)(cslot + 28672), cb8 = *(const uint4*)(cslot + 32768);
    bf16x8 qf[4];
    {
        const bf16_t* qp = qk + rrow * 1024 + h * 128 + 8 * g;
#pragma unroll
        for (int ks = 0; ks < 4; ++ks) { qf[ks] = *(const bf16x8*)(qp + 32 * ks); if (!tvalid) qf[ks] = (bf16x8){0, 0, 0, 0, 0, 0, 0, 0}; }
    }
    mlstm_stage_kv(P, b, h, k, smem, smem + 36864, tid);
    if (wu == 0) {
        const float m_prev = ((const float*)(P.ws + WS_MSC))[((size_t)bh * 33 + k) * 4 + 2];
        const int p2 = 64 * k + lane;
        float lf = 0.f, li = -INFINITY;
        if (p2 < L) { lf = gates[(size_t)(b * L + p2) * 16 + 4 + h]; li = gates[(size_t)(b * L + p2) * 16 + h]; }
        float bc = lf;
#pragma unroll
        for (int o = 1; o < 64; o <<= 1) { const float n = __shfl_up(bc, o, 64); if (lane >= o) bc += n; }
        const float a = li - bc;
        float am = a;
#pragma unroll
        for (int o = 1; o < 64; o <<= 1) { const float n = __shfl_up(am, o, 64); if (lane >= o) am = fmaxf(am, n); }
        const float M = fmaxf(m_prev, am);
        ga[lane] = a; ga[64 + lane] = __expf(m_prev - M); ga[128 + lane] = __expf(-(bc + M)); ga[192 + lane] = M;
    }
    __syncthreads();
    const float Mt = ga[192 + 16 * w + lr], Wi = ga[64 + 16 * w + lr], Et = ga[128 + 16 * w + lr];
    bf16x8 pf[2];
    {
        f32x4 sa[4];
#pragma unroll
        for (int c = 0; c < 4; ++c) {
            sa[c] = (f32x4){0.f, 0.f, 0.f, 0.f};
            if (c <= wu) {
#pragma unroll
                for (int ks = 0; ks < 4; ++ks) {
                    const bf16x8 kf = *(const bf16x8*)(sK + (ks >> 1) * 8192 + vimg_off(16 * c + lr, 4 * (ks & 1) + g));
                    sa[c] = __builtin_amdgcn_mfma_f32_16x16x32_bf16(kf, qf[ks], sa[c], 0, 0, 0);
                }
                const f32x4 av = *(const f32x4*)(ga + 16 * c + 4 * g);
#pragma unroll
                for (int r = 0; r < 4; ++r) {
                    const float d = __expf(av[r] - Mt);
                    sa[c][r] = (16 * c + 4 * g + r <= 16 * w + lr) ? sa[c][r] * d : 0.f;
                }
            }
        }
#pragma unroll
        for (int s2 = 0; s2 < 2; ++s2) {
            uint4 u;
            u.x = cvt_pk_bf16(sa[2 * s2][0], sa[2 * s2][1]); u.y = cvt_pk_bf16(sa[2 * s2][2], sa[2 * s2][3]);
            u.z = cvt_pk_bf16(sa[2 * s2 + 1][0], sa[2 * s2 + 1][1]); u.w = cvt_pk_bf16(sa[2 * s2 + 1][2], sa[2 * s2 + 1][3]);
            pf[s2] = __builtin_bit_cast(bf16x8, u);
        }
    }
    __syncthreads();
    {
        unsigned char* d = sCb + tid * 16;
        *(uint4*)(d) = cb0; *(uint4*)(d + 4096) = cb1; *(uint4*)(d + 8192) = cb2; *(uint4*)(d + 12288) = cb3; *(uint4*)(d + 16384) = cb4;
        *(uint4*)(d + 20480) = cb5; *(uint4*)(d + 24576) = cb6; *(uint4*)(d + 28672) = cb7; *(uint4*)(d + 32768) = cb8;
    }
    __syncthreads();
    f32x4 na[9];
#define MC_TILE(c, lo0, hi0, lo1, hi1) { \
        na[c] = (f32x4){0.f, 0.f, 0.f, 0.f}; \
        _Pragma("unroll") for (int ks = 0; ks < 4; ++ks) { \
            const bf16x8 cf = *(const bf16x8*)(sCb + (ks >> 1) * 18432 + vimg_off(16 * (c) + lr, 4 * (ks & 1) + g)); \
            na[c] = __builtin_amdgcn_mfma_f32_16x16x32_bf16(cf, qf[ks], na[c], 0, 0, 0); } \
        na[c] *= Wi; \
        na[c] = __builtin_amdgcn_mfma_f32_16x16x32_bf16(tr_pair(lo0, hi0), pf[0], na[c], 0, 0, 0); \
        na[c] = __builtin_amdgcn_mfma_f32_16x16x32_bf16(tr_pair(lo1, hi1), pf[1], na[c], 0, 0, 0); }
    {
        uint2 vr[4][4];
        tr_read_4c(sV, g, lr, vr);
        MC_TILE(0, vr[0][0], vr[0][1], vr[0][2], vr[0][3]) MC_TILE(1, vr[1][0], vr[1][1], vr[1][2], vr[1][3])
        MC_TILE(2, vr[2][0], vr[2][1], vr[2][2], vr[2][3]) MC_TILE(3, vr[3][0], vr[3][1], vr[3][2], vr[3][3])
        tr_read_4c(sV + 8192, g, lr, vr);
        MC_TILE(4, vr[0][0], vr[0][1], vr[0][2], vr[0][3]) MC_TILE(5, vr[1][0], vr[1][1], vr[1][2], vr[1][3])
        MC_TILE(6, vr[2][0], vr[2][1], vr[2][2], vr[2][3]) MC_TILE(7, vr[3][0], vr[3][1], vr[3][2], vr[3][3])
        const uint2 o0 = tr_frag(sV + 16384, 0, 0, g, lr), o1 = tr_frag(sV + 16384, 16, 0, g, lr), o2 = tr_frag(sV + 16384, 32, 0, g, lr), o3 = tr_frag(sV + 16384, 48, 0, g, lr);
        MC_TILE(8, o0, o1, o2, o3)
    }
#undef MC_TILE
    const float den = __shfl(na[8][0], lr, 64);
    const float rden = 1.0f / fmaxf(fabsf(den), Et);
    float hs = 0.f;
#pragma unroll
    for (int c = 0; c < 8; ++c) { na[c] *= rden; hs += na[c][0] * na[c][0] + na[c][1] * na[c][1] + na[c][2] * na[c][2] + na[c][3] * na[c][3]; }
    hs = x4_sum(hs);
    const float rstd = rsqrtf(hs * (1.0f / 128.0f) + EPS);
    const float* gainp = P.m_out_norm + h * 128 + 4 * g;
#pragma unroll
    for (int c = 0; c < 8; ++c) {
        const uint2 og = *(const uint2*)(z + rrow * NZ + ZC_MO + h * 128 + 16 * c + 4 * g);
        const float o0 = bflo(og.x), o1 = bfhi(og.x), o2 = bflo(og.y), o3 = bfhi(og.y);
        const float4 gn = *(const float4*)(gainp + 16 * c);
        uint2 u;
        u.x = pk2(na[c][0] * rstd * gn.x / (1.f + __expf(-o0)), na[c][1] * rstd * gn.y / (1.f + __expf(-o1)));
        u.y = pk2(na[c][2] * rstd * gn.z / (1.f + __expf(-o2)), na[c][3] * rstd * gn.w / (1.f + __expf(-o3)));
        if (tvalid) *(uint2*)(y + rrow * NZ + h * 128 + 16 * c + 4 * g) = u;
    }
}

__device__ __forceinline__ void peer_token(const Params& P, int t, int lane, int* sidx, float* sval, int* sid, float* sgate, const unsigned char* slut, const unsigned* szero) {
    const unsigned* tk = (const unsigned*)(P.ws + WS_TK) + (size_t)t * 256;
#pragma unroll
    for (int i = 0; i < 4; ++i) {
        const unsigned k = tk[lane * 4 + i];
        sidx[lane * 4 + i] = 127 - (int)(k & 127u);
        sval[lane * 4 + i] = unord_key(k & ~127u);
    }
    __builtin_amdgcn_s_waitcnt(0xc07f);
    __builtin_amdgcn_wave_barrier();
    {
        const int hd = lane >> 3, sub = lane & 7;
        unsigned x[8];
#pragma unroll
        for (int r = 0; r < 8; ++r) {
            const int c = sub * 8 + r;
            const unsigned ij = slut[c < 50 ? c : 0];
            const int i = ij >> 4, j = ij & 15;
            const unsigned kx = (ord_key(sval[(2 * hd) * 16 + i] + sval[(2 * hd + 1) * 16 + j]) & ~255u) | (unsigned)(255 - (i * 16 + j));
            x[r] = c < 50 ? kx : 0u;
        }
#pragma unroll
        for (int k = 2; k <= 64; k <<= 1) {
#pragma unroll
            for (int j = k >> 1; j >= 1; j >>= 1) {
                if (j >= 8) {
                    const int ld = j >> 3;
                    const bool lower = (sub & ld) == 0;
                    const bool desc = k >= 64 ? true : ((sub * 8) & k) == 0;
                    const bool takemax = (lower == desc);
#pragma unroll
                    for (int r = 0; r < 8; ++r) {
                        const unsigned o = (unsigned)__shfl_xor((int)x[r], ld, 64);
                        const unsigned hi = max(x[r], o), lo = min(x[r], o);
                        x[r] = takemax ? hi : lo;
                    }
                } else {
#pragma unroll
                    for (int r = 0; r < 8; ++r) {
                        if ((r & j) == 0) {
                            const int p = r | j;
                            const unsigned hi = max(x[r], x[p]), lo = min(x[r], x[p]);
                            if (k <= 4) { const bool desc = (r & k) == 0; x[r] = desc ? hi : lo; x[p] = desc ? lo : hi; }
                            else if (k >= 64) { x[r] = hi; x[p] = lo; }
                            else { const bool desc = ((sub * 8) & k) == 0; x[r] = desc ? hi : lo; x[p] = desc ? lo : hi; }
                        }
                    }
                }
            }
        }
        const float smax = unord_key((unsigned)__shfl((int)x[0], hd * 8, 64) & ~255u);
        float e[8]; float den = 0.f;
#pragma unroll
        for (int r = 0; r < 8; ++r) { e[r] = __expf(unord_key(x[r] & ~255u) - smax); den += e[r]; }
        den += __shfl_xor(den, 1, 64);
        const float inv = 1.f / den;
        if (sub < 2) {
#pragma unroll
            for (int r = 0; r < 8; ++r) {
                const int pos = 255 - (int)(x[r] & 255u), i = pos >> 4, j = pos & 15;
                sid[hd * 16 + sub * 8 + r] = sidx[(2 * hd) * 16 + i] * 128 + sidx[(2 * hd + 1) * 16 + j];
                sgate[hd * 16 + sub * 8 + r] = e[r] * inv;
            }
        }
    }
    __builtin_amdgcn_s_waitcnt(0xc07f);
    __builtin_amdgcn_wave_barrier();
    const bf16_t* xn = (const bf16_t*)(P.ws + WS_XN) + (size_t)t * DM;
    const float rstd = ((const float*)(P.ws + WS_RSTD))[t];
    const unsigned char* V = P.ws + WS_V + lane * 8;
    const float* usc = (const float*)(P.ws + WS_USC);
    const float* vsc = (const float*)(P.ws + WS_VSC);
    const int g = lane >> 4, lr = lane & 15;
    unsigned char* shi = (unsigned char*)sval;
    unsigned char* slo = (unsigned char*)sidx;
    {
        const uint4 xa = *(const uint4*)(xn + lane * 16), xb = *(const uint4*)(xn + lane * 16 + 8);
        const unsigned xw[8] = {xa.x, xa.y, xa.z, xa.w, xb.x, xb.y, xb.z, xb.w};
        unsigned hi[4], lo[4];
#pragma unroll
        for (int i = 0; i < 4; ++i) {
            const float x0 = bflo(xw[2 * i]), x1 = bfhi(xw[2 * i]), x2 = bflo(xw[2 * i + 1]), x3 = bfhi(xw[2 * i + 1]);
            int wd = 0;
            wd = __builtin_amdgcn_cvt_pk_fp8_f32(x0, x1, wd, false);
            wd = __builtin_amdgcn_cvt_pk_fp8_f32(x2, x3, wd, true);
            const f32x2 h01 = __builtin_amdgcn_cvt_pk_f32_fp8(wd, false), h23 = __builtin_amdgcn_cvt_pk_f32_fp8(wd, true);
            int wl = 0;
            wl = __builtin_amdgcn_cvt_pk_fp8_f32(x0 - h01.x, x1 - h01.y, wl, false);
            wl = __builtin_amdgcn_cvt_pk_fp8_f32(x2 - h23.x, x3 - h23.y, wl, true);
            hi[i] = (unsigned)wd; lo[i] = (unsigned)wl;
        }
        *(uint4*)(shi + lane * 16) = make_uint4(hi[0], hi[1], hi[2], hi[3]);
        *(uint4*)(slo + lane * 16) = make_uint4(lo[0], lo[1], lo[2], lo[3]);
    }
    __builtin_amdgcn_s_waitcnt(0xc07f);
    __builtin_amdgcn_wave_barrier();
    {
        typedef int v8i __attribute__((ext_vector_type(8)));
        const unsigned char* Ub = P.ws + WS_U + 16 * g;
        const unsigned char* bsrc = (lr == 0) ? (shi + 16 * g) : (lr == 1) ? (slo + 16 * g) : (const unsigned char*)szero;
        const int bstep = (lr < 2) ? 128 : 0, bhalf = (lr < 2) ? 64 : 16;
        v8i Bv[8];
#pragma unroll
        for (int st = 0; st < 8; ++st) {
            const uint4 b0 = *(const uint4*)(bsrc + bstep * st), b1 = *(const uint4*)(bsrc + bstep * st + bhalf);
            Bv[st] = (v8i){(int)b0.x, (int)b0.y, (int)b0.z, (int)b0.w, (int)b1.x, (int)b1.y, (int)b1.z, (int)b1.w};
        }
        unsigned off[8];
#pragma unroll
        for (int T = 0; T < 8; ++T) off[T] = (unsigned)sid[16 * T + lr] * 512u;
        __builtin_amdgcn_s_waitcnt(0xc07f);
        __builtin_amdgcn_wave_barrier();
        float* sact = (float*)sidx + ((lr == 1) ? 128 : 0);
        uint4 abuf[2][8];
#pragma unroll
        for (int st = 0; st < 8; ++st) abuf[0][st] = *(const uint4*)(Ub + off[0] + 64 * st);
#pragma unroll
        for (int T = 0; T < 8; ++T) {
            if (T + 1 < 8) {
#pragma unroll
                for (int st = 0; st < 8; ++st) abuf[(T + 1) & 1][st] = *(const uint4*)(Ub + off[T + 1] + 64 * st);
            }
            f32x4 au = (f32x4){0.f, 0.f, 0.f, 0.f};
#pragma unroll
            for (int st = 0; st < 8; ++st) {
                const uint4 a4 = abuf[T & 1][st];
                const v8i Av = {(int)a4.x, (int)a4.y, (int)a4.z, (int)a4.w, 0, 0, 0, 0};
                au = __builtin_amdgcn_mfma_scale_f32_16x16x128_f8f6f4(Av, Bv[st], au, 4, 0, 0, 0x7f7f7f7f, 0, 0x7f7f7f7f);
            }
            if (lr < 2) *(f32x4*)(sact + 16 * T + 4 * g) = au;
        }
    }
    __builtin_amdgcn_s_waitcnt(0xc07f);
    __builtin_amdgcn_wave_barrier();
    {
        float* sw = (float*)sidx;
        float wv[2];
#pragma unroll
        for (int hh = 0; hh < 2; ++hh) {
            const int e = lane + 64 * hh, id = sid[e];
            const float a = (sw[e] + sw[128 + e]) * usc[id] * rstd;
            wv[hh] = sgate[e] * vsc[id] * 0.5f * a * (1.f + erff(a * 0.70710678118654752f));
        }
        sw[lane] = wv[0]; sw[lane + 64] = wv[1];
    }
    __builtin_amdgcn_s_waitcnt(0xc07f);
    __builtin_amdgcn_wave_barrier();
    f32x2 acc[8];
#pragma unroll
    for (int j = 0; j < 8; ++j) acc[j] = (f32x2){0.f, 0.f};
#pragma unroll 1
    for (int e0 = 0; e0 < 128; e0 += 16) {
        uint2 vr[16];
#pragma unroll
        for (int q = 0; q < 16; ++q) vr[q] = *(const uint2*)(V + (size_t)sid[e0 + q] * 512);
        const float* sw = (const float*)sidx + e0;
        const f32x4 w0 = *(const f32x4*)(sw), w1 = *(const f32x4*)(sw + 4), w2 = *(const f32x4*)(sw + 8), w3 = *(const f32x4*)(sw + 12);
        const float wq[16] = {w0[0], w0[1], w0[2], w0[3], w1[0], w1[1], w1[2], w1[3], w2[0], w2[1], w2[2], w2[3], w3[0], w3[1], w3[2], w3[3]};
#pragma unroll
        for (int q = 0; q < 16; ++q) {
            const float w = wq[q];
#define FP4_AXPY(k) { acc[k] += w * __builtin_amdgcn_cvt_scalef32_pk_f32_fp4(vr[q].x, 1.0f, k); acc[4 + k] += w * __builtin_amdgcn_cvt_scalef32_pk_f32_fp4(vr[q].y, 1.0f, k); }
            FP4_AXPY(0) FP4_AXPY(1) FP4_AXPY(2) FP4_AXPY(3)
#undef FP4_AXPY
        }
    }
    f32x2 xf[8];
    {
        const uint4 xa = *(const uint4*)(xn + lane * 16), xb = *(const uint4*)(xn + lane * 16 + 8);
        xf[0] = (f32x2){bflo(xa.x), bfhi(xa.x)}; xf[1] = (f32x2){bflo(xa.y), bfhi(xa.y)}; xf[2] = (f32x2){bflo(xa.z), bfhi(xa.z)}; xf[3] = (f32x2){bflo(xa.w), bfhi(xa.w)};
        xf[4] = (f32x2){bflo(xb.x), bfhi(xb.x)}; xf[5] = (f32x2){bflo(xb.y), bfhi(xb.y)}; xf[6] = (f32x2){bflo(xb.z), bfhi(xb.z)}; xf[7] = (f32x2){bflo(xb.w), bfhi(xb.w)};
    }
    float* o = P.out + (size_t)t * DM + lane * 16;
    float4 h0, h1, h2, h3;
    {
        const float4 g0 = *(const float4*)(P.norm_ffn + lane * 16), g1 = *(const float4*)(P.norm_ffn + lane * 16 + 4), g2 = *(const float4*)(P.norm_ffn + lane * 16 + 8), g3 = *(const float4*)(P.norm_ffn + lane * 16 + 12);
        h0.x = xf[0].x / g0.x + acc[0].x; h0.y = xf[0].y / g0.y + acc[0].y; h0.z = xf[1].x / g0.z + acc[1].x; h0.w = xf[1].y / g0.w + acc[1].y;
        h1.x = xf[2].x / g1.x + acc[2].x; h1.y = xf[2].y / g1.y + acc[2].y; h1.z = xf[3].x / g1.z + acc[3].x; h1.w = xf[3].y / g1.w + acc[3].y;
        h2.x = xf[4].x / g2.x + acc[4].x; h2.y = xf[4].y / g2.y + acc[4].y; h2.z = xf[5].x / g2.z + acc[5].x; h2.w = xf[5].y / g2.w + acc[5].y;
        h3.x = xf[6].x / g3.x + acc[6].x; h3.y = xf[6].y / g3.y + acc[6].y; h3.z = xf[7].x / g3.z + acc[7].x; h3.w = xf[7].y / g3.w + acc[7].y;
    }
    *(float4*)(o) = h0; *(float4*)(o + 4) = h1; *(float4*)(o + 8) = h2; *(float4*)(o + 12) = h3;
    __builtin_amdgcn_s_waitcnt(0xc07f);
    __builtin_amdgcn_wave_barrier();
}

#define LAS __attribute__((address_space(3)))
#define XB_TMO      128
#define XB_XCNT(j)  (256  + 64 * (j))
#define XB_XSUB(j)  (1280 + 64 * (j))
#define XB_XGEN(j)  (2304 + 64 * (j))
#define XB_TOP      3328
#define XB_TOPGEN   3392
#define XCD_BAR_WORDS 3456
#define XB_SPIN_CAP (1u << 18)
__device__ __forceinline__ unsigned xb_ld(unsigned* p)              { return __hip_atomic_load(p, __ATOMIC_RELAXED, __HIP_MEMORY_SCOPE_AGENT); }
__device__ __forceinline__ unsigned xb_add(unsigned* p, unsigned v) { return __hip_atomic_fetch_add(p, v, __ATOMIC_RELAXED, __HIP_MEMORY_SCOPE_AGENT); }
__device__ __forceinline__ unsigned xb_xcc_id() { return (unsigned)__builtin_amdgcn_s_getreg((3 << 11) | 20) & 0xFu; }
#define XB_SPIN(cond, bar) do { unsigned _sp = 0; while (cond) { __builtin_amdgcn_s_sleep(1); \
    if ((++_sp & 255u) == 0u) { if (xb_ld(&(bar)[XB_TMO])) break; if (_sp > XB_SPIN_CAP) { atomicAdd(&(bar)[XB_TMO], 1u); break; } } } } while (0)
struct XcdBarrier { unsigned* bar; unsigned x; volatile LAS unsigned* st; };
__device__ __forceinline__ XcdBarrier xcd_barrier_post(unsigned* bar, volatile LAS unsigned* st) {
    XcdBarrier b; b.bar = bar; b.x = xb_xcc_id(); b.st = st;
    if (threadIdx.x == 0) (void)xb_add(&bar[XB_XCNT(b.x)], 1u);
    return b;
}
__device__ __forceinline__ void xcd_barrier_complete(unsigned* bar, unsigned x, unsigned& nloc, unsigned& nx) {
    const unsigned G = gridDim.x * gridDim.y * gridDim.z;
    unsigned sum, cnt, mine, sp = 0u;
    for (;;) {
        sum = 0u; cnt = 0u; mine = 0u;
#pragma unroll
        for (unsigned j = 0; j < 16; ++j) { const unsigned c = xb_ld(&bar[XB_XCNT(j)]); sum += c; cnt += (c > 0u) ? 1u : 0u; mine = (j == x) ? c : mine; }
        if (sum == G) break;
        __builtin_amdgcn_s_sleep(1);
        if ((++sp & 255u) == 0u) { if (xb_ld(&bar[XB_TMO])) break; if (sp > XB_SPIN_CAP) { atomicAdd(&bar[XB_TMO], 1u); break; } }
    }
    nloc = mine > 0u ? mine : 1u; nx = cnt > 0u ? cnt : 1u;
}
__device__ __forceinline__ void xcd_barrier(const XcdBarrier& b) {
    asm volatile("s_waitcnt vmcnt(0)" ::: "memory");
    __syncthreads();
    if (threadIdx.x == 0) {
        unsigned* bar = b.bar;
        __builtin_amdgcn_s_waitcnt(0);
        unsigned nloc = b.st[0], nx = b.st[1];
        if (nloc == 0u) { xcd_barrier_complete(bar, b.x, nloc, nx); b.st[0] = nloc; b.st[1] = nx; }
        const unsigned old = xb_add(&bar[XB_XSUB(b.x)], 1u);
        const unsigned gen = old / nloc;
        if (old + 1u == (gen + 1u) * nloc) {
            __builtin_amdgcn_fence(__ATOMIC_RELEASE, "agent");
            asm volatile("s_waitcnt vmcnt(0)" ::: "memory");
            const unsigned og = xb_add(&bar[XB_TOP], 1u);
            const unsigned tg = og / nx;
            if (og + 1u == (tg + 1u) * nx) xb_add(&bar[XB_TOPGEN], 1u);
            else XB_SPIN(xb_ld(&bar[XB_TOPGEN]) == tg, bar);
            __builtin_amdgcn_fence(__ATOMIC_ACQUIRE, "agent");
            xb_add(&bar[XB_XGEN(b.x)], 1u);
            asm volatile("s_waitcnt vmcnt(0)" ::: "memory");
        } else {
            XB_SPIN(xb_ld(&bar[XB_XGEN(b.x)]) == gen, bar);
            __builtin_amdgcn_fence(__ATOMIC_ACQUIRE, "agent");
            asm volatile("s_waitcnt vmcnt(0)" ::: "memory");
        }
    }
    __syncthreads();
}

__device__ __forceinline__ void hand_release() { asm volatile("s_waitcnt vmcnt(0)" ::: "memory"); __builtin_amdgcn_fence(__ATOMIC_RELEASE, "agent"); asm volatile("s_waitcnt vmcnt(0)" ::: "memory"); }
__device__ __forceinline__ void hand_acquire() { __builtin_amdgcn_fence(__ATOMIC_ACQUIRE, "agent"); asm volatile("s_waitcnt vmcnt(0)" ::: "memory"); }

__global__ void __launch_bounds__(256, 2) mega(Params P) {
    extern __shared__ __attribute__((aligned(16))) unsigned char smem[];
    const int tid = threadIdx.x, lane = tid & 63, wave = tid >> 6;
    const int G = gridDim.x, bid = blockIdx.x;
    unsigned* ctl = (unsigned*)(P.ws + WS_CTL);
    volatile LAS unsigned* bst = (volatile LAS unsigned*)(smem + 65552);
    if (tid == 0) { bst[0] = 0u; bst[1] = 0u; }
    __syncthreads();
    const XcdBarrier xb = xcd_barrier_post(ctl + 1024, bst);
    unsigned* cucnt = ctl + 5120;
    if (tid == 0) {
        const unsigned phys = ((xb_xcc_id() & 7u) << 8) | ((unsigned)__builtin_amdgcn_s_getreg((7 << 11) | (8 << 6) | 4) & 0xFFu);
        bst[2] = phys; bst[3] = xb_add(&cucnt[phys], 1u);
    }
    phase0(P, smem);
    xcd_barrier(xb);
    {
        int vb;
        const unsigned phys = bst[2];
        unsigned part = 0;
#pragma unroll
        for (int q = 0; q < 8; ++q) { const unsigned i = (unsigned)(tid + 256 * q); const unsigned c = xb_ld(&cucnt[i]); part += (i < phys) ? c : 0u; }
#pragma unroll
        for (int o = 1; o < 64; o <<= 1) part += (unsigned)__shfl_xor((int)part, o, 64);
        if (lane == 0) bst[4 + wave] = part;
        __syncthreads();
        vb = (int)(bst[4] + bst[5] + bst[6] + bst[7] + bst[3]);
        vb = __builtin_amdgcn_readfirstlane(vb);
        if (vb < 0 || vb >= G) vb = bid;
        __syncthreads();
        if (tid == 0) bst[8] = (unsigned)vb;
        __syncthreads();
    }
#define VB_LOAD() __builtin_amdgcn_readfirstlane((int)bst[8])
    {
        const int gw = bid * 4 + wave;
        if (gw < 64) fox_cum_wave(P, gw, lane);
        const int vb = VB_LOAD();
        for (int tile = vb; tile < 129 * 28; tile += G) gemm_tile<1>(P, tile / 28, tile % 28, smem);
        {
            const int rem = (129 * 28) % G;
            if (rem > 0 && rem < G) { if (vb >= rem) convert_uv_rows(P, (vb - rem) * 4 + wave, (G - rem) * 4, lane); }
            else convert_uv_rows(P, vb * 4 + wave, G * 4, lane);
        }
    }
    xcd_barrier(xb);
    {
        volatile int* s_item = (volatile int*)(smem + 65536);
        const int wave_u = __builtin_amdgcn_readfirstlane(wave);
        auto fetch = [&](unsigned* counter) -> int {
            if (wave_u == 0) {
                unsigned v = atomicAdd(counter, lane == 0 ? 1u : 0u);
                *s_item = (int)__builtin_amdgcn_readfirstlane(v);
            }
            __syncthreads();
            const int item = __builtin_amdgcn_readfirstlane(*s_item);
            __syncthreads();
            return item;
        };
        for (;;) {
            const int item = fetch(&ctl[2]);
            if (item >= 33 * 32) break;
            mlstm_A(P, item, smem);
        }
        xcd_barrier(xb);
        for (;;) {
            const int item = fetch(&ctl[4]);
            if (item >= 96) break;
            mlstm_B(P, item);
        }
        for (;;) {
            const int item = fetch(&ctl[3]);
            if (item >= 64 * 17) break;
            attn_block(P, item & 63, 16 - (item >> 6), smem);
        }
        xcd_barrier(xb);
        for (;;) {
            const int item = fetch(&ctl[5]);
            if (item >= 33 * 32) break;
            mlstm_C(P, item, smem);
        }
    }
    xcd_barrier(xb);
    for (int tile = VB_LOAD(); tile < 128 * 8; tile += G) gemm_tile<2>(P, tile >> 3, tile & 7, smem);
    xcd_barrier(xb);
    for (int tile = VB_LOAD(); tile < 128 * 16; tile += G) gemm_tile<3>(P, tile >> 4, tile & 15, smem);
    xcd_barrier(xb);
    {
        unsigned char* slut = smem + 12288;
        if (tid < 64) {
            int c = tid, i = 0;
            while (i < 16 && c >= 16 / (i + 1)) { c -= 16 / (i + 1); ++i; }
            slut[tid] = (unsigned char)(i < 16 ? ((i << 4) | c) : 0);
        }
        unsigned* szero = (unsigned*)(smem + 12288 + 64);
        if (tid < 16) szero[tid] = 0u;
        __syncthreads();
        int* sidx = (int*)(smem + wave * 3072); float* sval = (float*)(smem + wave * 3072 + 1024);
        int* sid = (int*)(smem + wave * 3072 + 2048); float* sgate = (float*)(smem + wave * 3072 + 2560);
        int lane5 = lane;
        asm volatile("" : "+v"(lane5));
        for (int t = bid * 4 + wave; t < T2; t += G * 4) peer_token(P, t, lane5, sidx, sval, sid, sgate, slut, szero);
    }
}

}

extern "C" void kernel_launch(void* const* d_in, const int* in_sizes, int n_in, void* d_out, int out_size, void* d_ws, size_t ws_size, hipStream_t stream) {
    if (n_in != 17 || ws_size < WS_END) { fprintf(stderr, "kernel_launch: unexpected n_in %d or ws_size %zu (need %zu)\n", n_in, ws_size, (size_t)WS_END); return; }
    constexpr int LDS_BYTES = 66560;
    static int grid_blocks = 0;
    if (!grid_blocks) {
        int dev = 0, cus = 0, per_cu = 0;
        (void)hipGetDevice(&dev);
        (void)hipDeviceGetAttribute(&cus, hipDeviceAttributeMultiprocessorCount, dev);
        (void)hipFuncSetAttribute((const void*)mega, hipFuncAttributeMaxDynamicSharedMemorySize, LDS_BYTES);
        (void)hipOccupancyMaxActiveBlocksPerMultiprocessor(&per_cu, (const void*)mega, 256, LDS_BYTES);
        if (per_cu < 1) per_cu = 1;
        if (per_cu > 2) per_cu = 2;
        grid_blocks = cus * per_cu;
        fprintf(stderr, "kernel_launch: cus %d per_cu %d grid %d\n", cus, per_cu, grid_blocks);
    }
    Params P{};
    P.x = (const float*)d_in[0]; P.meta = (const float*)d_in[1]; P.norm_mix = (const float*)d_in[2]; P.w_in = (const float*)d_in[3];
    P.conv_qk = (const float*)d_in[4]; P.b_igate = (const float*)d_in[5]; P.b_fgate_m = (const float*)d_in[6]; P.m_out_norm = (const float*)d_in[7];
    P.b_fgate_f = (const float*)d_in[8]; P.f_q_norm = (const float*)d_in[9]; P.f_k_norm = (const float*)d_in[10]; P.w_out = (const float*)d_in[11];
    P.norm_ffn = (const float*)d_in[12]; P.peer_query = (const float*)d_in[13]; P.peer_keys = (const float*)d_in[14]; P.peer_u = (const float*)d_in[15];
    P.peer_v = (const float*)d_in[16]; P.out = (float*)d_out; P.ws = (unsigned char*)d_ws;
    (void)hipMemsetAsync((unsigned char*)d_ws + WS_CTL, 0, 32768, stream);
    void* args[] = {&P};
    hipError_t e = hipLaunchCooperativeKernel((const void*)mega, dim3(grid_blocks), dim3(256), args, LDS_BYTES, stream);
    if (e != hipSuccess) fprintf(stderr, "cooperative launch failed: %s (grid %d)\n", hipGetErrorString(e), grid_blocks);
}
```

```cpp
#include <hip/hip_runtime.h>
#include <stdint.h>
#include <stdio.h>
#include <hip/hip_cooperative_groups.h>
namespace cg = cooperative_groups;

namespace {

constexpr int NB = 8, SEQ = 2048, DM = 1024, NMETA = 16, L = SEQ + NMETA;
constexpr int T1 = NB * L;
constexpr int T2 = NB * SEQ;
constexpr int NZ = 3584;
constexpr int ZC_MQ = 0, ZC_MK = 512, ZC_MV = 1024, ZC_MO = 1536, ZC_FQ = 2048, ZC_FK = 2560, ZC_FV = 3072;
constexpr int PROJ = 3600;
constexpr float EPS = 1e-6f;

constexpr size_t WS_CTL = 0;
constexpr size_t WS_RA = 65536;
constexpr size_t WS_Z = WS_RA + (size_t)T1 * DM * 2;
constexpr size_t WS_GATES = WS_Z + (size_t)T1 * NZ * 2;
constexpr size_t WS_CUM = WS_GATES + (size_t)T1 * 16 * 4;
constexpr size_t WS_SSQ = WS_CUM + (size_t)NB * 8 * L * 4;
constexpr size_t WS_RSTD = WS_SSQ + (size_t)T2 * 16 * 4;
constexpr size_t WS_SSQM = WS_RSTD + (size_t)T2 * 4;
constexpr size_t WS_BT2 = WS_SSQM + (size_t)T1 * 16 * 4;
constexpr size_t WS_BT3 = WS_BT2 + (size_t)DM * DM * 2;
constexpr size_t WS_KEYS = WS_BT3 + (size_t)2048 * DM * 2;
constexpr size_t WS_MSC = WS_KEYS + (size_t)16 * 128 * 128 * 2;
constexpr size_t WS_MST = WS_MSC + (size_t)128 * 33 * 16;
constexpr size_t WS_BT1 = WS_MST + (size_t)32 * 33 * 36864;
constexpr size_t WS_CBI = WS_BT1;
constexpr size_t WS_UV = WS_CBI + (size_t)32 * 33 * 36864;
constexpr size_t WS_END = WS_UV + (size_t)2 * 16384 * 512 + (size_t)2 * 16384 * 4;
constexpr size_t WS_XN = WS_RA;
constexpr size_t WS_U = WS_UV;
constexpr size_t WS_V = WS_U + (size_t)16384 * 512;
constexpr size_t WS_USC = WS_V + (size_t)16384 * 512;
constexpr size_t WS_VSC = WS_USC + (size_t)16384 * 4;
constexpr size_t WS_TK = WS_CBI;
constexpr float LOG2E = 1.4426950408889634f;

typedef unsigned short bf16_t;
typedef short bf16x8 __attribute__((ext_vector_type(8)));
typedef float f32x4 __attribute__((ext_vector_type(4)));
typedef __attribute__((ext_vector_type(2))) __bf16 bf16x2_t;

struct Params {
    const float* x; const float* meta; const float* norm_mix; const float* w_in; const float* conv_qk;
    const float* b_igate; const float* b_fgate_m; const float* m_out_norm; const float* b_fgate_f;
    const float* f_q_norm; const float* f_k_norm; const float* w_out; const float* norm_ffn;
    const float* peer_query; const float* peer_keys; const float* peer_u; const float* peer_v;
    float* out; unsigned char* ws;
};

__device__ __forceinline__ unsigned f2bf(float f) { unsigned u = __float_as_uint(f); return (u + 0x7fffu + ((u >> 16) & 1u)) >> 16; }
__device__ __forceinline__ float bf2f(unsigned h) { return __uint_as_float(h << 16); }
typedef float f32x2 __attribute__((ext_vector_type(2)));
typedef __bf16 bf16x2v __attribute__((ext_vector_type(2)));
__device__ __forceinline__ unsigned cvt_pk_bf16(float lo, float hi) { f32x2 v = {lo, hi}; bf16x2v b = __builtin_convertvector(v, bf16x2v); return __builtin_bit_cast(unsigned, b); }
__device__ __forceinline__ unsigned pk2(float lo, float hi) { return cvt_pk_bf16(lo, hi); }
__device__ __forceinline__ float bflo(unsigned w) { return __uint_as_float(w << 16); }
__device__ __forceinline__ float bfhi(unsigned w) { return __uint_as_float(w & 0xffff0000u); }
__device__ __forceinline__ float wave_sum(float v) {
#pragma unroll
    for (int o = 32; o > 0; o >>= 1) v += __shfl_xor(v, o, 64);
    return v;
}
__device__ __forceinline__ float wave_max(float v) {
#pragma unroll
    for (int o = 32; o > 0; o >>= 1) v = fmaxf(v, __shfl_xor(v, o, 64));
    return v;
}
__device__ __forceinline__ float logsigmoidf(float x) { return fminf(x, 0.f) - log1pf(expf(-fabsf(x))); }
__device__ __forceinline__ unsigned ord_key(float f) { unsigned u = __float_as_uint(f); return u ^ ((u >> 31) ? 0xffffffffu : 0x80000000u); }
__device__ __forceinline__ float unord_key(unsigned k) { unsigned u = (k & 0x80000000u) ? (k ^ 0x80000000u) : ~k; return __uint_as_float(u); }

__device__ __forceinline__ void phase0(const Params& P, unsigned char* smem) {
    const int tid = threadIdx.x, lane = tid & 63, wave = tid >> 6;
    unsigned* ctl = (unsigned*)(P.ws + WS_CTL);
    float* gw = (float*)smem;
    for (int idx = tid; idx < 16 * 1024; idx += 256) {
        const int k = idx >> 4, c = idx & 15;
        const int col = c < 8 ? 2048 + c : 3592 + (c - 8);
        gw[c * 1024 + k] = P.w_in[(size_t)k * PROJ + col];
    }
    __syncthreads();
    {
        bf16_t* hn = (bf16_t*)(P.ws + WS_RA);
        float* gates = (float*)(P.ws + WS_GATES);
        const int c0 = lane * 8, c1 = 512 + lane * 8;
        float gm[16];
        {
            const float4 a0 = *(const float4*)(P.norm_mix + c0), a1 = *(const float4*)(P.norm_mix + c0 + 4);
            const float4 a2 = *(const float4*)(P.norm_mix + c1), a3 = *(const float4*)(P.norm_mix + c1 + 4);
            gm[0] = a0.x; gm[1] = a0.y; gm[2] = a0.z; gm[3] = a0.w; gm[4] = a1.x; gm[5] = a1.y; gm[6] = a1.z; gm[7] = a1.w;
            gm[8] = a2.x; gm[9] = a2.y; gm[10] = a2.z; gm[11] = a2.w; gm[12] = a3.x; gm[13] = a3.y; gm[14] = a3.z; gm[15] = a3.w;
        }
        const int myq = ((lane >> 5) & 1) * 8 + ((lane >> 4) & 1) * 4 + ((lane >> 3) & 1) * 2 + ((lane >> 2) & 1);
        const float mybias = myq < 4 ? P.b_igate[myq] : (myq < 8 ? P.b_fgate_m[myq - 4] : P.b_fgate_f[myq - 8]);
        const int rstep = gridDim.x * 4;
        int r = blockIdx.x * 4 + wave;
        float4 n0, n1, n2, n3;
        auto load_row = [&](int rr) {
            const int b = rr / L, p = rr - b * L;
            const float* src = (p < NMETA) ? (P.meta + (size_t)p * DM) : (P.x + ((size_t)b * SEQ + (p - NMETA)) * DM);
            n0 = *(const float4*)(src + c0); n1 = *(const float4*)(src + c0 + 4); n2 = *(const float4*)(src + c1); n3 = *(const float4*)(src + c1 + 4);
        };
        if (r < T1) load_row(r);
        for (; r < T1; r += rstep) {
            float v[16];
            v[0] = n0.x; v[1] = n0.y; v[2] = n0.z; v[3] = n0.w; v[4] = n1.x; v[5] = n1.y; v[6] = n1.z; v[7] = n1.w;
            v[8] = n2.x; v[9] = n2.y; v[10] = n2.z; v[11] = n2.w; v[12] = n3.x; v[13] = n3.y; v[14] = n3.z; v[15] = n3.w;
            if (r + rstep < T1) load_row(r + rstep);
            float ss = 0.f;
#pragma unroll
            for (int j = 0; j < 16; ++j) ss += v[j] * v[j];
            ss = wave_sum(ss);
            const float rstd = rsqrtf(ss * (1.0f / DM) + EPS);
#pragma unroll
            for (int j = 0; j < 16; ++j) v[j] *= rstd * gm[j];
            uint4 o0, o1;
            o0.x = pk2(v[0], v[1]); o0.y = pk2(v[2], v[3]); o0.z = pk2(v[4], v[5]); o0.w = pk2(v[6], v[7]);
            o1.x = pk2(v[8], v[9]); o1.y = pk2(v[10], v[11]); o1.z = pk2(v[12], v[13]); o1.w = pk2(v[14], v[15]);
            *(uint4*)(hn + (size_t)r * DM + c0) = o0;
            *(uint4*)(hn + (size_t)r * DM + c1) = o1;
            float r8[8], r4[4], r2[2], r1;
#pragma unroll
            for (int i = 0; i < 8; ++i) {
                float dd[2];
#pragma unroll
                for (int hh = 0; hh < 2; ++hh) {
                    const float* gwc = gw + (i + 8 * hh) * 1024;
                    const float4 w0 = *(const float4*)(gwc + c0), w1 = *(const float4*)(gwc + c0 + 4), w2 = *(const float4*)(gwc + c1), w3 = *(const float4*)(gwc + c1 + 4);
                    dd[hh] = v[0] * w0.x + v[1] * w0.y + v[2] * w0.z + v[3] * w0.w + v[4] * w1.x + v[5] * w1.y + v[6] * w1.z + v[7] * w1.w
                           + v[8] * w2.x + v[9] * w2.y + v[10] * w2.z + v[11] * w2.w + v[12] * w3.x + v[13] * w3.y + v[14] * w3.z + v[15] * w3.w;
                }
                const bool up = (lane & 32) != 0; const float keep = up ? dd[1] : dd[0], send = up ? dd[0] : dd[1];
                r8[i] = keep + __shfl_xor(send, 32, 64);
                __builtin_amdgcn_sched_barrier(0);
            }
#pragma unroll
            for (int i = 0; i < 4; ++i) { const bool up = (lane & 16) != 0; const float keep = up ? r8[i + 4] : r8[i], send = up ? r8[i] : r8[i + 4]; r4[i] = keep + __shfl_xor(send, 16, 64); }
#pragma unroll
            for (int i = 0; i < 2; ++i) { const bool up = (lane & 8) != 0; const float keep = up ? r4[i + 2] : r4[i], send = up ? r4[i] : r4[i + 2]; r2[i] = keep + __shfl_xor(send, 8, 64); }
            { const bool up = (lane & 4) != 0; const float keep = up ? r2[1] : r2[0], send = up ? r2[0] : r2[1]; r1 = keep + __shfl_xor(send, 4, 64); }
            r1 += __shfl_xor(r1, 2, 64); r1 += __shfl_xor(r1, 1, 64);
            if ((lane & 3) == 0) {
                const float pre = r1 + mybias;
                gates[(size_t)r * 16 + myq] = myq < 4 ? pre : logsigmoidf(pre);
            }
        }
    }
    __syncthreads();
    {
        float (*tile)[65] = (float (*)[65])smem;
        for (int item = blockIdx.x; item < 1664; item += gridDim.x) {
            const float* W; int ldn, ntn, shift_from, it; bf16_t* out;
            if (item < 896) { W = P.w_in; ldn = PROJ; ntn = 56; shift_from = 2048; it = item; out = (bf16_t*)(P.ws + WS_BT1); }
            else if (item < 1152) { W = P.w_out; ldn = 1024; ntn = 16; shift_from = 1 << 30; it = item - 896; out = (bf16_t*)(P.ws + WS_BT2); }
            else { W = P.peer_query; ldn = 2048; ntn = 32; shift_from = 1 << 30; it = item - 1152; out = (bf16_t*)(P.ws + WS_BT3); }
            const int tk = it / ntn, tn = it - tk * ntn, k0 = tk * 64, n0 = tn * 64;
            {
                const int nl = tid & 63;
                int n = n0 + nl; if (n >= shift_from) n += 8;
#pragma unroll
                for (int i = 0; i < 16; ++i) { const int kl = (tid >> 6) + 4 * i; tile[kl][nl] = W[(size_t)(k0 + kl) * ldn + n]; }
            }
            __syncthreads();
            {
                const int kl = tid & 63;
#pragma unroll
                for (int i = 0; i < 16; ++i) { const int nl = (tid >> 6) + 4 * i; out[(size_t)(n0 + nl) * 1024 + k0 + kl] = (bf16_t)f2bf(tile[kl][nl]); }
            }
            __syncthreads();
        }
    }
    {
        const size_t gt = (size_t)blockIdx.x * 256 + tid, gs = (size_t)gridDim.x * 256;
        const float* src = P.peer_keys; bf16_t* dst = (bf16_t*)(P.ws + WS_KEYS);
        for (size_t i = gt; i < (size_t)(16 * 128 * 128 / 8); i += gs) {
            const float4 a = *(const float4*)(src + i * 8), b = *(const float4*)(src + i * 8 + 4);
            uint4 o; o.x = pk2(a.x, a.y); o.y = pk2(a.z, a.w); o.z = pk2(b.x, b.y); o.w = pk2(b.z, b.w);
            *(uint4*)(dst + i * 8) = o;
        }
    }
}

__device__ __forceinline__ void convert_uv_rows(const Params& P, int gwave, int nwaves, int lane) {
    for (int rr0 = gwave * 4; rr0 < 2 * 16384; rr0 += nwaves * 4) {
        float4 a[4][4];
#pragma unroll
        for (int q = 0; q < 4; ++q) {
            const int rr = rr0 + q, which = rr >> 14, row = rr & 16383;
            const float* src = (which ? P.peer_v : P.peer_u) + (size_t)row * DM + lane * 16;
            a[q][0] = *(const float4*)(src); a[q][1] = *(const float4*)(src + 4); a[q][2] = *(const float4*)(src + 8); a[q][3] = *(const float4*)(src + 12);
        }
#pragma unroll
        for (int q = 0; q < 4; ++q) {
            const int rr = rr0 + q, which = rr >> 14, row = rr & 16383;
            float mx = 0.f;
#pragma unroll
            for (int j = 0; j < 4; ++j) mx = fmaxf(mx, fmaxf(fmaxf(fabsf(a[q][j].x), fabsf(a[q][j].y)), fmaxf(fabsf(a[q][j].z), fabsf(a[q][j].w))));
            mx = wave_max(mx);
            const float sc = mx > 0.f ? 6.0f / mx : 1.0f;
            unsigned w0 = 0u, w1 = 0u;
            w0 = __builtin_amdgcn_cvt_scalef32_pk_fp4_f32(w0, a[q][0].x * sc, a[q][0].y * sc, 1.0f, 0); w0 = __builtin_amdgcn_cvt_scalef32_pk_fp4_f32(w0, a[q][0].z * sc, a[q][0].w * sc, 1.0f, 1);
            w0 = __builtin_amdgcn_cvt_scalef32_pk_fp4_f32(w0, a[q][1].x * sc, a[q][1].y * sc, 1.0f, 2); w0 = __builtin_amdgcn_cvt_scalef32_pk_fp4_f32(w0, a[q][1].z * sc, a[q][1].w * sc, 1.0f, 3);
            w1 = __builtin_amdgcn_cvt_scalef32_pk_fp4_f32(w1, a[q][2].x * sc, a[q][2].y * sc, 1.0f, 0); w1 = __builtin_amdgcn_cvt_scalef32_pk_fp4_f32(w1, a[q][2].z * sc, a[q][2].w * sc, 1.0f, 1);
            w1 = __builtin_amdgcn_cvt_scalef32_pk_fp4_f32(w1, a[q][3].x * sc, a[q][3].y * sc, 1.0f, 2); w1 = __builtin_amdgcn_cvt_scalef32_pk_fp4_f32(w1, a[q][3].z * sc, a[q][3].w * sc, 1.0f, 3);
            *(uint2*)(P.ws + (which ? WS_V : WS_U) + (size_t)row * 512 + lane * 8) = make_uint2(w0, w1);
            if (lane == 0) ((float*)(P.ws + (which ? WS_VSC : WS_USC)))[row] = mx > 0.f ? mx * (1.0f / 6.0f) : 1.0f;
        }
    }
}

__device__ __forceinline__ void bitonic_sort16_desc(unsigned (&v)[16]) {
#pragma unroll
    for (int k = 2; k <= 16; k <<= 1)
#pragma unroll
        for (int j = k >> 1; j >= 1; j >>= 1)
#pragma unroll
            for (int i = 0; i < 16; ++i)
                if ((i & j) == 0) {
                    const int p = i | j;
                    const bool desc = (k >= 16) ? true : ((i & k) == 0);
                    const unsigned hi = max(v[i], v[p]), lo = min(v[i], v[p]);
                    v[i] = desc ? hi : lo; v[p] = desc ? lo : hi;
                }
}
__device__ __forceinline__ void bitonic_merge16_top(unsigned (&a)[16], const unsigned (&b)[16]) {
#pragma unroll
    for (int i = 0; i < 16; ++i) a[i] = max(a[i], b[15 - i]);
#pragma unroll
    for (int j = 8; j >= 1; j >>= 1)
#pragma unroll
        for (int i = 0; i < 16; ++i)
            if ((i & j) == 0) { const int p = i | j; const unsigned hi = max(a[i], a[p]), lo = min(a[i], a[p]); a[i] = hi; a[p] = lo; }
}

__device__ __forceinline__ float x4_max(float x) {
    const unsigned xi = __float_as_uint(x);
    const auto r = __builtin_amdgcn_permlane32_swap(xi, xi, false, false);
    const float m = fmaxf(__uint_as_float(r[0]), __uint_as_float(r[1]));
    const unsigned mi = __float_as_uint(m);
    const auto r2 = __builtin_amdgcn_permlane16_swap(mi, mi, false, false);
    return fmaxf(__uint_as_float(r2[0]), __uint_as_float(r2[1]));
}
__device__ __forceinline__ float x4_sum(float x) {
    const unsigned xi = __float_as_uint(x);
    const auto r = __builtin_amdgcn_permlane32_swap(xi, xi, false, false);
    const float m = __uint_as_float(r[0]) + __uint_as_float(r[1]);
    const unsigned mi = __float_as_uint(m);
    const auto r2 = __builtin_amdgcn_permlane16_swap(mi, mi, false, false);
    return __uint_as_float(r2[0]) + __uint_as_float(r2[1]);
}

__device__ __forceinline__ int opaque_tid() { int t = threadIdx.x; asm volatile("" : "+v"(t)); return t; }

__device__ __forceinline__ void mma_ktile(const unsigned char* sA, const unsigned char* sB, int arow_off, int brow_off, int g, int sw, f32x4 (&acc)[4][4]) {
#pragma unroll
    for (int s = 0; s < 2; ++s) {
        bf16x8 a[4], b[4];
        const int ch = (((s * 4 + g) ^ sw) << 4);
#pragma unroll
        for (int i = 0; i < 4; ++i) a[i] = *(const bf16x8*)(sA + arow_off + i * 2048 + ch);
#pragma unroll
        for (int j = 0; j < 4; ++j) b[j] = *(const bf16x8*)(sB + brow_off + j * 2048 + ch);
#pragma unroll
        for (int i = 0; i < 4; ++i)
#pragma unroll
            for (int j = 0; j < 4; ++j) acc[i][j] = __builtin_amdgcn_mfma_f32_16x16x32_bf16(b[j], a[i], acc[i][j], 0, 0, 0);
    }
}

__device__ __forceinline__ void store_tile_bf16(const f32x4 (&acc)[4][4], unsigned char* smem, bf16_t* dst, size_t ld, int m0, int n0, int tid, int wr, int wc, int g, int lr) {
#pragma unroll
    for (int i = 0; i < 4; ++i)
#pragma unroll
        for (int j = 0; j < 4; ++j) {
            const int row = wr * 64 + 16 * i + lr, col = wc * 64 + 16 * j + 4 * g;
            uint2 w; w.x = pk2(acc[i][j][0], acc[i][j][1]); w.y = pk2(acc[i][j][2], acc[i][j][3]);
            *(uint2*)(smem + row * 272 + col * 2) = w;
        }
    __syncthreads();
#pragma unroll
    for (int q = 0; q < 8; ++q) {
        const int id = tid + 256 * q, row = id >> 4, ch = id & 15;
        const uint4 v = *(const uint4*)(smem + row * 272 + ch * 16);
        *(uint4*)(dst + (size_t)(m0 + row) * ld + n0 + ch * 8) = v;
    }
    __syncthreads();
}

template <int MODE>
__device__ __forceinline__ void gemm_tile(const Params& P, int tm, int tn, unsigned char* smem) {
    const bf16_t* A; const bf16_t* Bt;
    if (MODE == 1) { A = (const bf16_t*)(P.ws + WS_RA); Bt = (const bf16_t*)(P.ws + WS_BT1); }
    else if (MODE == 2) { A = (const bf16_t*)(P.ws + WS_Z); Bt = (const bf16_t*)(P.ws + WS_BT2); }
    else { A = (const bf16_t*)(P.ws + WS_XN); Bt = (const bf16_t*)(P.ws + WS_BT3); }
    const int tid = opaque_tid(), lane = tid & 63, wave = tid >> 6, wr = wave >> 1, wc = wave & 1, g = lane >> 4, lr = lane & 15;
    const int m0 = tm * 128, n0 = tn * 128;
    const int srow = tid >> 3, sc = tid & 7;
    constexpr unsigned LDA = (MODE == 2 ? NZ : 1024) * 2u;
    unsigned aoff, boff; int soff0;
    {
        int ar = m0 + srow;
        if (MODE == 2) { const int b = ar >> 11, t = ar & 2047; ar = b * L + NMETA + t; }
        aoff = (unsigned)ar * LDA + (unsigned)sc * 16u;
        boff = (unsigned)(n0 + srow) * 2048u + (unsigned)sc * 16u;
        soff0 = srow * 128 + ((sc ^ (srow & 7)) << 4);
    }
    const unsigned char* Ab = (const unsigned char*)A; const unsigned char* Bb = (const unsigned char*)Bt;
    f32x4 acc[4][4];
#pragma unroll
    for (int i = 0; i < 4; ++i)
#pragma unroll
        for (int j = 0; j < 4; ++j) acc[i][j] = (f32x4){0.f, 0.f, 0.f, 0.f};
    uint4 ra0, ra1, ra2, ra3, rb0, rb1, rb2, rb3;
#define G_LOAD(KT) { const unsigned ko = (unsigned)(KT) * 128u; \
        ra0 = *(const uint4*)(Ab + (aoff + ko)); ra1 = *(const uint4*)(Ab + (aoff + 32u * LDA + ko)); ra2 = *(const uint4*)(Ab + (aoff + 64u * LDA + ko)); ra3 = *(const uint4*)(Ab + (aoff + 96u * LDA + ko)); \
        rb0 = *(const uint4*)(Bb + (boff + ko)); rb1 = *(const uint4*)(Bb + (boff + 32u * 2048u + ko)); rb2 = *(const uint4*)(Bb + (boff + 64u * 2048u + ko)); rb3 = *(const uint4*)(Bb + (boff + 96u * 2048u + ko)); }
#define G_WRITE(SA, SB) { *(uint4*)((SA) + soff0) = ra0; *(uint4*)((SA) + soff0 + 4096) = ra1; *(uint4*)((SA) + soff0 + 8192) = ra2; *(uint4*)((SA) + soff0 + 12288) = ra3; \
        *(uint4*)((SB) + soff0) = rb0; *(uint4*)((SB) + soff0 + 4096) = rb1; *(uint4*)((SB) + soff0 + 8192) = rb2; *(uint4*)((SB) + soff0 + 12288) = rb3; }
    unsigned char* sA0 = smem; unsigned char* sB0 = smem + 16384; unsigned char* sA1 = smem + 32768; unsigned char* sB1 = smem + 49152;
    G_LOAD(0)
    G_WRITE(sA0, sB0)
    __syncthreads();
    const int arow_off = (wr * 64 + lr) * 128, brow_off = (wc * 64 + lr) * 128, sw = lr & 7;
    G_LOAD(1)
    for (int kt = 0; kt < 16; ++kt) {
        unsigned char* sA = (kt & 1) ? sA1 : sA0; unsigned char* sB = (kt & 1) ? sB1 : sB0;
        unsigned char* nA = (kt & 1) ? sA0 : sA1; unsigned char* nB = (kt & 1) ? sB0 : sB1;
        bf16x8 fa[4], fb[4], ga[4], gb[4];
        const int ch0 = ((g ^ sw) << 4), ch1 = (((4 + g) ^ sw) << 4);
        const unsigned ko = (unsigned)(kt + 2) * 128u;
        const bool wr_ok = kt < 15, ld_ok = kt < 14;
#pragma unroll
        for (int i = 0; i < 4; ++i) { fa[i] = *(const bf16x8*)(sA + arow_off + i * 2048 + ch0); fb[i] = *(const bf16x8*)(sB + brow_off + i * 2048 + ch0); }
        __builtin_amdgcn_sched_barrier(0);
        if (wr_ok) { *(uint4*)(nA + soff0) = ra0; *(uint4*)(nA + soff0 + 4096) = ra1; }
        if (ld_ok) { ra0 = *(const uint4*)(Ab + (aoff + ko)); ra1 = *(const uint4*)(Ab + (aoff + 32u * LDA + ko)); }
        __builtin_amdgcn_sched_barrier(0);
#pragma unroll
        for (int i = 0; i < 2; ++i)
#pragma unroll
            for (int j = 0; j < 4; ++j) acc[i][j] = __builtin_amdgcn_mfma_f32_16x16x32_bf16(fb[j], fa[i], acc[i][j], 0, 0, 0);
        __builtin_amdgcn_sched_barrier(0);
        if (wr_ok) { *(uint4*)(nA + soff0 + 8192) = ra2; *(uint4*)(nA + soff0 + 12288) = ra3; }
        if (ld_ok) { ra2 = *(const uint4*)(Ab + (aoff + 64u * LDA + ko)); ra3 = *(const uint4*)(Ab + (aoff + 96u * LDA + ko)); }
        __builtin_amdgcn_sched_barrier(0);
#pragma unroll
        for (int i = 0; i < 4; ++i) { ga[i] = *(const bf16x8*)(sA + arow_off + i * 2048 + ch1); gb[i] = *(const bf16x8*)(sB + brow_off + i * 2048 + ch1); }
#pragma unroll
        for (int i = 2; i < 4; ++i)
#pragma unroll
            for (int j = 0; j < 4; ++j) acc[i][j] = __builtin_amdgcn_mfma_f32_16x16x32_bf16(fb[j], fa[i], acc[i][j], 0, 0, 0);
        __builtin_amdgcn_sched_barrier(0);
        if (wr_ok) { *(uint4*)(nB + soff0) = rb0; *(uint4*)(nB + soff0 + 4096) = rb1; }
        if (ld_ok) { rb0 = *(const uint4*)(Bb + (boff + ko)); rb1 = *(const uint4*)(Bb + (boff + 32u * 2048u + ko)); }
        __builtin_amdgcn_sched_barrier(0);
#pragma unroll
        for (int i = 0; i < 2; ++i)
#pragma unroll
            for (int j = 0; j < 4; ++j) acc[i][j] = __builtin_amdgcn_mfma_f32_16x16x32_bf16(gb[j], ga[i], acc[i][j], 0, 0, 0);
        __builtin_amdgcn_sched_barrier(0);
        if (wr_ok) { *(uint4*)(nB + soff0 + 8192) = rb2; *(uint4*)(nB + soff0 + 12288) = rb3; }
        if (ld_ok) { rb2 = *(const uint4*)(Bb + (boff + 64u * 2048u + ko)); rb3 = *(const uint4*)(Bb + (boff + 96u * 2048u + ko)); }
        __builtin_amdgcn_sched_barrier(0);
#pragma unroll
        for (int i = 2; i < 4; ++i)
#pragma unroll
            for (int j = 0; j < 4; ++j) acc[i][j] = __builtin_amdgcn_mfma_f32_16x16x32_bf16(gb[j], ga[i], acc[i][j], 0, 0, 0);
        __syncthreads();
    }
#undef G_LOAD
#undef G_WRITE
    if (MODE == 1) {
        if (n0 >= ZC_FQ && n0 < ZC_FV) {
            const bool isk = n0 >= ZC_FK;
            const float* gain = isk ? P.f_k_norm : P.f_q_norm;
            const float scl = isk ? 1.0f : 0.125f * LOG2E;
            float gn[4][4];
#pragma unroll
            for (int j = 0; j < 4; ++j)
#pragma unroll
                for (int r = 0; r < 4; ++r) gn[j][r] = gain[16 * j + 4 * g + r];
#pragma unroll
            for (int i = 0; i < 4; ++i) {
                float ss = 0.f;
#pragma unroll
                for (int j = 0; j < 4; ++j)
#pragma unroll
                    for (int r = 0; r < 4; ++r) ss += acc[i][j][r] * acc[i][j][r];
                ss = x4_sum(ss);
                const float rstd = rsqrtf(ss * (1.0f / 64.0f) + EPS) * scl;
#pragma unroll
                for (int j = 0; j < 4; ++j)
#pragma unroll
                    for (int r = 0; r < 4; ++r) acc[i][j][r] *= rstd * gn[j][r];
            }
        }
        store_tile_bf16(acc, smem, (bf16_t*)(P.ws + WS_Z), NZ, m0, n0, tid, wr, wc, g, lr);
    } else if (MODE == 2) {
        float* ssq = (float*)(P.ws + WS_SSQ);
#pragma unroll
        for (int i = 0; i < 4; ++i) {
            const int row = m0 + wr * 64 + 16 * i + lr;
            float ss = 0.f;
#pragma unroll
            for (int j = 0; j < 4; ++j) {
                const int col = n0 + wc * 64 + 16 * j + 4 * g;
                const float4 xv = *(const float4*)(P.x + (size_t)row * DM + col);
                const float4 gv = *(const float4*)(P.norm_ffn + col);
                float4 hv; hv.x = acc[i][j][0] + xv.x; hv.y = acc[i][j][1] + xv.y; hv.z = acc[i][j][2] + xv.z; hv.w = acc[i][j][3] + xv.w;
                ss += hv.x * hv.x + hv.y * hv.y + hv.z * hv.z + hv.w * hv.w;
                acc[i][j][0] = hv.x * gv.x; acc[i][j][1] = hv.y * gv.y; acc[i][j][2] = hv.z * gv.z; acc[i][j][3] = hv.w * gv.w;
            }
            ss = x4_sum(ss);
            if (g == 0) ssq[(size_t)row * 16 + tn * 2 + wc] = ss;
        }
        store_tile_bf16(acc, smem, (bf16_t*)(P.ws + WS_XN), 1024, m0, n0, tid, wr, wc, g, lr);
    } else {
        const int hp = tn;
        const float* ssq = (const float*)(P.ws + WS_SSQ);
        float rs[4];
#pragma unroll
        for (int i = 0; i < 4; ++i) {
            const int row = m0 + wr * 64 + 16 * i + lr;
            const float4 p0 = *(const float4*)(ssq + (size_t)row * 16), p1 = *(const float4*)(ssq + (size_t)row * 16 + 4);
            const float4 p2 = *(const float4*)(ssq + (size_t)row * 16 + 8), p3 = *(const float4*)(ssq + (size_t)row * 16 + 12);
            const float s = ((p0.x + p0.y) + (p0.z + p0.w)) + ((p1.x + p1.y) + (p1.z + p1.w)) + ((p2.x + p2.y) + (p2.z + p2.w)) + ((p3.x + p3.y) + (p3.z + p3.w));
            rs[i] = rsqrtf(s * (1.0f / DM) + EPS);
            if (tn == 0 && wc == 0 && g == 0) ((float*)(P.ws + WS_RSTD))[row] = rs[i];
        }
        {
            unsigned char* sAq = wc ? sA1 : sA0;
#pragma unroll
            for (int i = 0; i < 4; ++i)
#pragma unroll
                for (int j = 0; j < 4; ++j) {
                    const int row = wr * 64 + 16 * i + lr;
                    const int chunk = 2 * j + (g >> 1);
                    uint2 w; w.x = pk2(acc[i][j][0] * rs[i], acc[i][j][1] * rs[i]); w.y = pk2(acc[i][j][2] * rs[i], acc[i][j][3] * rs[i]);
                    *(uint2*)(sAq + row * 128 + ((chunk ^ (row & 7)) << 4) + 8 * (g & 1)) = w;
                }
            const bf16_t* keys = (const bf16_t*)(P.ws + WS_KEYS) + (size_t)hp * 128 * 128;
#pragma unroll
            for (int j = 0; j < 4; ++j) {
                const int row = srow + 32 * j;
                const uint4 k0 = *(const uint4*)(keys + (size_t)row * 128 + sc * 8);
                const uint4 k1 = *(const uint4*)(keys + (size_t)row * 128 + 64 + sc * 8);
                *(uint4*)(sB0 + soff0 + j * 4096) = k0; *(uint4*)(sB1 + soff0 + j * 4096) = k1;
            }
        }
        __syncthreads();
#pragma unroll
        for (int i = 0; i < 4; ++i)
#pragma unroll
            for (int j = 0; j < 4; ++j) acc[i][j] = (f32x4){0.f, 0.f, 0.f, 0.f};
        mma_ktile(sA0, sB0, arow_off, brow_off, g, sw, acc);
        mma_ktile(sA1, sB1, arow_off, brow_off, g, sw, acc);
        __syncthreads();
#pragma unroll
        for (int i = 0; i < 4; ++i)
#pragma unroll
            for (int j = 0; j < 4; ++j) {
                const int row = wr * 64 + 16 * i + lr;
                const int c4 = wc * 16 + 4 * j + g;
                *(f32x4*)(smem + row * 512 + ((c4 ^ (row & 31)) << 4)) = acc[i][j];
            }
        __syncthreads();
        unsigned top[16];
        const int row = tid & 127, half = tid >> 7;
        {
            auto load_keys = [&](unsigned (&dst)[16], int q4) {
#pragma unroll
                for (int s4 = 0; s4 < 4; ++s4) {
                    const int c4 = half * 16 + q4 * 4 + s4;
                    const f32x4 v = *(const f32x4*)(smem + row * 512 + ((c4 ^ (row & 31)) << 4));
#pragma unroll
                    for (int e = 0; e < 4; ++e) dst[s4 * 4 + e] = (ord_key(v[e]) & ~127u) | (unsigned)(127 - (c4 * 4 + e));
                }
            };
            load_keys(top, 0);
            bitonic_sort16_desc(top);
#pragma unroll 1
            for (int q4 = 1; q4 < 4; ++q4) {
                unsigned gq[16];
                load_keys(gq, q4);
                bitonic_sort16_desc(gq);
                bitonic_merge16_top(top, gq);
            }
        }
        __syncthreads();
        if (half) {
            uint4* lp = (uint4*)(smem + row * 64);
            lp[0] = make_uint4(top[0], top[1], top[2], top[3]); lp[1] = make_uint4(top[4], top[5], top[6], top[7]);
            lp[2] = make_uint4(top[8], top[9], top[10], top[11]); lp[3] = make_uint4(top[12], top[13], top[14], top[15]);
        }
        __syncthreads();
        if (!half) {
            const uint4* lp = (const uint4*)(smem + row * 64);
            unsigned other[16];
#pragma unroll
            for (int c = 0; c < 4; ++c) { const uint4 o = lp[c]; other[4 * c] = o.x; other[4 * c + 1] = o.y; other[4 * c + 2] = o.z; other[4 * c + 3] = o.w; }
            bitonic_merge16_top(top, other);
            uint4* tk = (uint4*)((unsigned*)(P.ws + WS_TK) + ((size_t)(m0 + row) * 16 + hp) * 16);
            tk[0] = make_uint4(top[0], top[1], top[2], top[3]); tk[1] = make_uint4(top[4], top[5], top[6], top[7]);
            tk[2] = make_uint4(top[8], top[9], top[10], top[11]); tk[3] = make_uint4(top[12], top[13], top[14], top[15]);
        }
        __syncthreads();
    }
}

__device__ __forceinline__ void fox_cum_wave(const Params& P, int bh, int lane) {
    const int b = bh >> 3, h = bh & 7;
    const float* gates = (const float*)(P.ws + WS_GATES);
    float* cum = (float*)(P.ws + WS_CUM) + (size_t)bh * L;
    constexpr int SEG = 33;
    const int t0 = lane * SEG;
    float loc = 0.f;
    for (int i = 0; i < SEG; ++i) { const int t = t0 + i; if (t < L) loc += gates[(size_t)(b * L + t) * 16 + 8 + h]; }
    float incl = loc;
#pragma unroll
    for (int o = 1; o < 64; o <<= 1) { const float n = __shfl_up(incl, o, 64); if (lane >= o) incl += n; }
    float run = incl - loc;
    for (int i = 0; i < SEG; ++i) { const int t = t0 + i; if (t < L) { run += gates[(size_t)(b * L + t) * 16 + 8 + h]; cum[t] = run * LOG2E; } }
}

#define TR_SLOW 0

__device__ __forceinline__ int vimg_off(int row, int ch) { return row * 128 + ((ch ^ (((row >> 1) & 3) << 1)) << 4); }
__device__ __forceinline__ uint2 tr_frag(const unsigned char* img, int row0, int c, int g, int lr) {
#if TR_SLOW
    unsigned short e[4];
#pragma unroll
    for (int k = 0; k < 4; ++k) { const int row = row0 + 4 * g + k, col = 16 * c + lr; e[k] = *(const unsigned short*)(img + vimg_off(row, col >> 3) + (col & 7) * 2); }
    uint2 r; r.x = (unsigned)e[0] | ((unsigned)e[1] << 16); r.y = (unsigned)e[2] | ((unsigned)e[3] << 16); return r;
#else
    const int q = lr >> 2, p = lr & 3, row = row0 + 4 * g + q;
    const unsigned addr = (unsigned)(size_t)(img + vimg_off(row, 2 * c + (p >> 1)) + 8 * (p & 1));
    uint2 r;
    asm volatile("ds_read_b64_tr_b16 %0, %1\n\ts_waitcnt lgkmcnt(0)" : "=&v"(r) : "v"(addr) : "memory");
    return r;
#endif
}

__device__ __forceinline__ unsigned tr_lane_addr(const unsigned char* img, int c, int g, int lr) {
    const int q = lr >> 2, p = lr & 3, row = 4 * g + q;
    return (unsigned)(size_t)(img + vimg_off(row, 2 * c + (p >> 1)) + 8 * (p & 1));
}
#define TR_GROUP(o0, o1, o2, o3, a) "ds_read_b64_tr_b16 %" #o0 ", %" #a "\n\tds_read_b64_tr_b16 %" #o1 ", %" #a " offset:2048\n\tds_read_b64_tr_b16 %" #o2 ", %" #a " offset:4096\n\tds_read_b64_tr_b16 %" #o3 ", %" #a " offset:6144\n\t"
__device__ __forceinline__ void tr_read_4c(const unsigned char* img, int g, int lr, uint2 (&r)[4][4]) {
    const unsigned a0 = tr_lane_addr(img, 0, g, lr), a1 = tr_lane_addr(img, 1, g, lr), a2 = tr_lane_addr(img, 2, g, lr), a3 = tr_lane_addr(img, 3, g, lr);
    asm volatile(TR_GROUP(0, 1, 2, 3, 16) TR_GROUP(4, 5, 6, 7, 17) TR_GROUP(8, 9, 10, 11, 18) TR_GROUP(12, 13, 14, 15, 19) "s_waitcnt lgkmcnt(0)"
        : "=&v"(r[0][0]), "=&v"(r[0][1]), "=&v"(r[0][2]), "=&v"(r[0][3]), "=&v"(r[1][0]), "=&v"(r[1][1]), "=&v"(r[1][2]), "=&v"(r[1][3]),
          "=&v"(r[2][0]), "=&v"(r[2][1]), "=&v"(r[2][2]), "=&v"(r[2][3]), "=&v"(r[3][0]), "=&v"(r[3][1]), "=&v"(r[3][2]), "=&v"(r[3][3])
        : "v"(a0), "v"(a1), "v"(a2), "v"(a3) : "memory");
}
__device__ __forceinline__ void tr_read_3c(const unsigned char* img, int g, int lr, uint2 (&r)[3][4]) {
    const unsigned a0 = tr_lane_addr(img, 0, g, lr), a1 = tr_lane_addr(img, 1, g, lr), a2 = tr_lane_addr(img, 2, g, lr);
    asm volatile(TR_GROUP(0, 1, 2, 3, 12) TR_GROUP(4, 5, 6, 7, 13) TR_GROUP(8, 9, 10, 11, 14) "s_waitcnt lgkmcnt(0)"
        : "=&v"(r[0][0]), "=&v"(r[0][1]), "=&v"(r[0][2]), "=&v"(r[0][3]), "=&v"(r[1][0]), "=&v"(r[1][1]), "=&v"(r[1][2]), "=&v"(r[1][3]),
          "=&v"(r[2][0]), "=&v"(r[2][1]), "=&v"(r[2][2]), "=&v"(r[2][3])
        : "v"(a0), "v"(a1), "v"(a2) : "memory");
}
__device__ __forceinline__ void tr_read_2(const unsigned char* img0, int c0, const unsigned char* img1, int c1, int g, int lr, uint2 (&r)[2][4]) {
    const unsigned a0 = tr_lane_addr(img0, c0, g, lr), a1 = tr_lane_addr(img1, c1, g, lr);
    asm volatile(TR_GROUP(0, 1, 2, 3, 8) TR_GROUP(4, 5, 6, 7, 9) "s_waitcnt lgkmcnt(0)"
        : "=&v"(r[0][0]), "=&v"(r[0][1]), "=&v"(r[0][2]), "=&v"(r[0][3]), "=&v"(r[1][0]), "=&v"(r[1][1]), "=&v"(r[1][2]), "=&v"(r[1][3])
        : "v"(a0), "v"(a1) : "memory");
}
__device__ __forceinline__ bf16x8 tr_pair(const uint2& lo, const uint2& hi) { uint4 u; u.x = lo.x; u.y = lo.y; u.z = hi.x; u.w = hi.y; return __builtin_bit_cast(bf16x8, u); }

__device__ __forceinline__ void attn_block(const Params& P, int bh, int qb, unsigned char* smem) {
    const int tid = opaque_tid(), lane = tid & 63, w = tid >> 6, g = lane >> 4, lr = lane & 15;
    const int b = bh >> 3, h = bh & 7;
    const bf16_t* z = (const bf16_t*)(P.ws + WS_Z);
    const float* cum = (const float*)(P.ws + WS_CUM) + (size_t)bh * L;
    int tq[2]; bool qvalid[2]; bf16x8 qf[2][2];
#pragma unroll
    for (int u = 0; u < 2; ++u) {
        tq[u] = qb * 128 + 32 * w + 16 * u + lr;
        qvalid[u] = tq[u] < L;
        const bf16_t* qp = z + (size_t)(b * L + (qvalid[u] ? tq[u] : 0)) * NZ + ZC_FQ + h * 64 + 8 * g;
        qf[u][0] = *(const bf16x8*)(qp); qf[u][1] = *(const bf16x8*)(qp + 32);
    }
    const int nkv = (2 * qb + 2 < 33) ? 2 * qb + 2 : 33;
    const int srow0 = tid >> 3, sch = tid & 7;
    uint4 rk[2], rv[2]; float rc = 0.f;
    auto load_tile = [&](int kv) {
#pragma unroll
        for (int j = 0; j < 2; ++j) {
            const int key = kv * 64 + srow0 + 32 * j;
            if (key < L) {
                const bf16_t* p = z + (size_t)(b * L + key) * NZ + h * 64 + sch * 8;
                rk[j] = *(const uint4*)(p + ZC_FK); rv[j] = *(const uint4*)(p + ZC_FV);
            } else { rk[j] = make_uint4(0, 0, 0, 0); rv[j] = make_uint4(0, 0, 0, 0); }
        }
        if (tid < 64) { const int key = kv * 64 + tid; rc = key < L ? cum[key] : 0.f; }
    };
    auto store_tile = [&](int buf) {
        unsigned char* sK = smem + buf * 16384; unsigned char* sV = sK + 8192;
#pragma unroll
        for (int j = 0; j < 2; ++j) {
            const int row = srow0 + 32 * j;
            *(uint4*)(sK + row * 128 + ((sch ^ (row & 7)) << 4)) = rk[j];
            *(uint4*)(sV + vimg_off(row, sch)) = rv[j];
        }
        if (tid < 64) ((float*)(smem + 32768 + buf * 256))[tid] = rc;
    };
    float m[2] = {-1e30f, -1e30f};
    f32x4 o[2][5];
#pragma unroll
    for (int u = 0; u < 2; ++u)
#pragma unroll
        for (int c = 0; c < 5; ++c) o[u][c] = (f32x4){0.f, 0.f, 0.f, 0.f};
    const unsigned onew = (lr == 0) ? 0x3F803F80u : 0u;
    const bf16x8 vones = __builtin_bit_cast(bf16x8, make_uint4(onew, onew, onew, onew));
    load_tile(nkv - 1); store_tile((nkv - 1) & 1);
    __syncthreads();
    for (int kv = nkv - 1; kv >= 0; --kv) {
        const int buf = kv & 1;
        if (kv > 0) load_tile(kv - 1);
        const unsigned char* sK = smem + buf * 16384; const unsigned char* sV = sK + 8192;
        const float* sck = (const float*)(smem + 32768 + buf * 256);
        f32x4 sa[2][4];
#pragma unroll
        for (int c = 0; c < 4; ++c) {
            sa[0][c] = (f32x4){0.f, 0.f, 0.f, 0.f}; sa[1][c] = (f32x4){0.f, 0.f, 0.f, 0.f};
#pragma unroll
            for (int s = 0; s < 2; ++s) {
                const bf16x8 kf = *(const bf16x8*)(sK + (16 * c + lr) * 128 + (((4 * s + g) ^ (lr & 7)) << 4));
                sa[0][c] = __builtin_amdgcn_mfma_f32_16x16x32_bf16(kf, qf[0][s], sa[0][c], 0, 0, 0);
                sa[1][c] = __builtin_amdgcn_mfma_f32_16x16x32_bf16(kf, qf[1][s], sa[1][c], 0, 0, 0);
            }
        }
        if (kv >= 2 * qb) {
#pragma unroll
            for (int u = 0; u < 2; ++u)
#pragma unroll
                for (int c = 0; c < 4; ++c)
#pragma unroll
                    for (int r = 0; r < 4; ++r)
                        if (64 * kv + 16 * c + 4 * g + r > tq[u]) sa[u][c][r] = -INFINITY;
        }
        f32x4 ck[4];
#pragma unroll
        for (int c = 0; c < 4; ++c) ck[c] = *(const f32x4*)(sck + 16 * c + 4 * g);
        bf16x8 pf[2][2];
#pragma unroll
        for (int u = 0; u < 2; ++u) {
            float mx = -INFINITY;
#pragma unroll
            for (int c = 0; c < 4; ++c) {
                sa[u][c] -= ck[c];
                mx = fmaxf(mx, fmaxf(fmaxf(sa[u][c][0], sa[u][c][1]), fmaxf(sa[u][c][2], sa[u][c][3])));
            }
            mx = x4_max(mx);
            if (__builtin_amdgcn_ballot_w64(mx > m[u]) != 0ull) {
                const float mn = fmaxf(m[u], mx);
                const float alpha = __builtin_amdgcn_exp2f(m[u] - mn);
                m[u] = mn;
#pragma unroll
                for (int c = 0; c < 5; ++c) o[u][c] *= alpha;
            }
            const float mn = m[u];
#pragma unroll
            for (int c = 0; c < 4; ++c)
#pragma unroll
                for (int r = 0; r < 4; ++r) sa[u][c][r] = __builtin_amdgcn_exp2f(sa[u][c][r] - mn);
#pragma unroll
            for (int s2 = 0; s2 < 2; ++s2) {
                uint4 uu;
                uu.x = cvt_pk_bf16(sa[u][2 * s2][0], sa[u][2 * s2][1]); uu.y = cvt_pk_bf16(sa[u][2 * s2][2], sa[u][2 * s2][3]);
                uu.z = cvt_pk_bf16(sa[u][2 * s2 + 1][0], sa[u][2 * s2 + 1][1]); uu.w = cvt_pk_bf16(sa[u][2 * s2 + 1][2], sa[u][2 * s2 + 1][3]);
                pf[u][s2] = __builtin_bit_cast(bf16x8, uu);
            }
        }
        {
            uint2 vr[4][4];
            tr_read_4c(sV, g, lr, vr);
#pragma unroll
            for (int c = 0; c < 4; ++c)
#pragma unroll
                for (int s2 = 0; s2 < 2; ++s2) {
                    const bf16x8 vf = tr_pair(vr[c][2 * s2], vr[c][2 * s2 + 1]);
                    o[0][c] = __builtin_amdgcn_mfma_f32_16x16x32_bf16(vf, pf[0][s2], o[0][c], 0, 0, 0);
                    o[1][c] = __builtin_amdgcn_mfma_f32_16x16x32_bf16(vf, pf[1][s2], o[1][c], 0, 0, 0);
                }
#pragma unroll
            for (int s2 = 0; s2 < 2; ++s2) {
                o[0][4] = __builtin_amdgcn_mfma_f32_16x16x32_bf16(vones, pf[0][s2], o[0][4], 0, 0, 0);
                o[1][4] = __builtin_amdgcn_mfma_f32_16x16x32_bf16(vones, pf[1][s2], o[1][4], 0, 0, 0);
            }
        }
        if (kv > 0) store_tile(buf ^ 1);
        __syncthreads();
    }
#pragma unroll
    for (int u = 0; u < 2; ++u) {
        const float ls = __shfl(o[u][4][0], lr, 64);
        const float inv = 1.0f / ls;
        if (qvalid[u]) {
            bf16_t* y = (bf16_t*)(P.ws + WS_Z) + (size_t)(b * L + tq[u]) * NZ + 512 + h * 64 + 4 * g;
#pragma unroll
            for (int c = 0; c < 4; ++c) {
                uint2 uu; uu.x = pk2(o[u][c][0] * inv, o[u][c][1] * inv); uu.y = pk2(o[u][c][2] * inv, o[u][c][3] * inv);
                *(uint2*)(y + 16 * c) = uu;
            }
        }
    }
}

__device__ __forceinline__ void conv_item(const Params& P, int ci) {
    const int tid = opaque_tid(), cc = tid & 127, rg = tid >> 7;
    const bf16_t* z = (const bf16_t*)(P.ws + WS_Z);
    bf16_t* qk = (bf16_t*)(P.ws + WS_RA);
    const int col0 = cc * 8;
    float w[4][8];
#pragma unroll
    for (int j = 0; j < 4; ++j) {
        const float4 a = *(const float4*)(P.conv_qk + j * 1024 + col0), b = *(const float4*)(P.conv_qk + j * 1024 + col0 + 4);
        w[j][0] = a.x; w[j][1] = a.y; w[j][2] = a.z; w[j][3] = a.w; w[j][4] = b.x; w[j][5] = b.y; w[j][6] = b.z; w[j][7] = b.w;
    }
    const float oscale = (col0 >= 512) ? 0.08838834764831845f : 1.0f;
    const int r0 = ci * 64 + rg * 32;
    int t = r0 % L;
    float xw[3][8];
#pragma unroll
    for (int j = 0; j < 3; ++j) {
        const int back = 3 - j;
        if (t - back >= 0) {
            const uint4 v = *(const uint4*)(z + (size_t)(r0 - back) * NZ + col0);
            xw[j][0] = bflo(v.x); xw[j][1] = bfhi(v.x); xw[j][2] = bflo(v.y); xw[j][3] = bfhi(v.y); xw[j][4] = bflo(v.z); xw[j][5] = bfhi(v.z); xw[j][6] = bflo(v.w); xw[j][7] = bfhi(v.w);
        } else {
#pragma unroll
            for (int e = 0; e < 8; ++e) xw[j][e] = 0.f;
        }
    }
#pragma unroll 2
    for (int i = 0; i < 32; ++i) {
        const int r = r0 + i;
        if (t == 0) {
#pragma unroll
            for (int j = 0; j < 3; ++j)
#pragma unroll
                for (int e = 0; e < 8; ++e) xw[j][e] = 0.f;
        }
        const uint4 v = *(const uint4*)(z + (size_t)r * NZ + col0);
        float xt[8];
        xt[0] = bflo(v.x); xt[1] = bfhi(v.x); xt[2] = bflo(v.y); xt[3] = bfhi(v.y); xt[4] = bflo(v.z); xt[5] = bfhi(v.z); xt[6] = bflo(v.w); xt[7] = bfhi(v.w);
        float o[8];
#pragma unroll
        for (int e = 0; e < 8; ++e) {
            const float cv = w[0][e] * xw[0][e] + w[1][e] * xw[1][e] + w[2][e] * xw[2][e] + w[3][e] * xt[e];
            o[e] = oscale * cv / (1.f + __expf(-cv));
            xw[0][e] = xw[1][e]; xw[1][e] = xw[2][e]; xw[2][e] = xt[e];
        }
        uint4 ov; ov.x = pk2(o[0], o[1]); ov.y = pk2(o[2], o[3]); ov.z = pk2(o[4], o[5]); ov.w = pk2(o[6], o[7]);
        *(uint4*)(qk + (size_t)r * 1024 + col0) = ov;
        t = (t + 1 == L) ? 0 : t + 1;
    }
}

constexpr int ST_IMG = 36864;
__device__ __forceinline__ int st_piece_off(int jt, int c, int g, int lr) { return (jt >> 2) * 18432 + vimg_off(16 * c + lr, 2 * (jt & 3) + (g >> 1)) + 8 * (g & 1); }

__device__ __forceinline__ void mlstm_stage_kv(const Params& P, int b, int h, int k, unsigned char* sKimg, unsigned char* sVimg, int tid) {
    const bf16_t* z = (const bf16_t*)(P.ws + WS_Z);
    const bf16_t* qk = (const bf16_t*)(P.ws + WS_RA);
    uint4 pk_[4], pv_[4];
#pragma unroll
    for (int j = 0; j < 4; ++j) {
        const int id = tid + 256 * j, row = id >> 4, ch16 = id & 15, pos = 64 * k + row;
        const bool ok = pos < L;
        pk_[j] = ok ? *(const uint4*)(qk + (size_t)(b * L + pos) * 1024 + 512 + h * 128 + ch16 * 8) : make_uint4(0, 0, 0, 0);
        pv_[j] = ok ? *(const uint4*)(z + (size_t)(b * L + pos) * NZ + ZC_MV + h * 128 + ch16 * 8) : make_uint4(0, 0, 0, 0);
    }
#pragma unroll
    for (int j = 0; j < 4; ++j) {
        const int id = tid + 256 * j, row = id >> 4, ch16 = id & 15;
        *(uint4*)(sKimg + (ch16 >> 3) * 8192 + vimg_off(row, ch16 & 7)) = pk_[j];
        *(uint4*)(sVimg + (ch16 >> 3) * 8192 + vimg_off(row, ch16 & 7)) = pv_[j];
    }
    if (tid < 128) {
        const int row = tid >> 1, ch = tid & 1;
        *(uint4*)(sVimg + 16384 + vimg_off(row, ch)) = ch ? make_uint4(0, 0, 0, 0) : make_uint4(0x3F80u, 0, 0, 0);
    }
}

__device__ __forceinline__ void mlstm_stage_A(const Params& P, int b, int h, int k, unsigned char* sKimg, unsigned char* sVimg, int tid) {
    const bf16_t* z = (const bf16_t*)(P.ws + WS_Z);
    bf16_t* qk = (bf16_t*)(P.ws + WS_RA);
    uint4 pv_[4];
#pragma unroll
    for (int j = 0; j < 4; ++j) {
        const int id = tid + 256 * j, row = id >> 4, ch16 = id & 15, pos = 64 * k + row;
        pv_[j] = (pos < L) ? *(const uint4*)(z + (size_t)(b * L + pos) * NZ + ZC_MV + h * 128 + ch16 * 8) : make_uint4(0, 0, 0, 0);
    }
    const int cch = tid & 31, rg = tid >> 5, isk = cch >> 4;
    const int zcol = (isk ? ZC_MK : ZC_MQ) + h * 128 + (cch & 15) * 8;
    float w[4][8];
#pragma unroll
    for (int j = 0; j < 4; ++j) {
        const float4 a = *(const float4*)(P.conv_qk + j * 1024 + zcol), c = *(const float4*)(P.conv_qk + j * 1024 + zcol + 4);
        w[j][0] = a.x; w[j][1] = a.y; w[j][2] = a.z; w[j][3] = a.w; w[j][4] = c.x; w[j][5] = c.y; w[j][6] = c.z; w[j][7] = c.w;
    }
    const float oscale = isk ? 0.08838834764831845f : 1.0f;
    const int p0 = 64 * k + 8 * rg;
    uint4 raw[11];
#pragma unroll
    for (int i = 0; i < 11; ++i) {
        const int pos = p0 - 3 + i;
        raw[i] = (pos >= 0 && pos < L) ? *(const uint4*)(z + (size_t)(b * L + pos) * NZ + zcol) : make_uint4(0, 0, 0, 0);
    }
#pragma unroll
    for (int j = 0; j < 4; ++j) {
        const int id = tid + 256 * j, row = id >> 4, ch16 = id & 15;
        *(uint4*)(sVimg + (ch16 >> 3) * 8192 + vimg_off(row, ch16 & 7)) = pv_[j];
    }
    if (tid < 128) {
        const int row = tid >> 1, ch = tid & 1;
        *(uint4*)(sVimg + 16384 + vimg_off(row, ch)) = ch ? make_uint4(0, 0, 0, 0) : make_uint4(0x3F80u, 0, 0, 0);
    }
#pragma unroll
    for (int i = 0; i < 8; ++i) {
        const int pos = p0 + i, row = 8 * rg + i;
        float o[8];
#pragma unroll
        for (int e = 0; e < 8; ++e) {
            const unsigned w0 = (&raw[i].x)[e >> 1], w1 = (&raw[i + 1].x)[e >> 1], w2 = (&raw[i + 2].x)[e >> 1], w3 = (&raw[i + 3].x)[e >> 1];
            const float x0 = (e & 1) ? bfhi(w0) : bflo(w0), x1 = (e & 1) ? bfhi(w1) : bflo(w1), x2 = (e & 1) ? bfhi(w2) : bflo(w2), x3 = (e & 1) ? bfhi(w3) : bflo(w3);
            const float cv = w[0][e] * x0 + w[1][e] * x1 + w[2][e] * x2 + w[3][e] * x3;
            o[e] = oscale * cv / (1.f + __expf(-cv));
        }
        uint4 ov; ov.x = pk2(o[0], o[1]); ov.y = pk2(o[2], o[3]); ov.z = pk2(o[4], o[5]); ov.w = pk2(o[6], o[7]);
        const bool ok = pos < L;
        if (!ok) ov = make_uint4(0, 0, 0, 0);
        if (ok) *(uint4*)(qk + (size_t)(b * L + pos) * 1024 + (isk ? 512 : 0) + h * 128 + (cch & 15) * 8) = ov;
        if (isk) { const int ch16 = cch & 15; *(uint4*)(sKimg + (ch16 >> 3) * 8192 + vimg_off(row, ch16 & 7)) = ov; }
    }
}

__device__ __forceinline__ void mlstm_A(const Params& P, int item, unsigned char* smem) {
    const int tid = opaque_tid(), lane = tid & 63, w = tid >> 6, g = lane >> 4, lr = lane & 15;
    const int wu = __builtin_amdgcn_readfirstlane(w);
    const int k = item >> 5, bh = item & 31, b = bh >> 2, h = bh & 3;
    const float* gates = (const float*)(P.ws + WS_GATES);
    const unsigned char* sK = smem; const unsigned char* sV = smem + 16384;
    float* ga = (float*)(smem + 40960);
    mlstm_stage_A(P, b, h, k, smem, smem + 16384, tid);
    if (wu == 0) {
        const int pos = 64 * k + lane;
        float lf = 0.f, li = -INFINITY;
        if (pos < L) { lf = gates[(size_t)(b * L + pos) * 16 + 4 + h]; li = gates[(size_t)(b * L + pos) * 16 + h]; }
        float bc = lf;
#pragma unroll
        for (int o = 1; o < 64; o <<= 1) { const float n = __shfl_up(bc, o, 64); if (lane >= o) bc += n; }
        const float a = li - bc;
        const float A = wave_max(a);
        ga[lane] = __expf(a - A);
        if (lane == 63) { float* msc = (float*)(P.ws + WS_MSC) + ((size_t)bh * 33 + k) * 4; msc[0] = A; msc[1] = bc; }
    }
    __syncthreads();
    f32x4 Ct[2][9];
#pragma unroll
    for (int a = 0; a < 2; ++a)
#pragma unroll
        for (int c = 0; c < 9; ++c) Ct[a][c] = (f32x4){0.f, 0.f, 0.f, 0.f};
    bf16x8 kt[2][2];
#pragma unroll
    for (int a = 0; a < 2; ++a)
#pragma unroll
        for (int s2 = 0; s2 < 2; ++s2) {
            const int jt = 2 * w + a;
            kt[a][s2] = tr_pair(tr_frag(sK + (jt >> 2) * 8192, 32 * s2, jt & 3, g, lr), tr_frag(sK + (jt >> 2) * 8192, 32 * s2 + 16, jt & 3, g, lr));
        }
    f32x4 wg4[4];
#pragma unroll
    for (int j = 0; j < 4; ++j) wg4[j] = *(const f32x4*)(ga + 16 * j + 4 * g);
#define MA_TILE(c, lo0, hi0, lo1, hi1) { \
        { const f32x4 w0 = wg4[0], w1 = wg4[1]; uint4 o; \
          o.x = cvt_pk_bf16(bflo(lo0.x) * w0[0], bfhi(lo0.x) * w0[1]); o.y = cvt_pk_bf16(bflo(lo0.y) * w0[2], bfhi(lo0.y) * w0[3]); \
          o.z = cvt_pk_bf16(bflo(hi0.x) * w1[0], bfhi(hi0.x) * w1[1]); o.w = cvt_pk_bf16(bflo(hi0.y) * w1[2], bfhi(hi0.y) * w1[3]); \
          const bf16x8 vw = __builtin_bit_cast(bf16x8, o); \
          Ct[0][c] = __builtin_amdgcn_mfma_f32_16x16x32_bf16(kt[0][0], vw, Ct[0][c], 0, 0, 0); Ct[1][c] = __builtin_amdgcn_mfma_f32_16x16x32_bf16(kt[1][0], vw, Ct[1][c], 0, 0, 0); } \
        { const f32x4 w0 = wg4[2], w1 = wg4[3]; uint4 o; \
          o.x = cvt_pk_bf16(bflo(lo1.x) * w0[0], bfhi(lo1.x) * w0[1]); o.y = cvt_pk_bf16(bflo(lo1.y) * w0[2], bfhi(lo1.y) * w0[3]); \
          o.z = cvt_pk_bf16(bflo(hi1.x) * w1[0], bfhi(hi1.x) * w1[1]); o.w = cvt_pk_bf16(bflo(hi1.y) * w1[2], bfhi(hi1.y) * w1[3]); \
          const bf16x8 vw = __builtin_bit_cast(bf16x8, o); \
          Ct[0][c] = __builtin_amdgcn_mfma_f32_16x16x32_bf16(kt[0][1], vw, Ct[0][c], 0, 0, 0); Ct[1][c] = __builtin_amdgcn_mfma_f32_16x16x32_bf16(kt[1][1], vw, Ct[1][c], 0, 0, 0); } }
    {
        uint2 vr[4][4];
        tr_read_4c(sV, g, lr, vr);
        MA_TILE(0, vr[0][0], vr[0][1], vr[0][2], vr[0][3]) MA_TILE(1, vr[1][0], vr[1][1], vr[1][2], vr[1][3])
        MA_TILE(2, vr[2][0], vr[2][1], vr[2][2], vr[2][3]) MA_TILE(3, vr[3][0], vr[3][1], vr[3][2], vr[3][3])
        tr_read_4c(sV + 8192, g, lr, vr);
        MA_TILE(4, vr[0][0], vr[0][1], vr[0][2], vr[0][3]) MA_TILE(5, vr[1][0], vr[1][1], vr[1][2], vr[1][3])
        MA_TILE(6, vr[2][0], vr[2][1], vr[2][2], vr[2][3]) MA_TILE(7, vr[3][0], vr[3][1], vr[3][2], vr[3][3])
        const uint2 o0 = tr_frag(sV + 16384, 0, 0, g, lr), o1 = tr_frag(sV + 16384, 16, 0, g, lr), o2 = tr_frag(sV + 16384, 32, 0, g, lr), o3 = tr_frag(sV + 16384, 48, 0, g, lr);
        MA_TILE(8, o0, o1, o2, o3)
    }
#undef MA_TILE
    unsigned char* slot = P.ws + WS_MST + ((size_t)bh * 33 + k) * ST_IMG;
#pragma unroll
    for (int a = 0; a < 2; ++a)
#pragma unroll
        for (int c = 0; c < 9; ++c) {
            uint2 u; u.x = cvt_pk_bf16(Ct[a][c][0], Ct[a][c][1]); u.y = cvt_pk_bf16(Ct[a][c][2], Ct[a][c][3]);
            *(uint2*)(slot + st_piece_off(2 * w + a, c, g, lr)) = u;
        }
}

__device__ __forceinline__ void mlstm_B(const Params& P, int item) {
    const int tid = opaque_tid();
    const int bh = item / 3, part = item - bh * 3;
    const unsigned char* base = P.ws + WS_MST + (size_t)bh * 33 * ST_IMG + part * 12288 + tid * 48;
    unsigned char* obase = P.ws + WS_CBI + (size_t)bh * 33 * ST_IMG + part * 12288 + tid * 48;
    float* msc = (float*)(P.ws + WS_MSC) + (size_t)bh * 33 * 4;
    float C[6][4];
#pragma unroll
    for (int i = 0; i < 6; ++i)
#pragma unroll
        for (int r = 0; r < 4; ++r) C[i][r] = 0.f;
    float m = 0.f;
    uint2 d0[6], d1[6];
    float2 ab0, ab1;
#pragma unroll
    for (int i = 0; i < 6; ++i) { d0[i] = *(const uint2*)(base + i * 8); d1[i] = *(const uint2*)(base + ST_IMG + i * 8); }
    ab0 = *(const float2*)(msc); ab1 = *(const float2*)(msc + 4);
    for (int k = 0; k < 33; ++k) {
        uint2 d2[6]; float2 ab2 = make_float2(0.f, 0.f);
        if (k + 2 < 33) {
#pragma unroll
            for (int i = 0; i < 6; ++i) d2[i] = *(const uint2*)(base + (size_t)(k + 2) * ST_IMG + i * 8);
            ab2 = *(const float2*)(msc + (k + 2) * 4);
        } else {
#pragma unroll
            for (int i = 0; i < 6; ++i) d2[i] = make_uint2(0, 0);
        }
#pragma unroll
        for (int i = 0; i < 6; ++i) {
            uint2 u; u.x = cvt_pk_bf16(C[i][0], C[i][1]); u.y = cvt_pk_bf16(C[i][2], C[i][3]);
            *(uint2*)(obase + (size_t)k * ST_IMG + i * 8) = u;
        }
        if (tid == 0 && part == 0) msc[k * 4 + 2] = m;
        const float M = fmaxf(m, ab0.x);
        const float decay = __expf(m - M), sc = __expf(ab0.x - M);
#pragma unroll
        for (int i = 0; i < 6; ++i) {
            C[i][0] = decay * C[i][0] + sc * bflo(d0[i].x); C[i][1] = decay * C[i][1] + sc * bfhi(d0[i].x);
            C[i][2] = decay * C[i][2] + sc * bflo(d0[i].y); C[i][3] = decay * C[i][3] + sc * bfhi(d0[i].y);
        }
        m = ab0.y + M;
#pragma unroll
        for (int i = 0; i < 6; ++i) { d0[i] = d1[i]; d1[i] = d2[i]; }
        ab0 = ab1; ab1 = ab2;
    }
}

__device__ __forceinline__ void mlstm_C(const Params& P, int item, unsigned char* smem) {
    const int tid = opaque_tid(), lane = tid & 63, w = tid >> 6, g = lane >> 4, lr = lane & 15;
    const int wu = __builtin_amdgcn_readfirstlane(w);
    const int k = item >> 5, bh = item & 31, b = bh >> 2, h = bh & 3;
    const bf16_t* z = (const bf16_t*)(P.ws + WS_Z);
    const bf16_t* qk = (const bf16_t*)(P.ws + WS_RA);
    const float* gates = (const float*)(P.ws + WS_GATES);
    bf16_t* y = (bf16_t*)(P.ws + WS_Z);
    const unsigned char* sK = smem; const unsigned char* sV = smem + 36864; unsigned char* sCb = smem;
    float* ga = (float*)(smem + 61440);
    const int pos = 64 * k + 16 * w + lr;
    const bool tvalid = pos < L;
    const size_t rrow = (size_t)(b * L + (tvalid ? pos : 0));
    const unsigned char* cslot = P.ws + WS_CBI + ((size_t)bh * 33 + k) * ST_IMG + tid * 16;
    const uint4 cb0 = *(const uint4*)(cslot), cb1 = *(const uint4*)(cslot + 4096), cb2 = *(const uint4*)(cslot + 8192), cb3 = *(const uint4*)(cslot + 12288), cb4 = *(const uint4*)(cslot + 16384),
                cb5 = *(const uint4*)(cslot + 20480), cb6 = *(const uint4*)(cslot + 24576), cb7 = *(const uint4*)(cslot + 28672), cb8 = *(const uint4*)(cslot + 32768);
    bf16x8 qf[4];
    {
        const bf16_t* qp = qk + rrow * 1024 + h * 128 + 8 * g;
#pragma unroll
        for (int ks = 0; ks < 4; ++ks) { qf[ks] = *(const bf16x8*)(qp + 32 * ks); if (!tvalid) qf[ks] = (bf16x8){0, 0, 0, 0, 0, 0, 0, 0}; }
    }
    mlstm_stage_kv(P, b, h, k, smem, smem + 36864, tid);
    if (wu == 0) {
        const float m_prev = ((const float*)(P.ws + WS_MSC))[((size_t)bh * 33 + k) * 4 + 2];
        const int p2 = 64 * k + lane;
        float lf = 0.f, li = -INFINITY;
        if (p2 < L) { lf = gates[(size_t)(b * L + p2) * 16 + 4 + h]; li = gates[(size_t)(b * L + p2) * 16 + h]; }
        float bc = lf;
#pragma unroll
        for (int o = 1; o < 64; o <<= 1) { const float n = __shfl_up(bc, o, 64); if (lane >= o) bc += n; }
        const float a = li - bc;
        float am = a;
#pragma unroll
        for (int o = 1; o < 64; o <<= 1) { const float n = __shfl_up(am, o, 64); if (lane >= o) am = fmaxf(am, n); }
        const float M = fmaxf(m_prev, am);
        ga[lane] = a; ga[64 + lane] = __expf(m_prev - M); ga[128 + lane] = __expf(-(bc + M)); ga[192 + lane] = M;
    }
    __syncthreads();
    const float Mt = ga[192 + 16 * w + lr], Wi = ga[64 + 16 * w + lr], Et = ga[128 + 16 * w + lr];
    bf16x8 pf[2];
    {
        f32x4 sa[4];
#pragma unroll
        for (int c = 0; c < 4; ++c) {
            sa[c] = (f32x4){0.f, 0.f, 0.f, 0.f};
            if (c <= wu) {
#pragma unroll
                for (int ks = 0; ks < 4; ++ks) {
                    const bf16x8 kf = *(const bf16x8*)(sK + (ks >> 1) * 8192 + vimg_off(16 * c + lr, 4 * (ks & 1) + g));
                    sa[c] = __builtin_amdgcn_mfma_f32_16x16x32_bf16(kf, qf[ks], sa[c], 0, 0, 0);
                }
                const f32x4 av = *(const f32x4*)(ga + 16 * c + 4 * g);
#pragma unroll
                for (int r = 0; r < 4; ++r) {
                    const float d = __expf(av[r] - Mt);
                    sa[c][r] = (16 * c + 4 * g + r <= 16 * w + lr) ? sa[c][r] * d : 0.f;
                }
            }
        }
#pragma unroll
        for (int s2 = 0; s2 < 2; ++s2) {
            uint4 u;
            u.x = cvt_pk_bf16(sa[2 * s2][0], sa[2 * s2][1]); u.y = cvt_pk_bf16(sa[2 * s2][2], sa[2 * s2][3]);
            u.z = cvt_pk_bf16(sa[2 * s2 + 1][0], sa[2 * s2 + 1][1]); u.w = cvt_pk_bf16(sa[2 * s2 + 1][2], sa[2 * s2 + 1][3]);
            pf[s2] = __builtin_bit_cast(bf16x8, u);
        }
    }
    __syncthreads();
    {
        unsigned char* d = sCb + tid * 16;
        *(uint4*)(d) = cb0; *(uint4*)(d + 4096) = cb1; *(uint4*)(d + 8192) = cb2; *(uint4*)(d + 12288) = cb3; *(uint4*)(d + 16384) = cb4;
        *(uint4*)(d + 20480) = cb5; *(uint4*)(d + 24576) = cb6; *(uint4*)(d + 28672) = cb7; *(uint4*)(d + 32768) = cb8;
    }
    __syncthreads();
    f32x4 na[9];
#define MC_TILE(c, lo0, hi0, lo1, hi1) { \
        na[c] = (f32x4){0.f, 0.f, 0.f, 0.f}; \
        _Pragma("unroll") for (int ks = 0; ks < 4; ++ks) { \
            const bf16x8 cf = *(const bf16x8*)(sCb + (ks >> 1) * 18432 + vimg_off(16 * (c) + lr, 4 * (ks & 1) + g)); \
            na[c] = __builtin_amdgcn_mfma_f32_16x16x32_bf16(cf, qf[ks], na[c], 0, 0, 0); } \
        na[c] *= Wi; \
        na[c] = __builtin_amdgcn_mfma_f32_16x16x32_bf16(tr_pair(lo0, hi0), pf[0], na[c], 0, 0, 0); \
        na[c] = __builtin_amdgcn_mfma_f32_16x16x32_bf16(tr_pair(lo1, hi1), pf[1], na[c], 0, 0, 0); }
    {
        uint2 vr[4][4];
        tr_read_4c(sV, g, lr, vr);
        MC_TILE(0, vr[0][0], vr[0][1], vr[0][2], vr[0][3]) MC_TILE(1, vr[1][0], vr[1][1], vr[1][2], vr[1][3])
        MC_TILE(2, vr[2][0], vr[2][1], vr[2][2], vr[2][3]) MC_TILE(3, vr[3][0], vr[3][1], vr[3][2], vr[3][3])
        tr_read_4c(sV + 8192, g, lr, vr);
        MC_TILE(4, vr[0][0], vr[0][1], vr[0][2], vr[0][3]) MC_TILE(5, vr[1][0], vr[1][1], vr[1][2], vr[1][3])
        MC_TILE(6, vr[2][0], vr[2][1], vr[2][2], vr[2][3]) MC_TILE(7, vr[3][0], vr[3][1], vr[3][2], vr[3][3])
        const uint2 o0 = tr_frag(sV + 16384, 0, 0, g, lr), o1 = tr_frag(sV + 16384, 16, 0, g, lr), o2 = tr_frag(sV + 16384, 32, 0, g, lr), o3 = tr_frag(sV + 16384, 48, 0, g, lr);
        MC_TILE(8, o0, o1, o2, o3)
    }
#undef MC_TILE
    const float den = __shfl(na[8][0], lr, 64);
    const float rden = 1.0f / fmaxf(fabsf(den), Et);
    float hs = 0.f;
#pragma unroll
    for (int c = 0; c < 8; ++c) { na[c] *= rden; hs += na[c][0] * na[c][0] + na[c][1] * na[c][1] + na[c][2] * na[c][2] + na[c][3] * na[c][3]; }
    hs = x4_sum(hs);
    const float rstd = rsqrtf(hs * (1.0f / 128.0f) + EPS);
    const float* gainp = P.m_out_norm + h * 128 + 4 * g;
#pragma unroll
    for (int c = 0; c < 8; ++c) {
        const uint2 og = *(const uint2*)(z + rrow * NZ + ZC_MO + h * 128 + 16 * c + 4 * g);
        const float o0 = bflo(og.x), o1 = bfhi(og.x), o2 = bflo(og.y), o3 = bfhi(og.y);
        const float4 gn = *(const float4*)(gainp + 16 * c);
        uint2 u;
        u.x = pk2(na[c][0] * rstd * gn.x / (1.f + __expf(-o0)), na[c][1] * rstd * gn.y / (1.f + __expf(-o1)));
        u.y = pk2(na[c][2] * rstd * gn.z / (1.f + __expf(-o2)), na[c][3] * rstd * gn.w / (1.f + __expf(-o3)));
        if (tvalid) *(uint2*)(y + rrow * NZ + h * 128 + 16 * c + 4 * g) = u;
    }
}

__device__ __forceinline__ void peer_token(const Params& P, int t, int lane, int* sidx, float* sval, int* sid, float* sgate, const unsigned char* slut, const unsigned* szero) {
    const unsigned* tk = (const unsigned*)(P.ws + WS_TK) + (size_t)t * 256;
#pragma unroll
    for (int i = 0; i < 4; ++i) {
        const unsigned k = tk[lane * 4 + i];
        sidx[lane * 4 + i] = 127 - (int)(k & 127u);
        sval[lane * 4 + i] = unord_key(k & ~127u);
    }
    __builtin_amdgcn_s_waitcnt(0xc07f);
    __builtin_amdgcn_wave_barrier();
    {
        const int hd = lane >> 3, sub = lane & 7;
        unsigned x[8];
#pragma unroll
        for (int r = 0; r < 8; ++r) {
            const int c = sub * 8 + r;
            const unsigned ij = slut[c < 50 ? c : 0];
            const int i = ij >> 4, j = ij & 15;
            const unsigned kx = (ord_key(sval[(2 * hd) * 16 + i] + sval[(2 * hd + 1) * 16 + j]) & ~255u) | (unsigned)(255 - (i * 16 + j));
            x[r] = c < 50 ? kx : 0u;
        }
#pragma unroll
        for (int k = 2; k <= 64; k <<= 1) {
#pragma unroll
            for (int j = k >> 1; j >= 1; j >>= 1) {
                if (j >= 8) {
                    const int ld = j >> 3;
                    const bool lower = (sub & ld) == 0;
                    const bool desc = k >= 64 ? true : ((sub * 8) & k) == 0;
                    const bool takemax = (lower == desc);
#pragma unroll
                    for (int r = 0; r < 8; ++r) {
                        const unsigned o = (unsigned)__shfl_xor((int)x[r], ld, 64);
                        const unsigned hi = max(x[r], o), lo = min(x[r], o);
                        x[r] = takemax ? hi : lo;
                    }
                } else {
#pragma unroll
                    for (int r = 0; r < 8; ++r) {
                        if ((r & j) == 0) {
                            const int p = r | j;
                            const unsigned hi = max(x[r], x[p]), lo = min(x[r], x[p]);
                            if (k <= 4) { const bool desc = (r & k) == 0; x[r] = desc ? hi : lo; x[p] = desc ? lo : hi; }
                            else if (k >= 64) { x[r] = hi; x[p] = lo; }
                            else { const bool desc = ((sub * 8) & k) == 0; x[r] = desc ? hi : lo; x[p] = desc ? lo : hi; }
                        }
                    }
                }
            }
        }
        const float smax = unord_key((unsigned)__shfl((int)x[0], hd * 8, 64) & ~255u);
        float e[8]; float den = 0.f;
#pragma unroll
        for (int r = 0; r < 8; ++r) { e[r] = __expf(unord_key(x[r] & ~255u) - smax); den += e[r]; }
        den += __shfl_xor(den, 1, 64);
        const float inv = 1.f / den;
        if (sub < 2) {
#pragma unroll
            for (int r = 0; r < 8; ++r) {
                const int pos = 255 - (int)(x[r] & 255u), i = pos >> 4, j = pos & 15;
                sid[hd * 16 + sub * 8 + r] = sidx[(2 * hd) * 16 + i] * 128 + sidx[(2 * hd + 1) * 16 + j];
                sgate[hd * 16 + sub * 8 + r] = e[r] * inv;
            }
        }
    }
    __builtin_amdgcn_s_waitcnt(0xc07f);
    __builtin_amdgcn_wave_barrier();
    const bf16_t* xn = (const bf16_t*)(P.ws + WS_XN) + (size_t)t * DM;
    const float rstd = ((const float*)(P.ws + WS_RSTD))[t];
    const unsigned char* V = P.ws + WS_V + lane * 8;
    const float* usc = (const float*)(P.ws + WS_USC);
    const float* vsc = (const float*)(P.ws + WS_VSC);
    const int g = lane >> 4, lr = lane & 15;
    unsigned char* shi = (unsigned char*)sval;
    unsigned char* slo = (unsigned char*)sidx;
    {
        const uint4 xa = *(const uint4*)(xn + lane * 16), xb = *(const uint4*)(xn + lane * 16 + 8);
        const unsigned xw[8] = {xa.x, xa.y, xa.z, xa.w, xb.x, xb.y, xb.z, xb.w};
        unsigned hi[4], lo[4];
#pragma unroll
        for (int i = 0; i < 4; ++i) {
            const float x0 = bflo(xw[2 * i]), x1 = bfhi(xw[2 * i]), x2 = bflo(xw[2 * i + 1]), x3 = bfhi(xw[2 * i + 1]);
            int wd = 0;
            wd = __builtin_amdgcn_cvt_pk_fp8_f32(x0, x1, wd, false);
            wd = __builtin_amdgcn_cvt_pk_fp8_f32(x2, x3, wd, true);
            const f32x2 h01 = __builtin_amdgcn_cvt_pk_f32_fp8(wd, false), h23 = __builtin_amdgcn_cvt_pk_f32_fp8(wd, true);
            int wl = 0;
            wl = __builtin_amdgcn_cvt_pk_fp8_f32(x0 - h01.x, x1 - h01.y, wl, false);
            wl = __builtin_amdgcn_cvt_pk_fp8_f32(x2 - h23.x, x3 - h23.y, wl, true);
            hi[i] = (unsigned)wd; lo[i] = (unsigned)wl;
        }
        *(uint4*)(shi + lane * 16) = make_uint4(hi[0], hi[1], hi[2], hi[3]);
        *(uint4*)(slo + lane * 16) = make_uint4(lo[0], lo[1], lo[2], lo[3]);
    }
    __builtin_amdgcn_s_waitcnt(0xc07f);
    __builtin_amdgcn_wave_barrier();
    {
        typedef int v8i __attribute__((ext_vector_type(8)));
        const unsigned char* Ub = P.ws + WS_U + 16 * g;
        const unsigned char* bsrc = (lr == 0) ? (shi + 16 * g) : (lr == 1) ? (slo + 16 * g) : (const unsigned char*)szero;
        const int bstep = (lr < 2) ? 128 : 0, bhalf = (lr < 2) ? 64 : 16;
        v8i Bv[8];
#pragma unroll
        for (int st = 0; st < 8; ++st) {
            const uint4 b0 = *(const uint4*)(bsrc + bstep * st), b1 = *(const uint4*)(bsrc + bstep * st + bhalf);
            Bv[st] = (v8i){(int)b0.x, (int)b0.y, (int)b0.z, (int)b0.w, (int)b1.x, (int)b1.y, (int)b1.z, (int)b1.w};
        }
        unsigned off[8];
#pragma unroll
        for (int T = 0; T < 8; ++T) off[T] = (unsigned)sid[16 * T + lr] * 512u;
        __builtin_amdgcn_s_waitcnt(0xc07f);
        __builtin_amdgcn_wave_barrier();
        float* sact = (float*)sidx + ((lr == 1) ? 128 : 0);
        uint4 abuf[2][8];
#pragma unroll
        for (int st = 0; st < 8; ++st) abuf[0][st] = *(const uint4*)(Ub + off[0] + 64 * st);
#pragma unroll
        for (int T = 0; T < 8; ++T) {
            if (T + 1 < 8) {
#pragma unroll
                for (int st = 0; st < 8; ++st) abuf[(T + 1) & 1][st] = *(const uint4*)(Ub + off[T + 1] + 64 * st);
            }
            f32x4 au = (f32x4){0.f, 0.f, 0.f, 0.f};
#pragma unroll
            for (int st = 0; st < 8; ++st) {
                const uint4 a4 = abuf[T & 1][st];
                const v8i Av = {(int)a4.x, (int)a4.y, (int)a4.z, (int)a4.w, 0, 0, 0, 0};
                au = __builtin_amdgcn_mfma_scale_f32_16x16x128_f8f6f4(Av, Bv[st], au, 4, 0, 0, 0x7f7f7f7f, 0, 0x7f7f7f7f);
            }
            if (lr < 2) *(f32x4*)(sact + 16 * T + 4 * g) = au;
        }
    }
    __builtin_amdgcn_s_waitcnt(0xc07f);
    __builtin_amdgcn_wave_barrier();
    {
        float* sw = (float*)sidx;
        float wv[2];
#pragma unroll
        for (int hh = 0; hh < 2; ++hh) {
            const int e = lane + 64 * hh, id = sid[e];
            const float a = (sw[e] + sw[128 + e]) * usc[id] * rstd;
            wv[hh] = sgate[e] * vsc[id] * 0.5f * a * (1.f + erff(a * 0.70710678118654752f));
        }
        sw[lane] = wv[0]; sw[lane + 64] = wv[1];
    }
    __builtin_amdgcn_s_waitcnt(0xc07f);
    __builtin_amdgcn_wave_barrier();
    f32x2 acc[8];
#pragma unroll
    for (int j = 0; j < 8; ++j) acc[j] = (f32x2){0.f, 0.f};
#pragma unroll 1
    for (int e0 = 0; e0 < 128; e0 += 16) {
        uint2 vr[16];
#pragma unroll
        for (int q = 0; q < 16; ++q) vr[q] = *(const uint2*)(V + (size_t)sid[e0 + q] * 512);
        const float* sw = (const float*)sidx + e0;
        const f32x4 w0 = *(const f32x4*)(sw), w1 = *(const f32x4*)(sw + 4), w2 = *(const f32x4*)(sw + 8), w3 = *(const f32x4*)(sw + 12);
        const float wq[16] = {w0[0], w0[1], w0[2], w0[3], w1[0], w1[1], w1[2], w1[3], w2[0], w2[1], w2[2], w2[3], w3[0], w3[1], w3[2], w3[3]};
#pragma unroll
        for (int q = 0; q < 16; ++q) {
            const float w = wq[q];
#define FP4_AXPY(k) { acc[k] += w * __builtin_amdgcn_cvt_scalef32_pk_f32_fp4(vr[q].x, 1.0f, k); acc[4 + k] += w * __builtin_amdgcn_cvt_scalef32_pk_f32_fp4(vr[q].y, 1.0f, k); }
            FP4_AXPY(0) FP4_AXPY(1) FP4_AXPY(2) FP4_AXPY(3)
#undef FP4_AXPY
        }
    }
    f32x2 xf[8];
    {
        const uint4 xa = *(const uint4*)(xn + lane * 16), xb = *(const uint4*)(xn + lane * 16 + 8);
        xf[0] = (f32x2){bflo(xa.x), bfhi(xa.x)}; xf[1] = (f32x2){bflo(xa.y), bfhi(xa.y)}; xf[2] = (f32x2){bflo(xa.z), bfhi(xa.z)}; xf[3] = (f32x2){bflo(xa.w), bfhi(xa.w)};
        xf[4] = (f32x2){bflo(xb.x), bfhi(xb.x)}; xf[5] = (f32x2){bflo(xb.y), bfhi(xb.y)}; xf[6] = (f32x2){bflo(xb.z), bfhi(xb.z)}; xf[7] = (f32x2){bflo(xb.w), bfhi(xb.w)};
    }
    float* o = P.out + (size_t)t * DM + lane * 16;
    float4 h0, h1, h2, h3;
    {
        const float4 g0 = *(const float4*)(P.norm_ffn + lane * 16), g1 = *(const float4*)(P.norm_ffn + lane * 16 + 4), g2 = *(const float4*)(P.norm_ffn + lane * 16 + 8), g3 = *(const float4*)(P.norm_ffn + lane * 16 + 12);
        h0.x = xf[0].x / g0.x + acc[0].x; h0.y = xf[0].y / g0.y + acc[0].y; h0.z = xf[1].x / g0.z + acc[1].x; h0.w = xf[1].y / g0.w + acc[1].y;
        h1.x = xf[2].x / g1.x + acc[2].x; h1.y = xf[2].y / g1.y + acc[2].y; h1.z = xf[3].x / g1.z + acc[3].x; h1.w = xf[3].y / g1.w + acc[3].y;
        h2.x = xf[4].x / g2.x + acc[4].x; h2.y = xf[4].y / g2.y + acc[4].y; h2.z = xf[5].x / g2.z + acc[5].x; h2.w = xf[5].y / g2.w + acc[5].y;
        h3.x = xf[6].x / g3.x + acc[6].x; h3.y = xf[6].y / g3.y + acc[6].y; h3.z = xf[7].x / g3.z + acc[7].x; h3.w = xf[7].y / g3.w + acc[7].y;
    }
    *(float4*)(o) = h0; *(float4*)(o + 4) = h1; *(float4*)(o + 8) = h2; *(float4*)(o + 12) = h3;
    __builtin_amdgcn_s_waitcnt(0xc07f);
    __builtin_amdgcn_wave_barrier();
}

#define LAS __attribute__((address_space(3)))
#define XB_TMO      128
#define XB_XCNT(j)  (256  + 64 * (j))
#define XB_XSUB(j)  (1280 + 64 * (j))
#define XB_XGEN(j)  (2304 + 64 * (j))
#define XB_TOP      3328
#define XB_TOPGEN   3392
#define XCD_BAR_WORDS 3456
#define XB_SPIN_CAP (1u << 18)
__device__ __forceinline__ unsigned xb_ld(unsigned* p)              { return __hip_atomic_load(p, __ATOMIC_RELAXED, __HIP_MEMORY_SCOPE_AGENT); }
__device__ __forceinline__ unsigned xb_add(unsigned* p, unsigned v) { return __hip_atomic_fetch_add(p, v, __ATOMIC_RELAXED, __HIP_MEMORY_SCOPE_AGENT); }
__device__ __forceinline__ unsigned xb_xcc_id() { return (unsigned)__builtin_amdgcn_s_getreg((3 << 11) | 20) & 0xFu; }
#define XB_SPIN(cond, bar) do { unsigned _sp = 0; while (cond) { __builtin_amdgcn_s_sleep(1); \
    if ((++_sp & 255u) == 0u) { if (xb_ld(&(bar)[XB_TMO])) break; if (_sp > XB_SPIN_CAP) { atomicAdd(&(bar)[XB_TMO], 1u); break; } } } } while (0)
struct XcdBarrier { unsigned* bar; unsigned x; volatile LAS unsigned* st; };
__device__ __forceinline__ XcdBarrier xcd_barrier_post(unsigned* bar, volatile LAS unsigned* st) {
    XcdBarrier b; b.bar = bar; b.x = xb_xcc_id(); b.st = st;
    if (threadIdx.x == 0) (void)xb_add(&bar[XB_XCNT(b.x)], 1u);
    return b;
}
__device__ __forceinline__ void xcd_barrier_complete(unsigned* bar, unsigned x, unsigned& nloc, unsigned& nx) {
    const unsigned G = gridDim.x * gridDim.y * gridDim.z;
    unsigned sum, cnt, mine, sp = 0u;
    for (;;) {
        sum = 0u; cnt = 0u; mine = 0u;
#pragma unroll
        for (unsigned j = 0; j < 16; ++j) { const unsigned c = xb_ld(&bar[XB_XCNT(j)]); sum += c; cnt += (c > 0u) ? 1u : 0u; mine = (j == x) ? c : mine; }
        if (sum == G) break;
        __builtin_amdgcn_s_sleep(1);
        if ((++sp & 255u) == 0u) { if (xb_ld(&bar[XB_TMO])) break; if (sp > XB_SPIN_CAP) { atomicAdd(&bar[XB_TMO], 1u); break; } }
    }
    nloc = mine > 0u ? mine : 1u; nx = cnt > 0u ? cnt : 1u;
}
__device__ __forceinline__ void xcd_barrier(const XcdBarrier& b) {
    asm volatile("s_waitcnt vmcnt(0)" ::: "memory");
    __syncthreads();
    if (threadIdx.x == 0) {
        unsigned* bar = b.bar;
        __builtin_amdgcn_s_waitcnt(0);
        unsigned nloc = b.st[0], nx = b.st[1];
        if (nloc == 0u) { xcd_barrier_complete(bar, b.x, nloc, nx); b.st[0] = nloc; b.st[1] = nx; }
        const unsigned old = xb_add(&bar[XB_XSUB(b.x)], 1u);
        const unsigned gen = old / nloc;
        if (old + 1u == (gen + 1u) * nloc) {
            __builtin_amdgcn_fence(__ATOMIC_RELEASE, "agent");
            asm volatile("s_waitcnt vmcnt(0)" ::: "memory");
            const unsigned og = xb_add(&bar[XB_TOP], 1u);
            const unsigned tg = og / nx;
            if (og + 1u == (tg + 1u) * nx) xb_add(&bar[XB_TOPGEN], 1u);
            else XB_SPIN(xb_ld(&bar[XB_TOPGEN]) == tg, bar);
            __builtin_amdgcn_fence(__ATOMIC_ACQUIRE, "agent");
            xb_add(&bar[XB_XGEN(b.x)], 1u);
            asm volatile("s_waitcnt vmcnt(0)" ::: "memory");
        } else {
            XB_SPIN(xb_ld(&bar[XB_XGEN(b.x)]) == gen, bar);
            __builtin_amdgcn_fence(__ATOMIC_ACQUIRE, "agent");
            asm volatile("s_waitcnt vmcnt(0)" ::: "memory");
        }
    }
    __syncthreads();
}

__device__ __forceinline__ void hand_release() { asm volatile("s_waitcnt vmcnt(0)" ::: "memory"); __builtin_amdgcn_fence(__ATOMIC_RELEASE, "agent"); asm volatile("s_waitcnt vmcnt(0)" ::: "memory"); }
__device__ __forceinline__ void hand_acquire() { __builtin_amdgcn_fence(__ATOMIC_ACQUIRE, "agent"); asm volatile("s_waitcnt vmcnt(0)" ::: "memory"); }

__global__ void __launch_bounds__(256, 2) mega(Params P) {
    extern __shared__ __attribute__((aligned(16))) unsigned char smem[];
    const int tid = threadIdx.x, lane = tid & 63, wave = tid >> 6;
    const int G = gridDim.x, bid = blockIdx.x;
    unsigned* ctl = (unsigned*)(P.ws + WS_CTL);
    volatile LAS unsigned* bst = (volatile LAS unsigned*)(smem + 65552);
    if (tid == 0) { bst[0] = 0u; bst[1] = 0u; }
    __syncthreads();
    const XcdBarrier xb = xcd_barrier_post(ctl + 1024, bst);
    unsigned* cucnt = ctl + 5120;
    if (tid == 0) {
        const unsigned phys = ((xb_xcc_id() & 7u) << 8) | ((unsigned)__builtin_amdgcn_s_getreg((7 << 11) | (8 << 6) | 4) & 0xFFu);
        bst[2] = phys; bst[3] = xb_add(&cucnt[phys], 1u);
    }
    phase0(P, smem);
    xcd_barrier(xb);
    {
        int vb;
        const unsigned phys = bst[2];
        unsigned part = 0;
#pragma unroll
        for (int q = 0; q < 8; ++q) { const unsigned i = (unsigned)(tid + 256 * q); const unsigned c = xb_ld(&cucnt[i]); part += (i < phys) ? c : 0u; }
#pragma unroll
        for (int o = 1; o < 64; o <<= 1) part += (unsigned)__shfl_xor((int)part, o, 64);
        if (lane == 0) bst[4 + wave] = part;
        __syncthreads();
        vb = (int)(bst[4] + bst[5] + bst[6] + bst[7] + bst[3]);
        vb = __builtin_amdgcn_readfirstlane(vb);
        if (vb < 0 || vb >= G) vb = bid;
        __syncthreads();
        if (tid == 0) bst[8] = (unsigned)vb;
        __syncthreads();
    }
#define VB_LOAD() __builtin_amdgcn_readfirstlane((int)bst[8])
    {
        const int gw = bid * 4 + wave;
        if (gw < 64) fox_cum_wave(P, gw, lane);
        const int vb = VB_LOAD();
        for (int tile = vb; tile < 129 * 28; tile += G) gemm_tile<1>(P, tile / 28, tile % 28, smem);
        {
            const int rem = (129 * 28) % G;
            if (rem > 0 && rem < G) { if (vb >= rem) convert_uv_rows(P, (vb - rem) * 4 + wave, (G - rem) * 4, lane); }
            else convert_uv_rows(P, vb * 4 + wave, G * 4, lane);
        }
    }
    xcd_barrier(xb);
    {
        volatile int* s_item = (volatile int*)(smem + 65536);
        const int wave_u = __builtin_amdgcn_readfirstlane(wave);
        auto fetch = [&](unsigned* counter) -> int {
            if (wave_u == 0) {
                unsigned v = atomicAdd(counter, lane == 0 ? 1u : 0u);
                *s_item = (int)__builtin_amdgcn_readfirstlane(v);
            }
            __syncthreads();
            const int item = __builtin_amdgcn_readfirstlane(*s_item);
            __syncthreads();
            return item;
        };
        for (;;) {
            const int item = fetch(&ctl[2]);
            if (item >= 33 * 32) break;
            mlstm_A(P, item, smem);
        }
        xcd_barrier(xb);
        for (;;) {
            const int item = fetch(&ctl[4]);
            if (item >= 96) break;
            mlstm_B(P, item);
        }
        for (;;) {
            const int item = fetch(&ctl[3]);
            if (item >= 64 * 17) break;
            attn_block(P, item & 63, 16 - (item >> 6), smem);
        }
        xcd_barrier(xb);
        for (;;) {
            const int item = fetch(&ctl[5]);
            if (item >= 33 * 32) break;
            mlstm_C(P, item, smem);
        }
    }
    xcd_barrier(xb);
    for (int tile = VB_LOAD(); tile < 128 * 8; tile += G) gemm_tile<2>(P, tile >> 3, tile & 7, smem);
    xcd_barrier(xb);
    for (int tile = VB_LOAD(); tile < 128 * 16; tile += G) gemm_tile<3>(P, tile >> 4, tile & 15, smem);
    xcd_barrier(xb);
    {
        unsigned char* slut = smem + 12288;
        if (tid < 64) {
            int c = tid, i = 0;
            while (i < 16 && c >= 16 / (i + 1)) { c -= 16 / (i + 1); ++i; }
            slut[tid] = (unsigned char)(i < 16 ? ((i << 4) | c) : 0);
        }
        unsigned* szero = (unsigned*)(smem + 12288 + 64);
        if (tid < 16) szero[tid] = 0u;
        __syncthreads();
        int* sidx = (int*)(smem + wave * 3072); float* sval = (float*)(smem + wave * 3072 + 1024);
        int* sid = (int*)(smem + wave * 3072 + 2048); float* sgate = (float*)(smem + wave * 3072 + 2560);
        int lane5 = lane;
        asm volatile("" : "+v"(lane5));
        for (int t = bid * 4 + wave; t < T2; t += G * 4) peer_token(P, t, lane5, sidx, sval, sid, sgate, slut, szero);
    }
}

}

extern "C" void kernel_launch(void* const* d_in, const int* in_sizes, int n_in, void* d_out, int out_size, void* d_ws, size_t ws_size, hipStream_t stream) {
    if (n_in != 17 || ws_size < WS_END) { fprintf(stderr, "kernel_launch: unexpected n_in %d or ws_size %zu (need %zu)\n", n_in, ws_size, (size_t)WS_END); return; }
    constexpr int LDS_BYTES = 66560;
    static int grid_blocks = 0;
    if (!grid_blocks) {
        int dev = 0, cus = 0, per_cu = 0;
        (void)hipGetDevice(&dev);
        (void)hipDeviceGetAttribute(&cus, hipDeviceAttributeMultiprocessorCount, dev);
        (void)hipFuncSetAttribute((const void*)mega, hipFuncAttributeMaxDynamicSharedMemorySize, LDS_BYTES);
        (void)hipOccupancyMaxActiveBlocksPerMultiprocessor(&per_cu, (const void*)mega, 256, LDS_BYTES);
        if (per_cu < 1) per_cu = 1;
        if (per_cu > 2) per_cu = 2;
        grid_blocks = cus * per_cu;
        fprintf(stderr, "kernel_launch: cus %d per_cu %d grid %d\n", cus, per_cu, grid_blocks);
    }
    Params P{};
    P.x = (const float*)d_in[0]; P.meta = (const float*)d_in[1]; P.norm_mix = (const float*)d_in[2]; P.w_in = (const float*)d_in[3];
    P.conv_qk = (const float*)d_in[4]; P.b_igate = (const float*)d_in[5]; P.b_fgate_m = (const float*)d_in[6]; P.m_out_norm = (const float*)d_in[7];
    P.b_fgate_f = (const float*)d_in[8]; P.f_q_norm = (const float*)d_in[9]; P.f_k_norm = (const float*)d_in[10]; P.w_out = (const float*)d_in[11];
    P.norm_ffn = (const float*)d_in[12]; P.peer_query = (const float*)d_in[13]; P.peer_keys = (const float*)d_in[14]; P.peer_u = (const float*)d_in[15];
    P.peer_v = (const float*)d_in[16]; P.out = (float*)d_out; P.ws = (unsigned char*)d_ws;
    (void)hipMemsetAsync((unsigned char*)d_ws + WS_CTL, 0, 32768, stream);
    void* args[] = {&P};
    hipError_t e = hipLaunchCooperativeKernel((const void*)mega, dim3(grid_blocks), dim3(256), args, LDS_BYTES, stream);
    if (e != hipSuccess) fprintf(stderr, "cooperative launch failed: %s (grid %d)\n", hipGetErrorString(e), grid_blocks);
}
```

```cpp
#include <hip/hip_runtime.h>
#include <stdint.h>
#include <stdio.h>
#include <hip/hip_cooperative_groups.h>
namespace cg = cooperative_groups;

namespace {

constexpr int NB = 8, SEQ = 2048, DM = 1024, NMETA = 16, L = SEQ + NMETA;
constexpr int T1 = NB * L;
constexpr int T2 = NB * SEQ;
constexpr int NZ = 3584;
constexpr int ZC_MQ = 0, ZC_MK = 512, ZC_MV = 1024, ZC_MO = 1536, ZC_FQ = 2048, ZC_FK = 2560, ZC_FV = 3072;
constexpr int PROJ = 3600;
constexpr float EPS = 1e-6f;

constexpr size_t WS_CTL = 0;
constexpr size_t WS_RA = 65536;
constexpr size_t WS_Z = WS_RA + (size_t)T1 * DM * 2;
constexpr size_t WS_GATES = WS_Z + (size_t)T1 * NZ * 2;
constexpr size_t WS_CUM = WS_GATES + (size_t)T1 * 16 * 4;
constexpr size_t WS_SSQ = WS_CUM + (size_t)NB * 8 * L * 4;
constexpr size_t WS_RSTD = WS_SSQ + (size_t)T2 * 16 * 4;
constexpr size_t WS_SSQM = WS_RSTD + (size_t)T2 * 4;
constexpr size_t WS_BT2 = WS_SSQM + (size_t)T1 * 16 * 4;
constexpr size_t WS_BT3 = WS_BT2 + (size_t)DM * DM * 2;
constexpr size_t WS_KEYS = WS_BT3 + (size_t)2048 * DM * 2;
constexpr size_t WS_MSC = WS_KEYS + (size_t)16 * 128 * 128 * 2;
constexpr size_t WS_MST = WS_MSC + (size_t)128 * 33 * 16;
constexpr size_t WS_BT1 = WS_MST + (size_t)32 * 33 * 36864;
constexpr size_t WS_CBI = WS_BT1;
constexpr size_t WS_UV = WS_CBI + (size_t)32 * 33 * 36864;
constexpr size_t WS_END = WS_UV + (size_t)2 * 16384 * 512 + (size_t)2 * 16384 * 4;
constexpr size_t WS_XN = WS_RA;
constexpr size_t WS_U = WS_UV;
constexpr size_t WS_V = WS_U + (size_t)16384 * 512;
constexpr size_t WS_USC = WS_V + (size_t)16384 * 512;
constexpr size_t WS_VSC = WS_USC + (size_t)16384 * 4;
constexpr size_t WS_TK = WS_CBI;
constexpr float LOG2E = 1.4426950408889634f;

typedef unsigned short bf16_t;
typedef short bf16x8 __attribute__((ext_vector_type(8)));
typedef float f32x4 __attribute__((ext_vector_type(4)));
typedef __attribute__((ext_vector_type(2))) __bf16 bf16x2_t;

struct Params {
    const float* x; const float* meta; const float* norm_mix; const float* w_in; const float* conv_qk;
    const float* b_igate; const float* b_fgate_m; const float* m_out_norm; const float* b_fgate_f;
    const float* f_q_norm; const float* f_k_norm; const float* w_out; const float* norm_ffn;
    const float* peer_query; const float* peer_keys; const float* peer_u; const float* peer_v;
    float* out; unsigned char* ws;
};

__device__ __forceinline__ unsigned f2bf(float f) { unsigned u = __float_as_uint(f); return (u + 0x7fffu + ((u >> 16) & 1u)) >> 16; }
__device__ __forceinline__ float bf2f(unsigned h) { return __uint_as_float(h << 16); }
typedef float f32x2 __attribute__((ext_vector_type(2)));
typedef __bf16 bf16x2v __attribute__((ext_vector_type(2)));
__device__ __forceinline__ unsigned cvt_pk_bf16(float lo, float hi) { f32x2 v = {lo, hi}; bf16x2v b = __builtin_convertvector(v, bf16x2v); return __builtin_bit_cast(unsigned, b); }
__device__ __forceinline__ unsigned pk2(float lo, float hi) { return cvt_pk_bf16(lo, hi); }
__device__ __forceinline__ float bflo(unsigned w) { return __uint_as_float(w << 16); }
__device__ __forceinline__ float bfhi(unsigned w) { return __uint_as_float(w & 0xffff0000u); }
__device__ __forceinline__ float wave_sum(float v) {
#pragma unroll
    for (int o = 32; o > 0; o >>= 1) v += __shfl_xor(v, o, 64);
    return v;
}
__device__ __forceinline__ float wave_max(float v) {
#pragma unroll
    for (int o = 32; o > 0; o >>= 1) v = fmaxf(v, __shfl_xor(v, o, 64));
    return v;
}
__device__ __forceinline__ float logsigmoidf(float x) { return fminf(x, 0.f) - log1pf(expf(-fabsf(x))); }
__device__ __forceinline__ unsigned ord_key(float f) { unsigned u = __float_as_uint(f); return u ^ ((u >> 31) ? 0xffffffffu : 0x80000000u); }
__device__ __forceinline__ float unord_key(unsigned k) { unsigned u = (k & 0x80000000u) ? (k ^ 0x80000000u) : ~k; return __uint_as_float(u); }

__device__ __forceinline__ void phase0(const Params& P, unsigned char* smem) {
    const int tid = threadIdx.x, lane = tid & 63, wave = tid >> 6;
    unsigned* ctl = (unsigned*)(P.ws + WS_CTL);
    float* gw = (float*)smem;
    for (int idx = tid; idx < 16 * 1024; idx += 256) {
        const int k = idx >> 4, c = idx & 15;
        const int col = c < 8 ? 2048 + c : 3592 + (c - 8);
        gw[c * 1024 + k] = P.w_in[(size_t)k * PROJ + col];
    }
    __syncthreads();
    {
        bf16_t* hn = (bf16_t*)(P.ws + WS_RA);
        float* gates = (float*)(P.ws + WS_GATES);
        const int c0 = lane * 8, c1 = 512 + lane * 8;
        float gm[16];
        {
            const float4 a0 = *(const float4*)(P.norm_mix + c0), a1 = *(const float4*)(P.norm_mix + c0 + 4);
            const float4 a2 = *(const float4*)(P.norm_mix + c1), a3 = *(const float4*)(P.norm_mix + c1 + 4);
            gm[0] = a0.x; gm[1] = a0.y; gm[2] = a0.z; gm[3] = a0.w; gm[4] = a1.x; gm[5] = a1.y; gm[6] = a1.z; gm[7] = a1.w;
            gm[8] = a2.x; gm[9] = a2.y; gm[10] = a2.z; gm[11] = a2.w; gm[12] = a3.x; gm[13] = a3.y; gm[14] = a3.z; gm[15] = a3.w;
        }
        const int myq = ((lane >> 5) & 1) * 8 + ((lane >> 4) & 1) * 4 + ((lane >> 3) & 1) * 2 + ((lane >> 2) & 1);
        const float mybias = myq < 4 ? P.b_igate[myq] : (myq < 8 ? P.b_fgate_m[myq - 4] : P.b_fgate_f[myq - 8]);
        const int rstep = gridDim.x * 4;
        int r = blockIdx.x * 4 + wave;
        float4 n0, n1, n2, n3;
        auto load_row = [&](int rr) {
            const int b = rr / L, p = rr - b * L;
            const float* src = (p < NMETA) ? (P.meta + (size_t)p * DM) : (P.x + ((size_t)b * SEQ + (p - NMETA)) * DM);
            n0 = *(const float4*)(src + c0); n1 = *(const float4*)(src + c0 + 4); n2 = *(const float4*)(src + c1); n3 = *(const float4*)(src + c1 + 4);
        };
        if (r < T1) load_row(r);
        for (; r < T1; r += rstep) {
            float v[16];
            v[0] = n0.x; v[1] = n0.y; v[2] = n0.z; v[3] = n0.w; v[4] = n1.x; v[5] = n1.y; v[6] = n1.z; v[7] = n1.w;
            v[8] = n2.x; v[9] = n2.y; v[10] = n2.z; v[11] = n2.w; v[12] = n3.x; v[13] = n3.y; v[14] = n3.z; v[15] = n3.w;
            if (r + rstep < T1) load_row(r + rstep);
            float ss = 0.f;
#pragma unroll
            for (int j = 0; j < 16; ++j) ss += v[j] * v[j];
            ss = wave_sum(ss);
            const float rstd = rsqrtf(ss * (1.0f / DM) + EPS);
#pragma unroll
            for (int j = 0; j < 16; ++j) v[j] *= rstd * gm[j];
            uint4 o0, o1;
            o0.x = pk2(v[0], v[1]); o0.y = pk2(v[2], v[3]); o0.z = pk2(v[4], v[5]); o0.w = pk2(v[6], v[7]);
            o1.x = pk2(v[8], v[9]); o1.y = pk2(v[10], v[11]); o1.z = pk2(v[12], v[13]); o1.w = pk2(v[14], v[15]);
            *(uint4*)(hn + (size_t)r * DM + c0) = o0;
            *(uint4*)(hn + (size_t)r * DM + c1) = o1;
            float r8[8], r4[4], r2[2], r1;
#pragma unroll
            for (int i = 0; i < 8; ++i) {
                float dd[2];
#pragma unroll
                for (int hh = 0; hh < 2; ++hh) {
                    const float* gwc = gw + (i + 8 * hh) * 1024;
                    const float4 w0 = *(const float4*)(gwc + c0), w1 = *(const float4*)(gwc + c0 + 4), w2 = *(const float4*)(gwc + c1), w3 = *(const float4*)(gwc + c1 + 4);
                    dd[hh] = v[0] * w0.x + v[1] * w0.y + v[2] * w0.z + v[3] * w0.w + v[4] * w1.x + v[5] * w1.y + v[6] * w1.z + v[7] * w1.w
                           + v[8] * w2.x + v[9] * w2.y + v[10] * w2.z + v[11] * w2.w + v[12] * w3.x + v[13] * w3.y + v[14] * w3.z + v[15] * w3.w;
                }
                const bool up = (lane & 32) != 0; const float keep = up ? dd[1] : dd[0], send = up ? dd[0] : dd[1];
                r8[i] = keep + __shfl_xor(send, 32, 64);
                __builtin_amdgcn_sched_barrier(0);
            }
#pragma unroll
            for (int i = 0; i < 4; ++i) { const bool up = (lane & 16) != 0; const float keep = up ? r8[i + 4] : r8[i], send = up ? r8[i] : r8[i + 4]; r4[i] = keep + __shfl_xor(send, 16, 64); }
#pragma unroll
            for (int i = 0; i < 2; ++i) { const bool up = (lane & 8) != 0; const float keep = up ? r4[i + 2] : r4[i], send = up ? r4[i] : r4[i + 2]; r2[i] = keep + __shfl_xor(send, 8, 64); }
            { const bool up = (lane & 4) != 0; const float keep = up ? r2[1] : r2[0], send = up ? r2[0] : r2[1]; r1 = keep + __shfl_xor(send, 4, 64); }
            r1 += __shfl_xor(r1, 2, 64); r1 += __shfl_xor(r1, 1, 64);
            if ((lane & 3) == 0) {
                const float pre = r1 + mybias;
                gates[(size_t)r * 16 + myq] = myq < 4 ? pre : logsigmoidf(pre);
            }
        }
    }
    __syncthreads();
    {
        float (*tile)[65] = (float (*)[65])smem;
        for (int item = blockIdx.x; item < 1664; item += gridDim.x) {
            const float* W; int ldn, ntn, shift_from, it; bf16_t* out;
            if (item < 896) { W = P.w_in; ldn = PROJ; ntn = 56; shift_from = 2048; it = item; out = (bf16_t*)(P.ws + WS_BT1); }
            else if (item < 1152) { W = P.w_out; ldn = 1024; ntn = 16; shift_from = 1 << 30; it = item - 896; out = (bf16_t*)(P.ws + WS_BT2); }
            else { W = P.peer_query; ldn = 2048; ntn = 32; shift_from = 1 << 30; it = item - 1152; out = (bf16_t*)(P.ws + WS_BT3); }
            const int tk = it / ntn, tn = it - tk * ntn, k0 = tk * 64, n0 = tn * 64;
            {
                const int nl = tid & 63;
                int n = n0 + nl; if (n >= shift_from) n += 8;
#pragma unroll
                for (int i = 0; i < 16; ++i) { const int kl = (tid >> 6) + 4 * i; tile[kl][nl] = W[(size_t)(k0 + kl) * ldn + n]; }
            }
            __syncthreads();
            {
                const int kl = tid & 63;
#pragma unroll
                for (int i = 0; i < 16; ++i) { const int nl = (tid >> 6) + 4 * i; out[(size_t)(n0 + nl) * 1024 + k0 + kl] = (bf16_t)f2bf(tile[kl][nl]); }
            }
            __syncthreads();
        }
    }
    {
        const size_t gt = (size_t)blockIdx.x * 256 + tid, gs = (size_t)gridDim.x * 256;
        const float* src = P.peer_keys; bf16_t* dst = (bf16_t*)(P.ws + WS_KEYS);
        for (size_t i = gt; i < (size_t)(16 * 128 * 128 / 8); i += gs) {
            const float4 a = *(const float4*)(src + i * 8), b = *(const float4*)(src + i * 8 + 4);
            uint4 o; o.x = pk2(a.x, a.y); o.y = pk2(a.z, a.w); o.z = pk2(b.x, b.y); o.w = pk2(b.z, b.w);
            *(uint4*)(dst + i * 8) = o;
        }
    }
}

__device__ __forceinline__ void convert_uv_rows(const Params& P, int gwave, int nwaves, int lane) {
    for (int rr0 = gwave * 4; rr0 < 2 * 16384; rr0 += nwaves * 4) {
        float4 a[4][4];
#pragma unroll
        for (int q = 0; q < 4; ++q) {
            const int rr = rr0 + q, which = rr >> 14, row = rr & 16383;
            const float* src = (which ? P.peer_v : P.peer_u) + (size_t)row * DM + lane * 16;
            a[q][0] = *(const float4*)(src); a[q][1] = *(const float4*)(src + 4); a[q][2] = *(const float4*)(src + 8); a[q][3] = *(const float4*)(src + 12);
        }
#pragma unroll
        for (int q = 0; q < 4; ++q) {
            const int rr = rr0 + q, which = rr >> 14, row = rr & 16383;
            float mx = 0.f;
#pragma unroll
            for (int j = 0; j < 4; ++j) mx = fmaxf(mx, fmaxf(fmaxf(fabsf(a[q][j].x), fabsf(a[q][j].y)), fmaxf(fabsf(a[q][j].z), fabsf(a[q][j].w))));
            mx = wave_max(mx);
            const float sc = mx > 0.f ? 6.0f / mx : 1.0f;
            unsigned w0 = 0u, w1 = 0u;
            w0 = __builtin_amdgcn_cvt_scalef32_pk_fp4_f32(w0, a[q][0].x * sc, a[q][0].y * sc, 1.0f, 0); w0 = __builtin_amdgcn_cvt_scalef32_pk_fp4_f32(w0, a[q][0].z * sc, a[q][0].w * sc, 1.0f, 1);
            w0 = __builtin_amdgcn_cvt_scalef32_pk_fp4_f32(w0, a[q][1].x * sc, a[q][1].y * sc, 1.0f, 2); w0 = __builtin_amdgcn_cvt_scalef32_pk_fp4_f32(w0, a[q][1].z * sc, a[q][1].w * sc, 1.0f, 3);
            w1 = __builtin_amdgcn_cvt_scalef32_pk_fp4_f32(w1, a[q][2].x * sc, a[q][2].y * sc, 1.0f, 0); w1 = __builtin_amdgcn_cvt_scalef32_pk_fp4_f32(w1, a[q][2].z * sc, a[q][2].w * sc, 1.0f, 1);
            w1 = __builtin_amdgcn_cvt_scalef32_pk_fp4_f32(w1, a[q][3].x * sc, a[q][3].y * sc, 1.0f, 2); w1 = __builtin_amdgcn_cvt_scalef32_pk_fp4_f32(w1, a[q][3].z * sc, a[q][3].w * sc, 1.0f, 3);
            *(uint2*)(P.ws + (which ? WS_V : WS_U) + (size_t)row * 512 + lane * 8) = make_uint2(w0, w1);
            if (lane == 0) ((float*)(P.ws + (which ? WS_VSC : WS_USC)))[row] = mx > 0.f ? mx * (1.0f / 6.0f) : 1.0f;
        }
    }
}

__device__ __forceinline__ void bitonic_sort16_desc(unsigned (&v)[16]) {
#pragma unroll
    for (int k = 2; k <= 16; k <<= 1)
#pragma unroll
        for (int j = k >> 1; j >= 1; j >>= 1)
#pragma unroll
            for (int i = 0; i < 16; ++i)
                if ((i & j) == 0) {
                    const int p = i | j;
                    const bool desc = (k >= 16) ? true : ((i & k) == 0);
                    const unsigned hi = max(v[i], v[p]), lo = min(v[i], v[p]);
                    v[i] = desc ? hi : lo; v[p] = desc ? lo : hi;
                }
}
__device__ __forceinline__ void bitonic_merge16_top(unsigned (&a)[16], const unsigned (&b)[16]) {
#pragma unroll
    for (int i = 0; i < 16; ++i) a[i] = max(a[i], b[15 - i]);
#pragma unroll
    for (int j = 8; j >= 1; j >>= 1)
#pragma unroll
        for (int i = 0; i < 16; ++i)
            if ((i & j) == 0) { const int p = i | j; const unsigned hi = max(a[i], a[p]), lo = min(a[i], a[p]); a[i] = hi; a[p] = lo; }
}

__device__ __forceinline__ float x4_max(float x) {
    const unsigned xi = __float_as_uint(x);
    const auto r = __builtin_amdgcn_permlane32_swap(xi, xi, false, false);
    const float m = fmaxf(__uint_as_float(r[0]), __uint_as_float(r[1]));
    const unsigned mi = __float_as_uint(m);
    const auto r2 = __builtin_amdgcn_permlane16_swap(mi, mi, false, false);
    return fmaxf(__uint_as_float(r2[0]), __uint_as_float(r2[1]));
}
__device__ __forceinline__ float x4_sum(float x) {
    const unsigned xi = __float_as_uint(x);
    const auto r = __builtin_amdgcn_permlane32_swap(xi, xi, false, false);
    const float m = __uint_as_float(r[0]) + __uint_as_float(r[1]);
    const unsigned mi = __float_as_uint(m);
    const auto r2 = __builtin_amdgcn_permlane16_swap(mi, mi, false, false);
    return __uint_as_float(r2[0]) + __uint_as_float(r2[1]);
}

__device__ __forceinline__ int opaque_tid() { int t = threadIdx.x; asm volatile("" : "+v"(t)); return t; }

__device__ __forceinline__ void mma_ktile(const unsigned char* sA, const unsigned char* sB, int arow_off, int brow_off, int g, int sw, f32x4 (&acc)[4][4]) {
#pragma unroll
    for (int s = 0; s < 2; ++s) {
        bf16x8 a[4], b[4];
        const int ch = (((s * 4 + g) ^ sw) << 4);
#pragma unroll
        for (int i = 0; i < 4; ++i) a[i] = *(const bf16x8*)(sA + arow_off + i * 2048 + ch);
#pragma unroll
        for (int j = 0; j < 4; ++j) b[j] = *(const bf16x8*)(sB + brow_off + j * 2048 + ch);
#pragma unroll
        for (int i = 0; i < 4; ++i)
#pragma unroll
            for (int j = 0; j < 4; ++j) acc[i][j] = __builtin_amdgcn_mfma_f32_16x16x32_bf16(b[j], a[i], acc[i][j], 0, 0, 0);
    }
}

__device__ __forceinline__ void store_tile_bf16(const f32x4 (&acc)[4][4], unsigned char* smem, bf16_t* dst, size_t ld, int m0, int n0, int tid, int wr, int wc, int g, int lr) {
#pragma unroll
    for (int i = 0; i < 4; ++i)
#pragma unroll
        for (int j = 0; j < 4; ++j) {
            const int row = wr * 64 + 16 * i + lr, col = wc * 64 + 16 * j + 4 * g;
            uint2 w; w.x = pk2(acc[i][j][0], acc[i][j][1]); w.y = pk2(acc[i][j][2], acc[i][j][3]);
            *(uint2*)(smem + row * 272 + col * 2) = w;
        }
    __syncthreads();
#pragma unroll
    for (int q = 0; q < 8; ++q) {
        const int id = tid + 256 * q, row = id >> 4, ch = id & 15;
        const uint4 v = *(const uint4*)(smem + row * 272 + ch * 16);
        *(uint4*)(dst + (size_t)(m0 + row) * ld + n0 + ch * 8) = v;
    }
    __syncthreads();
}

template <int MODE>
__device__ __forceinline__ void gemm_tile(const Params& P, int tm, int tn, unsigned char* smem) {
    const bf16_t* A; const bf16_t* Bt;
    if (MODE == 1) { A = (const bf16_t*)(P.ws + WS_RA); Bt = (const bf16_t*)(P.ws + WS_BT1); }
    else if (MODE == 2) { A = (const bf16_t*)(P.ws + WS_Z); Bt = (const bf16_t*)(P.ws + WS_BT2); }
    else { A = (const bf16_t*)(P.ws + WS_XN); Bt = (const bf16_t*)(P.ws + WS_BT3); }
    const int tid = opaque_tid(), lane = tid & 63, wave = tid >> 6, wr = wave >> 1, wc = wave & 1, g = lane >> 4, lr = lane & 15;
    const int m0 = tm * 128, n0 = tn * 128;
    const int srow = tid >> 3, sc = tid & 7;
    constexpr unsigned LDA = (MODE == 2 ? NZ : 1024) * 2u;
    unsigned aoff, boff; int soff0;
    {
        int ar = m0 + srow;
        if (MODE == 2) { const int b = ar >> 11, t = ar & 2047; ar = b * L + NMETA + t; }
        aoff = (unsigned)ar * LDA + (unsigned)sc * 16u;
        boff = (unsigned)(n0 + srow) * 2048u + (unsigned)sc * 16u;
        soff0 = srow * 128 + ((sc ^ (srow & 7)) << 4);
    }
    const unsigned char* Ab = (const unsigned char*)A; const unsigned char* Bb = (const unsigned char*)Bt;
    f32x4 acc[4][4];
#pragma unroll
    for (int i = 0; i < 4; ++i)
#pragma unroll
        for (int j = 0; j < 4; ++j) acc[i][j] = (f32x4){0.f, 0.f, 0.f, 0.f};
    uint4 ra0, ra1, ra2, ra3, rb0, rb1, rb2, rb3;
#define G_LOAD(KT) { const unsigned ko = (unsigned)(KT) * 128u; \
        ra0 = *(const uint4*)(Ab + (aoff + ko)); ra1 = *(const uint4*)(Ab + (aoff + 32u * LDA + ko)); ra2 = *(const uint4*)(Ab + (aoff + 64u * LDA + ko)); ra3 = *(const uint4*)(Ab + (aoff + 96u * LDA + ko)); \
        rb0 = *(const uint4*)(Bb + (boff + ko)); rb1 = *(const uint4*)(Bb + (boff + 32u * 2048u + ko)); rb2 = *(const uint4*)(Bb + (boff + 64u * 2048u + ko)); rb3 = *(const uint4*)(Bb + (boff + 96u * 2048u + ko)); }
#define G_WRITE(SA, SB) { *(uint4*)((SA) + soff0) = ra0; *(uint4*)((SA) + soff0 + 4096) = ra1; *(uint4*)((SA) + soff0 + 8192) = ra2; *(uint4*)((SA) + soff0 + 12288) = ra3; \
        *(uint4*)((SB) + soff0) = rb0; *(uint4*)((SB) + soff0 + 4096) = rb1; *(uint4*)((SB) + soff0 + 8192) = rb2; *(uint4*)((SB) + soff0 + 12288) = rb3; }
    unsigned char* sA0 = smem; unsigned char* sB0 = smem + 16384; unsigned char* sA1 = smem + 32768; unsigned char* sB1 = smem + 49152;
    G_LOAD(0)
    G_WRITE(sA0, sB0)
    __syncthreads();
    const int arow_off = (wr * 64 + lr) * 128, brow_off = (wc * 64 + lr) * 128, sw = lr & 7;
    G_LOAD(1)
    for (int kt = 0; kt < 16; ++kt) {
        unsigned char* sA = (kt & 1) ? sA1 : sA0; unsigned char* sB = (kt & 1) ? sB1 : sB0;
        unsigned char* nA = (kt & 1) ? sA0 : sA1; unsigned char* nB = (kt & 1) ? sB0 : sB1;
        bf16x8 fa[4], fb[4], ga[4], gb[4];
        const int ch0 = ((g ^ sw) << 4), ch1 = (((4 + g) ^ sw) << 4);
        const unsigned ko = (unsigned)(kt + 2) * 128u;
        const bool wr_ok = kt < 15, ld_ok = kt < 14;
#pragma unroll
        for (int i = 0; i < 4; ++i) { fa[i] = *(const bf16x8*)(sA + arow_off + i * 2048 + ch0); fb[i] = *(const bf16x8*)(sB + brow_off + i * 2048 + ch0); }
        __builtin_amdgcn_sched_barrier(0);
        __builtin_amdgcn_s_setprio(2);
        if (wr_ok) *(uint4*)(nA + soff0) = ra0;
        if (ld_ok) ra0 = *(const uint4*)(Ab + (aoff + 0u * LDA + ko));
        ga[0] = *(const bf16x8*)(sA + arow_off + 0 * 2048 + ch1); gb[0] = *(const bf16x8*)(sB + brow_off + 0 * 2048 + ch1);
        __builtin_amdgcn_sched_barrier(0);
#pragma unroll
        for (int j = 0; j < 4; ++j) acc[0][j] = __builtin_amdgcn_mfma_f32_16x16x32_bf16(fb[j], fa[0], acc[0][j], 0, 0, 0);
        __builtin_amdgcn_sched_barrier(0);
        if (wr_ok) *(uint4*)(nA + soff0 + 4096) = ra1;
        if (ld_ok) ra1 = *(const uint4*)(Ab + (aoff + 32u * LDA + ko));
        ga[1] = *(const bf16x8*)(sA + arow_off + 1 * 2048 + ch1); gb[1] = *(const bf16x8*)(sB + brow_off + 1 * 2048 + ch1);
        __builtin_amdgcn_sched_barrier(0);
#pragma unroll
        for (int j = 0; j < 4; ++j) acc[1][j] = __builtin_amdgcn_mfma_f32_16x16x32_bf16(fb[j], fa[1], acc[1][j], 0, 0, 0);
        __builtin_amdgcn_sched_barrier(0);
        if (wr_ok) *(uint4*)(nA + soff0 + 8192) = ra2;
        if (ld_ok) ra2 = *(const uint4*)(Ab + (aoff + 64u * LDA + ko));
        ga[2] = *(const bf16x8*)(sA + arow_off + 2 * 2048 + ch1); gb[2] = *(const bf16x8*)(sB + brow_off + 2 * 2048 + ch1);
        __builtin_amdgcn_sched_barrier(0);
#pragma unroll
        for (int j = 0; j < 4; ++j) acc[2][j] = __builtin_amdgcn_mfma_f32_16x16x32_bf16(fb[j], fa[2], acc[2][j], 0, 0, 0);
        __builtin_amdgcn_sched_barrier(0);
        if (wr_ok) *(uint4*)(nA + soff0 + 12288) = ra3;
        if (ld_ok) ra3 = *(const uint4*)(Ab + (aoff + 96u * LDA + ko));
        ga[3] = *(const bf16x8*)(sA + arow_off + 3 * 2048 + ch1); gb[3] = *(const bf16x8*)(sB + brow_off + 3 * 2048 + ch1);
        __builtin_amdgcn_sched_barrier(0);
#pragma unroll
        for (int j = 0; j < 4; ++j) acc[3][j] = __builtin_amdgcn_mfma_f32_16x16x32_bf16(fb[j], fa[3], acc[3][j], 0, 0, 0);
        __builtin_amdgcn_sched_barrier(0);
        if (wr_ok) *(uint4*)(nB + soff0) = rb0;
        if (ld_ok) rb0 = *(const uint4*)(Bb + (boff + 0u * 2048u + ko));
        __builtin_amdgcn_sched_barrier(0);
#pragma unroll
        for (int j = 0; j < 4; ++j) acc[0][j] = __builtin_amdgcn_mfma_f32_16x16x32_bf16(gb[j], ga[0], acc[0][j], 0, 0, 0);
        __builtin_amdgcn_sched_barrier(0);
        if (wr_ok) *(uint4*)(nB + soff0 + 4096) = rb1;
        if (ld_ok) rb1 = *(const uint4*)(Bb + (boff + 32u * 2048u + ko));
        __builtin_amdgcn_sched_barrier(0);
#pragma unroll
        for (int j = 0; j < 4; ++j) acc[1][j] = __builtin_amdgcn_mfma_f32_16x16x32_bf16(gb[j], ga[1], acc[1][j], 0, 0, 0);
        __builtin_amdgcn_sched_barrier(0);
        if (wr_ok) *(uint4*)(nB + soff0 + 8192) = rb2;
        if (ld_ok) rb2 = *(const uint4*)(Bb + (boff + 64u * 2048u + ko));
        __builtin_amdgcn_sched_barrier(0);
#pragma unroll
        for (int j = 0; j < 4; ++j) acc[2][j] = __builtin_amdgcn_mfma_f32_16x16x32_bf16(gb[j], ga[2], acc[2][j], 0, 0, 0);
        __builtin_amdgcn_sched_barrier(0);
        if (wr_ok) *(uint4*)(nB + soff0 + 12288) = rb3;
        if (ld_ok) rb3 = *(const uint4*)(Bb + (boff + 96u * 2048u + ko));
        __builtin_amdgcn_sched_barrier(0);
#pragma unroll
        for (int j = 0; j < 4; ++j) acc[3][j] = __builtin_amdgcn_mfma_f32_16x16x32_bf16(gb[j], ga[3], acc[3][j], 0, 0, 0);
        __builtin_amdgcn_s_setprio(0);
        __syncthreads();
    }
#undef G_LOAD
#undef G_WRITE
    if (MODE == 1) {
        if (n0 >= ZC_FQ && n0 < ZC_FV) {
            const bool isk = n0 >= ZC_FK;
            const float* gain = isk ? P.f_k_norm : P.f_q_norm;
            const float scl = isk ? 1.0f : 0.125f * LOG2E;
            float gn[4][4];
#pragma unroll
            for (int j = 0; j < 4; ++j)
#pragma unroll
                for (int r = 0; r < 4; ++r) gn[j][r] = gain[16 * j + 4 * g + r];
#pragma unroll
            for (int i = 0; i < 4; ++i) {
                float ss = 0.f;
#pragma unroll
                for (int j = 0; j < 4; ++j)
#pragma unroll
                    for (int r = 0; r < 4; ++r) ss += acc[i][j][r] * acc[i][j][r];
                ss = x4_sum(ss);
                const float rstd = rsqrtf(ss * (1.0f / 64.0f) + EPS) * scl;
#pragma unroll
                for (int j = 0; j < 4; ++j)
#pragma unroll
                    for (int r = 0; r < 4; ++r) acc[i][j][r] *= rstd * gn[j][r];
            }
        }
        store_tile_bf16(acc, smem, (bf16_t*)(P.ws + WS_Z), NZ, m0, n0, tid, wr, wc, g, lr);
    } else if (MODE == 2) {
        float* ssq = (float*)(P.ws + WS_SSQ);
#pragma unroll
        for (int i = 0; i < 4; ++i) {
            const int row = m0 + wr * 64 + 16 * i + lr;
            float ss = 0.f;
#pragma unroll
            for (int j = 0; j < 4; ++j) {
                const int col = n0 + wc * 64 + 16 * j + 4 * g;
                const float4 xv = *(const float4*)(P.x + (size_t)row * DM + col);
                const float4 gv = *(const float4*)(P.norm_ffn + col);
                float4 hv; hv.x = acc[i][j][0] + xv.x; hv.y = acc[i][j][1] + xv.y; hv.z = acc[i][j][2] + xv.z; hv.w = acc[i][j][3] + xv.w;
                ss += hv.x * hv.x + hv.y * hv.y + hv.z * hv.z + hv.w * hv.w;
                acc[i][j][0] = hv.x * gv.x; acc[i][j][1] = hv.y * gv.y; acc[i][j][2] = hv.z * gv.z; acc[i][j][3] = hv.w * gv.w;
            }
            ss = x4_sum(ss);
            if (g == 0) ssq[(size_t)row * 16 + tn * 2 + wc] = ss;
        }
        store_tile_bf16(acc, smem, (bf16_t*)(P.ws + WS_XN), 1024, m0, n0, tid, wr, wc, g, lr);
    } else {
        const int hp = tn;
        const float* ssq = (const float*)(P.ws + WS_SSQ);
        float rs[4];
#pragma unroll
        for (int i = 0; i < 4; ++i) {
            const int row = m0 + wr * 64 + 16 * i + lr;
            const float4 p0 = *(const float4*)(ssq + (size_t)row * 16), p1 = *(const float4*)(ssq + (size_t)row * 16 + 4);
            const float4 p2 = *(const float4*)(ssq + (size_t)row * 16 + 8), p3 = *(const float4*)(ssq + (size_t)row * 16 + 12);
            const float s = ((p0.x + p0.y) + (p0.z + p0.w)) + ((p1.x + p1.y) + (p1.z + p1.w)) + ((p2.x + p2.y) + (p2.z + p2.w)) + ((p3.x + p3.y) + (p3.z + p3.w));
            rs[i] = rsqrtf(s * (1.0f / DM) + EPS);
            if (tn == 0 && wc == 0 && g == 0) ((float*)(P.ws + WS_RSTD))[row] = rs[i];
        }
        {
            unsigned char* sAq = wc ? sA1 : sA0;
#pragma unroll
            for (int i = 0; i < 4; ++i)
#pragma unroll
                for (int j = 0; j < 4; ++j) {
                    const int row = wr * 64 + 16 * i + lr;
                    const int chunk = 2 * j + (g >> 1);
                    uint2 w; w.x = pk2(acc[i][j][0] * rs[i], acc[i][j][1] * rs[i]); w.y = pk2(acc[i][j][2] * rs[i], acc[i][j][3] * rs[i]);
                    *(uint2*)(sAq + row * 128 + ((chunk ^ (row & 7)) << 4) + 8 * (g & 1)) = w;
                }
            const bf16_t* keys = (const bf16_t*)(P.ws + WS_KEYS) + (size_t)hp * 128 * 128;
#pragma unroll
            for (int j = 0; j < 4; ++j) {
                const int row = srow + 32 * j;
                const uint4 k0 = *(const uint4*)(keys + (size_t)row * 128 + sc * 8);
                const uint4 k1 = *(const uint4*)(keys + (size_t)row * 128 + 64 + sc * 8);
                *(uint4*)(sB0 + soff0 + j * 4096) = k0; *(uint4*)(sB1 + soff0 + j * 4096) = k1;
            }
        }
        __syncthreads();
#pragma unroll
        for (int i = 0; i < 4; ++i)
#pragma unroll
            for (int j = 0; j < 4; ++j) acc[i][j] = (f32x4){0.f, 0.f, 0.f, 0.f};
        mma_ktile(sA0, sB0, arow_off, brow_off, g, sw, acc);
        mma_ktile(sA1, sB1, arow_off, brow_off, g, sw, acc);
        __syncthreads();
#pragma unroll
        for (int i = 0; i < 4; ++i)
#pragma unroll
            for (int j = 0; j < 4; ++j) {
                const int row = wr * 64 + 16 * i + lr;
                const int c4 = wc * 16 + 4 * j + g;
                *(f32x4*)(smem + row * 512 + ((c4 ^ (row & 31)) << 4)) = acc[i][j];
            }
        __syncthreads();
        unsigned top[16];
        const int row = tid & 127, half = tid >> 7;
        {
            auto load_keys = [&](unsigned (&dst)[16], int q4) {
#pragma unroll
                for (int s4 = 0; s4 < 4; ++s4) {
                    const int c4 = half * 16 + q4 * 4 + s4;
                    const f32x4 v = *(const f32x4*)(smem + row * 512 + ((c4 ^ (row & 31)) << 4));
#pragma unroll
                    for (int e = 0; e < 4; ++e) dst[s4 * 4 + e] = (ord_key(v[e]) & ~127u) | (unsigned)(127 - (c4 * 4 + e));
                }
            };
            load_keys(top, 0);
            bitonic_sort16_desc(top);
#pragma unroll 1
            for (int q4 = 1; q4 < 4; ++q4) {
                unsigned gq[16];
                load_keys(gq, q4);
                bitonic_sort16_desc(gq);
                bitonic_merge16_top(top, gq);
            }
        }
        __syncthreads();
        if (half) {
            uint4* lp = (uint4*)(smem + row * 64);
            lp[0] = make_uint4(top[0], top[1], top[2], top[3]); lp[1] = make_uint4(top[4], top[5], top[6], top[7]);
            lp[2] = make_uint4(top[8], top[9], top[10], top[11]); lp[3] = make_uint4(top[12], top[13], top[14], top[15]);
        }
        __syncthreads();
        if (!half) {
            const uint4* lp = (const uint4*)(smem + row * 64);
            unsigned other[16];
#pragma unroll
            for (int c = 0; c < 4; ++c) { const uint4 o = lp[c]; other[4 * c] = o.x; other[4 * c + 1] = o.y; other[4 * c + 2] = o.z; other[4 * c + 3] = o.w; }
            bitonic_merge16_top(top, other);
            uint4* tk = (uint4*)((unsigned*)(P.ws + WS_TK) + ((size_t)(m0 + row) * 16 + hp) * 16);
            tk[0] = make_uint4(top[0], top[1], top[2], top[3]); tk[1] = make_uint4(top[4], top[5], top[6], top[7]);
            tk[2] = make_uint4(top[8], top[9], top[10], top[11]); tk[3] = make_uint4(top[12], top[13], top[14], top[15]);
        }
        __syncthreads();
    }
}

__device__ __forceinline__ void fox_cum_wave(const Params& P, int bh, int lane) {
    const int b = bh >> 3, h = bh & 7;
    const float* gates = (const float*)(P.ws + WS_GATES);
    float* cum = (float*)(P.ws + WS_CUM) + (size_t)bh * L;
    constexpr int SEG = 33;
    const int t0 = lane * SEG;
    float loc = 0.f;
    for (int i = 0; i < SEG; ++i) { const int t = t0 + i; if (t < L) loc += gates[(size_t)(b * L + t) * 16 + 8 + h]; }
    float incl = loc;
#pragma unroll
    for (int o = 1; o < 64; o <<= 1) { const float n = __shfl_up(incl, o, 64); if (lane >= o) incl += n; }
    float run = incl - loc;
    for (int i = 0; i < SEG; ++i) { const int t = t0 + i; if (t < L) { run += gates[(size_t)(b * L + t) * 16 + 8 + h]; cum[t] = run * LOG2E; } }
}

#define TR_SLOW 0

__device__ __forceinline__ int vimg_off(int row, int ch) { return row * 128 + ((ch ^ (((row >> 1) & 3) << 1)) << 4); }
__device__ __forceinline__ uint2 tr_frag(const unsigned char* img, int row0, int c, int g, int lr) {
#if TR_SLOW
    unsigned short e[4];
#pragma unroll
    for (int k = 0; k < 4; ++k) { const int row = row0 + 4 * g + k, col = 16 * c + lr; e[k] = *(const unsigned short*)(img + vimg_off(row, col >> 3) + (col & 7) * 2); }
    uint2 r; r.x = (unsigned)e[0] | ((unsigned)e[1] << 16); r.y = (unsigned)e[2] | ((unsigned)e[3] << 16); return r;
#else
    const int q = lr >> 2, p = lr & 3, row = row0 + 4 * g + q;
    const unsigned addr = (unsigned)(size_t)(img + vimg_off(row, 2 * c + (p >> 1)) + 8 * (p & 1));
    uint2 r;
    asm volatile("ds_read_b64_tr_b16 %0, %1\n\ts_waitcnt lgkmcnt(0)" : "=&v"(r) : "v"(addr) : "memory");
    return r;
#endif
}

__device__ __forceinline__ unsigned tr_lane_addr(const unsigned char* img, int c, int g, int lr) {
    const int q = lr >> 2, p = lr & 3, row = 4 * g + q;
    return (unsigned)(size_t)(img + vimg_off(row, 2 * c + (p >> 1)) + 8 * (p & 1));
}
#define TR_GROUP(o0, o1, o2, o3, a) "ds_read_b64_tr_b16 %" #o0 ", %" #a "\n\tds_read_b64_tr_b16 %" #o1 ", %" #a " offset:2048\n\tds_read_b64_tr_b16 %" #o2 ", %" #a " offset:4096\n\tds_read_b64_tr_b16 %" #o3 ", %" #a " offset:6144\n\t"
__device__ __forceinline__ void tr_read_4c(const unsigned char* img, int g, int lr, uint2 (&r)[4][4]) {
    const unsigned a0 = tr_lane_addr(img, 0, g, lr), a1 = tr_lane_addr(img, 1, g, lr), a2 = tr_lane_addr(img, 2, g, lr), a3 = tr_lane_addr(img, 3, g, lr);
    asm volatile(TR_GROUP(0, 1, 2, 3, 16) TR_GROUP(4, 5, 6, 7, 17) TR_GROUP(8, 9, 10, 11, 18) TR_GROUP(12, 13, 14, 15, 19) "s_waitcnt lgkmcnt(0)"
        : "=&v"(r[0][0]), "=&v"(r[0][1]), "=&v"(r[0][2]), "=&v"(r[0][3]), "=&v"(r[1][0]), "=&v"(r[1][1]), "=&v"(r[1][2]), "=&v"(r[1][3]),
          "=&v"(r[2][0]), "=&v"(r[2][1]), "=&v"(r[2][2]), "=&v"(r[2][3]), "=&v"(r[3][0]), "=&v"(r[3][1]), "=&v"(r[3][2]), "=&v"(r[3][3])
        : "v"(a0), "v"(a1), "v"(a2), "v"(a3) : "memory");
}
__device__ __forceinline__ void tr_read_3c(const unsigned char* img, int g, int lr, uint2 (&r)[3][4]) {
    const unsigned a0 = tr_lane_addr(img, 0, g, lr), a1 = tr_lane_addr(img, 1, g, lr), a2 = tr_lane_addr(img, 2, g, lr);
    asm volatile(TR_GROUP(0, 1, 2, 3, 12) TR_GROUP(4, 5, 6, 7, 13) TR_GROUP(8, 9, 10, 11, 14) "s_waitcnt lgkmcnt(0)"
        : "=&v"(r[0][0]), "=&v"(r[0][1]), "=&v"(r[0][2]), "=&v"(r[0][3]), "=&v"(r[1][0]), "=&v"(r[1][1]), "=&v"(r[1][2]), "=&v"(r[1][3]),
          "=&v"(r[2][0]), "=&v"(r[2][1]), "=&v"(r[2][2]), "=&v"(r[2][3])
        : "v"(a0), "v"(a1), "v"(a2) : "memory");
}
__device__ __forceinline__ void tr_read_2(const unsigned char* img0, int c0, const unsigned char* img1, int c1, int g, int lr, uint2 (&r)[2][4]) {
    const unsigned a0 = tr_lane_addr(img0, c0, g, lr), a1 = tr_lane_addr(img1, c1, g, lr);
    asm volatile(TR_GROUP(0, 1, 2, 3, 8) TR_GROUP(4, 5, 6, 7, 9) "s_waitcnt lgkmcnt(0)"
        : "=&v"(r[0][0]), "=&v"(r[0][1]), "=&v"(r[0][2]), "=&v"(r[0][3]), "=&v"(r[1][0]), "=&v"(r[1][1]), "=&v"(r[1][2]), "=&v"(r[1][3])
        : "v"(a0), "v"(a1) : "memory");
}
__device__ __forceinline__ bf16x8 tr_pair(const uint2& lo, const uint2& hi) { uint4 u; u.x = lo.x; u.y = lo.y; u.z = hi.x; u.w = hi.y; return __builtin_bit_cast(bf16x8, u); }

__device__ __forceinline__ void attn_block(const Params& P, int bh, int qb, unsigned char* smem) {
    const int tid = opaque_tid(), lane = tid & 63, w = tid >> 6, g = lane >> 4, lr = lane & 15;
    const int b = bh >> 3, h = bh & 7;
    const bf16_t* z = (const bf16_t*)(P.ws + WS_Z);
    const float* cum = (const float*)(P.ws + WS_CUM) + (size_t)bh * L;
    int tq[2]; bool qvalid[2]; bf16x8 qf[2][2];
#pragma unroll
    for (int u = 0; u < 2; ++u) {
        tq[u] = qb * 128 + 32 * w + 16 * u + lr;
        qvalid[u] = tq[u] < L;
        const bf16_t* qp = z + (size_t)(b * L + (qvalid[u] ? tq[u] : 0)) * NZ + ZC_FQ + h * 64 + 8 * g;
        qf[u][0] = *(const bf16x8*)(qp); qf[u][1] = *(const bf16x8*)(qp + 32);
    }
    const int nkv = (2 * qb + 2 < 33) ? 2 * qb + 2 : 33;
    const int srow0 = tid >> 3, sch = tid & 7;
    uint4 rk[2], rv[2]; float rc = 0.f;
    auto load_tile = [&](int kv) {
#pragma unroll
        for (int j = 0; j < 2; ++j) {
            const int key = kv * 64 + srow0 + 32 * j;
            if (key < L) {
                const bf16_t* p = z + (size_t)(b * L + key) * NZ + h * 64 + sch * 8;
                rk[j] = *(const uint4*)(p + ZC_FK); rv[j] = *(const uint4*)(p + ZC_FV);
            } else { rk[j] = make_uint4(0, 0, 0, 0); rv[j] = make_uint4(0, 0, 0, 0); }
        }
        if (tid < 64) { const int key = kv * 64 + tid; rc = key < L ? cum[key] : 0.f; }
    };
    auto store_tile = [&](int buf) {
        unsigned char* sK = smem + buf * 16384; unsigned char* sV = sK + 8192;
#pragma unroll
        for (int j = 0; j < 2; ++j) {
            const int row = srow0 + 32 * j;
            *(uint4*)(sK + row * 128 + ((sch ^ (row & 7)) << 4)) = rk[j];
            *(uint4*)(sV + vimg_off(row, sch)) = rv[j];
        }
        if (tid < 64) ((float*)(smem + 32768 + buf * 256))[tid] = rc;
    };
    float m[2] = {-1e30f, -1e30f};
    f32x4 o[2][5];
#pragma unroll
    for (int u = 0; u < 2; ++u)
#pragma unroll
        for (int c = 0; c < 5; ++c) o[u][c] = (f32x4){0.f, 0.f, 0.f, 0.f};
    const unsigned onew = (lr == 0) ? 0x3F803F80u : 0u;
    const bf16x8 vones = __builtin_bit_cast(bf16x8, make_uint4(onew, onew, onew, onew));
    load_tile(nkv - 1); store_tile((nkv - 1) & 1);
    __syncthreads();
    for (int kv = nkv - 1; kv >= 0; --kv) {
        const int buf = kv & 1;
        if (kv > 0) load_tile(kv - 1);
        const unsigned char* sK = smem + buf * 16384; const unsigned char* sV = sK + 8192;
        const float* sck = (const float*)(smem + 32768 + buf * 256);
        f32x4 sa[2][4];
#pragma unroll
        for (int c = 0; c < 4; ++c) {
            sa[0][c] = (f32x4){0.f, 0.f, 0.f, 0.f}; sa[1][c] = (f32x4){0.f, 0.f, 0.f, 0.f};
#pragma unroll
            for (int s = 0; s < 2; ++s) {
                const bf16x8 kf = *(const bf16x8*)(sK + (16 * c + lr) * 128 + (((4 * s + g) ^ (lr & 7)) << 4));
                sa[0][c] = __builtin_amdgcn_mfma_f32_16x16x32_bf16(kf, qf[0][s], sa[0][c], 0, 0, 0);
                sa[1][c] = __builtin_amdgcn_mfma_f32_16x16x32_bf16(kf, qf[1][s], sa[1][c], 0, 0, 0);
            }
        }
        if (kv >= 2 * qb) {
#pragma unroll
            for (int u = 0; u < 2; ++u)
#pragma unroll
                for (int c = 0; c < 4; ++c)
#pragma unroll
                    for (int r = 0; r < 4; ++r)
                        if (64 * kv + 16 * c + 4 * g + r > tq[u]) sa[u][c][r] = -INFINITY;
        }
        f32x4 ck[4];
#pragma unroll
        for (int c = 0; c < 4; ++c) ck[c] = *(const f32x4*)(sck + 16 * c + 4 * g);
        bf16x8 pf[2][2];
#pragma unroll
        for (int u = 0; u < 2; ++u) {
            float mx = -INFINITY;
#pragma unroll
            for (int c = 0; c < 4; ++c) {
                sa[u][c] -= ck[c];
                mx = fmaxf(mx, fmaxf(fmaxf(sa[u][c][0], sa[u][c][1]), fmaxf(sa[u][c][2], sa[u][c][3])));
            }
            mx = x4_max(mx);
            if (__builtin_amdgcn_ballot_w64(mx > m[u]) != 0ull) {
                const float mn = fmaxf(m[u], mx);
                const float alpha = __builtin_amdgcn_exp2f(m[u] - mn);
                m[u] = mn;
#pragma unroll
                for (int c = 0; c < 5; ++c) o[u][c] *= alpha;
            }
            const float mn = m[u];
#pragma unroll
            for (int c = 0; c < 4; ++c)
#pragma unroll
                for (int r = 0; r < 4; ++r) sa[u][c][r] = __builtin_amdgcn_exp2f(sa[u][c][r] - mn);
#pragma unroll
            for (int s2 = 0; s2 < 2; ++s2) {
                uint4 uu;
                uu.x = cvt_pk_bf16(sa[u][2 * s2][0], sa[u][2 * s2][1]); uu.y = cvt_pk_bf16(sa[u][2 * s2][2], sa[u][2 * s2][3]);
                uu.z = cvt_pk_bf16(sa[u][2 * s2 + 1][0], sa[u][2 * s2 + 1][1]); uu.w = cvt_pk_bf16(sa[u][2 * s2 + 1][2], sa[u][2 * s2 + 1][3]);
                pf[u][s2] = __builtin_bit_cast(bf16x8, uu);
            }
        }
        {
            uint2 vr[4][4];
            tr_read_4c(sV, g, lr, vr);
#pragma unroll
            for (int c = 0; c < 4; ++c)
#pragma unroll
                for (int s2 = 0; s2 < 2; ++s2) {
                    const bf16x8 vf = tr_pair(vr[c][2 * s2], vr[c][2 * s2 + 1]);
                    o[0][c] = __builtin_amdgcn_mfma_f32_16x16x32_bf16(vf, pf[0][s2], o[0][c], 0, 0, 0);
                    o[1][c] = __builtin_amdgcn_mfma_f32_16x16x32_bf16(vf, pf[1][s2], o[1][c], 0, 0, 0);
                }
#pragma unroll
            for (int s2 = 0; s2 < 2; ++s2) {
                o[0][4] = __builtin_amdgcn_mfma_f32_16x16x32_bf16(vones, pf[0][s2], o[0][4], 0, 0, 0);
                o[1][4] = __builtin_amdgcn_mfma_f32_16x16x32_bf16(vones, pf[1][s2], o[1][4], 0, 0, 0);
            }
        }
        if (kv > 0) store_tile(buf ^ 1);
        __syncthreads();
    }
#pragma unroll
    for (int u = 0; u < 2; ++u) {
        const float ls = __shfl(o[u][4][0], lr, 64);
        const float inv = 1.0f / ls;
        if (qvalid[u]) {
            bf16_t* y = (bf16_t*)(P.ws + WS_Z) + (size_t)(b * L + tq[u]) * NZ + 512 + h * 64 + 4 * g;
#pragma unroll
            for (int c = 0; c < 4; ++c) {
                uint2 uu; uu.x = pk2(o[u][c][0] * inv, o[u][c][1] * inv); uu.y = pk2(o[u][c][2] * inv, o[u][c][3] * inv);
                *(uint2*)(y + 16 * c) = uu;
            }
        }
    }
}

__device__ __forceinline__ void conv_item(const Params& P, int ci) {
    const int tid = opaque_tid(), cc = tid & 127, rg = tid >> 7;
    const bf16_t* z = (const bf16_t*)(P.ws + WS_Z);
    bf16_t* qk = (bf16_t*)(P.ws + WS_RA);
    const int col0 = cc * 8;
    float w[4][8];
#pragma unroll
    for (int j = 0; j < 4; ++j) {
        const float4 a = *(const float4*)(P.conv_qk + j * 1024 + col0), b = *(const float4*)(P.conv_qk + j * 1024 + col0 + 4);
        w[j][0] = a.x; w[j][1] = a.y; w[j][2] = a.z; w[j][3] = a.w; w[j][4] = b.x; w[j][5] = b.y; w[j][6] = b.z; w[j][7] = b.w;
    }
    const float oscale = (col0 >= 512) ? 0.08838834764831845f : 1.0f;
    const int r0 = ci * 64 + rg * 32;
    int t = r0 % L;
    float xw[3][8];
#pragma unroll
    for (int j = 0; j < 3; ++j) {
        const int back = 3 - j;
        if (t - back >= 0) {
            const uint4 v = *(const uint4*)(z + (size_t)(r0 - back) * NZ + col0);
            xw[j][0] = bflo(v.x); xw[j][1] = bfhi(v.x); xw[j][2] = bflo(v.y); xw[j][3] = bfhi(v.y); xw[j][4] = bflo(v.z); xw[j][5] = bfhi(v.z); xw[j][6] = bflo(v.w); xw[j][7] = bfhi(v.w);
        } else {
#pragma unroll
            for (int e = 0; e < 8; ++e) xw[j][e] = 0.f;
        }
    }
#pragma unroll 2
    for (int i = 0; i < 32; ++i) {
        const int r = r0 + i;
        if (t == 0) {
#pragma unroll
            for (int j = 0; j < 3; ++j)
#pragma unroll
                for (int e = 0; e < 8; ++e) xw[j][e] = 0.f;
        }
        const uint4 v = *(const uint4*)(z + (size_t)r * NZ + col0);
        float xt[8];
        xt[0] = bflo(v.x); xt[1] = bfhi(v.x); xt[2] = bflo(v.y); xt[3] = bfhi(v.y); xt[4] = bflo(v.z); xt[5] = bfhi(v.z); xt[6] = bflo(v.w); xt[7] = bfhi(v.w);
        float o[8];
#pragma unroll
        for (int e = 0; e < 8; ++e) {
            const float cv = w[0][e] * xw[0][e] + w[1][e] * xw[1][e] + w[2][e] * xw[2][e] + w[3][e] * xt[e];
            o[e] = oscale * cv / (1.f + __expf(-cv));
            xw[0][e] = xw[1][e]; xw[1][e] = xw[2][e]; xw[2][e] = xt[e];
        }
        uint4 ov; ov.x = pk2(o[0], o[1]); ov.y = pk2(o[2], o[3]); ov.z = pk2(o[4], o[5]); ov.w = pk2(o[6], o[7]);
        *(uint4*)(qk + (size_t)r * 1024 + col0) = ov;
        t = (t + 1 == L) ? 0 : t + 1;
    }
}

constexpr int ST_IMG = 36864;
__device__ __forceinline__ int st_piece_off(int jt, int c, int g, int lr) { return (jt >> 2) * 18432 + vimg_off(16 * c + lr, 2 * (jt & 3) + (g >> 1)) + 8 * (g & 1); }

__device__ __forceinline__ void mlstm_stage_kv(const Params& P, int b, int h, int k, unsigned char* sKimg, unsigned char* sVimg, int tid) {
    const bf16_t* z = (const bf16_t*)(P.ws + WS_Z);
    const bf16_t* qk = (const bf16_t*)(P.ws + WS_RA);
    uint4 pk_[4], pv_[4];
#pragma unroll
    for (int j = 0; j < 4; ++j) {
        const int id = tid + 256 * j, row = id >> 4, ch16 = id & 15, pos = 64 * k + row;
        const bool ok = pos < L;
        pk_[j] = ok ? *(const uint4*)(qk + (size_t)(b * L + pos) * 1024 + 512 + h * 128 + ch16 * 8) : make_uint4(0, 0, 0, 0);
        pv_[j] = ok ? *(const uint4*)(z + (size_t)(b * L + pos) * NZ + ZC_MV + h * 128 + ch16 * 8) : make_uint4(0, 0, 0, 0);
    }
#pragma unroll
    for (int j = 0; j < 4; ++j) {
        const int id = tid + 256 * j, row = id >> 4, ch16 = id & 15;
        *(uint4*)(sKimg + (ch16 >> 3) * 8192 + vimg_off(row, ch16 & 7)) = pk_[j];
        *(uint4*)(sVimg + (ch16 >> 3) * 8192 + vimg_off(row, ch16 & 7)) = pv_[j];
    }
    if (tid < 128) {
        const int row = tid >> 1, ch = tid & 1;
        *(uint4*)(sVimg + 16384 + vimg_off(row, ch)) = ch ? make_uint4(0, 0, 0, 0) : make_uint4(0x3F80u, 0, 0, 0);
    }
}

__device__ __forceinline__ void mlstm_stage_A(const Params& P, int b, int h, int k, unsigned char* sKimg, unsigned char* sVimg, int tid) {
    const bf16_t* z = (const bf16_t*)(P.ws + WS_Z);
    bf16_t* qk = (bf16_t*)(P.ws + WS_RA);
    uint4 pv_[4];
#pragma unroll
    for (int j = 0; j < 4; ++j) {
        const int id = tid + 256 * j, row = id >> 4, ch16 = id & 15, pos = 64 * k + row;
        pv_[j] = (pos < L) ? *(const uint4*)(z + (size_t)(b * L + pos) * NZ + ZC_MV + h * 128 + ch16 * 8) : make_uint4(0, 0, 0, 0);
    }
    const int cch = tid & 31, rg = tid >> 5, isk = cch >> 4;
    const int zcol = (isk ? ZC_MK : ZC_MQ) + h * 128 + (cch & 15) * 8;
    float w[4][8];
#pragma unroll
    for (int j = 0; j < 4; ++j) {
        const float4 a = *(const float4*)(P.conv_qk + j * 1024 + zcol), c = *(const float4*)(P.conv_qk + j * 1024 + zcol + 4);
        w[j][0] = a.x; w[j][1] = a.y; w[j][2] = a.z; w[j][3] = a.w; w[j][4] = c.x; w[j][5] = c.y; w[j][6] = c.z; w[j][7] = c.w;
    }
    const float oscale = isk ? 0.08838834764831845f : 1.0f;
    const int p0 = 64 * k + 8 * rg;
    uint4 raw[11];
#pragma unroll
    for (int i = 0; i < 11; ++i) {
        const int pos = p0 - 3 + i;
        raw[i] = (pos >= 0 && pos < L) ? *(const uint4*)(z + (size_t)(b * L + pos) * NZ + zcol) : make_uint4(0, 0, 0, 0);
    }
#pragma unroll
    for (int j = 0; j < 4; ++j) {
        const int id = tid + 256 * j, row = id >> 4, ch16 = id & 15;
        *(uint4*)(sVimg + (ch16 >> 3) * 8192 + vimg_off(row, ch16 & 7)) = pv_[j];
    }
    if (tid < 128) {
        const int row = tid >> 1, ch = tid & 1;
        *(uint4*)(sVimg + 16384 + vimg_off(row, ch)) = ch ? make_uint4(0, 0, 0, 0) : make_uint4(0x3F80u, 0, 0, 0);
    }
#pragma unroll
    for (int i = 0; i < 8; ++i) {
        const int pos = p0 + i, row = 8 * rg + i;
        float o[8];
#pragma unroll
        for (int e = 0; e < 8; ++e) {
            const unsigned w0 = (&raw[i].x)[e >> 1], w1 = (&raw[i + 1].x)[e >> 1], w2 = (&raw[i + 2].x)[e >> 1], w3 = (&raw[i + 3].x)[e >> 1];
            const float x0 = (e & 1) ? bfhi(w0) : bflo(w0), x1 = (e & 1) ? bfhi(w1) : bflo(w1), x2 = (e & 1) ? bfhi(w2) : bflo(w2), x3 = (e & 1) ? bfhi(w3) : bflo(w3);
            const float cv = w[0][e] * x0 + w[1][e] * x1 + w[2][e] * x2 + w[3][e] * x3;
            o[e] = oscale * cv / (1.f + __expf(-cv));
        }
        uint4 ov; ov.x = pk2(o[0], o[1]); ov.y = pk2(o[2], o[3]); ov.z = pk2(o[4], o[5]); ov.w = pk2(o[6], o[7]);
        const bool ok = pos < L;
        if (!ok) ov = make_uint4(0, 0, 0, 0);
        if (ok) *(uint4*)(qk + (size_t)(b * L + pos) * 1024 + (isk ? 512 : 0) + h * 128 + (cch & 15) * 8) = ov;
        if (isk) { const int ch16 = cch & 15; *(uint4*)(sKimg + (ch16 >> 3) * 8192 + vimg_off(row, ch16 & 7)) = ov; }
    }
}

__device__ __forceinline__ void mlstm_A(const Params& P, int item, unsigned char* smem) {
    const int tid = opaque_tid(), lane = tid & 63, w = tid >> 6, g = lane >> 4, lr = lane & 15;
    const int wu = __builtin_amdgcn_readfirstlane(w);
    const int k = item >> 5, bh = item & 31, b = bh >> 2, h = bh & 3;
    const float* gates = (const float*)(P.ws + WS_GATES);
    const unsigned char* sK = smem; const unsigned char* sV = smem + 16384;
    float* ga = (float*)(smem + 40960);
    mlstm_stage_A(P, b, h, k, smem, smem + 16384, tid);
    if (wu == 0) {
        const int pos = 64 * k + lane;
        float lf = 0.f, li = -INFINITY;
        if (pos < L) { lf = gates[(size_t)(b * L + pos) * 16 + 4 + h]; li = gates[(size_t)(b * L + pos) * 16 + h]; }
        float bc = lf;
#pragma unroll
        for (int o = 1; o < 64; o <<= 1) { const float n = __shfl_up(bc, o, 64); if (lane >= o) bc += n; }
        const float a = li - bc;
        const float A = wave_max(a);
        ga[lane] = __expf(a - A);
        if (lane == 63) { float* msc = (float*)(P.ws + WS_MSC) + ((size_t)bh * 33 + k) * 4; msc[0] = A; msc[1] = bc; }
    }
    __syncthreads();
    f32x4 Ct[2][9];
#pragma unroll
    for (int a = 0; a < 2; ++a)
#pragma unroll
        for (int c = 0; c < 9; ++c) Ct[a][c] = (f32x4){0.f, 0.f, 0.f, 0.f};
    bf16x8 kt[2][2];
#pragma unroll
    for (int a = 0; a < 2; ++a)
#pragma unroll
        for (int s2 = 0; s2 < 2; ++s2) {
            const int jt = 2 * w + a;
            kt[a][s2] = tr_pair(tr_frag(sK + (jt >> 2) * 8192, 32 * s2, jt & 3, g, lr), tr_frag(sK + (jt >> 2) * 8192, 32 * s2 + 16, jt & 3, g, lr));
        }
    f32x4 wg4[4];
#pragma unroll
    for (int j = 0; j < 4; ++j) wg4[j] = *(const f32x4*)(ga + 16 * j + 4 * g);
#define MA_TILE(c, lo0, hi0, lo1, hi1) { \
        { const f32x4 w0 = wg4[0], w1 = wg4[1]; uint4 o; \
          o.x = cvt_pk_bf16(bflo(lo0.x) * w0[0], bfhi(lo0.x) * w0[1]); o.y = cvt_pk_bf16(bflo(lo0.y) * w0[2], bfhi(lo0.y) * w0[3]); \
          o.z = cvt_pk_bf16(bflo(hi0.x) * w1[0], bfhi(hi0.x) * w1[1]); o.w = cvt_pk_bf16(bflo(hi0.y) * w1[2], bfhi(hi0.y) * w1[3]); \
          const bf16x8 vw = __builtin_bit_cast(bf16x8, o); \
          Ct[0][c] = __builtin_amdgcn_mfma_f32_16x16x32_bf16(kt[0][0], vw, Ct[0][c], 0, 0, 0); Ct[1][c] = __builtin_amdgcn_mfma_f32_16x16x32_bf16(kt[1][0], vw, Ct[1][c], 0, 0, 0); } \
        { const f32x4 w0 = wg4[2], w1 = wg4[3]; uint4 o; \
          o.x = cvt_pk_bf16(bflo(lo1.x) * w0[0], bfhi(lo1.x) * w0[1]); o.y = cvt_pk_bf16(bflo(lo1.y) * w0[2], bfhi(lo1.y) * w0[3]); \
          o.z = cvt_pk_bf16(bflo(hi1.x) * w1[0], bfhi(hi1.x) * w1[1]); o.w = cvt_pk_bf16(bflo(hi1.y) * w1[2], bfhi(hi1.y) * w1[3]); \
          const bf16x8 vw = __builtin_bit_cast(bf16x8, o); \
          Ct[0][c] = __builtin_amdgcn_mfma_f32_16x16x32_bf16(kt[0][1], vw, Ct[0][c], 0, 0, 0); Ct[1][c] = __builtin_amdgcn_mfma_f32_16x16x32_bf16(kt[1][1], vw, Ct[1][c], 0, 0, 0); } }
    {
        uint2 vr[4][4];
        tr_read_4c(sV, g, lr, vr);
        MA_TILE(0, vr[0][0], vr[0][1], vr[0][2], vr[0][3]) MA_TILE(1, vr[1][0], vr[1][1], vr[1][2], vr[1][3])
        MA_TILE(2, vr[2][0], vr[2][1], vr[2][2], vr[2][3]) MA_TILE(3, vr[3][0], vr[3][1], vr[3][2], vr[3][3])
        tr_read_4c(sV + 8192, g, lr, vr);
        MA_TILE(4, vr[0][0], vr[0][1], vr[0][2], vr[0][3]) MA_TILE(5, vr[1][0], vr[1][1], vr[1][2], vr[1][3])
        MA_TILE(6, vr[2][0], vr[2][1], vr[2][2], vr[2][3]) MA_TILE(7, vr[3][0], vr[3][1], vr[3][2], vr[3][3])
        const uint2 o0 = tr_frag(sV + 16384, 0, 0, g, lr), o1 = tr_frag(sV + 16384, 16, 0, g, lr), o2 = tr_frag(sV + 16384, 32, 0, g, lr), o3 = tr_frag(sV + 16384, 48, 0, g, lr);
        MA_TILE(8, o0, o1, o2, o3)
    }
#undef MA_TILE
    unsigned char* slot = P.ws + WS_MST + ((size_t)bh * 33 + k) * ST_IMG;
#pragma unroll
    for (int a = 0; a < 2; ++a)
#pragma unroll
        for (int c = 0; c < 9; ++c) {
            uint2 u; u.x = cvt_pk_bf16(Ct[a][c][0], Ct[a][c][1]); u.y = cvt_pk_bf16(Ct[a][c][2], Ct[a][c][3]);
            *(uint2*)(slot + st_piece_off(2 * w + a, c, g, lr)) = u;
        }
}

__device__ __forceinline__ void mlstm_B(const Params& P, int item) {
    const int tid = opaque_tid();
    const int bh = item / 3, part = item - bh * 3;
    const unsigned char* base = P.ws + WS_MST + (size_t)bh * 33 * ST_IMG + part * 12288 + tid * 48;
    unsigned char* obase = P.ws + WS_CBI + (size_t)bh * 33 * ST_IMG + part * 12288 + tid * 48;
    float* msc = (float*)(P.ws + WS_MSC) + (size_t)bh * 33 * 4;
    float C[6][4];
#pragma unroll
    for (int i = 0; i < 6; ++i)
#pragma unroll
        for (int r = 0; r < 4; ++r) C[i][r] = 0.f;
    float m = 0.f;
    uint2 d0[6], d1[6];
    float2 ab0, ab1;
#pragma unroll
    for (int i = 0; i < 6; ++i) { d0[i] = *(const uint2*)(base + i * 8); d1[i] = *(const uint2*)(base + ST_IMG + i * 8); }
    ab0 = *(const float2*)(msc); ab1 = *(const float2*)(msc + 4);
    for (int k = 0; k < 33; ++k) {
        uint2 d2[6]; float2 ab2 = make_float2(0.f, 0.f);
        if (k + 2 < 33) {
#pragma unroll
            for (int i = 0; i < 6; ++i) d2[i] = *(const uint2*)(base + (size_t)(k + 2) * ST_IMG + i * 8);
            ab2 = *(const float2*)(msc + (k + 2) * 4);
        } else {
#pragma unroll
            for (int i = 0; i < 6; ++i) d2[i] = make_uint2(0, 0);
        }
#pragma unroll
        for (int i = 0; i < 6; ++i) {
            uint2 u; u.x = cvt_pk_bf16(C[i][0], C[i][1]); u.y = cvt_pk_bf16(C[i][2], C[i][3]);
            *(uint2*)(obase + (size_t)k * ST_IMG + i * 8) = u;
        }
        if (tid == 0 && part == 0) msc[k * 4 + 2] = m;
        const float M = fmaxf(m, ab0.x);
        const float decay = __expf(m - M), sc = __expf(ab0.x - M);
#pragma unroll
        for (int i = 0; i < 6; ++i) {
            C[i][0] = decay * C[i][0] + sc * bflo(d0[i].x); C[i][1] = decay * C[i][1] + sc * bfhi(d0[i].x);
            C[i][2] = decay * C[i][2] + sc * bflo(d0[i].y); C[i][3] = decay * C[i][3] + sc * bfhi(d0[i].y);
        }
        m = ab0.y + M;
#pragma unroll
        for (int i = 0; i < 6; ++i) { d0[i] = d1[i]; d1[i] = d2[i]; }
        ab0 = ab1; ab1 = ab2;
    }
}

__device__ __forceinline__ void mlstm_C(const Params& P, int item, unsigned char* smem) {
    const int tid = opaque_tid(), lane = tid & 63, w = tid >> 6, g = lane >> 4, lr = lane & 15;
    const int wu = __builtin_amdgcn_readfirstlane(w);
    const int k = item >> 5, bh = item & 31, b = bh >> 2, h = bh & 3;
    const bf16_t* z = (const bf16_t*)(P.ws + WS_Z);
    const bf16_t* qk = (const bf16_t*)(P.ws + WS_RA);
    const float* gates = (const float*)(P.ws + WS_GATES);
    bf16_t* y = (bf16_t*)(P.ws + WS_Z);
    const unsigned char* sK = smem; const unsigned char* sV = smem + 36864; unsigned char* sCb = smem;
    float* ga = (float*)(smem + 61440);
    const int pos = 64 * k + 16 * w + lr;
    const bool tvalid = pos < L;
    const size_t rrow = (size_t)(b * L + (tvalid ? pos : 0));
    const unsigned char* cslot = P.ws + WS_CBI + ((size_t)bh * 33 + k) * ST_IMG + tid * 16;
    const uint4 cb0 = *(const uint4*)(cslot), cb1 = *(const uint4*)(cslot + 4096), cb2 = *(const uint4*)(cslot + 8192), cb3 = *(const uint4*)(cslot + 12288), cb4 = *(const uint4*)(cslot + 16384),
                cb5 = *(const uint4*)(cslot + 20480), cb6 = *(const uint4*)(cslot + 24576), cb7 = *(const uint4*)(cslot + 28672), cb8 = *(const uint4*)(cslot + 32768);
    bf16x8 qf[4];
    {
        const bf16_t* qp = qk + rrow * 1024 + h * 128 + 8 * g;
#pragma unroll
        for (int ks = 0; ks < 4; ++ks) { qf[ks] = *(const bf16x8*)(qp + 32 * ks); if (!tvalid) qf[ks] = (bf16x8){0, 0, 0, 0, 0, 0, 0, 0}; }
    }
    mlstm_stage_kv(P, b, h, k, smem, smem + 36864, tid);
    if (wu == 0) {
        const float m_prev = ((const float*)(P.ws + WS_MSC))[((size_t)bh * 33 + k) * 4 + 2];
        const int p2 = 64 * k + lane;
        float lf = 0.f, li = -INFINITY;
        if (p2 < L) { lf = gates[(size_t)(b * L + p2) * 16 + 4 + h]; li = gates[(size_t)(b * L + p2) * 16 + h]; }
        float bc = lf;
#pragma unroll
        for (int o = 1; o < 64; o <<= 1) { const float n = __shfl_up(bc, o, 64); if (lane >= o) bc += n; }
        const float a = li - bc;
        float am = a;
#pragma unroll
        for (int o = 1; o < 64; o <<= 1) { const float n = __shfl_up(am, o, 64); if (lane >= o) am = fmaxf(am, n); }
        const float M = fmaxf(m_prev, am);
        ga[lane] = a; ga[64 + lane] = __expf(m_prev - M); ga[128 + lane] = __expf(-(bc + M)); ga[192 + lane] = M;
    }
    __syncthreads();
    const float Mt = ga[192 + 16 * w + lr], Wi = ga[64 + 16 * w + lr], Et = ga[128 + 16 * w + lr];
    bf16x8 pf[2];
    {
        f32x4 sa[4];
#pragma unroll
        for (int c = 0; c < 4; ++c) {
            sa[c] = (f32x4){0.f, 0.f, 0.f, 0.f};
            if (c <= wu) {
#pragma unroll
                for (int ks = 0; ks < 4; ++ks) {
                    const bf16x8 kf = *(const bf16x8*)(sK + (ks >> 1) * 8192 + vimg_off(16 * c + lr, 4 * (ks & 1) + g));
                    sa[c] = __builtin_amdgcn_mfma_f32_16x16x32_bf16(kf, qf[ks], sa[c], 0, 0, 0);
                }
                const f32x4 av = *(const f32x4*)(ga + 16 * c + 4 * g);
#pragma unroll
                for (int r = 0; r < 4; ++r) {
                    const float d = __expf(av[r] - Mt);
                    sa[c][r] = (16 * c + 4 * g + r <= 16 * w + lr) ? sa[c][r] * d : 0.f;
                }
            }
        }
#pragma unroll
        for (int s2 = 0; s2 < 2; ++s2) {
            uint4 u;
            u.x = cvt_pk_bf16(sa[2 * s2][0], sa[2 * s2][1]); u.y = cvt_pk_bf16(sa[2 * s2][2], sa[2 * s2][3]);
            u.z = cvt_pk_bf16(sa[2 * s2 + 1][0], sa[2 * s2 + 1][1]); u.w = cvt_pk_bf16(sa[2 * s2 + 1][2], sa[2 * s2 + 1][3]);
            pf[s2] = __builtin_bit_cast(bf16x8, u);
        }
    }
    __syncthreads();
    {
        unsigned char* d = sCb + tid * 16;
        *(uint4*)(d) = cb0; *(uint4*)(d + 4096) = cb1; *(uint4*)(d + 8192) = cb2; *(uint4*)(d + 12288) = cb3; *(uint4*)(d + 16384) = cb4;
        *(uint4*)(d + 20480) = cb5; *(uint4*)(d + 24576) = cb6; *(uint4*)(d + 28672) = cb7; *(uint4*)(d + 32768) = cb8;
    }
    __syncthreads();
    f32x4 na[9];
#define MC_TILE(c, lo0, hi0, lo1, hi1) { \
        na[c] = (f32x4){0.f, 0.f, 0.f, 0.f}; \
        _Pragma("unroll") for (int ks = 0; ks < 4; ++ks) { \
            const bf16x8 cf = *(const bf16x8*)(sCb + (ks >> 1) * 18432 + vimg_off(16 * (c) + lr, 4 * (ks & 1) + g)); \
            na[c] = __builtin_amdgcn_mfma_f32_16x16x32_bf16(cf, qf[ks], na[c], 0, 0, 0); } \
        na[c] *= Wi; \
        na[c] = __builtin_amdgcn_mfma_f32_16x16x32_bf16(tr_pair(lo0, hi0), pf[0], na[c], 0, 0, 0); \
        na[c] = __builtin_amdgcn_mfma_f32_16x16x32_bf16(tr_pair(lo1, hi1), pf[1], na[c], 0, 0, 0); }
    {
        uint2 vr[4][4];
        tr_read_4c(sV, g, lr, vr);
        MC_TILE(0, vr[0][0], vr[0][1], vr[0][2], vr[0][3]) MC_TILE(1, vr[1][0], vr[1][1], vr[1][2], vr[1][3])
        MC_TILE(2, vr[2][0], vr[2][1], vr[2][2], vr[2][3]) MC_TILE(3, vr[3][0], vr[3][1], vr[3][2], vr[3][3])
        tr_read_4c(sV + 8192, g, lr, vr);
        MC_TILE(4, vr[0][0], vr[0][1], vr[0][2], vr[0][3]) MC_TILE(5, vr[1][0], vr[1][1], vr[1][2], vr[1][3])
        MC_TILE(6, vr[2][0], vr[2][1], vr[2][2], vr[2][3]) MC_TILE(7, vr[3][0], vr[3][1], vr[3][2], vr[3][3])
        const uint2 o0 = tr_frag(sV + 16384, 0, 0, g, lr), o1 = tr_frag(sV + 16384, 16, 0, g, lr), o2 = tr_frag(sV + 16384, 32, 0, g, lr), o3 = tr_frag(sV + 16384, 48, 0, g, lr);
        MC_TILE(8, o0, o1, o2, o3)
    }
#undef MC_TILE
    const float den = __shfl(na[8][0], lr, 64);
    const float rden = 1.0f / fmaxf(fabsf(den), Et);
    float hs = 0.f;
#pragma unroll
    for (int c = 0; c < 8; ++c) { na[c] *= rden; hs += na[c][0] * na[c][0] + na[c][1] * na[c][1] + na[c][2] * na[c][2] + na[c][3] * na[c][3]; }
    hs = x4_sum(hs);
    const float rstd = rsqrtf(hs * (1.0f / 128.0f) + EPS);
    const float* gainp = P.m_out_norm + h * 128 + 4 * g;
#pragma unroll
    for (int c = 0; c < 8; ++c) {
        const uint2 og = *(const uint2*)(z + rrow * NZ + ZC_MO + h * 128 + 16 * c + 4 * g);
        const float o0 = bflo(og.x), o1 = bfhi(og.x), o2 = bflo(og.y), o3 = bfhi(og.y);
        const float4 gn = *(const float4*)(gainp + 16 * c);
        uint2 u;
        u.x = pk2(na[c][0] * rstd * gn.x / (1.f + __expf(-o0)), na[c][1] * rstd * gn.y / (1.f + __expf(-o1)));
        u.y = pk2(na[c][2] * rstd * gn.z / (1.f + __expf(-o2)), na[c][3] * rstd * gn.w / (1.f + __expf(-o3)));
        if (tvalid) *(uint2*)(y + rrow * NZ + h * 128 + 16 * c + 4 * g) = u;
    }
}

__device__ __forceinline__ void peer_token(const Params& P, int t, int lane, int* sidx, float* sval, int* sid, float* sgate, const unsigned char* slut, const unsigned* szero) {
    const unsigned* tk = (const unsigned*)(P.ws + WS_TK) + (size_t)t * 256;
#pragma unroll
    for (int i = 0; i < 4; ++i) {
        const unsigned k = tk[lane * 4 + i];
        sidx[lane * 4 + i] = 127 - (int)(k & 127u);
        sval[lane * 4 + i] = unord_key(k & ~127u);
    }
    __builtin_amdgcn_s_waitcnt(0xc07f);
    __builtin_amdgcn_wave_barrier();
    {
        const int hd = lane >> 3, sub = lane & 7;
        unsigned x[8];
#pragma unroll
        for (int r = 0; r < 8; ++r) {
            const int c = sub * 8 + r;
            const unsigned ij = slut[c < 50 ? c : 0];
            const int i = ij >> 4, j = ij & 15;
            const unsigned kx = (ord_key(sval[(2 * hd) * 16 + i] + sval[(2 * hd + 1) * 16 + j]) & ~255u) | (unsigned)(255 - (i * 16 + j));
            x[r] = c < 50 ? kx : 0u;
        }
#pragma unroll
        for (int k = 2; k <= 64; k <<= 1) {
#pragma unroll
            for (int j = k >> 1; j >= 1; j >>= 1) {
                if (j >= 8) {
                    const int ld = j >> 3;
                    const bool lower = (sub & ld) == 0;
                    const bool desc = k >= 64 ? true : ((sub * 8) & k) == 0;
                    const bool takemax = (lower == desc);
#pragma unroll
                    for (int r = 0; r < 8; ++r) {
                        const unsigned o = (unsigned)__shfl_xor((int)x[r], ld, 64);
                        const unsigned hi = max(x[r], o), lo = min(x[r], o);
                        x[r] = takemax ? hi : lo;
                    }
                } else {
#pragma unroll
                    for (int r = 0; r < 8; ++r) {
                        if ((r & j) == 0) {
                            const int p = r | j;
                            const unsigned hi = max(x[r], x[p]), lo = min(x[r], x[p]);
                            if (k <= 4) { const bool desc = (r & k) == 0; x[r] = desc ? hi : lo; x[p] = desc ? lo : hi; }
                            else if (k >= 64) { x[r] = hi; x[p] = lo; }
                            else { const bool desc = ((sub * 8) & k) == 0; x[r] = desc ? hi : lo; x[p] = desc ? lo : hi; }
                        }
                    }
                }
            }
        }
        const float smax = unord_key((unsigned)__shfl((int)x[0], hd * 8, 64) & ~255u);
        float e[8]; float den = 0.f;
#pragma unroll
        for (int r = 0; r < 8; ++r) { e[r] = __expf(unord_key(x[r] & ~255u) - smax); den += e[r]; }
        den += __shfl_xor(den, 1, 64);
        const float inv = 1.f / den;
        if (sub < 2) {
#pragma unroll
            for (int r = 0; r < 8; ++r) {
                const int pos = 255 - (int)(x[r] & 255u), i = pos >> 4, j = pos & 15;
                sid[hd * 16 + sub * 8 + r] = sidx[(2 * hd) * 16 + i] * 128 + sidx[(2 * hd + 1) * 16 + j];
                sgate[hd * 16 + sub * 8 + r] = e[r] * inv;
            }
        }
    }
    __builtin_amdgcn_s_waitcnt(0xc07f);
    __builtin_amdgcn_wave_barrier();
    const bf16_t* xn = (const bf16_t*)(P.ws + WS_XN) + (size_t)t * DM;
    const float rstd = ((const float*)(P.ws + WS_RSTD))[t];
    const unsigned char* V = P.ws + WS_V + lane * 8;
    const float* usc = (const float*)(P.ws + WS_USC);
    const float* vsc = (const float*)(P.ws + WS_VSC);
    const int g = lane >> 4, lr = lane & 15;
    unsigned char* shi = (unsigned char*)sval;
    unsigned char* slo = (unsigned char*)sidx;
    {
        const uint4 xa = *(const uint4*)(xn + lane * 16), xb = *(const uint4*)(xn + lane * 16 + 8);
        const unsigned xw[8] = {xa.x, xa.y, xa.z, xa.w, xb.x, xb.y, xb.z, xb.w};
        unsigned hi[4], lo[4];
#pragma unroll
        for (int i = 0; i < 4; ++i) {
            const float x0 = bflo(xw[2 * i]), x1 = bfhi(xw[2 * i]), x2 = bflo(xw[2 * i + 1]), x3 = bfhi(xw[2 * i + 1]);
            int wd = 0;
            wd = __builtin_amdgcn_cvt_pk_fp8_f32(x0, x1, wd, false);
            wd = __builtin_amdgcn_cvt_pk_fp8_f32(x2, x3, wd, true);
            const f32x2 h01 = __builtin_amdgcn_cvt_pk_f32_fp8(wd, false), h23 = __builtin_amdgcn_cvt_pk_f32_fp8(wd, true);
            int wl = 0;
            wl = __builtin_amdgcn_cvt_pk_fp8_f32(x0 - h01.x, x1 - h01.y, wl, false);
            wl = __builtin_amdgcn_cvt_pk_fp8_f32(x2 - h23.x, x3 - h23.y, wl, true);
            hi[i] = (unsigned)wd; lo[i] = (unsigned)wl;
        }
        *(uint4*)(shi + lane * 16) = make_uint4(hi[0], hi[1], hi[2], hi[3]);
        *(uint4*)(slo + lane * 16) = make_uint4(lo[0], lo[1], lo[2], lo[3]);
    }
    __builtin_amdgcn_s_waitcnt(0xc07f);
    __builtin_amdgcn_wave_barrier();
    {
        typedef int v8i __attribute__((ext_vector_type(8)));
        const unsigned char* Ub = P.ws + WS_U + 16 * g;
        const unsigned char* bsrc = (lr == 0) ? (shi + 16 * g) : (lr == 1) ? (slo + 16 * g) : (const unsigned char*)szero;
        const int bstep = (lr < 2) ? 128 : 0, bhalf = (lr < 2) ? 64 : 16;
        v8i Bv[8];
#pragma unroll
        for (int st = 0; st < 8; ++st) {
            const uint4 b0 = *(const uint4*)(bsrc + bstep * st), b1 = *(const uint4*)(bsrc + bstep * st + bhalf);
            Bv[st] = (v8i){(int)b0.x, (int)b0.y, (int)b0.z, (int)b0.w, (int)b1.x, (int)b1.y, (int)b1.z, (int)b1.w};
        }
        unsigned off[8];
#pragma unroll
        for (int T = 0; T < 8; ++T) off[T] = (unsigned)sid[16 * T + lr] * 512u;
        __builtin_amdgcn_s_waitcnt(0xc07f);
        __builtin_amdgcn_wave_barrier();
        float* sact = (float*)sidx + ((lr == 1) ? 128 : 0);
        uint4 abuf[2][8];
#pragma unroll
        for (int st = 0; st < 8; ++st) abuf[0][st] = *(const uint4*)(Ub + off[0] + 64 * st);
#pragma unroll
        for (int T = 0; T < 8; ++T) {
            if (T + 1 < 8) {
#pragma unroll
                for (int st = 0; st < 8; ++st) abuf[(T + 1) & 1][st] = *(const uint4*)(Ub + off[T + 1] + 64 * st);
            }
            f32x4 au = (f32x4){0.f, 0.f, 0.f, 0.f};
#pragma unroll
            for (int st = 0; st < 8; ++st) {
                const uint4 a4 = abuf[T & 1][st];
                const v8i Av = {(int)a4.x, (int)a4.y, (int)a4.z, (int)a4.w, 0, 0, 0, 0};
                au = __builtin_amdgcn_mfma_scale_f32_16x16x128_f8f6f4(Av, Bv[st], au, 4, 0, 0, 0x7f7f7f7f, 0, 0x7f7f7f7f);
            }
            if (lr < 2) *(f32x4*)(sact + 16 * T + 4 * g) = au;
        }
    }
    __builtin_amdgcn_s_waitcnt(0xc07f);
    __builtin_amdgcn_wave_barrier();
    {
        float* sw = (float*)sidx;
        float wv[2];
#pragma unroll
        for (int hh = 0; hh < 2; ++hh) {
            const int e = lane + 64 * hh, id = sid[e];
            const float a = (sw[e] + sw[128 + e]) * usc[id] * rstd;
            wv[hh] = sgate[e] * vsc[id] * 0.5f * a * (1.f + erff(a * 0.70710678118654752f));
        }
        sw[lane] = wv[0]; sw[lane + 64] = wv[1];
    }
    __builtin_amdgcn_s_waitcnt(0xc07f);
    __builtin_amdgcn_wave_barrier();
    f32x2 acc[8];
#pragma unroll
    for (int j = 0; j < 8; ++j) acc[j] = (f32x2){0.f, 0.f};
#pragma unroll 1
    for (int e0 = 0; e0 < 128; e0 += 16) {
        uint2 vr[16];
#pragma unroll
        for (int q = 0; q < 16; ++q) vr[q] = *(const uint2*)(V + (size_t)sid[e0 + q] * 512);
        const float* sw = (const float*)sidx + e0;
        const f32x4 w0 = *(const f32x4*)(sw), w1 = *(const f32x4*)(sw + 4), w2 = *(const f32x4*)(sw + 8), w3 = *(const f32x4*)(sw + 12);
        const float wq[16] = {w0[0], w0[1], w0[2], w0[3], w1[0], w1[1], w1[2], w1[3], w2[0], w2[1], w2[2], w2[3], w3[0], w3[1], w3[2], w3[3]};
#pragma unroll
        for (int q = 0; q < 16; ++q) {
            const float w = wq[q];
#define FP4_AXPY(k) { acc[k] += w * __builtin_amdgcn_cvt_scalef32_pk_f32_fp4(vr[q].x, 1.0f, k); acc[4 + k] += w * __builtin_amdgcn_cvt_scalef32_pk_f32_fp4(vr[q].y, 1.0f, k); }
            FP4_AXPY(0) FP4_AXPY(1) FP4_AXPY(2) FP4_AXPY(3)
#undef FP4_AXPY
        }
    }
    f32x2 xf[8];
    {
        const uint4 xa = *(const uint4*)(xn + lane * 16), xb = *(const uint4*)(xn + lane * 16 + 8);
        xf[0] = (f32x2){bflo(xa.x), bfhi(xa.x)}; xf[1] = (f32x2){bflo(xa.y), bfhi(xa.y)}; xf[2] = (f32x2){bflo(xa.z), bfhi(xa.z)}; xf[3] = (f32x2){bflo(xa.w), bfhi(xa.w)};
        xf[4] = (f32x2){bflo(xb.x), bfhi(xb.x)}; xf[5] = (f32x2){bflo(xb.y), bfhi(xb.y)}; xf[6] = (f32x2){bflo(xb.z), bfhi(xb.z)}; xf[7] = (f32x2){bflo(xb.w), bfhi(xb.w)};
    }
    float* o = P.out + (size_t)t * DM + lane * 16;
    float4 h0, h1, h2, h3;
    {
        const float4 g0 = *(const float4*)(P.norm_ffn + lane * 16), g1 = *(const float4*)(P.norm_ffn + lane * 16 + 4), g2 = *(const float4*)(P.norm_ffn + lane * 16 + 8), g3 = *(const float4*)(P.norm_ffn + lane * 16 + 12);
        h0.x = xf[0].x / g0.x + acc[0].x; h0.y = xf[0].y / g0.y + acc[0].y; h0.z = xf[1].x / g0.z + acc[1].x; h0.w = xf[1].y / g0.w + acc[1].y;
        h1.x = xf[2].x / g1.x + acc[2].x; h1.y = xf[2].y / g1.y + acc[2].y; h1.z = xf[3].x / g1.z + acc[3].x; h1.w = xf[3].y / g1.w + acc[3].y;
        h2.x = xf[4].x / g2.x + acc[4].x; h2.y = xf[4].y / g2.y + acc[4].y; h2.z = xf[5].x / g2.z + acc[5].x; h2.w = xf[5].y / g2.w + acc[5].y;
        h3.x = xf[6].x / g3.x + acc[6].x; h3.y = xf[6].y / g3.y + acc[6].y; h3.z = xf[7].x / g3.z + acc[7].x; h3.w = xf[7].y / g3.w + acc[7].y;
    }
    *(float4*)(o) = h0; *(float4*)(o + 4) = h1; *(float4*)(o + 8) = h2; *(float4*)(o + 12) = h3;
    __builtin_amdgcn_s_waitcnt(0xc07f);
    __builtin_amdgcn_wave_barrier();
}

#define LAS __attribute__((address_space(3)))
#define XB_TMO      128
#define XB_XCNT(j)  (256  + 64 * (j))
#define XB_XSUB(j)  (1280 + 64 * (j))
#define XB_XGEN(j)  (2304 + 64 * (j))
#define XB_TOP      3328
#define XB_TOPGEN   3392
#define XCD_BAR_WORDS 3456
#define XB_SPIN_CAP (1u << 18)
__device__ __forceinline__ unsigned xb_ld(unsigned* p)              { return __hip_atomic_load(p, __ATOMIC_RELAXED, __HIP_MEMORY_SCOPE_AGENT); }
__device__ __forceinline__ unsigned xb_add(unsigned* p, unsigned v) { return __hip_atomic_fetch_add(p, v, __ATOMIC_RELAXED, __HIP_MEMORY_SCOPE_AGENT); }
__device__ __forceinline__ unsigned xb_xcc_id() { return (unsigned)__builtin_amdgcn_s_getreg((3 << 11) | 20) & 0xFu; }
#define XB_SPIN(cond, bar) do { unsigned _sp = 0; while (cond) { __builtin_amdgcn_s_sleep(1); \
    if ((++_sp & 255u) == 0u) { if (xb_ld(&(bar)[XB_TMO])) break; if (_sp > XB_SPIN_CAP) { atomicAdd(&(bar)[XB_TMO], 1u); break; } } } } while (0)
struct XcdBarrier { unsigned* bar; unsigned x; volatile LAS unsigned* st; };
__device__ __forceinline__ XcdBarrier xcd_barrier_post(unsigned* bar, volatile LAS unsigned* st) {
    XcdBarrier b; b.bar = bar; b.x = xb_xcc_id(); b.st = st;
    if (threadIdx.x == 0) (void)xb_add(&bar[XB_XCNT(b.x)], 1u);
    return b;
}
__device__ __forceinline__ void xcd_barrier_complete(unsigned* bar, unsigned x, unsigned& nloc, unsigned& nx) {
    const unsigned G = gridDim.x * gridDim.y * gridDim.z;
    unsigned sum, cnt, mine, sp = 0u;
    for (;;) {
        sum = 0u; cnt = 0u; mine = 0u;
#pragma unroll
        for (unsigned j = 0; j < 16; ++j) { const unsigned c = xb_ld(&bar[XB_XCNT(j)]); sum += c; cnt += (c > 0u) ? 1u : 0u; mine = (j == x) ? c : mine; }
        if (sum == G) break;
        __builtin_amdgcn_s_sleep(1);
        if ((++sp & 255u) == 0u) { if (xb_ld(&bar[XB_TMO])) break; if (sp > XB_SPIN_CAP) { atomicAdd(&bar[XB_TMO], 1u); break; } }
    }
    nloc = mine > 0u ? mine : 1u; nx = cnt > 0u ? cnt : 1u;
}
__device__ __forceinline__ void xcd_barrier(const XcdBarrier& b) {
    asm volatile("s_waitcnt vmcnt(0)" ::: "memory");
    __syncthreads();
    if (threadIdx.x == 0) {
        unsigned* bar = b.bar;
        __builtin_amdgcn_s_waitcnt(0);
        unsigned nloc = b.st[0], nx = b.st[1];
        if (nloc == 0u) { xcd_barrier_complete(bar, b.x, nloc, nx); b.st[0] = nloc; b.st[1] = nx; }
        const unsigned old = xb_add(&bar[XB_XSUB(b.x)], 1u);
        const unsigned gen = old / nloc;
        if (old + 1u == (gen + 1u) * nloc) {
            __builtin_amdgcn_fence(__ATOMIC_RELEASE, "agent");
            asm volatile("s_waitcnt vmcnt(0)" ::: "memory");
            const unsigned og = xb_add(&bar[XB_TOP], 1u);
            const unsigned tg = og / nx;
            if (og + 1u == (tg + 1u) * nx) xb_add(&bar[XB_TOPGEN], 1u);
            else XB_SPIN(xb_ld(&bar[XB_TOPGEN]) == tg, bar);
            __builtin_amdgcn_fence(__ATOMIC_ACQUIRE, "agent");
            xb_add(&bar[XB_XGEN(b.x)], 1u);
            asm volatile("s_waitcnt vmcnt(0)" ::: "memory");
        } else {
            XB_SPIN(xb_ld(&bar[XB_XGEN(b.x)]) == gen, bar);
            __builtin_amdgcn_fence(__ATOMIC_ACQUIRE, "agent");
            asm volatile("s_waitcnt vmcnt(0)" ::: "memory");
        }
    }
    __syncthreads();
}

__device__ __forceinline__ void hand_release() { asm volatile("s_waitcnt vmcnt(0)" ::: "memory"); __builtin_amdgcn_fence(__ATOMIC_RELEASE, "agent"); asm volatile("s_waitcnt vmcnt(0)" ::: "memory"); }
__device__ __forceinline__ void hand_acquire() { __builtin_amdgcn_fence(__ATOMIC_ACQUIRE, "agent"); asm volatile("s_waitcnt vmcnt(0)" ::: "memory"); }

__global__ void __launch_bounds__(256, 2) mega(Params P) {
    extern __shared__ __attribute__((aligned(16))) unsigned char smem[];
    const int tid = threadIdx.x, lane = tid & 63, wave = tid >> 6;
    const int G = gridDim.x, bid = blockIdx.x;
    unsigned* ctl = (unsigned*)(P.ws + WS_CTL);
    volatile LAS unsigned* bst = (volatile LAS unsigned*)(smem + 65552);
    if (tid == 0) { bst[0] = 0u; bst[1] = 0u; }
    __syncthreads();
    const XcdBarrier xb = xcd_barrier_post(ctl + 1024, bst);
    unsigned* cucnt = ctl + 5120;
    if (tid == 0) {
        const unsigned phys = ((xb_xcc_id() & 7u) << 8) | ((unsigned)__builtin_amdgcn_s_getreg((7 << 11) | (8 << 6) | 4) & 0xFFu);
        bst[2] = phys; bst[3] = xb_add(&cucnt[phys], 1u);
    }
    phase0(P, smem);
    xcd_barrier(xb);
    {
        int vb;
        const unsigned phys = bst[2];
        unsigned part = 0;
#pragma unroll
        for (int q = 0; q < 8; ++q) { const unsigned i = (unsigned)(tid + 256 * q); const unsigned c = xb_ld(&cucnt[i]); part += (i < phys) ? c : 0u; }
#pragma unroll
        for (int o = 1; o < 64; o <<= 1) part += (unsigned)__shfl_xor((int)part, o, 64);
        if (lane == 0) bst[4 + wave] = part;
        __syncthreads();
        vb = (int)(bst[4] + bst[5] + bst[6] + bst[7] + bst[3]);
        vb = __builtin_amdgcn_readfirstlane(vb);
        if (vb < 0 || vb >= G) vb = bid;
        __syncthreads();
        if (tid == 0) bst[8] = (unsigned)vb;
        __syncthreads();
    }
#define VB_LOAD() __builtin_amdgcn_readfirstlane((int)bst[8])
    {
        const int gw = bid * 4 + wave;
        if (gw < 64) fox_cum_wave(P, gw, lane);
        const int vb = VB_LOAD();
        for (int tile = vb; tile < 129 * 28; tile += G) gemm_tile<1>(P, tile / 28, tile % 28, smem);
        {
            const int rem = (129 * 28) % G;
            if (rem > 0 && rem < G) { if (vb >= rem) convert_uv_rows(P, (vb - rem) * 4 + wave, (G - rem) * 4, lane); }
            else convert_uv_rows(P, vb * 4 + wave, G * 4, lane);
        }
    }
    xcd_barrier(xb);
    {
        volatile int* s_item = (volatile int*)(smem + 65536);
        const int wave_u = __builtin_amdgcn_readfirstlane(wave);
        auto fetch = [&](unsigned* counter) -> int {
            if (wave_u == 0) {
                unsigned v = atomicAdd(counter, lane == 0 ? 1u : 0u);
                *s_item = (int)__builtin_amdgcn_readfirstlane(v);
            }
            __syncthreads();
            const int item = __builtin_amdgcn_readfirstlane(*s_item);
            __syncthreads();
            return item;
        };
        for (;;) {
            const int item = fetch(&ctl[2]);
            if (item >= 33 * 32) break;
            mlstm_A(P, item, smem);
        }
        xcd_barrier(xb);
        for (;;) {
            const int item = fetch(&ctl[4]);
            if (item >= 96) break;
            mlstm_B(P, item);
        }
        for (;;) {
            const int item = fetch(&ctl[3]);
            if (item >= 64 * 17) break;
            attn_block(P, item & 63, 16 - (item >> 6), smem);
        }
        xcd_barrier(xb);
        for (;;) {
            const int item = fetch(&ctl[5]);
            if (item >= 33 * 32) break;
            mlstm_C(P, item, smem);
        }
    }
    xcd_barrier(xb);
    for (int tile = VB_LOAD(); tile < 128 * 8; tile += G) gemm_tile<2>(P, tile >> 3, tile & 7, smem);
    xcd_barrier(xb);
    for (int tile = VB_LOAD(); tile < 128 * 16; tile += G) gemm_tile<3>(P, tile >> 4, tile & 15, smem);
    xcd_barrier(xb);
    {
        unsigned char* slut = smem + 12288;
        if (tid < 64) {
            int c = tid, i = 0;
            while (i < 16 && c >= 16 / (i + 1)) { c -= 16 / (i + 1); ++i; }
            slut[tid] = (unsigned char)(i < 16 ? ((i << 4) | c) : 0);
        }
        unsigned* szero = (unsigned*)(smem + 12288 + 64);
        if (tid < 16) szero[tid] = 0u;
        __syncthreads();
        int* sidx = (int*)(smem + wave * 3072); float* sval = (float*)(smem + wave * 3072 + 1024);
        int* sid = (int*)(smem + wave * 3072 + 2048); float* sgate = (float*)(smem + wave * 3072 + 2560);
        int lane5 = lane;
        asm volatile("" : "+v"(lane5));
        for (int t = bid * 4 + wave; t < T2; t += G * 4) peer_token(P, t, lane5, sidx, sval, sid, sgate, slut, szero);
    }
}

}

extern "C" void kernel_launch(void* const* d_in, const int* in_sizes, int n_in, void* d_out, int out_size, void* d_ws, size_t ws_size, hipStream_t stream) {
    if (n_in != 17 || ws_size < WS_END) { fprintf(stderr, "kernel_launch: unexpected n_in %d or ws_size %zu (need %zu)\n", n_in, ws_size, (size_t)WS_END); return; }
    constexpr int LDS_BYTES = 66560;
    static int grid_blocks = 0;
    if (!grid_blocks) {
        int dev = 0, cus = 0, per_cu = 0;
        (void)hipGetDevice(&dev);
        (void)hipDeviceGetAttribute(&cus, hipDeviceAttributeMultiprocessorCount, dev);
        (void)hipFuncSetAttribute((const void*)mega, hipFuncAttributeMaxDynamicSharedMemorySize, LDS_BYTES);
        (void)hipOccupancyMaxActiveBlocksPerMultiprocessor(&per_cu, (const void*)mega, 256, LDS_BYTES);
        if (per_cu < 1) per_cu = 1;
        if (per_cu > 2) per_cu = 2;
        grid_blocks = cus * per_cu;
        fprintf(stderr, "kernel_launch: cus %d per_cu %d grid %d\n", cus, per_cu, grid_blocks);
    }
    Params P{};
    P.x = (const float*)d_in[0]; P.meta = (const float*)d_in[1]; P.norm_mix = (const float*)d_in[2]; P.w_in = (const float*)d_in[3];
    P.conv_qk = (const float*)d_in[4]; P.b_igate = (const float*)d_in[5]; P.b_fgate_m = (const float*)d_in[6]; P.m_out_norm = (const float*)d_in[7];
    P.b_fgate_f = (const float*)d_in[8]; P.f_q_norm = (const float*)d_in[9]; P.f_k_norm = (const float*)d_in[10]; P.w_out = (const float*)d_in[11];
    P.norm_ffn = (const float*)d_in[12]; P.peer_query = (const float*)d_in[13]; P.peer_keys = (const float*)d_in[14]; P.peer_u = (const float*)d_in[15];
    P.peer_v = (const float*)d_in[16]; P.out = (float*)d_out; P.ws = (unsigned char*)d_ws;
    (void)hipMemsetAsync((unsigned char*)d_ws + WS_CTL, 0, 32768, stream);
    void* args[] = {&P};
    hipError_t e = hipLaunchCooperativeKernel((const void*)mega, dim3(grid_blocks), dim3(256), args, LDS_BYTES, stream);
    if (e != hipSuccess) fprintf(stderr, "cooperative launch failed: %s (grid %d)\n", hipGetErrorString(e), grid_blocks);
}
```

```cpp
#include <hip/hip_runtime.h>
#include <stdint.h>
#include <stdio.h>
#include <hip/hip_cooperative_groups.h>
namespace cg = cooperative_groups;

namespace {

constexpr int NB = 8, SEQ = 2048, DM = 1024, NMETA = 16, L = SEQ + NMETA;
constexpr int T1 = NB * L;
constexpr int T2 = NB * SEQ;
constexpr int NZ = 3584;
constexpr int ZC_MQ = 0, ZC_MK = 512, ZC_MV = 1024, ZC_MO = 1536, ZC_FQ = 2048, ZC_FK = 2560, ZC_FV = 3072;
constexpr int PROJ = 3600;
constexpr float EPS = 1e-6f;

constexpr size_t WS_CTL = 0;
constexpr size_t WS_RA = 65536;
constexpr size_t WS_Z = WS_RA + (size_t)T1 * DM * 2;
constexpr size_t WS_GATES = WS_Z + (size_t)T1 * NZ * 2;
constexpr size_t WS_CUM = WS_GATES + (size_t)T1 * 16 * 4;
constexpr size_t WS_SSQ = WS_CUM + (size_t)NB * 8 * L * 4;
constexpr size_t WS_RSTD = WS_SSQ + (size_t)T2 * 16 * 4;
constexpr size_t WS_SSQM = WS_RSTD + (size_t)T2 * 4;
constexpr size_t WS_BT2 = WS_SSQM + (size_t)T1 * 16 * 4;
constexpr size_t WS_BT3 = WS_BT2 + (size_t)DM * DM * 2;
constexpr size_t WS_KEYS = WS_BT3 + (size_t)2048 * DM * 2;
constexpr size_t WS_MSC = WS_KEYS + (size_t)16 * 128 * 128 * 2;
constexpr size_t WS_MST = WS_MSC + (size_t)128 * 33 * 16;
constexpr size_t WS_BT1 = WS_MST + (size_t)32 * 33 * 36864;
constexpr size_t WS_CBI = WS_BT1;
constexpr size_t WS_UV = WS_CBI + (size_t)32 * 33 * 36864;
constexpr size_t WS_END = WS_UV + (size_t)2 * 16384 * 512 + (size_t)2 * 16384 * 4;
constexpr size_t WS_XN = WS_RA;
constexpr size_t WS_U = WS_UV;
constexpr size_t WS_V = WS_U + (size_t)16384 * 512;
constexpr size_t WS_USC = WS_V + (size_t)16384 * 512;
constexpr size_t WS_VSC = WS_USC + (size_t)16384 * 4;
constexpr size_t WS_TK = WS_CBI;
constexpr float LOG2E = 1.4426950408889634f;

typedef unsigned short bf16_t;
typedef short bf16x8 __attribute__((ext_vector_type(8)));
typedef float f32x4 __attribute__((ext_vector_type(4)));
typedef __attribute__((ext_vector_type(2))) __bf16 bf16x2_t;

struct Params {
    const float* x; const float* meta; const float* norm_mix; const float* w_in; const float* conv_qk;
    const float* b_igate; const float* b_fgate_m; const float* m_out_norm; const float* b_fgate_f;
    const float* f_q_norm; const float* f_k_norm; const float* w_out; const float* norm_ffn;
    const float* peer_query; const float* peer_keys; const float* peer_u; const float* peer_v;
    float* out; unsigned char* ws;
};

__device__ __forceinline__ unsigned f2bf(float f) { unsigned u = __float_as_uint(f); return (u + 0x7fffu + ((u >> 16) & 1u)) >> 16; }
__device__ __forceinline__ float bf2f(unsigned h) { return __uint_as_float(h << 16); }
typedef float f32x2 __attribute__((ext_vector_type(2)));
typedef __bf16 bf16x2v __attribute__((ext_vector_type(2)));
__device__ __forceinline__ unsigned cvt_pk_bf16(float lo, float hi) { f32x2 v = {lo, hi}; bf16x2v b = __builtin_convertvector(v, bf16x2v); return __builtin_bit_cast(unsigned, b); }
__device__ __forceinline__ unsigned pk2(float lo, float hi) { return cvt_pk_bf16(lo, hi); }
__device__ __forceinline__ float bflo(unsigned w) { return __uint_as_float(w << 16); }
__device__ __forceinline__ float bfhi(unsigned w) { return __uint_as_float(w & 0xffff0000u); }
__device__ __forceinline__ float wave_sum(float v) {
#pragma unroll
    for (int o = 32; o > 0; o >>= 1) v += __shfl_xor(v, o, 64);
    return v;
}
__device__ __forceinline__ float wave_max(float v) {
#pragma unroll
    for (int o = 32; o > 0; o >>= 1) v = fmaxf(v, __shfl_xor(v, o, 64));
    return v;
}
__device__ __forceinline__ float logsigmoidf(float x) { return fminf(x, 0.f) - log1pf(expf(-fabsf(x))); }
__device__ __forceinline__ unsigned ord_key(float f) { unsigned u = __float_as_uint(f); return u ^ ((u >> 31) ? 0xffffffffu : 0x80000000u); }
__device__ __forceinline__ float unord_key(unsigned k) { unsigned u = (k & 0x80000000u) ? (k ^ 0x80000000u) : ~k; return __uint_as_float(u); }

__device__ __forceinline__ void phase0(const Params& P, unsigned char* smem) {
    const int tid = threadIdx.x, lane = tid & 63, wave = tid >> 6;
    unsigned* ctl = (unsigned*)(P.ws + WS_CTL);
    float* gw = (float*)smem;
    for (int idx = tid; idx < 16 * 1024; idx += 256) {
        const int k = idx >> 4, c = idx & 15;
        const int col = c < 8 ? 2048 + c : 3592 + (c - 8);
        gw[c * 1024 + k] = P.w_in[(size_t)k * PROJ + col];
    }
    __syncthreads();
    {
        bf16_t* hn = (bf16_t*)(P.ws + WS_RA);
        float* gates = (float*)(P.ws + WS_GATES);
        const int c0 = lane * 8, c1 = 512 + lane * 8;
        float gm[16];
        {
            const float4 a0 = *(const float4*)(P.norm_mix + c0), a1 = *(const float4*)(P.norm_mix + c0 + 4);
            const float4 a2 = *(const float4*)(P.norm_mix + c1), a3 = *(const float4*)(P.norm_mix + c1 + 4);
            gm[0] = a0.x; gm[1] = a0.y; gm[2] = a0.z; gm[3] = a0.w; gm[4] = a1.x; gm[5] = a1.y; gm[6] = a1.z; gm[7] = a1.w;
            gm[8] = a2.x; gm[9] = a2.y; gm[10] = a2.z; gm[11] = a2.w; gm[12] = a3.x; gm[13] = a3.y; gm[14] = a3.z; gm[15] = a3.w;
        }
        const int myq = ((lane >> 5) & 1) * 8 + ((lane >> 4) & 1) * 4 + ((lane >> 3) & 1) * 2 + ((lane >> 2) & 1);
        const float mybias = myq < 4 ? P.b_igate[myq] : (myq < 8 ? P.b_fgate_m[myq - 4] : P.b_fgate_f[myq - 8]);
        const int rstep = gridDim.x * 4;
        int r = blockIdx.x * 4 + wave;
        float4 n0, n1, n2, n3;
        auto load_row = [&](int rr) {
            const int b = rr / L, p = rr - b * L;
            const float* src = (p < NMETA) ? (P.meta + (size_t)p * DM) : (P.x + ((size_t)b * SEQ + (p - NMETA)) * DM);
            n0 = *(const float4*)(src + c0); n1 = *(const float4*)(src + c0 + 4); n2 = *(const float4*)(src + c1); n3 = *(const float4*)(src + c1 + 4);
        };
        if (r < T1) load_row(r);
        for (; r < T1; r += rstep) {
            float v[16];
            v[0] = n0.x; v[1] = n0.y; v[2] = n0.z; v[3] = n0.w; v[4] = n1.x; v[5] = n1.y; v[6] = n1.z; v[7] = n1.w;
            v[8] = n2.x; v[9] = n2.y; v[10] = n2.z; v[11] = n2.w; v[12] = n3.x; v[13] = n3.y; v[14] = n3.z; v[15] = n3.w;
            if (r + rstep < T1) load_row(r + rstep);
            float ss = 0.f;
#pragma unroll
            for (int j = 0; j < 16; ++j) ss += v[j] * v[j];
            ss = wave_sum(ss);
            const float rstd = rsqrtf(ss * (1.0f / DM) + EPS);
#pragma unroll
            for (int j = 0; j < 16; ++j) v[j] *= rstd * gm[j];
            uint4 o0, o1;
            o0.x = pk2(v[0], v[1]); o0.y = pk2(v[2], v[3]); o0.z = pk2(v[4], v[5]); o0.w = pk2(v[6], v[7]);
            o1.x = pk2(v[8], v[9]); o1.y = pk2(v[10], v[11]); o1.z = pk2(v[12], v[13]); o1.w = pk2(v[14], v[15]);
            *(uint4*)(hn + (size_t)r * DM + c0) = o0;
            *(uint4*)(hn + (size_t)r * DM + c1) = o1;
            float r8[8], r4[4], r2[2], r1;
#pragma unroll
            for (int i = 0; i < 8; ++i) {
                float dd[2];
#pragma unroll
                for (int hh = 0; hh < 2; ++hh) {
                    const float* gwc = gw + (i + 8 * hh) * 1024;
                    const float4 w0 = *(const float4*)(gwc + c0), w1 = *(const float4*)(gwc + c0 + 4), w2 = *(const float4*)(gwc + c1), w3 = *(const float4*)(gwc + c1 + 4);
                    dd[hh] = v[0] * w0.x + v[1] * w0.y + v[2] * w0.z + v[3] * w0.w + v[4] * w1.x + v[5] * w1.y + v[6] * w1.z + v[7] * w1.w
                           + v[8] * w2.x + v[9] * w2.y + v[10] * w2.z + v[11] * w2.w + v[12] * w3.x + v[13] * w3.y + v[14] * w3.z + v[15] * w3.w;
                }
                const bool up = (lane & 32) != 0; const float keep = up ? dd[1] : dd[0], send = up ? dd[0] : dd[1];
                r8[i] = keep + __shfl_xor(send, 32, 64);
                __builtin_amdgcn_sched_barrier(0);
            }
#pragma unroll
            for (int i = 0; i < 4; ++i) { const bool up = (lane & 16) != 0; const float keep = up ? r8[i + 4] : r8[i], send = up ? r8[i] : r8[i + 4]; r4[i] = keep + __shfl_xor(send, 16, 64); }
#pragma unroll
            for (int i = 0; i < 2; ++i) { const bool up = (lane & 8) != 0; const float keep = up ? r4[i + 2] : r4[i], send = up ? r4[i] : r4[i + 2]; r2[i] = keep + __shfl_xor(send, 8, 64); }
            { const bool up = (lane & 4) != 0; const float keep = up ? r2[1] : r2[0], send = up ? r2[0] : r2[1]; r1 = keep + __shfl_xor(send, 4, 64); }
            r1 += __shfl_xor(r1, 2, 64); r1 += __shfl_xor(r1, 1, 64);
            if ((lane & 3) == 0) {
                const float pre = r1 + mybias;
                gates[(size_t)r * 16 + myq] = myq < 4 ? pre : logsigmoidf(pre);
            }
        }
    }
    __syncthreads();
    {
        float (*tile)[65] = (float (*)[65])smem;
        for (int item = blockIdx.x; item < 1664; item += gridDim.x) {
            const float* W; int ldn, ntn, shift_from, it; bf16_t* out;
            if (item < 896) { W = P.w_in; ldn = PROJ; ntn = 56; shift_from = 2048; it = item; out = (bf16_t*)(P.ws + WS_BT1); }
            else if (item < 1152) { W = P.w_out; ldn = 1024; ntn = 16; shift_from = 1 << 30; it = item - 896; out = (bf16_t*)(P.ws + WS_BT2); }
            else { W = P.peer_query; ldn = 2048; ntn = 32; shift_from = 1 << 30; it = item - 1152; out = (bf16_t*)(P.ws + WS_BT3); }
            const int tk = it / ntn, tn = it - tk * ntn, k0 = tk * 64, n0 = tn * 64;
            {
                const int nl = tid & 63;
                int n = n0 + nl; if (n >= shift_from) n += 8;
#pragma unroll
                for (int i = 0; i < 16; ++i) { const int kl = (tid >> 6) + 4 * i; tile[kl][nl] = W[(size_t)(k0 + kl) * ldn + n]; }
            }
            __syncthreads();
            {
                const int kl = tid & 63;
#pragma unroll
                for (int i = 0; i < 16; ++i) { const int nl = (tid >> 6) + 4 * i; out[(size_t)(n0 + nl) * 1024 + k0 + kl] = (bf16_t)f2bf(tile[kl][nl]); }
            }
            __syncthreads();
        }
    }
    {
        const size_t gt = (size_t)blockIdx.x * 256 + tid, gs = (size_t)gridDim.x * 256;
        const float* src = P.peer_keys; bf16_t* dst = (bf16_t*)(P.ws + WS_KEYS);
        for (size_t i = gt; i < (size_t)(16 * 128 * 128 / 8); i += gs) {
            const float4 a = *(const float4*)(src + i * 8), b = *(const float4*)(src + i * 8 + 4);
            uint4 o; o.x = pk2(a.x, a.y); o.y = pk2(a.z, a.w); o.z = pk2(b.x, b.y); o.w = pk2(b.z, b.w);
            *(uint4*)(dst + i * 8) = o;
        }
    }
}

__device__ __forceinline__ void convert_uv_rows(const Params& P, int gwave, int nwaves, int lane) {
    for (int rr0 = gwave * 4; rr0 < 2 * 16384; rr0 += nwaves * 4) {
        float4 a[4][4];
#pragma unroll
        for (int q = 0; q < 4; ++q) {
            const int rr = rr0 + q, which = rr >> 14, row = rr & 16383;
            const float* src = (which ? P.peer_v : P.peer_u) + (size_t)row * DM + lane * 16;
            a[q][0] = *(const float4*)(src); a[q][1] = *(const float4*)(src + 4); a[q][2] = *(const float4*)(src + 8); a[q][3] = *(const float4*)(src + 12);
        }
#pragma unroll
        for (int q = 0; q < 4; ++q) {
            const int rr = rr0 + q, which = rr >> 14, row = rr & 16383;
            float mx = 0.f;
#pragma unroll
            for (int j = 0; j < 4; ++j) mx = fmaxf(mx, fmaxf(fmaxf(fabsf(a[q][j].x), fabsf(a[q][j].y)), fmaxf(fabsf(a[q][j].z), fabsf(a[q][j].w))));
            mx = wave_max(mx);
            const float sc = mx > 0.f ? 6.0f / mx : 1.0f;
            unsigned w0 = 0u, w1 = 0u;
            w0 = __builtin_amdgcn_cvt_scalef32_pk_fp4_f32(w0, a[q][0].x * sc, a[q][0].y * sc, 1.0f, 0); w0 = __builtin_amdgcn_cvt_scalef32_pk_fp4_f32(w0, a[q][0].z * sc, a[q][0].w * sc, 1.0f, 1);
            w0 = __builtin_amdgcn_cvt_scalef32_pk_fp4_f32(w0, a[q][1].x * sc, a[q][1].y * sc, 1.0f, 2); w0 = __builtin_amdgcn_cvt_scalef32_pk_fp4_f32(w0, a[q][1].z * sc, a[q][1].w * sc, 1.0f, 3);
            w1 = __builtin_amdgcn_cvt_scalef32_pk_fp4_f32(w1, a[q][2].x * sc, a[q][2].y * sc, 1.0f, 0); w1 = __builtin_amdgcn_cvt_scalef32_pk_fp4_f32(w1, a[q][2].z * sc, a[q][2].w * sc, 1.0f, 1);
            w1 = __builtin_amdgcn_cvt_scalef32_pk_fp4_f32(w1, a[q][3].x * sc, a[q][3].y * sc, 1.0f, 2); w1 = __builtin_amdgcn_cvt_scalef32_pk_fp4_f32(w1, a[q][3].z * sc, a[q][3].w * sc, 1.0f, 3);
            *(uint2*)(P.ws + (which ? WS_V : WS_U) + (size_t)row * 512 + lane * 8) = make_uint2(w0, w1);
            if (lane == 0) ((float*)(P.ws + (which ? WS_VSC : WS_USC)))[row] = mx > 0.f ? mx * (1.0f / 6.0f) : 1.0f;
        }
    }
}

__device__ __forceinline__ void bitonic_sort16_desc(unsigned (&v)[16]) {
#pragma unroll
    for (int k = 2; k <= 16; k <<= 1)
#pragma unroll
        for (int j = k >> 1; j >= 1; j >>= 1)
#pragma unroll
            for (int i = 0; i < 16; ++i)
                if ((i & j) == 0) {
                    const int p = i | j;
                    const bool desc = (k >= 16) ? true : ((i & k) == 0);
                    const unsigned hi = max(v[i], v[p]), lo = min(v[i], v[p]);
                    v[i] = desc ? hi : lo; v[p] = desc ? lo : hi;
                }
}
__device__ __forceinline__ void bitonic_merge16_top(unsigned (&a)[16], const unsigned (&b)[16]) {
#pragma unroll
    for (int i = 0; i < 16; ++i) a[i] = max(a[i], b[15 - i]);
#pragma unroll
    for (int j = 8; j >= 1; j >>= 1)
#pragma unroll
        for (int i = 0; i < 16; ++i)
            if ((i & j) == 0) { const int p = i | j; const unsigned hi = max(a[i], a[p]), lo = min(a[i], a[p]); a[i] = hi; a[p] = lo; }
}

__device__ __forceinline__ float x4_max(float x) {
    const unsigned xi = __float_as_uint(x);
    const auto r = __builtin_amdgcn_permlane32_swap(xi, xi, false, false);
    const float m = fmaxf(__uint_as_float(r[0]), __uint_as_float(r[1]));
    const unsigned mi = __float_as_uint(m);
    const auto r2 = __builtin_amdgcn_permlane16_swap(mi, mi, false, false);
    return fmaxf(__uint_as_float(r2[0]), __uint_as_float(r2[1]));
}
__device__ __forceinline__ float x4_sum(float x) {
    const unsigned xi = __float_as_uint(x);
    const auto r = __builtin_amdgcn_permlane32_swap(xi, xi, false, false);
    const float m = __uint_as_float(r[0]) + __uint_as_float(r[1]);
    const unsigned mi = __float_as_uint(m);
    const auto r2 = __builtin_amdgcn_permlane16_swap(mi, mi, false, false);
    return __uint_as_float(r2[0]) + __uint_as_float(r2[1]);
}

__device__ __forceinline__ int opaque_tid() { int t = threadIdx.x; asm volatile("" : "+v"(t)); return t; }

__device__ __forceinline__ void mma_ktile(const unsigned char* sA, const unsigned char* sB, int arow_off, int brow_off, int g, int sw, f32x4 (&acc)[4][4]) {
#pragma unroll
    for (int s = 0; s < 2; ++s) {
        bf16x8 a[4], b[4];
        const int ch = (((s * 4 + g) ^ sw) << 4);
#pragma unroll
        for (int i = 0; i < 4; ++i) a[i] = *(const bf16x8*)(sA + arow_off + i * 2048 + ch);
#pragma unroll
        for (int j = 0; j < 4; ++j) b[j] = *(const bf16x8*)(sB + brow_off + j * 2048 + ch);
#pragma unroll
        for (int i = 0; i < 4; ++i)
#pragma unroll
            for (int j = 0; j < 4; ++j) acc[i][j] = __builtin_amdgcn_mfma_f32_16x16x32_bf16(b[j], a[i], acc[i][j], 0, 0, 0);
    }
}

__device__ __forceinline__ void store_tile_bf16(const f32x4 (&acc)[4][4], unsigned char* smem, bf16_t* dst, size_t ld, int m0, int n0, int tid, int wr, int wc, int g, int lr) {
#pragma unroll
    for (int i = 0; i < 4; ++i)
#pragma unroll
        for (int j = 0; j < 4; ++j) {
            const int row = wr * 64 + 16 * i + lr, col = wc * 64 + 16 * j + 4 * g;
            uint2 w; w.x = pk2(acc[i][j][0], acc[i][j][1]); w.y = pk2(acc[i][j][2], acc[i][j][3]);
            *(uint2*)(smem + row * 272 + col * 2) = w;
        }
    __syncthreads();
#pragma unroll
    for (int q = 0; q < 8; ++q) {
        const int id = tid + 256 * q, row = id >> 4, ch = id & 15;
        const uint4 v = *(const uint4*)(smem + row * 272 + ch * 16);
        *(uint4*)(dst + (size_t)(m0 + row) * ld + n0 + ch * 8) = v;
    }
    __syncthreads();
}

template <int MODE>
__device__ __forceinline__ void gemm_tile(const Params& P, int tm, int tn, unsigned char* smem) {
    const bf16_t* A; const bf16_t* Bt;
    if (MODE == 1) { A = (const bf16_t*)(P.ws + WS_RA); Bt = (const bf16_t*)(P.ws + WS_BT1); }
    else if (MODE == 2) { A = (const bf16_t*)(P.ws + WS_Z); Bt = (const bf16_t*)(P.ws + WS_BT2); }
    else { A = (const bf16_t*)(P.ws + WS_XN); Bt = (const bf16_t*)(P.ws + WS_BT3); }
    const int tid = opaque_tid(), lane = tid & 63, wave = tid >> 6, wr = wave >> 1, wc = wave & 1, g = lane >> 4, lr = lane & 15;
    const int m0 = tm * 128, n0 = tn * 128;
    const int srow = tid >> 3, sc = tid & 7;
    constexpr unsigned LDA = (MODE == 2 ? NZ : 1024) * 2u;
    unsigned aoff, boff; int soff0;
    {
        int ar = m0 + srow;
        if (MODE == 2) { const int b = ar >> 11, t = ar & 2047; ar = b * L + NMETA + t; }
        aoff = (unsigned)ar * LDA + (unsigned)sc * 16u;
        boff = (unsigned)(n0 + srow) * 2048u + (unsigned)sc * 16u;
        soff0 = srow * 128 + ((sc ^ (srow & 7)) << 4);
    }
    const unsigned char* Ab = (const unsigned char*)A; const unsigned char* Bb = (const unsigned char*)Bt;
    f32x4 acc[4][4];
#pragma unroll
    for (int i = 0; i < 4; ++i)
#pragma unroll
        for (int j = 0; j < 4; ++j) acc[i][j] = (f32x4){0.f, 0.f, 0.f, 0.f};
    uint4 ra0, ra1, ra2, ra3, rb0, rb1, rb2, rb3;
#define G_LOAD(KT) { const unsigned ko = (unsigned)(KT) * 128u; \
        ra0 = *(const uint4*)(Ab + (aoff + ko)); ra1 = *(const uint4*)(Ab + (aoff + 32u * LDA + ko)); ra2 = *(const uint4*)(Ab + (aoff + 64u * LDA + ko)); ra3 = *(const uint4*)(Ab + (aoff + 96u * LDA + ko)); \
        rb0 = *(const uint4*)(Bb + (boff + ko)); rb1 = *(const uint4*)(Bb + (boff + 32u * 2048u + ko)); rb2 = *(const uint4*)(Bb + (boff + 64u * 2048u + ko)); rb3 = *(const uint4*)(Bb + (boff + 96u * 2048u + ko)); }
#define G_WRITE(SA, SB) { *(uint4*)((SA) + soff0) = ra0; *(uint4*)((SA) + soff0 + 4096) = ra1; *(uint4*)((SA) + soff0 + 8192) = ra2; *(uint4*)((SA) + soff0 + 12288) = ra3; \
        *(uint4*)((SB) + soff0) = rb0; *(uint4*)((SB) + soff0 + 4096) = rb1; *(uint4*)((SB) + soff0 + 8192) = rb2; *(uint4*)((SB) + soff0 + 12288) = rb3; }
    unsigned char* sA0 = smem; unsigned char* sB0 = smem + 16384; unsigned char* sA1 = smem + 32768; unsigned char* sB1 = smem + 49152;
    G_LOAD(0)
    G_WRITE(sA0, sB0)
    __syncthreads();
    const int arow_off = (wr * 64 + lr) * 128, brow_off = (wc * 64 + lr) * 128, sw = lr & 7;
    G_LOAD(1)
    for (int kt = 0; kt < 16; ++kt) {
        unsigned char* sA = (kt & 1) ? sA1 : sA0; unsigned char* sB = (kt & 1) ? sB1 : sB0;
        unsigned char* nA = (kt & 1) ? sA0 : sA1; unsigned char* nB = (kt & 1) ? sB0 : sB1;
        bf16x8 fa[4], fb[4], ga[4], gb[4];
        const int ch0 = ((g ^ sw) << 4), ch1 = (((4 + g) ^ sw) << 4);
        const unsigned ko = (unsigned)(kt + 2) * 128u;
        const bool wr_ok = kt < 15, ld_ok = kt < 14;
#pragma unroll
        for (int i = 0; i < 4; ++i) { fa[i] = *(const bf16x8*)(sA + arow_off + i * 2048 + ch0); fb[i] = *(const bf16x8*)(sB + brow_off + i * 2048 + ch0); }
        __builtin_amdgcn_sched_barrier(0);
        __builtin_amdgcn_s_setprio(2);
        if (wr_ok) *(uint4*)(nA + soff0) = ra0;
        if (ld_ok) ra0 = *(const uint4*)(Ab + (aoff + 0u * LDA + ko));
        ga[0] = *(const bf16x8*)(sA + arow_off + 0 * 2048 + ch1); gb[0] = *(const bf16x8*)(sB + brow_off + 0 * 2048 + ch1);
        __builtin_amdgcn_sched_barrier(0);
#pragma unroll
        for (int j = 0; j < 4; ++j) acc[0][j] = __builtin_amdgcn_mfma_f32_16x16x32_bf16(fb[j], fa[0], acc[0][j], 0, 0, 0);
        __builtin_amdgcn_sched_barrier(0);
        if (wr_ok) *(uint4*)(nA + soff0 + 4096) = ra1;
        if (ld_ok) ra1 = *(const uint4*)(Ab + (aoff + 32u * LDA + ko));
        ga[1] = *(const bf16x8*)(sA + arow_off + 1 * 2048 + ch1); gb[1] = *(const bf16x8*)(sB + brow_off + 1 * 2048 + ch1);
        __builtin_amdgcn_sched_barrier(0);
#pragma unroll
        for (int j = 0; j < 4; ++j) acc[1][j] = __builtin_amdgcn_mfma_f32_16x16x32_bf16(fb[j], fa[1], acc[1][j], 0, 0, 0);
        __builtin_amdgcn_sched_barrier(0);
        if (wr_ok) *(uint4*)(nA + soff0 + 8192) = ra2;
        if (ld_ok) ra2 = *(const uint4*)(Ab + (aoff + 64u * LDA + ko));
        ga[2] = *(const bf16x8*)(sA + arow_off + 2 * 2048 + ch1); gb[2] = *(const bf16x8*)(sB + brow_off + 2 * 2048 + ch1);
        __builtin_amdgcn_sched_barrier(0);
#pragma unroll
        for (int j = 0; j < 4; ++j) acc[2][j] = __builtin_amdgcn_mfma_f32_16x16x32_bf16(fb[j], fa[2], acc[2][j], 0, 0, 0);
        __builtin_amdgcn_sched_barrier(0);
        if (wr_ok) *(uint4*)(nA + soff0 + 12288) = ra3;
        if (ld_ok) ra3 = *(const uint4*)(Ab + (aoff + 96u * LDA + ko));
        ga[3] = *(const bf16x8*)(sA + arow_off + 3 * 2048 + ch1); gb[3] = *(const bf16x8*)(sB + brow_off + 3 * 2048 + ch1);
        __builtin_amdgcn_sched_barrier(0);
#pragma unroll
        for (int j = 0; j < 4; ++j) acc[3][j] = __builtin_amdgcn_mfma_f32_16x16x32_bf16(fb[j], fa[3], acc[3][j], 0, 0, 0);
        __builtin_amdgcn_sched_barrier(0);
        if (wr_ok) *(uint4*)(nB + soff0) = rb0;
        if (ld_ok) rb0 = *(const uint4*)(Bb + (boff + 0u * 2048u + ko));
        __builtin_amdgcn_sched_barrier(0);
#pragma unroll
        for (int j = 0; j < 4; ++j) acc[0][j] = __builtin_amdgcn_mfma_f32_16x16x32_bf16(gb[j], ga[0], acc[0][j], 0, 0, 0);
        __builtin_amdgcn_sched_barrier(0);
        if (wr_ok) *(uint4*)(nB + soff0 + 4096) = rb1;
        if (ld_ok) rb1 = *(const uint4*)(Bb + (boff + 32u * 2048u + ko));
        __builtin_amdgcn_sched_barrier(0);
#pragma unroll
        for (int j = 0; j < 4; ++j) acc[1][j] = __builtin_amdgcn_mfma_f32_16x16x32_bf16(gb[j], ga[1], acc[1][j], 0, 0, 0);
        __builtin_amdgcn_sched_barrier(0);
        if (wr_ok) *(uint4*)(nB + soff0 + 8192) = rb2;
        if (ld_ok) rb2 = *(const uint4*)(Bb + (boff + 64u * 2048u + ko));
        __builtin_amdgcn_sched_barrier(0);
#pragma unroll
        for (int j = 0; j < 4; ++j) acc[2][j] = __builtin_amdgcn_mfma_f32_16x16x32_bf16(gb[j], ga[2], acc[2][j], 0, 0, 0);
        __builtin_amdgcn_sched_barrier(0);
        if (wr_ok) *(uint4*)(nB + soff0 + 12288) = rb3;
        if (ld_ok) rb3 = *(const uint4*)(Bb + (boff + 96u * 2048u + ko));
        __builtin_amdgcn_sched_barrier(0);
#pragma unroll
        for (int j = 0; j < 4; ++j) acc[3][j] = __builtin_amdgcn_mfma_f32_16x16x32_bf16(gb[j], ga[3], acc[3][j], 0, 0, 0);
        __builtin_amdgcn_s_setprio(0);
        __syncthreads();
    }
#undef G_LOAD
#undef G_WRITE
    if (MODE == 1) {
        if (n0 >= ZC_FQ && n0 < ZC_FV) {
            const bool isk = n0 >= ZC_FK;
            const float* gain = isk ? P.f_k_norm : P.f_q_norm;
            const float scl = isk ? 1.0f : 0.125f * LOG2E;
            float gn[4][4];
#pragma unroll
            for (int j = 0; j < 4; ++j)
#pragma unroll
                for (int r = 0; r < 4; ++r) gn[j][r] = gain[16 * j + 4 * g + r];
#pragma unroll
            for (int i = 0; i < 4; ++i) {
                float ss = 0.f;
#pragma unroll
                for (int j = 0; j < 4; ++j)
#pragma unroll
                    for (int r = 0; r < 4; ++r) ss += acc[i][j][r] * acc[i][j][r];
                ss = x4_sum(ss);
                const float rstd = rsqrtf(ss * (1.0f / 64.0f) + EPS) * scl;
#pragma unroll
                for (int j = 0; j < 4; ++j)
#pragma unroll
                    for (int r = 0; r < 4; ++r) acc[i][j][r] *= rstd * gn[j][r];
            }
        }
        store_tile_bf16(acc, smem, (bf16_t*)(P.ws + WS_Z), NZ, m0, n0, tid, wr, wc, g, lr);
    } else if (MODE == 2) {
        float* ssq = (float*)(P.ws + WS_SSQ);
#pragma unroll
        for (int i = 0; i < 4; ++i) {
            const int row = m0 + wr * 64 + 16 * i + lr;
            float ss = 0.f;
#pragma unroll
            for (int j = 0; j < 4; ++j) {
                const int col = n0 + wc * 64 + 16 * j + 4 * g;
                const float4 xv = *(const float4*)(P.x + (size_t)row * DM + col);
                const float4 gv = *(const float4*)(P.norm_ffn + col);
                float4 hv; hv.x = acc[i][j][0] + xv.x; hv.y = acc[i][j][1] + xv.y; hv.z = acc[i][j][2] + xv.z; hv.w = acc[i][j][3] + xv.w;
                ss += hv.x * hv.x + hv.y * hv.y + hv.z * hv.z + hv.w * hv.w;
                acc[i][j][0] = hv.x * gv.x; acc[i][j][1] = hv.y * gv.y; acc[i][j][2] = hv.z * gv.z; acc[i][j][3] = hv.w * gv.w;
            }
            ss = x4_sum(ss);
            if (g == 0) ssq[(size_t)row * 16 + tn * 2 + wc] = ss;
        }
        store_tile_bf16(acc, smem, (bf16_t*)(P.ws + WS_XN), 1024, m0, n0, tid, wr, wc, g, lr);
    } else {
        const int hp = tn;
        const float* ssq = (const float*)(P.ws + WS_SSQ);
        float rs[4];
#pragma unroll
        for (int i = 0; i < 4; ++i) {
            const int row = m0 + wr * 64 + 16 * i + lr;
            const float4 p0 = *(const float4*)(ssq + (size_t)row * 16), p1 = *(const float4*)(ssq + (size_t)row * 16 + 4);
            const float4 p2 = *(const float4*)(ssq + (size_t)row * 16 + 8), p3 = *(const float4*)(ssq + (size_t)row * 16 + 12);
            const float s = ((p0.x + p0.y) + (p0.z + p0.w)) + ((p1.x + p1.y) + (p1.z + p1.w)) + ((p2.x + p2.y) + (p2.z + p2.w)) + ((p3.x + p3.y) + (p3.z + p3.w));
            rs[i] = rsqrtf(s * (1.0f / DM) + EPS);
            if (tn == 0 && wc == 0 && g == 0) ((float*)(P.ws + WS_RSTD))[row] = rs[i];
        }
        {
            unsigned char* sAq = wc ? sA1 : sA0;
#pragma unroll
            for (int i = 0; i < 4; ++i)
#pragma unroll
                for (int j = 0; j < 4; ++j) {
                    const int row = wr * 64 + 16 * i + lr;
                    const int chunk = 2 * j + (g >> 1);
                    uint2 w; w.x = pk2(acc[i][j][0] * rs[i], acc[i][j][1] * rs[i]); w.y = pk2(acc[i][j][2] * rs[i], acc[i][j][3] * rs[i]);
                    *(uint2*)(sAq + row * 128 + ((chunk ^ (row & 7)) << 4) + 8 * (g & 1)) = w;
                }
            const bf16_t* keys = (const bf16_t*)(P.ws + WS_KEYS) + (size_t)hp * 128 * 128;
#pragma unroll
            for (int j = 0; j < 4; ++j) {
                const int row = srow + 32 * j;
                const uint4 k0 = *(const uint4*)(keys + (size_t)row * 128 + sc * 8);
                const uint4 k1 = *(const uint4*)(keys + (size_t)row * 128 + 64 + sc * 8);
                *(uint4*)(sB0 + soff0 + j * 4096) = k0; *(uint4*)(sB1 + soff0 + j * 4096) = k1;
            }
        }
        __syncthreads();
#pragma unroll
        for (int i = 0; i < 4; ++i)
#pragma unroll
            for (int j = 0; j < 4; ++j) acc[i][j] = (f32x4){0.f, 0.f, 0.f, 0.f};
        mma_ktile(sA0, sB0, arow_off, brow_off, g, sw, acc);
        mma_ktile(sA1, sB1, arow_off, brow_off, g, sw, acc);
        __syncthreads();
#pragma unroll
        for (int i = 0; i < 4; ++i)
#pragma unroll
            for (int j = 0; j < 4; ++j) {
                const int row = wr * 64 + 16 * i + lr;
                const int c4 = wc * 16 + 4 * j + g;
                *(f32x4*)(smem + row * 512 + ((c4 ^ (row & 31)) << 4)) = acc[i][j];
            }
        __syncthreads();
        unsigned top[16];
        const int row = tid & 127, half = tid >> 7;
        {
            auto load_keys = [&](unsigned (&dst)[16], int q4) {
#pragma unroll
                for (int s4 = 0; s4 < 4; ++s4) {
                    const int c4 = half * 16 + q4 * 4 + s4;
                    const f32x4 v = *(const f32x4*)(smem + row * 512 + ((c4 ^ (row & 31)) << 4));
#pragma unroll
                    for (int e = 0; e < 4; ++e) dst[s4 * 4 + e] = (ord_key(v[e]) & ~127u) | (unsigned)(127 - (c4 * 4 + e));
                }
            };
            load_keys(top, 0);
            bitonic_sort16_desc(top);
#pragma unroll 1
            for (int q4 = 1; q4 < 4; ++q4) {
                unsigned gq[16];
                load_keys(gq, q4);
                bitonic_sort16_desc(gq);
                bitonic_merge16_top(top, gq);
            }
        }
        __syncthreads();
        if (half) {
            uint4* lp = (uint4*)(smem + row * 64);
            lp[0] = make_uint4(top[0], top[1], top[2], top[3]); lp[1] = make_uint4(top[4], top[5], top[6], top[7]);
            lp[2] = make_uint4(top[8], top[9], top[10], top[11]); lp[3] = make_uint4(top[12], top[13], top[14], top[15]);
        }
        __syncthreads();
        if (!half) {
            const uint4* lp = (const uint4*)(smem + row * 64);
            unsigned other[16];
#pragma unroll
            for (int c = 0; c < 4; ++c) { const uint4 o = lp[c]; other[4 * c] = o.x; other[4 * c + 1] = o.y; other[4 * c + 2] = o.z; other[4 * c + 3] = o.w; }
            bitonic_merge16_top(top, other);
            uint4* tk = (uint4*)((unsigned*)(P.ws + WS_TK) + ((size_t)(m0 + row) * 16 + hp) * 16);
            tk[0] = make_uint4(top[0], top[1], top[2], top[3]); tk[1] = make_uint4(top[4], top[5], top[6], top[7]);
            tk[2] = make_uint4(top[8], top[9], top[10], top[11]); tk[3] = make_uint4(top[12], top[13], top[14], top[15]);
        }
        __syncthreads();
    }
}

__device__ __forceinline__ void fox_cum_wave(const Params& P, int bh, int lane) {
    const int b = bh >> 3, h = bh & 7;
    const float* gates = (const float*)(P.ws + WS_GATES);
    float* cum = (float*)(P.ws + WS_CUM) + (size_t)bh * L;
    constexpr int SEG = 33;
    const int t0 = lane * SEG;
    float loc = 0.f;
    for (int i = 0; i < SEG; ++i) { const int t = t0 + i; if (t < L) loc += gates[(size_t)(b * L + t) * 16 + 8 + h]; }
    float incl = loc;
#pragma unroll
    for (int o = 1; o < 64; o <<= 1) { const float n = __shfl_up(incl, o, 64); if (lane >= o) incl += n; }
    float run = incl - loc;
    for (int i = 0; i < SEG; ++i) { const int t = t0 + i; if (t < L) { run += gates[(size_t)(b * L + t) * 16 + 8 + h]; cum[t] = run * LOG2E; } }
}

#define TR_SLOW 0

__device__ __forceinline__ int vimg_off(int row, int ch) { return row * 128 + ((ch ^ (((row >> 1) & 3) << 1)) << 4); }
__device__ __forceinline__ uint2 tr_frag(const unsigned char* img, int row0, int c, int g, int lr) {
#if TR_SLOW
    unsigned short e[4];
#pragma unroll
    for (int k = 0; k < 4; ++k) { const int row = row0 + 4 * g + k, col = 16 * c + lr; e[k] = *(const unsigned short*)(img + vimg_off(row, col >> 3) + (col & 7) * 2); }
    uint2 r; r.x = (unsigned)e[0] | ((unsigned)e[1] << 16); r.y = (unsigned)e[2] | ((unsigned)e[3] << 16); return r;
#else
    const int q = lr >> 2, p = lr & 3, row = row0 + 4 * g + q;
    const unsigned addr = (unsigned)(size_t)(img + vimg_off(row, 2 * c + (p >> 1)) + 8 * (p & 1));
    uint2 r;
    asm volatile("ds_read_b64_tr_b16 %0, %1\n\ts_waitcnt lgkmcnt(0)" : "=&v"(r) : "v"(addr) : "memory");
    return r;
#endif
}

__device__ __forceinline__ unsigned tr_lane_addr(const unsigned char* img, int c, int g, int lr) {
    const int q = lr >> 2, p = lr & 3, row = 4 * g + q;
    return (unsigned)(size_t)(img + vimg_off(row, 2 * c + (p >> 1)) + 8 * (p & 1));
}
#define TR_GROUP(o0, o1, o2, o3, a) "ds_read_b64_tr_b16 %" #o0 ", %" #a "\n\tds_read_b64_tr_b16 %" #o1 ", %" #a " offset:2048\n\tds_read_b64_tr_b16 %" #o2 ", %" #a " offset:4096\n\tds_read_b64_tr_b16 %" #o3 ", %" #a " offset:6144\n\t"
__device__ __forceinline__ void tr_read_4c(const unsigned char* img, int g, int lr, uint2 (&r)[4][4]) {
    const unsigned a0 = tr_lane_addr(img, 0, g, lr), a1 = tr_lane_addr(img, 1, g, lr), a2 = tr_lane_addr(img, 2, g, lr), a3 = tr_lane_addr(img, 3, g, lr);
    asm volatile(TR_GROUP(0, 1, 2, 3, 16) TR_GROUP(4, 5, 6, 7, 17) TR_GROUP(8, 9, 10, 11, 18) TR_GROUP(12, 13, 14, 15, 19) "s_waitcnt lgkmcnt(0)"
        : "=&v"(r[0][0]), "=&v"(r[0][1]), "=&v"(r[0][2]), "=&v"(r[0][3]), "=&v"(r[1][0]), "=&v"(r[1][1]), "=&v"(r[1][2]), "=&v"(r[1][3]),
          "=&v"(r[2][0]), "=&v"(r[2][1]), "=&v"(r[2][2]), "=&v"(r[2][3]), "=&v"(r[3][0]), "=&v"(r[3][1]), "=&v"(r[3][2]), "=&v"(r[3][3])
        : "v"(a0), "v"(a1), "v"(a2), "v"(a3) : "memory");
}
__device__ __forceinline__ void tr_read_3c(const unsigned char* img, int g, int lr, uint2 (&r)[3][4]) {
    const unsigned a0 = tr_lane_addr(img, 0, g, lr), a1 = tr_lane_addr(img, 1, g, lr), a2 = tr_lane_addr(img, 2, g, lr);
    asm volatile(TR_GROUP(0, 1, 2, 3, 12) TR_GROUP(4, 5, 6, 7, 13) TR_GROUP(8, 9, 10, 11, 14) "s_waitcnt lgkmcnt(0)"
        : "=&v"(r[0][0]), "=&v"(r[0][1]), "=&v"(r[0][2]), "=&v"(r[0][3]), "=&v"(r[1][0]), "=&v"(r[1][1]), "=&v"(r[1][2]), "=&v"(r[1][3]),
          "=&v"(r[2][0]), "=&v"(r[2][1]), "=&v"(r[2][2]), "=&v"(r[2][3])
        : "v"(a0), "v"(a1), "v"(a2) : "memory");
}
__device__ __forceinline__ void tr_read_2(const unsigned char* img0, int c0, const unsigned char* img1, int c1, int g, int lr, uint2 (&r)[2][4]) {
    const unsigned a0 = tr_lane_addr(img0, c0, g, lr), a1 = tr_lane_addr(img1, c1, g, lr);
    asm volatile(TR_GROUP(0, 1, 2, 3, 8) TR_GROUP(4, 5, 6, 7, 9) "s_waitcnt lgkmcnt(0)"
        : "=&v"(r[0][0]), "=&v"(r[0][1]), "=&v"(r[0][2]), "=&v"(r[0][3]), "=&v"(r[1][0]), "=&v"(r[1][1]), "=&v"(r[1][2]), "=&v"(r[1][3])
        : "v"(a0), "v"(a1) : "memory");
}
__device__ __forceinline__ bf16x8 tr_pair(const uint2& lo, const uint2& hi) { uint4 u; u.x = lo.x; u.y = lo.y; u.z = hi.x; u.w = hi.y; return __builtin_bit_cast(bf16x8, u); }

__device__ __forceinline__ void attn_block(const Params& P, int bh, int qb, unsigned char* smem) {
    const int tid = opaque_tid(), lane = tid & 63, w = tid >> 6, g = lane >> 4, lr = lane & 15;
    const int b = bh >> 3, h = bh & 7;
    const bf16_t* z = (const bf16_t*)(P.ws + WS_Z);
    const float* cum = (const float*)(P.ws + WS_CUM) + (size_t)bh * L;
    int tq[2]; bool qvalid[2]; bf16x8 qf[2][2];
#pragma unroll
    for (int u = 0; u < 2; ++u) {
        tq[u] = qb * 128 + 32 * w + 16 * u + lr;
        qvalid[u] = tq[u] < L;
        const bf16_t* qp = z + (size_t)(b * L + (qvalid[u] ? tq[u] : 0)) * NZ + ZC_FQ + h * 64 + 8 * g;
        qf[u][0] = *(const bf16x8*)(qp); qf[u][1] = *(const bf16x8*)(qp + 32);
    }
    const int nkv = (2 * qb + 2 < 33) ? 2 * qb + 2 : 33;
    const int srow0 = tid >> 3, sch = tid & 7;
    uint4 rk[2], rv[2]; float rc = 0.f;
    auto load_tile = [&](int kv) {
#pragma unroll
        for (int j = 0; j < 2; ++j) {
            const int key = kv * 64 + srow0 + 32 * j;
            if (key < L) {
                const bf16_t* p = z + (size_t)(b * L + key) * NZ + h * 64 + sch * 8;
                rk[j] = *(const uint4*)(p + ZC_FK); rv[j] = *(const uint4*)(p + ZC_FV);
            } else { rk[j] = make_uint4(0, 0, 0, 0); rv[j] = make_uint4(0, 0, 0, 0); }
        }
        if (tid < 64) { const int key = kv * 64 + tid; rc = key < L ? cum[key] : 0.f; }
    };
    auto store_tile = [&](int buf) {
        unsigned char* sK = smem + buf * 16384; unsigned char* sV = sK + 8192;
#pragma unroll
        for (int j = 0; j < 2; ++j) {
            const int row = srow0 + 32 * j;
            *(uint4*)(sK + row * 128 + ((sch ^ (row & 7)) << 4)) = rk[j];
            *(uint4*)(sV + vimg_off(row, sch)) = rv[j];
        }
        if (tid < 64) ((float*)(smem + 32768 + buf * 256))[tid] = rc;
    };
    float m[2] = {-1e30f, -1e30f};
    f32x4 o[2][5];
#pragma unroll
    for (int u = 0; u < 2; ++u)
#pragma unroll
        for (int c = 0; c < 5; ++c) o[u][c] = (f32x4){0.f, 0.f, 0.f, 0.f};
    const unsigned onew = (lr == 0) ? 0x3F803F80u : 0u;
    const bf16x8 vones = __builtin_bit_cast(bf16x8, make_uint4(onew, onew, onew, onew));
    load_tile(nkv - 1); store_tile((nkv - 1) & 1);
    __syncthreads();
    for (int kv = nkv - 1; kv >= 0; --kv) {
        const int buf = kv & 1;
        if (kv > 0) load_tile(kv - 1);
        const unsigned char* sK = smem + buf * 16384; const unsigned char* sV = sK + 8192;
        const float* sck = (const float*)(smem + 32768 + buf * 256);
        f32x4 sa[2][4];
#pragma unroll
        for (int c = 0; c < 4; ++c) {
            sa[0][c] = (f32x4){0.f, 0.f, 0.f, 0.f}; sa[1][c] = (f32x4){0.f, 0.f, 0.f, 0.f};
#pragma unroll
            for (int s = 0; s < 2; ++s) {
                const bf16x8 kf = *(const bf16x8*)(sK + (16 * c + lr) * 128 + (((4 * s + g) ^ (lr & 7)) << 4));
                sa[0][c] = __builtin_amdgcn_mfma_f32_16x16x32_bf16(kf, qf[0][s], sa[0][c], 0, 0, 0);
                sa[1][c] = __builtin_amdgcn_mfma_f32_16x16x32_bf16(kf, qf[1][s], sa[1][c], 0, 0, 0);
            }
        }
        if (kv >= 2 * qb) {
#pragma unroll
            for (int u = 0; u < 2; ++u)
#pragma unroll
                for (int c = 0; c < 4; ++c)
#pragma unroll
                    for (int r = 0; r < 4; ++r)
                        if (64 * kv + 16 * c + 4 * g + r > tq[u]) sa[u][c][r] = -INFINITY;
        }
        f32x4 ck[4];
#pragma unroll
        for (int c = 0; c < 4; ++c) ck[c] = *(const f32x4*)(sck + 16 * c + 4 * g);
        bf16x8 pf[2][2];
#pragma unroll
        for (int u = 0; u < 2; ++u) {
            float mx = -INFINITY;
#pragma unroll
            for (int c = 0; c < 4; ++c) {
                sa[u][c] -= ck[c];
                mx = fmaxf(mx, fmaxf(fmaxf(sa[u][c][0], sa[u][c][1]), fmaxf(sa[u][c][2], sa[u][c][3])));
            }
            mx = x4_max(mx);
            if (__builtin_amdgcn_ballot_w64(mx > m[u]) != 0ull) {
                const float mn = fmaxf(m[u], mx);
                const float alpha = __builtin_amdgcn_exp2f(m[u] - mn);
                m[u] = mn;
#pragma unroll
                for (int c = 0; c < 5; ++c) o[u][c] *= alpha;
            }
            const float mn = m[u];
#pragma unroll
            for (int c = 0; c < 4; ++c)
#pragma unroll
                for (int r = 0; r < 4; ++r) sa[u][c][r] = __builtin_amdgcn_exp2f(sa[u][c][r] - mn);
#pragma unroll
            for (int s2 = 0; s2 < 2; ++s2) {
                uint4 uu;
                uu.x = cvt_pk_bf16(sa[u][2 * s2][0], sa[u][2 * s2][1]); uu.y = cvt_pk_bf16(sa[u][2 * s2][2], sa[u][2 * s2][3]);
                uu.z = cvt_pk_bf16(sa[u][2 * s2 + 1][0], sa[u][2 * s2 + 1][1]); uu.w = cvt_pk_bf16(sa[u][2 * s2 + 1][2], sa[u][2 * s2 + 1][3]);
                pf[u][s2] = __builtin_bit_cast(bf16x8, uu);
            }
        }
        {
            uint2 vr[4][4];
            tr_read_4c(sV, g, lr, vr);
#pragma unroll
            for (int c = 0; c < 4; ++c)
#pragma unroll
                for (int s2 = 0; s2 < 2; ++s2) {
                    const bf16x8 vf = tr_pair(vr[c][2 * s2], vr[c][2 * s2 + 1]);
                    o[0][c] = __builtin_amdgcn_mfma_f32_16x16x32_bf16(vf, pf[0][s2], o[0][c], 0, 0, 0);
                    o[1][c] = __builtin_amdgcn_mfma_f32_16x16x32_bf16(vf, pf[1][s2], o[1][c], 0, 0, 0);
                }
#pragma unroll
            for (int s2 = 0; s2 < 2; ++s2) {
                o[0][4] = __builtin_amdgcn_mfma_f32_16x16x32_bf16(vones, pf[0][s2], o[0][4], 0, 0, 0);
                o[1][4] = __builtin_amdgcn_mfma_f32_16x16x32_bf16(vones, pf[1][s2], o[1][4], 0, 0, 0);
            }
        }
        if (kv > 0) store_tile(buf ^ 1);
        __syncthreads();
    }
#pragma unroll
    for (int u = 0; u < 2; ++u) {
        const float ls = __shfl(o[u][4][0], lr, 64);
        const float inv = 1.0f / ls;
        if (qvalid[u]) {
            bf16_t* y = (bf16_t*)(P.ws + WS_Z) + (size_t)(b * L + tq[u]) * NZ + 512 + h * 64 + 4 * g;
#pragma unroll
            for (int c = 0; c < 4; ++c) {
                uint2 uu; uu.x = pk2(o[u][c][0] * inv, o[u][c][1] * inv); uu.y = pk2(o[u][c][2] * inv, o[u][c][3] * inv);
                *(uint2*)(y + 16 * c) = uu;
            }
        }
    }
}

__device__ __forceinline__ void conv_item(const Params& P, int ci) {
    const int tid = opaque_tid(), cc = tid & 127, rg = tid >> 7;
    const bf16_t* z = (const bf16_t*)(P.ws + WS_Z);
    bf16_t* qk = (bf16_t*)(P.ws + WS_RA);
    const int col0 = cc * 8;
    float w[4][8];
#pragma unroll
    for (int j = 0; j < 4; ++j) {
        const float4 a = *(const float4*)(P.conv_qk + j * 1024 + col0), b = *(const float4*)(P.conv_qk + j * 1024 + col0 + 4);
        w[j][0] = a.x; w[j][1] = a.y; w[j][2] = a.z; w[j][3] = a.w; w[j][4] = b.x; w[j][5] = b.y; w[j][6] = b.z; w[j][7] = b.w;
    }
    const float oscale = (col0 >= 512) ? 0.08838834764831845f : 1.0f;
    const int r0 = ci * 64 + rg * 32;
    int t = r0 % L;
    float xw[3][8];
#pragma unroll
    for (int j = 0; j < 3; ++j) {
        const int back = 3 - j;
        if (t - back >= 0) {
            const uint4 v = *(const uint4*)(z + (size_t)(r0 - back) * NZ + col0);
            xw[j][0] = bflo(v.x); xw[j][1] = bfhi(v.x); xw[j][2] = bflo(v.y); xw[j][3] = bfhi(v.y); xw[j][4] = bflo(v.z); xw[j][5] = bfhi(v.z); xw[j][6] = bflo(v.w); xw[j][7] = bfhi(v.w);
        } else {
#pragma unroll
            for (int e = 0; e < 8; ++e) xw[j][e] = 0.f;
        }
    }
#pragma unroll 2
    for (int i = 0; i < 32; ++i) {
        const int r = r0 + i;
        if (t == 0) {
#pragma unroll
            for (int j = 0; j < 3; ++j)
#pragma unroll
                for (int e = 0; e < 8; ++e) xw[j][e] = 0.f;
        }
        const uint4 v = *(const uint4*)(z + (size_t)r * NZ + col0);
        float xt[8];
        xt[0] = bflo(v.x); xt[1] = bfhi(v.x); xt[2] = bflo(v.y); xt[3] = bfhi(v.y); xt[4] = bflo(v.z); xt[5] = bfhi(v.z); xt[6] = bflo(v.w); xt[7] = bfhi(v.w);
        float o[8];
#pragma unroll
        for (int e = 0; e < 8; ++e) {
            const float cv = w[0][e] * xw[0][e] + w[1][e] * xw[1][e] + w[2][e] * xw[2][e] + w[3][e] * xt[e];
            o[e] = oscale * cv / (1.f + __expf(-cv));
            xw[0][e] = xw[1][e]; xw[1][e] = xw[2][e]; xw[2][e] = xt[e];
        }
        uint4 ov; ov.x = pk2(o[0], o[1]); ov.y = pk2(o[2], o[3]); ov.z = pk2(o[4], o[5]); ov.w = pk2(o[6], o[7]);
        *(uint4*)(qk + (size_t)r * 1024 + col0) = ov;
        t = (t + 1 == L) ? 0 : t + 1;
    }
}

constexpr int ST_IMG = 36864;
__device__ __forceinline__ int st_piece_off(int jt, int c, int g, int lr) { return (jt >> 2) * 18432 + vimg_off(16 * c + lr, 2 * (jt & 3) + (g >> 1)) + 8 * (g & 1); }

__device__ __forceinline__ void mlstm_stage_kv(const Params& P, int b, int h, int k, unsigned char* sKimg, unsigned char* sVimg, int tid) {
    const bf16_t* z = (const bf16_t*)(P.ws + WS_Z);
    const bf16_t* qk = (const bf16_t*)(P.ws + WS_RA);
    uint4 pk_[4], pv_[4];
#pragma unroll
    for (int j = 0; j < 4; ++j) {
        const int id = tid + 256 * j, row = id >> 4, ch16 = id & 15, pos = 64 * k + row;
        const bool ok = pos < L;
        pk_[j] = ok ? *(const uint4*)(qk + (size_t)(b * L + pos) * 1024 + 512 + h * 128 + ch16 * 8) : make_uint4(0, 0, 0, 0);
        pv_[j] = ok ? *(const uint4*)(z + (size_t)(b * L + pos) * NZ + ZC_MV + h * 128 + ch16 * 8) : make_uint4(0, 0, 0, 0);
    }
#pragma unroll
    for (int j = 0; j < 4; ++j) {
        const int id = tid + 256 * j, row = id >> 4, ch16 = id & 15;
        *(uint4*)(sKimg + (ch16 >> 3) * 8192 + vimg_off(row, ch16 & 7)) = pk_[j];
        *(uint4*)(sVimg + (ch16 >> 3) * 8192 + vimg_off(row, ch16 & 7)) = pv_[j];
    }
    if (tid < 128) {
        const int row = tid >> 1, ch = tid & 1;
        *(uint4*)(sVimg + 16384 + vimg_off(row, ch)) = ch ? make_uint4(0, 0, 0, 0) : make_uint4(0x3F80u, 0, 0, 0);
    }
}

__device__ __forceinline__ void mlstm_stage_A(const Params& P, int b, int h, int k, unsigned char* sKimg, unsigned char* sVimg, int tid) {
    const bf16_t* z = (const bf16_t*)(P.ws + WS_Z);
    bf16_t* qk = (bf16_t*)(P.ws + WS_RA);
    uint4 pv_[4];
#pragma unroll
    for (int j = 0; j < 4; ++j) {
        const int id = tid + 256 * j, row = id >> 4, ch16 = id & 15, pos = 64 * k + row;
        pv_[j] = (pos < L) ? *(const uint4*)(z + (size_t)(b * L + pos) * NZ + ZC_MV + h * 128 + ch16 * 8) : make_uint4(0, 0, 0, 0);
    }
    const int cch = tid & 31, rg = tid >> 5, isk = cch >> 4;
    const int zcol = (isk ? ZC_MK : ZC_MQ) + h * 128 + (cch & 15) * 8;
    float w[4][8];
#pragma unroll
    for (int j = 0; j < 4; ++j) {
        const float4 a = *(const float4*)(P.conv_qk + j * 1024 + zcol), c = *(const float4*)(P.conv_qk + j * 1024 + zcol + 4);
        w[j][0] = a.x; w[j][1] = a.y; w[j][2] = a.z; w[j][3] = a.w; w[j][4] = c.x; w[j][5] = c.y; w[j][6] = c.z; w[j][7] = c.w;
    }
    const float oscale = isk ? 0.08838834764831845f : 1.0f;
    const int p0 = 64 * k + 8 * rg;
    uint4 raw[11];
#pragma unroll
    for (int i = 0; i < 11; ++i) {
        const int pos = p0 - 3 + i;
        raw[i] = (pos >= 0 && pos < L) ? *(const uint4*)(z + (size_t)(b * L + pos) * NZ + zcol) : make_uint4(0, 0, 0, 0);
    }
#pragma unroll
    for (int j = 0; j < 4; ++j) {
        const int id = tid + 256 * j, row = id >> 4, ch16 = id & 15;
        *(uint4*)(sVimg + (ch16 >> 3) * 8192 + vimg_off(row, ch16 & 7)) = pv_[j];
    }
    if (tid < 128) {
        const int row = tid >> 1, ch = tid & 1;
        *(uint4*)(sVimg + 16384 + vimg_off(row, ch)) = ch ? make_uint4(0, 0, 0, 0) : make_uint4(0x3F80u, 0, 0, 0);
    }
#pragma unroll
    for (int i = 0; i < 8; ++i) {
        const int pos = p0 + i, row = 8 * rg + i;
        float o[8];
#pragma unroll
        for (int e = 0; e < 8; ++e) {
            const unsigned w0 = (&raw[i].x)[e >> 1], w1 = (&raw[i + 1].x)[e >> 1], w2 = (&raw[i + 2].x)[e >> 1], w3 = (&raw[i + 3].x)[e >> 1];
            const float x0 = (e & 1) ? bfhi(w0) : bflo(w0), x1 = (e & 1) ? bfhi(w1) : bflo(w1), x2 = (e & 1) ? bfhi(w2) : bflo(w2), x3 = (e & 1) ? bfhi(w3) : bflo(w3);
            const float cv = w[0][e] * x0 + w[1][e] * x1 + w[2][e] * x2 + w[3][e] * x3;
            o[e] = oscale * cv / (1.f + __expf(-cv));
        }
        uint4 ov; ov.x = pk2(o[0], o[1]); ov.y = pk2(o[2], o[3]); ov.z = pk2(o[4], o[5]); ov.w = pk2(o[6], o[7]);
        const bool ok = pos < L;
        if (!ok) ov = make_uint4(0, 0, 0, 0);
        if (ok) *(uint4*)(qk + (size_t)(b * L + pos) * 1024 + (isk ? 512 : 0) + h * 128 + (cch & 15) * 8) = ov;
        if (isk) { const int ch16 = cch & 15; *(uint4*)(sKimg + (ch16 >> 3) * 8192 + vimg_off(row, ch16 & 7)) = ov; }
    }
}

__device__ __forceinline__ void mlstm_A(const Params& P, int item, unsigned char* smem) {
    const int tid = opaque_tid(), lane = tid & 63, w = tid >> 6, g = lane >> 4, lr = lane & 15;
    const int wu = __builtin_amdgcn_readfirstlane(w);
    const int k = item >> 5, bh = item & 31, b = bh >> 2, h = bh & 3;
    const float* gates = (const float*)(P.ws + WS_GATES);
    const unsigned char* sK = smem; const unsigned char* sV = smem + 16384;
    float* ga = (float*)(smem + 40960);
    mlstm_stage_A(P, b, h, k, smem, smem + 16384, tid);
    if (wu == 0) {
        const int pos = 64 * k + lane;
        float lf = 0.f, li = -INFINITY;
        if (pos < L) { lf = gates[(size_t)(b * L + pos) * 16 + 4 + h]; li = gates[(size_t)(b * L + pos) * 16 + h]; }
        float bc = lf;
#pragma unroll
        for (int o = 1; o < 64; o <<= 1) { const float n = __shfl_up(bc, o, 64); if (lane >= o) bc += n; }
        const float a = li - bc;
        const float A = wave_max(a);
        ga[lane] = __expf(a - A);
        if (lane == 63) { float* msc = (float*)(P.ws + WS_MSC) + ((size_t)bh * 33 + k) * 4; msc[0] = A; msc[1] = bc; }
    }
    __syncthreads();
    f32x4 Ct[2][9];
#pragma unroll
    for (int a = 0; a < 2; ++a)
#pragma unroll
        for (int c = 0; c < 9; ++c) Ct[a][c] = (f32x4){0.f, 0.f, 0.f, 0.f};
    bf16x8 kt[2][2];
#pragma unroll
    for (int a = 0; a < 2; ++a)
#pragma unroll
        for (int s2 = 0; s2 < 2; ++s2) {
            const int jt = 2 * w + a;
            kt[a][s2] = tr_pair(tr_frag(sK + (jt >> 2) * 8192, 32 * s2, jt & 3, g, lr), tr_frag(sK + (jt >> 2) * 8192, 32 * s2 + 16, jt & 3, g, lr));
        }
    f32x4 wg4[4];
#pragma unroll
    for (int j = 0; j < 4; ++j) wg4[j] = *(const f32x4*)(ga + 16 * j + 4 * g);
#define MA_TILE(c, lo0, hi0, lo1, hi1) { \
        { const f32x4 w0 = wg4[0], w1 = wg4[1]; uint4 o; \
          o.x = cvt_pk_bf16(bflo(lo0.x) * w0[0], bfhi(lo0.x) * w0[1]); o.y = cvt_pk_bf16(bflo(lo0.y) * w0[2], bfhi(lo0.y) * w0[3]); \
          o.z = cvt_pk_bf16(bflo(hi0.x) * w1[0], bfhi(hi0.x) * w1[1]); o.w = cvt_pk_bf16(bflo(hi0.y) * w1[2], bfhi(hi0.y) * w1[3]); \
          const bf16x8 vw = __builtin_bit_cast(bf16x8, o); \
          Ct[0][c] = __builtin_amdgcn_mfma_f32_16x16x32_bf16(kt[0][0], vw, Ct[0][c], 0, 0, 0); Ct[1][c] = __builtin_amdgcn_mfma_f32_16x16x32_bf16(kt[1][0], vw, Ct[1][c], 0, 0, 0); } \
        { const f32x4 w0 = wg4[2], w1 = wg4[3]; uint4 o; \
          o.x = cvt_pk_bf16(bflo(lo1.x) * w0[0], bfhi(lo1.x) * w0[1]); o.y = cvt_pk_bf16(bflo(lo1.y) * w0[2], bfhi(lo1.y) * w0[3]); \
          o.z = cvt_pk_bf16(bflo(hi1.x) * w1[0], bfhi(hi1.x) * w1[1]); o.w = cvt_pk_bf16(bflo(hi1.y) * w1[2], bfhi(hi1.y) * w1[3]); \
          const bf16x8 vw = __builtin_bit_cast(bf16x8, o); \
          Ct[0][c] = __builtin_amdgcn_mfma_f32_16x16x32_bf16(kt[0][1], vw, Ct[0][c], 0, 0, 0); Ct[1][c] = __builtin_amdgcn_mfma_f32_16x16x32_bf16(kt[1][1], vw, Ct[1][c], 0, 0, 0); } }
    {
        uint2 vr[4][4];
        tr_read_4c(sV, g, lr, vr);
        MA_TILE(0, vr[0][0], vr[0][1], vr[0][2], vr[0][3]) MA_TILE(1, vr[1][0], vr[1][1], vr[1][2], vr[1][3])
        MA_TILE(2, vr[2][0], vr[2][1], vr[2][2], vr[2][3]) MA_TILE(3, vr[3][0], vr[3][1], vr[3][2], vr[3][3])
        tr_read_4c(sV + 8192, g, lr, vr);
        MA_TILE(4, vr[0][0], vr[0][1], vr[0][2], vr[0][3]) MA_TILE(5, vr[1][0], vr[1][1], vr[1][2], vr[1][3])
        MA_TILE(6, vr[2][0], vr[2][1], vr[2][2], vr[2][3]) MA_TILE(7, vr[3][0], vr[3][1], vr[3][2], vr[3][3])
        const uint2 o0 = tr_frag(sV + 16384, 0, 0, g, lr), o1 = tr_frag(sV + 16384, 16, 0, g, lr), o2 = tr_frag(sV + 16384, 32, 0, g, lr), o3 = tr_frag(sV + 16384, 48, 0, g, lr);
        MA_TILE(8, o0, o1, o2, o3)
    }
#undef MA_TILE
    unsigned char* slot = P.ws + WS_MST + ((size_t)bh * 33 + k) * ST_IMG;
#pragma unroll
    for (int a = 0; a < 2; ++a)
#pragma unroll
        for (int c = 0; c < 9; ++c) {
            uint2 u; u.x = cvt_pk_bf16(Ct[a][c][0], Ct[a][c][1]); u.y = cvt_pk_bf16(Ct[a][c][2], Ct[a][c][3]);
            *(uint2*)(slot + st_piece_off(2 * w + a, c, g, lr)) = u;
        }
}

__device__ __forceinline__ void mlstm_B(const Params& P, int item) {
    const int tid = opaque_tid();
    const int bh = item / 3, part = item - bh * 3;
    const unsigned char* base = P.ws + WS_MST + (size_t)bh * 33 * ST_IMG + part * 12288 + tid * 48;
    unsigned char* obase = P.ws + WS_CBI + (size_t)bh * 33 * ST_IMG + part * 12288 + tid * 48;
    float* msc = (float*)(P.ws + WS_MSC) + (size_t)bh * 33 * 4;
    float C[6][4];
#pragma unroll
    for (int i = 0; i < 6; ++i)
#pragma unroll
        for (int r = 0; r < 4; ++r) C[i][r] = 0.f;
    float m = 0.f;
    uint2 d0[6], d1[6];
    float2 ab0, ab1;
#pragma unroll
    for (int i = 0; i < 6; ++i) { d0[i] = *(const uint2*)(base + i * 8); d1[i] = *(const uint2*)(base + ST_IMG + i * 8); }
    ab0 = *(const float2*)(msc); ab1 = *(const float2*)(msc + 4);
    for (int k = 0; k < 33; ++k) {
        uint2 d2[6]; float2 ab2 = make_float2(0.f, 0.f);
        if (k + 2 < 33) {
#pragma unroll
            for (int i = 0; i < 6; ++i) d2[i] = *(const uint2*)(base + (size_t)(k + 2) * ST_IMG + i * 8);
            ab2 = *(const float2*)(msc + (k + 2) * 4);
        } else {
#pragma unroll
            for (int i = 0; i < 6; ++i) d2[i] = make_uint2(0, 0);
        }
#pragma unroll
        for (int i = 0; i < 6; ++i) {
            uint2 u; u.x = cvt_pk_bf16(C[i][0], C[i][1]); u.y = cvt_pk_bf16(C[i][2], C[i][3]);
            *(uint2*)(obase + (size_t)k * ST_IMG + i * 8) = u;
        }
        if (tid == 0 && part == 0) msc[k * 4 + 2] = m;
        const float M = fmaxf(m, ab0.x);
        const float decay = __expf(m - M), sc = __expf(ab0.x - M);
#pragma unroll
        for (int i = 0; i < 6; ++i) {
            C[i][0] = decay * C[i][0] + sc * bflo(d0[i].x); C[i][1] = decay * C[i][1] + sc * bfhi(d0[i].x);
            C[i][2] = decay * C[i][2] + sc * bflo(d0[i].y); C[i][3] = decay * C[i][3] + sc * bfhi(d0[i].y);
        }
        m = ab0.y + M;
#pragma unroll
        for (int i = 0; i < 6; ++i) { d0[i] = d1[i]; d1[i] = d2[i]; }
        ab0 = ab1; ab1 = ab2;
    }
}

__device__ __forceinline__ void mlstm_C(const Params& P, int item, unsigned char* smem) {
    const int tid = opaque_tid(), lane = tid & 63, w = tid >> 6, g = lane >> 4, lr = lane & 15;
    const int wu = __builtin_amdgcn_readfirstlane(w);
    const int k = item >> 5, bh = item & 31, b = bh >> 2, h = bh & 3;
    const bf16_t* z = (const bf16_t*)(P.ws + WS_Z);
    const bf16_t* qk = (const bf16_t*)(P.ws + WS_RA);
    const float* gates = (const float*)(P.ws + WS_GATES);
    bf16_t* y = (bf16_t*)(P.ws + WS_Z);
    const unsigned char* sK = smem; const unsigned char* sV = smem + 36864; unsigned char* sCb = smem;
    float* ga = (float*)(smem + 61440);
    const int pos = 64 * k + 16 * w + lr;
    const bool tvalid = pos < L;
    const size_t rrow = (size_t)(b * L + (tvalid ? pos : 0));
    const unsigned char* cslot = P.ws + WS_CBI + ((size_t)bh * 33 + k) * ST_IMG + tid * 16;
    const uint4 cb0 = *(const uint4*)(cslot), cb1 = *(const uint4*)(cslot + 4096), cb2 = *(const uint4*)(cslot + 8192), cb3 = *(const uint4*)(cslot + 12288), cb4 = *(const uint4*)(cslot + 16384),
                cb5 = *(const uint4*)(cslot + 20480), cb6 = *(const uint4*)(cslot + 24576), cb7 = *(const uint4*)(cslot + 28672), cb8 = *(const uint4*)(cslot + 32768);
    bf16x8 qf[4];
    {
        const bf16_t* qp = qk + rrow * 1024 + h * 128 + 8 * g;
#pragma unroll
        for (int ks = 0; ks < 4; ++ks) { qf[ks] = *(const bf16x8*)(qp + 32 * ks); if (!tvalid) qf[ks] = (bf16x8){0, 0, 0, 0, 0, 0, 0, 0}; }
    }
    mlstm_stage_kv(P, b, h, k, smem, smem + 36864, tid);
    if (wu == 0) {
        const float m_prev = ((const float*)(P.ws + WS_MSC))[((size_t)bh * 33 + k) * 4 + 2];
        const int p2 = 64 * k + lane;
        float lf = 0.f, li = -INFINITY;
        if (p2 < L) { lf = gates[(size_t)(b * L + p2) * 16 + 4 + h]; li = gates[(size_t)(b * L + p2) * 16 + h]; }
        float bc = lf;
#pragma unroll
        for (int o = 1; o < 64; o <<= 1) { const float n = __shfl_up(bc, o, 64); if (lane >= o) bc += n; }
        const float a = li - bc;
        float am = a;
#pragma unroll
        for (int o = 1; o < 64; o <<= 1) { const float n = __shfl_up(am, o, 64); if (lane >= o) am = fmaxf(am, n); }
        const float M = fmaxf(m_prev, am);
        ga[lane] = a; ga[64 + lane] = __expf(m_prev - M); ga[128 + lane] = __expf(-(bc + M)); ga[192 + lane] = M;
    }
    __syncthreads();
    const float Mt = ga[192 + 16 * w + lr], Wi = ga[64 + 16 * w + lr], Et = ga[128 + 16 * w + lr];
    bf16x8 pf[2];
    {
        f32x4 sa[4];
#pragma unroll
        for (int c = 0; c < 4; ++c) {
            sa[c] = (f32x4){0.f, 0.f, 0.f, 0.f};
            if (c <= wu) {
#pragma unroll
                for (int ks = 0; ks < 4; ++ks) {
                    const bf16x8 kf = *(const bf16x8*)(sK + (ks >> 1) * 8192 + vimg_off(16 * c + lr, 4 * (ks & 1) + g));
                    sa[c] = __builtin_amdgcn_mfma_f32_16x16x32_bf16(kf, qf[ks], sa[c], 0, 0, 0);
                }
                const f32x4 av = *(const f32x4*)(ga + 16 * c + 4 * g);
#pragma unroll
                for (int r = 0; r < 4; ++r) {
                    const float d = __expf(av[r] - Mt);
                    sa[c][r] = (16 * c + 4 * g + r <= 16 * w + lr) ? sa[c][r] * d : 0.f;
                }
            }
        }
#pragma unroll
        for (int s2 = 0; s2 < 2; ++s2) {
            uint4 u;
            u.x = cvt_pk_bf16(sa[2 * s2][0], sa[2 * s2][1]); u.y = cvt_pk_bf16(sa[2 * s2][2], sa[2 * s2][3]);
            u.z = cvt_pk_bf16(sa[2 * s2 + 1][0], sa[2 * s2 + 1][1]); u.w = cvt_pk_bf16(sa[2 * s2 + 1][2], sa[2 * s2 + 1][3]);
            pf[s2] = __builtin_bit_cast(bf16x8, u);
        }
    }
    __syncthreads();
    {
        unsigned char* d = sCb + tid * 16;
        *(uint4*)(d) = cb0; *(uint4*)(d + 4096) = cb1; *(uint4*)(d + 8192) = cb2; *(uint4*)(d + 12288) = cb3; *(uint4*)(d + 16384) = cb4;
        *(uint4*)(d + 20480) = cb5; *(uint4*)(d + 24576) = cb6; *(uint4*)(d + 28672) = cb7; *(uint4*)(d + 32768) = cb8;
    }
    __syncthreads();
    f32x4 na[9];
#define MC_TILE(c, lo0, hi0, lo1, hi1) { \
        na[c] = (f32x4){0.f, 0.f, 0.f, 0.f}; \
        _Pragma("unroll") for (int ks = 0; ks < 4; ++ks) { \
            const bf16x8 cf = *(const bf16x8*)(sCb + (ks >> 1) * 18432 + vimg_off(16 * (c) + lr, 4 * (ks & 1) + g)); \
            na[c] = __builtin_amdgcn_mfma_f32_16x16x32_bf16(cf, qf[ks], na[c], 0, 0, 0); } \
        na[c] *= Wi; \
        na[c] = __builtin_amdgcn_mfma_f32_16x16x32_bf16(tr_pair(lo0, hi0), pf[0], na[c], 0, 0, 0); \
        na[c] = __builtin_amdgcn_mfma_f32_16x16x32_bf16(tr_pair(lo1, hi1), pf[1], na[c], 0, 0, 0); }
    {
        uint2 vr[4][4];
        tr_read_4c(sV, g, lr, vr);
        MC_TILE(0, vr[0][0], vr[0][1], vr[0][2], vr[0][3]) MC_TILE(1, vr[1][0], vr[1][1], vr[1][2], vr[1][3])
        MC_TILE(2, vr[2][0], vr[2][1], vr[2][2], vr[2][3]) MC_TILE(3, vr[3][0], vr[3][1], vr[3][2], vr[3][3])
        tr_read_4c(sV + 8192, g, lr, vr);
        MC_TILE(4, vr[0][0], vr[0][1], vr[0][2], vr[0][3]) MC_TILE(5, vr[1][0], vr[1][1], vr[1][2], vr[1][3])
        MC_TILE(6, vr[2][0], vr[2][1], vr[2][2], vr[2][3]) MC_TILE(7, vr[3][0], vr[3][1], vr[3][2], vr[3][3])
        const uint2 o0 = tr_frag(sV + 16384, 0, 0, g, lr), o1 = tr_frag(sV + 16384, 16, 0, g, lr), o2 = tr_frag(sV + 16384, 32, 0, g, lr), o3 = tr_frag(sV + 16384, 48, 0, g, lr);
        MC_TILE(8, o0, o1, o2, o3)
    }
#undef MC_TILE
    const float den = __shfl(na[8][0], lr, 64);
    const float rden = 1.0f / fmaxf(fabsf(den), Et);
    float hs = 0.f;
#pragma unroll
    for (int c = 0; c < 8; ++c) { na[c] *= rden; hs += na[c][0] * na[c][0] + na[c][1] * na[c][1] + na[c][2] * na[c][2] + na[c][3] * na[c][3]; }
    hs = x4_sum(hs);
    const float rstd = rsqrtf(hs * (1.0f / 128.0f) + EPS);
    const float* gainp = P.m_out_norm + h * 128 + 4 * g;
#pragma unroll
    for (int c = 0; c < 8; ++c) {
        const uint2 og = *(const uint2*)(z + rrow * NZ + ZC_MO + h * 128 + 16 * c + 4 * g);
        const float o0 = bflo(og.x), o1 = bfhi(og.x), o2 = bflo(og.y), o3 = bfhi(og.y);
        const float4 gn = *(const float4*)(gainp + 16 * c);
        uint2 u;
        u.x = pk2(na[c][0] * rstd * gn.x / (1.f + __expf(-o0)), na[c][1] * rstd * gn.y / (1.f + __expf(-o1)));
        u.y = pk2(na[c][2] * rstd * gn.z / (1.f + __expf(-o2)), na[c][3] * rstd * gn.w / (1.f + __expf(-o3)));
        if (tvalid) *(uint2*)(y + rrow * NZ + h * 128 + 16 * c + 4 * g) = u;
    }
}

__device__ __forceinline__ void peer_token(const Params& P, int t, int lane, int* sidx, float* sval, int* sid, float* sgate, const unsigned char* slut, const unsigned* szero) {
    const unsigned* tk = (const unsigned*)(P.ws + WS_TK) + (size_t)t * 256;
#pragma unroll
    for (int i = 0; i < 4; ++i) {
        const unsigned k = tk[lane * 4 + i];
        sidx[lane * 4 + i] = 127 - (int)(k & 127u);
        sval[lane * 4 + i] = unord_key(k & ~127u);
    }
    __builtin_amdgcn_s_waitcnt(0xc07f);
    __builtin_amdgcn_wave_barrier();
    {
        const int hd = lane >> 3, sub = lane & 7;
        unsigned x[8];
#pragma unroll
        for (int r = 0; r < 8; ++r) {
            const int c = sub * 8 + r;
            const unsigned ij = slut[c < 50 ? c : 0];
            const int i = ij >> 4, j = ij & 15;
            const unsigned kx = (ord_key(sval[(2 * hd) * 16 + i] + sval[(2 * hd + 1) * 16 + j]) & ~255u) | (unsigned)(255 - (i * 16 + j));
            x[r] = c < 50 ? kx : 0u;
        }
#pragma unroll
        for (int k = 2; k <= 64; k <<= 1) {
#pragma unroll
            for (int j = k >> 1; j >= 1; j >>= 1) {
                if (j >= 8) {
                    const int ld = j >> 3;
                    const bool lower = (sub & ld) == 0;
                    const bool desc = k >= 64 ? true : ((sub * 8) & k) == 0;
                    const bool takemax = (lower == desc);
#pragma unroll
                    for (int r = 0; r < 8; ++r) {
                        const unsigned o = (unsigned)__shfl_xor((int)x[r], ld, 64);
                        const unsigned hi = max(x[r], o), lo = min(x[r], o);
                        x[r] = takemax ? hi : lo;
                    }
                } else {
#pragma unroll
                    for (int r = 0; r < 8; ++r) {
                        if ((r & j) == 0) {
                            const int p = r | j;
                            const unsigned hi = max(x[r], x[p]), lo = min(x[r], x[p]);
                            if (k <= 4) { const bool desc = (r & k) == 0; x[r] = desc ? hi : lo; x[p] = desc ? lo : hi; }
                            else if (k >= 64) { x[r] = hi; x[p] = lo; }
                            else { const bool desc = ((sub * 8) & k) == 0; x[r] = desc ? hi : lo; x[p] = desc ? lo : hi; }
                        }
                    }
                }
            }
        }
        const float smax = unord_key((unsigned)__shfl((int)x[0], hd * 8, 64) & ~255u);
        float e[8]; float den = 0.f;
#pragma unroll
        for (int r = 0; r < 8; ++r) { e[r] = __expf(unord_key(x[r] & ~255u) - smax); den += e[r]; }
        den += __shfl_xor(den, 1, 64);
        const float inv = 1.f / den;
        if (sub < 2) {
#pragma unroll
            for (int r = 0; r < 8; ++r) {
                const int pos = 255 - (int)(x[r] & 255u), i = pos >> 4, j = pos & 15;
                sid[hd * 16 + sub * 8 + r] = sidx[(2 * hd) * 16 + i] * 128 + sidx[(2 * hd + 1) * 16 + j];
                sgate[hd * 16 + sub * 8 + r] = e[r] * inv;
            }
        }
    }
    __builtin_amdgcn_s_waitcnt(0xc07f);
    __builtin_amdgcn_wave_barrier();
    const bf16_t* xn = (const bf16_t*)(P.ws + WS_XN) + (size_t)t * DM;
    const float rstd = ((const float*)(P.ws + WS_RSTD))[t];
    const unsigned char* V = P.ws + WS_V + lane * 8;
    const float* usc = (const float*)(P.ws + WS_USC);
    const float* vsc = (const float*)(P.ws + WS_VSC);
    const int g = lane >> 4, lr = lane & 15;
    unsigned char* shi = (unsigned char*)sval;
    unsigned char* slo = (unsigned char*)sidx;
    {
        const uint4 xa = *(const uint4*)(xn + lane * 16), xb = *(const uint4*)(xn + lane * 16 + 8);
        const unsigned xw[8] = {xa.x, xa.y, xa.z, xa.w, xb.x, xb.y, xb.z, xb.w};
        unsigned hi[4], lo[4];
#pragma unroll
        for (int i = 0; i < 4; ++i) {
            const float x0 = bflo(xw[2 * i]), x1 = bfhi(xw[2 * i]), x2 = bflo(xw[2 * i + 1]), x3 = bfhi(xw[2 * i + 1]);
            int wd = 0;
            wd = __builtin_amdgcn_cvt_pk_fp8_f32(x0, x1, wd, false);
            wd = __builtin_amdgcn_cvt_pk_fp8_f32(x2, x3, wd, true);
            const f32x2 h01 = __builtin_amdgcn_cvt_pk_f32_fp8(wd, false), h23 = __builtin_amdgcn_cvt_pk_f32_fp8(wd, true);
            int wl = 0;
            wl = __builtin_amdgcn_cvt_pk_fp8_f32(x0 - h01.x, x1 - h01.y, wl, false);
            wl = __builtin_amdgcn_cvt_pk_fp8_f32(x2 - h23.x, x3 - h23.y, wl, true);
            hi[i] = (unsigned)wd; lo[i] = (unsigned)wl;
        }
        *(uint4*)(shi + lane * 16) = make_uint4(hi[0], hi[1], hi[2], hi[3]);
        *(uint4*)(slo + lane * 16) = make_uint4(lo[0], lo[1], lo[2], lo[3]);
    }
    __builtin_amdgcn_s_waitcnt(0xc07f);
    __builtin_amdgcn_wave_barrier();
    {
        typedef int v8i __attribute__((ext_vector_type(8)));
        const unsigned char* Ub = P.ws + WS_U + 16 * g;
        const unsigned char* bsrc = (lr == 0) ? (shi + 16 * g) : (lr == 1) ? (slo + 16 * g) : (const unsigned char*)szero;
        const int bstep = (lr < 2) ? 128 : 0, bhalf = (lr < 2) ? 64 : 16;
        v8i Bv[8];
#pragma unroll
        for (int st = 0; st < 8; ++st) {
            const uint4 b0 = *(const uint4*)(bsrc + bstep * st), b1 = *(const uint4*)(bsrc + bstep * st + bhalf);
            Bv[st] = (v8i){(int)b0.x, (int)b0.y, (int)b0.z, (int)b0.w, (int)b1.x, (int)b1.y, (int)b1.z, (int)b1.w};
        }
        unsigned off[8];
#pragma unroll
        for (int T = 0; T < 8; ++T) off[T] = (unsigned)sid[16 * T + lr] * 512u;
        __builtin_amdgcn_s_waitcnt(0xc07f);
        __builtin_amdgcn_wave_barrier();
        float* sact = (float*)sidx + ((lr == 1) ? 128 : 0);
        uint4 abuf[2][8];
#pragma unroll
        for (int st = 0; st < 8; ++st) abuf[0][st] = *(const uint4*)(Ub + off[0] + 64 * st);
#pragma unroll
        for (int T = 0; T < 8; ++T) {
            if (T + 1 < 8) {
#pragma unroll
                for (int st = 0; st < 8; ++st) abuf[(T + 1) & 1][st] = *(const uint4*)(Ub + off[T + 1] + 64 * st);
            }
            f32x4 au = (f32x4){0.f, 0.f, 0.f, 0.f};
#pragma unroll
            for (int st = 0; st < 8; ++st) {
                const uint4 a4 = abuf[T & 1][st];
                const v8i Av = {(int)a4.x, (int)a4.y, (int)a4.z, (int)a4.w, 0, 0, 0, 0};
                au = __builtin_amdgcn_mfma_scale_f32_16x16x128_f8f6f4(Av, Bv[st], au, 4, 0, 0, 0x7f7f7f7f, 0, 0x7f7f7f7f);
            }
            if (lr < 2) *(f32x4*)(sact + 16 * T + 4 * g) = au;
        }
    }
    __builtin_amdgcn_s_waitcnt(0xc07f);
    __builtin_amdgcn_wave_barrier();
    {
        float* sw = (float*)sidx;
        float wv[2];
#pragma unroll
        for (int hh = 0; hh < 2; ++hh) {
            const int e = lane + 64 * hh, id = sid[e];
            const float a = (sw[e] + sw[128 + e]) * usc[id] * rstd;
            wv[hh] = sgate[e] * vsc[id] * 0.5f * a * (1.f + erff(a * 0.70710678118654752f));
        }
        sw[lane] = wv[0]; sw[lane + 64] = wv[1];
    }
    __builtin_amdgcn_s_waitcnt(0xc07f);
    __builtin_amdgcn_wave_barrier();
    const int half = lane >> 5, l5 = lane & 31;
    const int lane_o = 2 * l5 + half;
    f32x2 acc2[16];
#pragma unroll
    for (int j = 0; j < 16; ++j) acc2[j] = (f32x2){0.f, 0.f};
    const unsigned char* Vb = P.ws + WS_V;
    const unsigned vlo = (unsigned)l5 * 16u;
#pragma unroll 1
    for (int e0 = 0; e0 < 128; e0 += 16) {
        uint4 vr[8];
#pragma unroll
        for (int q = 0; q < 8; ++q) vr[q] = *(const uint4*)(Vb + ((unsigned)sid[e0 + 2 * q + half] * 512u + vlo));
        const float* sw = (const float*)sidx + e0;
        const f32x4 w0 = *(const f32x4*)(sw), w1 = *(const f32x4*)(sw + 4), w2 = *(const f32x4*)(sw + 8), w3 = *(const f32x4*)(sw + 12);
        const float wq[16] = {w0[0], w0[1], w0[2], w0[3], w1[0], w1[1], w1[2], w1[3], w2[0], w2[1], w2[2], w2[3], w3[0], w3[1], w3[2], w3[3]};
#pragma unroll
        for (int q = 0; q < 8; ++q) {
            const float w = half ? wq[2 * q + 1] : wq[2 * q];
#define FP4_AXPY(k) { acc2[k] += w * __builtin_amdgcn_cvt_scalef32_pk_f32_fp4(vr[q].x, 1.0f, k); acc2[4 + k] += w * __builtin_amdgcn_cvt_scalef32_pk_f32_fp4(vr[q].y, 1.0f, k); \
                      acc2[8 + k] += w * __builtin_amdgcn_cvt_scalef32_pk_f32_fp4(vr[q].z, 1.0f, k); acc2[12 + k] += w * __builtin_amdgcn_cvt_scalef32_pk_f32_fp4(vr[q].w, 1.0f, k); }
            FP4_AXPY(0) FP4_AXPY(1) FP4_AXPY(2) FP4_AXPY(3)
#undef FP4_AXPY
        }
    }
    f32x2 acc[8];
#pragma unroll
    for (int j = 0; j < 16; ++j) {
        const unsigned x0 = __float_as_uint(acc2[j].x), x1 = __float_as_uint(acc2[j].y);
        const auto r0 = __builtin_amdgcn_permlane32_swap(x0, x0, false, false);
        const auto r1 = __builtin_amdgcn_permlane32_swap(x1, x1, false, false);
        acc2[j].x = __uint_as_float(r0[0]) + __uint_as_float(r0[1]);
        acc2[j].y = __uint_as_float(r1[0]) + __uint_as_float(r1[1]);
    }
#pragma unroll
    for (int j = 0; j < 8; ++j) { acc[j].x = half ? acc2[8 + j].x : acc2[j].x; acc[j].y = half ? acc2[8 + j].y : acc2[j].y; }
    f32x2 xf[8];
    {
        const uint4 xa = *(const uint4*)(xn + lane_o * 16), xb = *(const uint4*)(xn + lane_o * 16 + 8);
        xf[0] = (f32x2){bflo(xa.x), bfhi(xa.x)}; xf[1] = (f32x2){bflo(xa.y), bfhi(xa.y)}; xf[2] = (f32x2){bflo(xa.z), bfhi(xa.z)}; xf[3] = (f32x2){bflo(xa.w), bfhi(xa.w)};
        xf[4] = (f32x2){bflo(xb.x), bfhi(xb.x)}; xf[5] = (f32x2){bflo(xb.y), bfhi(xb.y)}; xf[6] = (f32x2){bflo(xb.z), bfhi(xb.z)}; xf[7] = (f32x2){bflo(xb.w), bfhi(xb.w)};
    }
    float* o = P.out + (size_t)t * DM + lane_o * 16;
    float4 h0, h1, h2, h3;
    {
        const float4 g0 = *(const float4*)(P.norm_ffn + lane_o * 16), g1 = *(const float4*)(P.norm_ffn + lane_o * 16 + 4), g2 = *(const float4*)(P.norm_ffn + lane_o * 16 + 8), g3 = *(const float4*)(P.norm_ffn + lane_o * 16 + 12);
        h0.x = xf[0].x / g0.x + acc[0].x; h0.y = xf[0].y / g0.y + acc[0].y; h0.z = xf[1].x / g0.z + acc[1].x; h0.w = xf[1].y / g0.w + acc[1].y;
        h1.x = xf[2].x / g1.x + acc[2].x; h1.y = xf[2].y / g1.y + acc[2].y; h1.z = xf[3].x / g1.z + acc[3].x; h1.w = xf[3].y / g1.w + acc[3].y;
        h2.x = xf[4].x / g2.x + acc[4].x; h2.y = xf[4].y / g2.y + acc[4].y; h2.z = xf[5].x / g2.z + acc[5].x; h2.w = xf[5].y / g2.w + acc[5].y;
        h3.x = xf[6].x / g3.x + acc[6].x; h3.y = xf[6].y / g3.y + acc[6].y; h3.z = xf[7].x / g3.z + acc[7].x; h3.w = xf[7].y / g3.w + acc[7].y;
    }
    *(float4*)(o) = h0; *(float4*)(o + 4) = h1; *(float4*)(o + 8) = h2; *(float4*)(o + 12) = h3;
    __builtin_amdgcn_s_waitcnt(0xc07f);
    __builtin_amdgcn_wave_barrier();
}

#define LAS __attribute__((address_space(3)))
#define XB_TMO      128
#define XB_XCNT(j)  (256  + 64 * (j))
#define XB_XSUB(j)  (1280 + 64 * (j))
#define XB_XGEN(j)  (2304 + 64 * (j))
#define XB_TOP      3328
#define XB_TOPGEN   3392
#define XCD_BAR_WORDS 3456
#define XB_SPIN_CAP (1u << 18)
__device__ __forceinline__ unsigned xb_ld(unsigned* p)              { return __hip_atomic_load(p, __ATOMIC_RELAXED, __HIP_MEMORY_SCOPE_AGENT); }
__device__ __forceinline__ unsigned xb_add(unsigned* p, unsigned v) { return __hip_atomic_fetch_add(p, v, __ATOMIC_RELAXED, __HIP_MEMORY_SCOPE_AGENT); }
__device__ __forceinline__ unsigned xb_xcc_id() { return (unsigned)__builtin_amdgcn_s_getreg((3 << 11) | 20) & 0xFu; }
#define XB_SPIN(cond, bar) do { unsigned _sp = 0; while (cond) { __builtin_amdgcn_s_sleep(1); \
    if ((++_sp & 255u) == 0u) { if (xb_ld(&(bar)[XB_TMO])) break; if (_sp > XB_SPIN_CAP) { atomicAdd(&(bar)[XB_TMO], 1u); break; } } } } while (0)
struct XcdBarrier { unsigned* bar; unsigned x; volatile LAS unsigned* st; };
__device__ __forceinline__ XcdBarrier xcd_barrier_post(unsigned* bar, volatile LAS unsigned* st) {
    XcdBarrier b; b.bar = bar; b.x = xb_xcc_id(); b.st = st;
    if (threadIdx.x == 0) (void)xb_add(&bar[XB_XCNT(b.x)], 1u);
    return b;
}
__device__ __forceinline__ void xcd_barrier_complete(unsigned* bar, unsigned x, unsigned& nloc, unsigned& nx) {
    const unsigned G = gridDim.x * gridDim.y * gridDim.z;
    unsigned sum, cnt, mine, sp = 0u;
    for (;;) {
        sum = 0u; cnt = 0u; mine = 0u;
#pragma unroll
        for (unsigned j = 0; j < 16; ++j) { const unsigned c = xb_ld(&bar[XB_XCNT(j)]); sum += c; cnt += (c > 0u) ? 1u : 0u; mine = (j == x) ? c : mine; }
        if (sum == G) break;
        __builtin_amdgcn_s_sleep(1);
        if ((++sp & 255u) == 0u) { if (xb_ld(&bar[XB_TMO])) break; if (sp > XB_SPIN_CAP) { atomicAdd(&bar[XB_TMO], 1u); break; } }
    }
    nloc = mine > 0u ? mine : 1u; nx = cnt > 0u ? cnt : 1u;
}
__device__ __forceinline__ void xcd_barrier(const XcdBarrier& b) {
    asm volatile("s_waitcnt vmcnt(0)" ::: "memory");
    __syncthreads();
    if (threadIdx.x == 0) {
        unsigned* bar = b.bar;
        __builtin_amdgcn_s_waitcnt(0);
        unsigned nloc = b.st[0], nx = b.st[1];
        if (nloc == 0u) { xcd_barrier_complete(bar, b.x, nloc, nx); b.st[0] = nloc; b.st[1] = nx; }
        const unsigned old = xb_add(&bar[XB_XSUB(b.x)], 1u);
        const unsigned gen = old / nloc;
        if (old + 1u == (gen + 1u) * nloc) {
            __builtin_amdgcn_fence(__ATOMIC_RELEASE, "agent");
            asm volatile("s_waitcnt vmcnt(0)" ::: "memory");
            const unsigned og = xb_add(&bar[XB_TOP], 1u);
            const unsigned tg = og / nx;
            if (og + 1u == (tg + 1u) * nx) xb_add(&bar[XB_TOPGEN], 1u);
            else XB_SPIN(xb_ld(&bar[XB_TOPGEN]) == tg, bar);
            __builtin_amdgcn_fence(__ATOMIC_ACQUIRE, "agent");
            xb_add(&bar[XB_XGEN(b.x)], 1u);
            asm volatile("s_waitcnt vmcnt(0)" ::: "memory");
        } else {
            XB_SPIN(xb_ld(&bar[XB_XGEN(b.x)]) == gen, bar);
            __builtin_amdgcn_fence(__ATOMIC_ACQUIRE, "agent");
            asm volatile("s_waitcnt vmcnt(0)" ::: "memory");
        }
    }
    __syncthreads();
}

__device__ __forceinline__ void hand_release() { asm volatile("s_waitcnt vmcnt(0)" ::: "memory"); __builtin_amdgcn_fence(__ATOMIC_RELEASE, "agent"); asm volatile("s_waitcnt vmcnt(0)" ::: "memory"); }
__device__ __forceinline__ void hand_acquire() { __builtin_amdgcn_fence(__ATOMIC_ACQUIRE, "agent"); asm volatile("s_waitcnt vmcnt(0)" ::: "memory"); }

__global__ void __launch_bounds__(256, 2) mega(Params P) {
    extern __shared__ __attribute__((aligned(16))) unsigned char smem[];
    const int tid = threadIdx.x, lane = tid & 63, wave = tid >> 6;
    const int G = gridDim.x, bid = blockIdx.x;
    unsigned* ctl = (unsigned*)(P.ws + WS_CTL);
    volatile LAS unsigned* bst = (volatile LAS unsigned*)(smem + 65552);
    if (tid == 0) { bst[0] = 0u; bst[1] = 0u; }
    __syncthreads();
    const XcdBarrier xb = xcd_barrier_post(ctl + 1024, bst);
    unsigned* cucnt = ctl + 5120;
    if (tid == 0) {
        const unsigned phys = ((xb_xcc_id() & 7u) << 8) | ((unsigned)__builtin_amdgcn_s_getreg((7 << 11) | (8 << 6) | 4) & 0xFFu);
        bst[2] = phys; bst[3] = xb_add(&cucnt[phys], 1u);
    }
    phase0(P, smem);
    xcd_barrier(xb);
    {
        int vb;
        const unsigned phys = bst[2];
        unsigned part = 0;
#pragma unroll
        for (int q = 0; q < 8; ++q) { const unsigned i = (unsigned)(tid + 256 * q); const unsigned c = xb_ld(&cucnt[i]); part += (i < phys) ? c : 0u; }
#pragma unroll
        for (int o = 1; o < 64; o <<= 1) part += (unsigned)__shfl_xor((int)part, o, 64);
        if (lane == 0) bst[4 + wave] = part;
        __syncthreads();
        vb = (int)(bst[4] + bst[5] + bst[6] + bst[7] + bst[3]);
        vb = __builtin_amdgcn_readfirstlane(vb);
        if (vb < 0 || vb >= G) vb = bid;
        __syncthreads();
        if (tid == 0) bst[8] = (unsigned)vb;
        __syncthreads();
    }
#define VB_LOAD() __builtin_amdgcn_readfirstlane((int)bst[8])
    {
        const int gw = bid * 4 + wave;
        if (gw < 64) fox_cum_wave(P, gw, lane);
        const int vb = VB_LOAD();
        for (int tile = vb; tile < 129 * 28; tile += G) gemm_tile<1>(P, tile / 28, tile % 28, smem);
        {
            const int rem = (129 * 28) % G;
            if (rem > 0 && rem < G) { if (vb >= rem) convert_uv_rows(P, (vb - rem) * 4 + wave, (G - rem) * 4, lane); }
            else convert_uv_rows(P, vb * 4 + wave, G * 4, lane);
        }
    }
    xcd_barrier(xb);
    {
        volatile int* s_item = (volatile int*)(smem + 65536);
        const int wave_u = __builtin_amdgcn_readfirstlane(wave);
        auto fetch = [&](unsigned* counter) -> int {
            if (wave_u == 0) {
                unsigned v = atomicAdd(counter, lane == 0 ? 1u : 0u);
                *s_item = (int)__builtin_amdgcn_readfirstlane(v);
            }
            __syncthreads();
            const int item = __builtin_amdgcn_readfirstlane(*s_item);
            __syncthreads();
            return item;
        };
        for (;;) {
            const int item = fetch(&ctl[2]);
            if (item >= 33 * 32) break;
            mlstm_A(P, item, smem);
        }
        xcd_barrier(xb);
        for (;;) {
            const int item = fetch(&ctl[4]);
            if (item >= 96) break;
            mlstm_B(P, item);
        }
        for (;;) {
            const int item = fetch(&ctl[3]);
            if (item >= 64 * 17) break;
            attn_block(P, item & 63, 16 - (item >> 6), smem);
        }
        xcd_barrier(xb);
        for (;;) {
            const int item = fetch(&ctl[5]);
            if (item >= 33 * 32) break;
            mlstm_C(P, item, smem);
        }
    }
    xcd_barrier(xb);
    for (int tile = VB_LOAD(); tile < 128 * 8; tile += G) gemm_tile<2>(P, tile >> 3, tile & 7, smem);
    xcd_barrier(xb);
    for (int tile = VB_LOAD(); tile < 128 * 16; tile += G) gemm_tile<3>(P, tile >> 4, tile & 15, smem);
    xcd_barrier(xb);
    {
        unsigned char* slut = smem + 12288;
        if (tid < 64) {
            int c = tid, i = 0;
            while (i < 16 && c >= 16 / (i + 1)) { c -= 16 / (i + 1); ++i; }
            slut[tid] = (unsigned char)(i < 16 ? ((i << 4) | c) : 0);
        }
        unsigned* szero = (unsigned*)(smem + 12288 + 64);
        if (tid < 16) szero[tid] = 0u;
        __syncthreads();
        int* sidx = (int*)(smem + wave * 3072); float* sval = (float*)(smem + wave * 3072 + 1024);
        int* sid = (int*)(smem + wave * 3072 + 2048); float* sgate = (float*)(smem + wave * 3072 + 2560);
        int lane5 = lane;
        asm volatile("" : "+v"(lane5));
        for (int t = bid * 4 + wave; t < T2; t += G * 4) peer_token(P, t, lane5, sidx, sval, sid, sgate, slut, szero);
    }
}

}

extern "C" void kernel_launch(void* const* d_in, const int* in_sizes, int n_in, void* d_out, int out_size, void* d_ws, size_t ws_size, hipStream_t stream) {
    if (n_in != 17 || ws_size < WS_END) { fprintf(stderr, "kernel_launch: unexpected n_in %d or ws_size %zu (need %zu)\n", n_in, ws_size, (size_t)WS_END); return; }
    constexpr int LDS_BYTES = 66560;
    static int grid_blocks = 0;
    if (!grid_blocks) {
        int dev = 0, cus = 0, per_cu = 0;
        (void)hipGetDevice(&dev);
        (void)hipDeviceGetAttribute(&cus, hipDeviceAttributeMultiprocessorCount, dev);
        (void)hipFuncSetAttribute((const void*)mega, hipFuncAttributeMaxDynamicSharedMemorySize, LDS_BYTES);
        (void)hipOccupancyMaxActiveBlocksPerMultiprocessor(&per_cu, (const void*)mega, 256, LDS_BYTES);
        if (per_cu < 1) per_cu = 1;
        if (per_cu > 2) per_cu = 2;
        grid_blocks = cus * per_cu;
        fprintf(stderr, "kernel_launch: cus %d per_cu %d grid %d\n", cus, per_cu, grid_blocks);
    }
    Params P{};
    P.x = (const float*)d_in[0]; P.meta = (const float*)d_in[1]; P.norm_mix = (const float*)d_in[2]; P.w_in = (const float*)d_in[3];
    P.conv_qk = (const float*)d_in[4]; P.b_igate = (const float*)d_in[5]; P.b_fgate_m = (const float*)d_in[6]; P.m_out_norm = (const float*)d_in[7];
    P.b_fgate_f = (const float*)d_in[8]; P.f_q_norm = (const float*)d_in[9]; P.f_k_norm = (const float*)d_in[10]; P.w_out = (const float*)d_in[11];
    P.norm_ffn = (const float*)d_in[12]; P.peer_query = (const float*)d_in[13]; P.peer_keys = (const float*)d_in[14]; P.peer_u = (const float*)d_in[15];
    P.peer_v = (const float*)d_in[16]; P.out = (float*)d_out; P.ws = (unsigned char*)d_ws;
    (void)hipMemsetAsync((unsigned char*)d_ws + WS_CTL, 0, 32768, stream);
    void* args[] = {&P};
    hipError_t e = hipLaunchCooperativeKernel((const void*)mega, dim3(grid_blocks), dim3(256), args, LDS_BYTES, stream);
    if (e != hipSuccess) fprintf(stderr, "cooperative launch failed: %s (grid %d)\n", hipGetErrorString(e), grid_blocks);
}
```

```cpp
#include <hip/hip_runtime.h>
#include <stdint.h>
#include <stdio.h>
#include <hip/hip_cooperative_groups.h>
namespace cg = cooperative_groups;

namespace {

constexpr int NB = 8, SEQ = 2048, DM = 1024, NMETA = 16, L = SEQ + NMETA;
constexpr int T1 = NB * L;
constexpr int T2 = NB * SEQ;
constexpr int NZ = 3584;
constexpr int ZC_MQ = 0, ZC_MK = 512, ZC_MV = 1024, ZC_MO = 1536, ZC_FQ = 2048, ZC_FK = 2560, ZC_FV = 3072;
constexpr int PROJ = 3600;
constexpr float EPS = 1e-6f;

constexpr size_t WS_CTL = 0;
constexpr size_t WS_RA = 65536;
constexpr size_t WS_Z = WS_RA + (size_t)T1 * DM * 2;
constexpr size_t WS_GATES = WS_Z + (size_t)T1 * NZ * 2;
constexpr size_t WS_CUM = WS_GATES + (size_t)T1 * 16 * 4;
constexpr size_t WS_SSQ = WS_CUM + (size_t)NB * 8 * L * 4;
constexpr size_t WS_RSTD = WS_SSQ + (size_t)T2 * 16 * 4;
constexpr size_t WS_SSQM = WS_RSTD + (size_t)T2 * 4;
constexpr size_t WS_BT2 = WS_SSQM + (size_t)T1 * 16 * 4;
constexpr size_t WS_BT3 = WS_BT2 + (size_t)DM * DM * 2;
constexpr size_t WS_KEYS = WS_BT3 + (size_t)2048 * DM * 2;
constexpr size_t WS_MSC = WS_KEYS + (size_t)16 * 128 * 128 * 2;
constexpr size_t WS_MST = WS_MSC + (size_t)128 * 33 * 16;
constexpr size_t WS_BT1 = WS_MST + (size_t)32 * 33 * 36864;
constexpr size_t WS_CBI = WS_BT1;
constexpr size_t WS_UV = WS_CBI + (size_t)32 * 33 * 36864;
constexpr size_t WS_END = WS_UV + (size_t)2 * 16384 * 512 + (size_t)2 * 16384 * 4;
constexpr size_t WS_XN = WS_RA;
constexpr size_t WS_U = WS_UV;
constexpr size_t WS_V = WS_U + (size_t)16384 * 512;
constexpr size_t WS_USC = WS_V + (size_t)16384 * 512;
constexpr size_t WS_VSC = WS_USC + (size_t)16384 * 4;
constexpr size_t WS_TK = WS_CBI;
constexpr float LOG2E = 1.4426950408889634f;

typedef unsigned short bf16_t;
typedef short bf16x8 __attribute__((ext_vector_type(8)));
typedef float f32x4 __attribute__((ext_vector_type(4)));
typedef __attribute__((ext_vector_type(2))) __bf16 bf16x2_t;

struct Params {
    const float* x; const float* meta; const float* norm_mix; const float* w_in; const float* conv_qk;
    const float* b_igate; const float* b_fgate_m; const float* m_out_norm; const float* b_fgate_f;
    const float* f_q_norm; const float* f_k_norm; const float* w_out; const float* norm_ffn;
    const float* peer_query; const float* peer_keys; const float* peer_u; const float* peer_v;
    float* out; unsigned char* ws;
};

__device__ __forceinline__ unsigned f2bf(float f) { unsigned u = __float_as_uint(f); return (u + 0x7fffu + ((u >> 16) & 1u)) >> 16; }
__device__ __forceinline__ float bf2f(unsigned h) { return __uint_as_float(h << 16); }
typedef float f32x2 __attribute__((ext_vector_type(2)));
typedef __bf16 bf16x2v __attribute__((ext_vector_type(2)));
__device__ __forceinline__ unsigned cvt_pk_bf16(float lo, float hi) { f32x2 v = {lo, hi}; bf16x2v b = __builtin_convertvector(v, bf16x2v); return __builtin_bit_cast(unsigned, b); }
__device__ __forceinline__ unsigned pk2(float lo, float hi) { return cvt_pk_bf16(lo, hi); }
__device__ __forceinline__ float bflo(unsigned w) { return __uint_as_float(w << 16); }
__device__ __forceinline__ float bfhi(unsigned w) { return __uint_as_float(w & 0xffff0000u); }
__device__ __forceinline__ float wave_sum(float v) {
#pragma unroll
    for (int o = 32; o > 0; o >>= 1) v += __shfl_xor(v, o, 64);
    return v;
}
__device__ __forceinline__ float wave_max(float v) {
#pragma unroll
    for (int o = 32; o > 0; o >>= 1) v = fmaxf(v, __shfl_xor(v, o, 64));
    return v;
}
__device__ __forceinline__ float logsigmoidf(float x) { return fminf(x, 0.f) - log1pf(expf(-fabsf(x))); }
__device__ __forceinline__ unsigned ord_key(float f) { unsigned u = __float_as_uint(f); return u ^ ((u >> 31) ? 0xffffffffu : 0x80000000u); }
__device__ __forceinline__ float unord_key(unsigned k) { unsigned u = (k & 0x80000000u) ? (k ^ 0x80000000u) : ~k; return __uint_as_float(u); }

__device__ __forceinline__ void phase0(const Params& P, unsigned char* smem) {
    const int tid = threadIdx.x, lane = tid & 63, wave = tid >> 6;
    unsigned* ctl = (unsigned*)(P.ws + WS_CTL);
    float* gw = (float*)smem;
    for (int idx = tid; idx < 16 * 1024; idx += 256) {
        const int k = idx >> 4, c = idx & 15;
        const int col = c < 8 ? 2048 + c : 3592 + (c - 8);
        gw[c * 1024 + k] = P.w_in[(size_t)k * PROJ + col];
    }
    __syncthreads();
    {
        bf16_t* hn = (bf16_t*)(P.ws + WS_RA);
        float* gates = (float*)(P.ws + WS_GATES);
        const int c0 = lane * 8, c1 = 512 + lane * 8;
        float gm[16];
        {
            const float4 a0 = *(const float4*)(P.norm_mix + c0), a1 = *(const float4*)(P.norm_mix + c0 + 4);
            const float4 a2 = *(const float4*)(P.norm_mix + c1), a3 = *(const float4*)(P.norm_mix + c1 + 4);
            gm[0] = a0.x; gm[1] = a0.y; gm[2] = a0.z; gm[3] = a0.w; gm[4] = a1.x; gm[5] = a1.y; gm[6] = a1.z; gm[7] = a1.w;
            gm[8] = a2.x; gm[9] = a2.y; gm[10] = a2.z; gm[11] = a2.w; gm[12] = a3.x; gm[13] = a3.y; gm[14] = a3.z; gm[15] = a3.w;
        }
        const int myq = ((lane >> 5) & 1) * 8 + ((lane >> 4) & 1) * 4 + ((lane >> 3) & 1) * 2 + ((lane >> 2) & 1);
        const float mybias = myq < 4 ? P.b_igate[myq] : (myq < 8 ? P.b_fgate_m[myq - 4] : P.b_fgate_f[myq - 8]);
        const int rstep = gridDim.x * 4;
        int r = blockIdx.x * 4 + wave;
        float4 n0, n1, n2, n3;
        auto load_row = [&](int rr) {
            const int b = rr / L, p = rr - b * L;
            const float* src = (p < NMETA) ? (P.meta + (size_t)p * DM) : (P.x + ((size_t)b * SEQ + (p - NMETA)) * DM);
            n0 = *(const float4*)(src + c0); n1 = *(const float4*)(src + c0 + 4); n2 = *(const float4*)(src + c1); n3 = *(const float4*)(src + c1 + 4);
        };
        if (r < T1) load_row(r);
        for (; r < T1; r += rstep) {
            float v[16];
            v[0] = n0.x; v[1] = n0.y; v[2] = n0.z; v[3] = n0.w; v[4] = n1.x; v[5] = n1.y; v[6] = n1.z; v[7] = n1.w;
            v[8] = n2.x; v[9] = n2.y; v[10] = n2.z; v[11] = n2.w; v[12] = n3.x; v[13] = n3.y; v[14] = n3.z; v[15] = n3.w;
            if (r + rstep < T1) load_row(r + rstep);
            float ss = 0.f;
#pragma unroll
            for (int j = 0; j < 16; ++j) ss += v[j] * v[j];
            ss = wave_sum(ss);
            const float rstd = rsqrtf(ss * (1.0f / DM) + EPS);
#pragma unroll
            for (int j = 0; j < 16; ++j) v[j] *= rstd * gm[j];
            uint4 o0, o1;
            o0.x = pk2(v[0], v[1]); o0.y = pk2(v[2], v[3]); o0.z = pk2(v[4], v[5]); o0.w = pk2(v[6], v[7]);
            o1.x = pk2(v[8], v[9]); o1.y = pk2(v[10], v[11]); o1.z = pk2(v[12], v[13]); o1.w = pk2(v[14], v[15]);
            *(uint4*)(hn + (size_t)r * DM + c0) = o0;
            *(uint4*)(hn + (size_t)r * DM + c1) = o1;
            float r8[8], r4[4], r2[2], r1;
#pragma unroll
            for (int i = 0; i < 8; ++i) {
                float dd[2];
#pragma unroll
                for (int hh = 0; hh < 2; ++hh) {
                    const float* gwc = gw + (i + 8 * hh) * 1024;
                    const float4 w0 = *(const float4*)(gwc + c0), w1 = *(const float4*)(gwc + c0 + 4), w2 = *(const float4*)(gwc + c1), w3 = *(const float4*)(gwc + c1 + 4);
                    dd[hh] = v[0] * w0.x + v[1] * w0.y + v[2] * w0.z + v[3] * w0.w + v[4] * w1.x + v[5] * w1.y + v[6] * w1.z + v[7] * w1.w
                           + v[8] * w2.x + v[9] * w2.y + v[10] * w2.z + v[11] * w2.w + v[12] * w3.x + v[13] * w3.y + v[14] * w3.z + v[15] * w3.w;
                }
                const bool up = (lane & 32) != 0; const float keep = up ? dd[1] : dd[0], send = up ? dd[0] : dd[1];
                r8[i] = keep + __shfl_xor(send, 32, 64);
                __builtin_amdgcn_sched_barrier(0);
            }
#pragma unroll
            for (int i = 0; i < 4; ++i) { const bool up = (lane & 16) != 0; const float keep = up ? r8[i + 4] : r8[i], send = up ? r8[i] : r8[i + 4]; r4[i] = keep + __shfl_xor(send, 16, 64); }
#pragma unroll
            for (int i = 0; i < 2; ++i) { const bool up = (lane & 8) != 0; const float keep = up ? r4[i + 2] : r4[i], send = up ? r4[i] : r4[i + 2]; r2[i] = keep + __shfl_xor(send, 8, 64); }
            { const bool up = (lane & 4) != 0; const float keep = up ? r2[1] : r2[0], send = up ? r2[0] : r2[1]; r1 = keep + __shfl_xor(send, 4, 64); }
            r1 += __shfl_xor(r1, 2, 64); r1 += __shfl_xor(r1, 1, 64);
            if ((lane & 3) == 0) {
                const float pre = r1 + mybias;
                gates[(size_t)r * 16 + myq] = myq < 4 ? pre : logsigmoidf(pre);
            }
        }
    }
    __syncthreads();
    {
        float* tile = (float*)smem;
        for (int item = blockIdx.x; item < 1664; item += gridDim.x) {
            const float* W; int ldn, ntn, shift_from, it; bf16_t* out;
            if (item < 896) { W = P.w_in; ldn = PROJ; ntn = 56; shift_from = 2048; it = item; out = (bf16_t*)(P.ws + WS_BT1); }
            else if (item < 1152) { W = P.w_out; ldn = 1024; ntn = 16; shift_from = 1 << 30; it = item - 896; out = (bf16_t*)(P.ws + WS_BT2); }
            else { W = P.peer_query; ldn = 2048; ntn = 32; shift_from = 1 << 30; it = item - 1152; out = (bf16_t*)(P.ws + WS_BT3); }
            const int tk = it / ntn, tn = it - tk * ntn, k0 = tk * 64, n0 = tn * 64;
            {
                const int n4 = (tid & 15) * 4, kr = tid >> 4;
                int n = n0 + n4; if (n >= shift_from) n += 8;
                float4 v[4];
#pragma unroll
                for (int i = 0; i < 4; ++i) v[i] = *(const float4*)(W + (size_t)(k0 + kr + 16 * i) * ldn + n);
#pragma unroll
                for (int i = 0; i < 4; ++i) *(float4*)(tile + (kr + 16 * i) * 68 + n4) = v[i];
            }
            __syncthreads();
            {
#pragma unroll
                for (int i = 0; i < 2; ++i) {
                    const int id = tid + 256 * i, nl = id & 63, kc = id >> 6;
                    const float* tp = tile + (kc * 8) * 68 + nl;
                    uint4 o;
                    o.x = pk2(tp[0], tp[68]); o.y = pk2(tp[2 * 68], tp[3 * 68]); o.z = pk2(tp[4 * 68], tp[5 * 68]); o.w = pk2(tp[6 * 68], tp[7 * 68]);
                    *(uint4*)(out + (size_t)(n0 + nl) * 1024 + k0 + kc * 8) = o;
                }
            }
            __syncthreads();
        }
    }
    {
        const size_t gt = (size_t)blockIdx.x * 256 + tid, gs = (size_t)gridDim.x * 256;
        const float* src = P.peer_keys; bf16_t* dst = (bf16_t*)(P.ws + WS_KEYS);
        for (size_t i = gt; i < (size_t)(16 * 128 * 128 / 8); i += gs) {
            const float4 a = *(const float4*)(src + i * 8), b = *(const float4*)(src + i * 8 + 4);
            uint4 o; o.x = pk2(a.x, a.y); o.y = pk2(a.z, a.w); o.z = pk2(b.x, b.y); o.w = pk2(b.z, b.w);
            *(uint4*)(dst + i * 8) = o;
        }
    }
}

__device__ __forceinline__ void convert_uv_rows(const Params& P, int gwave, int nwaves, int lane) {
    for (int rr0 = gwave * 4; rr0 < 2 * 16384; rr0 += nwaves * 4) {
        float4 a[4][4];
#pragma unroll
        for (int q = 0; q < 4; ++q) {
            const int rr = rr0 + q, which = rr >> 14, row = rr & 16383;
            const float* src = (which ? P.peer_v : P.peer_u) + (size_t)row * DM + lane * 16;
            a[q][0] = *(const float4*)(src); a[q][1] = *(const float4*)(src + 4); a[q][2] = *(const float4*)(src + 8); a[q][3] = *(const float4*)(src + 12);
        }
#pragma unroll
        for (int q = 0; q < 4; ++q) {
            const int rr = rr0 + q, which = rr >> 14, row = rr & 16383;
            float mx = 0.f;
#pragma unroll
            for (int j = 0; j < 4; ++j) mx = fmaxf(mx, fmaxf(fmaxf(fabsf(a[q][j].x), fabsf(a[q][j].y)), fmaxf(fabsf(a[q][j].z), fabsf(a[q][j].w))));
            mx = wave_max(mx);
            const float sc = mx > 0.f ? 6.0f / mx : 1.0f;
            unsigned w0 = 0u, w1 = 0u;
            w0 = __builtin_amdgcn_cvt_scalef32_pk_fp4_f32(w0, a[q][0].x * sc, a[q][0].y * sc, 1.0f, 0); w0 = __builtin_amdgcn_cvt_scalef32_pk_fp4_f32(w0, a[q][0].z * sc, a[q][0].w * sc, 1.0f, 1);
            w0 = __builtin_amdgcn_cvt_scalef32_pk_fp4_f32(w0, a[q][1].x * sc, a[q][1].y * sc, 1.0f, 2); w0 = __builtin_amdgcn_cvt_scalef32_pk_fp4_f32(w0, a[q][1].z * sc, a[q][1].w * sc, 1.0f, 3);
            w1 = __builtin_amdgcn_cvt_scalef32_pk_fp4_f32(w1, a[q][2].x * sc, a[q][2].y * sc, 1.0f, 0); w1 = __builtin_amdgcn_cvt_scalef32_pk_fp4_f32(w1, a[q][2].z * sc, a[q][2].w * sc, 1.0f, 1);
            w1 = __builtin_amdgcn_cvt_scalef32_pk_fp4_f32(w1, a[q][3].x * sc, a[q][3].y * sc, 1.0f, 2); w1 = __builtin_amdgcn_cvt_scalef32_pk_fp4_f32(w1, a[q][3].z * sc, a[q][3].w * sc, 1.0f, 3);
            *(uint2*)(P.ws + (which ? WS_V : WS_U) + (size_t)row * 512 + lane * 8) = make_uint2(w0, w1);
            if (lane == 0) ((float*)(P.ws + (which ? WS_VSC : WS_USC)))[row] = mx > 0.f ? mx * (1.0f / 6.0f) : 1.0f;
        }
    }
}

__device__ __forceinline__ void bitonic_sort16_desc(unsigned (&v)[16]) {
#pragma unroll
    for (int k = 2; k <= 16; k <<= 1)
#pragma unroll
        for (int j = k >> 1; j >= 1; j >>= 1)
#pragma unroll
            for (int i = 0; i < 16; ++i)
                if ((i & j) == 0) {
                    const int p = i | j;
                    const bool desc = (k >= 16) ? true : ((i & k) == 0);
                    const unsigned hi = max(v[i], v[p]), lo = min(v[i], v[p]);
                    v[i] = desc ? hi : lo; v[p] = desc ? lo : hi;
                }
}
__device__ __forceinline__ void bitonic_merge16_top(unsigned (&a)[16], const unsigned (&b)[16]) {
#pragma unroll
    for (int i = 0; i < 16; ++i) a[i] = max(a[i], b[15 - i]);
#pragma unroll
    for (int j = 8; j >= 1; j >>= 1)
#pragma unroll
        for (int i = 0; i < 16; ++i)
            if ((i & j) == 0) { const int p = i | j; const unsigned hi = max(a[i], a[p]), lo = min(a[i], a[p]); a[i] = hi; a[p] = lo; }
}

__device__ __forceinline__ float x4_max(float x) {
    const unsigned xi = __float_as_uint(x);
    const auto r = __builtin_amdgcn_permlane32_swap(xi, xi, false, false);
    const float m = fmaxf(__uint_as_float(r[0]), __uint_as_float(r[1]));
    const unsigned mi = __float_as_uint(m);
    const auto r2 = __builtin_amdgcn_permlane16_swap(mi, mi, false, false);
    return fmaxf(__uint_as_float(r2[0]), __uint_as_float(r2[1]));
}
__device__ __forceinline__ float x4_sum(float x) {
    const unsigned xi = __float_as_uint(x);
    const auto r = __builtin_amdgcn_permlane32_swap(xi, xi, false, false);
    const float m = __uint_as_float(r[0]) + __uint_as_float(r[1]);
    const unsigned mi = __float_as_uint(m);
    const auto r2 = __builtin_amdgcn_permlane16_swap(mi, mi, false, false);
    return __uint_as_float(r2[0]) + __uint_as_float(r2[1]);
}

__device__ __forceinline__ int opaque_tid() { int t = threadIdx.x; asm volatile("" : "+v"(t)); return t; }

__device__ __forceinline__ void mma_ktile(const unsigned char* sA, const unsigned char* sB, int arow_off, int brow_off, int g, int sw, f32x4 (&acc)[4][4]) {
#pragma unroll
    for (int s = 0; s < 2; ++s) {
        bf16x8 a[4], b[4];
        const int ch = (((s * 4 + g) ^ sw) << 4);
#pragma unroll
        for (int i = 0; i < 4; ++i) a[i] = *(const bf16x8*)(sA + arow_off + i * 2048 + ch);
#pragma unroll
        for (int j = 0; j < 4; ++j) b[j] = *(const bf16x8*)(sB + brow_off + j * 2048 + ch);
#pragma unroll
        for (int i = 0; i < 4; ++i)
#pragma unroll
            for (int j = 0; j < 4; ++j) acc[i][j] = __builtin_amdgcn_mfma_f32_16x16x32_bf16(b[j], a[i], acc[i][j], 0, 0, 0);
    }
}

__device__ __forceinline__ void store_tile_bf16(const f32x4 (&acc)[4][4], unsigned char* smem, bf16_t* dst, size_t ld, int m0, int n0, int tid, int wr, int wc, int g, int lr) {
#pragma unroll
    for (int i = 0; i < 4; ++i)
#pragma unroll
        for (int j = 0; j < 4; ++j) {
            const int row = wr * 64 + 16 * i + lr, col = wc * 64 + 16 * j + 4 * g;
            uint2 w; w.x = pk2(acc[i][j][0], acc[i][j][1]); w.y = pk2(acc[i][j][2], acc[i][j][3]);
            *(uint2*)(smem + row * 272 + col * 2) = w;
        }
    __syncthreads();
#pragma unroll
    for (int q = 0; q < 8; ++q) {
        const int id = tid + 256 * q, row = id >> 4, ch = id & 15;
        const uint4 v = *(const uint4*)(smem + row * 272 + ch * 16);
        *(uint4*)(dst + (size_t)(m0 + row) * ld + n0 + ch * 8) = v;
    }
    __syncthreads();
}

template <int MODE>
__device__ __forceinline__ void gemm_tile(const Params& P, int tm, int tn, unsigned char* smem) {
    const bf16_t* A; const bf16_t* Bt;
    if (MODE == 1) { A = (const bf16_t*)(P.ws + WS_RA); Bt = (const bf16_t*)(P.ws + WS_BT1); }
    else if (MODE == 2) { A = (const bf16_t*)(P.ws + WS_Z); Bt = (const bf16_t*)(P.ws + WS_BT2); }
    else { A = (const bf16_t*)(P.ws + WS_XN); Bt = (const bf16_t*)(P.ws + WS_BT3); }
    const int tid = opaque_tid(), lane = tid & 63, wave = tid >> 6, wr = wave >> 1, wc = wave & 1, g = lane >> 4, lr = lane & 15;
    const int m0 = tm * 128, n0 = tn * 128;
    const int srow = tid >> 3, sc = tid & 7;
    constexpr unsigned LDA = (MODE == 2 ? NZ : 1024) * 2u;
    unsigned aoff, boff; int soff0;
    {
        int ar = m0 + srow;
        if (MODE == 2) { const int b = ar >> 11, t = ar & 2047; ar = b * L + NMETA + t; }
        aoff = (unsigned)ar * LDA + (unsigned)sc * 16u;
        boff = (unsigned)(n0 + srow) * 2048u + (unsigned)sc * 16u;
        soff0 = srow * 128 + ((sc ^ (srow & 7)) << 4);
    }
    const unsigned char* Ab = (const unsigned char*)A; const unsigned char* Bb = (const unsigned char*)Bt;
    f32x4 acc[4][4];
#pragma unroll
    for (int i = 0; i < 4; ++i)
#pragma unroll
        for (int j = 0; j < 4; ++j) acc[i][j] = (f32x4){0.f, 0.f, 0.f, 0.f};
    uint4 ra0, ra1, ra2, ra3, rb0, rb1, rb2, rb3;
#define G_LOAD(KT) { const unsigned ko = (unsigned)(KT) * 128u; \
        ra0 = *(const uint4*)(Ab + (aoff + ko)); ra1 = *(const uint4*)(Ab + (aoff + 32u * LDA + ko)); ra2 = *(const uint4*)(Ab + (aoff + 64u * LDA + ko)); ra3 = *(const uint4*)(Ab + (aoff + 96u * LDA + ko)); \
        rb0 = *(const uint4*)(Bb + (boff + ko)); rb1 = *(const uint4*)(Bb + (boff + 32u * 2048u + ko)); rb2 = *(const uint4*)(Bb + (boff + 64u * 2048u + ko)); rb3 = *(const uint4*)(Bb + (boff + 96u * 2048u + ko)); }
#define G_WRITE(SA, SB) { *(uint4*)((SA) + soff0) = ra0; *(uint4*)((SA) + soff0 + 4096) = ra1; *(uint4*)((SA) + soff0 + 8192) = ra2; *(uint4*)((SA) + soff0 + 12288) = ra3; \
        *(uint4*)((SB) + soff0) = rb0; *(uint4*)((SB) + soff0 + 4096) = rb1; *(uint4*)((SB) + soff0 + 8192) = rb2; *(uint4*)((SB) + soff0 + 12288) = rb3; }
    unsigned char* sA0 = smem; unsigned char* sB0 = smem + 16384; unsigned char* sA1 = smem + 32768; unsigned char* sB1 = smem + 49152;
    G_LOAD(0)
    G_WRITE(sA0, sB0)
    __syncthreads();
    const int arow_off = (wr * 64 + lr) * 128, brow_off = (wc * 64 + lr) * 128, sw = lr & 7;
    G_LOAD(1)
    for (int kt = 0; kt < 16; ++kt) {
        unsigned char* sA = (kt & 1) ? sA1 : sA0; unsigned char* sB = (kt & 1) ? sB1 : sB0;
        unsigned char* nA = (kt & 1) ? sA0 : sA1; unsigned char* nB = (kt & 1) ? sB0 : sB1;
        bf16x8 fa[4], fb[4], ga[4], gb[4];
        const int ch0 = ((g ^ sw) << 4), ch1 = (((4 + g) ^ sw) << 4);
        const unsigned ko = (unsigned)(kt + 2) * 128u;
        const bool wr_ok = kt < 15, ld_ok = kt < 14;
#pragma unroll
        for (int i = 0; i < 4; ++i) { fa[i] = *(const bf16x8*)(sA + arow_off + i * 2048 + ch0); fb[i] = *(const bf16x8*)(sB + brow_off + i * 2048 + ch0); }
        __builtin_amdgcn_sched_barrier(0);
        __builtin_amdgcn_s_setprio(2);
        if (wr_ok) *(uint4*)(nA + soff0) = ra0;
        if (ld_ok) ra0 = *(const uint4*)(Ab + (aoff + 0u * LDA + ko));
        ga[0] = *(const bf16x8*)(sA + arow_off + 0 * 2048 + ch1); gb[0] = *(const bf16x8*)(sB + brow_off + 0 * 2048 + ch1);
        __builtin_amdgcn_sched_barrier(0);
#pragma unroll
        for (int j = 0; j < 4; ++j) acc[0][j] = __builtin_amdgcn_mfma_f32_16x16x32_bf16(fb[j], fa[0], acc[0][j], 0, 0, 0);
        __builtin_amdgcn_sched_barrier(0);
        if (wr_ok) *(uint4*)(nA + soff0 + 4096) = ra1;
        if (ld_ok) ra1 = *(const uint4*)(Ab + (aoff + 32u * LDA + ko));
        ga[1] = *(const bf16x8*)(sA + arow_off + 1 * 2048 + ch1); gb[1] = *(const bf16x8*)(sB + brow_off + 1 * 2048 + ch1);
        __builtin_amdgcn_sched_barrier(0);
#pragma unroll
        for (int j = 0; j < 4; ++j) acc[1][j] = __builtin_amdgcn_mfma_f32_16x16x32_bf16(fb[j], fa[1], acc[1][j], 0, 0, 0);
        __builtin_amdgcn_sched_barrier(0);
        if (wr_ok) *(uint4*)(nA + soff0 + 8192) = ra2;
        if (ld_ok) ra2 = *(const uint4*)(Ab + (aoff + 64u * LDA + ko));
        ga[2] = *(const bf16x8*)(sA + arow_off + 2 * 2048 + ch1); gb[2] = *(const bf16x8*)(sB + brow_off + 2 * 2048 + ch1);
        __builtin_amdgcn_sched_barrier(0);
#pragma unroll
        for (int j = 0; j < 4; ++j) acc[2][j] = __builtin_amdgcn_mfma_f32_16x16x32_bf16(fb[j], fa[2], acc[2][j], 0, 0, 0);
        __builtin_amdgcn_sched_barrier(0);
        if (wr_ok) *(uint4*)(nA + soff0 + 12288) = ra3;
        if (ld_ok) ra3 = *(const uint4*)(Ab + (aoff + 96u * LDA + ko));
        ga[3] = *(const bf16x8*)(sA + arow_off + 3 * 2048 + ch1); gb[3] = *(const bf16x8*)(sB + brow_off + 3 * 2048 + ch1);
        __builtin_amdgcn_sched_barrier(0);
#pragma unroll
        for (int j = 0; j < 4; ++j) acc[3][j] = __builtin_amdgcn_mfma_f32_16x16x32_bf16(fb[j], fa[3], acc[3][j], 0, 0, 0);
        __builtin_amdgcn_sched_barrier(0);
        if (wr_ok) *(uint4*)(nB + soff0) = rb0;
        if (ld_ok) rb0 = *(const uint4*)(Bb + (boff + 0u * 2048u + ko));
        __builtin_amdgcn_sched_barrier(0);
#pragma unroll
        for (int j = 0; j < 4; ++j) acc[0][j] = __builtin_amdgcn_mfma_f32_16x16x32_bf16(gb[j], ga[0], acc[0][j], 0, 0, 0);
        __builtin_amdgcn_sched_barrier(0);
        if (wr_ok) *(uint4*)(nB + soff0 + 4096) = rb1;
        if (ld_ok) rb1 = *(const uint4*)(Bb + (boff + 32u * 2048u + ko));
        __builtin_amdgcn_sched_barrier(0);
#pragma unroll
        for (int j = 0; j < 4; ++j) acc[1][j] = __builtin_amdgcn_mfma_f32_16x16x32_bf16(gb[j], ga[1], acc[1][j], 0, 0, 0);
        __builtin_amdgcn_sched_barrier(0);
        if (wr_ok) *(uint4*)(nB + soff0 + 8192) = rb2;
        if (ld_ok) rb2 = *(const uint4*)(Bb + (boff + 64u * 2048u + ko));
        __builtin_amdgcn_sched_barrier(0);
#pragma unroll
        for (int j = 0; j < 4; ++j) acc[2][j] = __builtin_amdgcn_mfma_f32_16x16x32_bf16(gb[j], ga[2], acc[2][j], 0, 0, 0);
        __builtin_amdgcn_sched_barrier(0);
        if (wr_ok) *(uint4*)(nB + soff0 + 12288) = rb3;
        if (ld_ok) rb3 = *(const uint4*)(Bb + (boff + 96u * 2048u + ko));
        __builtin_amdgcn_sched_barrier(0);
#pragma unroll
        for (int j = 0; j < 4; ++j) acc[3][j] = __builtin_amdgcn_mfma_f32_16x16x32_bf16(gb[j], ga[3], acc[3][j], 0, 0, 0);
        __builtin_amdgcn_s_setprio(0);
        __syncthreads();
    }
#undef G_LOAD
#undef G_WRITE
    if (MODE == 1) {
        if (n0 >= ZC_FQ && n0 < ZC_FV) {
            const bool isk = n0 >= ZC_FK;
            const float* gain = isk ? P.f_k_norm : P.f_q_norm;
            const float scl = isk ? 1.0f : 0.125f * LOG2E;
            float gn[4][4];
#pragma unroll
            for (int j = 0; j < 4; ++j)
#pragma unroll
                for (int r = 0; r < 4; ++r) gn[j][r] = gain[16 * j + 4 * g + r];
#pragma unroll
            for (int i = 0; i < 4; ++i) {
                float ss = 0.f;
#pragma unroll
                for (int j = 0; j < 4; ++j)
#pragma unroll
                    for (int r = 0; r < 4; ++r) ss += acc[i][j][r] * acc[i][j][r];
                ss = x4_sum(ss);
                const float rstd = rsqrtf(ss * (1.0f / 64.0f) + EPS) * scl;
#pragma unroll
                for (int j = 0; j < 4; ++j)
#pragma unroll
                    for (int r = 0; r < 4; ++r) acc[i][j][r] *= rstd * gn[j][r];
            }
        }
        store_tile_bf16(acc, smem, (bf16_t*)(P.ws + WS_Z), NZ, m0, n0, tid, wr, wc, g, lr);
    } else if (MODE == 2) {
        float* ssq = (float*)(P.ws + WS_SSQ);
#pragma unroll
        for (int i = 0; i < 4; ++i) {
            const int row = m0 + wr * 64 + 16 * i + lr;
            float ss = 0.f;
#pragma unroll
            for (int j = 0; j < 4; ++j) {
                const int col = n0 + wc * 64 + 16 * j + 4 * g;
                const float4 xv = *(const float4*)(P.x + (size_t)row * DM + col);
                const float4 gv = *(const float4*)(P.norm_ffn + col);
                float4 hv; hv.x = acc[i][j][0] + xv.x; hv.y = acc[i][j][1] + xv.y; hv.z = acc[i][j][2] + xv.z; hv.w = acc[i][j][3] + xv.w;
                ss += hv.x * hv.x + hv.y * hv.y + hv.z * hv.z + hv.w * hv.w;
                acc[i][j][0] = hv.x * gv.x; acc[i][j][1] = hv.y * gv.y; acc[i][j][2] = hv.z * gv.z; acc[i][j][3] = hv.w * gv.w;
            }
            ss = x4_sum(ss);
            if (g == 0) ssq[(size_t)row * 16 + tn * 2 + wc] = ss;
        }
        store_tile_bf16(acc, smem, (bf16_t*)(P.ws + WS_XN), 1024, m0, n0, tid, wr, wc, g, lr);
    } else {
        const int hp = tn;
        const float* ssq = (const float*)(P.ws + WS_SSQ);
        float rs[4];
#pragma unroll
        for (int i = 0; i < 4; ++i) {
            const int row = m0 + wr * 64 + 16 * i + lr;
            const float4 p0 = *(const float4*)(ssq + (size_t)row * 16), p1 = *(const float4*)(ssq + (size_t)row * 16 + 4);
            const float4 p2 = *(const float4*)(ssq + (size_t)row * 16 + 8), p3 = *(const float4*)(ssq + (size_t)row * 16 + 12);
            const float s = ((p0.x + p0.y) + (p0.z + p0.w)) + ((p1.x + p1.y) + (p1.z + p1.w)) + ((p2.x + p2.y) + (p2.z + p2.w)) + ((p3.x + p3.y) + (p3.z + p3.w));
            rs[i] = rsqrtf(s * (1.0f / DM) + EPS);
            if (tn == 0 && wc == 0 && g == 0) ((float*)(P.ws + WS_RSTD))[row] = rs[i];
        }
        {
            unsigned char* sAq = wc ? sA1 : sA0;
#pragma unroll
            for (int i = 0; i < 4; ++i)
#pragma unroll
                for (int j = 0; j < 4; ++j) {
                    const int row = wr * 64 + 16 * i + lr;
                    const int chunk = 2 * j + (g >> 1);
                    uint2 w; w.x = pk2(acc[i][j][0] * rs[i], acc[i][j][1] * rs[i]); w.y = pk2(acc[i][j][2] * rs[i], acc[i][j][3] * rs[i]);
                    *(uint2*)(sAq + row * 128 + ((chunk ^ (row & 7)) << 4) + 8 * (g & 1)) = w;
                }
            const bf16_t* keys = (const bf16_t*)(P.ws + WS_KEYS) + (size_t)hp * 128 * 128;
#pragma unroll
            for (int j = 0; j < 4; ++j) {
                const int row = srow + 32 * j;
                const uint4 k0 = *(const uint4*)(keys + (size_t)row * 128 + sc * 8);
                const uint4 k1 = *(const uint4*)(keys + (size_t)row * 128 + 64 + sc * 8);
                *(uint4*)(sB0 + soff0 + j * 4096) = k0; *(uint4*)(sB1 + soff0 + j * 4096) = k1;
            }
        }
        __syncthreads();
#pragma unroll
        for (int i = 0; i < 4; ++i)
#pragma unroll
            for (int j = 0; j < 4; ++j) acc[i][j] = (f32x4){0.f, 0.f, 0.f, 0.f};
        mma_ktile(sA0, sB0, arow_off, brow_off, g, sw, acc);
        mma_ktile(sA1, sB1, arow_off, brow_off, g, sw, acc);
        __syncthreads();
#pragma unroll
        for (int i = 0; i < 4; ++i)
#pragma unroll
            for (int j = 0; j < 4; ++j) {
                const int row = wr * 64 + 16 * i + lr;
                const int c4 = wc * 16 + 4 * j + g;
                *(f32x4*)(smem + row * 512 + ((c4 ^ (row & 31)) << 4)) = acc[i][j];
            }
        __syncthreads();
        unsigned top[16];
        const int row = tid & 127, half = tid >> 7;
        {
            auto load_keys = [&](unsigned (&dst)[16], int q4) {
#pragma unroll
                for (int s4 = 0; s4 < 4; ++s4) {
                    const int c4 = half * 16 + q4 * 4 + s4;
                    const f32x4 v = *(const f32x4*)(smem + row * 512 + ((c4 ^ (row & 31)) << 4));
#pragma unroll
                    for (int e = 0; e < 4; ++e) dst[s4 * 4 + e] = (ord_key(v[e]) & ~127u) | (unsigned)(127 - (c4 * 4 + e));
                }
            };
            load_keys(top, 0);
            bitonic_sort16_desc(top);
#pragma unroll 1
            for (int q4 = 1; q4 < 4; ++q4) {
                unsigned gq[16];
                load_keys(gq, q4);
                bitonic_sort16_desc(gq);
                bitonic_merge16_top(top, gq);
            }
        }
        __syncthreads();
        if (half) {
            uint4* lp = (uint4*)(smem + row * 64);
            lp[0] = make_uint4(top[0], top[1], top[2], top[3]); lp[1] = make_uint4(top[4], top[5], top[6], top[7]);
            lp[2] = make_uint4(top[8], top[9], top[10], top[11]); lp[3] = make_uint4(top[12], top[13], top[14], top[15]);
        }
        __syncthreads();
        if (!half) {
            const uint4* lp = (const uint4*)(smem + row * 64);
            unsigned other[16];
#pragma unroll
            for (int c = 0; c < 4; ++c) { const uint4 o = lp[c]; other[4 * c] = o.x; other[4 * c + 1] = o.y; other[4 * c + 2] = o.z; other[4 * c + 3] = o.w; }
            bitonic_merge16_top(top, other);
            uint4* tk = (uint4*)((unsigned*)(P.ws + WS_TK) + ((size_t)(m0 + row) * 16 + hp) * 16);
            tk[0] = make_uint4(top[0], top[1], top[2], top[3]); tk[1] = make_uint4(top[4], top[5], top[6], top[7]);
            tk[2] = make_uint4(top[8], top[9], top[10], top[11]); tk[3] = make_uint4(top[12], top[13], top[14], top[15]);
        }
        __syncthreads();
    }
}

__device__ __forceinline__ void fox_cum_wave(const Params& P, int bh, int lane) {
    const int b = bh >> 3, h = bh & 7;
    const float* gates = (const float*)(P.ws + WS_GATES);
    float* cum = (float*)(P.ws + WS_CUM) + (size_t)bh * L;
    constexpr int SEG = 33;
    const int t0 = lane * SEG;
    float loc = 0.f;
    for (int i = 0; i < SEG; ++i) { const int t = t0 + i; if (t < L) loc += gates[(size_t)(b * L + t) * 16 + 8 + h]; }
    float incl = loc;
#pragma unroll
    for (int o = 1; o < 64; o <<= 1) { const float n = __shfl_up(incl, o, 64); if (lane >= o) incl += n; }
    float run = incl - loc;
    for (int i = 0; i < SEG; ++i) { const int t = t0 + i; if (t < L) { run += gates[(size_t)(b * L + t) * 16 + 8 + h]; cum[t] = run * LOG2E; } }
}

#define TR_SLOW 0

__device__ __forceinline__ int vimg_off(int row, int ch) { return row * 128 + ((ch ^ (((row >> 1) & 3) << 1)) << 4); }
__device__ __forceinline__ uint2 tr_frag(const unsigned char* img, int row0, int c, int g, int lr) {
#if TR_SLOW
    unsigned short e[4];
#pragma unroll
    for (int k = 0; k < 4; ++k) { const int row = row0 + 4 * g + k, col = 16 * c + lr; e[k] = *(const unsigned short*)(img + vimg_off(row, col >> 3) + (col & 7) * 2); }
    uint2 r; r.x = (unsigned)e[0] | ((unsigned)e[1] << 16); r.y = (unsigned)e[2] | ((unsigned)e[3] << 16); return r;
#else
    const int q = lr >> 2, p = lr & 3, row = row0 + 4 * g + q;
    const unsigned addr = (unsigned)(size_t)(img + vimg_off(row, 2 * c + (p >> 1)) + 8 * (p & 1));
    uint2 r;
    asm volatile("ds_read_b64_tr_b16 %0, %1\n\ts_waitcnt lgkmcnt(0)" : "=&v"(r) : "v"(addr) : "memory");
    return r;
#endif
}

__device__ __forceinline__ unsigned tr_lane_addr(const unsigned char* img, int c, int g, int lr) {
    const int q = lr >> 2, p = lr & 3, row = 4 * g + q;
    return (unsigned)(size_t)(img + vimg_off(row, 2 * c + (p >> 1)) + 8 * (p & 1));
}
#define TR_GROUP(o0, o1, o2, o3, a) "ds_read_b64_tr_b16 %" #o0 ", %" #a "\n\tds_read_b64_tr_b16 %" #o1 ", %" #a " offset:2048\n\tds_read_b64_tr_b16 %" #o2 ", %" #a " offset:4096\n\tds_read_b64_tr_b16 %" #o3 ", %" #a " offset:6144\n\t"
__device__ __forceinline__ void tr_read_4c(const unsigned char* img, int g, int lr, uint2 (&r)[4][4]) {
    const unsigned a0 = tr_lane_addr(img, 0, g, lr), a1 = tr_lane_addr(img, 1, g, lr), a2 = tr_lane_addr(img, 2, g, lr), a3 = tr_lane_addr(img, 3, g, lr);
    asm volatile(TR_GROUP(0, 1, 2, 3, 16) TR_GROUP(4, 5, 6, 7, 17) TR_GROUP(8, 9, 10, 11, 18) TR_GROUP(12, 13, 14, 15, 19) "s_waitcnt lgkmcnt(0)"
        : "=&v"(r[0][0]), "=&v"(r[0][1]), "=&v"(r[0][2]), "=&v"(r[0][3]), "=&v"(r[1][0]), "=&v"(r[1][1]), "=&v"(r[1][2]), "=&v"(r[1][3]),
          "=&v"(r[2][0]), "=&v"(r[2][1]), "=&v"(r[2][2]), "=&v"(r[2][3]), "=&v"(r[3][0]), "=&v"(r[3][1]), "=&v"(r[3][2]), "=&v"(r[3][3])
        : "v"(a0), "v"(a1), "v"(a2), "v"(a3) : "memory");
}
__device__ __forceinline__ void tr_read_3c(const unsigned char* img, int g, int lr, uint2 (&r)[3][4]) {
    const unsigned a0 = tr_lane_addr(img, 0, g, lr), a1 = tr_lane_addr(img, 1, g, lr), a2 = tr_lane_addr(img, 2, g, lr);
    asm volatile(TR_GROUP(0, 1, 2, 3, 12) TR_GROUP(4, 5, 6, 7, 13) TR_GROUP(8, 9, 10, 11, 14) "s_waitcnt lgkmcnt(0)"
        : "=&v"(r[0][0]), "=&v"(r[0][1]), "=&v"(r[0][2]), "=&v"(r[0][3]), "=&v"(r[1][0]), "=&v"(r[1][1]), "=&v"(r[1][2]), "=&v"(r[1][3]),
          "=&v"(r[2][0]), "=&v"(r[2][1]), "=&v"(r[2][2]), "=&v"(r[2][3])
        : "v"(a0), "v"(a1), "v"(a2) : "memory");
}
__device__ __forceinline__ void tr_read_2(const unsigned char* img0, int c0, const unsigned char* img1, int c1, int g, int lr, uint2 (&r)[2][4]) {
    const unsigned a0 = tr_lane_addr(img0, c0, g, lr), a1 = tr_lane_addr(img1, c1, g, lr);
    asm volatile(TR_GROUP(0, 1, 2, 3, 8) TR_GROUP(4, 5, 6, 7, 9) "s_waitcnt lgkmcnt(0)"
        : "=&v"(r[0][0]), "=&v"(r[0][1]), "=&v"(r[0][2]), "=&v"(r[0][3]), "=&v"(r[1][0]), "=&v"(r[1][1]), "=&v"(r[1][2]), "=&v"(r[1][3])
        : "v"(a0), "v"(a1) : "memory");
}
__device__ __forceinline__ bf16x8 tr_pair(const uint2& lo, const uint2& hi) { uint4 u; u.x = lo.x; u.y = lo.y; u.z = hi.x; u.w = hi.y; return __builtin_bit_cast(bf16x8, u); }

__device__ __forceinline__ void attn_block(const Params& P, int bh, int qb, unsigned char* smem) {
    const int tid = opaque_tid(), lane = tid & 63, w = tid >> 6, g = lane >> 4, lr = lane & 15;
    const int b = bh >> 3, h = bh & 7;
    const bf16_t* z = (const bf16_t*)(P.ws + WS_Z);
    const float* cum = (const float*)(P.ws + WS_CUM) + (size_t)bh * L;
    int tq[2]; bool qvalid[2]; bf16x8 qf[2][2];
#pragma unroll
    for (int u = 0; u < 2; ++u) {
        tq[u] = qb * 128 + 32 * w + 16 * u + lr;
        qvalid[u] = tq[u] < L;
        const bf16_t* qp = z + (size_t)(b * L + (qvalid[u] ? tq[u] : 0)) * NZ + ZC_FQ + h * 64 + 8 * g;
        qf[u][0] = *(const bf16x8*)(qp); qf[u][1] = *(const bf16x8*)(qp + 32);
    }
    const int nkv = (2 * qb + 2 < 33) ? 2 * qb + 2 : 33;
    const int srow0 = tid >> 3, sch = tid & 7;
    uint4 rk[2], rv[2]; float rc = 0.f;
    auto load_tile = [&](int kv) {
#pragma unroll
        for (int j = 0; j < 2; ++j) {
            const int key = kv * 64 + srow0 + 32 * j;
            if (key < L) {
                const bf16_t* p = z + (size_t)(b * L + key) * NZ + h * 64 + sch * 8;
                rk[j] = *(const uint4*)(p + ZC_FK); rv[j] = *(const uint4*)(p + ZC_FV);
            } else { rk[j] = make_uint4(0, 0, 0, 0); rv[j] = make_uint4(0, 0, 0, 0); }
        }
        if (tid < 64) { const int key = kv * 64 + tid; rc = key < L ? cum[key] : 0.f; }
    };
    auto store_tile = [&](int buf) {
        unsigned char* sK = smem + buf * 16384; unsigned char* sV = sK + 8192;
#pragma unroll
        for (int j = 0; j < 2; ++j) {
            const int row = srow0 + 32 * j;
            *(uint4*)(sK + row * 128 + ((sch ^ (row & 7)) << 4)) = rk[j];
            *(uint4*)(sV + vimg_off(row, sch)) = rv[j];
        }
        if (tid < 64) ((float*)(smem + 32768 + buf * 256))[tid] = rc;
    };
    float m[2] = {-1e30f, -1e30f};
    f32x4 o[2][5];
#pragma unroll
    for (int u = 0; u < 2; ++u)
#pragma unroll
        for (int c = 0; c < 5; ++c) o[u][c] = (f32x4){0.f, 0.f, 0.f, 0.f};
    const unsigned onew = (lr == 0) ? 0x3F803F80u : 0u;
    const bf16x8 vones = __builtin_bit_cast(bf16x8, make_uint4(onew, onew, onew, onew));
    load_tile(nkv - 1); store_tile((nkv - 1) & 1);
    __syncthreads();
    for (int kv = nkv - 1; kv >= 0; --kv) {
        const int buf = kv & 1;
        if (kv > 0) load_tile(kv - 1);
        const unsigned char* sK = smem + buf * 16384; const unsigned char* sV = sK + 8192;
        const float* sck = (const float*)(smem + 32768 + buf * 256);
        f32x4 sa[2][4];
#pragma unroll
        for (int c = 0; c < 4; ++c) {
            sa[0][c] = (f32x4){0.f, 0.f, 0.f, 0.f}; sa[1][c] = (f32x4){0.f, 0.f, 0.f, 0.f};
#pragma unroll
            for (int s = 0; s < 2; ++s) {
                const bf16x8 kf = *(const bf16x8*)(sK + (16 * c + lr) * 128 + (((4 * s + g) ^ (lr & 7)) << 4));
                sa[0][c] = __builtin_amdgcn_mfma_f32_16x16x32_bf16(kf, qf[0][s], sa[0][c], 0, 0, 0);
                sa[1][c] = __builtin_amdgcn_mfma_f32_16x16x32_bf16(kf, qf[1][s], sa[1][c], 0, 0, 0);
            }
        }
        if (kv >= 2 * qb) {
#pragma unroll
            for (int u = 0; u < 2; ++u)
#pragma unroll
                for (int c = 0; c < 4; ++c)
#pragma unroll
                    for (int r = 0; r < 4; ++r)
                        if (64 * kv + 16 * c + 4 * g + r > tq[u]) sa[u][c][r] = -INFINITY;
        }
        f32x4 ck[4];
#pragma unroll
        for (int c = 0; c < 4; ++c) ck[c] = *(const f32x4*)(sck + 16 * c + 4 * g);
        bf16x8 pf[2][2];
#pragma unroll
        for (int u = 0; u < 2; ++u) {
            float mx = -INFINITY;
#pragma unroll
            for (int c = 0; c < 4; ++c) {
                sa[u][c] -= ck[c];
                mx = fmaxf(mx, fmaxf(fmaxf(sa[u][c][0], sa[u][c][1]), fmaxf(sa[u][c][2], sa[u][c][3])));
            }
            mx = x4_max(mx);
            if (__builtin_amdgcn_ballot_w64(mx > m[u]) != 0ull) {
                const float mn = fmaxf(m[u], mx);
                const float alpha = __builtin_amdgcn_exp2f(m[u] - mn);
                m[u] = mn;
#pragma unroll
                for (int c = 0; c < 5; ++c) o[u][c] *= alpha;
            }
            const float mn = m[u];
#pragma unroll
            for (int c = 0; c < 4; ++c)
#pragma unroll
                for (int r = 0; r < 4; ++r) sa[u][c][r] = __builtin_amdgcn_exp2f(sa[u][c][r] - mn);
#pragma unroll
            for (int s2 = 0; s2 < 2; ++s2) {
                uint4 uu;
                uu.x = cvt_pk_bf16(sa[u][2 * s2][0], sa[u][2 * s2][1]); uu.y = cvt_pk_bf16(sa[u][2 * s2][2], sa[u][2 * s2][3]);
                uu.z = cvt_pk_bf16(sa[u][2 * s2 + 1][0], sa[u][2 * s2 + 1][1]); uu.w = cvt_pk_bf16(sa[u][2 * s2 + 1][2], sa[u][2 * s2 + 1][3]);
                pf[u][s2] = __builtin_bit_cast(bf16x8, uu);
            }
        }
        {
            uint2 vr[4][4];
            tr_read_4c(sV, g, lr, vr);
#pragma unroll
            for (int c = 0; c < 4; ++c)
#pragma unroll
                for (int s2 = 0; s2 < 2; ++s2) {
                    const bf16x8 vf = tr_pair(vr[c][2 * s2], vr[c][2 * s2 + 1]);
                    o[0][c] = __builtin_amdgcn_mfma_f32_16x16x32_bf16(vf, pf[0][s2], o[0][c], 0, 0, 0);
                    o[1][c] = __builtin_amdgcn_mfma_f32_16x16x32_bf16(vf, pf[1][s2], o[1][c], 0, 0, 0);
                }
#pragma unroll
            for (int s2 = 0; s2 < 2; ++s2) {
                o[0][4] = __builtin_amdgcn_mfma_f32_16x16x32_bf16(vones, pf[0][s2], o[0][4], 0, 0, 0);
                o[1][4] = __builtin_amdgcn_mfma_f32_16x16x32_bf16(vones, pf[1][s2], o[1][4], 0, 0, 0);
            }
        }
        if (kv > 0) store_tile(buf ^ 1);
        __syncthreads();
    }
#pragma unroll
    for (int u = 0; u < 2; ++u) {
        const float ls = __shfl(o[u][4][0], lr, 64);
        const float inv = 1.0f / ls;
        if (qvalid[u]) {
            bf16_t* y = (bf16_t*)(P.ws + WS_Z) + (size_t)(b * L + tq[u]) * NZ + 512 + h * 64 + 4 * g;
#pragma unroll
            for (int c = 0; c < 4; ++c) {
                uint2 uu; uu.x = pk2(o[u][c][0] * inv, o[u][c][1] * inv); uu.y = pk2(o[u][c][2] * inv, o[u][c][3] * inv);
                *(uint2*)(y + 16 * c) = uu;
            }
        }
    }
}

__device__ __forceinline__ void conv_item(const Params& P, int ci) {
    const int tid = opaque_tid(), cc = tid & 127, rg = tid >> 7;
    const bf16_t* z = (const bf16_t*)(P.ws + WS_Z);
    bf16_t* qk = (bf16_t*)(P.ws + WS_RA);
    const int col0 = cc * 8;
    float w[4][8];
#pragma unroll
    for (int j = 0; j < 4; ++j) {
        const float4 a = *(const float4*)(P.conv_qk + j * 1024 + col0), b = *(const float4*)(P.conv_qk + j * 1024 + col0 + 4);
        w[j][0] = a.x; w[j][1] = a.y; w[j][2] = a.z; w[j][3] = a.w; w[j][4] = b.x; w[j][5] = b.y; w[j][6] = b.z; w[j][7] = b.w;
    }
    const float oscale = (col0 >= 512) ? 0.08838834764831845f : 1.0f;
    const int r0 = ci * 64 + rg * 32;
    int t = r0 % L;
    float xw[3][8];
#pragma unroll
    for (int j = 0; j < 3; ++j) {
        const int back = 3 - j;
        if (t - back >= 0) {
            const uint4 v = *(const uint4*)(z + (size_t)(r0 - back) * NZ + col0);
            xw[j][0] = bflo(v.x); xw[j][1] = bfhi(v.x); xw[j][2] = bflo(v.y); xw[j][3] = bfhi(v.y); xw[j][4] = bflo(v.z); xw[j][5] = bfhi(v.z); xw[j][6] = bflo(v.w); xw[j][7] = bfhi(v.w);
        } else {
#pragma unroll
            for (int e = 0; e < 8; ++e) xw[j][e] = 0.f;
        }
    }
#pragma unroll 2
    for (int i = 0; i < 32; ++i) {
        const int r = r0 + i;
        if (t == 0) {
#pragma unroll
            for (int j = 0; j < 3; ++j)
#pragma unroll
                for (int e = 0; e < 8; ++e) xw[j][e] = 0.f;
        }
        const uint4 v = *(const uint4*)(z + (size_t)r * NZ + col0);
        float xt[8];
        xt[0] = bflo(v.x); xt[1] = bfhi(v.x); xt[2] = bflo(v.y); xt[3] = bfhi(v.y); xt[4] = bflo(v.z); xt[5] = bfhi(v.z); xt[6] = bflo(v.w); xt[7] = bfhi(v.w);
        float o[8];
#pragma unroll
        for (int e = 0; e < 8; ++e) {
            const float cv = w[0][e] * xw[0][e] + w[1][e] * xw[1][e] + w[2][e] * xw[2][e] + w[3][e] * xt[e];
            o[e] = oscale * cv / (1.f + __expf(-cv));
            xw[0][e] = xw[1][e]; xw[1][e] = xw[2][e]; xw[2][e] = xt[e];
        }
        uint4 ov; ov.x = pk2(o[0], o[1]); ov.y = pk2(o[2], o[3]); ov.z = pk2(o[4], o[5]); ov.w = pk2(o[6], o[7]);
        *(uint4*)(qk + (size_t)r * 1024 + col0) = ov;
        t = (t + 1 == L) ? 0 : t + 1;
    }
}

constexpr int ST_IMG = 36864;
__device__ __forceinline__ int st_piece_off(int jt, int c, int g, int lr) { return (jt >> 2) * 18432 + vimg_off(16 * c + lr, 2 * (jt & 3) + (g >> 1)) + 8 * (g & 1); }

__device__ __forceinline__ void mlstm_stage_kv(const Params& P, int b, int h, int k, unsigned char* sKimg, unsigned char* sVimg, int tid) {
    const bf16_t* z = (const bf16_t*)(P.ws + WS_Z);
    const bf16_t* qk = (const bf16_t*)(P.ws + WS_RA);
    uint4 pk_[4], pv_[4];
#pragma unroll
    for (int j = 0; j < 4; ++j) {
        const int id = tid + 256 * j, row = id >> 4, ch16 = id & 15, pos = 64 * k + row;
        const bool ok = pos < L;
        pk_[j] = ok ? *(const uint4*)(qk + (size_t)(b * L + pos) * 1024 + 512 + h * 128 + ch16 * 8) : make_uint4(0, 0, 0, 0);
        pv_[j] = ok ? *(const uint4*)(z + (size_t)(b * L + pos) * NZ + ZC_MV + h * 128 + ch16 * 8) : make_uint4(0, 0, 0, 0);
    }
#pragma unroll
    for (int j = 0; j < 4; ++j) {
        const int id = tid + 256 * j, row = id >> 4, ch16 = id & 15;
        *(uint4*)(sKimg + (ch16 >> 3) * 8192 + vimg_off(row, ch16 & 7)) = pk_[j];
        *(uint4*)(sVimg + (ch16 >> 3) * 8192 + vimg_off(row, ch16 & 7)) = pv_[j];
    }
    if (tid < 128) {
        const int row = tid >> 1, ch = tid & 1;
        *(uint4*)(sVimg + 16384 + vimg_off(row, ch)) = ch ? make_uint4(0, 0, 0, 0) : make_uint4(0x3F80u, 0, 0, 0);
    }
}

__device__ __forceinline__ void mlstm_stage_A(const Params& P, int b, int h, int k, unsigned char* sKimg, unsigned char* sVimg, int tid) {
    const bf16_t* z = (const bf16_t*)(P.ws + WS_Z);
    bf16_t* qk = (bf16_t*)(P.ws + WS_RA);
    uint4 pv_[4];
#pragma unroll
    for (int j = 0; j < 4; ++j) {
        const int id = tid + 256 * j, row = id >> 4, ch16 = id & 15, pos = 64 * k + row;
        pv_[j] = (pos < L) ? *(const uint4*)(z + (size_t)(b * L + pos) * NZ + ZC_MV + h * 128 + ch16 * 8) : make_uint4(0, 0, 0, 0);
    }
    const int cch = tid & 31, rg = tid >> 5, isk = cch >> 4;
    const int zcol = (isk ? ZC_MK : ZC_MQ) + h * 128 + (cch & 15) * 8;
    float w[4][8];
#pragma unroll
    for (int j = 0; j < 4; ++j) {
        const float4 a = *(const float4*)(P.conv_qk + j * 1024 + zcol), c = *(const float4*)(P.conv_qk + j * 1024 + zcol + 4);
        w[j][0] = a.x; w[j][1] = a.y; w[j][2] = a.z; w[j][3] = a.w; w[j][4] = c.x; w[j][5] = c.y; w[j][6] = c.z; w[j][7] = c.w;
    }
    const float oscale = isk ? 0.08838834764831845f : 1.0f;
    const int p0 = 64 * k + 8 * rg;
    uint4 raw[11];
#pragma unroll
    for (int i = 0; i < 11; ++i) {
        const int pos = p0 - 3 + i;
        raw[i] = (pos >= 0 && pos < L) ? *(const uint4*)(z + (size_t)(b * L + pos) * NZ + zcol) : make_uint4(0, 0, 0, 0);
    }
#pragma unroll
    for (int j = 0; j < 4; ++j) {
        const int id = tid + 256 * j, row = id >> 4, ch16 = id & 15;
        *(uint4*)(sVimg + (ch16 >> 3) * 8192 + vimg_off(row, ch16 & 7)) = pv_[j];
    }
    if (tid < 128) {
        const int row = tid >> 1, ch = tid & 1;
        *(uint4*)(sVimg + 16384 + vimg_off(row, ch)) = ch ? make_uint4(0, 0, 0, 0) : make_uint4(0x3F80u, 0, 0, 0);
    }
#pragma unroll
    for (int i = 0; i < 8; ++i) {
        const int pos = p0 + i, row = 8 * rg + i;
        float o[8];
#pragma unroll
        for (int e = 0; e < 8; ++e) {
            const unsigned w0 = (&raw[i].x)[e >> 1], w1 = (&raw[i + 1].x)[e >> 1], w2 = (&raw[i + 2].x)[e >> 1], w3 = (&raw[i + 3].x)[e >> 1];
            const float x0 = (e & 1) ? bfhi(w0) : bflo(w0), x1 = (e & 1) ? bfhi(w1) : bflo(w1), x2 = (e & 1) ? bfhi(w2) : bflo(w2), x3 = (e & 1) ? bfhi(w3) : bflo(w3);
            const float cv = w[0][e] * x0 + w[1][e] * x1 + w[2][e] * x2 + w[3][e] * x3;
            o[e] = oscale * cv / (1.f + __expf(-cv));
        }
        uint4 ov; ov.x = pk2(o[0], o[1]); ov.y = pk2(o[2], o[3]); ov.z = pk2(o[4], o[5]); ov.w = pk2(o[6], o[7]);
        const bool ok = pos < L;
        if (!ok) ov = make_uint4(0, 0, 0, 0);
        if (ok) *(uint4*)(qk + (size_t)(b * L + pos) * 1024 + (isk ? 512 : 0) + h * 128 + (cch & 15) * 8) = ov;
        if (isk) { const int ch16 = cch & 15; *(uint4*)(sKimg + (ch16 >> 3) * 8192 + vimg_off(row, ch16 & 7)) = ov; }
    }
}

__device__ __forceinline__ void mlstm_A(const Params& P, int item, unsigned char* smem) {
    const int tid = opaque_tid(), lane = tid & 63, w = tid >> 6, g = lane >> 4, lr = lane & 15;
    const int wu = __builtin_amdgcn_readfirstlane(w);
    const int k = item >> 5, bh = item & 31, b = bh >> 2, h = bh & 3;
    const float* gates = (const float*)(P.ws + WS_GATES);
    const unsigned char* sK = smem; const unsigned char* sV = smem + 16384;
    float* ga = (float*)(smem + 40960);
    mlstm_stage_A(P, b, h, k, smem, smem + 16384, tid);
    if (wu == 0) {
        const int pos = 64 * k + lane;
        float lf = 0.f, li = -INFINITY;
        if (pos < L) { lf = gates[(size_t)(b * L + pos) * 16 + 4 + h]; li = gates[(size_t)(b * L + pos) * 16 + h]; }
        float bc = lf;
#pragma unroll
        for (int o = 1; o < 64; o <<= 1) { const float n = __shfl_up(bc, o, 64); if (lane >= o) bc += n; }
        const float a = li - bc;
        const float A = wave_max(a);
        ga[lane] = __expf(a - A);
        if (lane == 63) { float* msc = (float*)(P.ws + WS_MSC) + ((size_t)bh * 33 + k) * 4; msc[0] = A; msc[1] = bc; }
    }
    __syncthreads();
    f32x4 Ct[2][9];
#pragma unroll
    for (int a = 0; a < 2; ++a)
#pragma unroll
        for (int c = 0; c < 9; ++c) Ct[a][c] = (f32x4){0.f, 0.f, 0.f, 0.f};
    bf16x8 kt[2][2];
#pragma unroll
    for (int a = 0; a < 2; ++a)
#pragma unroll
        for (int s2 = 0; s2 < 2; ++s2) {
            const int jt = 2 * w + a;
            kt[a][s2] = tr_pair(tr_frag(sK + (jt >> 2) * 8192, 32 * s2, jt & 3, g, lr), tr_frag(sK + (jt >> 2) * 8192, 32 * s2 + 16, jt & 3, g, lr));
        }
    f32x4 wg4[4];
#pragma unroll
    for (int j = 0; j < 4; ++j) wg4[j] = *(const f32x4*)(ga + 16 * j + 4 * g);
#define MA_TILE(c, lo0, hi0, lo1, hi1) { \
        { const f32x4 w0 = wg4[0], w1 = wg4[1]; uint4 o; \
          o.x = cvt_pk_bf16(bflo(lo0.x) * w0[0], bfhi(lo0.x) * w0[1]); o.y = cvt_pk_bf16(bflo(lo0.y) * w0[2], bfhi(lo0.y) * w0[3]); \
          o.z = cvt_pk_bf16(bflo(hi0.x) * w1[0], bfhi(hi0.x) * w1[1]); o.w = cvt_pk_bf16(bflo(hi0.y) * w1[2], bfhi(hi0.y) * w1[3]); \
          const bf16x8 vw = __builtin_bit_cast(bf16x8, o); \
          Ct[0][c] = __builtin_amdgcn_mfma_f32_16x16x32_bf16(kt[0][0], vw, Ct[0][c], 0, 0, 0); Ct[1][c] = __builtin_amdgcn_mfma_f32_16x16x32_bf16(kt[1][0], vw, Ct[1][c], 0, 0, 0); } \
        { const f32x4 w0 = wg4[2], w1 = wg4[3]; uint4 o; \
          o.x = cvt_pk_bf16(bflo(lo1.x) * w0[0], bfhi(lo1.x) * w0[1]); o.y = cvt_pk_bf16(bflo(lo1.y) * w0[2], bfhi(lo1.y) * w0[3]); \
          o.z = cvt_pk_bf16(bflo(hi1.x) * w1[0], bfhi(hi1.x) * w1[1]); o.w = cvt_pk_bf16(bflo(hi1.y) * w1[2], bfhi(hi1.y) * w1[3]); \
          const bf16x8 vw = __builtin_bit_cast(bf16x8, o); \
          Ct[0][c] = __builtin_amdgcn_mfma_f32_16x16x32_bf16(kt[0][1], vw, Ct[0][c], 0, 0, 0); Ct[1][c] = __builtin_amdgcn_mfma_f32_16x16x32_bf16(kt[1][1], vw, Ct[1][c], 0, 0, 0); } }
    {
        uint2 vr[4][4];
        tr_read_4c(sV, g, lr, vr);
        MA_TILE(0, vr[0][0], vr[0][1], vr[0][2], vr[0][3]) MA_TILE(1, vr[1][0], vr[1][1], vr[1][2], vr[1][3])
        MA_TILE(2, vr[2][0], vr[2][1], vr[2][2], vr[2][3]) MA_TILE(3, vr[3][0], vr[3][1], vr[3][2], vr[3][3])
        tr_read_4c(sV + 8192, g, lr, vr);
        MA_TILE(4, vr[0][0], vr[0][1], vr[0][2], vr[0][3]) MA_TILE(5, vr[1][0], vr[1][1], vr[1][2], vr[1][3])
        MA_TILE(6, vr[2][0], vr[2][1], vr[2][2], vr[2][3]) MA_TILE(7, vr[3][0], vr[3][1], vr[3][2], vr[3][3])
        const uint2 o0 = tr_frag(sV + 16384, 0, 0, g, lr), o1 = tr_frag(sV + 16384, 16, 0, g, lr), o2 = tr_frag(sV + 16384, 32, 0, g, lr), o3 = tr_frag(sV + 16384, 48, 0, g, lr);
        MA_TILE(8, o0, o1, o2, o3)
    }
#undef MA_TILE
    unsigned char* slot = P.ws + WS_MST + ((size_t)bh * 33 + k) * ST_IMG;
#pragma unroll
    for (int a = 0; a < 2; ++a)
#pragma unroll
        for (int c = 0; c < 9; ++c) {
            uint2 u; u.x = cvt_pk_bf16(Ct[a][c][0], Ct[a][c][1]); u.y = cvt_pk_bf16(Ct[a][c][2], Ct[a][c][3]);
            *(uint2*)(slot + st_piece_off(2 * w + a, c, g, lr)) = u;
        }
}

__device__ __forceinline__ void mlstm_B(const Params& P, int item) {
    const int tid = opaque_tid();
    const int bh = item / 3, part = item - bh * 3;
    const unsigned char* base = P.ws + WS_MST + (size_t)bh * 33 * ST_IMG + part * 12288 + tid * 48;
    unsigned char* obase = P.ws + WS_CBI + (size_t)bh * 33 * ST_IMG + part * 12288 + tid * 48;
    float* msc = (float*)(P.ws + WS_MSC) + (size_t)bh * 33 * 4;
    float C[6][4];
#pragma unroll
    for (int i = 0; i < 6; ++i)
#pragma unroll
        for (int r = 0; r < 4; ++r) C[i][r] = 0.f;
    float m = 0.f;
    uint2 d0[6], d1[6];
    float2 ab0, ab1;
#pragma unroll
    for (int i = 0; i < 6; ++i) { d0[i] = *(const uint2*)(base + i * 8); d1[i] = *(const uint2*)(base + ST_IMG + i * 8); }
    ab0 = *(const float2*)(msc); ab1 = *(const float2*)(msc + 4);
    for (int k = 0; k < 33; ++k) {
        uint2 d2[6]; float2 ab2 = make_float2(0.f, 0.f);
        if (k + 2 < 33) {
#pragma unroll
            for (int i = 0; i < 6; ++i) d2[i] = *(const uint2*)(base + (size_t)(k + 2) * ST_IMG + i * 8);
            ab2 = *(const float2*)(msc + (k + 2) * 4);
        } else {
#pragma unroll
            for (int i = 0; i < 6; ++i) d2[i] = make_uint2(0, 0);
        }
#pragma unroll
        for (int i = 0; i < 6; ++i) {
            uint2 u; u.x = cvt_pk_bf16(C[i][0], C[i][1]); u.y = cvt_pk_bf16(C[i][2], C[i][3]);
            *(uint2*)(obase + (size_t)k * ST_IMG + i * 8) = u;
        }
        if (tid == 0 && part == 0) msc[k * 4 + 2] = m;
        const float M = fmaxf(m, ab0.x);
        const float decay = __expf(m - M), sc = __expf(ab0.x - M);
#pragma unroll
        for (int i = 0; i < 6; ++i) {
            C[i][0] = decay * C[i][0] + sc * bflo(d0[i].x); C[i][1] = decay * C[i][1] + sc * bfhi(d0[i].x);
            C[i][2] = decay * C[i][2] + sc * bflo(d0[i].y); C[i][3] = decay * C[i][3] + sc * bfhi(d0[i].y);
        }
        m = ab0.y + M;
#pragma unroll
        for (int i = 0; i < 6; ++i) { d0[i] = d1[i]; d1[i] = d2[i]; }
        ab0 = ab1; ab1 = ab2;
    }
}

__device__ __forceinline__ void mlstm_C(const Params& P, int item, unsigned char* smem) {
    const int tid = opaque_tid(), lane = tid & 63, w = tid >> 6, g = lane >> 4, lr = lane & 15;
    const int wu = __builtin_amdgcn_readfirstlane(w);
    const int k = item >> 5, bh = item & 31, b = bh >> 2, h = bh & 3;
    const bf16_t* z = (const bf16_t*)(P.ws + WS_Z);
    const bf16_t* qk = (const bf16_t*)(P.ws + WS_RA);
    const float* gates = (const float*)(P.ws + WS_GATES);
    bf16_t* y = (bf16_t*)(P.ws + WS_Z);
    const unsigned char* sK = smem; const unsigned char* sV = smem + 36864; unsigned char* sCb = smem;
    float* ga = (float*)(smem + 61440);
    const int pos = 64 * k + 16 * w + lr;
    const bool tvalid = pos < L;
    const size_t rrow = (size_t)(b * L + (tvalid ? pos : 0));
    const unsigned char* cslot = P.ws + WS_CBI + ((size_t)bh * 33 + k) * ST_IMG + tid * 16;
    const uint4 cb0 = *(const uint4*)(cslot), cb1 = *(const uint4*)(cslot + 4096), cb2 = *(const uint4*)(cslot + 8192), cb3 = *(const uint4*)(cslot + 12288), cb4 = *(const uint4*)(cslot + 16384),
                cb5 = *(const uint4*)(cslot + 20480), cb6 = *(const uint4*)(cslot + 24576), cb7 = *(const uint4*)(cslot + 28672), cb8 = *(const uint4*)(cslot + 32768);
    bf16x8 qf[4];
    {
        const bf16_t* qp = qk + rrow * 1024 + h * 128 + 8 * g;
#pragma unroll
        for (int ks = 0; ks < 4; ++ks) { qf[ks] = *(const bf16x8*)(qp + 32 * ks); if (!tvalid) qf[ks] = (bf16x8){0, 0, 0, 0, 0, 0, 0, 0}; }
    }
    mlstm_stage_kv(P, b, h, k, smem, smem + 36864, tid);
    if (wu == 0) {
        const float m_prev = ((const float*)(P.ws + WS_MSC))[((size_t)bh * 33 + k) * 4 + 2];
        const int p2 = 64 * k + lane;
        float lf = 0.f, li = -INFINITY;
        if (p2 < L) { lf = gates[(size_t)(b * L + p2) * 16 + 4 + h]; li = gates[(size_t)(b * L + p2) * 16 + h]; }
        float bc = lf;
#pragma unroll
        for (int o = 1; o < 64; o <<= 1) { const float n = __shfl_up(bc, o, 64); if (lane >= o) bc += n; }
        const float a = li - bc;
        float am = a;
#pragma unroll
        for (int o = 1; o < 64; o <<= 1) { const float n = __shfl_up(am, o, 64); if (lane >= o) am = fmaxf(am, n); }
        const float M = fmaxf(m_prev, am);
        ga[lane] = a; ga[64 + lane] = __expf(m_prev - M); ga[128 + lane] = __expf(-(bc + M)); ga[192 + lane] = M;
    }
    __syncthreads();
    const float Mt = ga[192 + 16 * w + lr], Wi = ga[64 + 16 * w + lr], Et = ga[128 + 16 * w + lr];
    bf16x8 pf[2];
    {
        f32x4 sa[4];
#pragma unroll
        for (int c = 0; c < 4; ++c) {
            sa[c] = (f32x4){0.f, 0.f, 0.f, 0.f};
            if (c <= wu) {
#pragma unroll
                for (int ks = 0; ks < 4; ++ks) {
                    const bf16x8 kf = *(const bf16x8*)(sK + (ks >> 1) * 8192 + vimg_off(16 * c + lr, 4 * (ks & 1) + g));
                    sa[c] = __builtin_amdgcn_mfma_f32_16x16x32_bf16(kf, qf[ks], sa[c], 0, 0, 0);
                }
                const f32x4 av = *(const f32x4*)(ga + 16 * c + 4 * g);
#pragma unroll
                for (int r = 0; r < 4; ++r) {
                    const float d = __expf(av[r] - Mt);
                    sa[c][r] = (16 * c + 4 * g + r <= 16 * w + lr) ? sa[c][r] * d : 0.f;
                }
            }
        }
#pragma unroll
        for (int s2 = 0; s2 < 2; ++s2) {
            uint4 u;
            u.x = cvt_pk_bf16(sa[2 * s2][0], sa[2 * s2][1]); u.y = cvt_pk_bf16(sa[2 * s2][2], sa[2 * s2][3]);
            u.z = cvt_pk_bf16(sa[2 * s2 + 1][0], sa[2 * s2 + 1][1]); u.w = cvt_pk_bf16(sa[2 * s2 + 1][2], sa[2 * s2 + 1][3]);
            pf[s2] = __builtin_bit_cast(bf16x8, u);
        }
    }
    __syncthreads();
    {
        unsigned char* d = sCb + tid * 16;
        *(uint4*)(d) = cb0; *(uint4*)(d + 4096) = cb1; *(uint4*)(d + 8192) = cb2; *(uint4*)(d + 12288) = cb3; *(uint4*)(d + 16384) = cb4;
        *(uint4*)(d + 20480) = cb5; *(uint4*)(d + 24576) = cb6; *(uint4*)(d + 28672) = cb7; *(uint4*)(d + 32768) = cb8;
    }
    __syncthreads();
    f32x4 na[9];
#define MC_TILE(c, lo0, hi0, lo1, hi1) { \
        na[c] = (f32x4){0.f, 0.f, 0.f, 0.f}; \
        _Pragma("unroll") for (int ks = 0; ks < 4; ++ks) { \
            const bf16x8 cf = *(const bf16x8*)(sCb + (ks >> 1) * 18432 + vimg_off(16 * (c) + lr, 4 * (ks & 1) + g)); \
            na[c] = __builtin_amdgcn_mfma_f32_16x16x32_bf16(cf, qf[ks], na[c], 0, 0, 0); } \
        na[c] *= Wi; \
        na[c] = __builtin_amdgcn_mfma_f32_16x16x32_bf16(tr_pair(lo0, hi0), pf[0], na[c], 0, 0, 0); \
        na[c] = __builtin_amdgcn_mfma_f32_16x16x32_bf16(tr_pair(lo1, hi1), pf[1], na[c], 0, 0, 0); }
    {
        uint2 vr[4][4];
        tr_read_4c(sV, g, lr, vr);
        MC_TILE(0, vr[0][0], vr[0][1], vr[0][2], vr[0][3]) MC_TILE(1, vr[1][0], vr[1][1], vr[1][2], vr[1][3])
        MC_TILE(2, vr[2][0], vr[2][1], vr[2][2], vr[2][3]) MC_TILE(3, vr[3][0], vr[3][1], vr[3][2], vr[3][3])
        tr_read_4c(sV + 8192, g, lr, vr);
        MC_TILE(4, vr[0][0], vr[0][1], vr[0][2], vr[0][3]) MC_TILE(5, vr[1][0], vr[1][1], vr[1][2], vr[1][3])
        MC_TILE(6, vr[2][0], vr[2][1], vr[2][2], vr[2][3]) MC_TILE(7, vr[3][0], vr[3][1], vr[3][2], vr[3][3])
        const uint2 o0 = tr_frag(sV + 16384, 0, 0, g, lr), o1 = tr_frag(sV + 16384, 16, 0, g, lr), o2 = tr_frag(sV + 16384, 32, 0, g, lr), o3 = tr_frag(sV + 16384, 48, 0, g, lr);
        MC_TILE(8, o0, o1, o2, o3)
    }
#undef MC_TILE
    const float den = __shfl(na[8][0], lr, 64);
    const float rden = 1.0f / fmaxf(fabsf(den), Et);
    float hs = 0.f;
#pragma unroll
    for (int c = 0; c < 8; ++c) { na[c] *= rden; hs += na[c][0] * na[c][0] + na[c][1] * na[c][1] + na[c][2] * na[c][2] + na[c][3] * na[c][3]; }
    hs = x4_sum(hs);
    const float rstd = rsqrtf(hs * (1.0f / 128.0f) + EPS);
    const float* gainp = P.m_out_norm + h * 128 + 4 * g;
#pragma unroll
    for (int c = 0; c < 8; ++c) {
        const uint2 og = *(const uint2*)(z + rrow * NZ + ZC_MO + h * 128 + 16 * c + 4 * g);
        const float o0 = bflo(og.x), o1 = bfhi(og.x), o2 = bflo(og.y), o3 = bfhi(og.y);
        const float4 gn = *(const float4*)(gainp + 16 * c);
        uint2 u;
        u.x = pk2(na[c][0] * rstd * gn.x / (1.f + __expf(-o0)), na[c][1] * rstd * gn.y / (1.f + __expf(-o1)));
        u.y = pk2(na[c][2] * rstd * gn.z / (1.f + __expf(-o2)), na[c][3] * rstd * gn.w / (1.f + __expf(-o3)));
        if (tvalid) *(uint2*)(y + rrow * NZ + h * 128 + 16 * c + 4 * g) = u;
    }
}

__device__ __forceinline__ void peer_token(const Params& P, int t, int lane, int* sidx, float* sval, int* sid, float* sgate, const unsigned char* slut, const unsigned* szero) {
    const unsigned* tk = (const unsigned*)(P.ws + WS_TK) + (size_t)t * 256;
#pragma unroll
    for (int i = 0; i < 4; ++i) {
        const unsigned k = tk[lane * 4 + i];
        sidx[lane * 4 + i] = 127 - (int)(k & 127u);
        sval[lane * 4 + i] = unord_key(k & ~127u);
    }
    __builtin_amdgcn_s_waitcnt(0xc07f);
    __builtin_amdgcn_wave_barrier();
    {
        const int hd = lane >> 3, sub = lane & 7;
        unsigned x[8];
#pragma unroll
        for (int r = 0; r < 8; ++r) {
            const int c = sub * 8 + r;
            const unsigned ij = slut[c < 50 ? c : 0];
            const int i = ij >> 4, j = ij & 15;
            const unsigned kx = (ord_key(sval[(2 * hd) * 16 + i] + sval[(2 * hd + 1) * 16 + j]) & ~255u) | (unsigned)(255 - (i * 16 + j));
            x[r] = c < 50 ? kx : 0u;
        }
#pragma unroll
        for (int k = 2; k <= 64; k <<= 1) {
#pragma unroll
            for (int j = k >> 1; j >= 1; j >>= 1) {
                if (j >= 8) {
                    const int ld = j >> 3;
                    const bool lower = (sub & ld) == 0;
                    const bool desc = k >= 64 ? true : ((sub * 8) & k) == 0;
                    const bool takemax = (lower == desc);
#pragma unroll
                    for (int r = 0; r < 8; ++r) {
                        const unsigned o = (unsigned)__shfl_xor((int)x[r], ld, 64);
                        const unsigned hi = max(x[r], o), lo = min(x[r], o);
                        x[r] = takemax ? hi : lo;
                    }
                } else {
#pragma unroll
                    for (int r = 0; r < 8; ++r) {
                        if ((r & j) == 0) {
                            const int p = r | j;
                            const unsigned hi = max(x[r], x[p]), lo = min(x[r], x[p]);
                            if (k <= 4) { const bool desc = (r & k) == 0; x[r] = desc ? hi : lo; x[p] = desc ? lo : hi; }
                            else if (k >= 64) { x[r] = hi; x[p] = lo; }
                            else { const bool desc = ((sub * 8) & k) == 0; x[r] = desc ? hi : lo; x[p] = desc ? lo : hi; }
                        }
                    }
                }
            }
        }
        const float smax = unord_key((unsigned)__shfl((int)x[0], hd * 8, 64) & ~255u);
        float e[8]; float den = 0.f;
#pragma unroll
        for (int r = 0; r < 8; ++r) { e[r] = __expf(unord_key(x[r] & ~255u) - smax); den += e[r]; }
        den += __shfl_xor(den, 1, 64);
        const float inv = 1.f / den;
        if (sub < 2) {
#pragma unroll
            for (int r = 0; r < 8; ++r) {
                const int pos = 255 - (int)(x[r] & 255u), i = pos >> 4, j = pos & 15;
                sid[hd * 16 + sub * 8 + r] = sidx[(2 * hd) * 16 + i] * 128 + sidx[(2 * hd + 1) * 16 + j];
                sgate[hd * 16 + sub * 8 + r] = e[r] * inv;
            }
        }
    }
    __builtin_amdgcn_s_waitcnt(0xc07f);
    __builtin_amdgcn_wave_barrier();
    const bf16_t* xn = (const bf16_t*)(P.ws + WS_XN) + (size_t)t * DM;
    const float rstd = ((const float*)(P.ws + WS_RSTD))[t];
    const unsigned char* V = P.ws + WS_V + lane * 8;
    const float* usc = (const float*)(P.ws + WS_USC);
    const float* vsc = (const float*)(P.ws + WS_VSC);
    const int g = lane >> 4, lr = lane & 15;
    unsigned char* shi = (unsigned char*)sval;
    unsigned char* slo = (unsigned char*)sidx;
    {
        const uint4 xa = *(const uint4*)(xn + lane * 16), xb = *(const uint4*)(xn + lane * 16 + 8);
        const unsigned xw[8] = {xa.x, xa.y, xa.z, xa.w, xb.x, xb.y, xb.z, xb.w};
        unsigned hi[4], lo[4];
#pragma unroll
        for (int i = 0; i < 4; ++i) {
            const float x0 = bflo(xw[2 * i]), x1 = bfhi(xw[2 * i]), x2 = bflo(xw[2 * i + 1]), x3 = bfhi(xw[2 * i + 1]);
            int wd = 0;
            wd = __builtin_amdgcn_cvt_pk_fp8_f32(x0, x1, wd, false);
            wd = __builtin_amdgcn_cvt_pk_fp8_f32(x2, x3, wd, true);
            const f32x2 h01 = __builtin_amdgcn_cvt_pk_f32_fp8(wd, false), h23 = __builtin_amdgcn_cvt_pk_f32_fp8(wd, true);
            int wl = 0;
            wl = __builtin_amdgcn_cvt_pk_fp8_f32(x0 - h01.x, x1 - h01.y, wl, false);
            wl = __builtin_amdgcn_cvt_pk_fp8_f32(x2 - h23.x, x3 - h23.y, wl, true);
            hi[i] = (unsigned)wd; lo[i] = (unsigned)wl;
        }
        *(uint4*)(shi + lane * 16) = make_uint4(hi[0], hi[1], hi[2], hi[3]);
        *(uint4*)(slo + lane * 16) = make_uint4(lo[0], lo[1], lo[2], lo[3]);
    }
    __builtin_amdgcn_s_waitcnt(0xc07f);
    __builtin_amdgcn_wave_barrier();
    {
        typedef int v8i __attribute__((ext_vector_type(8)));
        const unsigned char* Ub = P.ws + WS_U;
        const unsigned lofs = 64u * (unsigned)(lr >> 3) + 16u * (unsigned)g;
        const unsigned char* bsrc = (lr < 4) ? (((lr & 2) ? slo : shi) + 128 * (lr & 1) + 16 * g) : (const unsigned char*)szero;
        const int bstep = (lr < 4) ? 256 : 0, bhalf = (lr < 4) ? 64 : 16;
        v8i Bv[4];
#pragma unroll
        for (int st = 0; st < 4; ++st) {
            const uint4 b0 = *(const uint4*)(bsrc + bstep * st), b1 = *(const uint4*)(bsrc + bstep * st + bhalf);
            Bv[st] = (v8i){(int)b0.x, (int)b0.y, (int)b0.z, (int)b0.w, (int)b1.x, (int)b1.y, (int)b1.z, (int)b1.w};
        }
        __builtin_amdgcn_s_waitcnt(0xc07f);
        __builtin_amdgcn_wave_barrier();
        float* sact = (float*)sidx + 128 * (lr & 3) + 4 * (g & 1);
        const bool owner = (lr < 4) && ((g >> 1) == (lr & 1));
        uint4 abuf[2][2][4];
        unsigned off2[2];
#pragma unroll
        for (int hh = 0; hh < 2; ++hh) off2[hh] = (unsigned)sid[8 * hh + (lr & 7)] * 512u + lofs;
#pragma unroll
        for (int hh = 0; hh < 2; ++hh)
#pragma unroll
            for (int st = 0; st < 4; ++st) abuf[0][hh][st] = *(const uint4*)(Ub + (off2[hh] + 128 * st));
#pragma unroll
        for (int T = 0; T < 8; ++T) {
            if (T + 1 < 8) {
#pragma unroll
                for (int hh = 0; hh < 2; ++hh) off2[hh] = (unsigned)sid[16 * (T + 1) + 8 * hh + (lr & 7)] * 512u + lofs;
#pragma unroll
                for (int hh = 0; hh < 2; ++hh)
#pragma unroll
                    for (int st = 0; st < 4; ++st) abuf[(T + 1) & 1][hh][st] = *(const uint4*)(Ub + (off2[hh] + 128 * st));
            }
#pragma unroll
            for (int hh = 0; hh < 2; ++hh) {
                f32x4 au = (f32x4){0.f, 0.f, 0.f, 0.f};
#pragma unroll
                for (int st = 0; st < 4; ++st) {
                    const uint4 a4 = abuf[T & 1][hh][st];
                    const v8i Av = {(int)a4.x, (int)a4.y, (int)a4.z, (int)a4.w, 0, 0, 0, 0};
                    au = __builtin_amdgcn_mfma_scale_f32_16x16x128_f8f6f4(Av, Bv[st], au, 4, 0, 0, 0x7f7f7f7f, 0, 0x7f7f7f7f);
                }
                if (owner) *(f32x4*)(sact + 16 * T + 8 * hh) = au;
            }
        }
    }
    __builtin_amdgcn_s_waitcnt(0xc07f);
    __builtin_amdgcn_wave_barrier();
    {
        float* sw = (float*)sidx;
        float wv[2];
#pragma unroll
        for (int hh = 0; hh < 2; ++hh) {
            const int e = lane + 64 * hh, id = sid[e];
            const float a = ((sw[e] + sw[128 + e]) + (sw[256 + e] + sw[384 + e])) * usc[id] * rstd;
            wv[hh] = sgate[e] * vsc[id] * 0.5f * a * (1.f + erff(a * 0.70710678118654752f));
        }
        __builtin_amdgcn_s_waitcnt(0xc07f);
        __builtin_amdgcn_wave_barrier();
        sw[lane] = wv[0]; sw[lane + 64] = wv[1];
    }
    __builtin_amdgcn_s_waitcnt(0xc07f);
    __builtin_amdgcn_wave_barrier();
    const int half = lane >> 5, l5 = lane & 31;
    const int lane_o = 2 * l5 + half;
    f32x2 acc2[16];
#pragma unroll
    for (int j = 0; j < 16; ++j) acc2[j] = (f32x2){0.f, 0.f};
    const unsigned char* Vb = P.ws + WS_V;
    const unsigned vlo = (unsigned)l5 * 16u;
#pragma unroll 1
    for (int e0 = 0; e0 < 128; e0 += 16) {
        uint4 vr[8];
#pragma unroll
        for (int q = 0; q < 8; ++q) vr[q] = *(const uint4*)(Vb + ((unsigned)sid[e0 + 2 * q + half] * 512u + vlo));
        const float* sw = (const float*)sidx + e0;
        const f32x4 w0 = *(const f32x4*)(sw), w1 = *(const f32x4*)(sw + 4), w2 = *(const f32x4*)(sw + 8), w3 = *(const f32x4*)(sw + 12);
        const float wq[16] = {w0[0], w0[1], w0[2], w0[3], w1[0], w1[1], w1[2], w1[3], w2[0], w2[1], w2[2], w2[3], w3[0], w3[1], w3[2], w3[3]};
#pragma unroll
        for (int q = 0; q < 8; ++q) {
            const float w = half ? wq[2 * q + 1] : wq[2 * q];
#define FP4_AXPY(k) { acc2[k] += w * __builtin_amdgcn_cvt_scalef32_pk_f32_fp4(vr[q].x, 1.0f, k); acc2[4 + k] += w * __builtin_amdgcn_cvt_scalef32_pk_f32_fp4(vr[q].y, 1.0f, k); \
                      acc2[8 + k] += w * __builtin_amdgcn_cvt_scalef32_pk_f32_fp4(vr[q].z, 1.0f, k); acc2[12 + k] += w * __builtin_amdgcn_cvt_scalef32_pk_f32_fp4(vr[q].w, 1.0f, k); }
            FP4_AXPY(0) FP4_AXPY(1) FP4_AXPY(2) FP4_AXPY(3)
#undef FP4_AXPY
        }
    }
    f32x2 acc[8];
#pragma unroll
    for (int j = 0; j < 16; ++j) {
        const unsigned x0 = __float_as_uint(acc2[j].x), x1 = __float_as_uint(acc2[j].y);
        const auto r0 = __builtin_amdgcn_permlane32_swap(x0, x0, false, false);
        const auto r1 = __builtin_amdgcn_permlane32_swap(x1, x1, false, false);
        acc2[j].x = __uint_as_float(r0[0]) + __uint_as_float(r0[1]);
        acc2[j].y = __uint_as_float(r1[0]) + __uint_as_float(r1[1]);
    }
#pragma unroll
    for (int j = 0; j < 8; ++j) { acc[j].x = half ? acc2[8 + j].x : acc2[j].x; acc[j].y = half ? acc2[8 + j].y : acc2[j].y; }
    f32x2 xf[8];
    {
        const uint4 xa = *(const uint4*)(xn + lane_o * 16), xb = *(const uint4*)(xn + lane_o * 16 + 8);
        xf[0] = (f32x2){bflo(xa.x), bfhi(xa.x)}; xf[1] = (f32x2){bflo(xa.y), bfhi(xa.y)}; xf[2] = (f32x2){bflo(xa.z), bfhi(xa.z)}; xf[3] = (f32x2){bflo(xa.w), bfhi(xa.w)};
        xf[4] = (f32x2){bflo(xb.x), bfhi(xb.x)}; xf[5] = (f32x2){bflo(xb.y), bfhi(xb.y)}; xf[6] = (f32x2){bflo(xb.z), bfhi(xb.z)}; xf[7] = (f32x2){bflo(xb.w), bfhi(xb.w)};
    }
    float* o = P.out + (size_t)t * DM + lane_o * 16;
    float4 h0, h1, h2, h3;
    {
        const float4 g0 = *(const float4*)(P.norm_ffn + lane_o * 16), g1 = *(const float4*)(P.norm_ffn + lane_o * 16 + 4), g2 = *(const float4*)(P.norm_ffn + lane_o * 16 + 8), g3 = *(const float4*)(P.norm_ffn + lane_o * 16 + 12);
        h0.x = xf[0].x / g0.x + acc[0].x; h0.y = xf[0].y / g0.y + acc[0].y; h0.z = xf[1].x / g0.z + acc[1].x; h0.w = xf[1].y / g0.w + acc[1].y;
        h1.x = xf[2].x / g1.x + acc[2].x; h1.y = xf[2].y / g1.y + acc[2].y; h1.z = xf[3].x / g1.z + acc[3].x; h1.w = xf[3].y / g1.w + acc[3].y;
        h2.x = xf[4].x / g2.x + acc[4].x; h2.y = xf[4].y / g2.y + acc[4].y; h2.z = xf[5].x / g2.z + acc[5].x; h2.w = xf[5].y / g2.w + acc[5].y;
        h3.x = xf[6].x / g3.x + acc[6].x; h3.y = xf[6].y / g3.y + acc[6].y; h3.z = xf[7].x / g3.z + acc[7].x; h3.w = xf[7].y / g3.w + acc[7].y;
    }
    *(float4*)(o) = h0; *(float4*)(o + 4) = h1; *(float4*)(o + 8) = h2; *(float4*)(o + 12) = h3;
    __builtin_amdgcn_s_waitcnt(0xc07f);
    __builtin_amdgcn_wave_barrier();
}

#define LAS __attribute__((address_space(3)))
#define XB_TMO      128
#define XB_XCNT(j)  (256  + 64 * (j))
#define XB_XSUB(j)  (1280 + 64 * (j))
#define XB_XGEN(j)  (2304 + 64 * (j))
#define XB_TOP      3328
#define XB_TOPGEN   3392
#define XCD_BAR_WORDS 3456
#define XB_SPIN_CAP (1u << 18)
__device__ __forceinline__ unsigned xb_ld(unsigned* p)              { return __hip_atomic_load(p, __ATOMIC_RELAXED, __HIP_MEMORY_SCOPE_AGENT); }
__device__ __forceinline__ unsigned xb_add(unsigned* p, unsigned v) { return __hip_atomic_fetch_add(p, v, __ATOMIC_RELAXED, __HIP_MEMORY_SCOPE_AGENT); }
__device__ __forceinline__ unsigned xb_xcc_id() { return (unsigned)__builtin_amdgcn_s_getreg((3 << 11) | 20) & 0xFu; }
#define XB_SPIN(cond, bar) do { unsigned _sp = 0; while (cond) { __builtin_amdgcn_s_sleep(1); \
    if ((++_sp & 255u) == 0u) { if (xb_ld(&(bar)[XB_TMO])) break; if (_sp > XB_SPIN_CAP) { atomicAdd(&(bar)[XB_TMO], 1u); break; } } } } while (0)
struct XcdBarrier { unsigned* bar; unsigned x; volatile LAS unsigned* st; };
__device__ __forceinline__ XcdBarrier xcd_barrier_post(unsigned* bar, volatile LAS unsigned* st) {
    XcdBarrier b; b.bar = bar; b.x = xb_xcc_id(); b.st = st;
    if (threadIdx.x == 0) (void)xb_add(&bar[XB_XCNT(b.x)], 1u);
    return b;
}
__device__ __forceinline__ void xcd_barrier_complete(unsigned* bar, unsigned x, unsigned& nloc, unsigned& nx) {
    const unsigned G = gridDim.x * gridDim.y * gridDim.z;
    unsigned sum, cnt, mine, sp = 0u;
    for (;;) {
        sum = 0u; cnt = 0u; mine = 0u;
#pragma unroll
        for (unsigned j = 0; j < 16; ++j) { const unsigned c = xb_ld(&bar[XB_XCNT(j)]); sum += c; cnt += (c > 0u) ? 1u : 0u; mine = (j == x) ? c : mine; }
        if (sum == G) break;
        __builtin_amdgcn_s_sleep(1);
        if ((++sp & 255u) == 0u) { if (xb_ld(&bar[XB_TMO])) break; if (sp > XB_SPIN_CAP) { atomicAdd(&bar[XB_TMO], 1u); break; } }
    }
    nloc = mine > 0u ? mine : 1u; nx = cnt > 0u ? cnt : 1u;
}
__device__ __forceinline__ void xcd_barrier(const XcdBarrier& b) {
    asm volatile("s_waitcnt vmcnt(0)" ::: "memory");
    __syncthreads();
    if (threadIdx.x == 0) {
        unsigned* bar = b.bar;
        __builtin_amdgcn_s_waitcnt(0);
        unsigned nloc = b.st[0], nx = b.st[1];
        if (nloc == 0u) { xcd_barrier_complete(bar, b.x, nloc, nx); b.st[0] = nloc; b.st[1] = nx; }
        const unsigned old = xb_add(&bar[XB_XSUB(b.x)], 1u);
        const unsigned gen = old / nloc;
        if (old + 1u == (gen + 1u) * nloc) {
            __builtin_amdgcn_fence(__ATOMIC_RELEASE, "agent");
            asm volatile("s_waitcnt vmcnt(0)" ::: "memory");
            const unsigned og = xb_add(&bar[XB_TOP], 1u);
            const unsigned tg = og / nx;
            if (og + 1u == (tg + 1u) * nx) xb_add(&bar[XB_TOPGEN], 1u);
            else XB_SPIN(xb_ld(&bar[XB_TOPGEN]) == tg, bar);
            __builtin_amdgcn_fence(__ATOMIC_ACQUIRE, "agent");
            xb_add(&bar[XB_XGEN(b.x)], 1u);
            asm volatile("s_waitcnt vmcnt(0)" ::: "memory");
        } else {
            XB_SPIN(xb_ld(&bar[XB_XGEN(b.x)]) == gen, bar);
            __builtin_amdgcn_fence(__ATOMIC_ACQUIRE, "agent");
            asm volatile("s_waitcnt vmcnt(0)" ::: "memory");
        }
    }
    __syncthreads();
}

__device__ __forceinline__ void hand_release() { asm volatile("s_waitcnt vmcnt(0)" ::: "memory"); __builtin_amdgcn_fence(__ATOMIC_RELEASE, "agent"); asm volatile("s_waitcnt vmcnt(0)" ::: "memory"); }
__device__ __forceinline__ void hand_acquire() { __builtin_amdgcn_fence(__ATOMIC_ACQUIRE, "agent"); asm volatile("s_waitcnt vmcnt(0)" ::: "memory"); }

__global__ void __launch_bounds__(256, 2) mega(Params P) {
    extern __shared__ __attribute__((aligned(16))) unsigned char smem[];
    const int tid = threadIdx.x, lane = tid & 63, wave = tid >> 6;
    const int G = gridDim.x, bid = blockIdx.x;
    unsigned* ctl = (unsigned*)(P.ws + WS_CTL);
    volatile LAS unsigned* bst = (volatile LAS unsigned*)(smem + 65552);
    if (tid == 0) { bst[0] = 0u; bst[1] = 0u; }
    __syncthreads();
    const XcdBarrier xb = xcd_barrier_post(ctl + 1024, bst);
    unsigned* cucnt = ctl + 5120;
    if (tid == 0) {
        const unsigned phys = ((xb_xcc_id() & 7u) << 8) | ((unsigned)__builtin_amdgcn_s_getreg((7 << 11) | (8 << 6) | 4) & 0xFFu);
        bst[2] = phys; bst[3] = xb_add(&cucnt[phys], 1u);
    }
    phase0(P, smem);
    xcd_barrier(xb);
    {
        int vb;
        const unsigned phys = bst[2];
        unsigned part = 0;
#pragma unroll
        for (int q = 0; q < 8; ++q) { const unsigned i = (unsigned)(tid + 256 * q); const unsigned c = xb_ld(&cucnt[i]); part += (i < phys) ? c : 0u; }
#pragma unroll
        for (int o = 1; o < 64; o <<= 1) part += (unsigned)__shfl_xor((int)part, o, 64);
        if (lane == 0) bst[4 + wave] = part;
        __syncthreads();
        vb = (int)(bst[4] + bst[5] + bst[6] + bst[7] + bst[3]);
        vb = __builtin_amdgcn_readfirstlane(vb);
        if (vb < 0 || vb >= G) vb = bid;
        __syncthreads();
        if (tid == 0) bst[8] = (unsigned)vb;
        __syncthreads();
    }
#define VB_LOAD() __builtin_amdgcn_readfirstlane((int)bst[8])
    {
        const int gw = bid * 4 + wave;
        if (gw < 64) fox_cum_wave(P, gw, lane);
        const int vb = VB_LOAD();
        for (int tile = vb; tile < 129 * 28; tile += G) gemm_tile<1>(P, tile / 28, tile % 28, smem);
        {
            const int rem = (129 * 28) % G;
            if (rem > 0 && rem < G) { if (vb >= rem) convert_uv_rows(P, (vb - rem) * 4 + wave, (G - rem) * 4, lane); }
            else convert_uv_rows(P, vb * 4 + wave, G * 4, lane);
        }
    }
    xcd_barrier(xb);
    {
        volatile int* s_item = (volatile int*)(smem + 65536);
        const int wave_u = __builtin_amdgcn_readfirstlane(wave);
        auto fetch = [&](unsigned* counter) -> int {
            if (wave_u == 0) {
                unsigned v = atomicAdd(counter, lane == 0 ? 1u : 0u);
                *s_item = (int)__builtin_amdgcn_readfirstlane(v);
            }
            __syncthreads();
            const int item = __builtin_amdgcn_readfirstlane(*s_item);
            __syncthreads();
            return item;
        };
        for (;;) {
            const int item = fetch(&ctl[2]);
            if (item >= 33 * 32) break;
            mlstm_A(P, item, smem);
        }
        xcd_barrier(xb);
        for (;;) {
            const int item = fetch(&ctl[4]);
            if (item >= 96) break;
            mlstm_B(P, item);
        }
        for (;;) {
            const int item = fetch(&ctl[3]);
            if (item >= 64 * 17) break;
            attn_block(P, item & 63, 16 - (item >> 6), smem);
        }
        xcd_barrier(xb);
        for (;;) {
            const int item = fetch(&ctl[5]);
            if (item >= 33 * 32) break;
            mlstm_C(P, item, smem);
        }
    }
    xcd_barrier(xb);
    for (int tile = VB_LOAD(); tile < 128 * 8; tile += G) gemm_tile<2>(P, tile >> 3, tile & 7, smem);
    xcd_barrier(xb);
    for (int tile = VB_LOAD(); tile < 128 * 16; tile += G) gemm_tile<3>(P, tile >> 4, tile & 15, smem);
    xcd_barrier(xb);
    {
        unsigned char* slut = smem + 12288;
        if (tid < 64) {
            int c = tid, i = 0;
            while (i < 16 && c >= 16 / (i + 1)) { c -= 16 / (i + 1); ++i; }
            slut[tid] = (unsigned char)(i < 16 ? ((i << 4) | c) : 0);
        }
        unsigned* szero = (unsigned*)(smem + 12288 + 64);
        if (tid < 16) szero[tid] = 0u;
        __syncthreads();
        int* sidx = (int*)(smem + wave * 3072); float* sval = (float*)(smem + wave * 3072 + 1024);
        int* sid = (int*)(smem + wave * 3072 + 2048); float* sgate = (float*)(smem + wave * 3072 + 2560);
        int lane5 = lane;
        asm volatile("" : "+v"(lane5));
        for (int t = bid * 4 + wave; t < T2; t += G * 4) peer_token(P, t, lane5, sidx, sval, sid, sgate, slut, szero);
    }
}

}

extern "C" void kernel_launch(void* const* d_in, const int* in_sizes, int n_in, void* d_out, int out_size, void* d_ws, size_t ws_size, hipStream_t stream) {
    if (n_in != 17 || ws_size < WS_END) { fprintf(stderr, "kernel_launch: unexpected n_in %d or ws_size %zu (need %zu)\n", n_in, ws_size, (size_t)WS_END); return; }
    constexpr int LDS_BYTES = 66560;
    static int grid_blocks = 0;
    if (!grid_blocks) {
        int dev = 0, cus = 0, per_cu = 0;
        (void)hipGetDevice(&dev);
        (void)hipDeviceGetAttribute(&cus, hipDeviceAttributeMultiprocessorCount, dev);
        (void)hipFuncSetAttribute((const void*)mega, hipFuncAttributeMaxDynamicSharedMemorySize, LDS_BYTES);
        (void)hipOccupancyMaxActiveBlocksPerMultiprocessor(&per_cu, (const void*)mega, 256, LDS_BYTES);
        if (per_cu < 1) per_cu = 1;
        if (per_cu > 2) per_cu = 2;
        grid_blocks = cus * per_cu;
        fprintf(stderr, "kernel_launch: cus %d per_cu %d grid %d\n", cus, per_cu, grid_blocks);
    }
    Params P{};
    P.x = (const float*)d_in[0]; P.meta = (const float*)d_in[1]; P.norm_mix = (const float*)d_in[2]; P.w_in = (const float*)d_in[3];
    P.conv_qk = (const float*)d_in[4]; P.b_igate = (const float*)d_in[5]; P.b_fgate_m = (const float*)d_in[6]; P.m_out_norm = (const float*)d_in[7];
    P.b_fgate_f = (const float*)d_in[8]; P.f_q_norm = (const float*)d_in[9]; P.f_k_norm = (const float*)d_in[10]; P.w_out = (const float*)d_in[11];
    P.norm_ffn = (const float*)d_in[12]; P.peer_query = (const float*)d_in[13]; P.peer_keys = (const float*)d_in[14]; P.peer_u = (const float*)d_in[15];
    P.peer_v = (const float*)d_in[16]; P.out = (float*)d_out; P.ws = (unsigned char*)d_ws;
    (void)hipMemsetAsync((unsigned char*)d_ws + WS_CTL, 0, 32768, stream);
    void* args[] = {&P};
    hipError_t e = hipLaunchCooperativeKernel((const void*)mega, dim3(grid_blocks), dim3(256), args, LDS_BYTES, stream);
    if (e != hipSuccess) fprintf(stderr, "cooperative launch failed: %s (grid %d)\n", hipGetErrorString(e), grid_blocks);
}
```

```cpp
#include <hip/hip_runtime.h>
#include <stdint.h>
#include <stdio.h>
#include <hip/hip_cooperative_groups.h>
namespace cg = cooperative_groups;

namespace {

constexpr int NB = 8, SEQ = 2048, DM = 1024, NMETA = 16, L = SEQ + NMETA;
constexpr int T1 = NB * L;
constexpr int T2 = NB * SEQ;
constexpr int NZ = 3584;
constexpr int ZC_MQ = 0, ZC_MK = 512, ZC_MV = 1024, ZC_MO = 1536, ZC_FQ = 2048, ZC_FK = 2560, ZC_FV = 3072;
constexpr int PROJ = 3600;
constexpr float EPS = 1e-6f;

constexpr size_t WS_CTL = 0;
constexpr size_t WS_RA = 65536;
constexpr size_t WS_Z = WS_RA + (size_t)T1 * DM * 2;
constexpr size_t WS_GATES = WS_Z + (size_t)T1 * NZ * 2;
constexpr size_t WS_CUM = WS_GATES + (size_t)T1 * 16 * 4;
constexpr size_t WS_SSQ = WS_CUM + (size_t)NB * 8 * L * 4;
constexpr size_t WS_RSTD = WS_SSQ + (size_t)T2 * 16 * 4;
constexpr size_t WS_SSQM = WS_RSTD + (size_t)T2 * 4;
constexpr size_t WS_BT2 = WS_SSQM + (size_t)T1 * 16 * 4;
constexpr size_t WS_BT3 = WS_BT2 + (size_t)DM * DM * 2;
constexpr size_t WS_KEYS = WS_BT3 + (size_t)2048 * DM * 2;
constexpr size_t WS_MSC = WS_KEYS + (size_t)16 * 128 * 128 * 2;
constexpr size_t WS_MST = WS_MSC + (size_t)128 * 33 * 16;
constexpr size_t WS_BT1 = WS_MST + (size_t)32 * 33 * 36864;
constexpr size_t WS_CBI = WS_BT1;
constexpr size_t WS_UV = WS_CBI + (size_t)32 * 33 * 36864;
constexpr size_t WS_END = WS_UV + (size_t)2 * 16384 * 512 + (size_t)2 * 16384 * 4;
constexpr size_t WS_XN = WS_RA;
constexpr size_t WS_U = WS_UV;
constexpr size_t WS_V = WS_U + (size_t)16384 * 512;
constexpr size_t WS_USC = WS_V + (size_t)16384 * 512;
constexpr size_t WS_VSC = WS_USC + (size_t)16384 * 4;
constexpr size_t WS_TK = WS_CBI;
constexpr float LOG2E = 1.4426950408889634f;

typedef unsigned short bf16_t;
typedef short bf16x8 __attribute__((ext_vector_type(8)));
typedef float f32x4 __attribute__((ext_vector_type(4)));
typedef __attribute__((ext_vector_type(2))) __bf16 bf16x2_t;

struct Params {
    const float* x; const float* meta; const float* norm_mix; const float* w_in; const float* conv_qk;
    const float* b_igate; const float* b_fgate_m; const float* m_out_norm; const float* b_fgate_f;
    const float* f_q_norm; const float* f_k_norm; const float* w_out; const float* norm_ffn;
    const float* peer_query; const float* peer_keys; const float* peer_u; const float* peer_v;
    float* out; unsigned char* ws;
};

__device__ __forceinline__ unsigned f2bf(float f) { unsigned u = __float_as_uint(f); return (u + 0x7fffu + ((u >> 16) & 1u)) >> 16; }
__device__ __forceinline__ float bf2f(unsigned h) { return __uint_as_float(h << 16); }
typedef float f32x2 __attribute__((ext_vector_type(2)));
typedef __bf16 bf16x2v __attribute__((ext_vector_type(2)));
__device__ __forceinline__ unsigned cvt_pk_bf16(float lo, float hi) { f32x2 v = {lo, hi}; bf16x2v b = __builtin_convertvector(v, bf16x2v); return __builtin_bit_cast(unsigned, b); }
__device__ __forceinline__ unsigned pk2(float lo, float hi) { return cvt_pk_bf16(lo, hi); }
__device__ __forceinline__ float bflo(unsigned w) { return __uint_as_float(w << 16); }
__device__ __forceinline__ float bfhi(unsigned w) { return __uint_as_float(w & 0xffff0000u); }
__device__ __forceinline__ float wave_sum(float v) {
#pragma unroll
    for (int o = 32; o > 0; o >>= 1) v += __shfl_xor(v, o, 64);
    return v;
}
__device__ __forceinline__ float wave_max(float v) {
#pragma unroll
    for (int o = 32; o > 0; o >>= 1) v = fmaxf(v, __shfl_xor(v, o, 64));
    return v;
}
__device__ __forceinline__ float logsigmoidf(float x) { return fminf(x, 0.f) - log1pf(expf(-fabsf(x))); }
__device__ __forceinline__ unsigned ord_key(float f) { unsigned u = __float_as_uint(f); return u ^ ((u >> 31) ? 0xffffffffu : 0x80000000u); }
__device__ __forceinline__ float unord_key(unsigned k) { unsigned u = (k & 0x80000000u) ? (k ^ 0x80000000u) : ~k; return __uint_as_float(u); }

__device__ __forceinline__ void phase0(const Params& P, unsigned char* smem) {
    const int tid = threadIdx.x, lane = tid & 63, wave = tid >> 6;
    unsigned* ctl = (unsigned*)(P.ws + WS_CTL);
    float* gw = (float*)smem;
    for (int idx = tid; idx < 16 * 1024; idx += 256) {
        const int k = idx >> 4, c = idx & 15;
        const int col = c < 8 ? 2048 + c : 3592 + (c - 8);
        gw[c * 1024 + k] = P.w_in[(size_t)k * PROJ + col];
    }
    __syncthreads();
    {
        bf16_t* hn = (bf16_t*)(P.ws + WS_RA);
        float* gates = (float*)(P.ws + WS_GATES);
        const int c0 = lane * 8, c1 = 512 + lane * 8;
        float gm[16];
        {
            const float4 a0 = *(const float4*)(P.norm_mix + c0), a1 = *(const float4*)(P.norm_mix + c0 + 4);
            const float4 a2 = *(const float4*)(P.norm_mix + c1), a3 = *(const float4*)(P.norm_mix + c1 + 4);
            gm[0] = a0.x; gm[1] = a0.y; gm[2] = a0.z; gm[3] = a0.w; gm[4] = a1.x; gm[5] = a1.y; gm[6] = a1.z; gm[7] = a1.w;
            gm[8] = a2.x; gm[9] = a2.y; gm[10] = a2.z; gm[11] = a2.w; gm[12] = a3.x; gm[13] = a3.y; gm[14] = a3.z; gm[15] = a3.w;
        }
        const int myq = ((lane >> 5) & 1) * 8 + ((lane >> 4) & 1) * 4 + ((lane >> 3) & 1) * 2 + ((lane >> 2) & 1);
        const float mybias = myq < 4 ? P.b_igate[myq] : (myq < 8 ? P.b_fgate_m[myq - 4] : P.b_fgate_f[myq - 8]);
        const int rstep = gridDim.x * 4;
        int r = blockIdx.x * 4 + wave;
        float4 n0, n1, n2, n3;
        auto load_row = [&](int rr) {
            const int b = rr / L, p = rr - b * L;
            const float* src = (p < NMETA) ? (P.meta + (size_t)p * DM) : (P.x + ((size_t)b * SEQ + (p - NMETA)) * DM);
            n0 = *(const float4*)(src + c0); n1 = *(const float4*)(src + c0 + 4); n2 = *(const float4*)(src + c1); n3 = *(const float4*)(src + c1 + 4);
        };
        if (r < T1) load_row(r);
        for (; r < T1; r += rstep) {
            float v[16];
            v[0] = n0.x; v[1] = n0.y; v[2] = n0.z; v[3] = n0.w; v[4] = n1.x; v[5] = n1.y; v[6] = n1.z; v[7] = n1.w;
            v[8] = n2.x; v[9] = n2.y; v[10] = n2.z; v[11] = n2.w; v[12] = n3.x; v[13] = n3.y; v[14] = n3.z; v[15] = n3.w;
            if (r + rstep < T1) load_row(r + rstep);
            float ss = 0.f;
#pragma unroll
            for (int j = 0; j < 16; ++j) ss += v[j] * v[j];
            ss = wave_sum(ss);
            const float rstd = rsqrtf(ss * (1.0f / DM) + EPS);
#pragma unroll
            for (int j = 0; j < 16; ++j) v[j] *= rstd * gm[j];
            uint4 o0, o1;
            o0.x = pk2(v[0], v[1]); o0.y = pk2(v[2], v[3]); o0.z = pk2(v[4], v[5]); o0.w = pk2(v[6], v[7]);
            o1.x = pk2(v[8], v[9]); o1.y = pk2(v[10], v[11]); o1.z = pk2(v[12], v[13]); o1.w = pk2(v[14], v[15]);
            *(uint4*)(hn + (size_t)r * DM + c0) = o0;
            *(uint4*)(hn + (size_t)r * DM + c1) = o1;
            float r8[8], r4[4], r2[2], r1;
#pragma unroll
            for (int i = 0; i < 8; ++i) {
                float dd[2];
#pragma unroll
                for (int hh = 0; hh < 2; ++hh) {
                    const float* gwc = gw + (i + 8 * hh) * 1024;
                    const float4 w0 = *(const float4*)(gwc + c0), w1 = *(const float4*)(gwc + c0 + 4), w2 = *(const float4*)(gwc + c1), w3 = *(const float4*)(gwc + c1 + 4);
                    dd[hh] = v[0] * w0.x + v[1] * w0.y + v[2] * w0.z + v[3] * w0.w + v[4] * w1.x + v[5] * w1.y + v[6] * w1.z + v[7] * w1.w
                           + v[8] * w2.x + v[9] * w2.y + v[10] * w2.z + v[11] * w2.w + v[12] * w3.x + v[13] * w3.y + v[14] * w3.z + v[15] * w3.w;
                }
                const bool up = (lane & 32) != 0; const float keep = up ? dd[1] : dd[0], send = up ? dd[0] : dd[1];
                r8[i] = keep + __shfl_xor(send, 32, 64);
                __builtin_amdgcn_sched_barrier(0);
            }
#pragma unroll
            for (int i = 0; i < 4; ++i) { const bool up = (lane & 16) != 0; const float keep = up ? r8[i + 4] : r8[i], send = up ? r8[i] : r8[i + 4]; r4[i] = keep + __shfl_xor(send, 16, 64); }
#pragma unroll
            for (int i = 0; i < 2; ++i) { const bool up = (lane & 8) != 0; const float keep = up ? r4[i + 2] : r4[i], send = up ? r4[i] : r4[i + 2]; r2[i] = keep + __shfl_xor(send, 8, 64); }
            { const bool up = (lane & 4) != 0; const float keep = up ? r2[1] : r2[0], send = up ? r2[0] : r2[1]; r1 = keep + __shfl_xor(send, 4, 64); }
            r1 += __shfl_xor(r1, 2, 64); r1 += __shfl_xor(r1, 1, 64);
            if ((lane & 3) == 0) {
                const float pre = r1 + mybias;
                gates[(size_t)r * 16 + myq] = myq < 4 ? pre : logsigmoidf(pre);
            }
        }
    }
    __syncthreads();
    {
        float* tile = (float*)smem;
        for (int item = blockIdx.x; item < 1664; item += gridDim.x) {
            const float* W; int ldn, ntn, shift_from, it; bf16_t* out;
            if (item < 896) { W = P.w_in; ldn = PROJ; ntn = 56; shift_from = 2048; it = item; out = (bf16_t*)(P.ws + WS_BT1); }
            else if (item < 1152) { W = P.w_out; ldn = 1024; ntn = 16; shift_from = 1 << 30; it = item - 896; out = (bf16_t*)(P.ws + WS_BT2); }
            else { W = P.peer_query; ldn = 2048; ntn = 32; shift_from = 1 << 30; it = item - 1152; out = (bf16_t*)(P.ws + WS_BT3); }
            const int tk = it / ntn, tn = it - tk * ntn, k0 = tk * 64, n0 = tn * 64;
            {
                const int n4 = (tid & 15) * 4, kr = tid >> 4;
                int n = n0 + n4; if (n >= shift_from) n += 8;
                float4 v[4];
#pragma unroll
                for (int i = 0; i < 4; ++i) v[i] = *(const float4*)(W + (size_t)(k0 + kr + 16 * i) * ldn + n);
#pragma unroll
                for (int i = 0; i < 4; ++i) *(float4*)(tile + (kr + 16 * i) * 68 + n4) = v[i];
            }
            __syncthreads();
            {
#pragma unroll
                for (int i = 0; i < 2; ++i) {
                    const int id = tid + 256 * i, nl = id & 63, kc = id >> 6;
                    const float* tp = tile + (kc * 8) * 68 + nl;
                    uint4 o;
                    o.x = pk2(tp[0], tp[68]); o.y = pk2(tp[2 * 68], tp[3 * 68]); o.z = pk2(tp[4 * 68], tp[5 * 68]); o.w = pk2(tp[6 * 68], tp[7 * 68]);
                    *(uint4*)(out + (size_t)(n0 + nl) * 1024 + k0 + kc * 8) = o;
                }
            }
            __syncthreads();
        }
    }
    {
        const size_t gt = (size_t)blockIdx.x * 256 + tid, gs = (size_t)gridDim.x * 256;
        const float* src = P.peer_keys; bf16_t* dst = (bf16_t*)(P.ws + WS_KEYS);
        for (size_t i = gt; i < (size_t)(16 * 128 * 128 / 8); i += gs) {
            const float4 a = *(const float4*)(src + i * 8), b = *(const float4*)(src + i * 8 + 4);
            uint4 o; o.x = pk2(a.x, a.y); o.y = pk2(a.z, a.w); o.z = pk2(b.x, b.y); o.w = pk2(b.z, b.w);
            *(uint4*)(dst + i * 8) = o;
        }
    }
}

__device__ __forceinline__ void convert_uv_rows(const Params& P, int gwave, int nwaves, int lane) {
    for (int rr0 = gwave * 4; rr0 < 2 * 16384; rr0 += nwaves * 4) {
        float4 a[4][4];
#pragma unroll
        for (int q = 0; q < 4; ++q) {
            const int rr = rr0 + q, which = rr >> 14, row = rr & 16383;
            const float* src = (which ? P.peer_v : P.peer_u) + (size_t)row * DM + lane * 16;
            a[q][0] = *(const float4*)(src); a[q][1] = *(const float4*)(src + 4); a[q][2] = *(const float4*)(src + 8); a[q][3] = *(const float4*)(src + 12);
        }
#pragma unroll
        for (int q = 0; q < 4; ++q) {
            const int rr = rr0 + q, which = rr >> 14, row = rr & 16383;
            float mx = 0.f;
#pragma unroll
            for (int j = 0; j < 4; ++j) mx = fmaxf(mx, fmaxf(fmaxf(fabsf(a[q][j].x), fabsf(a[q][j].y)), fmaxf(fabsf(a[q][j].z), fabsf(a[q][j].w))));
            mx = wave_max(mx);
            const float sc = mx > 0.f ? 6.0f / mx : 1.0f;
            unsigned w0 = 0u, w1 = 0u;
            w0 = __builtin_amdgcn_cvt_scalef32_pk_fp4_f32(w0, a[q][0].x * sc, a[q][0].y * sc, 1.0f, 0); w0 = __builtin_amdgcn_cvt_scalef32_pk_fp4_f32(w0, a[q][0].z * sc, a[q][0].w * sc, 1.0f, 1);
            w0 = __builtin_amdgcn_cvt_scalef32_pk_fp4_f32(w0, a[q][1].x * sc, a[q][1].y * sc, 1.0f, 2); w0 = __builtin_amdgcn_cvt_scalef32_pk_fp4_f32(w0, a[q][1].z * sc, a[q][1].w * sc, 1.0f, 3);
            w1 = __builtin_amdgcn_cvt_scalef32_pk_fp4_f32(w1, a[q][2].x * sc, a[q][2].y * sc, 1.0f, 0); w1 = __builtin_amdgcn_cvt_scalef32_pk_fp4_f32(w1, a[q][2].z * sc, a[q][2].w * sc, 1.0f, 1);
            w1 = __builtin_amdgcn_cvt_scalef32_pk_fp4_f32(w1, a[q][3].x * sc, a[q][3].y * sc, 1.0f, 2); w1 = __builtin_amdgcn_cvt_scalef32_pk_fp4_f32(w1, a[q][3].z * sc, a[q][3].w * sc, 1.0f, 3);
            *(uint2*)(P.ws + (which ? WS_V : WS_U) + (size_t)row * 512 + lane * 8) = make_uint2(w0, w1);
            if (lane == 0) ((float*)(P.ws + (which ? WS_VSC : WS_USC)))[row] = mx > 0.f ? mx * (1.0f / 6.0f) : 1.0f;
        }
    }
}

__device__ __forceinline__ void bitonic_sort16_desc(unsigned (&v)[16]) {
#pragma unroll
    for (int k = 2; k <= 16; k <<= 1)
#pragma unroll
        for (int j = k >> 1; j >= 1; j >>= 1)
#pragma unroll
            for (int i = 0; i < 16; ++i)
                if ((i & j) == 0) {
                    const int p = i | j;
                    const bool desc = (k >= 16) ? true : ((i & k) == 0);
                    const unsigned hi = max(v[i], v[p]), lo = min(v[i], v[p]);
                    v[i] = desc ? hi : lo; v[p] = desc ? lo : hi;
                }
}
__device__ __forceinline__ void bitonic_merge16_top(unsigned (&a)[16], const unsigned (&b)[16]) {
#pragma unroll
    for (int i = 0; i < 16; ++i) a[i] = max(a[i], b[15 - i]);
#pragma unroll
    for (int j = 8; j >= 1; j >>= 1)
#pragma unroll
        for (int i = 0; i < 16; ++i)
            if ((i & j) == 0) { const int p = i | j; const unsigned hi = max(a[i], a[p]), lo = min(a[i], a[p]); a[i] = hi; a[p] = lo; }
}

__device__ __forceinline__ float x4_max(float x) {
    const unsigned xi = __float_as_uint(x);
    const auto r = __builtin_amdgcn_permlane32_swap(xi, xi, false, false);
    const float m = fmaxf(__uint_as_float(r[0]), __uint_as_float(r[1]));
    const unsigned mi = __float_as_uint(m);
    const auto r2 = __builtin_amdgcn_permlane16_swap(mi, mi, false, false);
    return fmaxf(__uint_as_float(r2[0]), __uint_as_float(r2[1]));
}
__device__ __forceinline__ float x4_sum(float x) {
    const unsigned xi = __float_as_uint(x);
    const auto r = __builtin_amdgcn_permlane32_swap(xi, xi, false, false);
    const float m = __uint_as_float(r[0]) + __uint_as_float(r[1]);
    const unsigned mi = __float_as_uint(m);
    const auto r2 = __builtin_amdgcn_permlane16_swap(mi, mi, false, false);
    return __uint_as_float(r2[0]) + __uint_as_float(r2[1]);
}

__device__ __forceinline__ int opaque_tid() { int t = threadIdx.x; asm volatile("" : "+v"(t)); return t; }

__device__ __forceinline__ void mma_ktile(const unsigned char* sA, const unsigned char* sB, int arow_off, int brow_off, int g, int sw, f32x4 (&acc)[4][4]) {
#pragma unroll
    for (int s = 0; s < 2; ++s) {
        bf16x8 a[4], b[4];
        const int ch = (((s * 4 + g) ^ sw) << 4);
#pragma unroll
        for (int i = 0; i < 4; ++i) a[i] = *(const bf16x8*)(sA + arow_off + i * 2048 + ch);
#pragma unroll
        for (int j = 0; j < 4; ++j) b[j] = *(const bf16x8*)(sB + brow_off + j * 2048 + ch);
#pragma unroll
        for (int i = 0; i < 4; ++i)
#pragma unroll
            for (int j = 0; j < 4; ++j) acc[i][j] = __builtin_amdgcn_mfma_f32_16x16x32_bf16(b[j], a[i], acc[i][j], 0, 0, 0);
    }
}

__device__ __forceinline__ void store_tile_bf16(const f32x4 (&acc)[4][4], unsigned char* smem, bf16_t* dst, size_t ld, int m0, int n0, int tid, int wr, int wc, int g, int lr) {
#pragma unroll
    for (int i = 0; i < 4; ++i)
#pragma unroll
        for (int j = 0; j < 4; ++j) {
            const int row = wr * 64 + 16 * i + lr, col = wc * 64 + 16 * j + 4 * g;
            uint2 w; w.x = pk2(acc[i][j][0], acc[i][j][1]); w.y = pk2(acc[i][j][2], acc[i][j][3]);
            *(uint2*)(smem + row * 272 + col * 2) = w;
        }
    __syncthreads();
#pragma unroll
    for (int q = 0; q < 8; ++q) {
        const int id = tid + 256 * q, row = id >> 4, ch = id & 15;
        const uint4 v = *(const uint4*)(smem + row * 272 + ch * 16);
        *(uint4*)(dst + (size_t)(m0 + row) * ld + n0 + ch * 8) = v;
    }
    __syncthreads();
}

template <int MODE>
__device__ __forceinline__ void gemm_tile(const Params& P, int tm, int tn, unsigned char* smem) {
    const bf16_t* A; const bf16_t* Bt;
    if (MODE == 1) { A = (const bf16_t*)(P.ws + WS_RA); Bt = (const bf16_t*)(P.ws + WS_BT1); }
    else if (MODE == 2) { A = (const bf16_t*)(P.ws + WS_Z); Bt = (const bf16_t*)(P.ws + WS_BT2); }
    else { A = (const bf16_t*)(P.ws + WS_XN); Bt = (const bf16_t*)(P.ws + WS_BT3); }
    const int tid = opaque_tid(), lane = tid & 63, wave = tid >> 6, wr = wave >> 1, wc = wave & 1, g = lane >> 4, lr = lane & 15;
    const int m0 = tm * 128, n0 = tn * 128;
    const int srow = tid >> 3, sc = tid & 7;
    constexpr unsigned LDA = (MODE == 2 ? NZ : 1024) * 2u;
    unsigned aoff, boff; int soff0;
    {
        int ar = m0 + srow;
        if (MODE == 2) { const int b = ar >> 11, t = ar & 2047; ar = b * L + NMETA + t; }
        aoff = (unsigned)ar * LDA + (unsigned)sc * 16u;
        boff = (unsigned)(n0 + srow) * 2048u + (unsigned)sc * 16u;
        soff0 = srow * 128 + ((sc ^ (srow & 7)) << 4);
    }
    const unsigned char* Ab = (const unsigned char*)A; const unsigned char* Bb = (const unsigned char*)Bt;
    f32x4 acc[4][4];
#pragma unroll
    for (int i = 0; i < 4; ++i)
#pragma unroll
        for (int j = 0; j < 4; ++j) acc[i][j] = (f32x4){0.f, 0.f, 0.f, 0.f};
    uint4 ra0, ra1, ra2, ra3, rb0, rb1, rb2, rb3;
#define G_LOAD(KT) { const unsigned ko = (unsigned)(KT) * 128u; \
        ra0 = *(const uint4*)(Ab + (aoff + ko)); ra1 = *(const uint4*)(Ab + (aoff + 32u * LDA + ko)); ra2 = *(const uint4*)(Ab + (aoff + 64u * LDA + ko)); ra3 = *(const uint4*)(Ab + (aoff + 96u * LDA + ko)); \
        rb0 = *(const uint4*)(Bb + (boff + ko)); rb1 = *(const uint4*)(Bb + (boff + 32u * 2048u + ko)); rb2 = *(const uint4*)(Bb + (boff + 64u * 2048u + ko)); rb3 = *(const uint4*)(Bb + (boff + 96u * 2048u + ko)); }
#define G_WRITE(SA, SB) { *(uint4*)((SA) + soff0) = ra0; *(uint4*)((SA) + soff0 + 4096) = ra1; *(uint4*)((SA) + soff0 + 8192) = ra2; *(uint4*)((SA) + soff0 + 12288) = ra3; \
        *(uint4*)((SB) + soff0) = rb0; *(uint4*)((SB) + soff0 + 4096) = rb1; *(uint4*)((SB) + soff0 + 8192) = rb2; *(uint4*)((SB) + soff0 + 12288) = rb3; }
    unsigned char* sA0 = smem; unsigned char* sB0 = smem + 16384; unsigned char* sA1 = smem + 32768; unsigned char* sB1 = smem + 49152;
    G_LOAD(0)
    G_WRITE(sA0, sB0)
    __syncthreads();
    const int arow_off = (wr * 64 + lr) * 128, brow_off = (wc * 64 + lr) * 128, sw = lr & 7;
    G_LOAD(1)
    for (int kt = 0; kt < 16; ++kt) {
        unsigned char* sA = (kt & 1) ? sA1 : sA0; unsigned char* sB = (kt & 1) ? sB1 : sB0;
        unsigned char* nA = (kt & 1) ? sA0 : sA1; unsigned char* nB = (kt & 1) ? sB0 : sB1;
        bf16x8 fa[4], fb[4], ga[4], gb[4];
        const int ch0 = ((g ^ sw) << 4), ch1 = (((4 + g) ^ sw) << 4);
        const unsigned ko = (unsigned)(kt + 2) * 128u;
        const bool wr_ok = kt < 15, ld_ok = kt < 14;
#pragma unroll
        for (int i = 0; i < 4; ++i) { fa[i] = *(const bf16x8*)(sA + arow_off + i * 2048 + ch0); fb[i] = *(const bf16x8*)(sB + brow_off + i * 2048 + ch0); }
        __builtin_amdgcn_sched_barrier(0);
        __builtin_amdgcn_s_setprio(2);
        if (wr_ok) *(uint4*)(nA + soff0) = ra0;
        if (ld_ok) ra0 = *(const uint4*)(Ab + (aoff + 0u * LDA + ko));
        ga[0] = *(const bf16x8*)(sA + arow_off + 0 * 2048 + ch1); gb[0] = *(const bf16x8*)(sB + brow_off + 0 * 2048 + ch1);
        __builtin_amdgcn_sched_barrier(0);
#pragma unroll
        for (int j = 0; j < 4; ++j) acc[0][j] = __builtin_amdgcn_mfma_f32_16x16x32_bf16(fb[j], fa[0], acc[0][j], 0, 0, 0);
        __builtin_amdgcn_sched_barrier(0);
        if (wr_ok) *(uint4*)(nA + soff0 + 4096) = ra1;
        if (ld_ok) ra1 = *(const uint4*)(Ab + (aoff + 32u * LDA + ko));
        ga[1] = *(const bf16x8*)(sA + arow_off + 1 * 2048 + ch1); gb[1] = *(const bf16x8*)(sB + brow_off + 1 * 2048 + ch1);
        __builtin_amdgcn_sched_barrier(0);
#pragma unroll
        for (int j = 0; j < 4; ++j) acc[1][j] = __builtin_amdgcn_mfma_f32_16x16x32_bf16(fb[j], fa[1], acc[1][j], 0, 0, 0);
        __builtin_amdgcn_sched_barrier(0);
        if (wr_ok) *(uint4*)(nA + soff0 + 8192) = ra2;
        if (ld_ok) ra2 = *(const uint4*)(Ab + (aoff + 64u * LDA + ko));
        ga[2] = *(const bf16x8*)(sA + arow_off + 2 * 2048 + ch1); gb[2] = *(const bf16x8*)(sB + brow_off + 2 * 2048 + ch1);
        __builtin_amdgcn_sched_barrier(0);
#pragma unroll
        for (int j = 0; j < 4; ++j) acc[2][j] = __builtin_amdgcn_mfma_f32_16x16x32_bf16(fb[j], fa[2], acc[2][j], 0, 0, 0);
        __builtin_amdgcn_sched_barrier(0);
        if (wr_ok) *(uint4*)(nA + soff0 + 12288) = ra3;
        if (ld_ok) ra3 = *(const uint4*)(Ab + (aoff + 96u * LDA + ko));
        ga[3] = *(const bf16x8*)(sA + arow_off + 3 * 2048 + ch1); gb[3] = *(const bf16x8*)(sB + brow_off + 3 * 2048 + ch1);
        __builtin_amdgcn_sched_barrier(0);
#pragma unroll
        for (int j = 0; j < 4; ++j) acc[3][j] = __builtin_amdgcn_mfma_f32_16x16x32_bf16(fb[j], fa[3], acc[3][j], 0, 0, 0);
        __builtin_amdgcn_sched_barrier(0);
        if (wr_ok) *(uint4*)(nB + soff0) = rb0;
        if (ld_ok) rb0 = *(const uint4*)(Bb + (boff + 0u * 2048u + ko));
        __builtin_amdgcn_sched_barrier(0);
#pragma unroll
        for (int j = 0; j < 4; ++j) acc[0][j] = __builtin_amdgcn_mfma_f32_16x16x32_bf16(gb[j], ga[0], acc[0][j], 0, 0, 0);
        __builtin_amdgcn_sched_barrier(0);
        if (wr_ok) *(uint4*)(nB + soff0 + 4096) = rb1;
        if (ld_ok) rb1 = *(const uint4*)(Bb + (boff + 32u * 2048u + ko));
        __builtin_amdgcn_sched_barrier(0);
#pragma unroll
        for (int j = 0; j < 4; ++j) acc[1][j] = __builtin_amdgcn_mfma_f32_16x16x32_bf16(gb[j], ga[1], acc[1][j], 0, 0, 0);
        __builtin_amdgcn_sched_barrier(0);
        if (wr_ok) *(uint4*)(nB + soff0 + 8192) = rb2;
        if (ld_ok) rb2 = *(const uint4*)(Bb + (boff + 64u * 2048u + ko));
        __builtin_amdgcn_sched_barrier(0);
#pragma unroll
        for (int j = 0; j < 4; ++j) acc[2][j] = __builtin_amdgcn_mfma_f32_16x16x32_bf16(gb[j], ga[2], acc[2][j], 0, 0, 0);
        __builtin_amdgcn_sched_barrier(0);
        if (wr_ok) *(uint4*)(nB + soff0 + 12288) = rb3;
        if (ld_ok) rb3 = *(const uint4*)(Bb + (boff + 96u * 2048u + ko));
        __builtin_amdgcn_sched_barrier(0);
#pragma unroll
        for (int j = 0; j < 4; ++j) acc[3][j] = __builtin_amdgcn_mfma_f32_16x16x32_bf16(gb[j], ga[3], acc[3][j], 0, 0, 0);
        __builtin_amdgcn_s_setprio(0);
        __syncthreads();
    }
#undef G_LOAD
#undef G_WRITE
    if (MODE == 1) {
        if (n0 >= ZC_FQ && n0 < ZC_FV) {
            const bool isk = n0 >= ZC_FK;
            const float* gain = isk ? P.f_k_norm : P.f_q_norm;
            const float scl = isk ? 1.0f : 0.125f * LOG2E;
            float gn[4][4];
#pragma unroll
            for (int j = 0; j < 4; ++j)
#pragma unroll
                for (int r = 0; r < 4; ++r) gn[j][r] = gain[16 * j + 4 * g + r];
#pragma unroll
            for (int i = 0; i < 4; ++i) {
                float ss = 0.f;
#pragma unroll
                for (int j = 0; j < 4; ++j)
#pragma unroll
                    for (int r = 0; r < 4; ++r) ss += acc[i][j][r] * acc[i][j][r];
                ss = x4_sum(ss);
                const float rstd = rsqrtf(ss * (1.0f / 64.0f) + EPS) * scl;
#pragma unroll
                for (int j = 0; j < 4; ++j)
#pragma unroll
                    for (int r = 0; r < 4; ++r) acc[i][j][r] *= rstd * gn[j][r];
            }
        }
        store_tile_bf16(acc, smem, (bf16_t*)(P.ws + WS_Z), NZ, m0, n0, tid, wr, wc, g, lr);
    } else if (MODE == 2) {
        float* ssq = (float*)(P.ws + WS_SSQ);
#pragma unroll
        for (int i = 0; i < 4; ++i) {
            const int row = m0 + wr * 64 + 16 * i + lr;
            float ss = 0.f;
#pragma unroll
            for (int j = 0; j < 4; ++j) {
                const int col = n0 + wc * 64 + 16 * j + 4 * g;
                const float4 xv = *(const float4*)(P.x + (size_t)row * DM + col);
                const float4 gv = *(const float4*)(P.norm_ffn + col);
                float4 hv; hv.x = acc[i][j][0] + xv.x; hv.y = acc[i][j][1] + xv.y; hv.z = acc[i][j][2] + xv.z; hv.w = acc[i][j][3] + xv.w;
                ss += hv.x * hv.x + hv.y * hv.y + hv.z * hv.z + hv.w * hv.w;
                acc[i][j][0] = hv.x * gv.x; acc[i][j][1] = hv.y * gv.y; acc[i][j][2] = hv.z * gv.z; acc[i][j][3] = hv.w * gv.w;
            }
            ss = x4_sum(ss);
            if (g == 0) ssq[(size_t)row * 16 + tn * 2 + wc] = ss;
        }
        store_tile_bf16(acc, smem, (bf16_t*)(P.ws + WS_XN), 1024, m0, n0, tid, wr, wc, g, lr);
    } else {
        const int hp = tn;
        const float* ssq = (const float*)(P.ws + WS_SSQ);
        float rs[4];
#pragma unroll
        for (int i = 0; i < 4; ++i) {
            const int row = m0 + wr * 64 + 16 * i + lr;
            const float4 p0 = *(const float4*)(ssq + (size_t)row * 16), p1 = *(const float4*)(ssq + (size_t)row * 16 + 4);
            const float4 p2 = *(const float4*)(ssq + (size_t)row * 16 + 8), p3 = *(const float4*)(ssq + (size_t)row * 16 + 12);
            const float s = ((p0.x + p0.y) + (p0.z + p0.w)) + ((p1.x + p1.y) + (p1.z + p1.w)) + ((p2.x + p2.y) + (p2.z + p2.w)) + ((p3.x + p3.y) + (p3.z + p3.w));
            rs[i] = rsqrtf(s * (1.0f / DM) + EPS);
            if (tn == 0 && wc == 0 && g == 0) ((float*)(P.ws + WS_RSTD))[row] = rs[i];
        }
        {
            unsigned char* sAq = wc ? sA1 : sA0;
#pragma unroll
            for (int i = 0; i < 4; ++i)
#pragma unroll
                for (int j = 0; j < 4; ++j) {
                    const int row = wr * 64 + 16 * i + lr;
                    const int chunk = 2 * j + (g >> 1);
                    uint2 w; w.x = pk2(acc[i][j][0] * rs[i], acc[i][j][1] * rs[i]); w.y = pk2(acc[i][j][2] * rs[i], acc[i][j][3] * rs[i]);
                    *(uint2*)(sAq + row * 128 + ((chunk ^ (row & 7)) << 4) + 8 * (g & 1)) = w;
                }
            const bf16_t* keys = (const bf16_t*)(P.ws + WS_KEYS) + (size_t)hp * 128 * 128;
#pragma unroll
            for (int j = 0; j < 4; ++j) {
                const int row = srow + 32 * j;
                const uint4 k0 = *(const uint4*)(keys + (size_t)row * 128 + sc * 8);
                const uint4 k1 = *(const uint4*)(keys + (size_t)row * 128 + 64 + sc * 8);
                *(uint4*)(sB0 + soff0 + j * 4096) = k0; *(uint4*)(sB1 + soff0 + j * 4096) = k1;
            }
        }
        __syncthreads();
#pragma unroll
        for (int i = 0; i < 4; ++i)
#pragma unroll
            for (int j = 0; j < 4; ++j) acc[i][j] = (f32x4){0.f, 0.f, 0.f, 0.f};
        mma_ktile(sA0, sB0, arow_off, brow_off, g, sw, acc);
        mma_ktile(sA1, sB1, arow_off, brow_off, g, sw, acc);
        __syncthreads();
#pragma unroll
        for (int i = 0; i < 4; ++i)
#pragma unroll
            for (int j = 0; j < 4; ++j) {
                const int row = wr * 64 + 16 * i + lr;
                const int c4 = wc * 16 + 4 * j + g;
                *(f32x4*)(smem + row * 512 + ((c4 ^ (row & 31)) << 4)) = acc[i][j];
            }
        __syncthreads();
        unsigned top[16];
        const int row = tid & 127, half = tid >> 7;
        {
            auto load_keys = [&](unsigned (&dst)[16], int q4) {
#pragma unroll
                for (int s4 = 0; s4 < 4; ++s4) {
                    const int c4 = half * 16 + q4 * 4 + s4;
                    const f32x4 v = *(const f32x4*)(smem + row * 512 + ((c4 ^ (row & 31)) << 4));
#pragma unroll
                    for (int e = 0; e < 4; ++e) dst[s4 * 4 + e] = (ord_key(v[e]) & ~127u) | (unsigned)(127 - (c4 * 4 + e));
                }
            };
            load_keys(top, 0);
            bitonic_sort16_desc(top);
#pragma unroll 1
            for (int q4 = 1; q4 < 4; ++q4) {
                unsigned gq[16];
                load_keys(gq, q4);
                bitonic_sort16_desc(gq);
                bitonic_merge16_top(top, gq);
            }
        }
        __syncthreads();
        if (half) {
            uint4* lp = (uint4*)(smem + row * 64);
            lp[0] = make_uint4(top[0], top[1], top[2], top[3]); lp[1] = make_uint4(top[4], top[5], top[6], top[7]);
            lp[2] = make_uint4(top[8], top[9], top[10], top[11]); lp[3] = make_uint4(top[12], top[13], top[14], top[15]);
        }
        __syncthreads();
        if (!half) {
            const uint4* lp = (const uint4*)(smem + row * 64);
            unsigned other[16];
#pragma unroll
            for (int c = 0; c < 4; ++c) { const uint4 o = lp[c]; other[4 * c] = o.x; other[4 * c + 1] = o.y; other[4 * c + 2] = o.z; other[4 * c + 3] = o.w; }
            bitonic_merge16_top(top, other);
            uint4* tk = (uint4*)((unsigned*)(P.ws + WS_TK) + ((size_t)(m0 + row) * 16 + hp) * 16);
            tk[0] = make_uint4(top[0], top[1], top[2], top[3]); tk[1] = make_uint4(top[4], top[5], top[6], top[7]);
            tk[2] = make_uint4(top[8], top[9], top[10], top[11]); tk[3] = make_uint4(top[12], top[13], top[14], top[15]);
        }
        __syncthreads();
    }
}

__device__ __forceinline__ void fox_cum_wave(const Params& P, int bh, int lane) {
    const int b = bh >> 3, h = bh & 7;
    const float* gates = (const float*)(P.ws + WS_GATES);
    float* cum = (float*)(P.ws + WS_CUM) + (size_t)bh * L;
    constexpr int SEG = 33;
    const int t0 = lane * SEG;
    float loc = 0.f;
    for (int i = 0; i < SEG; ++i) { const int t = t0 + i; if (t < L) loc += gates[(size_t)(b * L + t) * 16 + 8 + h]; }
    float incl = loc;
#pragma unroll
    for (int o = 1; o < 64; o <<= 1) { const float n = __shfl_up(incl, o, 64); if (lane >= o) incl += n; }
    float run = incl - loc;
    for (int i = 0; i < SEG; ++i) { const int t = t0 + i; if (t < L) { run += gates[(size_t)(b * L + t) * 16 + 8 + h]; cum[t] = run * LOG2E; } }
}

#define TR_SLOW 0

__device__ __forceinline__ int vimg_off(int row, int ch) { return row * 128 + ((ch ^ (((row >> 1) & 3) << 1)) << 4); }
__device__ __forceinline__ uint2 tr_frag(const unsigned char* img, int row0, int c, int g, int lr) {
#if TR_SLOW
    unsigned short e[4];
#pragma unroll
    for (int k = 0; k < 4; ++k) { const int row = row0 + 4 * g + k, col = 16 * c + lr; e[k] = *(const unsigned short*)(img + vimg_off(row, col >> 3) + (col & 7) * 2); }
    uint2 r; r.x = (unsigned)e[0] | ((unsigned)e[1] << 16); r.y = (unsigned)e[2] | ((unsigned)e[3] << 16); return r;
#else
    const int q = lr >> 2, p = lr & 3, row = row0 + 4 * g + q;
    const unsigned addr = (unsigned)(size_t)(img + vimg_off(row, 2 * c + (p >> 1)) + 8 * (p & 1));
    uint2 r;
    asm volatile("ds_read_b64_tr_b16 %0, %1\n\ts_waitcnt lgkmcnt(0)" : "=&v"(r) : "v"(addr) : "memory");
    return r;
#endif
}

__device__ __forceinline__ unsigned tr_lane_addr(const unsigned char* img, int c, int g, int lr) {
    const int q = lr >> 2, p = lr & 3, row = 4 * g + q;
    return (unsigned)(size_t)(img + vimg_off(row, 2 * c + (p >> 1)) + 8 * (p & 1));
}
#define TR_GROUP(o0, o1, o2, o3, a) "ds_read_b64_tr_b16 %" #o0 ", %" #a "\n\tds_read_b64_tr_b16 %" #o1 ", %" #a " offset:2048\n\tds_read_b64_tr_b16 %" #o2 ", %" #a " offset:4096\n\tds_read_b64_tr_b16 %" #o3 ", %" #a " offset:6144\n\t"
__device__ __forceinline__ void tr_read_4c(const unsigned char* img, int g, int lr, uint2 (&r)[4][4]) {
    const unsigned a0 = tr_lane_addr(img, 0, g, lr), a1 = tr_lane_addr(img, 1, g, lr), a2 = tr_lane_addr(img, 2, g, lr), a3 = tr_lane_addr(img, 3, g, lr);
    asm volatile(TR_GROUP(0, 1, 2, 3, 16) TR_GROUP(4, 5, 6, 7, 17) TR_GROUP(8, 9, 10, 11, 18) TR_GROUP(12, 13, 14, 15, 19) "s_waitcnt lgkmcnt(0)"
        : "=&v"(r[0][0]), "=&v"(r[0][1]), "=&v"(r[0][2]), "=&v"(r[0][3]), "=&v"(r[1][0]), "=&v"(r[1][1]), "=&v"(r[1][2]), "=&v"(r[1][3]),
          "=&v"(r[2][0]), "=&v"(r[2][1]), "=&v"(r[2][2]), "=&v"(r[2][3]), "=&v"(r[3][0]), "=&v"(r[3][1]), "=&v"(r[3][2]), "=&v"(r[3][3])
        : "v"(a0), "v"(a1), "v"(a2), "v"(a3) : "memory");
}
__device__ __forceinline__ void tr_read_3c(const unsigned char* img, int g, int lr, uint2 (&r)[3][4]) {
    const unsigned a0 = tr_lane_addr(img, 0, g, lr), a1 = tr_lane_addr(img, 1, g, lr), a2 = tr_lane_addr(img, 2, g, lr);
    asm volatile(TR_GROUP(0, 1, 2, 3, 12) TR_GROUP(4, 5, 6, 7, 13) TR_GROUP(8, 9, 10, 11, 14) "s_waitcnt lgkmcnt(0)"
        : "=&v"(r[0][0]), "=&v"(r[0][1]), "=&v"(r[0][2]), "=&v"(r[0][3]), "=&v"(r[1][0]), "=&v"(r[1][1]), "=&v"(r[1][2]), "=&v"(r[1][3]),
          "=&v"(r[2][0]), "=&v"(r[2][1]), "=&v"(r[2][2]), "=&v"(r[2][3])
        : "v"(a0), "v"(a1), "v"(a2) : "memory");
}
__device__ __forceinline__ void tr_read_2(const unsigned char* img0, int c0, const unsigned char* img1, int c1, int g, int lr, uint2 (&r)[2][4]) {
    const unsigned a0 = tr_lane_addr(img0, c0, g, lr), a1 = tr_lane_addr(img1, c1, g, lr);
    asm volatile(TR_GROUP(0, 1, 2, 3, 8) TR_GROUP(4, 5, 6, 7, 9) "s_waitcnt lgkmcnt(0)"
        : "=&v"(r[0][0]), "=&v"(r[0][1]), "=&v"(r[0][2]), "=&v"(r[0][3]), "=&v"(r[1][0]), "=&v"(r[1][1]), "=&v"(r[1][2]), "=&v"(r[1][3])
        : "v"(a0), "v"(a1) : "memory");
}
__device__ __forceinline__ bf16x8 tr_pair(const uint2& lo, const uint2& hi) { uint4 u; u.x = lo.x; u.y = lo.y; u.z = hi.x; u.w = hi.y; return __builtin_bit_cast(bf16x8, u); }

__device__ __forceinline__ void attn_block(const Params& P, int bh, int qb, unsigned char* smem) {
    const int tid = opaque_tid(), lane = tid & 63, w = tid >> 6, g = lane >> 4, lr = lane & 15;
    const int b = bh >> 3, h = bh & 7;
    const bf16_t* z = (const bf16_t*)(P.ws + WS_Z);
    const float* cum = (const float*)(P.ws + WS_CUM) + (size_t)bh * L;
    int tq[2]; bool qvalid[2]; bf16x8 qf[2][2];
#pragma unroll
    for (int u = 0; u < 2; ++u) {
        tq[u] = qb * 128 + 32 * w + 16 * u + lr;
        qvalid[u] = tq[u] < L;
        const bf16_t* qp = z + (size_t)(b * L + (qvalid[u] ? tq[u] : 0)) * NZ + ZC_FQ + h * 64 + 8 * g;
        qf[u][0] = *(const bf16x8*)(qp); qf[u][1] = *(const bf16x8*)(qp + 32);
    }
    const int nkv = (2 * qb + 2 < 33) ? 2 * qb + 2 : 33;
    const int srow0 = tid >> 3, sch = tid & 7;
    uint4 rk[2], rv[2]; float rc = 0.f;
    auto load_tile = [&](int kv) {
#pragma unroll
        for (int j = 0; j < 2; ++j) {
            const int key = kv * 64 + srow0 + 32 * j;
            if (key < L) {
                const bf16_t* p = z + (size_t)(b * L + key) * NZ + h * 64 + sch * 8;
                rk[j] = *(const uint4*)(p + ZC_FK); rv[j] = *(const uint4*)(p + ZC_FV);
            } else { rk[j] = make_uint4(0, 0, 0, 0); rv[j] = make_uint4(0, 0, 0, 0); }
        }
        if (tid < 64) { const int key = kv * 64 + tid; rc = key < L ? cum[key] : 0.f; }
    };
    auto store_tile = [&](int buf) {
        unsigned char* sK = smem + buf * 16384; unsigned char* sV = sK + 8192;
#pragma unroll
        for (int j = 0; j < 2; ++j) {
            const int row = srow0 + 32 * j;
            *(uint4*)(sK + row * 128 + ((sch ^ (row & 7)) << 4)) = rk[j];
            *(uint4*)(sV + vimg_off(row, sch)) = rv[j];
        }
        if (tid < 64) ((float*)(smem + 32768 + buf * 256))[tid] = rc;
    };
    float m[2] = {-1e30f, -1e30f};
    f32x4 o[2][5];
#pragma unroll
    for (int u = 0; u < 2; ++u)
#pragma unroll
        for (int c = 0; c < 5; ++c) o[u][c] = (f32x4){0.f, 0.f, 0.f, 0.f};
    const unsigned onew = (lr == 0) ? 0x3F803F80u : 0u;
    const bf16x8 vones = __builtin_bit_cast(bf16x8, make_uint4(onew, onew, onew, onew));
    load_tile(nkv - 1); store_tile((nkv - 1) & 1);
    __syncthreads();
    for (int kv = nkv - 1; kv >= 0; --kv) {
        const int buf = kv & 1;
        if (kv > 0) load_tile(kv - 1);
        const unsigned char* sK = smem + buf * 16384; const unsigned char* sV = sK + 8192;
        const float* sck = (const float*)(smem + 32768 + buf * 256);
        f32x4 sa[2][4];
#pragma unroll
        for (int c = 0; c < 4; ++c) {
            sa[0][c] = (f32x4){0.f, 0.f, 0.f, 0.f}; sa[1][c] = (f32x4){0.f, 0.f, 0.f, 0.f};
#pragma unroll
            for (int s = 0; s < 2; ++s) {
                const bf16x8 kf = *(const bf16x8*)(sK + (16 * c + lr) * 128 + (((4 * s + g) ^ (lr & 7)) << 4));
                sa[0][c] = __builtin_amdgcn_mfma_f32_16x16x32_bf16(kf, qf[0][s], sa[0][c], 0, 0, 0);
                sa[1][c] = __builtin_amdgcn_mfma_f32_16x16x32_bf16(kf, qf[1][s], sa[1][c], 0, 0, 0);
            }
        }
        if (kv >= 2 * qb) {
#pragma unroll
            for (int u = 0; u < 2; ++u)
#pragma unroll
                for (int c = 0; c < 4; ++c)
#pragma unroll
                    for (int r = 0; r < 4; ++r)
                        if (64 * kv + 16 * c + 4 * g + r > tq[u]) sa[u][c][r] = -INFINITY;
        }
        f32x4 ck[4];
#pragma unroll
        for (int c = 0; c < 4; ++c) ck[c] = *(const f32x4*)(sck + 16 * c + 4 * g);
        bf16x8 pf[2][2];
#pragma unroll
        for (int u = 0; u < 2; ++u) {
            float mx = -INFINITY;
#pragma unroll
            for (int c = 0; c < 4; ++c) {
                sa[u][c] -= ck[c];
                mx = fmaxf(mx, fmaxf(fmaxf(sa[u][c][0], sa[u][c][1]), fmaxf(sa[u][c][2], sa[u][c][3])));
            }
            mx = x4_max(mx);
            if (__builtin_amdgcn_ballot_w64(mx > m[u]) != 0ull) {
                const float mn = fmaxf(m[u], mx);
                const float alpha = __builtin_amdgcn_exp2f(m[u] - mn);
                m[u] = mn;
#pragma unroll
                for (int c = 0; c < 5; ++c) o[u][c] *= alpha;
            }
            const float mn = m[u];
#pragma unroll
            for (int c = 0; c < 4; ++c)
#pragma unroll
                for (int r = 0; r < 4; ++r) sa[u][c][r] = __builtin_amdgcn_exp2f(sa[u][c][r] - mn);
#pragma unroll
            for (int s2 = 0; s2 < 2; ++s2) {
                uint4 uu;
                uu.x = cvt_pk_bf16(sa[u][2 * s2][0], sa[u][2 * s2][1]); uu.y = cvt_pk_bf16(sa[u][2 * s2][2], sa[u][2 * s2][3]);
                uu.z = cvt_pk_bf16(sa[u][2 * s2 + 1][0], sa[u][2 * s2 + 1][1]); uu.w = cvt_pk_bf16(sa[u][2 * s2 + 1][2], sa[u][2 * s2 + 1][3]);
                pf[u][s2] = __builtin_bit_cast(bf16x8, uu);
            }
        }
        {
            uint2 vr[4][4];
            tr_read_4c(sV, g, lr, vr);
#pragma unroll
            for (int c = 0; c < 4; ++c)
#pragma unroll
                for (int s2 = 0; s2 < 2; ++s2) {
                    const bf16x8 vf = tr_pair(vr[c][2 * s2], vr[c][2 * s2 + 1]);
                    o[0][c] = __builtin_amdgcn_mfma_f32_16x16x32_bf16(vf, pf[0][s2], o[0][c], 0, 0, 0);
                    o[1][c] = __builtin_amdgcn_mfma_f32_16x16x32_bf16(vf, pf[1][s2], o[1][c], 0, 0, 0);
                }
#pragma unroll
            for (int s2 = 0; s2 < 2; ++s2) {
                o[0][4] = __builtin_amdgcn_mfma_f32_16x16x32_bf16(vones, pf[0][s2], o[0][4], 0, 0, 0);
                o[1][4] = __builtin_amdgcn_mfma_f32_16x16x32_bf16(vones, pf[1][s2], o[1][4], 0, 0, 0);
            }
        }
        if (kv > 0) store_tile(buf ^ 1);
        __syncthreads();
    }
#pragma unroll
    for (int u = 0; u < 2; ++u) {
        const float ls = __shfl(o[u][4][0], lr, 64);
        const float inv = 1.0f / ls;
        if (qvalid[u]) {
            bf16_t* y = (bf16_t*)(P.ws + WS_Z) + (size_t)(b * L + tq[u]) * NZ + 512 + h * 64 + 4 * g;
#pragma unroll
            for (int c = 0; c < 4; ++c) {
                uint2 uu; uu.x = pk2(o[u][c][0] * inv, o[u][c][1] * inv); uu.y = pk2(o[u][c][2] * inv, o[u][c][3] * inv);
                *(uint2*)(y + 16 * c) = uu;
            }
        }
    }
}

__device__ __forceinline__ void conv_item(const Params& P, int ci) {
    const int tid = opaque_tid(), cc = tid & 127, rg = tid >> 7;
    const bf16_t* z = (const bf16_t*)(P.ws + WS_Z);
    bf16_t* qk = (bf16_t*)(P.ws + WS_RA);
    const int col0 = cc * 8;
    float w[4][8];
#pragma unroll
    for (int j = 0; j < 4; ++j) {
        const float4 a = *(const float4*)(P.conv_qk + j * 1024 + col0), b = *(const float4*)(P.conv_qk + j * 1024 + col0 + 4);
        w[j][0] = a.x; w[j][1] = a.y; w[j][2] = a.z; w[j][3] = a.w; w[j][4] = b.x; w[j][5] = b.y; w[j][6] = b.z; w[j][7] = b.w;
    }
    const float oscale = (col0 >= 512) ? 0.08838834764831845f : 1.0f;
    const int r0 = ci * 64 + rg * 32;
    int t = r0 % L;
    float xw[3][8];
#pragma unroll
    for (int j = 0; j < 3; ++j) {
        const int back = 3 - j;
        if (t - back >= 0) {
            const uint4 v = *(const uint4*)(z + (size_t)(r0 - back) * NZ + col0);
            xw[j][0] = bflo(v.x); xw[j][1] = bfhi(v.x); xw[j][2] = bflo(v.y); xw[j][3] = bfhi(v.y); xw[j][4] = bflo(v.z); xw[j][5] = bfhi(v.z); xw[j][6] = bflo(v.w); xw[j][7] = bfhi(v.w);
        } else {
#pragma unroll
            for (int e = 0; e < 8; ++e) xw[j][e] = 0.f;
        }
    }
#pragma unroll 2
    for (int i = 0; i < 32; ++i) {
        const int r = r0 + i;
        if (t == 0) {
#pragma unroll
            for (int j = 0; j < 3; ++j)
#pragma unroll
                for (int e = 0; e < 8; ++e) xw[j][e] = 0.f;
        }
        const uint4 v = *(const uint4*)(z + (size_t)r * NZ + col0);
        float xt[8];
        xt[0] = bflo(v.x); xt[1] = bfhi(v.x); xt[2] = bflo(v.y); xt[3] = bfhi(v.y); xt[4] = bflo(v.z); xt[5] = bfhi(v.z); xt[6] = bflo(v.w); xt[7] = bfhi(v.w);
        float o[8];
#pragma unroll
        for (int e = 0; e < 8; ++e) {
            const float cv = w[0][e] * xw[0][e] + w[1][e] * xw[1][e] + w[2][e] * xw[2][e] + w[3][e] * xt[e];
            o[e] = oscale * cv / (1.f + __expf(-cv));
            xw[0][e] = xw[1][e]; xw[1][e] = xw[2][e]; xw[2][e] = xt[e];
        }
        uint4 ov; ov.x = pk2(o[0], o[1]); ov.y = pk2(o[2], o[3]); ov.z = pk2(o[4], o[5]); ov.w = pk2(o[6], o[7]);
        *(uint4*)(qk + (size_t)r * 1024 + col0) = ov;
        t = (t + 1 == L) ? 0 : t + 1;
    }
}

constexpr int ST_IMG = 36864;
__device__ __forceinline__ int st_piece_off(int jt, int c, int g, int lr) { return (jt >> 2) * 18432 + vimg_off(16 * c + lr, 2 * (jt & 3) + (g >> 1)) + 8 * (g & 1); }

__device__ __forceinline__ void mlstm_stage_kv(const Params& P, int b, int h, int k, unsigned char* sKimg, unsigned char* sVimg, int tid) {
    const bf16_t* z = (const bf16_t*)(P.ws + WS_Z);
    const bf16_t* qk = (const bf16_t*)(P.ws + WS_RA);
    uint4 pk_[4], pv_[4];
#pragma unroll
    for (int j = 0; j < 4; ++j) {
        const int id = tid + 256 * j, row = id >> 4, ch16 = id & 15, pos = 64 * k + row;
        const bool ok = pos < L;
        pk_[j] = ok ? *(const uint4*)(qk + (size_t)(b * L + pos) * 1024 + 512 + h * 128 + ch16 * 8) : make_uint4(0, 0, 0, 0);
        pv_[j] = ok ? *(const uint4*)(z + (size_t)(b * L + pos) * NZ + ZC_MV + h * 128 + ch16 * 8) : make_uint4(0, 0, 0, 0);
    }
#pragma unroll
    for (int j = 0; j < 4; ++j) {
        const int id = tid + 256 * j, row = id >> 4, ch16 = id & 15;
        *(uint4*)(sKimg + (ch16 >> 3) * 8192 + vimg_off(row, ch16 & 7)) = pk_[j];
        *(uint4*)(sVimg + (ch16 >> 3) * 8192 + vimg_off(row, ch16 & 7)) = pv_[j];
    }
    if (tid < 128) {
        const int row = tid >> 1, ch = tid & 1;
        *(uint4*)(sVimg + 16384 + vimg_off(row, ch)) = ch ? make_uint4(0, 0, 0, 0) : make_uint4(0x3F80u, 0, 0, 0);
    }
}

__device__ __forceinline__ void mlstm_stage_A(const Params& P, int b, int h, int k, unsigned char* sKimg, unsigned char* sVimg, int tid) {
    const bf16_t* z = (const bf16_t*)(P.ws + WS_Z);
    bf16_t* qk = (bf16_t*)(P.ws + WS_RA);
    uint4 pv_[4];
#pragma unroll
    for (int j = 0; j < 4; ++j) {
        const int id = tid + 256 * j, row = id >> 4, ch16 = id & 15, pos = 64 * k + row;
        pv_[j] = (pos < L) ? *(const uint4*)(z + (size_t)(b * L + pos) * NZ + ZC_MV + h * 128 + ch16 * 8) : make_uint4(0, 0, 0, 0);
    }
    const int cch = tid & 31, rg = tid >> 5, isk = cch >> 4;
    const int zcol = (isk ? ZC_MK : ZC_MQ) + h * 128 + (cch & 15) * 8;
    float w[4][8];
#pragma unroll
    for (int j = 0; j < 4; ++j) {
        const float4 a = *(const float4*)(P.conv_qk + j * 1024 + zcol), c = *(const float4*)(P.conv_qk + j * 1024 + zcol + 4);
        w[j][0] = a.x; w[j][1] = a.y; w[j][2] = a.z; w[j][3] = a.w; w[j][4] = c.x; w[j][5] = c.y; w[j][6] = c.z; w[j][7] = c.w;
    }
    const float oscale = isk ? 0.08838834764831845f : 1.0f;
    const int p0 = 64 * k + 8 * rg;
    uint4 raw[11];
#pragma unroll
    for (int i = 0; i < 11; ++i) {
        const int pos = p0 - 3 + i;
        raw[i] = (pos >= 0 && pos < L) ? *(const uint4*)(z + (size_t)(b * L + pos) * NZ + zcol) : make_uint4(0, 0, 0, 0);
    }
#pragma unroll
    for (int j = 0; j < 4; ++j) {
        const int id = tid + 256 * j, row = id >> 4, ch16 = id & 15;
        *(uint4*)(sVimg + (ch16 >> 3) * 8192 + vimg_off(row, ch16 & 7)) = pv_[j];
    }
    if (tid < 128) {
        const int row = tid >> 1, ch = tid & 1;
        *(uint4*)(sVimg + 16384 + vimg_off(row, ch)) = ch ? make_uint4(0, 0, 0, 0) : make_uint4(0x3F80u, 0, 0, 0);
    }
#pragma unroll
    for (int i = 0; i < 8; ++i) {
        const int pos = p0 + i, row = 8 * rg + i;
        float o[8];
#pragma unroll
        for (int e = 0; e < 8; ++e) {
            const unsigned w0 = (&raw[i].x)[e >> 1], w1 = (&raw[i + 1].x)[e >> 1], w2 = (&raw[i + 2].x)[e >> 1], w3 = (&raw[i + 3].x)[e >> 1];
            const float x0 = (e & 1) ? bfhi(w0) : bflo(w0), x1 = (e & 1) ? bfhi(w1) : bflo(w1), x2 = (e & 1) ? bfhi(w2) : bflo(w2), x3 = (e & 1) ? bfhi(w3) : bflo(w3);
            const float cv = w[0][e] * x0 + w[1][e] * x1 + w[2][e] * x2 + w[3][e] * x3;
            o[e] = oscale * cv / (1.f + __expf(-cv));
        }
        uint4 ov; ov.x = pk2(o[0], o[1]); ov.y = pk2(o[2], o[3]); ov.z = pk2(o[4], o[5]); ov.w = pk2(o[6], o[7]);
        const bool ok = pos < L;
        if (!ok) ov = make_uint4(0, 0, 0, 0);
        if (ok) *(uint4*)(qk + (size_t)(b * L + pos) * 1024 + (isk ? 512 : 0) + h * 128 + (cch & 15) * 8) = ov;
        if (isk) { const int ch16 = cch & 15; *(uint4*)(sKimg + (ch16 >> 3) * 8192 + vimg_off(row, ch16 & 7)) = ov; }
    }
}

__device__ __forceinline__ void mlstm_A(const Params& P, int item, unsigned char* smem) {
    const int tid = opaque_tid(), lane = tid & 63, w = tid >> 6, g = lane >> 4, lr = lane & 15;
    const int wu = __builtin_amdgcn_readfirstlane(w);
    const int k = item >> 5, bh = item & 31, b = bh >> 2, h = bh & 3;
    const float* gates = (const float*)(P.ws + WS_GATES);
    const unsigned char* sK = smem; const unsigned char* sV = smem + 16384;
    float* ga = (float*)(smem + 40960);
    mlstm_stage_A(P, b, h, k, smem, smem + 16384, tid);
    if (wu == 0) {
        const int pos = 64 * k + lane;
        float lf = 0.f, li = -INFINITY;
        if (pos < L) { lf = gates[(size_t)(b * L + pos) * 16 + 4 + h]; li = gates[(size_t)(b * L + pos) * 16 + h]; }
        float bc = lf;
#pragma unroll
        for (int o = 1; o < 64; o <<= 1) { const float n = __shfl_up(bc, o, 64); if (lane >= o) bc += n; }
        const float a = li - bc;
        const float A = wave_max(a);
        ga[lane] = __expf(a - A);
        if (lane == 63) { float* msc = (float*)(P.ws + WS_MSC) + ((size_t)bh * 33 + k) * 4; msc[0] = A; msc[1] = bc; }
    }
    __syncthreads();
    f32x4 Ct[2][9];
#pragma unroll
    for (int a = 0; a < 2; ++a)
#pragma unroll
        for (int c = 0; c < 9; ++c) Ct[a][c] = (f32x4){0.f, 0.f, 0.f, 0.f};
    bf16x8 kt[2][2];
#pragma unroll
    for (int a = 0; a < 2; ++a)
#pragma unroll
        for (int s2 = 0; s2 < 2; ++s2) {
            const int jt = 2 * w + a;
            kt[a][s2] = tr_pair(tr_frag(sK + (jt >> 2) * 8192, 32 * s2, jt & 3, g, lr), tr_frag(sK + (jt >> 2) * 8192, 32 * s2 + 16, jt & 3, g, lr));
        }
    f32x4 wg4[4];
#pragma unroll
    for (int j = 0; j < 4; ++j) wg4[j] = *(const f32x4*)(ga + 16 * j + 4 * g);
#define MA_TILE(c, lo0, hi0, lo1, hi1) { \
        { const f32x4 w0 = wg4[0], w1 = wg4[1]; uint4 o; \
          o.x = cvt_pk_bf16(bflo(lo0.x) * w0[0], bfhi(lo0.x) * w0[1]); o.y = cvt_pk_bf16(bflo(lo0.y) * w0[2], bfhi(lo0.y) * w0[3]); \
          o.z = cvt_pk_bf16(bflo(hi0.x) * w1[0], bfhi(hi0.x) * w1[1]); o.w = cvt_pk_bf16(bflo(hi0.y) * w1[2], bfhi(hi0.y) * w1[3]); \
          const bf16x8 vw = __builtin_bit_cast(bf16x8, o); \
          Ct[0][c] = __builtin_amdgcn_mfma_f32_16x16x32_bf16(kt[0][0], vw, Ct[0][c], 0, 0, 0); Ct[1][c] = __builtin_amdgcn_mfma_f32_16x16x32_bf16(kt[1][0], vw, Ct[1][c], 0, 0, 0); } \
        { const f32x4 w0 = wg4[2], w1 = wg4[3]; uint4 o; \
          o.x = cvt_pk_bf16(bflo(lo1.x) * w0[0], bfhi(lo1.x) * w0[1]); o.y = cvt_pk_bf16(bflo(lo1.y) * w0[2], bfhi(lo1.y) * w0[3]); \
          o.z = cvt_pk_bf16(bflo(hi1.x) * w1[0], bfhi(hi1.x) * w1[1]); o.w = cvt_pk_bf16(bflo(hi1.y) * w1[2], bfhi(hi1.y) * w1[3]); \
          const bf16x8 vw = __builtin_bit_cast(bf16x8, o); \
          Ct[0][c] = __builtin_amdgcn_mfma_f32_16x16x32_bf16(kt[0][1], vw, Ct[0][c], 0, 0, 0); Ct[1][c] = __builtin_amdgcn_mfma_f32_16x16x32_bf16(kt[1][1], vw, Ct[1][c], 0, 0, 0); } }
    {
        uint2 vr[4][4];
        tr_read_4c(sV, g, lr, vr);
        MA_TILE(0, vr[0][0], vr[0][1], vr[0][2], vr[0][3]) MA_TILE(1, vr[1][0], vr[1][1], vr[1][2], vr[1][3])
        MA_TILE(2, vr[2][0], vr[2][1], vr[2][2], vr[2][3]) MA_TILE(3, vr[3][0], vr[3][1], vr[3][2], vr[3][3])
        tr_read_4c(sV + 8192, g, lr, vr);
        MA_TILE(4, vr[0][0], vr[0][1], vr[0][2], vr[0][3]) MA_TILE(5, vr[1][0], vr[1][1], vr[1][2], vr[1][3])
        MA_TILE(6, vr[2][0], vr[2][1], vr[2][2], vr[2][3]) MA_TILE(7, vr[3][0], vr[3][1], vr[3][2], vr[3][3])
        const uint2 o0 = tr_frag(sV + 16384, 0, 0, g, lr), o1 = tr_frag(sV + 16384, 16, 0, g, lr), o2 = tr_frag(sV + 16384, 32, 0, g, lr), o3 = tr_frag(sV + 16384, 48, 0, g, lr);
        MA_TILE(8, o0, o1, o2, o3)
    }
#undef MA_TILE
    unsigned char* slot = P.ws + WS_MST + ((size_t)bh * 33 + k) * ST_IMG;
#pragma unroll
    for (int a = 0; a < 2; ++a)
#pragma unroll
        for (int c = 0; c < 9; ++c) {
            uint2 u; u.x = cvt_pk_bf16(Ct[a][c][0], Ct[a][c][1]); u.y = cvt_pk_bf16(Ct[a][c][2], Ct[a][c][3]);
            *(uint2*)(slot + st_piece_off(2 * w + a, c, g, lr)) = u;
        }
}

__device__ __forceinline__ void mlstm_B(const Params& P, int item) {
    const int tid = opaque_tid();
    const int bh = item / 3, part = item - bh * 3;
    const unsigned char* base = P.ws + WS_MST + (size_t)bh * 33 * ST_IMG + part * 12288 + tid * 48;
    unsigned char* obase = P.ws + WS_CBI + (size_t)bh * 33 * ST_IMG + part * 12288 + tid * 48;
    float* msc = (float*)(P.ws + WS_MSC) + (size_t)bh * 33 * 4;
    float C[6][4];
#pragma unroll
    for (int i = 0; i < 6; ++i)
#pragma unroll
        for (int r = 0; r < 4; ++r) C[i][r] = 0.f;
    float m = 0.f;
    uint2 d0[6], d1[6];
    float2 ab0, ab1;
#pragma unroll
    for (int i = 0; i < 6; ++i) { d0[i] = *(const uint2*)(base + i * 8); d1[i] = *(const uint2*)(base + ST_IMG + i * 8); }
    ab0 = *(const float2*)(msc); ab1 = *(const float2*)(msc + 4);
    for (int k = 0; k < 33; ++k) {
        uint2 d2[6]; float2 ab2 = make_float2(0.f, 0.f);
        if (k + 2 < 33) {
#pragma unroll
            for (int i = 0; i < 6; ++i) d2[i] = *(const uint2*)(base + (size_t)(k + 2) * ST_IMG + i * 8);
            ab2 = *(const float2*)(msc + (k + 2) * 4);
        } else {
#pragma unroll
            for (int i = 0; i < 6; ++i) d2[i] = make_uint2(0, 0);
        }
#pragma unroll
        for (int i = 0; i < 6; ++i) {
            uint2 u; u.x = cvt_pk_bf16(C[i][0], C[i][1]); u.y = cvt_pk_bf16(C[i][2], C[i][3]);
            *(uint2*)(obase + (size_t)k * ST_IMG + i * 8) = u;
        }
        if (tid == 0 && part == 0) msc[k * 4 + 2] = m;
        const float M = fmaxf(m, ab0.x);
        const float decay = __expf(m - M), sc = __expf(ab0.x - M);
#pragma unroll
        for (int i = 0; i < 6; ++i) {
            C[i][0] = decay * C[i][0] + sc * bflo(d0[i].x); C[i][1] = decay * C[i][1] + sc * bfhi(d0[i].x);
            C[i][2] = decay * C[i][2] + sc * bflo(d0[i].y); C[i][3] = decay * C[i][3] + sc * bfhi(d0[i].y);
        }
        m = ab0.y + M;
#pragma unroll
        for (int i = 0; i < 6; ++i) { d0[i] = d1[i]; d1[i] = d2[i]; }
        ab0 = ab1; ab1 = ab2;
    }
}

__device__ __forceinline__ void mlstm_C(const Params& P, int item, unsigned char* smem) {
    const int tid = opaque_tid(), lane = tid & 63, w = tid >> 6, g = lane >> 4, lr = lane & 15;
    const int wu = __builtin_amdgcn_readfirstlane(w);
    const int k = item >> 5, bh = item & 31, b = bh >> 2, h = bh & 3;
    const bf16_t* z = (const bf16_t*)(P.ws + WS_Z);
    const bf16_t* qk = (const bf16_t*)(P.ws + WS_RA);
    const float* gates = (const float*)(P.ws + WS_GATES);
    bf16_t* y = (bf16_t*)(P.ws + WS_Z);
    const unsigned char* sK = smem; const unsigned char* sV = smem + 36864; unsigned char* sCb = smem;
    float* ga = (float*)(smem + 61440);
    const int pos = 64 * k + 16 * w + lr;
    const bool tvalid = pos < L;
    const size_t rrow = (size_t)(b * L + (tvalid ? pos : 0));
    const unsigned char* cslot = P.ws + WS_CBI + ((size_t)bh * 33 + k) * ST_IMG + tid * 16;
    const uint4 cb0 = *(const uint4*)(cslot), cb1 = *(const uint4*)(cslot + 4096), cb2 = *(const uint4*)(cslot + 8192), cb3 = *(const uint4*)(cslot + 12288), cb4 = *(const uint4*)(cslot + 16384),
                cb5 = *(const uint4*)(cslot + 20480), cb6 = *(const uint4*)(cslot + 24576), cb7 = *(const uint4*)(cslot + 28672), cb8 = *(const uint4*)(cslot + 32768);
    bf16x8 qf[4];
    {
        const bf16_t* qp = qk + rrow * 1024 + h * 128 + 8 * g;
#pragma unroll
        for (int ks = 0; ks < 4; ++ks) { qf[ks] = *(const bf16x8*)(qp + 32 * ks); if (!tvalid) qf[ks] = (bf16x8){0, 0, 0, 0, 0, 0, 0, 0}; }
    }
    mlstm_stage_kv(P, b, h, k, smem, smem + 36864, tid);
    if (wu == 0) {
        const float m_prev = ((const float*)(P.ws + WS_MSC))[((size_t)bh * 33 + k) * 4 + 2];
        const int p2 = 64 * k + lane;
        float lf = 0.f, li = -INFINITY;
        if (p2 < L) { lf = gates[(size_t)(b * L + p2) * 16 + 4 + h]; li = gates[(size_t)(b * L + p2) * 16 + h]; }
        float bc = lf;
#pragma unroll
        for (int o = 1; o < 64; o <<= 1) { const float n = __shfl_up(bc, o, 64); if (lane >= o) bc += n; }
        const float a = li - bc;
        float am = a;
#pragma unroll
        for (int o = 1; o < 64; o <<= 1) { const float n = __shfl_up(am, o, 64); if (lane >= o) am = fmaxf(am, n); }
        const float M = fmaxf(m_prev, am);
        ga[lane] = a; ga[64 + lane] = __expf(m_prev - M); ga[128 + lane] = __expf(-(bc + M)); ga[192 + lane] = M;
    }
    __syncthreads();
    const float Mt = ga[192 + 16 * w + lr], Wi = ga[64 + 16 * w + lr], Et = ga[128 + 16 * w + lr];
    bf16x8 pf[2];
    {
        f32x4 sa[4];
#pragma unroll
        for (int c = 0; c < 4; ++c) {
            sa[c] = (f32x4){0.f, 0.f, 0.f, 0.f};
            if (c <= wu) {
#pragma unroll
                for (int ks = 0; ks < 4; ++ks) {
                    const bf16x8 kf = *(const bf16x8*)(sK + (ks >> 1) * 8192 + vimg_off(16 * c + lr, 4 * (ks & 1) + g));
                    sa[c] = __builtin_amdgcn_mfma_f32_16x16x32_bf16(kf, qf[ks], sa[c], 0, 0, 0);
                }
                const f32x4 av = *(const f32x4*)(ga + 16 * c + 4 * g);
#pragma unroll
                for (int r = 0; r < 4; ++r) {
                    const float d = __expf(av[r] - Mt);
                    sa[c][r] = (16 * c + 4 * g + r <= 16 * w + lr) ? sa[c][r] * d : 0.f;
                }
            }
        }
#pragma unroll
        for (int s2 = 0; s2 < 2; ++s2) {
            uint4 u;
            u.x = cvt_pk_bf16(sa[2 * s2][0], sa[2 * s2][1]); u.y = cvt_pk_bf16(sa[2 * s2][2], sa[2 * s2][3]);
            u.z = cvt_pk_bf16(sa[2 * s2 + 1][0], sa[2 * s2 + 1][1]); u.w = cvt_pk_bf16(sa[2 * s2 + 1][2], sa[2 * s2 + 1][3]);
            pf[s2] = __builtin_bit_cast(bf16x8, u);
        }
    }
    __syncthreads();
    {
        unsigned char* d = sCb + tid * 16;
        *(uint4*)(d) = cb0; *(uint4*)(d + 4096) = cb1; *(uint4*)(d + 8192) = cb2; *(uint4*)(d + 12288) = cb3; *(uint4*)(d + 16384) = cb4;
        *(uint4*)(d + 20480) = cb5; *(uint4*)(d + 24576) = cb6; *(uint4*)(d + 28672) = cb7; *(uint4*)(d + 32768) = cb8;
    }
    __syncthreads();
    f32x4 na[9];
#define MC_TILE(c, lo0, hi0, lo1, hi1) { \
        na[c] = (f32x4){0.f, 0.f, 0.f, 0.f}; \
        _Pragma("unroll") for (int ks = 0; ks < 4; ++ks) { \
            const bf16x8 cf = *(const bf16x8*)(sCb + (ks >> 1) * 18432 + vimg_off(16 * (c) + lr, 4 * (ks & 1) + g)); \
            na[c] = __builtin_amdgcn_mfma_f32_16x16x32_bf16(cf, qf[ks], na[c], 0, 0, 0); } \
        na[c] *= Wi; \
        na[c] = __builtin_amdgcn_mfma_f32_16x16x32_bf16(tr_pair(lo0, hi0), pf[0], na[c], 0, 0, 0); \
        na[c] = __builtin_amdgcn_mfma_f32_16x16x32_bf16(tr_pair(lo1, hi1), pf[1], na[c], 0, 0, 0); }
    {
        uint2 vr[4][4];
        tr_read_4c(sV, g, lr, vr);
        MC_TILE(0, vr[0][0], vr[0][1], vr[0][2], vr[0][3]) MC_TILE(1, vr[1][0], vr[1][1], vr[1][2], vr[1][3])
        MC_TILE(2, vr[2][0], vr[2][1], vr[2][2], vr[2][3]) MC_TILE(3, vr[3][0], vr[3][1], vr[3][2], vr[3][3])
        tr_read_4c(sV + 8192, g, lr, vr);
        MC_TILE(4, vr[0][0], vr[0][1], vr[0][2], vr[0][3]) MC_TILE(5, vr[1][0], vr[1][1], vr[1][2], vr[1][3])
        MC_TILE(6, vr[2][0], vr[2][1], vr[2][2], vr[2][3]) MC_TILE(7, vr[3][0], vr[3][1], vr[3][2], vr[3][3])
        const uint2 o0 = tr_frag(sV + 16384, 0, 0, g, lr), o1 = tr_frag(sV + 16384, 16, 0, g, lr), o2 = tr_frag(sV + 16384, 32, 0, g, lr), o3 = tr_frag(sV + 16384, 48, 0, g, lr);
        MC_TILE(8, o0, o1, o2, o3)
    }
#undef MC_TILE
    const float den = __shfl(na[8][0], lr, 64);
    const float rden = 1.0f / fmaxf(fabsf(den), Et);
    float hs = 0.f;
#pragma unroll
    for (int c = 0; c < 8; ++c) { na[c] *= rden; hs += na[c][0] * na[c][0] + na[c][1] * na[c][1] + na[c][2] * na[c][2] + na[c][3] * na[c][3]; }
    hs = x4_sum(hs);
    const float rstd = rsqrtf(hs * (1.0f / 128.0f) + EPS);
    const float* gainp = P.m_out_norm + h * 128 + 4 * g;
#pragma unroll
    for (int c = 0; c < 8; ++c) {
        const uint2 og = *(const uint2*)(z + rrow * NZ + ZC_MO + h * 128 + 16 * c + 4 * g);
        const float o0 = bflo(og.x), o1 = bfhi(og.x), o2 = bflo(og.y), o3 = bfhi(og.y);
        const float4 gn = *(const float4*)(gainp + 16 * c);
        uint2 u;
        u.x = pk2(na[c][0] * rstd * gn.x / (1.f + __expf(-o0)), na[c][1] * rstd * gn.y / (1.f + __expf(-o1)));
        u.y = pk2(na[c][2] * rstd * gn.z / (1.f + __expf(-o2)), na[c][3] * rstd * gn.w / (1.f + __expf(-o3)));
        if (tvalid) *(uint2*)(y + rrow * NZ + h * 128 + 16 * c + 4 * g) = u;
    }
}

__device__ __forceinline__ void peer_token(const Params& P, int t, int tnext, uint4& tkw, int lane, int* sidx, float* sval, int* sid, float* sgate, const unsigned char* slut, const unsigned* szero) {
    {
        const unsigned kk[4] = {tkw.x, tkw.y, tkw.z, tkw.w};
#pragma unroll
        for (int i = 0; i < 4; ++i) {
            const unsigned k = kk[i];
            sidx[lane * 4 + i] = 127 - (int)(k & 127u);
            sval[lane * 4 + i] = unord_key(k & ~127u);
        }
        tkw = *(const uint4*)((const unsigned*)(P.ws + WS_TK) + (size_t)tnext * 256 + lane * 4);
    }
    const bf16_t* xn = (const bf16_t*)(P.ws + WS_XN) + (size_t)t * DM;
    const uint4 xa_pre = *(const uint4*)(xn + lane * 16), xb_pre = *(const uint4*)(xn + lane * 16 + 8);
    const float rstd = ((const float*)(P.ws + WS_RSTD))[t];
    __builtin_amdgcn_s_waitcnt(0xc07f);
    __builtin_amdgcn_wave_barrier();
    {
        const int hd = lane >> 3, sub = lane & 7;
        unsigned x[8];
#pragma unroll
        for (int r = 0; r < 8; ++r) {
            const int c = sub * 8 + r;
            const unsigned ij = slut[c < 50 ? c : 0];
            const int i = ij >> 4, j = ij & 15;
            const unsigned kx = (ord_key(sval[(2 * hd) * 16 + i] + sval[(2 * hd + 1) * 16 + j]) & ~255u) | (unsigned)(255 - (i * 16 + j));
            x[r] = c < 50 ? kx : 0u;
        }
#pragma unroll
        for (int k = 2; k <= 64; k <<= 1) {
#pragma unroll
            for (int j = k >> 1; j >= 1; j >>= 1) {
                if (j >= 8) {
                    const int ld = j >> 3;
                    const bool lower = (sub & ld) == 0;
                    const bool desc = k >= 64 ? true : ((sub * 8) & k) == 0;
                    const bool takemax = (lower == desc);
#pragma unroll
                    for (int r = 0; r < 8; ++r) {
                        const unsigned o = (unsigned)__shfl_xor((int)x[r], ld, 64);
                        const unsigned hi = max(x[r], o), lo = min(x[r], o);
                        x[r] = takemax ? hi : lo;
                    }
                } else {
#pragma unroll
                    for (int r = 0; r < 8; ++r) {
                        if ((r & j) == 0) {
                            const int p = r | j;
                            const unsigned hi = max(x[r], x[p]), lo = min(x[r], x[p]);
                            if (k <= 4) { const bool desc = (r & k) == 0; x[r] = desc ? hi : lo; x[p] = desc ? lo : hi; }
                            else if (k >= 64) { x[r] = hi; x[p] = lo; }
                            else { const bool desc = ((sub * 8) & k) == 0; x[r] = desc ? hi : lo; x[p] = desc ? lo : hi; }
                        }
                    }
                }
            }
        }
        const float smax = unord_key((unsigned)__shfl((int)x[0], hd * 8, 64) & ~255u);
        float e[8]; float den = 0.f;
#pragma unroll
        for (int r = 0; r < 8; ++r) { e[r] = __expf(unord_key(x[r] & ~255u) - smax); den += e[r]; }
        den += __shfl_xor(den, 1, 64);
        const float inv = 1.f / den;
        if (sub < 2) {
#pragma unroll
            for (int r = 0; r < 8; ++r) {
                const int pos = 255 - (int)(x[r] & 255u), i = pos >> 4, j = pos & 15;
                sid[hd * 16 + sub * 8 + r] = sidx[(2 * hd) * 16 + i] * 128 + sidx[(2 * hd + 1) * 16 + j];
                sgate[hd * 16 + sub * 8 + r] = e[r] * inv;
            }
        }
    }
    __builtin_amdgcn_s_waitcnt(0xc07f);
    __builtin_amdgcn_wave_barrier();
    const unsigned char* V = P.ws + WS_V + lane * 8;
    const float* usc = (const float*)(P.ws + WS_USC);
    const float* vsc = (const float*)(P.ws + WS_VSC);
    const int g = lane >> 4, lr = lane & 15;
    unsigned char* shi = (unsigned char*)sval;
    unsigned char* slo = (unsigned char*)sidx;
    {
        const uint4 xa = xa_pre, xb = xb_pre;
        const unsigned xw[8] = {xa.x, xa.y, xa.z, xa.w, xb.x, xb.y, xb.z, xb.w};
        unsigned hi[4], lo[4];
#pragma unroll
        for (int i = 0; i < 4; ++i) {
            const float x0 = bflo(xw[2 * i]), x1 = bfhi(xw[2 * i]), x2 = bflo(xw[2 * i + 1]), x3 = bfhi(xw[2 * i + 1]);
            int wd = 0;
            wd = __builtin_amdgcn_cvt_pk_fp8_f32(x0, x1, wd, false);
            wd = __builtin_amdgcn_cvt_pk_fp8_f32(x2, x3, wd, true);
            const f32x2 h01 = __builtin_amdgcn_cvt_pk_f32_fp8(wd, false), h23 = __builtin_amdgcn_cvt_pk_f32_fp8(wd, true);
            int wl = 0;
            wl = __builtin_amdgcn_cvt_pk_fp8_f32(x0 - h01.x, x1 - h01.y, wl, false);
            wl = __builtin_amdgcn_cvt_pk_fp8_f32(x2 - h23.x, x3 - h23.y, wl, true);
            hi[i] = (unsigned)wd; lo[i] = (unsigned)wl;
        }
        *(uint4*)(shi + lane * 16) = make_uint4(hi[0], hi[1], hi[2], hi[3]);
        *(uint4*)(slo + lane * 16) = make_uint4(lo[0], lo[1], lo[2], lo[3]);
    }
    __builtin_amdgcn_s_waitcnt(0xc07f);
    __builtin_amdgcn_wave_barrier();
    {
        typedef int v8i __attribute__((ext_vector_type(8)));
        const unsigned char* Ub = P.ws + WS_U;
        const unsigned lofs = 64u * (unsigned)(lr >> 3) + 16u * (unsigned)g;
        const unsigned char* bsrc = (lr < 4) ? (((lr & 2) ? slo : shi) + 128 * (lr & 1) + 16 * g) : (const unsigned char*)szero;
        const int bstep = (lr < 4) ? 256 : 0, bhalf = (lr < 4) ? 64 : 16;
        v8i Bv[4];
#pragma unroll
        for (int st = 0; st < 4; ++st) {
            const uint4 b0 = *(const uint4*)(bsrc + bstep * st), b1 = *(const uint4*)(bsrc + bstep * st + bhalf);
            Bv[st] = (v8i){(int)b0.x, (int)b0.y, (int)b0.z, (int)b0.w, (int)b1.x, (int)b1.y, (int)b1.z, (int)b1.w};
        }
        __builtin_amdgcn_s_waitcnt(0xc07f);
        __builtin_amdgcn_wave_barrier();
        float* sact = (float*)sidx + 128 * (lr & 3) + 4 * (g & 1);
        const bool owner = (lr < 4) && ((g >> 1) == (lr & 1));
        uint4 abuf[2][2][4];
        unsigned off2[2];
#pragma unroll
        for (int hh = 0; hh < 2; ++hh) off2[hh] = (unsigned)sid[8 * hh + (lr & 7)] * 512u + lofs;
#pragma unroll
        for (int hh = 0; hh < 2; ++hh)
#pragma unroll
            for (int st = 0; st < 4; ++st) abuf[0][hh][st] = *(const uint4*)(Ub + (off2[hh] + 128 * st));
#pragma unroll
        for (int T = 0; T < 8; ++T) {
            if (T + 1 < 8) {
#pragma unroll
                for (int hh = 0; hh < 2; ++hh) off2[hh] = (unsigned)sid[16 * (T + 1) + 8 * hh + (lr & 7)] * 512u + lofs;
#pragma unroll
                for (int hh = 0; hh < 2; ++hh)
#pragma unroll
                    for (int st = 0; st < 4; ++st) abuf[(T + 1) & 1][hh][st] = *(const uint4*)(Ub + (off2[hh] + 128 * st));
            }
#pragma unroll
            for (int hh = 0; hh < 2; ++hh) {
                f32x4 au = (f32x4){0.f, 0.f, 0.f, 0.f};
#pragma unroll
                for (int st = 0; st < 4; ++st) {
                    const uint4 a4 = abuf[T & 1][hh][st];
                    const v8i Av = {(int)a4.x, (int)a4.y, (int)a4.z, (int)a4.w, 0, 0, 0, 0};
                    au = __builtin_amdgcn_mfma_scale_f32_16x16x128_f8f6f4(Av, Bv[st], au, 4, 0, 0, 0x7f7f7f7f, 0, 0x7f7f7f7f);
                }
                if (owner) *(f32x4*)(sact + 16 * T + 8 * hh) = au;
            }
        }
    }
    __builtin_amdgcn_s_waitcnt(0xc07f);
    __builtin_amdgcn_wave_barrier();
    {
        float* sw = (float*)sidx;
        float wv[2];
#pragma unroll
        for (int hh = 0; hh < 2; ++hh) {
            const int e = lane + 64 * hh, id = sid[e];
            const float a = ((sw[e] + sw[128 + e]) + (sw[256 + e] + sw[384 + e])) * usc[id] * rstd;
            wv[hh] = sgate[e] * vsc[id] * 0.5f * a * (1.f + erff(a * 0.70710678118654752f));
        }
        __builtin_amdgcn_s_waitcnt(0xc07f);
        __builtin_amdgcn_wave_barrier();
        sw[lane] = wv[0]; sw[lane + 64] = wv[1];
    }
    __builtin_amdgcn_s_waitcnt(0xc07f);
    __builtin_amdgcn_wave_barrier();
    const int half = lane >> 5, l5 = lane & 31;
    const int lane_o = 2 * l5 + half;
    f32x2 acc2[16];
#pragma unroll
    for (int j = 0; j < 16; ++j) acc2[j] = (f32x2){0.f, 0.f};
    const unsigned char* Vb = P.ws + WS_V;
    const unsigned vlo = (unsigned)l5 * 16u;
#pragma unroll 1
    for (int e0 = 0; e0 < 128; e0 += 16) {
        uint4 vr[8];
#pragma unroll
        for (int q = 0; q < 8; ++q) vr[q] = *(const uint4*)(Vb + ((unsigned)sid[e0 + 2 * q + half] * 512u + vlo));
        const float* sw = (const float*)sidx + e0;
        const f32x4 w0 = *(const f32x4*)(sw), w1 = *(const f32x4*)(sw + 4), w2 = *(const f32x4*)(sw + 8), w3 = *(const f32x4*)(sw + 12);
        const float wq[16] = {w0[0], w0[1], w0[2], w0[3], w1[0], w1[1], w1[2], w1[3], w2[0], w2[1], w2[2], w2[3], w3[0], w3[1], w3[2], w3[3]};
#pragma unroll
        for (int q = 0; q < 8; ++q) {
            const float w = half ? wq[2 * q + 1] : wq[2 * q];
#define FP4_AXPY(k) { acc2[k] += w * __builtin_amdgcn_cvt_scalef32_pk_f32_fp4(vr[q].x, 1.0f, k); acc2[4 + k] += w * __builtin_amdgcn_cvt_scalef32_pk_f32_fp4(vr[q].y, 1.0f, k); \
                      acc2[8 + k] += w * __builtin_amdgcn_cvt_scalef32_pk_f32_fp4(vr[q].z, 1.0f, k); acc2[12 + k] += w * __builtin_amdgcn_cvt_scalef32_pk_f32_fp4(vr[q].w, 1.0f, k); }
            FP4_AXPY(0) FP4_AXPY(1) FP4_AXPY(2) FP4_AXPY(3)
#undef FP4_AXPY
        }
    }
    f32x2 acc[8];
#pragma unroll
    for (int j = 0; j < 16; ++j) {
        const unsigned x0 = __float_as_uint(acc2[j].x), x1 = __float_as_uint(acc2[j].y);
        const auto r0 = __builtin_amdgcn_permlane32_swap(x0, x0, false, false);
        const auto r1 = __builtin_amdgcn_permlane32_swap(x1, x1, false, false);
        acc2[j].x = __uint_as_float(r0[0]) + __uint_as_float(r0[1]);
        acc2[j].y = __uint_as_float(r1[0]) + __uint_as_float(r1[1]);
    }
#pragma unroll
    for (int j = 0; j < 8; ++j) { acc[j].x = half ? acc2[8 + j].x : acc2[j].x; acc[j].y = half ? acc2[8 + j].y : acc2[j].y; }
    f32x2 xf[8];
    {
        const uint4 xa = *(const uint4*)(xn + lane_o * 16), xb = *(const uint4*)(xn + lane_o * 16 + 8);
        xf[0] = (f32x2){bflo(xa.x), bfhi(xa.x)}; xf[1] = (f32x2){bflo(xa.y), bfhi(xa.y)}; xf[2] = (f32x2){bflo(xa.z), bfhi(xa.z)}; xf[3] = (f32x2){bflo(xa.w), bfhi(xa.w)};
        xf[4] = (f32x2){bflo(xb.x), bfhi(xb.x)}; xf[5] = (f32x2){bflo(xb.y), bfhi(xb.y)}; xf[6] = (f32x2){bflo(xb.z), bfhi(xb.z)}; xf[7] = (f32x2){bflo(xb.w), bfhi(xb.w)};
    }
    float* o = P.out + (size_t)t * DM + lane_o * 16;
    float4 h0, h1, h2, h3;
    {
        const float4 g0 = *(const float4*)(P.norm_ffn + lane_o * 16), g1 = *(const float4*)(P.norm_ffn + lane_o * 16 + 4), g2 = *(const float4*)(P.norm_ffn + lane_o * 16 + 8), g3 = *(const float4*)(P.norm_ffn + lane_o * 16 + 12);
        h0.x = xf[0].x * __builtin_amdgcn_rcpf(g0.x) + acc[0].x; h0.y = xf[0].y * __builtin_amdgcn_rcpf(g0.y) + acc[0].y; h0.z = xf[1].x * __builtin_amdgcn_rcpf(g0.z) + acc[1].x; h0.w = xf[1].y * __builtin_amdgcn_rcpf(g0.w) + acc[1].y;
        h1.x = xf[2].x * __builtin_amdgcn_rcpf(g1.x) + acc[2].x; h1.y = xf[2].y * __builtin_amdgcn_rcpf(g1.y) + acc[2].y; h1.z = xf[3].x * __builtin_amdgcn_rcpf(g1.z) + acc[3].x; h1.w = xf[3].y * __builtin_amdgcn_rcpf(g1.w) + acc[3].y;
        h2.x = xf[4].x * __builtin_amdgcn_rcpf(g2.x) + acc[4].x; h2.y = xf[4].y * __builtin_amdgcn_rcpf(g2.y) + acc[4].y; h2.z = xf[5].x * __builtin_amdgcn_rcpf(g2.z) + acc[5].x; h2.w = xf[5].y * __builtin_amdgcn_rcpf(g2.w) + acc[5].y;
        h3.x = xf[6].x * __builtin_amdgcn_rcpf(g3.x) + acc[6].x; h3.y = xf[6].y * __builtin_amdgcn_rcpf(g3.y) + acc[6].y; h3.z = xf[7].x * __builtin_amdgcn_rcpf(g3.z) + acc[7].x; h3.w = xf[7].y * __builtin_amdgcn_rcpf(g3.w) + acc[7].y;
    }
    *(float4*)(o) = h0; *(float4*)(o + 4) = h1; *(float4*)(o + 8) = h2; *(float4*)(o + 12) = h3;
    __builtin_amdgcn_s_waitcnt(0xc07f);
    __builtin_amdgcn_wave_barrier();
}

#define LAS __attribute__((address_space(3)))
#define XB_TMO      128
#define XB_XCNT(j)  (256  + 64 * (j))
#define XB_XSUB(j)  (1280 + 64 * (j))
#define XB_XGEN(j)  (2304 + 64 * (j))
#define XB_TOP      3328
#define XB_TOPGEN   3392
#define XCD_BAR_WORDS 3456
#define XB_SPIN_CAP (1u << 18)
__device__ __forceinline__ unsigned xb_ld(unsigned* p)              { return __hip_atomic_load(p, __ATOMIC_RELAXED, __HIP_MEMORY_SCOPE_AGENT); }
__device__ __forceinline__ unsigned xb_add(unsigned* p, unsigned v) { return __hip_atomic_fetch_add(p, v, __ATOMIC_RELAXED, __HIP_MEMORY_SCOPE_AGENT); }
__device__ __forceinline__ unsigned xb_xcc_id() { return (unsigned)__builtin_amdgcn_s_getreg((3 << 11) | 20) & 0xFu; }
#define XB_SPIN(cond, bar) do { unsigned _sp = 0; while (cond) { __builtin_amdgcn_s_sleep(1); \
    if ((++_sp & 255u) == 0u) { if (xb_ld(&(bar)[XB_TMO])) break; if (_sp > XB_SPIN_CAP) { atomicAdd(&(bar)[XB_TMO], 1u); break; } } } } while (0)
struct XcdBarrier { unsigned* bar; unsigned x; volatile LAS unsigned* st; };
__device__ __forceinline__ XcdBarrier xcd_barrier_post(unsigned* bar, volatile LAS unsigned* st) {
    XcdBarrier b; b.bar = bar; b.x = xb_xcc_id(); b.st = st;
    if (threadIdx.x == 0) (void)xb_add(&bar[XB_XCNT(b.x)], 1u);
    return b;
}
__device__ __forceinline__ void xcd_barrier_complete(unsigned* bar, unsigned x, unsigned& nloc, unsigned& nx) {
    const unsigned G = gridDim.x * gridDim.y * gridDim.z;
    unsigned sum, cnt, mine, sp = 0u;
    for (;;) {
        sum = 0u; cnt = 0u; mine = 0u;
#pragma unroll
        for (unsigned j = 0; j < 16; ++j) { const unsigned c = xb_ld(&bar[XB_XCNT(j)]); sum += c; cnt += (c > 0u) ? 1u : 0u; mine = (j == x) ? c : mine; }
        if (sum == G) break;
        __builtin_amdgcn_s_sleep(1);
        if ((++sp & 255u) == 0u) { if (xb_ld(&bar[XB_TMO])) break; if (sp > XB_SPIN_CAP) { atomicAdd(&bar[XB_TMO], 1u); break; } }
    }
    nloc = mine > 0u ? mine : 1u; nx = cnt > 0u ? cnt : 1u;
}
__device__ __forceinline__ void xcd_barrier(const XcdBarrier& b) {
    asm volatile("s_waitcnt vmcnt(0)" ::: "memory");
    __syncthreads();
    if (threadIdx.x == 0) {
        unsigned* bar = b.bar;
        __builtin_amdgcn_s_waitcnt(0);
        unsigned nloc = b.st[0], nx = b.st[1];
        if (nloc == 0u) { xcd_barrier_complete(bar, b.x, nloc, nx); b.st[0] = nloc; b.st[1] = nx; }
        const unsigned old = xb_add(&bar[XB_XSUB(b.x)], 1u);
        const unsigned gen = old / nloc;
        if (old + 1u == (gen + 1u) * nloc) {
            __builtin_amdgcn_fence(__ATOMIC_RELEASE, "agent");
            asm volatile("s_waitcnt vmcnt(0)" ::: "memory");
            const unsigned og = xb_add(&bar[XB_TOP], 1u);
            const unsigned tg = og / nx;
            if (og + 1u == (tg + 1u) * nx) xb_add(&bar[XB_TOPGEN], 1u);
            else XB_SPIN(xb_ld(&bar[XB_TOPGEN]) == tg, bar);
            __builtin_amdgcn_fence(__ATOMIC_ACQUIRE, "agent");
            xb_add(&bar[XB_XGEN(b.x)], 1u);
            asm volatile("s_waitcnt vmcnt(0)" ::: "memory");
        } else {
            XB_SPIN(xb_ld(&bar[XB_XGEN(b.x)]) == gen, bar);
            __builtin_amdgcn_fence(__ATOMIC_ACQUIRE, "agent");
            asm volatile("s_waitcnt vmcnt(0)" ::: "memory");
        }
    }
    __syncthreads();
}

__device__ __forceinline__ void hand_release() { asm volatile("s_waitcnt vmcnt(0)" ::: "memory"); __builtin_amdgcn_fence(__ATOMIC_RELEASE, "agent"); asm volatile("s_waitcnt vmcnt(0)" ::: "memory"); }
__device__ __forceinline__ void hand_acquire() { __builtin_amdgcn_fence(__ATOMIC_ACQUIRE, "agent"); asm volatile("s_waitcnt vmcnt(0)" ::: "memory"); }

__global__ void __launch_bounds__(256, 2) mega(Params P) {
    extern __shared__ __attribute__((aligned(16))) unsigned char smem[];
    const int tid = threadIdx.x, lane = tid & 63, wave = tid >> 6;
    const int G = gridDim.x, bid = blockIdx.x;
    unsigned* ctl = (unsigned*)(P.ws + WS_CTL);
    volatile LAS unsigned* bst = (volatile LAS unsigned*)(smem + 65552);
    if (tid == 0) { bst[0] = 0u; bst[1] = 0u; }
    __syncthreads();
    const XcdBarrier xb = xcd_barrier_post(ctl + 1024, bst);
    unsigned* cucnt = ctl + 5120;
    if (tid == 0) {
        const unsigned phys = ((xb_xcc_id() & 7u) << 8) | ((unsigned)__builtin_amdgcn_s_getreg((7 << 11) | (8 << 6) | 4) & 0xFFu);
        bst[2] = phys; bst[3] = xb_add(&cucnt[phys], 1u);
    }
    phase0(P, smem);
    xcd_barrier(xb);
    {
        int vb;
        const unsigned phys = bst[2];
        unsigned part = 0;
#pragma unroll
        for (int q = 0; q < 8; ++q) { const unsigned i = (unsigned)(tid + 256 * q); const unsigned c = xb_ld(&cucnt[i]); part += (i < phys) ? c : 0u; }
#pragma unroll
        for (int o = 1; o < 64; o <<= 1) part += (unsigned)__shfl_xor((int)part, o, 64);
        if (lane == 0) bst[4 + wave] = part;
        __syncthreads();
        vb = (int)(bst[4] + bst[5] + bst[6] + bst[7] + bst[3]);
        vb = __builtin_amdgcn_readfirstlane(vb);
        if (vb < 0 || vb >= G) vb = bid;
        __syncthreads();
        if (tid == 0) bst[8] = (unsigned)vb;
        __syncthreads();
    }
#define VB_LOAD() __builtin_amdgcn_readfirstlane((int)bst[8])
    {
        const int gw = bid * 4 + wave;
        if (gw < 64) fox_cum_wave(P, gw, lane);
        const int vb = VB_LOAD();
        for (int tile = vb; tile < 129 * 28; tile += G) gemm_tile<1>(P, tile / 28, tile % 28, smem);
        {
            const int rem = (129 * 28) % G;
            if (rem > 0 && rem < G) { if (vb >= rem) convert_uv_rows(P, (vb - rem) * 4 + wave, (G - rem) * 4, lane); }
            else convert_uv_rows(P, vb * 4 + wave, G * 4, lane);
        }
    }
    xcd_barrier(xb);
    {
        volatile int* s_item = (volatile int*)(smem + 65536);
        const int wave_u = __builtin_amdgcn_readfirstlane(wave);
        auto fetch = [&](unsigned* counter) -> int {
            if (wave_u == 0) {
                unsigned v = atomicAdd(counter, lane == 0 ? 1u : 0u);
                *s_item = (int)__builtin_amdgcn_readfirstlane(v);
            }
            __syncthreads();
            const int item = __builtin_amdgcn_readfirstlane(*s_item);
            __syncthreads();
            return item;
        };
        for (;;) {
            const int item = fetch(&ctl[2]);
            if (item >= 33 * 32) break;
            mlstm_A(P, item, smem);
        }
        xcd_barrier(xb);
        for (;;) {
            const int item = fetch(&ctl[4]);
            if (item >= 96) break;
            mlstm_B(P, item);
        }
        for (;;) {
            const int item = fetch(&ctl[3]);
            if (item >= 64 * 17) break;
            attn_block(P, item & 63, 16 - (item >> 6), smem);
        }
        xcd_barrier(xb);
        for (;;) {
            const int item = fetch(&ctl[5]);
            if (item >= 33 * 32) break;
            mlstm_C(P, item, smem);
        }
    }
    xcd_barrier(xb);
    for (int tile = VB_LOAD(); tile < 128 * 8; tile += G) gemm_tile<2>(P, tile >> 3, tile & 7, smem);
    xcd_barrier(xb);
    for (int tile = VB_LOAD(); tile < 128 * 16; tile += G) gemm_tile<3>(P, tile >> 4, tile & 15, smem);
    xcd_barrier(xb);
    {
        unsigned char* slut = smem + 12288;
        if (tid < 64) {
            int c = tid, i = 0;
            while (i < 16 && c >= 16 / (i + 1)) { c -= 16 / (i + 1); ++i; }
            slut[tid] = (unsigned char)(i < 16 ? ((i << 4) | c) : 0);
        }
        unsigned* szero = (unsigned*)(smem + 12288 + 64);
        if (tid < 16) szero[tid] = 0u;
        __syncthreads();
        int* sidx = (int*)(smem + wave * 3072); float* sval = (float*)(smem + wave * 3072 + 1024);
        int* sid = (int*)(smem + wave * 3072 + 2048); float* sgate = (float*)(smem + wave * 3072 + 2560);
        int lane5 = lane;
        asm volatile("" : "+v"(lane5));
        {
            int t = bid * 4 + wave;
            uint4 tkw = *(const uint4*)((const unsigned*)(P.ws + WS_TK) + (size_t)(t < T2 ? t : 0) * 256 + lane5 * 4);
            for (; t < T2; t += G * 4) { const int tn = t + G * 4; peer_token(P, t, tn < T2 ? tn : t, tkw, lane5, sidx, sval, sid, sgate, slut, szero); }
        }
    }
}

}

extern "C" void kernel_launch(void* const* d_in, const int* in_sizes, int n_in, void* d_out, int out_size, void* d_ws, size_t ws_size, hipStream_t stream) {
    if (n_in != 17 || ws_size < WS_END) { fprintf(stderr, "kernel_launch: unexpected n_in %d or ws_size %zu (need %zu)\n", n_in, ws_size, (size_t)WS_END); return; }
    constexpr int LDS_BYTES = 66560;
    static int grid_blocks = 0;
    if (!grid_blocks) {
        int dev = 0, cus = 0, per_cu = 0;
        (void)hipGetDevice(&dev);
        (void)hipDeviceGetAttribute(&cus, hipDeviceAttributeMultiprocessorCount, dev);
        (void)hipFuncSetAttribute((const void*)mega, hipFuncAttributeMaxDynamicSharedMemorySize, LDS_BYTES);
        (void)hipOccupancyMaxActiveBlocksPerMultiprocessor(&per_cu, (const void*)mega, 256, LDS_BYTES);
        if (per_cu < 1) per_cu = 1;
        if (per_cu > 2) per_cu = 2;
        grid_blocks = cus * per_cu;
        fprintf(stderr, "kernel_launch: cus %d per_cu %d grid %d\n", cus, per_cu, grid_blocks);
    }
    Params P{};
    P.x = (const float*)d_in[0]; P.meta = (const float*)d_in[1]; P.norm_mix = (const float*)d_in[2]; P.w_in = (const float*)d_in[3];
    P.conv_qk = (const float*)d_in[4]; P.b_igate = (const float*)d_in[5]; P.b_fgate_m = (const float*)d_in[6]; P.m_out_norm = (const float*)d_in[7];
    P.b_fgate_f = (const float*)d_in[8]; P.f_q_norm = (const float*)d_in[9]; P.f_k_norm = (const float*)d_in[10]; P.w_out = (const float*)d_in[11];
    P.norm_ffn = (const float*)d_in[12]; P.peer_query = (const float*)d_in[13]; P.peer_keys = (const float*)d_in[14]; P.peer_u = (const float*)d_in[15];
    P.peer_v = (const float*)d_in[16]; P.out = (float*)d_out; P.ws = (unsigned char*)d_ws;
    (void)hipMemsetAsync((unsigned char*)d_ws + WS_CTL, 0, 32768, stream);
    void* args[] = {&P};
    hipError_t e = hipLaunchCooperativeKernel((const void*)mega, dim3(grid_blocks), dim3(256), args, LDS_BYTES, stream);
    if (e != hipSuccess) fprintf(stderr, "cooperative launch failed: %s (grid %d)\n", hipGetErrorString(e), grid_blocks);
}
```

```cpp
#include <hip/hip_runtime.h>
#include <stdint.h>
#include <stdio.h>
#include <hip/hip_cooperative_groups.h>
namespace cg = cooperative_groups;

namespace {

constexpr int NB = 8, SEQ = 2048, DM = 1024, NMETA = 16, L = SEQ + NMETA;
constexpr int T1 = NB * L;
constexpr int T2 = NB * SEQ;
constexpr int NZ = 3584;
constexpr int ZC_MQ = 0, ZC_MK = 512, ZC_MV = 1024, ZC_MO = 1536, ZC_FQ = 2048, ZC_FK = 2560, ZC_FV = 3072;
constexpr int PROJ = 3600;
constexpr float EPS = 1e-6f;

constexpr size_t WS_CTL = 0;
constexpr size_t WS_RA = 65536;
constexpr size_t WS_Z = WS_RA + (size_t)T1 * DM * 2;
constexpr size_t WS_GATES = WS_Z + (size_t)T1 * NZ * 2;
constexpr size_t WS_CUM = WS_GATES + (size_t)T1 * 16 * 4;
constexpr size_t WS_SSQ = WS_CUM + (size_t)NB * 8 * L * 4;
constexpr size_t WS_RSTD = WS_SSQ + (size_t)T2 * 16 * 4;
constexpr size_t WS_SSQM = WS_RSTD + (size_t)T2 * 4;
constexpr size_t WS_BT2 = WS_SSQM + (size_t)T1 * 16 * 4;
constexpr size_t WS_BT3 = WS_BT2 + (size_t)DM * DM * 2;
constexpr size_t WS_KEYS = WS_BT3 + (size_t)2048 * DM * 2;
constexpr size_t WS_MSC = WS_KEYS + (size_t)16 * 128 * 128 * 2;
constexpr size_t WS_MST = WS_MSC + (size_t)128 * 33 * 16;
constexpr size_t WS_BT1 = WS_MST + (size_t)32 * 33 * 36864;
constexpr size_t WS_CBI = WS_BT1;
constexpr size_t WS_UV = WS_CBI + (size_t)32 * 33 * 36864;
constexpr size_t WS_END = WS_UV + (size_t)2 * 16384 * 512 + (size_t)2 * 16384 * 4;
constexpr size_t WS_XN = WS_RA;
constexpr size_t WS_U = WS_UV;
constexpr size_t WS_V = WS_U + (size_t)16384 * 512;
constexpr size_t WS_USC = WS_V + (size_t)16384 * 512;
constexpr size_t WS_VSC = WS_USC + (size_t)16384 * 4;
constexpr size_t WS_TK = WS_CBI;
constexpr float LOG2E = 1.4426950408889634f;

typedef unsigned short bf16_t;
typedef short bf16x8 __attribute__((ext_vector_type(8)));
typedef float f32x4 __attribute__((ext_vector_type(4)));
typedef __attribute__((ext_vector_type(2))) __bf16 bf16x2_t;

struct Params {
    const float* x; const float* meta; const float* norm_mix; const float* w_in; const float* conv_qk;
    const float* b_igate; const float* b_fgate_m; const float* m_out_norm; const float* b_fgate_f;
    const float* f_q_norm; const float* f_k_norm; const float* w_out; const float* norm_ffn;
    const float* peer_query; const float* peer_keys; const float* peer_u; const float* peer_v;
    float* out; unsigned char* ws;
};

__device__ __forceinline__ unsigned f2bf(float f) { unsigned u = __float_as_uint(f); return (u + 0x7fffu + ((u >> 16) & 1u)) >> 16; }
__device__ __forceinline__ float bf2f(unsigned h) { return __uint_as_float(h << 16); }
typedef float f32x2 __attribute__((ext_vector_type(2)));
typedef __bf16 bf16x2v __attribute__((ext_vector_type(2)));
__device__ __forceinline__ unsigned cvt_pk_bf16(float lo, float hi) { f32x2 v = {lo, hi}; bf16x2v b = __builtin_convertvector(v, bf16x2v); return __builtin_bit_cast(unsigned, b); }
__device__ __forceinline__ unsigned pk2(float lo, float hi) { return cvt_pk_bf16(lo, hi); }
__device__ __forceinline__ float bflo(unsigned w) { return __uint_as_float(w << 16); }
__device__ __forceinline__ float bfhi(unsigned w) { return __uint_as_float(w & 0xffff0000u); }
__device__ __forceinline__ float wave_sum(float v) {
#pragma unroll
    for (int o = 32; o > 0; o >>= 1) v += __shfl_xor(v, o, 64);
    return v;
}
__device__ __forceinline__ float wave_max(float v) {
#pragma unroll
    for (int o = 32; o > 0; o >>= 1) v = fmaxf(v, __shfl_xor(v, o, 64));
    return v;
}
__device__ __forceinline__ float logsigmoidf(float x) { return fminf(x, 0.f) - log1pf(expf(-fabsf(x))); }
__device__ __forceinline__ unsigned ord_key(float f) { unsigned u = __float_as_uint(f); return u ^ ((u >> 31) ? 0xffffffffu : 0x80000000u); }
__device__ __forceinline__ float unord_key(unsigned k) { unsigned u = (k & 0x80000000u) ? (k ^ 0x80000000u) : ~k; return __uint_as_float(u); }

__device__ __forceinline__ void phase0(const Params& P, unsigned char* smem) {
    const int tid = threadIdx.x, lane = tid & 63, wave = tid >> 6;
    unsigned* ctl = (unsigned*)(P.ws + WS_CTL);
    float* gw = (float*)smem;
    for (int idx = tid; idx < 16 * 1024; idx += 256) {
        const int k = idx >> 4, c = idx & 15;
        const int col = c < 8 ? 2048 + c : 3592 + (c - 8);
        gw[c * 1024 + k] = P.w_in[(size_t)k * PROJ + col];
    }
    __syncthreads();
    {
        bf16_t* hn = (bf16_t*)(P.ws + WS_RA);
        float* gates = (float*)(P.ws + WS_GATES);
        const int c0 = lane * 8, c1 = 512 + lane * 8;
        float gm[16];
        {
            const float4 a0 = *(const float4*)(P.norm_mix + c0), a1 = *(const float4*)(P.norm_mix + c0 + 4);
            const float4 a2 = *(const float4*)(P.norm_mix + c1), a3 = *(const float4*)(P.norm_mix + c1 + 4);
            gm[0] = a0.x; gm[1] = a0.y; gm[2] = a0.z; gm[3] = a0.w; gm[4] = a1.x; gm[5] = a1.y; gm[6] = a1.z; gm[7] = a1.w;
            gm[8] = a2.x; gm[9] = a2.y; gm[10] = a2.z; gm[11] = a2.w; gm[12] = a3.x; gm[13] = a3.y; gm[14] = a3.z; gm[15] = a3.w;
        }
        const int myq = ((lane >> 5) & 1) * 8 + ((lane >> 4) & 1) * 4 + ((lane >> 3) & 1) * 2 + ((lane >> 2) & 1);
        const float mybias = myq < 4 ? P.b_igate[myq] : (myq < 8 ? P.b_fgate_m[myq - 4] : P.b_fgate_f[myq - 8]);
        const int rstep = gridDim.x * 4;
        int r = blockIdx.x * 4 + wave;
        float4 n0, n1, n2, n3;
        auto load_row = [&](int rr) {
            const int b = rr / L, p = rr - b * L;
            const float* src = (p < NMETA) ? (P.meta + (size_t)p * DM) : (P.x + ((size_t)b * SEQ + (p - NMETA)) * DM);
            n0 = *(const float4*)(src + c0); n1 = *(const float4*)(src + c0 + 4); n2 = *(const float4*)(src + c1); n3 = *(const float4*)(src + c1 + 4);
        };
        if (r < T1) load_row(r);
        for (; r < T1; r += rstep) {
            float v[16];
            v[0] = n0.x; v[1] = n0.y; v[2] = n0.z; v[3] = n0.w; v[4] = n1.x; v[5] = n1.y; v[6] = n1.z; v[7] = n1.w;
            v[8] = n2.x; v[9] = n2.y; v[10] = n2.z; v[11] = n2.w; v[12] = n3.x; v[13] = n3.y; v[14] = n3.z; v[15] = n3.w;
            if (r + rstep < T1) load_row(r + rstep);
            float ss = 0.f;
#pragma unroll
            for (int j = 0; j < 16; ++j) ss += v[j] * v[j];
            ss = wave_sum(ss);
            const float rstd = rsqrtf(ss * (1.0f / DM) + EPS);
#pragma unroll
            for (int j = 0; j < 16; ++j) v[j] *= rstd * gm[j];
            uint4 o0, o1;
            o0.x = pk2(v[0], v[1]); o0.y = pk2(v[2], v[3]); o0.z = pk2(v[4], v[5]); o0.w = pk2(v[6], v[7]);
            o1.x = pk2(v[8], v[9]); o1.y = pk2(v[10], v[11]); o1.z = pk2(v[12], v[13]); o1.w = pk2(v[14], v[15]);
            *(uint4*)(hn + (size_t)r * DM + c0) = o0;
            *(uint4*)(hn + (size_t)r * DM + c1) = o1;
            float r8[8], r4[4], r2[2], r1;
#pragma unroll
            for (int i = 0; i < 8; ++i) {
                float dd[2];
#pragma unroll
                for (int hh = 0; hh < 2; ++hh) {
                    const float* gwc = gw + (i + 8 * hh) * 1024;
                    const float4 w0 = *(const float4*)(gwc + c0), w1 = *(const float4*)(gwc + c0 + 4), w2 = *(const float4*)(gwc + c1), w3 = *(const float4*)(gwc + c1 + 4);
                    dd[hh] = v[0] * w0.x + v[1] * w0.y + v[2] * w0.z + v[3] * w0.w + v[4] * w1.x + v[5] * w1.y + v[6] * w1.z + v[7] * w1.w
                           + v[8] * w2.x + v[9] * w2.y + v[10] * w2.z + v[11] * w2.w + v[12] * w3.x + v[13] * w3.y + v[14] * w3.z + v[15] * w3.w;
                }
                const bool up = (lane & 32) != 0; const float keep = up ? dd[1] : dd[0], send = up ? dd[0] : dd[1];
                r8[i] = keep + __shfl_xor(send, 32, 64);
                __builtin_amdgcn_sched_barrier(0);
            }
#pragma unroll
            for (int i = 0; i < 4; ++i) { const bool up = (lane & 16) != 0; const float keep = up ? r8[i + 4] : r8[i], send = up ? r8[i] : r8[i + 4]; r4[i] = keep + __shfl_xor(send, 16, 64); }
#pragma unroll
            for (int i = 0; i < 2; ++i) { const bool up = (lane & 8) != 0; const float keep = up ? r4[i + 2] : r4[i], send = up ? r4[i] : r4[i + 2]; r2[i] = keep + __shfl_xor(send, 8, 64); }
            { const bool up = (lane & 4) != 0; const float keep = up ? r2[1] : r2[0], send = up ? r2[0] : r2[1]; r1 = keep + __shfl_xor(send, 4, 64); }
            r1 += __shfl_xor(r1, 2, 64); r1 += __shfl_xor(r1, 1, 64);
            if ((lane & 3) == 0) {
                const float pre = r1 + mybias;
                gates[(size_t)r * 16 + myq] = myq < 4 ? pre : logsigmoidf(pre);
            }
        }
    }
    __syncthreads();
    {
        float* tile = (float*)smem;
        for (int item = blockIdx.x; item < 1664; item += gridDim.x) {
            const float* W; int ldn, ntn, shift_from, it; bf16_t* out;
            if (item < 896) { W = P.w_in; ldn = PROJ; ntn = 56; shift_from = 2048; it = item; out = (bf16_t*)(P.ws + WS_BT1); }
            else if (item < 1152) { W = P.w_out; ldn = 1024; ntn = 16; shift_from = 1 << 30; it = item - 896; out = (bf16_t*)(P.ws + WS_BT2); }
            else { W = P.peer_query; ldn = 2048; ntn = 32; shift_from = 1 << 30; it = item - 1152; out = (bf16_t*)(P.ws + WS_BT3); }
            const int tk = it / ntn, tn = it - tk * ntn, k0 = tk * 64, n0 = tn * 64;
            {
                const int n4 = (tid & 15) * 4, kr = tid >> 4;
                int n = n0 + n4; if (n >= shift_from) n += 8;
                float4 v[4];
#pragma unroll
                for (int i = 0; i < 4; ++i) v[i] = *(const float4*)(W + (size_t)(k0 + kr + 16 * i) * ldn + n);
#pragma unroll
                for (int i = 0; i < 4; ++i) *(float4*)(tile + (kr + 16 * i) * 68 + n4) = v[i];
            }
            __syncthreads();
            {
#pragma unroll
                for (int i = 0; i < 2; ++i) {
                    const int id = tid + 256 * i, nl = id & 63, kc = id >> 6;
                    const float* tp = tile + (kc * 8) * 68 + nl;
                    uint4 o;
                    o.x = pk2(tp[0], tp[68]); o.y = pk2(tp[2 * 68], tp[3 * 68]); o.z = pk2(tp[4 * 68], tp[5 * 68]); o.w = pk2(tp[6 * 68], tp[7 * 68]);
                    *(uint4*)(out + (size_t)(n0 + nl) * 1024 + k0 + kc * 8) = o;
                }
            }
            __syncthreads();
        }
    }
    {
        const size_t gt = (size_t)blockIdx.x * 256 + tid, gs = (size_t)gridDim.x * 256;
        const float* src = P.peer_keys; bf16_t* dst = (bf16_t*)(P.ws + WS_KEYS);
        for (size_t i = gt; i < (size_t)(16 * 128 * 128 / 8); i += gs) {
            const float4 a = *(const float4*)(src + i * 8), b = *(const float4*)(src + i * 8 + 4);
            uint4 o; o.x = pk2(a.x, a.y); o.y = pk2(a.z, a.w); o.z = pk2(b.x, b.y); o.w = pk2(b.z, b.w);
            *(uint4*)(dst + i * 8) = o;
        }
    }
}

__device__ __forceinline__ void convert_uv_rows(const Params& P, int gwave, int nwaves, int lane) {
    for (int rr0 = gwave * 4; rr0 < 2 * 16384; rr0 += nwaves * 4) {
        float4 a[4][4];
#pragma unroll
        for (int q = 0; q < 4; ++q) {
            const int rr = rr0 + q, which = rr >> 14, row = rr & 16383;
            const float* src = (which ? P.peer_v : P.peer_u) + (size_t)row * DM + lane * 16;
            a[q][0] = *(const float4*)(src); a[q][1] = *(const float4*)(src + 4); a[q][2] = *(const float4*)(src + 8); a[q][3] = *(const float4*)(src + 12);
        }
#pragma unroll
        for (int q = 0; q < 4; ++q) {
            const int rr = rr0 + q, which = rr >> 14, row = rr & 16383;
            float mx = 0.f;
#pragma unroll
            for (int j = 0; j < 4; ++j) mx = fmaxf(mx, fmaxf(fmaxf(fabsf(a[q][j].x), fabsf(a[q][j].y)), fmaxf(fabsf(a[q][j].z), fabsf(a[q][j].w))));
            mx = wave_max(mx);
            const float sc = mx > 0.f ? 6.0f / mx : 1.0f;
            unsigned w0 = 0u, w1 = 0u;
            w0 = __builtin_amdgcn_cvt_scalef32_pk_fp4_f32(w0, a[q][0].x * sc, a[q][0].y * sc, 1.0f, 0); w0 = __builtin_amdgcn_cvt_scalef32_pk_fp4_f32(w0, a[q][0].z * sc, a[q][0].w * sc, 1.0f, 1);
            w0 = __builtin_amdgcn_cvt_scalef32_pk_fp4_f32(w0, a[q][1].x * sc, a[q][1].y * sc, 1.0f, 2); w0 = __builtin_amdgcn_cvt_scalef32_pk_fp4_f32(w0, a[q][1].z * sc, a[q][1].w * sc, 1.0f, 3);
            w1 = __builtin_amdgcn_cvt_scalef32_pk_fp4_f32(w1, a[q][2].x * sc, a[q][2].y * sc, 1.0f, 0); w1 = __builtin_amdgcn_cvt_scalef32_pk_fp4_f32(w1, a[q][2].z * sc, a[q][2].w * sc, 1.0f, 1);
            w1 = __builtin_amdgcn_cvt_scalef32_pk_fp4_f32(w1, a[q][3].x * sc, a[q][3].y * sc, 1.0f, 2); w1 = __builtin_amdgcn_cvt_scalef32_pk_fp4_f32(w1, a[q][3].z * sc, a[q][3].w * sc, 1.0f, 3);
            *(uint2*)(P.ws + (which ? WS_V : WS_U) + (size_t)row * 512 + lane * 8) = make_uint2(w0, w1);
            if (lane == 0) ((float*)(P.ws + (which ? WS_VSC : WS_USC)))[row] = mx > 0.f ? mx * (1.0f / 6.0f) : 1.0f;
        }
    }
}

__device__ __forceinline__ void bitonic_sort16_desc(unsigned (&v)[16]) {
#pragma unroll
    for (int k = 2; k <= 16; k <<= 1)
#pragma unroll
        for (int j = k >> 1; j >= 1; j >>= 1)
#pragma unroll
            for (int i = 0; i < 16; ++i)
                if ((i & j) == 0) {
                    const int p = i | j;
                    const bool desc = (k >= 16) ? true : ((i & k) == 0);
                    const unsigned hi = max(v[i], v[p]), lo = min(v[i], v[p]);
                    v[i] = desc ? hi : lo; v[p] = desc ? lo : hi;
                }
}
__device__ __forceinline__ void bitonic_merge16_top(unsigned (&a)[16], const unsigned (&b)[16]) {
#pragma unroll
    for (int i = 0; i < 16; ++i) a[i] = max(a[i], b[15 - i]);
#pragma unroll
    for (int j = 8; j >= 1; j >>= 1)
#pragma unroll
        for (int i = 0; i < 16; ++i)
            if ((i & j) == 0) { const int p = i | j; const unsigned hi = max(a[i], a[p]), lo = min(a[i], a[p]); a[i] = hi; a[p] = lo; }
}

__device__ __forceinline__ float x4_max(float x) {
    const unsigned xi = __float_as_uint(x);
    const auto r = __builtin_amdgcn_permlane32_swap(xi, xi, false, false);
    const float m = fmaxf(__uint_as_float(r[0]), __uint_as_float(r[1]));
    const unsigned mi = __float_as_uint(m);
    const auto r2 = __builtin_amdgcn_permlane16_swap(mi, mi, false, false);
    return fmaxf(__uint_as_float(r2[0]), __uint_as_float(r2[1]));
}
__device__ __forceinline__ float x4_sum(float x) {
    const unsigned xi = __float_as_uint(x);
    const auto r = __builtin_amdgcn_permlane32_swap(xi, xi, false, false);
    const float m = __uint_as_float(r[0]) + __uint_as_float(r[1]);
    const unsigned mi = __float_as_uint(m);
    const auto r2 = __builtin_amdgcn_permlane16_swap(mi, mi, false, false);
    return __uint_as_float(r2[0]) + __uint_as_float(r2[1]);
}

__device__ __forceinline__ int opaque_tid() { int t = threadIdx.x; asm volatile("" : "+v"(t)); return t; }

__device__ __forceinline__ void mma_ktile(const unsigned char* sA, const unsigned char* sB, int arow_off, int brow_off, int g, int sw, f32x4 (&acc)[4][4]) {
#pragma unroll
    for (int s = 0; s < 2; ++s) {
        bf16x8 a[4], b[4];
        const int ch = (((s * 4 + g) ^ sw) << 4);
#pragma unroll
        for (int i = 0; i < 4; ++i) a[i] = *(const bf16x8*)(sA + arow_off + i * 2048 + ch);
#pragma unroll
        for (int j = 0; j < 4; ++j) b[j] = *(const bf16x8*)(sB + brow_off + j * 2048 + ch);
#pragma unroll
        for (int i = 0; i < 4; ++i)
#pragma unroll
            for (int j = 0; j < 4; ++j) acc[i][j] = __builtin_amdgcn_mfma_f32_16x16x32_bf16(b[j], a[i], acc[i][j], 0, 0, 0);
    }
}

__device__ __forceinline__ void store_tile_bf16(const f32x4 (&acc)[4][4], unsigned char* smem, bf16_t* dst, size_t ld, int m0, int n0, int tid, int wr, int wc, int g, int lr) {
#pragma unroll
    for (int i = 0; i < 4; ++i)
#pragma unroll
        for (int j = 0; j < 4; ++j) {
            const int row = wr * 64 + 16 * i + lr, col = wc * 64 + 16 * j + 4 * g;
            uint2 w; w.x = pk2(acc[i][j][0], acc[i][j][1]); w.y = pk2(acc[i][j][2], acc[i][j][3]);
            *(uint2*)(smem + row * 272 + col * 2) = w;
        }
    __syncthreads();
#pragma unroll
    for (int q = 0; q < 8; ++q) {
        const int id = tid + 256 * q, row = id >> 4, ch = id & 15;
        const uint4 v = *(const uint4*)(smem + row * 272 + ch * 16);
        *(uint4*)(dst + (size_t)(m0 + row) * ld + n0 + ch * 8) = v;
    }
    __syncthreads();
}

template <int MODE>
__device__ __forceinline__ void gemm_tile(const Params& P, int tm, int tn, unsigned char* smem) {
    const bf16_t* A; const bf16_t* Bt;
    if (MODE == 1) { A = (const bf16_t*)(P.ws + WS_RA); Bt = (const bf16_t*)(P.ws + WS_BT1); }
    else if (MODE == 2) { A = (const bf16_t*)(P.ws + WS_Z); Bt = (const bf16_t*)(P.ws + WS_BT2); }
    else { A = (const bf16_t*)(P.ws + WS_XN); Bt = (const bf16_t*)(P.ws + WS_BT3); }
    const int tid = opaque_tid(), lane = tid & 63, wave = tid >> 6, wr = wave >> 1, wc = wave & 1, g = lane >> 4, lr = lane & 15;
    const int m0 = tm * 128, n0 = tn * 128;
    const int srow = tid >> 3, sc = tid & 7;
    constexpr unsigned LDA = (MODE == 2 ? NZ : 1024) * 2u;
    unsigned aoff, boff; int soff0;
    {
        int ar = m0 + srow;
        if (MODE == 2) { const int b = ar >> 11, t = ar & 2047; ar = b * L + NMETA + t; }
        aoff = (unsigned)ar * LDA + (unsigned)sc * 16u;
        boff = (unsigned)(n0 + srow) * 2048u + (unsigned)sc * 16u;
        soff0 = srow * 128 + ((sc ^ (srow & 7)) << 4);
    }
    const unsigned char* Ab = (const unsigned char*)A; const unsigned char* Bb = (const unsigned char*)Bt;
    uint4 kpa0, kpa1, kpa2, kpa3, kpb0, kpb1, kpb2, kpb3; float4 ssp0, ssp1, ssp2, ssp3;
    if (MODE == 3) {
        const bf16_t* keys = (const bf16_t*)(P.ws + WS_KEYS) + (size_t)tn * 128 * 128 + (size_t)srow * 128 + sc * 8;
        kpa0 = *(const uint4*)(keys); kpa1 = *(const uint4*)(keys + 32 * 128); kpa2 = *(const uint4*)(keys + 64 * 128); kpa3 = *(const uint4*)(keys + 96 * 128);
        kpb0 = *(const uint4*)(keys + 64); kpb1 = *(const uint4*)(keys + 32 * 128 + 64); kpb2 = *(const uint4*)(keys + 64 * 128 + 64); kpb3 = *(const uint4*)(keys + 96 * 128 + 64);
        const float* ssq = (const float*)(P.ws + WS_SSQ) + (size_t)(m0 + wr * 64 + lr) * 16 + 4 * g;
        ssp0 = *(const float4*)(ssq); ssp1 = *(const float4*)(ssq + 16 * 16); ssp2 = *(const float4*)(ssq + 32 * 16); ssp3 = *(const float4*)(ssq + 48 * 16);
    }
    f32x4 acc[4][4];
#pragma unroll
    for (int i = 0; i < 4; ++i)
#pragma unroll
        for (int j = 0; j < 4; ++j) acc[i][j] = (f32x4){0.f, 0.f, 0.f, 0.f};
    uint4 ra0, ra1, ra2, ra3, rb0, rb1, rb2, rb3;
#define G_LOAD(KT) { const unsigned ko = (unsigned)(KT) * 128u; \
        ra0 = *(const uint4*)(Ab + (aoff + ko)); ra1 = *(const uint4*)(Ab + (aoff + 32u * LDA + ko)); ra2 = *(const uint4*)(Ab + (aoff + 64u * LDA + ko)); ra3 = *(const uint4*)(Ab + (aoff + 96u * LDA + ko)); \
        rb0 = *(const uint4*)(Bb + (boff + ko)); rb1 = *(const uint4*)(Bb + (boff + 32u * 2048u + ko)); rb2 = *(const uint4*)(Bb + (boff + 64u * 2048u + ko)); rb3 = *(const uint4*)(Bb + (boff + 96u * 2048u + ko)); }
#define G_WRITE(SA, SB) { *(uint4*)((SA) + soff0) = ra0; *(uint4*)((SA) + soff0 + 4096) = ra1; *(uint4*)((SA) + soff0 + 8192) = ra2; *(uint4*)((SA) + soff0 + 12288) = ra3; \
        *(uint4*)((SB) + soff0) = rb0; *(uint4*)((SB) + soff0 + 4096) = rb1; *(uint4*)((SB) + soff0 + 8192) = rb2; *(uint4*)((SB) + soff0 + 12288) = rb3; }
    unsigned char* sA0 = smem; unsigned char* sB0 = smem + 16384; unsigned char* sA1 = smem + 32768; unsigned char* sB1 = smem + 49152;
    G_LOAD(0)
    G_WRITE(sA0, sB0)
    __syncthreads();
    const int arow_off = (wr * 64 + lr) * 128, brow_off = (wc * 64 + lr) * 128, sw = lr & 7;
    G_LOAD(1)
    for (int kt = 0; kt < 16; ++kt) {
        unsigned char* sA = (kt & 1) ? sA1 : sA0; unsigned char* sB = (kt & 1) ? sB1 : sB0;
        unsigned char* nA = (kt & 1) ? sA0 : sA1; unsigned char* nB = (kt & 1) ? sB0 : sB1;
        bf16x8 fa[4], fb[4], ga[4], gb[4];
        const int ch0 = ((g ^ sw) << 4), ch1 = (((4 + g) ^ sw) << 4);
        const unsigned ko = (unsigned)(kt + 2) * 128u;
        const bool wr_ok = kt < 15, ld_ok = kt < 14;
#pragma unroll
        for (int i = 0; i < 4; ++i) { fa[i] = *(const bf16x8*)(sA + arow_off + i * 2048 + ch0); fb[i] = *(const bf16x8*)(sB + brow_off + i * 2048 + ch0); }
        __builtin_amdgcn_sched_barrier(0);
        __builtin_amdgcn_s_setprio(2);
        if (wr_ok) *(uint4*)(nA + soff0) = ra0;
        if (ld_ok) ra0 = *(const uint4*)(Ab + (aoff + 0u * LDA + ko));
        ga[0] = *(const bf16x8*)(sA + arow_off + 0 * 2048 + ch1); gb[0] = *(const bf16x8*)(sB + brow_off + 0 * 2048 + ch1);
        __builtin_amdgcn_sched_barrier(0);
#pragma unroll
        for (int j = 0; j < 4; ++j) acc[0][j] = __builtin_amdgcn_mfma_f32_16x16x32_bf16(fb[j], fa[0], acc[0][j], 0, 0, 0);
        __builtin_amdgcn_sched_barrier(0);
        if (wr_ok) *(uint4*)(nA + soff0 + 4096) = ra1;
        if (ld_ok) ra1 = *(const uint4*)(Ab + (aoff + 32u * LDA + ko));
        ga[1] = *(const bf16x8*)(sA + arow_off + 1 * 2048 + ch1); gb[1] = *(const bf16x8*)(sB + brow_off + 1 * 2048 + ch1);
        __builtin_amdgcn_sched_barrier(0);
#pragma unroll
        for (int j = 0; j < 4; ++j) acc[1][j] = __builtin_amdgcn_mfma_f32_16x16x32_bf16(fb[j], fa[1], acc[1][j], 0, 0, 0);
        __builtin_amdgcn_sched_barrier(0);
        if (wr_ok) *(uint4*)(nA + soff0 + 8192) = ra2;
        if (ld_ok) ra2 = *(const uint4*)(Ab + (aoff + 64u * LDA + ko));
        ga[2] = *(const bf16x8*)(sA + arow_off + 2 * 2048 + ch1); gb[2] = *(const bf16x8*)(sB + brow_off + 2 * 2048 + ch1);
        __builtin_amdgcn_sched_barrier(0);
#pragma unroll
        for (int j = 0; j < 4; ++j) acc[2][j] = __builtin_amdgcn_mfma_f32_16x16x32_bf16(fb[j], fa[2], acc[2][j], 0, 0, 0);
        __builtin_amdgcn_sched_barrier(0);
        if (wr_ok) *(uint4*)(nA + soff0 + 12288) = ra3;
        if (ld_ok) ra3 = *(const uint4*)(Ab + (aoff + 96u * LDA + ko));
        ga[3] = *(const bf16x8*)(sA + arow_off + 3 * 2048 + ch1); gb[3] = *(const bf16x8*)(sB + brow_off + 3 * 2048 + ch1);
        __builtin_amdgcn_sched_barrier(0);
#pragma unroll
        for (int j = 0; j < 4; ++j) acc[3][j] = __builtin_amdgcn_mfma_f32_16x16x32_bf16(fb[j], fa[3], acc[3][j], 0, 0, 0);
        __builtin_amdgcn_sched_barrier(0);
        if (wr_ok) *(uint4*)(nB + soff0) = rb0;
        if (ld_ok) rb0 = *(const uint4*)(Bb + (boff + 0u * 2048u + ko));
        __builtin_amdgcn_sched_barrier(0);
#pragma unroll
        for (int j = 0; j < 4; ++j) acc[0][j] = __builtin_amdgcn_mfma_f32_16x16x32_bf16(gb[j], ga[0], acc[0][j], 0, 0, 0);
        __builtin_amdgcn_sched_barrier(0);
        if (wr_ok) *(uint4*)(nB + soff0 + 4096) = rb1;
        if (ld_ok) rb1 = *(const uint4*)(Bb + (boff + 32u * 2048u + ko));
        __builtin_amdgcn_sched_barrier(0);
#pragma unroll
        for (int j = 0; j < 4; ++j) acc[1][j] = __builtin_amdgcn_mfma_f32_16x16x32_bf16(gb[j], ga[1], acc[1][j], 0, 0, 0);
        __builtin_amdgcn_sched_barrier(0);
        if (wr_ok) *(uint4*)(nB + soff0 + 8192) = rb2;
        if (ld_ok) rb2 = *(const uint4*)(Bb + (boff + 64u * 2048u + ko));
        __builtin_amdgcn_sched_barrier(0);
#pragma unroll
        for (int j = 0; j < 4; ++j) acc[2][j] = __builtin_amdgcn_mfma_f32_16x16x32_bf16(gb[j], ga[2], acc[2][j], 0, 0, 0);
        __builtin_amdgcn_sched_barrier(0);
        if (wr_ok) *(uint4*)(nB + soff0 + 12288) = rb3;
        if (ld_ok) rb3 = *(const uint4*)(Bb + (boff + 96u * 2048u + ko));
        __builtin_amdgcn_sched_barrier(0);
#pragma unroll
        for (int j = 0; j < 4; ++j) acc[3][j] = __builtin_amdgcn_mfma_f32_16x16x32_bf16(gb[j], ga[3], acc[3][j], 0, 0, 0);
        __builtin_amdgcn_s_setprio(0);
        __syncthreads();
    }
#undef G_LOAD
#undef G_WRITE
    if (MODE == 1) {
        if (n0 >= ZC_FQ && n0 < ZC_FV) {
            const bool isk = n0 >= ZC_FK;
            const float* gain = isk ? P.f_k_norm : P.f_q_norm;
            const float scl = isk ? 1.0f : 0.125f * LOG2E;
            float gn[4][4];
#pragma unroll
            for (int j = 0; j < 4; ++j)
#pragma unroll
                for (int r = 0; r < 4; ++r) gn[j][r] = gain[16 * j + 4 * g + r];
#pragma unroll
            for (int i = 0; i < 4; ++i) {
                float ss = 0.f;
#pragma unroll
                for (int j = 0; j < 4; ++j)
#pragma unroll
                    for (int r = 0; r < 4; ++r) ss += acc[i][j][r] * acc[i][j][r];
                ss = x4_sum(ss);
                const float rstd = rsqrtf(ss * (1.0f / 64.0f) + EPS) * scl;
#pragma unroll
                for (int j = 0; j < 4; ++j)
#pragma unroll
                    for (int r = 0; r < 4; ++r) acc[i][j][r] *= rstd * gn[j][r];
            }
        }
        store_tile_bf16(acc, smem, (bf16_t*)(P.ws + WS_Z), NZ, m0, n0, tid, wr, wc, g, lr);
    } else if (MODE == 2) {
        float* ssq = (float*)(P.ws + WS_SSQ);
#pragma unroll
        for (int i = 0; i < 4; ++i) {
            const int row = m0 + wr * 64 + 16 * i + lr;
            float ss = 0.f;
#pragma unroll
            for (int j = 0; j < 4; ++j) {
                const int col = n0 + wc * 64 + 16 * j + 4 * g;
                const float4 xv = *(const float4*)(P.x + (size_t)row * DM + col);
                const float4 gv = *(const float4*)(P.norm_ffn + col);
                float4 hv; hv.x = acc[i][j][0] + xv.x; hv.y = acc[i][j][1] + xv.y; hv.z = acc[i][j][2] + xv.z; hv.w = acc[i][j][3] + xv.w;
                ss += hv.x * hv.x + hv.y * hv.y + hv.z * hv.z + hv.w * hv.w;
                acc[i][j][0] = hv.x * gv.x; acc[i][j][1] = hv.y * gv.y; acc[i][j][2] = hv.z * gv.z; acc[i][j][3] = hv.w * gv.w;
            }
            ss = x4_sum(ss);
            if (g == 0) ssq[(size_t)row * 16 + tn * 2 + wc] = ss;
        }
        store_tile_bf16(acc, smem, (bf16_t*)(P.ws + WS_XN), 1024, m0, n0, tid, wr, wc, g, lr);
    } else {
        const int hp = tn;
        float rs[4];
#pragma unroll
        for (int i = 0; i < 4; ++i) {
            const int row = m0 + wr * 64 + 16 * i + lr;
            const float4 sp = i == 0 ? ssp0 : i == 1 ? ssp1 : i == 2 ? ssp2 : ssp3;
            const float s = x4_sum((sp.x + sp.y) + (sp.z + sp.w));
            rs[i] = rsqrtf(s * (1.0f / DM) + EPS);
            if (tn == 0 && wc == 0 && g == 0) ((float*)(P.ws + WS_RSTD))[row] = rs[i];
        }
        {
            unsigned char* sAq = wc ? sA1 : sA0;
#pragma unroll
            for (int i = 0; i < 4; ++i)
#pragma unroll
                for (int j = 0; j < 4; ++j) {
                    const int row = wr * 64 + 16 * i + lr;
                    const int chunk = 2 * j + (g >> 1);
                    uint2 w; w.x = pk2(acc[i][j][0] * rs[i], acc[i][j][1] * rs[i]); w.y = pk2(acc[i][j][2] * rs[i], acc[i][j][3] * rs[i]);
                    *(uint2*)(sAq + row * 128 + ((chunk ^ (row & 7)) << 4) + 8 * (g & 1)) = w;
                }
#pragma unroll
            for (int j = 0; j < 1; ++j) {
                *(uint4*)(sB0 + soff0) = kpa0; *(uint4*)(sB0 + soff0 + 4096) = kpa1; *(uint4*)(sB0 + soff0 + 8192) = kpa2; *(uint4*)(sB0 + soff0 + 12288) = kpa3;
                *(uint4*)(sB1 + soff0) = kpb0; *(uint4*)(sB1 + soff0 + 4096) = kpb1; *(uint4*)(sB1 + soff0 + 8192) = kpb2; *(uint4*)(sB1 + soff0 + 12288) = kpb3;
            }
        }
        __syncthreads();
#pragma unroll
        for (int i = 0; i < 4; ++i)
#pragma unroll
            for (int j = 0; j < 4; ++j) acc[i][j] = (f32x4){0.f, 0.f, 0.f, 0.f};
        mma_ktile(sA0, sB0, arow_off, brow_off, g, sw, acc);
        mma_ktile(sA1, sB1, arow_off, brow_off, g, sw, acc);
        __syncthreads();
#pragma unroll
        for (int i = 0; i < 4; ++i)
#pragma unroll
            for (int j = 0; j < 4; ++j) {
                const int row = wr * 64 + 16 * i + lr;
                const int c4 = wc * 16 + 4 * j + g;
                *(f32x4*)(smem + row * 512 + ((c4 ^ (row & 31)) << 4)) = acc[i][j];
            }
        __syncthreads();
        unsigned top[16];
        const int row = tid & 127, half = tid >> 7;
        {
            auto load_keys = [&](unsigned (&dst)[16], int q4) {
#pragma unroll
                for (int s4 = 0; s4 < 4; ++s4) {
                    const int c4 = half * 16 + q4 * 4 + s4;
                    const f32x4 v = *(const f32x4*)(smem + row * 512 + ((c4 ^ (row & 31)) << 4));
#pragma unroll
                    for (int e = 0; e < 4; ++e) dst[s4 * 4 + e] = (ord_key(v[e]) & ~127u) | (unsigned)(127 - (c4 * 4 + e));
                }
            };
            load_keys(top, 0);
            bitonic_sort16_desc(top);
#pragma unroll 1
            for (int q4 = 1; q4 < 4; ++q4) {
                unsigned gq[16];
                load_keys(gq, q4);
                bitonic_sort16_desc(gq);
                bitonic_merge16_top(top, gq);
            }
        }
        __syncthreads();
        if (half) {
            uint4* lp = (uint4*)(smem + row * 64);
            lp[0] = make_uint4(top[0], top[1], top[2], top[3]); lp[1] = make_uint4(top[4], top[5], top[6], top[7]);
            lp[2] = make_uint4(top[8], top[9], top[10], top[11]); lp[3] = make_uint4(top[12], top[13], top[14], top[15]);
        }
        __syncthreads();
        if (!half) {
            const uint4* lp = (const uint4*)(smem + row * 64);
            unsigned other[16];
#pragma unroll
            for (int c = 0; c < 4; ++c) { const uint4 o = lp[c]; other[4 * c] = o.x; other[4 * c + 1] = o.y; other[4 * c + 2] = o.z; other[4 * c + 3] = o.w; }
            bitonic_merge16_top(top, other);
            uint4* tk = (uint4*)((unsigned*)(P.ws + WS_TK) + ((size_t)(m0 + row) * 16 + hp) * 16);
            tk[0] = make_uint4(top[0], top[1], top[2], top[3]); tk[1] = make_uint4(top[4], top[5], top[6], top[7]);
            tk[2] = make_uint4(top[8], top[9], top[10], top[11]); tk[3] = make_uint4(top[12], top[13], top[14], top[15]);
        }
        __syncthreads();
    }
}

__device__ __forceinline__ void fox_cum_wave(const Params& P, int bh, int lane) {
    const int b = bh >> 3, h = bh & 7;
    const float* gates = (const float*)(P.ws + WS_GATES);
    float* cum = (float*)(P.ws + WS_CUM) + (size_t)bh * L;
    constexpr int SEG = 33;
    const int t0 = lane * SEG;
    float loc = 0.f;
    for (int i = 0; i < SEG; ++i) { const int t = t0 + i; if (t < L) loc += gates[(size_t)(b * L + t) * 16 + 8 + h]; }
    float incl = loc;
#pragma unroll
    for (int o = 1; o < 64; o <<= 1) { const float n = __shfl_up(incl, o, 64); if (lane >= o) incl += n; }
    float run = incl - loc;
    for (int i = 0; i < SEG; ++i) { const int t = t0 + i; if (t < L) { run += gates[(size_t)(b * L + t) * 16 + 8 + h]; cum[t] = run * LOG2E; } }
}

#define TR_SLOW 0

__device__ __forceinline__ int vimg_off(int row, int ch) { return row * 128 + ((ch ^ (((row >> 1) & 3) << 1)) << 4); }
__device__ __forceinline__ uint2 tr_frag(const unsigned char* img, int row0, int c, int g, int lr) {
#if TR_SLOW
    unsigned short e[4];
#pragma unroll
    for (int k = 0; k < 4; ++k) { const int row = row0 + 4 * g + k, col = 16 * c + lr; e[k] = *(const unsigned short*)(img + vimg_off(row, col >> 3) + (col & 7) * 2); }
    uint2 r; r.x = (unsigned)e[0] | ((unsigned)e[1] << 16); r.y = (unsigned)e[2] | ((unsigned)e[3] << 16); return r;
#else
    const int q = lr >> 2, p = lr & 3, row = row0 + 4 * g + q;
    const unsigned addr = (unsigned)(size_t)(img + vimg_off(row, 2 * c + (p >> 1)) + 8 * (p & 1));
    uint2 r;
    asm volatile("ds_read_b64_tr_b16 %0, %1\n\ts_waitcnt lgkmcnt(0)" : "=&v"(r) : "v"(addr) : "memory");
    return r;
#endif
}

__device__ __forceinline__ unsigned tr_lane_addr(const unsigned char* img, int c, int g, int lr) {
    const int q = lr >> 2, p = lr & 3, row = 4 * g + q;
    return (unsigned)(size_t)(img + vimg_off(row, 2 * c + (p >> 1)) + 8 * (p & 1));
}
#define TR_GROUP(o0, o1, o2, o3, a) "ds_read_b64_tr_b16 %" #o0 ", %" #a "\n\tds_read_b64_tr_b16 %" #o1 ", %" #a " offset:2048\n\tds_read_b64_tr_b16 %" #o2 ", %" #a " offset:4096\n\tds_read_b64_tr_b16 %" #o3 ", %" #a " offset:6144\n\t"
__device__ __forceinline__ void tr_read_4c(const unsigned char* img, int g, int lr, uint2 (&r)[4][4]) {
    const unsigned a0 = tr_lane_addr(img, 0, g, lr), a1 = tr_lane_addr(img, 1, g, lr), a2 = tr_lane_addr(img, 2, g, lr), a3 = tr_lane_addr(img, 3, g, lr);
    asm volatile(TR_GROUP(0, 1, 2, 3, 16) TR_GROUP(4, 5, 6, 7, 17) TR_GROUP(8, 9, 10, 11, 18) TR_GROUP(12, 13, 14, 15, 19) "s_waitcnt lgkmcnt(0)"
        : "=&v"(r[0][0]), "=&v"(r[0][1]), "=&v"(r[0][2]), "=&v"(r[0][3]), "=&v"(r[1][0]), "=&v"(r[1][1]), "=&v"(r[1][2]), "=&v"(r[1][3]),
          "=&v"(r[2][0]), "=&v"(r[2][1]), "=&v"(r[2][2]), "=&v"(r[2][3]), "=&v"(r[3][0]), "=&v"(r[3][1]), "=&v"(r[3][2]), "=&v"(r[3][3])
        : "v"(a0), "v"(a1), "v"(a2), "v"(a3) : "memory");
}
__device__ __forceinline__ void tr_read_3c(const unsigned char* img, int g, int lr, uint2 (&r)[3][4]) {
    const unsigned a0 = tr_lane_addr(img, 0, g, lr), a1 = tr_lane_addr(img, 1, g, lr), a2 = tr_lane_addr(img, 2, g, lr);
    asm volatile(TR_GROUP(0, 1, 2, 3, 12) TR_GROUP(4, 5, 6, 7, 13) TR_GROUP(8, 9, 10, 11, 14) "s_waitcnt lgkmcnt(0)"
        : "=&v"(r[0][0]), "=&v"(r[0][1]), "=&v"(r[0][2]), "=&v"(r[0][3]), "=&v"(r[1][0]), "=&v"(r[1][1]), "=&v"(r[1][2]), "=&v"(r[1][3]),
          "=&v"(r[2][0]), "=&v"(r[2][1]), "=&v"(r[2][2]), "=&v"(r[2][3])
        : "v"(a0), "v"(a1), "v"(a2) : "memory");
}
__device__ __forceinline__ void tr_read_2(const unsigned char* img0, int c0, const unsigned char* img1, int c1, int g, int lr, uint2 (&r)[2][4]) {
    const unsigned a0 = tr_lane_addr(img0, c0, g, lr), a1 = tr_lane_addr(img1, c1, g, lr);
    asm volatile(TR_GROUP(0, 1, 2, 3, 8) TR_GROUP(4, 5, 6, 7, 9) "s_waitcnt lgkmcnt(0)"
        : "=&v"(r[0][0]), "=&v"(r[0][1]), "=&v"(r[0][2]), "=&v"(r[0][3]), "=&v"(r[1][0]), "=&v"(r[1][1]), "=&v"(r[1][2]), "=&v"(r[1][3])
        : "v"(a0), "v"(a1) : "memory");
}
__device__ __forceinline__ bf16x8 tr_pair(const uint2& lo, const uint2& hi) { uint4 u; u.x = lo.x; u.y = lo.y; u.z = hi.x; u.w = hi.y; return __builtin_bit_cast(bf16x8, u); }

__device__ __forceinline__ void attn_block(const Params& P, int bh, int qb, unsigned char* smem) {
    const int tid = opaque_tid(), lane = tid & 63, w = tid >> 6, g = lane >> 4, lr = lane & 15;
    const int b = bh >> 3, h = bh & 7;
    const bf16_t* z = (const bf16_t*)(P.ws + WS_Z);
    const float* cum = (const float*)(P.ws + WS_CUM) + (size_t)bh * L;
    int tq[2]; bool qvalid[2]; bf16x8 qf[2][2];
#pragma unroll
    for (int u = 0; u < 2; ++u) {
        tq[u] = qb * 128 + 32 * w + 16 * u + lr;
        qvalid[u] = tq[u] < L;
        const bf16_t* qp = z + (size_t)(b * L + (qvalid[u] ? tq[u] : 0)) * NZ + ZC_FQ + h * 64 + 8 * g;
        qf[u][0] = *(const bf16x8*)(qp); qf[u][1] = *(const bf16x8*)(qp + 32);
    }
    const int nkv = (2 * qb + 2 < 33) ? 2 * qb + 2 : 33;
    const int srow0 = tid >> 3, sch = tid & 7;
    uint4 rk[2], rv[2]; float rc = 0.f;
    auto load_tile = [&](int kv) {
#pragma unroll
        for (int j = 0; j < 2; ++j) {
            const int key = kv * 64 + srow0 + 32 * j;
            if (key < L) {
                const bf16_t* p = z + (size_t)(b * L + key) * NZ + h * 64 + sch * 8;
                rk[j] = *(const uint4*)(p + ZC_FK); rv[j] = *(const uint4*)(p + ZC_FV);
            } else { rk[j] = make_uint4(0, 0, 0, 0); rv[j] = make_uint4(0, 0, 0, 0); }
        }
        if (tid < 64) { const int key = kv * 64 + tid; rc = key < L ? cum[key] : 0.f; }
    };
    auto store_tile = [&](int buf) {
        unsigned char* sK = smem + buf * 16384; unsigned char* sV = sK + 8192;
#pragma unroll
        for (int j = 0; j < 2; ++j) {
            const int row = srow0 + 32 * j;
            *(uint4*)(sK + row * 128 + ((sch ^ (row & 7)) << 4)) = rk[j];
            *(uint4*)(sV + vimg_off(row, sch)) = rv[j];
        }
        if (tid < 64) ((float*)(smem + 32768 + buf * 256))[tid] = rc;
    };
    float m[2] = {-1e30f, -1e30f};
    f32x4 o[2][5];
#pragma unroll
    for (int u = 0; u < 2; ++u)
#pragma unroll
        for (int c = 0; c < 5; ++c) o[u][c] = (f32x4){0.f, 0.f, 0.f, 0.f};
    const unsigned onew = (lr == 0) ? 0x3F803F80u : 0u;
    const bf16x8 vones = __builtin_bit_cast(bf16x8, make_uint4(onew, onew, onew, onew));
    load_tile(nkv - 1); store_tile((nkv - 1) & 1);
    __syncthreads();
    for (int kv = nkv - 1; kv >= 0; --kv) {
        const int buf = kv & 1;
        if (kv > 0) load_tile(kv - 1);
        const unsigned char* sK = smem + buf * 16384; const unsigned char* sV = sK + 8192;
        const float* sck = (const float*)(smem + 32768 + buf * 256);
        f32x4 sa[2][4];
#pragma unroll
        for (int c = 0; c < 4; ++c) {
            sa[0][c] = (f32x4){0.f, 0.f, 0.f, 0.f}; sa[1][c] = (f32x4){0.f, 0.f, 0.f, 0.f};
#pragma unroll
            for (int s = 0; s < 2; ++s) {
                const bf16x8 kf = *(const bf16x8*)(sK + (16 * c + lr) * 128 + (((4 * s + g) ^ (lr & 7)) << 4));
                sa[0][c] = __builtin_amdgcn_mfma_f32_16x16x32_bf16(kf, qf[0][s], sa[0][c], 0, 0, 0);
                sa[1][c] = __builtin_amdgcn_mfma_f32_16x16x32_bf16(kf, qf[1][s], sa[1][c], 0, 0, 0);
            }
        }
        if (kv >= 2 * qb) {
#pragma unroll
            for (int u = 0; u < 2; ++u)
#pragma unroll
                for (int c = 0; c < 4; ++c)
#pragma unroll
                    for (int r = 0; r < 4; ++r)
                        if (64 * kv + 16 * c + 4 * g + r > tq[u]) sa[u][c][r] = -INFINITY;
        }
        f32x4 ck[4];
#pragma unroll
        for (int c = 0; c < 4; ++c) ck[c] = *(const f32x4*)(sck + 16 * c + 4 * g);
        bf16x8 pf[2][2];
#pragma unroll
        for (int u = 0; u < 2; ++u) {
            float mx = -INFINITY;
#pragma unroll
            for (int c = 0; c < 4; ++c) {
                sa[u][c] -= ck[c];
                mx = fmaxf(mx, fmaxf(fmaxf(sa[u][c][0], sa[u][c][1]), fmaxf(sa[u][c][2], sa[u][c][3])));
            }
            mx = x4_max(mx);
            if (__builtin_amdgcn_ballot_w64(mx > m[u]) != 0ull) {
                const float mn = fmaxf(m[u], mx);
                const float alpha = __builtin_amdgcn_exp2f(m[u] - mn);
                m[u] = mn;
#pragma unroll
                for (int c = 0; c < 5; ++c) o[u][c] *= alpha;
            }
            const float mn = m[u];
#pragma unroll
            for (int c = 0; c < 4; ++c)
#pragma unroll
                for (int r = 0; r < 4; ++r) sa[u][c][r] = __builtin_amdgcn_exp2f(sa[u][c][r] - mn);
#pragma unroll
            for (int s2 = 0; s2 < 2; ++s2) {
                uint4 uu;
                uu.x = cvt_pk_bf16(sa[u][2 * s2][0], sa[u][2 * s2][1]); uu.y = cvt_pk_bf16(sa[u][2 * s2][2], sa[u][2 * s2][3]);
                uu.z = cvt_pk_bf16(sa[u][2 * s2 + 1][0], sa[u][2 * s2 + 1][1]); uu.w = cvt_pk_bf16(sa[u][2 * s2 + 1][2], sa[u][2 * s2 + 1][3]);
                pf[u][s2] = __builtin_bit_cast(bf16x8, uu);
            }
        }
        {
            uint2 vr[4][4];
            tr_read_4c(sV, g, lr, vr);
#pragma unroll
            for (int c = 0; c < 4; ++c)
#pragma unroll
                for (int s2 = 0; s2 < 2; ++s2) {
                    const bf16x8 vf = tr_pair(vr[c][2 * s2], vr[c][2 * s2 + 1]);
                    o[0][c] = __builtin_amdgcn_mfma_f32_16x16x32_bf16(vf, pf[0][s2], o[0][c], 0, 0, 0);
                    o[1][c] = __builtin_amdgcn_mfma_f32_16x16x32_bf16(vf, pf[1][s2], o[1][c], 0, 0, 0);
                }
#pragma unroll
            for (int s2 = 0; s2 < 2; ++s2) {
                o[0][4] = __builtin_amdgcn_mfma_f32_16x16x32_bf16(vones, pf[0][s2], o[0][4], 0, 0, 0);
                o[1][4] = __builtin_amdgcn_mfma_f32_16x16x32_bf16(vones, pf[1][s2], o[1][4], 0, 0, 0);
            }
        }
        if (kv > 0) store_tile(buf ^ 1);
        __syncthreads();
    }
#pragma unroll
    for (int u = 0; u < 2; ++u) {
        const float ls = __shfl(o[u][4][0], lr, 64);
        const float inv = 1.0f / ls;
        if (qvalid[u]) {
            bf16_t* y = (bf16_t*)(P.ws + WS_Z) + (size_t)(b * L + tq[u]) * NZ + 512 + h * 64 + 4 * g;
#pragma unroll
            for (int c = 0; c < 4; ++c) {
                uint2 uu; uu.x = pk2(o[u][c][0] * inv, o[u][c][1] * inv); uu.y = pk2(o[u][c][2] * inv, o[u][c][3] * inv);
                *(uint2*)(y + 16 * c) = uu;
            }
        }
    }
}

__device__ __forceinline__ void conv_item(const Params& P, int ci) {
    const int tid = opaque_tid(), cc = tid & 127, rg = tid >> 7;
    const bf16_t* z = (const bf16_t*)(P.ws + WS_Z);
    bf16_t* qk = (bf16_t*)(P.ws + WS_RA);
    const int col0 = cc * 8;
    float w[4][8];
#pragma unroll
    for (int j = 0; j < 4; ++j) {
        const float4 a = *(const float4*)(P.conv_qk + j * 1024 + col0), b = *(const float4*)(P.conv_qk + j * 1024 + col0 + 4);
        w[j][0] = a.x; w[j][1] = a.y; w[j][2] = a.z; w[j][3] = a.w; w[j][4] = b.x; w[j][5] = b.y; w[j][6] = b.z; w[j][7] = b.w;
    }
    const float oscale = (col0 >= 512) ? 0.08838834764831845f : 1.0f;
    const int r0 = ci * 64 + rg * 32;
    int t = r0 % L;
    float xw[3][8];
#pragma unroll
    for (int j = 0; j < 3; ++j) {
        const int back = 3 - j;
        if (t - back >= 0) {
            const uint4 v = *(const uint4*)(z + (size_t)(r0 - back) * NZ + col0);
            xw[j][0] = bflo(v.x); xw[j][1] = bfhi(v.x); xw[j][2] = bflo(v.y); xw[j][3] = bfhi(v.y); xw[j][4] = bflo(v.z); xw[j][5] = bfhi(v.z); xw[j][6] = bflo(v.w); xw[j][7] = bfhi(v.w);
        } else {
#pragma unroll
            for (int e = 0; e < 8; ++e) xw[j][e] = 0.f;
        }
    }
#pragma unroll 2
    for (int i = 0; i < 32; ++i) {
        const int r = r0 + i;
        if (t == 0) {
#pragma unroll
            for (int j = 0; j < 3; ++j)
#pragma unroll
                for (int e = 0; e < 8; ++e) xw[j][e] = 0.f;
        }
        const uint4 v = *(const uint4*)(z + (size_t)r * NZ + col0);
        float xt[8];
        xt[0] = bflo(v.x); xt[1] = bfhi(v.x); xt[2] = bflo(v.y); xt[3] = bfhi(v.y); xt[4] = bflo(v.z); xt[5] = bfhi(v.z); xt[6] = bflo(v.w); xt[7] = bfhi(v.w);
        float o[8];
#pragma unroll
        for (int e = 0; e < 8; ++e) {
            const float cv = w[0][e] * xw[0][e] + w[1][e] * xw[1][e] + w[2][e] * xw[2][e] + w[3][e] * xt[e];
            o[e] = oscale * cv / (1.f + __expf(-cv));
            xw[0][e] = xw[1][e]; xw[1][e] = xw[2][e]; xw[2][e] = xt[e];
        }
        uint4 ov; ov.x = pk2(o[0], o[1]); ov.y = pk2(o[2], o[3]); ov.z = pk2(o[4], o[5]); ov.w = pk2(o[6], o[7]);
        *(uint4*)(qk + (size_t)r * 1024 + col0) = ov;
        t = (t + 1 == L) ? 0 : t + 1;
    }
}

constexpr int ST_IMG = 36864;
__device__ __forceinline__ int st_piece_off(int jt, int c, int g, int lr) { return (jt >> 2) * 18432 + vimg_off(16 * c + lr, 2 * (jt & 3) + (g >> 1)) + 8 * (g & 1); }

__device__ __forceinline__ void mlstm_stage_kv(const Params& P, int b, int h, int k, unsigned char* sKimg, unsigned char* sVimg, int tid) {
    const bf16_t* z = (const bf16_t*)(P.ws + WS_Z);
    const bf16_t* qk = (const bf16_t*)(P.ws + WS_RA);
    uint4 pk_[4], pv_[4];
#pragma unroll
    for (int j = 0; j < 4; ++j) {
        const int id = tid + 256 * j, row = id >> 4, ch16 = id & 15, pos = 64 * k + row;
        const bool ok = pos < L;
        pk_[j] = ok ? *(const uint4*)(qk + (size_t)(b * L + pos) * 1024 + 512 + h * 128 + ch16 * 8) : make_uint4(0, 0, 0, 0);
        pv_[j] = ok ? *(const uint4*)(z + (size_t)(b * L + pos) * NZ + ZC_MV + h * 128 + ch16 * 8) : make_uint4(0, 0, 0, 0);
    }
#pragma unroll
    for (int j = 0; j < 4; ++j) {
        const int id = tid + 256 * j, row = id >> 4, ch16 = id & 15;
        *(uint4*)(sKimg + (ch16 >> 3) * 8192 + vimg_off(row, ch16 & 7)) = pk_[j];
        *(uint4*)(sVimg + (ch16 >> 3) * 8192 + vimg_off(row, ch16 & 7)) = pv_[j];
    }
    if (tid < 128) {
        const int row = tid >> 1, ch = tid & 1;
        *(uint4*)(sVimg + 16384 + vimg_off(row, ch)) = ch ? make_uint4(0, 0, 0, 0) : make_uint4(0x3F80u, 0, 0, 0);
    }
}

__device__ __forceinline__ void mlstm_stage_A(const Params& P, int b, int h, int k, unsigned char* sKimg, unsigned char* sVimg, int tid) {
    const bf16_t* z = (const bf16_t*)(P.ws + WS_Z);
    bf16_t* qk = (bf16_t*)(P.ws + WS_RA);
    uint4 pv_[4];
#pragma unroll
    for (int j = 0; j < 4; ++j) {
        const int id = tid + 256 * j, row = id >> 4, ch16 = id & 15, pos = 64 * k + row;
        pv_[j] = (pos < L) ? *(const uint4*)(z + (size_t)(b * L + pos) * NZ + ZC_MV + h * 128 + ch16 * 8) : make_uint4(0, 0, 0, 0);
    }
    const int cch = tid & 31, rg = tid >> 5, isk = cch >> 4;
    const int zcol = (isk ? ZC_MK : ZC_MQ) + h * 128 + (cch & 15) * 8;
    float w[4][8];
#pragma unroll
    for (int j = 0; j < 4; ++j) {
        const float4 a = *(const float4*)(P.conv_qk + j * 1024 + zcol), c = *(const float4*)(P.conv_qk + j * 1024 + zcol + 4);
        w[j][0] = a.x; w[j][1] = a.y; w[j][2] = a.z; w[j][3] = a.w; w[j][4] = c.x; w[j][5] = c.y; w[j][6] = c.z; w[j][7] = c.w;
    }
    const float oscale = isk ? 0.08838834764831845f : 1.0f;
    const int p0 = 64 * k + 8 * rg;
    uint4 raw[11];
#pragma unroll
    for (int i = 0; i < 11; ++i) {
        const int pos = p0 - 3 + i;
        raw[i] = (pos >= 0 && pos < L) ? *(const uint4*)(z + (size_t)(b * L + pos) * NZ + zcol) : make_uint4(0, 0, 0, 0);
    }
#pragma unroll
    for (int j = 0; j < 4; ++j) {
        const int id = tid + 256 * j, row = id >> 4, ch16 = id & 15;
        *(uint4*)(sVimg + (ch16 >> 3) * 8192 + vimg_off(row, ch16 & 7)) = pv_[j];
    }
    if (tid < 128) {
        const int row = tid >> 1, ch = tid & 1;
        *(uint4*)(sVimg + 16384 + vimg_off(row, ch)) = ch ? make_uint4(0, 0, 0, 0) : make_uint4(0x3F80u, 0, 0, 0);
    }
#pragma unroll
    for (int i = 0; i < 8; ++i) {
        const int pos = p0 + i, row = 8 * rg + i;
        float o[8];
#pragma unroll
        for (int e = 0; e < 8; ++e) {
            const unsigned w0 = (&raw[i].x)[e >> 1], w1 = (&raw[i + 1].x)[e >> 1], w2 = (&raw[i + 2].x)[e >> 1], w3 = (&raw[i + 3].x)[e >> 1];
            const float x0 = (e & 1) ? bfhi(w0) : bflo(w0), x1 = (e & 1) ? bfhi(w1) : bflo(w1), x2 = (e & 1) ? bfhi(w2) : bflo(w2), x3 = (e & 1) ? bfhi(w3) : bflo(w3);
            const float cv = w[0][e] * x0 + w[1][e] * x1 + w[2][e] * x2 + w[3][e] * x3;
            o[e] = oscale * cv / (1.f + __expf(-cv));
        }
        uint4 ov; ov.x = pk2(o[0], o[1]); ov.y = pk2(o[2], o[3]); ov.z = pk2(o[4], o[5]); ov.w = pk2(o[6], o[7]);
        const bool ok = pos < L;
        if (!ok) ov = make_uint4(0, 0, 0, 0);
        if (ok) *(uint4*)(qk + (size_t)(b * L + pos) * 1024 + (isk ? 512 : 0) + h * 128 + (cch & 15) * 8) = ov;
        if (isk) { const int ch16 = cch & 15; *(uint4*)(sKimg + (ch16 >> 3) * 8192 + vimg_off(row, ch16 & 7)) = ov; }
    }
}

__device__ __forceinline__ void mlstm_A(const Params& P, int item, unsigned char* smem) {
    const int tid = opaque_tid(), lane = tid & 63, w = tid >> 6, g = lane >> 4, lr = lane & 15;
    const int wu = __builtin_amdgcn_readfirstlane(w);
    const int k = item >> 5, bh = item & 31, b = bh >> 2, h = bh & 3;
    const float* gates = (const float*)(P.ws + WS_GATES);
    const unsigned char* sK = smem; const unsigned char* sV = smem + 16384;
    float* ga = (float*)(smem + 40960);
    float lf = 0.f, li = -INFINITY;
    if (wu == 0) {
        const int pos = 64 * k + lane;
        if (pos < L) { lf = gates[(size_t)(b * L + pos) * 16 + 4 + h]; li = gates[(size_t)(b * L + pos) * 16 + h]; }
    }
    mlstm_stage_A(P, b, h, k, smem, smem + 16384, tid);
    if (wu == 0) {
        float bc = lf;
#pragma unroll
        for (int o = 1; o < 64; o <<= 1) { const float n = __shfl_up(bc, o, 64); if (lane >= o) bc += n; }
        const float a = li - bc;
        const float A = wave_max(a);
        ga[lane] = __expf(a - A);
        if (lane == 63) { float* msc = (float*)(P.ws + WS_MSC) + ((size_t)bh * 33 + k) * 4; msc[0] = A; msc[1] = bc; }
    }
    __syncthreads();
    f32x4 Ct[2][9];
#pragma unroll
    for (int a = 0; a < 2; ++a)
#pragma unroll
        for (int c = 0; c < 9; ++c) Ct[a][c] = (f32x4){0.f, 0.f, 0.f, 0.f};
    bf16x8 kt[2][2];
#pragma unroll
    for (int a = 0; a < 2; ++a)
#pragma unroll
        for (int s2 = 0; s2 < 2; ++s2) {
            const int jt = 2 * w + a;
            kt[a][s2] = tr_pair(tr_frag(sK + (jt >> 2) * 8192, 32 * s2, jt & 3, g, lr), tr_frag(sK + (jt >> 2) * 8192, 32 * s2 + 16, jt & 3, g, lr));
        }
    f32x4 wg4[4];
#pragma unroll
    for (int j = 0; j < 4; ++j) wg4[j] = *(const f32x4*)(ga + 16 * j + 4 * g);
#define MA_TILE(c, lo0, hi0, lo1, hi1) { \
        { const f32x4 w0 = wg4[0], w1 = wg4[1]; uint4 o; \
          o.x = cvt_pk_bf16(bflo(lo0.x) * w0[0], bfhi(lo0.x) * w0[1]); o.y = cvt_pk_bf16(bflo(lo0.y) * w0[2], bfhi(lo0.y) * w0[3]); \
          o.z = cvt_pk_bf16(bflo(hi0.x) * w1[0], bfhi(hi0.x) * w1[1]); o.w = cvt_pk_bf16(bflo(hi0.y) * w1[2], bfhi(hi0.y) * w1[3]); \
          const bf16x8 vw = __builtin_bit_cast(bf16x8, o); \
          Ct[0][c] = __builtin_amdgcn_mfma_f32_16x16x32_bf16(kt[0][0], vw, Ct[0][c], 0, 0, 0); Ct[1][c] = __builtin_amdgcn_mfma_f32_16x16x32_bf16(kt[1][0], vw, Ct[1][c], 0, 0, 0); } \
        { const f32x4 w0 = wg4[2], w1 = wg4[3]; uint4 o; \
          o.x = cvt_pk_bf16(bflo(lo1.x) * w0[0], bfhi(lo1.x) * w0[1]); o.y = cvt_pk_bf16(bflo(lo1.y) * w0[2], bfhi(lo1.y) * w0[3]); \
          o.z = cvt_pk_bf16(bflo(hi1.x) * w1[0], bfhi(hi1.x) * w1[1]); o.w = cvt_pk_bf16(bflo(hi1.y) * w1[2], bfhi(hi1.y) * w1[3]); \
          const bf16x8 vw = __builtin_bit_cast(bf16x8, o); \
          Ct[0][c] = __builtin_amdgcn_mfma_f32_16x16x32_bf16(kt[0][1], vw, Ct[0][c], 0, 0, 0); Ct[1][c] = __builtin_amdgcn_mfma_f32_16x16x32_bf16(kt[1][1], vw, Ct[1][c], 0, 0, 0); } }
    {
        uint2 vr[4][4];
        tr_read_4c(sV, g, lr, vr);
        MA_TILE(0, vr[0][0], vr[0][1], vr[0][2], vr[0][3]) MA_TILE(1, vr[1][0], vr[1][1], vr[1][2], vr[1][3])
        MA_TILE(2, vr[2][0], vr[2][1], vr[2][2], vr[2][3]) MA_TILE(3, vr[3][0], vr[3][1], vr[3][2], vr[3][3])
        tr_read_4c(sV + 8192, g, lr, vr);
        MA_TILE(4, vr[0][0], vr[0][1], vr[0][2], vr[0][3]) MA_TILE(5, vr[1][0], vr[1][1], vr[1][2], vr[1][3])
        MA_TILE(6, vr[2][0], vr[2][1], vr[2][2], vr[2][3]) MA_TILE(7, vr[3][0], vr[3][1], vr[3][2], vr[3][3])
        const uint2 o0 = tr_frag(sV + 16384, 0, 0, g, lr), o1 = tr_frag(sV + 16384, 16, 0, g, lr), o2 = tr_frag(sV + 16384, 32, 0, g, lr), o3 = tr_frag(sV + 16384, 48, 0, g, lr);
        MA_TILE(8, o0, o1, o2, o3)
    }
#undef MA_TILE
    unsigned char* slot = P.ws + WS_MST + ((size_t)bh * 33 + k) * ST_IMG;
#pragma unroll
    for (int a = 0; a < 2; ++a)
#pragma unroll
        for (int c = 0; c < 9; ++c) {
            uint2 u; u.x = cvt_pk_bf16(Ct[a][c][0], Ct[a][c][1]); u.y = cvt_pk_bf16(Ct[a][c][2], Ct[a][c][3]);
            *(uint2*)(slot + st_piece_off(2 * w + a, c, g, lr)) = u;
        }
}

__device__ __forceinline__ void mlstm_B(const Params& P, int item) {
    const int tid = opaque_tid();
    const int bh = item / 3, part = item - bh * 3;
    const unsigned char* base = P.ws + WS_MST + (size_t)bh * 33 * ST_IMG + part * 12288 + tid * 48;
    unsigned char* obase = P.ws + WS_CBI + (size_t)bh * 33 * ST_IMG + part * 12288 + tid * 48;
    float* msc = (float*)(P.ws + WS_MSC) + (size_t)bh * 33 * 4;
    float C[6][4];
#pragma unroll
    for (int i = 0; i < 6; ++i)
#pragma unroll
        for (int r = 0; r < 4; ++r) C[i][r] = 0.f;
    float m = 0.f;
    uint2 d0[6], d1[6];
    float2 ab0, ab1;
#pragma unroll
    for (int i = 0; i < 6; ++i) { d0[i] = *(const uint2*)(base + i * 8); d1[i] = *(const uint2*)(base + ST_IMG + i * 8); }
    ab0 = *(const float2*)(msc); ab1 = *(const float2*)(msc + 4);
    for (int k = 0; k < 33; ++k) {
        uint2 d2[6]; float2 ab2 = make_float2(0.f, 0.f);
        if (k + 2 < 33) {
#pragma unroll
            for (int i = 0; i < 6; ++i) d2[i] = *(const uint2*)(base + (size_t)(k + 2) * ST_IMG + i * 8);
            ab2 = *(const float2*)(msc + (k + 2) * 4);
        } else {
#pragma unroll
            for (int i = 0; i < 6; ++i) d2[i] = make_uint2(0, 0);
        }
#pragma unroll
        for (int i = 0; i < 6; ++i) {
            uint2 u; u.x = cvt_pk_bf16(C[i][0], C[i][1]); u.y = cvt_pk_bf16(C[i][2], C[i][3]);
            *(uint2*)(obase + (size_t)k * ST_IMG + i * 8) = u;
        }
        if (tid == 0 && part == 0) msc[k * 4 + 2] = m;
        const float M = fmaxf(m, ab0.x);
        const float decay = __expf(m - M), sc = __expf(ab0.x - M);
#pragma unroll
        for (int i = 0; i < 6; ++i) {
            C[i][0] = decay * C[i][0] + sc * bflo(d0[i].x); C[i][1] = decay * C[i][1] + sc * bfhi(d0[i].x);
            C[i][2] = decay * C[i][2] + sc * bflo(d0[i].y); C[i][3] = decay * C[i][3] + sc * bfhi(d0[i].y);
        }
        m = ab0.y + M;
#pragma unroll
        for (int i = 0; i < 6; ++i) { d0[i] = d1[i]; d1[i] = d2[i]; }
        ab0 = ab1; ab1 = ab2;
    }
}

__device__ __forceinline__ void mlstm_C(const Params& P, int item, unsigned char* smem) {
    const int tid = opaque_tid(), lane = tid & 63, w = tid >> 6, g = lane >> 4, lr = lane & 15;
    const int wu = __builtin_amdgcn_readfirstlane(w);
    const int k = item >> 5, bh = item & 31, b = bh >> 2, h = bh & 3;
    const bf16_t* z = (const bf16_t*)(P.ws + WS_Z);
    const bf16_t* qk = (const bf16_t*)(P.ws + WS_RA);
    const float* gates = (const float*)(P.ws + WS_GATES);
    bf16_t* y = (bf16_t*)(P.ws + WS_Z);
    const unsigned char* sK = smem; const unsigned char* sV = smem + 36864; unsigned char* sCb = smem;
    float* ga = (float*)(smem + 61440);
    const int pos = 64 * k + 16 * w + lr;
    const bool tvalid = pos < L;
    const size_t rrow = (size_t)(b * L + (tvalid ? pos : 0));
    const unsigned char* cslot = P.ws + WS_CBI + ((size_t)bh * 33 + k) * ST_IMG + tid * 16;
    const uint4 cb0 = *(const uint4*)(cslot), cb1 = *(const uint4*)(cslot + 4096), cb2 = *(const uint4*)(cslot + 8192), cb3 = *(const uint4*)(cslot + 12288), cb4 = *(const uint4*)(cslot + 16384),
                cb5 = *(const uint4*)(cslot + 20480), cb6 = *(const uint4*)(cslot + 24576), cb7 = *(const uint4*)(cslot + 28672), cb8 = *(const uint4*)(cslot + 32768);
    bf16x8 qf[4];
    {
        const bf16_t* qp = qk + rrow * 1024 + h * 128 + 8 * g;
#pragma unroll
        for (int ks = 0; ks < 4; ++ks) { qf[ks] = *(const bf16x8*)(qp + 32 * ks); if (!tvalid) qf[ks] = (bf16x8){0, 0, 0, 0, 0, 0, 0, 0}; }
    }
    float m_prev = 0.f, lf = 0.f, li = -INFINITY;
    if (wu == 0) {
        m_prev = ((const float*)(P.ws + WS_MSC))[((size_t)bh * 33 + k) * 4 + 2];
        const int p2 = 64 * k + lane;
        if (p2 < L) { lf = gates[(size_t)(b * L + p2) * 16 + 4 + h]; li = gates[(size_t)(b * L + p2) * 16 + h]; }
    }
    mlstm_stage_kv(P, b, h, k, smem, smem + 36864, tid);
    if (wu == 0) {
        float bc = lf;
#pragma unroll
        for (int o = 1; o < 64; o <<= 1) { const float n = __shfl_up(bc, o, 64); if (lane >= o) bc += n; }
        const float a = li - bc;
        float am = a;
#pragma unroll
        for (int o = 1; o < 64; o <<= 1) { const float n = __shfl_up(am, o, 64); if (lane >= o) am = fmaxf(am, n); }
        const float M = fmaxf(m_prev, am);
        ga[lane] = a; ga[64 + lane] = __expf(m_prev - M); ga[128 + lane] = __expf(-(bc + M)); ga[192 + lane] = M;
    }
    __syncthreads();
    const float Mt = ga[192 + 16 * w + lr], Wi = ga[64 + 16 * w + lr], Et = ga[128 + 16 * w + lr];
    bf16x8 pf[2];
    {
        f32x4 sa[4];
#pragma unroll
        for (int c = 0; c < 4; ++c) {
            sa[c] = (f32x4){0.f, 0.f, 0.f, 0.f};
            if (c <= wu) {
#pragma unroll
                for (int ks = 0; ks < 4; ++ks) {
                    const bf16x8 kf = *(const bf16x8*)(sK + (ks >> 1) * 8192 + vimg_off(16 * c + lr, 4 * (ks & 1) + g));
                    sa[c] = __builtin_amdgcn_mfma_f32_16x16x32_bf16(kf, qf[ks], sa[c], 0, 0, 0);
                }
                const f32x4 av = *(const f32x4*)(ga + 16 * c + 4 * g);
#pragma unroll
                for (int r = 0; r < 4; ++r) {
                    const float d = __expf(av[r] - Mt);
                    sa[c][r] = (16 * c + 4 * g + r <= 16 * w + lr) ? sa[c][r] * d : 0.f;
                }
            }
        }
#pragma unroll
        for (int s2 = 0; s2 < 2; ++s2) {
            uint4 u;
            u.x = cvt_pk_bf16(sa[2 * s2][0], sa[2 * s2][1]); u.y = cvt_pk_bf16(sa[2 * s2][2], sa[2 * s2][3]);
            u.z = cvt_pk_bf16(sa[2 * s2 + 1][0], sa[2 * s2 + 1][1]); u.w = cvt_pk_bf16(sa[2 * s2 + 1][2], sa[2 * s2 + 1][3]);
            pf[s2] = __builtin_bit_cast(bf16x8, u);
        }
    }
    __syncthreads();
    {
        unsigned char* d = sCb + tid * 16;
        *(uint4*)(d) = cb0; *(uint4*)(d + 4096) = cb1; *(uint4*)(d + 8192) = cb2; *(uint4*)(d + 12288) = cb3; *(uint4*)(d + 16384) = cb4;
        *(uint4*)(d + 20480) = cb5; *(uint4*)(d + 24576) = cb6; *(uint4*)(d + 28672) = cb7; *(uint4*)(d + 32768) = cb8;
    }
    __syncthreads();
    f32x4 na[9];
#define MC_TILE(c, lo0, hi0, lo1, hi1) { \
        na[c] = (f32x4){0.f, 0.f, 0.f, 0.f}; \
        _Pragma("unroll") for (int ks = 0; ks < 4; ++ks) { \
            const bf16x8 cf = *(const bf16x8*)(sCb + (ks >> 1) * 18432 + vimg_off(16 * (c) + lr, 4 * (ks & 1) + g)); \
            na[c] = __builtin_amdgcn_mfma_f32_16x16x32_bf16(cf, qf[ks], na[c], 0, 0, 0); } \
        na[c] *= Wi; \
        na[c] = __builtin_amdgcn_mfma_f32_16x16x32_bf16(tr_pair(lo0, hi0), pf[0], na[c], 0, 0, 0); \
        na[c] = __builtin_amdgcn_mfma_f32_16x16x32_bf16(tr_pair(lo1, hi1), pf[1], na[c], 0, 0, 0); }
    {
        uint2 vr[4][4];
        tr_read_4c(sV, g, lr, vr);
        MC_TILE(0, vr[0][0], vr[0][1], vr[0][2], vr[0][3]) MC_TILE(1, vr[1][0], vr[1][1], vr[1][2], vr[1][3])
        MC_TILE(2, vr[2][0], vr[2][1], vr[2][2], vr[2][3]) MC_TILE(3, vr[3][0], vr[3][1], vr[3][2], vr[3][3])
        tr_read_4c(sV + 8192, g, lr, vr);
        MC_TILE(4, vr[0][0], vr[0][1], vr[0][2], vr[0][3]) MC_TILE(5, vr[1][0], vr[1][1], vr[1][2], vr[1][3])
        MC_TILE(6, vr[2][0], vr[2][1], vr[2][2], vr[2][3]) MC_TILE(7, vr[3][0], vr[3][1], vr[3][2], vr[3][3])
        const uint2 o0 = tr_frag(sV + 16384, 0, 0, g, lr), o1 = tr_frag(sV + 16384, 16, 0, g, lr), o2 = tr_frag(sV + 16384, 32, 0, g, lr), o3 = tr_frag(sV + 16384, 48, 0, g, lr);
        MC_TILE(8, o0, o1, o2, o3)
    }
#undef MC_TILE
    const float den = __shfl(na[8][0], lr, 64);
    const float rden = 1.0f / fmaxf(fabsf(den), Et);
    float hs = 0.f;
#pragma unroll
    for (int c = 0; c < 8; ++c) { na[c] *= rden; hs += na[c][0] * na[c][0] + na[c][1] * na[c][1] + na[c][2] * na[c][2] + na[c][3] * na[c][3]; }
    hs = x4_sum(hs);
    const float rstd = rsqrtf(hs * (1.0f / 128.0f) + EPS);
    const float* gainp = P.m_out_norm + h * 128 + 4 * g;
#pragma unroll
    for (int c = 0; c < 8; ++c) {
        const uint2 og = *(const uint2*)(z + rrow * NZ + ZC_MO + h * 128 + 16 * c + 4 * g);
        const float o0 = bflo(og.x), o1 = bfhi(og.x), o2 = bflo(og.y), o3 = bfhi(og.y);
        const float4 gn = *(const float4*)(gainp + 16 * c);
        uint2 u;
        u.x = pk2(na[c][0] * rstd * gn.x / (1.f + __expf(-o0)), na[c][1] * rstd * gn.y / (1.f + __expf(-o1)));
        u.y = pk2(na[c][2] * rstd * gn.z / (1.f + __expf(-o2)), na[c][3] * rstd * gn.w / (1.f + __expf(-o3)));
        if (tvalid) *(uint2*)(y + rrow * NZ + h * 128 + 16 * c + 4 * g) = u;
    }
}

__device__ __forceinline__ void peer_token(const Params& P, int t, int tnext, uint4& tkw, int lane, int* sidx, float* sval, int* sid, float* sgate, const unsigned char* slut, const unsigned* szero) {
    {
        const unsigned kk[4] = {tkw.x, tkw.y, tkw.z, tkw.w};
#pragma unroll
        for (int i = 0; i < 4; ++i) {
            const unsigned k = kk[i];
            sidx[lane * 4 + i] = 127 - (int)(k & 127u);
            sval[lane * 4 + i] = unord_key(k & ~127u);
        }
        tkw = *(const uint4*)((const unsigned*)(P.ws + WS_TK) + (size_t)tnext * 256 + lane * 4);
    }
    const bf16_t* xn = (const bf16_t*)(P.ws + WS_XN) + (size_t)t * DM;
    const uint4 xa_pre = *(const uint4*)(xn + lane * 16), xb_pre = *(const uint4*)(xn + lane * 16 + 8);
    const float rstd = ((const float*)(P.ws + WS_RSTD))[t];
    __builtin_amdgcn_s_waitcnt(0xc07f);
    __builtin_amdgcn_wave_barrier();
    {
        const int hd = lane >> 3, sub = lane & 7;
        unsigned x[8];
#pragma unroll
        for (int r = 0; r < 8; ++r) {
            const int c = sub * 8 + r;
            const unsigned ij = slut[c < 50 ? c : 0];
            const int i = ij >> 4, j = ij & 15;
            const unsigned kx = (ord_key(sval[(2 * hd) * 16 + i] + sval[(2 * hd + 1) * 16 + j]) & ~255u) | (unsigned)(255 - (i * 16 + j));
            x[r] = c < 50 ? kx : 0u;
        }
#pragma unroll
        for (int k = 2; k <= 64; k <<= 1) {
#pragma unroll
            for (int j = k >> 1; j >= 1; j >>= 1) {
                if (j >= 8) {
                    const int ld = j >> 3;
                    const bool lower = (sub & ld) == 0;
                    const bool desc = k >= 64 ? true : ((sub * 8) & k) == 0;
                    const bool takemax = (lower == desc);
#pragma unroll
                    for (int r = 0; r < 8; ++r) {
                        const unsigned o = (unsigned)__shfl_xor((int)x[r], ld, 64);
                        const unsigned hi = max(x[r], o), lo = min(x[r], o);
                        x[r] = takemax ? hi : lo;
                    }
                } else {
#pragma unroll
                    for (int r = 0; r < 8; ++r) {
                        if ((r & j) == 0) {
                            const int p = r | j;
                            const unsigned hi = max(x[r], x[p]), lo = min(x[r], x[p]);
                            if (k <= 4) { const bool desc = (r & k) == 0; x[r] = desc ? hi : lo; x[p] = desc ? lo : hi; }
                            else if (k >= 64) { x[r] = hi; x[p] = lo; }
                            else { const bool desc = ((sub * 8) & k) == 0; x[r] = desc ? hi : lo; x[p] = desc ? lo : hi; }
                        }
                    }
                }
            }
        }
        const float smax = unord_key((unsigned)__shfl((int)x[0], hd * 8, 64) & ~255u);
        float e[8]; float den = 0.f;
#pragma unroll
        for (int r = 0; r < 8; ++r) { e[r] = __expf(unord_key(x[r] & ~255u) - smax); den += e[r]; }
        den += __shfl_xor(den, 1, 64);
        const float inv = 1.f / den;
        if (sub < 2) {
#pragma unroll
            for (int r = 0; r < 8; ++r) {
                const int pos = 255 - (int)(x[r] & 255u), i = pos >> 4, j = pos & 15;
                sid[hd * 16 + sub * 8 + r] = sidx[(2 * hd) * 16 + i] * 128 + sidx[(2 * hd + 1) * 16 + j];
                sgate[hd * 16 + sub * 8 + r] = e[r] * inv;
            }
        }
    }
    __builtin_amdgcn_s_waitcnt(0xc07f);
    __builtin_amdgcn_wave_barrier();
    const unsigned char* V = P.ws + WS_V + lane * 8;
    const float* usc = (const float*)(P.ws + WS_USC);
    const float* vsc = (const float*)(P.ws + WS_VSC);
    const int g = lane >> 4, lr = lane & 15;
    unsigned char* shi = (unsigned char*)sval;
    unsigned char* slo = (unsigned char*)sidx;
    {
        const uint4 xa = xa_pre, xb = xb_pre;
        const unsigned xw[8] = {xa.x, xa.y, xa.z, xa.w, xb.x, xb.y, xb.z, xb.w};
        unsigned hi[4], lo[4];
#pragma unroll
        for (int i = 0; i < 4; ++i) {
            const float x0 = bflo(xw[2 * i]), x1 = bfhi(xw[2 * i]), x2 = bflo(xw[2 * i + 1]), x3 = bfhi(xw[2 * i + 1]);
            int wd = 0;
            wd = __builtin_amdgcn_cvt_pk_fp8_f32(x0, x1, wd, false);
            wd = __builtin_amdgcn_cvt_pk_fp8_f32(x2, x3, wd, true);
            const f32x2 h01 = __builtin_amdgcn_cvt_pk_f32_fp8(wd, false), h23 = __builtin_amdgcn_cvt_pk_f32_fp8(wd, true);
            int wl = 0;
            wl = __builtin_amdgcn_cvt_pk_fp8_f32(x0 - h01.x, x1 - h01.y, wl, false);
            wl = __builtin_amdgcn_cvt_pk_fp8_f32(x2 - h23.x, x3 - h23.y, wl, true);
            hi[i] = (unsigned)wd; lo[i] = (unsigned)wl;
        }
        *(uint4*)(shi + lane * 16) = make_uint4(hi[0], hi[1], hi[2], hi[3]);
        *(uint4*)(slo + lane * 16) = make_uint4(lo[0], lo[1], lo[2], lo[3]);
    }
    __builtin_amdgcn_s_waitcnt(0xc07f);
    __builtin_amdgcn_wave_barrier();
    {
        typedef int v8i __attribute__((ext_vector_type(8)));
        const unsigned char* Ub = P.ws + WS_U;
        const unsigned lofs = 64u * (unsigned)(lr >> 3) + 16u * (unsigned)g;
        const unsigned char* bsrc = (lr < 4) ? (((lr & 2) ? slo : shi) + 128 * (lr & 1) + 16 * g) : (const unsigned char*)szero;
        const int bstep = (lr < 4) ? 256 : 0, bhalf = (lr < 4) ? 64 : 16;
        v8i Bv[4];
#pragma unroll
        for (int st = 0; st < 4; ++st) {
            const uint4 b0 = *(const uint4*)(bsrc + bstep * st), b1 = *(const uint4*)(bsrc + bstep * st + bhalf);
            Bv[st] = (v8i){(int)b0.x, (int)b0.y, (int)b0.z, (int)b0.w, (int)b1.x, (int)b1.y, (int)b1.z, (int)b1.w};
        }
        __builtin_amdgcn_s_waitcnt(0xc07f);
        __builtin_amdgcn_wave_barrier();
        float* sact = (float*)sidx + 128 * (lr & 3) + 4 * (g & 1);
        const bool owner = (lr < 4) && ((g >> 1) == (lr & 1));
        uint4 abuf[2][2][4];
        unsigned off2[2];
#pragma unroll
        for (int hh = 0; hh < 2; ++hh) off2[hh] = (unsigned)sid[8 * hh + (lr & 7)] * 512u + lofs;
#pragma unroll
        for (int hh = 0; hh < 2; ++hh)
#pragma unroll
            for (int st = 0; st < 4; ++st) abuf[0][hh][st] = *(const uint4*)(Ub + (off2[hh] + 128 * st));
#pragma unroll
        for (int T = 0; T < 8; ++T) {
            if (T + 1 < 8) {
#pragma unroll
                for (int hh = 0; hh < 2; ++hh) off2[hh] = (unsigned)sid[16 * (T + 1) + 8 * hh + (lr & 7)] * 512u + lofs;
#pragma unroll
                for (int hh = 0; hh < 2; ++hh)
#pragma unroll
                    for (int st = 0; st < 4; ++st) abuf[(T + 1) & 1][hh][st] = *(const uint4*)(Ub + (off2[hh] + 128 * st));
            }
#pragma unroll
            for (int hh = 0; hh < 2; ++hh) {
                f32x4 au = (f32x4){0.f, 0.f, 0.f, 0.f};
#pragma unroll
                for (int st = 0; st < 4; ++st) {
                    const uint4 a4 = abuf[T & 1][hh][st];
                    const v8i Av = {(int)a4.x, (int)a4.y, (int)a4.z, (int)a4.w, 0, 0, 0, 0};
                    au = __builtin_amdgcn_mfma_scale_f32_16x16x128_f8f6f4(Av, Bv[st], au, 4, 0, 0, 0x7f7f7f7f, 0, 0x7f7f7f7f);
                }
                if (owner) *(f32x4*)(sact + 16 * T + 8 * hh) = au;
            }
        }
    }
    __builtin_amdgcn_s_waitcnt(0xc07f);
    __builtin_amdgcn_wave_barrier();
    {
        float* sw = (float*)sidx;
        float wv[2];
#pragma unroll
        for (int hh = 0; hh < 2; ++hh) {
            const int e = lane + 64 * hh, id = sid[e];
            const float a = ((sw[e] + sw[128 + e]) + (sw[256 + e] + sw[384 + e])) * usc[id] * rstd;
            wv[hh] = sgate[e] * vsc[id] * 0.5f * a * (1.f + erff(a * 0.70710678118654752f));
        }
        __builtin_amdgcn_s_waitcnt(0xc07f);
        __builtin_amdgcn_wave_barrier();
        sw[lane] = wv[0]; sw[lane + 64] = wv[1];
    }
    __builtin_amdgcn_s_waitcnt(0xc07f);
    __builtin_amdgcn_wave_barrier();
    const int half = lane >> 5, l5 = lane & 31;
    const int lane_o = 2 * l5 + half;
    f32x2 acc2[16];
#pragma unroll
    for (int j = 0; j < 16; ++j) acc2[j] = (f32x2){0.f, 0.f};
    const unsigned char* Vb = P.ws + WS_V;
    const unsigned vlo = (unsigned)l5 * 16u;
#pragma unroll 1
    for (int e0 = 0; e0 < 128; e0 += 16) {
        uint4 vr[8];
#pragma unroll
        for (int q = 0; q < 8; ++q) vr[q] = *(const uint4*)(Vb + ((unsigned)sid[e0 + 2 * q + half] * 512u + vlo));
        const float* sw = (const float*)sidx + e0;
        const f32x4 w0 = *(const f32x4*)(sw), w1 = *(const f32x4*)(sw + 4), w2 = *(const f32x4*)(sw + 8), w3 = *(const f32x4*)(sw + 12);
        const float wq[16] = {w0[0], w0[1], w0[2], w0[3], w1[0], w1[1], w1[2], w1[3], w2[0], w2[1], w2[2], w2[3], w3[0], w3[1], w3[2], w3[3]};
#pragma unroll
        for (int q = 0; q < 8; ++q) {
            const float w = half ? wq[2 * q + 1] : wq[2 * q];
#define FP4_AXPY(k) { acc2[k] += w * __builtin_amdgcn_cvt_scalef32_pk_f32_fp4(vr[q].x, 1.0f, k); acc2[4 + k] += w * __builtin_amdgcn_cvt_scalef32_pk_f32_fp4(vr[q].y, 1.0f, k); \
                      acc2[8 + k] += w * __builtin_amdgcn_cvt_scalef32_pk_f32_fp4(vr[q].z, 1.0f, k); acc2[12 + k] += w * __builtin_amdgcn_cvt_scalef32_pk_f32_fp4(vr[q].w, 1.0f, k); }
            FP4_AXPY(0) FP4_AXPY(1) FP4_AXPY(2) FP4_AXPY(3)
#undef FP4_AXPY
        }
    }
    f32x2 acc[8];
#pragma unroll
    for (int j = 0; j < 16; ++j) {
        const unsigned x0 = __float_as_uint(acc2[j].x), x1 = __float_as_uint(acc2[j].y);
        const auto r0 = __builtin_amdgcn_permlane32_swap(x0, x0, false, false);
        const auto r1 = __builtin_amdgcn_permlane32_swap(x1, x1, false, false);
        acc2[j].x = __uint_as_float(r0[0]) + __uint_as_float(r0[1]);
        acc2[j].y = __uint_as_float(r1[0]) + __uint_as_float(r1[1]);
    }
#pragma unroll
    for (int j = 0; j < 8; ++j) { acc[j].x = half ? acc2[8 + j].x : acc2[j].x; acc[j].y = half ? acc2[8 + j].y : acc2[j].y; }
    f32x2 xf[8];
    {
        const uint4 xa = *(const uint4*)(xn + lane_o * 16), xb = *(const uint4*)(xn + lane_o * 16 + 8);
        xf[0] = (f32x2){bflo(xa.x), bfhi(xa.x)}; xf[1] = (f32x2){bflo(xa.y), bfhi(xa.y)}; xf[2] = (f32x2){bflo(xa.z), bfhi(xa.z)}; xf[3] = (f32x2){bflo(xa.w), bfhi(xa.w)};
        xf[4] = (f32x2){bflo(xb.x), bfhi(xb.x)}; xf[5] = (f32x2){bflo(xb.y), bfhi(xb.y)}; xf[6] = (f32x2){bflo(xb.z), bfhi(xb.z)}; xf[7] = (f32x2){bflo(xb.w), bfhi(xb.w)};
    }
    float* o = P.out + (size_t)t * DM + lane_o * 16;
    float4 h0, h1, h2, h3;
    {
        const float4 g0 = *(const float4*)(P.norm_ffn + lane_o * 16), g1 = *(const float4*)(P.norm_ffn + lane_o * 16 + 4), g2 = *(const float4*)(P.norm_ffn + lane_o * 16 + 8), g3 = *(const float4*)(P.norm_ffn + lane_o * 16 + 12);
        h0.x = xf[0].x * __builtin_amdgcn_rcpf(g0.x) + acc[0].x; h0.y = xf[0].y * __builtin_amdgcn_rcpf(g0.y) + acc[0].y; h0.z = xf[1].x * __builtin_amdgcn_rcpf(g0.z) + acc[1].x; h0.w = xf[1].y * __builtin_amdgcn_rcpf(g0.w) + acc[1].y;
        h1.x = xf[2].x * __builtin_amdgcn_rcpf(g1.x) + acc[2].x; h1.y = xf[2].y * __builtin_amdgcn_rcpf(g1.y) + acc[2].y; h1.z = xf[3].x * __builtin_amdgcn_rcpf(g1.z) + acc[3].x; h1.w = xf[3].y * __builtin_amdgcn_rcpf(g1.w) + acc[3].y;
        h2.x = xf[4].x * __builtin_amdgcn_rcpf(g2.x) + acc[4].x; h2.y = xf[4].y * __builtin_amdgcn_rcpf(g2.y) + acc[4].y; h2.z = xf[5].x * __builtin_amdgcn_rcpf(g2.z) + acc[5].x; h2.w = xf[5].y * __builtin_amdgcn_rcpf(g2.w) + acc[5].y;
        h3.x = xf[6].x * __builtin_amdgcn_rcpf(g3.x) + acc[6].x; h3.y = xf[6].y * __builtin_amdgcn_rcpf(g3.y) + acc[6].y; h3.z = xf[7].x * __builtin_amdgcn_rcpf(g3.z) + acc[7].x; h3.w = xf[7].y * __builtin_amdgcn_rcpf(g3.w) + acc[7].y;
    }
    *(float4*)(o) = h0; *(float4*)(o + 4) = h1; *(float4*)(o + 8) = h2; *(float4*)(o + 12) = h3;
    __builtin_amdgcn_s_waitcnt(0xc07f);
    __builtin_amdgcn_wave_barrier();
}

#define LAS __attribute__((address_space(3)))
#define XB_TMO      128
#define XB_XCNT(j)  (256  + 64 * (j))
#define XB_XSUB(j)  (1280 + 64 * (j))
#define XB_XGEN(j)  (2304 + 64 * (j))
#define XB_TOP      3328
#define XB_TOPGEN   3392
#define XCD_BAR_WORDS 3456
#define XB_SPIN_CAP (1u << 18)
__device__ __forceinline__ unsigned xb_ld(unsigned* p)              { return __hip_atomic_load(p, __ATOMIC_RELAXED, __HIP_MEMORY_SCOPE_AGENT); }
__device__ __forceinline__ unsigned xb_add(unsigned* p, unsigned v) { return __hip_atomic_fetch_add(p, v, __ATOMIC_RELAXED, __HIP_MEMORY_SCOPE_AGENT); }
__device__ __forceinline__ unsigned xb_xcc_id() { return (unsigned)__builtin_amdgcn_s_getreg((3 << 11) | 20) & 0xFu; }
#define XB_SPIN(cond, bar) do { unsigned _sp = 0; while (cond) { __builtin_amdgcn_s_sleep(1); \
    if ((++_sp & 255u) == 0u) { if (xb_ld(&(bar)[XB_TMO])) break; if (_sp > XB_SPIN_CAP) { atomicAdd(&(bar)[XB_TMO], 1u); break; } } } } while (0)
struct XcdBarrier { unsigned* bar; unsigned x; volatile LAS unsigned* st; };
__device__ __forceinline__ XcdBarrier xcd_barrier_post(unsigned* bar, volatile LAS unsigned* st) {
    XcdBarrier b; b.bar = bar; b.x = xb_xcc_id(); b.st = st;
    if (threadIdx.x == 0) (void)xb_add(&bar[XB_XCNT(b.x)], 1u);
    return b;
}
__device__ __forceinline__ void xcd_barrier_complete(unsigned* bar, unsigned x, unsigned& nloc, unsigned& nx) {
    const unsigned G = gridDim.x * gridDim.y * gridDim.z;
    unsigned sum, cnt, mine, sp = 0u;
    for (;;) {
        sum = 0u; cnt = 0u; mine = 0u;
#pragma unroll
        for (unsigned j = 0; j < 16; ++j) { const unsigned c = xb_ld(&bar[XB_XCNT(j)]); sum += c; cnt += (c > 0u) ? 1u : 0u; mine = (j == x) ? c : mine; }
        if (sum == G) break;
        __builtin_amdgcn_s_sleep(1);
        if ((++sp & 255u) == 0u) { if (xb_ld(&bar[XB_TMO])) break; if (sp > XB_SPIN_CAP) { atomicAdd(&bar[XB_TMO], 1u); break; } }
    }
    nloc = mine > 0u ? mine : 1u; nx = cnt > 0u ? cnt : 1u;
}
__device__ __forceinline__ void xcd_barrier(const XcdBarrier& b) {
    asm volatile("s_waitcnt vmcnt(0)" ::: "memory");
    __syncthreads();
    if (threadIdx.x == 0) {
        unsigned* bar = b.bar;
        __builtin_amdgcn_s_waitcnt(0);
        unsigned nloc = b.st[0], nx = b.st[1];
        if (nloc == 0u) { xcd_barrier_complete(bar, b.x, nloc, nx); b.st[0] = nloc; b.st[1] = nx; }
        const unsigned old = xb_add(&bar[XB_XSUB(b.x)], 1u);
        const unsigned gen = old / nloc;
        if (old + 1u == (gen + 1u) * nloc) {
            __builtin_amdgcn_fence(__ATOMIC_RELEASE, "agent");
            asm volatile("s_waitcnt vmcnt(0)" ::: "memory");
            const unsigned og = xb_add(&bar[XB_TOP], 1u);
            const unsigned tg = og / nx;
            if (og + 1u == (tg + 1u) * nx) xb_add(&bar[XB_TOPGEN], 1u);
            else XB_SPIN(xb_ld(&bar[XB_TOPGEN]) == tg, bar);
            __builtin_amdgcn_fence(__ATOMIC_ACQUIRE, "agent");
            xb_add(&bar[XB_XGEN(b.x)], 1u);
            asm volatile("s_waitcnt vmcnt(0)" ::: "memory");
        } else {
            XB_SPIN(xb_ld(&bar[XB_XGEN(b.x)]) == gen, bar);
            __builtin_amdgcn_fence(__ATOMIC_ACQUIRE, "agent");
            asm volatile("s_waitcnt vmcnt(0)" ::: "memory");
        }
    }
    __syncthreads();
}

__device__ __forceinline__ void hand_release() { asm volatile("s_waitcnt vmcnt(0)" ::: "memory"); __builtin_amdgcn_fence(__ATOMIC_RELEASE, "agent"); asm volatile("s_waitcnt vmcnt(0)" ::: "memory"); }
__device__ __forceinline__ void hand_acquire() { __builtin_amdgcn_fence(__ATOMIC_ACQUIRE, "agent"); asm volatile("s_waitcnt vmcnt(0)" ::: "memory"); }

__global__ void __launch_bounds__(256, 2) mega(Params P) {
    extern __shared__ __attribute__((aligned(16))) unsigned char smem[];
    const int tid = threadIdx.x, lane = tid & 63, wave = tid >> 6;
    const int G = gridDim.x, bid = blockIdx.x;
    unsigned* ctl = (unsigned*)(P.ws + WS_CTL);
    volatile LAS unsigned* bst = (volatile LAS unsigned*)(smem + 65552);
    if (tid == 0) { bst[0] = 0u; bst[1] = 0u; }
    __syncthreads();
    const XcdBarrier xb = xcd_barrier_post(ctl + 1024, bst);
    unsigned* cucnt = ctl + 5120;
    if (tid == 0) {
        const unsigned phys = ((xb_xcc_id() & 7u) << 8) | ((unsigned)__builtin_amdgcn_s_getreg((7 << 11) | (8 << 6) | 4) & 0xFFu);
        bst[2] = phys; bst[3] = xb_add(&cucnt[phys], 1u);
    }
    phase0(P, smem);
    xcd_barrier(xb);
    {
        int vb;
        const unsigned phys = bst[2];
        unsigned part = 0;
#pragma unroll
        for (int q = 0; q < 8; ++q) { const unsigned i = (unsigned)(tid + 256 * q); const unsigned c = xb_ld(&cucnt[i]); part += (i < phys) ? c : 0u; }
#pragma unroll
        for (int o = 1; o < 64; o <<= 1) part += (unsigned)__shfl_xor((int)part, o, 64);
        if (lane == 0) bst[4 + wave] = part;
        __syncthreads();
        vb = (int)(bst[4] + bst[5] + bst[6] + bst[7] + bst[3]);
        vb = __builtin_amdgcn_readfirstlane(vb);
        if (vb < 0 || vb >= G) vb = bid;
        __syncthreads();
        if (tid == 0) bst[8] = (unsigned)vb;
        __syncthreads();
    }
#define VB_LOAD() __builtin_amdgcn_readfirstlane((int)bst[8])
    {
        const int gw = bid * 4 + wave;
        if (gw < 64) fox_cum_wave(P, gw, lane);
        const int vb = VB_LOAD();
        for (int tile = vb; tile < 129 * 28; tile += G) gemm_tile<1>(P, tile / 28, tile % 28, smem);
        {
            const int rem = (129 * 28) % G;
            if (rem > 0 && rem < G) { if (vb >= rem) convert_uv_rows(P, (vb - rem) * 4 + wave, (G - rem) * 4, lane); }
            else convert_uv_rows(P, vb * 4 + wave, G * 4, lane);
        }
    }
    xcd_barrier(xb);
    {
        volatile int* s_item = (volatile int*)(smem + 65536);
        const int wave_u = __builtin_amdgcn_readfirstlane(wave);
        auto fetch = [&](unsigned* counter) -> int {
            if (wave_u == 0) {
                unsigned v = atomicAdd(counter, lane == 0 ? 1u : 0u);
                *s_item = (int)__builtin_amdgcn_readfirstlane(v);
            }
            __syncthreads();
            const int item = __builtin_amdgcn_readfirstlane(*s_item);
            __syncthreads();
            return item;
        };
        for (;;) {
            const int item = fetch(&ctl[2]);
            if (item >= 33 * 32) break;
            mlstm_A(P, item, smem);
        }
        xcd_barrier(xb);
        for (;;) {
            const int item = fetch(&ctl[4]);
            if (item >= 96) break;
            mlstm_B(P, item);
        }
        for (;;) {
            const int item = fetch(&ctl[3]);
            if (item >= 64 * 17) break;
            attn_block(P, item & 63, 16 - (item >> 6), smem);
        }
        xcd_barrier(xb);
        for (;;) {
            const int item = fetch(&ctl[5]);
            if (item >= 33 * 32) break;
            mlstm_C(P, item, smem);
        }
    }
    xcd_barrier(xb);
    for (int tile = VB_LOAD(); tile < 128 * 8; tile += G) gemm_tile<2>(P, tile >> 3, tile & 7, smem);
    xcd_barrier(xb);
    for (int tile = VB_LOAD(); tile < 128 * 16; tile += G) gemm_tile<3>(P, tile >> 4, tile & 15, smem);
    xcd_barrier(xb);
    {
        unsigned char* slut = smem + 12288;
        if (tid < 64) {
            int c = tid, i = 0;
            while (i < 16 && c >= 16 / (i + 1)) { c -= 16 / (i + 1); ++i; }
            slut[tid] = (unsigned char)(i < 16 ? ((i << 4) | c) : 0);
        }
        unsigned* szero = (unsigned*)(smem + 12288 + 64);
        if (tid < 16) szero[tid] = 0u;
        __syncthreads();
        int* sidx = (int*)(smem + wave * 3072); float* sval = (float*)(smem + wave * 3072 + 1024);
        int* sid = (int*)(smem + wave * 3072 + 2048); float* sgate = (float*)(smem + wave * 3072 + 2560);
        int lane5 = lane;
        asm volatile("" : "+v"(lane5));
        {
            int t = bid * 4 + wave;
            uint4 tkw = *(const uint4*)((const unsigned*)(P.ws + WS_TK) + (size_t)(t < T2 ? t : 0) * 256 + lane5 * 4);
            for (; t < T2; t += G * 4) { const int tn = t + G * 4; peer_token(P, t, tn < T2 ? tn : t, tkw, lane5, sidx, sval, sid, sgate, slut, szero); }
        }
    }
}

}

extern "C" void kernel_launch(void* const* d_in, const int* in_sizes, int n_in, void* d_out, int out_size, void* d_ws, size_t ws_size, hipStream_t stream) {
    if (n_in != 17 || ws_size < WS_END) { fprintf(stderr, "kernel_launch: unexpected n_in %d or ws_size %zu (need %zu)\n", n_in, ws_size, (size_t)WS_END); return; }
    constexpr int LDS_BYTES = 66560;
    static int grid_blocks = 0;
    if (!grid_blocks) {
        int dev = 0, cus = 0, per_cu = 0;
        (void)hipGetDevice(&dev);
        (void)hipDeviceGetAttribute(&cus, hipDeviceAttributeMultiprocessorCount, dev);
        (void)hipFuncSetAttribute((const void*)mega, hipFuncAttributeMaxDynamicSharedMemorySize, LDS_BYTES);
        (void)hipOccupancyMaxActiveBlocksPerMultiprocessor(&per_cu, (const void*)mega, 256, LDS_BYTES);
        if (per_cu < 1) per_cu = 1;
        if (per_cu > 2) per_cu = 2;
        grid_blocks = cus * per_cu;
        fprintf(stderr, "kernel_launch: cus %d per_cu %d grid %d\n", cus, per_cu, grid_blocks);
    }
    Params P{};
    P.x = (const float*)d_in[0]; P.meta = (const float*)d_in[1]; P.norm_mix = (const float*)d_in[2]; P.w_in = (const float*)d_in[3];
    P.conv_qk = (const float*)d_in[4]; P.b_igate = (const float*)d_in[5]; P.b_fgate_m = (const float*)d_in[6]; P.m_out_norm = (const float*)d_in[7];
    P.b_fgate_f = (const float*)d_in[8]; P.f_q_norm = (const float*)d_in[9]; P.f_k_norm = (const float*)d_in[10]; P.w_out = (const float*)d_in[11];
    P.norm_ffn = (const float*)d_in[12]; P.peer_query = (const float*)d_in[13]; P.peer_keys = (const float*)d_in[14]; P.peer_u = (const float*)d_in[15];
    P.peer_v = (const float*)d_in[16]; P.out = (float*)d_out; P.ws = (unsigned char*)d_ws;
    (void)hipMemsetAsync((unsigned char*)d_ws + WS_CTL, 0, 32768, stream);
    void* args[] = {&P};
    hipError_t e = hipLaunchCooperativeKernel((const void*)mega, dim3(grid_blocks), dim3(256), args, LDS_BYTES, stream);
    if (e != hipSuccess) fprintf(stderr, "cooperative launch failed: %s (grid %d)\n", hipGetErrorString(e), grid_blocks);
}
```

```cpp
#include <hip/hip_runtime.h>
#include <stdint.h>
#include <stdio.h>
#include <hip/hip_cooperative_groups.h>
namespace cg = cooperative_groups;

namespace {

constexpr int NB = 8, SEQ = 2048, DM = 1024, NMETA = 16, L = SEQ + NMETA;
constexpr int T1 = NB * L;
constexpr int T2 = NB * SEQ;
constexpr int NZ = 3584;
constexpr int ZC_MQ = 0, ZC_MK = 512, ZC_MV = 1024, ZC_MO = 1536, ZC_FQ = 2048, ZC_FK = 2560, ZC_FV = 3072;
constexpr int PROJ = 3600;
constexpr float EPS = 1e-6f;

constexpr size_t WS_CTL = 0;
constexpr size_t WS_RA = 65536;
constexpr size_t WS_Z = WS_RA + (size_t)T1 * DM * 2;
constexpr size_t WS_GATES = WS_Z + (size_t)T1 * NZ * 2;
constexpr size_t WS_CUM = WS_GATES + (size_t)T1 * 16 * 4;
constexpr size_t WS_SSQ = WS_CUM + (size_t)NB * 8 * L * 4;
constexpr size_t WS_RSTD = WS_SSQ + (size_t)T2 * 16 * 4;
constexpr size_t WS_SSQM = WS_RSTD + (size_t)T2 * 4;
constexpr size_t WS_BT2 = WS_SSQM + (size_t)T1 * 16 * 4;
constexpr size_t WS_BT3 = WS_BT2 + (size_t)DM * DM * 2;
constexpr size_t WS_KEYS = WS_BT3 + (size_t)2048 * DM * 2;
constexpr size_t WS_MSC = WS_KEYS + (size_t)16 * 128 * 128 * 2;
constexpr size_t WS_MST = WS_MSC + (size_t)128 * 33 * 16;
constexpr size_t WS_BT1 = WS_MST + (size_t)32 * 33 * 36864;
constexpr size_t WS_CBI = WS_BT1;
constexpr size_t WS_UV = WS_CBI + (size_t)32 * 33 * 36864;
constexpr size_t WS_END = WS_UV + (size_t)2 * 16384 * 512 + (size_t)2 * 16384 * 4;
constexpr size_t WS_XN = WS_RA;
constexpr size_t WS_U = WS_UV;
constexpr size_t WS_V = WS_U + (size_t)16384 * 512;
constexpr size_t WS_USC = WS_V + (size_t)16384 * 512;
constexpr size_t WS_VSC = WS_USC + (size_t)16384 * 4;
constexpr size_t WS_TK = WS_CBI;
constexpr float LOG2E = 1.4426950408889634f;

typedef unsigned short bf16_t;
typedef short bf16x8 __attribute__((ext_vector_type(8)));
typedef float f32x4 __attribute__((ext_vector_type(4)));
typedef __attribute__((ext_vector_type(2))) __bf16 bf16x2_t;

struct Params {
    const float* x; const float* meta; const float* norm_mix; const float* w_in; const float* conv_qk;
    const float* b_igate; const float* b_fgate_m; const float* m_out_norm; const float* b_fgate_f;
    const float* f_q_norm; const float* f_k_norm; const float* w_out; const float* norm_ffn;
    const float* peer_query; const float* peer_keys; const float* peer_u; const float* peer_v;
    float* out; unsigned char* ws;
};

__device__ __forceinline__ unsigned f2bf(float f) { unsigned u = __float_as_uint(f); return (u + 0x7fffu + ((u >> 16) & 1u)) >> 16; }
__device__ __forceinline__ float bf2f(unsigned h) { return __uint_as_float(h << 16); }
typedef float f32x2 __attribute__((ext_vector_type(2)));
typedef __bf16 bf16x2v __attribute__((ext_vector_type(2)));
__device__ __forceinline__ unsigned cvt_pk_bf16(float lo, float hi) { f32x2 v = {lo, hi}; bf16x2v b = __builtin_convertvector(v, bf16x2v); return __builtin_bit_cast(unsigned, b); }
__device__ __forceinline__ unsigned pk2(float lo, float hi) { return cvt_pk_bf16(lo, hi); }
__device__ __forceinline__ float bflo(unsigned w) { return __uint_as_float(w << 16); }
__device__ __forceinline__ float bfhi(unsigned w) { return __uint_as_float(w & 0xffff0000u); }
__device__ __forceinline__ float wave_sum(float v) {
#pragma unroll
    for (int o = 32; o > 0; o >>= 1) v += __shfl_xor(v, o, 64);
    return v;
}
__device__ __forceinline__ float wave_max(float v) {
#pragma unroll
    for (int o = 32; o > 0; o >>= 1) v = fmaxf(v, __shfl_xor(v, o, 64));
    return v;
}
__device__ __forceinline__ float logsigmoidf(float x) { return fminf(x, 0.f) - log1pf(expf(-fabsf(x))); }
__device__ __forceinline__ unsigned ord_key(float f) { unsigned u = __float_as_uint(f); return u ^ ((u >> 31) ? 0xffffffffu : 0x80000000u); }
__device__ __forceinline__ float unord_key(unsigned k) { unsigned u = (k & 0x80000000u) ? (k ^ 0x80000000u) : ~k; return __uint_as_float(u); }

__device__ __forceinline__ void phase0(const Params& P, unsigned char* smem) {
    const int tid = threadIdx.x, lane = tid & 63, wave = tid >> 6;
    unsigned* ctl = (unsigned*)(P.ws + WS_CTL);
    float* gw = (float*)smem;
    for (int idx = tid; idx < 16 * 1024; idx += 256) {
        const int k = idx >> 4, c = idx & 15;
        const int col = c < 8 ? 2048 + c : 3592 + (c - 8);
        gw[c * 1024 + k] = P.w_in[(size_t)k * PROJ + col];
    }
    __syncthreads();
    {
        bf16_t* hn = (bf16_t*)(P.ws + WS_RA);
        float* gates = (float*)(P.ws + WS_GATES);
        const int c0 = lane * 8, c1 = 512 + lane * 8;
        float gm[16];
        {
            const float4 a0 = *(const float4*)(P.norm_mix + c0), a1 = *(const float4*)(P.norm_mix + c0 + 4);
            const float4 a2 = *(const float4*)(P.norm_mix + c1), a3 = *(const float4*)(P.norm_mix + c1 + 4);
            gm[0] = a0.x; gm[1] = a0.y; gm[2] = a0.z; gm[3] = a0.w; gm[4] = a1.x; gm[5] = a1.y; gm[6] = a1.z; gm[7] = a1.w;
            gm[8] = a2.x; gm[9] = a2.y; gm[10] = a2.z; gm[11] = a2.w; gm[12] = a3.x; gm[13] = a3.y; gm[14] = a3.z; gm[15] = a3.w;
        }
        const int myq = ((lane >> 5) & 1) * 8 + ((lane >> 4) & 1) * 4 + ((lane >> 3) & 1) * 2 + ((lane >> 2) & 1);
        const float mybias = myq < 4 ? P.b_igate[myq] : (myq < 8 ? P.b_fgate_m[myq - 4] : P.b_fgate_f[myq - 8]);
        const int rstep = gridDim.x * 4;
        int r = blockIdx.x * 4 + wave;
        float4 n0, n1, n2, n3;
        auto load_row = [&](int rr) {
            const int b = rr / L, p = rr - b * L;
            const float* src = (p < NMETA) ? (P.meta + (size_t)p * DM) : (P.x + ((size_t)b * SEQ + (p - NMETA)) * DM);
            n0 = *(const float4*)(src + c0); n1 = *(const float4*)(src + c0 + 4); n2 = *(const float4*)(src + c1); n3 = *(const float4*)(src + c1 + 4);
        };
        if (r < T1) load_row(r);
        for (; r < T1; r += rstep) {
            float v[16];
            v[0] = n0.x; v[1] = n0.y; v[2] = n0.z; v[3] = n0.w; v[4] = n1.x; v[5] = n1.y; v[6] = n1.z; v[7] = n1.w;
            v[8] = n2.x; v[9] = n2.y; v[10] = n2.z; v[11] = n2.w; v[12] = n3.x; v[13] = n3.y; v[14] = n3.z; v[15] = n3.w;
            if (r + rstep < T1) load_row(r + rstep);
            float ss = 0.f;
#pragma unroll
            for (int j = 0; j < 16; ++j) ss += v[j] * v[j];
            ss = wave_sum(ss);
            const float rstd = rsqrtf(ss * (1.0f / DM) + EPS);
#pragma unroll
            for (int j = 0; j < 16; ++j) v[j] *= rstd * gm[j];
            uint4 o0, o1;
            o0.x = pk2(v[0], v[1]); o0.y = pk2(v[2], v[3]); o0.z = pk2(v[4], v[5]); o0.w = pk2(v[6], v[7]);
            o1.x = pk2(v[8], v[9]); o1.y = pk2(v[10], v[11]); o1.z = pk2(v[12], v[13]); o1.w = pk2(v[14], v[15]);
            *(uint4*)(hn + (size_t)r * DM + c0) = o0;
            *(uint4*)(hn + (size_t)r * DM + c1) = o1;
            float r8[8], r4[4], r2[2], r1;
#pragma unroll
            for (int i = 0; i < 8; ++i) {
                float dd[2];
#pragma unroll
                for (int hh = 0; hh < 2; ++hh) {
                    const float* gwc = gw + (i + 8 * hh) * 1024;
                    const float4 w0 = *(const float4*)(gwc + c0), w1 = *(const float4*)(gwc + c0 + 4), w2 = *(const float4*)(gwc + c1), w3 = *(const float4*)(gwc + c1 + 4);
                    dd[hh] = v[0] * w0.x + v[1] * w0.y + v[2] * w0.z + v[3] * w0.w + v[4] * w1.x + v[5] * w1.y + v[6] * w1.z + v[7] * w1.w
                           + v[8] * w2.x + v[9] * w2.y + v[10] * w2.z + v[11] * w2.w + v[12] * w3.x + v[13] * w3.y + v[14] * w3.z + v[15] * w3.w;
                }
                const bool up = (lane & 32) != 0; const float keep = up ? dd[1] : dd[0], send = up ? dd[0] : dd[1];
                r8[i] = keep + __shfl_xor(send, 32, 64);
                __builtin_amdgcn_sched_barrier(0);
            }
#pragma unroll
            for (int i = 0; i < 4; ++i) { const bool up = (lane & 16) != 0; const float keep = up ? r8[i + 4] : r8[i], send = up ? r8[i] : r8[i + 4]; r4[i] = keep + __shfl_xor(send, 16, 64); }
#pragma unroll
            for (int i = 0; i < 2; ++i) { const bool up = (lane & 8) != 0; const float keep = up ? r4[i + 2] : r4[i], send = up ? r4[i] : r4[i + 2]; r2[i] = keep + __shfl_xor(send, 8, 64); }
            { const bool up = (lane & 4) != 0; const float keep = up ? r2[1] : r2[0], send = up ? r2[0] : r2[1]; r1 = keep + __shfl_xor(send, 4, 64); }
            r1 += __shfl_xor(r1, 2, 64); r1 += __shfl_xor(r1, 1, 64);
            if ((lane & 3) == 0) {
                const float pre = r1 + mybias;
                gates[(size_t)r * 16 + myq] = myq < 4 ? pre : logsigmoidf(pre);
            }
        }
    }
    __syncthreads();
    {
        float* tile = (float*)smem;
        for (int item = blockIdx.x; item < 1664; item += gridDim.x) {
            const float* W; int ldn, ntn, shift_from, it; bf16_t* out;
            if (item < 896) { W = P.w_in; ldn = PROJ; ntn = 56; shift_from = 2048; it = item; out = (bf16_t*)(P.ws + WS_BT1); }
            else if (item < 1152) { W = P.w_out; ldn = 1024; ntn = 16; shift_from = 1 << 30; it = item - 896; out = (bf16_t*)(P.ws + WS_BT2); }
            else { W = P.peer_query; ldn = 2048; ntn = 32; shift_from = 1 << 30; it = item - 1152; out = (bf16_t*)(P.ws + WS_BT3); }
            const int tk = it / ntn, tn = it - tk * ntn, k0 = tk * 64, n0 = tn * 64;
            {
                const int n4 = (tid & 15) * 4, kr = tid >> 4;
                int n = n0 + n4; if (n >= shift_from) n += 8;
                float4 v[4];
#pragma unroll
                for (int i = 0; i < 4; ++i) v[i] = *(const float4*)(W + (size_t)(k0 + kr + 16 * i) * ldn + n);
#pragma unroll
                for (int i = 0; i < 4; ++i) *(float4*)(tile + (kr + 16 * i) * 68 + n4) = v[i];
            }
            __syncthreads();
            {
#pragma unroll
                for (int i = 0; i < 2; ++i) {
                    const int id = tid + 256 * i, nl = id & 63, kc = id >> 6;
                    const float* tp = tile + (kc * 8) * 68 + nl;
                    uint4 o;
                    o.x = pk2(tp[0], tp[68]); o.y = pk2(tp[2 * 68], tp[3 * 68]); o.z = pk2(tp[4 * 68], tp[5 * 68]); o.w = pk2(tp[6 * 68], tp[7 * 68]);
                    *(uint4*)(out + (size_t)(n0 + nl) * 1024 + k0 + kc * 8) = o;
                }
            }
            __syncthreads();
        }
    }
    {
        const size_t gt = (size_t)blockIdx.x * 256 + tid, gs = (size_t)gridDim.x * 256;
        const float* src = P.peer_keys; bf16_t* dst = (bf16_t*)(P.ws + WS_KEYS);
        for (size_t i = gt; i < (size_t)(16 * 128 * 128 / 8); i += gs) {
            const float4 a = *(const float4*)(src + i * 8), b = *(const float4*)(src + i * 8 + 4);
            uint4 o; o.x = pk2(a.x, a.y); o.y = pk2(a.z, a.w); o.z = pk2(b.x, b.y); o.w = pk2(b.z, b.w);
            *(uint4*)(dst + i * 8) = o;
        }
    }
}

__device__ __forceinline__ void convert_uv_rows(const Params& P, int gwave, int nwaves, int lane) {
    for (int rr0 = gwave * 4; rr0 < 2 * 16384; rr0 += nwaves * 4) {
        float4 a[4][4];
#pragma unroll
        for (int q = 0; q < 4; ++q) {
            const int rr = rr0 + q, which = rr >> 14, row = rr & 16383;
            const float* src = (which ? P.peer_v : P.peer_u) + (size_t)row * DM + lane * 16;
            a[q][0] = *(const float4*)(src); a[q][1] = *(const float4*)(src + 4); a[q][2] = *(const float4*)(src + 8); a[q][3] = *(const float4*)(src + 12);
        }
#pragma unroll
        for (int q = 0; q < 4; ++q) {
            const int rr = rr0 + q, which = rr >> 14, row = rr & 16383;
            float mx = 0.f;
#pragma unroll
            for (int j = 0; j < 4; ++j) mx = fmaxf(mx, fmaxf(fmaxf(fabsf(a[q][j].x), fabsf(a[q][j].y)), fmaxf(fabsf(a[q][j].z), fabsf(a[q][j].w))));
            mx = wave_max(mx);
            const float sc = mx > 0.f ? 6.0f / mx : 1.0f;
            unsigned w0 = 0u, w1 = 0u;
            w0 = __builtin_amdgcn_cvt_scalef32_pk_fp4_f32(w0, a[q][0].x * sc, a[q][0].y * sc, 1.0f, 0); w0 = __builtin_amdgcn_cvt_scalef32_pk_fp4_f32(w0, a[q][0].z * sc, a[q][0].w * sc, 1.0f, 1);
            w0 = __builtin_amdgcn_cvt_scalef32_pk_fp4_f32(w0, a[q][1].x * sc, a[q][1].y * sc, 1.0f, 2); w0 = __builtin_amdgcn_cvt_scalef32_pk_fp4_f32(w0, a[q][1].z * sc, a[q][1].w * sc, 1.0f, 3);
            w1 = __builtin_amdgcn_cvt_scalef32_pk_fp4_f32(w1, a[q][2].x * sc, a[q][2].y * sc, 1.0f, 0); w1 = __builtin_amdgcn_cvt_scalef32_pk_fp4_f32(w1, a[q][2].z * sc, a[q][2].w * sc, 1.0f, 1);
            w1 = __builtin_amdgcn_cvt_scalef32_pk_fp4_f32(w1, a[q][3].x * sc, a[q][3].y * sc, 1.0f, 2); w1 = __builtin_amdgcn_cvt_scalef32_pk_fp4_f32(w1, a[q][3].z * sc, a[q][3].w * sc, 1.0f, 3);
            *(uint2*)(P.ws + (which ? WS_V : WS_U) + (size_t)row * 512 + lane * 8) = make_uint2(w0, w1);
            if (lane == 0) ((float*)(P.ws + (which ? WS_VSC : WS_USC)))[row] = mx > 0.f ? mx * (1.0f / 6.0f) : 1.0f;
        }
    }
}

__device__ __forceinline__ void bitonic_sort16_desc(unsigned (&v)[16]) {
#pragma unroll
    for (int k = 2; k <= 16; k <<= 1)
#pragma unroll
        for (int j = k >> 1; j >= 1; j >>= 1)
#pragma unroll
            for (int i = 0; i < 16; ++i)
                if ((i & j) == 0) {
                    const int p = i | j;
                    const bool desc = (k >= 16) ? true : ((i & k) == 0);
                    const unsigned hi = max(v[i], v[p]), lo = min(v[i], v[p]);
                    v[i] = desc ? hi : lo; v[p] = desc ? lo : hi;
                }
}
__device__ __forceinline__ void bitonic_merge16_top(unsigned (&a)[16], const unsigned (&b)[16]) {
#pragma unroll
    for (int i = 0; i < 16; ++i) a[i] = max(a[i], b[15 - i]);
#pragma unroll
    for (int j = 8; j >= 1; j >>= 1)
#pragma unroll
        for (int i = 0; i < 16; ++i)
            if ((i & j) == 0) { const int p = i | j; const unsigned hi = max(a[i], a[p]), lo = min(a[i], a[p]); a[i] = hi; a[p] = lo; }
}

__device__ __forceinline__ float x4_max(float x) {
    const unsigned xi = __float_as_uint(x);
    const auto r = __builtin_amdgcn_permlane32_swap(xi, xi, false, false);
    const float m = fmaxf(__uint_as_float(r[0]), __uint_as_float(r[1]));
    const unsigned mi = __float_as_uint(m);
    const auto r2 = __builtin_amdgcn_permlane16_swap(mi, mi, false, false);
    return fmaxf(__uint_as_float(r2[0]), __uint_as_float(r2[1]));
}
__device__ __forceinline__ float x4_sum(float x) {
    const unsigned xi = __float_as_uint(x);
    const auto r = __builtin_amdgcn_permlane32_swap(xi, xi, false, false);
    const float m = __uint_as_float(r[0]) + __uint_as_float(r[1]);
    const unsigned mi = __float_as_uint(m);
    const auto r2 = __builtin_amdgcn_permlane16_swap(mi, mi, false, false);
    return __uint_as_float(r2[0]) + __uint_as_float(r2[1]);
}

__device__ __forceinline__ int opaque_tid() { int t = threadIdx.x; asm volatile("" : "+v"(t)); return t; }

__device__ __forceinline__ void mma_ktile(const unsigned char* sA, const unsigned char* sB, int arow_off, int brow_off, int g, int sw, f32x4 (&acc)[4][4]) {
#pragma unroll
    for (int s = 0; s < 2; ++s) {
        bf16x8 a[4], b[4];
        const int ch = (((s * 4 + g) ^ sw) << 4);
#pragma unroll
        for (int i = 0; i < 4; ++i) a[i] = *(const bf16x8*)(sA + arow_off + i * 2048 + ch);
#pragma unroll
        for (int j = 0; j < 4; ++j) b[j] = *(const bf16x8*)(sB + brow_off + j * 2048 + ch);
#pragma unroll
        for (int i = 0; i < 4; ++i)
#pragma unroll
            for (int j = 0; j < 4; ++j) acc[i][j] = __builtin_amdgcn_mfma_f32_16x16x32_bf16(b[j], a[i], acc[i][j], 0, 0, 0);
    }
}

__device__ __forceinline__ void store_tile_bf16(const f32x4 (&acc)[4][4], unsigned char* smem, bf16_t* dst, size_t ld, int m0, int n0, int tid, int wr, int wc, int g, int lr) {
#pragma unroll
    for (int i = 0; i < 4; ++i)
#pragma unroll
        for (int j = 0; j < 4; ++j) {
            const int row = wr * 64 + 16 * i + lr, col = wc * 64 + 16 * j + 4 * g;
            uint2 w; w.x = pk2(acc[i][j][0], acc[i][j][1]); w.y = pk2(acc[i][j][2], acc[i][j][3]);
            *(uint2*)(smem + row * 272 + col * 2) = w;
        }
    __syncthreads();
#pragma unroll
    for (int q = 0; q < 8; ++q) {
        const int id = tid + 256 * q, row = id >> 4, ch = id & 15;
        const uint4 v = *(const uint4*)(smem + row * 272 + ch * 16);
        *(uint4*)(dst + (size_t)(m0 + row) * ld + n0 + ch * 8) = v;
    }
    __syncthreads();
}

template <int MODE>
__device__ __forceinline__ void gemm_tile(const Params& P, int tm, int tn, unsigned char* smem) {
    const bf16_t* A; const bf16_t* Bt;
    if (MODE == 1) { A = (const bf16_t*)(P.ws + WS_RA); Bt = (const bf16_t*)(P.ws + WS_BT1); }
    else if (MODE == 2) { A = (const bf16_t*)(P.ws + WS_Z); Bt = (const bf16_t*)(P.ws + WS_BT2); }
    else { A = (const bf16_t*)(P.ws + WS_XN); Bt = (const bf16_t*)(P.ws + WS_BT3); }
    const int tid = opaque_tid(), lane = tid & 63, wave = tid >> 6, wr = wave >> 1, wc = wave & 1, g = lane >> 4, lr = lane & 15;
    const int m0 = tm * 128, n0 = tn * 128;
    const int srow = tid >> 3, sc = tid & 7;
    constexpr unsigned LDA = (MODE == 2 ? NZ : 1024) * 2u;
    unsigned aoff, boff; int soff0;
    {
        int ar = m0 + srow;
        if (MODE == 2) { const int b = ar >> 11, t = ar & 2047; ar = b * L + NMETA + t; }
        aoff = (unsigned)ar * LDA + (unsigned)sc * 16u;
        boff = (unsigned)(n0 + srow) * 2048u + (unsigned)sc * 16u;
        soff0 = srow * 128 + ((sc ^ (srow & 7)) << 4);
    }
    const unsigned char* Ab = (const unsigned char*)A; const unsigned char* Bb = (const unsigned char*)Bt;
    uint4 kpa0, kpa1, kpa2, kpa3, kpb0, kpb1, kpb2, kpb3; float4 ssp0, ssp1, ssp2, ssp3;
    if (MODE == 3) {
        const bf16_t* keys = (const bf16_t*)(P.ws + WS_KEYS) + (size_t)tn * 128 * 128 + (size_t)srow * 128 + sc * 8;
        kpa0 = *(const uint4*)(keys); kpa1 = *(const uint4*)(keys + 32 * 128); kpa2 = *(const uint4*)(keys + 64 * 128); kpa3 = *(const uint4*)(keys + 96 * 128);
        kpb0 = *(const uint4*)(keys + 64); kpb1 = *(const uint4*)(keys + 32 * 128 + 64); kpb2 = *(const uint4*)(keys + 64 * 128 + 64); kpb3 = *(const uint4*)(keys + 96 * 128 + 64);
        const float* ssq = (const float*)(P.ws + WS_SSQ) + (size_t)(m0 + wr * 64 + lr) * 16 + 4 * g;
        ssp0 = *(const float4*)(ssq); ssp1 = *(const float4*)(ssq + 16 * 16); ssp2 = *(const float4*)(ssq + 32 * 16); ssp3 = *(const float4*)(ssq + 48 * 16);
    }
    f32x4 acc[4][4];
#pragma unroll
    for (int i = 0; i < 4; ++i)
#pragma unroll
        for (int j = 0; j < 4; ++j) acc[i][j] = (f32x4){0.f, 0.f, 0.f, 0.f};
    uint4 ra0, ra1, ra2, ra3, rb0, rb1, rb2, rb3;
#define G_LOAD(KT) { const unsigned ko = (unsigned)(KT) * 128u; \
        ra0 = *(const uint4*)(Ab + (aoff + ko)); ra1 = *(const uint4*)(Ab + (aoff + 32u * LDA + ko)); ra2 = *(const uint4*)(Ab + (aoff + 64u * LDA + ko)); ra3 = *(const uint4*)(Ab + (aoff + 96u * LDA + ko)); \
        rb0 = *(const uint4*)(Bb + (boff + ko)); rb1 = *(const uint4*)(Bb + (boff + 32u * 2048u + ko)); rb2 = *(const uint4*)(Bb + (boff + 64u * 2048u + ko)); rb3 = *(const uint4*)(Bb + (boff + 96u * 2048u + ko)); }
#define G_WRITE(SA, SB) { *(uint4*)((SA) + soff0) = ra0; *(uint4*)((SA) + soff0 + 4096) = ra1; *(uint4*)((SA) + soff0 + 8192) = ra2; *(uint4*)((SA) + soff0 + 12288) = ra3; \
        *(uint4*)((SB) + soff0) = rb0; *(uint4*)((SB) + soff0 + 4096) = rb1; *(uint4*)((SB) + soff0 + 8192) = rb2; *(uint4*)((SB) + soff0 + 12288) = rb3; }
    unsigned char* sA0 = smem; unsigned char* sB0 = smem + 16384; unsigned char* sA1 = smem + 32768; unsigned char* sB1 = smem + 49152;
    G_LOAD(0)
    G_WRITE(sA0, sB0)
    __syncthreads();
    const int arow_off = (wr * 64 + lr) * 128, brow_off = (wc * 64 + lr) * 128, sw = lr & 7;
    G_LOAD(1)
    for (int kt = 0; kt < 16; ++kt) {
        unsigned char* sA = (kt & 1) ? sA1 : sA0; unsigned char* sB = (kt & 1) ? sB1 : sB0;
        unsigned char* nA = (kt & 1) ? sA0 : sA1; unsigned char* nB = (kt & 1) ? sB0 : sB1;
        bf16x8 fa[4], fb[4], ga[4], gb[4];
        const int ch0 = ((g ^ sw) << 4), ch1 = (((4 + g) ^ sw) << 4);
        const unsigned ko = (unsigned)(kt + 2) * 128u;
        const bool wr_ok = kt < 15, ld_ok = kt < 14;
#pragma unroll
        for (int i = 0; i < 4; ++i) { fa[i] = *(const bf16x8*)(sA + arow_off + i * 2048 + ch0); fb[i] = *(const bf16x8*)(sB + brow_off + i * 2048 + ch0); }
        __builtin_amdgcn_sched_barrier(0);
        __builtin_amdgcn_s_setprio(2);
        if (wr_ok) *(uint4*)(nA + soff0) = ra0;
        if (ld_ok) ra0 = *(const uint4*)(Ab + (aoff + 0u * LDA + ko));
        ga[0] = *(const bf16x8*)(sA + arow_off + 0 * 2048 + ch1); gb[0] = *(const bf16x8*)(sB + brow_off + 0 * 2048 + ch1);
        __builtin_amdgcn_sched_barrier(0);
#pragma unroll
        for (int j = 0; j < 4; ++j) acc[0][j] = __builtin_amdgcn_mfma_f32_16x16x32_bf16(fb[j], fa[0], acc[0][j], 0, 0, 0);
        __builtin_amdgcn_sched_barrier(0);
        if (wr_ok) *(uint4*)(nA + soff0 + 4096) = ra1;
        if (ld_ok) ra1 = *(const uint4*)(Ab + (aoff + 32u * LDA + ko));
        ga[1] = *(const bf16x8*)(sA + arow_off + 1 * 2048 + ch1); gb[1] = *(const bf16x8*)(sB + brow_off + 1 * 2048 + ch1);
        __builtin_amdgcn_sched_barrier(0);
#pragma unroll
        for (int j = 0; j < 4; ++j) acc[1][j] = __builtin_amdgcn_mfma_f32_16x16x32_bf16(fb[j], fa[1], acc[1][j], 0, 0, 0);
        __builtin_amdgcn_sched_barrier(0);
        if (wr_ok) *(uint4*)(nA + soff0 + 8192) = ra2;
        if (ld_ok) ra2 = *(const uint4*)(Ab + (aoff + 64u * LDA + ko));
        ga[2] = *(const bf16x8*)(sA + arow_off + 2 * 2048 + ch1); gb[2] = *(const bf16x8*)(sB + brow_off + 2 * 2048 + ch1);
        __builtin_amdgcn_sched_barrier(0);
#pragma unroll
        for (int j = 0; j < 4; ++j) acc[2][j] = __builtin_amdgcn_mfma_f32_16x16x32_bf16(fb[j], fa[2], acc[2][j], 0, 0, 0);
        __builtin_amdgcn_sched_barrier(0);
        if (wr_ok) *(uint4*)(nA + soff0 + 12288) = ra3;
        if (ld_ok) ra3 = *(const uint4*)(Ab + (aoff + 96u * LDA + ko));
        ga[3] = *(const bf16x8*)(sA + arow_off + 3 * 2048 + ch1); gb[3] = *(const bf16x8*)(sB + brow_off + 3 * 2048 + ch1);
        __builtin_amdgcn_sched_barrier(0);
#pragma unroll
        for (int j = 0; j < 4; ++j) acc[3][j] = __builtin_amdgcn_mfma_f32_16x16x32_bf16(fb[j], fa[3], acc[3][j], 0, 0, 0);
        __builtin_amdgcn_sched_barrier(0);
        if (wr_ok) *(uint4*)(nB + soff0) = rb0;
        if (ld_ok) rb0 = *(const uint4*)(Bb + (boff + 0u * 2048u + ko));
        __builtin_amdgcn_sched_barrier(0);
#pragma unroll
        for (int j = 0; j < 4; ++j) acc[0][j] = __builtin_amdgcn_mfma_f32_16x16x32_bf16(gb[j], ga[0], acc[0][j], 0, 0, 0);
        __builtin_amdgcn_sched_barrier(0);
        if (wr_ok) *(uint4*)(nB + soff0 + 4096) = rb1;
        if (ld_ok) rb1 = *(const uint4*)(Bb + (boff + 32u * 2048u + ko));
        __builtin_amdgcn_sched_barrier(0);
#pragma unroll
        for (int j = 0; j < 4; ++j) acc[1][j] = __builtin_amdgcn_mfma_f32_16x16x32_bf16(gb[j], ga[1], acc[1][j], 0, 0, 0);
        __builtin_amdgcn_sched_barrier(0);
        if (wr_ok) *(uint4*)(nB + soff0 + 8192) = rb2;
        if (ld_ok) rb2 = *(const uint4*)(Bb + (boff + 64u * 2048u + ko));
        __builtin_amdgcn_sched_barrier(0);
#pragma unroll
        for (int j = 0; j < 4; ++j) acc[2][j] = __builtin_amdgcn_mfma_f32_16x16x32_bf16(gb[j], ga[2], acc[2][j], 0, 0, 0);
        __builtin_amdgcn_sched_barrier(0);
        if (wr_ok) *(uint4*)(nB + soff0 + 12288) = rb3;
        if (ld_ok) rb3 = *(const uint4*)(Bb + (boff + 96u * 2048u + ko));
        __builtin_amdgcn_sched_barrier(0);
#pragma unroll
        for (int j = 0; j < 4; ++j) acc[3][j] = __builtin_amdgcn_mfma_f32_16x16x32_bf16(gb[j], ga[3], acc[3][j], 0, 0, 0);
        __builtin_amdgcn_s_setprio(0);
        __syncthreads();
    }
#undef G_LOAD
#undef G_WRITE
    if (MODE == 1) {
        if (n0 >= ZC_FQ && n0 < ZC_FV) {
            const bool isk = n0 >= ZC_FK;
            const float* gain = isk ? P.f_k_norm : P.f_q_norm;
            const float scl = isk ? 1.0f : 0.125f * LOG2E;
            float gn[4][4];
#pragma unroll
            for (int j = 0; j < 4; ++j)
#pragma unroll
                for (int r = 0; r < 4; ++r) gn[j][r] = gain[16 * j + 4 * g + r];
#pragma unroll
            for (int i = 0; i < 4; ++i) {
                float ss = 0.f;
#pragma unroll
                for (int j = 0; j < 4; ++j)
#pragma unroll
                    for (int r = 0; r < 4; ++r) ss += acc[i][j][r] * acc[i][j][r];
                ss = x4_sum(ss);
                const float rstd = rsqrtf(ss * (1.0f / 64.0f) + EPS) * scl;
#pragma unroll
                for (int j = 0; j < 4; ++j)
#pragma unroll
                    for (int r = 0; r < 4; ++r) acc[i][j][r] *= rstd * gn[j][r];
            }
        }
        store_tile_bf16(acc, smem, (bf16_t*)(P.ws + WS_Z), NZ, m0, n0, tid, wr, wc, g, lr);
    } else if (MODE == 2) {
        float* ssq = (float*)(P.ws + WS_SSQ);
#pragma unroll
        for (int i = 0; i < 4; ++i) {
            const int row = m0 + wr * 64 + 16 * i + lr;
            float ss = 0.f;
#pragma unroll
            for (int j = 0; j < 4; ++j) {
                const int col = n0 + wc * 64 + 16 * j + 4 * g;
                const float4 xv = *(const float4*)(P.x + (size_t)row * DM + col);
                const float4 gv = *(const float4*)(P.norm_ffn + col);
                float4 hv; hv.x = acc[i][j][0] + xv.x; hv.y = acc[i][j][1] + xv.y; hv.z = acc[i][j][2] + xv.z; hv.w = acc[i][j][3] + xv.w;
                ss += hv.x * hv.x + hv.y * hv.y + hv.z * hv.z + hv.w * hv.w;
                acc[i][j][0] = hv.x * gv.x; acc[i][j][1] = hv.y * gv.y; acc[i][j][2] = hv.z * gv.z; acc[i][j][3] = hv.w * gv.w;
            }
            ss = x4_sum(ss);
            if (g == 0) ssq[(size_t)row * 16 + tn * 2 + wc] = ss;
        }
        store_tile_bf16(acc, smem, (bf16_t*)(P.ws + WS_XN), 1024, m0, n0, tid, wr, wc, g, lr);
    } else {
        const int hp = tn;
        float rs[4];
#pragma unroll
        for (int i = 0; i < 4; ++i) {
            const int row = m0 + wr * 64 + 16 * i + lr;
            const float4 sp = i == 0 ? ssp0 : i == 1 ? ssp1 : i == 2 ? ssp2 : ssp3;
            const float s = x4_sum((sp.x + sp.y) + (sp.z + sp.w));
            rs[i] = rsqrtf(s * (1.0f / DM) + EPS);
            if (tn == 0 && wc == 0 && g == 0) ((float*)(P.ws + WS_RSTD))[row] = rs[i];
        }
        {
            unsigned char* sAq = wc ? sA1 : sA0;
#pragma unroll
            for (int i = 0; i < 4; ++i)
#pragma unroll
                for (int j = 0; j < 4; ++j) {
                    const int row = wr * 64 + 16 * i + lr;
                    const int chunk = 2 * j + (g >> 1);
                    uint2 w; w.x = pk2(acc[i][j][0] * rs[i], acc[i][j][1] * rs[i]); w.y = pk2(acc[i][j][2] * rs[i], acc[i][j][3] * rs[i]);
                    *(uint2*)(sAq + row * 128 + ((chunk ^ (row & 7)) << 4) + 8 * (g & 1)) = w;
                }
#pragma unroll
            for (int j = 0; j < 1; ++j) {
                *(uint4*)(sB0 + soff0) = kpa0; *(uint4*)(sB0 + soff0 + 4096) = kpa1; *(uint4*)(sB0 + soff0 + 8192) = kpa2; *(uint4*)(sB0 + soff0 + 12288) = kpa3;
                *(uint4*)(sB1 + soff0) = kpb0; *(uint4*)(sB1 + soff0 + 4096) = kpb1; *(uint4*)(sB1 + soff0 + 8192) = kpb2; *(uint4*)(sB1 + soff0 + 12288) = kpb3;
            }
        }
        __syncthreads();
#pragma unroll
        for (int i = 0; i < 4; ++i)
#pragma unroll
            for (int j = 0; j < 4; ++j) acc[i][j] = (f32x4){0.f, 0.f, 0.f, 0.f};
        mma_ktile(sA0, sB0, arow_off, brow_off, g, sw, acc);
        mma_ktile(sA1, sB1, arow_off, brow_off, g, sw, acc);
        __syncthreads();
#pragma unroll
        for (int i = 0; i < 4; ++i)
#pragma unroll
            for (int j = 0; j < 4; ++j) {
                const int row = wr * 64 + 16 * i + lr;
                const int c4 = wc * 16 + 4 * j + g;
                *(f32x4*)(smem + row * 512 + ((c4 ^ (row & 31)) << 4)) = acc[i][j];
            }
        __syncthreads();
        unsigned top[16];
        const int row = tid & 127, half = tid >> 7;
        {
            auto load_keys = [&](unsigned (&dst)[16], int q4) {
#pragma unroll
                for (int s4 = 0; s4 < 4; ++s4) {
                    const int c4 = half * 16 + q4 * 4 + s4;
                    const f32x4 v = *(const f32x4*)(smem + row * 512 + ((c4 ^ (row & 31)) << 4));
#pragma unroll
                    for (int e = 0; e < 4; ++e) dst[s4 * 4 + e] = (ord_key(v[e]) & ~127u) | (unsigned)(127 - (c4 * 4 + e));
                }
            };
            load_keys(top, 0);
            bitonic_sort16_desc(top);
#pragma unroll 1
            for (int q4 = 1; q4 < 4; ++q4) {
                unsigned gq[16];
                load_keys(gq, q4);
                bitonic_sort16_desc(gq);
                bitonic_merge16_top(top, gq);
            }
        }
        __syncthreads();
        if (half) {
            uint4* lp = (uint4*)(smem + row * 64);
            lp[0] = make_uint4(top[0], top[1], top[2], top[3]); lp[1] = make_uint4(top[4], top[5], top[6], top[7]);
            lp[2] = make_uint4(top[8], top[9], top[10], top[11]); lp[3] = make_uint4(top[12], top[13], top[14], top[15]);
        }
        __syncthreads();
        if (!half) {
            const uint4* lp = (const uint4*)(smem + row * 64);
            unsigned other[16];
#pragma unroll
            for (int c = 0; c < 4; ++c) { const uint4 o = lp[c]; other[4 * c] = o.x; other[4 * c + 1] = o.y; other[4 * c + 2] = o.z; other[4 * c + 3] = o.w; }
            bitonic_merge16_top(top, other);
            uint4* tk = (uint4*)((unsigned*)(P.ws + WS_TK) + ((size_t)(m0 + row) * 16 + hp) * 16);
            tk[0] = make_uint4(top[0], top[1], top[2], top[3]); tk[1] = make_uint4(top[4], top[5], top[6], top[7]);
            tk[2] = make_uint4(top[8], top[9], top[10], top[11]); tk[3] = make_uint4(top[12], top[13], top[14], top[15]);
        }
        __syncthreads();
    }
}

__device__ __forceinline__ void fox_cum_wave(const Params& P, int bh, int lane) {
    const int b = bh >> 3, h = bh & 7;
    const float* gates = (const float*)(P.ws + WS_GATES);
    float* cum = (float*)(P.ws + WS_CUM) + (size_t)bh * L;
    constexpr int SEG = 33;
    const int t0 = lane * SEG;
    float loc = 0.f;
    for (int i = 0; i < SEG; ++i) { const int t = t0 + i; if (t < L) loc += gates[(size_t)(b * L + t) * 16 + 8 + h]; }
    float incl = loc;
#pragma unroll
    for (int o = 1; o < 64; o <<= 1) { const float n = __shfl_up(incl, o, 64); if (lane >= o) incl += n; }
    float run = incl - loc;
    for (int i = 0; i < SEG; ++i) { const int t = t0 + i; if (t < L) { run += gates[(size_t)(b * L + t) * 16 + 8 + h]; cum[t] = run * LOG2E; } }
}

#define TR_SLOW 0

__device__ __forceinline__ int vimg_off(int row, int ch) { return row * 128 + ((ch ^ (((row >> 1) & 3) << 1)) << 4); }
__device__ __forceinline__ uint2 tr_frag(const unsigned char* img, int row0, int c, int g, int lr) {
#if TR_SLOW
    unsigned short e[4];
#pragma unroll
    for (int k = 0; k < 4; ++k) { const int row = row0 + 4 * g + k, col = 16 * c + lr; e[k] = *(const unsigned short*)(img + vimg_off(row, col >> 3) + (col & 7) * 2); }
    uint2 r; r.x = (unsigned)e[0] | ((unsigned)e[1] << 16); r.y = (unsigned)e[2] | ((unsigned)e[3] << 16); return r;
#else
    const int q = lr >> 2, p = lr & 3, row = row0 + 4 * g + q;
    const unsigned addr = (unsigned)(size_t)(img + vimg_off(row, 2 * c + (p >> 1)) + 8 * (p & 1));
    uint2 r;
    asm volatile("ds_read_b64_tr_b16 %0, %1\n\ts_waitcnt lgkmcnt(0)" : "=&v"(r) : "v"(addr) : "memory");
    return r;
#endif
}

__device__ __forceinline__ unsigned tr_lane_addr(const unsigned char* img, int c, int g, int lr) {
    const int q = lr >> 2, p = lr & 3, row = 4 * g + q;
    return (unsigned)(size_t)(img + vimg_off(row, 2 * c + (p >> 1)) + 8 * (p & 1));
}
#define TR_GROUP(o0, o1, o2, o3, a) "ds_read_b64_tr_b16 %" #o0 ", %" #a "\n\tds_read_b64_tr_b16 %" #o1 ", %" #a " offset:2048\n\tds_read_b64_tr_b16 %" #o2 ", %" #a " offset:4096\n\tds_read_b64_tr_b16 %" #o3 ", %" #a " offset:6144\n\t"
__device__ __forceinline__ void tr_read_4c(const unsigned char* img, int g, int lr, uint2 (&r)[4][4]) {
    const unsigned a0 = tr_lane_addr(img, 0, g, lr), a1 = tr_lane_addr(img, 1, g, lr), a2 = tr_lane_addr(img, 2, g, lr), a3 = tr_lane_addr(img, 3, g, lr);
    asm volatile(TR_GROUP(0, 1, 2, 3, 16) TR_GROUP(4, 5, 6, 7, 17) TR_GROUP(8, 9, 10, 11, 18) TR_GROUP(12, 13, 14, 15, 19) "s_waitcnt lgkmcnt(0)"
        : "=&v"(r[0][0]), "=&v"(r[0][1]), "=&v"(r[0][2]), "=&v"(r[0][3]), "=&v"(r[1][0]), "=&v"(r[1][1]), "=&v"(r[1][2]), "=&v"(r[1][3]),
          "=&v"(r[2][0]), "=&v"(r[2][1]), "=&v"(r[2][2]), "=&v"(r[2][3]), "=&v"(r[3][0]), "=&v"(r[3][1]), "=&v"(r[3][2]), "=&v"(r[3][3])
        : "v"(a0), "v"(a1), "v"(a2), "v"(a3) : "memory");
}
__device__ __forceinline__ void tr_read_3c(const unsigned char* img, int g, int lr, uint2 (&r)[3][4]) {
    const unsigned a0 = tr_lane_addr(img, 0, g, lr), a1 = tr_lane_addr(img, 1, g, lr), a2 = tr_lane_addr(img, 2, g, lr);
    asm volatile(TR_GROUP(0, 1, 2, 3, 12) TR_GROUP(4, 5, 6, 7, 13) TR_GROUP(8, 9, 10, 11, 14) "s_waitcnt lgkmcnt(0)"
        : "=&v"(r[0][0]), "=&v"(r[0][1]), "=&v"(r[0][2]), "=&v"(r[0][3]), "=&v"(r[1][0]), "=&v"(r[1][1]), "=&v"(r[1][2]), "=&v"(r[1][3]),
          "=&v"(r[2][0]), "=&v"(r[2][1]), "=&v"(r[2][2]), "=&v"(r[2][3])
        : "v"(a0), "v"(a1), "v"(a2) : "memory");
}
__device__ __forceinline__ void tr_read_2(const unsigned char* img0, int c0, const unsigned char* img1, int c1, int g, int lr, uint2 (&r)[2][4]) {
    const unsigned a0 = tr_lane_addr(img0, c0, g, lr), a1 = tr_lane_addr(img1, c1, g, lr);
    asm volatile(TR_GROUP(0, 1, 2, 3, 8) TR_GROUP(4, 5, 6, 7, 9) "s_waitcnt lgkmcnt(0)"
        : "=&v"(r[0][0]), "=&v"(r[0][1]), "=&v"(r[0][2]), "=&v"(r[0][3]), "=&v"(r[1][0]), "=&v"(r[1][1]), "=&v"(r[1][2]), "=&v"(r[1][3])
        : "v"(a0), "v"(a1) : "memory");
}
__device__ __forceinline__ bf16x8 tr_pair(const uint2& lo, const uint2& hi) { uint4 u; u.x = lo.x; u.y = lo.y; u.z = hi.x; u.w = hi.y; return __builtin_bit_cast(bf16x8, u); }

__device__ __forceinline__ void attn_block(const Params& P, int bh, int qb, unsigned char* smem) {
    const int tid = opaque_tid(), lane = tid & 63, w = tid >> 6, g = lane >> 4, lr = lane & 15;
    const int b = bh >> 3, h = bh & 7;
    const bf16_t* z = (const bf16_t*)(P.ws + WS_Z);
    const float* cum = (const float*)(P.ws + WS_CUM) + (size_t)bh * L;
    int tq[2]; bool qvalid[2]; bf16x8 qf[2][2];
#pragma unroll
    for (int u = 0; u < 2; ++u) {
        tq[u] = qb * 128 + 32 * w + 16 * u + lr;
        qvalid[u] = tq[u] < L;
        const bf16_t* qp = z + (size_t)(b * L + (qvalid[u] ? tq[u] : 0)) * NZ + ZC_FQ + h * 64 + 8 * g;
        qf[u][0] = *(const bf16x8*)(qp); qf[u][1] = *(const bf16x8*)(qp + 32);
    }
    const int nkv = (2 * qb + 2 < 33) ? 2 * qb + 2 : 33;
    const int srow0 = tid >> 3, sch = tid & 7;
    uint4 rk0, rk1, rv0, rv1; float rc = 0.f;
    auto load_tile = [&](int kv) {
        const int key0 = kv * 64 + srow0, key1 = key0 + 32;
        const bf16_t* p0 = z + (size_t)(b * L + (key0 < L ? key0 : L - 1)) * NZ + h * 64 + sch * 8;
        const bf16_t* p1 = z + (size_t)(b * L + (key1 < L ? key1 : L - 1)) * NZ + h * 64 + sch * 8;
        rk0 = *(const uint4*)(p0 + ZC_FK); rv0 = *(const uint4*)(p0 + ZC_FV);
        rk1 = *(const uint4*)(p1 + ZC_FK); rv1 = *(const uint4*)(p1 + ZC_FV);
        const int keyc = kv * 64 + (tid & 63);
        rc = cum[keyc < L ? keyc : L - 1];
    };
    auto store_tile = [&](int buf) {
        unsigned char* sK = smem + buf * 16384; unsigned char* sV = sK + 8192;
        const int row0 = srow0, row1 = srow0 + 32;
        *(uint4*)(sK + row0 * 128 + ((sch ^ (row0 & 7)) << 4)) = rk0;
        *(uint4*)(sV + vimg_off(row0, sch)) = rv0;
        *(uint4*)(sK + row1 * 128 + ((sch ^ (row1 & 7)) << 4)) = rk1;
        *(uint4*)(sV + vimg_off(row1, sch)) = rv1;
        if (tid < 64) ((float*)(smem + 32768 + buf * 256))[tid] = rc;
    };
    float m[2] = {-1e30f, -1e30f};
    f32x4 o[2][5];
#pragma unroll
    for (int u = 0; u < 2; ++u)
#pragma unroll
        for (int c = 0; c < 5; ++c) o[u][c] = (f32x4){0.f, 0.f, 0.f, 0.f};
    const unsigned onew = (lr == 0) ? 0x3F803F80u : 0u;
    const bf16x8 vones = __builtin_bit_cast(bf16x8, make_uint4(onew, onew, onew, onew));
    load_tile(nkv - 1); store_tile((nkv - 1) & 1);
    __syncthreads();
    if (nkv > 1) load_tile(nkv - 2);
    for (int kv = nkv - 1; kv >= 0; --kv) {
        const int buf = kv & 1;
        const unsigned char* sK = smem + buf * 16384; const unsigned char* sV = sK + 8192;
        const float* sck = (const float*)(smem + 32768 + buf * 256);
        f32x4 sa[2][4];
#pragma unroll
        for (int c = 0; c < 4; ++c) {
            sa[0][c] = (f32x4){0.f, 0.f, 0.f, 0.f}; sa[1][c] = (f32x4){0.f, 0.f, 0.f, 0.f};
#pragma unroll
            for (int s = 0; s < 2; ++s) {
                const bf16x8 kf = *(const bf16x8*)(sK + (16 * c + lr) * 128 + (((4 * s + g) ^ (lr & 7)) << 4));
                sa[0][c] = __builtin_amdgcn_mfma_f32_16x16x32_bf16(kf, qf[0][s], sa[0][c], 0, 0, 0);
                sa[1][c] = __builtin_amdgcn_mfma_f32_16x16x32_bf16(kf, qf[1][s], sa[1][c], 0, 0, 0);
            }
        }
        __builtin_amdgcn_sched_barrier(0);
        if (kv > 0) store_tile(buf ^ 1);
        if (kv > 1) load_tile(kv - 2);
        __builtin_amdgcn_sched_barrier(0);
        if (kv >= 2 * qb) {
#pragma unroll
            for (int u = 0; u < 2; ++u)
#pragma unroll
                for (int c = 0; c < 4; ++c)
#pragma unroll
                    for (int r = 0; r < 4; ++r)
                        if (64 * kv + 16 * c + 4 * g + r > tq[u]) sa[u][c][r] = -INFINITY;
        }
        f32x4 ck[4];
#pragma unroll
        for (int c = 0; c < 4; ++c) ck[c] = *(const f32x4*)(sck + 16 * c + 4 * g);
        bf16x8 pf[2][2];
#pragma unroll
        for (int u = 0; u < 2; ++u) {
            float mx = -INFINITY;
#pragma unroll
            for (int c = 0; c < 4; ++c) {
                sa[u][c] -= ck[c];
                mx = fmaxf(mx, fmaxf(fmaxf(sa[u][c][0], sa[u][c][1]), fmaxf(sa[u][c][2], sa[u][c][3])));
            }
            mx = x4_max(mx);
            if (__builtin_amdgcn_ballot_w64(mx > m[u]) != 0ull) {
                const float mn = fmaxf(m[u], mx);
                const float alpha = __builtin_amdgcn_exp2f(m[u] - mn);
                m[u] = mn;
#pragma unroll
                for (int c = 0; c < 5; ++c) o[u][c] *= alpha;
            }
            const float mn = m[u];
#pragma unroll
            for (int c = 0; c < 4; ++c)
#pragma unroll
                for (int r = 0; r < 4; ++r) sa[u][c][r] = __builtin_amdgcn_exp2f(sa[u][c][r] - mn);
#pragma unroll
            for (int s2 = 0; s2 < 2; ++s2) {
                uint4 uu;
                uu.x = cvt_pk_bf16(sa[u][2 * s2][0], sa[u][2 * s2][1]); uu.y = cvt_pk_bf16(sa[u][2 * s2][2], sa[u][2 * s2][3]);
                uu.z = cvt_pk_bf16(sa[u][2 * s2 + 1][0], sa[u][2 * s2 + 1][1]); uu.w = cvt_pk_bf16(sa[u][2 * s2 + 1][2], sa[u][2 * s2 + 1][3]);
                pf[u][s2] = __builtin_bit_cast(bf16x8, uu);
            }
        }
        {
            uint2 vr[4][4];
            tr_read_4c(sV, g, lr, vr);
#pragma unroll
            for (int c = 0; c < 4; ++c)
#pragma unroll
                for (int s2 = 0; s2 < 2; ++s2) {
                    const bf16x8 vf = tr_pair(vr[c][2 * s2], vr[c][2 * s2 + 1]);
                    o[0][c] = __builtin_amdgcn_mfma_f32_16x16x32_bf16(vf, pf[0][s2], o[0][c], 0, 0, 0);
                    o[1][c] = __builtin_amdgcn_mfma_f32_16x16x32_bf16(vf, pf[1][s2], o[1][c], 0, 0, 0);
                }
#pragma unroll
            for (int s2 = 0; s2 < 2; ++s2) {
                o[0][4] = __builtin_amdgcn_mfma_f32_16x16x32_bf16(vones, pf[0][s2], o[0][4], 0, 0, 0);
                o[1][4] = __builtin_amdgcn_mfma_f32_16x16x32_bf16(vones, pf[1][s2], o[1][4], 0, 0, 0);
            }
        }
        __syncthreads();
    }
#pragma unroll
    for (int u = 0; u < 2; ++u) {
        const float ls = __shfl(o[u][4][0], lr, 64);
        const float inv = 1.0f / ls;
        if (qvalid[u]) {
            bf16_t* y = (bf16_t*)(P.ws + WS_Z) + (size_t)(b * L + tq[u]) * NZ + 512 + h * 64 + 4 * g;
#pragma unroll
            for (int c = 0; c < 4; ++c) {
                uint2 uu; uu.x = pk2(o[u][c][0] * inv, o[u][c][1] * inv); uu.y = pk2(o[u][c][2] * inv, o[u][c][3] * inv);
                *(uint2*)(y + 16 * c) = uu;
            }
        }
    }
}

__device__ __forceinline__ void conv_item(const Params& P, int ci) {
    const int tid = opaque_tid(), cc = tid & 127, rg = tid >> 7;
    const bf16_t* z = (const bf16_t*)(P.ws + WS_Z);
    bf16_t* qk = (bf16_t*)(P.ws + WS_RA);
    const int col0 = cc * 8;
    float w[4][8];
#pragma unroll
    for (int j = 0; j < 4; ++j) {
        const float4 a = *(const float4*)(P.conv_qk + j * 1024 + col0), b = *(const float4*)(P.conv_qk + j * 1024 + col0 + 4);
        w[j][0] = a.x; w[j][1] = a.y; w[j][2] = a.z; w[j][3] = a.w; w[j][4] = b.x; w[j][5] = b.y; w[j][6] = b.z; w[j][7] = b.w;
    }
    const float oscale = (col0 >= 512) ? 0.08838834764831845f : 1.0f;
    const int r0 = ci * 64 + rg * 32;
    int t = r0 % L;
    float xw[3][8];
#pragma unroll
    for (int j = 0; j < 3; ++j) {
        const int back = 3 - j;
        if (t - back >= 0) {
            const uint4 v = *(const uint4*)(z + (size_t)(r0 - back) * NZ + col0);
            xw[j][0] = bflo(v.x); xw[j][1] = bfhi(v.x); xw[j][2] = bflo(v.y); xw[j][3] = bfhi(v.y); xw[j][4] = bflo(v.z); xw[j][5] = bfhi(v.z); xw[j][6] = bflo(v.w); xw[j][7] = bfhi(v.w);
        } else {
#pragma unroll
            for (int e = 0; e < 8; ++e) xw[j][e] = 0.f;
        }
    }
#pragma unroll 2
    for (int i = 0; i < 32; ++i) {
        const int r = r0 + i;
        if (t == 0) {
#pragma unroll
            for (int j = 0; j < 3; ++j)
#pragma unroll
                for (int e = 0; e < 8; ++e) xw[j][e] = 0.f;
        }
        const uint4 v = *(const uint4*)(z + (size_t)r * NZ + col0);
        float xt[8];
        xt[0] = bflo(v.x); xt[1] = bfhi(v.x); xt[2] = bflo(v.y); xt[3] = bfhi(v.y); xt[4] = bflo(v.z); xt[5] = bfhi(v.z); xt[6] = bflo(v.w); xt[7] = bfhi(v.w);
        float o[8];
#pragma unroll
        for (int e = 0; e < 8; ++e) {
            const float cv = w[0][e] * xw[0][e] + w[1][e] * xw[1][e] + w[2][e] * xw[2][e] + w[3][e] * xt[e];
            o[e] = oscale * cv / (1.f + __expf(-cv));
            xw[0][e] = xw[1][e]; xw[1][e] = xw[2][e]; xw[2][e] = xt[e];
        }
        uint4 ov; ov.x = pk2(o[0], o[1]); ov.y = pk2(o[2], o[3]); ov.z = pk2(o[4], o[5]); ov.w = pk2(o[6], o[7]);
        *(uint4*)(qk + (size_t)r * 1024 + col0) = ov;
        t = (t + 1 == L) ? 0 : t + 1;
    }
}

constexpr int ST_IMG = 36864;
__device__ __forceinline__ int st_piece_off(int jt, int c, int g, int lr) { return (jt >> 2) * 18432 + vimg_off(16 * c + lr, 2 * (jt & 3) + (g >> 1)) + 8 * (g & 1); }

__device__ __forceinline__ void mlstm_stage_kv(const Params& P, int b, int h, int k, unsigned char* sKimg, unsigned char* sVimg, int tid) {
    const bf16_t* z = (const bf16_t*)(P.ws + WS_Z);
    const bf16_t* qk = (const bf16_t*)(P.ws + WS_RA);
    uint4 pk_[4], pv_[4];
#pragma unroll
    for (int j = 0; j < 4; ++j) {
        const int id = tid + 256 * j, row = id >> 4, ch16 = id & 15, pos = 64 * k + row;
        const bool ok = pos < L;
        pk_[j] = ok ? *(const uint4*)(qk + (size_t)(b * L + pos) * 1024 + 512 + h * 128 + ch16 * 8) : make_uint4(0, 0, 0, 0);
        pv_[j] = ok ? *(const uint4*)(z + (size_t)(b * L + pos) * NZ + ZC_MV + h * 128 + ch16 * 8) : make_uint4(0, 0, 0, 0);
    }
#pragma unroll
    for (int j = 0; j < 4; ++j) {
        const int id = tid + 256 * j, row = id >> 4, ch16 = id & 15;
        *(uint4*)(sKimg + (ch16 >> 3) * 8192 + vimg_off(row, ch16 & 7)) = pk_[j];
        *(uint4*)(sVimg + (ch16 >> 3) * 8192 + vimg_off(row, ch16 & 7)) = pv_[j];
    }
    if (tid < 128) {
        const int row = tid >> 1, ch = tid & 1;
        *(uint4*)(sVimg + 16384 + vimg_off(row, ch)) = ch ? make_uint4(0, 0, 0, 0) : make_uint4(0x3F80u, 0, 0, 0);
    }
}

__device__ __forceinline__ void mlstm_stage_A(const Params& P, int b, int h, int k, unsigned char* sKimg, unsigned char* sVimg, int tid) {
    const bf16_t* z = (const bf16_t*)(P.ws + WS_Z);
    bf16_t* qk = (bf16_t*)(P.ws + WS_RA);
    uint4 pv_[4];
#pragma unroll
    for (int j = 0; j < 4; ++j) {
        const int id = tid + 256 * j, row = id >> 4, ch16 = id & 15, pos = 64 * k + row;
        pv_[j] = (pos < L) ? *(const uint4*)(z + (size_t)(b * L + pos) * NZ + ZC_MV + h * 128 + ch16 * 8) : make_uint4(0, 0, 0, 0);
    }
    const int cch = tid & 31, rg = tid >> 5, isk = cch >> 4;
    const int zcol = (isk ? ZC_MK : ZC_MQ) + h * 128 + (cch & 15) * 8;
    float w[4][8];
#pragma unroll
    for (int j = 0; j < 4; ++j) {
        const float4 a = *(const float4*)(P.conv_qk + j * 1024 + zcol), c = *(const float4*)(P.conv_qk + j * 1024 + zcol + 4);
        w[j][0] = a.x; w[j][1] = a.y; w[j][2] = a.z; w[j][3] = a.w; w[j][4] = c.x; w[j][5] = c.y; w[j][6] = c.z; w[j][7] = c.w;
    }
    const float oscale = isk ? 0.08838834764831845f : 1.0f;
    const int p0 = 64 * k + 8 * rg;
    uint4 raw[11];
#pragma unroll
    for (int i = 0; i < 11; ++i) {
        const int pos = p0 - 3 + i;
        raw[i] = (pos >= 0 && pos < L) ? *(const uint4*)(z + (size_t)(b * L + pos) * NZ + zcol) : make_uint4(0, 0, 0, 0);
    }
#pragma unroll
    for (int j = 0; j < 4; ++j) {
        const int id = tid + 256 * j, row = id >> 4, ch16 = id & 15;
        *(uint4*)(sVimg + (ch16 >> 3) * 8192 + vimg_off(row, ch16 & 7)) = pv_[j];
    }
    if (tid < 128) {
        const int row = tid >> 1, ch = tid & 1;
        *(uint4*)(sVimg + 16384 + vimg_off(row, ch)) = ch ? make_uint4(0, 0, 0, 0) : make_uint4(0x3F80u, 0, 0, 0);
    }
#pragma unroll
    for (int i = 0; i < 8; ++i) {
        const int pos = p0 + i, row = 8 * rg + i;
        float o[8];
#pragma unroll
        for (int e = 0; e < 8; ++e) {
            const unsigned w0 = (&raw[i].x)[e >> 1], w1 = (&raw[i + 1].x)[e >> 1], w2 = (&raw[i + 2].x)[e >> 1], w3 = (&raw[i + 3].x)[e >> 1];
            const float x0 = (e & 1) ? bfhi(w0) : bflo(w0), x1 = (e & 1) ? bfhi(w1) : bflo(w1), x2 = (e & 1) ? bfhi(w2) : bflo(w2), x3 = (e & 1) ? bfhi(w3) : bflo(w3);
            const float cv = w[0][e] * x0 + w[1][e] * x1 + w[2][e] * x2 + w[3][e] * x3;
            o[e] = oscale * cv / (1.f + __expf(-cv));
        }
        uint4 ov; ov.x = pk2(o[0], o[1]); ov.y = pk2(o[2], o[3]); ov.z = pk2(o[4], o[5]); ov.w = pk2(o[6], o[7]);
        const bool ok = pos < L;
        if (!ok) ov = make_uint4(0, 0, 0, 0);
        if (ok) *(uint4*)(qk + (size_t)(b * L + pos) * 1024 + (isk ? 512 : 0) + h * 128 + (cch & 15) * 8) = ov;
        if (isk) { const int ch16 = cch & 15; *(uint4*)(sKimg + (ch16 >> 3) * 8192 + vimg_off(row, ch16 & 7)) = ov; }
    }
}

__device__ __forceinline__ void mlstm_A(const Params& P, int item, unsigned char* smem) {
    const int tid = opaque_tid(), lane = tid & 63, w = tid >> 6, g = lane >> 4, lr = lane & 15;
    const int wu = __builtin_amdgcn_readfirstlane(w);
    const int k = item >> 5, bh = item & 31, b = bh >> 2, h = bh & 3;
    const float* gates = (const float*)(P.ws + WS_GATES);
    const unsigned char* sK = smem; const unsigned char* sV = smem + 16384;
    float* ga = (float*)(smem + 40960);
    float lf = 0.f, li = -INFINITY;
    if (wu == 0) {
        const int pos = 64 * k + lane;
        if (pos < L) { lf = gates[(size_t)(b * L + pos) * 16 + 4 + h]; li = gates[(size_t)(b * L + pos) * 16 + h]; }
    }
    mlstm_stage_A(P, b, h, k, smem, smem + 16384, tid);
    if (wu == 0) {
        float bc = lf;
#pragma unroll
        for (int o = 1; o < 64; o <<= 1) { const float n = __shfl_up(bc, o, 64); if (lane >= o) bc += n; }
        const float a = li - bc;
        const float A = wave_max(a);
        ga[lane] = __expf(a - A);
        if (lane == 63) { float* msc = (float*)(P.ws + WS_MSC) + ((size_t)bh * 33 + k) * 4; msc[0] = A; msc[1] = bc; }
    }
    __syncthreads();
    f32x4 Ct[2][9];
#pragma unroll
    for (int a = 0; a < 2; ++a)
#pragma unroll
        for (int c = 0; c < 9; ++c) Ct[a][c] = (f32x4){0.f, 0.f, 0.f, 0.f};
    bf16x8 kt[2][2];
#pragma unroll
    for (int a = 0; a < 2; ++a)
#pragma unroll
        for (int s2 = 0; s2 < 2; ++s2) {
            const int jt = 2 * w + a;
            kt[a][s2] = tr_pair(tr_frag(sK + (jt >> 2) * 8192, 32 * s2, jt & 3, g, lr), tr_frag(sK + (jt >> 2) * 8192, 32 * s2 + 16, jt & 3, g, lr));
        }
    f32x4 wg4[4];
#pragma unroll
    for (int j = 0; j < 4; ++j) wg4[j] = *(const f32x4*)(ga + 16 * j + 4 * g);
#define MA_TILE(c, lo0, hi0, lo1, hi1) { \
        { const f32x4 w0 = wg4[0], w1 = wg4[1]; uint4 o; \
          o.x = cvt_pk_bf16(bflo(lo0.x) * w0[0], bfhi(lo0.x) * w0[1]); o.y = cvt_pk_bf16(bflo(lo0.y) * w0[2], bfhi(lo0.y) * w0[3]); \
          o.z = cvt_pk_bf16(bflo(hi0.x) * w1[0], bfhi(hi0.x) * w1[1]); o.w = cvt_pk_bf16(bflo(hi0.y) * w1[2], bfhi(hi0.y) * w1[3]); \
          const bf16x8 vw = __builtin_bit_cast(bf16x8, o); \
          Ct[0][c] = __builtin_amdgcn_mfma_f32_16x16x32_bf16(kt[0][0], vw, Ct[0][c], 0, 0, 0); Ct[1][c] = __builtin_amdgcn_mfma_f32_16x16x32_bf16(kt[1][0], vw, Ct[1][c], 0, 0, 0); } \
        { const f32x4 w0 = wg4[2], w1 = wg4[3]; uint4 o; \
          o.x = cvt_pk_bf16(bflo(lo1.x) * w0[0], bfhi(lo1.x) * w0[1]); o.y = cvt_pk_bf16(bflo(lo1.y) * w0[2], bfhi(lo1.y) * w0[3]); \
          o.z = cvt_pk_bf16(bflo(hi1.x) * w1[0], bfhi(hi1.x) * w1[1]); o.w = cvt_pk_bf16(bflo(hi1.y) * w1[2], bfhi(hi1.y) * w1[3]); \
          const bf16x8 vw = __builtin_bit_cast(bf16x8, o); \
          Ct[0][c] = __builtin_amdgcn_mfma_f32_16x16x32_bf16(kt[0][1], vw, Ct[0][c], 0, 0, 0); Ct[1][c] = __builtin_amdgcn_mfma_f32_16x16x32_bf16(kt[1][1], vw, Ct[1][c], 0, 0, 0); } }
    {
        uint2 vr[4][4];
        tr_read_4c(sV, g, lr, vr);
        MA_TILE(0, vr[0][0], vr[0][1], vr[0][2], vr[0][3]) MA_TILE(1, vr[1][0], vr[1][1], vr[1][2], vr[1][3])
        MA_TILE(2, vr[2][0], vr[2][1], vr[2][2], vr[2][3]) MA_TILE(3, vr[3][0], vr[3][1], vr[3][2], vr[3][3])
        tr_read_4c(sV + 8192, g, lr, vr);
        MA_TILE(4, vr[0][0], vr[0][1], vr[0][2], vr[0][3]) MA_TILE(5, vr[1][0], vr[1][1], vr[1][2], vr[1][3])
        MA_TILE(6, vr[2][0], vr[2][1], vr[2][2], vr[2][3]) MA_TILE(7, vr[3][0], vr[3][1], vr[3][2], vr[3][3])
        const uint2 o0 = tr_frag(sV + 16384, 0, 0, g, lr), o1 = tr_frag(sV + 16384, 16, 0, g, lr), o2 = tr_frag(sV + 16384, 32, 0, g, lr), o3 = tr_frag(sV + 16384, 48, 0, g, lr);
        MA_TILE(8, o0, o1, o2, o3)
    }
#undef MA_TILE
    unsigned char* slot = P.ws + WS_MST + ((size_t)bh * 33 + k) * ST_IMG;
#pragma unroll
    for (int a = 0; a < 2; ++a)
#pragma unroll
        for (int c = 0; c < 9; ++c) {
            uint2 u; u.x = cvt_pk_bf16(Ct[a][c][0], Ct[a][c][1]); u.y = cvt_pk_bf16(Ct[a][c][2], Ct[a][c][3]);
            *(uint2*)(slot + st_piece_off(2 * w + a, c, g, lr)) = u;
        }
}

__device__ __forceinline__ void mlstm_B(const Params& P, int item) {
    const int tid = opaque_tid();
    const int bh = item / 3, part = item - bh * 3;
    const unsigned char* base = P.ws + WS_MST + (size_t)bh * 33 * ST_IMG + part * 12288 + tid * 48;
    unsigned char* obase = P.ws + WS_CBI + (size_t)bh * 33 * ST_IMG + part * 12288 + tid * 48;
    float* msc = (float*)(P.ws + WS_MSC) + (size_t)bh * 33 * 4;
    float C[6][4];
#pragma unroll
    for (int i = 0; i < 6; ++i)
#pragma unroll
        for (int r = 0; r < 4; ++r) C[i][r] = 0.f;
    float m = 0.f;
    uint2 d0[6], d1[6];
    float2 ab0, ab1;
#pragma unroll
    for (int i = 0; i < 6; ++i) { d0[i] = *(const uint2*)(base + i * 8); d1[i] = *(const uint2*)(base + ST_IMG + i * 8); }
    ab0 = *(const float2*)(msc); ab1 = *(const float2*)(msc + 4);
    for (int k = 0; k < 33; ++k) {
        uint2 d2[6]; float2 ab2 = make_float2(0.f, 0.f);
        if (k + 2 < 33) {
#pragma unroll
            for (int i = 0; i < 6; ++i) d2[i] = *(const uint2*)(base + (size_t)(k + 2) * ST_IMG + i * 8);
            ab2 = *(const float2*)(msc + (k + 2) * 4);
        } else {
#pragma unroll
            for (int i = 0; i < 6; ++i) d2[i] = make_uint2(0, 0);
        }
#pragma unroll
        for (int i = 0; i < 6; ++i) {
            uint2 u; u.x = cvt_pk_bf16(C[i][0], C[i][1]); u.y = cvt_pk_bf16(C[i][2], C[i][3]);
            *(uint2*)(obase + (size_t)k * ST_IMG + i * 8) = u;
        }
        if (tid == 0 && part == 0) msc[k * 4 + 2] = m;
        const float M = fmaxf(m, ab0.x);
        const float decay = __expf(m - M), sc = __expf(ab0.x - M);
#pragma unroll
        for (int i = 0; i < 6; ++i) {
            C[i][0] = decay * C[i][0] + sc * bflo(d0[i].x); C[i][1] = decay * C[i][1] + sc * bfhi(d0[i].x);
            C[i][2] = decay * C[i][2] + sc * bflo(d0[i].y); C[i][3] = decay * C[i][3] + sc * bfhi(d0[i].y);
        }
        m = ab0.y + M;
#pragma unroll
        for (int i = 0; i < 6; ++i) { d0[i] = d1[i]; d1[i] = d2[i]; }
        ab0 = ab1; ab1 = ab2;
    }
}

__device__ __forceinline__ void mlstm_C(const Params& P, int item, unsigned char* smem) {
    const int tid = opaque_tid(), lane = tid & 63, w = tid >> 6, g = lane >> 4, lr = lane & 15;
    const int wu = __builtin_amdgcn_readfirstlane(w);
    const int k = item >> 5, bh = item & 31, b = bh >> 2, h = bh & 3;
    const bf16_t* z = (const bf16_t*)(P.ws + WS_Z);
    const bf16_t* qk = (const bf16_t*)(P.ws + WS_RA);
    const float* gates = (const float*)(P.ws + WS_GATES);
    bf16_t* y = (bf16_t*)(P.ws + WS_Z);
    const unsigned char* sK = smem; const unsigned char* sV = smem + 36864; unsigned char* sCb = smem;
    float* ga = (float*)(smem + 61440);
    const int pos = 64 * k + 16 * w + lr;
    const bool tvalid = pos < L;
    const size_t rrow = (size_t)(b * L + (tvalid ? pos : 0));
    const unsigned char* cslot = P.ws + WS_CBI + ((size_t)bh * 33 + k) * ST_IMG + tid * 16;
    const uint4 cb0 = *(const uint4*)(cslot), cb1 = *(const uint4*)(cslot + 4096), cb2 = *(const uint4*)(cslot + 8192), cb3 = *(const uint4*)(cslot + 12288), cb4 = *(const uint4*)(cslot + 16384),
                cb5 = *(const uint4*)(cslot + 20480), cb6 = *(const uint4*)(cslot + 24576), cb7 = *(const uint4*)(cslot + 28672), cb8 = *(const uint4*)(cslot + 32768);
    bf16x8 qf[4];
    {
        const bf16_t* qp = qk + rrow * 1024 + h * 128 + 8 * g;
#pragma unroll
        for (int ks = 0; ks < 4; ++ks) { qf[ks] = *(const bf16x8*)(qp + 32 * ks); if (!tvalid) qf[ks] = (bf16x8){0, 0, 0, 0, 0, 0, 0, 0}; }
    }
    float m_prev = 0.f, lf = 0.f, li = -INFINITY;
    if (wu == 0) {
        m_prev = ((const float*)(P.ws + WS_MSC))[((size_t)bh * 33 + k) * 4 + 2];
        const int p2 = 64 * k + lane;
        if (p2 < L) { lf = gates[(size_t)(b * L + p2) * 16 + 4 + h]; li = gates[(size_t)(b * L + p2) * 16 + h]; }
    }
    mlstm_stage_kv(P, b, h, k, smem, smem + 36864, tid);
    if (wu == 0) {
        float bc = lf;
#pragma unroll
        for (int o = 1; o < 64; o <<= 1) { const float n = __shfl_up(bc, o, 64); if (lane >= o) bc += n; }
        const float a = li - bc;
        float am = a;
#pragma unroll
        for (int o = 1; o < 64; o <<= 1) { const float n = __shfl_up(am, o, 64); if (lane >= o) am = fmaxf(am, n); }
        const float M = fmaxf(m_prev, am);
        ga[lane] = a; ga[64 + lane] = __expf(m_prev - M); ga[128 + lane] = __expf(-(bc + M)); ga[192 + lane] = M;
    }
    __syncthreads();
    const float Mt = ga[192 + 16 * w + lr], Wi = ga[64 + 16 * w + lr], Et = ga[128 + 16 * w + lr];
    bf16x8 pf[2];
    {
        f32x4 sa[4];
#pragma unroll
        for (int c = 0; c < 4; ++c) {
            sa[c] = (f32x4){0.f, 0.f, 0.f, 0.f};
            if (c <= wu) {
#pragma unroll
                for (int ks = 0; ks < 4; ++ks) {
                    const bf16x8 kf = *(const bf16x8*)(sK + (ks >> 1) * 8192 + vimg_off(16 * c + lr, 4 * (ks & 1) + g));
                    sa[c] = __builtin_amdgcn_mfma_f32_16x16x32_bf16(kf, qf[ks], sa[c], 0, 0, 0);
                }
                const f32x4 av = *(const f32x4*)(ga + 16 * c + 4 * g);
#pragma unroll
                for (int r = 0; r < 4; ++r) {
                    const float d = __expf(av[r] - Mt);
                    sa[c][r] = (16 * c + 4 * g + r <= 16 * w + lr) ? sa[c][r] * d : 0.f;
                }
            }
        }
#pragma unroll
        for (int s2 = 0; s2 < 2; ++s2) {
            uint4 u;
            u.x = cvt_pk_bf16(sa[2 * s2][0], sa[2 * s2][1]); u.y = cvt_pk_bf16(sa[2 * s2][2], sa[2 * s2][3]);
            u.z = cvt_pk_bf16(sa[2 * s2 + 1][0], sa[2 * s2 + 1][1]); u.w = cvt_pk_bf16(sa[2 * s2 + 1][2], sa[2 * s2 + 1][3]);
            pf[s2] = __builtin_bit_cast(bf16x8, u);
        }
    }
    __syncthreads();
    {
        unsigned char* d = sCb + tid * 16;
        *(uint4*)(d) = cb0; *(uint4*)(d + 4096) = cb1; *(uint4*)(d + 8192) = cb2; *(uint4*)(d + 12288) = cb3; *(uint4*)(d + 16384) = cb4;
        *(uint4*)(d + 20480) = cb5; *(uint4*)(d + 24576) = cb6; *(uint4*)(d + 28672) = cb7; *(uint4*)(d + 32768) = cb8;
    }
    __syncthreads();
    f32x4 na[9];
#define MC_TILE(c, lo0, hi0, lo1, hi1) { \
        na[c] = (f32x4){0.f, 0.f, 0.f, 0.f}; \
        _Pragma("unroll") for (int ks = 0; ks < 4; ++ks) { \
            const bf16x8 cf = *(const bf16x8*)(sCb + (ks >> 1) * 18432 + vimg_off(16 * (c) + lr, 4 * (ks & 1) + g)); \
            na[c] = __builtin_amdgcn_mfma_f32_16x16x32_bf16(cf, qf[ks], na[c], 0, 0, 0); } \
        na[c] *= Wi; \
        na[c] = __builtin_amdgcn_mfma_f32_16x16x32_bf16(tr_pair(lo0, hi0), pf[0], na[c], 0, 0, 0); \
        na[c] = __builtin_amdgcn_mfma_f32_16x16x32_bf16(tr_pair(lo1, hi1), pf[1], na[c], 0, 0, 0); }
    {
        uint2 vr[4][4];
        tr_read_4c(sV, g, lr, vr);
        MC_TILE(0, vr[0][0], vr[0][1], vr[0][2], vr[0][3]) MC_TILE(1, vr[1][0], vr[1][1], vr[1][2], vr[1][3])
        MC_TILE(2, vr[2][0], vr[2][1], vr[2][2], vr[2][3]) MC_TILE(3, vr[3][0], vr[3][1], vr[3][2], vr[3][3])
        tr_read_4c(sV + 8192, g, lr, vr);
        MC_TILE(4, vr[0][0], vr[0][1], vr[0][2], vr[0][3]) MC_TILE(5, vr[1][0], vr[1][1], vr[1][2], vr[1][3])
        MC_TILE(6, vr[2][0], vr[2][1], vr[2][2], vr[2][3]) MC_TILE(7, vr[3][0], vr[3][1], vr[3][2], vr[3][3])
        const uint2 o0 = tr_frag(sV + 16384, 0, 0, g, lr), o1 = tr_frag(sV + 16384, 16, 0, g, lr), o2 = tr_frag(sV + 16384, 32, 0, g, lr), o3 = tr_frag(sV + 16384, 48, 0, g, lr);
        MC_TILE(8, o0, o1, o2, o3)
    }
#undef MC_TILE
    const float den = __shfl(na[8][0], lr, 64);
    const float rden = 1.0f / fmaxf(fabsf(den), Et);
    float hs = 0.f;
#pragma unroll
    for (int c = 0; c < 8; ++c) { na[c] *= rden; hs += na[c][0] * na[c][0] + na[c][1] * na[c][1] + na[c][2] * na[c][2] + na[c][3] * na[c][3]; }
    hs = x4_sum(hs);
    const float rstd = rsqrtf(hs * (1.0f / 128.0f) + EPS);
    const float* gainp = P.m_out_norm + h * 128 + 4 * g;
#pragma unroll
    for (int c = 0; c < 8; ++c) {
        const uint2 og = *(const uint2*)(z + rrow * NZ + ZC_MO + h * 128 + 16 * c + 4 * g);
        const float o0 = bflo(og.x), o1 = bfhi(og.x), o2 = bflo(og.y), o3 = bfhi(og.y);
        const float4 gn = *(const float4*)(gainp + 16 * c);
        uint2 u;
        u.x = pk2(na[c][0] * rstd * gn.x / (1.f + __expf(-o0)), na[c][1] * rstd * gn.y / (1.f + __expf(-o1)));
        u.y = pk2(na[c][2] * rstd * gn.z / (1.f + __expf(-o2)), na[c][3] * rstd * gn.w / (1.f + __expf(-o3)));
        if (tvalid) *(uint2*)(y + rrow * NZ + h * 128 + 16 * c + 4 * g) = u;
    }
}

__device__ __forceinline__ void peer_token(const Params& P, int t, int tnext, uint4& tkw, int lane, int* sidx, float* sval, int* sid, float* sgate, const unsigned char* slut, const unsigned* szero) {
    {
        const unsigned kk[4] = {tkw.x, tkw.y, tkw.z, tkw.w};
#pragma unroll
        for (int i = 0; i < 4; ++i) {
            const unsigned k = kk[i];
            sidx[lane * 4 + i] = 127 - (int)(k & 127u);
            sval[lane * 4 + i] = unord_key(k & ~127u);
        }
        tkw = *(const uint4*)((const unsigned*)(P.ws + WS_TK) + (size_t)tnext * 256 + lane * 4);
    }
    const bf16_t* xn = (const bf16_t*)(P.ws + WS_XN) + (size_t)t * DM;
    const uint4 xa_pre = *(const uint4*)(xn + lane * 16), xb_pre = *(const uint4*)(xn + lane * 16 + 8);
    const float rstd = ((const float*)(P.ws + WS_RSTD))[t];
    __builtin_amdgcn_s_waitcnt(0xc07f);
    __builtin_amdgcn_wave_barrier();
    {
        const int hd = lane >> 3, sub = lane & 7;
        unsigned x[8];
#pragma unroll
        for (int r = 0; r < 8; ++r) {
            const int c = sub * 8 + r;
            const unsigned ij = slut[c < 50 ? c : 0];
            const int i = ij >> 4, j = ij & 15;
            const unsigned kx = (ord_key(sval[(2 * hd) * 16 + i] + sval[(2 * hd + 1) * 16 + j]) & ~255u) | (unsigned)(255 - (i * 16 + j));
            x[r] = c < 50 ? kx : 0u;
        }
#pragma unroll
        for (int k = 2; k <= 64; k <<= 1) {
#pragma unroll
            for (int j = k >> 1; j >= 1; j >>= 1) {
                if (j >= 8) {
                    const int ld = j >> 3;
                    const bool lower = (sub & ld) == 0;
                    const bool desc = k >= 64 ? true : ((sub * 8) & k) == 0;
                    const bool takemax = (lower == desc);
#pragma unroll
                    for (int r = 0; r < 8; ++r) {
                        const unsigned o = (unsigned)__shfl_xor((int)x[r], ld, 64);
                        const unsigned hi = max(x[r], o), lo = min(x[r], o);
                        x[r] = takemax ? hi : lo;
                    }
                } else {
#pragma unroll
                    for (int r = 0; r < 8; ++r) {
                        if ((r & j) == 0) {
                            const int p = r | j;
                            const unsigned hi = max(x[r], x[p]), lo = min(x[r], x[p]);
                            if (k <= 4) { const bool desc = (r & k) == 0; x[r] = desc ? hi : lo; x[p] = desc ? lo : hi; }
                            else if (k >= 64) { x[r] = hi; x[p] = lo; }
                            else { const bool desc = ((sub * 8) & k) == 0; x[r] = desc ? hi : lo; x[p] = desc ? lo : hi; }
                        }
                    }
                }
            }
        }
        const float smax = unord_key((unsigned)__shfl((int)x[0], hd * 8, 64) & ~255u);
        float e[8]; float den = 0.f;
#pragma unroll
        for (int r = 0; r < 8; ++r) { e[r] = __expf(unord_key(x[r] & ~255u) - smax); den += e[r]; }
        den += __shfl_xor(den, 1, 64);
        const float inv = 1.f / den;
        if (sub < 2) {
#pragma unroll
            for (int r = 0; r < 8; ++r) {
                const int pos = 255 - (int)(x[r] & 255u), i = pos >> 4, j = pos & 15;
                sid[hd * 16 + sub * 8 + r] = sidx[(2 * hd) * 16 + i] * 128 + sidx[(2 * hd + 1) * 16 + j];
                sgate[hd * 16 + sub * 8 + r] = e[r] * inv;
            }
        }
    }
    __builtin_amdgcn_s_waitcnt(0xc07f);
    __builtin_amdgcn_wave_barrier();
    const unsigned char* V = P.ws + WS_V + lane * 8;
    const float* usc = (const float*)(P.ws + WS_USC);
    const float* vsc = (const float*)(P.ws + WS_VSC);
    const int g = lane >> 4, lr = lane & 15;
    unsigned char* shi = (unsigned char*)sval;
    unsigned char* slo = (unsigned char*)sidx;
    {
        const uint4 xa = xa_pre, xb = xb_pre;
        const unsigned xw[8] = {xa.x, xa.y, xa.z, xa.w, xb.x, xb.y, xb.z, xb.w};
        unsigned hi[4], lo[4];
#pragma unroll
        for (int i = 0; i < 4; ++i) {
            const float x0 = bflo(xw[2 * i]), x1 = bfhi(xw[2 * i]), x2 = bflo(xw[2 * i + 1]), x3 = bfhi(xw[2 * i + 1]);
            int wd = 0;
            wd = __builtin_amdgcn_cvt_pk_fp8_f32(x0, x1, wd, false);
            wd = __builtin_amdgcn_cvt_pk_fp8_f32(x2, x3, wd, true);
            const f32x2 h01 = __builtin_amdgcn_cvt_pk_f32_fp8(wd, false), h23 = __builtin_amdgcn_cvt_pk_f32_fp8(wd, true);
            int wl = 0;
            wl = __builtin_amdgcn_cvt_pk_fp8_f32(x0 - h01.x, x1 - h01.y, wl, false);
            wl = __builtin_amdgcn_cvt_pk_fp8_f32(x2 - h23.x, x3 - h23.y, wl, true);
            hi[i] = (unsigned)wd; lo[i] = (unsigned)wl;
        }
        *(uint4*)(shi + lane * 16) = make_uint4(hi[0], hi[1], hi[2], hi[3]);
        *(uint4*)(slo + lane * 16) = make_uint4(lo[0], lo[1], lo[2], lo[3]);
    }
    __builtin_amdgcn_s_waitcnt(0xc07f);
    __builtin_amdgcn_wave_barrier();
    {
        typedef int v8i __attribute__((ext_vector_type(8)));
        const unsigned char* Ub = P.ws + WS_U;
        const unsigned lofs = 64u * (unsigned)(lr >> 3) + 16u * (unsigned)g;
        const unsigned char* bsrc = (lr < 4) ? (((lr & 2) ? slo : shi) + 128 * (lr & 1) + 16 * g) : (const unsigned char*)szero;
        const int bstep = (lr < 4) ? 256 : 0, bhalf = (lr < 4) ? 64 : 16;
        v8i Bv[4];
#pragma unroll
        for (int st = 0; st < 4; ++st) {
            const uint4 b0 = *(const uint4*)(bsrc + bstep * st), b1 = *(const uint4*)(bsrc + bstep * st + bhalf);
            Bv[st] = (v8i){(int)b0.x, (int)b0.y, (int)b0.z, (int)b0.w, (int)b1.x, (int)b1.y, (int)b1.z, (int)b1.w};
        }
        __builtin_amdgcn_s_waitcnt(0xc07f);
        __builtin_amdgcn_wave_barrier();
        float* sact = (float*)sidx + 128 * (lr & 3) + 4 * (g & 1);
        const bool owner = (lr < 4) && ((g >> 1) == (lr & 1));
        uint4 abuf[2][2][4];
        unsigned off2[2];
#pragma unroll
        for (int hh = 0; hh < 2; ++hh) off2[hh] = (unsigned)sid[8 * hh + (lr & 7)] * 512u + lofs;
#pragma unroll
        for (int hh = 0; hh < 2; ++hh)
#pragma unroll
            for (int st = 0; st < 4; ++st) abuf[0][hh][st] = *(const uint4*)(Ub + (off2[hh] + 128 * st));
#pragma unroll
        for (int T = 0; T < 8; ++T) {
            if (T + 1 < 8) {
#pragma unroll
                for (int hh = 0; hh < 2; ++hh) off2[hh] = (unsigned)sid[16 * (T + 1) + 8 * hh + (lr & 7)] * 512u + lofs;
#pragma unroll
                for (int hh = 0; hh < 2; ++hh)
#pragma unroll
                    for (int st = 0; st < 4; ++st) abuf[(T + 1) & 1][hh][st] = *(const uint4*)(Ub + (off2[hh] + 128 * st));
            }
#pragma unroll
            for (int hh = 0; hh < 2; ++hh) {
                f32x4 au = (f32x4){0.f, 0.f, 0.f, 0.f};
#pragma unroll
                for (int st = 0; st < 4; ++st) {
                    const uint4 a4 = abuf[T & 1][hh][st];
                    const v8i Av = {(int)a4.x, (int)a4.y, (int)a4.z, (int)a4.w, 0, 0, 0, 0};
                    au = __builtin_amdgcn_mfma_scale_f32_16x16x128_f8f6f4(Av, Bv[st], au, 4, 0, 0, 0x7f7f7f7f, 0, 0x7f7f7f7f);
                }
                if (owner) *(f32x4*)(sact + 16 * T + 8 * hh) = au;
            }
        }
    }
    __builtin_amdgcn_s_waitcnt(0xc07f);
    __builtin_amdgcn_wave_barrier();
    {
        float* sw = (float*)sidx;
        float wv[2];
#pragma unroll
        for (int hh = 0; hh < 2; ++hh) {
            const int e = lane + 64 * hh, id = sid[e];
            const float a = ((sw[e] + sw[128 + e]) + (sw[256 + e] + sw[384 + e])) * usc[id] * rstd;
            wv[hh] = sgate[e] * vsc[id] * 0.5f * a * (1.f + erff(a * 0.70710678118654752f));
        }
        __builtin_amdgcn_s_waitcnt(0xc07f);
        __builtin_amdgcn_wave_barrier();
        sw[lane] = wv[0]; sw[lane + 64] = wv[1];
    }
    __builtin_amdgcn_s_waitcnt(0xc07f);
    __builtin_amdgcn_wave_barrier();
    const int half = lane >> 5, l5 = lane & 31;
    const int lane_o = 2 * l5 + half;
    f32x2 acc2[16];
#pragma unroll
    for (int j = 0; j < 16; ++j) acc2[j] = (f32x2){0.f, 0.f};
    const unsigned char* Vb = P.ws + WS_V;
    const unsigned vlo = (unsigned)l5 * 16u;
#pragma unroll 1
    for (int e0 = 0; e0 < 128; e0 += 16) {
        uint4 vr[8];
#pragma unroll
        for (int q = 0; q < 8; ++q) vr[q] = *(const uint4*)(Vb + ((unsigned)sid[e0 + 2 * q + half] * 512u + vlo));
        const float* sw = (const float*)sidx + e0;
        const f32x4 w0 = *(const f32x4*)(sw), w1 = *(const f32x4*)(sw + 4), w2 = *(const f32x4*)(sw + 8), w3 = *(const f32x4*)(sw + 12);
        const float wq[16] = {w0[0], w0[1], w0[2], w0[3], w1[0], w1[1], w1[2], w1[3], w2[0], w2[1], w2[2], w2[3], w3[0], w3[1], w3[2], w3[3]};
#pragma unroll
        for (int q = 0; q < 8; ++q) {
            const float w = half ? wq[2 * q + 1] : wq[2 * q];
#define FP4_AXPY(k) { acc2[k] += w * __builtin_amdgcn_cvt_scalef32_pk_f32_fp4(vr[q].x, 1.0f, k); acc2[4 + k] += w * __builtin_amdgcn_cvt_scalef32_pk_f32_fp4(vr[q].y, 1.0f, k); \
                      acc2[8 + k] += w * __builtin_amdgcn_cvt_scalef32_pk_f32_fp4(vr[q].z, 1.0f, k); acc2[12 + k] += w * __builtin_amdgcn_cvt_scalef32_pk_f32_fp4(vr[q].w, 1.0f, k); }
            FP4_AXPY(0) FP4_AXPY(1) FP4_AXPY(2) FP4_AXPY(3)
#undef FP4_AXPY
        }
    }
    f32x2 acc[8];
#pragma unroll
    for (int j = 0; j < 16; ++j) {
        const unsigned x0 = __float_as_uint(acc2[j].x), x1 = __float_as_uint(acc2[j].y);
        const auto r0 = __builtin_amdgcn_permlane32_swap(x0, x0, false, false);
        const auto r1 = __builtin_amdgcn_permlane32_swap(x1, x1, false, false);
        acc2[j].x = __uint_as_float(r0[0]) + __uint_as_float(r0[1]);
        acc2[j].y = __uint_as_float(r1[0]) + __uint_as_float(r1[1]);
    }
#pragma unroll
    for (int j = 0; j < 8; ++j) { acc[j].x = half ? acc2[8 + j].x : acc2[j].x; acc[j].y = half ? acc2[8 + j].y : acc2[j].y; }
    f32x2 xf[8];
    {
        const uint4 xa = *(const uint4*)(xn + lane_o * 16), xb = *(const uint4*)(xn + lane_o * 16 + 8);
        xf[0] = (f32x2){bflo(xa.x), bfhi(xa.x)}; xf[1] = (f32x2){bflo(xa.y), bfhi(xa.y)}; xf[2] = (f32x2){bflo(xa.z), bfhi(xa.z)}; xf[3] = (f32x2){bflo(xa.w), bfhi(xa.w)};
        xf[4] = (f32x2){bflo(xb.x), bfhi(xb.x)}; xf[5] = (f32x2){bflo(xb.y), bfhi(xb.y)}; xf[6] = (f32x2){bflo(xb.z), bfhi(xb.z)}; xf[7] = (f32x2){bflo(xb.w), bfhi(xb.w)};
    }
    float* o = P.out + (size_t)t * DM + lane_o * 16;
    float4 h0, h1, h2, h3;
    {
        const float4 g0 = *(const float4*)(P.norm_ffn + lane_o * 16), g1 = *(const float4*)(P.norm_ffn + lane_o * 16 + 4), g2 = *(const float4*)(P.norm_ffn + lane_o * 16 + 8), g3 = *(const float4*)(P.norm_ffn + lane_o * 16 + 12);
        h0.x = xf[0].x * __builtin_amdgcn_rcpf(g0.x) + acc[0].x; h0.y = xf[0].y * __builtin_amdgcn_rcpf(g0.y) + acc[0].y; h0.z = xf[1].x * __builtin_amdgcn_rcpf(g0.z) + acc[1].x; h0.w = xf[1].y * __builtin_amdgcn_rcpf(g0.w) + acc[1].y;
        h1.x = xf[2].x * __builtin_amdgcn_rcpf(g1.x) + acc[2].x; h1.y = xf[2].y * __builtin_amdgcn_rcpf(g1.y) + acc[2].y; h1.z = xf[3].x * __builtin_amdgcn_rcpf(g1.z) + acc[3].x; h1.w = xf[3].y * __builtin_amdgcn_rcpf(g1.w) + acc[3].y;
        h2.x = xf[4].x * __builtin_amdgcn_rcpf(g2.x) + acc[4].x; h2.y = xf[4].y * __builtin_amdgcn_rcpf(g2.y) + acc[4].y; h2.z = xf[5].x * __builtin_amdgcn_rcpf(g2.z) + acc[5].x; h2.w = xf[5].y * __builtin_amdgcn_rcpf(g2.w) + acc[5].y;
        h3.x = xf[6].x * __builtin_amdgcn_rcpf(g3.x) + acc[6].x; h3.y = xf[6].y * __builtin_amdgcn_rcpf(g3.y) + acc[6].y; h3.z = xf[7].x * __builtin_amdgcn_rcpf(g3.z) + acc[7].x; h3.w = xf[7].y * __builtin_amdgcn_rcpf(g3.w) + acc[7].y;
    }
    *(float4*)(o) = h0; *(float4*)(o + 4) = h1; *(float4*)(o + 8) = h2; *(float4*)(o + 12) = h3;
    __builtin_amdgcn_s_waitcnt(0xc07f);
    __builtin_amdgcn_wave_barrier();
}

#define LAS __attribute__((address_space(3)))
#define XB_TMO      128
#define XB_XCNT(j)  (256  + 64 * (j))
#define XB_XSUB(j)  (1280 + 64 * (j))
#define XB_XGEN(j)  (2304 + 64 * (j))
#define XB_TOP      3328
#define XB_TOPGEN   3392
#define XCD_BAR_WORDS 3456
#define XB_SPIN_CAP (1u << 18)
__device__ __forceinline__ unsigned xb_ld(unsigned* p)              { return __hip_atomic_load(p, __ATOMIC_RELAXED, __HIP_MEMORY_SCOPE_AGENT); }
__device__ __forceinline__ unsigned xb_add(unsigned* p, unsigned v) { return __hip_atomic_fetch_add(p, v, __ATOMIC_RELAXED, __HIP_MEMORY_SCOPE_AGENT); }
__device__ __forceinline__ unsigned xb_xcc_id() { return (unsigned)__builtin_amdgcn_s_getreg((3 << 11) | 20) & 0xFu; }
#define XB_SPIN(cond, bar) do { unsigned _sp = 0; while (cond) { __builtin_amdgcn_s_sleep(1); \
    if ((++_sp & 255u) == 0u) { if (xb_ld(&(bar)[XB_TMO])) break; if (_sp > XB_SPIN_CAP) { atomicAdd(&(bar)[XB_TMO], 1u); break; } } } } while (0)
struct XcdBarrier { unsigned* bar; unsigned x; volatile LAS unsigned* st; };
__device__ __forceinline__ XcdBarrier xcd_barrier_post(unsigned* bar, volatile LAS unsigned* st) {
    XcdBarrier b; b.bar = bar; b.x = xb_xcc_id(); b.st = st;
    if (threadIdx.x == 0) (void)xb_add(&bar[XB_XCNT(b.x)], 1u);
    return b;
}
__device__ __forceinline__ void xcd_barrier_complete(unsigned* bar, unsigned x, unsigned& nloc, unsigned& nx) {
    const unsigned G = gridDim.x * gridDim.y * gridDim.z;
    unsigned sum, cnt, mine, sp = 0u;
    for (;;) {
        sum = 0u; cnt = 0u; mine = 0u;
#pragma unroll
        for (unsigned j = 0; j < 16; ++j) { const unsigned c = xb_ld(&bar[XB_XCNT(j)]); sum += c; cnt += (c > 0u) ? 1u : 0u; mine = (j == x) ? c : mine; }
        if (sum == G) break;
        __builtin_amdgcn_s_sleep(1);
        if ((++sp & 255u) == 0u) { if (xb_ld(&bar[XB_TMO])) break; if (sp > XB_SPIN_CAP) { atomicAdd(&bar[XB_TMO], 1u); break; } }
    }
    nloc = mine > 0u ? mine : 1u; nx = cnt > 0u ? cnt : 1u;
}
__device__ __forceinline__ void xcd_barrier(const XcdBarrier& b) {
    asm volatile("s_waitcnt vmcnt(0)" ::: "memory");
    __syncthreads();
    if (threadIdx.x == 0) {
        unsigned* bar = b.bar;
        __builtin_amdgcn_s_waitcnt(0);
        unsigned nloc = b.st[0], nx = b.st[1];
        if (nloc == 0u) { xcd_barrier_complete(bar, b.x, nloc, nx); b.st[0] = nloc; b.st[1] = nx; }
        const unsigned old = xb_add(&bar[XB_XSUB(b.x)], 1u);
        const unsigned gen = old / nloc;
        if (old + 1u == (gen + 1u) * nloc) {
            __builtin_amdgcn_fence(__ATOMIC_RELEASE, "agent");
            asm volatile("s_waitcnt vmcnt(0)" ::: "memory");
            const unsigned og = xb_add(&bar[XB_TOP], 1u);
            const unsigned tg = og / nx;
            if (og + 1u == (tg + 1u) * nx) xb_add(&bar[XB_TOPGEN], 1u);
            else XB_SPIN(xb_ld(&bar[XB_TOPGEN]) == tg, bar);
            __builtin_amdgcn_fence(__ATOMIC_ACQUIRE, "agent");
            xb_add(&bar[XB_XGEN(b.x)], 1u);
            asm volatile("s_waitcnt vmcnt(0)" ::: "memory");
        } else {
            XB_SPIN(xb_ld(&bar[XB_XGEN(b.x)]) == gen, bar);
            __builtin_amdgcn_fence(__ATOMIC_ACQUIRE, "agent");
            asm volatile("s_waitcnt vmcnt(0)" ::: "memory");
        }
    }
    __syncthreads();
}

__device__ __forceinline__ void hand_release() { asm volatile("s_waitcnt vmcnt(0)" ::: "memory"); __builtin_amdgcn_fence(__ATOMIC_RELEASE, "agent"); asm volatile("s_waitcnt vmcnt(0)" ::: "memory"); }
__device__ __forceinline__ void hand_acquire() { __builtin_amdgcn_fence(__ATOMIC_ACQUIRE, "agent"); asm volatile("s_waitcnt vmcnt(0)" ::: "memory"); }

__global__ void __launch_bounds__(256, 2) mega(Params P) {
    extern __shared__ __attribute__((aligned(16))) unsigned char smem[];
    const int tid = threadIdx.x, lane = tid & 63, wave = tid >> 6;
    const int G = gridDim.x, bid = blockIdx.x;
    unsigned* ctl = (unsigned*)(P.ws + WS_CTL);
    volatile LAS unsigned* bst = (volatile LAS unsigned*)(smem + 65552);
    if (tid == 0) { bst[0] = 0u; bst[1] = 0u; }
    __syncthreads();
    const XcdBarrier xb = xcd_barrier_post(ctl + 1024, bst);
    unsigned* cucnt = ctl + 5120;
    if (tid == 0) {
        const unsigned phys = ((xb_xcc_id() & 7u) << 8) | ((unsigned)__builtin_amdgcn_s_getreg((7 << 11) | (8 << 6) | 4) & 0xFFu);
        bst[2] = phys; bst[3] = xb_add(&cucnt[phys], 1u);
    }
    phase0(P, smem);
    xcd_barrier(xb);
    {
        int vb;
        const unsigned phys = bst[2];
        unsigned part = 0;
#pragma unroll
        for (int q = 0; q < 8; ++q) { const unsigned i = (unsigned)(tid + 256 * q); const unsigned c = xb_ld(&cucnt[i]); part += (i < phys) ? c : 0u; }
#pragma unroll
        for (int o = 1; o < 64; o <<= 1) part += (unsigned)__shfl_xor((int)part, o, 64);
        if (lane == 0) bst[4 + wave] = part;
        __syncthreads();
        vb = (int)(bst[4] + bst[5] + bst[6] + bst[7] + bst[3]);
        vb = __builtin_amdgcn_readfirstlane(vb);
        if (vb < 0 || vb >= G) vb = bid;
        __syncthreads();
        if (tid == 0) bst[8] = (unsigned)vb;
        __syncthreads();
    }
#define VB_LOAD() __builtin_amdgcn_readfirstlane((int)bst[8])
    {
        const int gw = bid * 4 + wave;
        if (gw < 64) fox_cum_wave(P, gw, lane);
        const int vb = VB_LOAD();
        for (int tile = vb; tile < 129 * 28; tile += G) gemm_tile<1>(P, tile / 28, tile % 28, smem);
        {
            const int rem = (129 * 28) % G;
            if (rem > 0 && rem < G) { if (vb >= rem) convert_uv_rows(P, (vb - rem) * 4 + wave, (G - rem) * 4, lane); }
            else convert_uv_rows(P, vb * 4 + wave, G * 4, lane);
        }
    }
    xcd_barrier(xb);
    {
        volatile int* s_item = (volatile int*)(smem + 65536);
        const int wave_u = __builtin_amdgcn_readfirstlane(wave);
        auto fetch = [&](unsigned* counter) -> int {
            if (wave_u == 0) {
                unsigned v = atomicAdd(counter, lane == 0 ? 1u : 0u);
                *s_item = (int)__builtin_amdgcn_readfirstlane(v);
            }
            __syncthreads();
            const int item = __builtin_amdgcn_readfirstlane(*s_item);
            __syncthreads();
            return item;
        };
        for (;;) {
            const int item = fetch(&ctl[2]);
            if (item >= 33 * 32) break;
            mlstm_A(P, item, smem);
        }
        xcd_barrier(xb);
        for (;;) {
            const int item = fetch(&ctl[4]);
            if (item >= 96) break;
            mlstm_B(P, item);
        }
        for (;;) {
            const int item = fetch(&ctl[3]);
            if (item >= 64 * 17) break;
            attn_block(P, item & 63, 16 - (item >> 6), smem);
        }
        xcd_barrier(xb);
        for (;;) {
            const int item = fetch(&ctl[5]);
            if (item >= 33 * 32) break;
            mlstm_C(P, item, smem);
        }
    }
    xcd_barrier(xb);
    for (int tile = VB_LOAD(); tile < 128 * 8; tile += G) gemm_tile<2>(P, tile >> 3, tile & 7, smem);
    xcd_barrier(xb);
    for (int tile = VB_LOAD(); tile < 128 * 16; tile += G) gemm_tile<3>(P, tile >> 4, tile & 15, smem);
    xcd_barrier(xb);
    {
        unsigned char* slut = smem + 12288;
        if (tid < 64) {
            int c = tid, i = 0;
            while (i < 16 && c >= 16 / (i + 1)) { c -= 16 / (i + 1); ++i; }
            slut[tid] = (unsigned char)(i < 16 ? ((i << 4) | c) : 0);
        }
        unsigned* szero = (unsigned*)(smem + 12288 + 64);
        if (tid < 16) szero[tid] = 0u;
        __syncthreads();
        int* sidx = (int*)(smem + wave * 3072); float* sval = (float*)(smem + wave * 3072 + 1024);
        int* sid = (int*)(smem + wave * 3072 + 2048); float* sgate = (float*)(smem + wave * 3072 + 2560);
        int lane5 = lane;
        asm volatile("" : "+v"(lane5));
        {
            int t = bid * 4 + wave;
            uint4 tkw = *(const uint4*)((const unsigned*)(P.ws + WS_TK) + (size_t)(t < T2 ? t : 0) * 256 + lane5 * 4);
            for (; t < T2; t += G * 4) { const int tn = t + G * 4; peer_token(P, t, tn < T2 ? tn : t, tkw, lane5, sidx, sval, sid, sgate, slut, szero); }
        }
    }
}

}

extern "C" void kernel_launch(void* const* d_in, const int* in_sizes, int n_in, void* d_out, int out_size, void* d_ws, size_t ws_size, hipStream_t stream) {
    if (n_in != 17 || ws_size < WS_END) { fprintf(stderr, "kernel_launch: unexpected n_in %d or ws_size %zu (need %zu)\n", n_in, ws_size, (size_t)WS_END); return; }
    constexpr int LDS_BYTES = 66560;
    static int grid_blocks = 0;
    if (!grid_blocks) {
        int dev = 0, cus = 0, per_cu = 0;
        (void)hipGetDevice(&dev);
        (void)hipDeviceGetAttribute(&cus, hipDeviceAttributeMultiprocessorCount, dev);
        (void)hipFuncSetAttribute((const void*)mega, hipFuncAttributeMaxDynamicSharedMemorySize, LDS_BYTES);
        (void)hipOccupancyMaxActiveBlocksPerMultiprocessor(&per_cu, (const void*)mega, 256, LDS_BYTES);
        if (per_cu < 1) per_cu = 1;
        if (per_cu > 2) per_cu = 2;
        grid_blocks = cus * per_cu;
        fprintf(stderr, "kernel_launch: cus %d per_cu %d grid %d\n", cus, per_cu, grid_blocks);
    }
    Params P{};
    P.x = (const float*)d_in[0]; P.meta = (const float*)d_in[1]; P.norm_mix = (const float*)d_in[2]; P.w_in = (const float*)d_in[3];
    P.conv_qk = (const float*)d_in[4]; P.b_igate = (const float*)d_in[5]; P.b_fgate_m = (const float*)d_in[6]; P.m_out_norm = (const float*)d_in[7];
    P.b_fgate_f = (const float*)d_in[8]; P.f_q_norm = (const float*)d_in[9]; P.f_k_norm = (const float*)d_in[10]; P.w_out = (const float*)d_in[11];
    P.norm_ffn = (const float*)d_in[12]; P.peer_query = (const float*)d_in[13]; P.peer_keys = (const float*)d_in[14]; P.peer_u = (const float*)d_in[15];
    P.peer_v = (const float*)d_in[16]; P.out = (float*)d_out; P.ws = (unsigned char*)d_ws;
    (void)hipMemsetAsync((unsigned char*)d_ws + WS_CTL, 0, 32768, stream);
    void* args[] = {&P};
    hipError_t e = hipLaunchCooperativeKernel((const void*)mega, dim3(grid_blocks), dim3(256), args, LDS_BYTES, stream);
    if (e != hipSuccess) fprintf(stderr, "cooperative launch failed: %s (grid %d)\n", hipGetErrorString(e), grid_blocks);
}
```

```cpp
#include <hip/hip_runtime.h>
#include <stdint.h>
#include <stdio.h>
#include <hip/hip_cooperative_groups.h>
namespace cg = cooperative_groups;

namespace {

constexpr int NB = 8, SEQ = 2048, DM = 1024, NMETA = 16, L = SEQ + NMETA;
constexpr int T1 = NB * L;
constexpr int T2 = NB * SEQ;
constexpr int NZ = 3584;
constexpr int ZC_MQ = 0, ZC_MK = 512, ZC_MV = 1024, ZC_MO = 1536, ZC_FQ = 2048, ZC_FK = 2560, ZC_FV = 3072;
constexpr int PROJ = 3600;
constexpr float EPS = 1e-6f;

constexpr size_t WS_CTL = 0;
constexpr size_t WS_RA = 65536;
constexpr size_t WS_Z = WS_RA + (size_t)T1 * DM * 2;
constexpr size_t WS_GATES = WS_Z + (size_t)T1 * NZ * 2;
constexpr size_t WS_CUM = WS_GATES + (size_t)T1 * 16 * 4;
constexpr size_t WS_SSQ = WS_CUM + (size_t)NB * 8 * L * 4;
constexpr size_t WS_RSTD = WS_SSQ + (size_t)T2 * 16 * 4;
constexpr size_t WS_SSQM = WS_RSTD + (size_t)T2 * 4;
constexpr size_t WS_BT2 = WS_SSQM + (size_t)T1 * 16 * 4;
constexpr size_t WS_BT3 = WS_BT2 + (size_t)DM * DM * 2;
constexpr size_t WS_KEYS = WS_BT3 + (size_t)2048 * DM * 2;
constexpr size_t WS_MSC = WS_KEYS + (size_t)16 * 128 * 128 * 2;
constexpr size_t WS_MST = WS_MSC + (size_t)128 * 33 * 16;
constexpr size_t WS_BT1 = WS_MST + (size_t)32 * 33 * 36864;
constexpr size_t WS_CBI = WS_BT1;
constexpr size_t WS_UV = WS_CBI + (size_t)32 * 33 * 36864;
constexpr size_t WS_END = WS_UV + (size_t)2 * 16384 * 512 + (size_t)2 * 16384 * 4;
constexpr size_t WS_XN = WS_RA;
constexpr size_t WS_U = WS_UV;
constexpr size_t WS_V = WS_U + (size_t)16384 * 512;
constexpr size_t WS_USC = WS_V + (size_t)16384 * 512;
constexpr size_t WS_VSC = WS_USC + (size_t)16384 * 4;
constexpr size_t WS_TK = WS_CBI;
constexpr float LOG2E = 1.4426950408889634f;

typedef unsigned short bf16_t;
typedef short bf16x8 __attribute__((ext_vector_type(8)));
typedef float f32x4 __attribute__((ext_vector_type(4)));
typedef __attribute__((ext_vector_type(2))) __bf16 bf16x2_t;

struct Params {
    const float* x; const float* meta; const float* norm_mix; const float* w_in; const float* conv_qk;
    const float* b_igate; const float* b_fgate_m; const float* m_out_norm; const float* b_fgate_f;
    const float* f_q_norm; const float* f_k_norm; const float* w_out; const float* norm_ffn;
    const float* peer_query; const float* peer_keys; const float* peer_u; const float* peer_v;
    float* out; unsigned char* ws;
};

__device__ __forceinline__ unsigned f2bf(float f) { unsigned u = __float_as_uint(f); return (u + 0x7fffu + ((u >> 16) & 1u)) >> 16; }
__device__ __forceinline__ float bf2f(unsigned h) { return __uint_as_float(h << 16); }
typedef float f32x2 __attribute__((ext_vector_type(2)));
typedef __bf16 bf16x2v __attribute__((ext_vector_type(2)));
__device__ __forceinline__ unsigned cvt_pk_bf16(float lo, float hi) { f32x2 v = {lo, hi}; bf16x2v b = __builtin_convertvector(v, bf16x2v); return __builtin_bit_cast(unsigned, b); }
__device__ __forceinline__ unsigned pk2(float lo, float hi) { return cvt_pk_bf16(lo, hi); }
__device__ __forceinline__ float bflo(unsigned w) { return __uint_as_float(w << 16); }
__device__ __forceinline__ float bfhi(unsigned w) { return __uint_as_float(w & 0xffff0000u); }
__device__ __forceinline__ float wave_sum(float v) {
#pragma unroll
    for (int o = 32; o > 0; o >>= 1) v += __shfl_xor(v, o, 64);
    return v;
}
__device__ __forceinline__ float wave_max(float v) {
#pragma unroll
    for (int o = 32; o > 0; o >>= 1) v = fmaxf(v, __shfl_xor(v, o, 64));
    return v;
}
__device__ __forceinline__ float logsigmoidf(float x) { return fminf(x, 0.f) - log1pf(expf(-fabsf(x))); }
__device__ __forceinline__ unsigned ord_key(float f) { unsigned u = __float_as_uint(f); return u ^ ((u >> 31) ? 0xffffffffu : 0x80000000u); }
__device__ __forceinline__ float unord_key(unsigned k) { unsigned u = (k & 0x80000000u) ? (k ^ 0x80000000u) : ~k; return __uint_as_float(u); }

__device__ __forceinline__ void phase0(const Params& P, unsigned char* smem) {
    const int tid = threadIdx.x, lane = tid & 63, wave = tid >> 6;
    unsigned* ctl = (unsigned*)(P.ws + WS_CTL);
    float* gw = (float*)smem;
    for (int idx = tid; idx < 16 * 1024; idx += 256) {
        const int k = idx >> 4, c = idx & 15;
        const int col = c < 8 ? 2048 + c : 3592 + (c - 8);
        gw[c * 1024 + k] = P.w_in[(size_t)k * PROJ + col];
    }
    __syncthreads();
    {
        bf16_t* hn = (bf16_t*)(P.ws + WS_RA);
        float* gates = (float*)(P.ws + WS_GATES);
        const int c0 = lane * 8, c1 = 512 + lane * 8;
        float gm[16];
        {
            const float4 a0 = *(const float4*)(P.norm_mix + c0), a1 = *(const float4*)(P.norm_mix + c0 + 4);
            const float4 a2 = *(const float4*)(P.norm_mix + c1), a3 = *(const float4*)(P.norm_mix + c1 + 4);
            gm[0] = a0.x; gm[1] = a0.y; gm[2] = a0.z; gm[3] = a0.w; gm[4] = a1.x; gm[5] = a1.y; gm[6] = a1.z; gm[7] = a1.w;
            gm[8] = a2.x; gm[9] = a2.y; gm[10] = a2.z; gm[11] = a2.w; gm[12] = a3.x; gm[13] = a3.y; gm[14] = a3.z; gm[15] = a3.w;
        }
        const int myq = ((lane >> 5) & 1) * 8 + ((lane >> 4) & 1) * 4 + ((lane >> 3) & 1) * 2 + ((lane >> 2) & 1);
        const float mybias = myq < 4 ? P.b_igate[myq] : (myq < 8 ? P.b_fgate_m[myq - 4] : P.b_fgate_f[myq - 8]);
        const int rstep = gridDim.x * 4;
        int r = blockIdx.x * 4 + wave;
        float4 n0, n1, n2, n3;
        auto load_row = [&](int rr) {
            const int b = rr / L, p = rr - b * L;
            const float* src = (p < NMETA) ? (P.meta + (size_t)p * DM) : (P.x + ((size_t)b * SEQ + (p - NMETA)) * DM);
            n0 = *(const float4*)(src + c0); n1 = *(const float4*)(src + c0 + 4); n2 = *(const float4*)(src + c1); n3 = *(const float4*)(src + c1 + 4);
        };
        if (r < T1) load_row(r);
        for (; r < T1; r += rstep) {
            float v[16];
            v[0] = n0.x; v[1] = n0.y; v[2] = n0.z; v[3] = n0.w; v[4] = n1.x; v[5] = n1.y; v[6] = n1.z; v[7] = n1.w;
            v[8] = n2.x; v[9] = n2.y; v[10] = n2.z; v[11] = n2.w; v[12] = n3.x; v[13] = n3.y; v[14] = n3.z; v[15] = n3.w;
            if (r + rstep < T1) load_row(r + rstep);
            float ss = 0.f;
#pragma unroll
            for (int j = 0; j < 16; ++j) ss += v[j] * v[j];
            ss = wave_sum(ss);
            const float rstd = rsqrtf(ss * (1.0f / DM) + EPS);
#pragma unroll
            for (int j = 0; j < 16; ++j) v[j] *= rstd * gm[j];
            uint4 o0, o1;
            o0.x = pk2(v[0], v[1]); o0.y = pk2(v[2], v[3]); o0.z = pk2(v[4], v[5]); o0.w = pk2(v[6], v[7]);
            o1.x = pk2(v[8], v[9]); o1.y = pk2(v[10], v[11]); o1.z = pk2(v[12], v[13]); o1.w = pk2(v[14], v[15]);
            *(uint4*)(hn + (size_t)r * DM + c0) = o0;
            *(uint4*)(hn + (size_t)r * DM + c1) = o1;
            float r8[8], r4[4], r2[2], r1;
#pragma unroll
            for (int i = 0; i < 8; ++i) {
                float dd[2];
#pragma unroll
                for (int hh = 0; hh < 2; ++hh) {
                    const float* gwc = gw + (i + 8 * hh) * 1024;
                    const float4 w0 = *(const float4*)(gwc + c0), w1 = *(const float4*)(gwc + c0 + 4), w2 = *(const float4*)(gwc + c1), w3 = *(const float4*)(gwc + c1 + 4);
                    dd[hh] = v[0] * w0.x + v[1] * w0.y + v[2] * w0.z + v[3] * w0.w + v[4] * w1.x + v[5] * w1.y + v[6] * w1.z + v[7] * w1.w
                           + v[8] * w2.x + v[9] * w2.y + v[10] * w2.z + v[11] * w2.w + v[12] * w3.x + v[13] * w3.y + v[14] * w3.z + v[15] * w3.w;
                }
                const bool up = (lane & 32) != 0; const float keep = up ? dd[1] : dd[0], send = up ? dd[0] : dd[1];
                r8[i] = keep + __shfl_xor(send, 32, 64);
                __builtin_amdgcn_sched_barrier(0);
            }
#pragma unroll
            for (int i = 0; i < 4; ++i) { const bool up = (lane & 16) != 0; const float keep = up ? r8[i + 4] : r8[i], send = up ? r8[i] : r8[i + 4]; r4[i] = keep + __shfl_xor(send, 16, 64); }
#pragma unroll
            for (int i = 0; i < 2; ++i) { const bool up = (lane & 8) != 0; const float keep = up ? r4[i + 2] : r4[i], send = up ? r4[i] : r4[i + 2]; r2[i] = keep + __shfl_xor(send, 8, 64); }
            { const bool up = (lane & 4) != 0; const float keep = up ? r2[1] : r2[0], send = up ? r2[0] : r2[1]; r1 = keep + __shfl_xor(send, 4, 64); }
            r1 += __shfl_xor(r1, 2, 64); r1 += __shfl_xor(r1, 1, 64);
            if ((lane & 3) == 0) {
                const float pre = r1 + mybias;
                gates[(size_t)r * 16 + myq] = myq < 4 ? pre : logsigmoidf(pre);
            }
        }
    }
    __syncthreads();
    {
        float* tile = (float*)smem;
        for (int item = blockIdx.x; item < 1664; item += gridDim.x) {
            const float* W; int ldn, ntn, shift_from, it; bf16_t* out;
            if (item < 896) { W = P.w_in; ldn = PROJ; ntn = 56; shift_from = 2048; it = item; out = (bf16_t*)(P.ws + WS_BT1); }
            else if (item < 1152) { W = P.w_out; ldn = 1024; ntn = 16; shift_from = 1 << 30; it = item - 896; out = (bf16_t*)(P.ws + WS_BT2); }
            else { W = P.peer_query; ldn = 2048; ntn = 32; shift_from = 1 << 30; it = item - 1152; out = (bf16_t*)(P.ws + WS_BT3); }
            const int tk = it / ntn, tn = it - tk * ntn, k0 = tk * 64, n0 = tn * 64;
            {
                const int n4 = (tid & 15) * 4, kr = tid >> 4;
                int n = n0 + n4; if (n >= shift_from) n += 8;
                float4 v[4];
#pragma unroll
                for (int i = 0; i < 4; ++i) v[i] = *(const float4*)(W + (size_t)(k0 + kr + 16 * i) * ldn + n);
#pragma unroll
                for (int i = 0; i < 4; ++i) *(float4*)(tile + (kr + 16 * i) * 68 + n4) = v[i];
            }
            __syncthreads();
            {
#pragma unroll
                for (int i = 0; i < 2; ++i) {
                    const int id = tid + 256 * i, nl = id & 63, kc = id >> 6;
                    const float* tp = tile + (kc * 8) * 68 + nl;
                    uint4 o;
                    o.x = pk2(tp[0], tp[68]); o.y = pk2(tp[2 * 68], tp[3 * 68]); o.z = pk2(tp[4 * 68], tp[5 * 68]); o.w = pk2(tp[6 * 68], tp[7 * 68]);
                    *(uint4*)(out + (size_t)(n0 + nl) * 1024 + k0 + kc * 8) = o;
                }
            }
            __syncthreads();
        }
    }
    {
        const size_t gt = (size_t)blockIdx.x * 256 + tid, gs = (size_t)gridDim.x * 256;
        const float* src = P.peer_keys; bf16_t* dst = (bf16_t*)(P.ws + WS_KEYS);
        for (size_t i = gt; i < (size_t)(16 * 128 * 128 / 8); i += gs) {
            const float4 a = *(const float4*)(src + i * 8), b = *(const float4*)(src + i * 8 + 4);
            uint4 o; o.x = pk2(a.x, a.y); o.y = pk2(a.z, a.w); o.z = pk2(b.x, b.y); o.w = pk2(b.z, b.w);
            *(uint4*)(dst + i * 8) = o;
        }
    }
}

__device__ __forceinline__ void convert_uv_rows(const Params& P, int gwave, int nwaves, int lane) {
    for (int rr0 = gwave * 4; rr0 < 2 * 16384; rr0 += nwaves * 4) {
        float4 a[4][4];
#pragma unroll
        for (int q = 0; q < 4; ++q) {
            const int rr = rr0 + q, which = rr >> 14, row = rr & 16383;
            const float* src = (which ? P.peer_v : P.peer_u) + (size_t)row * DM + lane * 16;
            a[q][0] = *(const float4*)(src); a[q][1] = *(const float4*)(src + 4); a[q][2] = *(const float4*)(src + 8); a[q][3] = *(const float4*)(src + 12);
        }
#pragma unroll
        for (int q = 0; q < 4; ++q) {
            const int rr = rr0 + q, which = rr >> 14, row = rr & 16383;
            float mx = 0.f;
#pragma unroll
            for (int j = 0; j < 4; ++j) mx = fmaxf(mx, fmaxf(fmaxf(fabsf(a[q][j].x), fabsf(a[q][j].y)), fmaxf(fabsf(a[q][j].z), fabsf(a[q][j].w))));
            mx = wave_max(mx);
            const float sc = mx > 0.f ? 6.0f / mx : 1.0f;
            unsigned w0 = 0u, w1 = 0u;
            w0 = __builtin_amdgcn_cvt_scalef32_pk_fp4_f32(w0, a[q][0].x * sc, a[q][0].y * sc, 1.0f, 0); w0 = __builtin_amdgcn_cvt_scalef32_pk_fp4_f32(w0, a[q][0].z * sc, a[q][0].w * sc, 1.0f, 1);
            w0 = __builtin_amdgcn_cvt_scalef32_pk_fp4_f32(w0, a[q][1].x * sc, a[q][1].y * sc, 1.0f, 2); w0 = __builtin_amdgcn_cvt_scalef32_pk_fp4_f32(w0, a[q][1].z * sc, a[q][1].w * sc, 1.0f, 3);
            w1 = __builtin_amdgcn_cvt_scalef32_pk_fp4_f32(w1, a[q][2].x * sc, a[q][2].y * sc, 1.0f, 0); w1 = __builtin_amdgcn_cvt_scalef32_pk_fp4_f32(w1, a[q][2].z * sc, a[q][2].w * sc, 1.0f, 1);
            w1 = __builtin_amdgcn_cvt_scalef32_pk_fp4_f32(w1, a[q][3].x * sc, a[q][3].y * sc, 1.0f, 2); w1 = __builtin_amdgcn_cvt_scalef32_pk_fp4_f32(w1, a[q][3].z * sc, a[q][3].w * sc, 1.0f, 3);
            *(uint2*)(P.ws + (which ? WS_V : WS_U) + (size_t)row * 512 + lane * 8) = make_uint2(w0, w1);
            if (lane == 0) ((float*)(P.ws + (which ? WS_VSC : WS_USC)))[row] = mx > 0.f ? mx * (1.0f / 6.0f) : 1.0f;
        }
    }
}

__device__ __forceinline__ void bitonic_sort16_desc(unsigned (&v)[16]) {
#pragma unroll
    for (int k = 2; k <= 16; k <<= 1)
#pragma unroll
        for (int j = k >> 1; j >= 1; j >>= 1)
#pragma unroll
            for (int i = 0; i < 16; ++i)
                if ((i & j) == 0) {
                    const int p = i | j;
                    const bool desc = (k >= 16) ? true : ((i & k) == 0);
                    const unsigned hi = max(v[i], v[p]), lo = min(v[i], v[p]);
                    v[i] = desc ? hi : lo; v[p] = desc ? lo : hi;
                }
}
__device__ __forceinline__ void bitonic_merge16_top(unsigned (&a)[16], const unsigned (&b)[16]) {
#pragma unroll
    for (int i = 0; i < 16; ++i) a[i] = max(a[i], b[15 - i]);
#pragma unroll
    for (int j = 8; j >= 1; j >>= 1)
#pragma unroll
        for (int i = 0; i < 16; ++i)
            if ((i & j) == 0) { const int p = i | j; const unsigned hi = max(a[i], a[p]), lo = min(a[i], a[p]); a[i] = hi; a[p] = lo; }
}

__device__ __forceinline__ float x4_max(float x) {
    const unsigned xi = __float_as_uint(x);
    const auto r = __builtin_amdgcn_permlane32_swap(xi, xi, false, false);
    const float m = fmaxf(__uint_as_float(r[0]), __uint_as_float(r[1]));
    const unsigned mi = __float_as_uint(m);
    const auto r2 = __builtin_amdgcn_permlane16_swap(mi, mi, false, false);
    return fmaxf(__uint_as_float(r2[0]), __uint_as_float(r2[1]));
}
__device__ __forceinline__ float x4_sum(float x) {
    const unsigned xi = __float_as_uint(x);
    const auto r = __builtin_amdgcn_permlane32_swap(xi, xi, false, false);
    const float m = __uint_as_float(r[0]) + __uint_as_float(r[1]);
    const unsigned mi = __float_as_uint(m);
    const auto r2 = __builtin_amdgcn_permlane16_swap(mi, mi, false, false);
    return __uint_as_float(r2[0]) + __uint_as_float(r2[1]);
}

__device__ __forceinline__ int opaque_tid() { int t = threadIdx.x; asm volatile("" : "+v"(t)); return t; }

__device__ __forceinline__ void mma_ktile(const unsigned char* sA, const unsigned char* sB, int arow_off, int brow_off, int g, int sw, f32x4 (&acc)[4][4]) {
#pragma unroll
    for (int s = 0; s < 2; ++s) {
        bf16x8 a[4], b[4];
        const int ch = (((s * 4 + g) ^ sw) << 4);
#pragma unroll
        for (int i = 0; i < 4; ++i) a[i] = *(const bf16x8*)(sA + arow_off + i * 2048 + ch);
#pragma unroll
        for (int j = 0; j < 4; ++j) b[j] = *(const bf16x8*)(sB + brow_off + j * 2048 + ch);
#pragma unroll
        for (int i = 0; i < 4; ++i)
#pragma unroll
            for (int j = 0; j < 4; ++j) acc[i][j] = __builtin_amdgcn_mfma_f32_16x16x32_bf16(b[j], a[i], acc[i][j], 0, 0, 0);
    }
}

__device__ __forceinline__ void store_tile_bf16(const f32x4 (&acc)[4][4], unsigned char* smem, bf16_t* dst, size_t ld, int m0, int n0, int tid, int wr, int wc, int g, int lr) {
#pragma unroll
    for (int i = 0; i < 4; ++i)
#pragma unroll
        for (int j = 0; j < 4; ++j) {
            const int row = wr * 64 + 16 * i + lr, col = wc * 64 + 16 * j + 4 * g;
            uint2 w; w.x = pk2(acc[i][j][0], acc[i][j][1]); w.y = pk2(acc[i][j][2], acc[i][j][3]);
            *(uint2*)(smem + row * 272 + col * 2) = w;
        }
    __syncthreads();
#pragma unroll
    for (int q = 0; q < 8; ++q) {
        const int id = tid + 256 * q, row = id >> 4, ch = id & 15;
        const uint4 v = *(const uint4*)(smem + row * 272 + ch * 16);
        *(uint4*)(dst + (size_t)(m0 + row) * ld + n0 + ch * 8) = v;
    }
    __syncthreads();
}

template <int MODE>
__device__ __forceinline__ void gemm_tile(const Params& P, int tm, int tn, unsigned char* smem) {
    const bf16_t* A; const bf16_t* Bt;
    if (MODE == 1) { A = (const bf16_t*)(P.ws + WS_RA); Bt = (const bf16_t*)(P.ws + WS_BT1); }
    else if (MODE == 2) { A = (const bf16_t*)(P.ws + WS_Z); Bt = (const bf16_t*)(P.ws + WS_BT2); }
    else { A = (const bf16_t*)(P.ws + WS_XN); Bt = (const bf16_t*)(P.ws + WS_BT3); }
    const int tid = opaque_tid(), lane = tid & 63, wave = tid >> 6, wr = wave >> 1, wc = wave & 1, g = lane >> 4, lr = lane & 15;
    const int m0 = tm * 128, n0 = tn * 128;
    const int srow = tid >> 3, sc = tid & 7;
    constexpr unsigned LDA = (MODE == 2 ? NZ : 1024) * 2u;
    unsigned aoff, boff; int soff0;
    {
        int ar = m0 + srow;
        if (MODE == 2) { const int b = ar >> 11, t = ar & 2047; ar = b * L + NMETA + t; }
        aoff = (unsigned)ar * LDA + (unsigned)sc * 16u;
        boff = (unsigned)(n0 + srow) * 2048u + (unsigned)sc * 16u;
        soff0 = srow * 128 + ((sc ^ (srow & 7)) << 4);
    }
    const unsigned char* Ab = (const unsigned char*)A; const unsigned char* Bb = (const unsigned char*)Bt;
    uint4 kpa0, kpa1, kpa2, kpa3, kpb0, kpb1, kpb2, kpb3; float4 ssp0, ssp1, ssp2, ssp3;
    if (MODE == 3) {
        const bf16_t* keys = (const bf16_t*)(P.ws + WS_KEYS) + (size_t)tn * 128 * 128 + (size_t)srow * 128 + sc * 8;
        kpa0 = *(const uint4*)(keys); kpa1 = *(const uint4*)(keys + 32 * 128); kpa2 = *(const uint4*)(keys + 64 * 128); kpa3 = *(const uint4*)(keys + 96 * 128);
        kpb0 = *(const uint4*)(keys + 64); kpb1 = *(const uint4*)(keys + 32 * 128 + 64); kpb2 = *(const uint4*)(keys + 64 * 128 + 64); kpb3 = *(const uint4*)(keys + 96 * 128 + 64);
        const float* ssq = (const float*)(P.ws + WS_SSQ) + (size_t)(m0 + wr * 64 + lr) * 16 + 4 * g;
        ssp0 = *(const float4*)(ssq); ssp1 = *(const float4*)(ssq + 16 * 16); ssp2 = *(const float4*)(ssq + 32 * 16); ssp3 = *(const float4*)(ssq + 48 * 16);
    }
    f32x4 acc[4][4];
#pragma unroll
    for (int i = 0; i < 4; ++i)
#pragma unroll
        for (int j = 0; j < 4; ++j) acc[i][j] = (f32x4){0.f, 0.f, 0.f, 0.f};
    uint4 ra0, ra1, ra2, ra3, rb0, rb1, rb2, rb3;
#define G_LOAD(KT) { const unsigned ko = (unsigned)(KT) * 128u; \
        ra0 = *(const uint4*)(Ab + (aoff + ko)); ra1 = *(const uint4*)(Ab + (aoff + 32u * LDA + ko)); ra2 = *(const uint4*)(Ab + (aoff + 64u * LDA + ko)); ra3 = *(const uint4*)(Ab + (aoff + 96u * LDA + ko)); \
        rb0 = *(const uint4*)(Bb + (boff + ko)); rb1 = *(const uint4*)(Bb + (boff + 32u * 2048u + ko)); rb2 = *(const uint4*)(Bb + (boff + 64u * 2048u + ko)); rb3 = *(const uint4*)(Bb + (boff + 96u * 2048u + ko)); }
#define G_WRITE(SA, SB) { *(uint4*)((SA) + soff0) = ra0; *(uint4*)((SA) + soff0 + 4096) = ra1; *(uint4*)((SA) + soff0 + 8192) = ra2; *(uint4*)((SA) + soff0 + 12288) = ra3; \
        *(uint4*)((SB) + soff0) = rb0; *(uint4*)((SB) + soff0 + 4096) = rb1; *(uint4*)((SB) + soff0 + 8192) = rb2; *(uint4*)((SB) + soff0 + 12288) = rb3; }
    unsigned char* sA0 = smem; unsigned char* sB0 = smem + 16384; unsigned char* sA1 = smem + 32768; unsigned char* sB1 = smem + 49152;
    G_LOAD(0)
    G_WRITE(sA0, sB0)
    __syncthreads();
    const int arow_off = (wr * 64 + lr) * 128, brow_off = (wc * 64 + lr) * 128, sw = lr & 7;
    G_LOAD(1)
    for (int kt = 0; kt < 16; ++kt) {
        unsigned char* sA = (kt & 1) ? sA1 : sA0; unsigned char* sB = (kt & 1) ? sB1 : sB0;
        unsigned char* nA = (kt & 1) ? sA0 : sA1; unsigned char* nB = (kt & 1) ? sB0 : sB1;
        bf16x8 fa[4], fb[4], ga[4], gb[4];
        const int ch0 = ((g ^ sw) << 4), ch1 = (((4 + g) ^ sw) << 4);
        const unsigned ko = (unsigned)(kt + 2) * 128u;
        const bool wr_ok = kt < 15, ld_ok = kt < 14;
#pragma unroll
        for (int i = 0; i < 4; ++i) { fa[i] = *(const bf16x8*)(sA + arow_off + i * 2048 + ch0); fb[i] = *(const bf16x8*)(sB + brow_off + i * 2048 + ch0); }
        __builtin_amdgcn_sched_barrier(0);
        __builtin_amdgcn_s_setprio(2);
        if (wr_ok) *(uint4*)(nA + soff0) = ra0;
        if (ld_ok) ra0 = *(const uint4*)(Ab + (aoff + 0u * LDA + ko));
        ga[0] = *(const bf16x8*)(sA + arow_off + 0 * 2048 + ch1); gb[0] = *(const bf16x8*)(sB + brow_off + 0 * 2048 + ch1);
        __builtin_amdgcn_sched_barrier(0);
#pragma unroll
        for (int j = 0; j < 4; ++j) acc[0][j] = __builtin_amdgcn_mfma_f32_16x16x32_bf16(fb[j], fa[0], acc[0][j], 0, 0, 0);
        __builtin_amdgcn_sched_barrier(0);
        if (wr_ok) *(uint4*)(nA + soff0 + 4096) = ra1;
        if (ld_ok) ra1 = *(const uint4*)(Ab + (aoff + 32u * LDA + ko));
        ga[1] = *(const bf16x8*)(sA + arow_off + 1 * 2048 + ch1); gb[1] = *(const bf16x8*)(sB + brow_off + 1 * 2048 + ch1);
        __builtin_amdgcn_sched_barrier(0);
#pragma unroll
        for (int j = 0; j < 4; ++j) acc[1][j] = __builtin_amdgcn_mfma_f32_16x16x32_bf16(fb[j], fa[1], acc[1][j], 0, 0, 0);
        __builtin_amdgcn_sched_barrier(0);
        if (wr_ok) *(uint4*)(nA + soff0 + 8192) = ra2;
        if (ld_ok) ra2 = *(const uint4*)(Ab + (aoff + 64u * LDA + ko));
        ga[2] = *(const bf16x8*)(sA + arow_off + 2 * 2048 + ch1); gb[2] = *(const bf16x8*)(sB + brow_off + 2 * 2048 + ch1);
        __builtin_amdgcn_sched_barrier(0);
#pragma unroll
        for (int j = 0; j < 4; ++j) acc[2][j] = __builtin_amdgcn_mfma_f32_16x16x32_bf16(fb[j], fa[2], acc[2][j], 0, 0, 0);
        __builtin_amdgcn_sched_barrier(0);
        if (wr_ok) *(uint4*)(nA + soff0 + 12288) = ra3;
        if (ld_ok) ra3 = *(const uint4*)(Ab + (aoff + 96u * LDA + ko));
        ga[3] = *(const bf16x8*)(sA + arow_off + 3 * 2048 + ch1); gb[3] = *(const bf16x8*)(sB + brow_off + 3 * 2048 + ch1);
        __builtin_amdgcn_sched_barrier(0);
#pragma unroll
        for (int j = 0; j < 4; ++j) acc[3][j] = __builtin_amdgcn_mfma_f32_16x16x32_bf16(fb[j], fa[3], acc[3][j], 0, 0, 0);
        __builtin_amdgcn_sched_barrier(0);
        if (wr_ok) *(uint4*)(nB + soff0) = rb0;
        if (ld_ok) rb0 = *(const uint4*)(Bb + (boff + 0u * 2048u + ko));
        __builtin_amdgcn_sched_barrier(0);
#pragma unroll
        for (int j = 0; j < 4; ++j) acc[0][j] = __builtin_amdgcn_mfma_f32_16x16x32_bf16(gb[j], ga[0], acc[0][j], 0, 0, 0);
        __builtin_amdgcn_sched_barrier(0);
        if (wr_ok) *(uint4*)(nB + soff0 + 4096) = rb1;
        if (ld_ok) rb1 = *(const uint4*)(Bb + (boff + 32u * 2048u + ko));
        __builtin_amdgcn_sched_barrier(0);
#pragma unroll
        for (int j = 0; j < 4; ++j) acc[1][j] = __builtin_amdgcn_mfma_f32_16x16x32_bf16(gb[j], ga[1], acc[1][j], 0, 0, 0);
        __builtin_amdgcn_sched_barrier(0);
        if (wr_ok) *(uint4*)(nB + soff0 + 8192) = rb2;
        if (ld_ok) rb2 = *(const uint4*)(Bb + (boff + 64u * 2048u + ko));
        __builtin_amdgcn_sched_barrier(0);
#pragma unroll
        for (int j = 0; j < 4; ++j) acc[2][j] = __builtin_amdgcn_mfma_f32_16x16x32_bf16(gb[j], ga[2], acc[2][j], 0, 0, 0);
        __builtin_amdgcn_sched_barrier(0);
        if (wr_ok) *(uint4*)(nB + soff0 + 12288) = rb3;
        if (ld_ok) rb3 = *(const uint4*)(Bb + (boff + 96u * 2048u + ko));
        __builtin_amdgcn_sched_barrier(0);
#pragma unroll
        for (int j = 0; j < 4; ++j) acc[3][j] = __builtin_amdgcn_mfma_f32_16x16x32_bf16(gb[j], ga[3], acc[3][j], 0, 0, 0);
        __builtin_amdgcn_s_setprio(0);
        __syncthreads();
    }
#undef G_LOAD
#undef G_WRITE
    if (MODE == 1) {
        if (n0 >= ZC_FQ && n0 < ZC_FV) {
            const bool isk = n0 >= ZC_FK;
            const float* gain = isk ? P.f_k_norm : P.f_q_norm;
            const float scl = isk ? 1.0f : 0.125f * LOG2E;
            float gn[4][4];
#pragma unroll
            for (int j = 0; j < 4; ++j)
#pragma unroll
                for (int r = 0; r < 4; ++r) gn[j][r] = gain[16 * j + 4 * g + r];
#pragma unroll
            for (int i = 0; i < 4; ++i) {
                float ss = 0.f;
#pragma unroll
                for (int j = 0; j < 4; ++j)
#pragma unroll
                    for (int r = 0; r < 4; ++r) ss += acc[i][j][r] * acc[i][j][r];
                ss = x4_sum(ss);
                const float rstd = rsqrtf(ss * (1.0f / 64.0f) + EPS) * scl;
#pragma unroll
                for (int j = 0; j < 4; ++j)
#pragma unroll
                    for (int r = 0; r < 4; ++r) acc[i][j][r] *= rstd * gn[j][r];
            }
        }
        store_tile_bf16(acc, smem, (bf16_t*)(P.ws + WS_Z), NZ, m0, n0, tid, wr, wc, g, lr);
    } else if (MODE == 2) {
        float* ssq = (float*)(P.ws + WS_SSQ);
#pragma unroll
        for (int i = 0; i < 4; ++i) {
            const int row = m0 + wr * 64 + 16 * i + lr;
            float ss = 0.f;
#pragma unroll
            for (int j = 0; j < 4; ++j) {
                const int col = n0 + wc * 64 + 16 * j + 4 * g;
                const float4 xv = *(const float4*)(P.x + (size_t)row * DM + col);
                const float4 gv = *(const float4*)(P.norm_ffn + col);
                float4 hv; hv.x = acc[i][j][0] + xv.x; hv.y = acc[i][j][1] + xv.y; hv.z = acc[i][j][2] + xv.z; hv.w = acc[i][j][3] + xv.w;
                ss += hv.x * hv.x + hv.y * hv.y + hv.z * hv.z + hv.w * hv.w;
                acc[i][j][0] = hv.x * gv.x; acc[i][j][1] = hv.y * gv.y; acc[i][j][2] = hv.z * gv.z; acc[i][j][3] = hv.w * gv.w;
            }
            ss = x4_sum(ss);
            if (g == 0) ssq[(size_t)row * 16 + tn * 2 + wc] = ss;
        }
        store_tile_bf16(acc, smem, (bf16_t*)(P.ws + WS_XN), 1024, m0, n0, tid, wr, wc, g, lr);
    } else {
        const int hp = tn;
        float rs[4];
#pragma unroll
        for (int i = 0; i < 4; ++i) {
            const int row = m0 + wr * 64 + 16 * i + lr;
            const float4 sp = i == 0 ? ssp0 : i == 1 ? ssp1 : i == 2 ? ssp2 : ssp3;
            const float s = x4_sum((sp.x + sp.y) + (sp.z + sp.w));
            rs[i] = rsqrtf(s * (1.0f / DM) + EPS);
            if (tn == 0 && wc == 0 && g == 0) ((float*)(P.ws + WS_RSTD))[row] = rs[i];
        }
        {
            unsigned char* sAq = wc ? sA1 : sA0;
#pragma unroll
            for (int i = 0; i < 4; ++i)
#pragma unroll
                for (int j = 0; j < 4; ++j) {
                    const int row = wr * 64 + 16 * i + lr;
                    const int chunk = 2 * j + (g >> 1);
                    uint2 w; w.x = pk2(acc[i][j][0] * rs[i], acc[i][j][1] * rs[i]); w.y = pk2(acc[i][j][2] * rs[i], acc[i][j][3] * rs[i]);
                    *(uint2*)(sAq + row * 128 + ((chunk ^ (row & 7)) << 4) + 8 * (g & 1)) = w;
                }
#pragma unroll
            for (int j = 0; j < 1; ++j) {
                *(uint4*)(sB0 + soff0) = kpa0; *(uint4*)(sB0 + soff0 + 4096) = kpa1; *(uint4*)(sB0 + soff0 + 8192) = kpa2; *(uint4*)(sB0 + soff0 + 12288) = kpa3;
                *(uint4*)(sB1 + soff0) = kpb0; *(uint4*)(sB1 + soff0 + 4096) = kpb1; *(uint4*)(sB1 + soff0 + 8192) = kpb2; *(uint4*)(sB1 + soff0 + 12288) = kpb3;
            }
        }
        __syncthreads();
#pragma unroll
        for (int i = 0; i < 4; ++i)
#pragma unroll
            for (int j = 0; j < 4; ++j) acc[i][j] = (f32x4){0.f, 0.f, 0.f, 0.f};
        mma_ktile(sA0, sB0, arow_off, brow_off, g, sw, acc);
        mma_ktile(sA1, sB1, arow_off, brow_off, g, sw, acc);
        __syncthreads();
#pragma unroll
        for (int i = 0; i < 4; ++i)
#pragma unroll
            for (int j = 0; j < 4; ++j) {
                const int row = wr * 64 + 16 * i + lr;
                const int c4 = wc * 16 + 4 * j + g;
                *(f32x4*)(smem + row * 512 + ((c4 ^ (row & 31)) << 4)) = acc[i][j];
            }
        __syncthreads();
        unsigned top[16];
        const int row = tid & 127, half = tid >> 7;
        {
            auto load_keys = [&](unsigned (&dst)[16], int q4) {
#pragma unroll
                for (int s4 = 0; s4 < 4; ++s4) {
                    const int c4 = half * 16 + q4 * 4 + s4;
                    const f32x4 v = *(const f32x4*)(smem + row * 512 + ((c4 ^ (row & 31)) << 4));
#pragma unroll
                    for (int e = 0; e < 4; ++e) dst[s4 * 4 + e] = (ord_key(v[e]) & ~127u) | (unsigned)(127 - (c4 * 4 + e));
                }
            };
            load_keys(top, 0);
            bitonic_sort16_desc(top);
#pragma unroll 1
            for (int q4 = 1; q4 < 4; ++q4) {
                unsigned gq[16];
                load_keys(gq, q4);
                bitonic_sort16_desc(gq);
                bitonic_merge16_top(top, gq);
            }
        }
        __syncthreads();
        if (half) {
            uint4* lp = (uint4*)(smem + row * 64);
            lp[0] = make_uint4(top[0], top[1], top[2], top[3]); lp[1] = make_uint4(top[4], top[5], top[6], top[7]);
            lp[2] = make_uint4(top[8], top[9], top[10], top[11]); lp[3] = make_uint4(top[12], top[13], top[14], top[15]);
        }
        __syncthreads();
        if (!half) {
            const uint4* lp = (const uint4*)(smem + row * 64);
            unsigned other[16];
#pragma unroll
            for (int c = 0; c < 4; ++c) { const uint4 o = lp[c]; other[4 * c] = o.x; other[4 * c + 1] = o.y; other[4 * c + 2] = o.z; other[4 * c + 3] = o.w; }
            bitonic_merge16_top(top, other);
            uint4* tk = (uint4*)((unsigned*)(P.ws + WS_TK) + ((size_t)(m0 + row) * 16 + hp) * 16);
            tk[0] = make_uint4(top[0], top[1], top[2], top[3]); tk[1] = make_uint4(top[4], top[5], top[6], top[7]);
            tk[2] = make_uint4(top[8], top[9], top[10], top[11]); tk[3] = make_uint4(top[12], top[13], top[14], top[15]);
        }
        __syncthreads();
    }
}

__device__ __forceinline__ void fox_cum_wave(const Params& P, int bh, int lane) {
    const int b = bh >> 3, h = bh & 7;
    const float* gates = (const float*)(P.ws + WS_GATES) + (size_t)b * L * 16 + 8 + h;
    float* cum = (float*)(P.ws + WS_CUM) + (size_t)bh * L;
    constexpr int SEG = 33;
    const int t0 = lane * SEG;
    float v[SEG];
#pragma unroll
    for (int i = 0; i < SEG; ++i) { const int t = t0 + i; const float x = gates[(size_t)(t < L ? t : L - 1) * 16]; v[i] = t < L ? x : 0.f; }
    float loc = 0.f;
#pragma unroll
    for (int i = 0; i < SEG; ++i) loc += v[i];
    float incl = loc;
#pragma unroll
    for (int o = 1; o < 64; o <<= 1) { const float n = __shfl_up(incl, o, 64); if (lane >= o) incl += n; }
    float run = incl - loc;
#pragma unroll
    for (int i = 0; i < SEG; ++i) { const int t = t0 + i; run += v[i]; if (t < L) cum[t] = run * LOG2E; }
}

#define TR_SLOW 0

__device__ __forceinline__ int vimg_off(int row, int ch) { return row * 128 + ((ch ^ (((row >> 1) & 3) << 1)) << 4); }
__device__ __forceinline__ uint2 tr_frag(const unsigned char* img, int row0, int c, int g, int lr) {
#if TR_SLOW
    unsigned short e[4];
#pragma unroll
    for (int k = 0; k < 4; ++k) { const int row = row0 + 4 * g + k, col = 16 * c + lr; e[k] = *(const unsigned short*)(img + vimg_off(row, col >> 3) + (col & 7) * 2); }
    uint2 r; r.x = (unsigned)e[0] | ((unsigned)e[1] << 16); r.y = (unsigned)e[2] | ((unsigned)e[3] << 16); return r;
#else
    const int q = lr >> 2, p = lr & 3, row = row0 + 4 * g + q;
    const unsigned addr = (unsigned)(size_t)(img + vimg_off(row, 2 * c + (p >> 1)) + 8 * (p & 1));
    uint2 r;
    asm volatile("ds_read_b64_tr_b16 %0, %1\n\ts_waitcnt lgkmcnt(0)" : "=&v"(r) : "v"(addr) : "memory");
    return r;
#endif
}

__device__ __forceinline__ unsigned tr_lane_addr(const unsigned char* img, int c, int g, int lr) {
    const int q = lr >> 2, p = lr & 3, row = 4 * g + q;
    return (unsigned)(size_t)(img + vimg_off(row, 2 * c + (p >> 1)) + 8 * (p & 1));
}
#define TR_GROUP(o0, o1, o2, o3, a) "ds_read_b64_tr_b16 %" #o0 ", %" #a "\n\tds_read_b64_tr_b16 %" #o1 ", %" #a " offset:2048\n\tds_read_b64_tr_b16 %" #o2 ", %" #a " offset:4096\n\tds_read_b64_tr_b16 %" #o3 ", %" #a " offset:6144\n\t"
__device__ __forceinline__ void tr_read_4c(const unsigned char* img, int g, int lr, uint2 (&r)[4][4]) {
    const unsigned a0 = tr_lane_addr(img, 0, g, lr), a1 = tr_lane_addr(img, 1, g, lr), a2 = tr_lane_addr(img, 2, g, lr), a3 = tr_lane_addr(img, 3, g, lr);
    asm volatile(TR_GROUP(0, 1, 2, 3, 16) TR_GROUP(4, 5, 6, 7, 17) TR_GROUP(8, 9, 10, 11, 18) TR_GROUP(12, 13, 14, 15, 19) "s_waitcnt lgkmcnt(0)"
        : "=&v"(r[0][0]), "=&v"(r[0][1]), "=&v"(r[0][2]), "=&v"(r[0][3]), "=&v"(r[1][0]), "=&v"(r[1][1]), "=&v"(r[1][2]), "=&v"(r[1][3]),
          "=&v"(r[2][0]), "=&v"(r[2][1]), "=&v"(r[2][2]), "=&v"(r[2][3]), "=&v"(r[3][0]), "=&v"(r[3][1]), "=&v"(r[3][2]), "=&v"(r[3][3])
        : "v"(a0), "v"(a1), "v"(a2), "v"(a3) : "memory");
}
__device__ __forceinline__ void tr_read_3c(const unsigned char* img, int g, int lr, uint2 (&r)[3][4]) {
    const unsigned a0 = tr_lane_addr(img, 0, g, lr), a1 = tr_lane_addr(img, 1, g, lr), a2 = tr_lane_addr(img, 2, g, lr);
    asm volatile(TR_GROUP(0, 1, 2, 3, 12) TR_GROUP(4, 5, 6, 7, 13) TR_GROUP(8, 9, 10, 11, 14) "s_waitcnt lgkmcnt(0)"
        : "=&v"(r[0][0]), "=&v"(r[0][1]), "=&v"(r[0][2]), "=&v"(r[0][3]), "=&v"(r[1][0]), "=&v"(r[1][1]), "=&v"(r[1][2]), "=&v"(r[1][3]),
          "=&v"(r[2][0]), "=&v"(r[2][1]), "=&v"(r[2][2]), "=&v"(r[2][3])
        : "v"(a0), "v"(a1), "v"(a2) : "memory");
}
__device__ __forceinline__ void tr_read_2(const unsigned char* img0, int c0, const unsigned char* img1, int c1, int g, int lr, uint2 (&r)[2][4]) {
    const unsigned a0 = tr_lane_addr(img0, c0, g, lr), a1 = tr_lane_addr(img1, c1, g, lr);
    asm volatile(TR_GROUP(0, 1, 2, 3, 8) TR_GROUP(4, 5, 6, 7, 9) "s_waitcnt lgkmcnt(0)"
        : "=&v"(r[0][0]), "=&v"(r[0][1]), "=&v"(r[0][2]), "=&v"(r[0][3]), "=&v"(r[1][0]), "=&v"(r[1][1]), "=&v"(r[1][2]), "=&v"(r[1][3])
        : "v"(a0), "v"(a1) : "memory");
}
__device__ __forceinline__ bf16x8 tr_pair(const uint2& lo, const uint2& hi) { uint4 u; u.x = lo.x; u.y = lo.y; u.z = hi.x; u.w = hi.y; return __builtin_bit_cast(bf16x8, u); }

__device__ __forceinline__ void attn_block(const Params& P, int bh, int qb, unsigned char* smem) {
    const int tid = opaque_tid(), lane = tid & 63, w = tid >> 6, g = lane >> 4, lr = lane & 15;
    const int b = bh >> 3, h = bh & 7;
    const bf16_t* z = (const bf16_t*)(P.ws + WS_Z);
    const float* cum = (const float*)(P.ws + WS_CUM) + (size_t)bh * L;
    int tq[2]; bool qvalid[2]; bf16x8 qf[2][2];
#pragma unroll
    for (int u = 0; u < 2; ++u) {
        tq[u] = qb * 128 + 32 * w + 16 * u + lr;
        qvalid[u] = tq[u] < L;
        const bf16_t* qp = z + (size_t)(b * L + (qvalid[u] ? tq[u] : 0)) * NZ + ZC_FQ + h * 64 + 8 * g;
        qf[u][0] = *(const bf16x8*)(qp); qf[u][1] = *(const bf16x8*)(qp + 32);
    }
    const int nkv = (2 * qb + 2 < 33) ? 2 * qb + 2 : 33;
    const int srow0 = tid >> 3, sch = tid & 7;
    uint4 rk0, rk1, rv0, rv1; float rc = 0.f;
    auto load_tile = [&](int kv) {
        const int key0 = kv * 64 + srow0, key1 = key0 + 32;
        const bf16_t* p0 = z + (size_t)(b * L + (key0 < L ? key0 : L - 1)) * NZ + h * 64 + sch * 8;
        const bf16_t* p1 = z + (size_t)(b * L + (key1 < L ? key1 : L - 1)) * NZ + h * 64 + sch * 8;
        rk0 = *(const uint4*)(p0 + ZC_FK); rv0 = *(const uint4*)(p0 + ZC_FV);
        rk1 = *(const uint4*)(p1 + ZC_FK); rv1 = *(const uint4*)(p1 + ZC_FV);
        const int keyc = kv * 64 + (tid & 63);
        rc = cum[keyc < L ? keyc : L - 1];
    };
    auto store_tile = [&](int buf) {
        unsigned char* sK = smem + buf * 16384; unsigned char* sV = sK + 8192;
        const int row0 = srow0, row1 = srow0 + 32;
        *(uint4*)(sK + row0 * 128 + ((sch ^ (row0 & 7)) << 4)) = rk0;
        *(uint4*)(sV + vimg_off(row0, sch)) = rv0;
        *(uint4*)(sK + row1 * 128 + ((sch ^ (row1 & 7)) << 4)) = rk1;
        *(uint4*)(sV + vimg_off(row1, sch)) = rv1;
        if (tid < 64) ((float*)(smem + 32768 + buf * 256))[tid] = rc;
    };
    float m[2] = {-1e30f, -1e30f};
    f32x4 o[2][5];
#pragma unroll
    for (int u = 0; u < 2; ++u)
#pragma unroll
        for (int c = 0; c < 5; ++c) o[u][c] = (f32x4){0.f, 0.f, 0.f, 0.f};
    const unsigned onew = (lr == 0) ? 0x3F803F80u : 0u;
    const bf16x8 vones = __builtin_bit_cast(bf16x8, make_uint4(onew, onew, onew, onew));
    load_tile(nkv - 1); store_tile((nkv - 1) & 1);
    __syncthreads();
    if (nkv > 1) load_tile(nkv - 2);
    for (int kv = nkv - 1; kv >= 0; --kv) {
        const int buf = kv & 1;
        const unsigned char* sK = smem + buf * 16384; const unsigned char* sV = sK + 8192;
        const float* sck = (const float*)(smem + 32768 + buf * 256);
        f32x4 sa[2][4];
#pragma unroll
        for (int c = 0; c < 4; ++c) {
            sa[0][c] = (f32x4){0.f, 0.f, 0.f, 0.f}; sa[1][c] = (f32x4){0.f, 0.f, 0.f, 0.f};
#pragma unroll
            for (int s = 0; s < 2; ++s) {
                const bf16x8 kf = *(const bf16x8*)(sK + (16 * c + lr) * 128 + (((4 * s + g) ^ (lr & 7)) << 4));
                sa[0][c] = __builtin_amdgcn_mfma_f32_16x16x32_bf16(kf, qf[0][s], sa[0][c], 0, 0, 0);
                sa[1][c] = __builtin_amdgcn_mfma_f32_16x16x32_bf16(kf, qf[1][s], sa[1][c], 0, 0, 0);
            }
        }
        __builtin_amdgcn_sched_barrier(0);
        if (kv > 0) store_tile(buf ^ 1);
        if (kv > 1) load_tile(kv - 2);
        __builtin_amdgcn_sched_barrier(0);
        if (kv >= 2 * qb) {
#pragma unroll
            for (int u = 0; u < 2; ++u)
#pragma unroll
                for (int c = 0; c < 4; ++c)
#pragma unroll
                    for (int r = 0; r < 4; ++r)
                        if (64 * kv + 16 * c + 4 * g + r > tq[u]) sa[u][c][r] = -INFINITY;
        }
        f32x4 ck[4];
#pragma unroll
        for (int c = 0; c < 4; ++c) ck[c] = *(const f32x4*)(sck + 16 * c + 4 * g);
        bf16x8 pf[2][2];
#pragma unroll
        for (int u = 0; u < 2; ++u) {
            float mx = -INFINITY;
#pragma unroll
            for (int c = 0; c < 4; ++c) {
                sa[u][c] -= ck[c];
                mx = fmaxf(mx, fmaxf(fmaxf(sa[u][c][0], sa[u][c][1]), fmaxf(sa[u][c][2], sa[u][c][3])));
            }
            mx = x4_max(mx);
            if (__builtin_amdgcn_ballot_w64(mx > m[u]) != 0ull) {
                const float mn = fmaxf(m[u], mx);
                const float alpha = __builtin_amdgcn_exp2f(m[u] - mn);
                m[u] = mn;
#pragma unroll
                for (int c = 0; c < 5; ++c) o[u][c] *= alpha;
            }
            const float mn = m[u];
#pragma unroll
            for (int c = 0; c < 4; ++c)
#pragma unroll
                for (int r = 0; r < 4; ++r) sa[u][c][r] = __builtin_amdgcn_exp2f(sa[u][c][r] - mn);
#pragma unroll
            for (int s2 = 0; s2 < 2; ++s2) {
                uint4 uu;
                uu.x = cvt_pk_bf16(sa[u][2 * s2][0], sa[u][2 * s2][1]); uu.y = cvt_pk_bf16(sa[u][2 * s2][2], sa[u][2 * s2][3]);
                uu.z = cvt_pk_bf16(sa[u][2 * s2 + 1][0], sa[u][2 * s2 + 1][1]); uu.w = cvt_pk_bf16(sa[u][2 * s2 + 1][2], sa[u][2 * s2 + 1][3]);
                pf[u][s2] = __builtin_bit_cast(bf16x8, uu);
            }
        }
        {
            uint2 vr[4][4];
            tr_read_4c(sV, g, lr, vr);
#pragma unroll
            for (int c = 0; c < 4; ++c)
#pragma unroll
                for (int s2 = 0; s2 < 2; ++s2) {
                    const bf16x8 vf = tr_pair(vr[c][2 * s2], vr[c][2 * s2 + 1]);
                    o[0][c] = __builtin_amdgcn_mfma_f32_16x16x32_bf16(vf, pf[0][s2], o[0][c], 0, 0, 0);
                    o[1][c] = __builtin_amdgcn_mfma_f32_16x16x32_bf16(vf, pf[1][s2], o[1][c], 0, 0, 0);
                }
#pragma unroll
            for (int s2 = 0; s2 < 2; ++s2) {
                o[0][4] = __builtin_amdgcn_mfma_f32_16x16x32_bf16(vones, pf[0][s2], o[0][4], 0, 0, 0);
                o[1][4] = __builtin_amdgcn_mfma_f32_16x16x32_bf16(vones, pf[1][s2], o[1][4], 0, 0, 0);
            }
        }
        __syncthreads();
    }
#pragma unroll
    for (int u = 0; u < 2; ++u) {
        const float ls = __shfl(o[u][4][0], lr, 64);
        const float inv = 1.0f / ls;
        if (qvalid[u]) {
            bf16_t* y = (bf16_t*)(P.ws + WS_Z) + (size_t)(b * L + tq[u]) * NZ + 512 + h * 64 + 4 * g;
#pragma unroll
            for (int c = 0; c < 4; ++c) {
                uint2 uu; uu.x = pk2(o[u][c][0] * inv, o[u][c][1] * inv); uu.y = pk2(o[u][c][2] * inv, o[u][c][3] * inv);
                *(uint2*)(y + 16 * c) = uu;
            }
        }
    }
}

__device__ __forceinline__ void conv_item(const Params& P, int ci) {
    const int tid = opaque_tid(), cc = tid & 127, rg = tid >> 7;
    const bf16_t* z = (const bf16_t*)(P.ws + WS_Z);
    bf16_t* qk = (bf16_t*)(P.ws + WS_RA);
    const int col0 = cc * 8;
    float w[4][8];
#pragma unroll
    for (int j = 0; j < 4; ++j) {
        const float4 a = *(const float4*)(P.conv_qk + j * 1024 + col0), b = *(const float4*)(P.conv_qk + j * 1024 + col0 + 4);
        w[j][0] = a.x; w[j][1] = a.y; w[j][2] = a.z; w[j][3] = a.w; w[j][4] = b.x; w[j][5] = b.y; w[j][6] = b.z; w[j][7] = b.w;
    }
    const float oscale = (col0 >= 512) ? 0.08838834764831845f : 1.0f;
    const int r0 = ci * 64 + rg * 32;
    int t = r0 % L;
    float xw[3][8];
#pragma unroll
    for (int j = 0; j < 3; ++j) {
        const int back = 3 - j;
        if (t - back >= 0) {
            const uint4 v = *(const uint4*)(z + (size_t)(r0 - back) * NZ + col0);
            xw[j][0] = bflo(v.x); xw[j][1] = bfhi(v.x); xw[j][2] = bflo(v.y); xw[j][3] = bfhi(v.y); xw[j][4] = bflo(v.z); xw[j][5] = bfhi(v.z); xw[j][6] = bflo(v.w); xw[j][7] = bfhi(v.w);
        } else {
#pragma unroll
            for (int e = 0; e < 8; ++e) xw[j][e] = 0.f;
        }
    }
#pragma unroll 2
    for (int i = 0; i < 32; ++i) {
        const int r = r0 + i;
        if (t == 0) {
#pragma unroll
            for (int j = 0; j < 3; ++j)
#pragma unroll
                for (int e = 0; e < 8; ++e) xw[j][e] = 0.f;
        }
        const uint4 v = *(const uint4*)(z + (size_t)r * NZ + col0);
        float xt[8];
        xt[0] = bflo(v.x); xt[1] = bfhi(v.x); xt[2] = bflo(v.y); xt[3] = bfhi(v.y); xt[4] = bflo(v.z); xt[5] = bfhi(v.z); xt[6] = bflo(v.w); xt[7] = bfhi(v.w);
        float o[8];
#pragma unroll
        for (int e = 0; e < 8; ++e) {
            const float cv = w[0][e] * xw[0][e] + w[1][e] * xw[1][e] + w[2][e] * xw[2][e] + w[3][e] * xt[e];
            o[e] = oscale * cv / (1.f + __expf(-cv));
            xw[0][e] = xw[1][e]; xw[1][e] = xw[2][e]; xw[2][e] = xt[e];
        }
        uint4 ov; ov.x = pk2(o[0], o[1]); ov.y = pk2(o[2], o[3]); ov.z = pk2(o[4], o[5]); ov.w = pk2(o[6], o[7]);
        *(uint4*)(qk + (size_t)r * 1024 + col0) = ov;
        t = (t + 1 == L) ? 0 : t + 1;
    }
}

constexpr int ST_IMG = 36864;
__device__ __forceinline__ int st_piece_off(int jt, int c, int g, int lr) { return (jt >> 2) * 18432 + vimg_off(16 * c + lr, 2 * (jt & 3) + (g >> 1)) + 8 * (g & 1); }

__device__ __forceinline__ void mlstm_stage_kv(const Params& P, int b, int h, int k, unsigned char* sKimg, unsigned char* sVimg, int tid) {
    const bf16_t* z = (const bf16_t*)(P.ws + WS_Z);
    const bf16_t* qk = (const bf16_t*)(P.ws + WS_RA);
    uint4 pk_[4], pv_[4];
#pragma unroll
    for (int j = 0; j < 4; ++j) {
        const int id = tid + 256 * j, row = id >> 4, ch16 = id & 15, pos = 64 * k + row;
        const bool ok = pos < L;
        pk_[j] = ok ? *(const uint4*)(qk + (size_t)(b * L + pos) * 1024 + 512 + h * 128 + ch16 * 8) : make_uint4(0, 0, 0, 0);
        pv_[j] = ok ? *(const uint4*)(z + (size_t)(b * L + pos) * NZ + ZC_MV + h * 128 + ch16 * 8) : make_uint4(0, 0, 0, 0);
    }
#pragma unroll
    for (int j = 0; j < 4; ++j) {
        const int id = tid + 256 * j, row = id >> 4, ch16 = id & 15;
        *(uint4*)(sKimg + (ch16 >> 3) * 8192 + vimg_off(row, ch16 & 7)) = pk_[j];
        *(uint4*)(sVimg + (ch16 >> 3) * 8192 + vimg_off(row, ch16 & 7)) = pv_[j];
    }
    if (tid < 128) {
        const int row = tid >> 1, ch = tid & 1;
        *(uint4*)(sVimg + 16384 + vimg_off(row, ch)) = ch ? make_uint4(0, 0, 0, 0) : make_uint4(0x3F80u, 0, 0, 0);
    }
}

__device__ __forceinline__ void mlstm_stage_A(const Params& P, int b, int h, int k, unsigned char* sKimg, unsigned char* sVimg, int tid) {
    const bf16_t* z = (const bf16_t*)(P.ws + WS_Z);
    bf16_t* qk = (bf16_t*)(P.ws + WS_RA);
    uint4 pv_[4];
#pragma unroll
    for (int j = 0; j < 4; ++j) {
        const int id = tid + 256 * j, row = id >> 4, ch16 = id & 15, pos = 64 * k + row;
        pv_[j] = (pos < L) ? *(const uint4*)(z + (size_t)(b * L + pos) * NZ + ZC_MV + h * 128 + ch16 * 8) : make_uint4(0, 0, 0, 0);
    }
    const int cch = tid & 31, rg = tid >> 5, isk = cch >> 4;
    const int zcol = (isk ? ZC_MK : ZC_MQ) + h * 128 + (cch & 15) * 8;
    float w[4][8];
#pragma unroll
    for (int j = 0; j < 4; ++j) {
        const float4 a = *(const float4*)(P.conv_qk + j * 1024 + zcol), c = *(const float4*)(P.conv_qk + j * 1024 + zcol + 4);
        w[j][0] = a.x; w[j][1] = a.y; w[j][2] = a.z; w[j][3] = a.w; w[j][4] = c.x; w[j][5] = c.y; w[j][6] = c.z; w[j][7] = c.w;
    }
    const float oscale = isk ? 0.08838834764831845f : 1.0f;
    const int p0 = 64 * k + 8 * rg;
    uint4 raw[11];
#pragma unroll
    for (int i = 0; i < 11; ++i) {
        const int pos = p0 - 3 + i;
        raw[i] = (pos >= 0 && pos < L) ? *(const uint4*)(z + (size_t)(b * L + pos) * NZ + zcol) : make_uint4(0, 0, 0, 0);
    }
#pragma unroll
    for (int j = 0; j < 4; ++j) {
        const int id = tid + 256 * j, row = id >> 4, ch16 = id & 15;
        *(uint4*)(sVimg + (ch16 >> 3) * 8192 + vimg_off(row, ch16 & 7)) = pv_[j];
    }
    if (tid < 128) {
        const int row = tid >> 1, ch = tid & 1;
        *(uint4*)(sVimg + 16384 + vimg_off(row, ch)) = ch ? make_uint4(0, 0, 0, 0) : make_uint4(0x3F80u, 0, 0, 0);
    }
#pragma unroll
    for (int i = 0; i < 8; ++i) {
        const int pos = p0 + i, row = 8 * rg + i;
        float o[8];
#pragma unroll
        for (int e = 0; e < 8; ++e) {
            const unsigned w0 = (&raw[i].x)[e >> 1], w1 = (&raw[i + 1].x)[e >> 1], w2 = (&raw[i + 2].x)[e >> 1], w3 = (&raw[i + 3].x)[e >> 1];
            const float x0 = (e & 1) ? bfhi(w0) : bflo(w0), x1 = (e & 1) ? bfhi(w1) : bflo(w1), x2 = (e & 1) ? bfhi(w2) : bflo(w2), x3 = (e & 1) ? bfhi(w3) : bflo(w3);
            const float cv = w[0][e] * x0 + w[1][e] * x1 + w[2][e] * x2 + w[3][e] * x3;
            o[e] = oscale * cv / (1.f + __expf(-cv));
        }
        uint4 ov; ov.x = pk2(o[0], o[1]); ov.y = pk2(o[2], o[3]); ov.z = pk2(o[4], o[5]); ov.w = pk2(o[6], o[7]);
        const bool ok = pos < L;
        if (!ok) ov = make_uint4(0, 0, 0, 0);
        if (ok) *(uint4*)(qk + (size_t)(b * L + pos) * 1024 + (isk ? 512 : 0) + h * 128 + (cch & 15) * 8) = ov;
        if (isk) { const int ch16 = cch & 15; *(uint4*)(sKimg + (ch16 >> 3) * 8192 + vimg_off(row, ch16 & 7)) = ov; }
    }
}

__device__ __forceinline__ void mlstm_A(const Params& P, int item, unsigned char* smem) {
    const int tid = opaque_tid(), lane = tid & 63, w = tid >> 6, g = lane >> 4, lr = lane & 15;
    const int wu = __builtin_amdgcn_readfirstlane(w);
    const int k = item >> 5, bh = item & 31, b = bh >> 2, h = bh & 3;
    const float* gates = (const float*)(P.ws + WS_GATES);
    const unsigned char* sK = smem; const unsigned char* sV = smem + 16384;
    float* ga = (float*)(smem + 40960);
    float lf = 0.f, li = -INFINITY;
    if (wu == 0) {
        const int pos = 64 * k + lane;
        if (pos < L) { lf = gates[(size_t)(b * L + pos) * 16 + 4 + h]; li = gates[(size_t)(b * L + pos) * 16 + h]; }
    }
    mlstm_stage_A(P, b, h, k, smem, smem + 16384, tid);
    if (wu == 0) {
        float bc = lf;
#pragma unroll
        for (int o = 1; o < 64; o <<= 1) { const float n = __shfl_up(bc, o, 64); if (lane >= o) bc += n; }
        const float a = li - bc;
        const float A = wave_max(a);
        ga[lane] = __expf(a - A);
        if (lane == 63) { float* msc = (float*)(P.ws + WS_MSC) + ((size_t)bh * 33 + k) * 4; msc[0] = A; msc[1] = bc; }
    }
    __syncthreads();
    f32x4 Ct[2][9];
#pragma unroll
    for (int a = 0; a < 2; ++a)
#pragma unroll
        for (int c = 0; c < 9; ++c) Ct[a][c] = (f32x4){0.f, 0.f, 0.f, 0.f};
    bf16x8 kt[2][2];
#pragma unroll
    for (int a = 0; a < 2; ++a)
#pragma unroll
        for (int s2 = 0; s2 < 2; ++s2) {
            const int jt = 2 * w + a;
            kt[a][s2] = tr_pair(tr_frag(sK + (jt >> 2) * 8192, 32 * s2, jt & 3, g, lr), tr_frag(sK + (jt >> 2) * 8192, 32 * s2 + 16, jt & 3, g, lr));
        }
    f32x4 wg4[4];
#pragma unroll
    for (int j = 0; j < 4; ++j) wg4[j] = *(const f32x4*)(ga + 16 * j + 4 * g);
#define MA_TILE(c, lo0, hi0, lo1, hi1) { \
        { const f32x4 w0 = wg4[0], w1 = wg4[1]; uint4 o; \
          o.x = cvt_pk_bf16(bflo(lo0.x) * w0[0], bfhi(lo0.x) * w0[1]); o.y = cvt_pk_bf16(bflo(lo0.y) * w0[2], bfhi(lo0.y) * w0[3]); \
          o.z = cvt_pk_bf16(bflo(hi0.x) * w1[0], bfhi(hi0.x) * w1[1]); o.w = cvt_pk_bf16(bflo(hi0.y) * w1[2], bfhi(hi0.y) * w1[3]); \
          const bf16x8 vw = __builtin_bit_cast(bf16x8, o); \
          Ct[0][c] = __builtin_amdgcn_mfma_f32_16x16x32_bf16(kt[0][0], vw, Ct[0][c], 0, 0, 0); Ct[1][c] = __builtin_amdgcn_mfma_f32_16x16x32_bf16(kt[1][0], vw, Ct[1][c], 0, 0, 0); } \
        { const f32x4 w0 = wg4[2], w1 = wg4[3]; uint4 o; \
          o.x = cvt_pk_bf16(bflo(lo1.x) * w0[0], bfhi(lo1.x) * w0[1]); o.y = cvt_pk_bf16(bflo(lo1.y) * w0[2], bfhi(lo1.y) * w0[3]); \
          o.z = cvt_pk_bf16(bflo(hi1.x) * w1[0], bfhi(hi1.x) * w1[1]); o.w = cvt_pk_bf16(bflo(hi1.y) * w1[2], bfhi(hi1.y) * w1[3]); \
          const bf16x8 vw = __builtin_bit_cast(bf16x8, o); \
          Ct[0][c] = __builtin_amdgcn_mfma_f32_16x16x32_bf16(kt[0][1], vw, Ct[0][c], 0, 0, 0); Ct[1][c] = __builtin_amdgcn_mfma_f32_16x16x32_bf16(kt[1][1], vw, Ct[1][c], 0, 0, 0); } }
    {
        uint2 vr[4][4];
        tr_read_4c(sV, g, lr, vr);
        MA_TILE(0, vr[0][0], vr[0][1], vr[0][2], vr[0][3]) MA_TILE(1, vr[1][0], vr[1][1], vr[1][2], vr[1][3])
        MA_TILE(2, vr[2][0], vr[2][1], vr[2][2], vr[2][3]) MA_TILE(3, vr[3][0], vr[3][1], vr[3][2], vr[3][3])
        tr_read_4c(sV + 8192, g, lr, vr);
        MA_TILE(4, vr[0][0], vr[0][1], vr[0][2], vr[0][3]) MA_TILE(5, vr[1][0], vr[1][1], vr[1][2], vr[1][3])
        MA_TILE(6, vr[2][0], vr[2][1], vr[2][2], vr[2][3]) MA_TILE(7, vr[3][0], vr[3][1], vr[3][2], vr[3][3])
        const uint2 o0 = tr_frag(sV + 16384, 0, 0, g, lr), o1 = tr_frag(sV + 16384, 16, 0, g, lr), o2 = tr_frag(sV + 16384, 32, 0, g, lr), o3 = tr_frag(sV + 16384, 48, 0, g, lr);
        MA_TILE(8, o0, o1, o2, o3)
    }
#undef MA_TILE
    unsigned char* slot = P.ws + WS_MST + ((size_t)bh * 33 + k) * ST_IMG;
#pragma unroll
    for (int a = 0; a < 2; ++a)
#pragma unroll
        for (int c = 0; c < 9; ++c) {
            uint2 u; u.x = cvt_pk_bf16(Ct[a][c][0], Ct[a][c][1]); u.y = cvt_pk_bf16(Ct[a][c][2], Ct[a][c][3]);
            *(uint2*)(slot + st_piece_off(2 * w + a, c, g, lr)) = u;
        }
}

__device__ __forceinline__ void mlstm_B(const Params& P, int item) {
    const int tid = opaque_tid();
    const int bh = item / 3, part = item - bh * 3;
    const unsigned char* base = P.ws + WS_MST + (size_t)bh * 33 * ST_IMG + part * 12288 + tid * 48;
    unsigned char* obase = P.ws + WS_CBI + (size_t)bh * 33 * ST_IMG + part * 12288 + tid * 48;
    float* msc = (float*)(P.ws + WS_MSC) + (size_t)bh * 33 * 4;
    float C[6][4];
#pragma unroll
    for (int i = 0; i < 6; ++i)
#pragma unroll
        for (int r = 0; r < 4; ++r) C[i][r] = 0.f;
    float m = 0.f;
    uint2 d0[6], d1[6];
    float2 ab0, ab1;
#pragma unroll
    for (int i = 0; i < 6; ++i) { d0[i] = *(const uint2*)(base + i * 8); d1[i] = *(const uint2*)(base + ST_IMG + i * 8); }
    ab0 = *(const float2*)(msc); ab1 = *(const float2*)(msc + 4);
    for (int k = 0; k < 33; ++k) {
        uint2 d2[6]; float2 ab2 = make_float2(0.f, 0.f);
        if (k + 2 < 33) {
#pragma unroll
            for (int i = 0; i < 6; ++i) d2[i] = *(const uint2*)(base + (size_t)(k + 2) * ST_IMG + i * 8);
            ab2 = *(const float2*)(msc + (k + 2) * 4);
        } else {
#pragma unroll
            for (int i = 0; i < 6; ++i) d2[i] = make_uint2(0, 0);
        }
#pragma unroll
        for (int i = 0; i < 6; ++i) {
            uint2 u; u.x = cvt_pk_bf16(C[i][0], C[i][1]); u.y = cvt_pk_bf16(C[i][2], C[i][3]);
            *(uint2*)(obase + (size_t)k * ST_IMG + i * 8) = u;
        }
        if (tid == 0 && part == 0) msc[k * 4 + 2] = m;
        const float M = fmaxf(m, ab0.x);
        const float decay = __expf(m - M), sc = __expf(ab0.x - M);
#pragma unroll
        for (int i = 0; i < 6; ++i) {
            C[i][0] = decay * C[i][0] + sc * bflo(d0[i].x); C[i][1] = decay * C[i][1] + sc * bfhi(d0[i].x);
            C[i][2] = decay * C[i][2] + sc * bflo(d0[i].y); C[i][3] = decay * C[i][3] + sc * bfhi(d0[i].y);
        }
        m = ab0.y + M;
#pragma unroll
        for (int i = 0; i < 6; ++i) { d0[i] = d1[i]; d1[i] = d2[i]; }
        ab0 = ab1; ab1 = ab2;
    }
}

__device__ __forceinline__ void mlstm_C(const Params& P, int item, unsigned char* smem) {
    const int tid = opaque_tid(), lane = tid & 63, w = tid >> 6, g = lane >> 4, lr = lane & 15;
    const int wu = __builtin_amdgcn_readfirstlane(w);
    const int k = item >> 5, bh = item & 31, b = bh >> 2, h = bh & 3;
    const bf16_t* z = (const bf16_t*)(P.ws + WS_Z);
    const bf16_t* qk = (const bf16_t*)(P.ws + WS_RA);
    const float* gates = (const float*)(P.ws + WS_GATES);
    bf16_t* y = (bf16_t*)(P.ws + WS_Z);
    const unsigned char* sK = smem; const unsigned char* sV = smem + 36864; unsigned char* sCb = smem;
    float* ga = (float*)(smem + 61440);
    const int pos = 64 * k + 16 * w + lr;
    const bool tvalid = pos < L;
    const size_t rrow = (size_t)(b * L + (tvalid ? pos : 0));
    const unsigned char* cslot = P.ws + WS_CBI + ((size_t)bh * 33 + k) * ST_IMG + tid * 16;
    const uint4 cb0 = *(const uint4*)(cslot), cb1 = *(const uint4*)(cslot + 4096), cb2 = *(const uint4*)(cslot + 8192), cb3 = *(const uint4*)(cslot + 12288), cb4 = *(const uint4*)(cslot + 16384),
                cb5 = *(const uint4*)(cslot + 20480), cb6 = *(const uint4*)(cslot + 24576), cb7 = *(const uint4*)(cslot + 28672), cb8 = *(const uint4*)(cslot + 32768);
    bf16x8 qf[4];
    {
        const bf16_t* qp = qk + rrow * 1024 + h * 128 + 8 * g;
#pragma unroll
        for (int ks = 0; ks < 4; ++ks) { qf[ks] = *(const bf16x8*)(qp + 32 * ks); if (!tvalid) qf[ks] = (bf16x8){0, 0, 0, 0, 0, 0, 0, 0}; }
    }
    float m_prev = 0.f, lf = 0.f, li = -INFINITY;
    if (wu == 0) {
        m_prev = ((const float*)(P.ws + WS_MSC))[((size_t)bh * 33 + k) * 4 + 2];
        const int p2 = 64 * k + lane;
        if (p2 < L) { lf = gates[(size_t)(b * L + p2) * 16 + 4 + h]; li = gates[(size_t)(b * L + p2) * 16 + h]; }
    }
    mlstm_stage_kv(P, b, h, k, smem, smem + 36864, tid);
    if (wu == 0) {
        float bc = lf;
#pragma unroll
        for (int o = 1; o < 64; o <<= 1) { const float n = __shfl_up(bc, o, 64); if (lane >= o) bc += n; }
        const float a = li - bc;
        float am = a;
#pragma unroll
        for (int o = 1; o < 64; o <<= 1) { const float n = __shfl_up(am, o, 64); if (lane >= o) am = fmaxf(am, n); }
        const float M = fmaxf(m_prev, am);
        ga[lane] = a; ga[64 + lane] = __expf(m_prev - M); ga[128 + lane] = __expf(-(bc + M)); ga[192 + lane] = M;
    }
    __syncthreads();
    const float Mt = ga[192 + 16 * w + lr], Wi = ga[64 + 16 * w + lr], Et = ga[128 + 16 * w + lr];
    bf16x8 pf[2];
    {
        f32x4 sa[4];
#pragma unroll
        for (int c = 0; c < 4; ++c) {
            sa[c] = (f32x4){0.f, 0.f, 0.f, 0.f};
            if (c <= wu) {
#pragma unroll
                for (int ks = 0; ks < 4; ++ks) {
                    const bf16x8 kf = *(const bf16x8*)(sK + (ks >> 1) * 8192 + vimg_off(16 * c + lr, 4 * (ks & 1) + g));
                    sa[c] = __builtin_amdgcn_mfma_f32_16x16x32_bf16(kf, qf[ks], sa[c], 0, 0, 0);
                }
                const f32x4 av = *(const f32x4*)(ga + 16 * c + 4 * g);
#pragma unroll
                for (int r = 0; r < 4; ++r) {
                    const float d = __expf(av[r] - Mt);
                    sa[c][r] = (16 * c + 4 * g + r <= 16 * w + lr) ? sa[c][r] * d : 0.f;
                }
            }
        }
#pragma unroll
        for (int s2 = 0; s2 < 2; ++s2) {
            uint4 u;
            u.x = cvt_pk_bf16(sa[2 * s2][0], sa[2 * s2][1]); u.y = cvt_pk_bf16(sa[2 * s2][2], sa[2 * s2][3]);
            u.z = cvt_pk_bf16(sa[2 * s2 + 1][0], sa[2 * s2 + 1][1]); u.w = cvt_pk_bf16(sa[2 * s2 + 1][2], sa[2 * s2 + 1][3]);
            pf[s2] = __builtin_bit_cast(bf16x8, u);
        }
    }
    __syncthreads();
    {
        unsigned char* d = sCb + tid * 16;
        *(uint4*)(d) = cb0; *(uint4*)(d + 4096) = cb1; *(uint4*)(d + 8192) = cb2; *(uint4*)(d + 12288) = cb3; *(uint4*)(d + 16384) = cb4;
        *(uint4*)(d + 20480) = cb5; *(uint4*)(d + 24576) = cb6; *(uint4*)(d + 28672) = cb7; *(uint4*)(d + 32768) = cb8;
    }
    __syncthreads();
    f32x4 na[9];
#define MC_TILE(c, lo0, hi0, lo1, hi1) { \
        na[c] = (f32x4){0.f, 0.f, 0.f, 0.f}; \
        _Pragma("unroll") for (int ks = 0; ks < 4; ++ks) { \
            const bf16x8 cf = *(const bf16x8*)(sCb + (ks >> 1) * 18432 + vimg_off(16 * (c) + lr, 4 * (ks & 1) + g)); \
            na[c] = __builtin_amdgcn_mfma_f32_16x16x32_bf16(cf, qf[ks], na[c], 0, 0, 0); } \
        na[c] *= Wi; \
        na[c] = __builtin_amdgcn_mfma_f32_16x16x32_bf16(tr_pair(lo0, hi0), pf[0], na[c], 0, 0, 0); \
        na[c] = __builtin_amdgcn_mfma_f32_16x16x32_bf16(tr_pair(lo1, hi1), pf[1], na[c], 0, 0, 0); }
    {
        uint2 vr[4][4];
        tr_read_4c(sV, g, lr, vr);
        MC_TILE(0, vr[0][0], vr[0][1], vr[0][2], vr[0][3]) MC_TILE(1, vr[1][0], vr[1][1], vr[1][2], vr[1][3])
        MC_TILE(2, vr[2][0], vr[2][1], vr[2][2], vr[2][3]) MC_TILE(3, vr[3][0], vr[3][1], vr[3][2], vr[3][3])
        tr_read_4c(sV + 8192, g, lr, vr);
        MC_TILE(4, vr[0][0], vr[0][1], vr[0][2], vr[0][3]) MC_TILE(5, vr[1][0], vr[1][1], vr[1][2], vr[1][3])
        MC_TILE(6, vr[2][0], vr[2][1], vr[2][2], vr[2][3]) MC_TILE(7, vr[3][0], vr[3][1], vr[3][2], vr[3][3])
        const uint2 o0 = tr_frag(sV + 16384, 0, 0, g, lr), o1 = tr_frag(sV + 16384, 16, 0, g, lr), o2 = tr_frag(sV + 16384, 32, 0, g, lr), o3 = tr_frag(sV + 16384, 48, 0, g, lr);
        MC_TILE(8, o0, o1, o2, o3)
    }
#undef MC_TILE
    const float den = __shfl(na[8][0], lr, 64);
    const float rden = 1.0f / fmaxf(fabsf(den), Et);
    float hs = 0.f;
#pragma unroll
    for (int c = 0; c < 8; ++c) { na[c] *= rden; hs += na[c][0] * na[c][0] + na[c][1] * na[c][1] + na[c][2] * na[c][2] + na[c][3] * na[c][3]; }
    hs = x4_sum(hs);
    const float rstd = rsqrtf(hs * (1.0f / 128.0f) + EPS);
    const float* gainp = P.m_out_norm + h * 128 + 4 * g;
#pragma unroll
    for (int c = 0; c < 8; ++c) {
        const uint2 og = *(const uint2*)(z + rrow * NZ + ZC_MO + h * 128 + 16 * c + 4 * g);
        const float o0 = bflo(og.x), o1 = bfhi(og.x), o2 = bflo(og.y), o3 = bfhi(og.y);
        const float4 gn = *(const float4*)(gainp + 16 * c);
        uint2 u;
        u.x = pk2(na[c][0] * rstd * gn.x / (1.f + __expf(-o0)), na[c][1] * rstd * gn.y / (1.f + __expf(-o1)));
        u.y = pk2(na[c][2] * rstd * gn.z / (1.f + __expf(-o2)), na[c][3] * rstd * gn.w / (1.f + __expf(-o3)));
        if (tvalid) *(uint2*)(y + rrow * NZ + h * 128 + 16 * c + 4 * g) = u;
    }
}

__device__ __forceinline__ void peer_token(const Params& P, int t, int tnext, uint4& tkw, int lane, int* sidx, float* sval, int* sid, float* sgate, const unsigned char* slut, const unsigned* szero) {
    {
        const unsigned kk[4] = {tkw.x, tkw.y, tkw.z, tkw.w};
#pragma unroll
        for (int i = 0; i < 4; ++i) {
            const unsigned k = kk[i];
            sidx[lane * 4 + i] = 127 - (int)(k & 127u);
            sval[lane * 4 + i] = unord_key(k & ~127u);
        }
        tkw = *(const uint4*)((const unsigned*)(P.ws + WS_TK) + (size_t)tnext * 256 + lane * 4);
    }
    const bf16_t* xn = (const bf16_t*)(P.ws + WS_XN) + (size_t)t * DM;
    const uint4 xa_pre = *(const uint4*)(xn + lane * 16), xb_pre = *(const uint4*)(xn + lane * 16 + 8);
    const float rstd = ((const float*)(P.ws + WS_RSTD))[t];
    __builtin_amdgcn_s_waitcnt(0xc07f);
    __builtin_amdgcn_wave_barrier();
    {
        const int hd = lane >> 3, sub = lane & 7;
        unsigned x[8];
#pragma unroll
        for (int r = 0; r < 8; ++r) {
            const int c = sub * 8 + r;
            const unsigned ij = slut[c < 50 ? c : 0];
            const int i = ij >> 4, j = ij & 15;
            const unsigned kx = (ord_key(sval[(2 * hd) * 16 + i] + sval[(2 * hd + 1) * 16 + j]) & ~255u) | (unsigned)(255 - (i * 16 + j));
            x[r] = c < 50 ? kx : 0u;
        }
#pragma unroll
        for (int k = 2; k <= 64; k <<= 1) {
#pragma unroll
            for (int j = k >> 1; j >= 1; j >>= 1) {
                if (j >= 8) {
                    const int ld = j >> 3;
                    const bool lower = (sub & ld) == 0;
                    const bool desc = k >= 64 ? true : ((sub * 8) & k) == 0;
                    const bool takemax = (lower == desc);
#pragma unroll
                    for (int r = 0; r < 8; ++r) {
                        const unsigned o = (unsigned)__shfl_xor((int)x[r], ld, 64);
                        const unsigned hi = max(x[r], o), lo = min(x[r], o);
                        x[r] = takemax ? hi : lo;
                    }
                } else {
#pragma unroll
                    for (int r = 0; r < 8; ++r) {
                        if ((r & j) == 0) {
                            const int p = r | j;
                            const unsigned hi = max(x[r], x[p]), lo = min(x[r], x[p]);
                            if (k <= 4) { const bool desc = (r & k) == 0; x[r] = desc ? hi : lo; x[p] = desc ? lo : hi; }
                            else if (k >= 64) { x[r] = hi; x[p] = lo; }
                            else { const bool desc = ((sub * 8) & k) == 0; x[r] = desc ? hi : lo; x[p] = desc ? lo : hi; }
                        }
                    }
                }
            }
        }
        const float smax = unord_key((unsigned)__shfl((int)x[0], hd * 8, 64) & ~255u);
        float e[8]; float den = 0.f;
#pragma unroll
        for (int r = 0; r < 8; ++r) { e[r] = __expf(unord_key(x[r] & ~255u) - smax); den += e[r]; }
        den += __shfl_xor(den, 1, 64);
        const float inv = 1.f / den;
        if (sub < 2) {
#pragma unroll
            for (int r = 0; r < 8; ++r) {
                const int pos = 255 - (int)(x[r] & 255u), i = pos >> 4, j = pos & 15;
                sid[hd * 16 + sub * 8 + r] = sidx[(2 * hd) * 16 + i] * 128 + sidx[(2 * hd + 1) * 16 + j];
                sgate[hd * 16 + sub * 8 + r] = e[r] * inv;
            }
        }
    }
    __builtin_amdgcn_s_waitcnt(0xc07f);
    __builtin_amdgcn_wave_barrier();
    const unsigned char* V = P.ws + WS_V + lane * 8;
    const float* usc = (const float*)(P.ws + WS_USC);
    const float* vsc = (const float*)(P.ws + WS_VSC);
    const int g = lane >> 4, lr = lane & 15;
    unsigned char* shi = (unsigned char*)sval;
    unsigned char* slo = (unsigned char*)sidx;
    {
        const uint4 xa = xa_pre, xb = xb_pre;
        const unsigned xw[8] = {xa.x, xa.y, xa.z, xa.w, xb.x, xb.y, xb.z, xb.w};
        unsigned hi[4], lo[4];
#pragma unroll
        for (int i = 0; i < 4; ++i) {
            const float x0 = bflo(xw[2 * i]), x1 = bfhi(xw[2 * i]), x2 = bflo(xw[2 * i + 1]), x3 = bfhi(xw[2 * i + 1]);
            int wd = 0;
            wd = __builtin_amdgcn_cvt_pk_fp8_f32(x0, x1, wd, false);
            wd = __builtin_amdgcn_cvt_pk_fp8_f32(x2, x3, wd, true);
            const f32x2 h01 = __builtin_amdgcn_cvt_pk_f32_fp8(wd, false), h23 = __builtin_amdgcn_cvt_pk_f32_fp8(wd, true);
            int wl = 0;
            wl = __builtin_amdgcn_cvt_pk_fp8_f32(x0 - h01.x, x1 - h01.y, wl, false);
            wl = __builtin_amdgcn_cvt_pk_fp8_f32(x2 - h23.x, x3 - h23.y, wl, true);
            hi[i] = (unsigned)wd; lo[i] = (unsigned)wl;
        }
        *(uint4*)(shi + lane * 16) = make_uint4(hi[0], hi[1], hi[2], hi[3]);
        *(uint4*)(slo + lane * 16) = make_uint4(lo[0], lo[1], lo[2], lo[3]);
    }
    __builtin_amdgcn_s_waitcnt(0xc07f);
    __builtin_amdgcn_wave_barrier();
    {
        typedef int v8i __attribute__((ext_vector_type(8)));
        const unsigned char* Ub = P.ws + WS_U;
        const unsigned lofs = 64u * (unsigned)(lr >> 3) + 16u * (unsigned)g;
        const unsigned char* bsrc = (lr < 4) ? (((lr & 2) ? slo : shi) + 128 * (lr & 1) + 16 * g) : (const unsigned char*)szero;
        const int bstep = (lr < 4) ? 256 : 0, bhalf = (lr < 4) ? 64 : 16;
        v8i Bv[4];
#pragma unroll
        for (int st = 0; st < 4; ++st) {
            const uint4 b0 = *(const uint4*)(bsrc + bstep * st), b1 = *(const uint4*)(bsrc + bstep * st + bhalf);
            Bv[st] = (v8i){(int)b0.x, (int)b0.y, (int)b0.z, (int)b0.w, (int)b1.x, (int)b1.y, (int)b1.z, (int)b1.w};
        }
        __builtin_amdgcn_s_waitcnt(0xc07f);
        __builtin_amdgcn_wave_barrier();
        float* sact = (float*)sidx + 128 * (lr & 3) + 4 * (g & 1);
        const bool owner = (lr < 4) && ((g >> 1) == (lr & 1));
        uint4 abuf[2][2][4];
        unsigned off2[2];
#pragma unroll
        for (int hh = 0; hh < 2; ++hh) off2[hh] = (unsigned)sid[8 * hh + (lr & 7)] * 512u + lofs;
#pragma unroll
        for (int hh = 0; hh < 2; ++hh)
#pragma unroll
            for (int st = 0; st < 4; ++st) abuf[0][hh][st] = *(const uint4*)(Ub + (off2[hh] + 128 * st));
#pragma unroll
        for (int T = 0; T < 8; ++T) {
            if (T + 1 < 8) {
#pragma unroll
                for (int hh = 0; hh < 2; ++hh) off2[hh] = (unsigned)sid[16 * (T + 1) + 8 * hh + (lr & 7)] * 512u + lofs;
#pragma unroll
                for (int hh = 0; hh < 2; ++hh)
#pragma unroll
                    for (int st = 0; st < 4; ++st) abuf[(T + 1) & 1][hh][st] = *(const uint4*)(Ub + (off2[hh] + 128 * st));
            }
#pragma unroll
            for (int hh = 0; hh < 2; ++hh) {
                f32x4 au = (f32x4){0.f, 0.f, 0.f, 0.f};
#pragma unroll
                for (int st = 0; st < 4; ++st) {
                    const uint4 a4 = abuf[T & 1][hh][st];
                    const v8i Av = {(int)a4.x, (int)a4.y, (int)a4.z, (int)a4.w, 0, 0, 0, 0};
                    au = __builtin_amdgcn_mfma_scale_f32_16x16x128_f8f6f4(Av, Bv[st], au, 4, 0, 0, 0x7f7f7f7f, 0, 0x7f7f7f7f);
                }
                if (owner) *(f32x4*)(sact + 16 * T + 8 * hh) = au;
            }
        }
    }
    __builtin_amdgcn_s_waitcnt(0xc07f);
    __builtin_amdgcn_wave_barrier();
    {
        float* sw = (float*)sidx;
        float wv[2];
#pragma unroll
        for (int hh = 0; hh < 2; ++hh) {
            const int e = lane + 64 * hh, id = sid[e];
            const float a = ((sw[e] + sw[128 + e]) + (sw[256 + e] + sw[384 + e])) * usc[id] * rstd;
            wv[hh] = sgate[e] * vsc[id] * 0.5f * a * (1.f + erff(a * 0.70710678118654752f));
        }
        __builtin_amdgcn_s_waitcnt(0xc07f);
        __builtin_amdgcn_wave_barrier();
        sw[lane] = wv[0]; sw[lane + 64] = wv[1];
    }
    __builtin_amdgcn_s_waitcnt(0xc07f);
    __builtin_amdgcn_wave_barrier();
    const int half = lane >> 5, l5 = lane & 31;
    const int lane_o = 2 * l5 + half;
    f32x2 acc2[16];
#pragma unroll
    for (int j = 0; j < 16; ++j) acc2[j] = (f32x2){0.f, 0.f};
    const unsigned char* Vb = P.ws + WS_V;
    const unsigned vlo = (unsigned)l5 * 16u;
#pragma unroll 1
    for (int e0 = 0; e0 < 128; e0 += 16) {
        uint4 vr[8];
#pragma unroll
        for (int q = 0; q < 8; ++q) vr[q] = *(const uint4*)(Vb + ((unsigned)sid[e0 + 2 * q + half] * 512u + vlo));
        const float* sw = (const float*)sidx + e0;
        const f32x4 w0 = *(const f32x4*)(sw), w1 = *(const f32x4*)(sw + 4), w2 = *(const f32x4*)(sw + 8), w3 = *(const f32x4*)(sw + 12);
        const float wq[16] = {w0[0], w0[1], w0[2], w0[3], w1[0], w1[1], w1[2], w1[3], w2[0], w2[1], w2[2], w2[3], w3[0], w3[1], w3[2], w3[3]};
#pragma unroll
        for (int q = 0; q < 8; ++q) {
            const float w = half ? wq[2 * q + 1] : wq[2 * q];
#define FP4_AXPY(k) { acc2[k] += w * __builtin_amdgcn_cvt_scalef32_pk_f32_fp4(vr[q].x, 1.0f, k); acc2[4 + k] += w * __builtin_amdgcn_cvt_scalef32_pk_f32_fp4(vr[q].y, 1.0f, k); \
                      acc2[8 + k] += w * __builtin_amdgcn_cvt_scalef32_pk_f32_fp4(vr[q].z, 1.0f, k); acc2[12 + k] += w * __builtin_amdgcn_cvt_scalef32_pk_f32_fp4(vr[q].w, 1.0f, k); }
            FP4_AXPY(0) FP4_AXPY(1) FP4_AXPY(2) FP4_AXPY(3)
#undef FP4_AXPY
        }
    }
    f32x2 acc[8];
#pragma unroll
    for (int j = 0; j < 16; ++j) {
        const unsigned x0 = __float_as_uint(acc2[j].x), x1 = __float_as_uint(acc2[j].y);
        const auto r0 = __builtin_amdgcn_permlane32_swap(x0, x0, false, false);
        const auto r1 = __builtin_amdgcn_permlane32_swap(x1, x1, false, false);
        acc2[j].x = __uint_as_float(r0[0]) + __uint_as_float(r0[1]);
        acc2[j].y = __uint_as_float(r1[0]) + __uint_as_float(r1[1]);
    }
#pragma unroll
    for (int j = 0; j < 8; ++j) { acc[j].x = half ? acc2[8 + j].x : acc2[j].x; acc[j].y = half ? acc2[8 + j].y : acc2[j].y; }
    f32x2 xf[8];
    {
        const uint4 xa = *(const uint4*)(xn + lane_o * 16), xb = *(const uint4*)(xn + lane_o * 16 + 8);
        xf[0] = (f32x2){bflo(xa.x), bfhi(xa.x)}; xf[1] = (f32x2){bflo(xa.y), bfhi(xa.y)}; xf[2] = (f32x2){bflo(xa.z), bfhi(xa.z)}; xf[3] = (f32x2){bflo(xa.w), bfhi(xa.w)};
        xf[4] = (f32x2){bflo(xb.x), bfhi(xb.x)}; xf[5] = (f32x2){bflo(xb.y), bfhi(xb.y)}; xf[6] = (f32x2){bflo(xb.z), bfhi(xb.z)}; xf[7] = (f32x2){bflo(xb.w), bfhi(xb.w)};
    }
    float* o = P.out + (size_t)t * DM + lane_o * 16;
    float4 h0, h1, h2, h3;
    {
        const float4 g0 = *(const float4*)(P.norm_ffn + lane_o * 16), g1 = *(const float4*)(P.norm_ffn + lane_o * 16 + 4), g2 = *(const float4*)(P.norm_ffn + lane_o * 16 + 8), g3 = *(const float4*)(P.norm_ffn + lane_o * 16 + 12);
        h0.x = xf[0].x * __builtin_amdgcn_rcpf(g0.x) + acc[0].x; h0.y = xf[0].y * __builtin_amdgcn_rcpf(g0.y) + acc[0].y; h0.z = xf[1].x * __builtin_amdgcn_rcpf(g0.z) + acc[1].x; h0.w = xf[1].y * __builtin_amdgcn_rcpf(g0.w) + acc[1].y;
        h1.x = xf[2].x * __builtin_amdgcn_rcpf(g1.x) + acc[2].x; h1.y = xf[2].y * __builtin_amdgcn_rcpf(g1.y) + acc[2].y; h1.z = xf[3].x * __builtin_amdgcn_rcpf(g1.z) + acc[3].x; h1.w = xf[3].y * __builtin_amdgcn_rcpf(g1.w) + acc[3].y;
        h2.x = xf[4].x * __builtin_amdgcn_rcpf(g2.x) + acc[4].x; h2.y = xf[4].y * __builtin_amdgcn_rcpf(g2.y) + acc[4].y; h2.z = xf[5].x * __builtin_amdgcn_rcpf(g2.z) + acc[5].x; h2.w = xf[5].y * __builtin_amdgcn_rcpf(g2.w) + acc[5].y;
        h3.x = xf[6].x * __builtin_amdgcn_rcpf(g3.x) + acc[6].x; h3.y = xf[6].y * __builtin_amdgcn_rcpf(g3.y) + acc[6].y; h3.z = xf[7].x * __builtin_amdgcn_rcpf(g3.z) + acc[7].x; h3.w = xf[7].y * __builtin_amdgcn_rcpf(g3.w) + acc[7].y;
    }
    *(float4*)(o) = h0; *(float4*)(o + 4) = h1; *(float4*)(o + 8) = h2; *(float4*)(o + 12) = h3;
    __builtin_amdgcn_s_waitcnt(0xc07f);
    __builtin_amdgcn_wave_barrier();
}

#define LAS __attribute__((address_space(3)))
#define XB_TMO      128
#define XB_XCNT(j)  (256  + 64 * (j))
#define XB_XSUB(j)  (1280 + 64 * (j))
#define XB_XGEN(j)  (2304 + 64 * (j))
#define XB_TOP      3328
#define XB_TOPGEN   3392
#define XCD_BAR_WORDS 3456
#define XB_SPIN_CAP (1u << 18)
__device__ __forceinline__ unsigned xb_ld(unsigned* p)              { return __hip_atomic_load(p, __ATOMIC_RELAXED, __HIP_MEMORY_SCOPE_AGENT); }
__device__ __forceinline__ unsigned xb_add(unsigned* p, unsigned v) { return __hip_atomic_fetch_add(p, v, __ATOMIC_RELAXED, __HIP_MEMORY_SCOPE_AGENT); }
__device__ __forceinline__ unsigned xb_xcc_id() { return (unsigned)__builtin_amdgcn_s_getreg((3 << 11) | 20) & 0xFu; }
#define XB_SPIN(cond, bar) do { unsigned _sp = 0; while (cond) { __builtin_amdgcn_s_sleep(1); \
    if ((++_sp & 255u) == 0u) { if (xb_ld(&(bar)[XB_TMO])) break; if (_sp > XB_SPIN_CAP) { atomicAdd(&(bar)[XB_TMO], 1u); break; } } } } while (0)
struct XcdBarrier { unsigned* bar; unsigned x; volatile LAS unsigned* st; };
__device__ __forceinline__ XcdBarrier xcd_barrier_post(unsigned* bar, volatile LAS unsigned* st) {
    XcdBarrier b; b.bar = bar; b.x = xb_xcc_id(); b.st = st;
    if (threadIdx.x == 0) (void)xb_add(&bar[XB_XCNT(b.x)], 1u);
    return b;
}
__device__ __forceinline__ void xcd_barrier_complete(unsigned* bar, unsigned x, unsigned& nloc, unsigned& nx) {
    const unsigned G = gridDim.x * gridDim.y * gridDim.z;
    unsigned sum, cnt, mine, sp = 0u;
    for (;;) {
        sum = 0u; cnt = 0u; mine = 0u;
#pragma unroll
        for (unsigned j = 0; j < 16; ++j) { const unsigned c = xb_ld(&bar[XB_XCNT(j)]); sum += c; cnt += (c > 0u) ? 1u : 0u; mine = (j == x) ? c : mine; }
        if (sum == G) break;
        __builtin_amdgcn_s_sleep(1);
        if ((++sp & 255u) == 0u) { if (xb_ld(&bar[XB_TMO])) break; if (sp > XB_SPIN_CAP) { atomicAdd(&bar[XB_TMO], 1u); break; } }
    }
    nloc = mine > 0u ? mine : 1u; nx = cnt > 0u ? cnt : 1u;
}
__device__ __forceinline__ void xcd_barrier(const XcdBarrier& b) {
    asm volatile("s_waitcnt vmcnt(0)" ::: "memory");
    __syncthreads();
    if (threadIdx.x == 0) {
        unsigned* bar = b.bar;
        __builtin_amdgcn_s_waitcnt(0);
        unsigned nloc = b.st[0], nx = b.st[1];
        if (nloc == 0u) { xcd_barrier_complete(bar, b.x, nloc, nx); b.st[0] = nloc; b.st[1] = nx; }
        const unsigned old = xb_add(&bar[XB_XSUB(b.x)], 1u);
        const unsigned gen = old / nloc;
        if (old + 1u == (gen + 1u) * nloc) {
            __builtin_amdgcn_fence(__ATOMIC_RELEASE, "agent");
            asm volatile("s_waitcnt vmcnt(0)" ::: "memory");
            const unsigned og = xb_add(&bar[XB_TOP], 1u);
            const unsigned tg = og / nx;
            if (og + 1u == (tg + 1u) * nx) xb_add(&bar[XB_TOPGEN], 1u);
            else XB_SPIN(xb_ld(&bar[XB_TOPGEN]) == tg, bar);
            __builtin_amdgcn_fence(__ATOMIC_ACQUIRE, "agent");
            xb_add(&bar[XB_XGEN(b.x)], 1u);
            asm volatile("s_waitcnt vmcnt(0)" ::: "memory");
        } else {
            XB_SPIN(xb_ld(&bar[XB_XGEN(b.x)]) == gen, bar);
            __builtin_amdgcn_fence(__ATOMIC_ACQUIRE, "agent");
            asm volatile("s_waitcnt vmcnt(0)" ::: "memory");
        }
    }
    __syncthreads();
}

__device__ __forceinline__ void hand_release() { asm volatile("s_waitcnt vmcnt(0)" ::: "memory"); __builtin_amdgcn_fence(__ATOMIC_RELEASE, "agent"); asm volatile("s_waitcnt vmcnt(0)" ::: "memory"); }
__device__ __forceinline__ void hand_acquire() { __builtin_amdgcn_fence(__ATOMIC_ACQUIRE, "agent"); asm volatile("s_waitcnt vmcnt(0)" ::: "memory"); }

__global__ void __launch_bounds__(256, 2) mega(Params P) {
    extern __shared__ __attribute__((aligned(16))) unsigned char smem[];
    const int tid = threadIdx.x, lane = tid & 63, wave = tid >> 6;
    const int G = gridDim.x, bid = blockIdx.x;
    unsigned* ctl = (unsigned*)(P.ws + WS_CTL);
    volatile LAS unsigned* bst = (volatile LAS unsigned*)(smem + 65552);
    if (tid == 0) { bst[0] = 0u; bst[1] = 0u; }
    __syncthreads();
    const XcdBarrier xb = xcd_barrier_post(ctl + 1024, bst);
    unsigned* cucnt = ctl + 5120;
    if (tid == 0) {
        const unsigned phys = ((xb_xcc_id() & 7u) << 8) | ((unsigned)__builtin_amdgcn_s_getreg((7 << 11) | (8 << 6) | 4) & 0xFFu);
        bst[2] = phys; bst[3] = xb_add(&cucnt[phys], 1u);
    }
    phase0(P, smem);
    xcd_barrier(xb);
    {
        int vb;
        const unsigned phys = bst[2];
        unsigned part = 0;
#pragma unroll
        for (int q = 0; q < 8; ++q) { const unsigned i = (unsigned)(tid + 256 * q); const unsigned c = xb_ld(&cucnt[i]); part += (i < phys) ? c : 0u; }
#pragma unroll
        for (int o = 1; o < 64; o <<= 1) part += (unsigned)__shfl_xor((int)part, o, 64);
        if (lane == 0) bst[4 + wave] = part;
        __syncthreads();
        vb = (int)(bst[4] + bst[5] + bst[6] + bst[7] + bst[3]);
        vb = __builtin_amdgcn_readfirstlane(vb);
        if (vb < 0 || vb >= G) vb = bid;
        __syncthreads();
        if (tid == 0) bst[8] = (unsigned)vb;
        __syncthreads();
    }
#define VB_LOAD() __builtin_amdgcn_readfirstlane((int)bst[8])
    {
        const int gw = bid * 4 + wave;
        if (gw < 64) fox_cum_wave(P, gw, lane);
        const int vb = VB_LOAD();
        for (int tile = vb; tile < 129 * 28; tile += G) gemm_tile<1>(P, tile / 28, tile % 28, smem);
        {
            const int rem = (129 * 28) % G;
            if (rem > 0 && rem < G) { if (vb >= rem) convert_uv_rows(P, (vb - rem) * 4 + wave, (G - rem) * 4, lane); }
            else convert_uv_rows(P, vb * 4 + wave, G * 4, lane);
        }
    }
    xcd_barrier(xb);
    {
        volatile int* s_item = (volatile int*)(smem + 65536);
        const int wave_u = __builtin_amdgcn_readfirstlane(wave);
        auto fetch = [&](unsigned* counter) -> int {
            if (wave_u == 0) {
                unsigned v = atomicAdd(counter, lane == 0 ? 1u : 0u);
                *s_item = (int)__builtin_amdgcn_readfirstlane(v);
            }
            __syncthreads();
            const int item = __builtin_amdgcn_readfirstlane(*s_item);
            __syncthreads();
            return item;
        };
#define RUN_QUEUE(COUNTER, NITEMS, BODY) { \
            int item = bid; \
            while (item < (NITEMS)) { \
                unsigned nxt_ = 0u; \
                if (wave_u == 0) nxt_ = atomicAdd((COUNTER), lane == 0 ? 1u : 0u); \
                BODY; \
                if (wave_u == 0) *s_item = (int)__builtin_amdgcn_readfirstlane(nxt_) + G; \
                __syncthreads(); \
                item = __builtin_amdgcn_readfirstlane(*s_item); \
                __syncthreads(); \
            } }
        RUN_QUEUE(&ctl[2], 33 * 32, mlstm_A(P, item, smem))
        xcd_barrier(xb);
        RUN_QUEUE(&ctl[4], 96, mlstm_B(P, item))
        RUN_QUEUE(&ctl[3], 64 * 17, attn_block(P, item & 63, 16 - (item >> 6), smem))
        xcd_barrier(xb);
        RUN_QUEUE(&ctl[5], 33 * 32, mlstm_C(P, item, smem))
#undef RUN_QUEUE
    }
    xcd_barrier(xb);
    for (int tile = VB_LOAD(); tile < 128 * 8; tile += G) gemm_tile<2>(P, tile >> 3, tile & 7, smem);
    xcd_barrier(xb);
    for (int tile = VB_LOAD(); tile < 128 * 16; tile += G) gemm_tile<3>(P, tile >> 4, tile & 15, smem);
    xcd_barrier(xb);
    {
        unsigned char* slut = smem + 12288;
        if (tid < 64) {
            int c = tid, i = 0;
            while (i < 16 && c >= 16 / (i + 1)) { c -= 16 / (i + 1); ++i; }
            slut[tid] = (unsigned char)(i < 16 ? ((i << 4) | c) : 0);
        }
        unsigned* szero = (unsigned*)(smem + 12288 + 64);
        if (tid < 16) szero[tid] = 0u;
        __syncthreads();
        int* sidx = (int*)(smem + wave * 3072); float* sval = (float*)(smem + wave * 3072 + 1024);
        int* sid = (int*)(smem + wave * 3072 + 2048); float* sgate = (float*)(smem + wave * 3072 + 2560);
        int lane5 = lane;
        asm volatile("" : "+v"(lane5));
        {
            int t = bid * 4 + wave;
            uint4 tkw = *(const uint4*)((const unsigned*)(P.ws + WS_TK) + (size_t)(t < T2 ? t : 0) * 256 + lane5 * 4);
            for (; t < T2; t += G * 4) { const int tn = t + G * 4; peer_token(P, t, tn < T2 ? tn : t, tkw, lane5, sidx, sval, sid, sgate, slut, szero); }
        }
    }
}

}

extern "C" void kernel_launch(void* const* d_in, const int* in_sizes, int n_in, void* d_out, int out_size, void* d_ws, size_t ws_size, hipStream_t stream) {
    if (n_in != 17 || ws_size < WS_END) { fprintf(stderr, "kernel_launch: unexpected n_in %d or ws_size %zu (need %zu)\n", n_in, ws_size, (size_t)WS_END); return; }
    constexpr int LDS_BYTES = 66560;
    static int grid_blocks = 0;
    if (!grid_blocks) {
        int dev = 0, cus = 0, per_cu = 0;
        (void)hipGetDevice(&dev);
        (void)hipDeviceGetAttribute(&cus, hipDeviceAttributeMultiprocessorCount, dev);
        (void)hipFuncSetAttribute((const void*)mega, hipFuncAttributeMaxDynamicSharedMemorySize, LDS_BYTES);
        (void)hipOccupancyMaxActiveBlocksPerMultiprocessor(&per_cu, (const void*)mega, 256, LDS_BYTES);
        if (per_cu < 1) per_cu = 1;
        if (per_cu > 2) per_cu = 2;
        grid_blocks = cus * per_cu;
        fprintf(stderr, "kernel_launch: cus %d per_cu %d grid %d\n", cus, per_cu, grid_blocks);
    }
    Params P{};
    P.x = (const float*)d_in[0]; P.meta = (const float*)d_in[1]; P.norm_mix = (const float*)d_in[2]; P.w_in = (const float*)d_in[3];
    P.conv_qk = (const float*)d_in[4]; P.b_igate = (const float*)d_in[5]; P.b_fgate_m = (const float*)d_in[6]; P.m_out_norm = (const float*)d_in[7];
    P.b_fgate_f = (const float*)d_in[8]; P.f_q_norm = (const float*)d_in[9]; P.f_k_norm = (const float*)d_in[10]; P.w_out = (const float*)d_in[11];
    P.norm_ffn = (const float*)d_in[12]; P.peer_query = (const float*)d_in[13]; P.peer_keys = (const float*)d_in[14]; P.peer_u = (const float*)d_in[15];
    P.peer_v = (const float*)d_in[16]; P.out = (float*)d_out; P.ws = (unsigned char*)d_ws;
    (void)hipMemsetAsync((unsigned char*)d_ws + WS_CTL, 0, 32768, stream);
    void* args[] = {&P};
    hipError_t e = hipLaunchCooperativeKernel((const void*)mega, dim3(grid_blocks), dim3(256), args, LDS_BYTES, stream);
    if (e != hipSuccess) fprintf(stderr, "cooperative launch failed: %s (grid %d)\n", hipGetErrorString(e), grid_blocks);
}
```

```cpp
#include <hip/hip_runtime.h>
#include <stdint.h>
#include <stdio.h>
#include <hip/hip_cooperative_groups.h>
namespace cg = cooperative_groups;

namespace {

constexpr int NB = 8, SEQ = 2048, DM = 1024, NMETA = 16, L = SEQ + NMETA;
constexpr int T1 = NB * L;
constexpr int T2 = NB * SEQ;
constexpr int NZ = 3584;
constexpr int ZC_MQ = 0, ZC_MK = 512, ZC_MV = 1024, ZC_MO = 1536, ZC_FQ = 2048, ZC_FK = 2560, ZC_FV = 3072;
constexpr int PROJ = 3600;
constexpr float EPS = 1e-6f;

constexpr size_t WS_CTL = 0;
constexpr size_t WS_RA = 65536;
constexpr size_t WS_Z = WS_RA + (size_t)T1 * DM * 2;
constexpr size_t WS_GATES = WS_Z + (size_t)T1 * NZ * 2;
constexpr size_t WS_CUM = WS_GATES + (size_t)T1 * 16 * 4;
constexpr size_t WS_SSQ = WS_CUM + (size_t)NB * 8 * L * 4;
constexpr size_t WS_RSTD = WS_SSQ + (size_t)T2 * 16 * 4;
constexpr size_t WS_SSQM = WS_RSTD + (size_t)T2 * 4;
constexpr size_t WS_BT2 = WS_SSQM + (size_t)T1 * 16 * 4;
constexpr size_t WS_BT3 = WS_BT2 + (size_t)DM * DM * 2;
constexpr size_t WS_KEYS = WS_BT3 + (size_t)2048 * DM * 2;
constexpr size_t WS_MSC = WS_KEYS + (size_t)16 * 128 * 128 * 2;
constexpr size_t WS_MST = WS_MSC + (size_t)128 * 33 * 16;
constexpr size_t WS_BT1 = WS_MST + (size_t)32 * 33 * 36864;
constexpr size_t WS_CBI = WS_BT1;
constexpr size_t WS_UV = WS_CBI + (size_t)32 * 33 * 36864;
constexpr size_t WS_END = WS_UV + (size_t)2 * 16384 * 512 + (size_t)2 * 16384 * 4;
constexpr size_t WS_XN = WS_RA;
constexpr size_t WS_U = WS_UV;
constexpr size_t WS_V = WS_U + (size_t)16384 * 512;
constexpr size_t WS_USC = WS_V + (size_t)16384 * 512;
constexpr size_t WS_VSC = WS_USC + (size_t)16384 * 4;
constexpr size_t WS_TK = WS_CBI;
constexpr float LOG2E = 1.4426950408889634f;

typedef unsigned short bf16_t;
typedef short bf16x8 __attribute__((ext_vector_type(8)));
typedef float f32x4 __attribute__((ext_vector_type(4)));
typedef __attribute__((ext_vector_type(2))) __bf16 bf16x2_t;

struct Params {
    const float* x; const float* meta; const float* norm_mix; const float* w_in; const float* conv_qk;
    const float* b_igate; const float* b_fgate_m; const float* m_out_norm; const float* b_fgate_f;
    const float* f_q_norm; const float* f_k_norm; const float* w_out; const float* norm_ffn;
    const float* peer_query; const float* peer_keys; const float* peer_u; const float* peer_v;
    float* out; unsigned char* ws;
};

__device__ __forceinline__ unsigned f2bf(float f) { unsigned u = __float_as_uint(f); return (u + 0x7fffu + ((u >> 16) & 1u)) >> 16; }
__device__ __forceinline__ float bf2f(unsigned h) { return __uint_as_float(h << 16); }
typedef float f32x2 __attribute__((ext_vector_type(2)));
typedef __bf16 bf16x2v __attribute__((ext_vector_type(2)));
__device__ __forceinline__ unsigned cvt_pk_bf16(float lo, float hi) { f32x2 v = {lo, hi}; bf16x2v b = __builtin_convertvector(v, bf16x2v); return __builtin_bit_cast(unsigned, b); }
__device__ __forceinline__ unsigned pk2(float lo, float hi) { return cvt_pk_bf16(lo, hi); }
__device__ __forceinline__ float bflo(unsigned w) { return __uint_as_float(w << 16); }
__device__ __forceinline__ float bfhi(unsigned w) { return __uint_as_float(w & 0xffff0000u); }
__device__ __forceinline__ float wave_sum(float v) {
#pragma unroll
    for (int o = 32; o > 0; o >>= 1) v += __shfl_xor(v, o, 64);
    return v;
}
__device__ __forceinline__ float wave_max(float v) {
#pragma unroll
    for (int o = 32; o > 0; o >>= 1) v = fmaxf(v, __shfl_xor(v, o, 64));
    return v;
}
__device__ __forceinline__ float logsigmoidf(float x) { return fminf(x, 0.f) - log1pf(expf(-fabsf(x))); }
__device__ __forceinline__ unsigned ord_key(float f) { unsigned u = __float_as_uint(f); return u ^ ((u >> 31) ? 0xffffffffu : 0x80000000u); }
__device__ __forceinline__ float unord_key(unsigned k) { unsigned u = (k & 0x80000000u) ? (k ^ 0x80000000u) : ~k; return __uint_as_float(u); }

__device__ __forceinline__ void prod_job(const Params& P, int hp, int kt8, unsigned char* smem);
__device__ __forceinline__ void phase0(const Params& P, unsigned char* smem) {
    const int tid = threadIdx.x, lane = tid & 63, wave = tid >> 6;
    unsigned* ctl = (unsigned*)(P.ws + WS_CTL);
    float* gw = (float*)smem;
    for (int idx = tid; idx < 16 * 1024; idx += 256) {
        const int k = idx >> 4, c = idx & 15;
        const int col = c < 8 ? 2048 + c : 3592 + (c - 8);
        gw[c * 1024 + k] = P.w_in[(size_t)k * PROJ + col];
    }
    __syncthreads();
    {
        bf16_t* hn = (bf16_t*)(P.ws + WS_RA);
        float* gates = (float*)(P.ws + WS_GATES);
        const int c0 = lane * 8, c1 = 512 + lane * 8;
        float gm[16];
        {
            const float4 a0 = *(const float4*)(P.norm_mix + c0), a1 = *(const float4*)(P.norm_mix + c0 + 4);
            const float4 a2 = *(const float4*)(P.norm_mix + c1), a3 = *(const float4*)(P.norm_mix + c1 + 4);
            gm[0] = a0.x; gm[1] = a0.y; gm[2] = a0.z; gm[3] = a0.w; gm[4] = a1.x; gm[5] = a1.y; gm[6] = a1.z; gm[7] = a1.w;
            gm[8] = a2.x; gm[9] = a2.y; gm[10] = a2.z; gm[11] = a2.w; gm[12] = a3.x; gm[13] = a3.y; gm[14] = a3.z; gm[15] = a3.w;
        }
        const int myq = ((lane >> 5) & 1) * 8 + ((lane >> 4) & 1) * 4 + ((lane >> 3) & 1) * 2 + ((lane >> 2) & 1);
        const float mybias = myq < 4 ? P.b_igate[myq] : (myq < 8 ? P.b_fgate_m[myq - 4] : P.b_fgate_f[myq - 8]);
        const int rstep = gridDim.x * 4;
        int r = blockIdx.x * 4 + wave;
        float4 n0, n1, n2, n3;
        auto load_row = [&](int rr) {
            const int b = rr / L, p = rr - b * L;
            const float* src = (p < NMETA) ? (P.meta + (size_t)p * DM) : (P.x + ((size_t)b * SEQ + (p - NMETA)) * DM);
            n0 = *(const float4*)(src + c0); n1 = *(const float4*)(src + c0 + 4); n2 = *(const float4*)(src + c1); n3 = *(const float4*)(src + c1 + 4);
        };
        if (r < T1) load_row(r);
        for (; r < T1; r += rstep) {
            float v[16];
            v[0] = n0.x; v[1] = n0.y; v[2] = n0.z; v[3] = n0.w; v[4] = n1.x; v[5] = n1.y; v[6] = n1.z; v[7] = n1.w;
            v[8] = n2.x; v[9] = n2.y; v[10] = n2.z; v[11] = n2.w; v[12] = n3.x; v[13] = n3.y; v[14] = n3.z; v[15] = n3.w;
            if (r + rstep < T1) load_row(r + rstep);
            float ss = 0.f;
#pragma unroll
            for (int j = 0; j < 16; ++j) ss += v[j] * v[j];
            ss = wave_sum(ss);
            const float rstd = rsqrtf(ss * (1.0f / DM) + EPS);
#pragma unroll
            for (int j = 0; j < 16; ++j) v[j] *= rstd * gm[j];
            uint4 o0, o1;
            o0.x = pk2(v[0], v[1]); o0.y = pk2(v[2], v[3]); o0.z = pk2(v[4], v[5]); o0.w = pk2(v[6], v[7]);
            o1.x = pk2(v[8], v[9]); o1.y = pk2(v[10], v[11]); o1.z = pk2(v[12], v[13]); o1.w = pk2(v[14], v[15]);
            *(uint4*)(hn + (size_t)r * DM + c0) = o0;
            *(uint4*)(hn + (size_t)r * DM + c1) = o1;
            float r8[8], r4[4], r2[2], r1;
#pragma unroll
            for (int i = 0; i < 8; ++i) {
                float dd[2];
#pragma unroll
                for (int hh = 0; hh < 2; ++hh) {
                    const float* gwc = gw + (i + 8 * hh) * 1024;
                    const float4 w0 = *(const float4*)(gwc + c0), w1 = *(const float4*)(gwc + c0 + 4), w2 = *(const float4*)(gwc + c1), w3 = *(const float4*)(gwc + c1 + 4);
                    dd[hh] = v[0] * w0.x + v[1] * w0.y + v[2] * w0.z + v[3] * w0.w + v[4] * w1.x + v[5] * w1.y + v[6] * w1.z + v[7] * w1.w
                           + v[8] * w2.x + v[9] * w2.y + v[10] * w2.z + v[11] * w2.w + v[12] * w3.x + v[13] * w3.y + v[14] * w3.z + v[15] * w3.w;
                }
                const bool up = (lane & 32) != 0; const float keep = up ? dd[1] : dd[0], send = up ? dd[0] : dd[1];
                r8[i] = keep + __shfl_xor(send, 32, 64);
                __builtin_amdgcn_sched_barrier(0);
            }
#pragma unroll
            for (int i = 0; i < 4; ++i) { const bool up = (lane & 16) != 0; const float keep = up ? r8[i + 4] : r8[i], send = up ? r8[i] : r8[i + 4]; r4[i] = keep + __shfl_xor(send, 16, 64); }
#pragma unroll
            for (int i = 0; i < 2; ++i) { const bool up = (lane & 8) != 0; const float keep = up ? r4[i + 2] : r4[i], send = up ? r4[i] : r4[i + 2]; r2[i] = keep + __shfl_xor(send, 8, 64); }
            { const bool up = (lane & 4) != 0; const float keep = up ? r2[1] : r2[0], send = up ? r2[0] : r2[1]; r1 = keep + __shfl_xor(send, 4, 64); }
            r1 += __shfl_xor(r1, 2, 64); r1 += __shfl_xor(r1, 1, 64);
            if ((lane & 3) == 0) {
                const float pre = r1 + mybias;
                gates[(size_t)r * 16 + myq] = myq < 4 ? pre : logsigmoidf(pre);
            }
        }
    }
    __syncthreads();
    {
        float* tile = (float*)smem;
        for (int item = blockIdx.x; item < 1152; item += gridDim.x) {
            const float* W; int ldn, ntn, shift_from, it; bf16_t* out;
            if (item < 896) { W = P.w_in; ldn = PROJ; ntn = 56; shift_from = 2048; it = item; out = (bf16_t*)(P.ws + WS_BT1); }
            else { W = P.w_out; ldn = 1024; ntn = 16; shift_from = 1 << 30; it = item - 896; out = (bf16_t*)(P.ws + WS_BT2); }
            const int tk = it / ntn, tn = it - tk * ntn, k0 = tk * 64, n0 = tn * 64;
            {
                const int n4 = (tid & 15) * 4, kr = tid >> 4;
                int n = n0 + n4; if (n >= shift_from) n += 8;
                float4 v[4];
#pragma unroll
                for (int i = 0; i < 4; ++i) v[i] = *(const float4*)(W + (size_t)(k0 + kr + 16 * i) * ldn + n);
#pragma unroll
                for (int i = 0; i < 4; ++i) *(float4*)(tile + (kr + 16 * i) * 68 + n4) = v[i];
            }
            __syncthreads();
            {
#pragma unroll
                for (int i = 0; i < 2; ++i) {
                    const int id = tid + 256 * i, nl = id & 63, kc = id >> 6;
                    const float* tp = tile + (kc * 8) * 68 + nl;
                    uint4 o;
                    o.x = pk2(tp[0], tp[68]); o.y = pk2(tp[2 * 68], tp[3 * 68]); o.z = pk2(tp[4 * 68], tp[5 * 68]); o.w = pk2(tp[6 * 68], tp[7 * 68]);
                    *(uint4*)(out + (size_t)(n0 + nl) * 1024 + k0 + kc * 8) = o;
                }
            }
            __syncthreads();
        }
    }
    for (int job = blockIdx.x; job < 128; job += gridDim.x) prod_job(P, job >> 3, job & 7, smem);
}

__device__ __forceinline__ void convert_uv_rows(const Params& P, int gwave, int nwaves, int lane) {
    for (int rr0 = gwave * 4; rr0 < 2 * 16384; rr0 += nwaves * 4) {
        float4 a[4][4];
#pragma unroll
        for (int q = 0; q < 4; ++q) {
            const int rr = rr0 + q, which = rr >> 14, row = rr & 16383;
            const float* src = (which ? P.peer_v : P.peer_u) + (size_t)row * DM + lane * 16;
            a[q][0] = *(const float4*)(src); a[q][1] = *(const float4*)(src + 4); a[q][2] = *(const float4*)(src + 8); a[q][3] = *(const float4*)(src + 12);
        }
#pragma unroll
        for (int q = 0; q < 4; ++q) {
            const int rr = rr0 + q, which = rr >> 14, row = rr & 16383;
            float mx = 0.f;
#pragma unroll
            for (int j = 0; j < 4; ++j) mx = fmaxf(mx, fmaxf(fmaxf(fabsf(a[q][j].x), fabsf(a[q][j].y)), fmaxf(fabsf(a[q][j].z), fabsf(a[q][j].w))));
            mx = wave_max(mx);
            const float sc = mx > 0.f ? 6.0f / mx : 1.0f;
            unsigned w0 = 0u, w1 = 0u;
            w0 = __builtin_amdgcn_cvt_scalef32_pk_fp4_f32(w0, a[q][0].x * sc, a[q][0].y * sc, 1.0f, 0); w0 = __builtin_amdgcn_cvt_scalef32_pk_fp4_f32(w0, a[q][0].z * sc, a[q][0].w * sc, 1.0f, 1);
            w0 = __builtin_amdgcn_cvt_scalef32_pk_fp4_f32(w0, a[q][1].x * sc, a[q][1].y * sc, 1.0f, 2); w0 = __builtin_amdgcn_cvt_scalef32_pk_fp4_f32(w0, a[q][1].z * sc, a[q][1].w * sc, 1.0f, 3);
            w1 = __builtin_amdgcn_cvt_scalef32_pk_fp4_f32(w1, a[q][2].x * sc, a[q][2].y * sc, 1.0f, 0); w1 = __builtin_amdgcn_cvt_scalef32_pk_fp4_f32(w1, a[q][2].z * sc, a[q][2].w * sc, 1.0f, 1);
            w1 = __builtin_amdgcn_cvt_scalef32_pk_fp4_f32(w1, a[q][3].x * sc, a[q][3].y * sc, 1.0f, 2); w1 = __builtin_amdgcn_cvt_scalef32_pk_fp4_f32(w1, a[q][3].z * sc, a[q][3].w * sc, 1.0f, 3);
            *(uint2*)(P.ws + (which ? WS_V : WS_U) + (size_t)row * 512 + lane * 8) = make_uint2(w0, w1);
            if (lane == 0) ((float*)(P.ws + (which ? WS_VSC : WS_USC)))[row] = mx > 0.f ? mx * (1.0f / 6.0f) : 1.0f;
        }
    }
}

__device__ __forceinline__ void bitonic_sort16_desc(unsigned (&v)[16]) {
#pragma unroll
    for (int k = 2; k <= 16; k <<= 1)
#pragma unroll
        for (int j = k >> 1; j >= 1; j >>= 1)
#pragma unroll
            for (int i = 0; i < 16; ++i)
                if ((i & j) == 0) {
                    const int p = i | j;
                    const bool desc = (k >= 16) ? true : ((i & k) == 0);
                    const unsigned hi = max(v[i], v[p]), lo = min(v[i], v[p]);
                    v[i] = desc ? hi : lo; v[p] = desc ? lo : hi;
                }
}
__device__ __forceinline__ void bitonic_merge16_top(unsigned (&a)[16], const unsigned (&b)[16]) {
#pragma unroll
    for (int i = 0; i < 16; ++i) a[i] = max(a[i], b[15 - i]);
#pragma unroll
    for (int j = 8; j >= 1; j >>= 1)
#pragma unroll
        for (int i = 0; i < 16; ++i)
            if ((i & j) == 0) { const int p = i | j; const unsigned hi = max(a[i], a[p]), lo = min(a[i], a[p]); a[i] = hi; a[p] = lo; }
}

__device__ __forceinline__ float x4_max(float x) {
    const unsigned xi = __float_as_uint(x);
    const auto r = __builtin_amdgcn_permlane32_swap(xi, xi, false, false);
    const float m = fmaxf(__uint_as_float(r[0]), __uint_as_float(r[1]));
    const unsigned mi = __float_as_uint(m);
    const auto r2 = __builtin_amdgcn_permlane16_swap(mi, mi, false, false);
    return fmaxf(__uint_as_float(r2[0]), __uint_as_float(r2[1]));
}
__device__ __forceinline__ float x4_sum(float x) {
    const unsigned xi = __float_as_uint(x);
    const auto r = __builtin_amdgcn_permlane32_swap(xi, xi, false, false);
    const float m = __uint_as_float(r[0]) + __uint_as_float(r[1]);
    const unsigned mi = __float_as_uint(m);
    const auto r2 = __builtin_amdgcn_permlane16_swap(mi, mi, false, false);
    return __uint_as_float(r2[0]) + __uint_as_float(r2[1]);
}

__device__ __forceinline__ int opaque_tid() { int t = threadIdx.x; asm volatile("" : "+v"(t)); return t; }

__device__ __forceinline__ void mma_ktile(const unsigned char* sA, const unsigned char* sB, int arow_off, int brow_off, int g, int sw, f32x4 (&acc)[4][4]) {
#pragma unroll
    for (int s = 0; s < 2; ++s) {
        bf16x8 a[4], b[4];
        const int ch = (((s * 4 + g) ^ sw) << 4);
#pragma unroll
        for (int i = 0; i < 4; ++i) a[i] = *(const bf16x8*)(sA + arow_off + i * 2048 + ch);
#pragma unroll
        for (int j = 0; j < 4; ++j) b[j] = *(const bf16x8*)(sB + brow_off + j * 2048 + ch);
#pragma unroll
        for (int i = 0; i < 4; ++i)
#pragma unroll
            for (int j = 0; j < 4; ++j) acc[i][j] = __builtin_amdgcn_mfma_f32_16x16x32_bf16(b[j], a[i], acc[i][j], 0, 0, 0);
    }
}

__device__ __forceinline__ void store_tile_bf16(const f32x4 (&acc)[4][4], unsigned char* smem, bf16_t* dst, size_t ld, int m0, int n0, int tid, int wr, int wc, int g, int lr) {
#pragma unroll
    for (int i = 0; i < 4; ++i)
#pragma unroll
        for (int j = 0; j < 4; ++j) {
            const int row = wr * 64 + 16 * i + lr, col = wc * 64 + 16 * j + 4 * g;
            uint2 w; w.x = pk2(acc[i][j][0], acc[i][j][1]); w.y = pk2(acc[i][j][2], acc[i][j][3]);
            *(uint2*)(smem + row * 272 + col * 2) = w;
        }
    __syncthreads();
#pragma unroll
    for (int q = 0; q < 8; ++q) {
        const int id = tid + 256 * q, row = id >> 4, ch = id & 15;
        const uint4 v = *(const uint4*)(smem + row * 272 + ch * 16);
        *(uint4*)(dst + (size_t)(m0 + row) * ld + n0 + ch * 8) = v;
    }
    __syncthreads();
}

__device__ __forceinline__ void prod_job(const Params& P, int hp, int kt8, unsigned char* smem) {
    const int tid = opaque_tid(), lane = tid & 63, wave = tid >> 6, wr = wave >> 1, wc = wave & 1, g = lane >> 4, lr = lane & 15;
    const int srow = tid >> 3, sc = tid & 7;
    unsigned char* sA0 = smem; unsigned char* sB0 = smem + 16384; unsigned char* sA1 = smem + 32768; unsigned char* sB1 = smem + 49152;
    const int soff0 = srow * 128 + ((sc ^ (srow & 7)) << 4);
    const float* Ak = P.peer_keys + (size_t)hp * 128 * 128 + (size_t)srow * 128 + sc * 8;
    const float* Bq = P.peer_query + (size_t)(kt8 * 128 + srow) * 2048 + hp * 128 + sc * 8;
#pragma unroll
    for (int j = 0; j < 4; ++j) {
#pragma unroll
        for (int hk = 0; hk < 2; ++hk) {
            const float4 a0 = *(const float4*)(Ak + (size_t)(32 * j) * 128 + 64 * hk), a1 = *(const float4*)(Ak + (size_t)(32 * j) * 128 + 64 * hk + 4);
            const float4 b0 = *(const float4*)(Bq + (size_t)(32 * j) * 2048 + 64 * hk), b1 = *(const float4*)(Bq + (size_t)(32 * j) * 2048 + 64 * hk + 4);
            uint4 ua, ub;
            ua.x = pk2(a0.x, a0.y); ua.y = pk2(a0.z, a0.w); ua.z = pk2(a1.x, a1.y); ua.w = pk2(a1.z, a1.w);
            ub.x = pk2(b0.x, b0.y); ub.y = pk2(b0.z, b0.w); ub.z = pk2(b1.x, b1.y); ub.w = pk2(b1.z, b1.w);
            *(uint4*)((hk ? sA1 : sA0) + soff0 + j * 4096) = ua;
            *(uint4*)((hk ? sB1 : sB0) + soff0 + j * 4096) = ub;
        }
    }
    __syncthreads();
    f32x4 acc[4][4];
#pragma unroll
    for (int i = 0; i < 4; ++i)
#pragma unroll
        for (int j = 0; j < 4; ++j) acc[i][j] = (f32x4){0.f, 0.f, 0.f, 0.f};
    const int arow_off = (wr * 64 + lr) * 128, brow_off = (wc * 64 + lr) * 128, sw = lr & 7;
    mma_ktile(sA0, sB0, arow_off, brow_off, g, sw, acc);
    mma_ktile(sA1, sB1, arow_off, brow_off, g, sw, acc);
    __syncthreads();
    store_tile_bf16(acc, smem, (bf16_t*)(P.ws + WS_BT3), 1024, hp * 128, kt8 * 128, tid, wr, wc, g, lr);
}

template <int MODE>
__device__ __forceinline__ void gemm_tile(const Params& P, int tm, int tn, unsigned char* smem) {
    const bf16_t* A; const bf16_t* Bt;
    if (MODE == 1) { A = (const bf16_t*)(P.ws + WS_RA); Bt = (const bf16_t*)(P.ws + WS_BT1); }
    else if (MODE == 2) { A = (const bf16_t*)(P.ws + WS_Z); Bt = (const bf16_t*)(P.ws + WS_BT2); }
    else { A = (const bf16_t*)(P.ws + WS_XN); Bt = (const bf16_t*)(P.ws + WS_BT3); }
    const int tid = opaque_tid(), lane = tid & 63, wave = tid >> 6, wr = wave >> 1, wc = wave & 1, g = lane >> 4, lr = lane & 15;
    const int m0 = tm * 128, n0 = tn * 128;
    const int srow = tid >> 3, sc = tid & 7;
    constexpr unsigned LDA = (MODE == 2 ? NZ : 1024) * 2u;
    unsigned aoff, boff; int soff0;
    {
        int ar = m0 + srow;
        if (MODE == 2) { const int b = ar >> 11, t = ar & 2047; ar = b * L + NMETA + t; }
        aoff = (unsigned)ar * LDA + (unsigned)sc * 16u;
        boff = (unsigned)(n0 + srow) * 2048u + (unsigned)sc * 16u;
        soff0 = srow * 128 + ((sc ^ (srow & 7)) << 4);
    }
    const unsigned char* Ab = (const unsigned char*)A; const unsigned char* Bb = (const unsigned char*)Bt;
    float4 ssp0, ssp1, ssp2, ssp3;
    if (MODE == 3) {
        const float* ssq = (const float*)(P.ws + WS_SSQ) + (size_t)(m0 + wr * 64 + lr) * 16 + 4 * g;
        ssp0 = *(const float4*)(ssq); ssp1 = *(const float4*)(ssq + 16 * 16); ssp2 = *(const float4*)(ssq + 32 * 16); ssp3 = *(const float4*)(ssq + 48 * 16);
    }
    f32x4 acc[4][4];
#pragma unroll
    for (int i = 0; i < 4; ++i)
#pragma unroll
        for (int j = 0; j < 4; ++j) acc[i][j] = (f32x4){0.f, 0.f, 0.f, 0.f};
    uint4 ra0, ra1, ra2, ra3, rb0, rb1, rb2, rb3;
#define G_LOAD(KT) { const unsigned ko = (unsigned)(KT) * 128u; \
        ra0 = *(const uint4*)(Ab + (aoff + ko)); ra1 = *(const uint4*)(Ab + (aoff + 32u * LDA + ko)); ra2 = *(const uint4*)(Ab + (aoff + 64u * LDA + ko)); ra3 = *(const uint4*)(Ab + (aoff + 96u * LDA + ko)); \
        rb0 = *(const uint4*)(Bb + (boff + ko)); rb1 = *(const uint4*)(Bb + (boff + 32u * 2048u + ko)); rb2 = *(const uint4*)(Bb + (boff + 64u * 2048u + ko)); rb3 = *(const uint4*)(Bb + (boff + 96u * 2048u + ko)); }
#define G_WRITE(SA, SB) { *(uint4*)((SA) + soff0) = ra0; *(uint4*)((SA) + soff0 + 4096) = ra1; *(uint4*)((SA) + soff0 + 8192) = ra2; *(uint4*)((SA) + soff0 + 12288) = ra3; \
        *(uint4*)((SB) + soff0) = rb0; *(uint4*)((SB) + soff0 + 4096) = rb1; *(uint4*)((SB) + soff0 + 8192) = rb2; *(uint4*)((SB) + soff0 + 12288) = rb3; }
    unsigned char* sA0 = smem; unsigned char* sB0 = smem + 16384; unsigned char* sA1 = smem + 32768; unsigned char* sB1 = smem + 49152;
    G_LOAD(0)
    G_WRITE(sA0, sB0)
    __syncthreads();
    const int arow_off = (wr * 64 + lr) * 128, brow_off = (wc * 64 + lr) * 128, sw = lr & 7;
    G_LOAD(1)
    for (int kt = 0; kt < 16; ++kt) {
        unsigned char* sA = (kt & 1) ? sA1 : sA0; unsigned char* sB = (kt & 1) ? sB1 : sB0;
        unsigned char* nA = (kt & 1) ? sA0 : sA1; unsigned char* nB = (kt & 1) ? sB0 : sB1;
        bf16x8 fa[4], fb[4], ga[4], gb[4];
        const int ch0 = ((g ^ sw) << 4), ch1 = (((4 + g) ^ sw) << 4);
        const unsigned ko = (unsigned)(kt + 2) * 128u;
        const bool wr_ok = kt < 15, ld_ok = kt < 14;
#pragma unroll
        for (int i = 0; i < 4; ++i) { fa[i] = *(const bf16x8*)(sA + arow_off + i * 2048 + ch0); fb[i] = *(const bf16x8*)(sB + brow_off + i * 2048 + ch0); }
        __builtin_amdgcn_sched_barrier(0);
        __builtin_amdgcn_s_setprio(2);
        if (wr_ok) *(uint4*)(nA + soff0) = ra0;
        if (ld_ok) ra0 = *(const uint4*)(Ab + (aoff + 0u * LDA + ko));
        ga[0] = *(const bf16x8*)(sA + arow_off + 0 * 2048 + ch1); gb[0] = *(const bf16x8*)(sB + brow_off + 0 * 2048 + ch1);
        __builtin_amdgcn_sched_barrier(0);
#pragma unroll
        for (int j = 0; j < 4; ++j) acc[0][j] = __builtin_amdgcn_mfma_f32_16x16x32_bf16(fb[j], fa[0], acc[0][j], 0, 0, 0);
        __builtin_amdgcn_sched_barrier(0);
        if (wr_ok) *(uint4*)(nA + soff0 + 4096) = ra1;
        if (ld_ok) ra1 = *(const uint4*)(Ab + (aoff + 32u * LDA + ko));
        ga[1] = *(const bf16x8*)(sA + arow_off + 1 * 2048 + ch1); gb[1] = *(const bf16x8*)(sB + brow_off + 1 * 2048 + ch1);
        __builtin_amdgcn_sched_barrier(0);
#pragma unroll
        for (int j = 0; j < 4; ++j) acc[1][j] = __builtin_amdgcn_mfma_f32_16x16x32_bf16(fb[j], fa[1], acc[1][j], 0, 0, 0);
        __builtin_amdgcn_sched_barrier(0);
        if (wr_ok) *(uint4*)(nA + soff0 + 8192) = ra2;
        if (ld_ok) ra2 = *(const uint4*)(Ab + (aoff + 64u * LDA + ko));
        ga[2] = *(const bf16x8*)(sA + arow_off + 2 * 2048 + ch1); gb[2] = *(const bf16x8*)(sB + brow_off + 2 * 2048 + ch1);
        __builtin_amdgcn_sched_barrier(0);
#pragma unroll
        for (int j = 0; j < 4; ++j) acc[2][j] = __builtin_amdgcn_mfma_f32_16x16x32_bf16(fb[j], fa[2], acc[2][j], 0, 0, 0);
        __builtin_amdgcn_sched_barrier(0);
        if (wr_ok) *(uint4*)(nA + soff0 + 12288) = ra3;
        if (ld_ok) ra3 = *(const uint4*)(Ab + (aoff + 96u * LDA + ko));
        ga[3] = *(const bf16x8*)(sA + arow_off + 3 * 2048 + ch1); gb[3] = *(const bf16x8*)(sB + brow_off + 3 * 2048 + ch1);
        __builtin_amdgcn_sched_barrier(0);
#pragma unroll
        for (int j = 0; j < 4; ++j) acc[3][j] = __builtin_amdgcn_mfma_f32_16x16x32_bf16(fb[j], fa[3], acc[3][j], 0, 0, 0);
        __builtin_amdgcn_sched_barrier(0);
        if (wr_ok) *(uint4*)(nB + soff0) = rb0;
        if (ld_ok) rb0 = *(const uint4*)(Bb + (boff + 0u * 2048u + ko));
        __builtin_amdgcn_sched_barrier(0);
#pragma unroll
        for (int j = 0; j < 4; ++j) acc[0][j] = __builtin_amdgcn_mfma_f32_16x16x32_bf16(gb[j], ga[0], acc[0][j], 0, 0, 0);
        __builtin_amdgcn_sched_barrier(0);
        if (wr_ok) *(uint4*)(nB + soff0 + 4096) = rb1;
        if (ld_ok) rb1 = *(const uint4*)(Bb + (boff + 32u * 2048u + ko));
        __builtin_amdgcn_sched_barrier(0);
#pragma unroll
        for (int j = 0; j < 4; ++j) acc[1][j] = __builtin_amdgcn_mfma_f32_16x16x32_bf16(gb[j], ga[1], acc[1][j], 0, 0, 0);
        __builtin_amdgcn_sched_barrier(0);
        if (wr_ok) *(uint4*)(nB + soff0 + 8192) = rb2;
        if (ld_ok) rb2 = *(const uint4*)(Bb + (boff + 64u * 2048u + ko));
        __builtin_amdgcn_sched_barrier(0);
#pragma unroll
        for (int j = 0; j < 4; ++j) acc[2][j] = __builtin_amdgcn_mfma_f32_16x16x32_bf16(gb[j], ga[2], acc[2][j], 0, 0, 0);
        __builtin_amdgcn_sched_barrier(0);
        if (wr_ok) *(uint4*)(nB + soff0 + 12288) = rb3;
        if (ld_ok) rb3 = *(const uint4*)(Bb + (boff + 96u * 2048u + ko));
        __builtin_amdgcn_sched_barrier(0);
#pragma unroll
        for (int j = 0; j < 4; ++j) acc[3][j] = __builtin_amdgcn_mfma_f32_16x16x32_bf16(gb[j], ga[3], acc[3][j], 0, 0, 0);
        __builtin_amdgcn_s_setprio(0);
        __syncthreads();
    }
#undef G_LOAD
#undef G_WRITE
    if (MODE == 1) {
        if (n0 >= ZC_FQ && n0 < ZC_FV) {
            const bool isk = n0 >= ZC_FK;
            const float* gain = isk ? P.f_k_norm : P.f_q_norm;
            const float scl = isk ? 1.0f : 0.125f * LOG2E;
            float gn[4][4];
#pragma unroll
            for (int j = 0; j < 4; ++j)
#pragma unroll
                for (int r = 0; r < 4; ++r) gn[j][r] = gain[16 * j + 4 * g + r];
#pragma unroll
            for (int i = 0; i < 4; ++i) {
                float ss = 0.f;
#pragma unroll
                for (int j = 0; j < 4; ++j)
#pragma unroll
                    for (int r = 0; r < 4; ++r) ss += acc[i][j][r] * acc[i][j][r];
                ss = x4_sum(ss);
                const float rstd = rsqrtf(ss * (1.0f / 64.0f) + EPS) * scl;
#pragma unroll
                for (int j = 0; j < 4; ++j)
#pragma unroll
                    for (int r = 0; r < 4; ++r) acc[i][j][r] *= rstd * gn[j][r];
            }
        }
        store_tile_bf16(acc, smem, (bf16_t*)(P.ws + WS_Z), NZ, m0, n0, tid, wr, wc, g, lr);
    } else if (MODE == 2) {
        float* ssq = (float*)(P.ws + WS_SSQ);
#pragma unroll
        for (int i = 0; i < 4; ++i) {
            const int row = m0 + wr * 64 + 16 * i + lr;
            float ss = 0.f;
#pragma unroll
            for (int j = 0; j < 4; ++j) {
                const int col = n0 + wc * 64 + 16 * j + 4 * g;
                const float4 xv = *(const float4*)(P.x + (size_t)row * DM + col);
                const float4 gv = *(const float4*)(P.norm_ffn + col);
                float4 hv; hv.x = acc[i][j][0] + xv.x; hv.y = acc[i][j][1] + xv.y; hv.z = acc[i][j][2] + xv.z; hv.w = acc[i][j][3] + xv.w;
                ss += hv.x * hv.x + hv.y * hv.y + hv.z * hv.z + hv.w * hv.w;
                acc[i][j][0] = hv.x * gv.x; acc[i][j][1] = hv.y * gv.y; acc[i][j][2] = hv.z * gv.z; acc[i][j][3] = hv.w * gv.w;
            }
            ss = x4_sum(ss);
            if (g == 0) ssq[(size_t)row * 16 + tn * 2 + wc] = ss;
        }
        store_tile_bf16(acc, smem, (bf16_t*)(P.ws + WS_XN), 1024, m0, n0, tid, wr, wc, g, lr);
    } else {
        const int hp = tn;
        float rs[4];
#pragma unroll
        for (int i = 0; i < 4; ++i) {
            const int row = m0 + wr * 64 + 16 * i + lr;
            const float4 sp = i == 0 ? ssp0 : i == 1 ? ssp1 : i == 2 ? ssp2 : ssp3;
            const float s = x4_sum((sp.x + sp.y) + (sp.z + sp.w));
            rs[i] = rsqrtf(s * (1.0f / DM) + EPS);
            if (tn == 0 && wc == 0 && g == 0) ((float*)(P.ws + WS_RSTD))[row] = rs[i];
        }
#pragma unroll
        for (int i = 0; i < 4; ++i)
#pragma unroll
            for (int j = 0; j < 4; ++j) {
                const int row = wr * 64 + 16 * i + lr;
                const int c4 = wc * 16 + 4 * j + g;
                *(f32x4*)(smem + row * 512 + ((c4 ^ (row & 31)) << 4)) = acc[i][j] * rs[i];
            }
        __syncthreads();
        unsigned top[16];
        const int row = tid & 127, half = tid >> 7;
        {
            auto load_keys = [&](unsigned (&dst)[16], int q4) {
#pragma unroll
                for (int s4 = 0; s4 < 4; ++s4) {
                    const int c4 = half * 16 + q4 * 4 + s4;
                    const f32x4 v = *(const f32x4*)(smem + row * 512 + ((c4 ^ (row & 31)) << 4));
#pragma unroll
                    for (int e = 0; e < 4; ++e) dst[s4 * 4 + e] = (ord_key(v[e]) & ~127u) | (unsigned)(127 - (c4 * 4 + e));
                }
            };
            load_keys(top, 0);
            bitonic_sort16_desc(top);
#pragma unroll 1
            for (int q4 = 1; q4 < 4; ++q4) {
                unsigned gq[16];
                load_keys(gq, q4);
                bitonic_sort16_desc(gq);
                bitonic_merge16_top(top, gq);
            }
        }
        __syncthreads();
        if (half) {
            uint4* lp = (uint4*)(smem + row * 64);
            lp[0] = make_uint4(top[0], top[1], top[2], top[3]); lp[1] = make_uint4(top[4], top[5], top[6], top[7]);
            lp[2] = make_uint4(top[8], top[9], top[10], top[11]); lp[3] = make_uint4(top[12], top[13], top[14], top[15]);
        }
        __syncthreads();
        if (!half) {
            const uint4* lp = (const uint4*)(smem + row * 64);
            unsigned other[16];
#pragma unroll
            for (int c = 0; c < 4; ++c) { const uint4 o = lp[c]; other[4 * c] = o.x; other[4 * c + 1] = o.y; other[4 * c + 2] = o.z; other[4 * c + 3] = o.w; }
            bitonic_merge16_top(top, other);
            uint4* tk = (uint4*)((unsigned*)(P.ws + WS_TK) + ((size_t)(m0 + row) * 16 + hp) * 16);
            tk[0] = make_uint4(top[0], top[1], top[2], top[3]); tk[1] = make_uint4(top[4], top[5], top[6], top[7]);
            tk[2] = make_uint4(top[8], top[9], top[10], top[11]); tk[3] = make_uint4(top[12], top[13], top[14], top[15]);
        }
        __syncthreads();
    }
}

__device__ __forceinline__ void fox_cum_wave(const Params& P, int bh, int lane) {
    const int b = bh >> 3, h = bh & 7;
    const float* gates = (const float*)(P.ws + WS_GATES) + (size_t)b * L * 16 + 8 + h;
    float* cum = (float*)(P.ws + WS_CUM) + (size_t)bh * L;
    constexpr int SEG = 33;
    const int t0 = lane * SEG;
    float v[SEG];
#pragma unroll
    for (int i = 0; i < SEG; ++i) { const int t = t0 + i; const float x = gates[(size_t)(t < L ? t : L - 1) * 16]; v[i] = t < L ? x : 0.f; }
    float loc = 0.f;
#pragma unroll
    for (int i = 0; i < SEG; ++i) loc += v[i];
    float incl = loc;
#pragma unroll
    for (int o = 1; o < 64; o <<= 1) { const float n = __shfl_up(incl, o, 64); if (lane >= o) incl += n; }
    float run = incl - loc;
#pragma unroll
    for (int i = 0; i < SEG; ++i) { const int t = t0 + i; run += v[i]; if (t < L) cum[t] = run * LOG2E; }
}

#define TR_SLOW 0

__device__ __forceinline__ int vimg_off(int row, int ch) { return row * 128 + ((ch ^ (((row >> 1) & 3) << 1)) << 4); }
__device__ __forceinline__ uint2 tr_frag(const unsigned char* img, int row0, int c, int g, int lr) {
#if TR_SLOW
    unsigned short e[4];
#pragma unroll
    for (int k = 0; k < 4; ++k) { const int row = row0 + 4 * g + k, col = 16 * c + lr; e[k] = *(const unsigned short*)(img + vimg_off(row, col >> 3) + (col & 7) * 2); }
    uint2 r; r.x = (unsigned)e[0] | ((unsigned)e[1] << 16); r.y = (unsigned)e[2] | ((unsigned)e[3] << 16); return r;
#else
    const int q = lr >> 2, p = lr & 3, row = row0 + 4 * g + q;
    const unsigned addr = (unsigned)(size_t)(img + vimg_off(row, 2 * c + (p >> 1)) + 8 * (p & 1));
    uint2 r;
    asm volatile("ds_read_b64_tr_b16 %0, %1\n\ts_waitcnt lgkmcnt(0)" : "=&v"(r) : "v"(addr) : "memory");
    return r;
#endif
}

__device__ __forceinline__ unsigned tr_lane_addr(const unsigned char* img, int c, int g, int lr) {
    const int q = lr >> 2, p = lr & 3, row = 4 * g + q;
    return (unsigned)(size_t)(img + vimg_off(row, 2 * c + (p >> 1)) + 8 * (p & 1));
}
#define TR_GROUP(o0, o1, o2, o3, a) "ds_read_b64_tr_b16 %" #o0 ", %" #a "\n\tds_read_b64_tr_b16 %" #o1 ", %" #a " offset:2048\n\tds_read_b64_tr_b16 %" #o2 ", %" #a " offset:4096\n\tds_read_b64_tr_b16 %" #o3 ", %" #a " offset:6144\n\t"
__device__ __forceinline__ void tr_read_4c(const unsigned char* img, int g, int lr, uint2 (&r)[4][4]) {
    const unsigned a0 = tr_lane_addr(img, 0, g, lr), a1 = tr_lane_addr(img, 1, g, lr), a2 = tr_lane_addr(img, 2, g, lr), a3 = tr_lane_addr(img, 3, g, lr);
    asm volatile(TR_GROUP(0, 1, 2, 3, 16) TR_GROUP(4, 5, 6, 7, 17) TR_GROUP(8, 9, 10, 11, 18) TR_GROUP(12, 13, 14, 15, 19) "s_waitcnt lgkmcnt(0)"
        : "=&v"(r[0][0]), "=&v"(r[0][1]), "=&v"(r[0][2]), "=&v"(r[0][3]), "=&v"(r[1][0]), "=&v"(r[1][1]), "=&v"(r[1][2]), "=&v"(r[1][3]),
          "=&v"(r[2][0]), "=&v"(r[2][1]), "=&v"(r[2][2]), "=&v"(r[2][3]), "=&v"(r[3][0]), "=&v"(r[3][1]), "=&v"(r[3][2]), "=&v"(r[3][3])
        : "v"(a0), "v"(a1), "v"(a2), "v"(a3) : "memory");
}
__device__ __forceinline__ void tr_read_3c(const unsigned char* img, int g, int lr, uint2 (&r)[3][4]) {
    const unsigned a0 = tr_lane_addr(img, 0, g, lr), a1 = tr_lane_addr(img, 1, g, lr), a2 = tr_lane_addr(img, 2, g, lr);
    asm volatile(TR_GROUP(0, 1, 2, 3, 12) TR_GROUP(4, 5, 6, 7, 13) TR_GROUP(8, 9, 10, 11, 14) "s_waitcnt lgkmcnt(0)"
        : "=&v"(r[0][0]), "=&v"(r[0][1]), "=&v"(r[0][2]), "=&v"(r[0][3]), "=&v"(r[1][0]), "=&v"(r[1][1]), "=&v"(r[1][2]), "=&v"(r[1][3]),
          "=&v"(r[2][0]), "=&v"(r[2][1]), "=&v"(r[2][2]), "=&v"(r[2][3])
        : "v"(a0), "v"(a1), "v"(a2) : "memory");
}
__device__ __forceinline__ void tr_read_2(const unsigned char* img0, int c0, const unsigned char* img1, int c1, int g, int lr, uint2 (&r)[2][4]) {
    const unsigned a0 = tr_lane_addr(img0, c0, g, lr), a1 = tr_lane_addr(img1, c1, g, lr);
    asm volatile(TR_GROUP(0, 1, 2, 3, 8) TR_GROUP(4, 5, 6, 7, 9) "s_waitcnt lgkmcnt(0)"
        : "=&v"(r[0][0]), "=&v"(r[0][1]), "=&v"(r[0][2]), "=&v"(r[0][3]), "=&v"(r[1][0]), "=&v"(r[1][1]), "=&v"(r[1][2]), "=&v"(r[1][3])
        : "v"(a0), "v"(a1) : "memory");
}
__device__ __forceinline__ bf16x8 tr_pair(const uint2& lo, const uint2& hi) { uint4 u; u.x = lo.x; u.y = lo.y; u.z = hi.x; u.w = hi.y; return __builtin_bit_cast(bf16x8, u); }

__device__ __forceinline__ void attn_block(const Params& P, int bh, int qb, unsigned char* smem) {
    const int tid = opaque_tid(), lane = tid & 63, w = tid >> 6, g = lane >> 4, lr = lane & 15;
    const int b = bh >> 3, h = bh & 7;
    const bf16_t* z = (const bf16_t*)(P.ws + WS_Z);
    const float* cum = (const float*)(P.ws + WS_CUM) + (size_t)bh * L;
    int tq[2]; bool qvalid[2]; bf16x8 qf[2][2];
#pragma unroll
    for (int u = 0; u < 2; ++u) {
        tq[u] = qb * 128 + 32 * w + 16 * u + lr;
        qvalid[u] = tq[u] < L;
        const bf16_t* qp = z + (size_t)(b * L + (qvalid[u] ? tq[u] : 0)) * NZ + ZC_FQ + h * 64 + 8 * g;
        qf[u][0] = *(const bf16x8*)(qp); qf[u][1] = *(const bf16x8*)(qp + 32);
    }
    const int nkv = (2 * qb + 2 < 33) ? 2 * qb + 2 : 33;
    const int srow0 = tid >> 3, sch = tid & 7;
    uint4 rk0, rk1, rv0, rv1; float rc = 0.f;
    auto load_tile = [&](int kv) {
        const int key0 = kv * 64 + srow0, key1 = key0 + 32;
        const bf16_t* p0 = z + (size_t)(b * L + (key0 < L ? key0 : L - 1)) * NZ + h * 64 + sch * 8;
        const bf16_t* p1 = z + (size_t)(b * L + (key1 < L ? key1 : L - 1)) * NZ + h * 64 + sch * 8;
        rk0 = *(const uint4*)(p0 + ZC_FK); rv0 = *(const uint4*)(p0 + ZC_FV);
        rk1 = *(const uint4*)(p1 + ZC_FK); rv1 = *(const uint4*)(p1 + ZC_FV);
        const int keyc = kv * 64 + (tid & 63);
        rc = cum[keyc < L ? keyc : L - 1];
    };
    auto store_tile = [&](int buf) {
        unsigned char* sK = smem + buf * 16384; unsigned char* sV = sK + 8192;
        const int row0 = srow0, row1 = srow0 + 32;
        *(uint4*)(sK + row0 * 128 + ((sch ^ (row0 & 7)) << 4)) = rk0;
        *(uint4*)(sV + vimg_off(row0, sch)) = rv0;
        *(uint4*)(sK + row1 * 128 + ((sch ^ (row1 & 7)) << 4)) = rk1;
        *(uint4*)(sV + vimg_off(row1, sch)) = rv1;
        if (tid < 64) ((float*)(smem + 32768 + buf * 256))[tid] = rc;
    };
    float m[2] = {-1e30f, -1e30f};
    f32x4 o[2][5];
#pragma unroll
    for (int u = 0; u < 2; ++u)
#pragma unroll
        for (int c = 0; c < 5; ++c) o[u][c] = (f32x4){0.f, 0.f, 0.f, 0.f};
    const unsigned onew = (lr == 0) ? 0x3F803F80u : 0u;
    const bf16x8 vones = __builtin_bit_cast(bf16x8, make_uint4(onew, onew, onew, onew));
    load_tile(nkv - 1); store_tile((nkv - 1) & 1);
    __syncthreads();
    if (nkv > 1) load_tile(nkv - 2);
    for (int kv = nkv - 1; kv >= 0; --kv) {
        const int buf = kv & 1;
        const unsigned char* sK = smem + buf * 16384; const unsigned char* sV = sK + 8192;
        const float* sck = (const float*)(smem + 32768 + buf * 256);
        f32x4 sa[2][4];
#pragma unroll
        for (int c = 0; c < 4; ++c) {
            sa[0][c] = (f32x4){0.f, 0.f, 0.f, 0.f}; sa[1][c] = (f32x4){0.f, 0.f, 0.f, 0.f};
#pragma unroll
            for (int s = 0; s < 2; ++s) {
                const bf16x8 kf = *(const bf16x8*)(sK + (16 * c + lr) * 128 + (((4 * s + g) ^ (lr & 7)) << 4));
                sa[0][c] = __builtin_amdgcn_mfma_f32_16x16x32_bf16(kf, qf[0][s], sa[0][c], 0, 0, 0);
                sa[1][c] = __builtin_amdgcn_mfma_f32_16x16x32_bf16(kf, qf[1][s], sa[1][c], 0, 0, 0);
            }
        }
        __builtin_amdgcn_sched_barrier(0);
        if (kv > 0) store_tile(buf ^ 1);
        if (kv > 1) load_tile(kv - 2);
        __builtin_amdgcn_sched_barrier(0);
        if (kv >= 2 * qb) {
#pragma unroll
            for (int u = 0; u < 2; ++u)
#pragma unroll
                for (int c = 0; c < 4; ++c)
#pragma unroll
                    for (int r = 0; r < 4; ++r)
                        if (64 * kv + 16 * c + 4 * g + r > tq[u]) sa[u][c][r] = -INFINITY;
        }
        f32x4 ck[4];
#pragma unroll
        for (int c = 0; c < 4; ++c) ck[c] = *(const f32x4*)(sck + 16 * c + 4 * g);
        bf16x8 pf[2][2];
#pragma unroll
        for (int u = 0; u < 2; ++u) {
            float mx = -INFINITY;
#pragma unroll
            for (int c = 0; c < 4; ++c) {
                sa[u][c] -= ck[c];
                mx = fmaxf(mx, fmaxf(fmaxf(sa[u][c][0], sa[u][c][1]), fmaxf(sa[u][c][2], sa[u][c][3])));
            }
            mx = x4_max(mx);
            if (__builtin_amdgcn_ballot_w64(mx > m[u]) != 0ull) {
                const float mn = fmaxf(m[u], mx);
                const float alpha = __builtin_amdgcn_exp2f(m[u] - mn);
                m[u] = mn;
#pragma unroll
                for (int c = 0; c < 5; ++c) o[u][c] *= alpha;
            }
            const float mn = m[u];
#pragma unroll
            for (int c = 0; c < 4; ++c)
#pragma unroll
                for (int r = 0; r < 4; ++r) sa[u][c][r] = __builtin_amdgcn_exp2f(sa[u][c][r] - mn);
#pragma unroll
            for (int s2 = 0; s2 < 2; ++s2) {
                uint4 uu;
                uu.x = cvt_pk_bf16(sa[u][2 * s2][0], sa[u][2 * s2][1]); uu.y = cvt_pk_bf16(sa[u][2 * s2][2], sa[u][2 * s2][3]);
                uu.z = cvt_pk_bf16(sa[u][2 * s2 + 1][0], sa[u][2 * s2 + 1][1]); uu.w = cvt_pk_bf16(sa[u][2 * s2 + 1][2], sa[u][2 * s2 + 1][3]);
                pf[u][s2] = __builtin_bit_cast(bf16x8, uu);
            }
        }
        {
            uint2 vr[4][4];
            tr_read_4c(sV, g, lr, vr);
#pragma unroll
            for (int c = 0; c < 4; ++c)
#pragma unroll
                for (int s2 = 0; s2 < 2; ++s2) {
                    const bf16x8 vf = tr_pair(vr[c][2 * s2], vr[c][2 * s2 + 1]);
                    o[0][c] = __builtin_amdgcn_mfma_f32_16x16x32_bf16(vf, pf[0][s2], o[0][c], 0, 0, 0);
                    o[1][c] = __builtin_amdgcn_mfma_f32_16x16x32_bf16(vf, pf[1][s2], o[1][c], 0, 0, 0);
                }
#pragma unroll
            for (int s2 = 0; s2 < 2; ++s2) {
                o[0][4] = __builtin_amdgcn_mfma_f32_16x16x32_bf16(vones, pf[0][s2], o[0][4], 0, 0, 0);
                o[1][4] = __builtin_amdgcn_mfma_f32_16x16x32_bf16(vones, pf[1][s2], o[1][4], 0, 0, 0);
            }
        }
        __syncthreads();
    }
#pragma unroll
    for (int u = 0; u < 2; ++u) {
        const float ls = __shfl(o[u][4][0], lr, 64);
        const float inv = 1.0f / ls;
        if (qvalid[u]) {
            bf16_t* y = (bf16_t*)(P.ws + WS_Z) + (size_t)(b * L + tq[u]) * NZ + 512 + h * 64 + 4 * g;
#pragma unroll
            for (int c = 0; c < 4; ++c) {
                uint2 uu; uu.x = pk2(o[u][c][0] * inv, o[u][c][1] * inv); uu.y = pk2(o[u][c][2] * inv, o[u][c][3] * inv);
                *(uint2*)(y + 16 * c) = uu;
            }
        }
    }
}

__device__ __forceinline__ void conv_item(const Params& P, int ci) {
    const int tid = opaque_tid(), cc = tid & 127, rg = tid >> 7;
    const bf16_t* z = (const bf16_t*)(P.ws + WS_Z);
    bf16_t* qk = (bf16_t*)(P.ws + WS_RA);
    const int col0 = cc * 8;
    float w[4][8];
#pragma unroll
    for (int j = 0; j < 4; ++j) {
        const float4 a = *(const float4*)(P.conv_qk + j * 1024 + col0), b = *(const float4*)(P.conv_qk + j * 1024 + col0 + 4);
        w[j][0] = a.x; w[j][1] = a.y; w[j][2] = a.z; w[j][3] = a.w; w[j][4] = b.x; w[j][5] = b.y; w[j][6] = b.z; w[j][7] = b.w;
    }
    const float oscale = (col0 >= 512) ? 0.08838834764831845f : 1.0f;
    const int r0 = ci * 64 + rg * 32;
    int t = r0 % L;
    float xw[3][8];
#pragma unroll
    for (int j = 0; j < 3; ++j) {
        const int back = 3 - j;
        if (t - back >= 0) {
            const uint4 v = *(const uint4*)(z + (size_t)(r0 - back) * NZ + col0);
            xw[j][0] = bflo(v.x); xw[j][1] = bfhi(v.x); xw[j][2] = bflo(v.y); xw[j][3] = bfhi(v.y); xw[j][4] = bflo(v.z); xw[j][5] = bfhi(v.z); xw[j][6] = bflo(v.w); xw[j][7] = bfhi(v.w);
        } else {
#pragma unroll
            for (int e = 0; e < 8; ++e) xw[j][e] = 0.f;
        }
    }
#pragma unroll 2
    for (int i = 0; i < 32; ++i) {
        const int r = r0 + i;
        if (t == 0) {
#pragma unroll
            for (int j = 0; j < 3; ++j)
#pragma unroll
                for (int e = 0; e < 8; ++e) xw[j][e] = 0.f;
        }
        const uint4 v = *(const uint4*)(z + (size_t)r * NZ + col0);
        float xt[8];
        xt[0] = bflo(v.x); xt[1] = bfhi(v.x); xt[2] = bflo(v.y); xt[3] = bfhi(v.y); xt[4] = bflo(v.z); xt[5] = bfhi(v.z); xt[6] = bflo(v.w); xt[7] = bfhi(v.w);
        float o[8];
#pragma unroll
        for (int e = 0; e < 8; ++e) {
            const float cv = w[0][e] * xw[0][e] + w[1][e] * xw[1][e] + w[2][e] * xw[2][e] + w[3][e] * xt[e];
            o[e] = oscale * cv / (1.f + __expf(-cv));
            xw[0][e] = xw[1][e]; xw[1][e] = xw[2][e]; xw[2][e] = xt[e];
        }
        uint4 ov; ov.x = pk2(o[0], o[1]); ov.y = pk2(o[2], o[3]); ov.z = pk2(o[4], o[5]); ov.w = pk2(o[6], o[7]);
        *(uint4*)(qk + (size_t)r * 1024 + col0) = ov;
        t = (t + 1 == L) ? 0 : t + 1;
    }
}

constexpr int ST_IMG = 36864;
__device__ __forceinline__ int st_piece_off(int jt, int c, int g, int lr) { return (jt >> 2) * 18432 + vimg_off(16 * c + lr, 2 * (jt & 3) + (g >> 1)) + 8 * (g & 1); }

__device__ __forceinline__ void mlstm_stage_kv(const Params& P, int b, int h, int k, unsigned char* sKimg, unsigned char* sVimg, int tid) {
    const bf16_t* z = (const bf16_t*)(P.ws + WS_Z);
    const bf16_t* qk = (const bf16_t*)(P.ws + WS_RA);
    uint4 pk_[4], pv_[4];
#pragma unroll
    for (int j = 0; j < 4; ++j) {
        const int id = tid + 256 * j, row = id >> 4, ch16 = id & 15, pos = 64 * k + row;
        const bool ok = pos < L;
        pk_[j] = ok ? *(const uint4*)(qk + (size_t)(b * L + pos) * 1024 + 512 + h * 128 + ch16 * 8) : make_uint4(0, 0, 0, 0);
        pv_[j] = ok ? *(const uint4*)(z + (size_t)(b * L + pos) * NZ + ZC_MV + h * 128 + ch16 * 8) : make_uint4(0, 0, 0, 0);
    }
#pragma unroll
    for (int j = 0; j < 4; ++j) {
        const int id = tid + 256 * j, row = id >> 4, ch16 = id & 15;
        *(uint4*)(sKimg + (ch16 >> 3) * 8192 + vimg_off(row, ch16 & 7)) = pk_[j];
        *(uint4*)(sVimg + (ch16 >> 3) * 8192 + vimg_off(row, ch16 & 7)) = pv_[j];
    }
    if (tid < 128) {
        const int row = tid >> 1, ch = tid & 1;
        *(uint4*)(sVimg + 16384 + vimg_off(row, ch)) = ch ? make_uint4(0, 0, 0, 0) : make_uint4(0x3F80u, 0, 0, 0);
    }
}

__device__ __forceinline__ void mlstm_stage_A(const Params& P, int b, int h, int k, unsigned char* sKimg, unsigned char* sVimg, int tid) {
    const bf16_t* z = (const bf16_t*)(P.ws + WS_Z);
    bf16_t* qk = (bf16_t*)(P.ws + WS_RA);
    uint4 pv_[4];
#pragma unroll
    for (int j = 0; j < 4; ++j) {
        const int id = tid + 256 * j, row = id >> 4, ch16 = id & 15, pos = 64 * k + row;
        pv_[j] = (pos < L) ? *(const uint4*)(z + (size_t)(b * L + pos) * NZ + ZC_MV + h * 128 + ch16 * 8) : make_uint4(0, 0, 0, 0);
    }
    const int cch = tid & 31, rg = tid >> 5, isk = cch >> 4;
    const int zcol = (isk ? ZC_MK : ZC_MQ) + h * 128 + (cch & 15) * 8;
    float w[4][8];
#pragma unroll
    for (int j = 0; j < 4; ++j) {
        const float4 a = *(const float4*)(P.conv_qk + j * 1024 + zcol), c = *(const float4*)(P.conv_qk + j * 1024 + zcol + 4);
        w[j][0] = a.x; w[j][1] = a.y; w[j][2] = a.z; w[j][3] = a.w; w[j][4] = c.x; w[j][5] = c.y; w[j][6] = c.z; w[j][7] = c.w;
    }
    const float oscale = isk ? 0.08838834764831845f : 1.0f;
    const int p0 = 64 * k + 8 * rg;
    uint4 raw[11];
#pragma unroll
    for (int i = 0; i < 11; ++i) {
        const int pos = p0 - 3 + i;
        raw[i] = (pos >= 0 && pos < L) ? *(const uint4*)(z + (size_t)(b * L + pos) * NZ + zcol) : make_uint4(0, 0, 0, 0);
    }
#pragma unroll
    for (int j = 0; j < 4; ++j) {
        const int id = tid + 256 * j, row = id >> 4, ch16 = id & 15;
        *(uint4*)(sVimg + (ch16 >> 3) * 8192 + vimg_off(row, ch16 & 7)) = pv_[j];
    }
    if (tid < 128) {
        const int row = tid >> 1, ch = tid & 1;
        *(uint4*)(sVimg + 16384 + vimg_off(row, ch)) = ch ? make_uint4(0, 0, 0, 0) : make_uint4(0x3F80u, 0, 0, 0);
    }
#pragma unroll
    for (int i = 0; i < 8; ++i) {
        const int pos = p0 + i, row = 8 * rg + i;
        float o[8];
#pragma unroll
        for (int e = 0; e < 8; ++e) {
            const unsigned w0 = (&raw[i].x)[e >> 1], w1 = (&raw[i + 1].x)[e >> 1], w2 = (&raw[i + 2].x)[e >> 1], w3 = (&raw[i + 3].x)[e >> 1];
            const float x0 = (e & 1) ? bfhi(w0) : bflo(w0), x1 = (e & 1) ? bfhi(w1) : bflo(w1), x2 = (e & 1) ? bfhi(w2) : bflo(w2), x3 = (e & 1) ? bfhi(w3) : bflo(w3);
            const float cv = w[0][e] * x0 + w[1][e] * x1 + w[2][e] * x2 + w[3][e] * x3;
            o[e] = oscale * cv / (1.f + __expf(-cv));
        }
        uint4 ov; ov.x = pk2(o[0], o[1]); ov.y = pk2(o[2], o[3]); ov.z = pk2(o[4], o[5]); ov.w = pk2(o[6], o[7]);
        const bool ok = pos < L;
        if (!ok) ov = make_uint4(0, 0, 0, 0);
        if (ok) *(uint4*)(qk + (size_t)(b * L + pos) * 1024 + (isk ? 512 : 0) + h * 128 + (cch & 15) * 8) = ov;
        if (isk) { const int ch16 = cch & 15; *(uint4*)(sKimg + (ch16 >> 3) * 8192 + vimg_off(row, ch16 & 7)) = ov; }
    }
}

__device__ __forceinline__ void mlstm_A(const Params& P, int item, unsigned char* smem) {
    const int tid = opaque_tid(), lane = tid & 63, w = tid >> 6, g = lane >> 4, lr = lane & 15;
    const int wu = __builtin_amdgcn_readfirstlane(w);
    const int k = item >> 5, bh = item & 31, b = bh >> 2, h = bh & 3;
    const float* gates = (const float*)(P.ws + WS_GATES);
    const unsigned char* sK = smem; const unsigned char* sV = smem + 16384;
    float* ga = (float*)(smem + 40960);
    float lf = 0.f, li = -INFINITY;
    if (wu == 0) {
        const int pos = 64 * k + lane;
        if (pos < L) { lf = gates[(size_t)(b * L + pos) * 16 + 4 + h]; li = gates[(size_t)(b * L + pos) * 16 + h]; }
    }
    mlstm_stage_A(P, b, h, k, smem, smem + 16384, tid);
    if (wu == 0) {
        float bc = lf;
#pragma unroll
        for (int o = 1; o < 64; o <<= 1) { const float n = __shfl_up(bc, o, 64); if (lane >= o) bc += n; }
        const float a = li - bc;
        const float A = wave_max(a);
        ga[lane] = __expf(a - A);
        if (lane == 63) { float* msc = (float*)(P.ws + WS_MSC) + ((size_t)bh * 33 + k) * 4; msc[0] = A; msc[1] = bc; }
    }
    __syncthreads();
    f32x4 Ct[2][9];
#pragma unroll
    for (int a = 0; a < 2; ++a)
#pragma unroll
        for (int c = 0; c < 9; ++c) Ct[a][c] = (f32x4){0.f, 0.f, 0.f, 0.f};
    bf16x8 kt[2][2];
#pragma unroll
    for (int a = 0; a < 2; ++a)
#pragma unroll
        for (int s2 = 0; s2 < 2; ++s2) {
            const int jt = 2 * w + a;
            kt[a][s2] = tr_pair(tr_frag(sK + (jt >> 2) * 8192, 32 * s2, jt & 3, g, lr), tr_frag(sK + (jt >> 2) * 8192, 32 * s2 + 16, jt & 3, g, lr));
        }
    f32x4 wg4[4];
#pragma unroll
    for (int j = 0; j < 4; ++j) wg4[j] = *(const f32x4*)(ga + 16 * j + 4 * g);
#define MA_TILE(c, lo0, hi0, lo1, hi1) { \
        { const f32x4 w0 = wg4[0], w1 = wg4[1]; uint4 o; \
          o.x = cvt_pk_bf16(bflo(lo0.x) * w0[0], bfhi(lo0.x) * w0[1]); o.y = cvt_pk_bf16(bflo(lo0.y) * w0[2], bfhi(lo0.y) * w0[3]); \
          o.z = cvt_pk_bf16(bflo(hi0.x) * w1[0], bfhi(hi0.x) * w1[1]); o.w = cvt_pk_bf16(bflo(hi0.y) * w1[2], bfhi(hi0.y) * w1[3]); \
          const bf16x8 vw = __builtin_bit_cast(bf16x8, o); \
          Ct[0][c] = __builtin_amdgcn_mfma_f32_16x16x32_bf16(kt[0][0], vw, Ct[0][c], 0, 0, 0); Ct[1][c] = __builtin_amdgcn_mfma_f32_16x16x32_bf16(kt[1][0], vw, Ct[1][c], 0, 0, 0); } \
        { const f32x4 w0 = wg4[2], w1 = wg4[3]; uint4 o; \
          o.x = cvt_pk_bf16(bflo(lo1.x) * w0[0], bfhi(lo1.x) * w0[1]); o.y = cvt_pk_bf16(bflo(lo1.y) * w0[2], bfhi(lo1.y) * w0[3]); \
          o.z = cvt_pk_bf16(bflo(hi1.x) * w1[0], bfhi(hi1.x) * w1[1]); o.w = cvt_pk_bf16(bflo(hi1.y) * w1[2], bfhi(hi1.y) * w1[3]); \
          const bf16x8 vw = __builtin_bit_cast(bf16x8, o); \
          Ct[0][c] = __builtin_amdgcn_mfma_f32_16x16x32_bf16(kt[0][1], vw, Ct[0][c], 0, 0, 0); Ct[1][c] = __builtin_amdgcn_mfma_f32_16x16x32_bf16(kt[1][1], vw, Ct[1][c], 0, 0, 0); } }
    {
        uint2 vr[4][4];
        tr_read_4c(sV, g, lr, vr);
        MA_TILE(0, vr[0][0], vr[0][1], vr[0][2], vr[0][3]) MA_TILE(1, vr[1][0], vr[1][1], vr[1][2], vr[1][3])
        MA_TILE(2, vr[2][0], vr[2][1], vr[2][2], vr[2][3]) MA_TILE(3, vr[3][0], vr[3][1], vr[3][2], vr[3][3])
        tr_read_4c(sV + 8192, g, lr, vr);
        MA_TILE(4, vr[0][0], vr[0][1], vr[0][2], vr[0][3]) MA_TILE(5, vr[1][0], vr[1][1], vr[1][2], vr[1][3])
        MA_TILE(6, vr[2][0], vr[2][1], vr[2][2], vr[2][3]) MA_TILE(7, vr[3][0], vr[3][1], vr[3][2], vr[3][3])
        const uint2 o0 = tr_frag(sV + 16384, 0, 0, g, lr), o1 = tr_frag(sV + 16384, 16, 0, g, lr), o2 = tr_frag(sV + 16384, 32, 0, g, lr), o3 = tr_frag(sV + 16384, 48, 0, g, lr);
        MA_TILE(8, o0, o1, o2, o3)
    }
#undef MA_TILE
    unsigned char* slot = P.ws + WS_MST + ((size_t)bh * 33 + k) * ST_IMG;
#pragma unroll
    for (int a = 0; a < 2; ++a)
#pragma unroll
        for (int c = 0; c < 9; ++c) {
            uint2 u; u.x = cvt_pk_bf16(Ct[a][c][0], Ct[a][c][1]); u.y = cvt_pk_bf16(Ct[a][c][2], Ct[a][c][3]);
            *(uint2*)(slot + st_piece_off(2 * w + a, c, g, lr)) = u;
        }
}

__device__ __forceinline__ void mlstm_B(const Params& P, int item) {
    const int tid = opaque_tid();
    const int bh = item / 3, part = item - bh * 3;
    const unsigned char* base = P.ws + WS_MST + (size_t)bh * 33 * ST_IMG + part * 12288 + tid * 48;
    unsigned char* obase = P.ws + WS_CBI + (size_t)bh * 33 * ST_IMG + part * 12288 + tid * 48;
    float* msc = (float*)(P.ws + WS_MSC) + (size_t)bh * 33 * 4;
    float C[6][4];
#pragma unroll
    for (int i = 0; i < 6; ++i)
#pragma unroll
        for (int r = 0; r < 4; ++r) C[i][r] = 0.f;
    float m = 0.f;
    uint2 d0[6], d1[6];
    float2 ab0, ab1;
#pragma unroll
    for (int i = 0; i < 6; ++i) { d0[i] = *(const uint2*)(base + i * 8); d1[i] = *(const uint2*)(base + ST_IMG + i * 8); }
    ab0 = *(const float2*)(msc); ab1 = *(const float2*)(msc + 4);
    for (int k = 0; k < 33; ++k) {
        uint2 d2[6]; float2 ab2 = make_float2(0.f, 0.f);
        if (k + 2 < 33) {
#pragma unroll
            for (int i = 0; i < 6; ++i) d2[i] = *(const uint2*)(base + (size_t)(k + 2) * ST_IMG + i * 8);
            ab2 = *(const float2*)(msc + (k + 2) * 4);
        } else {
#pragma unroll
            for (int i = 0; i < 6; ++i) d2[i] = make_uint2(0, 0);
        }
#pragma unroll
        for (int i = 0; i < 6; ++i) {
            uint2 u; u.x = cvt_pk_bf16(C[i][0], C[i][1]); u.y = cvt_pk_bf16(C[i][2], C[i][3]);
            *(uint2*)(obase + (size_t)k * ST_IMG + i * 8) = u;
        }
        if (tid == 0 && part == 0) msc[k * 4 + 2] = m;
        const float M = fmaxf(m, ab0.x);
        const float decay = __expf(m - M), sc = __expf(ab0.x - M);
#pragma unroll
        for (int i = 0; i < 6; ++i) {
            C[i][0] = decay * C[i][0] + sc * bflo(d0[i].x); C[i][1] = decay * C[i][1] + sc * bfhi(d0[i].x);
            C[i][2] = decay * C[i][2] + sc * bflo(d0[i].y); C[i][3] = decay * C[i][3] + sc * bfhi(d0[i].y);
        }
        m = ab0.y + M;
#pragma unroll
        for (int i = 0; i < 6; ++i) { d0[i] = d1[i]; d1[i] = d2[i]; }
        ab0 = ab1; ab1 = ab2;
    }
}

__device__ __forceinline__ void mlstm_C(const Params& P, int item, unsigned char* smem) {
    const int tid = opaque_tid(), lane = tid & 63, w = tid >> 6, g = lane >> 4, lr = lane & 15;
    const int wu = __builtin_amdgcn_readfirstlane(w);
    const int k = item >> 5, bh = item & 31, b = bh >> 2, h = bh & 3;
    const bf16_t* z = (const bf16_t*)(P.ws + WS_Z);
    const bf16_t* qk = (const bf16_t*)(P.ws + WS_RA);
    const float* gates = (const float*)(P.ws + WS_GATES);
    bf16_t* y = (bf16_t*)(P.ws + WS_Z);
    const unsigned char* sK = smem; const unsigned char* sV = smem + 36864; unsigned char* sCb = smem;
    float* ga = (float*)(smem + 61440);
    const int pos = 64 * k + 16 * w + lr;
    const bool tvalid = pos < L;
    const size_t rrow = (size_t)(b * L + (tvalid ? pos : 0));
    const unsigned char* cslot = P.ws + WS_CBI + ((size_t)bh * 33 + k) * ST_IMG + tid * 16;
    const uint4 cb0 = *(const uint4*)(cslot), cb1 = *(const uint4*)(cslot + 4096), cb2 = *(const uint4*)(cslot + 8192), cb3 = *(const uint4*)(cslot + 12288), cb4 = *(const uint4*)(cslot + 16384),
                cb5 = *(const uint4*)(cslot + 20480), cb6 = *(const uint4*)(cslot + 24576), cb7 = *(const uint4*)(cslot + 28672), cb8 = *(const uint4*)(cslot + 32768);
    bf16x8 qf[4];
    {
        const bf16_t* qp = qk + rrow * 1024 + h * 128 + 8 * g;
#pragma unroll
        for (int ks = 0; ks < 4; ++ks) { qf[ks] = *(const bf16x8*)(qp + 32 * ks); if (!tvalid) qf[ks] = (bf16x8){0, 0, 0, 0, 0, 0, 0, 0}; }
    }
    float m_prev = 0.f, lf = 0.f, li = -INFINITY;
    if (wu == 0) {
        m_prev = ((const float*)(P.ws + WS_MSC))[((size_t)bh * 33 + k) * 4 + 2];
        const int p2 = 64 * k + lane;
        if (p2 < L) { lf = gates[(size_t)(b * L + p2) * 16 + 4 + h]; li = gates[(size_t)(b * L + p2) * 16 + h]; }
    }
    mlstm_stage_kv(P, b, h, k, smem, smem + 36864, tid);
    if (wu == 0) {
        float bc = lf;
#pragma unroll
        for (int o = 1; o < 64; o <<= 1) { const float n = __shfl_up(bc, o, 64); if (lane >= o) bc += n; }
        const float a = li - bc;
        float am = a;
#pragma unroll
        for (int o = 1; o < 64; o <<= 1) { const float n = __shfl_up(am, o, 64); if (lane >= o) am = fmaxf(am, n); }
        const float M = fmaxf(m_prev, am);
        ga[lane] = a; ga[64 + lane] = __expf(m_prev - M); ga[128 + lane] = __expf(-(bc + M)); ga[192 + lane] = M;
    }
    __syncthreads();
    const float Mt = ga[192 + 16 * w + lr], Wi = ga[64 + 16 * w + lr], Et = ga[128 + 16 * w + lr];
    bf16x8 pf[2];
    {
        f32x4 sa[4];
#pragma unroll
        for (int c = 0; c < 4; ++c) {
            sa[c] = (f32x4){0.f, 0.f, 0.f, 0.f};
            if (c <= wu) {
#pragma unroll
                for (int ks = 0; ks < 4; ++ks) {
                    const bf16x8 kf = *(const bf16x8*)(sK + (ks >> 1) * 8192 + vimg_off(16 * c + lr, 4 * (ks & 1) + g));
                    sa[c] = __builtin_amdgcn_mfma_f32_16x16x32_bf16(kf, qf[ks], sa[c], 0, 0, 0);
                }
                const f32x4 av = *(const f32x4*)(ga + 16 * c + 4 * g);
#pragma unroll
                for (int r = 0; r < 4; ++r) {
                    const float d = __expf(av[r] - Mt);
                    sa[c][r] = (16 * c + 4 * g + r <= 16 * w + lr) ? sa[c][r] * d : 0.f;
                }
            }
        }
#pragma unroll
        for (int s2 = 0; s2 < 2; ++s2) {
            uint4 u;
            u.x = cvt_pk_bf16(sa[2 * s2][0], sa[2 * s2][1]); u.y = cvt_pk_bf16(sa[2 * s2][2], sa[2 * s2][3]);
            u.z = cvt_pk_bf16(sa[2 * s2 + 1][0], sa[2 * s2 + 1][1]); u.w = cvt_pk_bf16(sa[2 * s2 + 1][2], sa[2 * s2 + 1][3]);
            pf[s2] = __builtin_bit_cast(bf16x8, u);
        }
    }
    __syncthreads();
    {
        unsigned char* d = sCb + tid * 16;
        *(uint4*)(d) = cb0; *(uint4*)(d + 4096) = cb1; *(uint4*)(d + 8192) = cb2; *(uint4*)(d + 12288) = cb3; *(uint4*)(d + 16384) = cb4;
        *(uint4*)(d + 20480) = cb5; *(uint4*)(d + 24576) = cb6; *(uint4*)(d + 28672) = cb7; *(uint4*)(d + 32768) = cb8;
    }
    __syncthreads();
    f32x4 na[9];
#define MC_TILE(c, lo0, hi0, lo1, hi1) { \
        na[c] = (f32x4){0.f, 0.f, 0.f, 0.f}; \
        _Pragma("unroll") for (int ks = 0; ks < 4; ++ks) { \
            const bf16x8 cf = *(const bf16x8*)(sCb + (ks >> 1) * 18432 + vimg_off(16 * (c) + lr, 4 * (ks & 1) + g)); \
            na[c] = __builtin_amdgcn_mfma_f32_16x16x32_bf16(cf, qf[ks], na[c], 0, 0, 0); } \
        na[c] *= Wi; \
        na[c] = __builtin_amdgcn_mfma_f32_16x16x32_bf16(tr_pair(lo0, hi0), pf[0], na[c], 0, 0, 0); \
        na[c] = __builtin_amdgcn_mfma_f32_16x16x32_bf16(tr_pair(lo1, hi1), pf[1], na[c], 0, 0, 0); }
    {
        uint2 vr[4][4];
        tr_read_4c(sV, g, lr, vr);
        MC_TILE(0, vr[0][0], vr[0][1], vr[0][2], vr[0][3]) MC_TILE(1, vr[1][0], vr[1][1], vr[1][2], vr[1][3])
        MC_TILE(2, vr[2][0], vr[2][1], vr[2][2], vr[2][3]) MC_TILE(3, vr[3][0], vr[3][1], vr[3][2], vr[3][3])
        tr_read_4c(sV + 8192, g, lr, vr);
        MC_TILE(4, vr[0][0], vr[0][1], vr[0][2], vr[0][3]) MC_TILE(5, vr[1][0], vr[1][1], vr[1][2], vr[1][3])
        MC_TILE(6, vr[2][0], vr[2][1], vr[2][2], vr[2][3]) MC_TILE(7, vr[3][0], vr[3][1], vr[3][2], vr[3][3])
        const uint2 o0 = tr_frag(sV + 16384, 0, 0, g, lr), o1 = tr_frag(sV + 16384, 16, 0, g, lr), o2 = tr_frag(sV + 16384, 32, 0, g, lr), o3 = tr_frag(sV + 16384, 48, 0, g, lr);
        MC_TILE(8, o0, o1, o2, o3)
    }
#undef MC_TILE
    const float den = __shfl(na[8][0], lr, 64);
    const float rden = 1.0f / fmaxf(fabsf(den), Et);
    float hs = 0.f;
#pragma unroll
    for (int c = 0; c < 8; ++c) { na[c] *= rden; hs += na[c][0] * na[c][0] + na[c][1] * na[c][1] + na[c][2] * na[c][2] + na[c][3] * na[c][3]; }
    hs = x4_sum(hs);
    const float rstd = rsqrtf(hs * (1.0f / 128.0f) + EPS);
    const float* gainp = P.m_out_norm + h * 128 + 4 * g;
#pragma unroll
    for (int c = 0; c < 8; ++c) {
        const uint2 og = *(const uint2*)(z + rrow * NZ + ZC_MO + h * 128 + 16 * c + 4 * g);
        const float o0 = bflo(og.x), o1 = bfhi(og.x), o2 = bflo(og.y), o3 = bfhi(og.y);
        const float4 gn = *(const float4*)(gainp + 16 * c);
        uint2 u;
        u.x = pk2(na[c][0] * rstd * gn.x / (1.f + __expf(-o0)), na[c][1] * rstd * gn.y / (1.f + __expf(-o1)));
        u.y = pk2(na[c][2] * rstd * gn.z / (1.f + __expf(-o2)), na[c][3] * rstd * gn.w / (1.f + __expf(-o3)));
        if (tvalid) *(uint2*)(y + rrow * NZ + h * 128 + 16 * c + 4 * g) = u;
    }
}

__device__ __forceinline__ void peer_token(const Params& P, int t, int tnext, uint4& tkw, int lane, int* sidx, float* sval, int* sid, float* sgate, const unsigned char* slut, const unsigned* szero) {
    {
        const unsigned kk[4] = {tkw.x, tkw.y, tkw.z, tkw.w};
#pragma unroll
        for (int i = 0; i < 4; ++i) {
            const unsigned k = kk[i];
            sidx[lane * 4 + i] = 127 - (int)(k & 127u);
            sval[lane * 4 + i] = unord_key(k & ~127u);
        }
        tkw = *(const uint4*)((const unsigned*)(P.ws + WS_TK) + (size_t)tnext * 256 + lane * 4);
    }
    const bf16_t* xn = (const bf16_t*)(P.ws + WS_XN) + (size_t)t * DM;
    const uint4 xa_pre = *(const uint4*)(xn + lane * 16), xb_pre = *(const uint4*)(xn + lane * 16 + 8);
    const float rstd = ((const float*)(P.ws + WS_RSTD))[t];
    __builtin_amdgcn_s_waitcnt(0xc07f);
    __builtin_amdgcn_wave_barrier();
    {
        const int hd = lane >> 3, sub = lane & 7;
        unsigned x[8];
#pragma unroll
        for (int r = 0; r < 8; ++r) {
            const int c = sub * 8 + r;
            const unsigned ij = slut[c < 50 ? c : 0];
            const int i = ij >> 4, j = ij & 15;
            const unsigned kx = (ord_key(sval[(2 * hd) * 16 + i] + sval[(2 * hd + 1) * 16 + j]) & ~255u) | (unsigned)(255 - (i * 16 + j));
            x[r] = c < 50 ? kx : 0u;
        }
#pragma unroll
        for (int k = 2; k <= 64; k <<= 1) {
#pragma unroll
            for (int j = k >> 1; j >= 1; j >>= 1) {
                if (j >= 8) {
                    const int ld = j >> 3;
                    const bool lower = (sub & ld) == 0;
                    const bool desc = k >= 64 ? true : ((sub * 8) & k) == 0;
                    const bool takemax = (lower == desc);
#pragma unroll
                    for (int r = 0; r < 8; ++r) {
                        const unsigned o = (unsigned)__shfl_xor((int)x[r], ld, 64);
                        const unsigned hi = max(x[r], o), lo = min(x[r], o);
                        x[r] = takemax ? hi : lo;
                    }
                } else {
#pragma unroll
                    for (int r = 0; r < 8; ++r) {
                        if ((r & j) == 0) {
                            const int p = r | j;
                            const unsigned hi = max(x[r], x[p]), lo = min(x[r], x[p]);
                            if (k <= 4) { const bool desc = (r & k) == 0; x[r] = desc ? hi : lo; x[p] = desc ? lo : hi; }
                            else if (k >= 64) { x[r] = hi; x[p] = lo; }
                            else { const bool desc = ((sub * 8) & k) == 0; x[r] = desc ? hi : lo; x[p] = desc ? lo : hi; }
                        }
                    }
                }
            }
        }
        const float smax = unord_key((unsigned)__shfl((int)x[0], hd * 8, 64) & ~255u);
        float e[8]; float den = 0.f;
#pragma unroll
        for (int r = 0; r < 8; ++r) { e[r] = __expf(unord_key(x[r] & ~255u) - smax); den += e[r]; }
        den += __shfl_xor(den, 1, 64);
        const float inv = 1.f / den;
        if (sub < 2) {
#pragma unroll
            for (int r = 0; r < 8; ++r) {
                const int pos = 255 - (int)(x[r] & 255u), i = pos >> 4, j = pos & 15;
                sid[hd * 16 + sub * 8 + r] = sidx[(2 * hd) * 16 + i] * 128 + sidx[(2 * hd + 1) * 16 + j];
                sgate[hd * 16 + sub * 8 + r] = e[r] * inv;
            }
        }
    }
    __builtin_amdgcn_s_waitcnt(0xc07f);
    __builtin_amdgcn_wave_barrier();
    const unsigned char* V = P.ws + WS_V + lane * 8;
    const float* usc = (const float*)(P.ws + WS_USC);
    const float* vsc = (const float*)(P.ws + WS_VSC);
    const int g = lane >> 4, lr = lane & 15;
    unsigned char* shi = (unsigned char*)sval;
    unsigned char* slo = (unsigned char*)sidx;
    {
        const uint4 xa = xa_pre, xb = xb_pre;
        const unsigned xw[8] = {xa.x, xa.y, xa.z, xa.w, xb.x, xb.y, xb.z, xb.w};
        unsigned hi[4], lo[4];
#pragma unroll
        for (int i = 0; i < 4; ++i) {
            const float x0 = bflo(xw[2 * i]), x1 = bfhi(xw[2 * i]), x2 = bflo(xw[2 * i + 1]), x3 = bfhi(xw[2 * i + 1]);
            int wd = 0;
            wd = __builtin_amdgcn_cvt_pk_fp8_f32(x0, x1, wd, false);
            wd = __builtin_amdgcn_cvt_pk_fp8_f32(x2, x3, wd, true);
            const f32x2 h01 = __builtin_amdgcn_cvt_pk_f32_fp8(wd, false), h23 = __builtin_amdgcn_cvt_pk_f32_fp8(wd, true);
            int wl = 0;
            wl = __builtin_amdgcn_cvt_pk_fp8_f32(x0 - h01.x, x1 - h01.y, wl, false);
            wl = __builtin_amdgcn_cvt_pk_fp8_f32(x2 - h23.x, x3 - h23.y, wl, true);
            hi[i] = (unsigned)wd; lo[i] = (unsigned)wl;
        }
        *(uint4*)(shi + lane * 16) = make_uint4(hi[0], hi[1], hi[2], hi[3]);
        *(uint4*)(slo + lane * 16) = make_uint4(lo[0], lo[1], lo[2], lo[3]);
    }
    __builtin_amdgcn_s_waitcnt(0xc07f);
    __builtin_amdgcn_wave_barrier();
    {
        typedef int v8i __attribute__((ext_vector_type(8)));
        const unsigned char* Ub = P.ws + WS_U;
        const unsigned lofs = 64u * (unsigned)(lr >> 3) + 16u * (unsigned)g;
        const unsigned char* bsrc = (lr < 4) ? (((lr & 2) ? slo : shi) + 128 * (lr & 1) + 16 * g) : (const unsigned char*)szero;
        const int bstep = (lr < 4) ? 256 : 0, bhalf = (lr < 4) ? 64 : 16;
        v8i Bv[4];
#pragma unroll
        for (int st = 0; st < 4; ++st) {
            const uint4 b0 = *(const uint4*)(bsrc + bstep * st), b1 = *(const uint4*)(bsrc + bstep * st + bhalf);
            Bv[st] = (v8i){(int)b0.x, (int)b0.y, (int)b0.z, (int)b0.w, (int)b1.x, (int)b1.y, (int)b1.z, (int)b1.w};
        }
        __builtin_amdgcn_s_waitcnt(0xc07f);
        __builtin_amdgcn_wave_barrier();
        float* sact = (float*)sidx + 128 * (lr & 3) + 4 * (g & 1);
        const bool owner = (lr < 4) && ((g >> 1) == (lr & 1));
        uint4 abuf[2][2][4];
        unsigned off2[2];
#pragma unroll
        for (int hh = 0; hh < 2; ++hh) off2[hh] = (unsigned)sid[8 * hh + (lr & 7)] * 512u + lofs;
#pragma unroll
        for (int hh = 0; hh < 2; ++hh)
#pragma unroll
            for (int st = 0; st < 4; ++st) abuf[0][hh][st] = *(const uint4*)(Ub + (off2[hh] + 128 * st));
#pragma unroll
        for (int T = 0; T < 8; ++T) {
            if (T + 1 < 8) {
#pragma unroll
                for (int hh = 0; hh < 2; ++hh) off2[hh] = (unsigned)sid[16 * (T + 1) + 8 * hh + (lr & 7)] * 512u + lofs;
#pragma unroll
                for (int hh = 0; hh < 2; ++hh)
#pragma unroll
                    for (int st = 0; st < 4; ++st) abuf[(T + 1) & 1][hh][st] = *(const uint4*)(Ub + (off2[hh] + 128 * st));
            }
#pragma unroll
            for (int hh = 0; hh < 2; ++hh) {
                f32x4 au = (f32x4){0.f, 0.f, 0.f, 0.f};
#pragma unroll
                for (int st = 0; st < 4; ++st) {
                    const uint4 a4 = abuf[T & 1][hh][st];
                    const v8i Av = {(int)a4.x, (int)a4.y, (int)a4.z, (int)a4.w, 0, 0, 0, 0};
                    au = __builtin_amdgcn_mfma_scale_f32_16x16x128_f8f6f4(Av, Bv[st], au, 4, 0, 0, 0x7f7f7f7f, 0, 0x7f7f7f7f);
                }
                if (owner) *(f32x4*)(sact + 16 * T + 8 * hh) = au;
            }
        }
    }
    __builtin_amdgcn_s_waitcnt(0xc07f);
    __builtin_amdgcn_wave_barrier();
    {
        float* sw = (float*)sidx;
        float wv[2];
#pragma unroll
        for (int hh = 0; hh < 2; ++hh) {
            const int e = lane + 64 * hh, id = sid[e];
            const float a = ((sw[e] + sw[128 + e]) + (sw[256 + e] + sw[384 + e])) * usc[id] * rstd;
            wv[hh] = sgate[e] * vsc[id] * 0.5f * a * (1.f + erff(a * 0.70710678118654752f));
        }
        __builtin_amdgcn_s_waitcnt(0xc07f);
        __builtin_amdgcn_wave_barrier();
        sw[lane] = wv[0]; sw[lane + 64] = wv[1];
    }
    __builtin_amdgcn_s_waitcnt(0xc07f);
    __builtin_amdgcn_wave_barrier();
    const int half = lane >> 5, l5 = lane & 31;
    const int lane_o = 2 * l5 + half;
    f32x2 acc2[16];
#pragma unroll
    for (int j = 0; j < 16; ++j) acc2[j] = (f32x2){0.f, 0.f};
    const unsigned char* Vb = P.ws + WS_V;
    const unsigned vlo = (unsigned)l5 * 16u;
#pragma unroll 1
    for (int e0 = 0; e0 < 128; e0 += 16) {
        uint4 vr[8];
#pragma unroll
        for (int q = 0; q < 8; ++q) vr[q] = *(const uint4*)(Vb + ((unsigned)sid[e0 + 2 * q + half] * 512u + vlo));
        const float* sw = (const float*)sidx + e0;
        const f32x4 w0 = *(const f32x4*)(sw), w1 = *(const f32x4*)(sw + 4), w2 = *(const f32x4*)(sw + 8), w3 = *(const f32x4*)(sw + 12);
        const float wq[16] = {w0[0], w0[1], w0[2], w0[3], w1[0], w1[1], w1[2], w1[3], w2[0], w2[1], w2[2], w2[3], w3[0], w3[1], w3[2], w3[3]};
#pragma unroll
        for (int q = 0; q < 8; ++q) {
            const float w = half ? wq[2 * q + 1] : wq[2 * q];
#define FP4_AXPY(k) { acc2[k] += w * __builtin_amdgcn_cvt_scalef32_pk_f32_fp4(vr[q].x, 1.0f, k); acc2[4 + k] += w * __builtin_amdgcn_cvt_scalef32_pk_f32_fp4(vr[q].y, 1.0f, k); \
                      acc2[8 + k] += w * __builtin_amdgcn_cvt_scalef32_pk_f32_fp4(vr[q].z, 1.0f, k); acc2[12 + k] += w * __builtin_amdgcn_cvt_scalef32_pk_f32_fp4(vr[q].w, 1.0f, k); }
            FP4_AXPY(0) FP4_AXPY(1) FP4_AXPY(2) FP4_AXPY(3)
#undef FP4_AXPY
        }
    }
    f32x2 acc[8];
#pragma unroll
    for (int j = 0; j < 16; ++j) {
        const unsigned x0 = __float_as_uint(acc2[j].x), x1 = __float_as_uint(acc2[j].y);
        const auto r0 = __builtin_amdgcn_permlane32_swap(x0, x0, false, false);
        const auto r1 = __builtin_amdgcn_permlane32_swap(x1, x1, false, false);
        acc2[j].x = __uint_as_float(r0[0]) + __uint_as_float(r0[1]);
        acc2[j].y = __uint_as_float(r1[0]) + __uint_as_float(r1[1]);
    }
#pragma unroll
    for (int j = 0; j < 8; ++j) { acc[j].x = half ? acc2[8 + j].x : acc2[j].x; acc[j].y = half ? acc2[8 + j].y : acc2[j].y; }
    f32x2 xf[8];
    {
        const uint4 xa = *(const uint4*)(xn + lane_o * 16), xb = *(const uint4*)(xn + lane_o * 16 + 8);
        xf[0] = (f32x2){bflo(xa.x), bfhi(xa.x)}; xf[1] = (f32x2){bflo(xa.y), bfhi(xa.y)}; xf[2] = (f32x2){bflo(xa.z), bfhi(xa.z)}; xf[3] = (f32x2){bflo(xa.w), bfhi(xa.w)};
        xf[4] = (f32x2){bflo(xb.x), bfhi(xb.x)}; xf[5] = (f32x2){bflo(xb.y), bfhi(xb.y)}; xf[6] = (f32x2){bflo(xb.z), bfhi(xb.z)}; xf[7] = (f32x2){bflo(xb.w), bfhi(xb.w)};
    }
    float* o = P.out + (size_t)t * DM + lane_o * 16;
    float4 h0, h1, h2, h3;
    {
        const float4 g0 = *(const float4*)(P.norm_ffn + lane_o * 16), g1 = *(const float4*)(P.norm_ffn + lane_o * 16 + 4), g2 = *(const float4*)(P.norm_ffn + lane_o * 16 + 8), g3 = *(const float4*)(P.norm_ffn + lane_o * 16 + 12);
        h0.x = xf[0].x * __builtin_amdgcn_rcpf(g0.x) + acc[0].x; h0.y = xf[0].y * __builtin_amdgcn_rcpf(g0.y) + acc[0].y; h0.z = xf[1].x * __builtin_amdgcn_rcpf(g0.z) + acc[1].x; h0.w = xf[1].y * __builtin_amdgcn_rcpf(g0.w) + acc[1].y;
        h1.x = xf[2].x * __builtin_amdgcn_rcpf(g1.x) + acc[2].x; h1.y = xf[2].y * __builtin_amdgcn_rcpf(g1.y) + acc[2].y; h1.z = xf[3].x * __builtin_amdgcn_rcpf(g1.z) + acc[3].x; h1.w = xf[3].y * __builtin_amdgcn_rcpf(g1.w) + acc[3].y;
        h2.x = xf[4].x * __builtin_amdgcn_rcpf(g2.x) + acc[4].x; h2.y = xf[4].y * __builtin_amdgcn_rcpf(g2.y) + acc[4].y; h2.z = xf[5].x * __builtin_amdgcn_rcpf(g2.z) + acc[5].x; h2.w = xf[5].y * __builtin_amdgcn_rcpf(g2.w) + acc[5].y;
        h3.x = xf[6].x * __builtin_amdgcn_rcpf(g3.x) + acc[6].x; h3.y = xf[6].y * __builtin_amdgcn_rcpf(g3.y) + acc[6].y; h3.z = xf[7].x * __builtin_amdgcn_rcpf(g3.z) + acc[7].x; h3.w = xf[7].y * __builtin_amdgcn_rcpf(g3.w) + acc[7].y;
    }
    *(float4*)(o) = h0; *(float4*)(o + 4) = h1; *(float4*)(o + 8) = h2; *(float4*)(o + 12) = h3;
    __builtin_amdgcn_s_waitcnt(0xc07f);
    __builtin_amdgcn_wave_barrier();
}

#define LAS __attribute__((address_space(3)))
#define XB_TMO      128
#define XB_XCNT(j)  (256  + 64 * (j))
#define XB_XSUB(j)  (1280 + 64 * (j))
#define XB_XGEN(j)  (2304 + 64 * (j))
#define XB_TOP      3328
#define XB_TOPGEN   3392
#define XCD_BAR_WORDS 3456
#define XB_SPIN_CAP (1u << 18)
__device__ __forceinline__ unsigned xb_ld(unsigned* p)              { return __hip_atomic_load(p, __ATOMIC_RELAXED, __HIP_MEMORY_SCOPE_AGENT); }
__device__ __forceinline__ unsigned xb_add(unsigned* p, unsigned v) { return __hip_atomic_fetch_add(p, v, __ATOMIC_RELAXED, __HIP_MEMORY_SCOPE_AGENT); }
__device__ __forceinline__ unsigned xb_xcc_id() { return (unsigned)__builtin_amdgcn_s_getreg((3 << 11) | 20) & 0xFu; }
#define XB_SPIN(cond, bar) do { unsigned _sp = 0; while (cond) { __builtin_amdgcn_s_sleep(1); \
    if ((++_sp & 255u) == 0u) { if (xb_ld(&(bar)[XB_TMO])) break; if (_sp > XB_SPIN_CAP) { atomicAdd(&(bar)[XB_TMO], 1u); break; } } } } while (0)
struct XcdBarrier { unsigned* bar; unsigned x; volatile LAS unsigned* st; };
__device__ __forceinline__ XcdBarrier xcd_barrier_post(unsigned* bar, volatile LAS unsigned* st) {
    XcdBarrier b; b.bar = bar; b.x = xb_xcc_id(); b.st = st;
    if (threadIdx.x == 0) (void)xb_add(&bar[XB_XCNT(b.x)], 1u);
    return b;
}
__device__ __forceinline__ void xcd_barrier_complete(unsigned* bar, unsigned x, unsigned& nloc, unsigned& nx) {
    const unsigned G = gridDim.x * gridDim.y * gridDim.z;
    unsigned sum, cnt, mine, sp = 0u;
    for (;;) {
        sum = 0u; cnt = 0u; mine = 0u;
#pragma unroll
        for (unsigned j = 0; j < 16; ++j) { const unsigned c = xb_ld(&bar[XB_XCNT(j)]); sum += c; cnt += (c > 0u) ? 1u : 0u; mine = (j == x) ? c : mine; }
        if (sum == G) break;
        __builtin_amdgcn_s_sleep(1);
        if ((++sp & 255u) == 0u) { if (xb_ld(&bar[XB_TMO])) break; if (sp > XB_SPIN_CAP) { atomicAdd(&bar[XB_TMO], 1u); break; } }
    }
    nloc = mine > 0u ? mine : 1u; nx = cnt > 0u ? cnt : 1u;
}
__device__ __forceinline__ void xcd_barrier(const XcdBarrier& b) {
    asm volatile("s_waitcnt vmcnt(0)" ::: "memory");
    __syncthreads();
    if (threadIdx.x == 0) {
        unsigned* bar = b.bar;
        __builtin_amdgcn_s_waitcnt(0);
        unsigned nloc = b.st[0], nx = b.st[1];
        if (nloc == 0u) { xcd_barrier_complete(bar, b.x, nloc, nx); b.st[0] = nloc; b.st[1] = nx; }
        const unsigned old = xb_add(&bar[XB_XSUB(b.x)], 1u);
        const unsigned gen = old / nloc;
        if (old + 1u == (gen + 1u) * nloc) {
            __builtin_amdgcn_fence(__ATOMIC_RELEASE, "agent");
            asm volatile("s_waitcnt vmcnt(0)" ::: "memory");
            const unsigned og = xb_add(&bar[XB_TOP], 1u);
            const unsigned tg = og / nx;
            if (og + 1u == (tg + 1u) * nx) xb_add(&bar[XB_TOPGEN], 1u);
            else XB_SPIN(xb_ld(&bar[XB_TOPGEN]) == tg, bar);
            __builtin_amdgcn_fence(__ATOMIC_ACQUIRE, "agent");
            xb_add(&bar[XB_XGEN(b.x)], 1u);
            asm volatile("s_waitcnt vmcnt(0)" ::: "memory");
        } else {
            XB_SPIN(xb_ld(&bar[XB_XGEN(b.x)]) == gen, bar);
            __builtin_amdgcn_fence(__ATOMIC_ACQUIRE, "agent");
            asm volatile("s_waitcnt vmcnt(0)" ::: "memory");
        }
    }
    __syncthreads();
}

__device__ __forceinline__ void hand_release() { asm volatile("s_waitcnt vmcnt(0)" ::: "memory"); __builtin_amdgcn_fence(__ATOMIC_RELEASE, "agent"); asm volatile("s_waitcnt vmcnt(0)" ::: "memory"); }
__device__ __forceinline__ void hand_acquire() { __builtin_amdgcn_fence(__ATOMIC_ACQUIRE, "agent"); asm volatile("s_waitcnt vmcnt(0)" ::: "memory"); }

__global__ void __launch_bounds__(256, 2) mega(Params P) {
    extern __shared__ __attribute__((aligned(16))) unsigned char smem[];
    const int tid = threadIdx.x, lane = tid & 63, wave = tid >> 6;
    const int G = gridDim.x, bid = blockIdx.x;
    unsigned* ctl = (unsigned*)(P.ws + WS_CTL);
    volatile LAS unsigned* bst = (volatile LAS unsigned*)(smem + 65552);
    if (tid == 0) { bst[0] = 0u; bst[1] = 0u; }
    __syncthreads();
    const XcdBarrier xb = xcd_barrier_post(ctl + 1024, bst);
    unsigned* cucnt = ctl + 5120;
    if (tid == 0) {
        const unsigned phys = ((xb_xcc_id() & 7u) << 8) | ((unsigned)__builtin_amdgcn_s_getreg((7 << 11) | (8 << 6) | 4) & 0xFFu);
        bst[2] = phys; bst[3] = xb_add(&cucnt[phys], 1u);
    }
    phase0(P, smem);
    xcd_barrier(xb);
    {
        int vb;
        const unsigned phys = bst[2];
        unsigned part = 0;
#pragma unroll
        for (int q = 0; q < 8; ++q) { const unsigned i = (unsigned)(tid + 256 * q); const unsigned c = xb_ld(&cucnt[i]); part += (i < phys) ? c : 0u; }
#pragma unroll
        for (int o = 1; o < 64; o <<= 1) part += (unsigned)__shfl_xor((int)part, o, 64);
        if (lane == 0) bst[4 + wave] = part;
        __syncthreads();
        vb = (int)(bst[4] + bst[5] + bst[6] + bst[7] + bst[3]);
        vb = __builtin_amdgcn_readfirstlane(vb);
        if (vb < 0 || vb >= G) vb = bid;
        __syncthreads();
        if (tid == 0) bst[8] = (unsigned)vb;
        __syncthreads();
    }
#define VB_LOAD() __builtin_amdgcn_readfirstlane((int)bst[8])
    {
        const int gw = bid * 4 + wave;
        if (gw < 64) fox_cum_wave(P, gw, lane);
        const int vb = VB_LOAD();
        for (int tile = vb; tile < 129 * 28; tile += G) gemm_tile<1>(P, tile / 28, tile % 28, smem);
        {
            const int rem = (129 * 28) % G;
            if (rem > 0 && rem < G) { if (vb >= rem) convert_uv_rows(P, (vb - rem) * 4 + wave, (G - rem) * 4, lane); }
            else convert_uv_rows(P, vb * 4 + wave, G * 4, lane);
        }
    }
    xcd_barrier(xb);
    {
        volatile int* s_item = (volatile int*)(smem + 65536);
        const int wave_u = __builtin_amdgcn_readfirstlane(wave);
        auto fetch = [&](unsigned* counter) -> int {
            if (wave_u == 0) {
                unsigned v = atomicAdd(counter, lane == 0 ? 1u : 0u);
                *s_item = (int)__builtin_amdgcn_readfirstlane(v);
            }
            __syncthreads();
            const int item = __builtin_amdgcn_readfirstlane(*s_item);
            __syncthreads();
            return item;
        };
#define RUN_QUEUE(COUNTER, NITEMS, BODY) { \
            int item = bid; \
            while (item < (NITEMS)) { \
                unsigned nxt_ = 0u; \
                if (wave_u == 0) nxt_ = atomicAdd((COUNTER), lane == 0 ? 1u : 0u); \
                BODY; \
                if (wave_u == 0) *s_item = (int)__builtin_amdgcn_readfirstlane(nxt_) + G; \
                __syncthreads(); \
                item = __builtin_amdgcn_readfirstlane(*s_item); \
                __syncthreads(); \
            } }
        RUN_QUEUE(&ctl[2], 33 * 32, mlstm_A(P, item, smem))
        xcd_barrier(xb);
        RUN_QUEUE(&ctl[4], 96, mlstm_B(P, item))
        RUN_QUEUE(&ctl[3], 64 * 17, attn_block(P, item & 63, 16 - (item >> 6), smem))
        xcd_barrier(xb);
        RUN_QUEUE(&ctl[5], 33 * 32, mlstm_C(P, item, smem))
#undef RUN_QUEUE
    }
    xcd_barrier(xb);
    for (int tile = VB_LOAD(); tile < 128 * 8; tile += G) gemm_tile<2>(P, tile >> 3, tile & 7, smem);
    xcd_barrier(xb);
    for (int tile = VB_LOAD(); tile < 128 * 16; tile += G) gemm_tile<3>(P, tile >> 4, tile & 15, smem);
    xcd_barrier(xb);
    {
        unsigned char* slut = smem + 12288;
        if (tid < 64) {
            int c = tid, i = 0;
            while (i < 16 && c >= 16 / (i + 1)) { c -= 16 / (i + 1); ++i; }
            slut[tid] = (unsigned char)(i < 16 ? ((i << 4) | c) : 0);
        }
        unsigned* szero = (unsigned*)(smem + 12288 + 64);
        if (tid < 16) szero[tid] = 0u;
        __syncthreads();
        int* sidx = (int*)(smem + wave * 3072); float* sval = (float*)(smem + wave * 3072 + 1024);
        int* sid = (int*)(smem + wave * 3072 + 2048); float* sgate = (float*)(smem + wave * 3072 + 2560);
        int lane5 = lane;
        asm volatile("" : "+v"(lane5));
        {
            int t = bid * 4 + wave;
            uint4 tkw = *(const uint4*)((const unsigned*)(P.ws + WS_TK) + (size_t)(t < T2 ? t : 0) * 256 + lane5 * 4);
            for (; t < T2; t += G * 4) { const int tn = t + G * 4; peer_token(P, t, tn < T2 ? tn : t, tkw, lane5, sidx, sval, sid, sgate, slut, szero); }
        }
    }
}

}

extern "C" void kernel_launch(void* const* d_in, const int* in_sizes, int n_in, void* d_out, int out_size, void* d_ws, size_t ws_size, hipStream_t stream) {
    if (n_in != 17 || ws_size < WS_END) { fprintf(stderr, "kernel_launch: unexpected n_in %d or ws_size %zu (need %zu)\n", n_in, ws_size, (size_t)WS_END); return; }
    constexpr int LDS_BYTES = 66560;
    static int grid_blocks = 0;
    if (!grid_blocks) {
        int dev = 0, cus = 0, per_cu = 0;
        (void)hipGetDevice(&dev);
        (void)hipDeviceGetAttribute(&cus, hipDeviceAttributeMultiprocessorCount, dev);
        (void)hipFuncSetAttribute((const void*)mega, hipFuncAttributeMaxDynamicSharedMemorySize, LDS_BYTES);
        (void)hipOccupancyMaxActiveBlocksPerMultiprocessor(&per_cu, (const void*)mega, 256, LDS_BYTES);
        if (per_cu < 1) per_cu = 1;
        if (per_cu > 2) per_cu = 2;
        grid_blocks = cus * per_cu;
        fprintf(stderr, "kernel_launch: cus %d per_cu %d grid %d\n", cus, per_cu, grid_blocks);
    }
    Params P{};
    P.x = (const float*)d_in[0]; P.meta = (const float*)d_in[1]; P.norm_mix = (const float*)d_in[2]; P.w_in = (const float*)d_in[3];
    P.conv_qk = (const float*)d_in[4]; P.b_igate = (const float*)d_in[5]; P.b_fgate_m = (const float*)d_in[6]; P.m_out_norm = (const float*)d_in[7];
    P.b_fgate_f = (const float*)d_in[8]; P.f_q_norm = (const float*)d_in[9]; P.f_k_norm = (const float*)d_in[10]; P.w_out = (const float*)d_in[11];
    P.norm_ffn = (const float*)d_in[12]; P.peer_query = (const float*)d_in[13]; P.peer_keys = (const float*)d_in[14]; P.peer_u = (const float*)d_in[15];
    P.peer_v = (const float*)d_in[16]; P.out = (float*)d_out; P.ws = (unsigned char*)d_ws;
    (void)hipMemsetAsync((unsigned char*)d_ws + WS_CTL, 0, 32768, stream);
    void* args[] = {&P};
    hipError_t e = hipLaunchCooperativeKernel((const void*)mega, dim3(grid_blocks), dim3(256), args, LDS_BYTES, stream);
    if (e != hipSuccess) fprintf(stderr, "cooperative launch failed: %s (grid %d)\n", hipGetErrorString(e), grid_blocks);
}
```

```cpp
#include <hip/hip_runtime.h>
#include <stdint.h>
#include <stdio.h>
#include <hip/hip_cooperative_groups.h>
namespace cg = cooperative_groups;

namespace {

constexpr int NB = 8, SEQ = 2048, DM = 1024, NMETA = 16, L = SEQ + NMETA;
constexpr int T1 = NB * L;
constexpr int T2 = NB * SEQ;
constexpr int NZ = 3584;
constexpr int ZC_MQ = 0, ZC_MK = 512, ZC_MV = 1024, ZC_MO = 1536, ZC_FQ = 2048, ZC_FK = 2560, ZC_FV = 3072;
constexpr int PROJ = 3600;
constexpr float EPS = 1e-6f;

constexpr size_t WS_CTL = 0;
constexpr size_t WS_RA = 65536;
constexpr size_t WS_Z = WS_RA + (size_t)T1 * DM * 2;
constexpr size_t WS_GATES = WS_Z + (size_t)T1 * NZ * 2;
constexpr size_t WS_CUM = WS_GATES + (size_t)T1 * 16 * 4;
constexpr size_t WS_SSQ = WS_CUM + (size_t)NB * 8 * L * 4;
constexpr size_t WS_RSTD = WS_SSQ + (size_t)T2 * 16 * 4;
constexpr size_t WS_SSQM = WS_RSTD + (size_t)T2 * 4;
constexpr size_t WS_BT2 = WS_SSQM + (size_t)T1 * 16 * 4;
constexpr size_t WS_BT3 = WS_BT2 + (size_t)DM * DM * 2;
constexpr size_t WS_KEYS = WS_BT3 + (size_t)2048 * DM * 2;
constexpr size_t WS_MSC = WS_KEYS + (size_t)16 * 128 * 128 * 2;
constexpr size_t WS_MST = WS_MSC + (size_t)128 * 33 * 16;
constexpr size_t WS_BT1 = WS_MST + (size_t)32 * 33 * 36864;
constexpr size_t WS_CBI = WS_BT1;
constexpr size_t WS_UV = WS_CBI + (size_t)32 * 33 * 36864;
constexpr size_t WS_END = WS_UV + (size_t)2 * 16384 * 512 + (size_t)2 * 16384 * 4;
constexpr size_t WS_XN = WS_RA;
constexpr size_t WS_U = WS_UV;
constexpr size_t WS_V = WS_U + (size_t)16384 * 512;
constexpr size_t WS_USC = WS_V + (size_t)16384 * 512;
constexpr size_t WS_VSC = WS_USC + (size_t)16384 * 4;
constexpr size_t WS_TK = WS_CBI;
constexpr float LOG2E = 1.4426950408889634f;

typedef unsigned short bf16_t;
typedef short bf16x8 __attribute__((ext_vector_type(8)));
typedef float f32x4 __attribute__((ext_vector_type(4)));
typedef __attribute__((ext_vector_type(2))) __bf16 bf16x2_t;

struct Params {
    const float* x; const float* meta; const float* norm_mix; const float* w_in; const float* conv_qk;
    const float* b_igate; const float* b_fgate_m; const float* m_out_norm; const float* b_fgate_f;
    const float* f_q_norm; const float* f_k_norm; const float* w_out; const float* norm_ffn;
    const float* peer_query; const float* peer_keys; const float* peer_u; const float* peer_v;
    float* out; unsigned char* ws;
};

__device__ __forceinline__ unsigned f2bf(float f) { unsigned u = __float_as_uint(f); return (u + 0x7fffu + ((u >> 16) & 1u)) >> 16; }
__device__ __forceinline__ float bf2f(unsigned h) { return __uint_as_float(h << 16); }
typedef float f32x2 __attribute__((ext_vector_type(2)));
typedef __bf16 bf16x2v __attribute__((ext_vector_type(2)));
__device__ __forceinline__ unsigned cvt_pk_bf16(float lo, float hi) { f32x2 v = {lo, hi}; bf16x2v b = __builtin_convertvector(v, bf16x2v); return __builtin_bit_cast(unsigned, b); }
__device__ __forceinline__ unsigned pk2(float lo, float hi) { return cvt_pk_bf16(lo, hi); }
__device__ __forceinline__ float bflo(unsigned w) { return __uint_as_float(w << 16); }
__device__ __forceinline__ float bfhi(unsigned w) { return __uint_as_float(w & 0xffff0000u); }
__device__ __forceinline__ float wave_sum(float v) {
#pragma unroll
    for (int o = 32; o > 0; o >>= 1) v += __shfl_xor(v, o, 64);
    return v;
}
__device__ __forceinline__ float wave_max(float v) {
#pragma unroll
    for (int o = 32; o > 0; o >>= 1) v = fmaxf(v, __shfl_xor(v, o, 64));
    return v;
}
__device__ __forceinline__ float logsigmoidf(float x) { return fminf(x, 0.f) - log1pf(expf(-fabsf(x))); }
__device__ __forceinline__ unsigned ord_key(float f) { unsigned u = __float_as_uint(f); return u ^ ((u >> 31) ? 0xffffffffu : 0x80000000u); }
__device__ __forceinline__ float unord_key(unsigned k) { unsigned u = (k & 0x80000000u) ? (k ^ 0x80000000u) : ~k; return __uint_as_float(u); }

__device__ __forceinline__ void prod_job(const Params& P, int hp, int kt8, unsigned char* smem);
__device__ __forceinline__ void phase0(const Params& P, unsigned char* smem) {
    const int tid = threadIdx.x, lane = tid & 63, wave = tid >> 6;
    unsigned* ctl = (unsigned*)(P.ws + WS_CTL);
    float* gw = (float*)smem;
    for (int idx = tid; idx < 16 * 1024; idx += 256) {
        const int k = idx >> 4, c = idx & 15;
        const int col = c < 8 ? 2048 + c : 3592 + (c - 8);
        gw[c * 1024 + k] = P.w_in[(size_t)k * PROJ + col];
    }
    __syncthreads();
    {
        bf16_t* hn = (bf16_t*)(P.ws + WS_RA);
        float* gates = (float*)(P.ws + WS_GATES);
        const int c0 = lane * 8, c1 = 512 + lane * 8;
        float gm[16];
        {
            const float4 a0 = *(const float4*)(P.norm_mix + c0), a1 = *(const float4*)(P.norm_mix + c0 + 4);
            const float4 a2 = *(const float4*)(P.norm_mix + c1), a3 = *(const float4*)(P.norm_mix + c1 + 4);
            gm[0] = a0.x; gm[1] = a0.y; gm[2] = a0.z; gm[3] = a0.w; gm[4] = a1.x; gm[5] = a1.y; gm[6] = a1.z; gm[7] = a1.w;
            gm[8] = a2.x; gm[9] = a2.y; gm[10] = a2.z; gm[11] = a2.w; gm[12] = a3.x; gm[13] = a3.y; gm[14] = a3.z; gm[15] = a3.w;
        }
        const int myq = ((lane >> 5) & 1) * 8 + ((lane >> 4) & 1) * 4 + ((lane >> 3) & 1) * 2 + ((lane >> 2) & 1);
        const float mybias = myq < 4 ? P.b_igate[myq] : (myq < 8 ? P.b_fgate_m[myq - 4] : P.b_fgate_f[myq - 8]);
        const int rstep = gridDim.x * 4;
        int r = blockIdx.x * 4 + wave;
        float4 n0, n1, n2, n3;
        auto load_row = [&](int rr) {
            const int b = rr / L, p = rr - b * L;
            const float* src = (p < NMETA) ? (P.meta + (size_t)p * DM) : (P.x + ((size_t)b * SEQ + (p - NMETA)) * DM);
            n0 = *(const float4*)(src + c0); n1 = *(const float4*)(src + c0 + 4); n2 = *(const float4*)(src + c1); n3 = *(const float4*)(src + c1 + 4);
        };
        if (r < T1) load_row(r);
        for (; r < T1; r += rstep) {
            float v[16];
            v[0] = n0.x; v[1] = n0.y; v[2] = n0.z; v[3] = n0.w; v[4] = n1.x; v[5] = n1.y; v[6] = n1.z; v[7] = n1.w;
            v[8] = n2.x; v[9] = n2.y; v[10] = n2.z; v[11] = n2.w; v[12] = n3.x; v[13] = n3.y; v[14] = n3.z; v[15] = n3.w;
            if (r + rstep < T1) load_row(r + rstep);
            float ss = 0.f;
#pragma unroll
            for (int j = 0; j < 16; ++j) ss += v[j] * v[j];
            ss = wave_sum(ss);
            const float rstd = rsqrtf(ss * (1.0f / DM) + EPS);
#pragma unroll
            for (int j = 0; j < 16; ++j) v[j] *= rstd * gm[j];
            uint4 o0, o1;
            o0.x = pk2(v[0], v[1]); o0.y = pk2(v[2], v[3]); o0.z = pk2(v[4], v[5]); o0.w = pk2(v[6], v[7]);
            o1.x = pk2(v[8], v[9]); o1.y = pk2(v[10], v[11]); o1.z = pk2(v[12], v[13]); o1.w = pk2(v[14], v[15]);
            *(uint4*)(hn + (size_t)r * DM + c0) = o0;
            *(uint4*)(hn + (size_t)r * DM + c1) = o1;
            float r8[8], r4[4], r2[2], r1;
#pragma unroll
            for (int i = 0; i < 8; ++i) {
                float dd[2];
#pragma unroll
                for (int hh = 0; hh < 2; ++hh) {
                    const float* gwc = gw + (i + 8 * hh) * 1024;
                    const float4 w0 = *(const float4*)(gwc + c0), w1 = *(const float4*)(gwc + c0 + 4), w2 = *(const float4*)(gwc + c1), w3 = *(const float4*)(gwc + c1 + 4);
                    dd[hh] = v[0] * w0.x + v[1] * w0.y + v[2] * w0.z + v[3] * w0.w + v[4] * w1.x + v[5] * w1.y + v[6] * w1.z + v[7] * w1.w
                           + v[8] * w2.x + v[9] * w2.y + v[10] * w2.z + v[11] * w2.w + v[12] * w3.x + v[13] * w3.y + v[14] * w3.z + v[15] * w3.w;
                }
                const bool up = (lane & 32) != 0; const float keep = up ? dd[1] : dd[0], send = up ? dd[0] : dd[1];
                r8[i] = keep + __shfl_xor(send, 32, 64);
                if ((i & 3) == 3) __builtin_amdgcn_sched_barrier(0);
            }
#pragma unroll
            for (int i = 0; i < 4; ++i) { const bool up = (lane & 16) != 0; const float keep = up ? r8[i + 4] : r8[i], send = up ? r8[i] : r8[i + 4]; r4[i] = keep + __shfl_xor(send, 16, 64); }
#pragma unroll
            for (int i = 0; i < 2; ++i) { const bool up = (lane & 8) != 0; const float keep = up ? r4[i + 2] : r4[i], send = up ? r4[i] : r4[i + 2]; r2[i] = keep + __shfl_xor(send, 8, 64); }
            { const bool up = (lane & 4) != 0; const float keep = up ? r2[1] : r2[0], send = up ? r2[0] : r2[1]; r1 = keep + __shfl_xor(send, 4, 64); }
            r1 += __shfl_xor(r1, 2, 64); r1 += __shfl_xor(r1, 1, 64);
            if ((lane & 3) == 0) {
                const float pre = r1 + mybias;
                gates[(size_t)r * 16 + myq] = myq < 4 ? pre : logsigmoidf(pre);
            }
        }
    }
    __syncthreads();
    {
        float* tile = (float*)smem;
        for (int item = blockIdx.x; item < 1152; item += gridDim.x) {
            const float* W; int ldn, ntn, shift_from, it; bf16_t* out;
            if (item < 896) { W = P.w_in; ldn = PROJ; ntn = 56; shift_from = 2048; it = item; out = (bf16_t*)(P.ws + WS_BT1); }
            else { W = P.w_out; ldn = 1024; ntn = 16; shift_from = 1 << 30; it = item - 896; out = (bf16_t*)(P.ws + WS_BT2); }
            const int tk = it / ntn, tn = it - tk * ntn, k0 = tk * 64, n0 = tn * 64;
            {
                const int n4 = (tid & 15) * 4, kr = tid >> 4;
                int n = n0 + n4; if (n >= shift_from) n += 8;
                float4 v[4];
#pragma unroll
                for (int i = 0; i < 4; ++i) v[i] = *(const float4*)(W + (size_t)(k0 + kr + 16 * i) * ldn + n);
#pragma unroll
                for (int i = 0; i < 4; ++i) *(float4*)(tile + (kr + 16 * i) * 68 + n4) = v[i];
            }
            __syncthreads();
            {
#pragma unroll
                for (int i = 0; i < 2; ++i) {
                    const int id = tid + 256 * i, nl = id & 63, kc = id >> 6;
                    const float* tp = tile + (kc * 8) * 68 + nl;
                    uint4 o;
                    o.x = pk2(tp[0], tp[68]); o.y = pk2(tp[2 * 68], tp[3 * 68]); o.z = pk2(tp[4 * 68], tp[5 * 68]); o.w = pk2(tp[6 * 68], tp[7 * 68]);
                    *(uint4*)(out + (size_t)(n0 + nl) * 1024 + k0 + kc * 8) = o;
                }
            }
            __syncthreads();
        }
    }
    for (int job = (int)gridDim.x - 1 - (int)blockIdx.x; job < 128; job += gridDim.x) prod_job(P, job >> 3, job & 7, smem);
}

__device__ __forceinline__ void convert_uv_rows(const Params& P, int gwave, int nwaves, int lane) {
    for (int rr0 = gwave * 4; rr0 < 2 * 16384; rr0 += nwaves * 4) {
        float4 a[4][4];
#pragma unroll
        for (int q = 0; q < 4; ++q) {
            const int rr = rr0 + q, which = rr >> 14, row = rr & 16383;
            const float* src = (which ? P.peer_v : P.peer_u) + (size_t)row * DM + lane * 16;
            a[q][0] = *(const float4*)(src); a[q][1] = *(const float4*)(src + 4); a[q][2] = *(const float4*)(src + 8); a[q][3] = *(const float4*)(src + 12);
        }
#pragma unroll
        for (int q = 0; q < 4; ++q) {
            const int rr = rr0 + q, which = rr >> 14, row = rr & 16383;
            float mx = 0.f;
#pragma unroll
            for (int j = 0; j < 4; ++j) mx = fmaxf(mx, fmaxf(fmaxf(fabsf(a[q][j].x), fabsf(a[q][j].y)), fmaxf(fabsf(a[q][j].z), fabsf(a[q][j].w))));
            mx = wave_max(mx);
            const float sc = mx > 0.f ? 6.0f / mx : 1.0f;
            unsigned w0 = 0u, w1 = 0u;
            w0 = __builtin_amdgcn_cvt_scalef32_pk_fp4_f32(w0, a[q][0].x * sc, a[q][0].y * sc, 1.0f, 0); w0 = __builtin_amdgcn_cvt_scalef32_pk_fp4_f32(w0, a[q][0].z * sc, a[q][0].w * sc, 1.0f, 1);
            w0 = __builtin_amdgcn_cvt_scalef32_pk_fp4_f32(w0, a[q][1].x * sc, a[q][1].y * sc, 1.0f, 2); w0 = __builtin_amdgcn_cvt_scalef32_pk_fp4_f32(w0, a[q][1].z * sc, a[q][1].w * sc, 1.0f, 3);
            w1 = __builtin_amdgcn_cvt_scalef32_pk_fp4_f32(w1, a[q][2].x * sc, a[q][2].y * sc, 1.0f, 0); w1 = __builtin_amdgcn_cvt_scalef32_pk_fp4_f32(w1, a[q][2].z * sc, a[q][2].w * sc, 1.0f, 1);
            w1 = __builtin_amdgcn_cvt_scalef32_pk_fp4_f32(w1, a[q][3].x * sc, a[q][3].y * sc, 1.0f, 2); w1 = __builtin_amdgcn_cvt_scalef32_pk_fp4_f32(w1, a[q][3].z * sc, a[q][3].w * sc, 1.0f, 3);
            *(uint2*)(P.ws + (which ? WS_V : WS_U) + (size_t)row * 512 + lane * 8) = make_uint2(w0, w1);
            if (lane == 0) ((float*)(P.ws + (which ? WS_VSC : WS_USC)))[row] = mx > 0.f ? mx * (1.0f / 6.0f) : 1.0f;
        }
    }
}

__device__ __forceinline__ void bitonic_sort16_desc(unsigned (&v)[16]) {
#pragma unroll
    for (int k = 2; k <= 16; k <<= 1)
#pragma unroll
        for (int j = k >> 1; j >= 1; j >>= 1)
#pragma unroll
            for (int i = 0; i < 16; ++i)
                if ((i & j) == 0) {
                    const int p = i | j;
                    const bool desc = (k >= 16) ? true : ((i & k) == 0);
                    const unsigned hi = max(v[i], v[p]), lo = min(v[i], v[p]);
                    v[i] = desc ? hi : lo; v[p] = desc ? lo : hi;
                }
}
__device__ __forceinline__ void bitonic_merge16_top(unsigned (&a)[16], const unsigned (&b)[16]) {
#pragma unroll
    for (int i = 0; i < 16; ++i) a[i] = max(a[i], b[15 - i]);
#pragma unroll
    for (int j = 8; j >= 1; j >>= 1)
#pragma unroll
        for (int i = 0; i < 16; ++i)
            if ((i & j) == 0) { const int p = i | j; const unsigned hi = max(a[i], a[p]), lo = min(a[i], a[p]); a[i] = hi; a[p] = lo; }
}

__device__ __forceinline__ float x4_max(float x) {
    const unsigned xi = __float_as_uint(x);
    const auto r = __builtin_amdgcn_permlane32_swap(xi, xi, false, false);
    const float m = fmaxf(__uint_as_float(r[0]), __uint_as_float(r[1]));
    const unsigned mi = __float_as_uint(m);
    const auto r2 = __builtin_amdgcn_permlane16_swap(mi, mi, false, false);
    return fmaxf(__uint_as_float(r2[0]), __uint_as_float(r2[1]));
}
__device__ __forceinline__ float x4_sum(float x) {
    const unsigned xi = __float_as_uint(x);
    const auto r = __builtin_amdgcn_permlane32_swap(xi, xi, false, false);
    const float m = __uint_as_float(r[0]) + __uint_as_float(r[1]);
    const unsigned mi = __float_as_uint(m);
    const auto r2 = __builtin_amdgcn_permlane16_swap(mi, mi, false, false);
    return __uint_as_float(r2[0]) + __uint_as_float(r2[1]);
}

__device__ __forceinline__ int opaque_tid() { int t = threadIdx.x; asm volatile("" : "+v"(t)); return t; }

__device__ __forceinline__ void mma_ktile(const unsigned char* sA, const unsigned char* sB, int arow_off, int brow_off, int g, int sw, f32x4 (&acc)[4][4]) {
#pragma unroll
    for (int s = 0; s < 2; ++s) {
        bf16x8 a[4], b[4];
        const int ch = (((s * 4 + g) ^ sw) << 4);
#pragma unroll
        for (int i = 0; i < 4; ++i) a[i] = *(const bf16x8*)(sA + arow_off + i * 2048 + ch);
#pragma unroll
        for (int j = 0; j < 4; ++j) b[j] = *(const bf16x8*)(sB + brow_off + j * 2048 + ch);
#pragma unroll
        for (int i = 0; i < 4; ++i)
#pragma unroll
            for (int j = 0; j < 4; ++j) acc[i][j] = __builtin_amdgcn_mfma_f32_16x16x32_bf16(b[j], a[i], acc[i][j], 0, 0, 0);
    }
}

__device__ __forceinline__ void store_tile_bf16(const f32x4 (&acc)[4][4], unsigned char* smem, bf16_t* dst, size_t ld, int m0, int n0, int tid, int wr, int wc, int g, int lr) {
#pragma unroll
    for (int i = 0; i < 4; ++i)
#pragma unroll
        for (int j = 0; j < 4; ++j) {
            const int row = wr * 64 + 16 * i + lr, col = wc * 64 + 16 * j + 4 * g;
            uint2 w; w.x = pk2(acc[i][j][0], acc[i][j][1]); w.y = pk2(acc[i][j][2], acc[i][j][3]);
            *(uint2*)(smem + row * 272 + col * 2) = w;
        }
    __syncthreads();
#pragma unroll
    for (int q = 0; q < 8; ++q) {
        const int id = tid + 256 * q, row = id >> 4, ch = id & 15;
        const uint4 v = *(const uint4*)(smem + row * 272 + ch * 16);
        *(uint4*)(dst + (size_t)(m0 + row) * ld + n0 + ch * 8) = v;
    }
    __syncthreads();
}

__device__ __forceinline__ void prod_job(const Params& P, int hp, int kt8, unsigned char* smem) {
    const int tid = opaque_tid(), lane = tid & 63, wave = tid >> 6, wr = wave >> 1, wc = wave & 1, g = lane >> 4, lr = lane & 15;
    const int srow = tid >> 3, sc = tid & 7;
    unsigned char* sA0 = smem; unsigned char* sB0 = smem + 16384; unsigned char* sA1 = smem + 32768; unsigned char* sB1 = smem + 49152;
    const int soff0 = srow * 128 + ((sc ^ (srow & 7)) << 4);
    const float* Ak = P.peer_keys + (size_t)hp * 128 * 128 + (size_t)srow * 128 + sc * 8;
    const float* Bq = P.peer_query + (size_t)(kt8 * 128 + srow) * 2048 + hp * 128 + sc * 8;
#pragma unroll
    for (int j = 0; j < 4; ++j) {
#pragma unroll
        for (int hk = 0; hk < 2; ++hk) {
            const float4 a0 = *(const float4*)(Ak + (size_t)(32 * j) * 128 + 64 * hk), a1 = *(const float4*)(Ak + (size_t)(32 * j) * 128 + 64 * hk + 4);
            const float4 b0 = *(const float4*)(Bq + (size_t)(32 * j) * 2048 + 64 * hk), b1 = *(const float4*)(Bq + (size_t)(32 * j) * 2048 + 64 * hk + 4);
            uint4 ua, ub;
            ua.x = pk2(a0.x, a0.y); ua.y = pk2(a0.z, a0.w); ua.z = pk2(a1.x, a1.y); ua.w = pk2(a1.z, a1.w);
            ub.x = pk2(b0.x, b0.y); ub.y = pk2(b0.z, b0.w); ub.z = pk2(b1.x, b1.y); ub.w = pk2(b1.z, b1.w);
            *(uint4*)((hk ? sA1 : sA0) + soff0 + j * 4096) = ua;
            *(uint4*)((hk ? sB1 : sB0) + soff0 + j * 4096) = ub;
        }
    }
    __syncthreads();
    f32x4 acc[4][4];
#pragma unroll
    for (int i = 0; i < 4; ++i)
#pragma unroll
        for (int j = 0; j < 4; ++j) acc[i][j] = (f32x4){0.f, 0.f, 0.f, 0.f};
    const int arow_off = (wr * 64 + lr) * 128, brow_off = (wc * 64 + lr) * 128, sw = lr & 7;
    mma_ktile(sA0, sB0, arow_off, brow_off, g, sw, acc);
    mma_ktile(sA1, sB1, arow_off, brow_off, g, sw, acc);
    __syncthreads();
    store_tile_bf16(acc, smem, (bf16_t*)(P.ws + WS_BT3), 1024, hp * 128, kt8 * 128, tid, wr, wc, g, lr);
}

template <int MODE>
__device__ __forceinline__ void gemm_tile(const Params& P, int tm, int tn, unsigned char* smem) {
    const bf16_t* A; const bf16_t* Bt;
    if (MODE == 1) { A = (const bf16_t*)(P.ws + WS_RA); Bt = (const bf16_t*)(P.ws + WS_BT1); }
    else if (MODE == 2) { A = (const bf16_t*)(P.ws + WS_Z); Bt = (const bf16_t*)(P.ws + WS_BT2); }
    else { A = (const bf16_t*)(P.ws + WS_XN); Bt = (const bf16_t*)(P.ws + WS_BT3); }
    const int tid = opaque_tid(), lane = tid & 63, wave = tid >> 6, wr = wave >> 1, wc = wave & 1, g = lane >> 4, lr = lane & 15;
    const int m0 = tm * 128, n0 = tn * 128;
    const int srow = tid >> 3, sc = tid & 7;
    constexpr unsigned LDA = (MODE == 2 ? NZ : 1024) * 2u;
    unsigned aoff, boff; int soff0;
    {
        int ar = m0 + srow;
        if (MODE == 2) { const int b = ar >> 11, t = ar & 2047; ar = b * L + NMETA + t; }
        aoff = (unsigned)ar * LDA + (unsigned)sc * 16u;
        boff = (unsigned)(n0 + srow) * 2048u + (unsigned)sc * 16u;
        soff0 = srow * 128 + ((sc ^ (srow & 7)) << 4);
    }
    const unsigned char* Ab = (const unsigned char*)A; const unsigned char* Bb = (const unsigned char*)Bt;
    float4 ssp0, ssp1, ssp2, ssp3;
    if (MODE == 3) {
        const float* ssq = (const float*)(P.ws + WS_SSQ) + (size_t)(m0 + wr * 64 + lr) * 16 + 4 * g;
        ssp0 = *(const float4*)(ssq); ssp1 = *(const float4*)(ssq + 16 * 16); ssp2 = *(const float4*)(ssq + 32 * 16); ssp3 = *(const float4*)(ssq + 48 * 16);
    }
    f32x4 acc[4][4];
#pragma unroll
    for (int i = 0; i < 4; ++i)
#pragma unroll
        for (int j = 0; j < 4; ++j) acc[i][j] = (f32x4){0.f, 0.f, 0.f, 0.f};
    uint4 ra0, ra1, ra2, ra3, rb0, rb1, rb2, rb3;
#define G_LOAD(KT) { const unsigned ko = (unsigned)(KT) * 128u; \
        ra0 = *(const uint4*)(Ab + (aoff + ko)); ra1 = *(const uint4*)(Ab + (aoff + 32u * LDA + ko)); ra2 = *(const uint4*)(Ab + (aoff + 64u * LDA + ko)); ra3 = *(const uint4*)(Ab + (aoff + 96u * LDA + ko)); \
        rb0 = *(const uint4*)(Bb + (boff + ko)); rb1 = *(const uint4*)(Bb + (boff + 32u * 2048u + ko)); rb2 = *(const uint4*)(Bb + (boff + 64u * 2048u + ko)); rb3 = *(const uint4*)(Bb + (boff + 96u * 2048u + ko)); }
#define G_WRITE(SA, SB) { *(uint4*)((SA) + soff0) = ra0; *(uint4*)((SA) + soff0 + 4096) = ra1; *(uint4*)((SA) + soff0 + 8192) = ra2; *(uint4*)((SA) + soff0 + 12288) = ra3; \
        *(uint4*)((SB) + soff0) = rb0; *(uint4*)((SB) + soff0 + 4096) = rb1; *(uint4*)((SB) + soff0 + 8192) = rb2; *(uint4*)((SB) + soff0 + 12288) = rb3; }
    unsigned char* sA0 = smem; unsigned char* sB0 = smem + 16384; unsigned char* sA1 = smem + 32768; unsigned char* sB1 = smem + 49152;
    G_LOAD(0)
    G_WRITE(sA0, sB0)
    __syncthreads();
    const int arow_off = (wr * 64 + lr) * 128, brow_off = (wc * 64 + lr) * 128, sw = lr & 7;
    G_LOAD(1)
    for (int kt = 0; kt < 16; ++kt) {
        unsigned char* sA = (kt & 1) ? sA1 : sA0; unsigned char* sB = (kt & 1) ? sB1 : sB0;
        unsigned char* nA = (kt & 1) ? sA0 : sA1; unsigned char* nB = (kt & 1) ? sB0 : sB1;
        bf16x8 fa[4], fb[4], ga[4], gb[4];
        const int ch0 = ((g ^ sw) << 4), ch1 = (((4 + g) ^ sw) << 4);
        const unsigned ko = (unsigned)(kt + 2) * 128u;
        const bool wr_ok = kt < 15, ld_ok = kt < 14;
#pragma unroll
        for (int i = 0; i < 4; ++i) { fa[i] = *(const bf16x8*)(sA + arow_off + i * 2048 + ch0); fb[i] = *(const bf16x8*)(sB + brow_off + i * 2048 + ch0); }
        __builtin_amdgcn_sched_barrier(0);
        __builtin_amdgcn_s_setprio(2);
        if (wr_ok) *(uint4*)(nA + soff0) = ra0;
        if (ld_ok) ra0 = *(const uint4*)(Ab + (aoff + 0u * LDA + ko));
        ga[0] = *(const bf16x8*)(sA + arow_off + 0 * 2048 + ch1); gb[0] = *(const bf16x8*)(sB + brow_off + 0 * 2048 + ch1);
        __builtin_amdgcn_sched_barrier(0);
#pragma unroll
        for (int j = 0; j < 4; ++j) acc[0][j] = __builtin_amdgcn_mfma_f32_16x16x32_bf16(fb[j], fa[0], acc[0][j], 0, 0, 0);
        __builtin_amdgcn_sched_barrier(0);
        if (wr_ok) *(uint4*)(nA + soff0 + 4096) = ra1;
        if (ld_ok) ra1 = *(const uint4*)(Ab + (aoff + 32u * LDA + ko));
        ga[1] = *(const bf16x8*)(sA + arow_off + 1 * 2048 + ch1); gb[1] = *(const bf16x8*)(sB + brow_off + 1 * 2048 + ch1);
        __builtin_amdgcn_sched_barrier(0);
#pragma unroll
        for (int j = 0; j < 4; ++j) acc[1][j] = __builtin_amdgcn_mfma_f32_16x16x32_bf16(fb[j], fa[1], acc[1][j], 0, 0, 0);
        __builtin_amdgcn_sched_barrier(0);
        if (wr_ok) *(uint4*)(nA + soff0 + 8192) = ra2;
        if (ld_ok) ra2 = *(const uint4*)(Ab + (aoff + 64u * LDA + ko));
        ga[2] = *(const bf16x8*)(sA + arow_off + 2 * 2048 + ch1); gb[2] = *(const bf16x8*)(sB + brow_off + 2 * 2048 + ch1);
        __builtin_amdgcn_sched_barrier(0);
#pragma unroll
        for (int j = 0; j < 4; ++j) acc[2][j] = __builtin_amdgcn_mfma_f32_16x16x32_bf16(fb[j], fa[2], acc[2][j], 0, 0, 0);
        __builtin_amdgcn_sched_barrier(0);
        if (wr_ok) *(uint4*)(nA + soff0 + 12288) = ra3;
        if (ld_ok) ra3 = *(const uint4*)(Ab + (aoff + 96u * LDA + ko));
        ga[3] = *(const bf16x8*)(sA + arow_off + 3 * 2048 + ch1); gb[3] = *(const bf16x8*)(sB + brow_off + 3 * 2048 + ch1);
        __builtin_amdgcn_sched_barrier(0);
#pragma unroll
        for (int j = 0; j < 4; ++j) acc[3][j] = __builtin_amdgcn_mfma_f32_16x16x32_bf16(fb[j], fa[3], acc[3][j], 0, 0, 0);
        __builtin_amdgcn_sched_barrier(0);
        if (wr_ok) *(uint4*)(nB + soff0) = rb0;
        if (ld_ok) rb0 = *(const uint4*)(Bb + (boff + 0u * 2048u + ko));
        __builtin_amdgcn_sched_barrier(0);
#pragma unroll
        for (int j = 0; j < 4; ++j) acc[0][j] = __builtin_amdgcn_mfma_f32_16x16x32_bf16(gb[j], ga[0], acc[0][j], 0, 0, 0);
        __builtin_amdgcn_sched_barrier(0);
        if (wr_ok) *(uint4*)(nB + soff0 + 4096) = rb1;
        if (ld_ok) rb1 = *(const uint4*)(Bb + (boff + 32u * 2048u + ko));
        __builtin_amdgcn_sched_barrier(0);
#pragma unroll
        for (int j = 0; j < 4; ++j) acc[1][j] = __builtin_amdgcn_mfma_f32_16x16x32_bf16(gb[j], ga[1], acc[1][j], 0, 0, 0);
        __builtin_amdgcn_sched_barrier(0);
        if (wr_ok) *(uint4*)(nB + soff0 + 8192) = rb2;
        if (ld_ok) rb2 = *(const uint4*)(Bb + (boff + 64u * 2048u + ko));
        __builtin_amdgcn_sched_barrier(0);
#pragma unroll
        for (int j = 0; j < 4; ++j) acc[2][j] = __builtin_amdgcn_mfma_f32_16x16x32_bf16(gb[j], ga[2], acc[2][j], 0, 0, 0);
        __builtin_amdgcn_sched_barrier(0);
        if (wr_ok) *(uint4*)(nB + soff0 + 12288) = rb3;
        if (ld_ok) rb3 = *(const uint4*)(Bb + (boff + 96u * 2048u + ko));
        __builtin_amdgcn_sched_barrier(0);
#pragma unroll
        for (int j = 0; j < 4; ++j) acc[3][j] = __builtin_amdgcn_mfma_f32_16x16x32_bf16(gb[j], ga[3], acc[3][j], 0, 0, 0);
        __builtin_amdgcn_s_setprio(0);
        __syncthreads();
    }
#undef G_LOAD
#undef G_WRITE
    if (MODE == 1) {
        if (n0 >= ZC_FQ && n0 < ZC_FV) {
            const bool isk = n0 >= ZC_FK;
            const float* gain = isk ? P.f_k_norm : P.f_q_norm;
            const float scl = isk ? 1.0f : 0.125f * LOG2E;
            float gn[4][4];
#pragma unroll
            for (int j = 0; j < 4; ++j)
#pragma unroll
                for (int r = 0; r < 4; ++r) gn[j][r] = gain[16 * j + 4 * g + r];
#pragma unroll
            for (int i = 0; i < 4; ++i) {
                float ss = 0.f;
#pragma unroll
                for (int j = 0; j < 4; ++j)
#pragma unroll
                    for (int r = 0; r < 4; ++r) ss += acc[i][j][r] * acc[i][j][r];
                ss = x4_sum(ss);
                const float rstd = rsqrtf(ss * (1.0f / 64.0f) + EPS) * scl;
#pragma unroll
                for (int j = 0; j < 4; ++j)
#pragma unroll
                    for (int r = 0; r < 4; ++r) acc[i][j][r] *= rstd * gn[j][r];
            }
        }
        store_tile_bf16(acc, smem, (bf16_t*)(P.ws + WS_Z), NZ, m0, n0, tid, wr, wc, g, lr);
    } else if (MODE == 2) {
        float* ssq = (float*)(P.ws + WS_SSQ);
#pragma unroll
        for (int i = 0; i < 4; ++i) {
            const int row = m0 + wr * 64 + 16 * i + lr;
            float ss = 0.f;
#pragma unroll
            for (int j = 0; j < 4; ++j) {
                const int col = n0 + wc * 64 + 16 * j + 4 * g;
                const float4 xv = *(const float4*)(P.x + (size_t)row * DM + col);
                const float4 gv = *(const float4*)(P.norm_ffn + col);
                float4 hv; hv.x = acc[i][j][0] + xv.x; hv.y = acc[i][j][1] + xv.y; hv.z = acc[i][j][2] + xv.z; hv.w = acc[i][j][3] + xv.w;
                ss += hv.x * hv.x + hv.y * hv.y + hv.z * hv.z + hv.w * hv.w;
                acc[i][j][0] = hv.x * gv.x; acc[i][j][1] = hv.y * gv.y; acc[i][j][2] = hv.z * gv.z; acc[i][j][3] = hv.w * gv.w;
            }
            ss = x4_sum(ss);
            if (g == 0) ssq[(size_t)row * 16 + tn * 2 + wc] = ss;
        }
        store_tile_bf16(acc, smem, (bf16_t*)(P.ws + WS_XN), 1024, m0, n0, tid, wr, wc, g, lr);
    } else {
        const int hp = tn;
        float rs[4];
#pragma unroll
        for (int i = 0; i < 4; ++i) {
            const int row = m0 + wr * 64 + 16 * i + lr;
            const float4 sp = i == 0 ? ssp0 : i == 1 ? ssp1 : i == 2 ? ssp2 : ssp3;
            const float s = x4_sum((sp.x + sp.y) + (sp.z + sp.w));
            rs[i] = rsqrtf(s * (1.0f / DM) + EPS);
            if (tn == 0 && wc == 0 && g == 0) ((float*)(P.ws + WS_RSTD))[row] = rs[i];
        }
#pragma unroll
        for (int i = 0; i < 4; ++i)
#pragma unroll
            for (int j = 0; j < 4; ++j) {
                const int row = wr * 64 + 16 * i + lr;
                const int c4 = wc * 16 + 4 * j + g;
                *(f32x4*)(smem + row * 512 + ((c4 ^ (row & 31)) << 4)) = acc[i][j] * rs[i];
            }
        __syncthreads();
        unsigned top[16];
        const int row = tid & 127, half = tid >> 7;
        {
            auto load_keys = [&](unsigned (&dst)[16], int q4) {
#pragma unroll
                for (int s4 = 0; s4 < 4; ++s4) {
                    const int c4 = half * 16 + q4 * 4 + s4;
                    const f32x4 v = *(const f32x4*)(smem + row * 512 + ((c4 ^ (row & 31)) << 4));
#pragma unroll
                    for (int e = 0; e < 4; ++e) dst[s4 * 4 + e] = (ord_key(v[e]) & ~127u) | (unsigned)(127 - (c4 * 4 + e));
                }
            };
            load_keys(top, 0);
            bitonic_sort16_desc(top);
#pragma unroll 1
            for (int q4 = 1; q4 < 4; ++q4) {
                unsigned gq[16];
                load_keys(gq, q4);
                bitonic_sort16_desc(gq);
                bitonic_merge16_top(top, gq);
            }
        }
        __syncthreads();
        if (half) {
            uint4* lp = (uint4*)(smem + row * 64);
            lp[0] = make_uint4(top[0], top[1], top[2], top[3]); lp[1] = make_uint4(top[4], top[5], top[6], top[7]);
            lp[2] = make_uint4(top[8], top[9], top[10], top[11]); lp[3] = make_uint4(top[12], top[13], top[14], top[15]);
        }
        __syncthreads();
        if (!half) {
            const uint4* lp = (const uint4*)(smem + row * 64);
            unsigned other[16];
#pragma unroll
            for (int c = 0; c < 4; ++c) { const uint4 o = lp[c]; other[4 * c] = o.x; other[4 * c + 1] = o.y; other[4 * c + 2] = o.z; other[4 * c + 3] = o.w; }
            bitonic_merge16_top(top, other);
            uint4* tk = (uint4*)((unsigned*)(P.ws + WS_TK) + ((size_t)(m0 + row) * 16 + hp) * 16);
            tk[0] = make_uint4(top[0], top[1], top[2], top[3]); tk[1] = make_uint4(top[4], top[5], top[6], top[7]);
            tk[2] = make_uint4(top[8], top[9], top[10], top[11]); tk[3] = make_uint4(top[12], top[13], top[14], top[15]);
        }
        __syncthreads();
    }
}

__device__ __forceinline__ void fox_cum_wave(const Params& P, int bh, int lane) {
    const int b = bh >> 3, h = bh & 7;
    const float* gates = (const float*)(P.ws + WS_GATES) + (size_t)b * L * 16 + 8 + h;
    float* cum = (float*)(P.ws + WS_CUM) + (size_t)bh * L;
    constexpr int SEG = 33;
    const int t0 = lane * SEG;
    float v[SEG];
#pragma unroll
    for (int i = 0; i < SEG; ++i) { const int t = t0 + i; const float x = gates[(size_t)(t < L ? t : L - 1) * 16]; v[i] = t < L ? x : 0.f; }
    float loc = 0.f;
#pragma unroll
    for (int i = 0; i < SEG; ++i) loc += v[i];
    float incl = loc;
#pragma unroll
    for (int o = 1; o < 64; o <<= 1) { const float n = __shfl_up(incl, o, 64); if (lane >= o) incl += n; }
    float run = incl - loc;
#pragma unroll
    for (int i = 0; i < SEG; ++i) { const int t = t0 + i; run += v[i]; if (t < L) cum[t] = run * LOG2E; }
}

#define TR_SLOW 0

__device__ __forceinline__ int vimg_off(int row, int ch) { return row * 128 + ((ch ^ (((row >> 1) & 3) << 1)) << 4); }
__device__ __forceinline__ uint2 tr_frag(const unsigned char* img, int row0, int c, int g, int lr) {
#if TR_SLOW
    unsigned short e[4];
#pragma unroll
    for (int k = 0; k < 4; ++k) { const int row = row0 + 4 * g + k, col = 16 * c + lr; e[k] = *(const unsigned short*)(img + vimg_off(row, col >> 3) + (col & 7) * 2); }
    uint2 r; r.x = (unsigned)e[0] | ((unsigned)e[1] << 16); r.y = (unsigned)e[2] | ((unsigned)e[3] << 16); return r;
#else
    const int q = lr >> 2, p = lr & 3, row = row0 + 4 * g + q;
    const unsigned addr = (unsigned)(size_t)(img + vimg_off(row, 2 * c + (p >> 1)) + 8 * (p & 1));
    uint2 r;
    asm volatile("ds_read_b64_tr_b16 %0, %1\n\ts_waitcnt lgkmcnt(0)" : "=&v"(r) : "v"(addr) : "memory");
    return r;
#endif
}

__device__ __forceinline__ unsigned tr_lane_addr(const unsigned char* img, int c, int g, int lr) {
    const int q = lr >> 2, p = lr & 3, row = 4 * g + q;
    return (unsigned)(size_t)(img + vimg_off(row, 2 * c + (p >> 1)) + 8 * (p & 1));
}
#define TR_GROUP(o0, o1, o2, o3, a) "ds_read_b64_tr_b16 %" #o0 ", %" #a "\n\tds_read_b64_tr_b16 %" #o1 ", %" #a " offset:2048\n\tds_read_b64_tr_b16 %" #o2 ", %" #a " offset:4096\n\tds_read_b64_tr_b16 %" #o3 ", %" #a " offset:6144\n\t"
__device__ __forceinline__ void tr_read_4c(const unsigned char* img, int g, int lr, uint2 (&r)[4][4]) {
    const unsigned a0 = tr_lane_addr(img, 0, g, lr), a1 = tr_lane_addr(img, 1, g, lr), a2 = tr_lane_addr(img, 2, g, lr), a3 = tr_lane_addr(img, 3, g, lr);
    asm volatile(TR_GROUP(0, 1, 2, 3, 16) TR_GROUP(4, 5, 6, 7, 17) TR_GROUP(8, 9, 10, 11, 18) TR_GROUP(12, 13, 14, 15, 19) "s_waitcnt lgkmcnt(0)"
        : "=&v"(r[0][0]), "=&v"(r[0][1]), "=&v"(r[0][2]), "=&v"(r[0][3]), "=&v"(r[1][0]), "=&v"(r[1][1]), "=&v"(r[1][2]), "=&v"(r[1][3]),
          "=&v"(r[2][0]), "=&v"(r[2][1]), "=&v"(r[2][2]), "=&v"(r[2][3]), "=&v"(r[3][0]), "=&v"(r[3][1]), "=&v"(r[3][2]), "=&v"(r[3][3])
        : "v"(a0), "v"(a1), "v"(a2), "v"(a3) : "memory");
}
__device__ __forceinline__ void tr_read_3c(const unsigned char* img, int g, int lr, uint2 (&r)[3][4]) {
    const unsigned a0 = tr_lane_addr(img, 0, g, lr), a1 = tr_lane_addr(img, 1, g, lr), a2 = tr_lane_addr(img, 2, g, lr);
    asm volatile(TR_GROUP(0, 1, 2, 3, 12) TR_GROUP(4, 5, 6, 7, 13) TR_GROUP(8, 9, 10, 11, 14) "s_waitcnt lgkmcnt(0)"
        : "=&v"(r[0][0]), "=&v"(r[0][1]), "=&v"(r[0][2]), "=&v"(r[0][3]), "=&v"(r[1][0]), "=&v"(r[1][1]), "=&v"(r[1][2]), "=&v"(r[1][3]),
          "=&v"(r[2][0]), "=&v"(r[2][1]), "=&v"(r[2][2]), "=&v"(r[2][3])
        : "v"(a0), "v"(a1), "v"(a2) : "memory");
}
__device__ __forceinline__ void tr_read_2(const unsigned char* img0, int c0, const unsigned char* img1, int c1, int g, int lr, uint2 (&r)[2][4]) {
    const unsigned a0 = tr_lane_addr(img0, c0, g, lr), a1 = tr_lane_addr(img1, c1, g, lr);
    asm volatile(TR_GROUP(0, 1, 2, 3, 8) TR_GROUP(4, 5, 6, 7, 9) "s_waitcnt lgkmcnt(0)"
        : "=&v"(r[0][0]), "=&v"(r[0][1]), "=&v"(r[0][2]), "=&v"(r[0][3]), "=&v"(r[1][0]), "=&v"(r[1][1]), "=&v"(r[1][2]), "=&v"(r[1][3])
        : "v"(a0), "v"(a1) : "memory");
}
__device__ __forceinline__ bf16x8 tr_pair(const uint2& lo, const uint2& hi) { uint4 u; u.x = lo.x; u.y = lo.y; u.z = hi.x; u.w = hi.y; return __builtin_bit_cast(bf16x8, u); }

__device__ __forceinline__ void attn_block(const Params& P, int bh, int qb, unsigned char* smem) {
    const int tid = opaque_tid(), lane = tid & 63, w = tid >> 6, g = lane >> 4, lr = lane & 15;
    const int b = bh >> 3, h = bh & 7;
    const bf16_t* z = (const bf16_t*)(P.ws + WS_Z);
    const float* cum = (const float*)(P.ws + WS_CUM) + (size_t)bh * L;
    int tq[2]; bool qvalid[2]; bf16x8 qf[2][2];
#pragma unroll
    for (int u = 0; u < 2; ++u) {
        tq[u] = qb * 128 + 32 * w + 16 * u + lr;
        qvalid[u] = tq[u] < L;
        const bf16_t* qp = z + (size_t)(b * L + (qvalid[u] ? tq[u] : 0)) * NZ + ZC_FQ + h * 64 + 8 * g;
        qf[u][0] = *(const bf16x8*)(qp); qf[u][1] = *(const bf16x8*)(qp + 32);
    }
    const int nkv = (2 * qb + 2 < 33) ? 2 * qb + 2 : 33;
    const int srow0 = tid >> 3, sch = tid & 7;
    uint4 rk0, rk1, rv0, rv1; float rc = 0.f;
    auto load_tile = [&](int kv) {
        const int key0 = kv * 64 + srow0, key1 = key0 + 32;
        const bf16_t* p0 = z + (size_t)(b * L + (key0 < L ? key0 : L - 1)) * NZ + h * 64 + sch * 8;
        const bf16_t* p1 = z + (size_t)(b * L + (key1 < L ? key1 : L - 1)) * NZ + h * 64 + sch * 8;
        rk0 = *(const uint4*)(p0 + ZC_FK); rv0 = *(const uint4*)(p0 + ZC_FV);
        rk1 = *(const uint4*)(p1 + ZC_FK); rv1 = *(const uint4*)(p1 + ZC_FV);
        const int keyc = kv * 64 + (tid & 63);
        rc = cum[keyc < L ? keyc : L - 1];
    };
    auto store_tile = [&](int buf) {
        unsigned char* sK = smem + buf * 16384; unsigned char* sV = sK + 8192;
        const int row0 = srow0, row1 = srow0 + 32;
        *(uint4*)(sK + row0 * 128 + ((sch ^ (row0 & 7)) << 4)) = rk0;
        *(uint4*)(sV + vimg_off(row0, sch)) = rv0;
        *(uint4*)(sK + row1 * 128 + ((sch ^ (row1 & 7)) << 4)) = rk1;
        *(uint4*)(sV + vimg_off(row1, sch)) = rv1;
        if (tid < 64) ((float*)(smem + 32768 + buf * 256))[tid] = rc;
    };
    float m[2] = {-1e30f, -1e30f};
    f32x4 o[2][5];
#pragma unroll
    for (int u = 0; u < 2; ++u)
#pragma unroll
        for (int c = 0; c < 5; ++c) o[u][c] = (f32x4){0.f, 0.f, 0.f, 0.f};
    const unsigned onew = (lr == 0) ? 0x3F803F80u : 0u;
    const bf16x8 vones = __builtin_bit_cast(bf16x8, make_uint4(onew, onew, onew, onew));
    load_tile(nkv - 1); store_tile((nkv - 1) & 1);
    __syncthreads();
    if (nkv > 1) load_tile(nkv - 2);
    for (int kv = nkv - 1; kv >= 0; --kv) {
        const int buf = kv & 1;
        const unsigned char* sK = smem + buf * 16384; const unsigned char* sV = sK + 8192;
        const float* sck = (const float*)(smem + 32768 + buf * 256);
        f32x4 sa[2][4];
#pragma unroll
        for (int c = 0; c < 4; ++c) {
            sa[0][c] = (f32x4){0.f, 0.f, 0.f, 0.f}; sa[1][c] = (f32x4){0.f, 0.f, 0.f, 0.f};
#pragma unroll
            for (int s = 0; s < 2; ++s) {
                const bf16x8 kf = *(const bf16x8*)(sK + (16 * c + lr) * 128 + (((4 * s + g) ^ (lr & 7)) << 4));
                sa[0][c] = __builtin_amdgcn_mfma_f32_16x16x32_bf16(kf, qf[0][s], sa[0][c], 0, 0, 0);
                sa[1][c] = __builtin_amdgcn_mfma_f32_16x16x32_bf16(kf, qf[1][s], sa[1][c], 0, 0, 0);
            }
        }
        __builtin_amdgcn_sched_barrier(0);
        if (kv > 0) store_tile(buf ^ 1);
        if (kv > 1) load_tile(kv - 2);
        __builtin_amdgcn_sched_barrier(0);
        if (kv >= 2 * qb) {
#pragma unroll
            for (int u = 0; u < 2; ++u)
#pragma unroll
                for (int c = 0; c < 4; ++c)
#pragma unroll
                    for (int r = 0; r < 4; ++r)
                        if (64 * kv + 16 * c + 4 * g + r > tq[u]) sa[u][c][r] = -INFINITY;
        }
        f32x4 ck[4];
#pragma unroll
        for (int c = 0; c < 4; ++c) ck[c] = *(const f32x4*)(sck + 16 * c + 4 * g);
        bf16x8 pf[2][2];
#pragma unroll
        for (int u = 0; u < 2; ++u) {
            float mx = -INFINITY;
#pragma unroll
            for (int c = 0; c < 4; ++c) {
                sa[u][c] -= ck[c];
                mx = fmaxf(mx, fmaxf(fmaxf(sa[u][c][0], sa[u][c][1]), fmaxf(sa[u][c][2], sa[u][c][3])));
            }
            mx = x4_max(mx);
            if (__builtin_amdgcn_ballot_w64(mx > m[u]) != 0ull) {
                const float mn = fmaxf(m[u], mx);
                const float alpha = __builtin_amdgcn_exp2f(m[u] - mn);
                m[u] = mn;
#pragma unroll
                for (int c = 0; c < 5; ++c) o[u][c] *= alpha;
            }
            const float mn = m[u];
#pragma unroll
            for (int c = 0; c < 4; ++c)
#pragma unroll
                for (int r = 0; r < 4; ++r) sa[u][c][r] = __builtin_amdgcn_exp2f(sa[u][c][r] - mn);
#pragma unroll
            for (int s2 = 0; s2 < 2; ++s2) {
                uint4 uu;
                uu.x = cvt_pk_bf16(sa[u][2 * s2][0], sa[u][2 * s2][1]); uu.y = cvt_pk_bf16(sa[u][2 * s2][2], sa[u][2 * s2][3]);
                uu.z = cvt_pk_bf16(sa[u][2 * s2 + 1][0], sa[u][2 * s2 + 1][1]); uu.w = cvt_pk_bf16(sa[u][2 * s2 + 1][2], sa[u][2 * s2 + 1][3]);
                pf[u][s2] = __builtin_bit_cast(bf16x8, uu);
            }
        }
        {
            uint2 vr[4][4];
            tr_read_4c(sV, g, lr, vr);
#pragma unroll
            for (int c = 0; c < 4; ++c)
#pragma unroll
                for (int s2 = 0; s2 < 2; ++s2) {
                    const bf16x8 vf = tr_pair(vr[c][2 * s2], vr[c][2 * s2 + 1]);
                    o[0][c] = __builtin_amdgcn_mfma_f32_16x16x32_bf16(vf, pf[0][s2], o[0][c], 0, 0, 0);
                    o[1][c] = __builtin_amdgcn_mfma_f32_16x16x32_bf16(vf, pf[1][s2], o[1][c], 0, 0, 0);
                }
#pragma unroll
            for (int s2 = 0; s2 < 2; ++s2) {
                o[0][4] = __builtin_amdgcn_mfma_f32_16x16x32_bf16(vones, pf[0][s2], o[0][4], 0, 0, 0);
                o[1][4] = __builtin_amdgcn_mfma_f32_16x16x32_bf16(vones, pf[1][s2], o[1][4], 0, 0, 0);
            }
        }
        __syncthreads();
    }
#pragma unroll
    for (int u = 0; u < 2; ++u) {
        const float ls = __shfl(o[u][4][0], lr, 64);
        const float inv = 1.0f / ls;
        if (qvalid[u]) {
            bf16_t* y = (bf16_t*)(P.ws + WS_Z) + (size_t)(b * L + tq[u]) * NZ + 512 + h * 64 + 4 * g;
#pragma unroll
            for (int c = 0; c < 4; ++c) {
                uint2 uu; uu.x = pk2(o[u][c][0] * inv, o[u][c][1] * inv); uu.y = pk2(o[u][c][2] * inv, o[u][c][3] * inv);
                *(uint2*)(y + 16 * c) = uu;
            }
        }
    }
}

__device__ __forceinline__ void conv_item(const Params& P, int ci) {
    const int tid = opaque_tid(), cc = tid & 127, rg = tid >> 7;
    const bf16_t* z = (const bf16_t*)(P.ws + WS_Z);
    bf16_t* qk = (bf16_t*)(P.ws + WS_RA);
    const int col0 = cc * 8;
    float w[4][8];
#pragma unroll
    for (int j = 0; j < 4; ++j) {
        const float4 a = *(const float4*)(P.conv_qk + j * 1024 + col0), b = *(const float4*)(P.conv_qk + j * 1024 + col0 + 4);
        w[j][0] = a.x; w[j][1] = a.y; w[j][2] = a.z; w[j][3] = a.w; w[j][4] = b.x; w[j][5] = b.y; w[j][6] = b.z; w[j][7] = b.w;
    }
    const float oscale = (col0 >= 512) ? 0.08838834764831845f : 1.0f;
    const int r0 = ci * 64 + rg * 32;
    int t = r0 % L;
    float xw[3][8];
#pragma unroll
    for (int j = 0; j < 3; ++j) {
        const int back = 3 - j;
        if (t - back >= 0) {
            const uint4 v = *(const uint4*)(z + (size_t)(r0 - back) * NZ + col0);
            xw[j][0] = bflo(v.x); xw[j][1] = bfhi(v.x); xw[j][2] = bflo(v.y); xw[j][3] = bfhi(v.y); xw[j][4] = bflo(v.z); xw[j][5] = bfhi(v.z); xw[j][6] = bflo(v.w); xw[j][7] = bfhi(v.w);
        } else {
#pragma unroll
            for (int e = 0; e < 8; ++e) xw[j][e] = 0.f;
        }
    }
#pragma unroll 2
    for (int i = 0; i < 32; ++i) {
        const int r = r0 + i;
        if (t == 0) {
#pragma unroll
            for (int j = 0; j < 3; ++j)
#pragma unroll
                for (int e = 0; e < 8; ++e) xw[j][e] = 0.f;
        }
        const uint4 v = *(const uint4*)(z + (size_t)r * NZ + col0);
        float xt[8];
        xt[0] = bflo(v.x); xt[1] = bfhi(v.x); xt[2] = bflo(v.y); xt[3] = bfhi(v.y); xt[4] = bflo(v.z); xt[5] = bfhi(v.z); xt[6] = bflo(v.w); xt[7] = bfhi(v.w);
        float o[8];
#pragma unroll
        for (int e = 0; e < 8; ++e) {
            const float cv = w[0][e] * xw[0][e] + w[1][e] * xw[1][e] + w[2][e] * xw[2][e] + w[3][e] * xt[e];
            o[e] = oscale * cv / (1.f + __expf(-cv));
            xw[0][e] = xw[1][e]; xw[1][e] = xw[2][e]; xw[2][e] = xt[e];
        }
        uint4 ov; ov.x = pk2(o[0], o[1]); ov.y = pk2(o[2], o[3]); ov.z = pk2(o[4], o[5]); ov.w = pk2(o[6], o[7]);
        *(uint4*)(qk + (size_t)r * 1024 + col0) = ov;
        t = (t + 1 == L) ? 0 : t + 1;
    }
}

constexpr int ST_IMG = 36864;
__device__ __forceinline__ int st_piece_off(int jt, int c, int g, int lr) { return (jt >> 2) * 18432 + vimg_off(16 * c + lr, 2 * (jt & 3) + (g >> 1)) + 8 * (g & 1); }

__device__ __forceinline__ void mlstm_stage_kv(const Params& P, int b, int h, int k, unsigned char* sKimg, unsigned char* sVimg, int tid) {
    const bf16_t* z = (const bf16_t*)(P.ws + WS_Z);
    const bf16_t* qk = (const bf16_t*)(P.ws + WS_RA);
    uint4 pk_[4], pv_[4];
#pragma unroll
    for (int j = 0; j < 4; ++j) {
        const int id = tid + 256 * j, row = id >> 4, ch16 = id & 15, pos = 64 * k + row;
        const bool ok = pos < L;
        pk_[j] = ok ? *(const uint4*)(qk + (size_t)(b * L + pos) * 1024 + 512 + h * 128 + ch16 * 8) : make_uint4(0, 0, 0, 0);
        pv_[j] = ok ? *(const uint4*)(z + (size_t)(b * L + pos) * NZ + ZC_MV + h * 128 + ch16 * 8) : make_uint4(0, 0, 0, 0);
    }
#pragma unroll
    for (int j = 0; j < 4; ++j) {
        const int id = tid + 256 * j, row = id >> 4, ch16 = id & 15;
        *(uint4*)(sKimg + (ch16 >> 3) * 8192 + vimg_off(row, ch16 & 7)) = pk_[j];
        *(uint4*)(sVimg + (ch16 >> 3) * 8192 + vimg_off(row, ch16 & 7)) = pv_[j];
    }
    if (tid < 128) {
        const int row = tid >> 1, ch = tid & 1;
        *(uint4*)(sVimg + 16384 + vimg_off(row, ch)) = ch ? make_uint4(0, 0, 0, 0) : make_uint4(0x3F80u, 0, 0, 0);
    }
}

__device__ __forceinline__ void mlstm_stage_A(const Params& P, int b, int h, int k, unsigned char* sKimg, unsigned char* sVimg, int tid) {
    const bf16_t* z = (const bf16_t*)(P.ws + WS_Z);
    bf16_t* qk = (bf16_t*)(P.ws + WS_RA);
    uint4 pv_[4];
#pragma unroll
    for (int j = 0; j < 4; ++j) {
        const int id = tid + 256 * j, row = id >> 4, ch16 = id & 15, pos = 64 * k + row;
        pv_[j] = (pos < L) ? *(const uint4*)(z + (size_t)(b * L + pos) * NZ + ZC_MV + h * 128 + ch16 * 8) : make_uint4(0, 0, 0, 0);
    }
    const int cch = tid & 31, rg = tid >> 5, isk = cch >> 4;
    const int zcol = (isk ? ZC_MK : ZC_MQ) + h * 128 + (cch & 15) * 8;
    float w[4][8];
#pragma unroll
    for (int j = 0; j < 4; ++j) {
        const float4 a = *(const float4*)(P.conv_qk + j * 1024 + zcol), c = *(const float4*)(P.conv_qk + j * 1024 + zcol + 4);
        w[j][0] = a.x; w[j][1] = a.y; w[j][2] = a.z; w[j][3] = a.w; w[j][4] = c.x; w[j][5] = c.y; w[j][6] = c.z; w[j][7] = c.w;
    }
    const float oscale = isk ? 0.08838834764831845f : 1.0f;
    const int p0 = 64 * k + 8 * rg;
    uint4 raw[11];
#pragma unroll
    for (int i = 0; i < 11; ++i) {
        const int pos = p0 - 3 + i;
        raw[i] = (pos >= 0 && pos < L) ? *(const uint4*)(z + (size_t)(b * L + pos) * NZ + zcol) : make_uint4(0, 0, 0, 0);
    }
#pragma unroll
    for (int j = 0; j < 4; ++j) {
        const int id = tid + 256 * j, row = id >> 4, ch16 = id & 15;
        *(uint4*)(sVimg + (ch16 >> 3) * 8192 + vimg_off(row, ch16 & 7)) = pv_[j];
    }
    if (tid < 128) {
        const int row = tid >> 1, ch = tid & 1;
        *(uint4*)(sVimg + 16384 + vimg_off(row, ch)) = ch ? make_uint4(0, 0, 0, 0) : make_uint4(0x3F80u, 0, 0, 0);
    }
#pragma unroll
    for (int i = 0; i < 8; ++i) {
        const int pos = p0 + i, row = 8 * rg + i;
        float o[8];
#pragma unroll
        for (int e = 0; e < 8; ++e) {
            const unsigned w0 = (&raw[i].x)[e >> 1], w1 = (&raw[i + 1].x)[e >> 1], w2 = (&raw[i + 2].x)[e >> 1], w3 = (&raw[i + 3].x)[e >> 1];
            const float x0 = (e & 1) ? bfhi(w0) : bflo(w0), x1 = (e & 1) ? bfhi(w1) : bflo(w1), x2 = (e & 1) ? bfhi(w2) : bflo(w2), x3 = (e & 1) ? bfhi(w3) : bflo(w3);
            const float cv = w[0][e] * x0 + w[1][e] * x1 + w[2][e] * x2 + w[3][e] * x3;
            o[e] = oscale * cv / (1.f + __expf(-cv));
        }
        uint4 ov; ov.x = pk2(o[0], o[1]); ov.y = pk2(o[2], o[3]); ov.z = pk2(o[4], o[5]); ov.w = pk2(o[6], o[7]);
        const bool ok = pos < L;
        if (!ok) ov = make_uint4(0, 0, 0, 0);
        if (ok) *(uint4*)(qk + (size_t)(b * L + pos) * 1024 + (isk ? 512 : 0) + h * 128 + (cch & 15) * 8) = ov;
        if (isk) { const int ch16 = cch & 15; *(uint4*)(sKimg + (ch16 >> 3) * 8192 + vimg_off(row, ch16 & 7)) = ov; }
    }
}

__device__ __forceinline__ void mlstm_A(const Params& P, int item, unsigned char* smem) {
    const int tid = opaque_tid(), lane = tid & 63, w = tid >> 6, g = lane >> 4, lr = lane & 15;
    const int wu = __builtin_amdgcn_readfirstlane(w);
    const int k = item >> 5, bh = item & 31, b = bh >> 2, h = bh & 3;
    const float* gates = (const float*)(P.ws + WS_GATES);
    const unsigned char* sK = smem; const unsigned char* sV = smem + 16384;
    float* ga = (float*)(smem + 40960);
    float lf = 0.f, li = -INFINITY;
    if (wu == 0) {
        const int pos = 64 * k + lane;
        if (pos < L) { lf = gates[(size_t)(b * L + pos) * 16 + 4 + h]; li = gates[(size_t)(b * L + pos) * 16 + h]; }
    }
    mlstm_stage_A(P, b, h, k, smem, smem + 16384, tid);
    if (wu == 0) {
        float bc = lf;
#pragma unroll
        for (int o = 1; o < 64; o <<= 1) { const float n = __shfl_up(bc, o, 64); if (lane >= o) bc += n; }
        const float a = li - bc;
        const float A = wave_max(a);
        ga[lane] = __expf(a - A);
        if (lane == 63) { float* msc = (float*)(P.ws + WS_MSC) + ((size_t)bh * 33 + k) * 4; msc[0] = A; msc[1] = bc; }
    }
    __syncthreads();
    f32x4 Ct[2][9];
#pragma unroll
    for (int a = 0; a < 2; ++a)
#pragma unroll
        for (int c = 0; c < 9; ++c) Ct[a][c] = (f32x4){0.f, 0.f, 0.f, 0.f};
    bf16x8 kt[2][2];
#pragma unroll
    for (int a = 0; a < 2; ++a)
#pragma unroll
        for (int s2 = 0; s2 < 2; ++s2) {
            const int jt = 2 * w + a;
            kt[a][s2] = tr_pair(tr_frag(sK + (jt >> 2) * 8192, 32 * s2, jt & 3, g, lr), tr_frag(sK + (jt >> 2) * 8192, 32 * s2 + 16, jt & 3, g, lr));
        }
    f32x4 wg4[4];
#pragma unroll
    for (int j = 0; j < 4; ++j) wg4[j] = *(const f32x4*)(ga + 16 * j + 4 * g);
#define MA_TILE(c, lo0, hi0, lo1, hi1) { \
        { const f32x4 w0 = wg4[0], w1 = wg4[1]; uint4 o; \
          o.x = cvt_pk_bf16(bflo(lo0.x) * w0[0], bfhi(lo0.x) * w0[1]); o.y = cvt_pk_bf16(bflo(lo0.y) * w0[2], bfhi(lo0.y) * w0[3]); \
          o.z = cvt_pk_bf16(bflo(hi0.x) * w1[0], bfhi(hi0.x) * w1[1]); o.w = cvt_pk_bf16(bflo(hi0.y) * w1[2], bfhi(hi0.y) * w1[3]); \
          const bf16x8 vw = __builtin_bit_cast(bf16x8, o); \
          Ct[0][c] = __builtin_amdgcn_mfma_f32_16x16x32_bf16(kt[0][0], vw, Ct[0][c], 0, 0, 0); Ct[1][c] = __builtin_amdgcn_mfma_f32_16x16x32_bf16(kt[1][0], vw, Ct[1][c], 0, 0, 0); } \
        { const f32x4 w0 = wg4[2], w1 = wg4[3]; uint4 o; \
          o.x = cvt_pk_bf16(bflo(lo1.x) * w0[0], bfhi(lo1.x) * w0[1]); o.y = cvt_pk_bf16(bflo(lo1.y) * w0[2], bfhi(lo1.y) * w0[3]); \
          o.z = cvt_pk_bf16(bflo(hi1.x) * w1[0], bfhi(hi1.x) * w1[1]); o.w = cvt_pk_bf16(bflo(hi1.y) * w1[2], bfhi(hi1.y) * w1[3]); \
          const bf16x8 vw = __builtin_bit_cast(bf16x8, o); \
          Ct[0][c] = __builtin_amdgcn_mfma_f32_16x16x32_bf16(kt[0][1], vw, Ct[0][c], 0, 0, 0); Ct[1][c] = __builtin_amdgcn_mfma_f32_16x16x32_bf16(kt[1][1], vw, Ct[1][c], 0, 0, 0); } }
    {
        uint2 vr[4][4];
        tr_read_4c(sV, g, lr, vr);
        MA_TILE(0, vr[0][0], vr[0][1], vr[0][2], vr[0][3]) MA_TILE(1, vr[1][0], vr[1][1], vr[1][2], vr[1][3])
        MA_TILE(2, vr[2][0], vr[2][1], vr[2][2], vr[2][3]) MA_TILE(3, vr[3][0], vr[3][1], vr[3][2], vr[3][3])
        tr_read_4c(sV + 8192, g, lr, vr);
        MA_TILE(4, vr[0][0], vr[0][1], vr[0][2], vr[0][3]) MA_TILE(5, vr[1][0], vr[1][1], vr[1][2], vr[1][3])
        MA_TILE(6, vr[2][0], vr[2][1], vr[2][2], vr[2][3]) MA_TILE(7, vr[3][0], vr[3][1], vr[3][2], vr[3][3])
        const uint2 o0 = tr_frag(sV + 16384, 0, 0, g, lr), o1 = tr_frag(sV + 16384, 16, 0, g, lr), o2 = tr_frag(sV + 16384, 32, 0, g, lr), o3 = tr_frag(sV + 16384, 48, 0, g, lr);
        MA_TILE(8, o0, o1, o2, o3)
    }
#undef MA_TILE
    unsigned char* slot = P.ws + WS_MST + ((size_t)bh * 33 + k) * ST_IMG;
#pragma unroll
    for (int a = 0; a < 2; ++a)
#pragma unroll
        for (int c = 0; c < 9; ++c) {
            uint2 u; u.x = cvt_pk_bf16(Ct[a][c][0], Ct[a][c][1]); u.y = cvt_pk_bf16(Ct[a][c][2], Ct[a][c][3]);
            *(uint2*)(slot + st_piece_off(2 * w + a, c, g, lr)) = u;
        }
}

__device__ __forceinline__ void mlstm_B(const Params& P, int item) {
    const int tid = opaque_tid();
    const int bh = item / 3, part = item - bh * 3;
    const unsigned char* base = P.ws + WS_MST + (size_t)bh * 33 * ST_IMG + part * 12288 + tid * 48;
    unsigned char* obase = P.ws + WS_CBI + (size_t)bh * 33 * ST_IMG + part * 12288 + tid * 48;
    float* msc = (float*)(P.ws + WS_MSC) + (size_t)bh * 33 * 4;
    float C[6][4];
#pragma unroll
    for (int i = 0; i < 6; ++i)
#pragma unroll
        for (int r = 0; r < 4; ++r) C[i][r] = 0.f;
    float m = 0.f;
    uint2 d0[6], d1[6];
    float2 ab0, ab1;
#pragma unroll
    for (int i = 0; i < 6; ++i) { d0[i] = *(const uint2*)(base + i * 8); d1[i] = *(const uint2*)(base + ST_IMG + i * 8); }
    ab0 = *(const float2*)(msc); ab1 = *(const float2*)(msc + 4);
    for (int k = 0; k < 33; ++k) {
        uint2 d2[6]; float2 ab2 = make_float2(0.f, 0.f);
        if (k + 2 < 33) {
#pragma unroll
            for (int i = 0; i < 6; ++i) d2[i] = *(const uint2*)(base + (size_t)(k + 2) * ST_IMG + i * 8);
            ab2 = *(const float2*)(msc + (k + 2) * 4);
        } else {
#pragma unroll
            for (int i = 0; i < 6; ++i) d2[i] = make_uint2(0, 0);
        }
#pragma unroll
        for (int i = 0; i < 6; ++i) {
            uint2 u; u.x = cvt_pk_bf16(C[i][0], C[i][1]); u.y = cvt_pk_bf16(C[i][2], C[i][3]);
            *(uint2*)(obase + (size_t)k * ST_IMG + i * 8) = u;
        }
        if (tid == 0 && part == 0) msc[k * 4 + 2] = m;
        const float M = fmaxf(m, ab0.x);
        const float decay = __expf(m - M), sc = __expf(ab0.x - M);
#pragma unroll
        for (int i = 0; i < 6; ++i) {
            C[i][0] = decay * C[i][0] + sc * bflo(d0[i].x); C[i][1] = decay * C[i][1] + sc * bfhi(d0[i].x);
            C[i][2] = decay * C[i][2] + sc * bflo(d0[i].y); C[i][3] = decay * C[i][3] + sc * bfhi(d0[i].y);
        }
        m = ab0.y + M;
#pragma unroll
        for (int i = 0; i < 6; ++i) { d0[i] = d1[i]; d1[i] = d2[i]; }
        ab0 = ab1; ab1 = ab2;
    }
}

__device__ __forceinline__ void mlstm_C(const Params& P, int item, unsigned char* smem) {
    const int tid = opaque_tid(), lane = tid & 63, w = tid >> 6, g = lane >> 4, lr = lane & 15;
    const int wu = __builtin_amdgcn_readfirstlane(w);
    const int k = item >> 5, bh = item & 31, b = bh >> 2, h = bh & 3;
    const bf16_t* z = (const bf16_t*)(P.ws + WS_Z);
    const bf16_t* qk = (const bf16_t*)(P.ws + WS_RA);
    const float* gates = (const float*)(P.ws + WS_GATES);
    bf16_t* y = (bf16_t*)(P.ws + WS_Z);
    const unsigned char* sK = smem; const unsigned char* sV = smem + 36864; unsigned char* sCb = smem;
    float* ga = (float*)(smem + 61440);
    const int pos = 64 * k + 16 * w + lr;
    const bool tvalid = pos < L;
    const size_t rrow = (size_t)(b * L + (tvalid ? pos : 0));
    const unsigned char* cslot = P.ws + WS_CBI + ((size_t)bh * 33 + k) * ST_IMG + tid * 16;
    const uint4 cb0 = *(const uint4*)(cslot), cb1 = *(const uint4*)(cslot + 4096), cb2 = *(const uint4*)(cslot + 8192), cb3 = *(const uint4*)(cslot + 12288), cb4 = *(const uint4*)(cslot + 16384),
                cb5 = *(const uint4*)(cslot + 20480), cb6 = *(const uint4*)(cslot + 24576), cb7 = *(const uint4*)(cslot + 28672), cb8 = *(const uint4*)(cslot + 32768);
    bf16x8 qf[4];
    {
        const bf16_t* qp = qk + rrow * 1024 + h * 128 + 8 * g;
#pragma unroll
        for (int ks = 0; ks < 4; ++ks) { qf[ks] = *(const bf16x8*)(qp + 32 * ks); if (!tvalid) qf[ks] = (bf16x8){0, 0, 0, 0, 0, 0, 0, 0}; }
    }
    float m_prev = 0.f, lf = 0.f, li = -INFINITY;
    if (wu == 0) {
        m_prev = ((const float*)(P.ws + WS_MSC))[((size_t)bh * 33 + k) * 4 + 2];
        const int p2 = 64 * k + lane;
        if (p2 < L) { lf = gates[(size_t)(b * L + p2) * 16 + 4 + h]; li = gates[(size_t)(b * L + p2) * 16 + h]; }
    }
    mlstm_stage_kv(P, b, h, k, smem, smem + 36864, tid);
    if (wu == 0) {
        float bc = lf;
#pragma unroll
        for (int o = 1; o < 64; o <<= 1) { const float n = __shfl_up(bc, o, 64); if (lane >= o) bc += n; }
        const float a = li - bc;
        float am = a;
#pragma unroll
        for (int o = 1; o < 64; o <<= 1) { const float n = __shfl_up(am, o, 64); if (lane >= o) am = fmaxf(am, n); }
        const float M = fmaxf(m_prev, am);
        ga[lane] = a; ga[64 + lane] = __expf(m_prev - M); ga[128 + lane] = __expf(-(bc + M)); ga[192 + lane] = M;
    }
    __syncthreads();
    const float Mt = ga[192 + 16 * w + lr], Wi = ga[64 + 16 * w + lr], Et = ga[128 + 16 * w + lr];
    bf16x8 pf[2];
    {
        f32x4 sa[4];
#pragma unroll
        for (int c = 0; c < 4; ++c) {
            sa[c] = (f32x4){0.f, 0.f, 0.f, 0.f};
            if (c <= wu) {
#pragma unroll
                for (int ks = 0; ks < 4; ++ks) {
                    const bf16x8 kf = *(const bf16x8*)(sK + (ks >> 1) * 8192 + vimg_off(16 * c + lr, 4 * (ks & 1) + g));
                    sa[c] = __builtin_amdgcn_mfma_f32_16x16x32_bf16(kf, qf[ks], sa[c], 0, 0, 0);
                }
                const f32x4 av = *(const f32x4*)(ga + 16 * c + 4 * g);
#pragma unroll
                for (int r = 0; r < 4; ++r) {
                    const float d = __expf(av[r] - Mt);
                    sa[c][r] = (16 * c + 4 * g + r <= 16 * w + lr) ? sa[c][r] * d : 0.f;
                }
            }
        }
#pragma unroll
        for (int s2 = 0; s2 < 2; ++s2) {
            uint4 u;
            u.x = cvt_pk_bf16(sa[2 * s2][0], sa[2 * s2][1]); u.y = cvt_pk_bf16(sa[2 * s2][2], sa[2 * s2][3]);
            u.z = cvt_pk_bf16(sa[2 * s2 + 1][0], sa[2 * s2 + 1][1]); u.w = cvt_pk_bf16(sa[2 * s2 + 1][2], sa[2 * s2 + 1][3]);
            pf[s2] = __builtin_bit_cast(bf16x8, u);
        }
    }
    __syncthreads();
    {
        unsigned char* d = sCb + tid * 16;
        *(uint4*)(d) = cb0; *(uint4*)(d + 4096) = cb1; *(uint4*)(d + 8192) = cb2; *(uint4*)(d + 12288) = cb3; *(uint4*)(d + 16384) = cb4;
        *(uint4*)(d + 20480) = cb5; *(uint4*)(d + 24576) = cb6; *(uint4*)(d + 28672) = cb7; *(uint4*)(d + 32768) = cb8;
    }
    __syncthreads();
    f32x4 na[9];
#define MC_TILE(c, lo0, hi0, lo1, hi1) { \
        na[c] = (f32x4){0.f, 0.f, 0.f, 0.f}; \
        _Pragma("unroll") for (int ks = 0; ks < 4; ++ks) { \
            const bf16x8 cf = *(const bf16x8*)(sCb + (ks >> 1) * 18432 + vimg_off(16 * (c) + lr, 4 * (ks & 1) + g)); \
            na[c] = __builtin_amdgcn_mfma_f32_16x16x32_bf16(cf, qf[ks], na[c], 0, 0, 0); } \
        na[c] *= Wi; \
        na[c] = __builtin_amdgcn_mfma_f32_16x16x32_bf16(tr_pair(lo0, hi0), pf[0], na[c], 0, 0, 0); \
        na[c] = __builtin_amdgcn_mfma_f32_16x16x32_bf16(tr_pair(lo1, hi1), pf[1], na[c], 0, 0, 0); }
    {
        uint2 vr[4][4];
        tr_read_4c(sV, g, lr, vr);
        MC_TILE(0, vr[0][0], vr[0][1], vr[0][2], vr[0][3]) MC_TILE(1, vr[1][0], vr[1][1], vr[1][2], vr[1][3])
        MC_TILE(2, vr[2][0], vr[2][1], vr[2][2], vr[2][3]) MC_TILE(3, vr[3][0], vr[3][1], vr[3][2], vr[3][3])
        tr_read_4c(sV + 8192, g, lr, vr);
        MC_TILE(4, vr[0][0], vr[0][1], vr[0][2], vr[0][3]) MC_TILE(5, vr[1][0], vr[1][1], vr[1][2], vr[1][3])
        MC_TILE(6, vr[2][0], vr[2][1], vr[2][2], vr[2][3]) MC_TILE(7, vr[3][0], vr[3][1], vr[3][2], vr[3][3])
        const uint2 o0 = tr_frag(sV + 16384, 0, 0, g, lr), o1 = tr_frag(sV + 16384, 16, 0, g, lr), o2 = tr_frag(sV + 16384, 32, 0, g, lr), o3 = tr_frag(sV + 16384, 48, 0, g, lr);
        MC_TILE(8, o0, o1, o2, o3)
    }
#undef MC_TILE
    const float den = __shfl(na[8][0], lr, 64);
    const float rden = 1.0f / fmaxf(fabsf(den), Et);
    float hs = 0.f;
#pragma unroll
    for (int c = 0; c < 8; ++c) { na[c] *= rden; hs += na[c][0] * na[c][0] + na[c][1] * na[c][1] + na[c][2] * na[c][2] + na[c][3] * na[c][3]; }
    hs = x4_sum(hs);
    const float rstd = rsqrtf(hs * (1.0f / 128.0f) + EPS);
    const float* gainp = P.m_out_norm + h * 128 + 4 * g;
#pragma unroll
    for (int c = 0; c < 8; ++c) {
        const uint2 og = *(const uint2*)(z + rrow * NZ + ZC_MO + h * 128 + 16 * c + 4 * g);
        const float o0 = bflo(og.x), o1 = bfhi(og.x), o2 = bflo(og.y), o3 = bfhi(og.y);
        const float4 gn = *(const float4*)(gainp + 16 * c);
        uint2 u;
        u.x = pk2(na[c][0] * rstd * gn.x / (1.f + __expf(-o0)), na[c][1] * rstd * gn.y / (1.f + __expf(-o1)));
        u.y = pk2(na[c][2] * rstd * gn.z / (1.f + __expf(-o2)), na[c][3] * rstd * gn.w / (1.f + __expf(-o3)));
        if (tvalid) *(uint2*)(y + rrow * NZ + h * 128 + 16 * c + 4 * g) = u;
    }
}

__device__ __forceinline__ void peer_token(const Params& P, int t, int tnext, uint4& tkw, int lane, int* sidx, float* sval, int* sid, float* sgate, const unsigned char* slut, const unsigned* szero) {
    {
        const unsigned kk[4] = {tkw.x, tkw.y, tkw.z, tkw.w};
#pragma unroll
        for (int i = 0; i < 4; ++i) {
            const unsigned k = kk[i];
            sidx[lane * 4 + i] = 127 - (int)(k & 127u);
            sval[lane * 4 + i] = unord_key(k & ~127u);
        }
        tkw = *(const uint4*)((const unsigned*)(P.ws + WS_TK) + (size_t)tnext * 256 + lane * 4);
    }
    const bf16_t* xn = (const bf16_t*)(P.ws + WS_XN) + (size_t)t * DM;
    const uint4 xa_pre = *(const uint4*)(xn + lane * 16), xb_pre = *(const uint4*)(xn + lane * 16 + 8);
    const float rstd = ((const float*)(P.ws + WS_RSTD))[t];
    __builtin_amdgcn_s_waitcnt(0xc07f);
    __builtin_amdgcn_wave_barrier();
    {
        const int hd = lane >> 3, sub = lane & 7;
        unsigned x[8];
#pragma unroll
        for (int r = 0; r < 8; ++r) {
            const int c = sub * 8 + r;
            const unsigned ij = slut[c < 50 ? c : 0];
            const int i = ij >> 4, j = ij & 15;
            const unsigned kx = (ord_key(sval[(2 * hd) * 16 + i] + sval[(2 * hd + 1) * 16 + j]) & ~255u) | (unsigned)(255 - (i * 16 + j));
            x[r] = c < 50 ? kx : 0u;
        }
#pragma unroll
        for (int k = 2; k <= 64; k <<= 1) {
#pragma unroll
            for (int j = k >> 1; j >= 1; j >>= 1) {
                if (j >= 8) {
                    const int ld = j >> 3;
                    const bool lower = (sub & ld) == 0;
                    const bool desc = k >= 64 ? true : ((sub * 8) & k) == 0;
                    const bool takemax = (lower == desc);
#pragma unroll
                    for (int r = 0; r < 8; ++r) {
                        const unsigned o = (unsigned)__shfl_xor((int)x[r], ld, 64);
                        const unsigned hi = max(x[r], o), lo = min(x[r], o);
                        x[r] = takemax ? hi : lo;
                    }
                } else {
#pragma unroll
                    for (int r = 0; r < 8; ++r) {
                        if ((r & j) == 0) {
                            const int p = r | j;
                            const unsigned hi = max(x[r], x[p]), lo = min(x[r], x[p]);
                            if (k <= 4) { const bool desc = (r & k) == 0; x[r] = desc ? hi : lo; x[p] = desc ? lo : hi; }
                            else if (k >= 64) { x[r] = hi; x[p] = lo; }
                            else { const bool desc = ((sub * 8) & k) == 0; x[r] = desc ? hi : lo; x[p] = desc ? lo : hi; }
                        }
                    }
                }
            }
        }
        const float smax = unord_key((unsigned)__shfl((int)x[0], hd * 8, 64) & ~255u);
        float e[8]; float den = 0.f;
#pragma unroll
        for (int r = 0; r < 8; ++r) { e[r] = __expf(unord_key(x[r] & ~255u) - smax); den += e[r]; }
        den += __shfl_xor(den, 1, 64);
        const float inv = 1.f / den;
        if (sub < 2) {
#pragma unroll
            for (int r = 0; r < 8; ++r) {
                const int pos = 255 - (int)(x[r] & 255u), i = pos >> 4, j = pos & 15;
                sid[hd * 16 + sub * 8 + r] = sidx[(2 * hd) * 16 + i] * 128 + sidx[(2 * hd + 1) * 16 + j];
                sgate[hd * 16 + sub * 8 + r] = e[r] * inv;
            }
        }
    }
    __builtin_amdgcn_s_waitcnt(0xc07f);
    __builtin_amdgcn_wave_barrier();
    const unsigned char* V = P.ws + WS_V + lane * 8;
    const float* usc = (const float*)(P.ws + WS_USC);
    const float* vsc = (const float*)(P.ws + WS_VSC);
    const int g = lane >> 4, lr = lane & 15;
    unsigned char* shi = (unsigned char*)sval;
    unsigned char* slo = (unsigned char*)sidx;
    {
        const uint4 xa = xa_pre, xb = xb_pre;
        const unsigned xw[8] = {xa.x, xa.y, xa.z, xa.w, xb.x, xb.y, xb.z, xb.w};
        unsigned hi[4], lo[4];
#pragma unroll
        for (int i = 0; i < 4; ++i) {
            const float x0 = bflo(xw[2 * i]), x1 = bfhi(xw[2 * i]), x2 = bflo(xw[2 * i + 1]), x3 = bfhi(xw[2 * i + 1]);
            int wd = 0;
            wd = __builtin_amdgcn_cvt_pk_fp8_f32(x0, x1, wd, false);
            wd = __builtin_amdgcn_cvt_pk_fp8_f32(x2, x3, wd, true);
            const f32x2 h01 = __builtin_amdgcn_cvt_pk_f32_fp8(wd, false), h23 = __builtin_amdgcn_cvt_pk_f32_fp8(wd, true);
            int wl = 0;
            wl = __builtin_amdgcn_cvt_pk_fp8_f32(x0 - h01.x, x1 - h01.y, wl, false);
            wl = __builtin_amdgcn_cvt_pk_fp8_f32(x2 - h23.x, x3 - h23.y, wl, true);
            hi[i] = (unsigned)wd; lo[i] = (unsigned)wl;
        }
        *(uint4*)(shi + lane * 16) = make_uint4(hi[0], hi[1], hi[2], hi[3]);
        *(uint4*)(slo + lane * 16) = make_uint4(lo[0], lo[1], lo[2], lo[3]);
    }
    __builtin_amdgcn_s_waitcnt(0xc07f);
    __builtin_amdgcn_wave_barrier();
    {
        typedef int v8i __attribute__((ext_vector_type(8)));
        const unsigned char* Ub = P.ws + WS_U;
        const unsigned lofs = 64u * (unsigned)(lr >> 3) + 16u * (unsigned)g;
        const unsigned char* bsrc = (lr < 4) ? (((lr & 2) ? slo : shi) + 128 * (lr & 1) + 16 * g) : (const unsigned char*)szero;
        const int bstep = (lr < 4) ? 256 : 0, bhalf = (lr < 4) ? 64 : 16;
        v8i Bv[4];
#pragma unroll
        for (int st = 0; st < 4; ++st) {
            const uint4 b0 = *(const uint4*)(bsrc + bstep * st), b1 = *(const uint4*)(bsrc + bstep * st + bhalf);
            Bv[st] = (v8i){(int)b0.x, (int)b0.y, (int)b0.z, (int)b0.w, (int)b1.x, (int)b1.y, (int)b1.z, (int)b1.w};
        }
        __builtin_amdgcn_s_waitcnt(0xc07f);
        __builtin_amdgcn_wave_barrier();
        float* sact = (float*)sidx + 128 * (lr & 3) + 4 * (g & 1);
        const bool owner = (lr < 4) && ((g >> 1) == (lr & 1));
        uint4 abuf[2][2][4];
        unsigned off2[2];
#pragma unroll
        for (int hh = 0; hh < 2; ++hh) off2[hh] = (unsigned)sid[8 * hh + (lr & 7)] * 512u + lofs;
#pragma unroll
        for (int hh = 0; hh < 2; ++hh)
#pragma unroll
            for (int st = 0; st < 4; ++st) abuf[0][hh][st] = *(const uint4*)(Ub + (off2[hh] + 128 * st));
#pragma unroll
        for (int T = 0; T < 8; ++T) {
            if (T + 1 < 8) {
#pragma unroll
                for (int hh = 0; hh < 2; ++hh) off2[hh] = (unsigned)sid[16 * (T + 1) + 8 * hh + (lr & 7)] * 512u + lofs;
#pragma unroll
                for (int hh = 0; hh < 2; ++hh)
#pragma unroll
                    for (int st = 0; st < 4; ++st) abuf[(T + 1) & 1][hh][st] = *(const uint4*)(Ub + (off2[hh] + 128 * st));
            }
#pragma unroll
            for (int hh = 0; hh < 2; ++hh) {
                f32x4 au = (f32x4){0.f, 0.f, 0.f, 0.f};
#pragma unroll
                for (int st = 0; st < 4; ++st) {
                    const uint4 a4 = abuf[T & 1][hh][st];
                    const v8i Av = {(int)a4.x, (int)a4.y, (int)a4.z, (int)a4.w, 0, 0, 0, 0};
                    au = __builtin_amdgcn_mfma_scale_f32_16x16x128_f8f6f4(Av, Bv[st], au, 4, 0, 0, 0x7f7f7f7f, 0, 0x7f7f7f7f);
                }
                if (owner) *(f32x4*)(sact + 16 * T + 8 * hh) = au;
            }
        }
    }
    __builtin_amdgcn_s_waitcnt(0xc07f);
    __builtin_amdgcn_wave_barrier();
    {
        float* sw = (float*)sidx;
        float wv[2];
#pragma unroll
        for (int hh = 0; hh < 2; ++hh) {
            const int e = lane + 64 * hh, id = sid[e];
            const float a = ((sw[e] + sw[128 + e]) + (sw[256 + e] + sw[384 + e])) * usc[id] * rstd;
            wv[hh] = sgate[e] * vsc[id] * 0.5f * a * (1.f + erff(a * 0.70710678118654752f));
        }
        __builtin_amdgcn_s_waitcnt(0xc07f);
        __builtin_amdgcn_wave_barrier();
        sw[lane] = wv[0]; sw[lane + 64] = wv[1];
    }
    __builtin_amdgcn_s_waitcnt(0xc07f);
    __builtin_amdgcn_wave_barrier();
    const int half = lane >> 5, l5 = lane & 31;
    const int lane_o = 2 * l5 + half;
    f32x2 acc2[16];
#pragma unroll
    for (int j = 0; j < 16; ++j) acc2[j] = (f32x2){0.f, 0.f};
    const unsigned char* Vb = P.ws + WS_V;
    const unsigned vlo = (unsigned)l5 * 16u;
#pragma unroll 1
    for (int e0 = 0; e0 < 128; e0 += 16) {
        uint4 vr[8];
#pragma unroll
        for (int q = 0; q < 8; ++q) vr[q] = *(const uint4*)(Vb + ((unsigned)sid[e0 + 2 * q + half] * 512u + vlo));
        const float* sw = (const float*)sidx + e0;
        const f32x4 w0 = *(const f32x4*)(sw), w1 = *(const f32x4*)(sw + 4), w2 = *(const f32x4*)(sw + 8), w3 = *(const f32x4*)(sw + 12);
        const float wq[16] = {w0[0], w0[1], w0[2], w0[3], w1[0], w1[1], w1[2], w1[3], w2[0], w2[1], w2[2], w2[3], w3[0], w3[1], w3[2], w3[3]};
#pragma unroll
        for (int q = 0; q < 8; ++q) {
            const float w = half ? wq[2 * q + 1] : wq[2 * q];
#define FP4_AXPY(k) { acc2[k] += w * __builtin_amdgcn_cvt_scalef32_pk_f32_fp4(vr[q].x, 1.0f, k); acc2[4 + k] += w * __builtin_amdgcn_cvt_scalef32_pk_f32_fp4(vr[q].y, 1.0f, k); \
                      acc2[8 + k] += w * __builtin_amdgcn_cvt_scalef32_pk_f32_fp4(vr[q].z, 1.0f, k); acc2[12 + k] += w * __builtin_amdgcn_cvt_scalef32_pk_f32_fp4(vr[q].w, 1.0f, k); }
            FP4_AXPY(0) FP4_AXPY(1) FP4_AXPY(2) FP4_AXPY(3)
#undef FP4_AXPY
        }
    }
    f32x2 acc[8];
#pragma unroll
    for (int j = 0; j < 16; ++j) {
        const unsigned x0 = __float_as_uint(acc2[j].x), x1 = __float_as_uint(acc2[j].y);
        const auto r0 = __builtin_amdgcn_permlane32_swap(x0, x0, false, false);
        const auto r1 = __builtin_amdgcn_permlane32_swap(x1, x1, false, false);
        acc2[j].x = __uint_as_float(r0[0]) + __uint_as_float(r0[1]);
        acc2[j].y = __uint_as_float(r1[0]) + __uint_as_float(r1[1]);
    }
#pragma unroll
    for (int j = 0; j < 8; ++j) { acc[j].x = half ? acc2[8 + j].x : acc2[j].x; acc[j].y = half ? acc2[8 + j].y : acc2[j].y; }
    f32x2 xf[8];
    {
        const uint4 xa = *(const uint4*)(xn + lane_o * 16), xb = *(const uint4*)(xn + lane_o * 16 + 8);
        xf[0] = (f32x2){bflo(xa.x), bfhi(xa.x)}; xf[1] = (f32x2){bflo(xa.y), bfhi(xa.y)}; xf[2] = (f32x2){bflo(xa.z), bfhi(xa.z)}; xf[3] = (f32x2){bflo(xa.w), bfhi(xa.w)};
        xf[4] = (f32x2){bflo(xb.x), bfhi(xb.x)}; xf[5] = (f32x2){bflo(xb.y), bfhi(xb.y)}; xf[6] = (f32x2){bflo(xb.z), bfhi(xb.z)}; xf[7] = (f32x2){bflo(xb.w), bfhi(xb.w)};
    }
    float* o = P.out + (size_t)t * DM + lane_o * 16;
    float4 h0, h1, h2, h3;
    {
        const float4 g0 = *(const float4*)(P.norm_ffn + lane_o * 16), g1 = *(const float4*)(P.norm_ffn + lane_o * 16 + 4), g2 = *(const float4*)(P.norm_ffn + lane_o * 16 + 8), g3 = *(const float4*)(P.norm_ffn + lane_o * 16 + 12);
        h0.x = xf[0].x * __builtin_amdgcn_rcpf(g0.x) + acc[0].x; h0.y = xf[0].y * __builtin_amdgcn_rcpf(g0.y) + acc[0].y; h0.z = xf[1].x * __builtin_amdgcn_rcpf(g0.z) + acc[1].x; h0.w = xf[1].y * __builtin_amdgcn_rcpf(g0.w) + acc[1].y;
        h1.x = xf[2].x * __builtin_amdgcn_rcpf(g1.x) + acc[2].x; h1.y = xf[2].y * __builtin_amdgcn_rcpf(g1.y) + acc[2].y; h1.z = xf[3].x * __builtin_amdgcn_rcpf(g1.z) + acc[3].x; h1.w = xf[3].y * __builtin_amdgcn_rcpf(g1.w) + acc[3].y;
        h2.x = xf[4].x * __builtin_amdgcn_rcpf(g2.x) + acc[4].x; h2.y = xf[4].y * __builtin_amdgcn_rcpf(g2.y) + acc[4].y; h2.z = xf[5].x * __builtin_amdgcn_rcpf(g2.z) + acc[5].x; h2.w = xf[5].y * __builtin_amdgcn_rcpf(g2.w) + acc[5].y;
        h3.x = xf[6].x * __builtin_amdgcn_rcpf(g3.x) + acc[6].x; h3.y = xf[6].y * __builtin_amdgcn_rcpf(g3.y) + acc[6].y; h3.z = xf[7].x * __builtin_amdgcn_rcpf(g3.z) + acc[7].x; h3.w = xf[7].y * __builtin_amdgcn_rcpf(g3.w) + acc[7].y;
    }
    *(float4*)(o) = h0; *(float4*)(o + 4) = h1; *(float4*)(o + 8) = h2; *(float4*)(o + 12) = h3;
    __builtin_amdgcn_s_waitcnt(0xc07f);
    __builtin_amdgcn_wave_barrier();
}

#define LAS __attribute__((address_space(3)))
#define XB_TMO      128
#define XB_XCNT(j)  (256  + 64 * (j))
#define XB_XSUB(j)  (1280 + 64 * (j))
#define XB_XGEN(j)  (2304 + 64 * (j))
#define XB_TOP      3328
#define XB_TOPGEN   3392
#define XCD_BAR_WORDS 3456
#define XB_SPIN_CAP (1u << 18)
__device__ __forceinline__ unsigned xb_ld(unsigned* p)              { return __hip_atomic_load(p, __ATOMIC_RELAXED, __HIP_MEMORY_SCOPE_AGENT); }
__device__ __forceinline__ unsigned xb_add(unsigned* p, unsigned v) { return __hip_atomic_fetch_add(p, v, __ATOMIC_RELAXED, __HIP_MEMORY_SCOPE_AGENT); }
__device__ __forceinline__ unsigned xb_xcc_id() { return (unsigned)__builtin_amdgcn_s_getreg((3 << 11) | 20) & 0xFu; }
#define XB_SPIN(cond, bar) do { unsigned _sp = 0; while (cond) { __builtin_amdgcn_s_sleep(1); \
    if ((++_sp & 255u) == 0u) { if (xb_ld(&(bar)[XB_TMO])) break; if (_sp > XB_SPIN_CAP) { atomicAdd(&(bar)[XB_TMO], 1u); break; } } } } while (0)
struct XcdBarrier { unsigned* bar; unsigned x; volatile LAS unsigned* st; };
__device__ __forceinline__ XcdBarrier xcd_barrier_post(unsigned* bar, volatile LAS unsigned* st) {
    XcdBarrier b; b.bar = bar; b.x = xb_xcc_id(); b.st = st;
    if (threadIdx.x == 0) (void)xb_add(&bar[XB_XCNT(b.x)], 1u);
    return b;
}
__device__ __forceinline__ void xcd_barrier_complete(unsigned* bar, unsigned x, unsigned& nloc, unsigned& nx) {
    const unsigned G = gridDim.x * gridDim.y * gridDim.z;
    unsigned sum, cnt, mine, sp = 0u;
    for (;;) {
        sum = 0u; cnt = 0u; mine = 0u;
#pragma unroll
        for (unsigned j = 0; j < 16; ++j) { const unsigned c = xb_ld(&bar[XB_XCNT(j)]); sum += c; cnt += (c > 0u) ? 1u : 0u; mine = (j == x) ? c : mine; }
        if (sum == G) break;
        __builtin_amdgcn_s_sleep(1);
        if ((++sp & 255u) == 0u) { if (xb_ld(&bar[XB_TMO])) break; if (sp > XB_SPIN_CAP) { atomicAdd(&bar[XB_TMO], 1u); break; } }
    }
    nloc = mine > 0u ? mine : 1u; nx = cnt > 0u ? cnt : 1u;
}
__device__ __forceinline__ void xcd_barrier(const XcdBarrier& b) {
    asm volatile("s_waitcnt vmcnt(0)" ::: "memory");
    __syncthreads();
    if (threadIdx.x == 0) {
        unsigned* bar = b.bar;
        __builtin_amdgcn_s_waitcnt(0);
        unsigned nloc = b.st[0], nx = b.st[1];
        if (nloc == 0u) { xcd_barrier_complete(bar, b.x, nloc, nx); b.st[0] = nloc; b.st[1] = nx; }
        const unsigned old = xb_add(&bar[XB_XSUB(b.x)], 1u);
        const unsigned gen = old / nloc;
        if (old + 1u == (gen + 1u) * nloc) {
            __builtin_amdgcn_fence(__ATOMIC_RELEASE, "agent");
            asm volatile("s_waitcnt vmcnt(0)" ::: "memory");
            const unsigned og = xb_add(&bar[XB_TOP], 1u);
            const unsigned tg = og / nx;
            if (og + 1u == (tg + 1u) * nx) xb_add(&bar[XB_TOPGEN], 1u);
            else XB_SPIN(xb_ld(&bar[XB_TOPGEN]) == tg, bar);
            __builtin_amdgcn_fence(__ATOMIC_ACQUIRE, "agent");
            xb_add(&bar[XB_XGEN(b.x)], 1u);
            asm volatile("s_waitcnt vmcnt(0)" ::: "memory");
        } else {
            XB_SPIN(xb_ld(&bar[XB_XGEN(b.x)]) == gen, bar);
            __builtin_amdgcn_fence(__ATOMIC_ACQUIRE, "agent");
            asm volatile("s_waitcnt vmcnt(0)" ::: "memory");
        }
    }
    __syncthreads();
}

__device__ __forceinline__ void hand_release() { asm volatile("s_waitcnt vmcnt(0)" ::: "memory"); __builtin_amdgcn_fence(__ATOMIC_RELEASE, "agent"); asm volatile("s_waitcnt vmcnt(0)" ::: "memory"); }
__device__ __forceinline__ void hand_acquire() { __builtin_amdgcn_fence(__ATOMIC_ACQUIRE, "agent"); asm volatile("s_waitcnt vmcnt(0)" ::: "memory"); }

__global__ void __launch_bounds__(256, 2) mega(Params P) {
    extern __shared__ __attribute__((aligned(16))) unsigned char smem[];
    const int tid = threadIdx.x, lane = tid & 63, wave = tid >> 6;
    const int G = gridDim.x, bid = blockIdx.x;
    unsigned* ctl = (unsigned*)(P.ws + WS_CTL);
    volatile LAS unsigned* bst = (volatile LAS unsigned*)(smem + 65552);
    if (tid == 0) { bst[0] = 0u; bst[1] = 0u; }
    __syncthreads();
    const XcdBarrier xb = xcd_barrier_post(ctl + 1024, bst);
    unsigned* cucnt = ctl + 5120;
    if (tid == 0) {
        const unsigned phys = ((xb_xcc_id() & 7u) << 8) | ((unsigned)__builtin_amdgcn_s_getreg((7 << 11) | (8 << 6) | 4) & 0xFFu);
        bst[2] = phys; bst[3] = xb_add(&cucnt[phys], 1u);
    }
    phase0(P, smem);
    xcd_barrier(xb);
    {
        int vb;
        const unsigned phys = bst[2];
        unsigned part = 0;
#pragma unroll
        for (int q = 0; q < 8; ++q) { const unsigned i = (unsigned)(tid + 256 * q); const unsigned c = xb_ld(&cucnt[i]); part += (i < phys) ? c : 0u; }
#pragma unroll
        for (int o = 1; o < 64; o <<= 1) part += (unsigned)__shfl_xor((int)part, o, 64);
        if (lane == 0) bst[4 + wave] = part;
        __syncthreads();
        vb = (int)(bst[4] + bst[5] + bst[6] + bst[7] + bst[3]);
        vb = __builtin_amdgcn_readfirstlane(vb);
        if (vb < 0 || vb >= G) vb = bid;
        __syncthreads();
        if (tid == 0) bst[8] = (unsigned)vb;
        __syncthreads();
    }
#define VB_LOAD() __builtin_amdgcn_readfirstlane((int)bst[8])
    {
        const int gw = bid * 4 + wave;
        if (gw < 64) fox_cum_wave(P, gw, lane);
        const int vb = VB_LOAD();
        for (int tile = vb; tile < 129 * 28; tile += G) gemm_tile<1>(P, tile / 28, tile % 28, smem);
        {
            const int rem = (129 * 28) % G;
            if (rem > 0 && rem < G) { if (vb >= rem) convert_uv_rows(P, (vb - rem) * 4 + wave, (G - rem) * 4, lane); }
            else convert_uv_rows(P, vb * 4 + wave, G * 4, lane);
        }
    }
    xcd_barrier(xb);
    {
        volatile int* s_item = (volatile int*)(smem + 65536);
        const int wave_u = __builtin_amdgcn_readfirstlane(wave);
        auto fetch = [&](unsigned* counter) -> int {
            if (wave_u == 0) {
                unsigned v = atomicAdd(counter, lane == 0 ? 1u : 0u);
                *s_item = (int)__builtin_amdgcn_readfirstlane(v);
            }
            __syncthreads();
            const int item = __builtin_amdgcn_readfirstlane(*s_item);
            __syncthreads();
            return item;
        };
#define RUN_QUEUE(COUNTER, NITEMS, BODY) { \
            int item = bid; \
            while (item < (NITEMS)) { \
                unsigned nxt_ = 0u; \
                if (wave_u == 0) nxt_ = atomicAdd((COUNTER), lane == 0 ? 1u : 0u); \
                BODY; \
                if (wave_u == 0) *s_item = (int)__builtin_amdgcn_readfirstlane(nxt_) + G; \
                __syncthreads(); \
                item = __builtin_amdgcn_readfirstlane(*s_item); \
                __syncthreads(); \
            } }
        RUN_QUEUE(&ctl[2], 33 * 32, mlstm_A(P, item, smem))
        xcd_barrier(xb);
        RUN_QUEUE(&ctl[4], 96, mlstm_B(P, item))
        RUN_QUEUE(&ctl[3], 64 * 17, attn_block(P, item & 63, 16 - (item >> 6), smem))
        xcd_barrier(xb);
        RUN_QUEUE(&ctl[5], 33 * 32, mlstm_C(P, item, smem))
#undef RUN_QUEUE
    }
    xcd_barrier(xb);
    for (int tile = VB_LOAD(); tile < 128 * 8; tile += G) gemm_tile<2>(P, tile >> 3, tile & 7, smem);
    xcd_barrier(xb);
    for (int tile = VB_LOAD(); tile < 128 * 16; tile += G) gemm_tile<3>(P, tile >> 4, tile & 15, smem);
    xcd_barrier(xb);
    {
        unsigned char* slut = smem + 12288;
        if (tid < 64) {
            int c = tid, i = 0;
            while (i < 16 && c >= 16 / (i + 1)) { c -= 16 / (i + 1); ++i; }
            slut[tid] = (unsigned char)(i < 16 ? ((i << 4) | c) : 0);
        }
        unsigned* szero = (unsigned*)(smem + 12288 + 64);
        if (tid < 16) szero[tid] = 0u;
        __syncthreads();
        int* sidx = (int*)(smem + wave * 3072); float* sval = (float*)(smem + wave * 3072 + 1024);
        int* sid = (int*)(smem + wave * 3072 + 2048); float* sgate = (float*)(smem + wave * 3072 + 2560);
        int lane5 = lane;
        asm volatile("" : "+v"(lane5));
        {
            int t = bid * 4 + wave;
            uint4 tkw = *(const uint4*)((const unsigned*)(P.ws + WS_TK) + (size_t)(t < T2 ? t : 0) * 256 + lane5 * 4);
            for (; t < T2; t += G * 4) { const int tn = t + G * 4; peer_token(P, t, tn < T2 ? tn : t, tkw, lane5, sidx, sval, sid, sgate, slut, szero); }
        }
    }
}

}

extern "C" void kernel_launch(void* const* d_in, const int* in_sizes, int n_in, void* d_out, int out_size, void* d_ws, size_t ws_size, hipStream_t stream) {
    if (n_in != 17 || ws_size < WS_END) { fprintf(stderr, "kernel_launch: unexpected n_in %d or ws_size %zu (need %zu)\n", n_in, ws_size, (size_t)WS_END); return; }
    constexpr int LDS_BYTES = 66560;
    static int grid_blocks = 0;
    if (!grid_blocks) {
        int dev = 0, cus = 0, per_cu = 0;
        (void)hipGetDevice(&dev);
        (void)hipDeviceGetAttribute(&cus, hipDeviceAttributeMultiprocessorCount, dev);
        (void)hipFuncSetAttribute((const void*)mega, hipFuncAttributeMaxDynamicSharedMemorySize, LDS_BYTES);
        (void)hipOccupancyMaxActiveBlocksPerMultiprocessor(&per_cu, (const void*)mega, 256, LDS_BYTES);
        if (per_cu < 1) per_cu = 1;
        if (per_cu > 2) per_cu = 2;
        grid_blocks = cus * per_cu;
        fprintf(stderr, "kernel_launch: cus %d per_cu %d grid %d\n", cus, per_cu, grid_blocks);
    }
    Params P{};
    P.x = (const float*)d_in[0]; P.meta = (const float*)d_in[1]; P.norm_mix = (const float*)d_in[2]; P.w_in = (const float*)d_in[3];
    P.conv_qk = (const float*)d_in[4]; P.b_igate = (const float*)d_in[5]; P.b_fgate_m = (const float*)d_in[6]; P.m_out_norm = (const float*)d_in[7];
    P.b_fgate_f = (const float*)d_in[8]; P.f_q_norm = (const float*)d_in[9]; P.f_k_norm = (const float*)d_in[10]; P.w_out = (const float*)d_in[11];
    P.norm_ffn = (const float*)d_in[12]; P.peer_query = (const float*)d_in[13]; P.peer_keys = (const float*)d_in[14]; P.peer_u = (const float*)d_in[15];
    P.peer_v = (const float*)d_in[16]; P.out = (float*)d_out; P.ws = (unsigned char*)d_ws;
    (void)hipMemsetAsync((unsigned char*)d_ws + WS_CTL, 0, 32768, stream);
    void* args[] = {&P};
    hipError_t e = hipLaunchCooperativeKernel((const void*)mega, dim3(grid_blocks), dim3(256), args, LDS_BYTES, stream);
    if (e != hipSuccess) fprintf(stderr, "cooperative launch failed: %s (grid %d)\n", hipGetErrorString(e), grid_blocks);
}
```

```cpp
#include <hip/hip_runtime.h>
#include <stdint.h>
#include <stdio.h>
#include <hip/hip_cooperative_groups.h>
namespace cg = cooperative_groups;

namespace {

constexpr int NB = 8, SEQ = 2048, DM = 1024, NMETA = 16, L = SEQ + NMETA;
constexpr int T1 = NB * L;
constexpr int T2 = NB * SEQ;
constexpr int NZ = 3584;
constexpr int ZC_MQ = 0, ZC_MK = 512, ZC_MV = 1024, ZC_MO = 1536, ZC_FQ = 2048, ZC_FK = 2560, ZC_FV = 3072;
constexpr int PROJ = 3600;
constexpr float EPS = 1e-6f;

constexpr size_t WS_CTL = 0;
constexpr size_t WS_RA = 65536;
constexpr size_t WS_Z = WS_RA + (size_t)T1 * DM * 2;
constexpr size_t WS_GATES = WS_Z + (size_t)T1 * NZ * 2;
constexpr size_t WS_CUM = WS_GATES + (size_t)T1 * 16 * 4;
constexpr size_t WS_SSQ = WS_CUM + (size_t)NB * 8 * L * 4;
constexpr size_t WS_RSTD = WS_SSQ + (size_t)T2 * 16 * 4;
constexpr size_t WS_SSQM = WS_RSTD + (size_t)T2 * 4;
constexpr size_t WS_BT2 = WS_SSQM + (size_t)T1 * 16 * 4;
constexpr size_t WS_BT3 = WS_BT2 + (size_t)DM * DM * 2;
constexpr size_t WS_KEYS = WS_BT3 + (size_t)2048 * DM * 2;
constexpr size_t WS_MSC = WS_KEYS + (size_t)16 * 128 * 128 * 2;
constexpr size_t WS_MST = WS_MSC + (size_t)128 * 33 * 16;
constexpr size_t WS_BT1 = WS_MST + (size_t)32 * 33 * 36864;
constexpr size_t WS_CBI = WS_BT1;
constexpr size_t WS_UV = WS_CBI + (size_t)32 * 33 * 36864;
constexpr size_t WS_END = WS_UV + (size_t)2 * 16384 * 512 + (size_t)2 * 16384 * 4;
constexpr size_t WS_XN = WS_RA;
constexpr size_t WS_U = WS_UV;
constexpr size_t WS_V = WS_U + (size_t)16384 * 512;
constexpr size_t WS_USC = WS_V + (size_t)16384 * 512;
constexpr size_t WS_VSC = WS_USC + (size_t)16384 * 4;
constexpr size_t WS_TK = WS_CBI;
constexpr float LOG2E = 1.4426950408889634f;

typedef unsigned short bf16_t;
typedef short bf16x8 __attribute__((ext_vector_type(8)));
typedef float f32x4 __attribute__((ext_vector_type(4)));
typedef __attribute__((ext_vector_type(2))) __bf16 bf16x2_t;

struct Params {
    const float* x; const float* meta; const float* norm_mix; const float* w_in; const float* conv_qk;
    const float* b_igate; const float* b_fgate_m; const float* m_out_norm; const float* b_fgate_f;
    const float* f_q_norm; const float* f_k_norm; const float* w_out; const float* norm_ffn;
    const float* peer_query; const float* peer_keys; const float* peer_u; const float* peer_v;
    float* out; unsigned char* ws;
};

__device__ __forceinline__ unsigned f2bf(float f) { unsigned u = __float_as_uint(f); return (u + 0x7fffu + ((u >> 16) & 1u)) >> 16; }
__device__ __forceinline__ float bf2f(unsigned h) { return __uint_as_float(h << 16); }
typedef float f32x2 __attribute__((ext_vector_type(2)));
typedef __bf16 bf16x2v __attribute__((ext_vector_type(2)));
__device__ __forceinline__ unsigned cvt_pk_bf16(float lo, float hi) { f32x2 v = {lo, hi}; bf16x2v b = __builtin_convertvector(v, bf16x2v); return __builtin_bit_cast(unsigned, b); }
__device__ __forceinline__ unsigned pk2(float lo, float hi) { return cvt_pk_bf16(lo, hi); }
__device__ __forceinline__ float bflo(unsigned w) { return __uint_as_float(w << 16); }
__device__ __forceinline__ float bfhi(unsigned w) { return __uint_as_float(w & 0xffff0000u); }
__device__ __forceinline__ float wave_sum(float v) {
#pragma unroll
    for (int o = 32; o > 0; o >>= 1) v += __shfl_xor(v, o, 64);
    return v;
}
__device__ __forceinline__ float wave_max(float v) {
#pragma unroll
    for (int o = 32; o > 0; o >>= 1) v = fmaxf(v, __shfl_xor(v, o, 64));
    return v;
}
__device__ __forceinline__ float logsigmoidf(float x) { return fminf(x, 0.f) - log1pf(expf(-fabsf(x))); }
__device__ __forceinline__ unsigned ord_key(float f) { unsigned u = __float_as_uint(f); return u ^ ((u >> 31) ? 0xffffffffu : 0x80000000u); }
__device__ __forceinline__ float unord_key(unsigned k) { unsigned u = (k & 0x80000000u) ? (k ^ 0x80000000u) : ~k; return __uint_as_float(u); }

__device__ __forceinline__ void prod_job(const Params& P, int hp, int kt8, unsigned char* smem);
__device__ __forceinline__ void phase0(const Params& P, unsigned char* smem) {
    const int tid = threadIdx.x, lane = tid & 63, wave = tid >> 6;
    unsigned* ctl = (unsigned*)(P.ws + WS_CTL);
    float* gw = (float*)smem;
    for (int idx = tid; idx < 16 * 1024; idx += 256) {
        const int k = idx >> 4, c = idx & 15;
        const int col = c < 8 ? 2048 + c : 3592 + (c - 8);
        gw[c * 1024 + k] = P.w_in[(size_t)k * PROJ + col];
    }
    __syncthreads();
    {
        bf16_t* hn = (bf16_t*)(P.ws + WS_RA);
        float* gates = (float*)(P.ws + WS_GATES);
        const int c0 = lane * 8, c1 = 512 + lane * 8;
        float gm[16];
        {
            const float4 a0 = *(const float4*)(P.norm_mix + c0), a1 = *(const float4*)(P.norm_mix + c0 + 4);
            const float4 a2 = *(const float4*)(P.norm_mix + c1), a3 = *(const float4*)(P.norm_mix + c1 + 4);
            gm[0] = a0.x; gm[1] = a0.y; gm[2] = a0.z; gm[3] = a0.w; gm[4] = a1.x; gm[5] = a1.y; gm[6] = a1.z; gm[7] = a1.w;
            gm[8] = a2.x; gm[9] = a2.y; gm[10] = a2.z; gm[11] = a2.w; gm[12] = a3.x; gm[13] = a3.y; gm[14] = a3.z; gm[15] = a3.w;
        }
        const int myq = ((lane >> 5) & 1) * 8 + ((lane >> 4) & 1) * 4 + ((lane >> 3) & 1) * 2 + ((lane >> 2) & 1);
        const float mybias = myq < 4 ? P.b_igate[myq] : (myq < 8 ? P.b_fgate_m[myq - 4] : P.b_fgate_f[myq - 8]);
        const int rstep = gridDim.x * 4;
        int r = blockIdx.x * 4 + wave;
        float4 n0, n1, n2, n3;
        auto load_row = [&](int rr) {
            const int b = rr / L, p = rr - b * L;
            const float* src = (p < NMETA) ? (P.meta + (size_t)p * DM) : (P.x + ((size_t)b * SEQ + (p - NMETA)) * DM);
            n0 = *(const float4*)(src + c0); n1 = *(const float4*)(src + c0 + 4); n2 = *(const float4*)(src + c1); n3 = *(const float4*)(src + c1 + 4);
        };
        if (r < T1) load_row(r);
        for (; r < T1; r += rstep) {
            float v[16];
            v[0] = n0.x; v[1] = n0.y; v[2] = n0.z; v[3] = n0.w; v[4] = n1.x; v[5] = n1.y; v[6] = n1.z; v[7] = n1.w;
            v[8] = n2.x; v[9] = n2.y; v[10] = n2.z; v[11] = n2.w; v[12] = n3.x; v[13] = n3.y; v[14] = n3.z; v[15] = n3.w;
            if (r + rstep < T1) load_row(r + rstep);
            float ss = 0.f;
#pragma unroll
            for (int j = 0; j < 16; ++j) ss += v[j] * v[j];
            ss = wave_sum(ss);
            const float rstd = rsqrtf(ss * (1.0f / DM) + EPS);
#pragma unroll
            for (int j = 0; j < 16; ++j) v[j] *= rstd * gm[j];
            uint4 o0, o1;
            o0.x = pk2(v[0], v[1]); o0.y = pk2(v[2], v[3]); o0.z = pk2(v[4], v[5]); o0.w = pk2(v[6], v[7]);
            o1.x = pk2(v[8], v[9]); o1.y = pk2(v[10], v[11]); o1.z = pk2(v[12], v[13]); o1.w = pk2(v[14], v[15]);
            *(uint4*)(hn + (size_t)r * DM + c0) = o0;
            *(uint4*)(hn + (size_t)r * DM + c1) = o1;
            float r8[8], r4[4], r2[2], r1;
#pragma unroll
            for (int i = 0; i < 8; ++i) {
                float dd[2];
#pragma unroll
                for (int hh = 0; hh < 2; ++hh) {
                    const float* gwc = gw + (i + 8 * hh) * 1024;
                    const float4 w0 = *(const float4*)(gwc + c0), w1 = *(const float4*)(gwc + c0 + 4), w2 = *(const float4*)(gwc + c1), w3 = *(const float4*)(gwc + c1 + 4);
                    dd[hh] = v[0] * w0.x + v[1] * w0.y + v[2] * w0.z + v[3] * w0.w + v[4] * w1.x + v[5] * w1.y + v[6] * w1.z + v[7] * w1.w
                           + v[8] * w2.x + v[9] * w2.y + v[10] * w2.z + v[11] * w2.w + v[12] * w3.x + v[13] * w3.y + v[14] * w3.z + v[15] * w3.w;
                }
                const bool up = (lane & 32) != 0; const float keep = up ? dd[1] : dd[0], send = up ? dd[0] : dd[1];
                r8[i] = keep + __shfl_xor(send, 32, 64);
                if ((i & 3) == 3) __builtin_amdgcn_sched_barrier(0);
            }
#pragma unroll
            for (int i = 0; i < 4; ++i) { const bool up = (lane & 16) != 0; const float keep = up ? r8[i + 4] : r8[i], send = up ? r8[i] : r8[i + 4]; r4[i] = keep + __shfl_xor(send, 16, 64); }
#pragma unroll
            for (int i = 0; i < 2; ++i) { const bool up = (lane & 8) != 0; const float keep = up ? r4[i + 2] : r4[i], send = up ? r4[i] : r4[i + 2]; r2[i] = keep + __shfl_xor(send, 8, 64); }
            { const bool up = (lane & 4) != 0; const float keep = up ? r2[1] : r2[0], send = up ? r2[0] : r2[1]; r1 = keep + __shfl_xor(send, 4, 64); }
            r1 += __shfl_xor(r1, 2, 64); r1 += __shfl_xor(r1, 1, 64);
            if ((lane & 3) == 0) {
                const float pre = r1 + mybias;
                gates[(size_t)r * 16 + myq] = myq < 4 ? pre : logsigmoidf(pre);
            }
        }
    }
    __syncthreads();
    {
        float* tile = (float*)smem;
        for (int item = blockIdx.x; item < 1152; item += gridDim.x) {
            const float* W; int ldn, ntn, shift_from, it; bf16_t* out;
            if (item < 896) { W = P.w_in; ldn = PROJ; ntn = 56; shift_from = 2048; it = item; out = (bf16_t*)(P.ws + WS_BT1); }
            else { W = P.w_out; ldn = 1024; ntn = 16; shift_from = 1 << 30; it = item - 896; out = (bf16_t*)(P.ws + WS_BT2); }
            const int tk = it / ntn, tn = it - tk * ntn, k0 = tk * 64, n0 = tn * 64;
            {
                const int n4 = (tid & 15) * 4, kr = tid >> 4;
                int n = n0 + n4; if (n >= shift_from) n += 8;
                float4 v[4];
#pragma unroll
                for (int i = 0; i < 4; ++i) v[i] = *(const float4*)(W + (size_t)(k0 + kr + 16 * i) * ldn + n);
#pragma unroll
                for (int i = 0; i < 4; ++i) *(float4*)(tile + (kr + 16 * i) * 68 + n4) = v[i];
            }
            __syncthreads();
            {
#pragma unroll
                for (int i = 0; i < 2; ++i) {
                    const int id = tid + 256 * i, nl = id & 63, kc = id >> 6;
                    const float* tp = tile + (kc * 8) * 68 + nl;
                    uint4 o;
                    o.x = pk2(tp[0], tp[68]); o.y = pk2(tp[2 * 68], tp[3 * 68]); o.z = pk2(tp[4 * 68], tp[5 * 68]); o.w = pk2(tp[6 * 68], tp[7 * 68]);
                    *(uint4*)(out + (size_t)(n0 + nl) * 1024 + k0 + kc * 8) = o;
                }
            }
            __syncthreads();
        }
    }
    for (int job = (int)gridDim.x - 1 - (int)blockIdx.x; job < 128; job += gridDim.x) prod_job(P, job >> 3, job & 7, smem);
}

__device__ __forceinline__ void convert_uv_rows(const Params& P, int gwave, int nwaves, int lane) {
    for (int rr0 = gwave * 4; rr0 < 2 * 16384; rr0 += nwaves * 4) {
        float4 a[4][4];
#pragma unroll
        for (int q = 0; q < 4; ++q) {
            const int rr = rr0 + q, which = rr >> 14, row = rr & 16383;
            const float* src = (which ? P.peer_v : P.peer_u) + (size_t)row * DM + lane * 16;
            a[q][0] = *(const float4*)(src); a[q][1] = *(const float4*)(src + 4); a[q][2] = *(const float4*)(src + 8); a[q][3] = *(const float4*)(src + 12);
        }
#pragma unroll
        for (int q = 0; q < 4; ++q) {
            const int rr = rr0 + q, which = rr >> 14, row = rr & 16383;
            float mx = 0.f;
#pragma unroll
            for (int j = 0; j < 4; ++j) mx = fmaxf(mx, fmaxf(fmaxf(fabsf(a[q][j].x), fabsf(a[q][j].y)), fmaxf(fabsf(a[q][j].z), fabsf(a[q][j].w))));
            mx = wave_max(mx);
            const float sc = mx > 0.f ? 6.0f / mx : 1.0f;
            unsigned w0 = 0u, w1 = 0u;
            w0 = __builtin_amdgcn_cvt_scalef32_pk_fp4_f32(w0, a[q][0].x * sc, a[q][0].y * sc, 1.0f, 0); w0 = __builtin_amdgcn_cvt_scalef32_pk_fp4_f32(w0, a[q][0].z * sc, a[q][0].w * sc, 1.0f, 1);
            w0 = __builtin_amdgcn_cvt_scalef32_pk_fp4_f32(w0, a[q][1].x * sc, a[q][1].y * sc, 1.0f, 2); w0 = __builtin_amdgcn_cvt_scalef32_pk_fp4_f32(w0, a[q][1].z * sc, a[q][1].w * sc, 1.0f, 3);
            w1 = __builtin_amdgcn_cvt_scalef32_pk_fp4_f32(w1, a[q][2].x * sc, a[q][2].y * sc, 1.0f, 0); w1 = __builtin_amdgcn_cvt_scalef32_pk_fp4_f32(w1, a[q][2].z * sc, a[q][2].w * sc, 1.0f, 1);
            w1 = __builtin_amdgcn_cvt_scalef32_pk_fp4_f32(w1, a[q][3].x * sc, a[q][3].y * sc, 1.0f, 2); w1 = __builtin_amdgcn_cvt_scalef32_pk_fp4_f32(w1, a[q][3].z * sc, a[q][3].w * sc, 1.0f, 3);
            *(uint2*)(P.ws + (which ? WS_V : WS_U) + (size_t)row * 512 + lane * 8) = make_uint2(w0, w1);
            if (lane == 0) ((float*)(P.ws + (which ? WS_VSC : WS_USC)))[row] = mx > 0.f ? mx * (1.0f / 6.0f) : 1.0f;
        }
    }
}

__device__ __forceinline__ void bitonic_sort16_desc(unsigned (&v)[16]) {
#pragma unroll
    for (int k = 2; k <= 16; k <<= 1)
#pragma unroll
        for (int j = k >> 1; j >= 1; j >>= 1)
#pragma unroll
            for (int i = 0; i < 16; ++i)
                if ((i & j) == 0) {
                    const int p = i | j;
                    const bool desc = (k >= 16) ? true : ((i & k) == 0);
                    const unsigned hi = max(v[i], v[p]), lo = min(v[i], v[p]);
                    v[i] = desc ? hi : lo; v[p] = desc ? lo : hi;
                }
}
__device__ __forceinline__ void bitonic_merge16_top(unsigned (&a)[16], const unsigned (&b)[16]) {
#pragma unroll
    for (int i = 0; i < 16; ++i) a[i] = max(a[i], b[15 - i]);
#pragma unroll
    for (int j = 8; j >= 1; j >>= 1)
#pragma unroll
        for (int i = 0; i < 16; ++i)
            if ((i & j) == 0) { const int p = i | j; const unsigned hi = max(a[i], a[p]), lo = min(a[i], a[p]); a[i] = hi; a[p] = lo; }
}

__device__ __forceinline__ float x4_max(float x) {
    const unsigned xi = __float_as_uint(x);
    const auto r = __builtin_amdgcn_permlane32_swap(xi, xi, false, false);
    const float m = fmaxf(__uint_as_float(r[0]), __uint_as_float(r[1]));
    const unsigned mi = __float_as_uint(m);
    const auto r2 = __builtin_amdgcn_permlane16_swap(mi, mi, false, false);
    return fmaxf(__uint_as_float(r2[0]), __uint_as_float(r2[1]));
}
__device__ __forceinline__ float x4_sum(float x) {
    const unsigned xi = __float_as_uint(x);
    const auto r = __builtin_amdgcn_permlane32_swap(xi, xi, false, false);
    const float m = __uint_as_float(r[0]) + __uint_as_float(r[1]);
    const unsigned mi = __float_as_uint(m);
    const auto r2 = __builtin_amdgcn_permlane16_swap(mi, mi, false, false);
    return __uint_as_float(r2[0]) + __uint_as_float(r2[1]);
}

__device__ __forceinline__ int opaque_tid() { int t = threadIdx.x; asm volatile("" : "+v"(t)); return t; }

__device__ __forceinline__ void mma_ktile(const unsigned char* sA, const unsigned char* sB, int arow_off, int brow_off, int g, int sw, f32x4 (&acc)[4][4]) {
#pragma unroll
    for (int s = 0; s < 2; ++s) {
        bf16x8 a[4], b[4];
        const int ch = (((s * 4 + g) ^ sw) << 4);
#pragma unroll
        for (int i = 0; i < 4; ++i) a[i] = *(const bf16x8*)(sA + arow_off + i * 2048 + ch);
#pragma unroll
        for (int j = 0; j < 4; ++j) b[j] = *(const bf16x8*)(sB + brow_off + j * 2048 + ch);
#pragma unroll
        for (int i = 0; i < 4; ++i)
#pragma unroll
            for (int j = 0; j < 4; ++j) acc[i][j] = __builtin_amdgcn_mfma_f32_16x16x32_bf16(b[j], a[i], acc[i][j], 0, 0, 0);
    }
}

__device__ __forceinline__ void store_tile_bf16(const f32x4 (&acc)[4][4], unsigned char* smem, bf16_t* dst, size_t ld, int m0, int n0, int tid, int wr, int wc, int g, int lr) {
#pragma unroll
    for (int i = 0; i < 4; ++i)
#pragma unroll
        for (int j = 0; j < 4; ++j) {
            const int row = wr * 64 + 16 * i + lr, col = wc * 64 + 16 * j + 4 * g;
            uint2 w; w.x = pk2(acc[i][j][0], acc[i][j][1]); w.y = pk2(acc[i][j][2], acc[i][j][3]);
            *(uint2*)(smem + row * 272 + col * 2) = w;
        }
    __syncthreads();
#pragma unroll
    for (int q = 0; q < 8; ++q) {
        const int id = tid + 256 * q, row = id >> 4, ch = id & 15;
        const uint4 v = *(const uint4*)(smem + row * 272 + ch * 16);
        *(uint4*)(dst + (size_t)(m0 + row) * ld + n0 + ch * 8) = v;
    }
    __syncthreads();
}

__device__ __forceinline__ void prod_job(const Params& P, int hp, int kt8, unsigned char* smem) {
    const int tid = opaque_tid(), lane = tid & 63, wave = tid >> 6, wr = wave >> 1, wc = wave & 1, g = lane >> 4, lr = lane & 15;
    const int srow = tid >> 3, sc = tid & 7;
    unsigned char* sA0 = smem; unsigned char* sB0 = smem + 16384; unsigned char* sA1 = smem + 32768; unsigned char* sB1 = smem + 49152;
    const int soff0 = srow * 128 + ((sc ^ (srow & 7)) << 4);
    const float* Ak = P.peer_keys + (size_t)hp * 128 * 128 + (size_t)srow * 128 + sc * 8;
    const float* Bq = P.peer_query + (size_t)(kt8 * 128 + srow) * 2048 + hp * 128 + sc * 8;
#pragma unroll
    for (int j = 0; j < 4; ++j) {
#pragma unroll
        for (int hk = 0; hk < 2; ++hk) {
            const float4 a0 = *(const float4*)(Ak + (size_t)(32 * j) * 128 + 64 * hk), a1 = *(const float4*)(Ak + (size_t)(32 * j) * 128 + 64 * hk + 4);
            const float4 b0 = *(const float4*)(Bq + (size_t)(32 * j) * 2048 + 64 * hk), b1 = *(const float4*)(Bq + (size_t)(32 * j) * 2048 + 64 * hk + 4);
            uint4 ua, ub;
            ua.x = pk2(a0.x, a0.y); ua.y = pk2(a0.z, a0.w); ua.z = pk2(a1.x, a1.y); ua.w = pk2(a1.z, a1.w);
            ub.x = pk2(b0.x, b0.y); ub.y = pk2(b0.z, b0.w); ub.z = pk2(b1.x, b1.y); ub.w = pk2(b1.z, b1.w);
            *(uint4*)((hk ? sA1 : sA0) + soff0 + j * 4096) = ua;
            *(uint4*)((hk ? sB1 : sB0) + soff0 + j * 4096) = ub;
        }
    }
    __syncthreads();
    f32x4 acc[4][4];
#pragma unroll
    for (int i = 0; i < 4; ++i)
#pragma unroll
        for (int j = 0; j < 4; ++j) acc[i][j] = (f32x4){0.f, 0.f, 0.f, 0.f};
    const int arow_off = (wr * 64 + lr) * 128, brow_off = (wc * 64 + lr) * 128, sw = lr & 7;
    mma_ktile(sA0, sB0, arow_off, brow_off, g, sw, acc);
    mma_ktile(sA1, sB1, arow_off, brow_off, g, sw, acc);
    __syncthreads();
    store_tile_bf16(acc, smem, (bf16_t*)(P.ws + WS_BT3), 1024, hp * 128, kt8 * 128, tid, wr, wc, g, lr);
}

template <int MODE>
__device__ __forceinline__ void gemm_tile(const Params& P, int tm, int tn, unsigned char* smem) {
    const bf16_t* A; const bf16_t* Bt;
    if (MODE == 1) { A = (const bf16_t*)(P.ws + WS_RA); Bt = (const bf16_t*)(P.ws + WS_BT1); }
    else if (MODE == 2) { A = (const bf16_t*)(P.ws + WS_Z); Bt = (const bf16_t*)(P.ws + WS_BT2); }
    else { A = (const bf16_t*)(P.ws + WS_XN); Bt = (const bf16_t*)(P.ws + WS_BT3); }
    const int tid = opaque_tid(), lane = tid & 63, wave = tid >> 6, wr = wave >> 1, wc = wave & 1, g = lane >> 4, lr = lane & 15;
    const int m0 = tm * 128, n0 = tn * 128;
    const int srow = tid >> 3, sc = tid & 7;
    constexpr unsigned LDA = (MODE == 2 ? NZ : 1024) * 2u;
    unsigned aoff, boff; int soff0;
    {
        int ar = m0 + srow;
        if (MODE == 2) { const int b = ar >> 11, t = ar & 2047; ar = b * L + NMETA + t; }
        aoff = (unsigned)ar * LDA + (unsigned)sc * 16u;
        boff = (unsigned)(n0 + srow) * 2048u + (unsigned)sc * 16u;
        soff0 = srow * 128 + ((sc ^ (srow & 7)) << 4);
    }
    const unsigned char* Ab = (const unsigned char*)A; const unsigned char* Bb = (const unsigned char*)Bt;
    float4 ssp0, ssp1, ssp2, ssp3;
    if (MODE == 3) {
        const float* ssq = (const float*)(P.ws + WS_SSQ) + (size_t)(m0 + wr * 64 + lr) * 16 + 4 * g;
        ssp0 = *(const float4*)(ssq); ssp1 = *(const float4*)(ssq + 16 * 16); ssp2 = *(const float4*)(ssq + 32 * 16); ssp3 = *(const float4*)(ssq + 48 * 16);
    }
    f32x4 acc[4][4];
#pragma unroll
    for (int i = 0; i < 4; ++i)
#pragma unroll
        for (int j = 0; j < 4; ++j) acc[i][j] = (f32x4){0.f, 0.f, 0.f, 0.f};
    uint4 ra0, ra1, ra2, ra3, rb0, rb1, rb2, rb3;
#define G_LOAD(KT) { const unsigned ko = (unsigned)(KT) * 128u; \
        ra0 = *(const uint4*)(Ab + (aoff + ko)); ra1 = *(const uint4*)(Ab + (aoff + 32u * LDA + ko)); ra2 = *(const uint4*)(Ab + (aoff + 64u * LDA + ko)); ra3 = *(const uint4*)(Ab + (aoff + 96u * LDA + ko)); \
        rb0 = *(const uint4*)(Bb + (boff + ko)); rb1 = *(const uint4*)(Bb + (boff + 32u * 2048u + ko)); rb2 = *(const uint4*)(Bb + (boff + 64u * 2048u + ko)); rb3 = *(const uint4*)(Bb + (boff + 96u * 2048u + ko)); }
#define G_WRITE(SA, SB) { *(uint4*)((SA) + soff0) = ra0; *(uint4*)((SA) + soff0 + 4096) = ra1; *(uint4*)((SA) + soff0 + 8192) = ra2; *(uint4*)((SA) + soff0 + 12288) = ra3; \
        *(uint4*)((SB) + soff0) = rb0; *(uint4*)((SB) + soff0 + 4096) = rb1; *(uint4*)((SB) + soff0 + 8192) = rb2; *(uint4*)((SB) + soff0 + 12288) = rb3; }
    unsigned char* sA0 = smem; unsigned char* sB0 = smem + 16384; unsigned char* sA1 = smem + 32768; unsigned char* sB1 = smem + 49152;
    G_LOAD(0)
    G_WRITE(sA0, sB0)
    __syncthreads();
    const int arow_off = (wr * 64 + lr) * 128, brow_off = (wc * 64 + lr) * 128, sw = lr & 7;
    G_LOAD(1)
    for (int kt = 0; kt < 16; ++kt) {
        unsigned char* sA = (kt & 1) ? sA1 : sA0; unsigned char* sB = (kt & 1) ? sB1 : sB0;
        unsigned char* nA = (kt & 1) ? sA0 : sA1; unsigned char* nB = (kt & 1) ? sB0 : sB1;
        bf16x8 fa[4], fb[4], ga[4], gb[4];
        const int ch0 = ((g ^ sw) << 4), ch1 = (((4 + g) ^ sw) << 4);
        const unsigned ko = (unsigned)(kt + 2) * 128u;
        const bool wr_ok = kt < 15, ld_ok = kt < 14;
#pragma unroll
        for (int i = 0; i < 4; ++i) { fa[i] = *(const bf16x8*)(sA + arow_off + i * 2048 + ch0); fb[i] = *(const bf16x8*)(sB + brow_off + i * 2048 + ch0); }
        __builtin_amdgcn_sched_barrier(0);
        __builtin_amdgcn_s_setprio(2);
        if (wr_ok) *(uint4*)(nA + soff0) = ra0;
        if (ld_ok) ra0 = *(const uint4*)(Ab + (aoff + 0u * LDA + ko));
        ga[0] = *(const bf16x8*)(sA + arow_off + 0 * 2048 + ch1); gb[0] = *(const bf16x8*)(sB + brow_off + 0 * 2048 + ch1);
        __builtin_amdgcn_sched_barrier(0);
#pragma unroll
        for (int j = 0; j < 4; ++j) acc[0][j] = __builtin_amdgcn_mfma_f32_16x16x32_bf16(fb[j], fa[0], acc[0][j], 0, 0, 0);
        __builtin_amdgcn_sched_barrier(0);
        if (wr_ok) *(uint4*)(nA + soff0 + 4096) = ra1;
        if (ld_ok) ra1 = *(const uint4*)(Ab + (aoff + 32u * LDA + ko));
        ga[1] = *(const bf16x8*)(sA + arow_off + 1 * 2048 + ch1); gb[1] = *(const bf16x8*)(sB + brow_off + 1 * 2048 + ch1);
        __builtin_amdgcn_sched_barrier(0);
#pragma unroll
        for (int j = 0; j < 4; ++j) acc[1][j] = __builtin_amdgcn_mfma_f32_16x16x32_bf16(fb[j], fa[1], acc[1][j], 0, 0, 0);
        __builtin_amdgcn_sched_barrier(0);
        if (wr_ok) *(uint4*)(nA + soff0 + 8192) = ra2;
        if (ld_ok) ra2 = *(const uint4*)(Ab + (aoff + 64u * LDA + ko));
        ga[2] = *(const bf16x8*)(sA + arow_off + 2 * 2048 + ch1); gb[2] = *(const bf16x8*)(sB + brow_off + 2 * 2048 + ch1);
        __builtin_amdgcn_sched_barrier(0);
#pragma unroll
        for (int j = 0; j < 4; ++j) acc[2][j] = __builtin_amdgcn_mfma_f32_16x16x32_bf16(fb[j], fa[2], acc[2][j], 0, 0, 0);
        __builtin_amdgcn_sched_barrier(0);
        if (wr_ok) *(uint4*)(nA + soff0 + 12288) = ra3;
        if (ld_ok) ra3 = *(const uint4*)(Ab + (aoff + 96u * LDA + ko));
        ga[3] = *(const bf16x8*)(sA + arow_off + 3 * 2048 + ch1); gb[3] = *(const bf16x8*)(sB + brow_off + 3 * 2048 + ch1);
        __builtin_amdgcn_sched_barrier(0);
#pragma unroll
        for (int j = 0; j < 4; ++j) acc[3][j] = __builtin_amdgcn_mfma_f32_16x16x32_bf16(fb[j], fa[3], acc[3][j], 0, 0, 0);
        __builtin_amdgcn_sched_barrier(0);
        if (wr_ok) *(uint4*)(nB + soff0) = rb0;
        if (ld_ok) rb0 = *(const uint4*)(Bb + (boff + 0u * 2048u + ko));
        __builtin_amdgcn_sched_barrier(0);
#pragma unroll
        for (int j = 0; j < 4; ++j) acc[0][j] = __builtin_amdgcn_mfma_f32_16x16x32_bf16(gb[j], ga[0], acc[0][j], 0, 0, 0);
        __builtin_amdgcn_sched_barrier(0);
        if (wr_ok) *(uint4*)(nB + soff0 + 4096) = rb1;
        if (ld_ok) rb1 = *(const uint4*)(Bb + (boff + 32u * 2048u + ko));
        __builtin_amdgcn_sched_barrier(0);
#pragma unroll
        for (int j = 0; j < 4; ++j) acc[1][j] = __builtin_amdgcn_mfma_f32_16x16x32_bf16(gb[j], ga[1], acc[1][j], 0, 0, 0);
        __builtin_amdgcn_sched_barrier(0);
        if (wr_ok) *(uint4*)(nB + soff0 + 8192) = rb2;
        if (ld_ok) rb2 = *(const uint4*)(Bb + (boff + 64u * 2048u + ko));
        __builtin_amdgcn_sched_barrier(0);
#pragma unroll
        for (int j = 0; j < 4; ++j) acc[2][j] = __builtin_amdgcn_mfma_f32_16x16x32_bf16(gb[j], ga[2], acc[2][j], 0, 0, 0);
        __builtin_amdgcn_sched_barrier(0);
        if (wr_ok) *(uint4*)(nB + soff0 + 12288) = rb3;
        if (ld_ok) rb3 = *(const uint4*)(Bb + (boff + 96u * 2048u + ko));
        __builtin_amdgcn_sched_barrier(0);
#pragma unroll
        for (int j = 0; j < 4; ++j) acc[3][j] = __builtin_amdgcn_mfma_f32_16x16x32_bf16(gb[j], ga[3], acc[3][j], 0, 0, 0);
        __builtin_amdgcn_s_setprio(0);
        __syncthreads();
    }
#undef G_LOAD
#undef G_WRITE
    if (MODE == 1) {
        if (n0 >= ZC_FQ && n0 < ZC_FV) {
            const bool isk = n0 >= ZC_FK;
            const float* gain = isk ? P.f_k_norm : P.f_q_norm;
            const float scl = isk ? 1.0f : 0.125f * LOG2E;
            float gn[4][4];
#pragma unroll
            for (int j = 0; j < 4; ++j)
#pragma unroll
                for (int r = 0; r < 4; ++r) gn[j][r] = gain[16 * j + 4 * g + r];
#pragma unroll
            for (int i = 0; i < 4; ++i) {
                float ss = 0.f;
#pragma unroll
                for (int j = 0; j < 4; ++j)
#pragma unroll
                    for (int r = 0; r < 4; ++r) ss += acc[i][j][r] * acc[i][j][r];
                ss = x4_sum(ss);
                const float rstd = rsqrtf(ss * (1.0f / 64.0f) + EPS) * scl;
#pragma unroll
                for (int j = 0; j < 4; ++j)
#pragma unroll
                    for (int r = 0; r < 4; ++r) acc[i][j][r] *= rstd * gn[j][r];
            }
        }
        store_tile_bf16(acc, smem, (bf16_t*)(P.ws + WS_Z), NZ, m0, n0, tid, wr, wc, g, lr);
    } else if (MODE == 2) {
        float* ssq = (float*)(P.ws + WS_SSQ);
#pragma unroll
        for (int i = 0; i < 4; ++i) {
            const int row = m0 + wr * 64 + 16 * i + lr;
            float ss = 0.f;
#pragma unroll
            for (int j = 0; j < 4; ++j) {
                const int col = n0 + wc * 64 + 16 * j + 4 * g;
                const float4 xv = *(const float4*)(P.x + (size_t)row * DM + col);
                const float4 gv = *(const float4*)(P.norm_ffn + col);
                float4 hv; hv.x = acc[i][j][0] + xv.x; hv.y = acc[i][j][1] + xv.y; hv.z = acc[i][j][2] + xv.z; hv.w = acc[i][j][3] + xv.w;
                ss += hv.x * hv.x + hv.y * hv.y + hv.z * hv.z + hv.w * hv.w;
                acc[i][j][0] = hv.x * gv.x; acc[i][j][1] = hv.y * gv.y; acc[i][j][2] = hv.z * gv.z; acc[i][j][3] = hv.w * gv.w;
            }
            ss = x4_sum(ss);
            if (g == 0) ssq[(size_t)row * 16 + tn * 2 + wc] = ss;
        }
        store_tile_bf16(acc, smem, (bf16_t*)(P.ws + WS_XN), 1024, m0, n0, tid, wr, wc, g, lr);
    } else {
        const int hp = tn;
        float rs[4];
#pragma unroll
        for (int i = 0; i < 4; ++i) {
            const int row = m0 + wr * 64 + 16 * i + lr;
            const float4 sp = i == 0 ? ssp0 : i == 1 ? ssp1 : i == 2 ? ssp2 : ssp3;
            const float s = x4_sum((sp.x + sp.y) + (sp.z + sp.w));
            rs[i] = rsqrtf(s * (1.0f / DM) + EPS);
            if (tn == 0 && wc == 0 && g == 0) ((float*)(P.ws + WS_RSTD))[row] = rs[i];
        }
#pragma unroll
        for (int i = 0; i < 4; ++i)
#pragma unroll
            for (int j = 0; j < 4; ++j) {
                const int row = wr * 64 + 16 * i + lr;
                const int c4 = wc * 16 + 4 * j + g;
                *(f32x4*)(smem + row * 512 + ((c4 ^ (row & 31)) << 4)) = acc[i][j] * rs[i];
            }
        __syncthreads();
        unsigned top[16];
        const int row = tid & 127, half = tid >> 7;
        {
            auto load_keys = [&](unsigned (&dst)[16], int q4) {
#pragma unroll
                for (int s4 = 0; s4 < 4; ++s4) {
                    const int c4 = half * 16 + q4 * 4 + s4;
                    const f32x4 v = *(const f32x4*)(smem + row * 512 + ((c4 ^ (row & 31)) << 4));
#pragma unroll
                    for (int e = 0; e < 4; ++e) dst[s4 * 4 + e] = (ord_key(v[e]) & ~127u) | (unsigned)(127 - (c4 * 4 + e));
                }
            };
            load_keys(top, 0);
            bitonic_sort16_desc(top);
#pragma unroll 1
            for (int q4 = 1; q4 < 4; ++q4) {
                unsigned gq[16];
                load_keys(gq, q4);
                bitonic_sort16_desc(gq);
                bitonic_merge16_top(top, gq);
            }
        }
        __syncthreads();
        if (half) {
            uint4* lp = (uint4*)(smem + row * 64);
            lp[0] = make_uint4(top[0], top[1], top[2], top[3]); lp[1] = make_uint4(top[4], top[5], top[6], top[7]);
            lp[2] = make_uint4(top[8], top[9], top[10], top[11]); lp[3] = make_uint4(top[12], top[13], top[14], top[15]);
        }
        __syncthreads();
        if (!half) {
            const uint4* lp = (const uint4*)(smem + row * 64);
            unsigned other[16];
#pragma unroll
            for (int c = 0; c < 4; ++c) { const uint4 o = lp[c]; other[4 * c] = o.x; other[4 * c + 1] = o.y; other[4 * c + 2] = o.z; other[4 * c + 3] = o.w; }
            bitonic_merge16_top(top, other);
            uint4* tk = (uint4*)((unsigned*)(P.ws + WS_TK) + ((size_t)(m0 + row) * 16 + hp) * 16);
            tk[0] = make_uint4(top[0], top[1], top[2], top[3]); tk[1] = make_uint4(top[4], top[5], top[6], top[7]);
            tk[2] = make_uint4(top[8], top[9], top[10], top[11]); tk[3] = make_uint4(top[12], top[13], top[14], top[15]);
        }
        __syncthreads();
    }
}

__device__ __forceinline__ void fox_cum_wave(const Params& P, int bh, int lane) {
    const int b = bh >> 3, h = bh & 7;
    const float* gates = (const float*)(P.ws + WS_GATES) + (size_t)b * L * 16 + 8 + h;
    float* cum = (float*)(P.ws + WS_CUM) + (size_t)bh * L;
    constexpr int SEG = 33;
    const int t0 = lane * SEG;
    float v[SEG];
#pragma unroll
    for (int i = 0; i < SEG; ++i) { const int t = t0 + i; const float x = gates[(size_t)(t < L ? t : L - 1) * 16]; v[i] = t < L ? x : 0.f; }
    float loc = 0.f;
#pragma unroll
    for (int i = 0; i < SEG; ++i) loc += v[i];
    float incl = loc;
#pragma unroll
    for (int o = 1; o < 64; o <<= 1) { const float n = __shfl_up(incl, o, 64); if (lane >= o) incl += n; }
    float run = incl - loc;
#pragma unroll
    for (int i = 0; i < SEG; ++i) { const int t = t0 + i; run += v[i]; if (t < L) cum[t] = run * LOG2E; }
}

#define TR_SLOW 0

__device__ __forceinline__ int vimg_off(int row, int ch) { return row * 128 + ((ch ^ (((row >> 1) & 3) << 1)) << 4); }
__device__ __forceinline__ uint2 tr_frag(const unsigned char* img, int row0, int c, int g, int lr) {
#if TR_SLOW
    unsigned short e[4];
#pragma unroll
    for (int k = 0; k < 4; ++k) { const int row = row0 + 4 * g + k, col = 16 * c + lr; e[k] = *(const unsigned short*)(img + vimg_off(row, col >> 3) + (col & 7) * 2); }
    uint2 r; r.x = (unsigned)e[0] | ((unsigned)e[1] << 16); r.y = (unsigned)e[2] | ((unsigned)e[3] << 16); return r;
#else
    const int q = lr >> 2, p = lr & 3, row = row0 + 4 * g + q;
    const unsigned addr = (unsigned)(size_t)(img + vimg_off(row, 2 * c + (p >> 1)) + 8 * (p & 1));
    uint2 r;
    asm volatile("ds_read_b64_tr_b16 %0, %1\n\ts_waitcnt lgkmcnt(0)" : "=&v"(r) : "v"(addr) : "memory");
    return r;
#endif
}

__device__ __forceinline__ unsigned tr_lane_addr(const unsigned char* img, int c, int g, int lr) {
    const int q = lr >> 2, p = lr & 3, row = 4 * g + q;
    return (unsigned)(size_t)(img + vimg_off(row, 2 * c + (p >> 1)) + 8 * (p & 1));
}
#define TR_GROUP(o0, o1, o2, o3, a) "ds_read_b64_tr_b16 %" #o0 ", %" #a "\n\tds_read_b64_tr_b16 %" #o1 ", %" #a " offset:2048\n\tds_read_b64_tr_b16 %" #o2 ", %" #a " offset:4096\n\tds_read_b64_tr_b16 %" #o3 ", %" #a " offset:6144\n\t"
__device__ __forceinline__ void tr_read_4c(const unsigned char* img, int g, int lr, uint2 (&r)[4][4]) {
    const unsigned a0 = tr_lane_addr(img, 0, g, lr), a1 = tr_lane_addr(img, 1, g, lr), a2 = tr_lane_addr(img, 2, g, lr), a3 = tr_lane_addr(img, 3, g, lr);
    asm volatile(TR_GROUP(0, 1, 2, 3, 16) TR_GROUP(4, 5, 6, 7, 17) TR_GROUP(8, 9, 10, 11, 18) TR_GROUP(12, 13, 14, 15, 19) "s_waitcnt lgkmcnt(0)"
        : "=&v"(r[0][0]), "=&v"(r[0][1]), "=&v"(r[0][2]), "=&v"(r[0][3]), "=&v"(r[1][0]), "=&v"(r[1][1]), "=&v"(r[1][2]), "=&v"(r[1][3]),
          "=&v"(r[2][0]), "=&v"(r[2][1]), "=&v"(r[2][2]), "=&v"(r[2][3]), "=&v"(r[3][0]), "=&v"(r[3][1]), "=&v"(r[3][2]), "=&v"(r[3][3])
        : "v"(a0), "v"(a1), "v"(a2), "v"(a3) : "memory");
}
__device__ __forceinline__ void tr_read_3c(const unsigned char* img, int g, int lr, uint2 (&r)[3][4]) {
    const unsigned a0 = tr_lane_addr(img, 0, g, lr), a1 = tr_lane_addr(img, 1, g, lr), a2 = tr_lane_addr(img, 2, g, lr);
    asm volatile(TR_GROUP(0, 1, 2, 3, 12) TR_GROUP(4, 5, 6, 7, 13) TR_GROUP(8, 9, 10, 11, 14) "s_waitcnt lgkmcnt(0)"
        : "=&v"(r[0][0]), "=&v"(r[0][1]), "=&v"(r[0][2]), "=&v"(r[0][3]), "=&v"(r[1][0]), "=&v"(r[1][1]), "=&v"(r[1][2]), "=&v"(r[1][3]),
          "=&v"(r[2][0]), "=&v"(r[2][1]), "=&v"(r[2][2]), "=&v"(r[2][3])
        : "v"(a0), "v"(a1), "v"(a2) : "memory");
}
__device__ __forceinline__ void tr_read_2(const unsigned char* img0, int c0, const unsigned char* img1, int c1, int g, int lr, uint2 (&r)[2][4]) {
    const unsigned a0 = tr_lane_addr(img0, c0, g, lr), a1 = tr_lane_addr(img1, c1, g, lr);
    asm volatile(TR_GROUP(0, 1, 2, 3, 8) TR_GROUP(4, 5, 6, 7, 9) "s_waitcnt lgkmcnt(0)"
        : "=&v"(r[0][0]), "=&v"(r[0][1]), "=&v"(r[0][2]), "=&v"(r[0][3]), "=&v"(r[1][0]), "=&v"(r[1][1]), "=&v"(r[1][2]), "=&v"(r[1][3])
        : "v"(a0), "v"(a1) : "memory");
}
__device__ __forceinline__ bf16x8 tr_pair(const uint2& lo, const uint2& hi) { uint4 u; u.x = lo.x; u.y = lo.y; u.z = hi.x; u.w = hi.y; return __builtin_bit_cast(bf16x8, u); }

__device__ __forceinline__ void attn_block(const Params& P, int bh, int qb, unsigned char* smem) {
    const int tid = opaque_tid(), lane = tid & 63, w = tid >> 6, g = lane >> 4, lr = lane & 15;
    const int b = bh >> 3, h = bh & 7;
    const bf16_t* z = (const bf16_t*)(P.ws + WS_Z);
    const float* cum = (const float*)(P.ws + WS_CUM) + (size_t)bh * L;
    int tq[2]; bool qvalid[2]; bf16x8 qf[2][2];
#pragma unroll
    for (int u = 0; u < 2; ++u) {
        tq[u] = qb * 128 + 32 * w + 16 * u + lr;
        qvalid[u] = tq[u] < L;
        const bf16_t* qp = z + (size_t)(b * L + (qvalid[u] ? tq[u] : 0)) * NZ + ZC_FQ + h * 64 + 8 * g;
        qf[u][0] = *(const bf16x8*)(qp); qf[u][1] = *(const bf16x8*)(qp + 32);
    }
    const int nkv = (2 * qb + 2 < 33) ? 2 * qb + 2 : 33;
    const int srow0 = tid >> 3, sch = tid & 7;
    uint4 rk0, rk1, rv0, rv1; float rc = 0.f;
    auto load_tile = [&](int kv) {
        const int key0 = kv * 64 + srow0, key1 = key0 + 32;
        const bf16_t* p0 = z + (size_t)(b * L + (key0 < L ? key0 : L - 1)) * NZ + h * 64 + sch * 8;
        const bf16_t* p1 = z + (size_t)(b * L + (key1 < L ? key1 : L - 1)) * NZ + h * 64 + sch * 8;
        rk0 = *(const uint4*)(p0 + ZC_FK); rv0 = *(const uint4*)(p0 + ZC_FV);
        rk1 = *(const uint4*)(p1 + ZC_FK); rv1 = *(const uint4*)(p1 + ZC_FV);
        const int keyc = kv * 64 + (tid & 63);
        rc = cum[keyc < L ? keyc : L - 1];
    };
    auto store_tile = [&](int buf) {
        unsigned char* sK = smem + buf * 16384; unsigned char* sV = sK + 8192;
        const int row0 = srow0, row1 = srow0 + 32;
        *(uint4*)(sK + row0 * 128 + ((sch ^ (row0 & 7)) << 4)) = rk0;
        *(uint4*)(sV + vimg_off(row0, sch)) = rv0;
        *(uint4*)(sK + row1 * 128 + ((sch ^ (row1 & 7)) << 4)) = rk1;
        *(uint4*)(sV + vimg_off(row1, sch)) = rv1;
        if (tid < 64) ((float*)(smem + 32768 + buf * 256))[tid] = rc;
    };
    float m[2] = {-1e30f, -1e30f};
    f32x4 o[2][5];
#pragma unroll
    for (int u = 0; u < 2; ++u)
#pragma unroll
        for (int c = 0; c < 5; ++c) o[u][c] = (f32x4){0.f, 0.f, 0.f, 0.f};
    const unsigned onew = (lr == 0) ? 0x3F803F80u : 0u;
    const bf16x8 vones = __builtin_bit_cast(bf16x8, make_uint4(onew, onew, onew, onew));
    load_tile(nkv - 1); store_tile((nkv - 1) & 1);
    __syncthreads();
    if (nkv > 1) load_tile(nkv - 2);
    for (int kv = nkv - 1; kv >= 0; --kv) {
        const int buf = kv & 1;
        const unsigned char* sK = smem + buf * 16384; const unsigned char* sV = sK + 8192;
        const float* sck = (const float*)(smem + 32768 + buf * 256);
        f32x4 sa[2][4];
#pragma unroll
        for (int c = 0; c < 4; ++c) {
            sa[0][c] = (f32x4){0.f, 0.f, 0.f, 0.f}; sa[1][c] = (f32x4){0.f, 0.f, 0.f, 0.f};
#pragma unroll
            for (int s = 0; s < 2; ++s) {
                const bf16x8 kf = *(const bf16x8*)(sK + (16 * c + lr) * 128 + (((4 * s + g) ^ (lr & 7)) << 4));
                sa[0][c] = __builtin_amdgcn_mfma_f32_16x16x32_bf16(kf, qf[0][s], sa[0][c], 0, 0, 0);
                sa[1][c] = __builtin_amdgcn_mfma_f32_16x16x32_bf16(kf, qf[1][s], sa[1][c], 0, 0, 0);
            }
        }
        __builtin_amdgcn_sched_barrier(0);
        if (kv > 0) store_tile(buf ^ 1);
        if (kv > 1) load_tile(kv - 2);
        __builtin_amdgcn_sched_barrier(0);
        if (kv >= 2 * qb) {
#pragma unroll
            for (int u = 0; u < 2; ++u)
#pragma unroll
                for (int c = 0; c < 4; ++c)
#pragma unroll
                    for (int r = 0; r < 4; ++r)
                        if (64 * kv + 16 * c + 4 * g + r > tq[u]) sa[u][c][r] = -INFINITY;
        }
        f32x4 ck[4];
#pragma unroll
        for (int c = 0; c < 4; ++c) ck[c] = *(const f32x4*)(sck + 16 * c + 4 * g);
        bf16x8 pf[2][2];
#pragma unroll
        for (int u = 0; u < 2; ++u) {
            float mx = -INFINITY;
#pragma unroll
            for (int c = 0; c < 4; ++c) {
                sa[u][c] -= ck[c];
                mx = fmaxf(mx, fmaxf(fmaxf(sa[u][c][0], sa[u][c][1]), fmaxf(sa[u][c][2], sa[u][c][3])));
            }
            mx = x4_max(mx);
            if (__builtin_amdgcn_ballot_w64(mx > m[u]) != 0ull) {
                const float mn = fmaxf(m[u], mx);
                const float alpha = __builtin_amdgcn_exp2f(m[u] - mn);
                m[u] = mn;
#pragma unroll
                for (int c = 0; c < 5; ++c) o[u][c] *= alpha;
            }
            const float mn = m[u];
#pragma unroll
            for (int c = 0; c < 4; ++c)
#pragma unroll
                for (int r = 0; r < 4; ++r) sa[u][c][r] = __builtin_amdgcn_exp2f(sa[u][c][r] - mn);
#pragma unroll
            for (int s2 = 0; s2 < 2; ++s2) {
                uint4 uu;
                uu.x = cvt_pk_bf16(sa[u][2 * s2][0], sa[u][2 * s2][1]); uu.y = cvt_pk_bf16(sa[u][2 * s2][2], sa[u][2 * s2][3]);
                uu.z = cvt_pk_bf16(sa[u][2 * s2 + 1][0], sa[u][2 * s2 + 1][1]); uu.w = cvt_pk_bf16(sa[u][2 * s2 + 1][2], sa[u][2 * s2 + 1][3]);
                pf[u][s2] = __builtin_bit_cast(bf16x8, uu);
            }
        }
        {
            uint2 vr[4][4];
            tr_read_4c(sV, g, lr, vr);
#pragma unroll
            for (int c = 0; c < 4; ++c)
#pragma unroll
                for (int s2 = 0; s2 < 2; ++s2) {
                    const bf16x8 vf = tr_pair(vr[c][2 * s2], vr[c][2 * s2 + 1]);
                    o[0][c] = __builtin_amdgcn_mfma_f32_16x16x32_bf16(vf, pf[0][s2], o[0][c], 0, 0, 0);
                    o[1][c] = __builtin_amdgcn_mfma_f32_16x16x32_bf16(vf, pf[1][s2], o[1][c], 0, 0, 0);
                }
#pragma unroll
            for (int s2 = 0; s2 < 2; ++s2) {
                o[0][4] = __builtin_amdgcn_mfma_f32_16x16x32_bf16(vones, pf[0][s2], o[0][4], 0, 0, 0);
                o[1][4] = __builtin_amdgcn_mfma_f32_16x16x32_bf16(vones, pf[1][s2], o[1][4], 0, 0, 0);
            }
        }
        __syncthreads();
    }
#pragma unroll
    for (int u = 0; u < 2; ++u) {
        const float ls = __shfl(o[u][4][0], lr, 64);
        const float inv = 1.0f / ls;
        if (qvalid[u]) {
            bf16_t* y = (bf16_t*)(P.ws + WS_Z) + (size_t)(b * L + tq[u]) * NZ + 512 + h * 64 + 4 * g;
#pragma unroll
            for (int c = 0; c < 4; ++c) {
                uint2 uu; uu.x = pk2(o[u][c][0] * inv, o[u][c][1] * inv); uu.y = pk2(o[u][c][2] * inv, o[u][c][3] * inv);
                *(uint2*)(y + 16 * c) = uu;
            }
        }
    }
}

__device__ __forceinline__ void conv_item(const Params& P, int ci) {
    const int tid = opaque_tid(), cc = tid & 127, rg = tid >> 7;
    const bf16_t* z = (const bf16_t*)(P.ws + WS_Z);
    bf16_t* qk = (bf16_t*)(P.ws + WS_RA);
    const int col0 = cc * 8;
    float w[4][8];
#pragma unroll
    for (int j = 0; j < 4; ++j) {
        const float4 a = *(const float4*)(P.conv_qk + j * 1024 + col0), b = *(const float4*)(P.conv_qk + j * 1024 + col0 + 4);
        w[j][0] = a.x; w[j][1] = a.y; w[j][2] = a.z; w[j][3] = a.w; w[j][4] = b.x; w[j][5] = b.y; w[j][6] = b.z; w[j][7] = b.w;
    }
    const float oscale = (col0 >= 512) ? 0.08838834764831845f : 1.0f;
    const int r0 = ci * 64 + rg * 32;
    int t = r0 % L;
    float xw[3][8];
#pragma unroll
    for (int j = 0; j < 3; ++j) {
        const int back = 3 - j;
        if (t - back >= 0) {
            const uint4 v = *(const uint4*)(z + (size_t)(r0 - back) * NZ + col0);
            xw[j][0] = bflo(v.x); xw[j][1] = bfhi(v.x); xw[j][2] = bflo(v.y); xw[j][3] = bfhi(v.y); xw[j][4] = bflo(v.z); xw[j][5] = bfhi(v.z); xw[j][6] = bflo(v.w); xw[j][7] = bfhi(v.w);
        } else {
#pragma unroll
            for (int e = 0; e < 8; ++e) xw[j][e] = 0.f;
        }
    }
#pragma unroll 2
    for (int i = 0; i < 32; ++i) {
        const int r = r0 + i;
        if (t == 0) {
#pragma unroll
            for (int j = 0; j < 3; ++j)
#pragma unroll
                for (int e = 0; e < 8; ++e) xw[j][e] = 0.f;
        }
        const uint4 v = *(const uint4*)(z + (size_t)r * NZ + col0);
        float xt[8];
        xt[0] = bflo(v.x); xt[1] = bfhi(v.x); xt[2] = bflo(v.y); xt[3] = bfhi(v.y); xt[4] = bflo(v.z); xt[5] = bfhi(v.z); xt[6] = bflo(v.w); xt[7] = bfhi(v.w);
        float o[8];
#pragma unroll
        for (int e = 0; e < 8; ++e) {
            const float cv = w[0][e] * xw[0][e] + w[1][e] * xw[1][e] + w[2][e] * xw[2][e] + w[3][e] * xt[e];
            o[e] = oscale * cv / (1.f + __expf(-cv));
            xw[0][e] = xw[1][e]; xw[1][e] = xw[2][e]; xw[2][e] = xt[e];
        }
        uint4 ov; ov.x = pk2(o[0], o[1]); ov.y = pk2(o[2], o[3]); ov.z = pk2(o[4], o[5]); ov.w = pk2(o[6], o[7]);
        *(uint4*)(qk + (size_t)r * 1024 + col0) = ov;
        t = (t + 1 == L) ? 0 : t + 1;
    }
}

constexpr int ST_IMG = 36864;
__device__ __forceinline__ int st_piece_off(int jt, int c, int g, int lr) { return (jt >> 2) * 18432 + vimg_off(16 * c + lr, 2 * (jt & 3) + (g >> 1)) + 8 * (g & 1); }

__device__ __forceinline__ void mlstm_stage_kv(const Params& P, int b, int h, int k, unsigned char* sKimg, unsigned char* sVimg, int tid) {
    const bf16_t* z = (const bf16_t*)(P.ws + WS_Z);
    const bf16_t* qk = (const bf16_t*)(P.ws + WS_RA);
    uint4 pk_[4], pv_[4];
#pragma unroll
    for (int j = 0; j < 4; ++j) {
        const int id = tid + 256 * j, row = id >> 4, ch16 = id & 15, pos = 64 * k + row;
        const bool ok = pos < L;
        pk_[j] = ok ? *(const uint4*)(qk + (size_t)(b * L + pos) * 1024 + 512 + h * 128 + ch16 * 8) : make_uint4(0, 0, 0, 0);
        pv_[j] = ok ? *(const uint4*)(z + (size_t)(b * L + pos) * NZ + ZC_MV + h * 128 + ch16 * 8) : make_uint4(0, 0, 0, 0);
    }
#pragma unroll
    for (int j = 0; j < 4; ++j) {
        const int id = tid + 256 * j, row = id >> 4, ch16 = id & 15;
        *(uint4*)(sKimg + (ch16 >> 3) * 8192 + vimg_off(row, ch16 & 7)) = pk_[j];
        *(uint4*)(sVimg + (ch16 >> 3) * 8192 + vimg_off(row, ch16 & 7)) = pv_[j];
    }
    if (tid < 128) {
        const int row = tid >> 1, ch = tid & 1;
        *(uint4*)(sVimg + 16384 + vimg_off(row, ch)) = ch ? make_uint4(0, 0, 0, 0) : make_uint4(0x3F80u, 0, 0, 0);
    }
}

__device__ __forceinline__ void mlstm_stage_A(const Params& P, int b, int h, int k, unsigned char* sKimg, unsigned char* sVimg, int tid) {
    const bf16_t* z = (const bf16_t*)(P.ws + WS_Z);
    bf16_t* qk = (bf16_t*)(P.ws + WS_RA);
    uint4 pv_[4];
#pragma unroll
    for (int j = 0; j < 4; ++j) {
        const int id = tid + 256 * j, row = id >> 4, ch16 = id & 15, pos = 64 * k + row;
        pv_[j] = (pos < L) ? *(const uint4*)(z + (size_t)(b * L + pos) * NZ + ZC_MV + h * 128 + ch16 * 8) : make_uint4(0, 0, 0, 0);
    }
    const int cch = tid & 31, rg = tid >> 5, isk = cch >> 4;
    const int zcol = (isk ? ZC_MK : ZC_MQ) + h * 128 + (cch & 15) * 8;
    float w[4][8];
#pragma unroll
    for (int j = 0; j < 4; ++j) {
        const float4 a = *(const float4*)(P.conv_qk + j * 1024 + zcol), c = *(const float4*)(P.conv_qk + j * 1024 + zcol + 4);
        w[j][0] = a.x; w[j][1] = a.y; w[j][2] = a.z; w[j][3] = a.w; w[j][4] = c.x; w[j][5] = c.y; w[j][6] = c.z; w[j][7] = c.w;
    }
    const float oscale = isk ? 0.08838834764831845f : 1.0f;
    const int p0 = 64 * k + 8 * rg;
    uint4 raw[11];
#pragma unroll
    for (int i = 0; i < 11; ++i) {
        const int pos = p0 - 3 + i;
        raw[i] = (pos >= 0 && pos < L) ? *(const uint4*)(z + (size_t)(b * L + pos) * NZ + zcol) : make_uint4(0, 0, 0, 0);
    }
#pragma unroll
    for (int j = 0; j < 4; ++j) {
        const int id = tid + 256 * j, row = id >> 4, ch16 = id & 15;
        *(uint4*)(sVimg + (ch16 >> 3) * 8192 + vimg_off(row, ch16 & 7)) = pv_[j];
    }
    if (tid < 128) {
        const int row = tid >> 1, ch = tid & 1;
        *(uint4*)(sVimg + 16384 + vimg_off(row, ch)) = ch ? make_uint4(0, 0, 0, 0) : make_uint4(0x3F80u, 0, 0, 0);
    }
#pragma unroll
    for (int i = 0; i < 8; ++i) {
        const int pos = p0 + i, row = 8 * rg + i;
        float o[8];
#pragma unroll
        for (int e = 0; e < 8; ++e) {
            const unsigned w0 = (&raw[i].x)[e >> 1], w1 = (&raw[i + 1].x)[e >> 1], w2 = (&raw[i + 2].x)[e >> 1], w3 = (&raw[i + 3].x)[e >> 1];
            const float x0 = (e & 1) ? bfhi(w0) : bflo(w0), x1 = (e & 1) ? bfhi(w1) : bflo(w1), x2 = (e & 1) ? bfhi(w2) : bflo(w2), x3 = (e & 1) ? bfhi(w3) : bflo(w3);
            const float cv = w[0][e] * x0 + w[1][e] * x1 + w[2][e] * x2 + w[3][e] * x3;
            o[e] = oscale * cv / (1.f + __expf(-cv));
        }
        uint4 ov; ov.x = pk2(o[0], o[1]); ov.y = pk2(o[2], o[3]); ov.z = pk2(o[4], o[5]); ov.w = pk2(o[6], o[7]);
        const bool ok = pos < L;
        if (!ok) ov = make_uint4(0, 0, 0, 0);
        if (ok) *(uint4*)(qk + (size_t)(b * L + pos) * 1024 + (isk ? 512 : 0) + h * 128 + (cch & 15) * 8) = ov;
        if (isk) { const int ch16 = cch & 15; *(uint4*)(sKimg + (ch16 >> 3) * 8192 + vimg_off(row, ch16 & 7)) = ov; }
    }
}

__device__ __forceinline__ void mlstm_A(const Params& P, int item, unsigned char* smem) {
    const int tid = opaque_tid(), lane = tid & 63, w = tid >> 6, g = lane >> 4, lr = lane & 15;
    const int wu = __builtin_amdgcn_readfirstlane(w);
    const int k = item >> 5, bh = item & 31, b = bh >> 2, h = bh & 3;
    const float* gates = (const float*)(P.ws + WS_GATES);
    const unsigned char* sK = smem; const unsigned char* sV = smem + 16384;
    float* ga = (float*)(smem + 40960);
    float lf = 0.f, li = -INFINITY;
    if (wu == 0) {
        const int pos = 64 * k + lane;
        if (pos < L) { lf = gates[(size_t)(b * L + pos) * 16 + 4 + h]; li = gates[(size_t)(b * L + pos) * 16 + h]; }
    }
    mlstm_stage_A(P, b, h, k, smem, smem + 16384, tid);
    if (wu == 0) {
        float bc = lf;
#pragma unroll
        for (int o = 1; o < 64; o <<= 1) { const float n = __shfl_up(bc, o, 64); if (lane >= o) bc += n; }
        const float a = li - bc;
        const float A = wave_max(a);
        ga[lane] = __expf(a - A);
        if (lane == 63) { float* msc = (float*)(P.ws + WS_MSC) + ((size_t)bh * 33 + k) * 4; msc[0] = A; msc[1] = bc; }
    }
    __syncthreads();
    f32x4 Ct[2][9];
#pragma unroll
    for (int a = 0; a < 2; ++a)
#pragma unroll
        for (int c = 0; c < 9; ++c) Ct[a][c] = (f32x4){0.f, 0.f, 0.f, 0.f};
    bf16x8 kt[2][2];
#pragma unroll
    for (int a = 0; a < 2; ++a)
#pragma unroll
        for (int s2 = 0; s2 < 2; ++s2) {
            const int jt = 2 * w + a;
            kt[a][s2] = tr_pair(tr_frag(sK + (jt >> 2) * 8192, 32 * s2, jt & 3, g, lr), tr_frag(sK + (jt >> 2) * 8192, 32 * s2 + 16, jt & 3, g, lr));
        }
    f32x4 wg4[4];
#pragma unroll
    for (int j = 0; j < 4; ++j) wg4[j] = *(const f32x4*)(ga + 16 * j + 4 * g);
#define MA_TILE(c, lo0, hi0, lo1, hi1) { \
        { const f32x4 w0 = wg4[0], w1 = wg4[1]; uint4 o; \
          o.x = cvt_pk_bf16(bflo(lo0.x) * w0[0], bfhi(lo0.x) * w0[1]); o.y = cvt_pk_bf16(bflo(lo0.y) * w0[2], bfhi(lo0.y) * w0[3]); \
          o.z = cvt_pk_bf16(bflo(hi0.x) * w1[0], bfhi(hi0.x) * w1[1]); o.w = cvt_pk_bf16(bflo(hi0.y) * w1[2], bfhi(hi0.y) * w1[3]); \
          const bf16x8 vw = __builtin_bit_cast(bf16x8, o); \
          Ct[0][c] = __builtin_amdgcn_mfma_f32_16x16x32_bf16(kt[0][0], vw, Ct[0][c], 0, 0, 0); Ct[1][c] = __builtin_amdgcn_mfma_f32_16x16x32_bf16(kt[1][0], vw, Ct[1][c], 0, 0, 0); } \
        { const f32x4 w0 = wg4[2], w1 = wg4[3]; uint4 o; \
          o.x = cvt_pk_bf16(bflo(lo1.x) * w0[0], bfhi(lo1.x) * w0[1]); o.y = cvt_pk_bf16(bflo(lo1.y) * w0[2], bfhi(lo1.y) * w0[3]); \
          o.z = cvt_pk_bf16(bflo(hi1.x) * w1[0], bfhi(hi1.x) * w1[1]); o.w = cvt_pk_bf16(bflo(hi1.y) * w1[2], bfhi(hi1.y) * w1[3]); \
          const bf16x8 vw = __builtin_bit_cast(bf16x8, o); \
          Ct[0][c] = __builtin_amdgcn_mfma_f32_16x16x32_bf16(kt[0][1], vw, Ct[0][c], 0, 0, 0); Ct[1][c] = __builtin_amdgcn_mfma_f32_16x16x32_bf16(kt[1][1], vw, Ct[1][c], 0, 0, 0); } }
    {
        uint2 vr[4][4];
        tr_read_4c(sV, g, lr, vr);
        MA_TILE(0, vr[0][0], vr[0][1], vr[0][2], vr[0][3]) MA_TILE(1, vr[1][0], vr[1][1], vr[1][2], vr[1][3])
        MA_TILE(2, vr[2][0], vr[2][1], vr[2][2], vr[2][3]) MA_TILE(3, vr[3][0], vr[3][1], vr[3][2], vr[3][3])
        tr_read_4c(sV + 8192, g, lr, vr);
        MA_TILE(4, vr[0][0], vr[0][1], vr[0][2], vr[0][3]) MA_TILE(5, vr[1][0], vr[1][1], vr[1][2], vr[1][3])
        MA_TILE(6, vr[2][0], vr[2][1], vr[2][2], vr[2][3]) MA_TILE(7, vr[3][0], vr[3][1], vr[3][2], vr[3][3])
        const uint2 o0 = tr_frag(sV + 16384, 0, 0, g, lr), o1 = tr_frag(sV + 16384, 16, 0, g, lr), o2 = tr_frag(sV + 16384, 32, 0, g, lr), o3 = tr_frag(sV + 16384, 48, 0, g, lr);
        MA_TILE(8, o0, o1, o2, o3)
    }
#undef MA_TILE
    unsigned char* slot = P.ws + WS_MST + ((size_t)bh * 33 + k) * ST_IMG;
#pragma unroll
    for (int a = 0; a < 2; ++a)
#pragma unroll
        for (int c = 0; c < 9; ++c) {
            uint2 u; u.x = cvt_pk_bf16(Ct[a][c][0], Ct[a][c][1]); u.y = cvt_pk_bf16(Ct[a][c][2], Ct[a][c][3]);
            *(uint2*)(slot + st_piece_off(2 * w + a, c, g, lr)) = u;
        }
}

__device__ __forceinline__ void mlstm_B(const Params& P, int item) {
    const int tid = opaque_tid();
    const int bh = item / 3, part = item - bh * 3;
    const unsigned char* base = P.ws + WS_MST + (size_t)bh * 33 * ST_IMG + part * 12288 + tid * 48;
    unsigned char* obase = P.ws + WS_CBI + (size_t)bh * 33 * ST_IMG + part * 12288 + tid * 48;
    float* msc = (float*)(P.ws + WS_MSC) + (size_t)bh * 33 * 4;
    float C[6][4];
#pragma unroll
    for (int i = 0; i < 6; ++i)
#pragma unroll
        for (int r = 0; r < 4; ++r) C[i][r] = 0.f;
    float m = 0.f;
    uint2 d0[6], d1[6];
    float2 ab0, ab1;
#pragma unroll
    for (int i = 0; i < 6; ++i) { d0[i] = *(const uint2*)(base + i * 8); d1[i] = *(const uint2*)(base + ST_IMG + i * 8); }
    ab0 = *(const float2*)(msc); ab1 = *(const float2*)(msc + 4);
    for (int k = 0; k < 33; ++k) {
        uint2 d2[6]; float2 ab2 = make_float2(0.f, 0.f);
        if (k + 2 < 33) {
#pragma unroll
            for (int i = 0; i < 6; ++i) d2[i] = *(const uint2*)(base + (size_t)(k + 2) * ST_IMG + i * 8);
            ab2 = *(const float2*)(msc + (k + 2) * 4);
        } else {
#pragma unroll
            for (int i = 0; i < 6; ++i) d2[i] = make_uint2(0, 0);
        }
#pragma unroll
        for (int i = 0; i < 6; ++i) {
            uint2 u; u.x = cvt_pk_bf16(C[i][0], C[i][1]); u.y = cvt_pk_bf16(C[i][2], C[i][3]);
            *(uint2*)(obase + (size_t)k * ST_IMG + i * 8) = u;
        }
        if (tid == 0 && part == 0) msc[k * 4 + 2] = m;
        const float M = fmaxf(m, ab0.x);
        const float decay = __expf(m - M), sc = __expf(ab0.x - M);
#pragma unroll
        for (int i = 0; i < 6; ++i) {
            C[i][0] = decay * C[i][0] + sc * bflo(d0[i].x); C[i][1] = decay * C[i][1] + sc * bfhi(d0[i].x);
            C[i][2] = decay * C[i][2] + sc * bflo(d0[i].y); C[i][3] = decay * C[i][3] + sc * bfhi(d0[i].y);
        }
        m = ab0.y + M;
#pragma unroll
        for (int i = 0; i < 6; ++i) { d0[i] = d1[i]; d1[i] = d2[i]; }
        ab0 = ab1; ab1 = ab2;
    }
}

__device__ __forceinline__ void mlstm_C(const Params& P, int item, unsigned char* smem) {
    const int tid = opaque_tid(), lane = tid & 63, w = tid >> 6, g = lane >> 4, lr = lane & 15;
    const int wu = __builtin_amdgcn_readfirstlane(w);
    const int k = item >> 5, bh = item & 31, b = bh >> 2, h = bh & 3;
    const bf16_t* z = (const bf16_t*)(P.ws + WS_Z);
    const bf16_t* qk = (const bf16_t*)(P.ws + WS_RA);
    const float* gates = (const float*)(P.ws + WS_GATES);
    bf16_t* y = (bf16_t*)(P.ws + WS_Z);
    const unsigned char* sK = smem; const unsigned char* sV = smem + 36864; unsigned char* sCb = smem;
    float* ga = (float*)(smem + 61440);
    const int pos = 64 * k + 16 * w + lr;
    const bool tvalid = pos < L;
    const size_t rrow = (size_t)(b * L + (tvalid ? pos : 0));
    const unsigned char* cslot = P.ws + WS_CBI + ((size_t)bh * 33 + k) * ST_IMG + tid * 16;
    const uint4 cb0 = *(const uint4*)(cslot), cb1 = *(const uint4*)(cslot + 4096), cb2 = *(const uint4*)(cslot + 8192), cb3 = *(const uint4*)(cslot + 12288), cb4 = *(const uint4*)(cslot + 16384),
                cb5 = *(const uint4*)(cslot + 20480), cb6 = *(const uint4*)(cslot + 24576), cb7 = *(const uint4*)(cslot + 28672), cb8 = *(const uint4*)(cslot + 32768);
    bf16x8 qf[4];
    {
        const bf16_t* qp = qk + rrow * 1024 + h * 128 + 8 * g;
#pragma unroll
        for (int ks = 0; ks < 4; ++ks) { qf[ks] = *(const bf16x8*)(qp + 32 * ks); if (!tvalid) qf[ks] = (bf16x8){0, 0, 0, 0, 0, 0, 0, 0}; }
    }
    float m_prev = 0.f, lf = 0.f, li = -INFINITY;
    if (wu == 0) {
        m_prev = ((const float*)(P.ws + WS_MSC))[((size_t)bh * 33 + k) * 4 + 2];
        const int p2 = 64 * k + lane;
        if (p2 < L) { lf = gates[(size_t)(b * L + p2) * 16 + 4 + h]; li = gates[(size_t)(b * L + p2) * 16 + h]; }
    }
    mlstm_stage_kv(P, b, h, k, smem, smem + 36864, tid);
    if (wu == 0) {
        float bc = lf;
#pragma unroll
        for (int o = 1; o < 64; o <<= 1) { const float n = __shfl_up(bc, o, 64); if (lane >= o) bc += n; }
        const float a = li - bc;
        float am = a;
#pragma unroll
        for (int o = 1; o < 64; o <<= 1) { const float n = __shfl_up(am, o, 64); if (lane >= o) am = fmaxf(am, n); }
        const float M = fmaxf(m_prev, am);
        ga[lane] = a; ga[64 + lane] = __expf(m_prev - M); ga[128 + lane] = __expf(-(bc + M)); ga[192 + lane] = M;
    }
    __syncthreads();
    const float Mt = ga[192 + 16 * w + lr], Wi = ga[64 + 16 * w + lr], Et = ga[128 + 16 * w + lr];
    bf16x8 pf[2];
    {
        f32x4 sa[4];
#pragma unroll
        for (int c = 0; c < 4; ++c) {
            sa[c] = (f32x4){0.f, 0.f, 0.f, 0.f};
            if (c <= wu) {
#pragma unroll
                for (int ks = 0; ks < 4; ++ks) {
                    const bf16x8 kf = *(const bf16x8*)(sK + (ks >> 1) * 8192 + vimg_off(16 * c + lr, 4 * (ks & 1) + g));
                    sa[c] = __builtin_amdgcn_mfma_f32_16x16x32_bf16(kf, qf[ks], sa[c], 0, 0, 0);
                }
                const f32x4 av = *(const f32x4*)(ga + 16 * c + 4 * g);
#pragma unroll
                for (int r = 0; r < 4; ++r) {
                    const float d = __expf(av[r] - Mt);
                    sa[c][r] = (16 * c + 4 * g + r <= 16 * w + lr) ? sa[c][r] * d : 0.f;
                }
            }
        }
#pragma unroll
        for (int s2 = 0; s2 < 2; ++s2) {
            uint4 u;
            u.x = cvt_pk_bf16(sa[2 * s2][0], sa[2 * s2][1]); u.y = cvt_pk_bf16(sa[2 * s2][2], sa[2 * s2][3]);
            u.z = cvt_pk_bf16(sa[2 * s2 + 1][0], sa[2 * s2 + 1][1]); u.w = cvt_pk_bf16(sa[2 * s2 + 1][2], sa[2 * s2 + 1][3]);
            pf[s2] = __builtin_bit_cast(bf16x8, u);
        }
    }
    __syncthreads();
    {
        unsigned char* d = sCb + tid * 16;
        *(uint4*)(d) = cb0; *(uint4*)(d + 4096) = cb1; *(uint4*)(d + 8192) = cb2; *(uint4*)(d + 12288) = cb3; *(uint4*)(d + 16384) = cb4;
        *(uint4*)(d + 20480) = cb5; *(uint4*)(d + 24576) = cb6; *(uint4*)(d + 28672) = cb7; *(uint4*)(d + 32768) = cb8;
    }
    __syncthreads();
    f32x4 na[9];
#define MC_TILE(c, lo0, hi0, lo1, hi1) { \
        na[c] = (f32x4){0.f, 0.f, 0.f, 0.f}; \
        _Pragma("unroll") for (int ks = 0; ks < 4; ++ks) { \
            const bf16x8 cf = *(const bf16x8*)(sCb + (ks >> 1) * 18432 + vimg_off(16 * (c) + lr, 4 * (ks & 1) + g)); \
            na[c] = __builtin_amdgcn_mfma_f32_16x16x32_bf16(cf, qf[ks], na[c], 0, 0, 0); } \
        na[c] *= Wi; \
        na[c] = __builtin_amdgcn_mfma_f32_16x16x32_bf16(tr_pair(lo0, hi0), pf[0], na[c], 0, 0, 0); \
        na[c] = __builtin_amdgcn_mfma_f32_16x16x32_bf16(tr_pair(lo1, hi1), pf[1], na[c], 0, 0, 0); }
    {
        uint2 vr[4][4];
        tr_read_4c(sV, g, lr, vr);
        MC_TILE(0, vr[0][0], vr[0][1], vr[0][2], vr[0][3]) MC_TILE(1, vr[1][0], vr[1][1], vr[1][2], vr[1][3])
        MC_TILE(2, vr[2][0], vr[2][1], vr[2][2], vr[2][3]) MC_TILE(3, vr[3][0], vr[3][1], vr[3][2], vr[3][3])
        tr_read_4c(sV + 8192, g, lr, vr);
        MC_TILE(4, vr[0][0], vr[0][1], vr[0][2], vr[0][3]) MC_TILE(5, vr[1][0], vr[1][1], vr[1][2], vr[1][3])
        MC_TILE(6, vr[2][0], vr[2][1], vr[2][2], vr[2][3]) MC_TILE(7, vr[3][0], vr[3][1], vr[3][2], vr[3][3])
        const uint2 o0 = tr_frag(sV + 16384, 0, 0, g, lr), o1 = tr_frag(sV + 16384, 16, 0, g, lr), o2 = tr_frag(sV + 16384, 32, 0, g, lr), o3 = tr_frag(sV + 16384, 48, 0, g, lr);
        MC_TILE(8, o0, o1, o2, o3)
    }
#undef MC_TILE
    const float den = __shfl(na[8][0], lr, 64);
    const float rden = 1.0f / fmaxf(fabsf(den), Et);
    float hs = 0.f;
#pragma unroll
    for (int c = 0; c < 8; ++c) { na[c] *= rden; hs += na[c][0] * na[c][0] + na[c][1] * na[c][1] + na[c][2] * na[c][2] + na[c][3] * na[c][3]; }
    hs = x4_sum(hs);
    const float rstd = rsqrtf(hs * (1.0f / 128.0f) + EPS);
    const float* gainp = P.m_out_norm + h * 128 + 4 * g;
#pragma unroll
    for (int c = 0; c < 8; ++c) {
        const uint2 og = *(const uint2*)(z + rrow * NZ + ZC_MO + h * 128 + 16 * c + 4 * g);
        const float o0 = bflo(og.x), o1 = bfhi(og.x), o2 = bflo(og.y), o3 = bfhi(og.y);
        const float4 gn = *(const float4*)(gainp + 16 * c);
        uint2 u;
        u.x = pk2(na[c][0] * rstd * gn.x / (1.f + __expf(-o0)), na[c][1] * rstd * gn.y / (1.f + __expf(-o1)));
        u.y = pk2(na[c][2] * rstd * gn.z / (1.f + __expf(-o2)), na[c][3] * rstd * gn.w / (1.f + __expf(-o3)));
        if (tvalid) *(uint2*)(y + rrow * NZ + h * 128 + 16 * c + 4 * g) = u;
    }
}

__device__ __forceinline__ void peer_token(const Params& P, int t, int tnext, uint4& tkw, int lane, int* sidx, float* sval, int* sid, float* sgate, const unsigned char* slut, const unsigned* szero) {
    {
        const unsigned kk[4] = {tkw.x, tkw.y, tkw.z, tkw.w};
#pragma unroll
        for (int i = 0; i < 4; ++i) {
            const unsigned k = kk[i];
            sidx[lane * 4 + i] = 127 - (int)(k & 127u);
            sval[lane * 4 + i] = unord_key(k & ~127u);
        }
        tkw = *(const uint4*)((const unsigned*)(P.ws + WS_TK) + (size_t)tnext * 256 + lane * 4);
    }
    const bf16_t* xn = (const bf16_t*)(P.ws + WS_XN) + (size_t)t * DM;
    const uint4 xa_pre = *(const uint4*)(xn + lane * 16), xb_pre = *(const uint4*)(xn + lane * 16 + 8);
    const float rstd = ((const float*)(P.ws + WS_RSTD))[t];
    __builtin_amdgcn_s_waitcnt(0xc07f);
    __builtin_amdgcn_wave_barrier();
    {
        const int hd = lane >> 3, sub = lane & 7;
        unsigned x[8];
#pragma unroll
        for (int r = 0; r < 8; ++r) {
            const int c = sub * 8 + r;
            const unsigned ij = slut[c < 50 ? c : 0];
            const int i = ij >> 4, j = ij & 15;
            const unsigned kx = (ord_key(sval[(2 * hd) * 16 + i] + sval[(2 * hd + 1) * 16 + j]) & ~255u) | (unsigned)(255 - (i * 16 + j));
            x[r] = c < 50 ? kx : 0u;
        }
#pragma unroll
        for (int k = 2; k <= 64; k <<= 1) {
#pragma unroll
            for (int j = k >> 1; j >= 1; j >>= 1) {
                if (j >= 8) {
                    const int ld = j >> 3;
                    const bool lower = (sub & ld) == 0;
                    const bool desc = k >= 64 ? true : ((sub * 8) & k) == 0;
                    const bool takemax = (lower == desc);
#pragma unroll
                    for (int r = 0; r < 8; ++r) {
                        const unsigned o = (unsigned)__shfl_xor((int)x[r], ld, 64);
                        const unsigned hi = max(x[r], o), lo = min(x[r], o);
                        x[r] = takemax ? hi : lo;
                    }
                } else {
#pragma unroll
                    for (int r = 0; r < 8; ++r) {
                        if ((r & j) == 0) {
                            const int p = r | j;
                            const unsigned hi = max(x[r], x[p]), lo = min(x[r], x[p]);
                            if (k <= 4) { const bool desc = (r & k) == 0; x[r] = desc ? hi : lo; x[p] = desc ? lo : hi; }
                            else if (k >= 64) { x[r] = hi; x[p] = lo; }
                            else { const bool desc = ((sub * 8) & k) == 0; x[r] = desc ? hi : lo; x[p] = desc ? lo : hi; }
                        }
                    }
                }
            }
        }
        const float smax = unord_key((unsigned)__shfl((int)x[0], hd * 8, 64) & ~255u);
        float e[8]; float den = 0.f;
#pragma unroll
        for (int r = 0; r < 8; ++r) { e[r] = __expf(unord_key(x[r] & ~255u) - smax); den += e[r]; }
        den += __shfl_xor(den, 1, 64);
        const float inv = 1.f / den;
        if (sub < 2) {
#pragma unroll
            for (int r = 0; r < 8; ++r) {
                const int pos = 255 - (int)(x[r] & 255u), i = pos >> 4, j = pos & 15;
                sid[hd * 16 + sub * 8 + r] = sidx[(2 * hd) * 16 + i] * 128 + sidx[(2 * hd + 1) * 16 + j];
                sgate[hd * 16 + sub * 8 + r] = e[r] * inv;
            }
        }
    }
    __builtin_amdgcn_s_waitcnt(0xc07f);
    __builtin_amdgcn_wave_barrier();
    const unsigned char* V = P.ws + WS_V + lane * 8;
    const float* usc = (const float*)(P.ws + WS_USC);
    const float* vsc = (const float*)(P.ws + WS_VSC);
    const int g = lane >> 4, lr = lane & 15;
    unsigned char* shi = (unsigned char*)sval;
    unsigned char* slo = (unsigned char*)sidx;
    {
        const uint4 xa = xa_pre, xb = xb_pre;
        const unsigned xw[8] = {xa.x, xa.y, xa.z, xa.w, xb.x, xb.y, xb.z, xb.w};
        unsigned hi[4], lo[4];
#pragma unroll
        for (int i = 0; i < 4; ++i) {
            const float x0 = bflo(xw[2 * i]), x1 = bfhi(xw[2 * i]), x2 = bflo(xw[2 * i + 1]), x3 = bfhi(xw[2 * i + 1]);
            int wd = 0;
            wd = __builtin_amdgcn_cvt_pk_fp8_f32(x0, x1, wd, false);
            wd = __builtin_amdgcn_cvt_pk_fp8_f32(x2, x3, wd, true);
            const f32x2 h01 = __builtin_amdgcn_cvt_pk_f32_fp8(wd, false), h23 = __builtin_amdgcn_cvt_pk_f32_fp8(wd, true);
            int wl = 0;
            wl = __builtin_amdgcn_cvt_pk_fp8_f32(x0 - h01.x, x1 - h01.y, wl, false);
            wl = __builtin_amdgcn_cvt_pk_fp8_f32(x2 - h23.x, x3 - h23.y, wl, true);
            hi[i] = (unsigned)wd; lo[i] = (unsigned)wl;
        }
        *(uint4*)(shi + lane * 16) = make_uint4(hi[0], hi[1], hi[2], hi[3]);
        *(uint4*)(slo + lane * 16) = make_uint4(lo[0], lo[1], lo[2], lo[3]);
    }
    __builtin_amdgcn_s_waitcnt(0xc07f);
    __builtin_amdgcn_wave_barrier();
    {
        typedef int v8i __attribute__((ext_vector_type(8)));
        const unsigned char* Ub = P.ws + WS_U;
        const unsigned lofs = 64u * (unsigned)(lr >> 3) + 16u * (unsigned)g;
        const unsigned char* bsrc = (lr < 4) ? (((lr & 2) ? slo : shi) + 128 * (lr & 1) + 16 * g) : (const unsigned char*)szero;
        const int bstep = (lr < 4) ? 256 : 0, bhalf = (lr < 4) ? 64 : 16;
        v8i Bv[4];
#pragma unroll
        for (int st = 0; st < 4; ++st) {
            const uint4 b0 = *(const uint4*)(bsrc + bstep * st), b1 = *(const uint4*)(bsrc + bstep * st + bhalf);
            Bv[st] = (v8i){(int)b0.x, (int)b0.y, (int)b0.z, (int)b0.w, (int)b1.x, (int)b1.y, (int)b1.z, (int)b1.w};
        }
        __builtin_amdgcn_s_waitcnt(0xc07f);
        __builtin_amdgcn_wave_barrier();
        float* sact = (float*)sidx + 128 * (lr & 3) + 4 * (g & 1);
        const bool owner = (lr < 4) && ((g >> 1) == (lr & 1));
        uint4 abuf[2][2][4];
        unsigned off2[2];
#pragma unroll
        for (int hh = 0; hh < 2; ++hh) off2[hh] = (unsigned)sid[8 * hh + (lr & 7)] * 512u + lofs;
#pragma unroll
        for (int hh = 0; hh < 2; ++hh)
#pragma unroll
            for (int st = 0; st < 4; ++st) abuf[0][hh][st] = *(const uint4*)(Ub + (off2[hh] + 128 * st));
#pragma unroll
        for (int T = 0; T < 8; ++T) {
            if (T + 1 < 8) {
#pragma unroll
                for (int hh = 0; hh < 2; ++hh) off2[hh] = (unsigned)sid[16 * (T + 1) + 8 * hh + (lr & 7)] * 512u + lofs;
#pragma unroll
                for (int hh = 0; hh < 2; ++hh)
#pragma unroll
                    for (int st = 0; st < 4; ++st) abuf[(T + 1) & 1][hh][st] = *(const uint4*)(Ub + (off2[hh] + 128 * st));
            }
#pragma unroll
            for (int hh = 0; hh < 2; ++hh) {
                f32x4 au = (f32x4){0.f, 0.f, 0.f, 0.f};
#pragma unroll
                for (int st = 0; st < 4; ++st) {
                    const uint4 a4 = abuf[T & 1][hh][st];
                    const v8i Av = {(int)a4.x, (int)a4.y, (int)a4.z, (int)a4.w, 0, 0, 0, 0};
                    au = __builtin_amdgcn_mfma_scale_f32_16x16x128_f8f6f4(Av, Bv[st], au, 4, 0, 0, 0x7f7f7f7f, 0, 0x7f7f7f7f);
                }
                if (owner) *(f32x4*)(sact + 16 * T + 8 * hh) = au;
            }
        }
    }
    __builtin_amdgcn_s_waitcnt(0xc07f);
    __builtin_amdgcn_wave_barrier();
    {
        float* sw = (float*)sidx;
        float wv[2];
#pragma unroll
        for (int hh = 0; hh < 2; ++hh) {
            const int e = lane + 64 * hh, id = sid[e];
            const float a = ((sw[e] + sw[128 + e]) + (sw[256 + e] + sw[384 + e])) * usc[id] * rstd;
            wv[hh] = sgate[e] * vsc[id] * 0.5f * a * (1.f + erff(a * 0.70710678118654752f));
        }
        __builtin_amdgcn_s_waitcnt(0xc07f);
        __builtin_amdgcn_wave_barrier();
        sw[lane] = wv[0]; sw[lane + 64] = wv[1];
    }
    __builtin_amdgcn_s_waitcnt(0xc07f);
    __builtin_amdgcn_wave_barrier();
    const int half = lane >> 5, l5 = lane & 31;
    const int lane_o = 2 * l5 + half;
    f32x2 acc2[16];
#pragma unroll
    for (int j = 0; j < 16; ++j) acc2[j] = (f32x2){0.f, 0.f};
    const unsigned char* Vb = P.ws + WS_V;
    const unsigned vlo = (unsigned)l5 * 16u;
#pragma unroll 1
    for (int e0 = 0; e0 < 128; e0 += 16) {
        uint4 vr[8];
#pragma unroll
        for (int q = 0; q < 8; ++q) vr[q] = *(const uint4*)(Vb + ((unsigned)sid[e0 + 2 * q + half] * 512u + vlo));
        const float* sw = (const float*)sidx + e0;
        const f32x4 w0 = *(const f32x4*)(sw), w1 = *(const f32x4*)(sw + 4), w2 = *(const f32x4*)(sw + 8), w3 = *(const f32x4*)(sw + 12);
        const float wq[16] = {w0[0], w0[1], w0[2], w0[3], w1[0], w1[1], w1[2], w1[3], w2[0], w2[1], w2[2], w2[3], w3[0], w3[1], w3[2], w3[3]};
#pragma unroll
        for (int q = 0; q < 8; ++q) {
            const float w = half ? wq[2 * q + 1] : wq[2 * q];
#define FP4_AXPY(k) { acc2[k] += w * __builtin_amdgcn_cvt_scalef32_pk_f32_fp4(vr[q].x, 1.0f, k); acc2[4 + k] += w * __builtin_amdgcn_cvt_scalef32_pk_f32_fp4(vr[q].y, 1.0f, k); \
                      acc2[8 + k] += w * __builtin_amdgcn_cvt_scalef32_pk_f32_fp4(vr[q].z, 1.0f, k); acc2[12 + k] += w * __builtin_amdgcn_cvt_scalef32_pk_f32_fp4(vr[q].w, 1.0f, k); }
            FP4_AXPY(0) FP4_AXPY(1) FP4_AXPY(2) FP4_AXPY(3)
#undef FP4_AXPY
        }
    }
    f32x2 acc[8];
#pragma unroll
    for (int j = 0; j < 16; ++j) {
        const unsigned x0 = __float_as_uint(acc2[j].x), x1 = __float_as_uint(acc2[j].y);
        const auto r0 = __builtin_amdgcn_permlane32_swap(x0, x0, false, false);
        const auto r1 = __builtin_amdgcn_permlane32_swap(x1, x1, false, false);
        acc2[j].x = __uint_as_float(r0[0]) + __uint_as_float(r0[1]);
        acc2[j].y = __uint_as_float(r1[0]) + __uint_as_float(r1[1]);
    }
#pragma unroll
    for (int j = 0; j < 8; ++j) { acc[j].x = half ? acc2[8 + j].x : acc2[j].x; acc[j].y = half ? acc2[8 + j].y : acc2[j].y; }
    f32x2 xf[8];
    {
        const uint4 xa = *(const uint4*)(xn + lane_o * 16), xb = *(const uint4*)(xn + lane_o * 16 + 8);
        xf[0] = (f32x2){bflo(xa.x), bfhi(xa.x)}; xf[1] = (f32x2){bflo(xa.y), bfhi(xa.y)}; xf[2] = (f32x2){bflo(xa.z), bfhi(xa.z)}; xf[3] = (f32x2){bflo(xa.w), bfhi(xa.w)};
        xf[4] = (f32x2){bflo(xb.x), bfhi(xb.x)}; xf[5] = (f32x2){bflo(xb.y), bfhi(xb.y)}; xf[6] = (f32x2){bflo(xb.z), bfhi(xb.z)}; xf[7] = (f32x2){bflo(xb.w), bfhi(xb.w)};
    }
    float* o = P.out + (size_t)t * DM + lane_o * 16;
    float4 h0, h1, h2, h3;
    {
        const float4 g0 = *(const float4*)(P.norm_ffn + lane_o * 16), g1 = *(const float4*)(P.norm_ffn + lane_o * 16 + 4), g2 = *(const float4*)(P.norm_ffn + lane_o * 16 + 8), g3 = *(const float4*)(P.norm_ffn + lane_o * 16 + 12);
        h0.x = xf[0].x * __builtin_amdgcn_rcpf(g0.x) + acc[0].x; h0.y = xf[0].y * __builtin_amdgcn_rcpf(g0.y) + acc[0].y; h0.z = xf[1].x * __builtin_amdgcn_rcpf(g0.z) + acc[1].x; h0.w = xf[1].y * __builtin_amdgcn_rcpf(g0.w) + acc[1].y;
        h1.x = xf[2].x * __builtin_amdgcn_rcpf(g1.x) + acc[2].x; h1.y = xf[2].y * __builtin_amdgcn_rcpf(g1.y) + acc[2].y; h1.z = xf[3].x * __builtin_amdgcn_rcpf(g1.z) + acc[3].x; h1.w = xf[3].y * __builtin_amdgcn_rcpf(g1.w) + acc[3].y;
        h2.x = xf[4].x * __builtin_amdgcn_rcpf(g2.x) + acc[4].x; h2.y = xf[4].y * __builtin_amdgcn_rcpf(g2.y) + acc[4].y; h2.z = xf[5].x * __builtin_amdgcn_rcpf(g2.z) + acc[5].x; h2.w = xf[5].y * __builtin_amdgcn_rcpf(g2.w) + acc[5].y;
        h3.x = xf[6].x * __builtin_amdgcn_rcpf(g3.x) + acc[6].x; h3.y = xf[6].y * __builtin_amdgcn_rcpf(g3.y) + acc[6].y; h3.z = xf[7].x * __builtin_amdgcn_rcpf(g3.z) + acc[7].x; h3.w = xf[7].y * __builtin_amdgcn_rcpf(g3.w) + acc[7].y;
    }
    *(float4*)(o) = h0; *(float4*)(o + 4) = h1; *(float4*)(o + 8) = h2; *(float4*)(o + 12) = h3;
    __builtin_amdgcn_s_waitcnt(0xc07f);
    __builtin_amdgcn_wave_barrier();
}

#define LAS __attribute__((address_space(3)))
#define XB_TMO      128
#define XB_XCNT(j)  (256  + 64 * (j))
#define XB_XSUB(j)  (1280 + 64 * (j))
#define XB_XGEN(j)  (2304 + 64 * (j))
#define XB_TOP      3328
#define XB_TOPGEN   3392
#define XCD_BAR_WORDS 3456
#define XB_SPIN_CAP (1u << 18)
__device__ __forceinline__ unsigned xb_ld(unsigned* p)              { return __hip_atomic_load(p, __ATOMIC_RELAXED, __HIP_MEMORY_SCOPE_AGENT); }
__device__ __forceinline__ unsigned xb_add(unsigned* p, unsigned v) { return __hip_atomic_fetch_add(p, v, __ATOMIC_RELAXED, __HIP_MEMORY_SCOPE_AGENT); }
__device__ __forceinline__ unsigned xb_xcc_id() { return (unsigned)__builtin_amdgcn_s_getreg((3 << 11) | 20) & 0xFu; }
#define XB_SPIN(cond, bar) do { unsigned _sp = 0; while (cond) { __builtin_amdgcn_s_sleep(1); \
    if ((++_sp & 255u) == 0u) { if (xb_ld(&(bar)[XB_TMO])) break; if (_sp > XB_SPIN_CAP) { atomicAdd(&(bar)[XB_TMO], 1u); break; } } } } while (0)
struct XcdBarrier { unsigned* bar; unsigned x; volatile LAS unsigned* st; };
__device__ __forceinline__ XcdBarrier xcd_barrier_post(unsigned* bar, volatile LAS unsigned* st) {
    XcdBarrier b; b.bar = bar; b.x = xb_xcc_id(); b.st = st;
    if (threadIdx.x == 0) (void)xb_add(&bar[XB_XCNT(b.x)], 1u);
    return b;
}
__device__ __forceinline__ void xcd_barrier_complete(unsigned* bar, unsigned x, unsigned& nloc, unsigned& nx, unsigned& xmask) {
    const unsigned G = gridDim.x * gridDim.y * gridDim.z;
    unsigned sum, cnt, mine, msk, sp = 0u;
    for (;;) {
        sum = 0u; cnt = 0u; mine = 0u; msk = 0u;
#pragma unroll
        for (unsigned j = 0; j < 16; ++j) { const unsigned c = xb_ld(&bar[XB_XCNT(j)]); sum += c; cnt += (c > 0u) ? 1u : 0u; msk |= (c > 0u) ? (1u << j) : 0u; mine = (j == x) ? c : mine; }
        if (sum == G) break;
        __builtin_amdgcn_s_sleep(1);
        if ((++sp & 255u) == 0u) { if (xb_ld(&bar[XB_TMO])) break; if (sp > XB_SPIN_CAP) { atomicAdd(&bar[XB_TMO], 1u); break; } }
    }
    nloc = mine > 0u ? mine : 1u; nx = cnt > 0u ? cnt : 1u; xmask = msk;
}
__device__ __forceinline__ void xcd_barrier(const XcdBarrier& b) {
    asm volatile("s_waitcnt vmcnt(0)" ::: "memory");
    __syncthreads();
    if (threadIdx.x == 0) {
        unsigned* bar = b.bar;
        __builtin_amdgcn_s_waitcnt(0);
        unsigned nloc = b.st[0], nx = b.st[1], xmask = b.st[9];
        if (nloc == 0u) { xcd_barrier_complete(bar, b.x, nloc, nx, xmask); b.st[0] = nloc; b.st[1] = nx; b.st[9] = xmask; }
        const unsigned old = xb_add(&bar[XB_XSUB(b.x)], 1u);
        const unsigned gen = old / nloc;
        if (old + 1u == (gen + 1u) * nloc) {
            __builtin_amdgcn_fence(__ATOMIC_RELEASE, "agent");
            asm volatile("s_waitcnt vmcnt(0)" ::: "memory");
            const unsigned og = xb_add(&bar[XB_TOP], 1u);
            const unsigned tg = og / nx;
            if (og + 1u == (tg + 1u) * nx) {
#pragma unroll
                for (unsigned j = 0; j < 16; ++j) if (xmask & (1u << j)) (void)xb_add(&bar[XB_XGEN(j)], 1u);
            }
        }
        XB_SPIN(xb_ld(&bar[XB_XGEN(b.x)]) == gen, bar);
        __builtin_amdgcn_fence(__ATOMIC_ACQUIRE, "agent");
        asm volatile("s_waitcnt vmcnt(0)" ::: "memory");
    }
    __syncthreads();
}

__device__ __forceinline__ void hand_release() { asm volatile("s_waitcnt vmcnt(0)" ::: "memory"); __builtin_amdgcn_fence(__ATOMIC_RELEASE, "agent"); asm volatile("s_waitcnt vmcnt(0)" ::: "memory"); }
__device__ __forceinline__ void hand_acquire() { __builtin_amdgcn_fence(__ATOMIC_ACQUIRE, "agent"); asm volatile("s_waitcnt vmcnt(0)" ::: "memory"); }

__global__ void __launch_bounds__(256, 2) mega(Params P) {
    extern __shared__ __attribute__((aligned(16))) unsigned char smem[];
    const int tid = threadIdx.x, lane = tid & 63, wave = tid >> 6;
    const int G = gridDim.x, bid = blockIdx.x;
    unsigned* ctl = (unsigned*)(P.ws + WS_CTL);
    volatile LAS unsigned* bst = (volatile LAS unsigned*)(smem + 65552);
    if (tid == 0) { bst[0] = 0u; bst[1] = 0u; }
    __syncthreads();
    const XcdBarrier xb = xcd_barrier_post(ctl + 1024, bst);
    unsigned* cucnt = ctl + 5120;
    if (tid == 0) {
        const unsigned phys = ((xb_xcc_id() & 7u) << 8) | ((unsigned)__builtin_amdgcn_s_getreg((7 << 11) | (8 << 6) | 4) & 0xFFu);
        bst[2] = phys; bst[3] = xb_add(&cucnt[phys], 1u);
    }
    phase0(P, smem);
    xcd_barrier(xb);
    {
        int vb;
        const unsigned phys = bst[2];
        unsigned part = 0;
#pragma unroll
        for (int q = 0; q < 8; ++q) { const unsigned i = (unsigned)(tid + 256 * q); const unsigned c = xb_ld(&cucnt[i]); part += (i < phys) ? c : 0u; }
#pragma unroll
        for (int o = 1; o < 64; o <<= 1) part += (unsigned)__shfl_xor((int)part, o, 64);
        if (lane == 0) bst[4 + wave] = part;
        __syncthreads();
        vb = (int)(bst[4] + bst[5] + bst[6] + bst[7] + bst[3]);
        vb = __builtin_amdgcn_readfirstlane(vb);
        if (vb < 0 || vb >= G) vb = bid;
        __syncthreads();
        if (tid == 0) bst[8] = (unsigned)vb;
        __syncthreads();
    }
#define VB_LOAD() __builtin_amdgcn_readfirstlane((int)bst[8])
    {
        const int gw = bid * 4 + wave;
        if (gw < 64) fox_cum_wave(P, gw, lane);
        const int vb = VB_LOAD();
        for (int tile = vb; tile < 129 * 28; tile += G) gemm_tile<1>(P, tile / 28, tile % 28, smem);
        {
            const int rem = (129 * 28) % G;
            if (rem > 0 && rem < G) { if (vb >= rem) convert_uv_rows(P, (vb - rem) * 4 + wave, (G - rem) * 4, lane); }
            else convert_uv_rows(P, vb * 4 + wave, G * 4, lane);
        }
    }
    xcd_barrier(xb);
    {
        volatile int* s_item = (volatile int*)(smem + 65536);
        const int wave_u = __builtin_amdgcn_readfirstlane(wave);
        auto fetch = [&](unsigned* counter) -> int {
            if (wave_u == 0) {
                unsigned v = atomicAdd(counter, lane == 0 ? 1u : 0u);
                *s_item = (int)__builtin_amdgcn_readfirstlane(v);
            }
            __syncthreads();
            const int item = __builtin_amdgcn_readfirstlane(*s_item);
            __syncthreads();
            return item;
        };
#define RUN_QUEUE(COUNTER, NITEMS, BODY) { \
            int item = bid; \
            while (item < (NITEMS)) { \
                unsigned nxt_ = 0u; \
                if (wave_u == 0) nxt_ = atomicAdd((COUNTER), lane == 0 ? 1u : 0u); \
                BODY; \
                if (wave_u == 0) *s_item = (int)__builtin_amdgcn_readfirstlane(nxt_) + G; \
                __syncthreads(); \
                item = __builtin_amdgcn_readfirstlane(*s_item); \
                __syncthreads(); \
            } }
        RUN_QUEUE(&ctl[2], 33 * 32, mlstm_A(P, item, smem))
        xcd_barrier(xb);
        RUN_QUEUE(&ctl[4], 96, mlstm_B(P, item))
        RUN_QUEUE(&ctl[3], 64 * 17, attn_block(P, item & 63, 16 - (item >> 6), smem))
        xcd_barrier(xb);
        RUN_QUEUE(&ctl[5], 33 * 32, mlstm_C(P, item, smem))
#undef RUN_QUEUE
    }
    xcd_barrier(xb);
    for (int tile = VB_LOAD(); tile < 128 * 8; tile += G) gemm_tile<2>(P, tile >> 3, tile & 7, smem);
    xcd_barrier(xb);
    for (int tile = VB_LOAD(); tile < 128 * 16; tile += G) gemm_tile<3>(P, tile >> 4, tile & 15, smem);
    xcd_barrier(xb);
    {
        unsigned char* slut = smem + 12288;
        if (tid < 64) {
            int c = tid, i = 0;
            while (i < 16 && c >= 16 / (i + 1)) { c -= 16 / (i + 1); ++i; }
            slut[tid] = (unsigned char)(i < 16 ? ((i << 4) | c) : 0);
        }
        unsigned* szero = (unsigned*)(smem + 12288 + 64);
        if (tid < 16) szero[tid] = 0u;
        __syncthreads();
        int* sidx = (int*)(smem + wave * 3072); float* sval = (float*)(smem + wave * 3072 + 1024);
        int* sid = (int*)(smem + wave * 3072 + 2048); float* sgate = (float*)(smem + wave * 3072 + 2560);
        int lane5 = lane;
        asm volatile("" : "+v"(lane5));
        {
            int t = bid * 4 + wave;
            uint4 tkw = *(const uint4*)((const unsigned*)(P.ws + WS_TK) + (size_t)(t < T2 ? t : 0) * 256 + lane5 * 4);
            for (; t < T2; t += G * 4) { const int tn = t + G * 4; peer_token(P, t, tn < T2 ? tn : t, tkw, lane5, sidx, sval, sid, sgate, slut, szero); }
        }
    }
}

}

extern "C" void kernel_launch(void* const* d_in, const int* in_sizes, int n_in, void* d_out, int out_size, void* d_ws, size_t ws_size, hipStream_t stream) {
    if (n_in != 17 || ws_size < WS_END) { fprintf(stderr, "kernel_launch: unexpected n_in %d or ws_size %zu (need %zu)\n", n_in, ws_size, (size_t)WS_END); return; }
    constexpr int LDS_BYTES = 66560;
    static int grid_blocks = 0;
    if (!grid_blocks) {
        int dev = 0, cus = 0, per_cu = 0;
        (void)hipGetDevice(&dev);
        (void)hipDeviceGetAttribute(&cus, hipDeviceAttributeMultiprocessorCount, dev);
        (void)hipFuncSetAttribute((const void*)mega, hipFuncAttributeMaxDynamicSharedMemorySize, LDS_BYTES);
        (void)hipOccupancyMaxActiveBlocksPerMultiprocessor(&per_cu, (const void*)mega, 256, LDS_BYTES);
        if (per_cu < 1) per_cu = 1;
        if (per_cu > 2) per_cu = 2;
        grid_blocks = cus * per_cu;
        fprintf(stderr, "kernel_launch: cus %d per_cu %d grid %d\n", cus, per_cu, grid_blocks);
    }
    Params P{};
    P.x = (const float*)d_in[0]; P.meta = (const float*)d_in[1]; P.norm_mix = (const float*)d_in[2]; P.w_in = (const float*)d_in[3];
    P.conv_qk = (const float*)d_in[4]; P.b_igate = (const float*)d_in[5]; P.b_fgate_m = (const float*)d_in[6]; P.m_out_norm = (const float*)d_in[7];
    P.b_fgate_f = (const float*)d_in[8]; P.f_q_norm = (const float*)d_in[9]; P.f_k_norm = (const float*)d_in[10]; P.w_out = (const float*)d_in[11];
    P.norm_ffn = (const float*)d_in[12]; P.peer_query = (const float*)d_in[13]; P.peer_keys = (const float*)d_in[14]; P.peer_u = (const float*)d_in[15];
    P.peer_v = (const float*)d_in[16]; P.out = (float*)d_out; P.ws = (unsigned char*)d_ws;
    (void)hipMemsetAsync((unsigned char*)d_ws + WS_CTL, 0, 32768, stream);
    void* args[] = {&P};
    hipError_t e = hipLaunchCooperativeKernel((const void*)mega, dim3(grid_blocks), dim3(256), args, LDS_BYTES, stream);
    if (e != hipSuccess) fprintf(stderr, "cooperative launch failed: %s (grid %d)\n", hipGetErrorString(e), grid_blocks);
}
```

```cpp
#include <hip/hip_runtime.h>
#include <stdint.h>
#include <stdio.h>
#include <hip/hip_cooperative_groups.h>
namespace cg = cooperative_groups;

namespace {

constexpr int NB = 8, SEQ = 2048, DM = 1024, NMETA = 16, L = SEQ + NMETA;
constexpr int T1 = NB * L;
constexpr int T2 = NB * SEQ;
constexpr int NZ = 3584;
constexpr int ZC_MQ = 0, ZC_MK = 512, ZC_MV = 1024, ZC_MO = 1536, ZC_FQ = 2048, ZC_FK = 2560, ZC_FV = 3072;
constexpr int PROJ = 3600;
constexpr float EPS = 1e-6f;

constexpr size_t WS_CTL = 0;
constexpr size_t WS_RA = 65536;
constexpr size_t WS_Z = WS_RA + (size_t)T1 * DM * 2;
constexpr size_t WS_GATES = WS_Z + (size_t)T1 * NZ * 2;
constexpr size_t WS_CUM = WS_GATES + (size_t)T1 * 16 * 4;
constexpr size_t WS_SSQ = WS_CUM + (size_t)NB * 8 * L * 4;
constexpr size_t WS_RSTD = WS_SSQ + (size_t)T2 * 16 * 4;
constexpr size_t WS_SSQM = WS_RSTD + (size_t)T2 * 4;
constexpr size_t WS_BT2 = WS_SSQM + (size_t)T1 * 16 * 4;
constexpr size_t WS_BT3 = WS_BT2 + (size_t)DM * DM * 2;
constexpr size_t WS_KEYS = WS_BT3 + (size_t)2048 * DM * 2;
constexpr size_t WS_MSC = WS_KEYS + (size_t)16 * 128 * 128 * 2;
constexpr size_t WS_MST = WS_MSC + (size_t)128 * 33 * 16;
constexpr size_t WS_BT1 = WS_MST + (size_t)32 * 33 * 36864;
constexpr size_t WS_CBI = WS_BT1;
constexpr size_t WS_UV = WS_CBI + (size_t)32 * 33 * 36864;
constexpr size_t WS_END = WS_UV + (size_t)2 * 16384 * 512 + (size_t)2 * 16384 * 4;
constexpr size_t WS_XN = WS_RA;
constexpr size_t WS_U = WS_UV;
constexpr size_t WS_V = WS_U + (size_t)16384 * 512;
constexpr size_t WS_USC = WS_V + (size_t)16384 * 512;
constexpr size_t WS_VSC = WS_USC + (size_t)16384 * 4;
constexpr size_t WS_TK = WS_CBI;
constexpr float LOG2E = 1.4426950408889634f;

typedef unsigned short bf16_t;
typedef short bf16x8 __attribute__((ext_vector_type(8)));
typedef float f32x4 __attribute__((ext_vector_type(4)));
typedef __attribute__((ext_vector_type(2))) __bf16 bf16x2_t;

struct Params {
    const float* x; const float* meta; const float* norm_mix; const float* w_in; const float* conv_qk;
    const float* b_igate; const float* b_fgate_m; const float* m_out_norm; const float* b_fgate_f;
    const float* f_q_norm; const float* f_k_norm; const float* w_out; const float* norm_ffn;
    const float* peer_query; const float* peer_keys; const float* peer_u; const float* peer_v;
    float* out; unsigned char* ws;
};

__device__ __forceinline__ unsigned f2bf(float f) { unsigned u = __float_as_uint(f); return (u + 0x7fffu + ((u >> 16) & 1u)) >> 16; }
__device__ __forceinline__ float bf2f(unsigned h) { return __uint_as_float(h << 16); }
typedef float f32x2 __attribute__((ext_vector_type(2)));
typedef __bf16 bf16x2v __attribute__((ext_vector_type(2)));
__device__ __forceinline__ unsigned cvt_pk_bf16(float lo, float hi) { f32x2 v = {lo, hi}; bf16x2v b = __builtin_convertvector(v, bf16x2v); return __builtin_bit_cast(unsigned, b); }
__device__ __forceinline__ unsigned pk2(float lo, float hi) { return cvt_pk_bf16(lo, hi); }
__device__ __forceinline__ float bflo(unsigned w) { return __uint_as_float(w << 16); }
__device__ __forceinline__ float bfhi(unsigned w) { return __uint_as_float(w & 0xffff0000u); }
__device__ __forceinline__ float wave_sum(float v) {
#pragma unroll
    for (int o = 32; o > 0; o >>= 1) v += __shfl_xor(v, o, 64);
    return v;
}
__device__ __forceinline__ float wave_max(float v) {
#pragma unroll
    for (int o = 32; o > 0; o >>= 1) v = fmaxf(v, __shfl_xor(v, o, 64));
    return v;
}
__device__ __forceinline__ float logsigmoidf(float x) { return fminf(x, 0.f) - log1pf(expf(-fabsf(x))); }
__device__ __forceinline__ unsigned ord_key(float f) { unsigned u = __float_as_uint(f); return u ^ ((u >> 31) ? 0xffffffffu : 0x80000000u); }
__device__ __forceinline__ float unord_key(unsigned k) { unsigned u = (k & 0x80000000u) ? (k ^ 0x80000000u) : ~k; return __uint_as_float(u); }

__device__ __forceinline__ void prod_job(const Params& P, int hp, int kt8, unsigned char* smem);
__device__ __forceinline__ void phase0(const Params& P, unsigned char* smem) {
    const int tid = threadIdx.x, lane = tid & 63, wave = tid >> 6;
    unsigned* ctl = (unsigned*)(P.ws + WS_CTL);
    float* gw = (float*)smem;
    for (int idx = tid; idx < 16 * 1024; idx += 256) {
        const int k = idx >> 4, c = idx & 15;
        const int col = c < 8 ? 2048 + c : 3592 + (c - 8);
        gw[c * 1024 + k] = P.w_in[(size_t)k * PROJ + col];
    }
    __syncthreads();
    {
        bf16_t* hn = (bf16_t*)(P.ws + WS_RA);
        float* gates = (float*)(P.ws + WS_GATES);
        const int c0 = lane * 8, c1 = 512 + lane * 8;
        float gm[16];
        {
            const float4 a0 = *(const float4*)(P.norm_mix + c0), a1 = *(const float4*)(P.norm_mix + c0 + 4);
            const float4 a2 = *(const float4*)(P.norm_mix + c1), a3 = *(const float4*)(P.norm_mix + c1 + 4);
            gm[0] = a0.x; gm[1] = a0.y; gm[2] = a0.z; gm[3] = a0.w; gm[4] = a1.x; gm[5] = a1.y; gm[6] = a1.z; gm[7] = a1.w;
            gm[8] = a2.x; gm[9] = a2.y; gm[10] = a2.z; gm[11] = a2.w; gm[12] = a3.x; gm[13] = a3.y; gm[14] = a3.z; gm[15] = a3.w;
        }
        const int myq = ((lane >> 5) & 1) * 8 + ((lane >> 4) & 1) * 4 + ((lane >> 3) & 1) * 2 + ((lane >> 2) & 1);
        const float mybias = myq < 4 ? P.b_igate[myq] : (myq < 8 ? P.b_fgate_m[myq - 4] : P.b_fgate_f[myq - 8]);
        const int rstep = gridDim.x * 4;
        int r = blockIdx.x * 4 + wave;
        float4 n0, n1, n2, n3;
        auto load_row = [&](int rr) {
            const int b = rr / L, p = rr - b * L;
            const float* src = (p < NMETA) ? (P.meta + (size_t)p * DM) : (P.x + ((size_t)b * SEQ + (p - NMETA)) * DM);
            n0 = *(const float4*)(src + c0); n1 = *(const float4*)(src + c0 + 4); n2 = *(const float4*)(src + c1); n3 = *(const float4*)(src + c1 + 4);
        };
        if (r < T1) load_row(r);
        for (; r < T1; r += rstep) {
            float v[16];
            v[0] = n0.x; v[1] = n0.y; v[2] = n0.z; v[3] = n0.w; v[4] = n1.x; v[5] = n1.y; v[6] = n1.z; v[7] = n1.w;
            v[8] = n2.x; v[9] = n2.y; v[10] = n2.z; v[11] = n2.w; v[12] = n3.x; v[13] = n3.y; v[14] = n3.z; v[15] = n3.w;
            if (r + rstep < T1) load_row(r + rstep);
            float ss = 0.f;
#pragma unroll
            for (int j = 0; j < 16; ++j) ss += v[j] * v[j];
            ss = wave_sum(ss);
            const float rstd = rsqrtf(ss * (1.0f / DM) + EPS);
#pragma unroll
            for (int j = 0; j < 16; ++j) v[j] *= rstd * gm[j];
            uint4 o0, o1;
            o0.x = pk2(v[0], v[1]); o0.y = pk2(v[2], v[3]); o0.z = pk2(v[4], v[5]); o0.w = pk2(v[6], v[7]);
            o1.x = pk2(v[8], v[9]); o1.y = pk2(v[10], v[11]); o1.z = pk2(v[12], v[13]); o1.w = pk2(v[14], v[15]);
            *(uint4*)(hn + (size_t)r * DM + c0) = o0;
            *(uint4*)(hn + (size_t)r * DM + c1) = o1;
            float r8[8], r4[4], r2[2], r1;
#pragma unroll
            for (int i = 0; i < 8; ++i) {
                float dd[2];
#pragma unroll
                for (int hh = 0; hh < 2; ++hh) {
                    const float* gwc = gw + (i + 8 * hh) * 1024;
                    const float4 w0 = *(const float4*)(gwc + c0), w1 = *(const float4*)(gwc + c0 + 4), w2 = *(const float4*)(gwc + c1), w3 = *(const float4*)(gwc + c1 + 4);
                    dd[hh] = v[0] * w0.x + v[1] * w0.y + v[2] * w0.z + v[3] * w0.w + v[4] * w1.x + v[5] * w1.y + v[6] * w1.z + v[7] * w1.w
                           + v[8] * w2.x + v[9] * w2.y + v[10] * w2.z + v[11] * w2.w + v[12] * w3.x + v[13] * w3.y + v[14] * w3.z + v[15] * w3.w;
                }
                const bool up = (lane & 32) != 0; const float keep = up ? dd[1] : dd[0], send = up ? dd[0] : dd[1];
                r8[i] = keep + __shfl_xor(send, 32, 64);
                if ((i & 3) == 3) __builtin_amdgcn_sched_barrier(0);
            }
#pragma unroll
            for (int i = 0; i < 4; ++i) { const bool up = (lane & 16) != 0; const float keep = up ? r8[i + 4] : r8[i], send = up ? r8[i] : r8[i + 4]; r4[i] = keep + __shfl_xor(send, 16, 64); }
#pragma unroll
            for (int i = 0; i < 2; ++i) { const bool up = (lane & 8) != 0; const float keep = up ? r4[i + 2] : r4[i], send = up ? r4[i] : r4[i + 2]; r2[i] = keep + __shfl_xor(send, 8, 64); }
            { const bool up = (lane & 4) != 0; const float keep = up ? r2[1] : r2[0], send = up ? r2[0] : r2[1]; r1 = keep + __shfl_xor(send, 4, 64); }
            r1 += __shfl_xor(r1, 2, 64); r1 += __shfl_xor(r1, 1, 64);
            if ((lane & 3) == 0) {
                const float pre = r1 + mybias;
                gates[(size_t)r * 16 + myq] = myq < 4 ? pre : logsigmoidf(pre);
            }
        }
    }
    __syncthreads();
    {
        float* tile = (float*)smem;
        for (int item = blockIdx.x; item < 1152; item += gridDim.x) {
            const float* W; int ldn, ntn, shift_from, it; bf16_t* out;
            if (item < 896) { W = P.w_in; ldn = PROJ; ntn = 56; shift_from = 2048; it = item; out = (bf16_t*)(P.ws + WS_BT1); }
            else { W = P.w_out; ldn = 1024; ntn = 16; shift_from = 1 << 30; it = item - 896; out = (bf16_t*)(P.ws + WS_BT2); }
            const int tk = it / ntn, tn = it - tk * ntn, k0 = tk * 64, n0 = tn * 64;
            {
                const int n4 = (tid & 15) * 4, kr = tid >> 4;
                int n = n0 + n4; if (n >= shift_from) n += 8;
                float4 v[4];
#pragma unroll
                for (int i = 0; i < 4; ++i) v[i] = *(const float4*)(W + (size_t)(k0 + kr + 16 * i) * ldn + n);
#pragma unroll
                for (int i = 0; i < 4; ++i) *(float4*)(tile + (kr + 16 * i) * 68 + n4) = v[i];
            }
            __syncthreads();
            {
#pragma unroll
                for (int i = 0; i < 2; ++i) {
                    const int id = tid + 256 * i, nl = id & 63, kc = id >> 6;
                    const float* tp = tile + (kc * 8) * 68 + nl;
                    uint4 o;
                    o.x = pk2(tp[0], tp[68]); o.y = pk2(tp[2 * 68], tp[3 * 68]); o.z = pk2(tp[4 * 68], tp[5 * 68]); o.w = pk2(tp[6 * 68], tp[7 * 68]);
                    *(uint4*)(out + (size_t)(n0 + nl) * 1024 + k0 + kc * 8) = o;
                }
            }
            __syncthreads();
        }
    }
    for (int job = (int)gridDim.x - 1 - (int)blockIdx.x; job < 128; job += gridDim.x) prod_job(P, job >> 3, job & 7, smem);
}

__device__ __forceinline__ void convert_uv_rows(const Params& P, int gwave, int nwaves, int lane, int row_begin, int row_end) {
    for (int rr0 = row_begin + gwave * 4; rr0 < row_end; rr0 += nwaves * 4) {
        float4 a[4][4];
#pragma unroll
        for (int q = 0; q < 4; ++q) {
            const int rr = rr0 + q, which = rr >> 14, row = rr & 16383;
            const float* src = (which ? P.peer_v : P.peer_u) + (size_t)row * DM + lane * 16;
            a[q][0] = *(const float4*)(src); a[q][1] = *(const float4*)(src + 4); a[q][2] = *(const float4*)(src + 8); a[q][3] = *(const float4*)(src + 12);
        }
#pragma unroll
        for (int q = 0; q < 4; ++q) {
            const int rr = rr0 + q, which = rr >> 14, row = rr & 16383;
            float mx = 0.f;
#pragma unroll
            for (int j = 0; j < 4; ++j) mx = fmaxf(mx, fmaxf(fmaxf(fabsf(a[q][j].x), fabsf(a[q][j].y)), fmaxf(fabsf(a[q][j].z), fabsf(a[q][j].w))));
            mx = wave_max(mx);
            const float sc = mx > 0.f ? 6.0f / mx : 1.0f;
            unsigned w0 = 0u, w1 = 0u;
            w0 = __builtin_amdgcn_cvt_scalef32_pk_fp4_f32(w0, a[q][0].x * sc, a[q][0].y * sc, 1.0f, 0); w0 = __builtin_amdgcn_cvt_scalef32_pk_fp4_f32(w0, a[q][0].z * sc, a[q][0].w * sc, 1.0f, 1);
            w0 = __builtin_amdgcn_cvt_scalef32_pk_fp4_f32(w0, a[q][1].x * sc, a[q][1].y * sc, 1.0f, 2); w0 = __builtin_amdgcn_cvt_scalef32_pk_fp4_f32(w0, a[q][1].z * sc, a[q][1].w * sc, 1.0f, 3);
            w1 = __builtin_amdgcn_cvt_scalef32_pk_fp4_f32(w1, a[q][2].x * sc, a[q][2].y * sc, 1.0f, 0); w1 = __builtin_amdgcn_cvt_scalef32_pk_fp4_f32(w1, a[q][2].z * sc, a[q][2].w * sc, 1.0f, 1);
            w1 = __builtin_amdgcn_cvt_scalef32_pk_fp4_f32(w1, a[q][3].x * sc, a[q][3].y * sc, 1.0f, 2); w1 = __builtin_amdgcn_cvt_scalef32_pk_fp4_f32(w1, a[q][3].z * sc, a[q][3].w * sc, 1.0f, 3);
            *(uint2*)(P.ws + (which ? WS_V : WS_U) + (size_t)row * 512 + lane * 8) = make_uint2(w0, w1);
            if (lane == 0) ((float*)(P.ws + (which ? WS_VSC : WS_USC)))[row] = mx > 0.f ? mx * (1.0f / 6.0f) : 1.0f;
        }
    }
}

__device__ __forceinline__ void bitonic_sort16_desc(unsigned (&v)[16]) {
#pragma unroll
    for (int k = 2; k <= 16; k <<= 1)
#pragma unroll
        for (int j = k >> 1; j >= 1; j >>= 1)
#pragma unroll
            for (int i = 0; i < 16; ++i)
                if ((i & j) == 0) {
                    const int p = i | j;
                    const bool desc = (k >= 16) ? true : ((i & k) == 0);
                    const unsigned hi = max(v[i], v[p]), lo = min(v[i], v[p]);
                    v[i] = desc ? hi : lo; v[p] = desc ? lo : hi;
                }
}
__device__ __forceinline__ void bitonic_merge16_top(unsigned (&a)[16], const unsigned (&b)[16]) {
#pragma unroll
    for (int i = 0; i < 16; ++i) a[i] = max(a[i], b[15 - i]);
#pragma unroll
    for (int j = 8; j >= 1; j >>= 1)
#pragma unroll
        for (int i = 0; i < 16; ++i)
            if ((i & j) == 0) { const int p = i | j; const unsigned hi = max(a[i], a[p]), lo = min(a[i], a[p]); a[i] = hi; a[p] = lo; }
}

__device__ __forceinline__ float x4_max(float x) {
    const unsigned xi = __float_as_uint(x);
    const auto r = __builtin_amdgcn_permlane32_swap(xi, xi, false, false);
    const float m = fmaxf(__uint_as_float(r[0]), __uint_as_float(r[1]));
    const unsigned mi = __float_as_uint(m);
    const auto r2 = __builtin_amdgcn_permlane16_swap(mi, mi, false, false);
    return fmaxf(__uint_as_float(r2[0]), __uint_as_float(r2[1]));
}
__device__ __forceinline__ float x4_sum(float x) {
    const unsigned xi = __float_as_uint(x);
    const auto r = __builtin_amdgcn_permlane32_swap(xi, xi, false, false);
    const float m = __uint_as_float(r[0]) + __uint_as_float(r[1]);
    const unsigned mi = __float_as_uint(m);
    const auto r2 = __builtin_amdgcn_permlane16_swap(mi, mi, false, false);
    return __uint_as_float(r2[0]) + __uint_as_float(r2[1]);
}

__device__ __forceinline__ int opaque_tid() { int t = threadIdx.x; asm volatile("" : "+v"(t)); return t; }

__device__ __forceinline__ void mma_ktile(const unsigned char* sA, const unsigned char* sB, int arow_off, int brow_off, int g, int sw, f32x4 (&acc)[4][4]) {
#pragma unroll
    for (int s = 0; s < 2; ++s) {
        bf16x8 a[4], b[4];
        const int ch = (((s * 4 + g) ^ sw) << 4);
#pragma unroll
        for (int i = 0; i < 4; ++i) a[i] = *(const bf16x8*)(sA + arow_off + i * 2048 + ch);
#pragma unroll
        for (int j = 0; j < 4; ++j) b[j] = *(const bf16x8*)(sB + brow_off + j * 2048 + ch);
#pragma unroll
        for (int i = 0; i < 4; ++i)
#pragma unroll
            for (int j = 0; j < 4; ++j) acc[i][j] = __builtin_amdgcn_mfma_f32_16x16x32_bf16(b[j], a[i], acc[i][j], 0, 0, 0);
    }
}

__device__ __forceinline__ void store_tile_bf16(const f32x4 (&acc)[4][4], unsigned char* smem, bf16_t* dst, size_t ld, int m0, int n0, int tid, int wr, int wc, int g, int lr) {
#pragma unroll
    for (int i = 0; i < 4; ++i)
#pragma unroll
        for (int j = 0; j < 4; ++j) {
            const int row = wr * 64 + 16 * i + lr, col = wc * 64 + 16 * j + 4 * g;
            uint2 w; w.x = pk2(acc[i][j][0], acc[i][j][1]); w.y = pk2(acc[i][j][2], acc[i][j][3]);
            *(uint2*)(smem + row * 272 + col * 2) = w;
        }
    __syncthreads();
#pragma unroll
    for (int q = 0; q < 8; ++q) {
        const int id = tid + 256 * q, row = id >> 4, ch = id & 15;
        const uint4 v = *(const uint4*)(smem + row * 272 + ch * 16);
        *(uint4*)(dst + (size_t)(m0 + row) * ld + n0 + ch * 8) = v;
    }
    __syncthreads();
}

__device__ __forceinline__ void prod_job(const Params& P, int hp, int kt8, unsigned char* smem) {
    const int tid = opaque_tid(), lane = tid & 63, wave = tid >> 6, wr = wave >> 1, wc = wave & 1, g = lane >> 4, lr = lane & 15;
    const int srow = tid >> 3, sc = tid & 7;
    unsigned char* sA0 = smem; unsigned char* sB0 = smem + 16384; unsigned char* sA1 = smem + 32768; unsigned char* sB1 = smem + 49152;
    const int soff0 = srow * 128 + ((sc ^ (srow & 7)) << 4);
    const float* Ak = P.peer_keys + (size_t)hp * 128 * 128 + (size_t)srow * 128 + sc * 8;
    const float* Bq = P.peer_query + (size_t)(kt8 * 128 + srow) * 2048 + hp * 128 + sc * 8;
#pragma unroll
    for (int j = 0; j < 4; ++j) {
#pragma unroll
        for (int hk = 0; hk < 2; ++hk) {
            const float4 a0 = *(const float4*)(Ak + (size_t)(32 * j) * 128 + 64 * hk), a1 = *(const float4*)(Ak + (size_t)(32 * j) * 128 + 64 * hk + 4);
            const float4 b0 = *(const float4*)(Bq + (size_t)(32 * j) * 2048 + 64 * hk), b1 = *(const float4*)(Bq + (size_t)(32 * j) * 2048 + 64 * hk + 4);
            uint4 ua, ub;
            ua.x = pk2(a0.x, a0.y); ua.y = pk2(a0.z, a0.w); ua.z = pk2(a1.x, a1.y); ua.w = pk2(a1.z, a1.w);
            ub.x = pk2(b0.x, b0.y); ub.y = pk2(b0.z, b0.w); ub.z = pk2(b1.x, b1.y); ub.w = pk2(b1.z, b1.w);
            *(uint4*)((hk ? sA1 : sA0) + soff0 + j * 4096) = ua;
            *(uint4*)((hk ? sB1 : sB0) + soff0 + j * 4096) = ub;
        }
    }
    __syncthreads();
    f32x4 acc[4][4];
#pragma unroll
    for (int i = 0; i < 4; ++i)
#pragma unroll
        for (int j = 0; j < 4; ++j) acc[i][j] = (f32x4){0.f, 0.f, 0.f, 0.f};
    const int arow_off = (wr * 64 + lr) * 128, brow_off = (wc * 64 + lr) * 128, sw = lr & 7;
    mma_ktile(sA0, sB0, arow_off, brow_off, g, sw, acc);
    mma_ktile(sA1, sB1, arow_off, brow_off, g, sw, acc);
    __syncthreads();
    store_tile_bf16(acc, smem, (bf16_t*)(P.ws + WS_BT3), 1024, hp * 128, kt8 * 128, tid, wr, wc, g, lr);
}

template <int MODE>
__device__ __forceinline__ void gemm_tile(const Params& P, int tm, int tn, unsigned char* smem) {
    const bf16_t* A; const bf16_t* Bt;
    if (MODE == 1) { A = (const bf16_t*)(P.ws + WS_RA); Bt = (const bf16_t*)(P.ws + WS_BT1); }
    else if (MODE == 2) { A = (const bf16_t*)(P.ws + WS_Z); Bt = (const bf16_t*)(P.ws + WS_BT2); }
    else { A = (const bf16_t*)(P.ws + WS_XN); Bt = (const bf16_t*)(P.ws + WS_BT3); }
    const int tid = opaque_tid(), lane = tid & 63, wave = tid >> 6, wr = wave >> 1, wc = wave & 1, g = lane >> 4, lr = lane & 15;
    const int m0 = tm * 128, n0 = tn * 128;
    const int srow = tid >> 3, sc = tid & 7;
    constexpr unsigned LDA = (MODE == 2 ? NZ : 1024) * 2u;
    unsigned aoff, boff; int soff0;
    {
        int ar = m0 + srow;
        if (MODE == 2) { const int b = ar >> 11, t = ar & 2047; ar = b * L + NMETA + t; }
        aoff = (unsigned)ar * LDA + (unsigned)sc * 16u;
        boff = (unsigned)(n0 + srow) * 2048u + (unsigned)sc * 16u;
        soff0 = srow * 128 + ((sc ^ (srow & 7)) << 4);
    }
    const unsigned char* Ab = (const unsigned char*)A; const unsigned char* Bb = (const unsigned char*)Bt;
    float4 ssp0, ssp1, ssp2, ssp3;
    if (MODE == 3) {
        const float* ssq = (const float*)(P.ws + WS_SSQ) + (size_t)(m0 + wr * 64 + lr) * 16 + 4 * g;
        ssp0 = *(const float4*)(ssq); ssp1 = *(const float4*)(ssq + 16 * 16); ssp2 = *(const float4*)(ssq + 32 * 16); ssp3 = *(const float4*)(ssq + 48 * 16);
    }
    f32x4 acc[4][4];
#pragma unroll
    for (int i = 0; i < 4; ++i)
#pragma unroll
        for (int j = 0; j < 4; ++j) acc[i][j] = (f32x4){0.f, 0.f, 0.f, 0.f};
    uint4 ra0, ra1, ra2, ra3, rb0, rb1, rb2, rb3;
#define G_LOAD(KT) { const unsigned ko = (unsigned)(KT) * 128u; \
        ra0 = *(const uint4*)(Ab + (aoff + ko)); ra1 = *(const uint4*)(Ab + (aoff + 32u * LDA + ko)); ra2 = *(const uint4*)(Ab + (aoff + 64u * LDA + ko)); ra3 = *(const uint4*)(Ab + (aoff + 96u * LDA + ko)); \
        rb0 = *(const uint4*)(Bb + (boff + ko)); rb1 = *(const uint4*)(Bb + (boff + 32u * 2048u + ko)); rb2 = *(const uint4*)(Bb + (boff + 64u * 2048u + ko)); rb3 = *(const uint4*)(Bb + (boff + 96u * 2048u + ko)); }
#define G_WRITE(SA, SB) { *(uint4*)((SA) + soff0) = ra0; *(uint4*)((SA) + soff0 + 4096) = ra1; *(uint4*)((SA) + soff0 + 8192) = ra2; *(uint4*)((SA) + soff0 + 12288) = ra3; \
        *(uint4*)((SB) + soff0) = rb0; *(uint4*)((SB) + soff0 + 4096) = rb1; *(uint4*)((SB) + soff0 + 8192) = rb2; *(uint4*)((SB) + soff0 + 12288) = rb3; }
    unsigned char* sA0 = smem; unsigned char* sB0 = smem + 16384; unsigned char* sA1 = smem + 32768; unsigned char* sB1 = smem + 49152;
    G_LOAD(0)
    G_WRITE(sA0, sB0)
    __syncthreads();
    const int arow_off = (wr * 64 + lr) * 128, brow_off = (wc * 64 + lr) * 128, sw = lr & 7;
    G_LOAD(1)
    for (int kt = 0; kt < 16; ++kt) {
        unsigned char* sA = (kt & 1) ? sA1 : sA0; unsigned char* sB = (kt & 1) ? sB1 : sB0;
        unsigned char* nA = (kt & 1) ? sA0 : sA1; unsigned char* nB = (kt & 1) ? sB0 : sB1;
        bf16x8 fa[4], fb[4], ga[4], gb[4];
        const int ch0 = ((g ^ sw) << 4), ch1 = (((4 + g) ^ sw) << 4);
        const unsigned ko = (unsigned)(kt + 2) * 128u;
        const unsigned koa = ko + ((MODE == 2 && kt + 2 >= 8) ? (unsigned)(ZC_FQ - 512) * 2u : 0u);
        const bool wr_ok = kt < 15, ld_ok = kt < 14;
#pragma unroll
        for (int i = 0; i < 4; ++i) { fa[i] = *(const bf16x8*)(sA + arow_off + i * 2048 + ch0); fb[i] = *(const bf16x8*)(sB + brow_off + i * 2048 + ch0); }
        __builtin_amdgcn_sched_barrier(0);
        __builtin_amdgcn_s_setprio(2);
        if (wr_ok) *(uint4*)(nA + soff0) = ra0;
        if (ld_ok) ra0 = *(const uint4*)(Ab + (aoff + 0u * LDA + koa));
        ga[0] = *(const bf16x8*)(sA + arow_off + 0 * 2048 + ch1); gb[0] = *(const bf16x8*)(sB + brow_off + 0 * 2048 + ch1);
        __builtin_amdgcn_sched_barrier(0);
#pragma unroll
        for (int j = 0; j < 4; ++j) acc[0][j] = __builtin_amdgcn_mfma_f32_16x16x32_bf16(fb[j], fa[0], acc[0][j], 0, 0, 0);
        __builtin_amdgcn_sched_barrier(0);
        if (wr_ok) *(uint4*)(nA + soff0 + 4096) = ra1;
        if (ld_ok) ra1 = *(const uint4*)(Ab + (aoff + 32u * LDA + koa));
        ga[1] = *(const bf16x8*)(sA + arow_off + 1 * 2048 + ch1); gb[1] = *(const bf16x8*)(sB + brow_off + 1 * 2048 + ch1);
        __builtin_amdgcn_sched_barrier(0);
#pragma unroll
        for (int j = 0; j < 4; ++j) acc[1][j] = __builtin_amdgcn_mfma_f32_16x16x32_bf16(fb[j], fa[1], acc[1][j], 0, 0, 0);
        __builtin_amdgcn_sched_barrier(0);
        if (wr_ok) *(uint4*)(nA + soff0 + 8192) = ra2;
        if (ld_ok) ra2 = *(const uint4*)(Ab + (aoff + 64u * LDA + koa));
        ga[2] = *(const bf16x8*)(sA + arow_off + 2 * 2048 + ch1); gb[2] = *(const bf16x8*)(sB + brow_off + 2 * 2048 + ch1);
        __builtin_amdgcn_sched_barrier(0);
#pragma unroll
        for (int j = 0; j < 4; ++j) acc[2][j] = __builtin_amdgcn_mfma_f32_16x16x32_bf16(fb[j], fa[2], acc[2][j], 0, 0, 0);
        __builtin_amdgcn_sched_barrier(0);
        if (wr_ok) *(uint4*)(nA + soff0 + 12288) = ra3;
        if (ld_ok) ra3 = *(const uint4*)(Ab + (aoff + 96u * LDA + koa));
        ga[3] = *(const bf16x8*)(sA + arow_off + 3 * 2048 + ch1); gb[3] = *(const bf16x8*)(sB + brow_off + 3 * 2048 + ch1);
        __builtin_amdgcn_sched_barrier(0);
#pragma unroll
        for (int j = 0; j < 4; ++j) acc[3][j] = __builtin_amdgcn_mfma_f32_16x16x32_bf16(fb[j], fa[3], acc[3][j], 0, 0, 0);
        __builtin_amdgcn_sched_barrier(0);
        if (wr_ok) *(uint4*)(nB + soff0) = rb0;
        if (ld_ok) rb0 = *(const uint4*)(Bb + (boff + 0u * 2048u + ko));
        __builtin_amdgcn_sched_barrier(0);
#pragma unroll
        for (int j = 0; j < 4; ++j) acc[0][j] = __builtin_amdgcn_mfma_f32_16x16x32_bf16(gb[j], ga[0], acc[0][j], 0, 0, 0);
        __builtin_amdgcn_sched_barrier(0);
        if (wr_ok) *(uint4*)(nB + soff0 + 4096) = rb1;
        if (ld_ok) rb1 = *(const uint4*)(Bb + (boff + 32u * 2048u + ko));
        __builtin_amdgcn_sched_barrier(0);
#pragma unroll
        for (int j = 0; j < 4; ++j) acc[1][j] = __builtin_amdgcn_mfma_f32_16x16x32_bf16(gb[j], ga[1], acc[1][j], 0, 0, 0);
        __builtin_amdgcn_sched_barrier(0);
        if (wr_ok) *(uint4*)(nB + soff0 + 8192) = rb2;
        if (ld_ok) rb2 = *(const uint4*)(Bb + (boff + 64u * 2048u + ko));
        __builtin_amdgcn_sched_barrier(0);
#pragma unroll
        for (int j = 0; j < 4; ++j) acc[2][j] = __builtin_amdgcn_mfma_f32_16x16x32_bf16(gb[j], ga[2], acc[2][j], 0, 0, 0);
        __builtin_amdgcn_sched_barrier(0);
        if (wr_ok) *(uint4*)(nB + soff0 + 12288) = rb3;
        if (ld_ok) rb3 = *(const uint4*)(Bb + (boff + 96u * 2048u + ko));
        __builtin_amdgcn_sched_barrier(0);
#pragma unroll
        for (int j = 0; j < 4; ++j) acc[3][j] = __builtin_amdgcn_mfma_f32_16x16x32_bf16(gb[j], ga[3], acc[3][j], 0, 0, 0);
        __builtin_amdgcn_s_setprio(0);
        __syncthreads();
    }
#undef G_LOAD
#undef G_WRITE
    if (MODE == 1) {
        if (n0 >= ZC_FQ && n0 < ZC_FV) {
            const bool isk = n0 >= ZC_FK;
            const float* gain = isk ? P.f_k_norm : P.f_q_norm;
            const float scl = isk ? 1.0f : 0.125f * LOG2E;
            float gn[4][4];
#pragma unroll
            for (int j = 0; j < 4; ++j)
#pragma unroll
                for (int r = 0; r < 4; ++r) gn[j][r] = gain[16 * j + 4 * g + r];
#pragma unroll
            for (int i = 0; i < 4; ++i) {
                float ss = 0.f;
#pragma unroll
                for (int j = 0; j < 4; ++j)
#pragma unroll
                    for (int r = 0; r < 4; ++r) ss += acc[i][j][r] * acc[i][j][r];
                ss = x4_sum(ss);
                const float rstd = rsqrtf(ss * (1.0f / 64.0f) + EPS) * scl;
#pragma unroll
                for (int j = 0; j < 4; ++j)
#pragma unroll
                    for (int r = 0; r < 4; ++r) acc[i][j][r] *= rstd * gn[j][r];
            }
        }
        store_tile_bf16(acc, smem, (bf16_t*)(P.ws + WS_Z), NZ, m0, n0, tid, wr, wc, g, lr);
    } else if (MODE == 2) {
        float* ssq = (float*)(P.ws + WS_SSQ);
#pragma unroll
        for (int i = 0; i < 4; ++i) {
            const int row = m0 + wr * 64 + 16 * i + lr;
            float ss = 0.f;
#pragma unroll
            for (int j = 0; j < 4; ++j) {
                const int col = n0 + wc * 64 + 16 * j + 4 * g;
                const float4 xv = *(const float4*)(P.x + (size_t)row * DM + col);
                const float4 gv = *(const float4*)(P.norm_ffn + col);
                float4 hv; hv.x = acc[i][j][0] + xv.x; hv.y = acc[i][j][1] + xv.y; hv.z = acc[i][j][2] + xv.z; hv.w = acc[i][j][3] + xv.w;
                ss += hv.x * hv.x + hv.y * hv.y + hv.z * hv.z + hv.w * hv.w;
                acc[i][j][0] = hv.x * gv.x; acc[i][j][1] = hv.y * gv.y; acc[i][j][2] = hv.z * gv.z; acc[i][j][3] = hv.w * gv.w;
            }
            ss = x4_sum(ss);
            if (g == 0) ssq[(size_t)row * 16 + tn * 2 + wc] = ss;
        }
        store_tile_bf16(acc, smem, (bf16_t*)(P.ws + WS_XN), 1024, m0, n0, tid, wr, wc, g, lr);
    } else {
        const int hp = tn;
        float rs[4];
#pragma unroll
        for (int i = 0; i < 4; ++i) {
            const int row = m0 + wr * 64 + 16 * i + lr;
            const float4 sp = i == 0 ? ssp0 : i == 1 ? ssp1 : i == 2 ? ssp2 : ssp3;
            const float s = x4_sum((sp.x + sp.y) + (sp.z + sp.w));
            rs[i] = rsqrtf(s * (1.0f / DM) + EPS);
            if (tn == 0 && wc == 0 && g == 0) ((float*)(P.ws + WS_RSTD))[row] = rs[i];
        }
#pragma unroll
        for (int i = 0; i < 4; ++i)
#pragma unroll
            for (int j = 0; j < 4; ++j) {
                const int row = wr * 64 + 16 * i + lr;
                const int c4 = wc * 16 + 4 * j + g;
                *(f32x4*)(smem + row * 512 + ((c4 ^ (row & 31)) << 4)) = acc[i][j] * rs[i];
            }
        __syncthreads();
        unsigned top[16];
        const int row = tid & 127, half = tid >> 7;
        {
            auto load_keys = [&](unsigned (&dst)[16], int q4) {
#pragma unroll
                for (int s4 = 0; s4 < 4; ++s4) {
                    const int c4 = half * 16 + q4 * 4 + s4;
                    const f32x4 v = *(const f32x4*)(smem + row * 512 + ((c4 ^ (row & 31)) << 4));
#pragma unroll
                    for (int e = 0; e < 4; ++e) dst[s4 * 4 + e] = (ord_key(v[e]) & ~127u) | (unsigned)(127 - (c4 * 4 + e));
                }
            };
            load_keys(top, 0);
            bitonic_sort16_desc(top);
#pragma unroll 1
            for (int q4 = 1; q4 < 4; ++q4) {
                unsigned gq[16];
                load_keys(gq, q4);
                bitonic_sort16_desc(gq);
                bitonic_merge16_top(top, gq);
            }
        }
        __syncthreads();
        if (half) {
            uint4* lp = (uint4*)(smem + row * 64);
            lp[0] = make_uint4(top[0], top[1], top[2], top[3]); lp[1] = make_uint4(top[4], top[5], top[6], top[7]);
            lp[2] = make_uint4(top[8], top[9], top[10], top[11]); lp[3] = make_uint4(top[12], top[13], top[14], top[15]);
        }
        __syncthreads();
        if (!half) {
            const uint4* lp = (const uint4*)(smem + row * 64);
            unsigned other[16];
#pragma unroll
            for (int c = 0; c < 4; ++c) { const uint4 o = lp[c]; other[4 * c] = o.x; other[4 * c + 1] = o.y; other[4 * c + 2] = o.z; other[4 * c + 3] = o.w; }
            bitonic_merge16_top(top, other);
            uint4* tk = (uint4*)((unsigned*)(P.ws + WS_TK) + ((size_t)(m0 + row) * 16 + hp) * 16);
            tk[0] = make_uint4(top[0], top[1], top[2], top[3]); tk[1] = make_uint4(top[4], top[5], top[6], top[7]);
            tk[2] = make_uint4(top[8], top[9], top[10], top[11]); tk[3] = make_uint4(top[12], top[13], top[14], top[15]);
        }
        __syncthreads();
    }
}

__device__ __forceinline__ void fox_cum_wave(const Params& P, int bh, int lane) {
    const int b = bh >> 3, h = bh & 7;
    const float* gates = (const float*)(P.ws + WS_GATES) + (size_t)b * L * 16 + 8 + h;
    float* cum = (float*)(P.ws + WS_CUM) + (size_t)bh * L;
    constexpr int SEG = 33;
    const int t0 = lane * SEG;
    float v[SEG];
#pragma unroll
    for (int i = 0; i < SEG; ++i) { const int t = t0 + i; const float x = gates[(size_t)(t < L ? t : L - 1) * 16]; v[i] = t < L ? x : 0.f; }
    float loc = 0.f;
#pragma unroll
    for (int i = 0; i < SEG; ++i) loc += v[i];
    float incl = loc;
#pragma unroll
    for (int o = 1; o < 64; o <<= 1) { const float n = __shfl_up(incl, o, 64); if (lane >= o) incl += n; }
    float run = incl - loc;
#pragma unroll
    for (int i = 0; i < SEG; ++i) { const int t = t0 + i; run += v[i]; if (t < L) cum[t] = run * LOG2E; }
}

#define TR_SLOW 0

__device__ __forceinline__ int vimg_off(int row, int ch) { return row * 128 + ((ch ^ (((row >> 1) & 3) << 1)) << 4); }
__device__ __forceinline__ uint2 tr_frag(const unsigned char* img, int row0, int c, int g, int lr) {
#if TR_SLOW
    unsigned short e[4];
#pragma unroll
    for (int k = 0; k < 4; ++k) { const int row = row0 + 4 * g + k, col = 16 * c + lr; e[k] = *(const unsigned short*)(img + vimg_off(row, col >> 3) + (col & 7) * 2); }
    uint2 r; r.x = (unsigned)e[0] | ((unsigned)e[1] << 16); r.y = (unsigned)e[2] | ((unsigned)e[3] << 16); return r;
#else
    const int q = lr >> 2, p = lr & 3, row = row0 + 4 * g + q;
    const unsigned addr = (unsigned)(size_t)(img + vimg_off(row, 2 * c + (p >> 1)) + 8 * (p & 1));
    uint2 r;
    asm volatile("ds_read_b64_tr_b16 %0, %1\n\ts_waitcnt lgkmcnt(0)" : "=&v"(r) : "v"(addr) : "memory");
    return r;
#endif
}

__device__ __forceinline__ unsigned tr_lane_addr(const unsigned char* img, int c, int g, int lr) {
    const int q = lr >> 2, p = lr & 3, row = 4 * g + q;
    return (unsigned)(size_t)(img + vimg_off(row, 2 * c + (p >> 1)) + 8 * (p & 1));
}
#define TR_GROUP(o0, o1, o2, o3, a) "ds_read_b64_tr_b16 %" #o0 ", %" #a "\n\tds_read_b64_tr_b16 %" #o1 ", %" #a " offset:2048\n\tds_read_b64_tr_b16 %" #o2 ", %" #a " offset:4096\n\tds_read_b64_tr_b16 %" #o3 ", %" #a " offset:6144\n\t"
__device__ __forceinline__ void tr_read_4c(const unsigned char* img, int g, int lr, uint2 (&r)[4][4]) {
    const unsigned a0 = tr_lane_addr(img, 0, g, lr), a1 = tr_lane_addr(img, 1, g, lr), a2 = tr_lane_addr(img, 2, g, lr), a3 = tr_lane_addr(img, 3, g, lr);
    asm volatile(TR_GROUP(0, 1, 2, 3, 16) TR_GROUP(4, 5, 6, 7, 17) TR_GROUP(8, 9, 10, 11, 18) TR_GROUP(12, 13, 14, 15, 19) "s_waitcnt lgkmcnt(0)"
        : "=&v"(r[0][0]), "=&v"(r[0][1]), "=&v"(r[0][2]), "=&v"(r[0][3]), "=&v"(r[1][0]), "=&v"(r[1][1]), "=&v"(r[1][2]), "=&v"(r[1][3]),
          "=&v"(r[2][0]), "=&v"(r[2][1]), "=&v"(r[2][2]), "=&v"(r[2][3]), "=&v"(r[3][0]), "=&v"(r[3][1]), "=&v"(r[3][2]), "=&v"(r[3][3])
        : "v"(a0), "v"(a1), "v"(a2), "v"(a3) : "memory");
}
__device__ __forceinline__ void tr_read_3c(const unsigned char* img, int g, int lr, uint2 (&r)[3][4]) {
    const unsigned a0 = tr_lane_addr(img, 0, g, lr), a1 = tr_lane_addr(img, 1, g, lr), a2 = tr_lane_addr(img, 2, g, lr);
    asm volatile(TR_GROUP(0, 1, 2, 3, 12) TR_GROUP(4, 5, 6, 7, 13) TR_GROUP(8, 9, 10, 11, 14) "s_waitcnt lgkmcnt(0)"
        : "=&v"(r[0][0]), "=&v"(r[0][1]), "=&v"(r[0][2]), "=&v"(r[0][3]), "=&v"(r[1][0]), "=&v"(r[1][1]), "=&v"(r[1][2]), "=&v"(r[1][3]),
          "=&v"(r[2][0]), "=&v"(r[2][1]), "=&v"(r[2][2]), "=&v"(r[2][3])
        : "v"(a0), "v"(a1), "v"(a2) : "memory");
}
__device__ __forceinline__ void tr_read_2(const unsigned char* img0, int c0, const unsigned char* img1, int c1, int g, int lr, uint2 (&r)[2][4]) {
    const unsigned a0 = tr_lane_addr(img0, c0, g, lr), a1 = tr_lane_addr(img1, c1, g, lr);
    asm volatile(TR_GROUP(0, 1, 2, 3, 8) TR_GROUP(4, 5, 6, 7, 9) "s_waitcnt lgkmcnt(0)"
        : "=&v"(r[0][0]), "=&v"(r[0][1]), "=&v"(r[0][2]), "=&v"(r[0][3]), "=&v"(r[1][0]), "=&v"(r[1][1]), "=&v"(r[1][2]), "=&v"(r[1][3])
        : "v"(a0), "v"(a1) : "memory");
}
__device__ __forceinline__ bf16x8 tr_pair(const uint2& lo, const uint2& hi) { uint4 u; u.x = lo.x; u.y = lo.y; u.z = hi.x; u.w = hi.y; return __builtin_bit_cast(bf16x8, u); }

__device__ __forceinline__ void attn_block(const Params& P, int bh, int qb, unsigned char* smem) {
    const int tid = opaque_tid(), lane = tid & 63, w = tid >> 6, g = lane >> 4, lr = lane & 15;
    const int b = bh >> 3, h = bh & 7;
    const bf16_t* z = (const bf16_t*)(P.ws + WS_Z);
    const float* cum = (const float*)(P.ws + WS_CUM) + (size_t)bh * L;
    int tq[2]; bool qvalid[2]; bf16x8 qf[2][2];
#pragma unroll
    for (int u = 0; u < 2; ++u) {
        tq[u] = qb * 128 + 32 * w + 16 * u + lr;
        qvalid[u] = tq[u] < L;
        const bf16_t* qp = z + (size_t)(b * L + (qvalid[u] ? tq[u] : 0)) * NZ + ZC_FQ + h * 64 + 8 * g;
        qf[u][0] = *(const bf16x8*)(qp); qf[u][1] = *(const bf16x8*)(qp + 32);
    }
    const int nkv = (2 * qb + 2 < 33) ? 2 * qb + 2 : 33;
    const int srow0 = tid >> 3, sch = tid & 7;
    uint4 rk0, rk1, rv0, rv1; float rc = 0.f;
    auto load_tile = [&](int kv) {
        const int key0 = kv * 64 + srow0, key1 = key0 + 32;
        const bf16_t* p0 = z + (size_t)(b * L + (key0 < L ? key0 : L - 1)) * NZ + h * 64 + sch * 8;
        const bf16_t* p1 = z + (size_t)(b * L + (key1 < L ? key1 : L - 1)) * NZ + h * 64 + sch * 8;
        rk0 = *(const uint4*)(p0 + ZC_FK); rv0 = *(const uint4*)(p0 + ZC_FV);
        rk1 = *(const uint4*)(p1 + ZC_FK); rv1 = *(const uint4*)(p1 + ZC_FV);
        const int keyc = kv * 64 + (tid & 63);
        rc = cum[keyc < L ? keyc : L - 1];
    };
    auto store_tile = [&](int buf) {
        unsigned char* sK = smem + buf * 16384; unsigned char* sV = sK + 8192;
        const int row0 = srow0, row1 = srow0 + 32;
        *(uint4*)(sK + row0 * 128 + ((sch ^ (row0 & 7)) << 4)) = rk0;
        *(uint4*)(sV + vimg_off(row0, sch)) = rv0;
        *(uint4*)(sK + row1 * 128 + ((sch ^ (row1 & 7)) << 4)) = rk1;
        *(uint4*)(sV + vimg_off(row1, sch)) = rv1;
        if (tid < 64) ((float*)(smem + 32768 + buf * 256))[tid] = rc;
    };
    float m[2] = {-1e30f, -1e30f};
    f32x4 o[2][5];
#pragma unroll
    for (int u = 0; u < 2; ++u)
#pragma unroll
        for (int c = 0; c < 5; ++c) o[u][c] = (f32x4){0.f, 0.f, 0.f, 0.f};
    const unsigned onew = (lr == 0) ? 0x3F803F80u : 0u;
    const bf16x8 vones = __builtin_bit_cast(bf16x8, make_uint4(onew, onew, onew, onew));
    load_tile(nkv - 1); store_tile((nkv - 1) & 1);
    __syncthreads();
    if (nkv > 1) load_tile(nkv - 2);
    for (int kv = nkv - 1; kv >= 0; --kv) {
        const int buf = kv & 1;
        const unsigned char* sK = smem + buf * 16384; const unsigned char* sV = sK + 8192;
        const float* sck = (const float*)(smem + 32768 + buf * 256);
        f32x4 sa[2][4];
#pragma unroll
        for (int c = 0; c < 4; ++c) {
            sa[0][c] = (f32x4){0.f, 0.f, 0.f, 0.f}; sa[1][c] = (f32x4){0.f, 0.f, 0.f, 0.f};
#pragma unroll
            for (int s = 0; s < 2; ++s) {
                const bf16x8 kf = *(const bf16x8*)(sK + (16 * c + lr) * 128 + (((4 * s + g) ^ (lr & 7)) << 4));
                sa[0][c] = __builtin_amdgcn_mfma_f32_16x16x32_bf16(kf, qf[0][s], sa[0][c], 0, 0, 0);
                sa[1][c] = __builtin_amdgcn_mfma_f32_16x16x32_bf16(kf, qf[1][s], sa[1][c], 0, 0, 0);
            }
        }
        __builtin_amdgcn_sched_barrier(0);
        if (kv > 0) store_tile(buf ^ 1);
        if (kv > 1) load_tile(kv - 2);
        __builtin_amdgcn_sched_barrier(0);
        if (kv >= 2 * qb) {
#pragma unroll
            for (int u = 0; u < 2; ++u)
#pragma unroll
                for (int c = 0; c < 4; ++c)
#pragma unroll
                    for (int r = 0; r < 4; ++r)
                        if (64 * kv + 16 * c + 4 * g + r > tq[u]) sa[u][c][r] = -INFINITY;
        }
        f32x4 ck[4];
#pragma unroll
        for (int c = 0; c < 4; ++c) ck[c] = *(const f32x4*)(sck + 16 * c + 4 * g);
        bf16x8 pf[2][2];
#pragma unroll
        for (int u = 0; u < 2; ++u) {
            float mx = -INFINITY;
#pragma unroll
            for (int c = 0; c < 4; ++c) {
                sa[u][c] -= ck[c];
                mx = fmaxf(mx, fmaxf(fmaxf(sa[u][c][0], sa[u][c][1]), fmaxf(sa[u][c][2], sa[u][c][3])));
            }
            mx = x4_max(mx);
            if (__builtin_amdgcn_ballot_w64(mx > m[u]) != 0ull) {
                const float mn = fmaxf(m[u], mx);
                const float alpha = __builtin_amdgcn_exp2f(m[u] - mn);
                m[u] = mn;
#pragma unroll
                for (int c = 0; c < 5; ++c) o[u][c] *= alpha;
            }
            const float mn = m[u];
#pragma unroll
            for (int c = 0; c < 4; ++c)
#pragma unroll
                for (int r = 0; r < 4; ++r) sa[u][c][r] = __builtin_amdgcn_exp2f(sa[u][c][r] - mn);
#pragma unroll
            for (int s2 = 0; s2 < 2; ++s2) {
                uint4 uu;
                uu.x = cvt_pk_bf16(sa[u][2 * s2][0], sa[u][2 * s2][1]); uu.y = cvt_pk_bf16(sa[u][2 * s2][2], sa[u][2 * s2][3]);
                uu.z = cvt_pk_bf16(sa[u][2 * s2 + 1][0], sa[u][2 * s2 + 1][1]); uu.w = cvt_pk_bf16(sa[u][2 * s2 + 1][2], sa[u][2 * s2 + 1][3]);
                pf[u][s2] = __builtin_bit_cast(bf16x8, uu);
            }
        }
        {
            uint2 vr[4][4];
            tr_read_4c(sV, g, lr, vr);
#pragma unroll
            for (int c = 0; c < 4; ++c)
#pragma unroll
                for (int s2 = 0; s2 < 2; ++s2) {
                    const bf16x8 vf = tr_pair(vr[c][2 * s2], vr[c][2 * s2 + 1]);
                    o[0][c] = __builtin_amdgcn_mfma_f32_16x16x32_bf16(vf, pf[0][s2], o[0][c], 0, 0, 0);
                    o[1][c] = __builtin_amdgcn_mfma_f32_16x16x32_bf16(vf, pf[1][s2], o[1][c], 0, 0, 0);
                }
#pragma unroll
            for (int s2 = 0; s2 < 2; ++s2) {
                o[0][4] = __builtin_amdgcn_mfma_f32_16x16x32_bf16(vones, pf[0][s2], o[0][4], 0, 0, 0);
                o[1][4] = __builtin_amdgcn_mfma_f32_16x16x32_bf16(vones, pf[1][s2], o[1][4], 0, 0, 0);
            }
        }
        __syncthreads();
    }
#pragma unroll
    for (int u = 0; u < 2; ++u) {
        const float ls = __shfl(o[u][4][0], lr, 64);
        const float inv = 1.0f / ls;
        if (qvalid[u]) {
            bf16_t* y = (bf16_t*)(P.ws + WS_Z) + (size_t)(b * L + tq[u]) * NZ + ZC_FQ + h * 64 + 4 * g;
#pragma unroll
            for (int c = 0; c < 4; ++c) {
                uint2 uu; uu.x = pk2(o[u][c][0] * inv, o[u][c][1] * inv); uu.y = pk2(o[u][c][2] * inv, o[u][c][3] * inv);
                *(uint2*)(y + 16 * c) = uu;
            }
        }
    }
}

__device__ __forceinline__ void conv_item(const Params& P, int ci) {
    const int tid = opaque_tid(), cc = tid & 127, rg = tid >> 7;
    const bf16_t* z = (const bf16_t*)(P.ws + WS_Z);
    bf16_t* qk = (bf16_t*)(P.ws + WS_RA);
    const int col0 = cc * 8;
    float w[4][8];
#pragma unroll
    for (int j = 0; j < 4; ++j) {
        const float4 a = *(const float4*)(P.conv_qk + j * 1024 + col0), b = *(const float4*)(P.conv_qk + j * 1024 + col0 + 4);
        w[j][0] = a.x; w[j][1] = a.y; w[j][2] = a.z; w[j][3] = a.w; w[j][4] = b.x; w[j][5] = b.y; w[j][6] = b.z; w[j][7] = b.w;
    }
    const float oscale = (col0 >= 512) ? 0.08838834764831845f : 1.0f;
    const int r0 = ci * 64 + rg * 32;
    int t = r0 % L;
    float xw[3][8];
#pragma unroll
    for (int j = 0; j < 3; ++j) {
        const int back = 3 - j;
        if (t - back >= 0) {
            const uint4 v = *(const uint4*)(z + (size_t)(r0 - back) * NZ + col0);
            xw[j][0] = bflo(v.x); xw[j][1] = bfhi(v.x); xw[j][2] = bflo(v.y); xw[j][3] = bfhi(v.y); xw[j][4] = bflo(v.z); xw[j][5] = bfhi(v.z); xw[j][6] = bflo(v.w); xw[j][7] = bfhi(v.w);
        } else {
#pragma unroll
            for (int e = 0; e < 8; ++e) xw[j][e] = 0.f;
        }
    }
#pragma unroll 2
    for (int i = 0; i < 32; ++i) {
        const int r = r0 + i;
        if (t == 0) {
#pragma unroll
            for (int j = 0; j < 3; ++j)
#pragma unroll
                for (int e = 0; e < 8; ++e) xw[j][e] = 0.f;
        }
        const uint4 v = *(const uint4*)(z + (size_t)r * NZ + col0);
        float xt[8];
        xt[0] = bflo(v.x); xt[1] = bfhi(v.x); xt[2] = bflo(v.y); xt[3] = bfhi(v.y); xt[4] = bflo(v.z); xt[5] = bfhi(v.z); xt[6] = bflo(v.w); xt[7] = bfhi(v.w);
        float o[8];
#pragma unroll
        for (int e = 0; e < 8; ++e) {
            const float cv = w[0][e] * xw[0][e] + w[1][e] * xw[1][e] + w[2][e] * xw[2][e] + w[3][e] * xt[e];
            o[e] = oscale * cv * __builtin_amdgcn_rcpf(1.f + __expf(-cv));
            xw[0][e] = xw[1][e]; xw[1][e] = xw[2][e]; xw[2][e] = xt[e];
        }
        uint4 ov; ov.x = pk2(o[0], o[1]); ov.y = pk2(o[2], o[3]); ov.z = pk2(o[4], o[5]); ov.w = pk2(o[6], o[7]);
        *(uint4*)(qk + (size_t)r * 1024 + col0) = ov;
        t = (t + 1 == L) ? 0 : t + 1;
    }
}

constexpr int ST_IMG = 36864;
constexpr int CONV_P1_ROWS = 24576;
__device__ __forceinline__ int st_piece_off(int jt, int c, int g, int lr) { return (jt >> 2) * 18432 + vimg_off(16 * c + lr, 2 * (jt & 3) + (g >> 1)) + 8 * (g & 1); }

__device__ __forceinline__ void mlstm_stage_kv(const Params& P, int b, int h, int k, unsigned char* sKimg, unsigned char* sVimg, int tid) {
    const bf16_t* z = (const bf16_t*)(P.ws + WS_Z);
    const bf16_t* qk = (const bf16_t*)(P.ws + WS_RA);
    uint4 pk_[4], pv_[4];
#pragma unroll
    for (int j = 0; j < 4; ++j) {
        const int id = tid + 256 * j, row = id >> 4, ch16 = id & 15, pos = 64 * k + row;
        const bool ok = pos < L;
        pk_[j] = ok ? *(const uint4*)(qk + (size_t)(b * L + pos) * 1024 + 512 + h * 128 + ch16 * 8) : make_uint4(0, 0, 0, 0);
        pv_[j] = ok ? *(const uint4*)(z + (size_t)(b * L + pos) * NZ + ZC_MV + h * 128 + ch16 * 8) : make_uint4(0, 0, 0, 0);
    }
#pragma unroll
    for (int j = 0; j < 4; ++j) {
        const int id = tid + 256 * j, row = id >> 4, ch16 = id & 15;
        *(uint4*)(sKimg + (ch16 >> 3) * 8192 + vimg_off(row, ch16 & 7)) = pk_[j];
        *(uint4*)(sVimg + (ch16 >> 3) * 8192 + vimg_off(row, ch16 & 7)) = pv_[j];
    }
    if (tid < 128) {
        const int row = tid >> 1, ch = tid & 1;
        *(uint4*)(sVimg + 16384 + vimg_off(row, ch)) = ch ? make_uint4(0, 0, 0, 0) : make_uint4(0x3F80u, 0, 0, 0);
    }
}

__device__ __forceinline__ void mlstm_stage_A(const Params& P, int b, int h, int k, unsigned char* sKimg, unsigned char* sVimg, int tid) {
    const bf16_t* z = (const bf16_t*)(P.ws + WS_Z);
    bf16_t* qk = (bf16_t*)(P.ws + WS_RA);
    uint4 pv_[4];
#pragma unroll
    for (int j = 0; j < 4; ++j) {
        const int id = tid + 256 * j, row = id >> 4, ch16 = id & 15, pos = 64 * k + row;
        pv_[j] = (pos < L) ? *(const uint4*)(z + (size_t)(b * L + pos) * NZ + ZC_MV + h * 128 + ch16 * 8) : make_uint4(0, 0, 0, 0);
    }
    const int cch = tid & 31, rg = tid >> 5, isk = cch >> 4;
    const int zcol = (isk ? ZC_MK : ZC_MQ) + h * 128 + (cch & 15) * 8;
    float w[4][8];
#pragma unroll
    for (int j = 0; j < 4; ++j) {
        const float4 a = *(const float4*)(P.conv_qk + j * 1024 + zcol), c = *(const float4*)(P.conv_qk + j * 1024 + zcol + 4);
        w[j][0] = a.x; w[j][1] = a.y; w[j][2] = a.z; w[j][3] = a.w; w[j][4] = c.x; w[j][5] = c.y; w[j][6] = c.z; w[j][7] = c.w;
    }
    const float oscale = isk ? 0.08838834764831845f : 1.0f;
    const int p0 = 64 * k + 8 * rg;
    uint4 raw[11];
#pragma unroll
    for (int i = 0; i < 11; ++i) {
        const int pos = p0 - 3 + i;
        raw[i] = (pos >= 0 && pos < L) ? *(const uint4*)(z + (size_t)(b * L + pos) * NZ + zcol) : make_uint4(0, 0, 0, 0);
    }
#pragma unroll
    for (int j = 0; j < 4; ++j) {
        const int id = tid + 256 * j, row = id >> 4, ch16 = id & 15;
        *(uint4*)(sVimg + (ch16 >> 3) * 8192 + vimg_off(row, ch16 & 7)) = pv_[j];
    }
    if (tid < 128) {
        const int row = tid >> 1, ch = tid & 1;
        *(uint4*)(sVimg + 16384 + vimg_off(row, ch)) = ch ? make_uint4(0, 0, 0, 0) : make_uint4(0x3F80u, 0, 0, 0);
    }
#pragma unroll
    for (int i = 0; i < 8; ++i) {
        const int pos = p0 + i, row = 8 * rg + i;
        float o[8];
#pragma unroll
        for (int e = 0; e < 8; ++e) {
            const unsigned w0 = (&raw[i].x)[e >> 1], w1 = (&raw[i + 1].x)[e >> 1], w2 = (&raw[i + 2].x)[e >> 1], w3 = (&raw[i + 3].x)[e >> 1];
            const float x0 = (e & 1) ? bfhi(w0) : bflo(w0), x1 = (e & 1) ? bfhi(w1) : bflo(w1), x2 = (e & 1) ? bfhi(w2) : bflo(w2), x3 = (e & 1) ? bfhi(w3) : bflo(w3);
            const float cv = w[0][e] * x0 + w[1][e] * x1 + w[2][e] * x2 + w[3][e] * x3;
            o[e] = oscale * cv * __builtin_amdgcn_rcpf(1.f + __expf(-cv));
        }
        uint4 ov; ov.x = pk2(o[0], o[1]); ov.y = pk2(o[2], o[3]); ov.z = pk2(o[4], o[5]); ov.w = pk2(o[6], o[7]);
        const bool ok = pos < L;
        if (!ok) ov = make_uint4(0, 0, 0, 0);
        if (ok) *(uint4*)(qk + (size_t)(b * L + pos) * 1024 + (isk ? 512 : 0) + h * 128 + (cch & 15) * 8) = ov;
        if (isk) { const int ch16 = cch & 15; *(uint4*)(sKimg + (ch16 >> 3) * 8192 + vimg_off(row, ch16 & 7)) = ov; }
    }
}

__device__ __forceinline__ void mlstm_A(const Params& P, int item, unsigned char* smem) {
    const int tid = opaque_tid(), lane = tid & 63, w = tid >> 6, g = lane >> 4, lr = lane & 15;
    const int wu = __builtin_amdgcn_readfirstlane(w);
    const int k = item >> 5, bh = item & 31, b = bh >> 2, h = bh & 3;
    const float* gates = (const float*)(P.ws + WS_GATES);
    const unsigned char* sK = smem; const unsigned char* sV = smem + 16384;
    float* ga = (float*)(smem + 40960);
    float lf = 0.f, li = -INFINITY;
    if (wu == 0) {
        const int pos = 64 * k + lane;
        if (pos < L) { lf = gates[(size_t)(b * L + pos) * 16 + 4 + h]; li = gates[(size_t)(b * L + pos) * 16 + h]; }
    }
    mlstm_stage_A(P, b, h, k, smem, smem + 16384, tid);
    if (wu == 0) {
        float bc = lf;
#pragma unroll
        for (int o = 1; o < 64; o <<= 1) { const float n = __shfl_up(bc, o, 64); if (lane >= o) bc += n; }
        const float a = li - bc;
        const float A = wave_max(a);
        ga[lane] = __expf(a - A);
        if (lane == 63) { float* msc = (float*)(P.ws + WS_MSC) + ((size_t)bh * 33 + k) * 4; msc[0] = A; msc[1] = bc; }
    }
    __syncthreads();
    f32x4 Ct[2][9];
#pragma unroll
    for (int a = 0; a < 2; ++a)
#pragma unroll
        for (int c = 0; c < 9; ++c) Ct[a][c] = (f32x4){0.f, 0.f, 0.f, 0.f};
    bf16x8 kt[2][2];
#pragma unroll
    for (int a = 0; a < 2; ++a)
#pragma unroll
        for (int s2 = 0; s2 < 2; ++s2) {
            const int jt = 2 * w + a;
            kt[a][s2] = tr_pair(tr_frag(sK + (jt >> 2) * 8192, 32 * s2, jt & 3, g, lr), tr_frag(sK + (jt >> 2) * 8192, 32 * s2 + 16, jt & 3, g, lr));
        }
    f32x4 wg4[4];
#pragma unroll
    for (int j = 0; j < 4; ++j) wg4[j] = *(const f32x4*)(ga + 16 * j + 4 * g);
#define MA_TILE(c, lo0, hi0, lo1, hi1) { \
        { const f32x4 w0 = wg4[0], w1 = wg4[1]; uint4 o; \
          o.x = cvt_pk_bf16(bflo(lo0.x) * w0[0], bfhi(lo0.x) * w0[1]); o.y = cvt_pk_bf16(bflo(lo0.y) * w0[2], bfhi(lo0.y) * w0[3]); \
          o.z = cvt_pk_bf16(bflo(hi0.x) * w1[0], bfhi(hi0.x) * w1[1]); o.w = cvt_pk_bf16(bflo(hi0.y) * w1[2], bfhi(hi0.y) * w1[3]); \
          const bf16x8 vw = __builtin_bit_cast(bf16x8, o); \
          Ct[0][c] = __builtin_amdgcn_mfma_f32_16x16x32_bf16(kt[0][0], vw, Ct[0][c], 0, 0, 0); Ct[1][c] = __builtin_amdgcn_mfma_f32_16x16x32_bf16(kt[1][0], vw, Ct[1][c], 0, 0, 0); } \
        { const f32x4 w0 = wg4[2], w1 = wg4[3]; uint4 o; \
          o.x = cvt_pk_bf16(bflo(lo1.x) * w0[0], bfhi(lo1.x) * w0[1]); o.y = cvt_pk_bf16(bflo(lo1.y) * w0[2], bfhi(lo1.y) * w0[3]); \
          o.z = cvt_pk_bf16(bflo(hi1.x) * w1[0], bfhi(hi1.x) * w1[1]); o.w = cvt_pk_bf16(bflo(hi1.y) * w1[2], bfhi(hi1.y) * w1[3]); \
          const bf16x8 vw = __builtin_bit_cast(bf16x8, o); \
          Ct[0][c] = __builtin_amdgcn_mfma_f32_16x16x32_bf16(kt[0][1], vw, Ct[0][c], 0, 0, 0); Ct[1][c] = __builtin_amdgcn_mfma_f32_16x16x32_bf16(kt[1][1], vw, Ct[1][c], 0, 0, 0); } }
    {
        uint2 vr[4][4];
        tr_read_4c(sV, g, lr, vr);
        MA_TILE(0, vr[0][0], vr[0][1], vr[0][2], vr[0][3]) MA_TILE(1, vr[1][0], vr[1][1], vr[1][2], vr[1][3])
        MA_TILE(2, vr[2][0], vr[2][1], vr[2][2], vr[2][3]) MA_TILE(3, vr[3][0], vr[3][1], vr[3][2], vr[3][3])
        tr_read_4c(sV + 8192, g, lr, vr);
        MA_TILE(4, vr[0][0], vr[0][1], vr[0][2], vr[0][3]) MA_TILE(5, vr[1][0], vr[1][1], vr[1][2], vr[1][3])
        MA_TILE(6, vr[2][0], vr[2][1], vr[2][2], vr[2][3]) MA_TILE(7, vr[3][0], vr[3][1], vr[3][2], vr[3][3])
        const uint2 o0 = tr_frag(sV + 16384, 0, 0, g, lr), o1 = tr_frag(sV + 16384, 16, 0, g, lr), o2 = tr_frag(sV + 16384, 32, 0, g, lr), o3 = tr_frag(sV + 16384, 48, 0, g, lr);
        MA_TILE(8, o0, o1, o2, o3)
    }
#undef MA_TILE
    unsigned char* slot = P.ws + WS_MST + ((size_t)bh * 33 + k) * ST_IMG;
#pragma unroll
    for (int a = 0; a < 2; ++a)
#pragma unroll
        for (int c = 0; c < 9; ++c) {
            uint2 u; u.x = cvt_pk_bf16(Ct[a][c][0], Ct[a][c][1]); u.y = cvt_pk_bf16(Ct[a][c][2], Ct[a][c][3]);
            *(uint2*)(slot + st_piece_off(2 * w + a, c, g, lr)) = u;
        }
}

__device__ __forceinline__ void mlstm_B(const Params& P, int item) {
    const int tid = opaque_tid();
    const int bh = item / 9, part = item - bh * 9;
    const unsigned char* base = P.ws + WS_MST + (size_t)bh * 33 * ST_IMG + part * 4096 + tid * 16;
    unsigned char* obase = P.ws + WS_CBI + (size_t)bh * 33 * ST_IMG + part * 4096 + tid * 16;
    float* msc = (float*)(P.ws + WS_MSC) + (size_t)bh * 33 * 4;
    float C[8];
#pragma unroll
    for (int r = 0; r < 8; ++r) C[r] = 0.f;
    float m = 0.f;
    uint4 d0, d1, d2, d3, d4, d5, d6, d7;
    float2 a0, a1, a2, a3, a4, a5, a6, a7;
#define B_LD(K, D, AB) { D = *(const uint4*)(base + (size_t)(K) * ST_IMG); AB = *(const float2*)(msc + (K) * 4); }
    B_LD(0, d0, a0) B_LD(1, d1, a1) B_LD(2, d2, a2) B_LD(3, d3, a3) B_LD(4, d4, a4) B_LD(5, d5, a5) B_LD(6, d6, a6) B_LD(7, d7, a7)
#define B_STEP(K, D, AB) { \
        { uint4 u; u.x = cvt_pk_bf16(C[0], C[1]); u.y = cvt_pk_bf16(C[2], C[3]); u.z = cvt_pk_bf16(C[4], C[5]); u.w = cvt_pk_bf16(C[6], C[7]); \
          *(uint4*)(obase + (size_t)(K) * ST_IMG) = u; }                      \
        if (tid == 0 && part == 0) msc[(K) * 4 + 2] = m; \
        const float M_ = fmaxf(m, AB.x); \
        const float decay_ = __expf(m - M_), sc_ = __expf(AB.x - M_); \
        C[0] = decay_ * C[0] + sc_ * bflo(D.x); C[1] = decay_ * C[1] + sc_ * bfhi(D.x); C[2] = decay_ * C[2] + sc_ * bflo(D.y); C[3] = decay_ * C[3] + sc_ * bfhi(D.y); \
        C[4] = decay_ * C[4] + sc_ * bflo(D.z); C[5] = decay_ * C[5] + sc_ * bfhi(D.z); C[6] = decay_ * C[6] + sc_ * bflo(D.w); C[7] = decay_ * C[7] + sc_ * bfhi(D.w); \
        m = AB.y + M_; \
        if ((K) + 8 < 33) B_LD((K) + 8, D, AB) }
#pragma unroll 1
    for (int k = 0; k < 32; k += 8) {
        B_STEP(k, d0, a0) B_STEP(k + 1, d1, a1) B_STEP(k + 2, d2, a2) B_STEP(k + 3, d3, a3)
        B_STEP(k + 4, d4, a4) B_STEP(k + 5, d5, a5) B_STEP(k + 6, d6, a6) B_STEP(k + 7, d7, a7)
    }
    B_STEP(32, d0, a0)
#undef B_STEP
#undef B_LD
}

__device__ __forceinline__ void mlstm_C(const Params& P, int item, unsigned char* smem) {
    const int tid = opaque_tid(), lane = tid & 63, w = tid >> 6, g = lane >> 4, lr = lane & 15;
    const int wu = __builtin_amdgcn_readfirstlane(w);
    const int k = item >> 5, bh = item & 31, b = bh >> 2, h = bh & 3;
    const bf16_t* z = (const bf16_t*)(P.ws + WS_Z);
    const bf16_t* qk = (const bf16_t*)(P.ws + WS_RA);
    const float* gates = (const float*)(P.ws + WS_GATES);
    bf16_t* y = (bf16_t*)(P.ws + WS_Z);
    const unsigned char* sK = smem; const unsigned char* sV = smem + 36864; unsigned char* sCb = smem;
    float* ga = (float*)(smem + 61440);
    const int pos = 64 * k + 16 * w + lr;
    const bool tvalid = pos < L;
    const size_t rrow = (size_t)(b * L + (tvalid ? pos : 0));
    const unsigned char* cslot = P.ws + WS_CBI + ((size_t)bh * 33 + k) * ST_IMG + tid * 16;
    const uint4 cb0 = *(const uint4*)(cslot), cb1 = *(const uint4*)(cslot + 4096), cb2 = *(const uint4*)(cslot + 8192), cb3 = *(const uint4*)(cslot + 12288), cb4 = *(const uint4*)(cslot + 16384),
                cb5 = *(const uint4*)(cslot + 20480), cb6 = *(const uint4*)(cslot + 24576), cb7 = *(const uint4*)(cslot + 28672), cb8 = *(const uint4*)(cslot + 32768);
    bf16x8 qf[4];
    {
        const bf16_t* qp = qk + rrow * 1024 + h * 128 + 8 * g;
#pragma unroll
        for (int ks = 0; ks < 4; ++ks) { qf[ks] = *(const bf16x8*)(qp + 32 * ks); if (!tvalid) qf[ks] = (bf16x8){0, 0, 0, 0, 0, 0, 0, 0}; }
    }
    float m_prev = 0.f, lf = 0.f, li = -INFINITY;
    if (wu == 0) {
        m_prev = ((const float*)(P.ws + WS_MSC))[((size_t)bh * 33 + k) * 4 + 2];
        const int p2 = 64 * k + lane;
        if (p2 < L) { lf = gates[(size_t)(b * L + p2) * 16 + 4 + h]; li = gates[(size_t)(b * L + p2) * 16 + h]; }
    }
    mlstm_stage_kv(P, b, h, k, smem, smem + 36864, tid);
    if (wu == 0) {
        float bc = lf;
#pragma unroll
        for (int o = 1; o < 64; o <<= 1) { const float n = __shfl_up(bc, o, 64); if (lane >= o) bc += n; }
        const float a = li - bc;
        float am = a;
#pragma unroll
        for (int o = 1; o < 64; o <<= 1) { const float n = __shfl_up(am, o, 64); if (lane >= o) am = fmaxf(am, n); }
        const float M = fmaxf(m_prev, am);
        ga[lane] = a; ga[64 + lane] = __expf(m_prev - M); ga[128 + lane] = __expf(-(bc + M)); ga[192 + lane] = M;
    }
    __syncthreads();
    const float Mt = ga[192 + 16 * w + lr], Wi = ga[64 + 16 * w + lr], Et = ga[128 + 16 * w + lr];
    bf16x8 pf[2];
    {
        f32x4 sa[4];
#pragma unroll
        for (int c = 0; c < 4; ++c) {
            sa[c] = (f32x4){0.f, 0.f, 0.f, 0.f};
            if (c <= wu) {
#pragma unroll
                for (int ks = 0; ks < 4; ++ks) {
                    const bf16x8 kf = *(const bf16x8*)(sK + (ks >> 1) * 8192 + vimg_off(16 * c + lr, 4 * (ks & 1) + g));
                    sa[c] = __builtin_amdgcn_mfma_f32_16x16x32_bf16(kf, qf[ks], sa[c], 0, 0, 0);
                }
                const f32x4 av = *(const f32x4*)(ga + 16 * c + 4 * g);
#pragma unroll
                for (int r = 0; r < 4; ++r) {
                    const float d = __expf(av[r] - Mt);
                    sa[c][r] = (16 * c + 4 * g + r <= 16 * w + lr) ? sa[c][r] * d : 0.f;
                }
            }
        }
#pragma unroll
        for (int s2 = 0; s2 < 2; ++s2) {
            uint4 u;
            u.x = cvt_pk_bf16(sa[2 * s2][0], sa[2 * s2][1]); u.y = cvt_pk_bf16(sa[2 * s2][2], sa[2 * s2][3]);
            u.z = cvt_pk_bf16(sa[2 * s2 + 1][0], sa[2 * s2 + 1][1]); u.w = cvt_pk_bf16(sa[2 * s2 + 1][2], sa[2 * s2 + 1][3]);
            pf[s2] = __builtin_bit_cast(bf16x8, u);
        }
    }
    __syncthreads();
    {
        unsigned char* d = sCb + tid * 16;
        *(uint4*)(d) = cb0; *(uint4*)(d + 4096) = cb1; *(uint4*)(d + 8192) = cb2; *(uint4*)(d + 12288) = cb3; *(uint4*)(d + 16384) = cb4;
        *(uint4*)(d + 20480) = cb5; *(uint4*)(d + 24576) = cb6; *(uint4*)(d + 28672) = cb7; *(uint4*)(d + 32768) = cb8;
    }
    __syncthreads();
    f32x4 na[9];
#define MC_TILE(c, lo0, hi0, lo1, hi1) { \
        na[c] = (f32x4){0.f, 0.f, 0.f, 0.f}; \
        _Pragma("unroll") for (int ks = 0; ks < 4; ++ks) { \
            const bf16x8 cf = *(const bf16x8*)(sCb + (ks >> 1) * 18432 + vimg_off(16 * (c) + lr, 4 * (ks & 1) + g)); \
            na[c] = __builtin_amdgcn_mfma_f32_16x16x32_bf16(cf, qf[ks], na[c], 0, 0, 0); } \
        na[c] *= Wi; \
        na[c] = __builtin_amdgcn_mfma_f32_16x16x32_bf16(tr_pair(lo0, hi0), pf[0], na[c], 0, 0, 0); \
        na[c] = __builtin_amdgcn_mfma_f32_16x16x32_bf16(tr_pair(lo1, hi1), pf[1], na[c], 0, 0, 0); }
    {
        uint2 vr[4][4];
        tr_read_4c(sV, g, lr, vr);
        MC_TILE(0, vr[0][0], vr[0][1], vr[0][2], vr[0][3]) MC_TILE(1, vr[1][0], vr[1][1], vr[1][2], vr[1][3])
        MC_TILE(2, vr[2][0], vr[2][1], vr[2][2], vr[2][3]) MC_TILE(3, vr[3][0], vr[3][1], vr[3][2], vr[3][3])
        tr_read_4c(sV + 8192, g, lr, vr);
        MC_TILE(4, vr[0][0], vr[0][1], vr[0][2], vr[0][3]) MC_TILE(5, vr[1][0], vr[1][1], vr[1][2], vr[1][3])
        MC_TILE(6, vr[2][0], vr[2][1], vr[2][2], vr[2][3]) MC_TILE(7, vr[3][0], vr[3][1], vr[3][2], vr[3][3])
        const uint2 o0 = tr_frag(sV + 16384, 0, 0, g, lr), o1 = tr_frag(sV + 16384, 16, 0, g, lr), o2 = tr_frag(sV + 16384, 32, 0, g, lr), o3 = tr_frag(sV + 16384, 48, 0, g, lr);
        MC_TILE(8, o0, o1, o2, o3)
    }
#undef MC_TILE
    const float den = __shfl(na[8][0], lr, 64);
    const float rden = 1.0f / fmaxf(fabsf(den), Et);
    float hs = 0.f;
#pragma unroll
    for (int c = 0; c < 8; ++c) { na[c] *= rden; hs += na[c][0] * na[c][0] + na[c][1] * na[c][1] + na[c][2] * na[c][2] + na[c][3] * na[c][3]; }
    hs = x4_sum(hs);
    const float rstd = rsqrtf(hs * (1.0f / 128.0f) + EPS);
    const float* gainp = P.m_out_norm + h * 128 + 4 * g;
#pragma unroll
    for (int c = 0; c < 8; ++c) {
        const uint2 og = *(const uint2*)(z + rrow * NZ + ZC_MO + h * 128 + 16 * c + 4 * g);
        const float o0 = bflo(og.x), o1 = bfhi(og.x), o2 = bflo(og.y), o3 = bfhi(og.y);
        const float4 gn = *(const float4*)(gainp + 16 * c);
        uint2 u;
        u.x = pk2(na[c][0] * rstd * gn.x * __builtin_amdgcn_rcpf(1.f + __expf(-o0)), na[c][1] * rstd * gn.y * __builtin_amdgcn_rcpf(1.f + __expf(-o1)));
        u.y = pk2(na[c][2] * rstd * gn.z * __builtin_amdgcn_rcpf(1.f + __expf(-o2)), na[c][3] * rstd * gn.w * __builtin_amdgcn_rcpf(1.f + __expf(-o3)));
        if (tvalid) *(uint2*)(y + rrow * NZ + h * 128 + 16 * c + 4 * g) = u;
    }
}

__device__ __forceinline__ void peer_stage2_batch(const Params& P, int tbase, int tstride, int lane, unsigned char* res, unsigned char* scr) {
    const int tau = lane >> 3, hd = lane & 7;
    const int t = tbase + tau * tstride;
    const uint4* lp = (const uint4*)((const unsigned*)(P.ws + WS_TK) + (size_t)(t < T2 ? t : tbase) * 256 + hd * 32);
    const uint4 L0 = lp[0], L1 = lp[1], L2 = lp[2], L3 = lp[3], L4 = lp[4], L5 = lp[5], L6 = lp[6], L7 = lp[7];
    const unsigned ka[16] = {L0.x, L0.y, L0.z, L0.w, L1.x, L1.y, L1.z, L1.w, L2.x, L2.y, L2.z, L2.w, L3.x, L3.y, L3.z, L3.w};
    const unsigned kb[16] = {L4.x, L4.y, L4.z, L4.w, L5.x, L5.y, L5.z, L5.w, L6.x, L6.y, L6.z, L6.w, L7.x, L7.y, L7.z, L7.w};
    float va[16], vb[16];
#pragma unroll
    for (int i = 0; i < 16; ++i) { va[i] = unord_key(ka[i] & ~127u); vb[i] = unord_key(kb[i] & ~127u); }
    {
        unsigned w[8];
#pragma unroll
        for (int q = 0; q < 4; ++q) {
            w[q]     = (127u - (ka[4 * q] & 127u)) | ((127u - (ka[4 * q + 1] & 127u)) << 8) | ((127u - (ka[4 * q + 2] & 127u)) << 16) | ((127u - (ka[4 * q + 3] & 127u)) << 24);
            w[4 + q] = (127u - (kb[4 * q] & 127u)) | ((127u - (kb[4 * q + 1] & 127u)) << 8) | ((127u - (kb[4 * q + 2] & 127u)) << 16) | ((127u - (kb[4 * q + 3] & 127u)) << 24);
        }
        *(uint4*)(scr + lane * 32) = make_uint4(w[0], w[1], w[2], w[3]);
        *(uint4*)(scr + lane * 32 + 16) = make_uint4(w[4], w[5], w[6], w[7]);
    }
    unsigned top[16] = {((ord_key(va[0] + vb[0]) & ~255u) | 255u), ((ord_key(va[0] + vb[1]) & ~255u) | 254u), ((ord_key(va[0] + vb[2]) & ~255u) | 253u), ((ord_key(va[0] + vb[3]) & ~255u) | 252u), ((ord_key(va[0] + vb[4]) & ~255u) | 251u), ((ord_key(va[0] + vb[5]) & ~255u) | 250u), ((ord_key(va[0] + vb[6]) & ~255u) | 249u), ((ord_key(va[0] + vb[7]) & ~255u) | 248u), ((ord_key(va[0] + vb[8]) & ~255u) | 247u), ((ord_key(va[0] + vb[9]) & ~255u) | 246u), ((ord_key(va[0] + vb[10]) & ~255u) | 245u), ((ord_key(va[0] + vb[11]) & ~255u) | 244u), ((ord_key(va[0] + vb[12]) & ~255u) | 243u), ((ord_key(va[0] + vb[13]) & ~255u) | 242u), ((ord_key(va[0] + vb[14]) & ~255u) | 241u), ((ord_key(va[0] + vb[15]) & ~255u) | 240u)};
    {
        unsigned gq[16] = {((ord_key(va[1] + vb[0]) & ~255u) | 239u), ((ord_key(va[1] + vb[1]) & ~255u) | 238u), ((ord_key(va[1] + vb[2]) & ~255u) | 237u), ((ord_key(va[1] + vb[3]) & ~255u) | 236u), ((ord_key(va[1] + vb[4]) & ~255u) | 235u), ((ord_key(va[1] + vb[5]) & ~255u) | 234u), ((ord_key(va[1] + vb[6]) & ~255u) | 233u), ((ord_key(va[1] + vb[7]) & ~255u) | 232u), ((ord_key(va[2] + vb[0]) & ~255u) | 223u), ((ord_key(va[2] + vb[1]) & ~255u) | 222u), ((ord_key(va[2] + vb[2]) & ~255u) | 221u), ((ord_key(va[2] + vb[3]) & ~255u) | 220u), ((ord_key(va[2] + vb[4]) & ~255u) | 219u), ((ord_key(va[3] + vb[0]) & ~255u) | 207u), ((ord_key(va[3] + vb[1]) & ~255u) | 206u), ((ord_key(va[3] + vb[2]) & ~255u) | 205u)};
        bitonic_sort16_desc(gq);
        bitonic_merge16_top(top, gq);
    }
    {
        unsigned gq[16] = {((ord_key(va[3] + vb[3]) & ~255u) | 204u), ((ord_key(va[4] + vb[0]) & ~255u) | 191u), ((ord_key(va[4] + vb[1]) & ~255u) | 190u), ((ord_key(va[4] + vb[2]) & ~255u) | 189u), ((ord_key(va[5] + vb[0]) & ~255u) | 175u), ((ord_key(va[5] + vb[1]) & ~255u) | 174u), ((ord_key(va[6] + vb[0]) & ~255u) | 159u), ((ord_key(va[6] + vb[1]) & ~255u) | 158u), ((ord_key(va[7] + vb[0]) & ~255u) | 143u), ((ord_key(va[7] + vb[1]) & ~255u) | 142u), ((ord_key(va[8] + vb[0]) & ~255u) | 127u), ((ord_key(va[9] + vb[0]) & ~255u) | 111u), ((ord_key(va[10] + vb[0]) & ~255u) | 95u), ((ord_key(va[11] + vb[0]) & ~255u) | 79u), ((ord_key(va[12] + vb[0]) & ~255u) | 63u), ((ord_key(va[13] + vb[0]) & ~255u) | 47u)};
        bitonic_sort16_desc(gq);
        bitonic_merge16_top(top, gq);
    }
    {
        const unsigned x48 = ((ord_key(va[14] + vb[0]) & ~255u) | 31u), x49 = ((ord_key(va[15] + vb[0]) & ~255u) | 15u);
        unsigned gq[16] = {max(x48, x49), min(x48, x49), 0u, 0u, 0u, 0u, 0u, 0u, 0u, 0u, 0u, 0u, 0u, 0u, 0u, 0u};
        bitonic_merge16_top(top, gq);
    }
    const float smax = unord_key(top[0] & ~255u);
    float e[16]; float den = 0.f;
#pragma unroll
    for (int r = 0; r < 16; ++r) { e[r] = __expf(unord_key(top[r] & ~255u) - smax); den += e[r]; }
    const float inv = 1.f / den;
    __builtin_amdgcn_s_waitcnt(0xc07f);
    __builtin_amdgcn_wave_barrier();
    int ids[16];
#pragma unroll
    for (int r = 0; r < 16; ++r) {
        const int pos = 255 - (int)(top[r] & 255u), i = pos >> 4, j = pos & 15;
        ids[r] = (int)scr[lane * 32 + i] * 128 + (int)scr[lane * 32 + 16 + j];
    }
    int* sid = (int*)(res + tau * 1024) + hd * 16; float* sgate = (float*)(res + tau * 1024 + 512) + hd * 16;
#pragma unroll
    for (int q = 0; q < 4; ++q) {
        *(int4*)(sid + 4 * q) = make_int4(ids[4 * q], ids[4 * q + 1], ids[4 * q + 2], ids[4 * q + 3]);
        *(float4*)(sgate + 4 * q) = make_float4(e[4 * q] * inv, e[4 * q + 1] * inv, e[4 * q + 2] * inv, e[4 * q + 3] * inv);
    }
    __builtin_amdgcn_s_waitcnt(0xc07f);
    __builtin_amdgcn_wave_barrier();
}

__device__ __forceinline__ void peer_token(const Params& P, int t, int lane, int* sidx, float* sval, const int* sid, const float* sgate, const unsigned* szero) {
    const bf16_t* xn = (const bf16_t*)(P.ws + WS_XN) + (size_t)t * DM;
    const uint4 xa_pre = *(const uint4*)(xn + lane * 16), xb_pre = *(const uint4*)(xn + lane * 16 + 8);
    const float rstd = ((const float*)(P.ws + WS_RSTD))[t];
    const unsigned char* V = P.ws + WS_V + lane * 8;
    const float* usc = (const float*)(P.ws + WS_USC);
    const float* vsc = (const float*)(P.ws + WS_VSC);
    const int g = lane >> 4, lr = lane & 15;
    unsigned char* shi = (unsigned char*)sval;
    unsigned char* slo = (unsigned char*)sidx;
    {
        const uint4 xa = xa_pre, xb = xb_pre;
        const unsigned xw[8] = {xa.x, xa.y, xa.z, xa.w, xb.x, xb.y, xb.z, xb.w};
        unsigned hi[4], lo[4];
#pragma unroll
        for (int i = 0; i < 4; ++i) {
            const float x0 = bflo(xw[2 * i]), x1 = bfhi(xw[2 * i]), x2 = bflo(xw[2 * i + 1]), x3 = bfhi(xw[2 * i + 1]);
            int wd = 0;
            wd = __builtin_amdgcn_cvt_pk_fp8_f32(x0, x1, wd, false);
            wd = __builtin_amdgcn_cvt_pk_fp8_f32(x2, x3, wd, true);
            const f32x2 h01 = __builtin_amdgcn_cvt_pk_f32_fp8(wd, false), h23 = __builtin_amdgcn_cvt_pk_f32_fp8(wd, true);
            int wl = 0;
            wl = __builtin_amdgcn_cvt_pk_fp8_f32(x0 - h01.x, x1 - h01.y, wl, false);
            wl = __builtin_amdgcn_cvt_pk_fp8_f32(x2 - h23.x, x3 - h23.y, wl, true);
            hi[i] = (unsigned)wd; lo[i] = (unsigned)wl;
        }
        *(uint4*)(shi + lane * 16) = make_uint4(hi[0], hi[1], hi[2], hi[3]);
        *(uint4*)(slo + lane * 16) = make_uint4(lo[0], lo[1], lo[2], lo[3]);
    }
    __builtin_amdgcn_s_waitcnt(0xc07f);
    __builtin_amdgcn_wave_barrier();
    {
        typedef int v8i __attribute__((ext_vector_type(8)));
        const unsigned char* Ub = P.ws + WS_U;
        const unsigned lofs = 64u * (unsigned)(lr >> 3) + 16u * (unsigned)g;
        const unsigned char* bsrc = (lr < 4) ? (((lr & 2) ? slo : shi) + 128 * (lr & 1) + 16 * g) : (const unsigned char*)szero;
        const int bstep = (lr < 4) ? 256 : 0, bhalf = (lr < 4) ? 64 : 16;
        v8i Bv[4];
#pragma unroll
        for (int st = 0; st < 4; ++st) {
            const uint4 b0 = *(const uint4*)(bsrc + bstep * st), b1 = *(const uint4*)(bsrc + bstep * st + bhalf);
            Bv[st] = (v8i){(int)b0.x, (int)b0.y, (int)b0.z, (int)b0.w, (int)b1.x, (int)b1.y, (int)b1.z, (int)b1.w};
        }
        __builtin_amdgcn_s_waitcnt(0xc07f);
        __builtin_amdgcn_wave_barrier();
        float* sact = (float*)sidx + 128 * (lr & 3) + 4 * (g & 1);
        const bool owner = (lr < 4) && ((g >> 1) == (lr & 1));
        uint4 abuf[2][2][4];
        unsigned off2[2];
#pragma unroll
        for (int hh = 0; hh < 2; ++hh) off2[hh] = (unsigned)sid[8 * hh + (lr & 7)] * 512u + lofs;
#pragma unroll
        for (int hh = 0; hh < 2; ++hh)
#pragma unroll
            for (int st = 0; st < 4; ++st) abuf[0][hh][st] = *(const uint4*)(Ub + (off2[hh] + 128 * st));
#pragma unroll
        for (int T = 0; T < 8; ++T) {
            if (T + 1 < 8) {
#pragma unroll
                for (int hh = 0; hh < 2; ++hh) off2[hh] = (unsigned)sid[16 * (T + 1) + 8 * hh + (lr & 7)] * 512u + lofs;
#pragma unroll
                for (int hh = 0; hh < 2; ++hh)
#pragma unroll
                    for (int st = 0; st < 4; ++st) abuf[(T + 1) & 1][hh][st] = *(const uint4*)(Ub + (off2[hh] + 128 * st));
            }
#pragma unroll
            for (int hh = 0; hh < 2; ++hh) {
                f32x4 au = (f32x4){0.f, 0.f, 0.f, 0.f};
#pragma unroll
                for (int st = 0; st < 4; ++st) {
                    const uint4 a4 = abuf[T & 1][hh][st];
                    const v8i Av = {(int)a4.x, (int)a4.y, (int)a4.z, (int)a4.w, 0, 0, 0, 0};
                    au = __builtin_amdgcn_mfma_scale_f32_16x16x128_f8f6f4(Av, Bv[st], au, 4, 0, 0, 0x7f7f7f7f, 0, 0x7f7f7f7f);
                }
                if (owner) *(f32x4*)(sact + 16 * T + 8 * hh) = au;
            }
        }
    }
    __builtin_amdgcn_s_waitcnt(0xc07f);
    __builtin_amdgcn_wave_barrier();
    {
        float* sw = (float*)sidx;
        float wv[2];
#pragma unroll
        for (int hh = 0; hh < 2; ++hh) {
            const int e = lane + 64 * hh, id = sid[e];
            const float a = ((sw[e] + sw[128 + e]) + (sw[256 + e] + sw[384 + e])) * usc[id] * rstd;
            wv[hh] = sgate[e] * vsc[id] * 0.5f * a * (1.f + erff(a * 0.70710678118654752f));
        }
        __builtin_amdgcn_s_waitcnt(0xc07f);
        __builtin_amdgcn_wave_barrier();
        sw[lane] = wv[0]; sw[lane + 64] = wv[1];
    }
    __builtin_amdgcn_s_waitcnt(0xc07f);
    __builtin_amdgcn_wave_barrier();
    const int half = lane >> 5, l5 = lane & 31;
    const int lane_o = 2 * l5 + half;
    f32x2 acc2[16];
#pragma unroll
    for (int j = 0; j < 16; ++j) acc2[j] = (f32x2){0.f, 0.f};
    const unsigned char* Vb = P.ws + WS_V;
    const unsigned vlo = (unsigned)l5 * 16u;
#pragma unroll 1
    for (int e0 = 0; e0 < 128; e0 += 16) {
        uint4 vr[8];
#pragma unroll
        for (int q = 0; q < 8; ++q) vr[q] = *(const uint4*)(Vb + ((unsigned)sid[e0 + 2 * q + half] * 512u + vlo));
        const float* sw = (const float*)sidx + e0;
        const f32x4 w0 = *(const f32x4*)(sw), w1 = *(const f32x4*)(sw + 4), w2 = *(const f32x4*)(sw + 8), w3 = *(const f32x4*)(sw + 12);
        const float wq[16] = {w0[0], w0[1], w0[2], w0[3], w1[0], w1[1], w1[2], w1[3], w2[0], w2[1], w2[2], w2[3], w3[0], w3[1], w3[2], w3[3]};
#pragma unroll
        for (int q = 0; q < 8; ++q) {
            const float w = half ? wq[2 * q + 1] : wq[2 * q];
#define FP4_AXPY(k) { acc2[k] += w * __builtin_amdgcn_cvt_scalef32_pk_f32_fp4(vr[q].x, 1.0f, k); acc2[4 + k] += w * __builtin_amdgcn_cvt_scalef32_pk_f32_fp4(vr[q].y, 1.0f, k); \
                      acc2[8 + k] += w * __builtin_amdgcn_cvt_scalef32_pk_f32_fp4(vr[q].z, 1.0f, k); acc2[12 + k] += w * __builtin_amdgcn_cvt_scalef32_pk_f32_fp4(vr[q].w, 1.0f, k); }
            FP4_AXPY(0) FP4_AXPY(1) FP4_AXPY(2) FP4_AXPY(3)
#undef FP4_AXPY
        }
    }
    f32x2 acc[8];
#pragma unroll
    for (int j = 0; j < 16; ++j) {
        const unsigned x0 = __float_as_uint(acc2[j].x), x1 = __float_as_uint(acc2[j].y);
        const auto r0 = __builtin_amdgcn_permlane32_swap(x0, x0, false, false);
        const auto r1 = __builtin_amdgcn_permlane32_swap(x1, x1, false, false);
        acc2[j].x = __uint_as_float(r0[0]) + __uint_as_float(r0[1]);
        acc2[j].y = __uint_as_float(r1[0]) + __uint_as_float(r1[1]);
    }
#pragma unroll
    for (int j = 0; j < 8; ++j) { acc[j].x = half ? acc2[8 + j].x : acc2[j].x; acc[j].y = half ? acc2[8 + j].y : acc2[j].y; }
    f32x2 xf[8];
    {
        const uint4 xa = *(const uint4*)(xn + lane_o * 16), xb = *(const uint4*)(xn + lane_o * 16 + 8);
        xf[0] = (f32x2){bflo(xa.x), bfhi(xa.x)}; xf[1] = (f32x2){bflo(xa.y), bfhi(xa.y)}; xf[2] = (f32x2){bflo(xa.z), bfhi(xa.z)}; xf[3] = (f32x2){bflo(xa.w), bfhi(xa.w)};
        xf[4] = (f32x2){bflo(xb.x), bfhi(xb.x)}; xf[5] = (f32x2){bflo(xb.y), bfhi(xb.y)}; xf[6] = (f32x2){bflo(xb.z), bfhi(xb.z)}; xf[7] = (f32x2){bflo(xb.w), bfhi(xb.w)};
    }
    float* o = P.out + (size_t)t * DM + lane_o * 16;
    float4 h0, h1, h2, h3;
    {
        const float4 g0 = *(const float4*)(P.norm_ffn + lane_o * 16), g1 = *(const float4*)(P.norm_ffn + lane_o * 16 + 4), g2 = *(const float4*)(P.norm_ffn + lane_o * 16 + 8), g3 = *(const float4*)(P.norm_ffn + lane_o * 16 + 12);
        h0.x = xf[0].x * __builtin_amdgcn_rcpf(g0.x) + acc[0].x; h0.y = xf[0].y * __builtin_amdgcn_rcpf(g0.y) + acc[0].y; h0.z = xf[1].x * __builtin_amdgcn_rcpf(g0.z) + acc[1].x; h0.w = xf[1].y * __builtin_amdgcn_rcpf(g0.w) + acc[1].y;
        h1.x = xf[2].x * __builtin_amdgcn_rcpf(g1.x) + acc[2].x; h1.y = xf[2].y * __builtin_amdgcn_rcpf(g1.y) + acc[2].y; h1.z = xf[3].x * __builtin_amdgcn_rcpf(g1.z) + acc[3].x; h1.w = xf[3].y * __builtin_amdgcn_rcpf(g1.w) + acc[3].y;
        h2.x = xf[4].x * __builtin_amdgcn_rcpf(g2.x) + acc[4].x; h2.y = xf[4].y * __builtin_amdgcn_rcpf(g2.y) + acc[4].y; h2.z = xf[5].x * __builtin_amdgcn_rcpf(g2.z) + acc[5].x; h2.w = xf[5].y * __builtin_amdgcn_rcpf(g2.w) + acc[5].y;
        h3.x = xf[6].x * __builtin_amdgcn_rcpf(g3.x) + acc[6].x; h3.y = xf[6].y * __builtin_amdgcn_rcpf(g3.y) + acc[6].y; h3.z = xf[7].x * __builtin_amdgcn_rcpf(g3.z) + acc[7].x; h3.w = xf[7].y * __builtin_amdgcn_rcpf(g3.w) + acc[7].y;
    }
    *(float4*)(o) = h0; *(float4*)(o + 4) = h1; *(float4*)(o + 8) = h2; *(float4*)(o + 12) = h3;
    __builtin_amdgcn_s_waitcnt(0xc07f);
    __builtin_amdgcn_wave_barrier();
}

#define LAS __attribute__((address_space(3)))
#define XB_TMO      128
#define XB_XCNT(j)  (256  + 64 * (j))
#define XB_XSUB(j)  (1280 + 64 * (j))
#define XB_XGEN(j)  (2304 + 64 * (j))
#define XB_TOP      3328
#define XB_TOPGEN   3392
#define XCD_BAR_WORDS 3456
#define XB_SPIN_CAP (1u << 18)
__device__ __forceinline__ unsigned xb_ld(unsigned* p)              { return __hip_atomic_load(p, __ATOMIC_RELAXED, __HIP_MEMORY_SCOPE_AGENT); }
__device__ __forceinline__ unsigned xb_add(unsigned* p, unsigned v) { return __hip_atomic_fetch_add(p, v, __ATOMIC_RELAXED, __HIP_MEMORY_SCOPE_AGENT); }
__device__ __forceinline__ unsigned xb_xcc_id() { return (unsigned)__builtin_amdgcn_s_getreg((3 << 11) | 20) & 0xFu; }
#define XB_SPIN(cond, bar) do { unsigned _sp = 0; while (cond) { __builtin_amdgcn_s_sleep(1); \
    if ((++_sp & 255u) == 0u) { if (xb_ld(&(bar)[XB_TMO])) break; if (_sp > XB_SPIN_CAP) { atomicAdd(&(bar)[XB_TMO], 1u); break; } } } } while (0)
struct XcdBarrier { unsigned* bar; unsigned x; volatile LAS unsigned* st; };
__device__ __forceinline__ XcdBarrier xcd_barrier_post(unsigned* bar, volatile LAS unsigned* st) {
    XcdBarrier b; b.bar = bar; b.x = xb_xcc_id(); b.st = st;
    if (threadIdx.x == 0) (void)xb_add(&bar[XB_XCNT(b.x)], 1u);
    return b;
}
__device__ __forceinline__ void xcd_barrier_complete(unsigned* bar, unsigned x, unsigned& nloc, unsigned& nx, unsigned& xmask) {
    const unsigned G = gridDim.x * gridDim.y * gridDim.z;
    unsigned sum, cnt, mine, msk, sp = 0u;
    for (;;) {
        sum = 0u; cnt = 0u; mine = 0u; msk = 0u;
#pragma unroll
        for (unsigned j = 0; j < 16; ++j) { const unsigned c = xb_ld(&bar[XB_XCNT(j)]); sum += c; cnt += (c > 0u) ? 1u : 0u; msk |= (c > 0u) ? (1u << j) : 0u; mine = (j == x) ? c : mine; }
        if (sum == G) break;
        __builtin_amdgcn_s_sleep(1);
        if ((++sp & 255u) == 0u) { if (xb_ld(&bar[XB_TMO])) break; if (sp > XB_SPIN_CAP) { atomicAdd(&bar[XB_TMO], 1u); break; } }
    }
    nloc = mine > 0u ? mine : 1u; nx = cnt > 0u ? cnt : 1u; xmask = msk;
}
__device__ __forceinline__ void xcd_barrier(const XcdBarrier& b) {
    asm volatile("s_waitcnt vmcnt(0)" ::: "memory");
    __syncthreads();
    if (threadIdx.x == 0) {
        unsigned* bar = b.bar;
        __builtin_amdgcn_s_waitcnt(0);
        unsigned nloc = b.st[0], nx = b.st[1], xmask = b.st[9];
        if (nloc == 0u) { xcd_barrier_complete(bar, b.x, nloc, nx, xmask); b.st[0] = nloc; b.st[1] = nx; b.st[9] = xmask; }
        const unsigned old = xb_add(&bar[XB_XSUB(b.x)], 1u);
        const unsigned gen = old / nloc;
        if (old + 1u == (gen + 1u) * nloc) {
            __builtin_amdgcn_fence(__ATOMIC_RELEASE, "agent");
            asm volatile("s_waitcnt vmcnt(0)" ::: "memory");
            const unsigned og = xb_add(&bar[XB_TOP], 1u);
            const unsigned tg = og / nx;
            if (og + 1u == (tg + 1u) * nx) {
#pragma unroll
                for (unsigned j = 0; j < 16; ++j) if (xmask & (1u << j)) (void)xb_add(&bar[XB_XGEN(j)], 1u);
            }
        }
        XB_SPIN(xb_ld(&bar[XB_XGEN(b.x)]) == gen, bar);
        __builtin_amdgcn_fence(__ATOMIC_ACQUIRE, "agent");
        asm volatile("s_waitcnt vmcnt(0)" ::: "memory");
    }
    __syncthreads();
}

__device__ __forceinline__ void split_arrive(unsigned* bar, unsigned x, volatile LAS unsigned* st, int wave_u, int lane) {
    asm volatile("s_waitcnt vmcnt(0)" ::: "memory");
    __syncthreads();
    if (wave_u == 0) {
        const unsigned nloc = __builtin_amdgcn_readfirstlane(st[0]), nx = __builtin_amdgcn_readfirstlane(st[1]), xmask = __builtin_amdgcn_readfirstlane(st[9]);
        const unsigned old = __builtin_amdgcn_readfirstlane(xb_add(&bar[XB_XSUB(x)], lane == 0 ? 1u : 0u));
        if (old + 1u == nloc) {
            __builtin_amdgcn_fence(__ATOMIC_RELEASE, "agent");
            asm volatile("s_waitcnt vmcnt(0)" ::: "memory");
            const unsigned og = __builtin_amdgcn_readfirstlane(xb_add(&bar[XB_TOP], lane == 0 ? 1u : 0u));
            if (og + 1u == nx) {
#pragma unroll
                for (unsigned j = 0; j < 16; ++j) if (xmask & (1u << j)) (void)xb_add(&bar[XB_XGEN(j)], lane == 0 ? 1u : 0u);
            }
        }
    }
}
__device__ __forceinline__ void split_wait(unsigned* bar, unsigned x, int wave_u) {
    if (wave_u == 0) {
        XB_SPIN(__builtin_amdgcn_readfirstlane(xb_ld(&bar[XB_XGEN(x)])) == 0u, bar);
        __builtin_amdgcn_fence(__ATOMIC_ACQUIRE, "agent");
        asm volatile("s_waitcnt vmcnt(0)" ::: "memory");
    }
    __syncthreads();
}

__device__ __forceinline__ void hand_release() { asm volatile("s_waitcnt vmcnt(0)" ::: "memory"); __builtin_amdgcn_fence(__ATOMIC_RELEASE, "agent"); asm volatile("s_waitcnt vmcnt(0)" ::: "memory"); }
__device__ __forceinline__ void hand_acquire() { __builtin_amdgcn_fence(__ATOMIC_ACQUIRE, "agent"); asm volatile("s_waitcnt vmcnt(0)" ::: "memory"); }

__global__ void __launch_bounds__(256, 2) mega(Params P) {
    extern __shared__ __attribute__((aligned(16))) unsigned char smem[];
    const int tid = threadIdx.x, lane = tid & 63, wave = tid >> 6;
    const int G = gridDim.x, bid = blockIdx.x;
    unsigned* ctl = (unsigned*)(P.ws + WS_CTL);
    volatile LAS unsigned* bst = (volatile LAS unsigned*)(smem + 65552);
    if (tid == 0) { bst[0] = 0u; bst[1] = 0u; }
    __syncthreads();
    const XcdBarrier xb = xcd_barrier_post(ctl + 1024, bst);
    unsigned* cucnt = ctl + 5120;
    if (tid == 0) {
        const unsigned phys = ((xb_xcc_id() & 7u) << 8) | ((unsigned)__builtin_amdgcn_s_getreg((7 << 11) | (8 << 6) | 4) & 0xFFu);
        bst[2] = phys; bst[3] = xb_add(&cucnt[phys], 1u);
    }
    phase0(P, smem);
    xcd_barrier(xb);
    {
        int vb;
        const unsigned phys = bst[2];
        unsigned part = 0;
#pragma unroll
        for (int q = 0; q < 8; ++q) { const unsigned i = (unsigned)(tid + 256 * q); const unsigned c = xb_ld(&cucnt[i]); part += (i < phys) ? c : 0u; }
#pragma unroll
        for (int o = 1; o < 64; o <<= 1) part += (unsigned)__shfl_xor((int)part, o, 64);
        if (lane == 0) bst[4 + wave] = part;
        __syncthreads();
        vb = (int)(bst[4] + bst[5] + bst[6] + bst[7] + bst[3]);
        vb = __builtin_amdgcn_readfirstlane(vb);
        if (vb < 0 || vb >= G) vb = bid;
        __syncthreads();
        if (tid == 0) bst[8] = (unsigned)vb;
        __syncthreads();
    }
#define VB_LOAD() __builtin_amdgcn_readfirstlane((int)bst[8])
    {
        const int vb = VB_LOAD();
        {
            const int fb = (G >= 64) ? vb - (G - 16) : bid;
            if (fb >= 0 && fb < 16) fox_cum_wave(P, fb * 4 + wave, lane);
        }
        constexpr int NT1 = 129 * 28;
        const int full = (NT1 / G) * G, rem = NT1 - full;
#define P1_TILE(TILE) { const int tile_ = (TILE); const int sr = tile_ / 224, within = tile_ - sr * 224, nrows = (129 - 8 * sr) < 8 ? (129 - 8 * sr) : 8; \
                        const int tn = within / nrows, tm = 8 * sr + (within - tn * nrows); gemm_tile<1>(P, tm, tn, smem); }
        for (int tile = vb; tile < full; tile += G) P1_TILE(tile)
        if (G == 512 && rem > 0 && rem <= 28) {
            const int q = vb / 18, isT = (vb - 18 * q == 0) && q < rem;
            if (isT) P1_TILE(full + q)
            else if (vb < G - 16) { const int below = (q + 1 < rem) ? q + 1 : rem; convert_uv_rows(P, (vb - below) * 4 + wave, (G - 16 - rem) * 4, lane, 0, CONV_P1_ROWS); }
        } else {
            if (vb < rem) P1_TILE(full + vb)
            else convert_uv_rows(P, (vb - rem) * 4 + wave, (G - rem) * 4, lane, 0, CONV_P1_ROWS);
        }
#undef P1_TILE
    }
    xcd_barrier(xb);
    {
        volatile int* s_item = (volatile int*)(smem + 65536);
        const int wave_u = __builtin_amdgcn_readfirstlane(wave);
        auto fetch = [&](unsigned* counter) -> int {
            if (wave_u == 0) {
                unsigned v = atomicAdd(counter, lane == 0 ? 1u : 0u);
                *s_item = (int)__builtin_amdgcn_readfirstlane(v);
            }
            __syncthreads();
            const int item = __builtin_amdgcn_readfirstlane(*s_item);
            __syncthreads();
            return item;
        };
        constexpr int N_A = 33 * 32, N_V = 128, N_B = 288, N_H = 896, N_C = 33 * 32, N_ATT = 64 * 17;
        constexpr int T_V = N_A, T_B = T_V + N_V, T_H = T_B + N_B, T_C = T_H + N_H, T_L = T_C + N_C, T_END = T_L + (N_ATT - N_H);
        unsigned* barA = ctl + 8192; unsigned* barB = ctl + 8192 + XCD_BAR_WORDS;
        bool arrA = false, arrB = false, passA = false, passB = false;
        int item = bid;
        while (item < T_END) {
            unsigned nxt_ = 0u;
            if (wave_u == 0) nxt_ = atomicAdd(&ctl[2], lane == 0 ? 1u : 0u);
            if (item >= T_V && !arrA) { split_arrive(barA, xb.x, bst, wave_u, lane); arrA = true; }
            if (item >= T_H && !arrB) { split_arrive(barB, xb.x, bst, wave_u, lane); arrB = true; }
            if (item < T_V) mlstm_A(P, item, smem);
            else if (item < T_B) convert_uv_rows(P, (item - T_V) * 4 + wave, N_V * 4, lane, CONV_P1_ROWS, 2 * 16384);
            else if (item < T_H) { if (!passA) { split_wait(barA, xb.x, wave_u); passA = true; } mlstm_B(P, item - T_B); }
            else if (item < T_C) { const int ai = item - T_H; attn_block(P, ai & 63, 16 - (ai >> 6), smem); }
            else if (item < T_L) { if (!passB) { split_wait(barB, xb.x, wave_u); passB = true; } mlstm_C(P, item - T_C, smem); }
            else { const int ai = item - T_L + N_H; attn_block(P, ai & 63, 16 - (ai >> 6), smem); }
            if (wave_u == 0) *s_item = (int)__builtin_amdgcn_readfirstlane(nxt_) + G;
            __syncthreads();
            item = __builtin_amdgcn_readfirstlane(*s_item);
            __syncthreads();
        }
        if (!arrA) split_arrive(barA, xb.x, bst, wave_u, lane);
        if (!arrB) split_arrive(barB, xb.x, bst, wave_u, lane);
    }
    xcd_barrier(xb);
    for (int tile = VB_LOAD(); tile < 128 * 8; tile += G) gemm_tile<2>(P, tile >> 3, tile & 7, smem);
    xcd_barrier(xb);
    for (int tile = VB_LOAD(); tile < 128 * 16; tile += G) gemm_tile<3>(P, (tile >> 7) * 8 + (tile & 7), (tile >> 3) & 15, smem);
    xcd_barrier(xb);
    {
        unsigned* szero = (unsigned*)(smem + 40960);
        if (tid < 16) szero[tid] = 0u;
        __syncthreads();
        unsigned char* res = smem + wave * 10240; unsigned char* work = res + 8192;
        int* sidx = (int*)work; float* sval = (float*)(work + 1024);
        int lane5 = lane;
        asm volatile("" : "+v"(lane5));
        const int tstride = G * 4;
        for (int tb = bid * 4 + wave; tb < T2; tb += tstride * 8) {
            peer_stage2_batch(P, tb, tstride, lane5, res, work);
#pragma unroll 1
            for (int tau = 0; tau < 8; ++tau) {
                const int t = tb + tau * tstride;
                if (t < T2) peer_token(P, t, lane5, sidx, sval, (const int*)(res + tau * 1024), (const float*)(res + tau * 1024 + 512), szero);
            }
        }
    }
}

}

extern "C" void kernel_launch(void* const* d_in, const int* in_sizes, int n_in, void* d_out, int out_size, void* d_ws, size_t ws_size, hipStream_t stream) {
    if (n_in != 17 || ws_size < WS_END) { fprintf(stderr, "kernel_launch: unexpected n_in %d or ws_size %zu (need %zu)\n", n_in, ws_size, (size_t)WS_END); return; }
    constexpr int LDS_BYTES = 66560;
    static int grid_blocks = 0;
    if (!grid_blocks) {
        int dev = 0, cus = 0, per_cu = 0;
        (void)hipGetDevice(&dev);
        (void)hipDeviceGetAttribute(&cus, hipDeviceAttributeMultiprocessorCount, dev);
        (void)hipFuncSetAttribute((const void*)mega, hipFuncAttributeMaxDynamicSharedMemorySize, LDS_BYTES);
        (void)hipOccupancyMaxActiveBlocksPerMultiprocessor(&per_cu, (const void*)mega, 256, LDS_BYTES);
        if (per_cu < 1) per_cu = 1;
        if (per_cu > 2) per_cu = 2;
        grid_blocks = cus * per_cu;
        fprintf(stderr, "kernel_launch: cus %d per_cu %d grid %d\n", cus, per_cu, grid_blocks);
    }
    Params P{};
    P.x = (const float*)d_in[0]; P.meta = (const float*)d_in[1]; P.norm_mix = (const float*)d_in[2]; P.w_in = (const float*)d_in[3];
    P.conv_qk = (const float*)d_in[4]; P.b_igate = (const float*)d_in[5]; P.b_fgate_m = (const float*)d_in[6]; P.m_out_norm = (const float*)d_in[7];
    P.b_fgate_f = (const float*)d_in[8]; P.f_q_norm = (const float*)d_in[9]; P.f_k_norm = (const float*)d_in[10]; P.w_out = (const float*)d_in[11];
    P.norm_ffn = (const float*)d_in[12]; P.peer_query = (const float*)d_in[13]; P.peer_keys = (const float*)d_in[14]; P.peer_u = (const float*)d_in[15];
    P.peer_v = (const float*)d_in[16]; P.out = (float*)d_out; P.ws = (unsigned char*)d_ws;
    (void)hipMemsetAsync((unsigned char*)d_ws + WS_CTL, 0, 65536, stream);
    void* args[] = {&P};
    hipError_t e = hipLaunchCooperativeKernel((const void*)mega, dim3(grid_blocks), dim3(256), args, LDS_BYTES, stream);
    if (e != hipSuccess) fprintf(stderr, "cooperative launch failed: %s (grid %d)\n", hipGetErrorString(e), grid_blocks);
}
```
